# Optimizing an MI355X kernel written in HIP

```python
import math
import jax, jax.numpy as jnp
from jax import lax
import numpy as np

D_MODEL = 1024
BATCH = 8
SEQ = 4096
DEPTH = 2

HEAD_DIM = 64
ATTN_HEADS = 8
ATTN_WIDTH = ATTN_HEADS * HEAD_DIM
DILATED_PATTERNS = ((128, 1), (512, 4), (2048, 16))
ATTN_BLOCK = 128
ROPE_THETA = 10000.0

SSD_HEADS = 8
SSD_HEAD_DIM = 64
SSD_WIDTH = SSD_HEADS * SSD_HEAD_DIM
SSD_GROUPS = 2
SSD_STATE = 128
SSD_CONV = 4
SSD_CHUNK = 128
SSD_CONV_DIM = SSD_WIDTH + 2 * SSD_GROUPS * SSD_STATE

SC_WIDTH = 512
SC_CONV = 3

MIX_WIDTH = ATTN_WIDTH + SSD_WIDTH + SC_WIDTH
IN_SPLITS = (ATTN_WIDTH, ATTN_WIDTH, ATTN_WIDTH,
             SSD_WIDTH, SSD_WIDTH, SSD_GROUPS * SSD_STATE, SSD_GROUPS * SSD_STATE, SSD_HEADS,
             SC_WIDTH, SC_WIDTH, SC_WIDTH)
IN_WIDTH = sum(IN_SPLITS)

N_EXPERTS = 32
TOP_K = 4
EXPERT_FF = D_MODEL
SWIGLU_ALPHA = 1.702
SWIGLU_LIMIT = 7.0
MOE_BLOCK = 128

ALPHA = (2.0 * DEPTH) ** 0.25
BETA = (8.0 * DEPTH) ** -0.25
LN_EPS = 1e-5
RMS_EPS = 1e-5

kernel_name = "hybrid_dilated_ssd_shortconv_moe_deepnorm"


def layer_norm(x, g, b):
    xf = x.astype(jnp.float32)
    mu = jnp.mean(xf, -1, keepdims=True)
    var = jnp.mean(jnp.square(xf - mu), -1, keepdims=True)
    return ((xf - mu) * lax.rsqrt(var + LN_EPS) * g + b).astype(x.dtype)


def rotary(x, pos):
    half = x.shape[-1] // 2
    inv = ROPE_THETA ** (-jnp.arange(half, dtype=jnp.float32) / half)
    ang = pos.astype(jnp.float32)[:, None] * inv[None, :]
    cos = jnp.cos(ang)[None, :, None, :]
    sin = jnp.sin(ang)[None, :, None, :]
    x1, x2 = x[..., :half], x[..., half:]
    return jnp.concatenate([x1 * cos - x2 * sin, x2 * cos + x1 * sin], -1).astype(x.dtype)


def causal_depthwise_conv(x, w):
    width = w.shape[0]
    return lax.conv_general_dilated(
        x, w.astype(x.dtype)[:, None, :], window_strides=(1,), padding=[(width - 1, 0)],
        dimension_numbers=("NWC", "WIO", "NWC"), feature_group_count=x.shape[-1])


def dilated_window_attention(q, k, v, dilation, span):
    B, S, H, hd = q.shape
    L = S // dilation
    nb = L // ATTN_BLOCK

    def strided(t):
        return (t.reshape(B, L, dilation, H, hd).transpose(0, 2, 1, 3, 4)
                .reshape(B * dilation, nb, ATTN_BLOCK, H, hd))

    def with_prev(t):
        prev = jnp.pad(t[:, :-1], ((0, 0), (1, 0), (0, 0), (0, 0), (0, 0)))
        return jnp.concatenate([prev, t], axis=2)

    qb = strided(q)
    kk = with_prev(strided(k))
    vv = with_prev(strided(v))
    s = jnp.einsum("bnqhd,bnkhd->bnhqk", qb, kk).astype(jnp.float32) * (hd ** -0.5)
    qi = jnp.arange(ATTN_BLOCK)[:, None]
    kj = jnp.arange(2 * ATTN_BLOCK)[None, :]
    dist = qi + ATTN_BLOCK - kj
    band = (dist >= 0) & (dist <= span)
    has_prev = (jnp.arange(nb)[:, None, None] > 0) | (kj >= ATTN_BLOCK)[None]
    valid = band[None] & has_prev
    s = jnp.where(valid[None, :, None], s, -jnp.inf)
    m = jnp.max(s, -1, keepdims=True)
    p = jnp.exp(s - m)
    l = jnp.sum(p, -1, keepdims=True)
    o = jnp.einsum("bnhqk,bnkhd->bnqhd", p, vv.astype(jnp.float32)) / l.transpose(0, 1, 3, 2, 4)
    lse = (m + jnp.log(l))[..., 0].transpose(0, 1, 3, 2)
    o = o.reshape(B, dilation, L, H, hd).transpose(0, 2, 1, 3, 4).reshape(B, S, H, hd)
    lse = lse.reshape(B, dilation, L, H).transpose(0, 2, 1, 3).reshape(B, S, H)
    return o, lse


def dilated_mixture_attention(q, k, v):
    B, S, H, hd = q.shape
    mult = ATTN_BLOCK * max(d for _, d in DILATED_PATTERNS)
    s_pad = -(-S // mult) * mult
    padw = ((0, 0), (0, s_pad - S), (0, 0), (0, 0))
    qp, kp, vp = jnp.pad(q, padw), jnp.pad(k, padw), jnp.pad(v, padw)
    outs, lses = [], []
    for window, dilation in DILATED_PATTERNS:
        o, lse = dilated_window_attention(qp, kp, vp, dilation, window // dilation)
        outs.append(o)
        lses.append(lse)
    w = jax.nn.softmax(jnp.stack(lses, 0), axis=0)
    o = jnp.sum(w[..., None] * jnp.stack(outs, 0), axis=0)
    return o[:, :S].astype(q.dtype)


def ssd_chunked(x, dt, a, bm, cm):
    B, S, H, P = x.shape
    N = bm.shape[-1]
    nc = S // SSD_CHUNK
    X = (x * dt[..., None]).reshape(B, nc, SSD_CHUNK, H, P)
    A = (dt * a).reshape(B, nc, SSD_CHUNK, H).transpose(0, 3, 1, 2)
    Bc = bm.reshape(B, nc, SSD_CHUNK, H, N)
    Cc = cm.reshape(B, nc, SSD_CHUNK, H, N)
    a_cum = jnp.cumsum(A, axis=-1)
    seg = a_cum[..., :, None] - a_cum[..., None, :]
    causal = jnp.tril(jnp.ones((SSD_CHUNK, SSD_CHUNK), dtype=bool))
    Lmat = jnp.exp(jnp.where(causal, seg, -jnp.inf))
    scores = jnp.einsum("bclhn,bcshn->bhcls", Cc, Bc) * Lmat
    y_diag = jnp.einsum("bhcls,bcshp->bclhp", scores, X)
    decay_states = jnp.exp(a_cum[..., -1:] - a_cum)
    states = jnp.einsum("bclhn,bhcl,bclhp->bchpn", Bc, decay_states, X)
    chunk_decay = jnp.exp(a_cum[..., -1])

    def step(h, inp):
        st, dec = inp
        return h * dec[..., None, None] + st, h

    h0 = jnp.zeros((B, H, P, N), jnp.float32)
    _, h_in = lax.scan(step, h0, (states.transpose(1, 0, 2, 3, 4), chunk_decay.transpose(2, 0, 1)))
    h_in = h_in.transpose(1, 0, 2, 3, 4)
    y_off = jnp.einsum("bclhn,bchpn,bhcl->bclhp", Cc, h_in, jnp.exp(a_cum))
    return (y_diag + y_off).reshape(B, S, H, P)


def mamba2_mixer(z, xs, bs, cs, dt_raw, conv_w, conv_b, dt_bias, a_log, d_skip, norm_g):
    B, S, _ = xs.shape
    xbc = causal_depthwise_conv(jnp.concatenate([xs, bs, cs], -1), conv_w) + conv_b.astype(xs.dtype)
    xbc = jax.nn.silu(xbc.astype(jnp.float32))
    gn = SSD_GROUPS * SSD_STATE
    xh = xbc[..., :SSD_WIDTH].reshape(B, S, SSD_HEADS, SSD_HEAD_DIM)
    rep = SSD_HEADS // SSD_GROUPS
    bm = jnp.repeat(xbc[..., SSD_WIDTH:SSD_WIDTH + gn].reshape(B, S, SSD_GROUPS, SSD_STATE), rep, axis=2)
    cm = jnp.repeat(xbc[..., SSD_WIDTH + gn:].reshape(B, S, SSD_GROUPS, SSD_STATE), rep, axis=2)
    dt = jax.nn.softplus(dt_raw.astype(jnp.float32) + dt_bias.astype(jnp.float32))
    a = -jnp.exp(a_log.astype(jnp.float32))
    y = ssd_chunked(xh, dt, a, bm, cm) + d_skip.astype(jnp.float32)[:, None] * xh
    y = y.reshape(B, S, SSD_WIDTH) * jax.nn.silu(z.astype(jnp.float32))
    yg = y.reshape(B, S, SSD_GROUPS, SSD_WIDTH // SSD_GROUPS)
    yg = yg * lax.rsqrt(jnp.mean(jnp.square(yg), -1, keepdims=True) + RMS_EPS)
    return (yg.reshape(B, S, SSD_WIDTH) * norm_g).astype(xs.dtype)


def short_gated_conv(b_gate, c_gate, h, conv_w):
    return b_gate * causal_depthwise_conv(c_gate * h, conv_w)


def mixing_sublayer(x, w_in, ssd_conv_w, ssd_conv_b, ssd_dt_bias, ssd_a_log, ssd_d, ssd_norm_g,
                    sc_conv_w, w_out):
    B, S, _ = x.shape
    proj = x @ w_in.astype(x.dtype)
    cuts = np.cumsum(IN_SPLITS)[:-1].tolist()
    q, k, v, z, xs, bs, cs, dt_raw, sb, sc, sh = jnp.split(proj, cuts, axis=-1)
    pos = jnp.arange(S)
    q = rotary(q.reshape(B, S, ATTN_HEADS, HEAD_DIM), pos)
    k = rotary(k.reshape(B, S, ATTN_HEADS, HEAD_DIM), pos)
    v = v.reshape(B, S, ATTN_HEADS, HEAD_DIM)
    attn = dilated_mixture_attention(q, k, v).reshape(B, S, ATTN_WIDTH)
    ssd = mamba2_mixer(z, xs, bs, cs, dt_raw, ssd_conv_w, ssd_conv_b, ssd_dt_bias, ssd_a_log,
                       ssd_d, ssd_norm_g)
    conv = short_gated_conv(sb, sc, sh, sc_conv_w)
    mixed = jnp.concatenate([attn.astype(x.dtype), ssd, conv.astype(x.dtype)], -1)
    return mixed @ w_out.astype(x.dtype)


def moe_sublayer(x, router_w, router_b, w_gu, b_gu, w_down, b_down):
    Bsz, S, D = x.shape
    N = Bsz * S
    xt = x.reshape(N, D)
    logits = (xt @ router_w.astype(x.dtype) + router_b.astype(x.dtype)).astype(jnp.float32)
    top_val, top_idx = lax.top_k(logits, TOP_K)
    gates = jax.nn.softmax(top_val, axis=-1)
    e_flat = top_idx.reshape(-1).astype(jnp.int32)
    tok_flat = jnp.arange(N * TOP_K, dtype=jnp.int32) // TOP_K
    g_flat = gates.reshape(-1)
    order = jnp.argsort(e_flat)
    e_sorted = e_flat[order]
    counts = jnp.zeros((N_EXPERTS,), jnp.int32).at[e_flat].add(1)
    padded = (counts + MOE_BLOCK - 1) // MOE_BLOCK * MOE_BLOCK
    start = jnp.cumsum(counts) - counts
    pend = jnp.cumsum(padded)
    pstart = pend - padded
    dest = pstart[e_sorted] + (jnp.arange(N * TOP_K, dtype=jnp.int32) - start[e_sorted])
    P = N * TOP_K + N_EXPERTS * MOE_BLOCK
    nblk = P // MOE_BLOCK
    buf_tok = jnp.full((P,), N, jnp.int32).at[dest].set(tok_flat[order])
    buf_gate = jnp.zeros((P,), jnp.float32).at[dest].set(g_flat[order])
    blk_expert = jnp.minimum(
        jnp.searchsorted(pend, jnp.arange(nblk, dtype=jnp.int32) * MOE_BLOCK, side="right"),
        N_EXPERTS - 1).astype(jnp.int32)
    x_pad = jnp.concatenate([xt, jnp.zeros((1, D), xt.dtype)], 0)

    def expert_block(args):
        tok, e = args
        xb = x_pad[tok]
        gu = xb @ w_gu[e].astype(xb.dtype) + b_gu[e].astype(xb.dtype)
        gate = jnp.minimum(gu[:, :EXPERT_FF], SWIGLU_LIMIT)
        up = jnp.clip(gu[:, EXPERT_FF:], -SWIGLU_LIMIT, SWIGLU_LIMIT)
        h = (up + 1.0) * gate * jax.nn.sigmoid(SWIGLU_ALPHA * gate)
        return h @ w_down[e].astype(xb.dtype) + b_down[e].astype(xb.dtype)

    y = lax.map(expert_block, (buf_tok.reshape(nblk, MOE_BLOCK), blk_expert))
    y = y.reshape(P, D) * buf_gate[:, None].astype(x.dtype)
    out = jnp.zeros((N + 1, D), x.dtype).at[buf_tok].add(y)
    return out[:N].reshape(Bsz, S, D)


def setup_inputs(seed: int = 0) -> dict:
    key = jax.random.key(seed)
    ks = jax.random.split(key, 20)
    f32 = jnp.float32
    L = DEPTH

    def nrm(k, shape, scale):
        return jax.random.normal(k, shape, f32) * scale

    x = nrm(ks[0], (BATCH, SEQ, D_MODEL), 1.0)
    w_in = nrm(ks[1], (L, D_MODEL, IN_WIDTH), D_MODEL ** -0.5)
    w_in = w_in.at[:, :, 2 * ATTN_WIDTH:3 * ATTN_WIDTH].multiply(BETA)
    ssd_conv_w = nrm(ks[2], (L, SSD_CONV, SSD_CONV_DIM), SSD_CONV ** -0.5)
    ssd_conv_b = nrm(ks[3], (L, SSD_CONV_DIM), 0.02)
    dt0 = jnp.exp(jax.random.uniform(ks[4], (L, SSD_HEADS), f32, math.log(1e-3), math.log(1e-1)))
    ssd_dt_bias = dt0 + jnp.log(-jnp.expm1(-dt0))
    ssd_a_log = jnp.log(jax.random.uniform(ks[5], (L, SSD_HEADS), f32, 1.0, 16.0))
    ssd_d = 1.0 + nrm(ks[6], (L, SSD_HEADS), 0.1)
    ssd_norm_g = 1.0 + nrm(ks[7], (L, SSD_WIDTH), 0.05)
    sc_conv_w = nrm(ks[8], (L, SC_CONV, SC_WIDTH), SC_CONV ** -0.5)
    w_out = nrm(ks[9], (L, MIX_WIDTH, D_MODEL), MIX_WIDTH ** -0.5 * BETA)
    ln1_g = 1.0 + nrm(ks[10], (L, D_MODEL), 0.05)
    ln1_b = nrm(ks[11], (L, D_MODEL), 0.02)
    router_w = nrm(ks[12], (L, D_MODEL, N_EXPERTS), D_MODEL ** -0.5)
    router_b = nrm(ks[13], (L, N_EXPERTS), 0.01)
    exp_w_gu = nrm(ks[14], (L, N_EXPERTS, D_MODEL, 2 * EXPERT_FF), D_MODEL ** -0.5)
    exp_b_gu = nrm(ks[15], (L, N_EXPERTS, 2 * EXPERT_FF), 0.01)
    exp_w_down = nrm(ks[16], (L, N_EXPERTS, EXPERT_FF, D_MODEL), EXPERT_FF ** -0.5 * BETA)
    exp_b_down = nrm(ks[17], (L, N_EXPERTS, D_MODEL), 0.01)
    ln2_g = 1.0 + nrm(ks[18], (L, D_MODEL), 0.05)
    ln2_b = nrm(ks[19], (L, D_MODEL), 0.02)
    return {"x": x, "w_in": w_in, "ssd_conv_w": ssd_conv_w, "ssd_conv_b": ssd_conv_b,
            "ssd_dt_bias": ssd_dt_bias, "ssd_a_log": ssd_a_log, "ssd_d": ssd_d,
            "ssd_norm_g": ssd_norm_g, "sc_conv_w": sc_conv_w, "w_out": w_out,
            "ln1_g": ln1_g, "ln1_b": ln1_b, "router_w": router_w, "router_b": router_b,
            "exp_w_gu": exp_w_gu, "exp_b_gu": exp_b_gu, "exp_w_down": exp_w_down,
            "exp_b_down": exp_b_down, "ln2_g": ln2_g, "ln2_b": ln2_b}


def reference(x, w_in, ssd_conv_w, ssd_conv_b, ssd_dt_bias, ssd_a_log, ssd_d, ssd_norm_g,
              sc_conv_w, w_out, ln1_g, ln1_b, router_w, router_b, exp_w_gu, exp_b_gu,
              exp_w_down, exp_b_down, ln2_g, ln2_b):
    for layer in range(DEPTH):
        mix = mixing_sublayer(x, w_in[layer], ssd_conv_w[layer], ssd_conv_b[layer],
                              ssd_dt_bias[layer], ssd_a_log[layer], ssd_d[layer],
                              ssd_norm_g[layer], sc_conv_w[layer], w_out[layer])
        x = layer_norm(ALPHA * x + mix, ln1_g[layer], ln1_b[layer])
        ffn = moe_sublayer(x, router_w[layer], router_b[layer], exp_w_gu[layer], exp_b_gu[layer],
                           exp_w_down[layer], exp_b_down[layer])
        x = layer_norm(ALPHA * x + ffn, ln2_g[layer], ln2_b[layer])
    return x
```

```cpp
#include <hip/hip_runtime.h>
#include <cstdio>
#include <cstdint>
#include <cmath>

namespace pg8 {
#define PG8_LAS __attribute__((address_space(3)))
typedef unsigned short bf16_t;
typedef short bf16x8 __attribute__((ext_vector_type(8)));
typedef float f32x4 __attribute__((ext_vector_type(4)));
typedef float f32x2 __attribute__((ext_vector_type(2)));
typedef unsigned u32x4 __attribute__((ext_vector_type(4)));
constexpr int BM = 256, BK = 64, HALF = 128, HTB = HALF * BK * 2  , STAGE_BYTES = 8 * HTB, NXCD = 8, WGM = 8;

__host__ __device__ __forceinline__ int lds_byte(int r, int c) { const int st = (r >> 4) * 2 + (c >> 5), rr = r & 15, cc = c & 31, ob = rr * 64 + cc * 2; return st * 1024 + (ob ^ (((ob >> 9) & 1) << 5)); }
__host__ __device__ __forceinline__ void stage_rc(int b, int& R, int& C) { const int st = b / 1024, sb = b % 1024, swz = sb ^ (((sb >> 9) & 1) << 5); R = (st >> 1) * 16 + swz / 64; C = (st & 1) * 32 + (swz % 64) / 2; }
__host__ __device__ __forceinline__ int perm32(int rho) { const int n = rho >> 4, i = rho & 15; return 8 * (i >> 2) + 4 * n + (i & 3); }

struct Unit { int pm, pn, e, r0; };
struct Gemm { const bf16_t* A; const bf16_t* Bt; int M, N, K; };

struct StaticOrder {
    int nM, nN, nwg, G, c;
    __device__ void init(int M, int N, int G_, int c_) { nM = M / BM; nN = N / BM; nwg = nM * nN; G = G_; c = c_; }
    __device__ __forceinline__ bool next(int i, Unit& u) const {
        const long L = (long)i * G + c; if (L >= nwg) return false;
        int wgid = (int)L; { const int q = nwg / NXCD, r = nwg % NXCD, xcd = wgid % NXCD, off = wgid / NXCD; wgid = (xcd < r ? xcd * (q + 1) : r * (q + 1) + (xcd - r) * q) + off; }
        const int nig = WGM * nN, gid = wgid / nig, fm = gid * WGM, gsz = (nM - fm) < WGM ? (nM - fm) : WGM;
        u.pm = fm + ((wgid % nig) % gsz); u.pn = (wgid % nig) / gsz; u.e = 0; u.r0 = 0; return true;
    }
    __device__ __forceinline__ const char* abase(const Unit& u, const Gemm& g, size_t tstep) const { return (const char*)g.A + (size_t)u.pm * tstep; }
    __device__ __forceinline__ const char* bbase(const Unit& u, const Gemm& g, size_t tstep) const { return (const char*)g.Bt + (size_t)u.pn * tstep; }
    __device__ __forceinline__ unsigned arow(const Unit&, int) const { return 0u; }
    __device__ __forceinline__ void a_ready(const Unit&) const {}
    __device__ __forceinline__ void done(const Unit&) const {}
};

struct MoeOrder {
    const PG8_LAS int* units;
    int nunits;
    const PG8_LAS int* cnt;
    const int* rowtok;
    int gather;
    size_t bstride;
    __device__ __forceinline__ bool next(int i, Unit& u) const {
        if (i >= nunits) return false;
        u.pm = __builtin_amdgcn_readfirstlane(units[4 * i + 0]); u.pn = __builtin_amdgcn_readfirstlane(units[4 * i + 1]);
        u.e = __builtin_amdgcn_readfirstlane(units[4 * i + 2]); u.r0 = __builtin_amdgcn_readfirstlane(units[4 * i + 3]); return true;
    }
    __device__ __forceinline__ const char* abase(const Unit& u, const Gemm& g, size_t tstep) const { return gather ? (const char*)g.A : (const char*)g.A + (size_t)u.pm * tstep; }
    __device__ __forceinline__ const char* bbase(const Unit& u, const Gemm& g, size_t tstep) const { return (const char*)g.Bt + (size_t)u.e * bstride + (size_t)u.pn * tstep; }
    __device__ __forceinline__ unsigned arow(const Unit& u, int R) const {
        const int r = u.r0 + R; const int idx = (r < cnt[u.e]) ? rowtok[(size_t)u.e * 32768 + r] : 0; return (unsigned)(idx >> 2) * 2048u; }
    __device__ __forceinline__ void a_ready(const Unit&) const {}
    __device__ __forceinline__ void done(const Unit&) const {}
};
__device__ __forceinline__ void moe_build_units(PG8_LAS int* units, PG8_LAS int* units_n, const PG8_LAS int* tstart, int nN, int G, int c, int tid) {
    if (tid < 64) {
        const int nT = tstart[32], nwg = nT * nN; const long L = (long)tid * G + c;
        int pm = 0, pn = 0, e = 0, r0 = 0;
        if (L < nwg) {
            int wgid = (int)L; { const int q = nwg / NXCD, r = nwg % NXCD, xcd = wgid % NXCD, off = wgid / NXCD; wgid = (xcd < r ? xcd * (q + 1) : r * (q + 1) + (xcd - r) * q) + off; }
            const int nig = WGM * nN, gid = wgid / nig, fm = gid * WGM, gsz = (nT - fm) < WGM ? (nT - fm) : WGM;
            pm = fm + ((wgid % nig) % gsz); pn = (wgid % nig) / gsz;
            for (int j = 1; j < 32; ++j) e += (tstart[j] <= pm) ? 1 : 0;
            r0 = (pm - tstart[e]) * 256;
        }
        units[4 * tid + 0] = pm; units[4 * tid + 1] = pn; units[4 * tid + 2] = e; units[4 * tid + 3] = r0;
        if (tid == 0) { int n = 0; if (c < nwg) n = (nwg - c + G - 1) / G; units_n[0] = n < 64 ? n : 64; }
    }
}

__device__ __forceinline__ unsigned cvt_pk_bf16(float lo, float hi) { unsigned r; asm volatile("v_cvt_pk_bf16_f32 %0, %1, %2" : "=v"(r) : "v"(lo), "v"(hi)); return r; }

struct EpiProj {
    static constexpr bool PERM = true, AFTER_DRAIN = false;
    bf16_t* O; int ldc; const float* rope; float qscale;
    __device__ __forceinline__ void operator()(const f32x4 (&acc)[2][2][4][2], const Unit& u, int wr, int wc, int fr, int fq) const {
        const int row0 = u.pm * BM + wr * 64 + fr; const int col0 = u.pn * BM + wc * 32 + 8 * fq;
        const bool rot = u.pn < 4; const float sc = u.pn < 2 ? qscale : 1.f; const int gq = 4 * (wc & 1) + fq;
#pragma unroll
        for (int ai = 0; ai < 2; ++ai)
#pragma unroll
            for (int m = 0; m < 4; ++m) { const int row = row0 + ai * HALF + m * 16; bf16_t* rowp = O + (size_t)row * ldc + col0;
                f32x4 cs0 = (f32x4){1.f, 0.f, 1.f, 0.f}, cs1 = cs0;
                if (rot) { const float* rp = rope + ((size_t)(row & 4095) * 32 + 4 * gq) * 2; cs0 = *(const f32x4*)rp; cs1 = *(const f32x4*)(rp + 4); }
#pragma unroll
                for (int bj = 0; bj < 2; ++bj) { f32x4 v0 = acc[ai][bj][m][0], v1 = acc[ai][bj][m][1];
                    if (rot) { f32x4 lo, hi;
                        lo[0] = v0[0] * cs0[0] - v1[0] * cs0[1]; hi[0] = v1[0] * cs0[0] + v0[0] * cs0[1];
                        lo[1] = v0[1] * cs0[2] - v1[1] * cs0[3]; hi[1] = v1[1] * cs0[2] + v0[1] * cs0[3];
                        lo[2] = v0[2] * cs1[0] - v1[2] * cs1[1]; hi[2] = v1[2] * cs1[0] + v0[2] * cs1[1];
                        lo[3] = v0[3] * cs1[2] - v1[3] * cs1[3]; hi[3] = v1[3] * cs1[2] + v0[3] * cs1[3];
                        v0 = lo * sc; v1 = hi * sc; }
                    u32x4 w; w.x = cvt_pk_bf16(v0[0], v0[1]); w.y = cvt_pk_bf16(v0[2], v0[3]); w.z = cvt_pk_bf16(v1[0], v1[1]); w.w = cvt_pk_bf16(v1[2], v1[3]);
                    *(u32x4*)(rowp + bj * HALF) = w; } }
    }
};
struct EpiF32 {
    static constexpr bool PERM = false, AFTER_DRAIN = false;
    float* O; int ldc;
    __device__ __forceinline__ void operator()(const f32x4 (&acc)[2][2][4][2], const Unit& u, int wr, int wc, int fr, int fq) const {
        const int row0 = u.pm * BM + wr * 64 + fr; const int col0 = u.pn * BM + wc * 32 + 4 * fq;
#pragma unroll
        for (int ai = 0; ai < 2; ++ai)
#pragma unroll
            for (int m = 0; m < 4; ++m) { float* rowp = O + (size_t)(row0 + ai * HALF + m * 16) * ldc + col0;
#pragma unroll
                for (int bj = 0; bj < 2; ++bj)
#pragma unroll
                    for (int n = 0; n < 2; ++n) *(f32x4*)(rowp + bj * HALF + n * 16) = acc[ai][bj][m][n]; }
    }
};
struct EpiSwiglu {
    static constexpr bool PERM = true, AFTER_DRAIN = false;
    bf16_t* H; const float* bgu; const float* rowgate; const PG8_LAS int* cnt;
    __device__ __forceinline__ void operator()(const f32x4 (&acc)[2][2][4][2], const Unit& u, int wr, int wc, int fr, int fq) const {
        const int ff = u.pn * HALF + wc * 32 + 8 * fq; const int n_e = cnt[u.e];
        f32x4 bg[2], bu[2];
#pragma unroll
        for (int n = 0; n < 2; ++n) { bg[n] = *(const f32x4*)(bgu + (size_t)u.e * 2048 + ff + 4 * n); bu[n] = *(const f32x4*)(bgu + (size_t)u.e * 2048 + 1024 + ff + 4 * n); }
#pragma unroll
        for (int ai = 0; ai < 2; ++ai)
#pragma unroll
            for (int m = 0; m < 4; ++m) { const int r = ai * HALF + wr * 64 + m * 16 + fr; const int er = u.r0 + r;
                const float rg = (er < n_e) ? rowgate[(size_t)u.e * 32768 + er] : 0.f;
                float hv[8];
#pragma unroll
                for (int n = 0; n < 2; ++n)
#pragma unroll
                    for (int q = 0; q < 4; ++q) { float g = acc[ai][0][m][n][q] + bg[n][q], up = acc[ai][1][m][n][q] + bu[n][q];
                        g = fminf(g, 7.0f); up = fminf(fmaxf(up, -7.0f), 7.0f);
                        const float sg = __builtin_amdgcn_rcpf(1.0f + __builtin_amdgcn_exp2f(-1.702f * 1.4426950408889634f * g));
                        hv[n * 4 + q] = (up + 1.0f) * g * sg * rg; }
                u32x4 w; w.x = cvt_pk_bf16(hv[0], hv[1]); w.y = cvt_pk_bf16(hv[2], hv[3]); w.z = cvt_pk_bf16(hv[4], hv[5]); w.w = cvt_pk_bf16(hv[6], hv[7]);
                *(u32x4*)(H + (size_t)(u.pm * BM + r) * 1024 + ff) = w; }
    }
};
struct EpiScatter {
    static constexpr bool PERM = true, AFTER_DRAIN = false;
    bf16_t* Y; const int* rowtok; const PG8_LAS int* cnt;
    __device__ __forceinline__ void operator()(const f32x4 (&acc)[2][2][4][2], const Unit& u, int wr, int wc, int fr, int fq) const {
        const int col0 = u.pn * BM + wc * 32 + 8 * fq; const int n_e = cnt[u.e];
#pragma unroll
        for (int ai = 0; ai < 2; ++ai)
#pragma unroll
            for (int m = 0; m < 4; ++m) { const int er = u.r0 + ai * HALF + wr * 64 + m * 16 + fr;
                if (er < n_e) { const int idx = rowtok[(size_t)u.e * 32768 + er]; bf16_t* rowp = Y + (size_t)idx * 1024 + col0;
#pragma unroll
                    for (int bj = 0; bj < 2; ++bj) { const f32x4 v0 = acc[ai][bj][m][0], v1 = acc[ai][bj][m][1];
                        u32x4 w; w.x = cvt_pk_bf16(v0[0], v0[1]); w.y = cvt_pk_bf16(v0[2], v0[3]); w.z = cvt_pk_bf16(v1[0], v1[1]); w.w = cvt_pk_bf16(v1[2], v1[3]);
                        *(u32x4*)(rowp + bj * HALF) = w; } } }
    }
};

template <class Epi, class Sched, bool ALIGN_EPI, bool GATHER>
__device__ __forceinline__ void gemm_phase(PG8_LAS unsigned char* lds, const Gemm g, const Sched& S, const Epi& E) {
    const int tid = threadIdx.x, wid = __builtin_amdgcn_readfirstlane(tid >> 6), lane = tid & 63, wr = wid >> 2, wc = wid & 3, fr = lane & 15, fq = lane >> 4;
    const int K = g.K, nt = K / BK;
    int sR[2], sC2[2]; unsigned voffB[2];
#pragma unroll
    for (int i = 0; i < 2; ++i) { int R, C; stage_rc(tid * 16 + i * 8192, R, C); const int Rb = Epi::PERM ? ((R & ~31) + perm32(R & 31)) : R;
        sR[i] = R; sC2[i] = C * 2; voffB[i] = (unsigned)(Rb * K + C) * 2u; }
    const size_t kstep = (size_t)(BK * 2);
    const size_t hstep = (size_t)HALF * K * 2;
    const size_t tstep = 2 * hstep;
    const unsigned ldsw = (unsigned)wid * 1024u;
    const int aoff = lds_byte(wr * 64 + fr, fq * 8), boff = lds_byte(wc * 32 + fr, fq * 8);
#define PG8_SA(b, h) (((b) * 2 + (h)) * HTB)
#define PG8_SB(b, h) ((4 + (b) * 2 + (h)) * HTB)
#define PG8_STAGE(bufoff, gbase, voff) do { _Pragma("unroll") for (int _i = 0; _i < 2; ++_i) \
        __builtin_amdgcn_global_load_lds((const unsigned*)((const char*)(gbase) + (voff)[_i]), (PG8_LAS unsigned*)(lds + (bufoff) + ldsw + _i * 8192), 16, 0, 0); } while (0)
#define PG8_LDA(dst, b, h) do { _Pragma("unroll") for (int m = 0; m < 4; ++m) _Pragma("unroll") for (int k = 0; k < 2; ++k) dst[m][k] = *(const PG8_LAS bf16x8*)(lds + PG8_SA(b, h) + aoff + m * 2048 + k * 1024); } while (0)
#define PG8_LDB(dst, b, h) do { _Pragma("unroll") for (int n = 0; n < 2; ++n) _Pragma("unroll") for (int k = 0; k < 2; ++k) dst[n][k] = *(const PG8_LAS bf16x8*)(lds + PG8_SB(b, h) + boff + n * 2048 + k * 1024); } while (0)
#define PG8_MMA(ai, bj, At, Bt) do { __builtin_amdgcn_s_setprio(1); _Pragma("unroll") for (int m = 0; m < 4; ++m) _Pragma("unroll") for (int n = 0; n < 2; ++n) _Pragma("unroll") for (int k = 0; k < 2; ++k) \
        acc[ai][bj][m][n] = __builtin_amdgcn_mfma_f32_16x16x32_bf16(Bt[n][k], At[m][k], acc[ai][bj][m][n], 0, 0, 0); __builtin_amdgcn_s_setprio(0); } while (0)
#define PG8_WAIT_V(n) asm volatile("s_waitcnt vmcnt(" #n ")" ::: "memory")
#define PG8_WAIT_L(n) asm volatile("s_waitcnt lgkmcnt(" #n ")" ::: "memory")
#define PG8_BAR __builtin_amdgcn_s_barrier()
#define PG8_SCHED __builtin_amdgcn_sched_barrier(0)
#define PG8_SETOFFS(o, u) do { _Pragma("unroll") for (int _h = 0; _h < 2; ++_h) _Pragma("unroll") for (int _i = 0; _i < 2; ++_i) \
        o[_h][_i] = GATHER ? (S.arow(u, sR[_i] + HALF * _h) + (unsigned)sC2[_i]) : ((unsigned)((sR[_i] + HALF * _h) * K) * 2u + (unsigned)sC2[_i]); } while (0)
    Unit cur, nxt; int ui = 0;
    if (!S.next(0, cur)) return;
    f32x4 acc[2][2][4][2];
#pragma unroll
    for (int a = 0; a < 2; ++a)
#pragma unroll
        for (int b = 0; b < 2; ++b)
#pragma unroll
            for (int m = 0; m < 4; ++m)
#pragma unroll
                for (int n = 0; n < 2; ++n) acc[a][b][m][n] = (f32x4){0.f, 0.f, 0.f, 0.f};
    bf16x8 At[4][2], B0[2][2], B1[2][2];
    unsigned cAo[2][2], nAo[2][2];
    PG8_SETOFFS(cAo, cur);
    const char* cA = S.abase(cur, g, tstep); const char* cB = S.bbase(cur, g, tstep);
    S.a_ready(cur);
    PG8_STAGE(PG8_SB(0, 0), cB, voffB); PG8_STAGE(PG8_SB(0, 1), cB + hstep, voffB); PG8_STAGE(PG8_SA(0, 0), cA, cAo[0]); PG8_STAGE(PG8_SA(0, 1), cA, cAo[1]);
    if (wr == 1) PG8_BAR;
    PG8_WAIT_V(2); PG8_BAR;
    PG8_STAGE(PG8_SB(1, 0), cB + kstep, voffB); PG8_STAGE(PG8_SA(1, 0), cA + kstep, cAo[0]); PG8_STAGE(PG8_SB(1, 1), cB + hstep + kstep, voffB);
    PG8_WAIT_V(6); PG8_BAR;
    for (;;) {
        const bool has_next = S.next(ui + 1, nxt);
        const char* nA = has_next ? S.abase(nxt, g, tstep) : cA; const char* nB = has_next ? S.bbase(nxt, g, tstep) : cB;
        if (has_next) { PG8_SETOFFS(nAo, nxt); } else {
#pragma unroll
            for (int _h = 0; _h < 2; ++_h)
#pragma unroll
                for (int _i = 0; _i < 2; ++_i) nAo[_h][_i] = cAo[_h][_i]; }
        for (int t = 0; t < nt; t += 2) {
            const bool last = (t == nt - 2);
            const char* a1 = cA + (size_t)(t + 1) * kstep;
            const char* a2 = last ? nA : cA + (size_t)(t + 2) * kstep; const char* b2 = last ? nB : cB + (size_t)(t + 2) * kstep;
            const char* a3 = a2 + kstep; const char* b3 = b2 + kstep;
            unsigned o2[2][2];
#pragma unroll
            for (int _h = 0; _h < 2; ++_h)
#pragma unroll
                for (int _i = 0; _i < 2; ++_i) o2[_h][_i] = last ? nAo[_h][_i] : cAo[_h][_i];
            if (last && has_next) S.a_ready(nxt);
            PG8_LDB(B0, 0, 0); PG8_LDB(B1, 0, 1); PG8_SCHED; PG8_LDA(At, 0, 0); PG8_STAGE(PG8_SA(1, 1), a1, cAo[1]);
            PG8_WAIT_V(8); PG8_WAIT_L(0); PG8_BAR; PG8_MMA(0, 0, At, B0); PG8_MMA(0, 1, At, B1); PG8_BAR; PG8_SCHED;
            PG8_LDA(At, 0, 1); PG8_STAGE(PG8_SB(0, 0), b2, voffB); PG8_STAGE(PG8_SB(0, 1), b2 + hstep, voffB); PG8_STAGE(PG8_SA(0, 0), a2, o2[0]);
            PG8_WAIT_V(8); PG8_WAIT_L(0); PG8_BAR; PG8_MMA(1, 0, At, B0); PG8_MMA(1, 1, At, B1); PG8_BAR; PG8_SCHED;
            PG8_LDB(B0, 1, 0); PG8_LDB(B1, 1, 1); PG8_SCHED; PG8_LDA(At, 1, 0); PG8_STAGE(PG8_SA(0, 1), a2, o2[1]);
            PG8_WAIT_V(8); PG8_WAIT_L(0); PG8_BAR; PG8_MMA(0, 0, At, B0); PG8_MMA(0, 1, At, B1); PG8_BAR; PG8_SCHED;
            PG8_LDA(At, 1, 1); PG8_STAGE(PG8_SB(1, 0), b3, voffB); PG8_STAGE(PG8_SB(1, 1), b3 + hstep, voffB); PG8_STAGE(PG8_SA(1, 0), a3, o2[0]);
            PG8_WAIT_V(8); PG8_WAIT_L(0); PG8_BAR; PG8_MMA(1, 0, At, B0); PG8_MMA(1, 1, At, B1); PG8_BAR; PG8_SCHED;
        }
        if constexpr (ALIGN_EPI) { if (wr == 0) PG8_BAR; }
        E(acc, cur, wr, wc, fr, fq); S.done(cur);
        if (!has_next) break;
#pragma unroll
        for (int a = 0; a < 2; ++a)
#pragma unroll
            for (int b = 0; b < 2; ++b)
#pragma unroll
                for (int m = 0; m < 4; ++m)
#pragma unroll
                    for (int n = 0; n < 2; ++n) acc[a][b][m][n] = (f32x4){0.f, 0.f, 0.f, 0.f};
        cur = nxt; cA = nA; cB = nB; ++ui;
#pragma unroll
        for (int _h = 0; _h < 2; ++_h)
#pragma unroll
            for (int _i = 0; _i < 2; ++_i) cAo[_h][_i] = nAo[_h][_i];
        if constexpr (ALIGN_EPI) { if (wr == 1) PG8_BAR; }
    }
    PG8_WAIT_V(0);
    if constexpr (!ALIGN_EPI) { if (wr == 0) PG8_BAR; }
    PG8_BAR;
#undef PG8_SA
#undef PG8_SB
#undef PG8_STAGE
#undef PG8_LDA
#undef PG8_LDB
#undef PG8_MMA
#undef PG8_WAIT_V
#undef PG8_WAIT_L
#undef PG8_BAR
#undef PG8_SCHED
#undef PG8_SETOFFS
}
}

constexpr int NB = 8, SEQ = 4096, DM = 1024, MROWS = NB * SEQ, NLAYER = 2;
constexpr int NPROJ = 4608, INW = 4616;
constexpr int C_Q = 0, C_K = 512, C_V = 1024, C_Z = 1536, C_XS = 2048, C_SB = 3072, C_SC = 3584, C_SH = 4096;
constexpr int MIXW = 1536, NEXP = 32, TOPK = 4, FF = 1024;
constexpr float ALPHA = 1.4142135623730951f;
constexpr float LN_EPS = 1e-5f, RMS_EPS = 1e-5f;
constexpr float QSCALE = 0.125f * 1.4426950408889634f;

constexpr size_t MiB = 1u << 20;
constexpr size_t WS_CTL = 0, CTL_ZERO_BYTES = 1 * MiB;
constexpr size_t WS_ROPE = 1 * MiB;
constexpr size_t WS_WDT = 2 * MiB;
constexpr size_t WS_ROUT = 2 * MiB + 65536;
constexpr size_t WS_WIN = 4 * MiB;
constexpr size_t WS_WOUT = 24 * MiB;
constexpr size_t WS_WGU = 32 * MiB;
constexpr size_t WS_WDN = 288 * MiB;
constexpr size_t WS_XB = 416 * MiB;
constexpr size_t WS_XF = 480 * MiB;
constexpr size_t WS_XF2 = 608 * MiB;
constexpr size_t WS_PROJ = 736 * MiB;
constexpr size_t WS_DT = 1024 * MiB;
constexpr size_t WS_DTS = 1025 * MiB;
constexpr size_t WS_ACUM = 1026 * MiB;
constexpr size_t WS_LSE = 1027 * MiB;
constexpr size_t WS_OP = 1030 * MiB;
constexpr size_t WS_U = 1126 * MiB;
constexpr size_t WS_G = 1190 * MiB;
constexpr size_t WS_ST = 1222 * MiB;
constexpr size_t WS_YD = 1286 * MiB;
constexpr size_t WS_MIXED = 1350 * MiB;
constexpr size_t WS_MIXF = 1446 * MiB;
constexpr size_t WS_TOPE = 1574 * MiB;
constexpr size_t WS_TOPG = 1575 * MiB;
constexpr size_t WS_ROWTOK = 1576 * MiB;
constexpr size_t WS_ROWGATE = 1580 * MiB;
constexpr size_t WS_H = 736 * MiB;
constexpr size_t WS_YB = 1030 * MiB;
constexpr size_t WS_END = 1584 * MiB;
constexpr int CW_TMO = 0;
constexpr int CW_CNT = 64;
constexpr int CW_BAR = 4096;

constexpr int RING_OFF = 0, RING_BYTES = 131072;
constexpr int LDSCTL_OFF = RING_BYTES;
constexpr int L_MISC = LDSCTL_OFF;
constexpr int L_TSTART = LDSCTL_OFF + 256;
constexpr int L_CNT = LDSCTL_OFF + 512;
constexpr int L_LCNT = LDSCTL_OFF + 640;
constexpr int L_LBASE = LDSCTL_OFF + 768;
constexpr int L_UNITS = LDSCTL_OFF + 1024;
constexpr int L_UNITSN = LDSCTL_OFF + 2048;
constexpr int LDS_BYTES = 147456;

#define GAS __attribute__((address_space(1)))
#define LAS __attribute__((address_space(3)))
typedef unsigned short bf16;
typedef unsigned v4u __attribute__((ext_vector_type(4)));
typedef unsigned v2u __attribute__((ext_vector_type(2)));
typedef float f32x4 __attribute__((ext_vector_type(4)));
typedef float f32x16 __attribute__((ext_vector_type(16)));
typedef short bf16x8 __attribute__((ext_vector_type(8)));
typedef GAS unsigned gu32;
#define RLX_AGENT __ATOMIC_RELAXED, __HIP_MEMORY_SCOPE_AGENT
#define LDS_WAIT() asm volatile("s_waitcnt lgkmcnt(0)" ::: "memory")
#define VM_WAIT() asm volatile("s_waitcnt vmcnt(0)" ::: "memory")
__device__ __forceinline__ unsigned f2bf(float f) { unsigned u = __builtin_bit_cast(unsigned, f); return (u + 0x7fffu + ((u >> 16) & 1u)) >> 16; }
__device__ __forceinline__ unsigned pk2(float lo, float hi) { return f2bf(lo) | (f2bf(hi) << 16); }
__device__ __forceinline__ float bf2f(unsigned short b) { return __builtin_bit_cast(float, (unsigned)b << 16); }
__device__ __forceinline__ float bflo(unsigned w) { return __builtin_bit_cast(float, w << 16); }
__device__ __forceinline__ float bfhi(unsigned w) { return __builtin_bit_cast(float, w & 0xffff0000u); }
__device__ __forceinline__ float siluf(float x) { return x / (1.0f + __expf(-x)); }
#define XB_TMO      128
#define XB_XCNT(j)  (256  + 64 * (j))
#define XB_XSUB(j)  (1280 + 64 * (j))
#define XB_XGEN(j)  (2304 + 64 * (j))
#define XB_TOP      3328
#define XB_TOPGEN   3392
#define XCD_BAR_WORDS 3456
#define XB_SPIN_CAP (1u << 18)

__device__ __forceinline__ unsigned xb_ld(unsigned* p)              { return __hip_atomic_load(p, __ATOMIC_RELAXED, __HIP_MEMORY_SCOPE_AGENT); }
__device__ __forceinline__ unsigned xb_add(unsigned* p, unsigned v) { return __hip_atomic_fetch_add(p, v, __ATOMIC_RELAXED, __HIP_MEMORY_SCOPE_AGENT); }
__device__ __forceinline__ unsigned xb_xcc_id() { return (unsigned)__builtin_amdgcn_s_getreg((3 << 11) | 20) & 0xFu; }
#define XB_SPIN(cond, bar) do { unsigned _sp = 0; while (cond) { __builtin_amdgcn_s_sleep(1); \
    if ((++_sp & 255u) == 0u) { if (xb_ld(&(bar)[XB_TMO])) break; if (_sp > XB_SPIN_CAP) { atomicAdd(&(bar)[XB_TMO], 1u); break; } } } } while (0)

struct XcdBarrier {
    unsigned* bar; unsigned x;
    volatile LAS unsigned* st;
};

__device__ __forceinline__ XcdBarrier xcd_barrier_post(unsigned* bar, volatile LAS unsigned* st) {
    XcdBarrier b; b.bar = bar; b.x = xb_xcc_id(); b.st = st;
    if (threadIdx.x == 0) (void)xb_add(&bar[XB_XCNT(b.x)], 1u);
    return b;
}
__device__ __forceinline__ void xcd_barrier_complete(unsigned* bar, unsigned x, unsigned& nloc, unsigned& nx) {
    const unsigned G = gridDim.x * gridDim.y * gridDim.z;
    unsigned sum, cnt, mine, sp = 0u;
    for (;;) {
        sum = 0u; cnt = 0u; mine = 0u;
#pragma unroll
        for (unsigned j = 0; j < 16; ++j) { const unsigned c = xb_ld(&bar[XB_XCNT(j)]); sum += c; cnt += (c > 0u) ? 1u : 0u; mine = (j == x) ? c : mine; }
        if (sum == G) break;
        __builtin_amdgcn_s_sleep(1);
        if ((++sp & 255u) == 0u) { if (xb_ld(&bar[XB_TMO])) break; if (sp > XB_SPIN_CAP) { atomicAdd(&bar[XB_TMO], 1u); break; } }
    }
    nloc = mine > 0u ? mine : 1u; nx = cnt > 0u ? cnt : 1u;
}

__device__ __forceinline__ void xcd_barrier(const XcdBarrier& b) {
    asm volatile("s_waitcnt vmcnt(0)" ::: "memory");
    __syncthreads();
    if (threadIdx.x == 0) {
        unsigned* bar = b.bar;
        __builtin_amdgcn_s_waitcnt(0);
        unsigned nloc = b.st[0], nx = b.st[1];
        if (nloc == 0u) { xcd_barrier_complete(bar, b.x, nloc, nx); b.st[0] = nloc; b.st[1] = nx; }
        const unsigned old = xb_add(&bar[XB_XSUB(b.x)], 1u);
        const unsigned gen = old / nloc;
        if (old + 1u == (gen + 1u) * nloc) {
            __builtin_amdgcn_fence(__ATOMIC_RELEASE, "agent");
            asm volatile("s_waitcnt vmcnt(0)" ::: "memory");
            const unsigned og = xb_add(&bar[XB_TOP], 1u);
            const unsigned tg = og / nx;
            if (og + 1u == (tg + 1u) * nx) xb_add(&bar[XB_TOPGEN], 1u);
            else XB_SPIN(xb_ld(&bar[XB_TOPGEN]) == tg, bar);
            __builtin_amdgcn_fence(__ATOMIC_ACQUIRE, "agent");
            xb_add(&bar[XB_XGEN(b.x)], 1u);
            asm volatile("s_waitcnt vmcnt(0)" ::: "memory");
        } else {
            XB_SPIN(xb_ld(&bar[XB_XGEN(b.x)]) == gen, bar);
            __builtin_amdgcn_fence(__ATOMIC_ACQUIRE, "agent");
            asm volatile("s_waitcnt vmcnt(0)" ::: "memory");
        }
    }
    __syncthreads();
}

__device__ __forceinline__ float wave_sum(float v) {
#pragma unroll
    for (int o = 1; o < 64; o <<= 1) v += __shfl_xor(v, o);
    return v;
}
__device__ __forceinline__ int win_dest_row(int n) {
    if (n < 1024) { const int hh = n >> 6, d = n & 63; const int p = (d < 32) ? (8 * (d >> 2) + (d & 3)) : (8 * ((d - 32) >> 2) + 4 + (d & 3)); return hh * 64 + p; }
    if (n < 3072) return n;
    if (n < 3080) return -1;
    return n - 8;
}
__device__ __forceinline__ int wgu_dest_row(int n) { return n < 1024 ? ((n >> 7) * 256 + (n & 127)) : (((n - 1024) >> 7) * 256 + 128 + ((n - 1024) & 127)); }
template <int MAP>
__device__ __forceinline__ void p0_transpose_item(const float* W, int K, int N, bf16* WT, float* wdt, LAS float* scr, int kb, int nb, int lane) {
    const int k0 = 64 * kb, n0 = 32 * nb;
    const int nn = n0 + (lane & 31); const bool nok = nn < N;
#pragma unroll 8
    for (int i = 0; i < 32; ++i) { const int kk = 2 * i + (lane >> 5); scr[kk * 33 + (lane & 31)] = nok ? W[(size_t)(k0 + kk) * N + nn] : 0.f; }
    LDS_WAIT(); asm volatile("" ::: "memory");
    const int c = lane & 7;
#pragma unroll
    for (int j = 0; j < 4; ++j) { const int n = (lane >> 3) + 8 * j; const LAS float* s = scr + (8 * c) * 33 + n;
        const int nsrc = n0 + n; if (nsrc >= N) continue;
        int drow = nsrc; if (MAP == 1) drow = win_dest_row(nsrc); if (MAP == 2) drow = wgu_dest_row(nsrc);
        if (MAP == 1 && drow < 0) { float* d = wdt + (size_t)(nsrc - 3072) * 1024 + k0 + 8 * c;
#pragma unroll
            for (int q = 0; q < 8; ++q) d[q] = s[q * 33]; continue; }
        v4u o; o.x = pk2(s[0 * 33], s[1 * 33]); o.y = pk2(s[2 * 33], s[3 * 33]); o.z = pk2(s[4 * 33], s[5 * 33]); o.w = pk2(s[6 * 33], s[7 * 33]);
        *(GAS v4u*)(WT + (size_t)drow * K + k0 + 8 * c) = o; }
    LDS_WAIT(); asm volatile("" ::: "memory");
}
__device__ __forceinline__ void row_dt(const f32x4 (&v)[4], const float* wdt, float* dst, int lane) {
    float r[8];
#pragma unroll
    for (int jj = 0; jj < 8; ++jj) { float s = 0.f;
#pragma unroll
        for (int j = 0; j < 4; ++j) { const f32x4 w = *(const f32x4*)(wdt + jj * 1024 + 4 * lane + 256 * j); s += v[j][0] * w[0] + v[j][1] * w[1] + v[j][2] * w[2] + v[j][3] * w[3]; }
        r[jj] = wave_sum(s); }
    if (lane == 0) { *(f32x4*)dst = (f32x4){r[0], r[1], r[2], r[3]}; *(f32x4*)(dst + 4) = (f32x4){r[4], r[5], r[6], r[7]}; }
}
__device__ __forceinline__ void ln_row(f32x4 (&v)[4], const float* gam, const float* bet, float* of32, bf16* ob16, int lane) {
    float s = 0.f;
#pragma unroll
    for (int j = 0; j < 4; ++j) s += (v[j][0] + v[j][1]) + (v[j][2] + v[j][3]);
    const float mean = wave_sum(s) * (1.f / DM); float s2 = 0.f;
#pragma unroll
    for (int j = 0; j < 4; ++j) { v[j] = v[j] - mean; s2 += (v[j][0] * v[j][0] + v[j][1] * v[j][1]) + (v[j][2] * v[j][2] + v[j][3] * v[j][3]); }
    const float rstd = 1.f / sqrtf(wave_sum(s2) * (1.f / DM) + LN_EPS);
#pragma unroll
    for (int j = 0; j < 4; ++j) { const f32x4 g = *(const f32x4*)(gam + 4 * lane + 256 * j), b = *(const f32x4*)(bet + 4 * lane + 256 * j);
        v[j] = v[j] * rstd * g + b;
        *(f32x4*)(of32 + 4 * lane + 256 * j) = v[j];
        v2u w; w.x = pk2(v[j][0], v[j][1]); w.y = pk2(v[j][2], v[j][3]); *(v2u*)(ob16 + 4 * lane + 256 * j) = w; }
}

struct Args { const float* in[20]; float* out; unsigned char* ws; int ph_lo, ph_hi; };
constexpr int NWAVES = 8;
constexpr int PH_PER_LAYER = 13, N_PHASES = 1 + NLAYER * PH_PER_LAYER;

template <int layer>
__device__ __forceinline__ void run_layer(const Args& args, int lo, int hi, const XcdBarrier& bar) {
    extern __shared__ __attribute__((aligned(16))) unsigned char lds[];
    LAS unsigned char* ldsp = (LAS unsigned char*)lds;
    const int tid = threadIdx.x, lane = tid & 63, wave = __builtin_amdgcn_readfirstlane(tid >> 6);
    const int G = gridDim.x, bid = blockIdx.x;
    const long gtid = (long)bid * (NWAVES * 64) + tid, GT = (long)G * (NWAVES * 64);
    const int gw = bid * NWAVES + wave, NGW = G * NWAVES;
    unsigned char* ws = args.ws;
    gu32* ctl = (gu32*)(ws + WS_CTL);
    const float* in_x = args.in[0]; const float* in_win = args.in[1]; const float* in_convw = args.in[2]; const float* in_convb = args.in[3];
    const float* in_dtb = args.in[4]; const float* in_alog = args.in[5]; const float* in_dsk = args.in[6]; const float* in_ng = args.in[7];
    const float* in_scw = args.in[8]; const float* in_wout = args.in[9]; const float* in_ln1g = args.in[10]; const float* in_ln1b = args.in[11];
    const float* in_rw = args.in[12]; const float* in_rb = args.in[13]; const float* in_wgu = args.in[14]; const float* in_bgu = args.in[15];
    const float* in_wdn = args.in[16]; const float* in_bdn = args.in[17]; const float* in_ln2g = args.in[18]; const float* in_ln2b = args.in[19];
    float* ROPE = (float*)(ws + WS_ROPE); float* WDT = (float*)(ws + WS_WDT); bf16* ROUT = (bf16*)(ws + WS_ROUT);
    bf16* WIN = (bf16*)(ws + WS_WIN); bf16* WOUT = (bf16*)(ws + WS_WOUT); bf16* WGU = (bf16*)(ws + WS_WGU); bf16* WDN = (bf16*)(ws + WS_WDN);
    bf16* XB = (bf16*)(ws + WS_XB); float* XF = (float*)(ws + WS_XF); float* XF2 = (float*)(ws + WS_XF2);
    bf16* PROJ = (bf16*)(ws + WS_PROJ); float* DT = (float*)(ws + WS_DT); float* DTS = (float*)(ws + WS_DTS); float* ACUM = (float*)(ws + WS_ACUM);
    float* LSE = (float*)(ws + WS_LSE); bf16* OP = (bf16*)(ws + WS_OP); bf16* U = (bf16*)(ws + WS_U); float* GB = (float*)(ws + WS_G);
    float* ST = (float*)(ws + WS_ST); float* YD = (float*)(ws + WS_YD); bf16* MIXED = (bf16*)(ws + WS_MIXED); float* MIXF = (float*)(ws + WS_MIXF);
    int* TOPE = (int*)(ws + WS_TOPE); float* TOPG = (float*)(ws + WS_TOPG); int* ROWTOK = (int*)(ws + WS_ROWTOK); float* ROWGATE = (float*)(ws + WS_ROWGATE);
    bf16* HB = (bf16*)(ws + WS_H); bf16* YB = (bf16*)(ws + WS_YB);

#define IN(k) (lo <= (k) && (k) < hi)
#define SEAM(k) do { if (IN(k) && IN((k) + 1)) xcd_barrier(bar); } while (0)

        const int pb = 1 + layer * PH_PER_LAYER;
        const float* xres = layer == 0 ? in_x : XF2;
        const bf16* WINl = WIN + (size_t)layer * NPROJ * DM; const bf16* WOUTl = WOUT + (size_t)layer * DM * MIXW;
        const bf16* WGUl = WGU + (size_t)layer * NEXP * 2048 * DM; const bf16* WDNl = WDN + (size_t)layer * NEXP * DM * FF;
        gu32* gcnt = ctl + CW_CNT + 64 * layer;

        if (IN(pb + 0)) {
            if (layer == 0) {
                for (int m = gw; m < MROWS; m += NGW) { const float* xr = in_x + (size_t)m * DM; f32x4 v[4];
#pragma unroll
                    for (int j = 0; j < 4; ++j) v[j] = *(const f32x4*)(xr + 4 * lane + 256 * j);
                    row_dt(v, WDT, DT + (size_t)m * 8, lane); }
            }
            pg8::Gemm g{XB, WINl, MROWS, NPROJ, DM}; pg8::StaticOrder S; S.init(MROWS, NPROJ, G, bid);
            pg8::EpiProj E{PROJ, NPROJ, ROPE, QSCALE};
            pg8::gemm_phase<pg8::EpiProj, pg8::StaticOrder, true, false>(ldsp + RING_OFF, g, S, E);
        }
        SEAM(pb + 0);
        if (IN(pb + 1)) {
            for (long it = gtid; it < 3L * MROWS * 8; it += GT) {
                const int h = (int)(it & 7); const long rp = it >> 3; const int row = (int)(rp % MROWS), p = (int)(rp / MROWS);
                const int d = (p == 0) ? 1 : (p == 1) ? 4 : 16; const int t = row & (SEQ - 1);
                float q[64], o[64];
                { const v4u* qp = (const v4u*)(PROJ + (size_t)row * NPROJ + C_Q + h * 64);
#pragma unroll
                  for (int c8 = 0; c8 < 8; ++c8) { const v4u w = qp[c8]; q[c8 * 8 + 0] = bflo(w.x); q[c8 * 8 + 1] = bfhi(w.x); q[c8 * 8 + 2] = bflo(w.y); q[c8 * 8 + 3] = bfhi(w.y); q[c8 * 8 + 4] = bflo(w.z); q[c8 * 8 + 5] = bfhi(w.z); q[c8 * 8 + 6] = bflo(w.w); q[c8 * 8 + 7] = bfhi(w.w); } }
#pragma unroll
                for (int i = 0; i < 64; ++i) o[i] = 0.f;
                float mx = -INFINITY, l = 0.f;
                const int nj = (t / d) < 128 ? (t / d) : 128;
#pragma unroll 1
                for (int j = 0; j <= nj; ++j) {
                    const bf16* kp = PROJ + (size_t)(row - j * d) * NPROJ + C_K + h * 64; const bf16* vp = kp + (C_V - C_K);
                    float s = 0.f;
#pragma unroll
                    for (int c8 = 0; c8 < 8; ++c8) { const v4u w = ((const v4u*)kp)[c8];
                        s += q[c8 * 8 + 0] * bflo(w.x) + q[c8 * 8 + 1] * bfhi(w.x) + q[c8 * 8 + 2] * bflo(w.y) + q[c8 * 8 + 3] * bfhi(w.y) + q[c8 * 8 + 4] * bflo(w.z) + q[c8 * 8 + 5] * bfhi(w.z) + q[c8 * 8 + 6] * bflo(w.w) + q[c8 * 8 + 7] * bfhi(w.w); }
                    const float mn = fmaxf(mx, s), a = exp2f(mx - mn), pj = exp2f(s - mn); l = l * a + pj; mx = mn;
#pragma unroll
                    for (int c8 = 0; c8 < 8; ++c8) { const v4u w = ((const v4u*)vp)[c8];
                        o[c8 * 8 + 0] = o[c8 * 8 + 0] * a + pj * bflo(w.x); o[c8 * 8 + 1] = o[c8 * 8 + 1] * a + pj * bfhi(w.x); o[c8 * 8 + 2] = o[c8 * 8 + 2] * a + pj * bflo(w.y); o[c8 * 8 + 3] = o[c8 * 8 + 3] * a + pj * bfhi(w.y);
                        o[c8 * 8 + 4] = o[c8 * 8 + 4] * a + pj * bflo(w.z); o[c8 * 8 + 5] = o[c8 * 8 + 5] * a + pj * bfhi(w.z); o[c8 * 8 + 6] = o[c8 * 8 + 6] * a + pj * bflo(w.w); o[c8 * 8 + 7] = o[c8 * 8 + 7] * a + pj * bfhi(w.w); }
                }
                const float il = 1.0f / l;
                v4u* op = (v4u*)(OP + ((size_t)p * MROWS + row) * 512 + h * 64);
#pragma unroll
                for (int c8 = 0; c8 < 8; ++c8) { v4u w; w.x = pk2(o[c8 * 8 + 0] * il, o[c8 * 8 + 1] * il); w.y = pk2(o[c8 * 8 + 2] * il, o[c8 * 8 + 3] * il); w.z = pk2(o[c8 * 8 + 4] * il, o[c8 * 8 + 5] * il); w.w = pk2(o[c8 * 8 + 6] * il, o[c8 * 8 + 7] * il); op[c8] = w; }
                LSE[((size_t)p * MROWS + row) * 8 + h] = mx + log2f(l);
            }
            const float* cw = in_convw + (size_t)layer * 4 * 1024; const float* cb = in_convb + (size_t)layer * 1024;
            for (long it = gtid; it < (long)MROWS * 1024; it += GT) { const int ch = (int)(it & 1023), row = (int)(it >> 10), t = row & (SEQ - 1);
                float a = cb[ch];
#pragma unroll
                for (int k = 0; k < 4; ++k) { const int tt = t - 3 + k; if (tt >= 0) a += cw[k * 1024 + ch] * bf2f(PROJ[(size_t)(row - 3 + k) * NPROJ + C_XS + ch]); }
                U[it] = (bf16)f2bf(siluf(a)); }
            for (long it = gtid; it < (long)MROWS * 8; it += GT) { const int h = (int)(it & 7); const float x = DT[it] + in_dtb[layer * 8 + h];
                DTS[it] = x > 20.f ? x : log1pf(__expf(x)); }
            const float* sw = in_scw + (size_t)layer * 3 * 512;
            for (long it = gtid; it < (long)MROWS * 512; it += GT) { const int ch = (int)(it & 511), row = (int)(it >> 9), t = row & (SEQ - 1);
                float a = 0.f;
#pragma unroll
                for (int k = 0; k < 3; ++k) { const int tt = t - 2 + k; if (tt >= 0) { const bf16* pr = PROJ + (size_t)(row - 2 + k) * NPROJ; a += sw[k * 512 + ch] * bf2f(pr[C_SC + ch]) * bf2f(pr[C_SH + ch]); } }
                MIXED[(size_t)row * MIXW + 1024 + ch] = (bf16)f2bf(a * bf2f(PROJ[(size_t)row * NPROJ + C_SB + ch])); }
        }
        SEAM(pb + 1);
        if (IN(pb + 2)) {
            for (long it = gtid; it < 2048; it += GT) { const int h = (int)(it & 7); const int bc = (int)(it >> 3); const float a = -__expf(in_alog[layer * 8 + h]); float acc = 0.f;
                for (int l = 0; l < 128; ++l) { const size_t r = (size_t)bc * 128 + l; acc += DTS[r * 8 + h] * a; ACUM[r * 8 + h] = acc; } }
            for (long it = gtid; it < 512L * 16384; it += GT) { const int s = (int)(it & 127), l = (int)((it >> 7) & 127), un = (int)(it >> 14); const int g = un & 1, bc = un >> 1;
                if (s > l) continue;
                const bf16* cp = U + ((size_t)bc * 128 + l) * 1024 + 768 + g * 128; const bf16* bp = U + ((size_t)bc * 128 + s) * 1024 + 512 + g * 128; float a = 0.f;
                for (int n = 0; n < 128; ++n) a += bf2f(cp[n]) * bf2f(bp[n]);
                GB[it] = a; }
        }
        SEAM(pb + 2);
        if (IN(pb + 3)) {
            for (long it = gtid; it < 2048L * 8192; it += GT) { const int n = (int)(it & 127), p = (int)((it >> 7) & 63), un = (int)(it >> 13); const int h = un & 7, bc = un >> 3, g = h >> 2;
                const size_t r0 = (size_t)bc * 128; const float alast = ACUM[(r0 + 127) * 8 + h]; float a = 0.f;
                for (int l = 0; l < 128; ++l) { const size_t r = r0 + l; a += bf2f(U[r * 1024 + 512 + g * 128 + n]) * __expf(alast - ACUM[r * 8 + h]) * DTS[r * 8 + h] * bf2f(U[r * 1024 + h * 64 + p]); }
                ST[it] = a; }
            for (long it = gtid; it < (long)MROWS * 512; it += GT) { const int p = (int)(it & 63), h = (int)((it >> 6) & 7), row = (int)(it >> 9); const int l = row & 127, g = h >> 2; const size_t r0 = (size_t)(row - l);
                const int un = (row >> 7) * 2 + g; const float al = ACUM[(size_t)row * 8 + h]; float a = 0.f;
                for (int s = 0; s <= l; ++s) { const size_t r = r0 + s; a += GB[((size_t)un * 128 + l) * 128 + s] * __expf(al - ACUM[r * 8 + h]) * DTS[r * 8 + h] * bf2f(U[r * 1024 + h * 64 + p]); }
                YD[it] = a + in_dsk[layer * 8 + h] * bf2f(U[(size_t)row * 1024 + h * 64 + p]); }
        }
        SEAM(pb + 3);
        if (IN(pb + 4)) {
            for (long it = gtid; it < 64L * 8192; it += GT) { const int pn = (int)(it & 8191), bh = (int)(it >> 13); const int h = bh & 7, b = bh >> 3; float hc = 0.f;
                for (int c = 0; c < 32; ++c) { const size_t idx = ((size_t)((b * 32 + c) * 8 + h)) * 8192 + pn; const float st = ST[idx]; ST[idx] = hc;
                    hc = hc * __expf(ACUM[((size_t)(b * 32 + c) * 128 + 127) * 8 + h]) + st; } }
        }
        SEAM(pb + 4);
        if (IN(pb + 5)) {
            for (long it = gtid; it < (long)MROWS * 512; it += GT) { const int p = (int)(it & 63), h = (int)((it >> 6) & 7), row = (int)(it >> 9); const int g = h >> 2;
                const float* hp = ST + ((size_t)((row >> 7) * 8 + h)) * 8192 + p * 128; const bf16* cp = U + (size_t)row * 1024 + 768 + g * 128; float a = 0.f;
                for (int n = 0; n < 128; ++n) a += bf2f(cp[n]) * hp[n];
                YD[it] += a * __expf(ACUM[(size_t)row * 8 + h]); }
        }
        SEAM(pb + 5);
        if (IN(pb + 6)) {
            const float* ng = in_ng + (size_t)layer * 512;
            for (long it = gtid; it < (long)MROWS * 2; it += GT) { const int g = (int)(it & 1), row = (int)(it >> 1); float ss = 0.f;
                for (int ch = 0; ch < 256; ++ch) { const float y = YD[(size_t)row * 512 + g * 256 + ch] * siluf(bf2f(PROJ[(size_t)row * NPROJ + C_Z + g * 256 + ch])); ss += y * y; }
                const float rs = 1.0f / sqrtf(ss * (1.f / 256.f) + RMS_EPS);
                for (int ch = 0; ch < 256; ++ch) { const float y = YD[(size_t)row * 512 + g * 256 + ch] * siluf(bf2f(PROJ[(size_t)row * NPROJ + C_Z + g * 256 + ch]));
                    MIXED[(size_t)row * MIXW + 512 + g * 256 + ch] = (bf16)f2bf(y * rs * ng[g * 256 + ch]); } }
            for (long it = gtid; it < (long)MROWS * 8; it += GT) { const int h = (int)(it & 7), row = (int)(it >> 3);
                const float l0 = LSE[((size_t)0 * MROWS + row) * 8 + h], l1 = LSE[((size_t)1 * MROWS + row) * 8 + h], l2 = LSE[((size_t)2 * MROWS + row) * 8 + h];
                const float mm = fmaxf(l0, fmaxf(l1, l2)); float w0 = exp2f(l0 - mm), w1 = exp2f(l1 - mm), w2 = exp2f(l2 - mm); const float iw = 1.0f / (w0 + w1 + w2); w0 *= iw; w1 *= iw; w2 *= iw;
                const bf16* o0 = OP + ((size_t)0 * MROWS + row) * 512 + h * 64; const bf16* o1 = OP + ((size_t)1 * MROWS + row) * 512 + h * 64; const bf16* o2 = OP + ((size_t)2 * MROWS + row) * 512 + h * 64;
                bf16* mo = MIXED + (size_t)row * MIXW + h * 64;
                for (int i = 0; i < 64; ++i) mo[i] = (bf16)f2bf(w0 * bf2f(o0[i]) + w1 * bf2f(o1[i]) + w2 * bf2f(o2[i])); }
        }
        SEAM(pb + 6);
        if (IN(pb + 7)) {
            pg8::Gemm g{MIXED, WOUTl, MROWS, DM, MIXW}; pg8::StaticOrder S; S.init(MROWS, DM, G, bid);
            pg8::EpiF32 E{MIXF, DM};
            pg8::gemm_phase<pg8::EpiF32, pg8::StaticOrder, true, false>(ldsp + RING_OFF, g, S, E);
        }
        SEAM(pb + 7);
        if (IN(pb + 8)) {
            const float* gam = in_ln1g + (size_t)layer * DM; const float* bet = in_ln1b + (size_t)layer * DM;
            for (int m = gw; m < MROWS; m += NGW) { f32x4 v[4];
#pragma unroll
                for (int j = 0; j < 4; ++j) { const f32x4 a = *(const f32x4*)(xres + (size_t)m * DM + 4 * lane + 256 * j), b = *(const f32x4*)(MIXF + (size_t)m * DM + 4 * lane + 256 * j); v[j] = a * ALPHA + b; }
                ln_row(v, gam, bet, XF + (size_t)m * DM, XB + (size_t)m * DM, lane); }
        }
        SEAM(pb + 8);
        if (IN(pb + 9)) {
            LAS int* lcnt = (LAS int*)(ldsp + L_LCNT); LAS int* lbase = (LAS int*)(ldsp + L_LBASE);
            const bf16* RT = ROUT + (size_t)layer * NEXP * DM; const float* rb = in_rb + (size_t)layer * NEXP;
            for (int blk = bid; blk < MROWS / 128; blk += G) {
                if (tid < 32) lcnt[tid] = 0;
                __syncthreads();
                const int r32 = lane & 31, hi = lane >> 5; const int row = blk * 128 + (wave & 3) * 32 + r32;
                float tv[4]; int te[4]; int lrank[4]; float gate[4];
                if (wave < 4) {
                    f32x16 acc = {};
                    const bf16* ap = RT + (size_t)r32 * DM + 8 * hi; const bf16* bp = XB + (size_t)row * DM + 8 * hi;
#pragma unroll 8
                    for (int s = 0; s < 64; ++s) { const bf16x8 a = *(const bf16x8*)(ap + 16 * s), b = *(const bf16x8*)(bp + 16 * s); acc = __builtin_amdgcn_mfma_f32_32x32x16_bf16(a, b, acc, 0, 0, 0); }
#pragma unroll
                    for (int k = 0; k < 4; ++k) { tv[k] = -INFINITY; te[k] = 1 << 20; }
#pragma unroll
                    for (int i = 0; i < 16; ++i) { const int e = (i & 3) + 8 * (i >> 2) + 4 * hi; float v = acc[i] + rb[e]; int ve = e;
#pragma unroll
                        for (int k = 0; k < 4; ++k) { const bool gt = (v > tv[k]) || (v == tv[k] && ve < te[k]); const float nv = gt ? tv[k] : v; const int ne = gt ? te[k] : ve; tv[k] = gt ? v : tv[k]; te[k] = gt ? ve : te[k]; v = nv; ve = ne; } }
                    float pv[4]; int pe[4];
#pragma unroll
                    for (int k = 0; k < 4; ++k) { pv[k] = __shfl_xor(tv[k], 32); pe[k] = __shfl_xor(te[k], 32); }
#pragma unroll
                    for (int j = 0; j < 4; ++j) { float v = pv[j]; int ve = pe[j];
#pragma unroll
                        for (int k = 0; k < 4; ++k) { const bool gt = (v > tv[k]) || (v == tv[k] && ve < te[k]); const float nv = gt ? tv[k] : v; const int ne = gt ? te[k] : ve; tv[k] = gt ? v : tv[k]; te[k] = gt ? ve : te[k]; v = nv; ve = ne; } }
                    float se = 0.f;
#pragma unroll
                    for (int k = 0; k < 4; ++k) { gate[k] = __expf(tv[k] - tv[0]); se += gate[k]; }
                    const float ise = 1.0f / se;
#pragma unroll
                    for (int k = 0; k < 4; ++k) gate[k] *= ise;
                    if (hi == 0) {
#pragma unroll
                        for (int k = 0; k < 4; ++k) lrank[k] = __hip_atomic_fetch_add(lcnt + te[k], 1, __ATOMIC_RELAXED, __HIP_MEMORY_SCOPE_WORKGROUP);
                    }
                }
                __syncthreads();
                if (tid < 32) lbase[tid] = (int)__hip_atomic_fetch_add(gcnt + tid, (unsigned)lcnt[tid], RLX_AGENT);
                __syncthreads();
                if (wave < 4 && hi == 0) {
#pragma unroll
                    for (int k = 0; k < 4; ++k) { const int r = lbase[te[k]] + lrank[k]; const size_t o = (size_t)te[k] * 32768 + r;
                        ROWTOK[o] = row * 4 + k; ROWGATE[o] = gate[k]; TOPE[(size_t)row * 4 + k] = te[k]; TOPG[(size_t)row * 4 + k] = gate[k]; }
                }
                __syncthreads();
            }
        }
        SEAM(pb + 9);
        if (IN(pb + 10) || IN(pb + 11)) {
            LAS int* tstart = (LAS int*)(ldsp + L_TSTART); LAS int* cntL = (LAS int*)(ldsp + L_CNT); LAS int* units = (LAS int*)(ldsp + L_UNITS); LAS int* unitsn = (LAS int*)(ldsp + L_UNITSN);
            if (tid == 0) { int acc = 0; for (int e = 0; e < 32; ++e) { const int c = (int)__hip_atomic_load(gcnt + e, RLX_AGENT); cntL[e] = c; tstart[e] = acc; acc += (c + 255) >> 8; } tstart[32] = acc; }
            __syncthreads();
            if (IN(pb + 10)) {
                pg8::moe_build_units(units, unitsn, tstart, 8, G, bid, tid);
                __syncthreads();
                pg8::Gemm g{XB, WGUl, 0, 2048, DM};
                pg8::MoeOrder S{units, __builtin_amdgcn_readfirstlane(unitsn[0]), cntL, ROWTOK, 1, (size_t)2048 * DM * 2};
                pg8::EpiSwiglu E{HB, in_bgu + (size_t)layer * NEXP * 2048, ROWGATE, cntL};
                pg8::gemm_phase<pg8::EpiSwiglu, pg8::MoeOrder, true, true>(ldsp + RING_OFF, g, S, E);
                __syncthreads();
            }
            SEAM(pb + 10);
            if (IN(pb + 11)) {
                pg8::moe_build_units(units, unitsn, tstart, 4, G, bid, tid);
                __syncthreads();
                pg8::Gemm g{HB, WDNl, 0, DM, FF};
                pg8::MoeOrder S{units, __builtin_amdgcn_readfirstlane(unitsn[0]), cntL, ROWTOK, 0, (size_t)DM * FF * 2};
                pg8::EpiScatter E{YB, ROWTOK, cntL};
                pg8::gemm_phase<pg8::EpiScatter, pg8::MoeOrder, true, false>(ldsp + RING_OFF, g, S, E);
                __syncthreads();
            }
        }
        SEAM(pb + 11);
        if (IN(pb + 12)) {
            const float* gam = in_ln2g + (size_t)layer * DM; const float* bet = in_ln2b + (size_t)layer * DM; const float* bdn = in_bdn + (size_t)layer * NEXP * DM;
            float* dstf = (layer == NLAYER - 1) ? args.out : XF2;
            for (int m = gw; m < MROWS; m += NGW) { f32x4 v[4];
#pragma unroll
                for (int j = 0; j < 4; ++j) v[j] = *(const f32x4*)(XF + (size_t)m * DM + 4 * lane + 256 * j) * ALPHA;
#pragma unroll
                for (int k = 0; k < 4; ++k) { const int e = TOPE[(size_t)m * 4 + k]; const float gk = TOPG[(size_t)m * 4 + k]; const bf16* yr = YB + ((size_t)m * 4 + k) * DM; const float* br = bdn + (size_t)e * DM;
#pragma unroll
                    for (int j = 0; j < 4; ++j) { const v2u w = *(const v2u*)(yr + 4 * lane + 256 * j); const f32x4 b = *(const f32x4*)(br + 4 * lane + 256 * j);
                        v[j][0] += bflo(w.x) + gk * b[0]; v[j][1] += bfhi(w.x) + gk * b[1]; v[j][2] += bflo(w.y) + gk * b[2]; v[j][3] += bfhi(w.y) + gk * b[3]; } }
                ln_row(v, gam, bet, dstf + (size_t)m * DM, XB + (size_t)m * DM, lane);
                if (layer + 1 < NLAYER) row_dt(v, WDT + (size_t)(layer + 1) * 8 * 1024, DT + (size_t)m * 8, lane); }
        }
        SEAM(pb + 12);
    #undef IN
#undef SEAM
}

__global__ void __launch_bounds__(NWAVES * 64, 2) mk_fwd(Args args) {
    extern __shared__ __attribute__((aligned(16))) unsigned char lds[];
    LAS unsigned char* ldsp = (LAS unsigned char*)lds;
    const int tid = threadIdx.x, lane = tid & 63, wave = __builtin_amdgcn_readfirstlane(tid >> 6);
    const int G = gridDim.x, bid = blockIdx.x;
    const long gtid = (long)bid * (NWAVES * 64) + tid, GT = (long)G * (NWAVES * 64);
    const int gw = bid * NWAVES + wave, NGW = G * NWAVES;
    unsigned char* ws = args.ws;
    gu32* ctl = (gu32*)(ws + WS_CTL);
    const float* in_x = args.in[0]; const float* in_win = args.in[1]; const float* in_convw = args.in[2]; const float* in_convb = args.in[3];
    const float* in_dtb = args.in[4]; const float* in_alog = args.in[5]; const float* in_dsk = args.in[6]; const float* in_ng = args.in[7];
    const float* in_scw = args.in[8]; const float* in_wout = args.in[9]; const float* in_ln1g = args.in[10]; const float* in_ln1b = args.in[11];
    const float* in_rw = args.in[12]; const float* in_rb = args.in[13]; const float* in_wgu = args.in[14]; const float* in_bgu = args.in[15];
    const float* in_wdn = args.in[16]; const float* in_bdn = args.in[17]; const float* in_ln2g = args.in[18]; const float* in_ln2b = args.in[19];
    float* ROPE = (float*)(ws + WS_ROPE); float* WDT = (float*)(ws + WS_WDT); bf16* ROUT = (bf16*)(ws + WS_ROUT);
    bf16* WIN = (bf16*)(ws + WS_WIN); bf16* WOUT = (bf16*)(ws + WS_WOUT); bf16* WGU = (bf16*)(ws + WS_WGU); bf16* WDN = (bf16*)(ws + WS_WDN);
    bf16* XB = (bf16*)(ws + WS_XB); float* XF = (float*)(ws + WS_XF); float* XF2 = (float*)(ws + WS_XF2);
    bf16* PROJ = (bf16*)(ws + WS_PROJ); float* DT = (float*)(ws + WS_DT); float* DTS = (float*)(ws + WS_DTS); float* ACUM = (float*)(ws + WS_ACUM);
    float* LSE = (float*)(ws + WS_LSE); bf16* OP = (bf16*)(ws + WS_OP); bf16* U = (bf16*)(ws + WS_U); float* GB = (float*)(ws + WS_G);
    float* ST = (float*)(ws + WS_ST); float* YD = (float*)(ws + WS_YD); bf16* MIXED = (bf16*)(ws + WS_MIXED); float* MIXF = (float*)(ws + WS_MIXF);
    int* TOPE = (int*)(ws + WS_TOPE); float* TOPG = (float*)(ws + WS_TOPG); int* ROWTOK = (int*)(ws + WS_ROWTOK); float* ROWGATE = (float*)(ws + WS_ROWGATE);
    bf16* HB = (bf16*)(ws + WS_H); bf16* YB = (bf16*)(ws + WS_YB);

    for (int u = tid; u < (LDS_BYTES - LDSCTL_OFF) / 4; u += NWAVES * 64) ((LAS unsigned*)(ldsp + LDSCTL_OFF))[u] = 0u;
    __syncthreads();
    XcdBarrier bar = xcd_barrier_post((unsigned*)(ctl + CW_BAR), (volatile LAS unsigned*)(ldsp + L_MISC) + 8);

    const int lo = args.ph_lo, hi = args.ph_hi;
#define IN(k) (lo <= (k) && (k) < hi)
#define SEAM(k) do { if (IN(k) && IN((k) + 1)) xcd_barrier(bar); } while (0)

    if (IN(0)) {
        for (long it = gtid; it < 4096 * 32; it += GT) { const int t = (int)(it >> 5), i = (int)(it & 31);
            const float inv = powf(10000.0f, -(float)i / 32.0f); const float ang = (float)t * inv; float sn, cs; sincosf(ang, &sn, &cs);
            ROPE[2 * it] = cs; ROPE[2 * it + 1] = sn; }
        LAS float* scr = (LAS float*)(ldsp + RING_OFF + wave * 16384);
        constexpr int I_IN = 16 * 145, I_OUT = 24 * 32, I_GU = 16 * 64, I_DN = 16 * 32, I_R = 16;
        constexpr int NIT = NLAYER * (I_IN + I_OUT + I_R) + NLAYER * NEXP * (I_GU + I_DN);
        for (int it = gw; it < NIT; it += NGW) {
            int r = it;
            if (r < NLAYER * I_IN) { const int l = r / I_IN; r %= I_IN; p0_transpose_item<1>(in_win + (size_t)l * DM * INW, DM, INW, WIN + (size_t)l * NPROJ * DM, WDT + (size_t)l * 8 * 1024, scr, r / 145, r % 145, lane); continue; } r -= NLAYER * I_IN;
            if (r < NLAYER * I_OUT) { const int l = r / I_OUT; r %= I_OUT; p0_transpose_item<0>(in_wout + (size_t)l * MIXW * DM, MIXW, DM, WOUT + (size_t)l * DM * MIXW, nullptr, scr, r / 32, r % 32, lane); continue; } r -= NLAYER * I_OUT;
            if (r < NLAYER * I_R) { const int l = r / I_R; r %= I_R; p0_transpose_item<0>(in_rw + (size_t)l * DM * NEXP, DM, NEXP, ROUT + (size_t)l * NEXP * DM, nullptr, scr, r, 0, lane); continue; } r -= NLAYER * I_R;
            if (r < NLAYER * NEXP * I_GU) { const int le = r / I_GU; r %= I_GU; p0_transpose_item<2>(in_wgu + (size_t)le * DM * 2048, DM, 2048, WGU + (size_t)le * 2048 * DM, nullptr, scr, r / 64, r % 64, lane); continue; } r -= NLAYER * NEXP * I_GU;
            { const int le = r / I_DN; r %= I_DN; p0_transpose_item<0>(in_wdn + (size_t)le * FF * DM, FF, DM, WDN + (size_t)le * DM * FF, nullptr, scr, r / 32, r % 32, lane); }
        }
        __syncthreads();
    }
    if (IN(0)) {
        for (int m = gw; m < MROWS; m += NGW) { const float* xr = in_x + (size_t)m * DM; bf16* ob = XB + (size_t)m * DM;
#pragma unroll
            for (int j = 0; j < 4; ++j) { const f32x4 v = *(const f32x4*)(xr + 4 * lane + 256 * j); v2u w; w.x = pk2(v[0], v[1]); w.y = pk2(v[2], v[3]); *(v2u*)(ob + 4 * lane + 256 * j) = w; } }
    }

    SEAM(0);
    run_layer<0>(args, lo, hi, bar);
    run_layer<1>(args, lo, hi, bar);
#undef IN
#undef SEAM
}

extern "C" void kernel_launch(void* const* d_in, const int* in_sizes, int n_in, void* d_out, int out_size, void* d_ws, size_t ws_size, hipStream_t stream) {
    static int grid = 0;
    if (grid == 0) {
        if (n_in != 20 || out_size != MROWS * DM || ws_size < WS_END) { fprintf(stderr, "kernel_launch: unexpected problem (n_in %d, out %d, ws %zu)\n", n_in, out_size, ws_size); grid = -1; return; }
        if (hipFuncSetAttribute((const void*)mk_fwd, hipFuncAttributeMaxDynamicSharedMemorySize, LDS_BYTES) != hipSuccess) { fprintf(stderr, "kernel_launch: hipFuncSetAttribute failed\n"); grid = -1; return; }
        int dev = 0, cus = 0, per_cu = 0;
        (void)hipGetDevice(&dev); (void)hipDeviceGetAttribute(&cus, hipDeviceAttributeMultiprocessorCount, dev);
        if (hipOccupancyMaxActiveBlocksPerMultiprocessor(&per_cu, (const void*)mk_fwd, NWAVES * 64, LDS_BYTES) != hipSuccess || per_cu < 1) fprintf(stderr, "kernel_launch: occupancy query says %d\n", per_cu);
        (void)hipGetLastError();
        grid = cus > 0 ? cus : 256;
    }
    if (grid < 0) return;
    (void)hipMemsetAsync((char*)d_ws + WS_CTL, 0, CTL_ZERO_BYTES, stream);
    Args a{};
    for (int i = 0; i < 20; ++i) a.in[i] = (const float*)d_in[i];
    a.out = (float*)d_out; a.ws = (unsigned char*)d_ws;
    a.ph_lo = 0; a.ph_hi = N_PHASES;
    hipLaunchKernelGGL(mk_fwd, dim3(grid), dim3(NWAVES * 64), LDS_BYTES, stream, a);
}
```

```cpp
#include <hip/hip_runtime.h>
#include <cstdio>
#include <cstdint>
#include <cmath>

namespace pg8 {
#define PG8_LAS __attribute__((address_space(3)))
typedef unsigned short bf16_t;
typedef short bf16x8 __attribute__((ext_vector_type(8)));
typedef float f32x4 __attribute__((ext_vector_type(4)));
typedef float f32x2 __attribute__((ext_vector_type(2)));
typedef unsigned u32x4 __attribute__((ext_vector_type(4)));
constexpr int BM = 256, BK = 64, HALF = 128, HTB = HALF * BK * 2  , STAGE_BYTES = 8 * HTB, NXCD = 8, WGM = 8;

__host__ __device__ __forceinline__ int lds_byte(int r, int c) { const int st = (r >> 4) * 2 + (c >> 5), rr = r & 15, cc = c & 31, ob = rr * 64 + cc * 2; return st * 1024 + (ob ^ (((ob >> 9) & 1) << 5)); }
__host__ __device__ __forceinline__ void stage_rc(int b, int& R, int& C) { const int st = b / 1024, sb = b % 1024, swz = sb ^ (((sb >> 9) & 1) << 5); R = (st >> 1) * 16 + swz / 64; C = (st & 1) * 32 + (swz % 64) / 2; }
__host__ __device__ __forceinline__ int perm32(int rho) { const int n = rho >> 4, i = rho & 15; return 8 * (i >> 2) + 4 * n + (i & 3); }

struct Unit { int pm, pn, e, r0; };
struct Gemm { const bf16_t* A; const bf16_t* Bt; int M, N, K; };

struct StaticOrder {
    int nM, nN, nwg, G, c;
    __device__ void init(int M, int N, int G_, int c_) { nM = M / BM; nN = N / BM; nwg = nM * nN; G = G_; c = c_; }
    __device__ __forceinline__ bool next(int i, Unit& u) const {
        const long L = (long)i * G + c; if (L >= nwg) return false;
        int wgid = (int)L; { const int q = nwg / NXCD, r = nwg % NXCD, xcd = wgid % NXCD, off = wgid / NXCD; wgid = (xcd < r ? xcd * (q + 1) : r * (q + 1) + (xcd - r) * q) + off; }
        const int nig = WGM * nN, gid = wgid / nig, fm = gid * WGM, gsz = (nM - fm) < WGM ? (nM - fm) : WGM;
        u.pm = fm + ((wgid % nig) % gsz); u.pn = (wgid % nig) / gsz; u.e = 0; u.r0 = 0; return true;
    }
    __device__ __forceinline__ const char* abase(const Unit& u, const Gemm& g, size_t tstep) const { return (const char*)g.A + (size_t)u.pm * tstep; }
    __device__ __forceinline__ const char* bbase(const Unit& u, const Gemm& g, size_t tstep) const { return (const char*)g.Bt + (size_t)u.pn * tstep; }
    __device__ __forceinline__ unsigned arow(const Unit&, int) const { return 0u; }
    __device__ __forceinline__ void a_ready(const Unit&) const {}
    __device__ __forceinline__ void done(const Unit&) const {}
};

struct MoeOrder {
    const PG8_LAS int* units;
    int nunits;
    const PG8_LAS int* cnt;
    const int* rowtok;
    int gather;
    size_t bstride;
    __device__ __forceinline__ bool next(int i, Unit& u) const {
        if (i >= nunits) return false;
        u.pm = __builtin_amdgcn_readfirstlane(units[4 * i + 0]); u.pn = __builtin_amdgcn_readfirstlane(units[4 * i + 1]);
        u.e = __builtin_amdgcn_readfirstlane(units[4 * i + 2]); u.r0 = __builtin_amdgcn_readfirstlane(units[4 * i + 3]); return true;
    }
    __device__ __forceinline__ const char* abase(const Unit& u, const Gemm& g, size_t tstep) const { return gather ? (const char*)g.A : (const char*)g.A + (size_t)u.pm * tstep; }
    __device__ __forceinline__ const char* bbase(const Unit& u, const Gemm& g, size_t tstep) const { return (const char*)g.Bt + (size_t)u.e * bstride + (size_t)u.pn * tstep; }
    __device__ __forceinline__ unsigned arow(const Unit& u, int R) const {
        const int r = u.r0 + R; const int idx = (r < cnt[u.e]) ? rowtok[(size_t)u.e * 32768 + r] : 0; return (unsigned)(idx >> 2) * 2048u; }
    __device__ __forceinline__ void a_ready(const Unit&) const {}
    __device__ __forceinline__ void done(const Unit&) const {}
};
__device__ __forceinline__ void moe_build_units(PG8_LAS int* units, PG8_LAS int* units_n, const PG8_LAS int* tstart, int nN, int G, int c, int tid) {
    if (tid < 64) {
        const int nT = tstart[32], nwg = nT * nN; const long L = (long)tid * G + c;
        int pm = 0, pn = 0, e = 0, r0 = 0;
        if (L < nwg) {
            int wgid = (int)L; { const int q = nwg / NXCD, r = nwg % NXCD, xcd = wgid % NXCD, off = wgid / NXCD; wgid = (xcd < r ? xcd * (q + 1) : r * (q + 1) + (xcd - r) * q) + off; }
            const int nig = WGM * nN, gid = wgid / nig, fm = gid * WGM, gsz = (nT - fm) < WGM ? (nT - fm) : WGM;
            pm = fm + ((wgid % nig) % gsz); pn = (wgid % nig) / gsz;
            for (int j = 1; j < 32; ++j) e += (tstart[j] <= pm) ? 1 : 0;
            r0 = (pm - tstart[e]) * 256;
        }
        units[4 * tid + 0] = pm; units[4 * tid + 1] = pn; units[4 * tid + 2] = e; units[4 * tid + 3] = r0;
        if (tid == 0) { int n = 0; if (c < nwg) n = (nwg - c + G - 1) / G; units_n[0] = n < 64 ? n : 64; }
    }
}

__device__ __forceinline__ unsigned cvt_pk_bf16(float lo, float hi) { unsigned r; asm volatile("v_cvt_pk_bf16_f32 %0, %1, %2" : "=v"(r) : "v"(lo), "v"(hi)); return r; }

struct EpiProj {
    static constexpr bool PERM = true, AFTER_DRAIN = false;
    bf16_t* O; int ldc; const float* rope; float qscale;
    __device__ __forceinline__ void operator()(const f32x4 (&acc)[2][2][4][2], const Unit& u, int wr, int wc, int fr, int fq) const {
        const int row0 = u.pm * BM + wr * 64 + fr; const int col0 = u.pn * BM + wc * 32 + 8 * fq;
        const bool rot = u.pn < 4; const float sc = u.pn < 2 ? qscale : 1.f; const int gq = 4 * (wc & 1) + fq;
#pragma unroll
        for (int ai = 0; ai < 2; ++ai)
#pragma unroll
            for (int m = 0; m < 4; ++m) { const int row = row0 + ai * HALF + m * 16; bf16_t* rowp = O + (size_t)row * ldc + col0;
                f32x4 cs0 = (f32x4){1.f, 0.f, 1.f, 0.f}, cs1 = cs0;
                if (rot) { const float* rp = rope + ((size_t)(row & 4095) * 32 + 4 * gq) * 2; cs0 = *(const f32x4*)rp; cs1 = *(const f32x4*)(rp + 4); }
#pragma unroll
                for (int bj = 0; bj < 2; ++bj) { f32x4 v0 = acc[ai][bj][m][0], v1 = acc[ai][bj][m][1];
                    if (rot) { f32x4 lo, hi;
                        lo[0] = v0[0] * cs0[0] - v1[0] * cs0[1]; hi[0] = v1[0] * cs0[0] + v0[0] * cs0[1];
                        lo[1] = v0[1] * cs0[2] - v1[1] * cs0[3]; hi[1] = v1[1] * cs0[2] + v0[1] * cs0[3];
                        lo[2] = v0[2] * cs1[0] - v1[2] * cs1[1]; hi[2] = v1[2] * cs1[0] + v0[2] * cs1[1];
                        lo[3] = v0[3] * cs1[2] - v1[3] * cs1[3]; hi[3] = v1[3] * cs1[2] + v0[3] * cs1[3];
                        v0 = lo * sc; v1 = hi * sc; }
                    u32x4 w; w.x = cvt_pk_bf16(v0[0], v0[1]); w.y = cvt_pk_bf16(v0[2], v0[3]); w.z = cvt_pk_bf16(v1[0], v1[1]); w.w = cvt_pk_bf16(v1[2], v1[3]);
                    *(u32x4*)(rowp + bj * HALF) = w; } }
    }
};
struct EpiF32 {
    static constexpr bool PERM = false, AFTER_DRAIN = false;
    float* O; int ldc;
    __device__ __forceinline__ void operator()(const f32x4 (&acc)[2][2][4][2], const Unit& u, int wr, int wc, int fr, int fq) const {
        const int row0 = u.pm * BM + wr * 64 + fr; const int col0 = u.pn * BM + wc * 32 + 4 * fq;
#pragma unroll
        for (int ai = 0; ai < 2; ++ai)
#pragma unroll
            for (int m = 0; m < 4; ++m) { float* rowp = O + (size_t)(row0 + ai * HALF + m * 16) * ldc + col0;
#pragma unroll
                for (int bj = 0; bj < 2; ++bj)
#pragma unroll
                    for (int n = 0; n < 2; ++n) *(f32x4*)(rowp + bj * HALF + n * 16) = acc[ai][bj][m][n]; }
    }
};
struct EpiSwiglu {
    static constexpr bool PERM = true, AFTER_DRAIN = false;
    bf16_t* H; const float* bgu; const float* rowgate; const PG8_LAS int* cnt;
    __device__ __forceinline__ void operator()(const f32x4 (&acc)[2][2][4][2], const Unit& u, int wr, int wc, int fr, int fq) const {
        const int ff = u.pn * HALF + wc * 32 + 8 * fq; const int n_e = cnt[u.e];
        f32x4 bg[2], bu[2];
#pragma unroll
        for (int n = 0; n < 2; ++n) { bg[n] = *(const f32x4*)(bgu + (size_t)u.e * 2048 + ff + 4 * n); bu[n] = *(const f32x4*)(bgu + (size_t)u.e * 2048 + 1024 + ff + 4 * n); }
#pragma unroll
        for (int ai = 0; ai < 2; ++ai)
#pragma unroll
            for (int m = 0; m < 4; ++m) { const int r = ai * HALF + wr * 64 + m * 16 + fr; const int er = u.r0 + r;
                const float rg = (er < n_e) ? rowgate[(size_t)u.e * 32768 + er] : 0.f;
                float hv[8];
#pragma unroll
                for (int n = 0; n < 2; ++n)
#pragma unroll
                    for (int q = 0; q < 4; ++q) { float g = acc[ai][0][m][n][q] + bg[n][q], up = acc[ai][1][m][n][q] + bu[n][q];
                        g = fminf(g, 7.0f); up = fminf(fmaxf(up, -7.0f), 7.0f);
                        const float sg = __builtin_amdgcn_rcpf(1.0f + __builtin_amdgcn_exp2f(-1.702f * 1.4426950408889634f * g));
                        hv[n * 4 + q] = (up + 1.0f) * g * sg * rg; }
                u32x4 w; w.x = cvt_pk_bf16(hv[0], hv[1]); w.y = cvt_pk_bf16(hv[2], hv[3]); w.z = cvt_pk_bf16(hv[4], hv[5]); w.w = cvt_pk_bf16(hv[6], hv[7]);
                *(u32x4*)(H + (size_t)(u.pm * BM + r) * 1024 + ff) = w; }
    }
};
struct EpiScatter {
    static constexpr bool PERM = true, AFTER_DRAIN = false;
    bf16_t* Y; const int* rowtok; const PG8_LAS int* cnt;
    __device__ __forceinline__ void operator()(const f32x4 (&acc)[2][2][4][2], const Unit& u, int wr, int wc, int fr, int fq) const {
        const int col0 = u.pn * BM + wc * 32 + 8 * fq; const int n_e = cnt[u.e];
#pragma unroll
        for (int ai = 0; ai < 2; ++ai)
#pragma unroll
            for (int m = 0; m < 4; ++m) { const int er = u.r0 + ai * HALF + wr * 64 + m * 16 + fr;
                if (er < n_e) { const int idx = rowtok[(size_t)u.e * 32768 + er]; bf16_t* rowp = Y + (size_t)idx * 1024 + col0;
#pragma unroll
                    for (int bj = 0; bj < 2; ++bj) { const f32x4 v0 = acc[ai][bj][m][0], v1 = acc[ai][bj][m][1];
                        u32x4 w; w.x = cvt_pk_bf16(v0[0], v0[1]); w.y = cvt_pk_bf16(v0[2], v0[3]); w.z = cvt_pk_bf16(v1[0], v1[1]); w.w = cvt_pk_bf16(v1[2], v1[3]);
                        *(u32x4*)(rowp + bj * HALF) = w; } } }
    }
};

template <class Epi, class Sched, bool ALIGN_EPI, bool GATHER>
__device__ __forceinline__ void gemm_phase(PG8_LAS unsigned char* lds, const Gemm g, const Sched& S, const Epi& E) {
    const int tid = threadIdx.x, wid = __builtin_amdgcn_readfirstlane(tid >> 6), lane = tid & 63, wr = wid >> 2, wc = wid & 3, fr = lane & 15, fq = lane >> 4;
    const int K = g.K, nt = K / BK;
    int sR[2], sC2[2]; unsigned voffB[2];
#pragma unroll
    for (int i = 0; i < 2; ++i) { int R, C; stage_rc(tid * 16 + i * 8192, R, C); const int Rb = Epi::PERM ? ((R & ~31) + perm32(R & 31)) : R;
        sR[i] = R; sC2[i] = C * 2; voffB[i] = (unsigned)(Rb * K + C) * 2u; }
    const size_t kstep = (size_t)(BK * 2);
    const size_t hstep = (size_t)HALF * K * 2;
    const size_t tstep = 2 * hstep;
    const unsigned ldsw = (unsigned)wid * 1024u;
    const int aoff = lds_byte(wr * 64 + fr, fq * 8), boff = lds_byte(wc * 32 + fr, fq * 8);
#define PG8_SA(b, h) (((b) * 2 + (h)) * HTB)
#define PG8_SB(b, h) ((4 + (b) * 2 + (h)) * HTB)
#define PG8_STAGE(bufoff, gbase, voff) do { _Pragma("unroll") for (int _i = 0; _i < 2; ++_i) \
        __builtin_amdgcn_global_load_lds((const unsigned*)((const char*)(gbase) + (voff)[_i]), (PG8_LAS unsigned*)(lds + (bufoff) + ldsw + _i * 8192), 16, 0, 0); } while (0)
#define PG8_LDA(dst, b, h) do { _Pragma("unroll") for (int m = 0; m < 4; ++m) _Pragma("unroll") for (int k = 0; k < 2; ++k) dst[m][k] = *(const PG8_LAS bf16x8*)(lds + PG8_SA(b, h) + aoff + m * 2048 + k * 1024); } while (0)
#define PG8_LDB(dst, b, h) do { _Pragma("unroll") for (int n = 0; n < 2; ++n) _Pragma("unroll") for (int k = 0; k < 2; ++k) dst[n][k] = *(const PG8_LAS bf16x8*)(lds + PG8_SB(b, h) + boff + n * 2048 + k * 1024); } while (0)
#define PG8_MMA(ai, bj, At, Bt) do { __builtin_amdgcn_s_setprio(1); _Pragma("unroll") for (int m = 0; m < 4; ++m) _Pragma("unroll") for (int n = 0; n < 2; ++n) _Pragma("unroll") for (int k = 0; k < 2; ++k) \
        acc[ai][bj][m][n] = __builtin_amdgcn_mfma_f32_16x16x32_bf16(Bt[n][k], At[m][k], acc[ai][bj][m][n], 0, 0, 0); __builtin_amdgcn_s_setprio(0); } while (0)
#define PG8_WAIT_V(n) asm volatile("s_waitcnt vmcnt(" #n ")" ::: "memory")
#define PG8_WAIT_L(n) asm volatile("s_waitcnt lgkmcnt(" #n ")" ::: "memory")
#define PG8_BAR __builtin_amdgcn_s_barrier()
#define PG8_SCHED __builtin_amdgcn_sched_barrier(0)
#define PG8_SETOFFS(o, u) do { _Pragma("unroll") for (int _h = 0; _h < 2; ++_h) _Pragma("unroll") for (int _i = 0; _i < 2; ++_i) \
        o[_h][_i] = GATHER ? (S.arow(u, sR[_i] + HALF * _h) + (unsigned)sC2[_i]) : ((unsigned)((sR[_i] + HALF * _h) * K) * 2u + (unsigned)sC2[_i]); } while (0)
    Unit cur, nxt; int ui = 0;
    if (!S.next(0, cur)) return;
    f32x4 acc[2][2][4][2];
#pragma unroll
    for (int a = 0; a < 2; ++a)
#pragma unroll
        for (int b = 0; b < 2; ++b)
#pragma unroll
            for (int m = 0; m < 4; ++m)
#pragma unroll
                for (int n = 0; n < 2; ++n) acc[a][b][m][n] = (f32x4){0.f, 0.f, 0.f, 0.f};
    bf16x8 At[4][2], B0[2][2], B1[2][2];
    unsigned cAo[2][2], nAo[2][2];
    PG8_SETOFFS(cAo, cur);
    const char* cA = S.abase(cur, g, tstep); const char* cB = S.bbase(cur, g, tstep);
    S.a_ready(cur);
    PG8_STAGE(PG8_SB(0, 0), cB, voffB); PG8_STAGE(PG8_SB(0, 1), cB + hstep, voffB); PG8_STAGE(PG8_SA(0, 0), cA, cAo[0]); PG8_STAGE(PG8_SA(0, 1), cA, cAo[1]);
    if (wr == 1) PG8_BAR;
    PG8_WAIT_V(2); PG8_BAR;
    PG8_STAGE(PG8_SB(1, 0), cB + kstep, voffB); PG8_STAGE(PG8_SA(1, 0), cA + kstep, cAo[0]); PG8_STAGE(PG8_SB(1, 1), cB + hstep + kstep, voffB);
    PG8_WAIT_V(6); PG8_BAR;
    for (;;) {
        const bool has_next = S.next(ui + 1, nxt);
        const char* nA = has_next ? S.abase(nxt, g, tstep) : cA; const char* nB = has_next ? S.bbase(nxt, g, tstep) : cB;
        if (has_next) { PG8_SETOFFS(nAo, nxt); } else {
#pragma unroll
            for (int _h = 0; _h < 2; ++_h)
#pragma unroll
                for (int _i = 0; _i < 2; ++_i) nAo[_h][_i] = cAo[_h][_i]; }
        for (int t = 0; t < nt; t += 2) {
            const bool last = (t == nt - 2);
            const char* a1 = cA + (size_t)(t + 1) * kstep;
            const char* a2 = last ? nA : cA + (size_t)(t + 2) * kstep; const char* b2 = last ? nB : cB + (size_t)(t + 2) * kstep;
            const char* a3 = a2 + kstep; const char* b3 = b2 + kstep;
            unsigned o2[2][2];
#pragma unroll
            for (int _h = 0; _h < 2; ++_h)
#pragma unroll
                for (int _i = 0; _i < 2; ++_i) o2[_h][_i] = last ? nAo[_h][_i] : cAo[_h][_i];
            if (last && has_next) S.a_ready(nxt);
            PG8_LDB(B0, 0, 0); PG8_LDB(B1, 0, 1); PG8_SCHED; PG8_LDA(At, 0, 0); PG8_STAGE(PG8_SA(1, 1), a1, cAo[1]);
            PG8_WAIT_V(8); PG8_WAIT_L(0); PG8_BAR; PG8_MMA(0, 0, At, B0); PG8_MMA(0, 1, At, B1); PG8_BAR; PG8_SCHED;
            PG8_LDA(At, 0, 1); PG8_STAGE(PG8_SB(0, 0), b2, voffB); PG8_STAGE(PG8_SB(0, 1), b2 + hstep, voffB); PG8_STAGE(PG8_SA(0, 0), a2, o2[0]);
            PG8_WAIT_V(8); PG8_WAIT_L(0); PG8_BAR; PG8_MMA(1, 0, At, B0); PG8_MMA(1, 1, At, B1); PG8_BAR; PG8_SCHED;
            PG8_LDB(B0, 1, 0); PG8_LDB(B1, 1, 1); PG8_SCHED; PG8_LDA(At, 1, 0); PG8_STAGE(PG8_SA(0, 1), a2, o2[1]);
            PG8_WAIT_V(8); PG8_WAIT_L(0); PG8_BAR; PG8_MMA(0, 0, At, B0); PG8_MMA(0, 1, At, B1); PG8_BAR; PG8_SCHED;
            PG8_LDA(At, 1, 1); PG8_STAGE(PG8_SB(1, 0), b3, voffB); PG8_STAGE(PG8_SB(1, 1), b3 + hstep, voffB); PG8_STAGE(PG8_SA(1, 0), a3, o2[0]);
            PG8_WAIT_V(8); PG8_WAIT_L(0); PG8_BAR; PG8_MMA(1, 0, At, B0); PG8_MMA(1, 1, At, B1); PG8_BAR; PG8_SCHED;
        }
        if constexpr (ALIGN_EPI) { if (wr == 0) PG8_BAR; }
        E(acc, cur, wr, wc, fr, fq); S.done(cur);
        if (!has_next) break;
#pragma unroll
        for (int a = 0; a < 2; ++a)
#pragma unroll
            for (int b = 0; b < 2; ++b)
#pragma unroll
                for (int m = 0; m < 4; ++m)
#pragma unroll
                    for (int n = 0; n < 2; ++n) acc[a][b][m][n] = (f32x4){0.f, 0.f, 0.f, 0.f};
        cur = nxt; cA = nA; cB = nB; ++ui;
#pragma unroll
        for (int _h = 0; _h < 2; ++_h)
#pragma unroll
            for (int _i = 0; _i < 2; ++_i) cAo[_h][_i] = nAo[_h][_i];
        if constexpr (ALIGN_EPI) { if (wr == 1) PG8_BAR; }
    }
    PG8_WAIT_V(0);
    if constexpr (!ALIGN_EPI) { if (wr == 0) PG8_BAR; }
    PG8_BAR;
#undef PG8_SA
#undef PG8_SB
#undef PG8_STAGE
#undef PG8_LDA
#undef PG8_LDB
#undef PG8_MMA
#undef PG8_WAIT_V
#undef PG8_WAIT_L
#undef PG8_BAR
#undef PG8_SCHED
#undef PG8_SETOFFS
}
}

constexpr int NB = 8, SEQ = 4096, DM = 1024, MROWS = NB * SEQ, NLAYER = 2;
constexpr int NPROJ = 4608, INW = 4616;
constexpr int C_Q = 0, C_K = 512, C_V = 1024, C_Z = 1536, C_XS = 2048, C_SB = 3072, C_SC = 3584, C_SH = 4096;
constexpr int MIXW = 1536, NEXP = 32, TOPK = 4, FF = 1024;
constexpr float ALPHA = 1.4142135623730951f;
constexpr float LN_EPS = 1e-5f, RMS_EPS = 1e-5f;
constexpr float QSCALE = 0.125f * 1.4426950408889634f;

constexpr size_t MiB = 1u << 20;
constexpr size_t WS_CTL = 0, CTL_ZERO_BYTES = 1 * MiB;
constexpr size_t WS_ROPE = 1 * MiB;
constexpr size_t WS_WDT = 2 * MiB;
constexpr size_t WS_ROUT = 2 * MiB + 65536;
constexpr size_t WS_WIN = 4 * MiB;
constexpr size_t WS_WOUT = 24 * MiB;
constexpr size_t WS_WGU = 32 * MiB;
constexpr size_t WS_WDN = 288 * MiB;
constexpr size_t WS_XB = 416 * MiB;
constexpr size_t WS_XF = 480 * MiB;
constexpr size_t WS_XF2 = 608 * MiB;
constexpr size_t WS_PROJ = 736 * MiB;
constexpr size_t WS_DT = 1024 * MiB;
constexpr size_t WS_DTS = 1025 * MiB;
constexpr size_t WS_ACUM = 1026 * MiB;
constexpr size_t WS_LSE = 1027 * MiB;
constexpr size_t WS_OP = 1030 * MiB;
constexpr size_t WS_U = 1126 * MiB;
constexpr size_t WS_G = 1190 * MiB;
constexpr size_t WS_ST = 1222 * MiB;
constexpr size_t WS_YD = 1286 * MiB;
constexpr size_t WS_MIXED = 1350 * MiB;
constexpr size_t WS_MIXF = 1446 * MiB;
constexpr size_t WS_TOPE = 1574 * MiB;
constexpr size_t WS_TOPG = 1575 * MiB;
constexpr size_t WS_ROWTOK = 1576 * MiB;
constexpr size_t WS_ROWGATE = 1580 * MiB;
constexpr size_t WS_H = 736 * MiB;
constexpr size_t WS_YB = 1030 * MiB;
constexpr size_t WS_END = 1584 * MiB;
constexpr int CW_TMO = 0;
constexpr int CW_CNT = 64;
constexpr int CW_BAR = 4096;

constexpr int RING_OFF = 0, RING_BYTES = 131072;
constexpr int LDSCTL_OFF = RING_BYTES;
constexpr int L_MISC = LDSCTL_OFF;
constexpr int L_TSTART = LDSCTL_OFF + 256;
constexpr int L_CNT = LDSCTL_OFF + 512;
constexpr int L_LCNT = LDSCTL_OFF + 640;
constexpr int L_LBASE = LDSCTL_OFF + 768;
constexpr int L_UNITS = LDSCTL_OFF + 1024;
constexpr int L_UNITSN = LDSCTL_OFF + 2048;
constexpr int LDS_BYTES = 147456;

#define GAS __attribute__((address_space(1)))
#define LAS __attribute__((address_space(3)))
typedef unsigned short bf16;
typedef unsigned v4u __attribute__((ext_vector_type(4)));
typedef unsigned v2u __attribute__((ext_vector_type(2)));
typedef float f32x4 __attribute__((ext_vector_type(4)));
typedef float f32x16 __attribute__((ext_vector_type(16)));
typedef short bf16x8 __attribute__((ext_vector_type(8)));
typedef GAS unsigned gu32;
#define RLX_AGENT __ATOMIC_RELAXED, __HIP_MEMORY_SCOPE_AGENT
#define LDS_WAIT() asm volatile("s_waitcnt lgkmcnt(0)" ::: "memory")
#define VM_WAIT() asm volatile("s_waitcnt vmcnt(0)" ::: "memory")
__device__ __forceinline__ unsigned f2bf(float f) { unsigned u = __builtin_bit_cast(unsigned, f); return (u + 0x7fffu + ((u >> 16) & 1u)) >> 16; }
__device__ __forceinline__ unsigned pk2(float lo, float hi) { return f2bf(lo) | (f2bf(hi) << 16); }
__device__ __forceinline__ float bf2f(unsigned short b) { return __builtin_bit_cast(float, (unsigned)b << 16); }
__device__ __forceinline__ float bflo(unsigned w) { return __builtin_bit_cast(float, w << 16); }
__device__ __forceinline__ float bfhi(unsigned w) { return __builtin_bit_cast(float, w & 0xffff0000u); }
__device__ __forceinline__ float siluf(float x) { return x / (1.0f + __expf(-x)); }
#define XB_TMO      128
#define XB_XCNT(j)  (256  + 64 * (j))
#define XB_XSUB(j)  (1280 + 64 * (j))
#define XB_XGEN(j)  (2304 + 64 * (j))
#define XB_TOP      3328
#define XB_TOPGEN   3392
#define XCD_BAR_WORDS 3456
#define XB_SPIN_CAP (1u << 18)

__device__ __forceinline__ unsigned xb_ld(unsigned* p)              { return __hip_atomic_load(p, __ATOMIC_RELAXED, __HIP_MEMORY_SCOPE_AGENT); }
__device__ __forceinline__ unsigned xb_add(unsigned* p, unsigned v) { return __hip_atomic_fetch_add(p, v, __ATOMIC_RELAXED, __HIP_MEMORY_SCOPE_AGENT); }
__device__ __forceinline__ unsigned xb_xcc_id() { return (unsigned)__builtin_amdgcn_s_getreg((3 << 11) | 20) & 0xFu; }
#define XB_SPIN(cond, bar) do { unsigned _sp = 0; while (cond) { __builtin_amdgcn_s_sleep(1); \
    if ((++_sp & 255u) == 0u) { if (xb_ld(&(bar)[XB_TMO])) break; if (_sp > XB_SPIN_CAP) { atomicAdd(&(bar)[XB_TMO], 1u); break; } } } } while (0)

struct XcdBarrier {
    unsigned* bar; unsigned x;
    volatile LAS unsigned* st;
};

__device__ __forceinline__ XcdBarrier xcd_barrier_post(unsigned* bar, volatile LAS unsigned* st) {
    XcdBarrier b; b.bar = bar; b.x = xb_xcc_id(); b.st = st;
    if (threadIdx.x == 0) (void)xb_add(&bar[XB_XCNT(b.x)], 1u);
    return b;
}
__device__ __forceinline__ void xcd_barrier_complete(unsigned* bar, unsigned x, unsigned& nloc, unsigned& nx) {
    const unsigned G = gridDim.x * gridDim.y * gridDim.z;
    unsigned sum, cnt, mine, sp = 0u;
    for (;;) {
        sum = 0u; cnt = 0u; mine = 0u;
#pragma unroll
        for (unsigned j = 0; j < 16; ++j) { const unsigned c = xb_ld(&bar[XB_XCNT(j)]); sum += c; cnt += (c > 0u) ? 1u : 0u; mine = (j == x) ? c : mine; }
        if (sum == G) break;
        __builtin_amdgcn_s_sleep(1);
        if ((++sp & 255u) == 0u) { if (xb_ld(&bar[XB_TMO])) break; if (sp > XB_SPIN_CAP) { atomicAdd(&bar[XB_TMO], 1u); break; } }
    }
    nloc = mine > 0u ? mine : 1u; nx = cnt > 0u ? cnt : 1u;
}

__device__ __forceinline__ void xcd_barrier(const XcdBarrier& b) {
    asm volatile("s_waitcnt vmcnt(0)" ::: "memory");
    __syncthreads();
    if (threadIdx.x == 0) {
        unsigned* bar = b.bar;
        __builtin_amdgcn_s_waitcnt(0);
        unsigned nloc = b.st[0], nx = b.st[1];
        if (nloc == 0u) { xcd_barrier_complete(bar, b.x, nloc, nx); b.st[0] = nloc; b.st[1] = nx; }
        const unsigned old = xb_add(&bar[XB_XSUB(b.x)], 1u);
        const unsigned gen = old / nloc;
        if (old + 1u == (gen + 1u) * nloc) {
            __builtin_amdgcn_fence(__ATOMIC_RELEASE, "agent");
            asm volatile("s_waitcnt vmcnt(0)" ::: "memory");
            const unsigned og = xb_add(&bar[XB_TOP], 1u);
            const unsigned tg = og / nx;
            if (og + 1u == (tg + 1u) * nx) xb_add(&bar[XB_TOPGEN], 1u);
            else XB_SPIN(xb_ld(&bar[XB_TOPGEN]) == tg, bar);
            __builtin_amdgcn_fence(__ATOMIC_ACQUIRE, "agent");
            xb_add(&bar[XB_XGEN(b.x)], 1u);
            asm volatile("s_waitcnt vmcnt(0)" ::: "memory");
        } else {
            XB_SPIN(xb_ld(&bar[XB_XGEN(b.x)]) == gen, bar);
            __builtin_amdgcn_fence(__ATOMIC_ACQUIRE, "agent");
            asm volatile("s_waitcnt vmcnt(0)" ::: "memory");
        }
    }
    __syncthreads();
}

__device__ __forceinline__ float wave_sum(float v) {
#pragma unroll
    for (int o = 1; o < 64; o <<= 1) v += __shfl_xor(v, o);
    return v;
}
__device__ __forceinline__ int win_dest_row(int n) {
    if (n < 1024) { const int hh = n >> 6, d = n & 63; const int p = (d < 32) ? (8 * (d >> 2) + (d & 3)) : (8 * ((d - 32) >> 2) + 4 + (d & 3)); return hh * 64 + p; }
    if (n < 3072) return n;
    if (n < 3080) return -1;
    return n - 8;
}
__device__ __forceinline__ int wgu_dest_row(int n) { return n < 1024 ? ((n >> 7) * 256 + (n & 127)) : (((n - 1024) >> 7) * 256 + 128 + ((n - 1024) & 127)); }
template <int MAP>
__device__ __forceinline__ void p0_transpose_item(const float* W, int K, int N, bf16* WT, float* wdt, LAS float* scr, int kb, int nb, int lane) {
    const int k0 = 64 * kb, n0 = 32 * nb;
    const int nn = n0 + (lane & 31); const bool nok = nn < N;
#pragma unroll 8
    for (int i = 0; i < 32; ++i) { const int kk = 2 * i + (lane >> 5); scr[kk * 33 + (lane & 31)] = nok ? W[(size_t)(k0 + kk) * N + nn] : 0.f; }
    LDS_WAIT(); asm volatile("" ::: "memory");
    const int c = lane & 7;
#pragma unroll
    for (int j = 0; j < 4; ++j) { const int n = (lane >> 3) + 8 * j; const LAS float* s = scr + (8 * c) * 33 + n;
        const int nsrc = n0 + n; if (nsrc >= N) continue;
        int drow = nsrc; if (MAP == 1) drow = win_dest_row(nsrc); if (MAP == 2) drow = wgu_dest_row(nsrc);
        if (MAP == 1 && drow < 0) { float* d = wdt + (size_t)(nsrc - 3072) * 1024 + k0 + 8 * c;
#pragma unroll
            for (int q = 0; q < 8; ++q) d[q] = s[q * 33]; continue; }
        v4u o; o.x = pk2(s[0 * 33], s[1 * 33]); o.y = pk2(s[2 * 33], s[3 * 33]); o.z = pk2(s[4 * 33], s[5 * 33]); o.w = pk2(s[6 * 33], s[7 * 33]);
        *(GAS v4u*)(WT + (size_t)drow * K + k0 + 8 * c) = o; }
    LDS_WAIT(); asm volatile("" ::: "memory");
}
__device__ __forceinline__ void row_dt(const f32x4 (&v)[4], const float* wdt, float* dst, int lane) {
    float r[8];
#pragma unroll
    for (int jj = 0; jj < 8; ++jj) { float s = 0.f;
#pragma unroll
        for (int j = 0; j < 4; ++j) { const f32x4 w = *(const f32x4*)(wdt + jj * 1024 + 4 * lane + 256 * j); s += v[j][0] * w[0] + v[j][1] * w[1] + v[j][2] * w[2] + v[j][3] * w[3]; }
        r[jj] = wave_sum(s); }
    if (lane == 0) { *(f32x4*)dst = (f32x4){r[0], r[1], r[2], r[3]}; *(f32x4*)(dst + 4) = (f32x4){r[4], r[5], r[6], r[7]}; }
}
__device__ __forceinline__ void ln_row(f32x4 (&v)[4], const float* gam, const float* bet, float* of32, bf16* ob16, int lane) {
    float s = 0.f;
#pragma unroll
    for (int j = 0; j < 4; ++j) s += (v[j][0] + v[j][1]) + (v[j][2] + v[j][3]);
    const float mean = wave_sum(s) * (1.f / DM); float s2 = 0.f;
#pragma unroll
    for (int j = 0; j < 4; ++j) { v[j] = v[j] - mean; s2 += (v[j][0] * v[j][0] + v[j][1] * v[j][1]) + (v[j][2] * v[j][2] + v[j][3] * v[j][3]); }
    const float rstd = 1.f / sqrtf(wave_sum(s2) * (1.f / DM) + LN_EPS);
#pragma unroll
    for (int j = 0; j < 4; ++j) { const f32x4 g = *(const f32x4*)(gam + 4 * lane + 256 * j), b = *(const f32x4*)(bet + 4 * lane + 256 * j);
        v[j] = v[j] * rstd * g + b;
        *(f32x4*)(of32 + 4 * lane + 256 * j) = v[j];
        v2u w; w.x = pk2(v[j][0], v[j][1]); w.y = pk2(v[j][2], v[j][3]); *(v2u*)(ob16 + 4 * lane + 256 * j) = w; }
}


typedef short v4i16_t __attribute__((ext_vector_type(4)));
__device__ __forceinline__ bf16x8 tr_pair(const LAS unsigned char* p0, const LAS unsigned char* p1) {
    const v4i16_t a = __builtin_amdgcn_ds_read_tr16_b64_v4i16((LAS v4i16_t*)p0), b = __builtin_amdgcn_ds_read_tr16_b64_v4i16((LAS v4i16_t*)p1);
    return (bf16x8){a[0], a[1], a[2], a[3], b[0], b[1], b[2], b[3]};
}
__device__ __forceinline__ int crow16(int r, int hi) { return (r & 3) + 8 * (r >> 2) + 4 * hi; }
constexpr int AV_PITCH = 192;
__device__ __forceinline__ void attn_wave_unit(const bf16* PROJ, bf16* OPp, float* LSEp, int b, int h, int d, int r, int qt, LAS unsigned char* vl, int lane) {
    const int i = lane & 31, h2 = lane >> 5;
    const size_t rowq = (size_t)b * SEQ + (size_t)(32 * qt + i) * d + r;
    bf16x8 qf[4];
    { const bf16* qp = PROJ + rowq * NPROJ + C_Q + h * 64 + 8 * h2;
#pragma unroll
      for (int s = 0; s < 4; ++s) qf[s] = *(const bf16x8*)(qp + 16 * s); }
    f32x16 o0 = {}, o1 = {}; float mrun = -INFINITY, lrun = 0.f;
    const int kt0 = qt > 4 ? qt - 4 : 0;
    bf16x8 kf[4]; v4u vr[4];
    { const size_t rowk = (size_t)b * SEQ + (size_t)(32 * kt0 + i) * d + r; const bf16* kp = PROJ + rowk * NPROJ + C_K + h * 64 + 8 * h2;
#pragma unroll
      for (int s = 0; s < 4; ++s) kf[s] = *(const bf16x8*)(kp + 16 * s);
#pragma unroll
      for (int c = 0; c < 4; ++c) { const size_t rowv = (size_t)b * SEQ + (size_t)(32 * kt0 + (lane >> 3) + 8 * c) * d + r; vr[c] = *(const v4u*)(PROJ + rowv * NPROJ + C_V + h * 64 + 8 * (lane & 7)); } }
    const LAS unsigned char* trb = vl + (4 * h2 + ((lane & 15) >> 2)) * AV_PITCH + (16 * ((lane >> 4) & 1) + 4 * (lane & 3)) * 2;
#pragma unroll 1
    for (int kt = kt0; kt <= qt; ++kt) {
#pragma unroll
        for (int c = 0; c < 4; ++c) *(LAS v4u*)(vl + ((lane >> 3) + 8 * c) * AV_PITCH + (lane & 7) * 16) = vr[c];
        f32x16 sacc = {};
#pragma unroll
        for (int s = 0; s < 4; ++s) sacc = __builtin_amdgcn_mfma_f32_32x32x16_bf16(kf[s], qf[s], sacc, 0, 0, 0);
        if (kt < qt) {
            const size_t rowk = (size_t)b * SEQ + (size_t)(32 * (kt + 1) + i) * d + r; const bf16* kp = PROJ + rowk * NPROJ + C_K + h * 64 + 8 * h2;
#pragma unroll
            for (int s = 0; s < 4; ++s) kf[s] = *(const bf16x8*)(kp + 16 * s);
#pragma unroll
            for (int c = 0; c < 4; ++c) { const size_t rowv = (size_t)b * SEQ + (size_t)(32 * (kt + 1) + (lane >> 3) + 8 * c) * d + r; vr[c] = *(const v4u*)(PROJ + rowv * NPROJ + C_V + h * 64 + 8 * (lane & 7)); }
        }
        if (kt == qt) {
#pragma unroll
            for (int rg = 0; rg < 16; ++rg) if (crow16(rg, h2) > i) sacc[rg] = -INFINITY;
        }
        if (kt + 4 == qt) {
#pragma unroll
            for (int rg = 0; rg < 16; ++rg) if (crow16(rg, h2) < i) sacc[rg] = -INFINITY;
        }
        float mx = sacc[0];
#pragma unroll
        for (int rg = 1; rg < 16; ++rg) mx = fmaxf(mx, sacc[rg]);
        mx = fmaxf(mx, __shfl_xor(mx, 32));
        const float mnew = fmaxf(mrun, mx), alpha = __builtin_amdgcn_exp2f(mrun - mnew); mrun = mnew;
        float ps = 0.f;
#pragma unroll
        for (int rg = 0; rg < 16; ++rg) { sacc[rg] = __builtin_amdgcn_exp2f(sacc[rg] - mnew); ps += sacc[rg]; }
        lrun = lrun * alpha + ps;
#pragma unroll
        for (int rg = 0; rg < 16; ++rg) { o0[rg] *= alpha; o1[rg] *= alpha; }
        bf16x8 pf[2];
#pragma unroll
        for (int ks = 0; ks < 2; ++ks) { v4u w; w.x = pg8::cvt_pk_bf16(sacc[8 * ks + 0], sacc[8 * ks + 1]); w.y = pg8::cvt_pk_bf16(sacc[8 * ks + 2], sacc[8 * ks + 3]); w.z = pg8::cvt_pk_bf16(sacc[8 * ks + 4], sacc[8 * ks + 5]); w.w = pg8::cvt_pk_bf16(sacc[8 * ks + 6], sacc[8 * ks + 7]); pf[ks] = __builtin_bit_cast(bf16x8, w); }
#pragma unroll
        for (int ks = 0; ks < 2; ++ks) {
            const bf16x8 v0 = tr_pair(trb + (16 * ks) * AV_PITCH, trb + (16 * ks + 8) * AV_PITCH);
            const bf16x8 v1 = tr_pair(trb + (16 * ks) * AV_PITCH + 64, trb + (16 * ks + 8) * AV_PITCH + 64);
            o0 = __builtin_amdgcn_mfma_f32_32x32x16_bf16(v0, pf[ks], o0, 0, 0, 0);
            o1 = __builtin_amdgcn_mfma_f32_32x32x16_bf16(v1, pf[ks], o1, 0, 0, 0);
        }
    }
    const float lt = lrun + __shfl_xor(lrun, 32); const float il = 1.0f / lt;
    bf16* op = OPp + rowq * 512 + h * 64 + 4 * h2;
#pragma unroll
    for (int g4 = 0; g4 < 4; ++g4) {
        v2u w0, w1; w0.x = pg8::cvt_pk_bf16(o0[4 * g4 + 0] * il, o0[4 * g4 + 1] * il); w0.y = pg8::cvt_pk_bf16(o0[4 * g4 + 2] * il, o0[4 * g4 + 3] * il);
        w1.x = pg8::cvt_pk_bf16(o1[4 * g4 + 0] * il, o1[4 * g4 + 1] * il); w1.y = pg8::cvt_pk_bf16(o1[4 * g4 + 2] * il, o1[4 * g4 + 3] * il);
        *(v2u*)(op + 8 * g4) = w0; *(v2u*)(op + 32 + 8 * g4) = w1; }
    if (h2 == 0) LSEp[rowq * 8 + h] = mrun + log2f(lt);
}

struct Args { const float* in[20]; float* out; unsigned char* ws; int ph_lo, ph_hi; };
constexpr int NWAVES = 8;
constexpr int PH_PER_LAYER = 13, N_PHASES = 1 + NLAYER * PH_PER_LAYER;

template <int layer>
__device__ __forceinline__ void run_layer(const Args& args, int lo, int hi, const XcdBarrier& bar) {
    extern __shared__ __attribute__((aligned(16))) unsigned char lds[];
    LAS unsigned char* ldsp = (LAS unsigned char*)lds;
    const int tid = threadIdx.x, lane = tid & 63, wave = __builtin_amdgcn_readfirstlane(tid >> 6);
    const int G = gridDim.x, bid = blockIdx.x;
    const long gtid = (long)bid * (NWAVES * 64) + tid, GT = (long)G * (NWAVES * 64);
    const int gw = bid * NWAVES + wave, NGW = G * NWAVES;
    unsigned char* ws = args.ws;
    gu32* ctl = (gu32*)(ws + WS_CTL);
    const float* in_x = args.in[0]; const float* in_win = args.in[1]; const float* in_convw = args.in[2]; const float* in_convb = args.in[3];
    const float* in_dtb = args.in[4]; const float* in_alog = args.in[5]; const float* in_dsk = args.in[6]; const float* in_ng = args.in[7];
    const float* in_scw = args.in[8]; const float* in_wout = args.in[9]; const float* in_ln1g = args.in[10]; const float* in_ln1b = args.in[11];
    const float* in_rw = args.in[12]; const float* in_rb = args.in[13]; const float* in_wgu = args.in[14]; const float* in_bgu = args.in[15];
    const float* in_wdn = args.in[16]; const float* in_bdn = args.in[17]; const float* in_ln2g = args.in[18]; const float* in_ln2b = args.in[19];
    float* ROPE = (float*)(ws + WS_ROPE); float* WDT = (float*)(ws + WS_WDT); bf16* ROUT = (bf16*)(ws + WS_ROUT);
    bf16* WIN = (bf16*)(ws + WS_WIN); bf16* WOUT = (bf16*)(ws + WS_WOUT); bf16* WGU = (bf16*)(ws + WS_WGU); bf16* WDN = (bf16*)(ws + WS_WDN);
    bf16* XB = (bf16*)(ws + WS_XB); float* XF = (float*)(ws + WS_XF); float* XF2 = (float*)(ws + WS_XF2);
    bf16* PROJ = (bf16*)(ws + WS_PROJ); float* DT = (float*)(ws + WS_DT); float* DTS = (float*)(ws + WS_DTS); float* ACUM = (float*)(ws + WS_ACUM);
    float* LSE = (float*)(ws + WS_LSE); bf16* OP = (bf16*)(ws + WS_OP); bf16* U = (bf16*)(ws + WS_U); float* GB = (float*)(ws + WS_G);
    float* ST = (float*)(ws + WS_ST); float* YD = (float*)(ws + WS_YD); bf16* MIXED = (bf16*)(ws + WS_MIXED); float* MIXF = (float*)(ws + WS_MIXF);
    int* TOPE = (int*)(ws + WS_TOPE); float* TOPG = (float*)(ws + WS_TOPG); int* ROWTOK = (int*)(ws + WS_ROWTOK); float* ROWGATE = (float*)(ws + WS_ROWGATE);
    bf16* HB = (bf16*)(ws + WS_H); bf16* YB = (bf16*)(ws + WS_YB);

#define IN(k) (lo <= (k) && (k) < hi)
#define SEAM(k) do { if (IN(k) && IN((k) + 1)) xcd_barrier(bar); } while (0)

        const int pb = 1 + layer * PH_PER_LAYER;
        const float* xres = layer == 0 ? in_x : XF2;
        const bf16* WINl = WIN + (size_t)layer * NPROJ * DM; const bf16* WOUTl = WOUT + (size_t)layer * DM * MIXW;
        const bf16* WGUl = WGU + (size_t)layer * NEXP * 2048 * DM; const bf16* WDNl = WDN + (size_t)layer * NEXP * DM * FF;
        gu32* gcnt = ctl + CW_CNT + 64 * layer;

        if (IN(pb + 0)) {
            if (layer == 0) {
                for (int m = gw; m < MROWS; m += NGW) { const float* xr = in_x + (size_t)m * DM; f32x4 v[4];
#pragma unroll
                    for (int j = 0; j < 4; ++j) v[j] = *(const f32x4*)(xr + 4 * lane + 256 * j);
                    row_dt(v, WDT, DT + (size_t)m * 8, lane); }
            }
            pg8::Gemm g{XB, WINl, MROWS, NPROJ, DM}; pg8::StaticOrder S; S.init(MROWS, NPROJ, G, bid);
            pg8::EpiProj E{PROJ, NPROJ, ROPE, QSCALE};
            pg8::gemm_phase<pg8::EpiProj, pg8::StaticOrder, true, false>(ldsp + RING_OFF, g, S, E);
        }
        SEAM(pb + 0);
        if (IN(pb + 1)) {
            { LAS unsigned char* vl = ldsp + RING_OFF + wave * 6144;
              for (int I = bid; I < 3072; I += G) {
                  const int p = I >> 10, rem = I & 1023, b = rem >> 7, h = (rem >> 4) & 7, grp = rem & 15;
                  const int d = (p == 0) ? 1 : (p == 1) ? 4 : 16; const int tpr = 128 / d;
                  const int T = grp * 8 + wave; const int r = T / tpr, qt = T % tpr;
                  attn_wave_unit(PROJ, OP + (size_t)p * MROWS * 512, LSE + (size_t)p * MROWS * 8, b, h, d, r, qt, vl, lane); } }
            const float* cw = in_convw + (size_t)layer * 4 * 1024; const float* cb = in_convb + (size_t)layer * 1024;
            for (long it = gtid; it < (long)MROWS * 1024; it += GT) { const int ch = (int)(it & 1023), row = (int)(it >> 10), t = row & (SEQ - 1);
                float a = cb[ch];
#pragma unroll
                for (int k = 0; k < 4; ++k) { const int tt = t - 3 + k; if (tt >= 0) a += cw[k * 1024 + ch] * bf2f(PROJ[(size_t)(row - 3 + k) * NPROJ + C_XS + ch]); }
                U[it] = (bf16)f2bf(siluf(a)); }
            for (long it = gtid; it < (long)MROWS * 8; it += GT) { const int h = (int)(it & 7); const float x = DT[it] + in_dtb[layer * 8 + h];
                DTS[it] = x > 20.f ? x : log1pf(__expf(x)); }
            const float* sw = in_scw + (size_t)layer * 3 * 512;
            for (long it = gtid; it < (long)MROWS * 64; it += GT) { const int c8 = (int)(it & 63), row = (int)(it >> 6), t = row & (SEQ - 1); const int ch = c8 * 8;
                float a[8];
#pragma unroll
                for (int q = 0; q < 8; ++q) a[q] = 0.f;
#pragma unroll
                for (int k = 0; k < 3; ++k) { const int tt = t - 2 + k; if (tt >= 0) { const bf16* pr = PROJ + (size_t)(row - 2 + k) * NPROJ; const v4u cc = *(const v4u*)(pr + C_SC + ch), hh = *(const v4u*)(pr + C_SH + ch);
                    const f32x4 w0 = *(const f32x4*)(sw + k * 512 + ch), w1 = *(const f32x4*)(sw + k * 512 + ch + 4);
                    a[0] += w0[0] * bflo(cc.x) * bflo(hh.x); a[1] += w0[1] * bfhi(cc.x) * bfhi(hh.x); a[2] += w0[2] * bflo(cc.y) * bflo(hh.y); a[3] += w0[3] * bfhi(cc.y) * bfhi(hh.y);
                    a[4] += w1[0] * bflo(cc.z) * bflo(hh.z); a[5] += w1[1] * bfhi(cc.z) * bfhi(hh.z); a[6] += w1[2] * bflo(cc.w) * bflo(hh.w); a[7] += w1[3] * bfhi(cc.w) * bfhi(hh.w); } }
                const v4u bb = *(const v4u*)(PROJ + (size_t)row * NPROJ + C_SB + ch);
                v4u o; o.x = pk2(a[0] * bflo(bb.x), a[1] * bfhi(bb.x)); o.y = pk2(a[2] * bflo(bb.y), a[3] * bfhi(bb.y)); o.z = pk2(a[4] * bflo(bb.z), a[5] * bfhi(bb.z)); o.w = pk2(a[6] * bflo(bb.w), a[7] * bfhi(bb.w));
                *(v4u*)(MIXED + (size_t)row * MIXW + 1024 + ch) = o; }
        }
        SEAM(pb + 1);
        if (IN(pb + 2)) {
            for (long it = gtid; it < 2048; it += GT) { const int h = (int)(it & 7); const int bc = (int)(it >> 3); const float a = -__expf(in_alog[layer * 8 + h]); float acc = 0.f;
                for (int l = 0; l < 128; ++l) { const size_t r = (size_t)bc * 128 + l; acc += DTS[r * 8 + h] * a; ACUM[r * 8 + h] = acc; } }
            for (long it = gtid; it < 512L * 16384; it += GT) { const int s = (int)(it & 127), l = (int)((it >> 7) & 127), un = (int)(it >> 14); const int g = un & 1, bc = un >> 1;
                if (s > l) continue;
                const bf16* cp = U + ((size_t)bc * 128 + l) * 1024 + 768 + g * 128; const bf16* bp = U + ((size_t)bc * 128 + s) * 1024 + 512 + g * 128; float a = 0.f;
                for (int n = 0; n < 128; ++n) a += bf2f(cp[n]) * bf2f(bp[n]);
                GB[it] = a; }
        }
        SEAM(pb + 2);
        if (IN(pb + 3)) {
            for (long it = gtid; it < 2048L * 8192; it += GT) { const int n = (int)(it & 127), p = (int)((it >> 7) & 63), un = (int)(it >> 13); const int h = un & 7, bc = un >> 3, g = h >> 2;
                const size_t r0 = (size_t)bc * 128; const float alast = ACUM[(r0 + 127) * 8 + h]; float a = 0.f;
                for (int l = 0; l < 128; ++l) { const size_t r = r0 + l; a += bf2f(U[r * 1024 + 512 + g * 128 + n]) * __expf(alast - ACUM[r * 8 + h]) * DTS[r * 8 + h] * bf2f(U[r * 1024 + h * 64 + p]); }
                ST[it] = a; }
            for (long it = gtid; it < (long)MROWS * 512; it += GT) { const int p = (int)(it & 63), h = (int)((it >> 6) & 7), row = (int)(it >> 9); const int l = row & 127, g = h >> 2; const size_t r0 = (size_t)(row - l);
                const int un = (row >> 7) * 2 + g; const float al = ACUM[(size_t)row * 8 + h]; float a = 0.f;
                for (int s = 0; s <= l; ++s) { const size_t r = r0 + s; a += GB[((size_t)un * 128 + l) * 128 + s] * __expf(al - ACUM[r * 8 + h]) * DTS[r * 8 + h] * bf2f(U[r * 1024 + h * 64 + p]); }
                YD[it] = a + in_dsk[layer * 8 + h] * bf2f(U[(size_t)row * 1024 + h * 64 + p]); }
        }
        SEAM(pb + 3);
        if (IN(pb + 4)) {
            for (long it = gtid; it < 64L * 8192; it += GT) { const int pn = (int)(it & 8191), bh = (int)(it >> 13); const int h = bh & 7, b = bh >> 3; float hc = 0.f;
                for (int c = 0; c < 32; ++c) { const size_t idx = ((size_t)((b * 32 + c) * 8 + h)) * 8192 + pn; const float st = ST[idx]; ST[idx] = hc;
                    hc = hc * __expf(ACUM[((size_t)(b * 32 + c) * 128 + 127) * 8 + h]) + st; } }
        }
        SEAM(pb + 4);
        if (IN(pb + 5)) {
            for (long it = gtid; it < (long)MROWS * 512; it += GT) { const int p = (int)(it & 63), h = (int)((it >> 6) & 7), row = (int)(it >> 9); const int g = h >> 2;
                const float* hp = ST + ((size_t)((row >> 7) * 8 + h)) * 8192 + p * 128; const bf16* cp = U + (size_t)row * 1024 + 768 + g * 128; float a = 0.f;
                for (int n = 0; n < 128; ++n) a += bf2f(cp[n]) * hp[n];
                YD[it] += a * __expf(ACUM[(size_t)row * 8 + h]); }
        }
        SEAM(pb + 5);
        if (IN(pb + 6)) {
            const float* ng = in_ng + (size_t)layer * 512;
            for (long it = gtid; it < (long)MROWS * 2; it += GT) { const int g = (int)(it & 1), row = (int)(it >> 1); float ss = 0.f;
                for (int ch = 0; ch < 256; ++ch) { const float y = YD[(size_t)row * 512 + g * 256 + ch] * siluf(bf2f(PROJ[(size_t)row * NPROJ + C_Z + g * 256 + ch])); ss += y * y; }
                const float rs = 1.0f / sqrtf(ss * (1.f / 256.f) + RMS_EPS);
                for (int ch = 0; ch < 256; ++ch) { const float y = YD[(size_t)row * 512 + g * 256 + ch] * siluf(bf2f(PROJ[(size_t)row * NPROJ + C_Z + g * 256 + ch]));
                    MIXED[(size_t)row * MIXW + 512 + g * 256 + ch] = (bf16)f2bf(y * rs * ng[g * 256 + ch]); } }
            for (long it = gtid; it < (long)MROWS * 64; it += GT) { const int c8 = (int)(it & 63), row = (int)(it >> 6); const int h = c8 >> 3;
                const float l0 = LSE[((size_t)0 * MROWS + row) * 8 + h], l1 = LSE[((size_t)1 * MROWS + row) * 8 + h], l2 = LSE[((size_t)2 * MROWS + row) * 8 + h];
                const float mm = fmaxf(l0, fmaxf(l1, l2)); float w0 = exp2f(l0 - mm), w1 = exp2f(l1 - mm), w2 = exp2f(l2 - mm); const float iw = 1.0f / (w0 + w1 + w2); w0 *= iw; w1 *= iw; w2 *= iw;
                const v4u a0 = *(const v4u*)(OP + ((size_t)0 * MROWS + row) * 512 + c8 * 8), a1 = *(const v4u*)(OP + ((size_t)1 * MROWS + row) * 512 + c8 * 8), a2 = *(const v4u*)(OP + ((size_t)2 * MROWS + row) * 512 + c8 * 8);
                v4u o;
                o.x = pk2(w0 * bflo(a0.x) + w1 * bflo(a1.x) + w2 * bflo(a2.x), w0 * bfhi(a0.x) + w1 * bfhi(a1.x) + w2 * bfhi(a2.x));
                o.y = pk2(w0 * bflo(a0.y) + w1 * bflo(a1.y) + w2 * bflo(a2.y), w0 * bfhi(a0.y) + w1 * bfhi(a1.y) + w2 * bfhi(a2.y));
                o.z = pk2(w0 * bflo(a0.z) + w1 * bflo(a1.z) + w2 * bflo(a2.z), w0 * bfhi(a0.z) + w1 * bfhi(a1.z) + w2 * bfhi(a2.z));
                o.w = pk2(w0 * bflo(a0.w) + w1 * bflo(a1.w) + w2 * bflo(a2.w), w0 * bfhi(a0.w) + w1 * bfhi(a1.w) + w2 * bfhi(a2.w));
                *(v4u*)(MIXED + (size_t)row * MIXW + c8 * 8) = o; }
        }
        SEAM(pb + 6);
        if (IN(pb + 7)) {
            pg8::Gemm g{MIXED, WOUTl, MROWS, DM, MIXW}; pg8::StaticOrder S; S.init(MROWS, DM, G, bid);
            pg8::EpiF32 E{MIXF, DM};
            pg8::gemm_phase<pg8::EpiF32, pg8::StaticOrder, true, false>(ldsp + RING_OFF, g, S, E);
        }
        SEAM(pb + 7);
        if (IN(pb + 8)) {
            const float* gam = in_ln1g + (size_t)layer * DM; const float* bet = in_ln1b + (size_t)layer * DM;
            for (int m = gw; m < MROWS; m += NGW) { f32x4 v[4];
#pragma unroll
                for (int j = 0; j < 4; ++j) { const f32x4 a = *(const f32x4*)(xres + (size_t)m * DM + 4 * lane + 256 * j), b = *(const f32x4*)(MIXF + (size_t)m * DM + 4 * lane + 256 * j); v[j] = a * ALPHA + b; }
                ln_row(v, gam, bet, XF + (size_t)m * DM, XB + (size_t)m * DM, lane); }
        }
        SEAM(pb + 8);
        if (IN(pb + 9)) {
            LAS int* lcnt = (LAS int*)(ldsp + L_LCNT); LAS int* lbase = (LAS int*)(ldsp + L_LBASE);
            const bf16* RT = ROUT + (size_t)layer * NEXP * DM; const float* rb = in_rb + (size_t)layer * NEXP;
            for (int blk = bid; blk < MROWS / 128; blk += G) {
                if (tid < 32) lcnt[tid] = 0;
                __syncthreads();
                const int r32 = lane & 31, hi = lane >> 5; const int row = blk * 128 + (wave & 3) * 32 + r32;
                float tv[4]; int te[4]; int lrank[4]; float gate[4];
                if (wave < 4) {
                    f32x16 acc = {};
                    const bf16* ap = RT + (size_t)r32 * DM + 8 * hi; const bf16* bp = XB + (size_t)row * DM + 8 * hi;
#pragma unroll 8
                    for (int s = 0; s < 64; ++s) { const bf16x8 a = *(const bf16x8*)(ap + 16 * s), b = *(const bf16x8*)(bp + 16 * s); acc = __builtin_amdgcn_mfma_f32_32x32x16_bf16(a, b, acc, 0, 0, 0); }
#pragma unroll
                    for (int k = 0; k < 4; ++k) { tv[k] = -INFINITY; te[k] = 1 << 20; }
#pragma unroll
                    for (int i = 0; i < 16; ++i) { const int e = (i & 3) + 8 * (i >> 2) + 4 * hi; float v = acc[i] + rb[e]; int ve = e;
#pragma unroll
                        for (int k = 0; k < 4; ++k) { const bool gt = (v > tv[k]) || (v == tv[k] && ve < te[k]); const float nv = gt ? tv[k] : v; const int ne = gt ? te[k] : ve; tv[k] = gt ? v : tv[k]; te[k] = gt ? ve : te[k]; v = nv; ve = ne; } }
                    float pv[4]; int pe[4];
#pragma unroll
                    for (int k = 0; k < 4; ++k) { pv[k] = __shfl_xor(tv[k], 32); pe[k] = __shfl_xor(te[k], 32); }
#pragma unroll
                    for (int j = 0; j < 4; ++j) { float v = pv[j]; int ve = pe[j];
#pragma unroll
                        for (int k = 0; k < 4; ++k) { const bool gt = (v > tv[k]) || (v == tv[k] && ve < te[k]); const float nv = gt ? tv[k] : v; const int ne = gt ? te[k] : ve; tv[k] = gt ? v : tv[k]; te[k] = gt ? ve : te[k]; v = nv; ve = ne; } }
                    float se = 0.f;
#pragma unroll
                    for (int k = 0; k < 4; ++k) { gate[k] = __expf(tv[k] - tv[0]); se += gate[k]; }
                    const float ise = 1.0f / se;
#pragma unroll
                    for (int k = 0; k < 4; ++k) gate[k] *= ise;
                    if (hi == 0) {
#pragma unroll
                        for (int k = 0; k < 4; ++k) lrank[k] = __hip_atomic_fetch_add(lcnt + te[k], 1, __ATOMIC_RELAXED, __HIP_MEMORY_SCOPE_WORKGROUP);
                    }
                }
                __syncthreads();
                if (tid < 32) lbase[tid] = (int)__hip_atomic_fetch_add(gcnt + tid, (unsigned)lcnt[tid], RLX_AGENT);
                __syncthreads();
                if (wave < 4 && hi == 0) {
#pragma unroll
                    for (int k = 0; k < 4; ++k) { const int r = lbase[te[k]] + lrank[k]; const size_t o = (size_t)te[k] * 32768 + r;
                        ROWTOK[o] = row * 4 + k; ROWGATE[o] = gate[k]; TOPE[(size_t)row * 4 + k] = te[k]; TOPG[(size_t)row * 4 + k] = gate[k]; }
                }
                __syncthreads();
            }
        }
        SEAM(pb + 9);
        if (IN(pb + 10) || IN(pb + 11)) {
            LAS int* tstart = (LAS int*)(ldsp + L_TSTART); LAS int* cntL = (LAS int*)(ldsp + L_CNT); LAS int* units = (LAS int*)(ldsp + L_UNITS); LAS int* unitsn = (LAS int*)(ldsp + L_UNITSN);
            if (tid == 0) { int acc = 0; for (int e = 0; e < 32; ++e) { const int c = (int)__hip_atomic_load(gcnt + e, RLX_AGENT); cntL[e] = c; tstart[e] = acc; acc += (c + 255) >> 8; } tstart[32] = acc; }
            __syncthreads();
            if (IN(pb + 10)) {
                pg8::moe_build_units(units, unitsn, tstart, 8, G, bid, tid);
                __syncthreads();
                pg8::Gemm g{XB, WGUl, 0, 2048, DM};
                pg8::MoeOrder S{units, __builtin_amdgcn_readfirstlane(unitsn[0]), cntL, ROWTOK, 1, (size_t)2048 * DM * 2};
                pg8::EpiSwiglu E{HB, in_bgu + (size_t)layer * NEXP * 2048, ROWGATE, cntL};
                pg8::gemm_phase<pg8::EpiSwiglu, pg8::MoeOrder, true, true>(ldsp + RING_OFF, g, S, E);
                __syncthreads();
            }
            SEAM(pb + 10);
            if (IN(pb + 11)) {
                pg8::moe_build_units(units, unitsn, tstart, 4, G, bid, tid);
                __syncthreads();
                pg8::Gemm g{HB, WDNl, 0, DM, FF};
                pg8::MoeOrder S{units, __builtin_amdgcn_readfirstlane(unitsn[0]), cntL, ROWTOK, 0, (size_t)DM * FF * 2};
                pg8::EpiScatter E{YB, ROWTOK, cntL};
                pg8::gemm_phase<pg8::EpiScatter, pg8::MoeOrder, true, false>(ldsp + RING_OFF, g, S, E);
                __syncthreads();
            }
        }
        SEAM(pb + 11);
        if (IN(pb + 12)) {
            const float* gam = in_ln2g + (size_t)layer * DM; const float* bet = in_ln2b + (size_t)layer * DM; const float* bdn = in_bdn + (size_t)layer * NEXP * DM;
            float* dstf = (layer == NLAYER - 1) ? args.out : XF2;
            for (int m = gw; m < MROWS; m += NGW) { f32x4 v[4];
#pragma unroll
                for (int j = 0; j < 4; ++j) v[j] = *(const f32x4*)(XF + (size_t)m * DM + 4 * lane + 256 * j) * ALPHA;
#pragma unroll
                for (int k = 0; k < 4; ++k) { const int e = TOPE[(size_t)m * 4 + k]; const float gk = TOPG[(size_t)m * 4 + k]; const bf16* yr = YB + ((size_t)m * 4 + k) * DM; const float* br = bdn + (size_t)e * DM;
#pragma unroll
                    for (int j = 0; j < 4; ++j) { const v2u w = *(const v2u*)(yr + 4 * lane + 256 * j); const f32x4 b = *(const f32x4*)(br + 4 * lane + 256 * j);
                        v[j][0] += bflo(w.x) + gk * b[0]; v[j][1] += bfhi(w.x) + gk * b[1]; v[j][2] += bflo(w.y) + gk * b[2]; v[j][3] += bfhi(w.y) + gk * b[3]; } }
                ln_row(v, gam, bet, dstf + (size_t)m * DM, XB + (size_t)m * DM, lane);
                if (layer + 1 < NLAYER) row_dt(v, WDT + (size_t)(layer + 1) * 8 * 1024, DT + (size_t)m * 8, lane); }
        }
        SEAM(pb + 12);
    #undef IN
#undef SEAM
}

__global__ void __launch_bounds__(NWAVES * 64, 2) mk_fwd(Args args) {
    extern __shared__ __attribute__((aligned(16))) unsigned char lds[];
    LAS unsigned char* ldsp = (LAS unsigned char*)lds;
    const int tid = threadIdx.x, lane = tid & 63, wave = __builtin_amdgcn_readfirstlane(tid >> 6);
    const int G = gridDim.x, bid = blockIdx.x;
    const long gtid = (long)bid * (NWAVES * 64) + tid, GT = (long)G * (NWAVES * 64);
    const int gw = bid * NWAVES + wave, NGW = G * NWAVES;
    unsigned char* ws = args.ws;
    gu32* ctl = (gu32*)(ws + WS_CTL);
    const float* in_x = args.in[0]; const float* in_win = args.in[1]; const float* in_convw = args.in[2]; const float* in_convb = args.in[3];
    const float* in_dtb = args.in[4]; const float* in_alog = args.in[5]; const float* in_dsk = args.in[6]; const float* in_ng = args.in[7];
    const float* in_scw = args.in[8]; const float* in_wout = args.in[9]; const float* in_ln1g = args.in[10]; const float* in_ln1b = args.in[11];
    const float* in_rw = args.in[12]; const float* in_rb = args.in[13]; const float* in_wgu = args.in[14]; const float* in_bgu = args.in[15];
    const float* in_wdn = args.in[16]; const float* in_bdn = args.in[17]; const float* in_ln2g = args.in[18]; const float* in_ln2b = args.in[19];
    float* ROPE = (float*)(ws + WS_ROPE); float* WDT = (float*)(ws + WS_WDT); bf16* ROUT = (bf16*)(ws + WS_ROUT);
    bf16* WIN = (bf16*)(ws + WS_WIN); bf16* WOUT = (bf16*)(ws + WS_WOUT); bf16* WGU = (bf16*)(ws + WS_WGU); bf16* WDN = (bf16*)(ws + WS_WDN);
    bf16* XB = (bf16*)(ws + WS_XB); float* XF = (float*)(ws + WS_XF); float* XF2 = (float*)(ws + WS_XF2);
    bf16* PROJ = (bf16*)(ws + WS_PROJ); float* DT = (float*)(ws + WS_DT); float* DTS = (float*)(ws + WS_DTS); float* ACUM = (float*)(ws + WS_ACUM);
    float* LSE = (float*)(ws + WS_LSE); bf16* OP = (bf16*)(ws + WS_OP); bf16* U = (bf16*)(ws + WS_U); float* GB = (float*)(ws + WS_G);
    float* ST = (float*)(ws + WS_ST); float* YD = (float*)(ws + WS_YD); bf16* MIXED = (bf16*)(ws + WS_MIXED); float* MIXF = (float*)(ws + WS_MIXF);
    int* TOPE = (int*)(ws + WS_TOPE); float* TOPG = (float*)(ws + WS_TOPG); int* ROWTOK = (int*)(ws + WS_ROWTOK); float* ROWGATE = (float*)(ws + WS_ROWGATE);
    bf16* HB = (bf16*)(ws + WS_H); bf16* YB = (bf16*)(ws + WS_YB);

    for (int u = tid; u < (LDS_BYTES - LDSCTL_OFF) / 4; u += NWAVES * 64) ((LAS unsigned*)(ldsp + LDSCTL_OFF))[u] = 0u;
    __syncthreads();
    XcdBarrier bar = xcd_barrier_post((unsigned*)(ctl + CW_BAR), (volatile LAS unsigned*)(ldsp + L_MISC) + 8);

    const int lo = args.ph_lo, hi = args.ph_hi;
#define IN(k) (lo <= (k) && (k) < hi)
#define SEAM(k) do { if (IN(k) && IN((k) + 1)) xcd_barrier(bar); } while (0)

    if (IN(0)) {
        for (long it = gtid; it < 4096 * 32; it += GT) { const int t = (int)(it >> 5), i = (int)(it & 31);
            const float inv = powf(10000.0f, -(float)i / 32.0f); const float ang = (float)t * inv; float sn, cs; sincosf(ang, &sn, &cs);
            ROPE[2 * it] = cs; ROPE[2 * it + 1] = sn; }
        LAS float* scr = (LAS float*)(ldsp + RING_OFF + wave * 16384);
        constexpr int I_IN = 16 * 145, I_OUT = 24 * 32, I_GU = 16 * 64, I_DN = 16 * 32, I_R = 16;
        constexpr int NIT = NLAYER * (I_IN + I_OUT + I_R) + NLAYER * NEXP * (I_GU + I_DN);
        for (int it = gw; it < NIT; it += NGW) {
            int r = it;
            if (r < NLAYER * I_IN) { const int l = r / I_IN; r %= I_IN; p0_transpose_item<1>(in_win + (size_t)l * DM * INW, DM, INW, WIN + (size_t)l * NPROJ * DM, WDT + (size_t)l * 8 * 1024, scr, r / 145, r % 145, lane); continue; } r -= NLAYER * I_IN;
            if (r < NLAYER * I_OUT) { const int l = r / I_OUT; r %= I_OUT; p0_transpose_item<0>(in_wout + (size_t)l * MIXW * DM, MIXW, DM, WOUT + (size_t)l * DM * MIXW, nullptr, scr, r / 32, r % 32, lane); continue; } r -= NLAYER * I_OUT;
            if (r < NLAYER * I_R) { const int l = r / I_R; r %= I_R; p0_transpose_item<0>(in_rw + (size_t)l * DM * NEXP, DM, NEXP, ROUT + (size_t)l * NEXP * DM, nullptr, scr, r, 0, lane); continue; } r -= NLAYER * I_R;
            if (r < NLAYER * NEXP * I_GU) { const int le = r / I_GU; r %= I_GU; p0_transpose_item<2>(in_wgu + (size_t)le * DM * 2048, DM, 2048, WGU + (size_t)le * 2048 * DM, nullptr, scr, r / 64, r % 64, lane); continue; } r -= NLAYER * NEXP * I_GU;
            { const int le = r / I_DN; r %= I_DN; p0_transpose_item<0>(in_wdn + (size_t)le * FF * DM, FF, DM, WDN + (size_t)le * DM * FF, nullptr, scr, r / 32, r % 32, lane); }
        }
        __syncthreads();
    }
    if (IN(0)) {
        for (int m = gw; m < MROWS; m += NGW) { const float* xr = in_x + (size_t)m * DM; bf16* ob = XB + (size_t)m * DM;
#pragma unroll
            for (int j = 0; j < 4; ++j) { const f32x4 v = *(const f32x4*)(xr + 4 * lane + 256 * j); v2u w; w.x = pk2(v[0], v[1]); w.y = pk2(v[2], v[3]); *(v2u*)(ob + 4 * lane + 256 * j) = w; } }
    }

    SEAM(0);
    run_layer<0>(args, lo, hi, bar);
    run_layer<1>(args, lo, hi, bar);
#undef IN
#undef SEAM
}

extern "C" void kernel_launch(void* const* d_in, const int* in_sizes, int n_in, void* d_out, int out_size, void* d_ws, size_t ws_size, hipStream_t stream) {
    static int grid = 0;
    if (grid == 0) {
        if (n_in != 20 || out_size != MROWS * DM || ws_size < WS_END) { fprintf(stderr, "kernel_launch: unexpected problem (n_in %d, out %d, ws %zu)\n", n_in, out_size, ws_size); grid = -1; return; }
        if (hipFuncSetAttribute((const void*)mk_fwd, hipFuncAttributeMaxDynamicSharedMemorySize, LDS_BYTES) != hipSuccess) { fprintf(stderr, "kernel_launch: hipFuncSetAttribute failed\n"); grid = -1; return; }
        int dev = 0, cus = 0, per_cu = 0;
        (void)hipGetDevice(&dev); (void)hipDeviceGetAttribute(&cus, hipDeviceAttributeMultiprocessorCount, dev);
        if (hipOccupancyMaxActiveBlocksPerMultiprocessor(&per_cu, (const void*)mk_fwd, NWAVES * 64, LDS_BYTES) != hipSuccess || per_cu < 1) fprintf(stderr, "kernel_launch: occupancy query says %d\n", per_cu);
        (void)hipGetLastError();
        grid = cus > 0 ? cus : 256;
    }
    if (grid < 0) return;
    (void)hipMemsetAsync((char*)d_ws + WS_CTL, 0, CTL_ZERO_BYTES, stream);
    Args a{};
    for (int i = 0; i < 20; ++i) a.in[i] = (const float*)d_in[i];
    a.out = (float*)d_out; a.ws = (unsigned char*)d_ws;
    a.ph_lo = 0; a.ph_hi = N_PHASES;
    hipLaunchKernelGGL(mk_fwd, dim3(grid), dim3(NWAVES * 64), LDS_BYTES, stream, a);
}
```

```cpp
#include <hip/hip_runtime.h>
#include <cstdio>
#include <cstdint>
#include <cmath>

namespace pg8 {
#define PG8_LAS __attribute__((address_space(3)))
typedef unsigned short bf16_t;
typedef short bf16x8 __attribute__((ext_vector_type(8)));
typedef float f32x4 __attribute__((ext_vector_type(4)));
typedef float f32x2 __attribute__((ext_vector_type(2)));
typedef unsigned u32x4 __attribute__((ext_vector_type(4)));
constexpr int BM = 256, BK = 64, HALF = 128, HTB = HALF * BK * 2  , STAGE_BYTES = 8 * HTB, NXCD = 8, WGM = 8;

__host__ __device__ __forceinline__ int lds_byte(int r, int c) { const int st = (r >> 4) * 2 + (c >> 5), rr = r & 15, cc = c & 31, ob = rr * 64 + cc * 2; return st * 1024 + (ob ^ (((ob >> 9) & 1) << 5)); }
__host__ __device__ __forceinline__ void stage_rc(int b, int& R, int& C) { const int st = b / 1024, sb = b % 1024, swz = sb ^ (((sb >> 9) & 1) << 5); R = (st >> 1) * 16 + swz / 64; C = (st & 1) * 32 + (swz % 64) / 2; }
__host__ __device__ __forceinline__ int perm32(int rho) { const int n = rho >> 4, i = rho & 15; return 8 * (i >> 2) + 4 * n + (i & 3); }

struct Unit { int pm, pn, e, r0; };
struct Gemm { const bf16_t* A; const bf16_t* Bt; int M, N, K; };

struct StaticOrder {
    int nM, nN, nwg, G, c;
    __device__ void init(int M, int N, int G_, int c_) { nM = M / BM; nN = N / BM; nwg = nM * nN; G = G_; c = c_; }
    __device__ __forceinline__ bool next(int i, Unit& u) const {
        const long L = (long)i * G + c; if (L >= nwg) return false;
        int wgid = (int)L; { const int q = nwg / NXCD, r = nwg % NXCD, xcd = wgid % NXCD, off = wgid / NXCD; wgid = (xcd < r ? xcd * (q + 1) : r * (q + 1) + (xcd - r) * q) + off; }
        const int nig = WGM * nN, gid = wgid / nig, fm = gid * WGM, gsz = (nM - fm) < WGM ? (nM - fm) : WGM;
        u.pm = fm + ((wgid % nig) % gsz); u.pn = (wgid % nig) / gsz; u.e = 0; u.r0 = 0; return true;
    }
    __device__ __forceinline__ const char* abase(const Unit& u, const Gemm& g, size_t tstep) const { return (const char*)g.A + (size_t)u.pm * tstep; }
    __device__ __forceinline__ const char* bbase(const Unit& u, const Gemm& g, size_t tstep) const { return (const char*)g.Bt + (size_t)u.pn * tstep; }
    __device__ __forceinline__ unsigned arow(const Unit&, int) const { return 0u; }
    __device__ __forceinline__ void a_ready(const Unit&) const {}
    __device__ __forceinline__ void done(const Unit&) const {}
};

struct MoeOrder {
    const PG8_LAS int* units;
    int nunits;
    const PG8_LAS int* cnt;
    const int* rowtok;
    int gather;
    size_t bstride;
    __device__ __forceinline__ bool next(int i, Unit& u) const {
        if (i >= nunits) return false;
        u.pm = __builtin_amdgcn_readfirstlane(units[4 * i + 0]); u.pn = __builtin_amdgcn_readfirstlane(units[4 * i + 1]);
        u.e = __builtin_amdgcn_readfirstlane(units[4 * i + 2]); u.r0 = __builtin_amdgcn_readfirstlane(units[4 * i + 3]); return true;
    }
    __device__ __forceinline__ const char* abase(const Unit& u, const Gemm& g, size_t tstep) const { return gather ? (const char*)g.A : (const char*)g.A + (size_t)u.pm * tstep; }
    __device__ __forceinline__ const char* bbase(const Unit& u, const Gemm& g, size_t tstep) const { return (const char*)g.Bt + (size_t)u.e * bstride + (size_t)u.pn * tstep; }
    __device__ __forceinline__ unsigned arow(const Unit& u, int R) const {
        const int r = u.r0 + R; const int idx = (r < cnt[u.e]) ? rowtok[(size_t)u.e * 32768 + r] : 0; return (unsigned)(idx >> 2) * 2048u; }
    __device__ __forceinline__ void a_ready(const Unit&) const {}
    __device__ __forceinline__ void done(const Unit&) const {}
};
__device__ __forceinline__ void moe_build_units(PG8_LAS int* units, PG8_LAS int* units_n, const PG8_LAS int* tstart, int nN, int G, int c, int tid) {
    if (tid < 64) {
        const int nT = tstart[32], nwg = nT * nN; const long L = (long)tid * G + c;
        int pm = 0, pn = 0, e = 0, r0 = 0;
        if (L < nwg) {
            int wgid = (int)L; { const int q = nwg / NXCD, r = nwg % NXCD, xcd = wgid % NXCD, off = wgid / NXCD; wgid = (xcd < r ? xcd * (q + 1) : r * (q + 1) + (xcd - r) * q) + off; }
            const int nig = WGM * nN, gid = wgid / nig, fm = gid * WGM, gsz = (nT - fm) < WGM ? (nT - fm) : WGM;
            pm = fm + ((wgid % nig) % gsz); pn = (wgid % nig) / gsz;
            for (int j = 1; j < 32; ++j) e += (tstart[j] <= pm) ? 1 : 0;
            r0 = (pm - tstart[e]) * 256;
        }
        units[4 * tid + 0] = pm; units[4 * tid + 1] = pn; units[4 * tid + 2] = e; units[4 * tid + 3] = r0;
        if (tid == 0) { int n = 0; if (c < nwg) n = (nwg - c + G - 1) / G; units_n[0] = n < 64 ? n : 64; }
    }
}

__device__ __forceinline__ unsigned cvt_pk_bf16(float lo, float hi) { unsigned r; asm volatile("v_cvt_pk_bf16_f32 %0, %1, %2" : "=v"(r) : "v"(lo), "v"(hi)); return r; }

struct EpiProj {
    static constexpr bool PERM = true, AFTER_DRAIN = false;
    bf16_t* O; int ldc; const float* rope; float qscale;
    __device__ __forceinline__ void operator()(const f32x4 (&acc)[2][2][4][2], const Unit& u, int wr, int wc, int fr, int fq) const {
        const int row0 = u.pm * BM + wr * 64 + fr; const int col0 = u.pn * BM + wc * 32 + 8 * fq;
        const bool rot = u.pn < 4; const float sc = u.pn < 2 ? qscale : 1.f; const int gq = 4 * (wc & 1) + fq;
#pragma unroll
        for (int ai = 0; ai < 2; ++ai)
#pragma unroll
            for (int m = 0; m < 4; ++m) { const int row = row0 + ai * HALF + m * 16; bf16_t* rowp = O + (size_t)row * ldc + col0;
                f32x4 cs0 = (f32x4){1.f, 0.f, 1.f, 0.f}, cs1 = cs0;
                if (rot) { const float* rp = rope + ((size_t)(row & 4095) * 32 + 4 * gq) * 2; cs0 = *(const f32x4*)rp; cs1 = *(const f32x4*)(rp + 4); }
#pragma unroll
                for (int bj = 0; bj < 2; ++bj) { f32x4 v0 = acc[ai][bj][m][0], v1 = acc[ai][bj][m][1];
                    if (rot) { f32x4 lo, hi;
                        lo[0] = v0[0] * cs0[0] - v1[0] * cs0[1]; hi[0] = v1[0] * cs0[0] + v0[0] * cs0[1];
                        lo[1] = v0[1] * cs0[2] - v1[1] * cs0[3]; hi[1] = v1[1] * cs0[2] + v0[1] * cs0[3];
                        lo[2] = v0[2] * cs1[0] - v1[2] * cs1[1]; hi[2] = v1[2] * cs1[0] + v0[2] * cs1[1];
                        lo[3] = v0[3] * cs1[2] - v1[3] * cs1[3]; hi[3] = v1[3] * cs1[2] + v0[3] * cs1[3];
                        v0 = lo * sc; v1 = hi * sc; }
                    u32x4 w; w.x = cvt_pk_bf16(v0[0], v0[1]); w.y = cvt_pk_bf16(v0[2], v0[3]); w.z = cvt_pk_bf16(v1[0], v1[1]); w.w = cvt_pk_bf16(v1[2], v1[3]);
                    *(u32x4*)(rowp + bj * HALF) = w; } }
    }
};
struct EpiF32 {
    static constexpr bool PERM = false, AFTER_DRAIN = false;
    float* O; int ldc;
    __device__ __forceinline__ void operator()(const f32x4 (&acc)[2][2][4][2], const Unit& u, int wr, int wc, int fr, int fq) const {
        const int row0 = u.pm * BM + wr * 64 + fr; const int col0 = u.pn * BM + wc * 32 + 4 * fq;
#pragma unroll
        for (int ai = 0; ai < 2; ++ai)
#pragma unroll
            for (int m = 0; m < 4; ++m) { float* rowp = O + (size_t)(row0 + ai * HALF + m * 16) * ldc + col0;
#pragma unroll
                for (int bj = 0; bj < 2; ++bj)
#pragma unroll
                    for (int n = 0; n < 2; ++n) *(f32x4*)(rowp + bj * HALF + n * 16) = acc[ai][bj][m][n]; }
    }
};
struct EpiSwiglu {
    static constexpr bool PERM = true, AFTER_DRAIN = false;
    bf16_t* H; const float* bgu; const float* rowgate; const PG8_LAS int* cnt;
    __device__ __forceinline__ void operator()(const f32x4 (&acc)[2][2][4][2], const Unit& u, int wr, int wc, int fr, int fq) const {
        const int ff = u.pn * HALF + wc * 32 + 8 * fq; const int n_e = cnt[u.e];
        f32x4 bg[2], bu[2];
#pragma unroll
        for (int n = 0; n < 2; ++n) { bg[n] = *(const f32x4*)(bgu + (size_t)u.e * 2048 + ff + 4 * n); bu[n] = *(const f32x4*)(bgu + (size_t)u.e * 2048 + 1024 + ff + 4 * n); }
#pragma unroll
        for (int ai = 0; ai < 2; ++ai)
#pragma unroll
            for (int m = 0; m < 4; ++m) { const int r = ai * HALF + wr * 64 + m * 16 + fr; const int er = u.r0 + r;
                const float rg = (er < n_e) ? rowgate[(size_t)u.e * 32768 + er] : 0.f;
                float hv[8];
#pragma unroll
                for (int n = 0; n < 2; ++n)
#pragma unroll
                    for (int q = 0; q < 4; ++q) { float g = acc[ai][0][m][n][q] + bg[n][q], up = acc[ai][1][m][n][q] + bu[n][q];
                        g = fminf(g, 7.0f); up = fminf(fmaxf(up, -7.0f), 7.0f);
                        const float sg = __builtin_amdgcn_rcpf(1.0f + __builtin_amdgcn_exp2f(-1.702f * 1.4426950408889634f * g));
                        hv[n * 4 + q] = (up + 1.0f) * g * sg * rg; }
                u32x4 w; w.x = cvt_pk_bf16(hv[0], hv[1]); w.y = cvt_pk_bf16(hv[2], hv[3]); w.z = cvt_pk_bf16(hv[4], hv[5]); w.w = cvt_pk_bf16(hv[6], hv[7]);
                *(u32x4*)(H + (size_t)(u.pm * BM + r) * 1024 + ff) = w; }
    }
};
struct EpiScatter {
    static constexpr bool PERM = true, AFTER_DRAIN = false;
    bf16_t* Y; const int* rowtok; const PG8_LAS int* cnt;
    __device__ __forceinline__ void operator()(const f32x4 (&acc)[2][2][4][2], const Unit& u, int wr, int wc, int fr, int fq) const {
        const int col0 = u.pn * BM + wc * 32 + 8 * fq; const int n_e = cnt[u.e];
#pragma unroll
        for (int ai = 0; ai < 2; ++ai)
#pragma unroll
            for (int m = 0; m < 4; ++m) { const int er = u.r0 + ai * HALF + wr * 64 + m * 16 + fr;
                if (er < n_e) { const int idx = rowtok[(size_t)u.e * 32768 + er]; bf16_t* rowp = Y + (size_t)idx * 1024 + col0;
#pragma unroll
                    for (int bj = 0; bj < 2; ++bj) { const f32x4 v0 = acc[ai][bj][m][0], v1 = acc[ai][bj][m][1];
                        u32x4 w; w.x = cvt_pk_bf16(v0[0], v0[1]); w.y = cvt_pk_bf16(v0[2], v0[3]); w.z = cvt_pk_bf16(v1[0], v1[1]); w.w = cvt_pk_bf16(v1[2], v1[3]);
                        *(u32x4*)(rowp + bj * HALF) = w; } } }
    }
};

template <class Epi, class Sched, bool ALIGN_EPI, bool GATHER>
__device__ __forceinline__ void gemm_phase(PG8_LAS unsigned char* lds, const Gemm g, const Sched& S, const Epi& E) {
    const int tid = threadIdx.x, wid = __builtin_amdgcn_readfirstlane(tid >> 6), lane = tid & 63, wr = wid >> 2, wc = wid & 3, fr = lane & 15, fq = lane >> 4;
    const int K = g.K, nt = K / BK;
    int sR[2], sC2[2]; unsigned voffB[2];
#pragma unroll
    for (int i = 0; i < 2; ++i) { int R, C; stage_rc(tid * 16 + i * 8192, R, C); const int Rb = Epi::PERM ? ((R & ~31) + perm32(R & 31)) : R;
        sR[i] = R; sC2[i] = C * 2; voffB[i] = (unsigned)(Rb * K + C) * 2u; }
    const size_t kstep = (size_t)(BK * 2);
    const size_t hstep = (size_t)HALF * K * 2;
    const size_t tstep = 2 * hstep;
    const unsigned ldsw = (unsigned)wid * 1024u;
    const int aoff = lds_byte(wr * 64 + fr, fq * 8), boff = lds_byte(wc * 32 + fr, fq * 8);
#define PG8_SA(b, h) (((b) * 2 + (h)) * HTB)
#define PG8_SB(b, h) ((4 + (b) * 2 + (h)) * HTB)
#define PG8_STAGE(bufoff, gbase, voff) do { _Pragma("unroll") for (int _i = 0; _i < 2; ++_i) \
        __builtin_amdgcn_global_load_lds((const unsigned*)((const char*)(gbase) + (voff)[_i]), (PG8_LAS unsigned*)(lds + (bufoff) + ldsw + _i * 8192), 16, 0, 0); } while (0)
#define PG8_LDA(dst, b, h) do { _Pragma("unroll") for (int m = 0; m < 4; ++m) _Pragma("unroll") for (int k = 0; k < 2; ++k) dst[m][k] = *(const PG8_LAS bf16x8*)(lds + PG8_SA(b, h) + aoff + m * 2048 + k * 1024); } while (0)
#define PG8_LDB(dst, b, h) do { _Pragma("unroll") for (int n = 0; n < 2; ++n) _Pragma("unroll") for (int k = 0; k < 2; ++k) dst[n][k] = *(const PG8_LAS bf16x8*)(lds + PG8_SB(b, h) + boff + n * 2048 + k * 1024); } while (0)
#define PG8_MMA(ai, bj, At, Bt) do { __builtin_amdgcn_s_setprio(1); _Pragma("unroll") for (int m = 0; m < 4; ++m) _Pragma("unroll") for (int n = 0; n < 2; ++n) _Pragma("unroll") for (int k = 0; k < 2; ++k) \
        acc[ai][bj][m][n] = __builtin_amdgcn_mfma_f32_16x16x32_bf16(Bt[n][k], At[m][k], acc[ai][bj][m][n], 0, 0, 0); __builtin_amdgcn_s_setprio(0); } while (0)
#define PG8_WAIT_V(n) asm volatile("s_waitcnt vmcnt(" #n ")" ::: "memory")
#define PG8_WAIT_L(n) asm volatile("s_waitcnt lgkmcnt(" #n ")" ::: "memory")
#define PG8_BAR __builtin_amdgcn_s_barrier()
#define PG8_SCHED __builtin_amdgcn_sched_barrier(0)
#define PG8_SETOFFS(o, u) do { _Pragma("unroll") for (int _h = 0; _h < 2; ++_h) _Pragma("unroll") for (int _i = 0; _i < 2; ++_i) \
        o[_h][_i] = GATHER ? (S.arow(u, sR[_i] + HALF * _h) + (unsigned)sC2[_i]) : ((unsigned)((sR[_i] + HALF * _h) * K) * 2u + (unsigned)sC2[_i]); } while (0)
    Unit cur, nxt; int ui = 0;
    if (!S.next(0, cur)) return;
    f32x4 acc[2][2][4][2];
#pragma unroll
    for (int a = 0; a < 2; ++a)
#pragma unroll
        for (int b = 0; b < 2; ++b)
#pragma unroll
            for (int m = 0; m < 4; ++m)
#pragma unroll
                for (int n = 0; n < 2; ++n) acc[a][b][m][n] = (f32x4){0.f, 0.f, 0.f, 0.f};
    bf16x8 At[4][2], B0[2][2], B1[2][2];
    unsigned cAo[2][2], nAo[2][2];
    PG8_SETOFFS(cAo, cur);
    const char* cA = S.abase(cur, g, tstep); const char* cB = S.bbase(cur, g, tstep);
    S.a_ready(cur);
    PG8_STAGE(PG8_SB(0, 0), cB, voffB); PG8_STAGE(PG8_SB(0, 1), cB + hstep, voffB); PG8_STAGE(PG8_SA(0, 0), cA, cAo[0]); PG8_STAGE(PG8_SA(0, 1), cA, cAo[1]);
    if (wr == 1) PG8_BAR;
    PG8_WAIT_V(2); PG8_BAR;
    PG8_STAGE(PG8_SB(1, 0), cB + kstep, voffB); PG8_STAGE(PG8_SA(1, 0), cA + kstep, cAo[0]); PG8_STAGE(PG8_SB(1, 1), cB + hstep + kstep, voffB);
    PG8_WAIT_V(6); PG8_BAR;
    for (;;) {
        const bool has_next = S.next(ui + 1, nxt);
        const char* nA = has_next ? S.abase(nxt, g, tstep) : cA; const char* nB = has_next ? S.bbase(nxt, g, tstep) : cB;
        if (has_next) { PG8_SETOFFS(nAo, nxt); } else {
#pragma unroll
            for (int _h = 0; _h < 2; ++_h)
#pragma unroll
                for (int _i = 0; _i < 2; ++_i) nAo[_h][_i] = cAo[_h][_i]; }
        for (int t = 0; t < nt; t += 2) {
            const bool last = (t == nt - 2);
            const char* a1 = cA + (size_t)(t + 1) * kstep;
            const char* a2 = last ? nA : cA + (size_t)(t + 2) * kstep; const char* b2 = last ? nB : cB + (size_t)(t + 2) * kstep;
            const char* a3 = a2 + kstep; const char* b3 = b2 + kstep;
            unsigned o2[2][2];
#pragma unroll
            for (int _h = 0; _h < 2; ++_h)
#pragma unroll
                for (int _i = 0; _i < 2; ++_i) o2[_h][_i] = last ? nAo[_h][_i] : cAo[_h][_i];
            if (last && has_next) S.a_ready(nxt);
            PG8_LDB(B0, 0, 0); PG8_LDB(B1, 0, 1); PG8_SCHED; PG8_LDA(At, 0, 0); PG8_STAGE(PG8_SA(1, 1), a1, cAo[1]);
            PG8_WAIT_V(8); PG8_WAIT_L(0); PG8_BAR; PG8_MMA(0, 0, At, B0); PG8_MMA(0, 1, At, B1); PG8_BAR; PG8_SCHED;
            PG8_LDA(At, 0, 1); PG8_STAGE(PG8_SB(0, 0), b2, voffB); PG8_STAGE(PG8_SB(0, 1), b2 + hstep, voffB); PG8_STAGE(PG8_SA(0, 0), a2, o2[0]);
            PG8_WAIT_V(8); PG8_WAIT_L(0); PG8_BAR; PG8_MMA(1, 0, At, B0); PG8_MMA(1, 1, At, B1); PG8_BAR; PG8_SCHED;
            PG8_LDB(B0, 1, 0); PG8_LDB(B1, 1, 1); PG8_SCHED; PG8_LDA(At, 1, 0); PG8_STAGE(PG8_SA(0, 1), a2, o2[1]);
            PG8_WAIT_V(8); PG8_WAIT_L(0); PG8_BAR; PG8_MMA(0, 0, At, B0); PG8_MMA(0, 1, At, B1); PG8_BAR; PG8_SCHED;
            PG8_LDA(At, 1, 1); PG8_STAGE(PG8_SB(1, 0), b3, voffB); PG8_STAGE(PG8_SB(1, 1), b3 + hstep, voffB); PG8_STAGE(PG8_SA(1, 0), a3, o2[0]);
            PG8_WAIT_V(8); PG8_WAIT_L(0); PG8_BAR; PG8_MMA(1, 0, At, B0); PG8_MMA(1, 1, At, B1); PG8_BAR; PG8_SCHED;
        }
        if constexpr (ALIGN_EPI) { if (wr == 0) PG8_BAR; }
        E(acc, cur, wr, wc, fr, fq); S.done(cur);
        if (!has_next) break;
#pragma unroll
        for (int a = 0; a < 2; ++a)
#pragma unroll
            for (int b = 0; b < 2; ++b)
#pragma unroll
                for (int m = 0; m < 4; ++m)
#pragma unroll
                    for (int n = 0; n < 2; ++n) acc[a][b][m][n] = (f32x4){0.f, 0.f, 0.f, 0.f};
        cur = nxt; cA = nA; cB = nB; ++ui;
#pragma unroll
        for (int _h = 0; _h < 2; ++_h)
#pragma unroll
            for (int _i = 0; _i < 2; ++_i) cAo[_h][_i] = nAo[_h][_i];
        if constexpr (ALIGN_EPI) { if (wr == 1) PG8_BAR; }
    }
    PG8_WAIT_V(0);
    if constexpr (!ALIGN_EPI) { if (wr == 0) PG8_BAR; }
    PG8_BAR;
#undef PG8_SA
#undef PG8_SB
#undef PG8_STAGE
#undef PG8_LDA
#undef PG8_LDB
#undef PG8_MMA
#undef PG8_WAIT_V
#undef PG8_WAIT_L
#undef PG8_BAR
#undef PG8_SCHED
#undef PG8_SETOFFS
}
}

constexpr int NB = 8, SEQ = 4096, DM = 1024, MROWS = NB * SEQ, NLAYER = 2;
constexpr int NPROJ = 4608, INW = 4616;
constexpr int C_Q = 0, C_K = 512, C_V = 1024, C_Z = 1536, C_XS = 2048, C_SB = 3072, C_SC = 3584, C_SH = 4096;
constexpr int MIXW = 1536, NEXP = 32, TOPK = 4, FF = 1024;
constexpr float ALPHA = 1.4142135623730951f;
constexpr float LN_EPS = 1e-5f, RMS_EPS = 1e-5f;
constexpr float QSCALE = 0.125f * 1.4426950408889634f;

constexpr size_t MiB = 1u << 20;
constexpr size_t WS_CTL = 0, CTL_ZERO_BYTES = 1 * MiB;
constexpr size_t WS_ROPE = 1 * MiB;
constexpr size_t WS_WDT = 2 * MiB;
constexpr size_t WS_ROUT = 2 * MiB + 65536;
constexpr size_t WS_WIN = 4 * MiB;
constexpr size_t WS_WOUT = 24 * MiB;
constexpr size_t WS_WGU = 32 * MiB;
constexpr size_t WS_WDN = 288 * MiB;
constexpr size_t WS_XB = 416 * MiB;
constexpr size_t WS_XF = 480 * MiB;
constexpr size_t WS_XF2 = 608 * MiB;
constexpr size_t WS_PROJ = 736 * MiB;
constexpr size_t WS_DT = 1024 * MiB;
constexpr size_t WS_DTS = 1025 * MiB;
constexpr size_t WS_ACUM = 1026 * MiB;
constexpr size_t WS_LSE = 1027 * MiB;
constexpr size_t WS_OP = 1030 * MiB;
constexpr size_t WS_U = 1126 * MiB;
constexpr size_t WS_G = 1190 * MiB;
constexpr size_t WS_ST = 1222 * MiB;
constexpr size_t WS_YD = 1286 * MiB;
constexpr size_t WS_MIXED = 1350 * MiB;
constexpr size_t WS_MIXF = 1446 * MiB;
constexpr size_t WS_TOPE = 1574 * MiB;
constexpr size_t WS_TOPG = 1575 * MiB;
constexpr size_t WS_ROWTOK = 1576 * MiB;
constexpr size_t WS_ROWGATE = 1580 * MiB;
constexpr size_t WS_H = 736 * MiB;
constexpr size_t WS_YB = 1030 * MiB;
constexpr size_t WS_END = 1584 * MiB;
constexpr int CW_TMO = 0;
constexpr int CW_CNT = 64;
constexpr int CW_BAR = 4096;

constexpr int RING_OFF = 0, RING_BYTES = 131072;
constexpr int LDSCTL_OFF = 155648;
constexpr int L_MISC = LDSCTL_OFF;
constexpr int L_TSTART = LDSCTL_OFF + 256;
constexpr int L_CNT = LDSCTL_OFF + 512;
constexpr int L_LCNT = LDSCTL_OFF + 640;
constexpr int L_LBASE = LDSCTL_OFF + 768;
constexpr int L_UNITS = LDSCTL_OFF + 1024;
constexpr int L_UNITSN = LDSCTL_OFF + 2048;
constexpr int LDS_BYTES = 163840;

#define GAS __attribute__((address_space(1)))
#define LAS __attribute__((address_space(3)))
typedef unsigned short bf16;
typedef unsigned v4u __attribute__((ext_vector_type(4)));
typedef unsigned v2u __attribute__((ext_vector_type(2)));
typedef float f32x4 __attribute__((ext_vector_type(4)));
typedef float f32x16 __attribute__((ext_vector_type(16)));
typedef short bf16x8 __attribute__((ext_vector_type(8)));
typedef GAS unsigned gu32;
#define RLX_AGENT __ATOMIC_RELAXED, __HIP_MEMORY_SCOPE_AGENT
#define LDS_WAIT() asm volatile("s_waitcnt lgkmcnt(0)" ::: "memory")
#define VM_WAIT() asm volatile("s_waitcnt vmcnt(0)" ::: "memory")
__device__ __forceinline__ unsigned f2bf(float f) { unsigned u = __builtin_bit_cast(unsigned, f); return (u + 0x7fffu + ((u >> 16) & 1u)) >> 16; }
__device__ __forceinline__ unsigned pk2(float lo, float hi) { return f2bf(lo) | (f2bf(hi) << 16); }
__device__ __forceinline__ float bf2f(unsigned short b) { return __builtin_bit_cast(float, (unsigned)b << 16); }
__device__ __forceinline__ float bflo(unsigned w) { return __builtin_bit_cast(float, w << 16); }
__device__ __forceinline__ float bfhi(unsigned w) { return __builtin_bit_cast(float, w & 0xffff0000u); }
__device__ __forceinline__ float siluf(float x) { return x / (1.0f + __expf(-x)); }
#define XB_TMO      128
#define XB_XCNT(j)  (256  + 64 * (j))
#define XB_XSUB(j)  (1280 + 64 * (j))
#define XB_XGEN(j)  (2304 + 64 * (j))
#define XB_TOP      3328
#define XB_TOPGEN   3392
#define XCD_BAR_WORDS 3456
#define XB_SPIN_CAP (1u << 18)

__device__ __forceinline__ unsigned xb_ld(unsigned* p)              { return __hip_atomic_load(p, __ATOMIC_RELAXED, __HIP_MEMORY_SCOPE_AGENT); }
__device__ __forceinline__ unsigned xb_add(unsigned* p, unsigned v) { return __hip_atomic_fetch_add(p, v, __ATOMIC_RELAXED, __HIP_MEMORY_SCOPE_AGENT); }
__device__ __forceinline__ unsigned xb_xcc_id() { return (unsigned)__builtin_amdgcn_s_getreg((3 << 11) | 20) & 0xFu; }
#define XB_SPIN(cond, bar) do { unsigned _sp = 0; while (cond) { __builtin_amdgcn_s_sleep(1); \
    if ((++_sp & 255u) == 0u) { if (xb_ld(&(bar)[XB_TMO])) break; if (_sp > XB_SPIN_CAP) { atomicAdd(&(bar)[XB_TMO], 1u); break; } } } } while (0)

struct XcdBarrier {
    unsigned* bar; unsigned x;
    volatile LAS unsigned* st;
};

__device__ __forceinline__ XcdBarrier xcd_barrier_post(unsigned* bar, volatile LAS unsigned* st) {
    XcdBarrier b; b.bar = bar; b.x = xb_xcc_id(); b.st = st;
    if (threadIdx.x == 0) (void)xb_add(&bar[XB_XCNT(b.x)], 1u);
    return b;
}
__device__ __forceinline__ void xcd_barrier_complete(unsigned* bar, unsigned x, unsigned& nloc, unsigned& nx) {
    const unsigned G = gridDim.x * gridDim.y * gridDim.z;
    unsigned sum, cnt, mine, sp = 0u;
    for (;;) {
        sum = 0u; cnt = 0u; mine = 0u;
#pragma unroll
        for (unsigned j = 0; j < 16; ++j) { const unsigned c = xb_ld(&bar[XB_XCNT(j)]); sum += c; cnt += (c > 0u) ? 1u : 0u; mine = (j == x) ? c : mine; }
        if (sum == G) break;
        __builtin_amdgcn_s_sleep(1);
        if ((++sp & 255u) == 0u) { if (xb_ld(&bar[XB_TMO])) break; if (sp > XB_SPIN_CAP) { atomicAdd(&bar[XB_TMO], 1u); break; } }
    }
    nloc = mine > 0u ? mine : 1u; nx = cnt > 0u ? cnt : 1u;
}

__device__ __forceinline__ void xcd_barrier(const XcdBarrier& b) {
    asm volatile("s_waitcnt vmcnt(0)" ::: "memory");
    __syncthreads();
    if (threadIdx.x == 0) {
        unsigned* bar = b.bar;
        __builtin_amdgcn_s_waitcnt(0);
        unsigned nloc = b.st[0], nx = b.st[1];
        if (nloc == 0u) { xcd_barrier_complete(bar, b.x, nloc, nx); b.st[0] = nloc; b.st[1] = nx; }
        const unsigned old = xb_add(&bar[XB_XSUB(b.x)], 1u);
        const unsigned gen = old / nloc;
        if (old + 1u == (gen + 1u) * nloc) {
            __builtin_amdgcn_fence(__ATOMIC_RELEASE, "agent");
            asm volatile("s_waitcnt vmcnt(0)" ::: "memory");
            const unsigned og = xb_add(&bar[XB_TOP], 1u);
            const unsigned tg = og / nx;
            if (og + 1u == (tg + 1u) * nx) xb_add(&bar[XB_TOPGEN], 1u);
            else XB_SPIN(xb_ld(&bar[XB_TOPGEN]) == tg, bar);
            __builtin_amdgcn_fence(__ATOMIC_ACQUIRE, "agent");
            xb_add(&bar[XB_XGEN(b.x)], 1u);
            asm volatile("s_waitcnt vmcnt(0)" ::: "memory");
        } else {
            XB_SPIN(xb_ld(&bar[XB_XGEN(b.x)]) == gen, bar);
            __builtin_amdgcn_fence(__ATOMIC_ACQUIRE, "agent");
            asm volatile("s_waitcnt vmcnt(0)" ::: "memory");
        }
    }
    __syncthreads();
}

__device__ __forceinline__ float wave_sum(float v) {
#pragma unroll
    for (int o = 1; o < 64; o <<= 1) v += __shfl_xor(v, o);
    return v;
}
__device__ __forceinline__ int win_dest_row(int n) {
    if (n < 1024) { const int hh = n >> 6, d = n & 63; const int p = (d < 32) ? (8 * (d >> 2) + (d & 3)) : (8 * ((d - 32) >> 2) + 4 + (d & 3)); return hh * 64 + p; }
    if (n < 3072) return n;
    if (n < 3080) return -1;
    return n - 8;
}
__device__ __forceinline__ int wgu_dest_row(int n) { return n < 1024 ? ((n >> 7) * 256 + (n & 127)) : (((n - 1024) >> 7) * 256 + 128 + ((n - 1024) & 127)); }
template <int MAP>
__device__ __forceinline__ void p0_transpose_item(const float* W, int K, int N, bf16* WT, float* wdt, LAS float* scr, int kb, int nb, int lane) {
    const int k0 = 64 * kb, n0 = 32 * nb;
    const int nn = n0 + (lane & 31); const bool nok = nn < N;
#pragma unroll 8
    for (int i = 0; i < 32; ++i) { const int kk = 2 * i + (lane >> 5); scr[kk * 33 + (lane & 31)] = nok ? W[(size_t)(k0 + kk) * N + nn] : 0.f; }
    LDS_WAIT(); asm volatile("" ::: "memory");
    const int c = lane & 7;
#pragma unroll
    for (int j = 0; j < 4; ++j) { const int n = (lane >> 3) + 8 * j; const LAS float* s = scr + (8 * c) * 33 + n;
        const int nsrc = n0 + n; if (nsrc >= N) continue;
        int drow = nsrc; if (MAP == 1) drow = win_dest_row(nsrc); if (MAP == 2) drow = wgu_dest_row(nsrc);
        if (MAP == 1 && drow < 0) { float* d = wdt + (size_t)(nsrc - 3072) * 1024 + k0 + 8 * c;
#pragma unroll
            for (int q = 0; q < 8; ++q) d[q] = s[q * 33]; continue; }
        v4u o; o.x = pk2(s[0 * 33], s[1 * 33]); o.y = pk2(s[2 * 33], s[3 * 33]); o.z = pk2(s[4 * 33], s[5 * 33]); o.w = pk2(s[6 * 33], s[7 * 33]);
        *(GAS v4u*)(WT + (size_t)drow * K + k0 + 8 * c) = o; }
    LDS_WAIT(); asm volatile("" ::: "memory");
}
__device__ __forceinline__ void row_dt(const f32x4 (&v)[4], const float* wdt, float* dst, int lane) {
    float r[8];
#pragma unroll
    for (int jj = 0; jj < 8; ++jj) { float s = 0.f;
#pragma unroll
        for (int j = 0; j < 4; ++j) { const f32x4 w = *(const f32x4*)(wdt + jj * 1024 + 4 * lane + 256 * j); s += v[j][0] * w[0] + v[j][1] * w[1] + v[j][2] * w[2] + v[j][3] * w[3]; }
        r[jj] = wave_sum(s); }
    if (lane == 0) { *(f32x4*)dst = (f32x4){r[0], r[1], r[2], r[3]}; *(f32x4*)(dst + 4) = (f32x4){r[4], r[5], r[6], r[7]}; }
}
__device__ __forceinline__ void ln_row(f32x4 (&v)[4], const float* gam, const float* bet, float* of32, bf16* ob16, int lane) {
    float s = 0.f;
#pragma unroll
    for (int j = 0; j < 4; ++j) s += (v[j][0] + v[j][1]) + (v[j][2] + v[j][3]);
    const float mean = wave_sum(s) * (1.f / DM); float s2 = 0.f;
#pragma unroll
    for (int j = 0; j < 4; ++j) { v[j] = v[j] - mean; s2 += (v[j][0] * v[j][0] + v[j][1] * v[j][1]) + (v[j][2] * v[j][2] + v[j][3] * v[j][3]); }
    const float rstd = 1.f / sqrtf(wave_sum(s2) * (1.f / DM) + LN_EPS);
#pragma unroll
    for (int j = 0; j < 4; ++j) { const f32x4 g = *(const f32x4*)(gam + 4 * lane + 256 * j), b = *(const f32x4*)(bet + 4 * lane + 256 * j);
        v[j] = v[j] * rstd * g + b;
        *(f32x4*)(of32 + 4 * lane + 256 * j) = v[j];
        v2u w; w.x = pk2(v[j][0], v[j][1]); w.y = pk2(v[j][2], v[j][3]); *(v2u*)(ob16 + 4 * lane + 256 * j) = w; }
}


typedef short v4i16_t __attribute__((ext_vector_type(4)));
__device__ __forceinline__ bf16x8 tr_pair(const LAS unsigned char* p0, const LAS unsigned char* p1) {
    const v4i16_t a = __builtin_amdgcn_ds_read_tr16_b64_v4i16((LAS v4i16_t*)p0), b = __builtin_amdgcn_ds_read_tr16_b64_v4i16((LAS v4i16_t*)p1);
    return (bf16x8){a[0], a[1], a[2], a[3], b[0], b[1], b[2], b[3]};
}
__device__ __forceinline__ int crow16(int r, int hi) { return (r & 3) + 8 * (r >> 2) + 4 * hi; }
constexpr int AV_PITCH = 192;
__device__ __forceinline__ void attn_wave_unit(const bf16* PROJ, bf16* OPp, float* LSEp, int b, int h, int d, int r, int qt, LAS unsigned char* vl, int lane) {
    const int i = lane & 31, h2 = lane >> 5;
    const size_t rowq = (size_t)b * SEQ + (size_t)(32 * qt + i) * d + r;
    bf16x8 qf[4];
    { const bf16* qp = PROJ + rowq * NPROJ + C_Q + h * 64 + 8 * h2;
#pragma unroll
      for (int s = 0; s < 4; ++s) qf[s] = *(const bf16x8*)(qp + 16 * s); }
    f32x16 o0 = {}, o1 = {}; float mrun = -INFINITY, lrun = 0.f;
    const int kt0 = qt > 4 ? qt - 4 : 0;
    bf16x8 kf[4]; v4u vr[4];
    { const size_t rowk = (size_t)b * SEQ + (size_t)(32 * kt0 + i) * d + r; const bf16* kp = PROJ + rowk * NPROJ + C_K + h * 64 + 8 * h2;
#pragma unroll
      for (int s = 0; s < 4; ++s) kf[s] = *(const bf16x8*)(kp + 16 * s);
#pragma unroll
      for (int c = 0; c < 4; ++c) { const size_t rowv = (size_t)b * SEQ + (size_t)(32 * kt0 + (lane >> 3) + 8 * c) * d + r; vr[c] = *(const v4u*)(PROJ + rowv * NPROJ + C_V + h * 64 + 8 * (lane & 7)); } }
    const LAS unsigned char* trb = vl + (4 * h2 + ((lane & 15) >> 2)) * AV_PITCH + (16 * ((lane >> 4) & 1) + 4 * (lane & 3)) * 2;
#pragma unroll 1
    for (int kt = kt0; kt <= qt; ++kt) {
#pragma unroll
        for (int c = 0; c < 4; ++c) *(LAS v4u*)(vl + ((lane >> 3) + 8 * c) * AV_PITCH + (lane & 7) * 16) = vr[c];
        f32x16 sacc = {};
#pragma unroll
        for (int s = 0; s < 4; ++s) sacc = __builtin_amdgcn_mfma_f32_32x32x16_bf16(kf[s], qf[s], sacc, 0, 0, 0);
        if (kt < qt) {
            const size_t rowk = (size_t)b * SEQ + (size_t)(32 * (kt + 1) + i) * d + r; const bf16* kp = PROJ + rowk * NPROJ + C_K + h * 64 + 8 * h2;
#pragma unroll
            for (int s = 0; s < 4; ++s) kf[s] = *(const bf16x8*)(kp + 16 * s);
#pragma unroll
            for (int c = 0; c < 4; ++c) { const size_t rowv = (size_t)b * SEQ + (size_t)(32 * (kt + 1) + (lane >> 3) + 8 * c) * d + r; vr[c] = *(const v4u*)(PROJ + rowv * NPROJ + C_V + h * 64 + 8 * (lane & 7)); }
        }
        if (kt == qt) {
#pragma unroll
            for (int rg = 0; rg < 16; ++rg) if (crow16(rg, h2) > i) sacc[rg] = -INFINITY;
        }
        if (kt + 4 == qt) {
#pragma unroll
            for (int rg = 0; rg < 16; ++rg) if (crow16(rg, h2) < i) sacc[rg] = -INFINITY;
        }
        float mx = sacc[0];
#pragma unroll
        for (int rg = 1; rg < 16; ++rg) mx = fmaxf(mx, sacc[rg]);
        mx = fmaxf(mx, __shfl_xor(mx, 32));
        const float mnew = fmaxf(mrun, mx), alpha = __builtin_amdgcn_exp2f(mrun - mnew); mrun = mnew;
        float ps = 0.f;
#pragma unroll
        for (int rg = 0; rg < 16; ++rg) { sacc[rg] = __builtin_amdgcn_exp2f(sacc[rg] - mnew); ps += sacc[rg]; }
        lrun = lrun * alpha + ps;
#pragma unroll
        for (int rg = 0; rg < 16; ++rg) { o0[rg] *= alpha; o1[rg] *= alpha; }
        bf16x8 pf[2];
#pragma unroll
        for (int ks = 0; ks < 2; ++ks) { v4u w; w.x = pg8::cvt_pk_bf16(sacc[8 * ks + 0], sacc[8 * ks + 1]); w.y = pg8::cvt_pk_bf16(sacc[8 * ks + 2], sacc[8 * ks + 3]); w.z = pg8::cvt_pk_bf16(sacc[8 * ks + 4], sacc[8 * ks + 5]); w.w = pg8::cvt_pk_bf16(sacc[8 * ks + 6], sacc[8 * ks + 7]); pf[ks] = __builtin_bit_cast(bf16x8, w); }
#pragma unroll
        for (int ks = 0; ks < 2; ++ks) {
            const bf16x8 v0 = tr_pair(trb + (16 * ks) * AV_PITCH, trb + (16 * ks + 8) * AV_PITCH);
            const bf16x8 v1 = tr_pair(trb + (16 * ks) * AV_PITCH + 64, trb + (16 * ks + 8) * AV_PITCH + 64);
            o0 = __builtin_amdgcn_mfma_f32_32x32x16_bf16(v0, pf[ks], o0, 0, 0, 0);
            o1 = __builtin_amdgcn_mfma_f32_32x32x16_bf16(v1, pf[ks], o1, 0, 0, 0);
        }
    }
    const float lt = lrun + __shfl_xor(lrun, 32); const float il = 1.0f / lt;
    bf16* op = OPp + rowq * 512 + h * 64 + 4 * h2;
#pragma unroll
    for (int g4 = 0; g4 < 4; ++g4) {
        v2u w0, w1; w0.x = pg8::cvt_pk_bf16(o0[4 * g4 + 0] * il, o0[4 * g4 + 1] * il); w0.y = pg8::cvt_pk_bf16(o0[4 * g4 + 2] * il, o0[4 * g4 + 3] * il);
        w1.x = pg8::cvt_pk_bf16(o1[4 * g4 + 0] * il, o1[4 * g4 + 1] * il); w1.y = pg8::cvt_pk_bf16(o1[4 * g4 + 2] * il, o1[4 * g4 + 3] * il);
        *(v2u*)(op + 8 * g4) = w0; *(v2u*)(op + 32 + 8 * g4) = w1; }
    if (h2 == 0) LSEp[rowq * 8 + h] = mrun + log2f(lt);
}


constexpr int SS_DTS = 0, SS_ACUM = 2048, SS_TMP = 4096, SS_SSX = 6144, SS_IMG = 8192;
constexpr int S1_PB = 320, S1_PX = 576;
constexpr int S1_B = SS_IMG, S1_X = SS_IMG + 128 * S1_PB;
constexpr int S3_PBC = 272, S3_PX = 576;
constexpr int S3_B = SS_IMG, S3_C = S3_B + 128 * S3_PBC, S3_X = S3_C + 128 * S3_PBC;

__device__ __forceinline__ void ssd_prep(LAS unsigned char* sl, const float* DT, const float* dtb, const float* alog, size_t row0, int g, int tid, int lane, int wave) {
    LAS float* dts = (LAS float*)(sl + SS_DTS); LAS float* acum = (LAS float*)(sl + SS_ACUM); LAS float* tmp = (LAS float*)(sl + SS_TMP);
    { const int l = tid >> 2, hq = tid & 3; const float x = DT[(row0 + l) * 8 + 4 * g + hq] + dtb[4 * g + hq];
      const float dt = x > 20.f ? x : log1pf(__expf(x)); dts[hq * 128 + l] = dt; tmp[hq * 128 + l] = dt * (-__expf(alog[4 * g + hq])); }
    __syncthreads();
    if (wave < 4) { const float v0 = tmp[wave * 128 + 2 * lane], v1 = tmp[wave * 128 + 2 * lane + 1]; float s = v0 + v1;
#pragma unroll
        for (int off = 1; off < 64; off <<= 1) { const float t = __shfl_up(s, off); if (lane >= off) s += t; }
        acum[wave * 128 + 2 * lane] = s - v1; acum[wave * 128 + 2 * lane + 1] = s; }
    __syncthreads();
}
template <int NCOLS, int FACMODE>
__device__ __forceinline__ void conv_tile(const bf16* PROJ, size_t row0, int t0, int pcol0, const float* cw, const float* cb, int cch0, LAS unsigned char* dst, int pitch, const LAS unsigned char* sl, int hq0, int tid) {
    constexpr int NCH8 = NCOLS / 8, NSEG = 512 / NCH8, RPS = 128 / NSEG;
    const int c8 = tid % NCH8, seg = tid / NCH8, l0 = seg * RPS;
    float w[4][8], bias[8], hst[3][8];
#pragma unroll
    for (int k = 0; k < 4; ++k) { const f32x4 a = *(const f32x4*)(cw + k * 1024 + cch0 + c8 * 8), b = *(const f32x4*)(cw + k * 1024 + cch0 + c8 * 8 + 4);
        w[k][0] = a[0]; w[k][1] = a[1]; w[k][2] = a[2]; w[k][3] = a[3]; w[k][4] = b[0]; w[k][5] = b[1]; w[k][6] = b[2]; w[k][7] = b[3]; }
    { const f32x4 a = *(const f32x4*)(cb + cch0 + c8 * 8), b = *(const f32x4*)(cb + cch0 + c8 * 8 + 4);
      bias[0] = a[0]; bias[1] = a[1]; bias[2] = a[2]; bias[3] = a[3]; bias[4] = b[0]; bias[5] = b[1]; bias[6] = b[2]; bias[7] = b[3]; }
    const bf16* src = PROJ + pcol0 + c8 * 8;
#pragma unroll
    for (int k = 0; k < 3; ++k) { const int l = l0 - 3 + k; v4u v = (v4u){0u, 0u, 0u, 0u}; if (t0 + l >= 0) v = *(const v4u*)(src + (size_t)((long)row0 + l) * NPROJ);
        hst[k][0] = bflo(v.x); hst[k][1] = bfhi(v.x); hst[k][2] = bflo(v.y); hst[k][3] = bfhi(v.y); hst[k][4] = bflo(v.z); hst[k][5] = bfhi(v.z); hst[k][6] = bflo(v.w); hst[k][7] = bfhi(v.w); }
    const LAS float* dts = (const LAS float*)(sl + SS_DTS); const LAS float* acum = (const LAS float*)(sl + SS_ACUM);
    const int hq = hq0 + (c8 * 8) / 64;
    const float alast = (FACMODE == 2) ? acum[hq * 128 + 127] : 0.f;
#pragma unroll
    for (int rr = 0; rr < RPS; ++rr) { const int l = l0 + rr; const v4u v = *(const v4u*)(src + (row0 + l) * NPROJ);
        float cur[8]; cur[0] = bflo(v.x); cur[1] = bfhi(v.x); cur[2] = bflo(v.y); cur[3] = bfhi(v.y); cur[4] = bflo(v.z); cur[5] = bfhi(v.z); cur[6] = bflo(v.w); cur[7] = bfhi(v.w);
        float f = 1.f; if (FACMODE >= 1) f = dts[hq * 128 + l]; if (FACMODE == 2) f *= __expf(alast - acum[hq * 128 + l]);
        float o[8];
#pragma unroll
        for (int e = 0; e < 8; ++e) { const float a = bias[e] + w[0][e] * hst[0][e] + w[1][e] * hst[1][e] + w[2][e] * hst[2][e] + w[3][e] * cur[e]; o[e] = siluf(a) * f;
            hst[0][e] = hst[1][e]; hst[1][e] = hst[2][e]; hst[2][e] = cur[e]; }
        v4u ov; ov.x = pk2(o[0], o[1]); ov.y = pk2(o[2], o[3]); ov.z = pk2(o[4], o[5]); ov.w = pk2(o[6], o[7]);
        *(LAS v4u*)(dst + l * pitch + c8 * 16) = ov; }
}
__device__ __forceinline__ void ssd_s1_unit(LAS unsigned char* sl, const bf16* PROJ, const float* DT, const float* dtb, const float* alog, const float* cw, const float* cb, float* ST, float* CDEC, int un, int tid, int lane, int wave) {
    const int g = un & 1, bc = un >> 1; const size_t row0 = (size_t)bc * 128; const int t0 = (bc & 31) * 128;
    __syncthreads();
    ssd_prep(sl, DT, dtb, alog, row0, g, tid, lane, wave);
    conv_tile<128, 0>(PROJ, row0, t0, C_XS + 512 + g * 128, cw, cb, 512 + g * 128, sl + S1_B, S1_PB, sl, 0, tid);
    conv_tile<256, 2>(PROJ, row0, t0, C_XS + g * 256, cw, cb, g * 256, sl + S1_X, S1_PX, sl, 0, tid);
    if (tid < 4) CDEC[(size_t)bc * 8 + 4 * g + tid] = __expf(((const LAS float*)(sl + SS_ACUM))[tid * 128 + 127]);
    __syncthreads();
    const int hq = wave >> 1, pt = wave & 1, h2 = lane >> 5, q = (lane & 15) >> 2, pp = lane & 3, dsel = (lane >> 4) & 1;
    const LAS unsigned char* xb = sl + S1_X + (8 * h2 + q) * S1_PX + (hq * 64 + pt * 32 + 16 * dsel + 4 * pp) * 2;
    const LAS unsigned char* bb = sl + S1_B + (8 * h2 + q) * S1_PB + (16 * dsel + 4 * pp) * 2;
    f32x16 acc[4];
#pragma unroll
    for (int nt = 0; nt < 4; ++nt) acc[nt] = (f32x16){};
#pragma unroll
    for (int ks = 0; ks < 8; ++ks) { const bf16x8 a = tr_pair(xb + (16 * ks) * S1_PX, xb + (16 * ks + 4) * S1_PX);
#pragma unroll
        for (int nt = 0; nt < 4; ++nt) { const bf16x8 b = tr_pair(bb + (16 * ks) * S1_PB + nt * 64, bb + (16 * ks + 4) * S1_PB + nt * 64); acc[nt] = __builtin_amdgcn_mfma_f32_32x32x16_bf16(a, b, acc[nt], 0, 0, 0); } }
    float* sp = ST + ((size_t)(bc * 8 + 4 * g + hq) * 64 + pt * 32) * 128 + (lane & 31);
#pragma unroll
    for (int nt = 0; nt < 4; ++nt)
#pragma unroll
        for (int rg = 0; rg < 16; ++rg) sp[(size_t)crow16(rg, h2) * 128 + 32 * nt] = acc[nt][rg];
}
__device__ __forceinline__ void ssd_s3_unit(LAS unsigned char* sl, const bf16* PROJ, const float* DT, const float* dtb, const float* alog, const float* cw, const float* cb, const float* dsk, const float* ng,
                                            const bf16* HIN, bf16* MIXED, int un, int tid, int lane, int wave) {
    const int g = un & 1, bc = un >> 1; const size_t row0 = (size_t)bc * 128; const int t0 = (bc & 31) * 128;
    __syncthreads();
    ssd_prep(sl, DT, dtb, alog, row0, g, tid, lane, wave);
    conv_tile<128, 0>(PROJ, row0, t0, C_XS + 512 + g * 128, cw, cb, 512 + g * 128, sl + S3_B, S3_PBC, sl, 0, tid);
    conv_tile<128, 0>(PROJ, row0, t0, C_XS + 768 + g * 128, cw, cb, 768 + g * 128, sl + S3_C, S3_PBC, sl, 0, tid);
    conv_tile<256, 1>(PROJ, row0, t0, C_XS + g * 256, cw, cb, g * 256, sl + S3_X, S3_PX, sl, 0, tid);
    __syncthreads();
    const LAS float* dts = (const LAS float*)(sl + SS_DTS); const LAS float* acum = (const LAS float*)(sl + SS_ACUM); LAS float* ssx = (LAS float*)(sl + SS_SSX);
    const int lt = wave & 3, ph = wave >> 2, lq = lane & 31, hi = lane >> 5, q = (lane & 15) >> 2, pp = lane & 3, dsel = (lane >> 4) & 1;
    const int lrow = 32 * lt + lq;
    const LAS unsigned char* crd = sl + S3_C + lrow * S3_PBC + 16 * hi;
    f32x16 ag[4];
#pragma unroll
    for (int st = 0; st < 4; ++st) { ag[st] = (f32x16){};
        if (st <= lt) { const LAS unsigned char* brd = sl + S3_B + (32 * st + lq) * S3_PBC + 16 * hi;
#pragma unroll
            for (int ks = 0; ks < 8; ++ks) ag[st] = __builtin_amdgcn_mfma_f32_32x32x16_bf16(*(const LAS bf16x8*)(brd + 32 * ks), *(const LAS bf16x8*)(crd + 32 * ks), ag[st], 0, 0, 0); } }
    unsigned ayp[4][8]; float ss = 0.f; const size_t grow = row0 + lrow;
#pragma unroll
    for (int hq = 0; hq < 4; ++hq) {
            const float al = acum[hq * 128 + lrow], dd = dsk[4 * g + hq] / dts[hq * 128 + lrow];
            const LAS unsigned char* xb = sl + S3_X + (4 * hi + q) * S3_PX + (hq * 64 + ph * 32 + 16 * dsel + 4 * pp) * 2;
            f32x16 y = (f32x16){};
            { const bf16* hp = HIN + ((size_t)(bc * 8 + 4 * g + hq) * 64 + ph * 32 + lq) * 128 + 8 * hi;
#pragma unroll
              for (int ks = 0; ks < 8; ++ks) y = __builtin_amdgcn_mfma_f32_32x32x16_bf16(*(const bf16x8*)(hp + 16 * ks), *(const LAS bf16x8*)(crd + 32 * ks), y, 0, 0, 0);
              const float ea = __expf(al);
#pragma unroll
              for (int rg = 0; rg < 16; ++rg) y[rg] *= ea; }
#pragma unroll
            for (int st = 0; st < 4; ++st) if (st <= lt) {
                float pm[16];
#pragma unroll
                for (int g4 = 0; g4 < 4; ++g4) { const f32x4 as4 = *(const LAS f32x4*)(acum + hq * 128 + 32 * st + 8 * g4 + 4 * hi);
#pragma unroll
                    for (int e = 0; e < 4; ++e) { const int rg = 4 * g4 + e; float v = ag[st][rg] * __expf(al - as4[e]);
                        if (st == lt) { const int sl_ = 8 * g4 + 4 * hi + e; if (sl_ > lq) v = 0.f; if (sl_ == lq) v += dd; }
                        pm[rg] = v; } }
#pragma unroll
                for (int ks = 0; ks < 2; ++ks) { v4u wv; wv.x = pg8::cvt_pk_bf16(pm[8 * ks + 0], pm[8 * ks + 1]); wv.y = pg8::cvt_pk_bf16(pm[8 * ks + 2], pm[8 * ks + 3]); wv.z = pg8::cvt_pk_bf16(pm[8 * ks + 4], pm[8 * ks + 5]); wv.w = pg8::cvt_pk_bf16(pm[8 * ks + 6], pm[8 * ks + 7]);
                    const bf16x8 xt = tr_pair(xb + (32 * st + 16 * ks) * S3_PX, xb + (32 * st + 16 * ks + 8) * S3_PX);
                    y = __builtin_amdgcn_mfma_f32_32x32x16_bf16(xt, __builtin_bit_cast(bf16x8, wv), y, 0, 0, 0); }
            }
#pragma unroll
            for (int g4 = 0; g4 < 4; ++g4) { const int ch = hq * 64 + ph * 32 + 8 * g4 + 4 * hi; const v2u z = *(const v2u*)(PROJ + grow * NPROJ + C_Z + g * 256 + ch);
                const float y0 = y[4 * g4 + 0] * siluf(bflo(z.x)), y1 = y[4 * g4 + 1] * siluf(bfhi(z.x)), y2 = y[4 * g4 + 2] * siluf(bflo(z.y)), y3 = y[4 * g4 + 3] * siluf(bfhi(z.y));
                ss += (y0 * y0 + y1 * y1) + (y2 * y2 + y3 * y3);
                ayp[hq][2 * g4] = pg8::cvt_pk_bf16(y0, y1); ayp[hq][2 * g4 + 1] = pg8::cvt_pk_bf16(y2, y3); }
    }
    ss += __shfl_xor(ss, 32);
    if (hi == 0) ssx[ph * 128 + lrow] = ss;
    __syncthreads();
    const float rs = 1.0f / sqrtf((ssx[lrow] + ssx[128 + lrow]) * (1.f / 256.f) + RMS_EPS);
#pragma unroll
    for (int hq = 0; hq < 4; ++hq)
#pragma unroll
        for (int g4 = 0; g4 < 4; ++g4) { const int ch = hq * 64 + ph * 32 + 8 * g4 + 4 * hi; const f32x4 gn = *(const f32x4*)(ng + g * 256 + ch);
            const unsigned p0 = ayp[hq][2 * g4], p1 = ayp[hq][2 * g4 + 1];
            v2u o; o.x = pg8::cvt_pk_bf16(bflo(p0) * rs * gn[0], bfhi(p0) * rs * gn[1]); o.y = pg8::cvt_pk_bf16(bflo(p1) * rs * gn[2], bfhi(p1) * rs * gn[3]);
            *(v2u*)(MIXED + grow * MIXW + 512 + g * 256 + ch) = o; }
}

struct Args { const float* in[20]; float* out; unsigned char* ws; int ph_lo, ph_hi; };
constexpr int NWAVES = 8;
constexpr int PH_PER_LAYER = 10, N_PHASES = 1 + NLAYER * PH_PER_LAYER;

#define in_x (args.in[0])
#define in_win (args.in[1])
#define in_convw (args.in[2])
#define in_convb (args.in[3])
#define in_dtb (args.in[4])
#define in_alog (args.in[5])
#define in_dsk (args.in[6])
#define in_ng (args.in[7])
#define in_scw (args.in[8])
#define in_wout (args.in[9])
#define in_ln1g (args.in[10])
#define in_ln1b (args.in[11])
#define in_rw (args.in[12])
#define in_rb (args.in[13])
#define in_wgu (args.in[14])
#define in_bgu (args.in[15])
#define in_wdn (args.in[16])
#define in_bdn (args.in[17])
#define in_ln2g (args.in[18])
#define in_ln2b (args.in[19])
#define ROPE ((float*)(args.ws + WS_ROPE))
#define WDT ((float*)(args.ws + WS_WDT))
#define ROUT ((bf16*)(args.ws + WS_ROUT))
#define WIN ((bf16*)(args.ws + WS_WIN))
#define WOUT ((bf16*)(args.ws + WS_WOUT))
#define WGU ((bf16*)(args.ws + WS_WGU))
#define WDN ((bf16*)(args.ws + WS_WDN))
#define XB ((bf16*)(args.ws + WS_XB))
#define XF ((float*)(args.ws + WS_XF))
#define XF2 ((float*)(args.ws + WS_XF2))
#define PROJ ((bf16*)(args.ws + WS_PROJ))
#define DT ((float*)(args.ws + WS_DT))
#define DTS ((float*)(args.ws + WS_DTS))
#define ACUM ((float*)(args.ws + WS_ACUM))
#define LSE ((float*)(args.ws + WS_LSE))
#define OP ((bf16*)(args.ws + WS_OP))
#define U ((bf16*)(args.ws + WS_U))
#define GB ((float*)(args.ws + WS_G))
#define ST ((float*)(args.ws + WS_ST))
#define YD ((float*)(args.ws + WS_YD))
#define MIXED ((bf16*)(args.ws + WS_MIXED))
#define MIXF ((float*)(args.ws + WS_MIXF))
#define TOPE ((int*)(args.ws + WS_TOPE))
#define TOPG ((float*)(args.ws + WS_TOPG))
#define ROWTOK ((int*)(args.ws + WS_ROWTOK))
#define ROWGATE ((float*)(args.ws + WS_ROWGATE))
#define HB ((bf16*)(args.ws + WS_H))
#define YB ((bf16*)(args.ws + WS_YB))
#define HIN ((bf16*)(args.ws + WS_G))
#define CDEC ((float*)(args.ws + WS_ACUM))
template <int layer>
__device__ __forceinline__ void run_layer(const Args& args, int lo, int hi, const XcdBarrier& bar) {
    extern __shared__ __attribute__((aligned(16))) unsigned char lds[];
    LAS unsigned char* ldsp = (LAS unsigned char*)lds;
    const int tid = threadIdx.x, lane = tid & 63, wave = __builtin_amdgcn_readfirstlane(tid >> 6);
    const int G = gridDim.x, bid = blockIdx.x;
    const int gw = bid * NWAVES + wave, NGW = G * NWAVES;
    gu32* ctl = (gu32*)(args.ws + WS_CTL);

#define IN(k) (lo <= (k) && (k) < hi)
#define SEAM(k) do { if (IN(k) && IN((k) + 1)) xcd_barrier(bar); } while (0)

        const int pb = 1 + layer * PH_PER_LAYER;
        const float* xres = layer == 0 ? in_x : XF2;
        const bf16* WINl = WIN + (size_t)layer * NPROJ * DM; const bf16* WOUTl = WOUT + (size_t)layer * DM * MIXW;
        const bf16* WGUl = WGU + (size_t)layer * NEXP * 2048 * DM; const bf16* WDNl = WDN + (size_t)layer * NEXP * DM * FF;
        gu32* gcnt = ctl + CW_CNT + 64 * layer;

        if (IN(pb + 0)) {
            if (layer == 0) {
                for (int m = gw; m < MROWS; m += NGW) { const float* xr = in_x + (size_t)m * DM; f32x4 v[4];
#pragma unroll
                    for (int j = 0; j < 4; ++j) v[j] = *(const f32x4*)(xr + 4 * lane + 256 * j);
                    row_dt(v, WDT, DT + (size_t)m * 8, lane); }
            }
            pg8::Gemm g{XB, WINl, MROWS, NPROJ, DM}; pg8::StaticOrder S; S.init(MROWS, NPROJ, G, bid);
            pg8::EpiProj E{PROJ, NPROJ, ROPE, QSCALE};
            pg8::gemm_phase<pg8::EpiProj, pg8::StaticOrder, true, false>(ldsp + RING_OFF, g, S, E);
        }
        SEAM(pb + 0);
        if (IN(pb + 1)) {
            { LAS unsigned char* vl = ldsp + RING_OFF + wave * 6144;
              for (int I = bid; I < 3072; I += G) {
                  const int p = I >> 10, rem = I & 1023, b = rem >> 7, h = (rem >> 4) & 7, grp = rem & 15;
                  const int d = (p == 0) ? 1 : (p == 1) ? 4 : 16; const int tpr = 128 / d;
                  const int T = grp * 8 + wave; const int r = T / tpr, qt = T % tpr;
                  attn_wave_unit(PROJ, OP + (size_t)p * MROWS * 512, LSE + (size_t)p * MROWS * 8, b, h, d, r, qt, vl, lane); } }
            { const float* cw = in_convw + (size_t)layer * 4 * 1024; const float* cb = in_convb + (size_t)layer * 1024;
              for (int un = bid; un < 512; un += G)
                  ssd_s1_unit(ldsp + RING_OFF, PROJ, DT, in_dtb + layer * 8, in_alog + layer * 8, cw, cb, ST, CDEC, un, tid, lane, wave);
              __syncthreads(); }
            const float* sw = in_scw + (size_t)layer * 3 * 512;
            for (int it = bid * (NWAVES * 64) + tid; it < (int)((long)MROWS * 64); it += G * (NWAVES * 64)) { const int c8 = (int)(it & 63), row = (int)(it >> 6), t = row & (SEQ - 1); const int ch = c8 * 8;
                float a[8];
#pragma unroll
                for (int q = 0; q < 8; ++q) a[q] = 0.f;
#pragma unroll
                for (int k = 0; k < 3; ++k) { const int tt = t - 2 + k; if (tt >= 0) { const bf16* pr = PROJ + (size_t)(row - 2 + k) * NPROJ; const v4u cc = *(const v4u*)(pr + C_SC + ch), hh = *(const v4u*)(pr + C_SH + ch);
                    const f32x4 w0 = *(const f32x4*)(sw + k * 512 + ch), w1 = *(const f32x4*)(sw + k * 512 + ch + 4);
                    a[0] += w0[0] * bflo(cc.x) * bflo(hh.x); a[1] += w0[1] * bfhi(cc.x) * bfhi(hh.x); a[2] += w0[2] * bflo(cc.y) * bflo(hh.y); a[3] += w0[3] * bfhi(cc.y) * bfhi(hh.y);
                    a[4] += w1[0] * bflo(cc.z) * bflo(hh.z); a[5] += w1[1] * bfhi(cc.z) * bfhi(hh.z); a[6] += w1[2] * bflo(cc.w) * bflo(hh.w); a[7] += w1[3] * bfhi(cc.w) * bfhi(hh.w); } }
                const v4u bb = *(const v4u*)(PROJ + (size_t)row * NPROJ + C_SB + ch);
                v4u o; o.x = pk2(a[0] * bflo(bb.x), a[1] * bfhi(bb.x)); o.y = pk2(a[2] * bflo(bb.y), a[3] * bfhi(bb.y)); o.z = pk2(a[4] * bflo(bb.z), a[5] * bfhi(bb.z)); o.w = pk2(a[6] * bflo(bb.w), a[7] * bfhi(bb.w));
                *(v4u*)(MIXED + (size_t)row * MIXW + 1024 + ch) = o; }
        }
        SEAM(pb + 1);
        if (IN(pb + 2)) {
            for (int it = bid * (NWAVES * 64) + tid; it < (int)(64L * 2048); it += G * (NWAVES * 64)) { const int pn4 = (int)(it & 2047), bh = (int)(it >> 11); const int h = bh & 7, b = bh >> 3; f32x4 hc = (f32x4){0.f, 0.f, 0.f, 0.f};
#pragma unroll 8
                for (int c = 0; c < 32; ++c) { const size_t idx = ((size_t)((b * 32 + c) * 8 + h)) * 8192 + pn4 * 4; const f32x4 st = *(const f32x4*)(ST + idx);
                    v2u o; o.x = pk2(hc[0], hc[1]); o.y = pk2(hc[2], hc[3]); *(v2u*)(HIN + idx) = o;
                    hc = hc * CDEC[(size_t)(b * 32 + c) * 8 + h] + st; } }
        }
        SEAM(pb + 2);
        if (IN(pb + 3)) {
            { const float* cw = in_convw + (size_t)layer * 4 * 1024; const float* cb = in_convb + (size_t)layer * 1024;
              for (int un = bid; un < 512; un += G)
                  ssd_s3_unit(ldsp + RING_OFF, PROJ, DT, in_dtb + layer * 8, in_alog + layer * 8, cw, cb, in_dsk + layer * 8, in_ng + (size_t)layer * 512, HIN, MIXED, un, tid, lane, wave);
              __syncthreads(); }
            for (int it = bid * (NWAVES * 64) + tid; it < (int)((long)MROWS * 64); it += G * (NWAVES * 64)) { const int c8 = (int)(it & 63), row = (int)(it >> 6); const int h = c8 >> 3;
                const float l0 = LSE[((size_t)0 * MROWS + row) * 8 + h], l1 = LSE[((size_t)1 * MROWS + row) * 8 + h], l2 = LSE[((size_t)2 * MROWS + row) * 8 + h];
                const float mm = fmaxf(l0, fmaxf(l1, l2)); float w0 = exp2f(l0 - mm), w1 = exp2f(l1 - mm), w2 = exp2f(l2 - mm); const float iw = 1.0f / (w0 + w1 + w2); w0 *= iw; w1 *= iw; w2 *= iw;
                const v4u a0 = *(const v4u*)(OP + ((size_t)0 * MROWS + row) * 512 + c8 * 8), a1 = *(const v4u*)(OP + ((size_t)1 * MROWS + row) * 512 + c8 * 8), a2 = *(const v4u*)(OP + ((size_t)2 * MROWS + row) * 512 + c8 * 8);
                v4u o;
                o.x = pk2(w0 * bflo(a0.x) + w1 * bflo(a1.x) + w2 * bflo(a2.x), w0 * bfhi(a0.x) + w1 * bfhi(a1.x) + w2 * bfhi(a2.x));
                o.y = pk2(w0 * bflo(a0.y) + w1 * bflo(a1.y) + w2 * bflo(a2.y), w0 * bfhi(a0.y) + w1 * bfhi(a1.y) + w2 * bfhi(a2.y));
                o.z = pk2(w0 * bflo(a0.z) + w1 * bflo(a1.z) + w2 * bflo(a2.z), w0 * bfhi(a0.z) + w1 * bfhi(a1.z) + w2 * bfhi(a2.z));
                o.w = pk2(w0 * bflo(a0.w) + w1 * bflo(a1.w) + w2 * bflo(a2.w), w0 * bfhi(a0.w) + w1 * bfhi(a1.w) + w2 * bfhi(a2.w));
                *(v4u*)(MIXED + (size_t)row * MIXW + c8 * 8) = o; }
        }
        SEAM(pb + 3);
        if (IN(pb + 4)) {
            pg8::Gemm g{MIXED, WOUTl, MROWS, DM, MIXW}; pg8::StaticOrder S; S.init(MROWS, DM, G, bid);
            pg8::EpiF32 E{MIXF, DM};
            pg8::gemm_phase<pg8::EpiF32, pg8::StaticOrder, true, false>(ldsp + RING_OFF, g, S, E);
        }
        SEAM(pb + 4);
        if (IN(pb + 5)) {
            const float* gam = in_ln1g + (size_t)layer * DM; const float* bet = in_ln1b + (size_t)layer * DM;
            for (int m = gw; m < MROWS; m += NGW) { f32x4 v[4];
#pragma unroll
                for (int j = 0; j < 4; ++j) { const f32x4 a = *(const f32x4*)(xres + (size_t)m * DM + 4 * lane + 256 * j), b = *(const f32x4*)(MIXF + (size_t)m * DM + 4 * lane + 256 * j); v[j] = a * ALPHA + b; }
                ln_row(v, gam, bet, XF + (size_t)m * DM, XB + (size_t)m * DM, lane); }
        }
        SEAM(pb + 5);
        if (IN(pb + 6)) {
            LAS int* lcnt = (LAS int*)(ldsp + L_LCNT); LAS int* lbase = (LAS int*)(ldsp + L_LBASE);
            const bf16* RT = ROUT + (size_t)layer * NEXP * DM; const float* rb = in_rb + (size_t)layer * NEXP;
            for (int blk = bid; blk < MROWS / 128; blk += G) {
                if (tid < 32) lcnt[tid] = 0;
                __syncthreads();
                const int r32 = lane & 31, hi = lane >> 5; const int row = blk * 128 + (wave & 3) * 32 + r32;
                float tv[4]; int te[4]; int lrank[4]; float gate[4];
                if (wave < 4) {
                    f32x16 acc = {};
                    const bf16* ap = RT + (size_t)r32 * DM + 8 * hi; const bf16* bp = XB + (size_t)row * DM + 8 * hi;
#pragma unroll 8
                    for (int s = 0; s < 64; ++s) { const bf16x8 a = *(const bf16x8*)(ap + 16 * s), b = *(const bf16x8*)(bp + 16 * s); acc = __builtin_amdgcn_mfma_f32_32x32x16_bf16(a, b, acc, 0, 0, 0); }
#pragma unroll
                    for (int k = 0; k < 4; ++k) { tv[k] = -INFINITY; te[k] = 1 << 20; }
#pragma unroll
                    for (int i = 0; i < 16; ++i) { const int e = (i & 3) + 8 * (i >> 2) + 4 * hi; float v = acc[i] + rb[e]; int ve = e;
#pragma unroll
                        for (int k = 0; k < 4; ++k) { const bool gt = (v > tv[k]) || (v == tv[k] && ve < te[k]); const float nv = gt ? tv[k] : v; const int ne = gt ? te[k] : ve; tv[k] = gt ? v : tv[k]; te[k] = gt ? ve : te[k]; v = nv; ve = ne; } }
                    float pv[4]; int pe[4];
#pragma unroll
                    for (int k = 0; k < 4; ++k) { pv[k] = __shfl_xor(tv[k], 32); pe[k] = __shfl_xor(te[k], 32); }
#pragma unroll
                    for (int j = 0; j < 4; ++j) { float v = pv[j]; int ve = pe[j];
#pragma unroll
                        for (int k = 0; k < 4; ++k) { const bool gt = (v > tv[k]) || (v == tv[k] && ve < te[k]); const float nv = gt ? tv[k] : v; const int ne = gt ? te[k] : ve; tv[k] = gt ? v : tv[k]; te[k] = gt ? ve : te[k]; v = nv; ve = ne; } }
                    float se = 0.f;
#pragma unroll
                    for (int k = 0; k < 4; ++k) { gate[k] = __expf(tv[k] - tv[0]); se += gate[k]; }
                    const float ise = 1.0f / se;
#pragma unroll
                    for (int k = 0; k < 4; ++k) gate[k] *= ise;
                    if (hi == 0) {
#pragma unroll
                        for (int k = 0; k < 4; ++k) lrank[k] = __hip_atomic_fetch_add(lcnt + te[k], 1, __ATOMIC_RELAXED, __HIP_MEMORY_SCOPE_WORKGROUP);
                    }
                }
                __syncthreads();
                if (tid < 32) lbase[tid] = (int)__hip_atomic_fetch_add(gcnt + tid, (unsigned)lcnt[tid], RLX_AGENT);
                __syncthreads();
                if (wave < 4 && hi == 0) {
#pragma unroll
                    for (int k = 0; k < 4; ++k) { const int r = lbase[te[k]] + lrank[k]; const size_t o = (size_t)te[k] * 32768 + r;
                        ROWTOK[o] = row * 4 + k; ROWGATE[o] = gate[k]; TOPE[(size_t)row * 4 + k] = te[k]; TOPG[(size_t)row * 4 + k] = gate[k]; }
                }
                __syncthreads();
            }
        }
        SEAM(pb + 6);
        if (IN(pb + 7) || IN(pb + 8)) {
            LAS int* tstart = (LAS int*)(ldsp + L_TSTART); LAS int* cntL = (LAS int*)(ldsp + L_CNT); LAS int* units = (LAS int*)(ldsp + L_UNITS); LAS int* unitsn = (LAS int*)(ldsp + L_UNITSN);
            if (tid == 0) { int acc = 0; for (int e = 0; e < 32; ++e) { const int c = (int)__hip_atomic_load(gcnt + e, RLX_AGENT); cntL[e] = c; tstart[e] = acc; acc += (c + 255) >> 8; } tstart[32] = acc; }
            __syncthreads();
            if (IN(pb + 7)) {
                pg8::moe_build_units(units, unitsn, tstart, 8, G, bid, tid);
                __syncthreads();
                pg8::Gemm g{XB, WGUl, 0, 2048, DM};
                pg8::MoeOrder S{units, __builtin_amdgcn_readfirstlane(unitsn[0]), cntL, ROWTOK, 1, (size_t)2048 * DM * 2};
                pg8::EpiSwiglu E{HB, in_bgu + (size_t)layer * NEXP * 2048, ROWGATE, cntL};
                pg8::gemm_phase<pg8::EpiSwiglu, pg8::MoeOrder, true, true>(ldsp + RING_OFF, g, S, E);
                __syncthreads();
            }
            SEAM(pb + 7);
            if (IN(pb + 8)) {
                pg8::moe_build_units(units, unitsn, tstart, 4, G, bid, tid);
                __syncthreads();
                pg8::Gemm g{HB, WDNl, 0, DM, FF};
                pg8::MoeOrder S{units, __builtin_amdgcn_readfirstlane(unitsn[0]), cntL, ROWTOK, 0, (size_t)DM * FF * 2};
                pg8::EpiScatter E{YB, ROWTOK, cntL};
                pg8::gemm_phase<pg8::EpiScatter, pg8::MoeOrder, true, false>(ldsp + RING_OFF, g, S, E);
                __syncthreads();
            }
        }
        SEAM(pb + 8);
        if (IN(pb + 9)) {
            const float* gam = in_ln2g + (size_t)layer * DM; const float* bet = in_ln2b + (size_t)layer * DM; const float* bdn = in_bdn + (size_t)layer * NEXP * DM;
            float* dstf = (layer == NLAYER - 1) ? args.out : XF2;
            for (int m = gw; m < MROWS; m += NGW) { f32x4 v[4];
#pragma unroll
                for (int j = 0; j < 4; ++j) v[j] = *(const f32x4*)(XF + (size_t)m * DM + 4 * lane + 256 * j) * ALPHA;
#pragma unroll
                for (int k = 0; k < 4; ++k) { const int e = TOPE[(size_t)m * 4 + k]; const float gk = TOPG[(size_t)m * 4 + k]; const bf16* yr = YB + ((size_t)m * 4 + k) * DM; const float* br = bdn + (size_t)e * DM;
#pragma unroll
                    for (int j = 0; j < 4; ++j) { const v2u w = *(const v2u*)(yr + 4 * lane + 256 * j); const f32x4 b = *(const f32x4*)(br + 4 * lane + 256 * j);
                        v[j][0] += bflo(w.x) + gk * b[0]; v[j][1] += bfhi(w.x) + gk * b[1]; v[j][2] += bflo(w.y) + gk * b[2]; v[j][3] += bfhi(w.y) + gk * b[3]; } }
                ln_row(v, gam, bet, dstf + (size_t)m * DM, XB + (size_t)m * DM, lane);
                if (layer + 1 < NLAYER) row_dt(v, WDT + (size_t)(layer + 1) * 8 * 1024, DT + (size_t)m * 8, lane); }
        }
        SEAM(pb + 9);
    #undef IN
#undef SEAM
}

__global__ void __launch_bounds__(NWAVES * 64, 2) mk_fwd(Args args) {
    extern __shared__ __attribute__((aligned(16))) unsigned char lds[];
    LAS unsigned char* ldsp = (LAS unsigned char*)lds;
    const int tid = threadIdx.x, lane = tid & 63, wave = __builtin_amdgcn_readfirstlane(tid >> 6);
    const int G = gridDim.x, bid = blockIdx.x;
    const int gw = bid * NWAVES + wave, NGW = G * NWAVES;
    gu32* ctl = (gu32*)(args.ws + WS_CTL);

    for (int u = tid; u < (LDS_BYTES - LDSCTL_OFF) / 4; u += NWAVES * 64) ((LAS unsigned*)(ldsp + LDSCTL_OFF))[u] = 0u;
    __syncthreads();
    XcdBarrier bar = xcd_barrier_post((unsigned*)(ctl + CW_BAR), (volatile LAS unsigned*)(ldsp + L_MISC) + 8);

    const int lo = args.ph_lo, hi = args.ph_hi;
#define IN(k) (lo <= (k) && (k) < hi)
#define SEAM(k) do { if (IN(k) && IN((k) + 1)) xcd_barrier(bar); } while (0)

    if (IN(0)) {
        for (int it = bid * (NWAVES * 64) + tid; it < (int)(4096 * 32); it += G * (NWAVES * 64)) { const int t = (int)(it >> 5), i = (int)(it & 31);
            const float inv = powf(10000.0f, -(float)i / 32.0f); const float ang = (float)t * inv; float sn, cs; sincosf(ang, &sn, &cs);
            ROPE[2 * it] = cs; ROPE[2 * it + 1] = sn; }
        LAS float* scr = (LAS float*)(ldsp + RING_OFF + wave * 16384);
        constexpr int I_IN = 16 * 145, I_OUT = 24 * 32, I_GU = 16 * 64, I_DN = 16 * 32, I_R = 16;
        constexpr int NIT = NLAYER * (I_IN + I_OUT + I_R) + NLAYER * NEXP * (I_GU + I_DN);
        for (int it = gw; it < NIT; it += NGW) {
            int r = it;
            if (r < NLAYER * I_IN) { const int l = r / I_IN; r %= I_IN; p0_transpose_item<1>(in_win + (size_t)l * DM * INW, DM, INW, WIN + (size_t)l * NPROJ * DM, WDT + (size_t)l * 8 * 1024, scr, r / 145, r % 145, lane); continue; } r -= NLAYER * I_IN;
            if (r < NLAYER * I_OUT) { const int l = r / I_OUT; r %= I_OUT; p0_transpose_item<0>(in_wout + (size_t)l * MIXW * DM, MIXW, DM, WOUT + (size_t)l * DM * MIXW, nullptr, scr, r / 32, r % 32, lane); continue; } r -= NLAYER * I_OUT;
            if (r < NLAYER * I_R) { const int l = r / I_R; r %= I_R; p0_transpose_item<0>(in_rw + (size_t)l * DM * NEXP, DM, NEXP, ROUT + (size_t)l * NEXP * DM, nullptr, scr, r, 0, lane); continue; } r -= NLAYER * I_R;
            if (r < NLAYER * NEXP * I_GU) { const int le = r / I_GU; r %= I_GU; p0_transpose_item<2>(in_wgu + (size_t)le * DM * 2048, DM, 2048, WGU + (size_t)le * 2048 * DM, nullptr, scr, r / 64, r % 64, lane); continue; } r -= NLAYER * NEXP * I_GU;
            { const int le = r / I_DN; r %= I_DN; p0_transpose_item<0>(in_wdn + (size_t)le * FF * DM, FF, DM, WDN + (size_t)le * DM * FF, nullptr, scr, r / 32, r % 32, lane); }
        }
        __syncthreads();
    }
    if (IN(0)) {
        for (int m = gw; m < MROWS; m += NGW) { const float* xr = in_x + (size_t)m * DM; bf16* ob = XB + (size_t)m * DM;
#pragma unroll
            for (int j = 0; j < 4; ++j) { const f32x4 v = *(const f32x4*)(xr + 4 * lane + 256 * j); v2u w; w.x = pk2(v[0], v[1]); w.y = pk2(v[2], v[3]); *(v2u*)(ob + 4 * lane + 256 * j) = w; } }
    }

    SEAM(0);
    run_layer<0>(args, lo, hi, bar);
    run_layer<1>(args, lo, hi, bar);
#undef IN
#undef SEAM
}

extern "C" void kernel_launch(void* const* d_in, const int* in_sizes, int n_in, void* d_out, int out_size, void* d_ws, size_t ws_size, hipStream_t stream) {
    static int grid = 0;
    if (grid == 0) {
        if (n_in != 20 || out_size != MROWS * DM || ws_size < WS_END) { fprintf(stderr, "kernel_launch: unexpected problem (n_in %d, out %d, ws %zu)\n", n_in, out_size, ws_size); grid = -1; return; }
        if (hipFuncSetAttribute((const void*)mk_fwd, hipFuncAttributeMaxDynamicSharedMemorySize, LDS_BYTES) != hipSuccess) { fprintf(stderr, "kernel_launch: hipFuncSetAttribute failed\n"); grid = -1; return; }
        int dev = 0, cus = 0, per_cu = 0;
        (void)hipGetDevice(&dev); (void)hipDeviceGetAttribute(&cus, hipDeviceAttributeMultiprocessorCount, dev);
        if (hipOccupancyMaxActiveBlocksPerMultiprocessor(&per_cu, (const void*)mk_fwd, NWAVES * 64, LDS_BYTES) != hipSuccess || per_cu < 1) fprintf(stderr, "kernel_launch: occupancy query says %d\n", per_cu);
        (void)hipGetLastError();
        grid = cus > 0 ? cus : 256;
    }
    if (grid < 0) return;
    (void)hipMemsetAsync((char*)d_ws + WS_CTL, 0, CTL_ZERO_BYTES, stream);
    Args a{};
    for (int i = 0; i < 20; ++i) a.in[i] = (const float*)d_in[i];
    a.out = (float*)d_out; a.ws = (unsigned char*)d_ws;
    a.ph_lo = 0; a.ph_hi = N_PHASES;
    hipLaunchKernelGGL(mk_fwd, dim3(grid), dim3(NWAVES * 64), LDS_BYTES, stream, a);
}
```

```cpp
#include <hip/hip_runtime.h>
#include <cstdio>
#include <cstdint>
#include <cmath>

namespace pg8 {
#define PG8_LAS __attribute__((address_space(3)))
typedef unsigned short bf16_t;
typedef short bf16x8 __attribute__((ext_vector_type(8)));
typedef float f32x4 __attribute__((ext_vector_type(4)));
typedef float f32x2 __attribute__((ext_vector_type(2)));
typedef unsigned u32x4 __attribute__((ext_vector_type(4)));
constexpr int BM = 256, BK = 64, HALF = 128, HTB = HALF * BK * 2  , STAGE_BYTES = 8 * HTB, NXCD = 8, WGM = 8;

__host__ __device__ __forceinline__ int lds_byte(int r, int c) { const int st = (r >> 4) * 2 + (c >> 5), rr = r & 15, cc = c & 31, ob = rr * 64 + cc * 2; return st * 1024 + (ob ^ (((ob >> 9) & 1) << 5)); }
__host__ __device__ __forceinline__ void stage_rc(int b, int& R, int& C) { const int st = b / 1024, sb = b % 1024, swz = sb ^ (((sb >> 9) & 1) << 5); R = (st >> 1) * 16 + swz / 64; C = (st & 1) * 32 + (swz % 64) / 2; }
__host__ __device__ __forceinline__ int perm32(int rho) { const int n = rho >> 4, i = rho & 15; return 8 * (i >> 2) + 4 * n + (i & 3); }

struct Unit { int pm, pn, e, r0; };
struct Gemm { const bf16_t* A; const bf16_t* Bt; int M, N, K; };

struct StaticOrder {
    int nM, nN, nwg, G, c;
    __device__ void init(int M, int N, int G_, int c_) { nM = M / BM; nN = N / BM; nwg = nM * nN; G = G_; c = c_; }
    __device__ __forceinline__ bool next(int i, Unit& u) const {
        const long L = (long)i * G + c; if (L >= nwg) return false;
        int wgid = (int)L; { const int q = nwg / NXCD, r = nwg % NXCD, xcd = wgid % NXCD, off = wgid / NXCD; wgid = (xcd < r ? xcd * (q + 1) : r * (q + 1) + (xcd - r) * q) + off; }
        const int nig = WGM * nN, gid = wgid / nig, fm = gid * WGM, gsz = (nM - fm) < WGM ? (nM - fm) : WGM;
        u.pm = fm + ((wgid % nig) % gsz); u.pn = (wgid % nig) / gsz; u.e = 0; u.r0 = 0; return true;
    }
    __device__ __forceinline__ const char* abase(const Unit& u, const Gemm& g, size_t tstep) const { return (const char*)g.A + (size_t)u.pm * tstep; }
    __device__ __forceinline__ const char* bbase(const Unit& u, const Gemm& g, size_t tstep) const { return (const char*)g.Bt + (size_t)u.pn * tstep; }
    __device__ __forceinline__ unsigned arow(const Unit&, int) const { return 0u; }
    __device__ __forceinline__ void a_ready(const Unit&) const {}
    __device__ __forceinline__ void done(const Unit&) const {}
};

struct MoeOrder {
    const PG8_LAS int* units;
    int nunits;
    const PG8_LAS int* cnt;
    const int* rowtok;
    int gather;
    unsigned rowbytes;
    size_t bstride;
    __device__ __forceinline__ bool next(int i, Unit& u) const {
        if (i >= nunits) return false;
        u.pm = __builtin_amdgcn_readfirstlane(units[4 * i + 0]); u.pn = __builtin_amdgcn_readfirstlane(units[4 * i + 1]);
        u.e = __builtin_amdgcn_readfirstlane(units[4 * i + 2]); u.r0 = __builtin_amdgcn_readfirstlane(units[4 * i + 3]); return true;
    }
    __device__ __forceinline__ const char* abase(const Unit& u, const Gemm& g, size_t tstep) const { return gather ? (const char*)g.A : (const char*)g.A + (size_t)u.pm * tstep; }
    __device__ __forceinline__ const char* bbase(const Unit& u, const Gemm& g, size_t tstep) const { return (const char*)g.Bt + (size_t)u.e * bstride + (size_t)u.pn * tstep; }
    __device__ __forceinline__ unsigned arow(const Unit& u, int R) const {
        const int r = u.r0 + R; const int idx = (r < cnt[u.e]) ? rowtok[(size_t)u.e * 32768 + r] : 0; return (unsigned)(idx >> 2) * rowbytes; }
    __device__ __forceinline__ void a_ready(const Unit&) const {}
    __device__ __forceinline__ void done(const Unit&) const {}
};
__device__ __forceinline__ void moe_build_units(PG8_LAS int* units, PG8_LAS int* units_n, const PG8_LAS int* tstart, int nN, int G, int c, int tid) {
    if (tid < 64) {
        const int nT = tstart[32], nwg = nT * nN; const long L = (long)tid * G + c;
        int pm = 0, pn = 0, e = 0, r0 = 0;
        if (L < nwg) {
            int wgid = (int)L; { const int q = nwg / NXCD, r = nwg % NXCD, xcd = wgid % NXCD, off = wgid / NXCD; wgid = (xcd < r ? xcd * (q + 1) : r * (q + 1) + (xcd - r) * q) + off; }
            const int nig = WGM * nN, gid = wgid / nig, fm = gid * WGM, gsz = (nT - fm) < WGM ? (nT - fm) : WGM;
            pm = fm + ((wgid % nig) % gsz); pn = (wgid % nig) / gsz;
            for (int j = 1; j < 32; ++j) e += (tstart[j] <= pm) ? 1 : 0;
            r0 = (pm - tstart[e]) * 256;
        }
        units[4 * tid + 0] = pm; units[4 * tid + 1] = pn; units[4 * tid + 2] = e; units[4 * tid + 3] = r0;
        if (tid == 0) { int n = 0; if (c < nwg) n = (nwg - c + G - 1) / G; units_n[0] = n < 64 ? n : 64; }
    }
}

typedef int v8i_t __attribute__((ext_vector_type(8)));
typedef int v4i_t __attribute__((ext_vector_type(4)));
__device__ __forceinline__ v8i_t cat8(bf16x8 lo, bf16x8 hi) { const v4i_t a = __builtin_bit_cast(v4i_t, lo), b = __builtin_bit_cast(v4i_t, hi); return __builtin_shufflevector(a, b, 0, 1, 2, 3, 4, 5, 6, 7); }
__device__ __forceinline__ void mfma8(f32x4& acc, v8i_t a, v8i_t b, int scl) { asm volatile("v_mfma_scale_f32_16x16x128_f8f6f4 %0, %1, %2, %0, %3, %3 op_sel_hi:[0,0,0]" : "+v"(acc) : "v"(a), "v"(b), "v"(scl)); }
__device__ __forceinline__ unsigned pk4_fp8(float a, float b, float c, float d) { unsigned w = 0u; w = __builtin_amdgcn_cvt_pk_fp8_f32(a, b, w, false); w = __builtin_amdgcn_cvt_pk_fp8_f32(c, d, w, true); return w; }
__device__ __forceinline__ unsigned cvt_pk_bf16(float lo, float hi) { unsigned r; asm volatile("v_cvt_pk_bf16_f32 %0, %1, %2" : "=v"(r) : "v"(lo), "v"(hi)); return r; }

struct EpiProj {
    static constexpr bool PERM = true, AFTER_DRAIN = false;
    bf16_t* O; int ldc; const float* rope; float qscale;
    __device__ __forceinline__ void operator()(const f32x4 (&acc)[2][2][4][2], const Unit& u, int wr, int wc, int fr, int fq) const {
        const int row0 = u.pm * BM + wr * 64 + fr; const int col0 = u.pn * BM + wc * 32 + 8 * fq;
        const bool rot = u.pn < 4; const float sc = u.pn < 2 ? qscale : 1.f; const int gq = 4 * (wc & 1) + fq;
#pragma unroll
        for (int ai = 0; ai < 2; ++ai)
#pragma unroll
            for (int m = 0; m < 4; ++m) { const int row = row0 + ai * HALF + m * 16; bf16_t* rowp = O + (size_t)row * ldc + col0;
                f32x4 cs0 = (f32x4){1.f, 0.f, 1.f, 0.f}, cs1 = cs0;
                if (rot) { const float* rp = rope + ((size_t)(row & 4095) * 32 + 4 * gq) * 2; cs0 = *(const f32x4*)rp; cs1 = *(const f32x4*)(rp + 4); }
#pragma unroll
                for (int bj = 0; bj < 2; ++bj) { f32x4 v0 = acc[ai][bj][m][0], v1 = acc[ai][bj][m][1];
                    if (rot) { f32x4 lo, hi;
                        lo[0] = v0[0] * cs0[0] - v1[0] * cs0[1]; hi[0] = v1[0] * cs0[0] + v0[0] * cs0[1];
                        lo[1] = v0[1] * cs0[2] - v1[1] * cs0[3]; hi[1] = v1[1] * cs0[2] + v0[1] * cs0[3];
                        lo[2] = v0[2] * cs1[0] - v1[2] * cs1[1]; hi[2] = v1[2] * cs1[0] + v0[2] * cs1[1];
                        lo[3] = v0[3] * cs1[2] - v1[3] * cs1[3]; hi[3] = v1[3] * cs1[2] + v0[3] * cs1[3];
                        v0 = lo * sc; v1 = hi * sc; }
                    u32x4 w; w.x = cvt_pk_bf16(v0[0], v0[1]); w.y = cvt_pk_bf16(v0[2], v0[3]); w.z = cvt_pk_bf16(v1[0], v1[1]); w.w = cvt_pk_bf16(v1[2], v1[3]);
                    *(u32x4*)(rowp + bj * HALF) = w; } }
    }
};
struct EpiF32 {
    static constexpr bool PERM = false, AFTER_DRAIN = false;
    float* O; int ldc;
    __device__ __forceinline__ void operator()(const f32x4 (&acc)[2][2][4][2], const Unit& u, int wr, int wc, int fr, int fq) const {
        const int row0 = u.pm * BM + wr * 64 + fr; const int col0 = u.pn * BM + wc * 32 + 4 * fq;
#pragma unroll
        for (int ai = 0; ai < 2; ++ai)
#pragma unroll
            for (int m = 0; m < 4; ++m) { float* rowp = O + (size_t)(row0 + ai * HALF + m * 16) * ldc + col0;
#pragma unroll
                for (int bj = 0; bj < 2; ++bj)
#pragma unroll
                    for (int n = 0; n < 2; ++n) *(f32x4*)(rowp + bj * HALF + n * 16) = acc[ai][bj][m][n]; }
    }
};
struct EpiSwiglu {
    static constexpr bool PERM = true, AFTER_DRAIN = false;
    unsigned char* H; const float* bgu; const float* rowgate; const PG8_LAS int* cnt; float dq, hscale;
    __device__ __forceinline__ void operator()(const f32x4 (&acc)[2][2][4][2], const Unit& u, int wr, int wc, int fr, int fq) const {
        const int ff = u.pn * HALF + wc * 32 + 8 * fq; const int n_e = cnt[u.e];
        f32x4 bg[2], bu[2];
#pragma unroll
        for (int n = 0; n < 2; ++n) { bg[n] = *(const f32x4*)(bgu + (size_t)u.e * 2048 + ff + 4 * n); bu[n] = *(const f32x4*)(bgu + (size_t)u.e * 2048 + 1024 + ff + 4 * n); }
#pragma unroll
        for (int ai = 0; ai < 2; ++ai)
#pragma unroll
            for (int m = 0; m < 4; ++m) { const int r = ai * HALF + wr * 64 + m * 16 + fr; const int er = u.r0 + r;
                const float rg = ((er < n_e) ? rowgate[(size_t)u.e * 32768 + er] : 0.f) * hscale;
                float hv[8];
#pragma unroll
                for (int n = 0; n < 2; ++n)
#pragma unroll
                    for (int q = 0; q < 4; ++q) { float g = acc[ai][0][m][n][q] * dq + bg[n][q], up = acc[ai][1][m][n][q] * dq + bu[n][q];
                        g = fminf(g, 7.0f); up = fminf(fmaxf(up, -7.0f), 7.0f);
                        const float sg = __builtin_amdgcn_rcpf(1.0f + __builtin_amdgcn_exp2f(-1.702f * 1.4426950408889634f * g));
                        hv[n * 4 + q] = (up + 1.0f) * g * sg * rg; }
                u32x4 dummy; (void)dummy;
                unsigned w0 = pk4_fp8(hv[0], hv[1], hv[2], hv[3]), w1 = pk4_fp8(hv[4], hv[5], hv[6], hv[7]);
                typedef unsigned u32x2 __attribute__((ext_vector_type(2)));
                *(u32x2*)(H + (size_t)(u.pm * BM + r) * 1024 + ff) = (u32x2){w0, w1};
                asm volatile("" ::: "memory"); }
    }
};
struct EpiScatter {
    static constexpr bool PERM = true, AFTER_DRAIN = false;
    bf16_t* Y; const int* rowtok; const PG8_LAS int* cnt; float dq;
    __device__ __forceinline__ void operator()(const f32x4 (&acc)[2][2][4][2], const Unit& u, int wr, int wc, int fr, int fq) const {
        const int col0 = u.pn * BM + wc * 32 + 8 * fq; const int n_e = cnt[u.e];
#pragma unroll
        for (int ai = 0; ai < 2; ++ai)
#pragma unroll
            for (int m = 0; m < 4; ++m) { const int er = u.r0 + ai * HALF + wr * 64 + m * 16 + fr;
                if (er < n_e) { const int idx = rowtok[(size_t)u.e * 32768 + er]; bf16_t* rowp = Y + (size_t)idx * 1024 + col0;
#pragma unroll
                    for (int bj = 0; bj < 2; ++bj) { const f32x4 v0 = acc[ai][bj][m][0] * dq, v1 = acc[ai][bj][m][1] * dq;
                        u32x4 w; w.x = cvt_pk_bf16(v0[0], v0[1]); w.y = cvt_pk_bf16(v0[2], v0[3]); w.z = cvt_pk_bf16(v1[0], v1[1]); w.w = cvt_pk_bf16(v1[2], v1[3]);
                        *(u32x4*)(rowp + bj * HALF) = w; } }
                asm volatile("" ::: "memory"); }
    }
};

template <class Epi, class Sched, bool ALIGN_EPI, bool GATHER, bool FP8 = false>
__device__ __forceinline__ void gemm_phase(PG8_LAS unsigned char* lds, const Gemm g, const Sched& S, const Epi& E) {
    const int tid = threadIdx.x, wid = __builtin_amdgcn_readfirstlane(tid >> 6), lane = tid & 63, wr = wid >> 2, wc = wid & 3, fr = lane & 15, fq = lane >> 4;
    const int K = g.K, nt = K / BK;
    unsigned voffB[2];
#pragma unroll
    for (int i = 0; i < 2; ++i) { int R, C; stage_rc(tid * 16 + i * 8192, R, C); const int Rb = Epi::PERM ? ((R & ~31) + perm32(R & 31)) : R;
        voffB[i] = (unsigned)(Rb * K + C) * 2u; }
    PG8_LAS u32x4* const nslot = (PG8_LAS u32x4*)(lds + STAGE_BYTES) + tid;
    const size_t kstep = (size_t)(BK * 2);
    const size_t hstep = (size_t)HALF * K * 2;
    const size_t tstep = 2 * hstep;
    const unsigned ldsw = (unsigned)wid * 1024u;
    const int aoff = lds_byte(wr * 64 + fr, fq * 8), boff = lds_byte(wc * 32 + fr, fq * 8);
#define PG8_SA(b, h) (((b) * 2 + (h)) * HTB)
#define PG8_SB(b, h) ((4 + (b) * 2 + (h)) * HTB)
#define PG8_STAGE(bufoff, gbase, voff) do { _Pragma("unroll") for (int _i = 0; _i < 2; ++_i) \
        __builtin_amdgcn_global_load_lds((const unsigned*)((const char*)(gbase) + (voff)[_i]), (PG8_LAS unsigned*)(lds + (bufoff) + ldsw + _i * 8192), 16, 0, 0); } while (0)
#define PG8_LDA(dst, b, h) do { _Pragma("unroll") for (int m = 0; m < 4; ++m) _Pragma("unroll") for (int k = 0; k < 2; ++k) dst[m][k] = *(const PG8_LAS bf16x8*)(lds + PG8_SA(b, h) + aoff + m * 2048 + k * 1024); } while (0)
#define PG8_LDB(dst, b, h) do { _Pragma("unroll") for (int n = 0; n < 2; ++n) _Pragma("unroll") for (int k = 0; k < 2; ++k) dst[n][k] = *(const PG8_LAS bf16x8*)(lds + PG8_SB(b, h) + boff + n * 2048 + k * 1024); } while (0)
#define PG8_MMA(ai, bj, At, Bt) do { __builtin_amdgcn_s_setprio(1); _Pragma("unroll") for (int m = 0; m < 4; ++m) _Pragma("unroll") for (int n = 0; n < 2; ++n) { \
        if constexpr (FP8) mfma8(acc[ai][bj][m][n], cat8(Bt[n][0], Bt[n][1]), cat8(At[m][0], At[m][1]), scl8); \
        else { _Pragma("unroll") for (int k = 0; k < 2; ++k) acc[ai][bj][m][n] = __builtin_amdgcn_mfma_f32_16x16x32_bf16(Bt[n][k], At[m][k], acc[ai][bj][m][n], 0, 0, 0); } } __builtin_amdgcn_s_setprio(0); } while (0)
#define PG8_WAIT_V(n) asm volatile("s_waitcnt vmcnt(" #n ")" ::: "memory")
#define PG8_WAIT_L(n) asm volatile("s_waitcnt lgkmcnt(" #n ")" ::: "memory")
#define PG8_BAR __builtin_amdgcn_s_barrier()
#define PG8_SCHED __builtin_amdgcn_sched_barrier(0)
#define PG8_SETOFFS(o, u) do { _Pragma("unroll") for (int _h = 0; _h < 2; ++_h) _Pragma("unroll") for (int _i = 0; _i < 2; ++_i) { int _R, _C; stage_rc(tid * 16 + _i * 8192, _R, _C); \
        o[_h][_i] = GATHER ? (S.arow(u, _R + HALF * _h) + (unsigned)(_C * 2)) : ((unsigned)((_R + HALF * _h) * K) * 2u + (unsigned)(_C * 2)); } } while (0)
    int scl8 = 0x7F7F7F7F; asm volatile("" : "+v"(scl8));
    Unit cur, nxt; int ui = 0;
    if (!S.next(0, cur)) return;
    f32x4 acc[2][2][4][2];
#pragma unroll
    for (int a = 0; a < 2; ++a)
#pragma unroll
        for (int b = 0; b < 2; ++b)
#pragma unroll
            for (int m = 0; m < 4; ++m)
#pragma unroll
                for (int n = 0; n < 2; ++n) { acc[a][b][m][n] = (f32x4){0.f, 0.f, 0.f, 0.f}; if constexpr (FP8) asm volatile("" : "+v"(acc[a][b][m][n])); }
    bf16x8 At[4][2], B0[2][2], B1[2][2];
    unsigned cAo[2][2];
    PG8_SETOFFS(cAo, cur);
    const char* cA = S.abase(cur, g, tstep); const char* cB = S.bbase(cur, g, tstep);
    S.a_ready(cur);
    PG8_STAGE(PG8_SB(0, 0), cB, voffB); PG8_STAGE(PG8_SB(0, 1), cB + hstep, voffB); PG8_STAGE(PG8_SA(0, 0), cA, cAo[0]); PG8_STAGE(PG8_SA(0, 1), cA, cAo[1]);
    if (wr == 1) PG8_BAR;
    PG8_WAIT_V(2); PG8_BAR;
    PG8_STAGE(PG8_SB(1, 0), cB + kstep, voffB); PG8_STAGE(PG8_SA(1, 0), cA + kstep, cAo[0]); PG8_STAGE(PG8_SB(1, 1), cB + hstep + kstep, voffB);
    PG8_WAIT_V(6); PG8_BAR;
    for (;;) {
        const bool has_next = S.next(ui + 1, nxt);
        const char* nA = has_next ? S.abase(nxt, g, tstep) : cA; const char* nB = has_next ? S.bbase(nxt, g, tstep) : cB;
        if constexpr (GATHER) { if (has_next) { unsigned no[2][2]; PG8_SETOFFS(no, nxt); *nslot = (u32x4){no[0][0], no[0][1], no[1][0], no[1][1]}; } }
#pragma unroll 1
        for (int t = 0; t < nt; t += 2) {
            const bool last = (t == nt - 2);
            const char* a1 = cA + (size_t)(t + 1) * kstep;
            const char* a2 = last ? nA : cA + (size_t)(t + 2) * kstep; const char* b2 = last ? nB : cB + (size_t)(t + 2) * kstep;
            const char* a3 = a2 + kstep; const char* b3 = b2 + kstep;
            if (last && has_next) S.a_ready(nxt);
            PG8_LDB(B0, 0, 0); PG8_LDB(B1, 0, 1); PG8_SCHED; PG8_LDA(At, 0, 0); PG8_STAGE(PG8_SA(1, 1), a1, cAo[1]);
            if constexpr (GATHER) { if (last && has_next) { const u32x4 no = *nslot; cAo[0][0] = no.x; cAo[0][1] = no.y; cAo[1][0] = no.z; cAo[1][1] = no.w; } }
            PG8_WAIT_V(8); PG8_WAIT_L(0); PG8_BAR; PG8_MMA(0, 0, At, B0); PG8_MMA(0, 1, At, B1); PG8_BAR; PG8_SCHED;
            PG8_LDA(At, 0, 1); PG8_STAGE(PG8_SB(0, 0), b2, voffB); PG8_STAGE(PG8_SB(0, 1), b2 + hstep, voffB); PG8_STAGE(PG8_SA(0, 0), a2, cAo[0]);
            PG8_WAIT_V(8); PG8_WAIT_L(0); PG8_BAR; PG8_MMA(1, 0, At, B0); PG8_MMA(1, 1, At, B1); PG8_BAR; PG8_SCHED;
            PG8_LDB(B0, 1, 0); PG8_LDB(B1, 1, 1); PG8_SCHED; PG8_LDA(At, 1, 0); PG8_STAGE(PG8_SA(0, 1), a2, cAo[1]);
            PG8_WAIT_V(8); PG8_WAIT_L(0); PG8_BAR; PG8_MMA(0, 0, At, B0); PG8_MMA(0, 1, At, B1); PG8_BAR; PG8_SCHED;
            PG8_LDA(At, 1, 1); PG8_STAGE(PG8_SB(1, 0), b3, voffB); PG8_STAGE(PG8_SB(1, 1), b3 + hstep, voffB); PG8_STAGE(PG8_SA(1, 0), a3, cAo[0]);
            PG8_WAIT_V(8); PG8_WAIT_L(0); PG8_BAR; PG8_MMA(1, 0, At, B0); PG8_MMA(1, 1, At, B1); PG8_BAR; PG8_SCHED;
        }
        if constexpr (ALIGN_EPI) { if (wr == 0) PG8_BAR; }
        if constexpr (FP8) asm volatile("s_nop 15\n\ts_nop 15" ::: "memory");
        PG8_SCHED; E(acc, cur, wr, wc, fr, fq); S.done(cur); PG8_SCHED;
        if (!has_next) break;
#pragma unroll
        for (int a = 0; a < 2; ++a)
#pragma unroll
            for (int b = 0; b < 2; ++b)
#pragma unroll
                for (int m = 0; m < 4; ++m)
#pragma unroll
                    for (int n = 0; n < 2; ++n) { acc[a][b][m][n] = (f32x4){0.f, 0.f, 0.f, 0.f}; if constexpr (FP8) asm volatile("" : "+v"(acc[a][b][m][n])); }
        cur = nxt; cA = nA; cB = nB; ++ui;
        if constexpr (ALIGN_EPI) { if (wr == 1) PG8_BAR; }
    }
    PG8_WAIT_V(0);
    if constexpr (!ALIGN_EPI) { if (wr == 0) PG8_BAR; }
    PG8_BAR;
#undef PG8_SA
#undef PG8_SB
#undef PG8_STAGE
#undef PG8_LDA
#undef PG8_LDB
#undef PG8_MMA
#undef PG8_WAIT_V
#undef PG8_WAIT_L
#undef PG8_BAR
#undef PG8_SCHED
#undef PG8_SETOFFS
}
}

constexpr int NB = 8, SEQ = 4096, DM = 1024, MROWS = NB * SEQ, NLAYER = 2;
constexpr int NPROJ = 4608, INW = 4616;
constexpr int C_Q = 0, C_K = 512, C_V = 1024, C_Z = 1536, C_XS = 2048, C_SB = 3072, C_SC = 3584, C_SH = 4096;
constexpr int MIXW = 1536, NEXP = 32, TOPK = 4, FF = 1024;
constexpr float ALPHA = 1.4142135623730951f;
constexpr float LN_EPS = 1e-5f, RMS_EPS = 1e-5f;
constexpr float QSCALE = 0.125f * 1.4426950408889634f;

constexpr size_t MiB = 1u << 20;
constexpr size_t WS_CTL = 0, CTL_ZERO_BYTES = 1 * MiB;
constexpr size_t WS_ROPE = 1 * MiB;
constexpr size_t WS_WDT = 2 * MiB;
constexpr size_t WS_ROUT = 2 * MiB + 65536;
constexpr size_t WS_WIN = 4 * MiB;
constexpr size_t WS_WOUT = 24 * MiB;
constexpr size_t WS_WGU = 32 * MiB;
constexpr size_t WS_WDN = 288 * MiB;
constexpr size_t WS_XB = 416 * MiB;
constexpr size_t WS_XF = 480 * MiB;
constexpr size_t WS_XF2 = 608 * MiB;
constexpr size_t WS_PROJ = 736 * MiB;
constexpr size_t WS_DT = 1024 * MiB;
constexpr size_t WS_DTS = 1025 * MiB;
constexpr size_t WS_ACUM = 1026 * MiB;
constexpr size_t WS_LSE = 1027 * MiB;
constexpr size_t WS_OP = 1030 * MiB;
constexpr size_t WS_U = 1126 * MiB;
constexpr size_t WS_G = 1190 * MiB;
constexpr size_t WS_ST = 1222 * MiB;
constexpr size_t WS_YD = 1286 * MiB;
constexpr size_t WS_MIXED = 1350 * MiB;
constexpr size_t WS_MIXF = 1446 * MiB;
constexpr size_t WS_TOPE = 1574 * MiB;
constexpr size_t WS_TOPG = 1575 * MiB;
constexpr size_t WS_ROWTOK = 1576 * MiB;
constexpr size_t WS_ROWGATE = 1580 * MiB;
constexpr size_t WS_H = 736 * MiB;
constexpr size_t WS_YB = 1030 * MiB;
constexpr size_t WS_END = 1584 * MiB;
constexpr int CW_TMO = 0;
constexpr int CW_CNT = 64;
constexpr int CW_BAR = 4096;

constexpr int RING_OFF = 0, RING_BYTES = 131072;
constexpr int LDSCTL_OFF = 155648;
constexpr int L_MISC = LDSCTL_OFF;
constexpr int L_TSTART = LDSCTL_OFF + 256;
constexpr int L_CNT = LDSCTL_OFF + 512;
constexpr int L_LCNT = LDSCTL_OFF + 640;
constexpr int L_LBASE = LDSCTL_OFF + 768;
constexpr int L_UNITS = LDSCTL_OFF + 1024;
constexpr int L_UNITSN = LDSCTL_OFF + 2048;
constexpr int LDS_BYTES = 163840;

#define GAS __attribute__((address_space(1)))
#define LAS __attribute__((address_space(3)))
typedef unsigned short bf16;
typedef unsigned v4u __attribute__((ext_vector_type(4)));
typedef unsigned v2u __attribute__((ext_vector_type(2)));
typedef float f32x4 __attribute__((ext_vector_type(4)));
typedef float f32x16 __attribute__((ext_vector_type(16)));
typedef short bf16x8 __attribute__((ext_vector_type(8)));
typedef GAS unsigned gu32;
#define RLX_AGENT __ATOMIC_RELAXED, __HIP_MEMORY_SCOPE_AGENT
#define LDS_WAIT() asm volatile("s_waitcnt lgkmcnt(0)" ::: "memory")
#define VM_WAIT() asm volatile("s_waitcnt vmcnt(0)" ::: "memory")
__device__ __forceinline__ unsigned f2bf(float f) { unsigned u = __builtin_bit_cast(unsigned, f); return (u + 0x7fffu + ((u >> 16) & 1u)) >> 16; }
__device__ __forceinline__ unsigned pk2(float lo, float hi) { return f2bf(lo) | (f2bf(hi) << 16); }
__device__ __forceinline__ float bf2f(unsigned short b) { return __builtin_bit_cast(float, (unsigned)b << 16); }
__device__ __forceinline__ float bflo(unsigned w) { return __builtin_bit_cast(float, w << 16); }
__device__ __forceinline__ float bfhi(unsigned w) { return __builtin_bit_cast(float, w & 0xffff0000u); }
__device__ __forceinline__ float siluf(float x) { return x / (1.0f + __expf(-x)); }
#define XB_TMO      128
#define XB_XCNT(j)  (256  + 64 * (j))
#define XB_XSUB(j)  (1280 + 64 * (j))
#define XB_XGEN(j)  (2304 + 64 * (j))
#define XB_TOP      3328
#define XB_TOPGEN   3392
#define XCD_BAR_WORDS 3456
#define XB_SPIN_CAP (1u << 18)

__device__ __forceinline__ unsigned xb_ld(unsigned* p)              { return __hip_atomic_load(p, __ATOMIC_RELAXED, __HIP_MEMORY_SCOPE_AGENT); }
__device__ __forceinline__ unsigned xb_add(unsigned* p, unsigned v) { return __hip_atomic_fetch_add(p, v, __ATOMIC_RELAXED, __HIP_MEMORY_SCOPE_AGENT); }
__device__ __forceinline__ unsigned xb_xcc_id() { return (unsigned)__builtin_amdgcn_s_getreg((3 << 11) | 20) & 0xFu; }
#define XB_SPIN(cond, bar) do { unsigned _sp = 0; while (cond) { __builtin_amdgcn_s_sleep(1); \
    if ((++_sp & 255u) == 0u) { if (xb_ld(&(bar)[XB_TMO])) break; if (_sp > XB_SPIN_CAP) { atomicAdd(&(bar)[XB_TMO], 1u); break; } } } } while (0)

struct XcdBarrier {
    unsigned* bar; unsigned x;
    volatile LAS unsigned* st;
};

__device__ __forceinline__ XcdBarrier xcd_barrier_post(unsigned* bar, volatile LAS unsigned* st) {
    XcdBarrier b; b.bar = bar; b.x = xb_xcc_id(); b.st = st;
    if (threadIdx.x == 0) (void)xb_add(&bar[XB_XCNT(b.x)], 1u);
    return b;
}
__device__ __forceinline__ void xcd_barrier_complete(unsigned* bar, unsigned x, unsigned& nloc, unsigned& nx) {
    const unsigned G = gridDim.x * gridDim.y * gridDim.z;
    unsigned sum, cnt, mine, sp = 0u;
    for (;;) {
        sum = 0u; cnt = 0u; mine = 0u;
#pragma unroll
        for (unsigned j = 0; j < 16; ++j) { const unsigned c = xb_ld(&bar[XB_XCNT(j)]); sum += c; cnt += (c > 0u) ? 1u : 0u; mine = (j == x) ? c : mine; }
        if (sum == G) break;
        __builtin_amdgcn_s_sleep(1);
        if ((++sp & 255u) == 0u) { if (xb_ld(&bar[XB_TMO])) break; if (sp > XB_SPIN_CAP) { atomicAdd(&bar[XB_TMO], 1u); break; } }
    }
    nloc = mine > 0u ? mine : 1u; nx = cnt > 0u ? cnt : 1u;
}

__device__ __forceinline__ void xcd_barrier(const XcdBarrier& b) {
    asm volatile("s_waitcnt vmcnt(0)" ::: "memory");
    __syncthreads();
    if (threadIdx.x == 0) {
        unsigned* bar = b.bar;
        __builtin_amdgcn_s_waitcnt(0);
        unsigned nloc = b.st[0], nx = b.st[1];
        if (nloc == 0u) { xcd_barrier_complete(bar, b.x, nloc, nx); b.st[0] = nloc; b.st[1] = nx; }
        const unsigned old = xb_add(&bar[XB_XSUB(b.x)], 1u);
        const unsigned gen = old / nloc;
        if (old + 1u == (gen + 1u) * nloc) {
            __builtin_amdgcn_fence(__ATOMIC_RELEASE, "agent");
            asm volatile("s_waitcnt vmcnt(0)" ::: "memory");
            const unsigned og = xb_add(&bar[XB_TOP], 1u);
            const unsigned tg = og / nx;
            if (og + 1u == (tg + 1u) * nx) xb_add(&bar[XB_TOPGEN], 1u);
            else XB_SPIN(xb_ld(&bar[XB_TOPGEN]) == tg, bar);
            __builtin_amdgcn_fence(__ATOMIC_ACQUIRE, "agent");
            xb_add(&bar[XB_XGEN(b.x)], 1u);
            asm volatile("s_waitcnt vmcnt(0)" ::: "memory");
        } else {
            XB_SPIN(xb_ld(&bar[XB_XGEN(b.x)]) == gen, bar);
            __builtin_amdgcn_fence(__ATOMIC_ACQUIRE, "agent");
            asm volatile("s_waitcnt vmcnt(0)" ::: "memory");
        }
    }
    __syncthreads();
}

__device__ __forceinline__ float wave_sum(float v) {
#pragma unroll
    for (int o = 1; o < 64; o <<= 1) v += __shfl_xor(v, o);
    return v;
}
__device__ __forceinline__ int win_dest_row(int n) {
    if (n < 1024) { const int hh = n >> 6, d = n & 63; const int p = (d < 32) ? (8 * (d >> 2) + (d & 3)) : (8 * ((d - 32) >> 2) + 4 + (d & 3)); return hh * 64 + p; }
    if (n < 3072) return n;
    if (n < 3080) return -1;
    return n - 8;
}
__device__ __forceinline__ int wgu_dest_row(int n) { return n < 1024 ? ((n >> 7) * 256 + (n & 127)) : (((n - 1024) >> 7) * 256 + 128 + ((n - 1024) & 127)); }
template <int MAP>
__device__ __forceinline__ void p0_transpose_item(const float* W, int K, int N, bf16* WT, float* wdt, LAS float* scr, int kb, int nb, int lane) {
    const int k0 = 64 * kb, n0 = 32 * nb;
    const int nn = n0 + (lane & 31); const bool nok = nn < N;
#pragma unroll 8
    for (int i = 0; i < 32; ++i) { const int kk = 2 * i + (lane >> 5); scr[kk * 33 + (lane & 31)] = nok ? W[(size_t)(k0 + kk) * N + nn] : 0.f; }
    LDS_WAIT(); asm volatile("" ::: "memory");
    const int c = lane & 7;
#pragma unroll
    for (int j = 0; j < 4; ++j) { const int n = (lane >> 3) + 8 * j; const LAS float* s = scr + (8 * c) * 33 + n;
        const int nsrc = n0 + n; if (nsrc >= N) continue;
        int drow = nsrc; if (MAP == 1) drow = win_dest_row(nsrc); if (MAP == 2) drow = wgu_dest_row(nsrc);
        if (MAP == 1 && drow < 0) { float* d = wdt + (size_t)(nsrc - 3072) * 1024 + k0 + 8 * c;
#pragma unroll
            for (int q = 0; q < 8; ++q) d[q] = s[q * 33]; continue; }
        v4u o; o.x = pk2(s[0 * 33], s[1 * 33]); o.y = pk2(s[2 * 33], s[3 * 33]); o.z = pk2(s[4 * 33], s[5 * 33]); o.w = pk2(s[6 * 33], s[7 * 33]);
        *(GAS v4u*)(WT + (size_t)drow * K + k0 + 8 * c) = o; }
    LDS_WAIT(); asm volatile("" ::: "memory");
}
template <int MAP>
__device__ __forceinline__ void p0_transpose_item8(const float* W, int K, int N, unsigned char* WT, float scale, LAS float* scr, int kb, int nb, int lane) {
    const int k0 = 64 * kb, n0 = 32 * nb;
#pragma unroll 8
    for (int i = 0; i < 32; ++i) { const int kk = 2 * i + (lane >> 5); scr[kk * 33 + (lane & 31)] = W[(size_t)(k0 + kk) * N + n0 + (lane & 31)]; }
    LDS_WAIT(); asm volatile("" ::: "memory");
    const int n = lane & 31, hk = lane >> 5; const LAS float* s = scr + (32 * hk) * 33 + n;
    int drow = n0 + n; if (MAP == 2) drow = wgu_dest_row(n0 + n);
    unsigned w[8];
#pragma unroll
    for (int q = 0; q < 8; ++q) w[q] = pg8::pk4_fp8(s[(4 * q + 0) * 33] * scale, s[(4 * q + 1) * 33] * scale, s[(4 * q + 2) * 33] * scale, s[(4 * q + 3) * 33] * scale);
    GAS v4u* d = (GAS v4u*)(WT + (size_t)drow * K + k0 + 32 * hk);
    d[0] = (v4u){w[0], w[1], w[2], w[3]}; d[1] = (v4u){w[4], w[5], w[6], w[7]};
    LDS_WAIT(); asm volatile("" ::: "memory");
}
__device__ __forceinline__ void row_dt(const f32x4 (&v)[4], const float* wdt, float* dst, int lane) {
    float r[8];
#pragma unroll
    for (int jj = 0; jj < 8; ++jj) { float s = 0.f;
#pragma unroll
        for (int j = 0; j < 4; ++j) { const f32x4 w = *(const f32x4*)(wdt + jj * 1024 + 4 * lane + 256 * j); s += v[j][0] * w[0] + v[j][1] * w[1] + v[j][2] * w[2] + v[j][3] * w[3]; }
        r[jj] = wave_sum(s); }
    if (lane == 0) { *(f32x4*)dst = (f32x4){r[0], r[1], r[2], r[3]}; *(f32x4*)(dst + 4) = (f32x4){r[4], r[5], r[6], r[7]}; }
}
template <bool W8>
__device__ __forceinline__ void ln_row(f32x4 (&v)[4], const float* gam, const float* bet, float* of32, bf16* ob16, unsigned char* o8, float s8, int lane) {
    float s = 0.f;
#pragma unroll
    for (int j = 0; j < 4; ++j) s += (v[j][0] + v[j][1]) + (v[j][2] + v[j][3]);
    const float mean = wave_sum(s) * (1.f / DM); float s2 = 0.f;
#pragma unroll
    for (int j = 0; j < 4; ++j) { v[j] = v[j] - mean; s2 += (v[j][0] * v[j][0] + v[j][1] * v[j][1]) + (v[j][2] * v[j][2] + v[j][3] * v[j][3]); }
    const float rstd = 1.f / sqrtf(wave_sum(s2) * (1.f / DM) + LN_EPS);
#pragma unroll
    for (int j = 0; j < 4; ++j) { const f32x4 g = *(const f32x4*)(gam + 4 * lane + 256 * j), b = *(const f32x4*)(bet + 4 * lane + 256 * j);
        v[j] = v[j] * rstd * g + b;
        *(f32x4*)(of32 + 4 * lane + 256 * j) = v[j];
        v2u w; w.x = pk2(v[j][0], v[j][1]); w.y = pk2(v[j][2], v[j][3]); *(v2u*)(ob16 + 4 * lane + 256 * j) = w;
        if (W8) *(unsigned*)(o8 + 4 * lane + 256 * j) = pg8::pk4_fp8(v[j][0] * s8, v[j][1] * s8, v[j][2] * s8, v[j][3] * s8); }
}


typedef short v4i16_t __attribute__((ext_vector_type(4)));
__device__ __forceinline__ bf16x8 tr_pair(const LAS unsigned char* p0, const LAS unsigned char* p1) {
    const v4i16_t a = __builtin_amdgcn_ds_read_tr16_b64_v4i16((LAS v4i16_t*)p0), b = __builtin_amdgcn_ds_read_tr16_b64_v4i16((LAS v4i16_t*)p1);
    return (bf16x8){a[0], a[1], a[2], a[3], b[0], b[1], b[2], b[3]};
}
__device__ __forceinline__ int crow16(int r, int hi) { return (r & 3) + 8 * (r >> 2) + 4 * hi; }
constexpr int AK_PITCH = 144, AV_PITCH = 192, AK_TILE = 32 * AK_PITCH, AV_TILE = 32 * AV_PITCH;
constexpr int AT_K = 0, AT_V = 12 * AK_TILE;
struct AttnItem { int p, b, h, d, r, qt0; };
__device__ __forceinline__ AttnItem attn_item(int I) { AttnItem a; a.p = I >> 10; const int rem = I & 1023; a.b = rem >> 7; a.h = (rem >> 4) & 7; const int grp = rem & 15;
    a.d = (a.p == 0) ? 1 : (a.p == 1) ? 4 : 16; const int tpr = 128 / a.d; const int T = grp * 8; a.r = T / tpr; a.qt0 = T % tpr; return a; }
__device__ __forceinline__ void attn_request(const bf16* PROJ, const AttnItem& a, v4u (&st)[12], int tid) {
    const int rr = tid >> 4, ch = tid & 15; const int col = (ch < 8 ? C_K : C_V - 64) + a.h * 64 + ch * 8;
#pragma unroll
    for (int tl = 0; tl < 12; ++tl) { const int kt = a.qt0 - 4 + tl; st[tl] = (v4u){0u, 0u, 0u, 0u};
        if (kt >= 0) { const size_t row = (size_t)a.b * SEQ + (size_t)(32 * kt + rr) * a.d + a.r; st[tl] = *(const v4u*)(PROJ + row * NPROJ + col); } }
}
__device__ __forceinline__ void attn_deposit(LAS unsigned char* al, const v4u (&st)[12], int tid) {
    const int rr = tid >> 4, ch = tid & 15;
    LAS unsigned char* dst = (ch < 8) ? (al + AT_K + rr * AK_PITCH + ch * 16) : (al + AT_V + rr * AV_PITCH + (ch - 8) * 16); const int tstep = (ch < 8) ? AK_TILE : AV_TILE;
#pragma unroll
    for (int tl = 0; tl < 12; ++tl) *(LAS v4u*)(dst + tl * tstep) = st[tl];
}
__device__ __forceinline__ void attn_wave_compute(const bf16* PROJ, bf16* OPp, float* LSEp, const AttnItem& a, const LAS unsigned char* al, int wave, int lane) {
    const int i = lane & 31, h2 = lane >> 5; const int qt = a.qt0 + wave;
    const size_t rowq = (size_t)a.b * SEQ + (size_t)(32 * qt + i) * a.d + a.r;
    bf16x8 qf[4];
    { const bf16* qp = PROJ + rowq * NPROJ + C_Q + a.h * 64 + 8 * h2;
#pragma unroll
      for (int s = 0; s < 4; ++s) qf[s] = *(const bf16x8*)(qp + 16 * s); }
    f32x16 o0 = {}, o1 = {}; float mrun = -INFINITY, lrun = 0.f;
    const int kt0 = qt > 4 ? qt - 4 : 0;
    const LAS unsigned char* krd = al + AT_K + i * AK_PITCH + 16 * h2;
    const LAS unsigned char* trb = al + AT_V + (4 * h2 + ((lane & 15) >> 2)) * AV_PITCH + (16 * ((lane >> 4) & 1) + 4 * (lane & 3)) * 2;
#pragma unroll 1
    for (int kt = kt0; kt <= qt; ++kt) {
        const int tl = kt - a.qt0 + 4;
        const LAS unsigned char* kp = krd + tl * AK_TILE; const LAS unsigned char* vp = trb + tl * AV_TILE;
        f32x16 sacc = {};
#pragma unroll
        for (int s = 0; s < 4; ++s) sacc = __builtin_amdgcn_mfma_f32_32x32x16_bf16(*(const LAS bf16x8*)(kp + 32 * s), qf[s], sacc, 0, 0, 0);
        if (kt == qt) {
#pragma unroll
            for (int rg = 0; rg < 16; ++rg) if (crow16(rg, h2) > i) sacc[rg] = -INFINITY;
        }
        if (kt + 4 == qt) {
#pragma unroll
            for (int rg = 0; rg < 16; ++rg) if (crow16(rg, h2) < i) sacc[rg] = -INFINITY;
        }
        float mx = sacc[0];
#pragma unroll
        for (int rg = 1; rg < 16; ++rg) mx = fmaxf(mx, sacc[rg]);
        mx = fmaxf(mx, __shfl_xor(mx, 32));
        const float mnew = fmaxf(mrun, mx), alpha = __builtin_amdgcn_exp2f(mrun - mnew); mrun = mnew;
        float ps = 0.f;
#pragma unroll
        for (int rg = 0; rg < 16; ++rg) { sacc[rg] = __builtin_amdgcn_exp2f(sacc[rg] - mnew); ps += sacc[rg]; }
        lrun = lrun * alpha + ps;
#pragma unroll
        for (int rg = 0; rg < 16; ++rg) { o0[rg] *= alpha; o1[rg] *= alpha; }
        bf16x8 pf[2];
#pragma unroll
        for (int ks = 0; ks < 2; ++ks) { v4u w; w.x = pg8::cvt_pk_bf16(sacc[8 * ks + 0], sacc[8 * ks + 1]); w.y = pg8::cvt_pk_bf16(sacc[8 * ks + 2], sacc[8 * ks + 3]); w.z = pg8::cvt_pk_bf16(sacc[8 * ks + 4], sacc[8 * ks + 5]); w.w = pg8::cvt_pk_bf16(sacc[8 * ks + 6], sacc[8 * ks + 7]); pf[ks] = __builtin_bit_cast(bf16x8, w); }
#pragma unroll
        for (int ks = 0; ks < 2; ++ks) {
            const bf16x8 v0 = tr_pair(vp + (16 * ks) * AV_PITCH, vp + (16 * ks + 8) * AV_PITCH);
            const bf16x8 v1 = tr_pair(vp + (16 * ks) * AV_PITCH + 64, vp + (16 * ks + 8) * AV_PITCH + 64);
            o0 = __builtin_amdgcn_mfma_f32_32x32x16_bf16(v0, pf[ks], o0, 0, 0, 0);
            o1 = __builtin_amdgcn_mfma_f32_32x32x16_bf16(v1, pf[ks], o1, 0, 0, 0);
        }
    }
    const float lt = lrun + __shfl_xor(lrun, 32); const float il = 1.0f / lt;
    bf16* op = OPp + rowq * 512 + a.h * 64 + 4 * h2;
#pragma unroll
    for (int g4 = 0; g4 < 4; ++g4) {
        v2u w0, w1; w0.x = pg8::cvt_pk_bf16(o0[4 * g4 + 0] * il, o0[4 * g4 + 1] * il); w0.y = pg8::cvt_pk_bf16(o0[4 * g4 + 2] * il, o0[4 * g4 + 3] * il);
        w1.x = pg8::cvt_pk_bf16(o1[4 * g4 + 0] * il, o1[4 * g4 + 1] * il); w1.y = pg8::cvt_pk_bf16(o1[4 * g4 + 2] * il, o1[4 * g4 + 3] * il);
        *(v2u*)(op + 8 * g4) = w0; *(v2u*)(op + 32 + 8 * g4) = w1; }
    if (h2 == 0) LSEp[rowq * 8 + a.h] = mrun + log2f(lt);
}
__device__ __forceinline__ void attn_phase(LAS unsigned char* al, const bf16* PROJ, bf16* OP, float* LSE, int bid, int G, int tid, int wave, int lane) {
    v4u st[12];
    int I = bid;
    if (I < 3072) { const AttnItem a = attn_item(I); attn_request(PROJ, a, st, tid); }
    for (; I < 3072; I += G) {
        const AttnItem a = attn_item(I);
        __syncthreads();
        attn_deposit(al, st, tid);
        __syncthreads();
        if (I + G < 3072) { const AttnItem n = attn_item(I + G); attn_request(PROJ, n, st, tid); }
        attn_wave_compute(PROJ, OP + (size_t)a.p * MROWS * 512, LSE + (size_t)a.p * MROWS * 8, a, al, wave, lane);
    }
    __syncthreads();
}

constexpr int SS_DTS = 0, SS_ACUM = 2048, SS_TMP = 4096, SS_SSX = 6144, SS_IMG = 8192;
constexpr int S1_PB = 320, S1_PX = 576;
constexpr int S1_B = SS_IMG, S1_X = SS_IMG + 128 * S1_PB;
constexpr int S3_PBC = 272, S3_PX = 576;
constexpr int S3_B = SS_IMG, S3_C = S3_B + 128 * S3_PBC, S3_X = S3_C + 128 * S3_PBC;

__device__ __forceinline__ void ssd_prep(LAS unsigned char* sl, const float* DT, const float* dtb, const float* alog, size_t row0, int g, int tid, int lane, int wave) {
    LAS float* dts = (LAS float*)(sl + SS_DTS); LAS float* acum = (LAS float*)(sl + SS_ACUM); LAS float* tmp = (LAS float*)(sl + SS_TMP);
    { const int l = tid >> 2, hq = tid & 3; const float x = DT[(row0 + l) * 8 + 4 * g + hq] + dtb[4 * g + hq];
      const float dt = x > 20.f ? x : log1pf(__expf(x)); dts[hq * 128 + l] = dt; tmp[hq * 128 + l] = dt * (-__expf(alog[4 * g + hq])); }
    __syncthreads();
    if (wave < 4) { const float v0 = tmp[wave * 128 + 2 * lane], v1 = tmp[wave * 128 + 2 * lane + 1]; float s = v0 + v1;
#pragma unroll
        for (int off = 1; off < 64; off <<= 1) { const float t = __shfl_up(s, off); if (lane >= off) s += t; }
        acum[wave * 128 + 2 * lane] = s - v1; acum[wave * 128 + 2 * lane + 1] = s; }
    __syncthreads();
}
template <int NCOLS, int FACMODE>
__device__ __forceinline__ void conv_tile(const bf16* PROJ, size_t row0, int t0, int pcol0, const float* cw, const float* cb, int cch0, LAS unsigned char* dst, int pitch, const LAS unsigned char* sl, int hq0, int tid) {
    constexpr int NCH8 = NCOLS / 8, NSEG = 512 / NCH8, RPS = 128 / NSEG;
    const int c8 = tid % NCH8, seg = tid / NCH8, l0 = seg * RPS;
    float w[4][8], bias[8], hst[3][8];
#pragma unroll
    for (int k = 0; k < 4; ++k) { const f32x4 a = *(const f32x4*)(cw + k * 1024 + cch0 + c8 * 8), b = *(const f32x4*)(cw + k * 1024 + cch0 + c8 * 8 + 4);
        w[k][0] = a[0]; w[k][1] = a[1]; w[k][2] = a[2]; w[k][3] = a[3]; w[k][4] = b[0]; w[k][5] = b[1]; w[k][6] = b[2]; w[k][7] = b[3]; }
    { const f32x4 a = *(const f32x4*)(cb + cch0 + c8 * 8), b = *(const f32x4*)(cb + cch0 + c8 * 8 + 4);
      bias[0] = a[0]; bias[1] = a[1]; bias[2] = a[2]; bias[3] = a[3]; bias[4] = b[0]; bias[5] = b[1]; bias[6] = b[2]; bias[7] = b[3]; }
    const bf16* src = PROJ + pcol0 + c8 * 8;
#pragma unroll
    for (int k = 0; k < 3; ++k) { const int l = l0 - 3 + k; v4u v = (v4u){0u, 0u, 0u, 0u}; if (t0 + l >= 0) v = *(const v4u*)(src + (size_t)((long)row0 + l) * NPROJ);
        hst[k][0] = bflo(v.x); hst[k][1] = bfhi(v.x); hst[k][2] = bflo(v.y); hst[k][3] = bfhi(v.y); hst[k][4] = bflo(v.z); hst[k][5] = bfhi(v.z); hst[k][6] = bflo(v.w); hst[k][7] = bfhi(v.w); }
    const LAS float* dts = (const LAS float*)(sl + SS_DTS); const LAS float* acum = (const LAS float*)(sl + SS_ACUM);
    const int hq = hq0 + (c8 * 8) / 64;
    const float alast = (FACMODE == 2) ? acum[hq * 128 + 127] : 0.f;
#pragma unroll
    for (int rr = 0; rr < RPS; ++rr) { const int l = l0 + rr; const v4u v = *(const v4u*)(src + (row0 + l) * NPROJ);
        float cur[8]; cur[0] = bflo(v.x); cur[1] = bfhi(v.x); cur[2] = bflo(v.y); cur[3] = bfhi(v.y); cur[4] = bflo(v.z); cur[5] = bfhi(v.z); cur[6] = bflo(v.w); cur[7] = bfhi(v.w);
        float f = 1.f; if (FACMODE >= 1) f = dts[hq * 128 + l]; if (FACMODE == 2) f *= __expf(alast - acum[hq * 128 + l]);
        float o[8];
#pragma unroll
        for (int e = 0; e < 8; ++e) { const float a = bias[e] + w[0][e] * hst[0][e] + w[1][e] * hst[1][e] + w[2][e] * hst[2][e] + w[3][e] * cur[e]; o[e] = siluf(a) * f;
            hst[0][e] = hst[1][e]; hst[1][e] = hst[2][e]; hst[2][e] = cur[e]; }
        v4u ov; ov.x = pk2(o[0], o[1]); ov.y = pk2(o[2], o[3]); ov.z = pk2(o[4], o[5]); ov.w = pk2(o[6], o[7]);
        *(LAS v4u*)(dst + l * pitch + c8 * 16) = ov; }
}
__device__ __forceinline__ void ssd_s1_unit(LAS unsigned char* sl, const bf16* PROJ, const float* DT, const float* dtb, const float* alog, const float* cw, const float* cb, float* ST, float* CDEC, int un, int tid, int lane, int wave) {
    const int g = un & 1, bc = un >> 1; const size_t row0 = (size_t)bc * 128; const int t0 = (bc & 31) * 128;
    __syncthreads();
    ssd_prep(sl, DT, dtb, alog, row0, g, tid, lane, wave);
    conv_tile<128, 0>(PROJ, row0, t0, C_XS + 512 + g * 128, cw, cb, 512 + g * 128, sl + S1_B, S1_PB, sl, 0, tid);
    conv_tile<256, 2>(PROJ, row0, t0, C_XS + g * 256, cw, cb, g * 256, sl + S1_X, S1_PX, sl, 0, tid);
    if (tid < 4) CDEC[(size_t)bc * 8 + 4 * g + tid] = __expf(((const LAS float*)(sl + SS_ACUM))[tid * 128 + 127]);
    __syncthreads();
    const int hq = wave >> 1, pt = wave & 1, h2 = lane >> 5, q = (lane & 15) >> 2, pp = lane & 3, dsel = (lane >> 4) & 1;
    const LAS unsigned char* xb = sl + S1_X + (8 * h2 + q) * S1_PX + (hq * 64 + pt * 32 + 16 * dsel + 4 * pp) * 2;
    const LAS unsigned char* bb = sl + S1_B + (8 * h2 + q) * S1_PB + (16 * dsel + 4 * pp) * 2;
    f32x16 acc[4];
#pragma unroll
    for (int nt = 0; nt < 4; ++nt) acc[nt] = (f32x16){};
#pragma unroll
    for (int ks = 0; ks < 8; ++ks) { const bf16x8 a = tr_pair(xb + (16 * ks) * S1_PX, xb + (16 * ks + 4) * S1_PX);
#pragma unroll
        for (int nt = 0; nt < 4; ++nt) { const bf16x8 b = tr_pair(bb + (16 * ks) * S1_PB + nt * 64, bb + (16 * ks + 4) * S1_PB + nt * 64); acc[nt] = __builtin_amdgcn_mfma_f32_32x32x16_bf16(a, b, acc[nt], 0, 0, 0); } }
    float* sp = ST + ((size_t)(bc * 8 + 4 * g + hq) * 64 + pt * 32) * 128 + (lane & 31);
#pragma unroll
    for (int nt = 0; nt < 4; ++nt)
#pragma unroll
        for (int rg = 0; rg < 16; ++rg) sp[(size_t)crow16(rg, h2) * 128 + 32 * nt] = acc[nt][rg];
}
__device__ __forceinline__ void ssd_s3_unit(LAS unsigned char* sl, const bf16* PROJ, const float* DT, const float* dtb, const float* alog, const float* cw, const float* cb, const float* dsk, const float* ng,
                                            const bf16* HIN, bf16* MIXED, int un, int tid, int lane, int wave) {
    const int g = un & 1, bc = un >> 1; const size_t row0 = (size_t)bc * 128; const int t0 = (bc & 31) * 128;
    __syncthreads();
    ssd_prep(sl, DT, dtb, alog, row0, g, tid, lane, wave);
    conv_tile<128, 0>(PROJ, row0, t0, C_XS + 512 + g * 128, cw, cb, 512 + g * 128, sl + S3_B, S3_PBC, sl, 0, tid);
    conv_tile<128, 0>(PROJ, row0, t0, C_XS + 768 + g * 128, cw, cb, 768 + g * 128, sl + S3_C, S3_PBC, sl, 0, tid);
    conv_tile<256, 1>(PROJ, row0, t0, C_XS + g * 256, cw, cb, g * 256, sl + S3_X, S3_PX, sl, 0, tid);
    __syncthreads();
    const LAS float* dts = (const LAS float*)(sl + SS_DTS); const LAS float* acum = (const LAS float*)(sl + SS_ACUM); LAS float* ssx = (LAS float*)(sl + SS_SSX);
    const int lt = wave & 3, ph = wave >> 2, lq = lane & 31, hi = lane >> 5, q = (lane & 15) >> 2, pp = lane & 3, dsel = (lane >> 4) & 1;
    const int lrow = 32 * lt + lq;
    const LAS unsigned char* crd = sl + S3_C + lrow * S3_PBC + 16 * hi;
    f32x16 ag[4];
#pragma unroll
    for (int st = 0; st < 4; ++st) { ag[st] = (f32x16){};
        if (st <= lt) { const LAS unsigned char* brd = sl + S3_B + (32 * st + lq) * S3_PBC + 16 * hi;
#pragma unroll
            for (int ks = 0; ks < 8; ++ks) ag[st] = __builtin_amdgcn_mfma_f32_32x32x16_bf16(*(const LAS bf16x8*)(brd + 32 * ks), *(const LAS bf16x8*)(crd + 32 * ks), ag[st], 0, 0, 0); } }
    unsigned ayp[4][8]; float ss = 0.f; const size_t grow = row0 + lrow;
#pragma unroll
    for (int hq = 0; hq < 4; ++hq) {
            const float al = acum[hq * 128 + lrow], dd = dsk[4 * g + hq] / dts[hq * 128 + lrow];
            const LAS unsigned char* xb = sl + S3_X + (4 * hi + q) * S3_PX + (hq * 64 + ph * 32 + 16 * dsel + 4 * pp) * 2;
            f32x16 y = (f32x16){};
            { const bf16* hp = HIN + ((size_t)(bc * 8 + 4 * g + hq) * 64 + ph * 32 + lq) * 128 + 8 * hi;
#pragma unroll
              for (int ks = 0; ks < 8; ++ks) y = __builtin_amdgcn_mfma_f32_32x32x16_bf16(*(const bf16x8*)(hp + 16 * ks), *(const LAS bf16x8*)(crd + 32 * ks), y, 0, 0, 0);
              const float ea = __expf(al);
#pragma unroll
              for (int rg = 0; rg < 16; ++rg) y[rg] *= ea; }
#pragma unroll
            for (int st = 0; st < 4; ++st) if (st <= lt) {
                float pm[16];
#pragma unroll
                for (int g4 = 0; g4 < 4; ++g4) { const f32x4 as4 = *(const LAS f32x4*)(acum + hq * 128 + 32 * st + 8 * g4 + 4 * hi);
#pragma unroll
                    for (int e = 0; e < 4; ++e) { const int rg = 4 * g4 + e; float v = ag[st][rg] * __expf(al - as4[e]);
                        if (st == lt) { const int sl_ = 8 * g4 + 4 * hi + e; if (sl_ > lq) v = 0.f; if (sl_ == lq) v += dd; }
                        pm[rg] = v; } }
#pragma unroll
                for (int ks = 0; ks < 2; ++ks) { v4u wv; wv.x = pg8::cvt_pk_bf16(pm[8 * ks + 0], pm[8 * ks + 1]); wv.y = pg8::cvt_pk_bf16(pm[8 * ks + 2], pm[8 * ks + 3]); wv.z = pg8::cvt_pk_bf16(pm[8 * ks + 4], pm[8 * ks + 5]); wv.w = pg8::cvt_pk_bf16(pm[8 * ks + 6], pm[8 * ks + 7]);
                    const bf16x8 xt = tr_pair(xb + (32 * st + 16 * ks) * S3_PX, xb + (32 * st + 16 * ks + 8) * S3_PX);
                    y = __builtin_amdgcn_mfma_f32_32x32x16_bf16(xt, __builtin_bit_cast(bf16x8, wv), y, 0, 0, 0); }
            }
#pragma unroll
            for (int g4 = 0; g4 < 4; ++g4) { const int ch = hq * 64 + ph * 32 + 8 * g4 + 4 * hi; const v2u z = *(const v2u*)(PROJ + grow * NPROJ + C_Z + g * 256 + ch);
                const float y0 = y[4 * g4 + 0] * siluf(bflo(z.x)), y1 = y[4 * g4 + 1] * siluf(bfhi(z.x)), y2 = y[4 * g4 + 2] * siluf(bflo(z.y)), y3 = y[4 * g4 + 3] * siluf(bfhi(z.y));
                ss += (y0 * y0 + y1 * y1) + (y2 * y2 + y3 * y3);
                ayp[hq][2 * g4] = pg8::cvt_pk_bf16(y0, y1); ayp[hq][2 * g4 + 1] = pg8::cvt_pk_bf16(y2, y3); }
    }
    ss += __shfl_xor(ss, 32);
    if (hi == 0) ssx[ph * 128 + lrow] = ss;
    __syncthreads();
    const float rs = 1.0f / sqrtf((ssx[lrow] + ssx[128 + lrow]) * (1.f / 256.f) + RMS_EPS);
#pragma unroll
    for (int hq = 0; hq < 4; ++hq)
#pragma unroll
        for (int g4 = 0; g4 < 4; ++g4) { const int ch = hq * 64 + ph * 32 + 8 * g4 + 4 * hi; const f32x4 gn = *(const f32x4*)(ng + g * 256 + ch);
            const unsigned p0 = ayp[hq][2 * g4], p1 = ayp[hq][2 * g4 + 1];
            v2u o; o.x = pg8::cvt_pk_bf16(bflo(p0) * rs * gn[0], bfhi(p0) * rs * gn[1]); o.y = pg8::cvt_pk_bf16(bflo(p1) * rs * gn[2], bfhi(p1) * rs * gn[3]);
            *(v2u*)(MIXED + grow * MIXW + 512 + g * 256 + ch) = o; }
}

constexpr float SC_X = 4.f, SC_WGU = 32.f, SC_H = 4.f, SC_WDN = 64.f;
struct Args { const float* in[20]; float* out; unsigned char* ws; int ph_lo, ph_hi, sub, pad; };
constexpr int NWAVES = 8;
constexpr int PH_PER_LAYER = 10, N_PHASES = 1 + NLAYER * PH_PER_LAYER;

#define in_x (args.in[0])
#define in_win (args.in[1])
#define in_convw (args.in[2])
#define in_convb (args.in[3])
#define in_dtb (args.in[4])
#define in_alog (args.in[5])
#define in_dsk (args.in[6])
#define in_ng (args.in[7])
#define in_scw (args.in[8])
#define in_wout (args.in[9])
#define in_ln1g (args.in[10])
#define in_ln1b (args.in[11])
#define in_rw (args.in[12])
#define in_rb (args.in[13])
#define in_wgu (args.in[14])
#define in_bgu (args.in[15])
#define in_wdn (args.in[16])
#define in_bdn (args.in[17])
#define in_ln2g (args.in[18])
#define in_ln2b (args.in[19])
#define ROPE ((float*)(args.ws + WS_ROPE))
#define WDT ((float*)(args.ws + WS_WDT))
#define ROUT ((bf16*)(args.ws + WS_ROUT))
#define WIN ((bf16*)(args.ws + WS_WIN))
#define WOUT ((bf16*)(args.ws + WS_WOUT))
#define WGU ((bf16*)(args.ws + WS_WGU))
#define WDN ((bf16*)(args.ws + WS_WDN))
#define XB ((bf16*)(args.ws + WS_XB))
#define XF ((float*)(args.ws + WS_XF))
#define XF2 ((float*)(args.ws + WS_XF2))
#define PROJ ((bf16*)(args.ws + WS_PROJ))
#define DT ((float*)(args.ws + WS_DT))
#define DTS ((float*)(args.ws + WS_DTS))
#define ACUM ((float*)(args.ws + WS_ACUM))
#define LSE ((float*)(args.ws + WS_LSE))
#define OP ((bf16*)(args.ws + WS_OP))
#define U ((bf16*)(args.ws + WS_U))
#define GB ((float*)(args.ws + WS_G))
#define ST ((float*)(args.ws + WS_ST))
#define YD ((float*)(args.ws + WS_YD))
#define MIXED ((bf16*)(args.ws + WS_MIXED))
#define MIXF ((float*)(args.ws + WS_MIXF))
#define TOPE ((int*)(args.ws + WS_TOPE))
#define TOPG ((float*)(args.ws + WS_TOPG))
#define ROWTOK ((int*)(args.ws + WS_ROWTOK))
#define ROWGATE ((float*)(args.ws + WS_ROWGATE))
#define HB ((bf16*)(args.ws + WS_H))
#define YB ((bf16*)(args.ws + WS_YB))
#define HIN ((bf16*)(args.ws + WS_G))
#define WGU8 ((unsigned char*)(args.ws + WS_WGU))
#define WDN8 ((unsigned char*)(args.ws + WS_WDN))
#define XB8 ((unsigned char*)(args.ws + WS_U))
#define H8 ((unsigned char*)(args.ws + WS_H))
#define CDEC ((float*)(args.ws + WS_ACUM))
template <int layer>
__device__ __forceinline__ void run_layer(const Args& args, int lo, int hi, const XcdBarrier& bar) {
    extern __shared__ __attribute__((aligned(16))) unsigned char lds[];
    LAS unsigned char* ldsp = (LAS unsigned char*)lds;
    const int tid = threadIdx.x, lane = tid & 63, wave = __builtin_amdgcn_readfirstlane(tid >> 6);
    const int G = gridDim.x, bid = blockIdx.x;
    const int gw = bid * NWAVES + wave, NGW = G * NWAVES;
    gu32* ctl = (gu32*)(args.ws + WS_CTL);

#define IN(k) (lo <= (k) && (k) < hi)
#define SEAM(k) do { if (IN(k) && IN((k) + 1)) xcd_barrier(bar); } while (0)

        const int pb = 1 + layer * PH_PER_LAYER;
        const float* xres = layer == 0 ? in_x : XF2;
        const bf16* WINl = WIN + (size_t)layer * NPROJ * DM; const bf16* WOUTl = WOUT + (size_t)layer * DM * MIXW;
        const unsigned char* WGUl = WGU8 + (size_t)layer * NEXP * 2048 * DM; const unsigned char* WDNl = WDN8 + (size_t)layer * NEXP * DM * FF;
        gu32* gcnt = ctl + CW_CNT + 64 * layer;

        if (IN(pb + 0)) {
            if (layer == 0) {
                for (int m = gw; m < MROWS; m += NGW) { const float* xr = in_x + (size_t)m * DM; f32x4 v[4];
#pragma unroll
                    for (int j = 0; j < 4; ++j) v[j] = *(const f32x4*)(xr + 4 * lane + 256 * j);
                    row_dt(v, WDT, DT + (size_t)m * 8, lane); }
            }
            pg8::Gemm g{XB, WINl, MROWS, NPROJ, DM}; pg8::StaticOrder S; S.init(MROWS, NPROJ, G, bid);
            pg8::EpiProj E{PROJ, NPROJ, ROPE, QSCALE};
            pg8::gemm_phase<pg8::EpiProj, pg8::StaticOrder, true, false>(ldsp + RING_OFF, g, S, E);
        }
        SEAM(pb + 0);
        if (IN(pb + 1)) {
            if (args.sub & 1) attn_phase(ldsp + RING_OFF, PROJ, OP, LSE, bid, G, tid, wave, lane);
            if (args.sub & 2) { const float* cw = in_convw + (size_t)layer * 4 * 1024; const float* cb = in_convb + (size_t)layer * 1024;
              for (int un = bid; un < 512; un += G)
                  ssd_s1_unit(ldsp + RING_OFF, PROJ, DT, in_dtb + layer * 8, in_alog + layer * 8, cw, cb, ST, CDEC, un, tid, lane, wave);
              __syncthreads(); }
            const float* sw = in_scw + (size_t)layer * 3 * 512;
            if (args.sub & 4) for (int it = bid * (NWAVES * 64) + tid; it < (int)((long)MROWS * 64); it += G * (NWAVES * 64)) { const int c8 = (int)(it & 63), row = (int)(it >> 6), t = row & (SEQ - 1); const int ch = c8 * 8;
                float a[8];
#pragma unroll
                for (int q = 0; q < 8; ++q) a[q] = 0.f;
#pragma unroll
                for (int k = 0; k < 3; ++k) { const int tt = t - 2 + k; if (tt >= 0) { const bf16* pr = PROJ + (size_t)(row - 2 + k) * NPROJ; const v4u cc = *(const v4u*)(pr + C_SC + ch), hh = *(const v4u*)(pr + C_SH + ch);
                    const f32x4 w0 = *(const f32x4*)(sw + k * 512 + ch), w1 = *(const f32x4*)(sw + k * 512 + ch + 4);
                    a[0] += w0[0] * bflo(cc.x) * bflo(hh.x); a[1] += w0[1] * bfhi(cc.x) * bfhi(hh.x); a[2] += w0[2] * bflo(cc.y) * bflo(hh.y); a[3] += w0[3] * bfhi(cc.y) * bfhi(hh.y);
                    a[4] += w1[0] * bflo(cc.z) * bflo(hh.z); a[5] += w1[1] * bfhi(cc.z) * bfhi(hh.z); a[6] += w1[2] * bflo(cc.w) * bflo(hh.w); a[7] += w1[3] * bfhi(cc.w) * bfhi(hh.w); } }
                const v4u bb = *(const v4u*)(PROJ + (size_t)row * NPROJ + C_SB + ch);
                v4u o; o.x = pk2(a[0] * bflo(bb.x), a[1] * bfhi(bb.x)); o.y = pk2(a[2] * bflo(bb.y), a[3] * bfhi(bb.y)); o.z = pk2(a[4] * bflo(bb.z), a[5] * bfhi(bb.z)); o.w = pk2(a[6] * bflo(bb.w), a[7] * bfhi(bb.w));
                *(v4u*)(MIXED + (size_t)row * MIXW + 1024 + ch) = o; }
        }
        SEAM(pb + 1);
        if (IN(pb + 2)) {
            for (int it = bid * (NWAVES * 64) + tid; it < (int)(64L * 2048); it += G * (NWAVES * 64)) { const int pn4 = (int)(it & 2047), bh = (int)(it >> 11); const int h = bh & 7, b = bh >> 3; f32x4 hc = (f32x4){0.f, 0.f, 0.f, 0.f};
#pragma unroll 8
                for (int c = 0; c < 32; ++c) { const size_t idx = ((size_t)((b * 32 + c) * 8 + h)) * 8192 + pn4 * 4; const f32x4 st = *(const f32x4*)(ST + idx);
                    v2u o; o.x = pk2(hc[0], hc[1]); o.y = pk2(hc[2], hc[3]); *(v2u*)(HIN + idx) = o;
                    hc = hc * CDEC[(size_t)(b * 32 + c) * 8 + h] + st; } }
        }
        SEAM(pb + 2);
        if (IN(pb + 3)) {
            if (args.sub & 1) { const float* cw = in_convw + (size_t)layer * 4 * 1024; const float* cb = in_convb + (size_t)layer * 1024;
              for (int un = bid; un < 512; un += G)
                  ssd_s3_unit(ldsp + RING_OFF, PROJ, DT, in_dtb + layer * 8, in_alog + layer * 8, cw, cb, in_dsk + layer * 8, in_ng + (size_t)layer * 512, HIN, MIXED, un, tid, lane, wave);
              __syncthreads(); }
            if (args.sub & 2) for (int it = bid * (NWAVES * 64) + tid; it < (int)((long)MROWS * 64); it += G * (NWAVES * 64)) { const int c8 = (int)(it & 63), row = (int)(it >> 6); const int h = c8 >> 3;
                const float l0 = LSE[((size_t)0 * MROWS + row) * 8 + h], l1 = LSE[((size_t)1 * MROWS + row) * 8 + h], l2 = LSE[((size_t)2 * MROWS + row) * 8 + h];
                const float mm = fmaxf(l0, fmaxf(l1, l2)); float w0 = exp2f(l0 - mm), w1 = exp2f(l1 - mm), w2 = exp2f(l2 - mm); const float iw = 1.0f / (w0 + w1 + w2); w0 *= iw; w1 *= iw; w2 *= iw;
                const v4u a0 = *(const v4u*)(OP + ((size_t)0 * MROWS + row) * 512 + c8 * 8), a1 = *(const v4u*)(OP + ((size_t)1 * MROWS + row) * 512 + c8 * 8), a2 = *(const v4u*)(OP + ((size_t)2 * MROWS + row) * 512 + c8 * 8);
                v4u o;
                o.x = pk2(w0 * bflo(a0.x) + w1 * bflo(a1.x) + w2 * bflo(a2.x), w0 * bfhi(a0.x) + w1 * bfhi(a1.x) + w2 * bfhi(a2.x));
                o.y = pk2(w0 * bflo(a0.y) + w1 * bflo(a1.y) + w2 * bflo(a2.y), w0 * bfhi(a0.y) + w1 * bfhi(a1.y) + w2 * bfhi(a2.y));
                o.z = pk2(w0 * bflo(a0.z) + w1 * bflo(a1.z) + w2 * bflo(a2.z), w0 * bfhi(a0.z) + w1 * bfhi(a1.z) + w2 * bfhi(a2.z));
                o.w = pk2(w0 * bflo(a0.w) + w1 * bflo(a1.w) + w2 * bflo(a2.w), w0 * bfhi(a0.w) + w1 * bfhi(a1.w) + w2 * bfhi(a2.w));
                *(v4u*)(MIXED + (size_t)row * MIXW + c8 * 8) = o; }
        }
        SEAM(pb + 3);
        if (IN(pb + 4)) {
            pg8::Gemm g{MIXED, WOUTl, MROWS, DM, MIXW}; pg8::StaticOrder S; S.init(MROWS, DM, G, bid);
            pg8::EpiF32 E{MIXF, DM};
            pg8::gemm_phase<pg8::EpiF32, pg8::StaticOrder, true, false>(ldsp + RING_OFF, g, S, E);
        }
        SEAM(pb + 4);
        if (IN(pb + 5)) {
            const float* gam = in_ln1g + (size_t)layer * DM; const float* bet = in_ln1b + (size_t)layer * DM;
            for (int m = gw; m < MROWS; m += NGW) { f32x4 v[4];
#pragma unroll
                for (int j = 0; j < 4; ++j) { const f32x4 a = *(const f32x4*)(xres + (size_t)m * DM + 4 * lane + 256 * j), b = *(const f32x4*)(MIXF + (size_t)m * DM + 4 * lane + 256 * j); v[j] = a * ALPHA + b; }
                ln_row<true>(v, gam, bet, XF + (size_t)m * DM, XB + (size_t)m * DM, XB8 + (size_t)m * DM, SC_X, lane); }
        }
        SEAM(pb + 5);
        if (IN(pb + 6)) {
            LAS int* lcnt = (LAS int*)(ldsp + L_LCNT); LAS int* lbase = (LAS int*)(ldsp + L_LBASE);
            const bf16* RT = ROUT + (size_t)layer * NEXP * DM; const float* rb = in_rb + (size_t)layer * NEXP;
            for (int blk = bid; blk < MROWS / 128; blk += G) {
                if (tid < 32) lcnt[tid] = 0;
                __syncthreads();
                const int r32 = lane & 31, hi = lane >> 5; const int row = blk * 128 + (wave & 3) * 32 + r32;
                float tv[4]; int te[4]; int lrank[4]; float gate[4];
                if (wave < 4) {
                    f32x16 acc = {};
                    const bf16* ap = RT + (size_t)r32 * DM + 8 * hi; const bf16* bp = XB + (size_t)row * DM + 8 * hi;
#pragma unroll 8
                    for (int s = 0; s < 64; ++s) { const bf16x8 a = *(const bf16x8*)(ap + 16 * s), b = *(const bf16x8*)(bp + 16 * s); acc = __builtin_amdgcn_mfma_f32_32x32x16_bf16(a, b, acc, 0, 0, 0); }
#pragma unroll
                    for (int k = 0; k < 4; ++k) { tv[k] = -INFINITY; te[k] = 1 << 20; }
#pragma unroll
                    for (int i = 0; i < 16; ++i) { const int e = (i & 3) + 8 * (i >> 2) + 4 * hi; float v = acc[i] + rb[e]; int ve = e;
#pragma unroll
                        for (int k = 0; k < 4; ++k) { const bool gt = (v > tv[k]) || (v == tv[k] && ve < te[k]); const float nv = gt ? tv[k] : v; const int ne = gt ? te[k] : ve; tv[k] = gt ? v : tv[k]; te[k] = gt ? ve : te[k]; v = nv; ve = ne; } }
                    float pv[4]; int pe[4];
#pragma unroll
                    for (int k = 0; k < 4; ++k) { pv[k] = __shfl_xor(tv[k], 32); pe[k] = __shfl_xor(te[k], 32); }
#pragma unroll
                    for (int j = 0; j < 4; ++j) { float v = pv[j]; int ve = pe[j];
#pragma unroll
                        for (int k = 0; k < 4; ++k) { const bool gt = (v > tv[k]) || (v == tv[k] && ve < te[k]); const float nv = gt ? tv[k] : v; const int ne = gt ? te[k] : ve; tv[k] = gt ? v : tv[k]; te[k] = gt ? ve : te[k]; v = nv; ve = ne; } }
                    float se = 0.f;
#pragma unroll
                    for (int k = 0; k < 4; ++k) { gate[k] = __expf(tv[k] - tv[0]); se += gate[k]; }
                    const float ise = 1.0f / se;
#pragma unroll
                    for (int k = 0; k < 4; ++k) gate[k] *= ise;
                    if (hi == 0) {
#pragma unroll
                        for (int k = 0; k < 4; ++k) lrank[k] = __hip_atomic_fetch_add(lcnt + te[k], 1, __ATOMIC_RELAXED, __HIP_MEMORY_SCOPE_WORKGROUP);
                    }
                }
                __syncthreads();
                if (tid < 32) lbase[tid] = (int)__hip_atomic_fetch_add(gcnt + tid, (unsigned)lcnt[tid], RLX_AGENT);
                __syncthreads();
                if (wave < 4 && hi == 0) {
#pragma unroll
                    for (int k = 0; k < 4; ++k) { const int r = lbase[te[k]] + lrank[k]; const size_t o = (size_t)te[k] * 32768 + r;
                        ROWTOK[o] = row * 4 + k; ROWGATE[o] = gate[k]; TOPE[(size_t)row * 4 + k] = te[k]; TOPG[(size_t)row * 4 + k] = gate[k]; }
                }
                __syncthreads();
            }
        }
        SEAM(pb + 6);
        if (IN(pb + 7) || IN(pb + 8)) {
            LAS int* tstart = (LAS int*)(ldsp + L_TSTART); LAS int* cntL = (LAS int*)(ldsp + L_CNT); LAS int* units = (LAS int*)(ldsp + L_UNITS); LAS int* unitsn = (LAS int*)(ldsp + L_UNITSN);
            if (tid == 0) { int acc = 0; for (int e = 0; e < 32; ++e) { const int c = (int)__hip_atomic_load(gcnt + e, RLX_AGENT); cntL[e] = c; tstart[e] = acc; acc += (c + 255) >> 8; } tstart[32] = acc; }
            __syncthreads();
            if (IN(pb + 7)) {
                pg8::moe_build_units(units, unitsn, tstart, 8, G, bid, tid);
                __syncthreads();
                pg8::Gemm g{(const pg8::bf16_t*)XB8, (const pg8::bf16_t*)WGUl, 0, 2048, DM / 2};
                pg8::MoeOrder S{units, __builtin_amdgcn_readfirstlane(unitsn[0]), cntL, ROWTOK, 1, (unsigned)DM, (size_t)2048 * DM};
                pg8::EpiSwiglu E{H8, in_bgu + (size_t)layer * NEXP * 2048, ROWGATE, cntL, 1.0f / (SC_X * SC_WGU), SC_H};
                pg8::gemm_phase<pg8::EpiSwiglu, pg8::MoeOrder, true, true, true>(ldsp + RING_OFF, g, S, E);
                __syncthreads();
            }
            SEAM(pb + 7);
            if (IN(pb + 8)) {
                pg8::moe_build_units(units, unitsn, tstart, 4, G, bid, tid);
                __syncthreads();
                pg8::Gemm g{(const pg8::bf16_t*)H8, (const pg8::bf16_t*)WDNl, 0, DM, FF / 2};
                pg8::MoeOrder S{units, __builtin_amdgcn_readfirstlane(unitsn[0]), cntL, ROWTOK, 0, (unsigned)FF, (size_t)DM * FF};
                pg8::EpiScatter E{YB, ROWTOK, cntL, 1.0f / (SC_H * SC_WDN)};
                pg8::gemm_phase<pg8::EpiScatter, pg8::MoeOrder, true, false, true>(ldsp + RING_OFF, g, S, E);
                __syncthreads();
            }
        }
        SEAM(pb + 8);
        if (IN(pb + 9)) {
            const float* gam = in_ln2g + (size_t)layer * DM; const float* bet = in_ln2b + (size_t)layer * DM; const float* bdn = in_bdn + (size_t)layer * NEXP * DM;
            float* dstf = (layer == NLAYER - 1) ? args.out : XF2;
            for (int m = gw; m < MROWS; m += NGW) { f32x4 v[4];
#pragma unroll
                for (int j = 0; j < 4; ++j) v[j] = *(const f32x4*)(XF + (size_t)m * DM + 4 * lane + 256 * j) * ALPHA;
#pragma unroll
                for (int k = 0; k < 4; ++k) { const int e = TOPE[(size_t)m * 4 + k]; const float gk = TOPG[(size_t)m * 4 + k]; const bf16* yr = YB + ((size_t)m * 4 + k) * DM; const float* br = bdn + (size_t)e * DM;
#pragma unroll
                    for (int j = 0; j < 4; ++j) { const v2u w = *(const v2u*)(yr + 4 * lane + 256 * j); const f32x4 b = *(const f32x4*)(br + 4 * lane + 256 * j);
                        v[j][0] += bflo(w.x) + gk * b[0]; v[j][1] += bfhi(w.x) + gk * b[1]; v[j][2] += bflo(w.y) + gk * b[2]; v[j][3] += bfhi(w.y) + gk * b[3]; } }
                ln_row<false>(v, gam, bet, dstf + (size_t)m * DM, XB + (size_t)m * DM, nullptr, 1.f, lane);
                if (layer + 1 < NLAYER) row_dt(v, WDT + (size_t)(layer + 1) * 8 * 1024, DT + (size_t)m * 8, lane); }
        }
        SEAM(pb + 9);
    #undef IN
#undef SEAM
}

__global__ void __launch_bounds__(NWAVES * 64, 2) mk_fwd(Args args) {
    extern __shared__ __attribute__((aligned(16))) unsigned char lds[];
    LAS unsigned char* ldsp = (LAS unsigned char*)lds;
    const int tid = threadIdx.x, lane = tid & 63, wave = __builtin_amdgcn_readfirstlane(tid >> 6);
    const int G = gridDim.x, bid = blockIdx.x;
    const int gw = bid * NWAVES + wave, NGW = G * NWAVES;
    gu32* ctl = (gu32*)(args.ws + WS_CTL);

    for (int u = tid; u < (LDS_BYTES - LDSCTL_OFF) / 4; u += NWAVES * 64) ((LAS unsigned*)(ldsp + LDSCTL_OFF))[u] = 0u;
    __syncthreads();
    XcdBarrier bar = xcd_barrier_post((unsigned*)(ctl + CW_BAR), (volatile LAS unsigned*)(ldsp + L_MISC) + 8);

    const int lo = args.ph_lo, hi = args.ph_hi;
#define IN(k) (lo <= (k) && (k) < hi)
#define SEAM(k) do { if (IN(k) && IN((k) + 1)) xcd_barrier(bar); } while (0)

    if (IN(0)) {
        for (int it = bid * (NWAVES * 64) + tid; it < (int)(4096 * 32); it += G * (NWAVES * 64)) { const int t = (int)(it >> 5), i = (int)(it & 31);
            const float inv = powf(10000.0f, -(float)i / 32.0f); const float ang = (float)t * inv; float sn, cs; sincosf(ang, &sn, &cs);
            ROPE[2 * it] = cs; ROPE[2 * it + 1] = sn; }
        LAS float* scr = (LAS float*)(ldsp + RING_OFF + wave * 16384);
        constexpr int I_IN = 16 * 145, I_OUT = 24 * 32, I_GU = 16 * 64, I_DN = 16 * 32, I_R = 16;
        constexpr int NIT = NLAYER * (I_IN + I_OUT + I_R) + NLAYER * NEXP * (I_GU + I_DN);
        for (int it = gw; it < NIT; it += NGW) {
            int r = it;
            if (r < NLAYER * I_IN) { const int l = r / I_IN; r %= I_IN; p0_transpose_item<1>(in_win + (size_t)l * DM * INW, DM, INW, WIN + (size_t)l * NPROJ * DM, WDT + (size_t)l * 8 * 1024, scr, r / 145, r % 145, lane); continue; } r -= NLAYER * I_IN;
            if (r < NLAYER * I_OUT) { const int l = r / I_OUT; r %= I_OUT; p0_transpose_item<0>(in_wout + (size_t)l * MIXW * DM, MIXW, DM, WOUT + (size_t)l * DM * MIXW, nullptr, scr, r / 32, r % 32, lane); continue; } r -= NLAYER * I_OUT;
            if (r < NLAYER * I_R) { const int l = r / I_R; r %= I_R; p0_transpose_item<0>(in_rw + (size_t)l * DM * NEXP, DM, NEXP, ROUT + (size_t)l * NEXP * DM, nullptr, scr, r, 0, lane); continue; } r -= NLAYER * I_R;
            if (r < NLAYER * NEXP * I_GU) { const int le = r / I_GU; r %= I_GU; p0_transpose_item8<2>(in_wgu + (size_t)le * DM * 2048, DM, 2048, WGU8 + (size_t)le * 2048 * DM, SC_WGU, scr, r / 64, r % 64, lane); continue; } r -= NLAYER * NEXP * I_GU;
            { const int le = r / I_DN; r %= I_DN; p0_transpose_item8<0>(in_wdn + (size_t)le * FF * DM, FF, DM, WDN8 + (size_t)le * DM * FF, SC_WDN, scr, r / 32, r % 32, lane); }
        }
        __syncthreads();
    }
    if (IN(0)) {
        for (int m = gw; m < MROWS; m += NGW) { const float* xr = in_x + (size_t)m * DM; bf16* ob = XB + (size_t)m * DM;
#pragma unroll
            for (int j = 0; j < 4; ++j) { const f32x4 v = *(const f32x4*)(xr + 4 * lane + 256 * j); v2u w; w.x = pk2(v[0], v[1]); w.y = pk2(v[2], v[3]); *(v2u*)(ob + 4 * lane + 256 * j) = w; } }
    }

    SEAM(0);
    run_layer<0>(args, lo, hi, bar);
    run_layer<1>(args, lo, hi, bar);
#undef IN
#undef SEAM
}

extern "C" void kernel_launch(void* const* d_in, const int* in_sizes, int n_in, void* d_out, int out_size, void* d_ws, size_t ws_size, hipStream_t stream) {
    static int grid = 0;
    if (grid == 0) {
        if (n_in != 20 || out_size != MROWS * DM || ws_size < WS_END) { fprintf(stderr, "kernel_launch: unexpected problem (n_in %d, out %d, ws %zu)\n", n_in, out_size, ws_size); grid = -1; return; }
        if (hipFuncSetAttribute((const void*)mk_fwd, hipFuncAttributeMaxDynamicSharedMemorySize, LDS_BYTES) != hipSuccess) { fprintf(stderr, "kernel_launch: hipFuncSetAttribute failed\n"); grid = -1; return; }
        int dev = 0, cus = 0, per_cu = 0;
        (void)hipGetDevice(&dev); (void)hipDeviceGetAttribute(&cus, hipDeviceAttributeMultiprocessorCount, dev);
        if (hipOccupancyMaxActiveBlocksPerMultiprocessor(&per_cu, (const void*)mk_fwd, NWAVES * 64, LDS_BYTES) != hipSuccess || per_cu < 1) fprintf(stderr, "kernel_launch: occupancy query says %d\n", per_cu);
        (void)hipGetLastError();
        grid = cus > 0 ? cus : 256;
    }
    if (grid < 0) return;
    (void)hipMemsetAsync((char*)d_ws + WS_CTL, 0, CTL_ZERO_BYTES, stream);
    Args a{};
    for (int i = 0; i < 20; ++i) a.in[i] = (const float*)d_in[i];
    a.out = (float*)d_out; a.ws = (unsigned char*)d_ws;
    a.ph_lo = 0; a.ph_hi = N_PHASES; a.sub = 7; a.pad = 0;
    hipLaunchKernelGGL(mk_fwd, dim3(grid), dim3(NWAVES * 64), LDS_BYTES, stream, a);
#ifdef PROBE_PH
#ifndef PROBE_SUB
#define PROBE_SUB 7
#endif
    for (int i = 0; i < PROBE_N; ++i) { a.ph_lo = PROBE_PH; a.ph_hi = PROBE_PH + 1; a.sub = PROBE_SUB; hipLaunchKernelGGL(mk_fwd, dim3(grid), dim3(NWAVES * 64), LDS_BYTES, stream, a); }
#endif
}
```

```cpp
#include <hip/hip_runtime.h>
#include <cstdio>
#include <cstdint>
#include <cmath>

namespace pg8 {
#define PG8_LAS __attribute__((address_space(3)))
typedef unsigned short bf16_t;
typedef short bf16x8 __attribute__((ext_vector_type(8)));
typedef float f32x4 __attribute__((ext_vector_type(4)));
typedef float f32x2 __attribute__((ext_vector_type(2)));
typedef unsigned u32x4 __attribute__((ext_vector_type(4)));
constexpr int BM = 256, BK = 64, HALF = 128, HTB = HALF * BK * 2  , STAGE_BYTES = 8 * HTB, NXCD = 8, WGM = 8;

__host__ __device__ __forceinline__ int lds_byte(int r, int c) { const int st = (r >> 4) * 2 + (c >> 5), rr = r & 15, cc = c & 31, ob = rr * 64 + cc * 2; return st * 1024 + (ob ^ (((ob >> 9) & 1) << 5)); }
__host__ __device__ __forceinline__ void stage_rc(int b, int& R, int& C) { const int st = b / 1024, sb = b % 1024, swz = sb ^ (((sb >> 9) & 1) << 5); R = (st >> 1) * 16 + swz / 64; C = (st & 1) * 32 + (swz % 64) / 2; }
__host__ __device__ __forceinline__ int perm32(int rho) { const int n = rho >> 4, i = rho & 15; return 8 * (i >> 2) + 4 * n + (i & 3); }

struct Unit { int pm, pn, e, r0; };
struct Gemm { const bf16_t* A; const bf16_t* Bt; int M, N, K; };

struct StaticOrder {
    int nM, nN, nwg, G, c;
    __device__ void init(int M, int N, int G_, int c_) { nM = M / BM; nN = N / BM; nwg = nM * nN; G = G_; c = c_; }
    __device__ __forceinline__ bool next(int i, Unit& u) const {
        const long L = (long)i * G + c; if (L >= nwg) return false;
        int wgid = (int)L; { const int q = nwg / NXCD, r = nwg % NXCD, xcd = wgid % NXCD, off = wgid / NXCD; wgid = (xcd < r ? xcd * (q + 1) : r * (q + 1) + (xcd - r) * q) + off; }
        const int nig = WGM * nN, gid = wgid / nig, fm = gid * WGM, gsz = (nM - fm) < WGM ? (nM - fm) : WGM;
        u.pm = fm + ((wgid % nig) % gsz); u.pn = (wgid % nig) / gsz; u.e = 0; u.r0 = 0; return true;
    }
    __device__ __forceinline__ const char* abase(const Unit& u, const Gemm& g, size_t tstep) const { return (const char*)g.A + (size_t)u.pm * tstep; }
    __device__ __forceinline__ const char* bbase(const Unit& u, const Gemm& g, size_t tstep) const { return (const char*)g.Bt + (size_t)u.pn * tstep; }
    __device__ __forceinline__ unsigned arow(const Unit&, int) const { return 0u; }
    __device__ __forceinline__ void a_ready(const Unit&) const {}
    __device__ __forceinline__ void done(const Unit&) const {}
};

struct MoeOrder {
    const PG8_LAS int* units;
    int nunits;
    const PG8_LAS int* cnt;
    const int* rowtok;
    int gather;
    unsigned rowbytes;
    size_t bstride;
    __device__ __forceinline__ bool next(int i, Unit& u) const {
        if (i >= nunits) return false;
        u.pm = __builtin_amdgcn_readfirstlane(units[4 * i + 0]); u.pn = __builtin_amdgcn_readfirstlane(units[4 * i + 1]);
        u.e = __builtin_amdgcn_readfirstlane(units[4 * i + 2]); u.r0 = __builtin_amdgcn_readfirstlane(units[4 * i + 3]); return true;
    }
    __device__ __forceinline__ const char* abase(const Unit& u, const Gemm& g, size_t tstep) const { return gather ? (const char*)g.A : (const char*)g.A + (size_t)u.pm * tstep; }
    __device__ __forceinline__ const char* bbase(const Unit& u, const Gemm& g, size_t tstep) const { return (const char*)g.Bt + (size_t)u.e * bstride + (size_t)u.pn * tstep; }
    __device__ __forceinline__ unsigned arow(const Unit& u, int R) const {
        const int r = u.r0 + R; const int idx = (r < cnt[u.e]) ? rowtok[(size_t)u.e * 32768 + r] : 0; return (unsigned)(idx >> 2) * rowbytes; }
    __device__ __forceinline__ void a_ready(const Unit&) const {}
    __device__ __forceinline__ void done(const Unit&) const {}
};
__device__ __forceinline__ void moe_build_units(PG8_LAS int* units, PG8_LAS int* units_n, const PG8_LAS int* tstart, int nN, int G, int c, int tid) {
    if (tid < 64) {
        const int nT = tstart[32], nwg = nT * nN; const long L = (long)tid * G + c;
        int pm = 0, pn = 0, e = 0, r0 = 0;
        if (L < nwg) {
            int wgid = (int)L; { const int q = nwg / NXCD, r = nwg % NXCD, xcd = wgid % NXCD, off = wgid / NXCD; wgid = (xcd < r ? xcd * (q + 1) : r * (q + 1) + (xcd - r) * q) + off; }
            const int nig = WGM * nN, gid = wgid / nig, fm = gid * WGM, gsz = (nT - fm) < WGM ? (nT - fm) : WGM;
            pm = fm + ((wgid % nig) % gsz); pn = (wgid % nig) / gsz;
            for (int j = 1; j < 32; ++j) e += (tstart[j] <= pm) ? 1 : 0;
            r0 = (pm - tstart[e]) * 256;
        }
        units[4 * tid + 0] = pm; units[4 * tid + 1] = pn; units[4 * tid + 2] = e; units[4 * tid + 3] = r0;
        if (tid == 0) { int n = 0; if (c < nwg) n = (nwg - c + G - 1) / G; units_n[0] = n < 64 ? n : 64; }
    }
}

typedef int v8i_t __attribute__((ext_vector_type(8)));
typedef int v4i_t __attribute__((ext_vector_type(4)));
__device__ __forceinline__ v8i_t cat8(bf16x8 lo, bf16x8 hi) { const v4i_t a = __builtin_bit_cast(v4i_t, lo), b = __builtin_bit_cast(v4i_t, hi); return __builtin_shufflevector(a, b, 0, 1, 2, 3, 4, 5, 6, 7); }
__device__ __forceinline__ void mfma8(f32x4& acc, v8i_t a, v8i_t b, int scl) { asm volatile("v_mfma_scale_f32_16x16x128_f8f6f4 %0, %1, %2, %0, %3, %3 op_sel_hi:[0,0,0]" : "+v"(acc) : "v"(a), "v"(b), "v"(scl)); }
__device__ __forceinline__ unsigned pk4_fp8(float a, float b, float c, float d) { unsigned w = 0u; w = __builtin_amdgcn_cvt_pk_fp8_f32(a, b, w, false); w = __builtin_amdgcn_cvt_pk_fp8_f32(c, d, w, true); return w; }
__device__ __forceinline__ unsigned cvt_pk_bf16(float lo, float hi) { unsigned r; asm volatile("v_cvt_pk_bf16_f32 %0, %1, %2" : "=v"(r) : "v"(lo), "v"(hi)); return r; }

struct EpiProj {
    static constexpr bool PERM = true, AFTER_DRAIN = false;
    bf16_t* O; int ldc; const float* rope; float qscale;
    __device__ __forceinline__ void operator()(const f32x4 (&acc)[2][2][4][2], const Unit& u, int wr, int wc, int fr, int fq) const {
        const int row0 = u.pm * BM + wr * 64 + fr; const int col0 = u.pn * BM + wc * 32 + 8 * fq;
        const bool rot = u.pn < 4; const float sc = u.pn < 2 ? qscale : 1.f; const int gq = 4 * (wc & 1) + fq;
#pragma unroll
        for (int ai = 0; ai < 2; ++ai)
#pragma unroll
            for (int m = 0; m < 4; ++m) { const int row = row0 + ai * HALF + m * 16; bf16_t* rowp = O + (size_t)row * ldc + col0;
                f32x4 cs0 = (f32x4){1.f, 0.f, 1.f, 0.f}, cs1 = cs0;
                if (rot) { const float* rp = rope + ((size_t)(row & 4095) * 32 + 4 * gq) * 2; cs0 = *(const f32x4*)rp; cs1 = *(const f32x4*)(rp + 4); }
#pragma unroll
                for (int bj = 0; bj < 2; ++bj) { f32x4 v0 = acc[ai][bj][m][0], v1 = acc[ai][bj][m][1];
                    if (rot) { f32x4 lo, hi;
                        lo[0] = v0[0] * cs0[0] - v1[0] * cs0[1]; hi[0] = v1[0] * cs0[0] + v0[0] * cs0[1];
                        lo[1] = v0[1] * cs0[2] - v1[1] * cs0[3]; hi[1] = v1[1] * cs0[2] + v0[1] * cs0[3];
                        lo[2] = v0[2] * cs1[0] - v1[2] * cs1[1]; hi[2] = v1[2] * cs1[0] + v0[2] * cs1[1];
                        lo[3] = v0[3] * cs1[2] - v1[3] * cs1[3]; hi[3] = v1[3] * cs1[2] + v0[3] * cs1[3];
                        v0 = lo * sc; v1 = hi * sc; }
                    u32x4 w; w.x = cvt_pk_bf16(v0[0], v0[1]); w.y = cvt_pk_bf16(v0[2], v0[3]); w.z = cvt_pk_bf16(v1[0], v1[1]); w.w = cvt_pk_bf16(v1[2], v1[3]);
                    *(u32x4*)(rowp + bj * HALF) = w; } }
    }
};
struct EpiF32 {
    static constexpr bool PERM = false, AFTER_DRAIN = false;
    float* O; int ldc;
    __device__ __forceinline__ void operator()(const f32x4 (&acc)[2][2][4][2], const Unit& u, int wr, int wc, int fr, int fq) const {
        const int row0 = u.pm * BM + wr * 64 + fr; const int col0 = u.pn * BM + wc * 32 + 4 * fq;
#pragma unroll
        for (int ai = 0; ai < 2; ++ai)
#pragma unroll
            for (int m = 0; m < 4; ++m) { float* rowp = O + (size_t)(row0 + ai * HALF + m * 16) * ldc + col0;
#pragma unroll
                for (int bj = 0; bj < 2; ++bj)
#pragma unroll
                    for (int n = 0; n < 2; ++n) *(f32x4*)(rowp + bj * HALF + n * 16) = acc[ai][bj][m][n]; }
    }
};
struct EpiSwiglu {
    static constexpr bool PERM = true, AFTER_DRAIN = false;
    unsigned char* H; const float* bgu; const float* rowgate; const PG8_LAS int* cnt; float dq, hscale;
    __device__ __forceinline__ void operator()(const f32x4 (&acc)[2][2][4][2], const Unit& u, int wr, int wc, int fr, int fq) const {
        const int ff = u.pn * HALF + wc * 32 + 8 * fq; const int n_e = cnt[u.e];
        f32x4 bg[2], bu[2];
#pragma unroll
        for (int n = 0; n < 2; ++n) { bg[n] = *(const f32x4*)(bgu + (size_t)u.e * 2048 + ff + 4 * n); bu[n] = *(const f32x4*)(bgu + (size_t)u.e * 2048 + 1024 + ff + 4 * n); }
#pragma unroll
        for (int ai = 0; ai < 2; ++ai)
#pragma unroll
            for (int m = 0; m < 4; ++m) { const int r = ai * HALF + wr * 64 + m * 16 + fr; const int er = u.r0 + r;
                const float rg = ((er < n_e) ? rowgate[(size_t)u.e * 32768 + er] : 0.f) * hscale;
                float hv[8];
#pragma unroll
                for (int n = 0; n < 2; ++n)
#pragma unroll
                    for (int q = 0; q < 4; ++q) { float g = acc[ai][0][m][n][q] * dq + bg[n][q], up = acc[ai][1][m][n][q] * dq + bu[n][q];
                        g = fminf(g, 7.0f); up = fminf(fmaxf(up, -7.0f), 7.0f);
                        const float sg = __builtin_amdgcn_rcpf(1.0f + __builtin_amdgcn_exp2f(-1.702f * 1.4426950408889634f * g));
                        hv[n * 4 + q] = (up + 1.0f) * g * sg * rg; }
                u32x4 dummy; (void)dummy;
                unsigned w0 = pk4_fp8(hv[0], hv[1], hv[2], hv[3]), w1 = pk4_fp8(hv[4], hv[5], hv[6], hv[7]);
                typedef unsigned u32x2 __attribute__((ext_vector_type(2)));
                *(u32x2*)(H + (size_t)(u.pm * BM + r) * 1024 + ff) = (u32x2){w0, w1};
                asm volatile("" ::: "memory"); }
    }
};
struct EpiScatter {
    static constexpr bool PERM = true, AFTER_DRAIN = false;
    bf16_t* Y; const int* rowtok; const PG8_LAS int* cnt; float dq;
    __device__ __forceinline__ void operator()(const f32x4 (&acc)[2][2][4][2], const Unit& u, int wr, int wc, int fr, int fq) const {
        const int col0 = u.pn * BM + wc * 32 + 8 * fq; const int n_e = cnt[u.e];
#pragma unroll
        for (int ai = 0; ai < 2; ++ai)
#pragma unroll
            for (int m = 0; m < 4; ++m) { const int er = u.r0 + ai * HALF + wr * 64 + m * 16 + fr;
                if (er < n_e) { const int idx = rowtok[(size_t)u.e * 32768 + er]; bf16_t* rowp = Y + (size_t)idx * 1024 + col0;
#pragma unroll
                    for (int bj = 0; bj < 2; ++bj) { const f32x4 v0 = acc[ai][bj][m][0] * dq, v1 = acc[ai][bj][m][1] * dq;
                        u32x4 w; w.x = cvt_pk_bf16(v0[0], v0[1]); w.y = cvt_pk_bf16(v0[2], v0[3]); w.z = cvt_pk_bf16(v1[0], v1[1]); w.w = cvt_pk_bf16(v1[2], v1[3]);
                        *(u32x4*)(rowp + bj * HALF) = w; } }
                asm volatile("" ::: "memory"); }
    }
};

template <class Epi, class Sched, bool ALIGN_EPI, bool GATHER, bool FP8 = false>
__device__ __forceinline__ void gemm_phase(PG8_LAS unsigned char* lds, const Gemm g, const Sched& S, const Epi& E) {
    const int tid = threadIdx.x, wid = __builtin_amdgcn_readfirstlane(tid >> 6), lane = tid & 63, wr = wid >> 2, wc = wid & 3, fr = lane & 15, fq = lane >> 4;
    const int K = g.K, nt = K / BK;
    unsigned voffB[2];
#pragma unroll
    for (int i = 0; i < 2; ++i) { int R, C; stage_rc(tid * 16 + i * 8192, R, C); const int Rb = Epi::PERM ? ((R & ~31) + perm32(R & 31)) : R;
        voffB[i] = (unsigned)(Rb * K + C) * 2u; }
    PG8_LAS u32x4* const nslot = (PG8_LAS u32x4*)(lds + STAGE_BYTES) + tid;
    const size_t kstep = (size_t)(BK * 2);
    const size_t hstep = (size_t)HALF * K * 2;
    const size_t tstep = 2 * hstep;
    const unsigned ldsw = (unsigned)wid * 1024u;
    const int aoff = lds_byte(wr * 64 + fr, fq * 8), boff = lds_byte(wc * 32 + fr, fq * 8);
#define PG8_SA(b, h) (((b) * 2 + (h)) * HTB)
#define PG8_SB(b, h) ((4 + (b) * 2 + (h)) * HTB)
#define PG8_STAGE(bufoff, gbase, voff) do { _Pragma("unroll") for (int _i = 0; _i < 2; ++_i) \
        __builtin_amdgcn_global_load_lds((const unsigned*)((const char*)(gbase) + (voff)[_i]), (PG8_LAS unsigned*)(lds + (bufoff) + ldsw + _i * 8192), 16, 0, 0); } while (0)
#define PG8_LDA(dst, b, h) do { _Pragma("unroll") for (int m = 0; m < 4; ++m) _Pragma("unroll") for (int k = 0; k < 2; ++k) dst[m][k] = *(const PG8_LAS bf16x8*)(lds + PG8_SA(b, h) + aoff + m * 2048 + k * 1024); } while (0)
#define PG8_LDB(dst, b, h) do { _Pragma("unroll") for (int n = 0; n < 2; ++n) _Pragma("unroll") for (int k = 0; k < 2; ++k) dst[n][k] = *(const PG8_LAS bf16x8*)(lds + PG8_SB(b, h) + boff + n * 2048 + k * 1024); } while (0)
#define PG8_MMA(ai, bj, At, Bt) do { __builtin_amdgcn_s_setprio(1); _Pragma("unroll") for (int m = 0; m < 4; ++m) _Pragma("unroll") for (int n = 0; n < 2; ++n) { \
        if constexpr (FP8) mfma8(acc[ai][bj][m][n], cat8(Bt[n][0], Bt[n][1]), cat8(At[m][0], At[m][1]), scl8); \
        else { _Pragma("unroll") for (int k = 0; k < 2; ++k) acc[ai][bj][m][n] = __builtin_amdgcn_mfma_f32_16x16x32_bf16(Bt[n][k], At[m][k], acc[ai][bj][m][n], 0, 0, 0); } } __builtin_amdgcn_s_setprio(0); } while (0)
#define PG8_WAIT_V(n) asm volatile("s_waitcnt vmcnt(" #n ")" ::: "memory")
#define PG8_WAIT_L(n) asm volatile("s_waitcnt lgkmcnt(" #n ")" ::: "memory")
#define PG8_BAR __builtin_amdgcn_s_barrier()
#define PG8_SCHED __builtin_amdgcn_sched_barrier(0)
#define PG8_SETOFFS(o, u) do { _Pragma("unroll") for (int _h = 0; _h < 2; ++_h) _Pragma("unroll") for (int _i = 0; _i < 2; ++_i) { int _R, _C; stage_rc(tid * 16 + _i * 8192, _R, _C); \
        o[_h][_i] = GATHER ? (S.arow(u, _R + HALF * _h) + (unsigned)(_C * 2)) : ((unsigned)((_R + HALF * _h) * K) * 2u + (unsigned)(_C * 2)); } } while (0)
    int scl8 = 0x7F7F7F7F; asm volatile("" : "+v"(scl8));
    Unit cur, nxt; int ui = 0;
    if (!S.next(0, cur)) return;
    f32x4 acc[2][2][4][2];
#pragma unroll
    for (int a = 0; a < 2; ++a)
#pragma unroll
        for (int b = 0; b < 2; ++b)
#pragma unroll
            for (int m = 0; m < 4; ++m)
#pragma unroll
                for (int n = 0; n < 2; ++n) { acc[a][b][m][n] = (f32x4){0.f, 0.f, 0.f, 0.f}; if constexpr (FP8) asm volatile("" : "+v"(acc[a][b][m][n])); }
    bf16x8 At[4][2], B0[2][2], B1[2][2];
    unsigned cAo[2][2];
    PG8_SETOFFS(cAo, cur);
    const char* cA = S.abase(cur, g, tstep); const char* cB = S.bbase(cur, g, tstep);
    S.a_ready(cur);
    PG8_STAGE(PG8_SB(0, 0), cB, voffB); PG8_STAGE(PG8_SB(0, 1), cB + hstep, voffB); PG8_STAGE(PG8_SA(0, 0), cA, cAo[0]); PG8_STAGE(PG8_SA(0, 1), cA, cAo[1]);
    if (wr == 1) PG8_BAR;
    PG8_WAIT_V(2); PG8_BAR;
    PG8_STAGE(PG8_SB(1, 0), cB + kstep, voffB); PG8_STAGE(PG8_SA(1, 0), cA + kstep, cAo[0]); PG8_STAGE(PG8_SB(1, 1), cB + hstep + kstep, voffB);
    PG8_WAIT_V(6); PG8_BAR;
    for (;;) {
        const bool has_next = S.next(ui + 1, nxt);
        const char* nA = has_next ? S.abase(nxt, g, tstep) : cA; const char* nB = has_next ? S.bbase(nxt, g, tstep) : cB;
        if constexpr (GATHER) { if (has_next) { unsigned no[2][2]; PG8_SETOFFS(no, nxt); *nslot = (u32x4){no[0][0], no[0][1], no[1][0], no[1][1]}; } }
#pragma unroll 1
        for (int t = 0; t < nt; t += 2) {
            const bool last = (t == nt - 2);
            const char* a1 = cA + (size_t)(t + 1) * kstep;
            const char* a2 = last ? nA : cA + (size_t)(t + 2) * kstep; const char* b2 = last ? nB : cB + (size_t)(t + 2) * kstep;
            const char* a3 = a2 + kstep; const char* b3 = b2 + kstep;
            if (last && has_next) S.a_ready(nxt);
            PG8_LDB(B0, 0, 0); PG8_LDB(B1, 0, 1); PG8_SCHED; PG8_LDA(At, 0, 0); PG8_STAGE(PG8_SA(1, 1), a1, cAo[1]);
            if constexpr (GATHER) { if (last && has_next) { const u32x4 no = *nslot; cAo[0][0] = no.x; cAo[0][1] = no.y; cAo[1][0] = no.z; cAo[1][1] = no.w; } }
            PG8_WAIT_V(8); PG8_WAIT_L(0); PG8_BAR; PG8_MMA(0, 0, At, B0); PG8_MMA(0, 1, At, B1); PG8_BAR; PG8_SCHED;
            PG8_LDA(At, 0, 1); PG8_STAGE(PG8_SB(0, 0), b2, voffB); PG8_STAGE(PG8_SB(0, 1), b2 + hstep, voffB); PG8_STAGE(PG8_SA(0, 0), a2, cAo[0]);
            PG8_WAIT_V(8); PG8_WAIT_L(0); PG8_BAR; PG8_MMA(1, 0, At, B0); PG8_MMA(1, 1, At, B1); PG8_BAR; PG8_SCHED;
            PG8_LDB(B0, 1, 0); PG8_LDB(B1, 1, 1); PG8_SCHED; PG8_LDA(At, 1, 0); PG8_STAGE(PG8_SA(0, 1), a2, cAo[1]);
            PG8_WAIT_V(8); PG8_WAIT_L(0); PG8_BAR; PG8_MMA(0, 0, At, B0); PG8_MMA(0, 1, At, B1); PG8_BAR; PG8_SCHED;
            PG8_LDA(At, 1, 1); PG8_STAGE(PG8_SB(1, 0), b3, voffB); PG8_STAGE(PG8_SB(1, 1), b3 + hstep, voffB); PG8_STAGE(PG8_SA(1, 0), a3, cAo[0]);
            PG8_WAIT_V(8); PG8_WAIT_L(0); PG8_BAR; PG8_MMA(1, 0, At, B0); PG8_MMA(1, 1, At, B1); PG8_BAR; PG8_SCHED;
        }
        if constexpr (ALIGN_EPI) { if (wr == 0) PG8_BAR; }
        if constexpr (FP8) asm volatile("s_nop 15\n\ts_nop 15" ::: "memory");
        PG8_SCHED; E(acc, cur, wr, wc, fr, fq); S.done(cur); PG8_SCHED;
        if (!has_next) break;
#pragma unroll
        for (int a = 0; a < 2; ++a)
#pragma unroll
            for (int b = 0; b < 2; ++b)
#pragma unroll
                for (int m = 0; m < 4; ++m)
#pragma unroll
                    for (int n = 0; n < 2; ++n) { acc[a][b][m][n] = (f32x4){0.f, 0.f, 0.f, 0.f}; if constexpr (FP8) asm volatile("" : "+v"(acc[a][b][m][n])); }
        cur = nxt; cA = nA; cB = nB; ++ui;
        if constexpr (ALIGN_EPI) { if (wr == 1) PG8_BAR; }
    }
    PG8_WAIT_V(0);
    if constexpr (!ALIGN_EPI) { if (wr == 0) PG8_BAR; }
    PG8_BAR;
#undef PG8_SA
#undef PG8_SB
#undef PG8_STAGE
#undef PG8_LDA
#undef PG8_LDB
#undef PG8_MMA
#undef PG8_WAIT_V
#undef PG8_WAIT_L
#undef PG8_BAR
#undef PG8_SCHED
#undef PG8_SETOFFS
}
}

constexpr int NB = 8, SEQ = 4096, DM = 1024, MROWS = NB * SEQ, NLAYER = 2;
constexpr int NPROJ = 4608, INW = 4616;
constexpr int C_Q = 0, C_K = 512, C_V = 1024, C_Z = 1536, C_XS = 2048, C_SB = 3072, C_SC = 3584, C_SH = 4096;
constexpr int MIXW = 1536, NEXP = 32, TOPK = 4, FF = 1024;
constexpr float ALPHA = 1.4142135623730951f;
constexpr float LN_EPS = 1e-5f, RMS_EPS = 1e-5f;
constexpr float QSCALE = 0.125f * 1.4426950408889634f;

constexpr size_t MiB = 1u << 20;
constexpr size_t WS_CTL = 0, CTL_ZERO_BYTES = 1 * MiB;
constexpr size_t WS_ROPE = 1 * MiB;
constexpr size_t WS_WDT = 2 * MiB;
constexpr size_t WS_ROUT = 2 * MiB + 65536;
constexpr size_t WS_WIN = 4 * MiB;
constexpr size_t WS_WOUT = 24 * MiB;
constexpr size_t WS_WGU = 32 * MiB;
constexpr size_t WS_WDN = 288 * MiB;
constexpr size_t WS_XB = 416 * MiB;
constexpr size_t WS_XF = 480 * MiB;
constexpr size_t WS_XF2 = 608 * MiB;
constexpr size_t WS_PROJ = 736 * MiB;
constexpr size_t WS_DT = 1024 * MiB;
constexpr size_t WS_DTS = 1025 * MiB;
constexpr size_t WS_ACUM = 1026 * MiB;
constexpr size_t WS_LSE = 1027 * MiB;
constexpr size_t WS_OP = 1030 * MiB;
constexpr size_t WS_U = 1126 * MiB;
constexpr size_t WS_G = 1190 * MiB;
constexpr size_t WS_ST = 1222 * MiB;
constexpr size_t WS_YD = 1286 * MiB;
constexpr size_t WS_MIXED = 1350 * MiB;
constexpr size_t WS_MIXF = 1446 * MiB;
constexpr size_t WS_TOPE = 1574 * MiB;
constexpr size_t WS_TOPG = 1575 * MiB;
constexpr size_t WS_ROWTOK = 1576 * MiB;
constexpr size_t WS_ROWGATE = 1580 * MiB;
constexpr size_t WS_H = 736 * MiB;
constexpr size_t WS_YB = 1030 * MiB;
constexpr size_t WS_END = 1584 * MiB;
constexpr int CW_TMO = 0;
constexpr int CW_CNT = 64;
constexpr int CW_BAR = 4096;

constexpr int RING_OFF = 0, RING_BYTES = 131072;
constexpr int LDSCTL_OFF = 155648;
constexpr int L_MISC = LDSCTL_OFF;
constexpr int L_TSTART = LDSCTL_OFF + 256;
constexpr int L_CNT = LDSCTL_OFF + 512;
constexpr int L_LCNT = LDSCTL_OFF + 640;
constexpr int L_LBASE = LDSCTL_OFF + 768;
constexpr int L_UNITS = LDSCTL_OFF + 1024;
constexpr int L_UNITSN = LDSCTL_OFF + 2048;
constexpr int LDS_BYTES = 163840;

#define GAS __attribute__((address_space(1)))
#define LAS __attribute__((address_space(3)))
typedef unsigned short bf16;
typedef unsigned v4u __attribute__((ext_vector_type(4)));
typedef unsigned v2u __attribute__((ext_vector_type(2)));
typedef float f32x4 __attribute__((ext_vector_type(4)));
typedef float f32x16 __attribute__((ext_vector_type(16)));
typedef short bf16x8 __attribute__((ext_vector_type(8)));
typedef GAS unsigned gu32;
#define RLX_AGENT __ATOMIC_RELAXED, __HIP_MEMORY_SCOPE_AGENT
#define LDS_WAIT() asm volatile("s_waitcnt lgkmcnt(0)" ::: "memory")
#define VM_WAIT() asm volatile("s_waitcnt vmcnt(0)" ::: "memory")
__device__ __forceinline__ unsigned f2bf(float f) { unsigned u = __builtin_bit_cast(unsigned, f); return (u + 0x7fffu + ((u >> 16) & 1u)) >> 16; }
__device__ __forceinline__ unsigned pk2(float lo, float hi) { return f2bf(lo) | (f2bf(hi) << 16); }
__device__ __forceinline__ float bf2f(unsigned short b) { return __builtin_bit_cast(float, (unsigned)b << 16); }
__device__ __forceinline__ float bflo(unsigned w) { return __builtin_bit_cast(float, w << 16); }
__device__ __forceinline__ float bfhi(unsigned w) { return __builtin_bit_cast(float, w & 0xffff0000u); }
__device__ __forceinline__ float siluf(float x) { return x / (1.0f + __expf(-x)); }
#define XB_TMO      128
#define XB_XCNT(j)  (256  + 64 * (j))
#define XB_XSUB(j)  (1280 + 64 * (j))
#define XB_XGEN(j)  (2304 + 64 * (j))
#define XB_TOP      3328
#define XB_TOPGEN   3392
#define XCD_BAR_WORDS 3456
#define XB_SPIN_CAP (1u << 18)

__device__ __forceinline__ unsigned xb_ld(unsigned* p)              { return __hip_atomic_load(p, __ATOMIC_RELAXED, __HIP_MEMORY_SCOPE_AGENT); }
__device__ __forceinline__ unsigned xb_add(unsigned* p, unsigned v) { return __hip_atomic_fetch_add(p, v, __ATOMIC_RELAXED, __HIP_MEMORY_SCOPE_AGENT); }
__device__ __forceinline__ unsigned xb_xcc_id() { return (unsigned)__builtin_amdgcn_s_getreg((3 << 11) | 20) & 0xFu; }
#define XB_SPIN(cond, bar) do { unsigned _sp = 0; while (cond) { __builtin_amdgcn_s_sleep(1); \
    if ((++_sp & 255u) == 0u) { if (xb_ld(&(bar)[XB_TMO])) break; if (_sp > XB_SPIN_CAP) { atomicAdd(&(bar)[XB_TMO], 1u); break; } } } } while (0)

struct XcdBarrier {
    unsigned* bar; unsigned x;
    volatile LAS unsigned* st;
};

__device__ __forceinline__ XcdBarrier xcd_barrier_post(unsigned* bar, volatile LAS unsigned* st) {
    XcdBarrier b; b.bar = bar; b.x = xb_xcc_id(); b.st = st;
    if (threadIdx.x == 0) (void)xb_add(&bar[XB_XCNT(b.x)], 1u);
    return b;
}
__device__ __forceinline__ void xcd_barrier_complete(unsigned* bar, unsigned x, unsigned& nloc, unsigned& nx) {
    const unsigned G = gridDim.x * gridDim.y * gridDim.z;
    unsigned sum, cnt, mine, sp = 0u;
    for (;;) {
        sum = 0u; cnt = 0u; mine = 0u;
#pragma unroll
        for (unsigned j = 0; j < 16; ++j) { const unsigned c = xb_ld(&bar[XB_XCNT(j)]); sum += c; cnt += (c > 0u) ? 1u : 0u; mine = (j == x) ? c : mine; }
        if (sum == G) break;
        __builtin_amdgcn_s_sleep(1);
        if ((++sp & 255u) == 0u) { if (xb_ld(&bar[XB_TMO])) break; if (sp > XB_SPIN_CAP) { atomicAdd(&bar[XB_TMO], 1u); break; } }
    }
    nloc = mine > 0u ? mine : 1u; nx = cnt > 0u ? cnt : 1u;
}

__device__ __forceinline__ void xcd_barrier(const XcdBarrier& b) {
    asm volatile("s_waitcnt vmcnt(0)" ::: "memory");
    __syncthreads();
    if (threadIdx.x == 0) {
        unsigned* bar = b.bar;
        __builtin_amdgcn_s_waitcnt(0);
        unsigned nloc = b.st[0], nx = b.st[1];
        if (nloc == 0u) { xcd_barrier_complete(bar, b.x, nloc, nx); b.st[0] = nloc; b.st[1] = nx; }
        const unsigned old = xb_add(&bar[XB_XSUB(b.x)], 1u);
        const unsigned gen = old / nloc;
        if (old + 1u == (gen + 1u) * nloc) {
            __builtin_amdgcn_fence(__ATOMIC_RELEASE, "agent");
            asm volatile("s_waitcnt vmcnt(0)" ::: "memory");
            const unsigned og = xb_add(&bar[XB_TOP], 1u);
            const unsigned tg = og / nx;
            if (og + 1u == (tg + 1u) * nx) xb_add(&bar[XB_TOPGEN], 1u);
            else XB_SPIN(xb_ld(&bar[XB_TOPGEN]) == tg, bar);
            __builtin_amdgcn_fence(__ATOMIC_ACQUIRE, "agent");
            xb_add(&bar[XB_XGEN(b.x)], 1u);
            asm volatile("s_waitcnt vmcnt(0)" ::: "memory");
        } else {
            XB_SPIN(xb_ld(&bar[XB_XGEN(b.x)]) == gen, bar);
            __builtin_amdgcn_fence(__ATOMIC_ACQUIRE, "agent");
            asm volatile("s_waitcnt vmcnt(0)" ::: "memory");
        }
    }
    __syncthreads();
}

__device__ __forceinline__ float wave_sum(float v) {
#pragma unroll
    for (int o = 1; o < 64; o <<= 1) v += __shfl_xor(v, o);
    return v;
}
__device__ __forceinline__ int win_dest_row(int n) {
    if (n < 1024) { const int hh = n >> 6, d = n & 63; const int p = (d < 32) ? (8 * (d >> 2) + (d & 3)) : (8 * ((d - 32) >> 2) + 4 + (d & 3)); return hh * 64 + p; }
    if (n < 3072) return n;
    if (n < 3080) return -1;
    return n - 8;
}
__device__ __forceinline__ int wgu_dest_row(int n) { return n < 1024 ? ((n >> 7) * 256 + (n & 127)) : (((n - 1024) >> 7) * 256 + 128 + ((n - 1024) & 127)); }
template <int MAP>
__device__ __forceinline__ void p0_transpose_item(const float* W, int K, int N, bf16* WT, float* wdt, LAS float* scr, int kb, int nb, int lane) {
    const int k0 = 64 * kb, n0 = 32 * nb;
    const int nn = n0 + (lane & 31); const bool nok = nn < N;
#pragma unroll 8
    for (int i = 0; i < 32; ++i) { const int kk = 2 * i + (lane >> 5); scr[kk * 33 + (lane & 31)] = nok ? W[(size_t)(k0 + kk) * N + nn] : 0.f; }
    LDS_WAIT(); asm volatile("" ::: "memory");
    const int c = lane & 7;
#pragma unroll
    for (int j = 0; j < 4; ++j) { const int n = (lane >> 3) + 8 * j; const LAS float* s = scr + (8 * c) * 33 + n;
        const int nsrc = n0 + n; if (nsrc >= N) continue;
        int drow = nsrc; if (MAP == 1) drow = win_dest_row(nsrc); if (MAP == 2) drow = wgu_dest_row(nsrc);
        if (MAP == 1 && drow < 0) { float* d = wdt + (size_t)(nsrc - 3072) * 1024 + k0 + 8 * c;
#pragma unroll
            for (int q = 0; q < 8; ++q) d[q] = s[q * 33]; continue; }
        v4u o; o.x = pk2(s[0 * 33], s[1 * 33]); o.y = pk2(s[2 * 33], s[3 * 33]); o.z = pk2(s[4 * 33], s[5 * 33]); o.w = pk2(s[6 * 33], s[7 * 33]);
        *(GAS v4u*)(WT + (size_t)drow * K + k0 + 8 * c) = o; }
    LDS_WAIT(); asm volatile("" ::: "memory");
}
template <int MAP>
__device__ __forceinline__ void p0_transpose_item8(const float* W, int K, int N, unsigned char* WT, float scale, LAS float* scr, int kb, int nb, int lane) {
    const int n0 = 64 * nb;
    int drow = n0 + lane; if (MAP == 2) drow = wgu_dest_row(n0 + lane);
#pragma unroll 1
    for (int half = 0; half < 2; ++half) { const int k0 = 128 * kb + 64 * half;
        f32x4 ld[16];
#pragma unroll
        for (int i = 0; i < 16; ++i) ld[i] = *(const f32x4*)(W + (size_t)(k0 + 4 * i + (lane >> 4)) * N + n0 + 4 * (lane & 15));
#pragma unroll
        for (int i = 0; i < 16; ++i) *(LAS f32x4*)(scr + (4 * i + (lane >> 4)) * 64 + 4 * (lane & 15)) = ld[i];
        LDS_WAIT(); asm volatile("" ::: "memory");
        unsigned w[16];
#pragma unroll
        for (int q = 0; q < 16; ++q) w[q] = pg8::pk4_fp8(scr[(4 * q + 0) * 64 + lane] * scale, scr[(4 * q + 1) * 64 + lane] * scale, scr[(4 * q + 2) * 64 + lane] * scale, scr[(4 * q + 3) * 64 + lane] * scale);
        GAS v4u* d = (GAS v4u*)(WT + (size_t)drow * K + k0);
#pragma unroll
        for (int q = 0; q < 4; ++q) d[q] = (v4u){w[4 * q], w[4 * q + 1], w[4 * q + 2], w[4 * q + 3]};
        LDS_WAIT(); asm volatile("" ::: "memory"); }
}
__device__ __forceinline__ void row_dt(const f32x4 (&v)[4], const float* wdt, float* dst, int lane) {
    float r[8];
#pragma unroll
    for (int jj = 0; jj < 8; ++jj) { float s = 0.f;
#pragma unroll
        for (int j = 0; j < 4; ++j) { const f32x4 w = *(const f32x4*)(wdt + jj * 1024 + 4 * lane + 256 * j); s += v[j][0] * w[0] + v[j][1] * w[1] + v[j][2] * w[2] + v[j][3] * w[3]; }
        r[jj] = wave_sum(s); }
    if (lane == 0) { *(f32x4*)dst = (f32x4){r[0], r[1], r[2], r[3]}; *(f32x4*)(dst + 4) = (f32x4){r[4], r[5], r[6], r[7]}; }
}
template <bool W8, bool WF>
__device__ __forceinline__ void ln_row(f32x4 (&v)[4], const float* gam, const float* bet, float* of32, bf16* ob16, unsigned char* o8, float s8, int lane) {
    float s = 0.f;
#pragma unroll
    for (int j = 0; j < 4; ++j) s += (v[j][0] + v[j][1]) + (v[j][2] + v[j][3]);
    const float mean = wave_sum(s) * (1.f / DM); float s2 = 0.f;
#pragma unroll
    for (int j = 0; j < 4; ++j) { v[j] = v[j] - mean; s2 += (v[j][0] * v[j][0] + v[j][1] * v[j][1]) + (v[j][2] * v[j][2] + v[j][3] * v[j][3]); }
    const float rstd = 1.f / sqrtf(wave_sum(s2) * (1.f / DM) + LN_EPS);
#pragma unroll
    for (int j = 0; j < 4; ++j) { const f32x4 g = *(const f32x4*)(gam + 4 * lane + 256 * j), b = *(const f32x4*)(bet + 4 * lane + 256 * j);
        v[j] = v[j] * rstd * g + b;
        if (WF) *(f32x4*)(of32 + 4 * lane + 256 * j) = v[j];
        v2u w; w.x = pk2(v[j][0], v[j][1]); w.y = pk2(v[j][2], v[j][3]); *(v2u*)(ob16 + 4 * lane + 256 * j) = w;
        if (W8) *(unsigned*)(o8 + 4 * lane + 256 * j) = pg8::pk4_fp8(v[j][0] * s8, v[j][1] * s8, v[j][2] * s8, v[j][3] * s8); }
}


typedef short v4i16_t __attribute__((ext_vector_type(4)));
__device__ __forceinline__ bf16x8 tr_pair(const LAS unsigned char* p0, const LAS unsigned char* p1) {
    const v4i16_t a = __builtin_amdgcn_ds_read_tr16_b64_v4i16((LAS v4i16_t*)p0), b = __builtin_amdgcn_ds_read_tr16_b64_v4i16((LAS v4i16_t*)p1);
    return (bf16x8){a[0], a[1], a[2], a[3], b[0], b[1], b[2], b[3]};
}
__device__ __forceinline__ int crow16(int r, int hi) { return (r & 3) + 8 * (r >> 2) + 4 * hi; }
constexpr int AK_PITCH = 144, AV_PITCH = 192, AK_TILE = 32 * AK_PITCH, AV_TILE = 32 * AV_PITCH;
constexpr int AT_K = 0, AT_V = 12 * AK_TILE;
struct AttnItem { int p, b, h, d, r, qt0; };
__device__ __forceinline__ AttnItem attn_item(int I) { AttnItem a; a.p = I >> 10; const int rem = I & 1023; a.b = rem >> 7; a.h = (rem >> 4) & 7; const int grp = rem & 15;
    a.d = (a.p == 0) ? 1 : (a.p == 1) ? 4 : 16; const int tpr = 128 / a.d; const int T = grp * 8; a.r = T / tpr; a.qt0 = T % tpr; return a; }
__device__ __forceinline__ void attn_request(const bf16* PROJ, const AttnItem& a, v4u (&st)[12], int tid) {
    const int rr = tid >> 4, ch = tid & 15; const int col = (ch < 8 ? C_K : C_V - 64) + a.h * 64 + ch * 8;
#pragma unroll
    for (int tl = 0; tl < 12; ++tl) { const int kt = a.qt0 - 4 + tl; st[tl] = (v4u){0u, 0u, 0u, 0u};
        if (kt >= 0) { const size_t row = (size_t)a.b * SEQ + (size_t)(32 * kt + rr) * a.d + a.r; st[tl] = *(const v4u*)(PROJ + row * NPROJ + col); } }
}
__device__ __forceinline__ void attn_deposit(LAS unsigned char* al, const v4u (&st)[12], int tid) {
    const int rr = tid >> 4, ch = tid & 15;
    LAS unsigned char* dst = (ch < 8) ? (al + AT_K + rr * AK_PITCH + ch * 16) : (al + AT_V + rr * AV_PITCH + (ch - 8) * 16); const int tstep = (ch < 8) ? AK_TILE : AV_TILE;
#pragma unroll
    for (int tl = 0; tl < 12; ++tl) *(LAS v4u*)(dst + tl * tstep) = st[tl];
}
__device__ __forceinline__ void attn_wave_compute(const bf16* PROJ, bf16* OPp, float* LSEp, const AttnItem& a, const LAS unsigned char* al, int wave, int lane) {
    const int i = lane & 31, h2 = lane >> 5; const int qt = a.qt0 + wave;
    const size_t rowq = (size_t)a.b * SEQ + (size_t)(32 * qt + i) * a.d + a.r;
    bf16x8 qf[4];
    { const bf16* qp = PROJ + rowq * NPROJ + C_Q + a.h * 64 + 8 * h2;
#pragma unroll
      for (int s = 0; s < 4; ++s) qf[s] = *(const bf16x8*)(qp + 16 * s); }
    f32x16 o0 = {}, o1 = {}; float mrun = -INFINITY, lrun = 0.f;
    const int kt0 = qt > 4 ? qt - 4 : 0;
    const LAS unsigned char* krd = al + AT_K + i * AK_PITCH + 16 * h2;
    const LAS unsigned char* trb = al + AT_V + (4 * h2 + ((lane & 15) >> 2)) * AV_PITCH + (16 * ((lane >> 4) & 1) + 4 * (lane & 3)) * 2;
#pragma unroll 1
    for (int kt = kt0; kt <= qt; ++kt) {
        const int tl = kt - a.qt0 + 4;
        const LAS unsigned char* kp = krd + tl * AK_TILE; const LAS unsigned char* vp = trb + tl * AV_TILE;
        f32x16 sacc = {};
#pragma unroll
        for (int s = 0; s < 4; ++s) sacc = __builtin_amdgcn_mfma_f32_32x32x16_bf16(*(const LAS bf16x8*)(kp + 32 * s), qf[s], sacc, 0, 0, 0);
        if (kt == qt) {
#pragma unroll
            for (int rg = 0; rg < 16; ++rg) if (crow16(rg, h2) > i) sacc[rg] = -INFINITY;
        }
        if (kt + 4 == qt) {
#pragma unroll
            for (int rg = 0; rg < 16; ++rg) if (crow16(rg, h2) < i) sacc[rg] = -INFINITY;
        }
        float mx = sacc[0];
#pragma unroll
        for (int rg = 1; rg < 16; ++rg) mx = fmaxf(mx, sacc[rg]);
        mx = fmaxf(mx, __shfl_xor(mx, 32));
        const float mnew = fmaxf(mrun, mx), alpha = __builtin_amdgcn_exp2f(mrun - mnew); mrun = mnew;
        float ps = 0.f;
#pragma unroll
        for (int rg = 0; rg < 16; ++rg) { sacc[rg] = __builtin_amdgcn_exp2f(sacc[rg] - mnew); ps += sacc[rg]; }
        lrun = lrun * alpha + ps;
#pragma unroll
        for (int rg = 0; rg < 16; ++rg) { o0[rg] *= alpha; o1[rg] *= alpha; }
        bf16x8 pf[2];
#pragma unroll
        for (int ks = 0; ks < 2; ++ks) { v4u w; w.x = pg8::cvt_pk_bf16(sacc[8 * ks + 0], sacc[8 * ks + 1]); w.y = pg8::cvt_pk_bf16(sacc[8 * ks + 2], sacc[8 * ks + 3]); w.z = pg8::cvt_pk_bf16(sacc[8 * ks + 4], sacc[8 * ks + 5]); w.w = pg8::cvt_pk_bf16(sacc[8 * ks + 6], sacc[8 * ks + 7]); pf[ks] = __builtin_bit_cast(bf16x8, w); }
#pragma unroll
        for (int ks = 0; ks < 2; ++ks) {
            const bf16x8 v0 = tr_pair(vp + (16 * ks) * AV_PITCH, vp + (16 * ks + 8) * AV_PITCH);
            const bf16x8 v1 = tr_pair(vp + (16 * ks) * AV_PITCH + 64, vp + (16 * ks + 8) * AV_PITCH + 64);
            o0 = __builtin_amdgcn_mfma_f32_32x32x16_bf16(v0, pf[ks], o0, 0, 0, 0);
            o1 = __builtin_amdgcn_mfma_f32_32x32x16_bf16(v1, pf[ks], o1, 0, 0, 0);
        }
    }
    const float lt = lrun + __shfl_xor(lrun, 32); const float il = 1.0f / lt;
    bf16* op = OPp + rowq * 512 + a.h * 64 + 4 * h2;
#pragma unroll
    for (int g4 = 0; g4 < 4; ++g4) {
        v2u w0, w1; w0.x = pg8::cvt_pk_bf16(o0[4 * g4 + 0] * il, o0[4 * g4 + 1] * il); w0.y = pg8::cvt_pk_bf16(o0[4 * g4 + 2] * il, o0[4 * g4 + 3] * il);
        w1.x = pg8::cvt_pk_bf16(o1[4 * g4 + 0] * il, o1[4 * g4 + 1] * il); w1.y = pg8::cvt_pk_bf16(o1[4 * g4 + 2] * il, o1[4 * g4 + 3] * il);
        *(v2u*)(op + 8 * g4) = w0; *(v2u*)(op + 32 + 8 * g4) = w1; }
    if (h2 == 0) LSEp[rowq * 8 + a.h] = mrun + log2f(lt);
}
__device__ __forceinline__ void attn_phase(LAS unsigned char* al, const bf16* PROJ, bf16* OP, float* LSE, int bid, int G, int tid, int wave, int lane) {
    v4u st[12];
    int I = bid;
    if (I < 3072) { const AttnItem a = attn_item(I); attn_request(PROJ, a, st, tid); }
    for (; I < 3072; I += G) {
        const AttnItem a = attn_item(I);
        __syncthreads();
        attn_deposit(al, st, tid);
        __syncthreads();
        if (I + G < 3072) { const AttnItem n = attn_item(I + G); attn_request(PROJ, n, st, tid); }
        attn_wave_compute(PROJ, OP + (size_t)a.p * MROWS * 512, LSE + (size_t)a.p * MROWS * 8, a, al, wave, lane);
    }
    __syncthreads();
}

constexpr int SS_DTS = 0, SS_ACUM = 2048, SS_TMP = 4096, SS_SSX = 6144, SS_IMG = 8192;
constexpr int S1_PB = 320, S1_PX = 576;
constexpr int S1_B = SS_IMG, S1_X = SS_IMG + 128 * S1_PB;
constexpr int S3_PBC = 272, S3_PX = 576;
constexpr int S3_B = SS_IMG, S3_C = S3_B + 128 * S3_PBC, S3_X = S3_C + 128 * S3_PBC;

__device__ __forceinline__ void ssd_prep(LAS unsigned char* sl, const float* DT, const float* dtb, const float* alog, size_t row0, int g, int tid, int lane, int wave) {
    LAS float* dts = (LAS float*)(sl + SS_DTS); LAS float* acum = (LAS float*)(sl + SS_ACUM); LAS float* tmp = (LAS float*)(sl + SS_TMP);
    { const int l = tid >> 2, hq = tid & 3; const float x = DT[(row0 + l) * 8 + 4 * g + hq] + dtb[4 * g + hq];
      const float dt = x > 20.f ? x : log1pf(__expf(x)); dts[hq * 128 + l] = dt; tmp[hq * 128 + l] = dt * (-__expf(alog[4 * g + hq])); }
    __syncthreads();
    if (wave < 4) { const float v0 = tmp[wave * 128 + 2 * lane], v1 = tmp[wave * 128 + 2 * lane + 1]; float s = v0 + v1;
#pragma unroll
        for (int off = 1; off < 64; off <<= 1) { const float t = __shfl_up(s, off); if (lane >= off) s += t; }
        acum[wave * 128 + 2 * lane] = s - v1; acum[wave * 128 + 2 * lane + 1] = s; }
    __syncthreads();
}
template <int NCOLS, int FACMODE>
__device__ __forceinline__ void conv_tile(const bf16* PROJ, size_t row0, int t0, int pcol0, const float* cw, const float* cb, int cch0, LAS unsigned char* dst, int pitch, const LAS unsigned char* sl, int hq0, int tid) {
    constexpr int NCH8 = NCOLS / 8, NSEG = 512 / NCH8, RPS = 128 / NSEG;
    const int c8 = tid % NCH8, seg = tid / NCH8, l0 = seg * RPS;
    float w[4][8], bias[8], hst[3][8];
#pragma unroll
    for (int k = 0; k < 4; ++k) { const f32x4 a = *(const f32x4*)(cw + k * 1024 + cch0 + c8 * 8), b = *(const f32x4*)(cw + k * 1024 + cch0 + c8 * 8 + 4);
        w[k][0] = a[0]; w[k][1] = a[1]; w[k][2] = a[2]; w[k][3] = a[3]; w[k][4] = b[0]; w[k][5] = b[1]; w[k][6] = b[2]; w[k][7] = b[3]; }
    { const f32x4 a = *(const f32x4*)(cb + cch0 + c8 * 8), b = *(const f32x4*)(cb + cch0 + c8 * 8 + 4);
      bias[0] = a[0]; bias[1] = a[1]; bias[2] = a[2]; bias[3] = a[3]; bias[4] = b[0]; bias[5] = b[1]; bias[6] = b[2]; bias[7] = b[3]; }
    const bf16* src = PROJ + pcol0 + c8 * 8;
#pragma unroll
    for (int k = 0; k < 3; ++k) { const int l = l0 - 3 + k; v4u v = (v4u){0u, 0u, 0u, 0u}; if (t0 + l >= 0) v = *(const v4u*)(src + (size_t)((long)row0 + l) * NPROJ);
        hst[k][0] = bflo(v.x); hst[k][1] = bfhi(v.x); hst[k][2] = bflo(v.y); hst[k][3] = bfhi(v.y); hst[k][4] = bflo(v.z); hst[k][5] = bfhi(v.z); hst[k][6] = bflo(v.w); hst[k][7] = bfhi(v.w); }
    const LAS float* dts = (const LAS float*)(sl + SS_DTS); const LAS float* acum = (const LAS float*)(sl + SS_ACUM);
    const int hq = hq0 + (c8 * 8) / 64;
    const float alast = (FACMODE == 2) ? acum[hq * 128 + 127] : 0.f;
#pragma unroll
    for (int rr = 0; rr < RPS; ++rr) { const int l = l0 + rr; const v4u v = *(const v4u*)(src + (row0 + l) * NPROJ);
        float cur[8]; cur[0] = bflo(v.x); cur[1] = bfhi(v.x); cur[2] = bflo(v.y); cur[3] = bfhi(v.y); cur[4] = bflo(v.z); cur[5] = bfhi(v.z); cur[6] = bflo(v.w); cur[7] = bfhi(v.w);
        float f = 1.f; if (FACMODE >= 1) f = dts[hq * 128 + l]; if (FACMODE == 2) f *= __expf(alast - acum[hq * 128 + l]);
        float o[8];
#pragma unroll
        for (int e = 0; e < 8; ++e) { const float a = bias[e] + w[0][e] * hst[0][e] + w[1][e] * hst[1][e] + w[2][e] * hst[2][e] + w[3][e] * cur[e]; o[e] = siluf(a) * f;
            hst[0][e] = hst[1][e]; hst[1][e] = hst[2][e]; hst[2][e] = cur[e]; }
        v4u ov; ov.x = pk2(o[0], o[1]); ov.y = pk2(o[2], o[3]); ov.z = pk2(o[4], o[5]); ov.w = pk2(o[6], o[7]);
        *(LAS v4u*)(dst + l * pitch + c8 * 16) = ov; }
}
__device__ __forceinline__ void ssd_s1_unit(LAS unsigned char* sl, const bf16* PROJ, const float* DT, const float* dtb, const float* alog, const float* cw, const float* cb, float* ST, float* CDEC, int un, int tid, int lane, int wave) {
    const int g = un & 1, bc = un >> 1; const size_t row0 = (size_t)bc * 128; const int t0 = (bc & 31) * 128;
    __syncthreads();
    ssd_prep(sl, DT, dtb, alog, row0, g, tid, lane, wave);
    conv_tile<128, 0>(PROJ, row0, t0, C_XS + 512 + g * 128, cw, cb, 512 + g * 128, sl + S1_B, S1_PB, sl, 0, tid);
    conv_tile<256, 2>(PROJ, row0, t0, C_XS + g * 256, cw, cb, g * 256, sl + S1_X, S1_PX, sl, 0, tid);
    if (tid < 4) CDEC[(size_t)bc * 8 + 4 * g + tid] = __expf(((const LAS float*)(sl + SS_ACUM))[tid * 128 + 127]);
    __syncthreads();
    const int hq = wave >> 1, pt = wave & 1, h2 = lane >> 5, q = (lane & 15) >> 2, pp = lane & 3, dsel = (lane >> 4) & 1;
    const LAS unsigned char* xb = sl + S1_X + (8 * h2 + q) * S1_PX + (hq * 64 + pt * 32 + 16 * dsel + 4 * pp) * 2;
    const LAS unsigned char* bb = sl + S1_B + (8 * h2 + q) * S1_PB + (16 * dsel + 4 * pp) * 2;
    f32x16 acc[4];
#pragma unroll
    for (int nt = 0; nt < 4; ++nt) acc[nt] = (f32x16){};
#pragma unroll
    for (int ks = 0; ks < 8; ++ks) { const bf16x8 a = tr_pair(xb + (16 * ks) * S1_PX, xb + (16 * ks + 4) * S1_PX);
#pragma unroll
        for (int nt = 0; nt < 4; ++nt) { const bf16x8 b = tr_pair(bb + (16 * ks) * S1_PB + nt * 64, bb + (16 * ks + 4) * S1_PB + nt * 64); acc[nt] = __builtin_amdgcn_mfma_f32_32x32x16_bf16(a, b, acc[nt], 0, 0, 0); } }
    float* sp = ST + ((size_t)(bc * 8 + 4 * g + hq) * 64 + pt * 32) * 128 + (lane & 31);
#pragma unroll
    for (int nt = 0; nt < 4; ++nt)
#pragma unroll
        for (int rg = 0; rg < 16; ++rg) sp[(size_t)crow16(rg, h2) * 128 + 32 * nt] = acc[nt][rg];
}
__device__ __forceinline__ void ssd_s3_unit(LAS unsigned char* sl, const bf16* PROJ, const float* DT, const float* dtb, const float* alog, const float* cw, const float* cb, const float* dsk, const float* ng,
                                            const bf16* HIN, bf16* MIXED, int un, int tid, int lane, int wave) {
    const int g = un & 1, bc = un >> 1; const size_t row0 = (size_t)bc * 128; const int t0 = (bc & 31) * 128;
    __syncthreads();
    ssd_prep(sl, DT, dtb, alog, row0, g, tid, lane, wave);
    conv_tile<128, 0>(PROJ, row0, t0, C_XS + 512 + g * 128, cw, cb, 512 + g * 128, sl + S3_B, S3_PBC, sl, 0, tid);
    conv_tile<128, 0>(PROJ, row0, t0, C_XS + 768 + g * 128, cw, cb, 768 + g * 128, sl + S3_C, S3_PBC, sl, 0, tid);
    conv_tile<256, 1>(PROJ, row0, t0, C_XS + g * 256, cw, cb, g * 256, sl + S3_X, S3_PX, sl, 0, tid);
    __syncthreads();
    const LAS float* dts = (const LAS float*)(sl + SS_DTS); const LAS float* acum = (const LAS float*)(sl + SS_ACUM); LAS float* ssx = (LAS float*)(sl + SS_SSX);
    const int lt = wave & 3, ph = wave >> 2, lq = lane & 31, hi = lane >> 5, q = (lane & 15) >> 2, pp = lane & 3, dsel = (lane >> 4) & 1;
    const int lrow = 32 * lt + lq;
    const LAS unsigned char* crd = sl + S3_C + lrow * S3_PBC + 16 * hi;
    f32x16 ag[4];
#pragma unroll
    for (int st = 0; st < 4; ++st) { ag[st] = (f32x16){};
        if (st <= lt) { const LAS unsigned char* brd = sl + S3_B + (32 * st + lq) * S3_PBC + 16 * hi;
#pragma unroll
            for (int ks = 0; ks < 8; ++ks) ag[st] = __builtin_amdgcn_mfma_f32_32x32x16_bf16(*(const LAS bf16x8*)(brd + 32 * ks), *(const LAS bf16x8*)(crd + 32 * ks), ag[st], 0, 0, 0); } }
    unsigned ayp[4][8]; float ss = 0.f; const size_t grow = row0 + lrow;
#pragma unroll
    for (int hq = 0; hq < 4; ++hq) {
            const float al = acum[hq * 128 + lrow], dd = dsk[4 * g + hq] / dts[hq * 128 + lrow];
            const LAS unsigned char* xb = sl + S3_X + (4 * hi + q) * S3_PX + (hq * 64 + ph * 32 + 16 * dsel + 4 * pp) * 2;
            f32x16 y = (f32x16){};
            { const bf16* hp = HIN + ((size_t)(bc * 8 + 4 * g + hq) * 64 + ph * 32 + lq) * 128 + 8 * hi;
#pragma unroll
              for (int ks = 0; ks < 8; ++ks) y = __builtin_amdgcn_mfma_f32_32x32x16_bf16(*(const bf16x8*)(hp + 16 * ks), *(const LAS bf16x8*)(crd + 32 * ks), y, 0, 0, 0);
              const float ea = __expf(al);
#pragma unroll
              for (int rg = 0; rg < 16; ++rg) y[rg] *= ea; }
#pragma unroll
            for (int st = 0; st < 4; ++st) if (st <= lt) {
                float pm[16];
#pragma unroll
                for (int g4 = 0; g4 < 4; ++g4) { const f32x4 as4 = *(const LAS f32x4*)(acum + hq * 128 + 32 * st + 8 * g4 + 4 * hi);
#pragma unroll
                    for (int e = 0; e < 4; ++e) { const int rg = 4 * g4 + e; float v = ag[st][rg] * __expf(al - as4[e]);
                        if (st == lt) { const int sl_ = 8 * g4 + 4 * hi + e; if (sl_ > lq) v = 0.f; if (sl_ == lq) v += dd; }
                        pm[rg] = v; } }
#pragma unroll
                for (int ks = 0; ks < 2; ++ks) { v4u wv; wv.x = pg8::cvt_pk_bf16(pm[8 * ks + 0], pm[8 * ks + 1]); wv.y = pg8::cvt_pk_bf16(pm[8 * ks + 2], pm[8 * ks + 3]); wv.z = pg8::cvt_pk_bf16(pm[8 * ks + 4], pm[8 * ks + 5]); wv.w = pg8::cvt_pk_bf16(pm[8 * ks + 6], pm[8 * ks + 7]);
                    const bf16x8 xt = tr_pair(xb + (32 * st + 16 * ks) * S3_PX, xb + (32 * st + 16 * ks + 8) * S3_PX);
                    y = __builtin_amdgcn_mfma_f32_32x32x16_bf16(xt, __builtin_bit_cast(bf16x8, wv), y, 0, 0, 0); }
            }
#pragma unroll
            for (int g4 = 0; g4 < 4; ++g4) { const int ch = hq * 64 + ph * 32 + 8 * g4 + 4 * hi; const v2u z = *(const v2u*)(PROJ + grow * NPROJ + C_Z + g * 256 + ch);
                const float y0 = y[4 * g4 + 0] * siluf(bflo(z.x)), y1 = y[4 * g4 + 1] * siluf(bfhi(z.x)), y2 = y[4 * g4 + 2] * siluf(bflo(z.y)), y3 = y[4 * g4 + 3] * siluf(bfhi(z.y));
                ss += (y0 * y0 + y1 * y1) + (y2 * y2 + y3 * y3);
                ayp[hq][2 * g4] = pg8::cvt_pk_bf16(y0, y1); ayp[hq][2 * g4 + 1] = pg8::cvt_pk_bf16(y2, y3); }
    }
    ss += __shfl_xor(ss, 32);
    if (hi == 0) ssx[ph * 128 + lrow] = ss;
    __syncthreads();
    const float rs = 1.0f / sqrtf((ssx[lrow] + ssx[128 + lrow]) * (1.f / 256.f) + RMS_EPS);
#pragma unroll
    for (int hq = 0; hq < 4; ++hq)
#pragma unroll
        for (int g4 = 0; g4 < 4; ++g4) { const int ch = hq * 64 + ph * 32 + 8 * g4 + 4 * hi; const f32x4 gn = *(const f32x4*)(ng + g * 256 + ch);
            const unsigned p0 = ayp[hq][2 * g4], p1 = ayp[hq][2 * g4 + 1];
            v2u o; o.x = pg8::cvt_pk_bf16(bflo(p0) * rs * gn[0], bfhi(p0) * rs * gn[1]); o.y = pg8::cvt_pk_bf16(bflo(p1) * rs * gn[2], bfhi(p1) * rs * gn[3]);
            *(v2u*)(MIXED + grow * MIXW + 512 + g * 256 + ch) = o; }
}

constexpr float SC_X = 4.f, SC_WGU = 32.f, SC_H = 4.f, SC_WDN = 64.f;
struct Args { const float* in[20]; float* out; unsigned char* ws; int ph_lo, ph_hi, sub, pad; };
constexpr int NWAVES = 8;
constexpr int PH_PER_LAYER = 10, N_PHASES = 1 + NLAYER * PH_PER_LAYER;

#define in_x (args.in[0])
#define in_win (args.in[1])
#define in_convw (args.in[2])
#define in_convb (args.in[3])
#define in_dtb (args.in[4])
#define in_alog (args.in[5])
#define in_dsk (args.in[6])
#define in_ng (args.in[7])
#define in_scw (args.in[8])
#define in_wout (args.in[9])
#define in_ln1g (args.in[10])
#define in_ln1b (args.in[11])
#define in_rw (args.in[12])
#define in_rb (args.in[13])
#define in_wgu (args.in[14])
#define in_bgu (args.in[15])
#define in_wdn (args.in[16])
#define in_bdn (args.in[17])
#define in_ln2g (args.in[18])
#define in_ln2b (args.in[19])
#define ROPE ((float*)(args.ws + WS_ROPE))
#define WDT ((float*)(args.ws + WS_WDT))
#define ROUT ((bf16*)(args.ws + WS_ROUT))
#define WIN ((bf16*)(args.ws + WS_WIN))
#define WOUT ((bf16*)(args.ws + WS_WOUT))
#define WGU ((bf16*)(args.ws + WS_WGU))
#define WDN ((bf16*)(args.ws + WS_WDN))
#define XB ((bf16*)(args.ws + WS_XB))
#define XF ((float*)(args.ws + WS_XF))
#define XF2 ((float*)(args.ws + WS_XF2))
#define PROJ ((bf16*)(args.ws + WS_PROJ))
#define DT ((float*)(args.ws + WS_DT))
#define DTS ((float*)(args.ws + WS_DTS))
#define ACUM ((float*)(args.ws + WS_ACUM))
#define LSE ((float*)(args.ws + WS_LSE))
#define OP ((bf16*)(args.ws + WS_OP))
#define U ((bf16*)(args.ws + WS_U))
#define GB ((float*)(args.ws + WS_G))
#define ST ((float*)(args.ws + WS_ST))
#define YD ((float*)(args.ws + WS_YD))
#define MIXED ((bf16*)(args.ws + WS_MIXED))
#define MIXF ((float*)(args.ws + WS_MIXF))
#define TOPE ((int*)(args.ws + WS_TOPE))
#define TOPG ((float*)(args.ws + WS_TOPG))
#define ROWTOK ((int*)(args.ws + WS_ROWTOK))
#define ROWGATE ((float*)(args.ws + WS_ROWGATE))
#define HB ((bf16*)(args.ws + WS_H))
#define YB ((bf16*)(args.ws + WS_YB))
#define HIN ((bf16*)(args.ws + WS_G))
#define WGU8 ((unsigned char*)(args.ws + WS_WGU))
#define WDN8 ((unsigned char*)(args.ws + WS_WDN))
#define XB8 ((unsigned char*)(args.ws + WS_U))
#define H8 ((unsigned char*)(args.ws + WS_H))
#define CDEC ((float*)(args.ws + WS_ACUM))
template <int layer>
__device__ __forceinline__ void run_layer(const Args& args, int lo, int hi, const XcdBarrier& bar) {
    extern __shared__ __attribute__((aligned(16))) unsigned char lds[];
    LAS unsigned char* ldsp = (LAS unsigned char*)lds;
    const int tid = threadIdx.x, lane = tid & 63, wave = __builtin_amdgcn_readfirstlane(tid >> 6);
    const int G = gridDim.x, bid = blockIdx.x;
    const int gw = bid * NWAVES + wave, NGW = G * NWAVES;
    gu32* ctl = (gu32*)(args.ws + WS_CTL);

#define IN(k) (lo <= (k) && (k) < hi)
#define SEAM(k) do { if (IN(k) && IN((k) + 1)) xcd_barrier(bar); } while (0)

        const int pb = 1 + layer * PH_PER_LAYER;
        const bf16* WINl = WIN + (size_t)layer * NPROJ * DM; const bf16* WOUTl = WOUT + (size_t)layer * DM * MIXW;
        const unsigned char* WGUl = WGU8 + (size_t)layer * NEXP * 2048 * DM; const unsigned char* WDNl = WDN8 + (size_t)layer * NEXP * DM * FF;
        gu32* gcnt = ctl + CW_CNT + 64 * layer;

        if (IN(pb + 0)) {
            if (layer == 0) {
                for (int m = gw; m < MROWS; m += NGW) { const float* xr = in_x + (size_t)m * DM; f32x4 v[4];
#pragma unroll
                    for (int j = 0; j < 4; ++j) v[j] = *(const f32x4*)(xr + 4 * lane + 256 * j);
                    row_dt(v, WDT, DT + (size_t)m * 8, lane); }
            }
            pg8::Gemm g{XB, WINl, MROWS, NPROJ, DM}; pg8::StaticOrder S; S.init(MROWS, NPROJ, G, bid);
            pg8::EpiProj E{PROJ, NPROJ, ROPE, QSCALE};
            pg8::gemm_phase<pg8::EpiProj, pg8::StaticOrder, true, false>(ldsp + RING_OFF, g, S, E);
        }
        SEAM(pb + 0);
        if (IN(pb + 1)) {
            if (args.sub & 1) attn_phase(ldsp + RING_OFF, PROJ, OP, LSE, bid, G, tid, wave, lane);
            if (args.sub & 2) { const float* cw = in_convw + (size_t)layer * 4 * 1024; const float* cb = in_convb + (size_t)layer * 1024;
              for (int un = bid; un < 512; un += G)
                  ssd_s1_unit(ldsp + RING_OFF, PROJ, DT, in_dtb + layer * 8, in_alog + layer * 8, cw, cb, ST, CDEC, un, tid, lane, wave);
              __syncthreads(); }
            const float* sw = in_scw + (size_t)layer * 3 * 512;
            if (args.sub & 4) for (int it = bid * (NWAVES * 64) + tid; it < (int)((long)MROWS * 64); it += G * (NWAVES * 64)) { const int c8 = (int)(it & 63), row = (int)(it >> 6), t = row & (SEQ - 1); const int ch = c8 * 8;
                float a[8];
#pragma unroll
                for (int q = 0; q < 8; ++q) a[q] = 0.f;
#pragma unroll
                for (int k = 0; k < 3; ++k) { const int tt = t - 2 + k; if (tt >= 0) { const bf16* pr = PROJ + (size_t)(row - 2 + k) * NPROJ; const v4u cc = *(const v4u*)(pr + C_SC + ch), hh = *(const v4u*)(pr + C_SH + ch);
                    const f32x4 w0 = *(const f32x4*)(sw + k * 512 + ch), w1 = *(const f32x4*)(sw + k * 512 + ch + 4);
                    a[0] += w0[0] * bflo(cc.x) * bflo(hh.x); a[1] += w0[1] * bfhi(cc.x) * bfhi(hh.x); a[2] += w0[2] * bflo(cc.y) * bflo(hh.y); a[3] += w0[3] * bfhi(cc.y) * bfhi(hh.y);
                    a[4] += w1[0] * bflo(cc.z) * bflo(hh.z); a[5] += w1[1] * bfhi(cc.z) * bfhi(hh.z); a[6] += w1[2] * bflo(cc.w) * bflo(hh.w); a[7] += w1[3] * bfhi(cc.w) * bfhi(hh.w); } }
                const v4u bb = *(const v4u*)(PROJ + (size_t)row * NPROJ + C_SB + ch);
                v4u o; o.x = pk2(a[0] * bflo(bb.x), a[1] * bfhi(bb.x)); o.y = pk2(a[2] * bflo(bb.y), a[3] * bfhi(bb.y)); o.z = pk2(a[4] * bflo(bb.z), a[5] * bfhi(bb.z)); o.w = pk2(a[6] * bflo(bb.w), a[7] * bfhi(bb.w));
                *(v4u*)(MIXED + (size_t)row * MIXW + 1024 + ch) = o; }
        }
        SEAM(pb + 1);
        if (IN(pb + 2)) {
            for (int it = bid * (NWAVES * 64) + tid; it < (int)(64L * 2048); it += G * (NWAVES * 64)) { const int pn4 = (int)(it & 2047), bh = (int)(it >> 11); const int h = bh & 7, b = bh >> 3; f32x4 hc = (f32x4){0.f, 0.f, 0.f, 0.f};
#pragma unroll 8
                for (int c = 0; c < 32; ++c) { const size_t idx = ((size_t)((b * 32 + c) * 8 + h)) * 8192 + pn4 * 4; const f32x4 st = *(const f32x4*)(ST + idx);
                    v2u o; o.x = pk2(hc[0], hc[1]); o.y = pk2(hc[2], hc[3]); *(v2u*)(HIN + idx) = o;
                    hc = hc * CDEC[(size_t)(b * 32 + c) * 8 + h] + st; } }
        }
        SEAM(pb + 2);
        if (IN(pb + 3)) {
            if (args.sub & 1) { const float* cw = in_convw + (size_t)layer * 4 * 1024; const float* cb = in_convb + (size_t)layer * 1024;
              for (int un = bid; un < 512; un += G)
                  ssd_s3_unit(ldsp + RING_OFF, PROJ, DT, in_dtb + layer * 8, in_alog + layer * 8, cw, cb, in_dsk + layer * 8, in_ng + (size_t)layer * 512, HIN, MIXED, un, tid, lane, wave);
              __syncthreads(); }
            if (args.sub & 2) for (int it = bid * (NWAVES * 64) + tid; it < (int)((long)MROWS * 64); it += G * (NWAVES * 64)) { const int c8 = (int)(it & 63), row = (int)(it >> 6); const int h = c8 >> 3;
                const float l0 = LSE[((size_t)0 * MROWS + row) * 8 + h], l1 = LSE[((size_t)1 * MROWS + row) * 8 + h], l2 = LSE[((size_t)2 * MROWS + row) * 8 + h];
                const float mm = fmaxf(l0, fmaxf(l1, l2)); float w0 = exp2f(l0 - mm), w1 = exp2f(l1 - mm), w2 = exp2f(l2 - mm); const float iw = 1.0f / (w0 + w1 + w2); w0 *= iw; w1 *= iw; w2 *= iw;
                const v4u a0 = *(const v4u*)(OP + ((size_t)0 * MROWS + row) * 512 + c8 * 8), a1 = *(const v4u*)(OP + ((size_t)1 * MROWS + row) * 512 + c8 * 8), a2 = *(const v4u*)(OP + ((size_t)2 * MROWS + row) * 512 + c8 * 8);
                v4u o;
                o.x = pk2(w0 * bflo(a0.x) + w1 * bflo(a1.x) + w2 * bflo(a2.x), w0 * bfhi(a0.x) + w1 * bfhi(a1.x) + w2 * bfhi(a2.x));
                o.y = pk2(w0 * bflo(a0.y) + w1 * bflo(a1.y) + w2 * bflo(a2.y), w0 * bfhi(a0.y) + w1 * bfhi(a1.y) + w2 * bfhi(a2.y));
                o.z = pk2(w0 * bflo(a0.z) + w1 * bflo(a1.z) + w2 * bflo(a2.z), w0 * bfhi(a0.z) + w1 * bfhi(a1.z) + w2 * bfhi(a2.z));
                o.w = pk2(w0 * bflo(a0.w) + w1 * bflo(a1.w) + w2 * bflo(a2.w), w0 * bfhi(a0.w) + w1 * bfhi(a1.w) + w2 * bfhi(a2.w));
                *(v4u*)(MIXED + (size_t)row * MIXW + c8 * 8) = o; }
        }
        SEAM(pb + 3);
        if (IN(pb + 4)) {
            pg8::Gemm g{MIXED, WOUTl, MROWS, DM, MIXW}; pg8::StaticOrder S; S.init(MROWS, DM, G, bid);
            pg8::EpiF32 E{MIXF, DM};
            pg8::gemm_phase<pg8::EpiF32, pg8::StaticOrder, true, false>(ldsp + RING_OFF, g, S, E);
        }
        SEAM(pb + 4);
        if (IN(pb + 5)) {
            const float* gam = in_ln1g + (size_t)layer * DM; const float* bet = in_ln1b + (size_t)layer * DM;
            for (int m = gw; m < MROWS; m += NGW) { f32x4 v[4];
#pragma unroll
                for (int j = 0; j < 4; ++j) { const v2u a = *(const v2u*)(XB + (size_t)m * DM + 4 * lane + 256 * j); const f32x4 b = *(const f32x4*)(MIXF + (size_t)m * DM + 4 * lane + 256 * j);
                    v[j] = (f32x4){bflo(a.x), bfhi(a.x), bflo(a.y), bfhi(a.y)} * ALPHA + b; }
                ln_row<true, false>(v, gam, bet, nullptr, XB + (size_t)m * DM, XB8 + (size_t)m * DM, SC_X, lane); }
        }
        SEAM(pb + 5);
        if (IN(pb + 6)) {
            LAS int* lcnt = (LAS int*)(ldsp + L_LCNT); LAS int* lbase = (LAS int*)(ldsp + L_LBASE);
            const bf16* RT = ROUT + (size_t)layer * NEXP * DM; const float* rb = in_rb + (size_t)layer * NEXP;
            for (int blk = bid; blk < MROWS / 128; blk += G) {
                if (tid < 32) lcnt[tid] = 0;
                __syncthreads();
                const int r32 = lane & 31, hi = lane >> 5; const int row = blk * 128 + (wave & 3) * 32 + r32;
                float tv[4]; int te[4]; int lrank[4]; float gate[4];
                if (wave < 4) {
                    f32x16 acc = {};
                    const bf16* ap = RT + (size_t)r32 * DM + 8 * hi; const bf16* bp = XB + (size_t)row * DM + 8 * hi;
#pragma unroll 8
                    for (int s = 0; s < 64; ++s) { const bf16x8 a = *(const bf16x8*)(ap + 16 * s), b = *(const bf16x8*)(bp + 16 * s); acc = __builtin_amdgcn_mfma_f32_32x32x16_bf16(a, b, acc, 0, 0, 0); }
#pragma unroll
                    for (int k = 0; k < 4; ++k) { tv[k] = -INFINITY; te[k] = 1 << 20; }
#pragma unroll
                    for (int i = 0; i < 16; ++i) { const int e = (i & 3) + 8 * (i >> 2) + 4 * hi; float v = acc[i] + rb[e]; int ve = e;
#pragma unroll
                        for (int k = 0; k < 4; ++k) { const bool gt = (v > tv[k]) || (v == tv[k] && ve < te[k]); const float nv = gt ? tv[k] : v; const int ne = gt ? te[k] : ve; tv[k] = gt ? v : tv[k]; te[k] = gt ? ve : te[k]; v = nv; ve = ne; } }
                    float pv[4]; int pe[4];
#pragma unroll
                    for (int k = 0; k < 4; ++k) { pv[k] = __shfl_xor(tv[k], 32); pe[k] = __shfl_xor(te[k], 32); }
#pragma unroll
                    for (int j = 0; j < 4; ++j) { float v = pv[j]; int ve = pe[j];
#pragma unroll
                        for (int k = 0; k < 4; ++k) { const bool gt = (v > tv[k]) || (v == tv[k] && ve < te[k]); const float nv = gt ? tv[k] : v; const int ne = gt ? te[k] : ve; tv[k] = gt ? v : tv[k]; te[k] = gt ? ve : te[k]; v = nv; ve = ne; } }
                    float se = 0.f;
#pragma unroll
                    for (int k = 0; k < 4; ++k) { gate[k] = __expf(tv[k] - tv[0]); se += gate[k]; }
                    const float ise = 1.0f / se;
#pragma unroll
                    for (int k = 0; k < 4; ++k) gate[k] *= ise;
                    if (hi == 0) {
#pragma unroll
                        for (int k = 0; k < 4; ++k) lrank[k] = __hip_atomic_fetch_add(lcnt + te[k], 1, __ATOMIC_RELAXED, __HIP_MEMORY_SCOPE_WORKGROUP);
                    }
                }
                __syncthreads();
                if (tid < 32) lbase[tid] = (int)__hip_atomic_fetch_add(gcnt + tid, (unsigned)lcnt[tid], RLX_AGENT);
                __syncthreads();
                if (wave < 4 && hi == 0) {
#pragma unroll
                    for (int k = 0; k < 4; ++k) { const int r = lbase[te[k]] + lrank[k]; const size_t o = (size_t)te[k] * 32768 + r;
                        ROWTOK[o] = row * 4 + k; ROWGATE[o] = gate[k]; TOPE[(size_t)row * 4 + k] = te[k]; TOPG[(size_t)row * 4 + k] = gate[k]; }
                }
                __syncthreads();
            }
        }
        SEAM(pb + 6);
        if (IN(pb + 7) || IN(pb + 8)) {
            LAS int* tstart = (LAS int*)(ldsp + L_TSTART); LAS int* cntL = (LAS int*)(ldsp + L_CNT); LAS int* units = (LAS int*)(ldsp + L_UNITS); LAS int* unitsn = (LAS int*)(ldsp + L_UNITSN);
            if (tid == 0) { int acc = 0; for (int e = 0; e < 32; ++e) { const int c = (int)__hip_atomic_load(gcnt + e, RLX_AGENT); cntL[e] = c; tstart[e] = acc; acc += (c + 255) >> 8; } tstart[32] = acc; }
            __syncthreads();
            if (IN(pb + 7)) {
                pg8::moe_build_units(units, unitsn, tstart, 8, G, bid, tid);
                __syncthreads();
                pg8::Gemm g{(const pg8::bf16_t*)XB8, (const pg8::bf16_t*)WGUl, 0, 2048, DM / 2};
                pg8::MoeOrder S{units, __builtin_amdgcn_readfirstlane(unitsn[0]), cntL, ROWTOK, 1, (unsigned)DM, (size_t)2048 * DM};
                pg8::EpiSwiglu E{H8, in_bgu + (size_t)layer * NEXP * 2048, ROWGATE, cntL, 1.0f / (SC_X * SC_WGU), SC_H};
                pg8::gemm_phase<pg8::EpiSwiglu, pg8::MoeOrder, true, true, true>(ldsp + RING_OFF, g, S, E);
                __syncthreads();
            }
            SEAM(pb + 7);
            if (IN(pb + 8)) {
                pg8::moe_build_units(units, unitsn, tstart, 4, G, bid, tid);
                __syncthreads();
                pg8::Gemm g{(const pg8::bf16_t*)H8, (const pg8::bf16_t*)WDNl, 0, DM, FF / 2};
                pg8::MoeOrder S{units, __builtin_amdgcn_readfirstlane(unitsn[0]), cntL, ROWTOK, 0, (unsigned)FF, (size_t)DM * FF};
                pg8::EpiScatter E{YB, ROWTOK, cntL, 1.0f / (SC_H * SC_WDN)};
                pg8::gemm_phase<pg8::EpiScatter, pg8::MoeOrder, true, false, true>(ldsp + RING_OFF, g, S, E);
                __syncthreads();
            }
        }
        SEAM(pb + 8);
        if (IN(pb + 9)) {
            const float* gam = in_ln2g + (size_t)layer * DM; const float* bet = in_ln2b + (size_t)layer * DM; const float* bdn = in_bdn + (size_t)layer * NEXP * DM;
            for (int m = gw; m < MROWS; m += NGW) { f32x4 v[4];
#pragma unroll
                for (int j = 0; j < 4; ++j) { const v2u a = *(const v2u*)(XB + (size_t)m * DM + 4 * lane + 256 * j); v[j] = (f32x4){bflo(a.x), bfhi(a.x), bflo(a.y), bfhi(a.y)} * ALPHA; }
#pragma unroll
                for (int k = 0; k < 4; ++k) { const int e = TOPE[(size_t)m * 4 + k]; const float gk = TOPG[(size_t)m * 4 + k]; const bf16* yr = YB + ((size_t)m * 4 + k) * DM; const float* br = bdn + (size_t)e * DM;
#pragma unroll
                    for (int j = 0; j < 4; ++j) { const v2u w = *(const v2u*)(yr + 4 * lane + 256 * j); const f32x4 b = *(const f32x4*)(br + 4 * lane + 256 * j);
                        v[j][0] += bflo(w.x) + gk * b[0]; v[j][1] += bfhi(w.x) + gk * b[1]; v[j][2] += bflo(w.y) + gk * b[2]; v[j][3] += bfhi(w.y) + gk * b[3]; } }
                ln_row<false, (layer == NLAYER - 1)>(v, gam, bet, args.out + (size_t)m * DM, XB + (size_t)m * DM, nullptr, 1.f, lane);
                if (layer + 1 < NLAYER) row_dt(v, WDT + (size_t)(layer + 1) * 8 * 1024, DT + (size_t)m * 8, lane); }
        }
        SEAM(pb + 9);
    #undef IN
#undef SEAM
}

__global__ void __launch_bounds__(NWAVES * 64, 2) mk_fwd(Args args) {
    extern __shared__ __attribute__((aligned(16))) unsigned char lds[];
    LAS unsigned char* ldsp = (LAS unsigned char*)lds;
    const int tid = threadIdx.x, lane = tid & 63, wave = __builtin_amdgcn_readfirstlane(tid >> 6);
    const int G = gridDim.x, bid = blockIdx.x;
    const int gw = bid * NWAVES + wave, NGW = G * NWAVES;
    gu32* ctl = (gu32*)(args.ws + WS_CTL);

    for (int u = tid; u < (LDS_BYTES - LDSCTL_OFF) / 4; u += NWAVES * 64) ((LAS unsigned*)(ldsp + LDSCTL_OFF))[u] = 0u;
    __syncthreads();
    XcdBarrier bar = xcd_barrier_post((unsigned*)(ctl + CW_BAR), (volatile LAS unsigned*)(ldsp + L_MISC) + 8);

    const int lo = args.ph_lo, hi = args.ph_hi;
#define IN(k) (lo <= (k) && (k) < hi)
#define SEAM(k) do { if (IN(k) && IN((k) + 1)) xcd_barrier(bar); } while (0)

    if (IN(0)) {
        for (int it = bid * (NWAVES * 64) + tid; it < (int)(4096 * 32); it += G * (NWAVES * 64)) { const int t = (int)(it >> 5), i = (int)(it & 31);
            const float inv = powf(10000.0f, -(float)i / 32.0f); const float ang = (float)t * inv; float sn, cs; sincosf(ang, &sn, &cs);
            ROPE[2 * it] = cs; ROPE[2 * it + 1] = sn; }
        LAS float* scr = (LAS float*)(ldsp + RING_OFF + wave * 16384);
        constexpr int I_IN = 16 * 145, I_OUT = 24 * 32, I_GU = 8 * 32, I_DN = 8 * 16, I_R = 16;
        constexpr int NIT = NLAYER * (I_IN + I_OUT + I_R) + NLAYER * NEXP * (I_GU + I_DN);
        for (int it = gw; it < NIT; it += NGW) {
            int r = it;
            if (r < NLAYER * I_IN) { const int l = r / I_IN; r %= I_IN; p0_transpose_item<1>(in_win + (size_t)l * DM * INW, DM, INW, WIN + (size_t)l * NPROJ * DM, WDT + (size_t)l * 8 * 1024, scr, r / 145, r % 145, lane); continue; } r -= NLAYER * I_IN;
            if (r < NLAYER * I_OUT) { const int l = r / I_OUT; r %= I_OUT; p0_transpose_item<0>(in_wout + (size_t)l * MIXW * DM, MIXW, DM, WOUT + (size_t)l * DM * MIXW, nullptr, scr, r / 32, r % 32, lane); continue; } r -= NLAYER * I_OUT;
            if (r < NLAYER * I_R) { const int l = r / I_R; r %= I_R; p0_transpose_item<0>(in_rw + (size_t)l * DM * NEXP, DM, NEXP, ROUT + (size_t)l * NEXP * DM, nullptr, scr, r, 0, lane); continue; } r -= NLAYER * I_R;
            if (r < NLAYER * NEXP * I_GU) { const int le = r / I_GU; r %= I_GU; p0_transpose_item8<2>(in_wgu + (size_t)le * DM * 2048, DM, 2048, WGU8 + (size_t)le * 2048 * DM, SC_WGU, scr, r / 32, r % 32, lane); continue; } r -= NLAYER * NEXP * I_GU;
            { const int le = r / I_DN; r %= I_DN; p0_transpose_item8<0>(in_wdn + (size_t)le * FF * DM, FF, DM, WDN8 + (size_t)le * DM * FF, SC_WDN, scr, r / 16, r % 16, lane); }
        }
        __syncthreads();
    }
    if (IN(0)) {
        for (int m = gw; m < MROWS; m += NGW) { const float* xr = in_x + (size_t)m * DM; bf16* ob = XB + (size_t)m * DM;
#pragma unroll
            for (int j = 0; j < 4; ++j) { const f32x4 v = *(const f32x4*)(xr + 4 * lane + 256 * j); v2u w; w.x = pk2(v[0], v[1]); w.y = pk2(v[2], v[3]); *(v2u*)(ob + 4 * lane + 256 * j) = w; } }
    }

    SEAM(0);
    run_layer<0>(args, lo, hi, bar);
    run_layer<1>(args, lo, hi, bar);
#undef IN
#undef SEAM
}

extern "C" void kernel_launch(void* const* d_in, const int* in_sizes, int n_in, void* d_out, int out_size, void* d_ws, size_t ws_size, hipStream_t stream) {
    static int grid = 0;
    if (grid == 0) {
        if (n_in != 20 || out_size != MROWS * DM || ws_size < WS_END) { fprintf(stderr, "kernel_launch: unexpected problem (n_in %d, out %d, ws %zu)\n", n_in, out_size, ws_size); grid = -1; return; }
        if (hipFuncSetAttribute((const void*)mk_fwd, hipFuncAttributeMaxDynamicSharedMemorySize, LDS_BYTES) != hipSuccess) { fprintf(stderr, "kernel_launch: hipFuncSetAttribute failed\n"); grid = -1; return; }
        int dev = 0, cus = 0, per_cu = 0;
        (void)hipGetDevice(&dev); (void)hipDeviceGetAttribute(&cus, hipDeviceAttributeMultiprocessorCount, dev);
        if (hipOccupancyMaxActiveBlocksPerMultiprocessor(&per_cu, (const void*)mk_fwd, NWAVES * 64, LDS_BYTES) != hipSuccess || per_cu < 1) fprintf(stderr, "kernel_launch: occupancy query says %d\n", per_cu);
        (void)hipGetLastError();
        grid = cus > 0 ? cus : 256;
    }
    if (grid < 0) return;
    (void)hipMemsetAsync((char*)d_ws + WS_CTL, 0, CTL_ZERO_BYTES, stream);
    Args a{};
    for (int i = 0; i < 20; ++i) a.in[i] = (const float*)d_in[i];
    a.out = (float*)d_out; a.ws = (unsigned char*)d_ws;
    a.ph_lo = 0; a.ph_hi = N_PHASES; a.sub = 7; a.pad = 0;
    hipLaunchKernelGGL(mk_fwd, dim3(grid), dim3(NWAVES * 64), LDS_BYTES, stream, a);
#ifdef PROBE_PH
#ifndef PROBE_SUB
#define PROBE_SUB 7
#endif
    for (int i = 0; i < PROBE_N; ++i) { a.ph_lo = PROBE_PH; a.ph_hi = PROBE_PH + 1; a.sub = PROBE_SUB; hipLaunchKernelGGL(mk_fwd, dim3(grid), dim3(NWAVES * 64), LDS_BYTES, stream, a); }
#endif
}
```

```cpp
#include <hip/hip_runtime.h>
#include <cstdio>
#include <cstdint>
#include <cmath>

namespace pg8 {
#define PG8_LAS __attribute__((address_space(3)))
typedef unsigned short bf16_t;
typedef short bf16x8 __attribute__((ext_vector_type(8)));
typedef float f32x4 __attribute__((ext_vector_type(4)));
typedef float f32x2 __attribute__((ext_vector_type(2)));
typedef unsigned u32x4 __attribute__((ext_vector_type(4)));
constexpr int BM = 256, BK = 64, HALF = 128, HTB = HALF * BK * 2  , STAGE_BYTES = 8 * HTB, NXCD = 8, WGM = 8;

__host__ __device__ __forceinline__ int lds_byte(int r, int c) { const int st = (r >> 4) * 2 + (c >> 5), rr = r & 15, cc = c & 31, ob = rr * 64 + cc * 2; return st * 1024 + (ob ^ (((ob >> 9) & 1) << 5)); }
__host__ __device__ __forceinline__ void stage_rc(int b, int& R, int& C) { const int st = b / 1024, sb = b % 1024, swz = sb ^ (((sb >> 9) & 1) << 5); R = (st >> 1) * 16 + swz / 64; C = (st & 1) * 32 + (swz % 64) / 2; }
__host__ __device__ __forceinline__ int perm32(int rho) { const int n = rho >> 4, i = rho & 15; return 8 * (i >> 2) + 4 * n + (i & 3); }

struct Unit { int pm, pn, e, r0; };
struct Gemm { const bf16_t* A; const bf16_t* Bt; int M, N, K; };

struct StaticOrder {
    int nM, nN, nwg, G, c;
    __device__ void init(int M, int N, int G_, int c_) { nM = M / BM; nN = N / BM; nwg = nM * nN; G = G_; c = c_; }
    __device__ __forceinline__ bool next(int i, Unit& u) const {
        const long L = (long)i * G + c; if (L >= nwg) return false;
        int wgid = (int)L; { const int q = nwg / NXCD, r = nwg % NXCD, xcd = wgid % NXCD, off = wgid / NXCD; wgid = (xcd < r ? xcd * (q + 1) : r * (q + 1) + (xcd - r) * q) + off; }
        const int nig = WGM * nN, gid = wgid / nig, fm = gid * WGM, gsz = (nM - fm) < WGM ? (nM - fm) : WGM;
        u.pm = fm + ((wgid % nig) % gsz); u.pn = (wgid % nig) / gsz; u.e = 0; u.r0 = 0; return true;
    }
    __device__ __forceinline__ const char* abase(const Unit& u, const Gemm& g, size_t tstep) const { return (const char*)g.A + (size_t)u.pm * tstep; }
    __device__ __forceinline__ const char* bbase(const Unit& u, const Gemm& g, size_t tstep) const { return (const char*)g.Bt + (size_t)u.pn * tstep; }
    static constexpr bool SIDE = false;
    __device__ __forceinline__ unsigned arow(const Unit&, int) const { return 0u; }
    __device__ __forceinline__ unsigned arow_side(const Unit&, int, const PG8_LAS unsigned char*) const { return 0u; }
    __device__ __forceinline__ const void* side_src(const Unit&, const Unit&, int, int) const { return nullptr; }
    __device__ __forceinline__ void a_ready(const Unit&) const {}
    __device__ __forceinline__ void done(const Unit&) const {}
};

struct MoeOrder {
    const PG8_LAS int* units;
    int nunits;
    const PG8_LAS int* cnt;
    const int* rowtok;
    int gather;
    unsigned rowbytes;
    size_t bstride;
    __device__ __forceinline__ bool next(int i, Unit& u) const {
        if (i >= nunits) return false;
        u.pm = __builtin_amdgcn_readfirstlane(units[4 * i + 0]); u.pn = __builtin_amdgcn_readfirstlane(units[4 * i + 1]);
        u.e = __builtin_amdgcn_readfirstlane(units[4 * i + 2]); u.r0 = __builtin_amdgcn_readfirstlane(units[4 * i + 3]); return true;
    }
    __device__ __forceinline__ const char* abase(const Unit& u, const Gemm& g, size_t tstep) const { return gather ? (const char*)g.A : (const char*)g.A + (size_t)u.pm * tstep; }
    __device__ __forceinline__ const char* bbase(const Unit& u, const Gemm& g, size_t tstep) const { return (const char*)g.Bt + (size_t)u.e * bstride + (size_t)u.pn * tstep; }
    static constexpr bool SIDE = true;
    const float* rowgate; const float* bgu;
    __device__ __forceinline__ unsigned arow(const Unit& u, int R) const {
        const int r = u.r0 + R; const int idx = (r < cnt[u.e]) ? rowtok[(size_t)u.e * 32768 + r] : 0; return (unsigned)(idx >> 2) * rowbytes; }
    __device__ __forceinline__ unsigned arow_side(const Unit& u, int R, const PG8_LAS unsigned char* sd) const {
        const int r = u.r0 + R; const int v = ((const PG8_LAS int*)sd)[R]; const int idx = (r < cnt[u.e]) ? v : 0; return (unsigned)(idx >> 2) * rowbytes; }
    __device__ __forceinline__ const void* side_src(const Unit& cur, const Unit& rt, int wid, int lane) const {
        if (rowgate != nullptr && wid == 1) return rowgate + (size_t)cur.e * 32768 + cur.r0 + 4 * lane;
        if (bgu != nullptr && wid == 2) return bgu + (size_t)cur.e * 2048 + (lane < 32 ? 0 : 1024 - 128) + cur.pn * 128 + 4 * lane;
        return rowtok + (size_t)rt.e * 32768 + rt.r0 + 4 * lane; }
    __device__ __forceinline__ void a_ready(const Unit&) const {}
    __device__ __forceinline__ void done(const Unit&) const {}
};
__device__ __forceinline__ void moe_build_units(PG8_LAS int* units, PG8_LAS int* units_n, const PG8_LAS int* tstart, int nN, int G, int c, int tid) {
    if (tid < 64) {
        const int nT = tstart[32], nwg = nT * nN; const long L = (long)tid * G + c;
        int pm = 0, pn = 0, e = 0, r0 = 0;
        if (L < nwg) {
            int wgid = (int)L; { const int q = nwg / NXCD, r = nwg % NXCD, xcd = wgid % NXCD, off = wgid / NXCD; wgid = (xcd < r ? xcd * (q + 1) : r * (q + 1) + (xcd - r) * q) + off; }
            const int nig = WGM * nN, gid = wgid / nig, fm = gid * WGM, gsz = (nT - fm) < WGM ? (nT - fm) : WGM;
            pm = fm + ((wgid % nig) % gsz); pn = (wgid % nig) / gsz;
            for (int j = 1; j < 32; ++j) e += (tstart[j] <= pm) ? 1 : 0;
            r0 = (pm - tstart[e]) * 256;
        }
        units[4 * tid + 0] = pm; units[4 * tid + 1] = pn; units[4 * tid + 2] = e; units[4 * tid + 3] = r0;
        if (tid == 0) { int n = 0; if (c < nwg) n = (nwg - c + G - 1) / G; units_n[0] = n < 64 ? n : 64; }
    }
}

typedef int v8i_t __attribute__((ext_vector_type(8)));
typedef int v4i_t __attribute__((ext_vector_type(4)));
__device__ __forceinline__ v8i_t cat8(bf16x8 lo, bf16x8 hi) { const v4i_t a = __builtin_bit_cast(v4i_t, lo), b = __builtin_bit_cast(v4i_t, hi); return __builtin_shufflevector(a, b, 0, 1, 2, 3, 4, 5, 6, 7); }
__device__ __forceinline__ void mfma8(f32x4& acc, v8i_t a, v8i_t b, int scl) { asm volatile("v_mfma_scale_f32_16x16x128_f8f6f4 %0, %1, %2, %0, %3, %3 op_sel_hi:[0,0,0]" : "+v"(acc) : "v"(a), "v"(b), "v"(scl)); }
__device__ __forceinline__ unsigned pk4_fp8(float a, float b, float c, float d) { unsigned w = 0u; w = __builtin_amdgcn_cvt_pk_fp8_f32(a, b, w, false); w = __builtin_amdgcn_cvt_pk_fp8_f32(c, d, w, true); return w; }
__device__ __forceinline__ unsigned cvt_pk_bf16(float lo, float hi) { unsigned r; asm volatile("v_cvt_pk_bf16_f32 %0, %1, %2" : "=v"(r) : "v"(lo), "v"(hi)); return r; }

struct EpiProj {
    static constexpr bool PERM = true, AFTER_DRAIN = false;
    bf16_t* O; int ldc; const float* rope; float qscale;
    __device__ __forceinline__ void operator()(const f32x4 (&acc)[2][2][4][2], const Unit& u, int wr, int wc, int fr, int fq, const PG8_LAS unsigned char* sd) const {
        const int row0 = u.pm * BM + wr * 64 + fr; const int col0 = u.pn * BM + wc * 32 + 8 * fq;
        const bool rot = u.pn < 4; const float sc = u.pn < 2 ? qscale : 1.f; const int gq = 4 * (wc & 1) + fq;
#pragma unroll
        for (int ai = 0; ai < 2; ++ai)
#pragma unroll
            for (int m = 0; m < 4; ++m) { const int row = row0 + ai * HALF + m * 16; bf16_t* rowp = O + (size_t)row * ldc + col0;
                f32x4 cs0 = (f32x4){1.f, 0.f, 1.f, 0.f}, cs1 = cs0;
                if (rot) { const float* rp = rope + ((size_t)(row & 4095) * 32 + 4 * gq) * 2; cs0 = *(const f32x4*)rp; cs1 = *(const f32x4*)(rp + 4); }
#pragma unroll
                for (int bj = 0; bj < 2; ++bj) { f32x4 v0 = acc[ai][bj][m][0], v1 = acc[ai][bj][m][1];
                    if (rot) { f32x4 lo, hi;
                        lo[0] = v0[0] * cs0[0] - v1[0] * cs0[1]; hi[0] = v1[0] * cs0[0] + v0[0] * cs0[1];
                        lo[1] = v0[1] * cs0[2] - v1[1] * cs0[3]; hi[1] = v1[1] * cs0[2] + v0[1] * cs0[3];
                        lo[2] = v0[2] * cs1[0] - v1[2] * cs1[1]; hi[2] = v1[2] * cs1[0] + v0[2] * cs1[1];
                        lo[3] = v0[3] * cs1[2] - v1[3] * cs1[3]; hi[3] = v1[3] * cs1[2] + v0[3] * cs1[3];
                        v0 = lo * sc; v1 = hi * sc; }
                    u32x4 w; w.x = cvt_pk_bf16(v0[0], v0[1]); w.y = cvt_pk_bf16(v0[2], v0[3]); w.z = cvt_pk_bf16(v1[0], v1[1]); w.w = cvt_pk_bf16(v1[2], v1[3]);
                    *(u32x4*)(rowp + bj * HALF) = w; } }
    }
};
struct EpiF32 {
    static constexpr bool PERM = false, AFTER_DRAIN = false;
    float* O; int ldc;
    __device__ __forceinline__ void operator()(const f32x4 (&acc)[2][2][4][2], const Unit& u, int wr, int wc, int fr, int fq, const PG8_LAS unsigned char* sd) const {
        const int row0 = u.pm * BM + wr * 64 + fr; const int col0 = u.pn * BM + wc * 32 + 4 * fq;
#pragma unroll
        for (int ai = 0; ai < 2; ++ai)
#pragma unroll
            for (int m = 0; m < 4; ++m) { float* rowp = O + (size_t)(row0 + ai * HALF + m * 16) * ldc + col0;
#pragma unroll
                for (int bj = 0; bj < 2; ++bj)
#pragma unroll
                    for (int n = 0; n < 2; ++n) *(f32x4*)(rowp + bj * HALF + n * 16) = acc[ai][bj][m][n]; }
    }
};
struct EpiSwiglu {
    static constexpr bool PERM = true, AFTER_DRAIN = false;
    unsigned char* H; const float* bgu; const float* rowgate; const PG8_LAS int* cnt; float dq, hscale;
    __device__ __forceinline__ void operator()(const f32x4 (&acc)[2][2][4][2], const Unit& u, int wr, int wc, int fr, int fq, const PG8_LAS unsigned char* sd) const {
        const int ff = u.pn * HALF + wc * 32 + 8 * fq; const int n_e = cnt[u.e];
        f32x4 bg[2], bu[2];
#pragma unroll
        for (int n = 0; n < 2; ++n) { bg[n] = *(const PG8_LAS f32x4*)(sd + 2048 + (wc * 32 + 8 * fq + 4 * n) * 4); bu[n] = *(const PG8_LAS f32x4*)(sd + 2048 + 512 + (wc * 32 + 8 * fq + 4 * n) * 4); }
#pragma unroll
        for (int ai = 0; ai < 2; ++ai)
#pragma unroll
            for (int m = 0; m < 4; ++m) { const int r = ai * HALF + wr * 64 + m * 16 + fr; const int er = u.r0 + r;
                const float rgl = ((const PG8_LAS float*)(sd + 1024))[r]; const float rg = ((er < n_e) ? rgl : 0.f) * hscale;
                float hv[8];
#pragma unroll
                for (int n = 0; n < 2; ++n)
#pragma unroll
                    for (int q = 0; q < 4; ++q) { float g = acc[ai][0][m][n][q] * dq + bg[n][q], up = acc[ai][1][m][n][q] * dq + bu[n][q];
                        g = fminf(g, 7.0f); up = fminf(fmaxf(up, -7.0f), 7.0f);
                        const float sg = __builtin_amdgcn_rcpf(1.0f + __builtin_amdgcn_exp2f(-1.702f * 1.4426950408889634f * g));
                        hv[n * 4 + q] = (up + 1.0f) * g * sg * rg; }
                u32x4 dummy; (void)dummy;
                unsigned w0 = pk4_fp8(hv[0], hv[1], hv[2], hv[3]), w1 = pk4_fp8(hv[4], hv[5], hv[6], hv[7]);
                typedef unsigned u32x2 __attribute__((ext_vector_type(2)));
                *(u32x2*)(H + (size_t)(u.pm * BM + r) * 1024 + ff) = (u32x2){w0, w1};
                asm volatile("" ::: "memory"); }
    }
};
struct EpiScatter {
    static constexpr bool PERM = true, AFTER_DRAIN = false;
    bf16_t* Y; const int* rowtok; const PG8_LAS int* cnt; float dq;
    __device__ __forceinline__ void operator()(const f32x4 (&acc)[2][2][4][2], const Unit& u, int wr, int wc, int fr, int fq, const PG8_LAS unsigned char* sd) const {
        const int col0 = u.pn * BM + wc * 32 + 8 * fq; const int n_e = cnt[u.e];
#pragma unroll
        for (int ai = 0; ai < 2; ++ai)
#pragma unroll
            for (int m = 0; m < 4; ++m) { const int er = u.r0 + ai * HALF + wr * 64 + m * 16 + fr;
                const int idx = ((const PG8_LAS int*)sd)[ai * HALF + wr * 64 + m * 16 + fr];
                if (er < n_e) { bf16_t* rowp = Y + (size_t)idx * 1024 + col0;
#pragma unroll
                    for (int bj = 0; bj < 2; ++bj) { const f32x4 v0 = acc[ai][bj][m][0] * dq, v1 = acc[ai][bj][m][1] * dq;
                        u32x4 w; w.x = cvt_pk_bf16(v0[0], v0[1]); w.y = cvt_pk_bf16(v0[2], v0[3]); w.z = cvt_pk_bf16(v1[0], v1[1]); w.w = cvt_pk_bf16(v1[2], v1[3]);
                        *(u32x4*)(rowp + bj * HALF) = w; } }
                asm volatile("" ::: "memory"); }
    }
};

template <class Epi, class Sched, bool ALIGN_EPI, bool GATHER, bool FP8 = false>
__device__ __forceinline__ void gemm_phase(PG8_LAS unsigned char* lds, const Gemm g, const Sched& S, const Epi& E) {
    const int tid = threadIdx.x, wid = __builtin_amdgcn_readfirstlane(tid >> 6), lane = tid & 63, wr = wid >> 2, wc = wid & 3, fr = lane & 15, fq = lane >> 4;
    const int K = g.K, nt = K / BK;
    unsigned voffB[2];
#pragma unroll
    for (int i = 0; i < 2; ++i) { int R, C; stage_rc(tid * 16 + i * 8192, R, C); const int Rb = Epi::PERM ? ((R & ~31) + perm32(R & 31)) : R;
        voffB[i] = (unsigned)(Rb * K + C) * 2u; }
    constexpr int SIDE_BYTES = 8192;
    PG8_LAS unsigned char* const side = lds + STAGE_BYTES;
    const size_t kstep = (size_t)(BK * 2);
    const size_t hstep = (size_t)HALF * K * 2;
    const size_t tstep = 2 * hstep;
    const unsigned ldsw = (unsigned)wid * 1024u;
    const int aoff = lds_byte(wr * 64 + fr, fq * 8), boff = lds_byte(wc * 32 + fr, fq * 8);
#define PG8_SA(b, h) (((b) * 2 + (h)) * HTB)
#define PG8_SB(b, h) ((4 + (b) * 2 + (h)) * HTB)
#define PG8_STAGE(bufoff, gbase, voff) do { _Pragma("unroll") for (int _i = 0; _i < 2; ++_i) \
        __builtin_amdgcn_global_load_lds((const unsigned*)((const char*)(gbase) + (voff)[_i]), (PG8_LAS unsigned*)(lds + (bufoff) + ldsw + _i * 8192), 16, 0, 0); } while (0)
#define PG8_LDA(dst, b, h) do { _Pragma("unroll") for (int m = 0; m < 4; ++m) _Pragma("unroll") for (int k = 0; k < 2; ++k) dst[m][k] = *(const PG8_LAS bf16x8*)(lds + PG8_SA(b, h) + aoff + m * 2048 + k * 1024); } while (0)
#define PG8_LDB(dst, b, h) do { _Pragma("unroll") for (int n = 0; n < 2; ++n) _Pragma("unroll") for (int k = 0; k < 2; ++k) dst[n][k] = *(const PG8_LAS bf16x8*)(lds + PG8_SB(b, h) + boff + n * 2048 + k * 1024); } while (0)
#define PG8_MMA(ai, bj, At, Bt) do { __builtin_amdgcn_s_setprio(1); _Pragma("unroll") for (int m = 0; m < 4; ++m) _Pragma("unroll") for (int n = 0; n < 2; ++n) { \
        if constexpr (FP8) mfma8(acc[ai][bj][m][n], cat8(Bt[n][0], Bt[n][1]), cat8(At[m][0], At[m][1]), scl8); \
        else { _Pragma("unroll") for (int k = 0; k < 2; ++k) acc[ai][bj][m][n] = __builtin_amdgcn_mfma_f32_16x16x32_bf16(Bt[n][k], At[m][k], acc[ai][bj][m][n], 0, 0, 0); } } __builtin_amdgcn_s_setprio(0); } while (0)
#define PG8_WAIT_V(n) asm volatile("s_waitcnt vmcnt(" #n ")" ::: "memory")
#define PG8_WAIT_L(n) asm volatile("s_waitcnt lgkmcnt(" #n ")" ::: "memory")
#define PG8_BAR __builtin_amdgcn_s_barrier()
#define PG8_SCHED __builtin_amdgcn_sched_barrier(0)
#define PG8_SETOFFS(o, u) do { _Pragma("unroll") for (int _h = 0; _h < 2; ++_h) _Pragma("unroll") for (int _i = 0; _i < 2; ++_i) { int _R, _C; stage_rc(tid * 16 + _i * 8192, _R, _C); \
        o[_h][_i] = GATHER ? (S.arow(u, _R + HALF * _h) + (unsigned)(_C * 2)) : ((unsigned)((_R + HALF * _h) * K) * 2u + (unsigned)(_C * 2)); } } while (0)
    int scl8 = 0x7F7F7F7F; asm volatile("" : "+v"(scl8));
    Unit cur, nxt; int ui = 0;
    if (!S.next(0, cur)) return;
    f32x4 acc[2][2][4][2];
#pragma unroll
    for (int a = 0; a < 2; ++a)
#pragma unroll
        for (int b = 0; b < 2; ++b)
#pragma unroll
            for (int m = 0; m < 4; ++m)
#pragma unroll
                for (int n = 0; n < 2; ++n) { acc[a][b][m][n] = (f32x4){0.f, 0.f, 0.f, 0.f}; if constexpr (FP8) asm volatile("" : "+v"(acc[a][b][m][n])); }
    bf16x8 At[4][2], B0[2][2], B1[2][2];
    unsigned cAo[2][2];
    PG8_SETOFFS(cAo, cur);
    const char* cA = S.abase(cur, g, tstep); const char* cB = S.bbase(cur, g, tstep);
    S.a_ready(cur);
    PG8_STAGE(PG8_SB(0, 0), cB, voffB); PG8_STAGE(PG8_SB(0, 1), cB + hstep, voffB); PG8_STAGE(PG8_SA(0, 0), cA, cAo[0]); PG8_STAGE(PG8_SA(0, 1), cA, cAo[1]);
    if (wr == 1) PG8_BAR;
    PG8_WAIT_V(2); PG8_BAR;
    PG8_STAGE(PG8_SB(1, 0), cB + kstep, voffB); PG8_STAGE(PG8_SA(1, 0), cA + kstep, cAo[0]); PG8_STAGE(PG8_SB(1, 1), cB + hstep + kstep, voffB);
    PG8_WAIT_V(6); PG8_BAR;
    for (;;) {
        const bool has_next = S.next(ui + 1, nxt);
        const char* nA = has_next ? S.abase(nxt, g, tstep) : cA; const char* nB = has_next ? S.bbase(nxt, g, tstep) : cB;
        if constexpr (Sched::SIDE) {
            const void* ssrc = S.side_src(cur, (GATHER && has_next) ? nxt : cur, wid, lane);
            __builtin_amdgcn_global_load_lds((const unsigned*)ssrc, (PG8_LAS unsigned*)(side + (ui & 1) * SIDE_BYTES + wid * 1024), 16, 0, 0); }
#pragma unroll 1
        for (int t = 0; t < nt; t += 2) {
            const bool last = (t == nt - 2);
            const char* a1 = cA + (size_t)(t + 1) * kstep;
            const char* a2 = last ? nA : cA + (size_t)(t + 2) * kstep; const char* b2 = last ? nB : cB + (size_t)(t + 2) * kstep;
            const char* a3 = a2 + kstep; const char* b3 = b2 + kstep;
            if (last && has_next) S.a_ready(nxt);
            PG8_LDB(B0, 0, 0); PG8_LDB(B1, 0, 1); PG8_SCHED; PG8_LDA(At, 0, 0); PG8_STAGE(PG8_SA(1, 1), a1, cAo[1]);
            if constexpr (GATHER) { if (last && has_next) {
                const PG8_LAS unsigned char* sdn = side + (ui & 1) * SIDE_BYTES;
#pragma unroll
                for (int _h = 0; _h < 2; ++_h)
#pragma unroll
                    for (int _i = 0; _i < 2; ++_i) { int _R, _C; stage_rc(tid * 16 + _i * 8192, _R, _C); cAo[_h][_i] = S.arow_side(nxt, _R + HALF * _h, sdn) + (unsigned)(_C * 2); } } }
            PG8_WAIT_V(8); PG8_WAIT_L(0); PG8_BAR; PG8_MMA(0, 0, At, B0); PG8_MMA(0, 1, At, B1); PG8_BAR; PG8_SCHED;
            PG8_LDA(At, 0, 1); PG8_STAGE(PG8_SB(0, 0), b2, voffB); PG8_STAGE(PG8_SB(0, 1), b2 + hstep, voffB); PG8_STAGE(PG8_SA(0, 0), a2, cAo[0]);
            PG8_WAIT_V(8); PG8_WAIT_L(0); PG8_BAR; PG8_MMA(1, 0, At, B0); PG8_MMA(1, 1, At, B1); PG8_BAR; PG8_SCHED;
            PG8_LDB(B0, 1, 0); PG8_LDB(B1, 1, 1); PG8_SCHED; PG8_LDA(At, 1, 0); PG8_STAGE(PG8_SA(0, 1), a2, cAo[1]);
            PG8_WAIT_V(8); PG8_WAIT_L(0); PG8_BAR; PG8_MMA(0, 0, At, B0); PG8_MMA(0, 1, At, B1); PG8_BAR; PG8_SCHED;
            PG8_LDA(At, 1, 1); PG8_STAGE(PG8_SB(1, 0), b3, voffB); PG8_STAGE(PG8_SB(1, 1), b3 + hstep, voffB); PG8_STAGE(PG8_SA(1, 0), a3, cAo[0]);
            PG8_WAIT_V(8); PG8_WAIT_L(0); PG8_BAR; PG8_MMA(1, 0, At, B0); PG8_MMA(1, 1, At, B1); PG8_BAR; PG8_SCHED;
        }
        if constexpr (ALIGN_EPI) { if (wr == 0) PG8_BAR; }
        if constexpr (FP8) asm volatile("s_nop 15\n\ts_nop 15" ::: "memory");
        PG8_SCHED; E(acc, cur, wr, wc, fr, fq, side + (ui & 1) * SIDE_BYTES); S.done(cur); PG8_SCHED;
        if (!has_next) break;
#pragma unroll
        for (int a = 0; a < 2; ++a)
#pragma unroll
            for (int b = 0; b < 2; ++b)
#pragma unroll
                for (int m = 0; m < 4; ++m)
#pragma unroll
                    for (int n = 0; n < 2; ++n) { acc[a][b][m][n] = (f32x4){0.f, 0.f, 0.f, 0.f}; if constexpr (FP8) asm volatile("" : "+v"(acc[a][b][m][n])); }
        cur = nxt; cA = nA; cB = nB; ++ui;
        if constexpr (ALIGN_EPI) { if (wr == 1) PG8_BAR; }
    }
    PG8_WAIT_V(0);
    if constexpr (!ALIGN_EPI) { if (wr == 0) PG8_BAR; }
    PG8_BAR;
#undef PG8_SA
#undef PG8_SB
#undef PG8_STAGE
#undef PG8_LDA
#undef PG8_LDB
#undef PG8_MMA
#undef PG8_WAIT_V
#undef PG8_WAIT_L
#undef PG8_BAR
#undef PG8_SCHED
#undef PG8_SETOFFS
}
}

constexpr int NB = 8, SEQ = 4096, DM = 1024, MROWS = NB * SEQ, NLAYER = 2;
constexpr int NPROJ = 4608, INW = 4616;
constexpr int C_Q = 0, C_K = 512, C_V = 1024, C_Z = 1536, C_XS = 2048, C_SB = 3072, C_SC = 3584, C_SH = 4096;
constexpr int MIXW = 1536, NEXP = 32, TOPK = 4, FF = 1024;
constexpr float ALPHA = 1.4142135623730951f;
constexpr float LN_EPS = 1e-5f, RMS_EPS = 1e-5f;
constexpr float QSCALE = 0.125f * 1.4426950408889634f;

constexpr size_t MiB = 1u << 20;
constexpr size_t WS_CTL = 0, CTL_ZERO_BYTES = 1 * MiB;
constexpr size_t WS_ROPE = 1 * MiB;
constexpr size_t WS_WDT = 2 * MiB;
constexpr size_t WS_ROUT = 2 * MiB + 65536;
constexpr size_t WS_WIN = 4 * MiB;
constexpr size_t WS_WOUT = 24 * MiB;
constexpr size_t WS_WGU = 32 * MiB;
constexpr size_t WS_WDN = 288 * MiB;
constexpr size_t WS_XB = 416 * MiB;
constexpr size_t WS_XF = 480 * MiB;
constexpr size_t WS_XF2 = 608 * MiB;
constexpr size_t WS_PROJ = 736 * MiB;
constexpr size_t WS_DT = 1024 * MiB;
constexpr size_t WS_DTS = 1025 * MiB;
constexpr size_t WS_ACUM = 1026 * MiB;
constexpr size_t WS_LSE = 1027 * MiB;
constexpr size_t WS_OP = 1030 * MiB;
constexpr size_t WS_U = 1126 * MiB;
constexpr size_t WS_G = 1190 * MiB;
constexpr size_t WS_ST = 1222 * MiB;
constexpr size_t WS_YD = 1286 * MiB;
constexpr size_t WS_MIXED = 1350 * MiB;
constexpr size_t WS_MIXF = 1446 * MiB;
constexpr size_t WS_TOPE = 1574 * MiB;
constexpr size_t WS_TOPG = 1575 * MiB;
constexpr size_t WS_ROWTOK = 1576 * MiB;
constexpr size_t WS_ROWGATE = 1580 * MiB;
constexpr size_t WS_H = 736 * MiB;
constexpr size_t WS_YB = 1030 * MiB;
constexpr size_t WS_END = 1584 * MiB;
constexpr int CW_TMO = 0;
constexpr int CW_CNT = 64;
constexpr int CW_BAR = 4096;

constexpr int RING_OFF = 0, RING_BYTES = 131072;
constexpr int LDSCTL_OFF = 155648;
constexpr int L_MISC = LDSCTL_OFF;
constexpr int L_TSTART = LDSCTL_OFF + 256;
constexpr int L_CNT = LDSCTL_OFF + 512;
constexpr int L_LCNT = LDSCTL_OFF + 640;
constexpr int L_LBASE = LDSCTL_OFF + 768;
constexpr int L_UNITS = LDSCTL_OFF + 1024;
constexpr int L_UNITSN = LDSCTL_OFF + 2048;
constexpr int LDS_BYTES = 163840;

#define GAS __attribute__((address_space(1)))
#define LAS __attribute__((address_space(3)))
typedef unsigned short bf16;
typedef unsigned v4u __attribute__((ext_vector_type(4)));
typedef unsigned v2u __attribute__((ext_vector_type(2)));
typedef float f32x4 __attribute__((ext_vector_type(4)));
typedef float f32x16 __attribute__((ext_vector_type(16)));
typedef short bf16x8 __attribute__((ext_vector_type(8)));
typedef GAS unsigned gu32;
#define RLX_AGENT __ATOMIC_RELAXED, __HIP_MEMORY_SCOPE_AGENT
#define LDS_WAIT() asm volatile("s_waitcnt lgkmcnt(0)" ::: "memory")
#define VM_WAIT() asm volatile("s_waitcnt vmcnt(0)" ::: "memory")
__device__ __forceinline__ unsigned f2bf(float f) { unsigned u = __builtin_bit_cast(unsigned, f); return (u + 0x7fffu + ((u >> 16) & 1u)) >> 16; }
__device__ __forceinline__ unsigned pk2(float lo, float hi) { return f2bf(lo) | (f2bf(hi) << 16); }
__device__ __forceinline__ float bf2f(unsigned short b) { return __builtin_bit_cast(float, (unsigned)b << 16); }
__device__ __forceinline__ float bflo(unsigned w) { return __builtin_bit_cast(float, w << 16); }
__device__ __forceinline__ float bfhi(unsigned w) { return __builtin_bit_cast(float, w & 0xffff0000u); }
__device__ __forceinline__ float siluf(float x) { return x / (1.0f + __expf(-x)); }
#define XB_TMO      128
#define XB_XCNT(j)  (256  + 64 * (j))
#define XB_XSUB(j)  (1280 + 64 * (j))
#define XB_XGEN(j)  (2304 + 64 * (j))
#define XB_TOP      3328
#define XB_TOPGEN   3392
#define XCD_BAR_WORDS 3456
#define XB_SPIN_CAP (1u << 18)

__device__ __forceinline__ unsigned xb_ld(unsigned* p)              { return __hip_atomic_load(p, __ATOMIC_RELAXED, __HIP_MEMORY_SCOPE_AGENT); }
__device__ __forceinline__ unsigned xb_add(unsigned* p, unsigned v) { return __hip_atomic_fetch_add(p, v, __ATOMIC_RELAXED, __HIP_MEMORY_SCOPE_AGENT); }
__device__ __forceinline__ unsigned xb_xcc_id() { return (unsigned)__builtin_amdgcn_s_getreg((3 << 11) | 20) & 0xFu; }
#define XB_SPIN(cond, bar) do { unsigned _sp = 0; while (cond) { __builtin_amdgcn_s_sleep(1); \
    if ((++_sp & 255u) == 0u) { if (xb_ld(&(bar)[XB_TMO])) break; if (_sp > XB_SPIN_CAP) { atomicAdd(&(bar)[XB_TMO], 1u); break; } } } } while (0)

struct XcdBarrier {
    unsigned* bar; unsigned x;
    volatile LAS unsigned* st;
};

__device__ __forceinline__ XcdBarrier xcd_barrier_post(unsigned* bar, volatile LAS unsigned* st) {
    XcdBarrier b; b.bar = bar; b.x = xb_xcc_id(); b.st = st;
    if (threadIdx.x == 0) (void)xb_add(&bar[XB_XCNT(b.x)], 1u);
    return b;
}
__device__ __forceinline__ void xcd_barrier_complete(unsigned* bar, unsigned x, unsigned& nloc, unsigned& nx) {
    const unsigned G = gridDim.x * gridDim.y * gridDim.z;
    unsigned sum, cnt, mine, sp = 0u;
    for (;;) {
        sum = 0u; cnt = 0u; mine = 0u;
#pragma unroll
        for (unsigned j = 0; j < 16; ++j) { const unsigned c = xb_ld(&bar[XB_XCNT(j)]); sum += c; cnt += (c > 0u) ? 1u : 0u; mine = (j == x) ? c : mine; }
        if (sum == G) break;
        __builtin_amdgcn_s_sleep(1);
        if ((++sp & 255u) == 0u) { if (xb_ld(&bar[XB_TMO])) break; if (sp > XB_SPIN_CAP) { atomicAdd(&bar[XB_TMO], 1u); break; } }
    }
    nloc = mine > 0u ? mine : 1u; nx = cnt > 0u ? cnt : 1u;
}

__device__ __forceinline__ void xcd_barrier(const XcdBarrier& b) {
    asm volatile("s_waitcnt vmcnt(0)" ::: "memory");
    __syncthreads();
    if (threadIdx.x == 0) {
        unsigned* bar = b.bar;
        __builtin_amdgcn_s_waitcnt(0);
        unsigned nloc = b.st[0], nx = b.st[1];
        if (nloc == 0u) { xcd_barrier_complete(bar, b.x, nloc, nx); b.st[0] = nloc; b.st[1] = nx; }
        const unsigned old = xb_add(&bar[XB_XSUB(b.x)], 1u);
        const unsigned gen = old / nloc;
        if (old + 1u == (gen + 1u) * nloc) {
            __builtin_amdgcn_fence(__ATOMIC_RELEASE, "agent");
            asm volatile("s_waitcnt vmcnt(0)" ::: "memory");
            const unsigned og = xb_add(&bar[XB_TOP], 1u);
            const unsigned tg = og / nx;
            if (og + 1u == (tg + 1u) * nx) xb_add(&bar[XB_TOPGEN], 1u);
            else XB_SPIN(xb_ld(&bar[XB_TOPGEN]) == tg, bar);
            __builtin_amdgcn_fence(__ATOMIC_ACQUIRE, "agent");
            xb_add(&bar[XB_XGEN(b.x)], 1u);
            asm volatile("s_waitcnt vmcnt(0)" ::: "memory");
        } else {
            XB_SPIN(xb_ld(&bar[XB_XGEN(b.x)]) == gen, bar);
            __builtin_amdgcn_fence(__ATOMIC_ACQUIRE, "agent");
            asm volatile("s_waitcnt vmcnt(0)" ::: "memory");
        }
    }
    __syncthreads();
}

constexpr float SC_X = 4.f, SC_WGU = 32.f, SC_H = 4.f, SC_WDN = 64.f;
__device__ __forceinline__ float wave_sum(float v) {
#pragma unroll
    for (int o = 1; o < 64; o <<= 1) v += __shfl_xor(v, o);
    return v;
}
__device__ __forceinline__ int win_dest_row(int n) {
    if (n < 1024) { const int hh = n >> 6, d = n & 63; const int p = (d < 32) ? (8 * (d >> 2) + (d & 3)) : (8 * ((d - 32) >> 2) + 4 + (d & 3)); return hh * 64 + p; }
    if (n < 3072) return n;
    if (n < 3080) return -1;
    return n - 8;
}
__device__ __forceinline__ int wgu_dest_row(int n) { return n < 1024 ? ((n >> 7) * 256 + (n & 127)) : (((n - 1024) >> 7) * 256 + 128 + ((n - 1024) & 127)); }
template <int MAP>
__device__ __forceinline__ void p0_transpose_item(const float* W, int K, int N, bf16* WT, float* wdt, LAS float* scr, int kb, int nb, int lane) {
    const int k0 = 64 * kb, n0 = 32 * nb;
    const int nn = n0 + (lane & 31); const bool nok = nn < N;
#pragma unroll 8
    for (int i = 0; i < 32; ++i) { const int kk = 2 * i + (lane >> 5); scr[kk * 33 + (lane & 31)] = nok ? W[(size_t)(k0 + kk) * N + nn] : 0.f; }
    LDS_WAIT(); asm volatile("" ::: "memory");
    const int c = lane & 7;
#pragma unroll
    for (int j = 0; j < 4; ++j) { const int n = (lane >> 3) + 8 * j; const LAS float* s = scr + (8 * c) * 33 + n;
        const int nsrc = n0 + n; if (nsrc >= N) continue;
        int drow = nsrc; if (MAP == 1) drow = win_dest_row(nsrc); if (MAP == 2) drow = wgu_dest_row(nsrc);
        if (MAP == 1 && drow < 0) { float* d = wdt + (size_t)(nsrc - 3072) * 1024 + k0 + 8 * c;
#pragma unroll
            for (int q = 0; q < 8; ++q) d[q] = s[q * 33]; continue; }
        v4u o; o.x = pk2(s[0 * 33], s[1 * 33]); o.y = pk2(s[2 * 33], s[3 * 33]); o.z = pk2(s[4 * 33], s[5 * 33]); o.w = pk2(s[6 * 33], s[7 * 33]);
        *(GAS v4u*)(WT + (size_t)drow * K + k0 + 8 * c) = o; }
    LDS_WAIT(); asm volatile("" ::: "memory");
}
struct SubT { const float* src; unsigned char* dst; int N; int dmap; float scale; };
__device__ __forceinline__ SubT fp8_subtile(int item, int half, const float* wgu, const float* wdn, unsigned char* WG8, unsigned char* WD8, int lane) {
    SubT t; int kb, nb, n0;
    if (item < 64 * 256) { const int le = item >> 8, r = item & 255; kb = r >> 5; nb = r & 31; n0 = 64 * nb; t.N = 2048; t.dmap = 1; t.scale = SC_WGU;
        t.src = wgu + (size_t)le * 1024 * 2048; t.dst = WG8 + (size_t)le * 2048 * 1024; }
    else { const int it2 = item - 64 * 256; const int le = it2 >> 7, r = it2 & 127; kb = r >> 4; nb = r & 15; n0 = 64 * nb; t.N = 1024; t.dmap = 0; t.scale = SC_WDN;
        t.src = wdn + (size_t)le * 1024 * 1024; t.dst = WD8 + (size_t)le * 1024 * 1024; }
    const int k0 = 128 * kb + 64 * half;
    t.src += (size_t)(k0 + (lane >> 4)) * t.N + n0 + 4 * (lane & 15);
    t.dst += (size_t)k0; t.dmap = t.dmap ? -(n0 + 1) : n0;
    return t;
}
__device__ __forceinline__ void fp8_sub_load(const SubT& t, f32x4 (&ld)[16]) {
#pragma unroll
    for (int i = 0; i < 16; ++i) ld[i] = __builtin_nontemporal_load((const f32x4*)(t.src + (size_t)(4 * i) * t.N));
}
__device__ __forceinline__ void fp8_sub_process(const SubT& t, const f32x4 (&ld)[16], LAS float* scr, int lane) {
#pragma unroll
    for (int i = 0; i < 16; ++i) *(LAS f32x4*)(scr + (4 * i + (lane >> 4)) * 64 + 4 * (lane & 15)) = ld[i];
    LDS_WAIT(); asm volatile("" ::: "memory");
    unsigned w[16];
#pragma unroll
    for (int q = 0; q < 16; ++q) w[q] = pg8::pk4_fp8(scr[(4 * q + 0) * 64 + lane] * t.scale, scr[(4 * q + 1) * 64 + lane] * t.scale, scr[(4 * q + 2) * 64 + lane] * t.scale, scr[(4 * q + 3) * 64 + lane] * t.scale);
    LDS_WAIT(); asm volatile("" ::: "memory");
    LAS unsigned char* t2 = (LAS unsigned char*)scr;
#pragma unroll
    for (int q = 0; q < 4; ++q) *(LAS v4u*)(t2 + lane * 80 + 16 * q) = (v4u){w[4 * q], w[4 * q + 1], w[4 * q + 2], w[4 * q + 3]};
    LDS_WAIT(); asm volatile("" ::: "memory");
#pragma unroll
    for (int q = 0; q < 4; ++q) { const int n = 16 * q + (lane >> 2); const v4u v = *(const LAS v4u*)(t2 + n * 80 + 16 * (lane & 3));
        const int nn = (t.dmap < 0) ? wgu_dest_row(-t.dmap - 1 + n) : (t.dmap + n);
        *(GAS v4u*)(t.dst + (size_t)nn * 1024 + 16 * (lane & 3)) = v; }
    LDS_WAIT(); asm volatile("" ::: "memory");
}
__device__ __forceinline__ void row_dt(const f32x4 (&v)[4], const float* wdt, float* dst, int lane) {
    float r[8];
#pragma unroll
    for (int jj = 0; jj < 8; ++jj) { float s = 0.f;
#pragma unroll
        for (int j = 0; j < 4; ++j) { const f32x4 w = *(const f32x4*)(wdt + jj * 1024 + 4 * lane + 256 * j); s += v[j][0] * w[0] + v[j][1] * w[1] + v[j][2] * w[2] + v[j][3] * w[3]; }
        r[jj] = wave_sum(s); }
    if (lane == 0) { *(f32x4*)dst = (f32x4){r[0], r[1], r[2], r[3]}; *(f32x4*)(dst + 4) = (f32x4){r[4], r[5], r[6], r[7]}; }
}
template <bool W8, bool WF>
__device__ __forceinline__ void ln_row(f32x4 (&v)[4], const float* gam, const float* bet, float* of32, bf16* ob16, unsigned char* o8, float s8, int lane) {
    float s = 0.f;
#pragma unroll
    for (int j = 0; j < 4; ++j) s += (v[j][0] + v[j][1]) + (v[j][2] + v[j][3]);
    const float mean = wave_sum(s) * (1.f / DM); float s2 = 0.f;
#pragma unroll
    for (int j = 0; j < 4; ++j) { v[j] = v[j] - mean; s2 += (v[j][0] * v[j][0] + v[j][1] * v[j][1]) + (v[j][2] * v[j][2] + v[j][3] * v[j][3]); }
    const float rstd = 1.f / sqrtf(wave_sum(s2) * (1.f / DM) + LN_EPS);
#pragma unroll
    for (int j = 0; j < 4; ++j) { const f32x4 g = *(const f32x4*)(gam + 4 * lane + 256 * j), b = *(const f32x4*)(bet + 4 * lane + 256 * j);
        v[j] = v[j] * rstd * g + b;
        if (WF) *(f32x4*)(of32 + 4 * lane + 256 * j) = v[j];
        v2u w; w.x = pk2(v[j][0], v[j][1]); w.y = pk2(v[j][2], v[j][3]); *(v2u*)(ob16 + 4 * lane + 256 * j) = w;
        if (W8) *(unsigned*)(o8 + 4 * lane + 256 * j) = pg8::pk4_fp8(v[j][0] * s8, v[j][1] * s8, v[j][2] * s8, v[j][3] * s8); }
}


typedef short v4i16_t __attribute__((ext_vector_type(4)));
__device__ __forceinline__ bf16x8 tr_pair(const LAS unsigned char* p0, const LAS unsigned char* p1) {
    const v4i16_t a = __builtin_amdgcn_ds_read_tr16_b64_v4i16((LAS v4i16_t*)p0), b = __builtin_amdgcn_ds_read_tr16_b64_v4i16((LAS v4i16_t*)p1);
    return (bf16x8){a[0], a[1], a[2], a[3], b[0], b[1], b[2], b[3]};
}
__device__ __forceinline__ int crow16(int r, int hi) { return (r & 3) + 8 * (r >> 2) + 4 * hi; }
constexpr int AK_PITCH = 144, AV_PITCH = 192, AK_TILE = 32 * AK_PITCH, AV_TILE = 32 * AV_PITCH;
constexpr int AT_K = 0, AT_V = 12 * AK_TILE;
struct AttnItem { int p, b, h, d, r, qt0; };
__device__ __forceinline__ AttnItem attn_item(int I) { AttnItem a; a.p = I >> 10; const int rem = I & 1023; a.b = rem >> 7; a.h = (rem >> 4) & 7; const int grp = rem & 15;
    a.d = (a.p == 0) ? 1 : (a.p == 1) ? 4 : 16; const int tpr = 128 / a.d; const int T = grp * 8; a.r = T / tpr; a.qt0 = T % tpr; return a; }
__device__ __forceinline__ void attn_request(const bf16* PROJ, const AttnItem& a, v4u (&st)[12], int tid) {
    const int rr = tid >> 4, ch = tid & 15; const int col = (ch < 8 ? C_K : C_V - 64) + a.h * 64 + ch * 8;
#pragma unroll
    for (int tl = 0; tl < 12; ++tl) { const int kt = a.qt0 - 4 + tl; st[tl] = (v4u){0u, 0u, 0u, 0u};
        if (kt >= 0) { const size_t row = (size_t)a.b * SEQ + (size_t)(32 * kt + rr) * a.d + a.r; st[tl] = *(const v4u*)(PROJ + row * NPROJ + col); } }
}
__device__ __forceinline__ void attn_deposit(LAS unsigned char* al, const v4u (&st)[12], int tid) {
    const int rr = tid >> 4, ch = tid & 15;
    LAS unsigned char* dst = (ch < 8) ? (al + AT_K + rr * AK_PITCH + ch * 16) : (al + AT_V + rr * AV_PITCH + (ch - 8) * 16); const int tstep = (ch < 8) ? AK_TILE : AV_TILE;
#pragma unroll
    for (int tl = 0; tl < 12; ++tl) *(LAS v4u*)(dst + tl * tstep) = st[tl];
}
__device__ __forceinline__ void attn_wave_compute(const bf16* PROJ, bf16* OPp, float* LSEp, const AttnItem& a, const LAS unsigned char* al, int wave, int lane) {
    const int i = lane & 31, h2 = lane >> 5; const int qt = a.qt0 + wave;
    const size_t rowq = (size_t)a.b * SEQ + (size_t)(32 * qt + i) * a.d + a.r;
    bf16x8 qf[4];
    { const bf16* qp = PROJ + rowq * NPROJ + C_Q + a.h * 64 + 8 * h2;
#pragma unroll
      for (int s = 0; s < 4; ++s) qf[s] = *(const bf16x8*)(qp + 16 * s); }
    f32x16 o0 = {}, o1 = {}; float mrun = -INFINITY, lrun = 0.f;
    const int kt0 = qt > 4 ? qt - 4 : 0;
    const LAS unsigned char* krd = al + AT_K + i * AK_PITCH + 16 * h2;
    const LAS unsigned char* trb = al + AT_V + (4 * h2 + ((lane & 15) >> 2)) * AV_PITCH + (16 * ((lane >> 4) & 1) + 4 * (lane & 3)) * 2;
#pragma unroll 1
    for (int kt = kt0; kt <= qt; ++kt) {
        const int tl = kt - a.qt0 + 4;
        const LAS unsigned char* kp = krd + tl * AK_TILE; const LAS unsigned char* vp = trb + tl * AV_TILE;
        f32x16 sacc = {};
#pragma unroll
        for (int s = 0; s < 4; ++s) sacc = __builtin_amdgcn_mfma_f32_32x32x16_bf16(*(const LAS bf16x8*)(kp + 32 * s), qf[s], sacc, 0, 0, 0);
        if (kt == qt) {
#pragma unroll
            for (int rg = 0; rg < 16; ++rg) if (crow16(rg, h2) > i) sacc[rg] = -INFINITY;
        }
        if (kt + 4 == qt) {
#pragma unroll
            for (int rg = 0; rg < 16; ++rg) if (crow16(rg, h2) < i) sacc[rg] = -INFINITY;
        }
        float mx = sacc[0];
#pragma unroll
        for (int rg = 1; rg < 16; ++rg) mx = fmaxf(mx, sacc[rg]);
        mx = fmaxf(mx, __shfl_xor(mx, 32));
        const float mnew = fmaxf(mrun, mx), alpha = __builtin_amdgcn_exp2f(mrun - mnew); mrun = mnew;
        float ps = 0.f;
#pragma unroll
        for (int rg = 0; rg < 16; ++rg) { sacc[rg] = __builtin_amdgcn_exp2f(sacc[rg] - mnew); ps += sacc[rg]; }
        lrun = lrun * alpha + ps;
#pragma unroll
        for (int rg = 0; rg < 16; ++rg) { o0[rg] *= alpha; o1[rg] *= alpha; }
        bf16x8 pf[2];
#pragma unroll
        for (int ks = 0; ks < 2; ++ks) { v4u w; w.x = pg8::cvt_pk_bf16(sacc[8 * ks + 0], sacc[8 * ks + 1]); w.y = pg8::cvt_pk_bf16(sacc[8 * ks + 2], sacc[8 * ks + 3]); w.z = pg8::cvt_pk_bf16(sacc[8 * ks + 4], sacc[8 * ks + 5]); w.w = pg8::cvt_pk_bf16(sacc[8 * ks + 6], sacc[8 * ks + 7]); pf[ks] = __builtin_bit_cast(bf16x8, w); }
#pragma unroll
        for (int ks = 0; ks < 2; ++ks) {
            const bf16x8 v0 = tr_pair(vp + (16 * ks) * AV_PITCH, vp + (16 * ks + 8) * AV_PITCH);
            const bf16x8 v1 = tr_pair(vp + (16 * ks) * AV_PITCH + 64, vp + (16 * ks + 8) * AV_PITCH + 64);
            o0 = __builtin_amdgcn_mfma_f32_32x32x16_bf16(v0, pf[ks], o0, 0, 0, 0);
            o1 = __builtin_amdgcn_mfma_f32_32x32x16_bf16(v1, pf[ks], o1, 0, 0, 0);
        }
    }
    const float lt = lrun + __shfl_xor(lrun, 32); const float il = 1.0f / lt;
    bf16* op = OPp + rowq * 512 + a.h * 64 + 4 * h2;
#pragma unroll
    for (int g4 = 0; g4 < 4; ++g4) {
        v2u w0, w1; w0.x = pg8::cvt_pk_bf16(o0[4 * g4 + 0] * il, o0[4 * g4 + 1] * il); w0.y = pg8::cvt_pk_bf16(o0[4 * g4 + 2] * il, o0[4 * g4 + 3] * il);
        w1.x = pg8::cvt_pk_bf16(o1[4 * g4 + 0] * il, o1[4 * g4 + 1] * il); w1.y = pg8::cvt_pk_bf16(o1[4 * g4 + 2] * il, o1[4 * g4 + 3] * il);
        *(v2u*)(op + 8 * g4) = w0; *(v2u*)(op + 32 + 8 * g4) = w1; }
    if (h2 == 0) LSEp[rowq * 8 + a.h] = mrun + log2f(lt);
}
__device__ __forceinline__ void attn_phase(LAS unsigned char* al, const bf16* PROJ, bf16* OP, float* LSE, int bid, int G, int tid, int wave, int lane) {
    v4u st[12];
    int I = bid;
    if (I < 3072) { const AttnItem a = attn_item(I); attn_request(PROJ, a, st, tid); }
    for (; I < 3072; I += G) {
        const AttnItem a = attn_item(I);
        __syncthreads();
        attn_deposit(al, st, tid);
        __syncthreads();
        if (I + G < 3072) { const AttnItem n = attn_item(I + G); attn_request(PROJ, n, st, tid); }
        attn_wave_compute(PROJ, OP + (size_t)a.p * MROWS * 512, LSE + (size_t)a.p * MROWS * 8, a, al, wave, lane);
    }
    __syncthreads();
}

constexpr int SS_DTS = 0, SS_ACUM = 2048, SS_TMP = 4096, SS_SSX = 6144, SS_IMG = 8192;
constexpr int S1_PB = 320, S1_PX = 576;
constexpr int S1_B = SS_IMG, S1_X = SS_IMG + 128 * S1_PB;
constexpr int S3_PBC = 272, S3_PX = 576;
constexpr int S3_B = SS_IMG, S3_C = S3_B + 128 * S3_PBC, S3_X = S3_C + 128 * S3_PBC;

__device__ __forceinline__ void ssd_prep(LAS unsigned char* sl, const float* DT, const float* dtb, const float* alog, size_t row0, int g, int tid, int lane, int wave) {
    LAS float* dts = (LAS float*)(sl + SS_DTS); LAS float* acum = (LAS float*)(sl + SS_ACUM); LAS float* tmp = (LAS float*)(sl + SS_TMP);
    { const int l = tid >> 2, hq = tid & 3; const float x = DT[(row0 + l) * 8 + 4 * g + hq] + dtb[4 * g + hq];
      const float dt = x > 20.f ? x : log1pf(__expf(x)); dts[hq * 128 + l] = dt; tmp[hq * 128 + l] = dt * (-__expf(alog[4 * g + hq])); }
    __syncthreads();
    if (wave < 4) { const float v0 = tmp[wave * 128 + 2 * lane], v1 = tmp[wave * 128 + 2 * lane + 1]; float s = v0 + v1;
#pragma unroll
        for (int off = 1; off < 64; off <<= 1) { const float t = __shfl_up(s, off); if (lane >= off) s += t; }
        acum[wave * 128 + 2 * lane] = s - v1; acum[wave * 128 + 2 * lane + 1] = s; }
    __syncthreads();
}
template <int NCOLS, int FACMODE>
__device__ __forceinline__ void conv_tile(const bf16* PROJ, size_t row0, int t0, int pcol0, const float* cw, const float* cb, int cch0, LAS unsigned char* dst, int pitch, const LAS unsigned char* sl, int hq0, int tid) {
    constexpr int NCH8 = NCOLS / 8, NSEG = 512 / NCH8, RPS = 128 / NSEG;
    const int c8 = tid % NCH8, seg = tid / NCH8, l0 = seg * RPS;
    float w[4][8], bias[8], hst[3][8];
#pragma unroll
    for (int k = 0; k < 4; ++k) { const f32x4 a = *(const f32x4*)(cw + k * 1024 + cch0 + c8 * 8), b = *(const f32x4*)(cw + k * 1024 + cch0 + c8 * 8 + 4);
        w[k][0] = a[0]; w[k][1] = a[1]; w[k][2] = a[2]; w[k][3] = a[3]; w[k][4] = b[0]; w[k][5] = b[1]; w[k][6] = b[2]; w[k][7] = b[3]; }
    { const f32x4 a = *(const f32x4*)(cb + cch0 + c8 * 8), b = *(const f32x4*)(cb + cch0 + c8 * 8 + 4);
      bias[0] = a[0]; bias[1] = a[1]; bias[2] = a[2]; bias[3] = a[3]; bias[4] = b[0]; bias[5] = b[1]; bias[6] = b[2]; bias[7] = b[3]; }
    const bf16* src = PROJ + pcol0 + c8 * 8;
#pragma unroll
    for (int k = 0; k < 3; ++k) { const int l = l0 - 3 + k; v4u v = (v4u){0u, 0u, 0u, 0u}; if (t0 + l >= 0) v = *(const v4u*)(src + (size_t)((long)row0 + l) * NPROJ);
        hst[k][0] = bflo(v.x); hst[k][1] = bfhi(v.x); hst[k][2] = bflo(v.y); hst[k][3] = bfhi(v.y); hst[k][4] = bflo(v.z); hst[k][5] = bfhi(v.z); hst[k][6] = bflo(v.w); hst[k][7] = bfhi(v.w); }
    const LAS float* dts = (const LAS float*)(sl + SS_DTS); const LAS float* acum = (const LAS float*)(sl + SS_ACUM);
    const int hq = hq0 + (c8 * 8) / 64;
    const float alast = (FACMODE == 2) ? acum[hq * 128 + 127] : 0.f;
#pragma unroll
    for (int rr = 0; rr < RPS; ++rr) { const int l = l0 + rr; const v4u v = *(const v4u*)(src + (row0 + l) * NPROJ);
        float cur[8]; cur[0] = bflo(v.x); cur[1] = bfhi(v.x); cur[2] = bflo(v.y); cur[3] = bfhi(v.y); cur[4] = bflo(v.z); cur[5] = bfhi(v.z); cur[6] = bflo(v.w); cur[7] = bfhi(v.w);
        float f = 1.f; if (FACMODE >= 1) f = dts[hq * 128 + l]; if (FACMODE == 2) f *= __expf(alast - acum[hq * 128 + l]);
        float o[8];
#pragma unroll
        for (int e = 0; e < 8; ++e) { const float a = bias[e] + w[0][e] * hst[0][e] + w[1][e] * hst[1][e] + w[2][e] * hst[2][e] + w[3][e] * cur[e]; o[e] = siluf(a) * f;
            hst[0][e] = hst[1][e]; hst[1][e] = hst[2][e]; hst[2][e] = cur[e]; }
        v4u ov; ov.x = pk2(o[0], o[1]); ov.y = pk2(o[2], o[3]); ov.z = pk2(o[4], o[5]); ov.w = pk2(o[6], o[7]);
        *(LAS v4u*)(dst + l * pitch + c8 * 16) = ov; }
}
__device__ __forceinline__ void ssd_s1_unit(LAS unsigned char* sl, const bf16* PROJ, const float* DT, const float* dtb, const float* alog, const float* cw, const float* cb, float* ST, float* CDEC, int un, int tid, int lane, int wave) {
    const int g = un & 1, bc = un >> 1; const size_t row0 = (size_t)bc * 128; const int t0 = (bc & 31) * 128;
    __syncthreads();
    ssd_prep(sl, DT, dtb, alog, row0, g, tid, lane, wave);
    conv_tile<128, 0>(PROJ, row0, t0, C_XS + 512 + g * 128, cw, cb, 512 + g * 128, sl + S1_B, S1_PB, sl, 0, tid);
    conv_tile<256, 2>(PROJ, row0, t0, C_XS + g * 256, cw, cb, g * 256, sl + S1_X, S1_PX, sl, 0, tid);
    if (tid < 4) CDEC[(size_t)bc * 8 + 4 * g + tid] = __expf(((const LAS float*)(sl + SS_ACUM))[tid * 128 + 127]);
    __syncthreads();
    const int hq = wave >> 1, pt = wave & 1, h2 = lane >> 5, q = (lane & 15) >> 2, pp = lane & 3, dsel = (lane >> 4) & 1;
    const LAS unsigned char* xb = sl + S1_X + (8 * h2 + q) * S1_PX + (hq * 64 + pt * 32 + 16 * dsel + 4 * pp) * 2;
    const LAS unsigned char* bb = sl + S1_B + (8 * h2 + q) * S1_PB + (16 * dsel + 4 * pp) * 2;
    f32x16 acc[4];
#pragma unroll
    for (int nt = 0; nt < 4; ++nt) acc[nt] = (f32x16){};
#pragma unroll
    for (int ks = 0; ks < 8; ++ks) { const bf16x8 a = tr_pair(xb + (16 * ks) * S1_PX, xb + (16 * ks + 4) * S1_PX);
#pragma unroll
        for (int nt = 0; nt < 4; ++nt) { const bf16x8 b = tr_pair(bb + (16 * ks) * S1_PB + nt * 64, bb + (16 * ks + 4) * S1_PB + nt * 64); acc[nt] = __builtin_amdgcn_mfma_f32_32x32x16_bf16(a, b, acc[nt], 0, 0, 0); } }
    float* sp = ST + ((size_t)(bc * 8 + 4 * g + hq) * 64 + pt * 32) * 128 + (lane & 31);
#pragma unroll
    for (int nt = 0; nt < 4; ++nt)
#pragma unroll
        for (int rg = 0; rg < 16; ++rg) sp[(size_t)crow16(rg, h2) * 128 + 32 * nt] = acc[nt][rg];
}
__device__ __forceinline__ void ssd_s3_unit(LAS unsigned char* sl, const bf16* PROJ, const float* DT, const float* dtb, const float* alog, const float* cw, const float* cb, const float* dsk, const float* ng,
                                            const bf16* HIN, bf16* MIXED, int un, int tid, int lane, int wave) {
    const int g = un & 1, bc = un >> 1; const size_t row0 = (size_t)bc * 128; const int t0 = (bc & 31) * 128;
    __syncthreads();
    ssd_prep(sl, DT, dtb, alog, row0, g, tid, lane, wave);
    conv_tile<128, 0>(PROJ, row0, t0, C_XS + 512 + g * 128, cw, cb, 512 + g * 128, sl + S3_B, S3_PBC, sl, 0, tid);
    conv_tile<128, 0>(PROJ, row0, t0, C_XS + 768 + g * 128, cw, cb, 768 + g * 128, sl + S3_C, S3_PBC, sl, 0, tid);
    conv_tile<256, 1>(PROJ, row0, t0, C_XS + g * 256, cw, cb, g * 256, sl + S3_X, S3_PX, sl, 0, tid);
    __syncthreads();
    const LAS float* dts = (const LAS float*)(sl + SS_DTS); const LAS float* acum = (const LAS float*)(sl + SS_ACUM); LAS float* ssx = (LAS float*)(sl + SS_SSX);
    const int lt = wave & 3, ph = wave >> 2, lq = lane & 31, hi = lane >> 5, q = (lane & 15) >> 2, pp = lane & 3, dsel = (lane >> 4) & 1;
    const int lrow = 32 * lt + lq;
    const LAS unsigned char* crd = sl + S3_C + lrow * S3_PBC + 16 * hi;
    f32x16 ag[4];
#pragma unroll
    for (int st = 0; st < 4; ++st) { ag[st] = (f32x16){};
        if (st <= lt) { const LAS unsigned char* brd = sl + S3_B + (32 * st + lq) * S3_PBC + 16 * hi;
#pragma unroll
            for (int ks = 0; ks < 8; ++ks) ag[st] = __builtin_amdgcn_mfma_f32_32x32x16_bf16(*(const LAS bf16x8*)(brd + 32 * ks), *(const LAS bf16x8*)(crd + 32 * ks), ag[st], 0, 0, 0); } }
    unsigned ayp[4][8]; float ss = 0.f; const size_t grow = row0 + lrow;
#pragma unroll
    for (int hq = 0; hq < 4; ++hq) {
            const float al = acum[hq * 128 + lrow], dd = dsk[4 * g + hq] / dts[hq * 128 + lrow];
            const LAS unsigned char* xb = sl + S3_X + (4 * hi + q) * S3_PX + (hq * 64 + ph * 32 + 16 * dsel + 4 * pp) * 2;
            f32x16 y = (f32x16){};
            { const bf16* hp = HIN + ((size_t)(bc * 8 + 4 * g + hq) * 64 + ph * 32 + lq) * 128 + 8 * hi;
#pragma unroll
              for (int ks = 0; ks < 8; ++ks) y = __builtin_amdgcn_mfma_f32_32x32x16_bf16(*(const bf16x8*)(hp + 16 * ks), *(const LAS bf16x8*)(crd + 32 * ks), y, 0, 0, 0);
              const float ea = __expf(al);
#pragma unroll
              for (int rg = 0; rg < 16; ++rg) y[rg] *= ea; }
#pragma unroll
            for (int st = 0; st < 4; ++st) if (st <= lt) {
                float pm[16];
#pragma unroll
                for (int g4 = 0; g4 < 4; ++g4) { const f32x4 as4 = *(const LAS f32x4*)(acum + hq * 128 + 32 * st + 8 * g4 + 4 * hi);
#pragma unroll
                    for (int e = 0; e < 4; ++e) { const int rg = 4 * g4 + e; float v = ag[st][rg] * __expf(al - as4[e]);
                        if (st == lt) { const int sl_ = 8 * g4 + 4 * hi + e; if (sl_ > lq) v = 0.f; if (sl_ == lq) v += dd; }
                        pm[rg] = v; } }
#pragma unroll
                for (int ks = 0; ks < 2; ++ks) { v4u wv; wv.x = pg8::cvt_pk_bf16(pm[8 * ks + 0], pm[8 * ks + 1]); wv.y = pg8::cvt_pk_bf16(pm[8 * ks + 2], pm[8 * ks + 3]); wv.z = pg8::cvt_pk_bf16(pm[8 * ks + 4], pm[8 * ks + 5]); wv.w = pg8::cvt_pk_bf16(pm[8 * ks + 6], pm[8 * ks + 7]);
                    const bf16x8 xt = tr_pair(xb + (32 * st + 16 * ks) * S3_PX, xb + (32 * st + 16 * ks + 8) * S3_PX);
                    y = __builtin_amdgcn_mfma_f32_32x32x16_bf16(xt, __builtin_bit_cast(bf16x8, wv), y, 0, 0, 0); }
            }
#pragma unroll
            for (int g4 = 0; g4 < 4; ++g4) { const int ch = hq * 64 + ph * 32 + 8 * g4 + 4 * hi; const v2u z = *(const v2u*)(PROJ + grow * NPROJ + C_Z + g * 256 + ch);
                const float y0 = y[4 * g4 + 0] * siluf(bflo(z.x)), y1 = y[4 * g4 + 1] * siluf(bfhi(z.x)), y2 = y[4 * g4 + 2] * siluf(bflo(z.y)), y3 = y[4 * g4 + 3] * siluf(bfhi(z.y));
                ss += (y0 * y0 + y1 * y1) + (y2 * y2 + y3 * y3);
                ayp[hq][2 * g4] = pg8::cvt_pk_bf16(y0, y1); ayp[hq][2 * g4 + 1] = pg8::cvt_pk_bf16(y2, y3); }
    }
    ss += __shfl_xor(ss, 32);
    if (hi == 0) ssx[ph * 128 + lrow] = ss;
    __syncthreads();
    const float rs = 1.0f / sqrtf((ssx[lrow] + ssx[128 + lrow]) * (1.f / 256.f) + RMS_EPS);
#pragma unroll
    for (int hq = 0; hq < 4; ++hq)
#pragma unroll
        for (int g4 = 0; g4 < 4; ++g4) { const int ch = hq * 64 + ph * 32 + 8 * g4 + 4 * hi; const f32x4 gn = *(const f32x4*)(ng + g * 256 + ch);
            const unsigned p0 = ayp[hq][2 * g4], p1 = ayp[hq][2 * g4 + 1];
            v2u o; o.x = pg8::cvt_pk_bf16(bflo(p0) * rs * gn[0], bfhi(p0) * rs * gn[1]); o.y = pg8::cvt_pk_bf16(bflo(p1) * rs * gn[2], bfhi(p1) * rs * gn[3]);
            *(v2u*)(MIXED + grow * MIXW + 512 + g * 256 + ch) = o; }
}

struct Args { const float* in[20]; float* out; unsigned char* ws; int ph_lo, ph_hi, sub, pad; };
constexpr int NWAVES = 8;
constexpr int PH_PER_LAYER = 10, N_PHASES = 1 + NLAYER * PH_PER_LAYER;

#define in_x (args.in[0])
#define in_win (args.in[1])
#define in_convw (args.in[2])
#define in_convb (args.in[3])
#define in_dtb (args.in[4])
#define in_alog (args.in[5])
#define in_dsk (args.in[6])
#define in_ng (args.in[7])
#define in_scw (args.in[8])
#define in_wout (args.in[9])
#define in_ln1g (args.in[10])
#define in_ln1b (args.in[11])
#define in_rw (args.in[12])
#define in_rb (args.in[13])
#define in_wgu (args.in[14])
#define in_bgu (args.in[15])
#define in_wdn (args.in[16])
#define in_bdn (args.in[17])
#define in_ln2g (args.in[18])
#define in_ln2b (args.in[19])
#define ROPE ((float*)(args.ws + WS_ROPE))
#define WDT ((float*)(args.ws + WS_WDT))
#define ROUT ((bf16*)(args.ws + WS_ROUT))
#define WIN ((bf16*)(args.ws + WS_WIN))
#define WOUT ((bf16*)(args.ws + WS_WOUT))
#define WGU ((bf16*)(args.ws + WS_WGU))
#define WDN ((bf16*)(args.ws + WS_WDN))
#define XB ((bf16*)(args.ws + WS_XB))
#define XF ((float*)(args.ws + WS_XF))
#define XF2 ((float*)(args.ws + WS_XF2))
#define PROJ ((bf16*)(args.ws + WS_PROJ))
#define DT ((float*)(args.ws + WS_DT))
#define DTS ((float*)(args.ws + WS_DTS))
#define ACUM ((float*)(args.ws + WS_ACUM))
#define LSE ((float*)(args.ws + WS_LSE))
#define OP ((bf16*)(args.ws + WS_OP))
#define U ((bf16*)(args.ws + WS_U))
#define GB ((float*)(args.ws + WS_G))
#define ST ((float*)(args.ws + WS_ST))
#define YD ((float*)(args.ws + WS_YD))
#define MIXED ((bf16*)(args.ws + WS_MIXED))
#define MIXF ((float*)(args.ws + WS_MIXF))
#define TOPE ((int*)(args.ws + WS_TOPE))
#define TOPG ((float*)(args.ws + WS_TOPG))
#define ROWTOK ((int*)(args.ws + WS_ROWTOK))
#define ROWGATE ((float*)(args.ws + WS_ROWGATE))
#define HB ((bf16*)(args.ws + WS_H))
#define YB ((bf16*)(args.ws + WS_YB))
#define HIN ((bf16*)(args.ws + WS_G))
#define WGU8 ((unsigned char*)(args.ws + WS_WGU))
#define WDN8 ((unsigned char*)(args.ws + WS_WDN))
#define XB8 ((unsigned char*)(args.ws + WS_U))
#define H8 ((unsigned char*)(args.ws + WS_H))
#define CDEC ((float*)(args.ws + WS_ACUM))
template <int layer>
__device__ __forceinline__ void run_layer(const Args& args, int lo, int hi, const XcdBarrier& bar) {
    extern __shared__ __attribute__((aligned(16))) unsigned char lds[];
    LAS unsigned char* ldsp = (LAS unsigned char*)lds;
    const int tid = threadIdx.x, lane = tid & 63, wave = __builtin_amdgcn_readfirstlane(tid >> 6);
    const int G = gridDim.x, bid = blockIdx.x;
    const int gw = bid * NWAVES + wave, NGW = G * NWAVES;
    gu32* ctl = (gu32*)(args.ws + WS_CTL);

#define IN(k) (lo <= (k) && (k) < hi)
#define SEAM(k) do { if (IN(k) && IN((k) + 1)) xcd_barrier(bar); } while (0)

        const int pb = 1 + layer * PH_PER_LAYER;
        const bf16* WINl = WIN + (size_t)layer * NPROJ * DM; const bf16* WOUTl = WOUT + (size_t)layer * DM * MIXW;
        const unsigned char* WGUl = WGU8 + (size_t)layer * NEXP * 2048 * DM; const unsigned char* WDNl = WDN8 + (size_t)layer * NEXP * DM * FF;
        gu32* gcnt = ctl + CW_CNT + 64 * layer;

        if (IN(pb + 0)) {
            if (layer == 0) {
                for (int m = gw; m < MROWS; m += NGW) { const float* xr = in_x + (size_t)m * DM; f32x4 v[4];
#pragma unroll
                    for (int j = 0; j < 4; ++j) v[j] = *(const f32x4*)(xr + 4 * lane + 256 * j);
                    row_dt(v, WDT, DT + (size_t)m * 8, lane); }
            }
            pg8::Gemm g{XB, WINl, MROWS, NPROJ, DM}; pg8::StaticOrder S; S.init(MROWS, NPROJ, G, bid);
            pg8::EpiProj E{PROJ, NPROJ, ROPE, QSCALE};
            pg8::gemm_phase<pg8::EpiProj, pg8::StaticOrder, true, false>(ldsp + RING_OFF, g, S, E);
        }
        SEAM(pb + 0);
        if (IN(pb + 1)) {
            if (args.sub & 1) attn_phase(ldsp + RING_OFF, PROJ, OP, LSE, bid, G, tid, wave, lane);
            if (args.sub & 2) { const float* cw = in_convw + (size_t)layer * 4 * 1024; const float* cb = in_convb + (size_t)layer * 1024;
              for (int un = bid; un < 512; un += G)
                  ssd_s1_unit(ldsp + RING_OFF, PROJ, DT, in_dtb + layer * 8, in_alog + layer * 8, cw, cb, ST, CDEC, un, tid, lane, wave);
              __syncthreads(); }
            const float* sw = in_scw + (size_t)layer * 3 * 512;
            if (args.sub & 4) for (int it = bid * (NWAVES * 64) + tid; it < (int)((long)MROWS * 64); it += G * (NWAVES * 64)) { const int c8 = (int)(it & 63), row = (int)(it >> 6), t = row & (SEQ - 1); const int ch = c8 * 8;
                float a[8];
#pragma unroll
                for (int q = 0; q < 8; ++q) a[q] = 0.f;
#pragma unroll
                for (int k = 0; k < 3; ++k) { const int tt = t - 2 + k; if (tt >= 0) { const bf16* pr = PROJ + (size_t)(row - 2 + k) * NPROJ; const v4u cc = *(const v4u*)(pr + C_SC + ch), hh = *(const v4u*)(pr + C_SH + ch);
                    const f32x4 w0 = *(const f32x4*)(sw + k * 512 + ch), w1 = *(const f32x4*)(sw + k * 512 + ch + 4);
                    a[0] += w0[0] * bflo(cc.x) * bflo(hh.x); a[1] += w0[1] * bfhi(cc.x) * bfhi(hh.x); a[2] += w0[2] * bflo(cc.y) * bflo(hh.y); a[3] += w0[3] * bfhi(cc.y) * bfhi(hh.y);
                    a[4] += w1[0] * bflo(cc.z) * bflo(hh.z); a[5] += w1[1] * bfhi(cc.z) * bfhi(hh.z); a[6] += w1[2] * bflo(cc.w) * bflo(hh.w); a[7] += w1[3] * bfhi(cc.w) * bfhi(hh.w); } }
                const v4u bb = *(const v4u*)(PROJ + (size_t)row * NPROJ + C_SB + ch);
                v4u o; o.x = pk2(a[0] * bflo(bb.x), a[1] * bfhi(bb.x)); o.y = pk2(a[2] * bflo(bb.y), a[3] * bfhi(bb.y)); o.z = pk2(a[4] * bflo(bb.z), a[5] * bfhi(bb.z)); o.w = pk2(a[6] * bflo(bb.w), a[7] * bfhi(bb.w));
                *(v4u*)(MIXED + (size_t)row * MIXW + 1024 + ch) = o; }
        }
        SEAM(pb + 1);
        if (IN(pb + 2)) {
            for (int it = bid * (NWAVES * 64) + tid; it < (int)(64L * 2048); it += G * (NWAVES * 64)) { const int pn4 = (int)(it & 2047), bh = (int)(it >> 11); const int h = bh & 7, b = bh >> 3; f32x4 hc = (f32x4){0.f, 0.f, 0.f, 0.f};
#pragma unroll 8
                for (int c = 0; c < 32; ++c) { const size_t idx = ((size_t)((b * 32 + c) * 8 + h)) * 8192 + pn4 * 4; const f32x4 st = *(const f32x4*)(ST + idx);
                    v2u o; o.x = pk2(hc[0], hc[1]); o.y = pk2(hc[2], hc[3]); *(v2u*)(HIN + idx) = o;
                    hc = hc * CDEC[(size_t)(b * 32 + c) * 8 + h] + st; } }
        }
        SEAM(pb + 2);
        if (IN(pb + 3)) {
            if (args.sub & 1) { const float* cw = in_convw + (size_t)layer * 4 * 1024; const float* cb = in_convb + (size_t)layer * 1024;
              for (int un = bid; un < 512; un += G)
                  ssd_s3_unit(ldsp + RING_OFF, PROJ, DT, in_dtb + layer * 8, in_alog + layer * 8, cw, cb, in_dsk + layer * 8, in_ng + (size_t)layer * 512, HIN, MIXED, un, tid, lane, wave);
              __syncthreads(); }
            if (args.sub & 2) for (int it = bid * (NWAVES * 64) + tid; it < (int)((long)MROWS * 64); it += G * (NWAVES * 64)) { const int c8 = (int)(it & 63), row = (int)(it >> 6); const int h = c8 >> 3;
                const float l0 = LSE[((size_t)0 * MROWS + row) * 8 + h], l1 = LSE[((size_t)1 * MROWS + row) * 8 + h], l2 = LSE[((size_t)2 * MROWS + row) * 8 + h];
                const float mm = fmaxf(l0, fmaxf(l1, l2)); float w0 = exp2f(l0 - mm), w1 = exp2f(l1 - mm), w2 = exp2f(l2 - mm); const float iw = 1.0f / (w0 + w1 + w2); w0 *= iw; w1 *= iw; w2 *= iw;
                const v4u a0 = *(const v4u*)(OP + ((size_t)0 * MROWS + row) * 512 + c8 * 8), a1 = *(const v4u*)(OP + ((size_t)1 * MROWS + row) * 512 + c8 * 8), a2 = *(const v4u*)(OP + ((size_t)2 * MROWS + row) * 512 + c8 * 8);
                v4u o;
                o.x = pk2(w0 * bflo(a0.x) + w1 * bflo(a1.x) + w2 * bflo(a2.x), w0 * bfhi(a0.x) + w1 * bfhi(a1.x) + w2 * bfhi(a2.x));
                o.y = pk2(w0 * bflo(a0.y) + w1 * bflo(a1.y) + w2 * bflo(a2.y), w0 * bfhi(a0.y) + w1 * bfhi(a1.y) + w2 * bfhi(a2.y));
                o.z = pk2(w0 * bflo(a0.z) + w1 * bflo(a1.z) + w2 * bflo(a2.z), w0 * bfhi(a0.z) + w1 * bfhi(a1.z) + w2 * bfhi(a2.z));
                o.w = pk2(w0 * bflo(a0.w) + w1 * bflo(a1.w) + w2 * bflo(a2.w), w0 * bfhi(a0.w) + w1 * bfhi(a1.w) + w2 * bfhi(a2.w));
                *(v4u*)(MIXED + (size_t)row * MIXW + c8 * 8) = o; }
        }
        SEAM(pb + 3);
        if (IN(pb + 4)) {
            pg8::Gemm g{MIXED, WOUTl, MROWS, DM, MIXW}; pg8::StaticOrder S; S.init(MROWS, DM, G, bid);
            pg8::EpiF32 E{MIXF, DM};
            pg8::gemm_phase<pg8::EpiF32, pg8::StaticOrder, true, false>(ldsp + RING_OFF, g, S, E);
        }
        SEAM(pb + 4);
        if (IN(pb + 5)) {
            const float* gam = in_ln1g + (size_t)layer * DM; const float* bet = in_ln1b + (size_t)layer * DM;
            for (int m = gw; m < MROWS; m += NGW) { f32x4 v[4];
#pragma unroll
                for (int j = 0; j < 4; ++j) { const v2u a = *(const v2u*)(XB + (size_t)m * DM + 4 * lane + 256 * j); const f32x4 b = *(const f32x4*)(MIXF + (size_t)m * DM + 4 * lane + 256 * j);
                    v[j] = (f32x4){bflo(a.x), bfhi(a.x), bflo(a.y), bfhi(a.y)} * ALPHA + b; }
                ln_row<true, false>(v, gam, bet, nullptr, XB + (size_t)m * DM, XB8 + (size_t)m * DM, SC_X, lane); }
        }
        SEAM(pb + 5);
        if (IN(pb + 6)) {
            LAS int* lcnt = (LAS int*)(ldsp + L_LCNT); LAS int* lbase = (LAS int*)(ldsp + L_LBASE);
            const bf16* RT = ROUT + (size_t)layer * NEXP * DM; const float* rb = in_rb + (size_t)layer * NEXP;
            for (int blk = bid; blk < MROWS / 128; blk += G) {
                if (tid < 32) lcnt[tid] = 0;
                __syncthreads();
                const int r32 = lane & 31, hi = lane >> 5; const int row = blk * 128 + (wave & 3) * 32 + r32;
                float tv[4]; int te[4]; int lrank[4]; float gate[4];
                if (wave < 4) {
                    f32x16 acc = {};
                    const bf16* ap = RT + (size_t)r32 * DM + 8 * hi; const bf16* bp = XB + (size_t)row * DM + 8 * hi;
#pragma unroll 8
                    for (int s = 0; s < 64; ++s) { const bf16x8 a = *(const bf16x8*)(ap + 16 * s), b = *(const bf16x8*)(bp + 16 * s); acc = __builtin_amdgcn_mfma_f32_32x32x16_bf16(a, b, acc, 0, 0, 0); }
#pragma unroll
                    for (int k = 0; k < 4; ++k) { tv[k] = -INFINITY; te[k] = 1 << 20; }
#pragma unroll
                    for (int i = 0; i < 16; ++i) { const int e = (i & 3) + 8 * (i >> 2) + 4 * hi; float v = acc[i] + rb[e]; int ve = e;
#pragma unroll
                        for (int k = 0; k < 4; ++k) { const bool gt = (v > tv[k]) || (v == tv[k] && ve < te[k]); const float nv = gt ? tv[k] : v; const int ne = gt ? te[k] : ve; tv[k] = gt ? v : tv[k]; te[k] = gt ? ve : te[k]; v = nv; ve = ne; } }
                    float pv[4]; int pe[4];
#pragma unroll
                    for (int k = 0; k < 4; ++k) { pv[k] = __shfl_xor(tv[k], 32); pe[k] = __shfl_xor(te[k], 32); }
#pragma unroll
                    for (int j = 0; j < 4; ++j) { float v = pv[j]; int ve = pe[j];
#pragma unroll
                        for (int k = 0; k < 4; ++k) { const bool gt = (v > tv[k]) || (v == tv[k] && ve < te[k]); const float nv = gt ? tv[k] : v; const int ne = gt ? te[k] : ve; tv[k] = gt ? v : tv[k]; te[k] = gt ? ve : te[k]; v = nv; ve = ne; } }
                    float se = 0.f;
#pragma unroll
                    for (int k = 0; k < 4; ++k) { gate[k] = __expf(tv[k] - tv[0]); se += gate[k]; }
                    const float ise = 1.0f / se;
#pragma unroll
                    for (int k = 0; k < 4; ++k) gate[k] *= ise;
                    if (hi == 0) {
#pragma unroll
                        for (int k = 0; k < 4; ++k) lrank[k] = __hip_atomic_fetch_add(lcnt + te[k], 1, __ATOMIC_RELAXED, __HIP_MEMORY_SCOPE_WORKGROUP);
                    }
                }
                __syncthreads();
                if (tid < 32) lbase[tid] = (int)__hip_atomic_fetch_add(gcnt + tid, (unsigned)lcnt[tid], RLX_AGENT);
                __syncthreads();
                if (wave < 4 && hi == 0) {
#pragma unroll
                    for (int k = 0; k < 4; ++k) { const int r = lbase[te[k]] + lrank[k]; const size_t o = (size_t)te[k] * 32768 + r;
                        ROWTOK[o] = row * 4 + k; ROWGATE[o] = gate[k]; TOPE[(size_t)row * 4 + k] = te[k]; TOPG[(size_t)row * 4 + k] = gate[k]; }
                }
                __syncthreads();
            }
        }
        SEAM(pb + 6);
        if (IN(pb + 7) || IN(pb + 8)) {
            LAS int* tstart = (LAS int*)(ldsp + L_TSTART); LAS int* cntL = (LAS int*)(ldsp + L_CNT); LAS int* units = (LAS int*)(ldsp + L_UNITS); LAS int* unitsn = (LAS int*)(ldsp + L_UNITSN);
            if (tid == 0) { int acc = 0; for (int e = 0; e < 32; ++e) { const int c = (int)__hip_atomic_load(gcnt + e, RLX_AGENT); cntL[e] = c; tstart[e] = acc; acc += (c + 255) >> 8; } tstart[32] = acc; }
            __syncthreads();
            if (IN(pb + 7)) {
                pg8::moe_build_units(units, unitsn, tstart, 8, G, bid, tid);
                __syncthreads();
                pg8::Gemm g{(const pg8::bf16_t*)XB8, (const pg8::bf16_t*)WGUl, 0, 2048, DM / 2};
                pg8::MoeOrder S{units, __builtin_amdgcn_readfirstlane(unitsn[0]), cntL, ROWTOK, 1, (unsigned)DM, (size_t)2048 * DM, ROWGATE, in_bgu + (size_t)layer * NEXP * 2048};
                pg8::EpiSwiglu E{H8, in_bgu + (size_t)layer * NEXP * 2048, ROWGATE, cntL, 1.0f / (SC_X * SC_WGU), SC_H};
                pg8::gemm_phase<pg8::EpiSwiglu, pg8::MoeOrder, true, true, true>(ldsp + RING_OFF, g, S, E);
                __syncthreads();
            }
            SEAM(pb + 7);
            if (IN(pb + 8)) {
                pg8::moe_build_units(units, unitsn, tstart, 4, G, bid, tid);
                __syncthreads();
                pg8::Gemm g{(const pg8::bf16_t*)H8, (const pg8::bf16_t*)WDNl, 0, DM, FF / 2};
                pg8::MoeOrder S{units, __builtin_amdgcn_readfirstlane(unitsn[0]), cntL, ROWTOK, 0, (unsigned)FF, (size_t)DM * FF, nullptr, nullptr};
                pg8::EpiScatter E{YB, ROWTOK, cntL, 1.0f / (SC_H * SC_WDN)};
                pg8::gemm_phase<pg8::EpiScatter, pg8::MoeOrder, true, false, true>(ldsp + RING_OFF, g, S, E);
                __syncthreads();
            }
        }
        SEAM(pb + 8);
        if (IN(pb + 9)) {
            const float* gam = in_ln2g + (size_t)layer * DM; const float* bet = in_ln2b + (size_t)layer * DM; const float* bdn = in_bdn + (size_t)layer * NEXP * DM;
            for (int m = gw; m < MROWS; m += NGW) { f32x4 v[4];
#pragma unroll
                for (int j = 0; j < 4; ++j) { const v2u a = *(const v2u*)(XB + (size_t)m * DM + 4 * lane + 256 * j); v[j] = (f32x4){bflo(a.x), bfhi(a.x), bflo(a.y), bfhi(a.y)} * ALPHA; }
#pragma unroll
                for (int k = 0; k < 4; ++k) { const int e = TOPE[(size_t)m * 4 + k]; const float gk = TOPG[(size_t)m * 4 + k]; const bf16* yr = YB + ((size_t)m * 4 + k) * DM; const float* br = bdn + (size_t)e * DM;
#pragma unroll
                    for (int j = 0; j < 4; ++j) { const v2u w = *(const v2u*)(yr + 4 * lane + 256 * j); const f32x4 b = *(const f32x4*)(br + 4 * lane + 256 * j);
                        v[j][0] += bflo(w.x) + gk * b[0]; v[j][1] += bfhi(w.x) + gk * b[1]; v[j][2] += bflo(w.y) + gk * b[2]; v[j][3] += bfhi(w.y) + gk * b[3]; } }
                ln_row<false, (layer == NLAYER - 1)>(v, gam, bet, args.out + (size_t)m * DM, XB + (size_t)m * DM, nullptr, 1.f, lane);
                if (layer + 1 < NLAYER) row_dt(v, WDT + (size_t)(layer + 1) * 8 * 1024, DT + (size_t)m * 8, lane); }
        }
        SEAM(pb + 9);
    #undef IN
#undef SEAM
}

__global__ void __launch_bounds__(NWAVES * 64, 2) mk_fwd(Args args) {
    extern __shared__ __attribute__((aligned(16))) unsigned char lds[];
    LAS unsigned char* ldsp = (LAS unsigned char*)lds;
    const int tid = threadIdx.x, lane = tid & 63, wave = __builtin_amdgcn_readfirstlane(tid >> 6);
    const int G = gridDim.x, bid = blockIdx.x;
    const int gw = bid * NWAVES + wave, NGW = G * NWAVES;
    gu32* ctl = (gu32*)(args.ws + WS_CTL);

    for (int u = tid; u < (LDS_BYTES - LDSCTL_OFF) / 4; u += NWAVES * 64) ((LAS unsigned*)(ldsp + LDSCTL_OFF))[u] = 0u;
    __syncthreads();
    XcdBarrier bar = xcd_barrier_post((unsigned*)(ctl + CW_BAR), (volatile LAS unsigned*)(ldsp + L_MISC) + 8);

    const int lo = args.ph_lo, hi = args.ph_hi;
#define IN(k) (lo <= (k) && (k) < hi)
#define SEAM(k) do { if (IN(k) && IN((k) + 1)) xcd_barrier(bar); } while (0)

    if (IN(0)) {
        for (int it = bid * (NWAVES * 64) + tid; it < (int)(4096 * 32); it += G * (NWAVES * 64)) { const int t = (int)(it >> 5), i = (int)(it & 31);
            const float inv = powf(10000.0f, -(float)i / 32.0f); const float ang = (float)t * inv; float sn, cs; sincosf(ang, &sn, &cs);
            ROPE[2 * it] = cs; ROPE[2 * it + 1] = sn; }
        LAS float* scr = (LAS float*)(ldsp + RING_OFF + wave * 16384);
        constexpr int I_IN = 16 * 145, I_OUT = 24 * 32, I_R = 16;
        constexpr int NIT = NLAYER * (I_IN + I_OUT + I_R);
        for (int it = gw; it < NIT; it += NGW) {
            int r = it;
            if (r < NLAYER * I_IN) { const int l = r / I_IN; r %= I_IN; p0_transpose_item<1>(in_win + (size_t)l * DM * INW, DM, INW, WIN + (size_t)l * NPROJ * DM, WDT + (size_t)l * 8 * 1024, scr, r / 145, r % 145, lane); continue; } r -= NLAYER * I_IN;
            if (r < NLAYER * I_OUT) { const int l = r / I_OUT; r %= I_OUT; p0_transpose_item<0>(in_wout + (size_t)l * MIXW * DM, MIXW, DM, WOUT + (size_t)l * DM * MIXW, nullptr, scr, r / 32, r % 32, lane); continue; } r -= NLAYER * I_OUT;
            { const int l = r / I_R; r %= I_R; p0_transpose_item<0>(in_rw + (size_t)l * DM * NEXP, DM, NEXP, ROUT + (size_t)l * NEXP * DM, nullptr, scr, r, 0, lane); }
        }
        { constexpr int NIT8 = 64 * 256 + 64 * 128;
          const int nmine = (gw < NIT8) ? (NIT8 - gw + NGW - 1) / NGW : 0; const int J = 2 * nmine;
          f32x4 lda[16], ldb[16];
          if (J > 0) { const SubT t = fp8_subtile(gw, 0, in_wgu, in_wdn, WGU8, WDN8, lane); fp8_sub_load(t, lda); }
#pragma unroll 1
          for (int j = 0; j < J; j += 2) {
              const int item = gw + (j >> 1) * NGW;
              const SubT t0 = fp8_subtile(item, 0, in_wgu, in_wdn, WGU8, WDN8, lane), t1 = fp8_subtile(item, 1, in_wgu, in_wdn, WGU8, WDN8, lane);
              fp8_sub_load(t1, ldb);
              fp8_sub_process(t0, lda, scr, lane);
              if (j + 2 < J) { const SubT t2 = fp8_subtile(item + NGW, 0, in_wgu, in_wdn, WGU8, WDN8, lane); fp8_sub_load(t2, lda); }
              fp8_sub_process(t1, ldb, scr, lane);
          } }
        __syncthreads();
    }
    if (IN(0)) {
        for (int m = gw; m < MROWS; m += NGW) { const float* xr = in_x + (size_t)m * DM; bf16* ob = XB + (size_t)m * DM;
#pragma unroll
            for (int j = 0; j < 4; ++j) { const f32x4 v = *(const f32x4*)(xr + 4 * lane + 256 * j); v2u w; w.x = pk2(v[0], v[1]); w.y = pk2(v[2], v[3]); *(v2u*)(ob + 4 * lane + 256 * j) = w; } }
    }

    SEAM(0);
    run_layer<0>(args, lo, hi, bar);
    run_layer<1>(args, lo, hi, bar);
#undef IN
#undef SEAM
}

extern "C" void kernel_launch(void* const* d_in, const int* in_sizes, int n_in, void* d_out, int out_size, void* d_ws, size_t ws_size, hipStream_t stream) {
    static int grid = 0;
    if (grid == 0) {
        if (n_in != 20 || out_size != MROWS * DM || ws_size < WS_END) { fprintf(stderr, "kernel_launch: unexpected problem (n_in %d, out %d, ws %zu)\n", n_in, out_size, ws_size); grid = -1; return; }
        if (hipFuncSetAttribute((const void*)mk_fwd, hipFuncAttributeMaxDynamicSharedMemorySize, LDS_BYTES) != hipSuccess) { fprintf(stderr, "kernel_launch: hipFuncSetAttribute failed\n"); grid = -1; return; }
        int dev = 0, cus = 0, per_cu = 0;
        (void)hipGetDevice(&dev); (void)hipDeviceGetAttribute(&cus, hipDeviceAttributeMultiprocessorCount, dev);
        if (hipOccupancyMaxActiveBlocksPerMultiprocessor(&per_cu, (const void*)mk_fwd, NWAVES * 64, LDS_BYTES) != hipSuccess || per_cu < 1) fprintf(stderr, "kernel_launch: occupancy query says %d\n", per_cu);
        (void)hipGetLastError();
        grid = cus > 0 ? cus : 256;
    }
    if (grid < 0) return;
    (void)hipMemsetAsync((char*)d_ws + WS_CTL, 0, CTL_ZERO_BYTES, stream);
    Args a{};
    for (int i = 0; i < 20; ++i) a.in[i] = (const float*)d_in[i];
    a.out = (float*)d_out; a.ws = (unsigned char*)d_ws;
    a.ph_lo = 0; a.ph_hi = N_PHASES; a.sub = 7; a.pad = 0;
    hipLaunchKernelGGL(mk_fwd, dim3(grid), dim3(NWAVES * 64), LDS_BYTES, stream, a);
#ifdef PROBE_PH
#ifndef PROBE_SUB
#define PROBE_SUB 7
#endif
    for (int i = 0; i < PROBE_N; ++i) { a.ph_lo = PROBE_PH; a.ph_hi = PROBE_PH + 1; a.sub = PROBE_SUB; hipLaunchKernelGGL(mk_fwd, dim3(grid), dim3(NWAVES * 64), LDS_BYTES, stream, a); }
#endif
}
```

```cpp
#include <hip/hip_runtime.h>
#include <cstdio>
#include <cstdint>
#include <cmath>

namespace pg8 {
#define PG8_LAS __attribute__((address_space(3)))
typedef unsigned short bf16_t;
typedef short bf16x8 __attribute__((ext_vector_type(8)));
typedef float f32x4 __attribute__((ext_vector_type(4)));
typedef float f32x2 __attribute__((ext_vector_type(2)));
typedef unsigned u32x4 __attribute__((ext_vector_type(4)));
constexpr int BM = 256, BK = 64, HALF = 128, HTB = HALF * BK * 2  , STAGE_BYTES = 8 * HTB, NXCD = 8, WGM = 8;

__host__ __device__ __forceinline__ int lds_byte(int r, int c) { const int st = (r >> 4) * 2 + (c >> 5), rr = r & 15, cc = c & 31, ob = rr * 64 + cc * 2; return st * 1024 + (ob ^ (((ob >> 9) & 1) << 5)); }
__host__ __device__ __forceinline__ void stage_rc(int b, int& R, int& C) { const int st = b / 1024, sb = b % 1024, swz = sb ^ (((sb >> 9) & 1) << 5); R = (st >> 1) * 16 + swz / 64; C = (st & 1) * 32 + (swz % 64) / 2; }
__host__ __device__ __forceinline__ int perm32(int rho) { const int n = rho >> 4, i = rho & 15; return 8 * (i >> 2) + 4 * n + (i & 3); }

struct Unit { int pm, pn, e, r0; };
struct Gemm { const bf16_t* A; const bf16_t* Bt; int M, N, K; };

struct StaticOrder {
    int nM, nN, nwg, G, c;
    __device__ void init(int M, int N, int G_, int c_) { nM = M / BM; nN = N / BM; nwg = nM * nN; G = G_; c = c_; }
    __device__ __forceinline__ bool next(int i, Unit& u) const {
        const long L = (long)i * G + c; if (L >= nwg) return false;
        int wgid = (int)L; { const int q = nwg / NXCD, r = nwg % NXCD, xcd = wgid % NXCD, off = wgid / NXCD; wgid = (xcd < r ? xcd * (q + 1) : r * (q + 1) + (xcd - r) * q) + off; }
        const int nig = WGM * nN, gid = wgid / nig, fm = gid * WGM, gsz = (nM - fm) < WGM ? (nM - fm) : WGM;
        u.pm = fm + ((wgid % nig) % gsz); u.pn = (wgid % nig) / gsz; u.e = 0; u.r0 = 0; return true;
    }
    __device__ __forceinline__ const char* abase(const Unit& u, const Gemm& g, size_t tstep) const { return (const char*)g.A + (size_t)u.pm * tstep; }
    __device__ __forceinline__ const char* bbase(const Unit& u, const Gemm& g, size_t tstep) const { return (const char*)g.Bt + (size_t)u.pn * tstep; }
    static constexpr bool SIDE = false;
    __device__ __forceinline__ unsigned arow(const Unit&, int) const { return 0u; }
    __device__ __forceinline__ unsigned arow_side(const Unit&, int, const PG8_LAS unsigned char*) const { return 0u; }
    __device__ __forceinline__ const void* side_src(const Unit&, const Unit&, int, int) const { return nullptr; }
    __device__ __forceinline__ void a_ready(const Unit&) const {}
    __device__ __forceinline__ void done(const Unit&) const {}
};

struct MoeOrder {
    const PG8_LAS int* units;
    int nunits;
    const PG8_LAS int* cnt;
    const int* rowtok;
    int gather;
    unsigned rowbytes;
    size_t bstride;
    __device__ __forceinline__ bool next(int i, Unit& u) const {
        if (i >= nunits) return false;
        u.pm = __builtin_amdgcn_readfirstlane(units[4 * i + 0]); u.pn = __builtin_amdgcn_readfirstlane(units[4 * i + 1]);
        u.e = __builtin_amdgcn_readfirstlane(units[4 * i + 2]); u.r0 = __builtin_amdgcn_readfirstlane(units[4 * i + 3]); return true;
    }
    __device__ __forceinline__ const char* abase(const Unit& u, const Gemm& g, size_t tstep) const { return gather ? (const char*)g.A : (const char*)g.A + (size_t)u.pm * tstep; }
    __device__ __forceinline__ const char* bbase(const Unit& u, const Gemm& g, size_t tstep) const { return (const char*)g.Bt + (size_t)u.e * bstride + (size_t)u.pn * tstep; }
    static constexpr bool SIDE = true;
    const float* rowgate; const float* bgu;
    __device__ __forceinline__ unsigned arow(const Unit& u, int R) const {
        const int r = u.r0 + R; const int idx = (r < cnt[u.e]) ? rowtok[(size_t)u.e * 32768 + r] : 0; return (unsigned)(idx >> 2) * rowbytes; }
    __device__ __forceinline__ unsigned arow_side(const Unit& u, int R, const PG8_LAS unsigned char* sd) const {
        const int r = u.r0 + R; const int v = ((const PG8_LAS int*)sd)[R]; const int idx = (r < cnt[u.e]) ? v : 0; return (unsigned)(idx >> 2) * rowbytes; }
    __device__ __forceinline__ const void* side_src(const Unit& cur, const Unit& rt, int wid, int lane) const {
        if (rowgate != nullptr && wid == 1) return rowgate + (size_t)cur.e * 32768 + cur.r0 + 4 * lane;
        if (bgu != nullptr && wid == 2) return bgu + (size_t)cur.e * 2048 + (lane < 32 ? 0 : 1024 - 128) + cur.pn * 128 + 4 * lane;
        return rowtok + (size_t)rt.e * 32768 + rt.r0 + 4 * lane; }
    __device__ __forceinline__ void a_ready(const Unit&) const {}
    __device__ __forceinline__ void done(const Unit&) const {}
};
__device__ __forceinline__ void moe_build_units(PG8_LAS int* units, PG8_LAS int* units_n, const PG8_LAS int* tstart, int nN, int G, int c, int tid) {
    if (tid < 64) {
        const int nT = tstart[32], nwg = nT * nN; const long L = (long)tid * G + c;
        int pm = 0, pn = 0, e = 0, r0 = 0;
        if (L < nwg) {
            int wgid = (int)L; { const int q = nwg / NXCD, r = nwg % NXCD, xcd = wgid % NXCD, off = wgid / NXCD; wgid = (xcd < r ? xcd * (q + 1) : r * (q + 1) + (xcd - r) * q) + off; }
            const int nig = WGM * nN, gid = wgid / nig, fm = gid * WGM, gsz = (nT - fm) < WGM ? (nT - fm) : WGM;
            pm = fm + ((wgid % nig) % gsz); pn = (wgid % nig) / gsz;
            for (int j = 1; j < 32; ++j) e += (tstart[j] <= pm) ? 1 : 0;
            r0 = (pm - tstart[e]) * 256;
        }
        units[4 * tid + 0] = pm; units[4 * tid + 1] = pn; units[4 * tid + 2] = e; units[4 * tid + 3] = r0;
        if (tid == 0) { int n = 0; if (c < nwg) n = (nwg - c + G - 1) / G; units_n[0] = n < 64 ? n : 64; }
    }
}

typedef int v8i_t __attribute__((ext_vector_type(8)));
typedef int v4i_t __attribute__((ext_vector_type(4)));
__device__ __forceinline__ v8i_t cat8(bf16x8 lo, bf16x8 hi) { const v4i_t a = __builtin_bit_cast(v4i_t, lo), b = __builtin_bit_cast(v4i_t, hi); return __builtin_shufflevector(a, b, 0, 1, 2, 3, 4, 5, 6, 7); }
__device__ __forceinline__ void mfma8(f32x4& acc, v8i_t a, v8i_t b, int scl) { asm volatile("v_mfma_scale_f32_16x16x128_f8f6f4 %0, %1, %2, %0, %3, %3 op_sel_hi:[0,0,0]" : "+v"(acc) : "v"(a), "v"(b), "v"(scl)); }
__device__ __forceinline__ unsigned pk4_fp8(float a, float b, float c, float d) { unsigned w = 0u; w = __builtin_amdgcn_cvt_pk_fp8_f32(a, b, w, false); w = __builtin_amdgcn_cvt_pk_fp8_f32(c, d, w, true); return w; }
__device__ __forceinline__ unsigned cvt_pk_bf16(float lo, float hi) { unsigned r; asm volatile("v_cvt_pk_bf16_f32 %0, %1, %2" : "=v"(r) : "v"(lo), "v"(hi)); return r; }

struct EpiProj {
    static constexpr bool PERM = true, AFTER_DRAIN = false;
    bf16_t* O; int ldc; const float* rope; float qscale;
    __device__ __forceinline__ void operator()(const f32x4 (&acc)[2][2][4][2], const Unit& u, int wr, int wc, int fr, int fq, const PG8_LAS unsigned char* sd) const {
        const int row0 = u.pm * BM + wr * 64 + fr; const int col0 = u.pn * BM + wc * 32 + 8 * fq;
        const bool rot = u.pn < 4; const float sc = u.pn < 2 ? qscale : 1.f; const int gq = 4 * (wc & 1) + fq;
#pragma unroll
        for (int ai = 0; ai < 2; ++ai)
#pragma unroll
            for (int m = 0; m < 4; ++m) { const int row = row0 + ai * HALF + m * 16; bf16_t* rowp = O + (size_t)row * ldc + col0;
                f32x4 cs0 = (f32x4){1.f, 0.f, 1.f, 0.f}, cs1 = cs0;
                if (rot) { const float* rp = rope + ((size_t)(row & 4095) * 32 + 4 * gq) * 2; cs0 = *(const f32x4*)rp; cs1 = *(const f32x4*)(rp + 4); }
#pragma unroll
                for (int bj = 0; bj < 2; ++bj) { f32x4 v0 = acc[ai][bj][m][0], v1 = acc[ai][bj][m][1];
                    if (rot) { f32x4 lo, hi;
                        lo[0] = v0[0] * cs0[0] - v1[0] * cs0[1]; hi[0] = v1[0] * cs0[0] + v0[0] * cs0[1];
                        lo[1] = v0[1] * cs0[2] - v1[1] * cs0[3]; hi[1] = v1[1] * cs0[2] + v0[1] * cs0[3];
                        lo[2] = v0[2] * cs1[0] - v1[2] * cs1[1]; hi[2] = v1[2] * cs1[0] + v0[2] * cs1[1];
                        lo[3] = v0[3] * cs1[2] - v1[3] * cs1[3]; hi[3] = v1[3] * cs1[2] + v0[3] * cs1[3];
                        v0 = lo * sc; v1 = hi * sc; }
                    u32x4 w; w.x = cvt_pk_bf16(v0[0], v0[1]); w.y = cvt_pk_bf16(v0[2], v0[3]); w.z = cvt_pk_bf16(v1[0], v1[1]); w.w = cvt_pk_bf16(v1[2], v1[3]);
                    *(u32x4*)(rowp + bj * HALF) = w; } }
    }
};
struct EpiF32 {
    static constexpr bool PERM = false, AFTER_DRAIN = false;
    float* O; int ldc;
    __device__ __forceinline__ void operator()(const f32x4 (&acc)[2][2][4][2], const Unit& u, int wr, int wc, int fr, int fq, const PG8_LAS unsigned char* sd) const {
        const int row0 = u.pm * BM + wr * 64 + fr; const int col0 = u.pn * BM + wc * 32 + 4 * fq;
#pragma unroll
        for (int ai = 0; ai < 2; ++ai)
#pragma unroll
            for (int m = 0; m < 4; ++m) { float* rowp = O + (size_t)(row0 + ai * HALF + m * 16) * ldc + col0;
#pragma unroll
                for (int bj = 0; bj < 2; ++bj)
#pragma unroll
                    for (int n = 0; n < 2; ++n) *(f32x4*)(rowp + bj * HALF + n * 16) = acc[ai][bj][m][n]; }
    }
};
struct EpiBf16Plain {
    static constexpr bool PERM = true, AFTER_DRAIN = false;
    bf16_t* O; int ldc;
    __device__ __forceinline__ void operator()(const f32x4 (&acc)[2][2][4][2], const Unit& u, int wr, int wc, int fr, int fq, const PG8_LAS unsigned char* sd) const {
        const int row0 = u.pm * BM + wr * 64 + fr; const int col0 = u.pn * BM + wc * 32 + 8 * fq;
#pragma unroll
        for (int ai = 0; ai < 2; ++ai)
#pragma unroll
            for (int m = 0; m < 4; ++m) { bf16_t* rowp = O + (size_t)(row0 + ai * HALF + m * 16) * ldc + col0;
#pragma unroll
                for (int bj = 0; bj < 2; ++bj) { const f32x4 v0 = acc[ai][bj][m][0], v1 = acc[ai][bj][m][1];
                    u32x4 w; w.x = cvt_pk_bf16(v0[0], v0[1]); w.y = cvt_pk_bf16(v0[2], v0[3]); w.z = cvt_pk_bf16(v1[0], v1[1]); w.w = cvt_pk_bf16(v1[2], v1[3]);
                    *(u32x4*)(rowp + bj * HALF) = w; } }
    }
};
struct EpiSwiglu {
    static constexpr bool PERM = true, AFTER_DRAIN = false;
    unsigned char* H; const float* bgu; const float* rowgate; const PG8_LAS int* cnt; float dq, hscale;
    __device__ __forceinline__ void operator()(const f32x4 (&acc)[2][2][4][2], const Unit& u, int wr, int wc, int fr, int fq, const PG8_LAS unsigned char* sd) const {
        const int ff = u.pn * HALF + wc * 32 + 8 * fq; const int n_e = cnt[u.e];
        f32x4 bg[2], bu[2];
#pragma unroll
        for (int n = 0; n < 2; ++n) { bg[n] = *(const PG8_LAS f32x4*)(sd + 2048 + (wc * 32 + 8 * fq + 4 * n) * 4); bu[n] = *(const PG8_LAS f32x4*)(sd + 2048 + 512 + (wc * 32 + 8 * fq + 4 * n) * 4); }
#pragma unroll
        for (int ai = 0; ai < 2; ++ai)
#pragma unroll
            for (int m = 0; m < 4; ++m) { const int r = ai * HALF + wr * 64 + m * 16 + fr; const int er = u.r0 + r;
                const float rgl = ((const PG8_LAS float*)(sd + 1024))[r]; const float rg = ((er < n_e) ? rgl : 0.f) * hscale;
                float hv[8];
#pragma unroll
                for (int n = 0; n < 2; ++n)
#pragma unroll
                    for (int q = 0; q < 4; ++q) { float g = acc[ai][0][m][n][q] * dq + bg[n][q], up = acc[ai][1][m][n][q] * dq + bu[n][q];
                        g = fminf(g, 7.0f); up = fminf(fmaxf(up, -7.0f), 7.0f);
                        const float sg = __builtin_amdgcn_rcpf(1.0f + __builtin_amdgcn_exp2f(-1.702f * 1.4426950408889634f * g));
                        hv[n * 4 + q] = (up + 1.0f) * g * sg * rg; }
                u32x4 dummy; (void)dummy;
                unsigned w0 = pk4_fp8(hv[0], hv[1], hv[2], hv[3]), w1 = pk4_fp8(hv[4], hv[5], hv[6], hv[7]);
                typedef unsigned u32x2 __attribute__((ext_vector_type(2)));
                *(u32x2*)(H + (size_t)(u.pm * BM + r) * 1024 + ff) = (u32x2){w0, w1};
                asm volatile("" ::: "memory"); }
    }
};
struct EpiScatter {
    static constexpr bool PERM = true, AFTER_DRAIN = false;
    bf16_t* Y; const int* rowtok; const PG8_LAS int* cnt; float dq;
    __device__ __forceinline__ void operator()(const f32x4 (&acc)[2][2][4][2], const Unit& u, int wr, int wc, int fr, int fq, const PG8_LAS unsigned char* sd) const {
        const int col0 = u.pn * BM + wc * 32 + 8 * fq; const int n_e = cnt[u.e];
#pragma unroll
        for (int ai = 0; ai < 2; ++ai)
#pragma unroll
            for (int m = 0; m < 4; ++m) { const int er = u.r0 + ai * HALF + wr * 64 + m * 16 + fr;
                const int idx = ((const PG8_LAS int*)sd)[ai * HALF + wr * 64 + m * 16 + fr];
                if (er < n_e) { bf16_t* rowp = Y + (size_t)idx * 1024 + col0;
#pragma unroll
                    for (int bj = 0; bj < 2; ++bj) { const f32x4 v0 = acc[ai][bj][m][0] * dq, v1 = acc[ai][bj][m][1] * dq;
                        u32x4 w; w.x = cvt_pk_bf16(v0[0], v0[1]); w.y = cvt_pk_bf16(v0[2], v0[3]); w.z = cvt_pk_bf16(v1[0], v1[1]); w.w = cvt_pk_bf16(v1[2], v1[3]);
                        *(u32x4*)(rowp + bj * HALF) = w; } }
                asm volatile("" ::: "memory"); }
    }
};

template <class Epi, class Sched, bool ALIGN_EPI, bool GATHER, bool FP8 = false>
__device__ __forceinline__ void gemm_phase(PG8_LAS unsigned char* lds, const Gemm g, const Sched& S, const Epi& E) {
    const int tid = threadIdx.x, wid = __builtin_amdgcn_readfirstlane(tid >> 6), lane = tid & 63, wr = wid >> 2, wc = wid & 3, fr = lane & 15, fq = lane >> 4;
    const int K = g.K, nt = K / BK;
    unsigned voffB[2];
#pragma unroll
    for (int i = 0; i < 2; ++i) { int R, C; stage_rc(tid * 16 + i * 8192, R, C); const int Rb = Epi::PERM ? ((R & ~31) + perm32(R & 31)) : R;
        voffB[i] = (unsigned)(Rb * K + C) * 2u; }
    constexpr int SIDE_BYTES = 8192;
    PG8_LAS unsigned char* const side = lds + STAGE_BYTES;
    const size_t kstep = (size_t)(BK * 2);
    const size_t hstep = (size_t)HALF * K * 2;
    const size_t tstep = 2 * hstep;
    const unsigned ldsw = (unsigned)wid * 1024u;
    const int aoff = lds_byte(wr * 64 + fr, fq * 8), boff = lds_byte(wc * 32 + fr, fq * 8);
#define PG8_SA(b, h) (((b) * 2 + (h)) * HTB)
#define PG8_SB(b, h) ((4 + (b) * 2 + (h)) * HTB)
#define PG8_STAGE(bufoff, gbase, voff) do { _Pragma("unroll") for (int _i = 0; _i < 2; ++_i) \
        __builtin_amdgcn_global_load_lds((const unsigned*)((const char*)(gbase) + (voff)[_i]), (PG8_LAS unsigned*)(lds + (bufoff) + ldsw + _i * 8192), 16, 0, 0); } while (0)
#define PG8_LDA(dst, b, h) do { _Pragma("unroll") for (int m = 0; m < 4; ++m) _Pragma("unroll") for (int k = 0; k < 2; ++k) dst[m][k] = *(const PG8_LAS bf16x8*)(lds + PG8_SA(b, h) + aoff + m * 2048 + k * 1024); } while (0)
#define PG8_LDB(dst, b, h) do { _Pragma("unroll") for (int n = 0; n < 2; ++n) _Pragma("unroll") for (int k = 0; k < 2; ++k) dst[n][k] = *(const PG8_LAS bf16x8*)(lds + PG8_SB(b, h) + boff + n * 2048 + k * 1024); } while (0)
#define PG8_MMA(ai, bj, At, Bt) do { __builtin_amdgcn_s_setprio(1); _Pragma("unroll") for (int m = 0; m < 4; ++m) _Pragma("unroll") for (int n = 0; n < 2; ++n) { \
        if constexpr (FP8) mfma8(acc[ai][bj][m][n], cat8(Bt[n][0], Bt[n][1]), cat8(At[m][0], At[m][1]), scl8); \
        else { _Pragma("unroll") for (int k = 0; k < 2; ++k) acc[ai][bj][m][n] = __builtin_amdgcn_mfma_f32_16x16x32_bf16(Bt[n][k], At[m][k], acc[ai][bj][m][n], 0, 0, 0); } } __builtin_amdgcn_s_setprio(0); } while (0)
#define PG8_WAIT_V(n) asm volatile("s_waitcnt vmcnt(" #n ")" ::: "memory")
#define PG8_WAIT_L(n) asm volatile("s_waitcnt lgkmcnt(" #n ")" ::: "memory")
#define PG8_BAR __builtin_amdgcn_s_barrier()
#define PG8_SCHED __builtin_amdgcn_sched_barrier(0)
#define PG8_SETOFFS(o, u) do { _Pragma("unroll") for (int _h = 0; _h < 2; ++_h) _Pragma("unroll") for (int _i = 0; _i < 2; ++_i) { int _R, _C; stage_rc(tid * 16 + _i * 8192, _R, _C); \
        o[_h][_i] = GATHER ? (S.arow(u, _R + HALF * _h) + (unsigned)(_C * 2)) : ((unsigned)((_R + HALF * _h) * K) * 2u + (unsigned)(_C * 2)); } } while (0)
    int scl8 = 0x7F7F7F7F; asm volatile("" : "+v"(scl8));
    Unit cur, nxt; int ui = 0;
    if (!S.next(0, cur)) return;
    f32x4 acc[2][2][4][2];
#pragma unroll
    for (int a = 0; a < 2; ++a)
#pragma unroll
        for (int b = 0; b < 2; ++b)
#pragma unroll
            for (int m = 0; m < 4; ++m)
#pragma unroll
                for (int n = 0; n < 2; ++n) { acc[a][b][m][n] = (f32x4){0.f, 0.f, 0.f, 0.f}; if constexpr (FP8) asm volatile("" : "+v"(acc[a][b][m][n])); }
    bf16x8 At[4][2], B0[2][2], B1[2][2];
    unsigned cAo[2][2];
    PG8_SETOFFS(cAo, cur);
    const char* cA = S.abase(cur, g, tstep); const char* cB = S.bbase(cur, g, tstep);
    S.a_ready(cur);
    PG8_STAGE(PG8_SB(0, 0), cB, voffB); PG8_STAGE(PG8_SB(0, 1), cB + hstep, voffB); PG8_STAGE(PG8_SA(0, 0), cA, cAo[0]); PG8_STAGE(PG8_SA(0, 1), cA, cAo[1]);
    if (wr == 1) PG8_BAR;
    PG8_WAIT_V(2); PG8_BAR;
    PG8_STAGE(PG8_SB(1, 0), cB + kstep, voffB); PG8_STAGE(PG8_SA(1, 0), cA + kstep, cAo[0]); PG8_STAGE(PG8_SB(1, 1), cB + hstep + kstep, voffB);
    PG8_WAIT_V(6); PG8_BAR;
    for (;;) {
        const bool has_next = S.next(ui + 1, nxt);
        const char* nA = has_next ? S.abase(nxt, g, tstep) : cA; const char* nB = has_next ? S.bbase(nxt, g, tstep) : cB;
        if constexpr (Sched::SIDE) {
            const void* ssrc = S.side_src(cur, (GATHER && has_next) ? nxt : cur, wid, lane);
            __builtin_amdgcn_global_load_lds((const unsigned*)ssrc, (PG8_LAS unsigned*)(side + (ui & 1) * SIDE_BYTES + wid * 1024), 16, 0, 0); }
#pragma unroll 1
        for (int t = 0; t < nt; t += 2) {
            const bool last = (t == nt - 2);
            const char* a1 = cA + (size_t)(t + 1) * kstep;
            const char* a2 = last ? nA : cA + (size_t)(t + 2) * kstep; const char* b2 = last ? nB : cB + (size_t)(t + 2) * kstep;
            const char* a3 = a2 + kstep; const char* b3 = b2 + kstep;
            if (last && has_next) S.a_ready(nxt);
            PG8_LDB(B0, 0, 0); PG8_LDB(B1, 0, 1); PG8_SCHED; PG8_LDA(At, 0, 0); PG8_STAGE(PG8_SA(1, 1), a1, cAo[1]);
            if constexpr (GATHER) { if (last && has_next) {
                const PG8_LAS unsigned char* sdn = side + (ui & 1) * SIDE_BYTES;
#pragma unroll
                for (int _h = 0; _h < 2; ++_h)
#pragma unroll
                    for (int _i = 0; _i < 2; ++_i) { int _R, _C; stage_rc(tid * 16 + _i * 8192, _R, _C); cAo[_h][_i] = S.arow_side(nxt, _R + HALF * _h, sdn) + (unsigned)(_C * 2); } } }
            PG8_WAIT_V(8); PG8_WAIT_L(0); PG8_BAR; PG8_MMA(0, 0, At, B0); PG8_MMA(0, 1, At, B1); PG8_BAR; PG8_SCHED;
            PG8_LDA(At, 0, 1); PG8_STAGE(PG8_SB(0, 0), b2, voffB); PG8_STAGE(PG8_SB(0, 1), b2 + hstep, voffB); PG8_STAGE(PG8_SA(0, 0), a2, cAo[0]);
            PG8_WAIT_V(8); PG8_WAIT_L(0); PG8_BAR; PG8_MMA(1, 0, At, B0); PG8_MMA(1, 1, At, B1); PG8_BAR; PG8_SCHED;
            PG8_LDB(B0, 1, 0); PG8_LDB(B1, 1, 1); PG8_SCHED; PG8_LDA(At, 1, 0); PG8_STAGE(PG8_SA(0, 1), a2, cAo[1]);
            PG8_WAIT_V(8); PG8_WAIT_L(0); PG8_BAR; PG8_MMA(0, 0, At, B0); PG8_MMA(0, 1, At, B1); PG8_BAR; PG8_SCHED;
            PG8_LDA(At, 1, 1); PG8_STAGE(PG8_SB(1, 0), b3, voffB); PG8_STAGE(PG8_SB(1, 1), b3 + hstep, voffB); PG8_STAGE(PG8_SA(1, 0), a3, cAo[0]);
            PG8_WAIT_V(8); PG8_WAIT_L(0); PG8_BAR; PG8_MMA(1, 0, At, B0); PG8_MMA(1, 1, At, B1); PG8_BAR; PG8_SCHED;
        }
        if constexpr (ALIGN_EPI) { if (wr == 0) PG8_BAR; }
        if constexpr (FP8) asm volatile("s_nop 15\n\ts_nop 15" ::: "memory");
        PG8_SCHED; E(acc, cur, wr, wc, fr, fq, side + (ui & 1) * SIDE_BYTES); S.done(cur); PG8_SCHED;
        if (!has_next) break;
#pragma unroll
        for (int a = 0; a < 2; ++a)
#pragma unroll
            for (int b = 0; b < 2; ++b)
#pragma unroll
                for (int m = 0; m < 4; ++m)
#pragma unroll
                    for (int n = 0; n < 2; ++n) { acc[a][b][m][n] = (f32x4){0.f, 0.f, 0.f, 0.f}; if constexpr (FP8) asm volatile("" : "+v"(acc[a][b][m][n])); }
        cur = nxt; cA = nA; cB = nB; ++ui;
        if constexpr (ALIGN_EPI) { if (wr == 1) PG8_BAR; }
    }
    PG8_WAIT_V(0);
    if constexpr (!ALIGN_EPI) { if (wr == 0) PG8_BAR; }
    PG8_BAR;
#undef PG8_SA
#undef PG8_SB
#undef PG8_STAGE
#undef PG8_LDA
#undef PG8_LDB
#undef PG8_MMA
#undef PG8_WAIT_V
#undef PG8_WAIT_L
#undef PG8_BAR
#undef PG8_SCHED
#undef PG8_SETOFFS
}
}

constexpr int NB = 8, SEQ = 4096, DM = 1024, MROWS = NB * SEQ, NLAYER = 2;
constexpr int NPROJ = 4608, INW = 4616;
constexpr int C_Q = 0, C_K = 512, C_V = 1024, C_Z = 1536, C_XS = 2048, C_SB = 3072, C_SC = 3584, C_SH = 4096;
constexpr int MIXW = 1536, NEXP = 32, TOPK = 4, FF = 1024;
constexpr float ALPHA = 1.4142135623730951f;
constexpr float LN_EPS = 1e-5f, RMS_EPS = 1e-5f;
constexpr float QSCALE = 0.125f * 1.4426950408889634f;

constexpr size_t MiB = 1u << 20;
constexpr size_t WS_CTL = 0, CTL_ZERO_BYTES = 1 * MiB;
constexpr size_t WS_ROPE = 1 * MiB;
constexpr size_t WS_WDT = 2 * MiB;
constexpr size_t WS_ROUT = 2 * MiB + 65536;
constexpr size_t WS_WIN = 4 * MiB;
constexpr size_t WS_WOUT = 24 * MiB;
constexpr size_t WS_WGU = 32 * MiB;
constexpr size_t WS_WDN = 288 * MiB;
constexpr size_t WS_XB = 416 * MiB;
constexpr size_t WS_XF = 480 * MiB;
constexpr size_t WS_XF2 = 608 * MiB;
constexpr size_t WS_PROJ = 736 * MiB;
constexpr size_t WS_DT = 1024 * MiB;
constexpr size_t WS_DTS = 1025 * MiB;
constexpr size_t WS_ACUM = 1026 * MiB;
constexpr size_t WS_LSE = 1027 * MiB;
constexpr size_t WS_OP = 1030 * MiB;
constexpr size_t WS_U = 1126 * MiB;
constexpr size_t WS_G = 1190 * MiB;
constexpr size_t WS_ST = 1222 * MiB;
constexpr size_t WS_YD = 1286 * MiB;
constexpr size_t WS_MIXED = 1350 * MiB;
constexpr size_t WS_MIXF = 1446 * MiB;
constexpr size_t WS_TOPE = 1574 * MiB;
constexpr size_t WS_TOPG = 1575 * MiB;
constexpr size_t WS_ROWTOK = 1576 * MiB;
constexpr size_t WS_ROWGATE = 1580 * MiB;
constexpr size_t WS_H = 736 * MiB;
constexpr size_t WS_YB = 1030 * MiB;
constexpr size_t WS_END = 1584 * MiB;
constexpr int CW_TMO = 0;
constexpr int CW_CNT = 64;
constexpr int CW_BAR = 4096;

constexpr int RING_OFF = 0, RING_BYTES = 131072;
constexpr int LDSCTL_OFF = 155648;
constexpr int L_MISC = LDSCTL_OFF;
constexpr int L_TSTART = LDSCTL_OFF + 256;
constexpr int L_CNT = LDSCTL_OFF + 512;
constexpr int L_LCNT = LDSCTL_OFF + 640;
constexpr int L_LBASE = LDSCTL_OFF + 768;
constexpr int L_UNITS = LDSCTL_OFF + 1024;
constexpr int L_UNITSN = LDSCTL_OFF + 2048;
constexpr int LDS_BYTES = 163840;

#define GAS __attribute__((address_space(1)))
#define LAS __attribute__((address_space(3)))
typedef unsigned short bf16;
typedef unsigned v4u __attribute__((ext_vector_type(4)));
typedef unsigned v2u __attribute__((ext_vector_type(2)));
typedef float f32x4 __attribute__((ext_vector_type(4)));
typedef float f32x16 __attribute__((ext_vector_type(16)));
typedef short bf16x8 __attribute__((ext_vector_type(8)));
typedef GAS unsigned gu32;
#define RLX_AGENT __ATOMIC_RELAXED, __HIP_MEMORY_SCOPE_AGENT
#define LDS_WAIT() asm volatile("s_waitcnt lgkmcnt(0)" ::: "memory")
#define VM_WAIT() asm volatile("s_waitcnt vmcnt(0)" ::: "memory")
__device__ __forceinline__ unsigned f2bf(float f) { unsigned u = __builtin_bit_cast(unsigned, f); return (u + 0x7fffu + ((u >> 16) & 1u)) >> 16; }
__device__ __forceinline__ unsigned pk2(float lo, float hi) { unsigned r; asm volatile("v_cvt_pk_bf16_f32 %0, %1, %2" : "=v"(r) : "v"(lo), "v"(hi)); return r; }
__device__ __forceinline__ float bf2f(unsigned short b) { return __builtin_bit_cast(float, (unsigned)b << 16); }
__device__ __forceinline__ float bflo(unsigned w) { return __builtin_bit_cast(float, w << 16); }
__device__ __forceinline__ float bfhi(unsigned w) { return __builtin_bit_cast(float, w & 0xffff0000u); }
__device__ __forceinline__ float siluf(float x) { return x * __builtin_amdgcn_rcpf(1.0f + __builtin_amdgcn_exp2f(-1.4426950408889634f * x)); }
#define XB_TMO      128
#define XB_XCNT(j)  (256  + 64 * (j))
#define XB_XSUB(j)  (1280 + 64 * (j))
#define XB_XGEN(j)  (2304 + 64 * (j))
#define XB_TOP      3328
#define XB_TOPGEN   3392
#define XCD_BAR_WORDS 3456
#define XB_SPIN_CAP (1u << 18)

__device__ __forceinline__ unsigned xb_ld(unsigned* p)              { return __hip_atomic_load(p, __ATOMIC_RELAXED, __HIP_MEMORY_SCOPE_AGENT); }
__device__ __forceinline__ unsigned xb_add(unsigned* p, unsigned v) { return __hip_atomic_fetch_add(p, v, __ATOMIC_RELAXED, __HIP_MEMORY_SCOPE_AGENT); }
__device__ __forceinline__ unsigned xb_xcc_id() { return (unsigned)__builtin_amdgcn_s_getreg((3 << 11) | 20) & 0xFu; }
#define XB_SPIN(cond, bar) do { unsigned _sp = 0; while (cond) { __builtin_amdgcn_s_sleep(1); \
    if ((++_sp & 255u) == 0u) { if (xb_ld(&(bar)[XB_TMO])) break; if (_sp > XB_SPIN_CAP) { atomicAdd(&(bar)[XB_TMO], 1u); break; } } } } while (0)

struct XcdBarrier {
    unsigned* bar; unsigned x;
    volatile LAS unsigned* st;
};

__device__ __forceinline__ XcdBarrier xcd_barrier_post(unsigned* bar, volatile LAS unsigned* st) {
    XcdBarrier b; b.bar = bar; b.x = xb_xcc_id(); b.st = st;
    if (threadIdx.x == 0) (void)xb_add(&bar[XB_XCNT(b.x)], 1u);
    return b;
}
__device__ __forceinline__ void xcd_barrier_complete(unsigned* bar, unsigned x, unsigned& nloc, unsigned& nx) {
    const unsigned G = gridDim.x * gridDim.y * gridDim.z;
    unsigned sum, cnt, mine, sp = 0u;
    for (;;) {
        sum = 0u; cnt = 0u; mine = 0u;
#pragma unroll
        for (unsigned j = 0; j < 16; ++j) { const unsigned c = xb_ld(&bar[XB_XCNT(j)]); sum += c; cnt += (c > 0u) ? 1u : 0u; mine = (j == x) ? c : mine; }
        if (sum == G) break;
        __builtin_amdgcn_s_sleep(1);
        if ((++sp & 255u) == 0u) { if (xb_ld(&bar[XB_TMO])) break; if (sp > XB_SPIN_CAP) { atomicAdd(&bar[XB_TMO], 1u); break; } }
    }
    nloc = mine > 0u ? mine : 1u; nx = cnt > 0u ? cnt : 1u;
}

__device__ __forceinline__ void xcd_barrier(const XcdBarrier& b) {
    asm volatile("s_waitcnt vmcnt(0)" ::: "memory");
    __syncthreads();
    if (threadIdx.x == 0) {
        unsigned* bar = b.bar;
        __builtin_amdgcn_s_waitcnt(0);
        unsigned nloc = b.st[0], nx = b.st[1];
        if (nloc == 0u) { xcd_barrier_complete(bar, b.x, nloc, nx); b.st[0] = nloc; b.st[1] = nx; }
        const unsigned old = xb_add(&bar[XB_XSUB(b.x)], 1u);
        const unsigned gen = old / nloc;
        if (old + 1u == (gen + 1u) * nloc) {
            __builtin_amdgcn_fence(__ATOMIC_RELEASE, "agent");
            asm volatile("s_waitcnt vmcnt(0)" ::: "memory");
            const unsigned og = xb_add(&bar[XB_TOP], 1u);
            const unsigned tg = og / nx;
            if (og + 1u == (tg + 1u) * nx) xb_add(&bar[XB_TOPGEN], 1u);
            else XB_SPIN(xb_ld(&bar[XB_TOPGEN]) == tg, bar);
            __builtin_amdgcn_fence(__ATOMIC_ACQUIRE, "agent");
            xb_add(&bar[XB_XGEN(b.x)], 1u);
            asm volatile("s_waitcnt vmcnt(0)" ::: "memory");
        } else {
            XB_SPIN(xb_ld(&bar[XB_XGEN(b.x)]) == gen, bar);
            __builtin_amdgcn_fence(__ATOMIC_ACQUIRE, "agent");
            asm volatile("s_waitcnt vmcnt(0)" ::: "memory");
        }
    }
    __syncthreads();
}

constexpr float SC_X = 4.f, SC_WGU = 32.f, SC_H = 4.f, SC_WDN = 64.f;
__device__ __forceinline__ float wave_sum(float v) {
#pragma unroll
    for (int o = 1; o < 64; o <<= 1) v += __shfl_xor(v, o);
    return v;
}
__device__ __forceinline__ int win_dest_row(int n) {
    if (n < 1024) { const int hh = n >> 6, d = n & 63; const int p = (d < 32) ? (8 * (d >> 2) + (d & 3)) : (8 * ((d - 32) >> 2) + 4 + (d & 3)); return hh * 64 + p; }
    if (n < 3072) return n;
    if (n < 3080) return -1;
    return n - 8;
}
__device__ __forceinline__ int wgu_dest_row(int n) { return n < 1024 ? ((n >> 7) * 256 + (n & 127)) : (((n - 1024) >> 7) * 256 + 128 + ((n - 1024) & 127)); }
template <int MAP>
__device__ __forceinline__ void p0_transpose_item(const float* W, int K, int N, bf16* WT, float* wdt, LAS float* scr, int kb, int nb, int lane) {
    const int k0 = 64 * kb, n0 = 32 * nb;
    const int nn = n0 + (lane & 31); const bool nok = nn < N;
#pragma unroll 8
    for (int i = 0; i < 32; ++i) { const int kk = 2 * i + (lane >> 5); scr[kk * 33 + (lane & 31)] = nok ? W[(size_t)(k0 + kk) * N + nn] : 0.f; }
    LDS_WAIT(); asm volatile("" ::: "memory");
    const int c = lane & 7;
#pragma unroll
    for (int j = 0; j < 4; ++j) { const int n = (lane >> 3) + 8 * j; const LAS float* s = scr + (8 * c) * 33 + n;
        const int nsrc = n0 + n; if (nsrc >= N) continue;
        int drow = nsrc; if (MAP == 1) drow = win_dest_row(nsrc); if (MAP == 2) drow = wgu_dest_row(nsrc);
        if (MAP == 1 && drow < 0) { float* d = wdt + (size_t)(nsrc - 3072) * 1024 + k0 + 8 * c;
#pragma unroll
            for (int q = 0; q < 8; ++q) d[q] = s[q * 33]; continue; }
        v4u o; o.x = pk2(s[0 * 33], s[1 * 33]); o.y = pk2(s[2 * 33], s[3 * 33]); o.z = pk2(s[4 * 33], s[5 * 33]); o.w = pk2(s[6 * 33], s[7 * 33]);
        *(GAS v4u*)(WT + (size_t)drow * K + k0 + 8 * c) = o; }
    LDS_WAIT(); asm volatile("" ::: "memory");
}
struct SubT { const float* src; unsigned char* dst; int N; int dmap; float scale; };
__device__ __forceinline__ SubT fp8_subtile(int item, int half, const float* wgu, const float* wdn, unsigned char* WG8, unsigned char* WD8, int lane) {
    SubT t; int kb, nb, n0;
    if (item < 64 * 256) { const int le = item >> 8, r = item & 255; kb = r >> 5; nb = r & 31; n0 = 64 * nb; t.N = 2048; t.dmap = 1; t.scale = SC_WGU;
        t.src = wgu + (size_t)le * 1024 * 2048; t.dst = WG8 + (size_t)le * 2048 * 1024; }
    else { const int it2 = item - 64 * 256; const int le = it2 >> 7, r = it2 & 127; kb = r >> 4; nb = r & 15; n0 = 64 * nb; t.N = 1024; t.dmap = 0; t.scale = SC_WDN;
        t.src = wdn + (size_t)le * 1024 * 1024; t.dst = WD8 + (size_t)le * 1024 * 1024; }
    const int k0 = 128 * kb + 64 * half;
    t.src += (size_t)(k0 + (lane >> 4)) * t.N + n0 + 4 * (lane & 15);
    t.dst += (size_t)k0; t.dmap = t.dmap ? -(n0 + 1) : n0;
    return t;
}
__device__ __forceinline__ void fp8_sub_load(const SubT& t, f32x4 (&ld)[16]) {
#pragma unroll
    for (int i = 0; i < 16; ++i) ld[i] = __builtin_nontemporal_load((const f32x4*)(t.src + (size_t)(4 * i) * t.N));
}
__device__ __forceinline__ void fp8_sub_process(const SubT& t, const f32x4 (&ld)[16], LAS float* scr, int lane) {
#pragma unroll
    for (int i = 0; i < 16; ++i) *(LAS f32x4*)(scr + (4 * i + (lane >> 4)) * 64 + 4 * (lane & 15)) = ld[i];
    LDS_WAIT(); asm volatile("" ::: "memory");
    unsigned w[16];
#pragma unroll
    for (int q = 0; q < 16; ++q) w[q] = pg8::pk4_fp8(scr[(4 * q + 0) * 64 + lane] * t.scale, scr[(4 * q + 1) * 64 + lane] * t.scale, scr[(4 * q + 2) * 64 + lane] * t.scale, scr[(4 * q + 3) * 64 + lane] * t.scale);
    LDS_WAIT(); asm volatile("" ::: "memory");
    LAS unsigned char* t2 = (LAS unsigned char*)scr;
#pragma unroll
    for (int q = 0; q < 4; ++q) *(LAS v4u*)(t2 + lane * 80 + 16 * q) = (v4u){w[4 * q], w[4 * q + 1], w[4 * q + 2], w[4 * q + 3]};
    LDS_WAIT(); asm volatile("" ::: "memory");
#pragma unroll
    for (int q = 0; q < 4; ++q) { const int n = 16 * q + (lane >> 2); const v4u v = *(const LAS v4u*)(t2 + n * 80 + 16 * (lane & 3));
        const int nn = (t.dmap < 0) ? wgu_dest_row(-t.dmap - 1 + n) : (t.dmap + n);
        *(GAS v4u*)(t.dst + (size_t)nn * 1024 + 16 * (lane & 3)) = v; }
    LDS_WAIT(); asm volatile("" ::: "memory");
}
__device__ __forceinline__ void row_dt(const f32x4 (&v)[4], const float* wdt, float* dst, int lane) {
    float r[8];
#pragma unroll
    for (int jj = 0; jj < 8; ++jj) { float s = 0.f;
#pragma unroll
        for (int j = 0; j < 4; ++j) { const f32x4 w = *(const f32x4*)(wdt + jj * 1024 + 4 * lane + 256 * j); s += v[j][0] * w[0] + v[j][1] * w[1] + v[j][2] * w[2] + v[j][3] * w[3]; }
        r[jj] = wave_sum(s); }
    if (lane == 0) { *(f32x4*)dst = (f32x4){r[0], r[1], r[2], r[3]}; *(f32x4*)(dst + 4) = (f32x4){r[4], r[5], r[6], r[7]}; }
}
template <bool W8, bool WF>
__device__ __forceinline__ void ln_row(f32x4 (&v)[4], const float* gam, const float* bet, float* of32, bf16* ob16, unsigned char* o8, float s8, int lane) {
    float s = 0.f;
#pragma unroll
    for (int j = 0; j < 4; ++j) s += (v[j][0] + v[j][1]) + (v[j][2] + v[j][3]);
    const float mean = wave_sum(s) * (1.f / DM); float s2 = 0.f;
#pragma unroll
    for (int j = 0; j < 4; ++j) { v[j] = v[j] - mean; s2 += (v[j][0] * v[j][0] + v[j][1] * v[j][1]) + (v[j][2] * v[j][2] + v[j][3] * v[j][3]); }
    const float rstd = 1.f / sqrtf(wave_sum(s2) * (1.f / DM) + LN_EPS);
#pragma unroll
    for (int j = 0; j < 4; ++j) { const f32x4 g = *(const f32x4*)(gam + 4 * lane + 256 * j), b = *(const f32x4*)(bet + 4 * lane + 256 * j);
        v[j] = v[j] * rstd * g + b;
        if (WF) *(f32x4*)(of32 + 4 * lane + 256 * j) = v[j];
        v2u w; w.x = pk2(v[j][0], v[j][1]); w.y = pk2(v[j][2], v[j][3]); *(v2u*)(ob16 + 4 * lane + 256 * j) = w;
        if (W8) *(unsigned*)(o8 + 4 * lane + 256 * j) = pg8::pk4_fp8(v[j][0] * s8, v[j][1] * s8, v[j][2] * s8, v[j][3] * s8); }
}


typedef short v4i16_t __attribute__((ext_vector_type(4)));
__device__ __forceinline__ bf16x8 tr_pair(const LAS unsigned char* p0, const LAS unsigned char* p1) {
    const v4i16_t a = __builtin_amdgcn_ds_read_tr16_b64_v4i16((LAS v4i16_t*)p0), b = __builtin_amdgcn_ds_read_tr16_b64_v4i16((LAS v4i16_t*)p1);
    return (bf16x8){a[0], a[1], a[2], a[3], b[0], b[1], b[2], b[3]};
}
__device__ __forceinline__ int crow16(int r, int hi) { return (r & 3) + 8 * (r >> 2) + 4 * hi; }
constexpr int AK_PITCH = 144, AV_PITCH = 192, AK_TILE = 32 * AK_PITCH, AV_TILE = 32 * AV_PITCH;
constexpr int AT_K = 0, AT_V = 12 * AK_TILE;
struct AttnItem { int p, b, h, d, r, qt0; };
__device__ __forceinline__ AttnItem attn_item(int I) { AttnItem a; a.p = I >> 10; const int rem = I & 1023; a.b = rem >> 7; a.h = (rem >> 4) & 7; const int grp = rem & 15;
    a.d = (a.p == 0) ? 1 : (a.p == 1) ? 4 : 16; const int tpr = 128 / a.d; const int T = grp * 8; a.r = T / tpr; a.qt0 = T % tpr; return a; }
__device__ __forceinline__ void attn_request(const bf16* PROJ, const AttnItem& a, v4u (&st)[12], int tid) {
    const int rr = tid >> 4, ch = tid & 15; const int col = (ch < 8 ? C_K : C_V - 64) + a.h * 64 + ch * 8;
#pragma unroll
    for (int tl = 0; tl < 12; ++tl) { const int kt = a.qt0 - 4 + tl; st[tl] = (v4u){0u, 0u, 0u, 0u};
        if (kt >= 0) { const size_t row = (size_t)a.b * SEQ + (size_t)(32 * kt + rr) * a.d + a.r; st[tl] = *(const v4u*)(PROJ + row * NPROJ + col); } }
}
__device__ __forceinline__ void attn_deposit(LAS unsigned char* al, const v4u (&st)[12], int tid) {
    const int rr = tid >> 4, ch = tid & 15;
    LAS unsigned char* dst = (ch < 8) ? (al + AT_K + rr * AK_PITCH + ch * 16) : (al + AT_V + rr * AV_PITCH + (ch - 8) * 16); const int tstep = (ch < 8) ? AK_TILE : AV_TILE;
#pragma unroll
    for (int tl = 0; tl < 12; ++tl) *(LAS v4u*)(dst + tl * tstep) = st[tl];
}
__device__ __forceinline__ void attn_wave_compute(const bf16* PROJ, bf16* OPp, float* LSEp, const AttnItem& a, const LAS unsigned char* al, int wave, int lane) {
    const int i = lane & 31, h2 = lane >> 5; const int qt = a.qt0 + wave;
    const size_t rowq = (size_t)a.b * SEQ + (size_t)(32 * qt + i) * a.d + a.r;
    bf16x8 qf[4];
    { const bf16* qp = PROJ + rowq * NPROJ + C_Q + a.h * 64 + 8 * h2;
#pragma unroll
      for (int s = 0; s < 4; ++s) qf[s] = *(const bf16x8*)(qp + 16 * s); }
    f32x16 o0 = {}, o1 = {}; float mrun = -INFINITY, lrun = 0.f;
    const int kt0 = qt > 4 ? qt - 4 : 0;
    const LAS unsigned char* krd = al + AT_K + i * AK_PITCH + 16 * h2;
    const LAS unsigned char* trb = al + AT_V + (4 * h2 + ((lane & 15) >> 2)) * AV_PITCH + (16 * ((lane >> 4) & 1) + 4 * (lane & 3)) * 2;
#pragma unroll 1
    for (int kt = kt0; kt <= qt; ++kt) {
        const int tl = kt - a.qt0 + 4;
        const LAS unsigned char* kp = krd + tl * AK_TILE; const LAS unsigned char* vp = trb + tl * AV_TILE;
        f32x16 sacc = {};
#pragma unroll
        for (int s = 0; s < 4; ++s) sacc = __builtin_amdgcn_mfma_f32_32x32x16_bf16(*(const LAS bf16x8*)(kp + 32 * s), qf[s], sacc, 0, 0, 0);
        if (kt == qt) {
#pragma unroll
            for (int rg = 0; rg < 16; ++rg) if (crow16(rg, h2) > i) sacc[rg] = -INFINITY;
        }
        if (kt + 4 == qt) {
#pragma unroll
            for (int rg = 0; rg < 16; ++rg) if (crow16(rg, h2) < i) sacc[rg] = -INFINITY;
        }
        float mx = sacc[0];
#pragma unroll
        for (int rg = 1; rg < 16; ++rg) mx = fmaxf(mx, sacc[rg]);
        mx = fmaxf(mx, __shfl_xor(mx, 32));
        const float mnew = fmaxf(mrun, mx), alpha = __builtin_amdgcn_exp2f(mrun - mnew); mrun = mnew;
        float ps = 0.f;
#pragma unroll
        for (int rg = 0; rg < 16; ++rg) { sacc[rg] = __builtin_amdgcn_exp2f(sacc[rg] - mnew); ps += sacc[rg]; }
        lrun = lrun * alpha + ps;
#pragma unroll
        for (int rg = 0; rg < 16; ++rg) { o0[rg] *= alpha; o1[rg] *= alpha; }
        bf16x8 pf[2];
#pragma unroll
        for (int ks = 0; ks < 2; ++ks) { v4u w; w.x = pg8::cvt_pk_bf16(sacc[8 * ks + 0], sacc[8 * ks + 1]); w.y = pg8::cvt_pk_bf16(sacc[8 * ks + 2], sacc[8 * ks + 3]); w.z = pg8::cvt_pk_bf16(sacc[8 * ks + 4], sacc[8 * ks + 5]); w.w = pg8::cvt_pk_bf16(sacc[8 * ks + 6], sacc[8 * ks + 7]); pf[ks] = __builtin_bit_cast(bf16x8, w); }
#pragma unroll
        for (int ks = 0; ks < 2; ++ks) {
            const bf16x8 v0 = tr_pair(vp + (16 * ks) * AV_PITCH, vp + (16 * ks + 8) * AV_PITCH);
            const bf16x8 v1 = tr_pair(vp + (16 * ks) * AV_PITCH + 64, vp + (16 * ks + 8) * AV_PITCH + 64);
            o0 = __builtin_amdgcn_mfma_f32_32x32x16_bf16(v0, pf[ks], o0, 0, 0, 0);
            o1 = __builtin_amdgcn_mfma_f32_32x32x16_bf16(v1, pf[ks], o1, 0, 0, 0);
        }
    }
    const float lt = lrun + __shfl_xor(lrun, 32); const float il = 1.0f / lt;
    bf16* op = OPp + rowq * 512 + a.h * 64 + 4 * h2;
#pragma unroll
    for (int g4 = 0; g4 < 4; ++g4) {
        v2u w0, w1; w0.x = pg8::cvt_pk_bf16(o0[4 * g4 + 0] * il, o0[4 * g4 + 1] * il); w0.y = pg8::cvt_pk_bf16(o0[4 * g4 + 2] * il, o0[4 * g4 + 3] * il);
        w1.x = pg8::cvt_pk_bf16(o1[4 * g4 + 0] * il, o1[4 * g4 + 1] * il); w1.y = pg8::cvt_pk_bf16(o1[4 * g4 + 2] * il, o1[4 * g4 + 3] * il);
        *(v2u*)(op + 8 * g4) = w0; *(v2u*)(op + 32 + 8 * g4) = w1; }
    if (h2 == 0) LSEp[rowq * 8 + a.h] = mrun + log2f(lt);
}
__device__ __forceinline__ void attn_phase(LAS unsigned char* al, const bf16* PROJ, bf16* OP, float* LSE, int bid, int G, int tid, int wave, int lane) {
    v4u st[12];
    int I = bid;
    if (I < 3072) { const AttnItem a = attn_item(I); attn_request(PROJ, a, st, tid); }
    for (; I < 3072; I += G) {
        const AttnItem a = attn_item(I);
        __syncthreads();
        attn_deposit(al, st, tid);
        __syncthreads();
        if (I + G < 3072) { const AttnItem n = attn_item(I + G); attn_request(PROJ, n, st, tid); }
        attn_wave_compute(PROJ, OP + (size_t)a.p * MROWS * 512, LSE + (size_t)a.p * MROWS * 8, a, al, wave, lane);
    }
    __syncthreads();
}

constexpr int SS_DTS = 0, SS_ACUM = 2048, SS_TMP = 4096, SS_SSX = 6144, SS_IMG = 8192;
constexpr int S1_PB = 320, S1_PX = 576;
constexpr int S1_B = SS_IMG, S1_X = SS_IMG + 128 * S1_PB;
constexpr int S3_PBC = 272, S3_PX = 576;
constexpr int S3_B = SS_IMG, S3_C = S3_B + 128 * S3_PBC, S3_X = S3_C + 128 * S3_PBC;

__device__ __forceinline__ void ssd_prep(LAS unsigned char* sl, const float* DT, const float* dtb, const float* alog, size_t row0, int g, int tid, int lane, int wave) {
    LAS float* dts = (LAS float*)(sl + SS_DTS); LAS float* acum = (LAS float*)(sl + SS_ACUM); LAS float* tmp = (LAS float*)(sl + SS_TMP);
    { const int l = tid >> 2, hq = tid & 3; const float x = DT[(row0 + l) * 8 + 4 * g + hq] + dtb[4 * g + hq];
      const float dt = x > 20.f ? x : log1pf(__expf(x)); dts[hq * 128 + l] = dt; tmp[hq * 128 + l] = dt * (-__expf(alog[4 * g + hq])); }
    __syncthreads();
    if (wave < 4) { const float v0 = tmp[wave * 128 + 2 * lane], v1 = tmp[wave * 128 + 2 * lane + 1]; float s = v0 + v1;
#pragma unroll
        for (int off = 1; off < 64; off <<= 1) { const float t = __shfl_up(s, off); if (lane >= off) s += t; }
        acum[wave * 128 + 2 * lane] = s - v1; acum[wave * 128 + 2 * lane + 1] = s; }
    __syncthreads();
}
template <int NCOLS, int FACMODE>
__device__ __forceinline__ void conv_tile(const bf16* PROJ, size_t row0, int t0, int pcol0, const float* cw, const float* cb, int cch0, LAS unsigned char* dst, int pitch, const LAS unsigned char* sl, int hq0, int tid) {
    constexpr int NCH8 = NCOLS / 8, NSEG = 512 / NCH8, RPS = 128 / NSEG;
    const int c8 = tid % NCH8, seg = tid / NCH8, l0 = seg * RPS;
    float w[4][8], bias[8], hst[3][8];
#pragma unroll
    for (int k = 0; k < 4; ++k) { const f32x4 a = *(const f32x4*)(cw + k * 1024 + cch0 + c8 * 8), b = *(const f32x4*)(cw + k * 1024 + cch0 + c8 * 8 + 4);
        w[k][0] = a[0]; w[k][1] = a[1]; w[k][2] = a[2]; w[k][3] = a[3]; w[k][4] = b[0]; w[k][5] = b[1]; w[k][6] = b[2]; w[k][7] = b[3]; }
    { const f32x4 a = *(const f32x4*)(cb + cch0 + c8 * 8), b = *(const f32x4*)(cb + cch0 + c8 * 8 + 4);
      bias[0] = a[0]; bias[1] = a[1]; bias[2] = a[2]; bias[3] = a[3]; bias[4] = b[0]; bias[5] = b[1]; bias[6] = b[2]; bias[7] = b[3]; }
    const bf16* src = PROJ + pcol0 + c8 * 8;
#pragma unroll
    for (int k = 0; k < 3; ++k) { const int l = l0 - 3 + k; v4u v = (v4u){0u, 0u, 0u, 0u}; if (t0 + l >= 0) v = *(const v4u*)(src + (size_t)((long)row0 + l) * NPROJ);
        hst[k][0] = bflo(v.x); hst[k][1] = bfhi(v.x); hst[k][2] = bflo(v.y); hst[k][3] = bfhi(v.y); hst[k][4] = bflo(v.z); hst[k][5] = bfhi(v.z); hst[k][6] = bflo(v.w); hst[k][7] = bfhi(v.w); }
    const LAS float* dts = (const LAS float*)(sl + SS_DTS); const LAS float* acum = (const LAS float*)(sl + SS_ACUM);
    const int hq = hq0 + (c8 * 8) / 64;
    const float alast = (FACMODE == 2) ? acum[hq * 128 + 127] : 0.f;
#pragma unroll
    for (int rr = 0; rr < RPS; ++rr) { const int l = l0 + rr; const v4u v = *(const v4u*)(src + (row0 + l) * NPROJ);
        float cur[8]; cur[0] = bflo(v.x); cur[1] = bfhi(v.x); cur[2] = bflo(v.y); cur[3] = bfhi(v.y); cur[4] = bflo(v.z); cur[5] = bfhi(v.z); cur[6] = bflo(v.w); cur[7] = bfhi(v.w);
        float f = 1.f; if (FACMODE >= 1) f = dts[hq * 128 + l]; if (FACMODE == 2) f *= __expf(alast - acum[hq * 128 + l]);
        float o[8];
#pragma unroll
        for (int e = 0; e < 8; ++e) { const float a = bias[e] + w[0][e] * hst[0][e] + w[1][e] * hst[1][e] + w[2][e] * hst[2][e] + w[3][e] * cur[e]; o[e] = siluf(a) * f;
            hst[0][e] = hst[1][e]; hst[1][e] = hst[2][e]; hst[2][e] = cur[e]; }
        v4u ov; ov.x = pk2(o[0], o[1]); ov.y = pk2(o[2], o[3]); ov.z = pk2(o[4], o[5]); ov.w = pk2(o[6], o[7]);
        *(LAS v4u*)(dst + l * pitch + c8 * 16) = ov; }
}
__device__ __forceinline__ void ssd_s1_unit(LAS unsigned char* sl, const bf16* PROJ, const float* DT, const float* dtb, const float* alog, const float* cw, const float* cb, float* ST, float* CDEC, int un, int tid, int lane, int wave) {
    const int g = un & 1, bc = un >> 1; const size_t row0 = (size_t)bc * 128; const int t0 = (bc & 31) * 128;
    __syncthreads();
    ssd_prep(sl, DT, dtb, alog, row0, g, tid, lane, wave);
    conv_tile<128, 0>(PROJ, row0, t0, C_XS + 512 + g * 128, cw, cb, 512 + g * 128, sl + S1_B, S1_PB, sl, 0, tid);
    conv_tile<256, 2>(PROJ, row0, t0, C_XS + g * 256, cw, cb, g * 256, sl + S1_X, S1_PX, sl, 0, tid);
    if (tid < 4) CDEC[(size_t)bc * 8 + 4 * g + tid] = __expf(((const LAS float*)(sl + SS_ACUM))[tid * 128 + 127]);
    __syncthreads();
    const int hq = wave >> 1, pt = wave & 1, h2 = lane >> 5, q = (lane & 15) >> 2, pp = lane & 3, dsel = (lane >> 4) & 1;
    const LAS unsigned char* xb = sl + S1_X + (8 * h2 + q) * S1_PX + (hq * 64 + pt * 32 + 16 * dsel + 4 * pp) * 2;
    const LAS unsigned char* bb = sl + S1_B + (8 * h2 + q) * S1_PB + (16 * dsel + 4 * pp) * 2;
    f32x16 acc[4];
#pragma unroll
    for (int nt = 0; nt < 4; ++nt) acc[nt] = (f32x16){};
#pragma unroll
    for (int ks = 0; ks < 8; ++ks) { const bf16x8 a = tr_pair(xb + (16 * ks) * S1_PX, xb + (16 * ks + 4) * S1_PX);
#pragma unroll
        for (int nt = 0; nt < 4; ++nt) { const bf16x8 b = tr_pair(bb + (16 * ks) * S1_PB + nt * 64, bb + (16 * ks + 4) * S1_PB + nt * 64); acc[nt] = __builtin_amdgcn_mfma_f32_32x32x16_bf16(a, b, acc[nt], 0, 0, 0); } }
    float* sp = ST + ((size_t)(bc * 8 + 4 * g + hq) * 64 + pt * 32) * 128 + (lane & 31);
#pragma unroll
    for (int nt = 0; nt < 4; ++nt)
#pragma unroll
        for (int rg = 0; rg < 16; ++rg) sp[(size_t)crow16(rg, h2) * 128 + 32 * nt] = acc[nt][rg];
}
__device__ __forceinline__ void ssd_s3_unit(LAS unsigned char* sl, const bf16* PROJ, const float* DT, const float* dtb, const float* alog, const float* cw, const float* cb, const float* dsk, const float* ng,
                                            const bf16* HIN, bf16* MIXED, int un, int tid, int lane, int wave) {
    const int g = un & 1, bc = un >> 1; const size_t row0 = (size_t)bc * 128; const int t0 = (bc & 31) * 128;
    const int lt = wave & 3, ph = wave >> 2, lq = lane & 31, hi = lane >> 5, q = (lane & 15) >> 2, pp = lane & 3, dsel = (lane >> 4) & 1;
    const int lrow = 32 * lt + lq;
    const size_t grow = row0 + lrow;
    __syncthreads();
    ssd_prep(sl, DT, dtb, alog, row0, g, tid, lane, wave);
    conv_tile<128, 0>(PROJ, row0, t0, C_XS + 512 + g * 128, cw, cb, 512 + g * 128, sl + S3_B, S3_PBC, sl, 0, tid);
    conv_tile<128, 0>(PROJ, row0, t0, C_XS + 768 + g * 128, cw, cb, 768 + g * 128, sl + S3_C, S3_PBC, sl, 0, tid);
    conv_tile<256, 1>(PROJ, row0, t0, C_XS + g * 256, cw, cb, g * 256, sl + S3_X, S3_PX, sl, 0, tid);
    __syncthreads();
    const LAS float* dts = (const LAS float*)(sl + SS_DTS); const LAS float* acum = (const LAS float*)(sl + SS_ACUM); LAS float* ssx = (LAS float*)(sl + SS_SSX);
    const LAS unsigned char* crd = sl + S3_C + lrow * S3_PBC + 16 * hi;
    f32x16 y[4];
    { bf16x8 hfa[8], hfb[8];
      const bf16* hp0 = HIN + ((size_t)(bc * 8 + 4 * g) * 64 + ph * 32 + lq) * 128 + 8 * hi;
#pragma unroll
      for (int ks = 0; ks < 8; ++ks) hfa[ks] = *(const bf16x8*)(hp0 + 16 * ks);
#pragma unroll
      for (int hq = 0; hq < 4; ++hq) {
          if (hq < 3) {
#pragma unroll
              for (int ks = 0; ks < 8; ++ks) { const bf16x8 v = *(const bf16x8*)(hp0 + (size_t)(hq + 1) * 8192 + 16 * ks); if (hq & 1) hfa[ks] = v; else hfb[ks] = v; } }
          f32x16 t = (f32x16){};
#pragma unroll
          for (int ks = 0; ks < 8; ++ks) t = __builtin_amdgcn_mfma_f32_32x32x16_bf16((hq & 1) ? hfb[ks] : hfa[ks], *(const LAS bf16x8*)(crd + 32 * ks), t, 0, 0, 0);
          const float ea = __expf(acum[hq * 128 + lrow]);
#pragma unroll
          for (int rg = 0; rg < 16; ++rg) t[rg] *= ea;
          y[hq] = t; } }
    v2u zr[4][4];
#pragma unroll
    for (int hq = 0; hq < 4; ++hq)
#pragma unroll
        for (int g4 = 0; g4 < 4; ++g4) zr[hq][g4] = *(const v2u*)(PROJ + grow * NPROJ + C_Z + g * 256 + hq * 64 + ph * 32 + 8 * g4 + 4 * hi);
#pragma unroll
    for (int st = 0; st < 4; ++st) if (st <= lt) {
        f32x16 ag = (f32x16){};
        { const LAS unsigned char* brd = sl + S3_B + (32 * st + lq) * S3_PBC + 16 * hi;
#pragma unroll
          for (int ks = 0; ks < 8; ++ks) ag = __builtin_amdgcn_mfma_f32_32x32x16_bf16(*(const LAS bf16x8*)(brd + 32 * ks), *(const LAS bf16x8*)(crd + 32 * ks), ag, 0, 0, 0); }
#pragma unroll
        for (int hq = 0; hq < 4; ++hq) {
            const float al = acum[hq * 128 + lrow], dd = dsk[4 * g + hq] / dts[hq * 128 + lrow];
            const LAS unsigned char* xb = sl + S3_X + (4 * hi + q) * S3_PX + (hq * 64 + ph * 32 + 16 * dsel + 4 * pp) * 2;
            float pm[16];
#pragma unroll
            for (int g4 = 0; g4 < 4; ++g4) { const f32x4 as4 = *(const LAS f32x4*)(acum + hq * 128 + 32 * st + 8 * g4 + 4 * hi);
#pragma unroll
                for (int e = 0; e < 4; ++e) { const int rg = 4 * g4 + e; float v = ag[rg] * __expf(al - as4[e]);
                    if (st == lt) { const int sl_ = 8 * g4 + 4 * hi + e; if (sl_ > lq) v = 0.f; if (sl_ == lq) v += dd; }
                    pm[rg] = v; } }
#pragma unroll
            for (int ks = 0; ks < 2; ++ks) { v4u wv; wv.x = pg8::cvt_pk_bf16(pm[8 * ks + 0], pm[8 * ks + 1]); wv.y = pg8::cvt_pk_bf16(pm[8 * ks + 2], pm[8 * ks + 3]); wv.z = pg8::cvt_pk_bf16(pm[8 * ks + 4], pm[8 * ks + 5]); wv.w = pg8::cvt_pk_bf16(pm[8 * ks + 6], pm[8 * ks + 7]);
                const bf16x8 xt = tr_pair(xb + (32 * st + 16 * ks) * S3_PX, xb + (32 * st + 16 * ks + 8) * S3_PX);
                y[hq] = __builtin_amdgcn_mfma_f32_32x32x16_bf16(xt, __builtin_bit_cast(bf16x8, wv), y[hq], 0, 0, 0); }
        }
    }
    unsigned ayp[4][8]; float ss = 0.f;
#pragma unroll
    for (int hq = 0; hq < 4; ++hq)
#pragma unroll
        for (int g4 = 0; g4 < 4; ++g4) { const v2u z = zr[hq][g4];
            const float y0 = y[hq][4 * g4 + 0] * siluf(bflo(z.x)), y1 = y[hq][4 * g4 + 1] * siluf(bfhi(z.x)), y2 = y[hq][4 * g4 + 2] * siluf(bflo(z.y)), y3 = y[hq][4 * g4 + 3] * siluf(bfhi(z.y));
            ss += (y0 * y0 + y1 * y1) + (y2 * y2 + y3 * y3);
            ayp[hq][2 * g4] = pg8::cvt_pk_bf16(y0, y1); ayp[hq][2 * g4 + 1] = pg8::cvt_pk_bf16(y2, y3); }
    ss += __shfl_xor(ss, 32);
    if (hi == 0) ssx[ph * 128 + lrow] = ss;
    __syncthreads();
    const float rs = 1.0f / sqrtf((ssx[lrow] + ssx[128 + lrow]) * (1.f / 256.f) + RMS_EPS);
#pragma unroll
    for (int hq = 0; hq < 4; ++hq)
#pragma unroll
        for (int g4 = 0; g4 < 4; ++g4) { const int ch = hq * 64 + ph * 32 + 8 * g4 + 4 * hi; const f32x4 gn = *(const f32x4*)(ng + g * 256 + ch);
            const unsigned p0 = ayp[hq][2 * g4], p1 = ayp[hq][2 * g4 + 1];
            v2u o; o.x = pg8::cvt_pk_bf16(bflo(p0) * rs * gn[0], bfhi(p0) * rs * gn[1]); o.y = pg8::cvt_pk_bf16(bflo(p1) * rs * gn[2], bfhi(p1) * rs * gn[3]);
            *(v2u*)(MIXED + grow * MIXW + 512 + g * 256 + ch) = o; }
}

struct Args { const float* in[20]; float* out; unsigned char* ws; int ph_lo, ph_hi, sub, pad; };
constexpr int NWAVES = 8;
constexpr int PH_PER_LAYER = 10, N_PHASES = 1 + NLAYER * PH_PER_LAYER;

#define in_x (args.in[0])
#define in_win (args.in[1])
#define in_convw (args.in[2])
#define in_convb (args.in[3])
#define in_dtb (args.in[4])
#define in_alog (args.in[5])
#define in_dsk (args.in[6])
#define in_ng (args.in[7])
#define in_scw (args.in[8])
#define in_wout (args.in[9])
#define in_ln1g (args.in[10])
#define in_ln1b (args.in[11])
#define in_rw (args.in[12])
#define in_rb (args.in[13])
#define in_wgu (args.in[14])
#define in_bgu (args.in[15])
#define in_wdn (args.in[16])
#define in_bdn (args.in[17])
#define in_ln2g (args.in[18])
#define in_ln2b (args.in[19])
#define ROPE ((float*)(args.ws + WS_ROPE))
#define WDT ((float*)(args.ws + WS_WDT))
#define ROUT ((bf16*)(args.ws + WS_ROUT))
#define WIN ((bf16*)(args.ws + WS_WIN))
#define WOUT ((bf16*)(args.ws + WS_WOUT))
#define WGU ((bf16*)(args.ws + WS_WGU))
#define WDN ((bf16*)(args.ws + WS_WDN))
#define XB ((bf16*)(args.ws + WS_XB))
#define XF ((float*)(args.ws + WS_XF))
#define XF2 ((float*)(args.ws + WS_XF2))
#define PROJ ((bf16*)(args.ws + WS_PROJ))
#define DT ((float*)(args.ws + WS_DT))
#define DTS ((float*)(args.ws + WS_DTS))
#define ACUM ((float*)(args.ws + WS_ACUM))
#define LSE ((float*)(args.ws + WS_LSE))
#define OP ((bf16*)(args.ws + WS_OP))
#define U ((bf16*)(args.ws + WS_U))
#define GB ((float*)(args.ws + WS_G))
#define ST ((float*)(args.ws + WS_ST))
#define YD ((float*)(args.ws + WS_YD))
#define MIXED ((bf16*)(args.ws + WS_MIXED))
#define MIXF ((bf16*)(args.ws + WS_MIXF))
#define TOPE ((int*)(args.ws + WS_TOPE))
#define TOPG ((float*)(args.ws + WS_TOPG))
#define ROWTOK ((int*)(args.ws + WS_ROWTOK))
#define ROWGATE ((float*)(args.ws + WS_ROWGATE))
#define HB ((bf16*)(args.ws + WS_H))
#define YB ((bf16*)(args.ws + WS_YB))
#define HIN ((bf16*)(args.ws + WS_G))
#define WGU8 ((unsigned char*)(args.ws + WS_WGU))
#define WDN8 ((unsigned char*)(args.ws + WS_WDN))
#define XB8 ((unsigned char*)(args.ws + WS_U))
#define H8 ((unsigned char*)(args.ws + WS_H))
#define CDEC ((float*)(args.ws + WS_ACUM))
template <int layer>
__device__ __forceinline__ void run_layer(const Args& args, int lo, int hi, const XcdBarrier& bar) {
    extern __shared__ __attribute__((aligned(16))) unsigned char lds[];
    LAS unsigned char* ldsp = (LAS unsigned char*)lds;
    const int tid = threadIdx.x, lane = tid & 63, wave = __builtin_amdgcn_readfirstlane(tid >> 6);
    const int G = gridDim.x, bid = blockIdx.x;
    const int gw = bid * NWAVES + wave, NGW = G * NWAVES;
    gu32* ctl = (gu32*)(args.ws + WS_CTL);

#define IN(k) (lo <= (k) && (k) < hi)
#define SEAM(k) do { if (IN(k) && IN((k) + 1)) xcd_barrier(bar); } while (0)

        const int pb = 1 + layer * PH_PER_LAYER;
        const bf16* WINl = WIN + (size_t)layer * NPROJ * DM; const bf16* WOUTl = WOUT + (size_t)layer * DM * MIXW;
        const unsigned char* WGUl = WGU8 + (size_t)layer * NEXP * 2048 * DM; const unsigned char* WDNl = WDN8 + (size_t)layer * NEXP * DM * FF;
        gu32* gcnt = ctl + CW_CNT + 64 * layer;

        if (IN(pb + 0)) {
            if (layer == 0) {
                for (int m = gw; m < MROWS; m += NGW) { const float* xr = in_x + (size_t)m * DM; f32x4 v[4];
#pragma unroll
                    for (int j = 0; j < 4; ++j) v[j] = *(const f32x4*)(xr + 4 * lane + 256 * j);
                    row_dt(v, WDT, DT + (size_t)m * 8, lane); }
            }
            pg8::Gemm g{XB, WINl, MROWS, NPROJ, DM}; pg8::StaticOrder S; S.init(MROWS, NPROJ, G, bid);
            pg8::EpiProj E{PROJ, NPROJ, ROPE, QSCALE};
            pg8::gemm_phase<pg8::EpiProj, pg8::StaticOrder, true, false>(ldsp + RING_OFF, g, S, E);
        }
        SEAM(pb + 0);
        if (IN(pb + 1)) {
            if (args.sub & 1) attn_phase(ldsp + RING_OFF, PROJ, OP, LSE, bid, G, tid, wave, lane);
            if (args.sub & 2) { const float* cw = in_convw + (size_t)layer * 4 * 1024; const float* cb = in_convb + (size_t)layer * 1024;
              for (int un = bid; un < 512; un += G)
                  ssd_s1_unit(ldsp + RING_OFF, PROJ, DT, in_dtb + layer * 8, in_alog + layer * 8, cw, cb, ST, CDEC, un, tid, lane, wave);
              __syncthreads(); }
            const float* sw = in_scw + (size_t)layer * 3 * 512;
            if (args.sub & 4) for (int it = bid * (NWAVES * 64) + tid; it < (int)((long)MROWS * 64); it += G * (NWAVES * 64)) { const int c8 = (int)(it & 63), row = (int)(it >> 6), t = row & (SEQ - 1); const int ch = c8 * 8;
                float a[8];
#pragma unroll
                for (int q = 0; q < 8; ++q) a[q] = 0.f;
#pragma unroll
                for (int k = 0; k < 3; ++k) { const int tt = t - 2 + k; if (tt >= 0) { const bf16* pr = PROJ + (size_t)(row - 2 + k) * NPROJ; const v4u cc = *(const v4u*)(pr + C_SC + ch), hh = *(const v4u*)(pr + C_SH + ch);
                    const f32x4 w0 = *(const f32x4*)(sw + k * 512 + ch), w1 = *(const f32x4*)(sw + k * 512 + ch + 4);
                    a[0] += w0[0] * bflo(cc.x) * bflo(hh.x); a[1] += w0[1] * bfhi(cc.x) * bfhi(hh.x); a[2] += w0[2] * bflo(cc.y) * bflo(hh.y); a[3] += w0[3] * bfhi(cc.y) * bfhi(hh.y);
                    a[4] += w1[0] * bflo(cc.z) * bflo(hh.z); a[5] += w1[1] * bfhi(cc.z) * bfhi(hh.z); a[6] += w1[2] * bflo(cc.w) * bflo(hh.w); a[7] += w1[3] * bfhi(cc.w) * bfhi(hh.w); } }
                const v4u bb = *(const v4u*)(PROJ + (size_t)row * NPROJ + C_SB + ch);
                v4u o; o.x = pk2(a[0] * bflo(bb.x), a[1] * bfhi(bb.x)); o.y = pk2(a[2] * bflo(bb.y), a[3] * bfhi(bb.y)); o.z = pk2(a[4] * bflo(bb.z), a[5] * bfhi(bb.z)); o.w = pk2(a[6] * bflo(bb.w), a[7] * bfhi(bb.w));
                *(v4u*)(MIXED + (size_t)row * MIXW + 1024 + ch) = o; }
        }
        SEAM(pb + 1);
        if (IN(pb + 2)) {
            for (int it = bid * (NWAVES * 64) + tid; it < (int)(64L * 2048); it += G * (NWAVES * 64)) { const int pn4 = (int)(it & 2047), bh = (int)(it >> 11); const int h = bh & 7, b = bh >> 3; f32x4 hc = (f32x4){0.f, 0.f, 0.f, 0.f};
#pragma unroll 8
                for (int c = 0; c < 32; ++c) { const size_t idx = ((size_t)((b * 32 + c) * 8 + h)) * 8192 + pn4 * 4; const f32x4 st = *(const f32x4*)(ST + idx);
                    v2u o; o.x = pk2(hc[0], hc[1]); o.y = pk2(hc[2], hc[3]); *(v2u*)(HIN + idx) = o;
                    hc = hc * CDEC[(size_t)(b * 32 + c) * 8 + h] + st; } }
        }
        SEAM(pb + 2);
        if (IN(pb + 3)) {
            if (args.sub & 1) { const float* cw = in_convw + (size_t)layer * 4 * 1024; const float* cb = in_convb + (size_t)layer * 1024;
              for (int un = bid; un < 512; un += G)
                  ssd_s3_unit(ldsp + RING_OFF, PROJ, DT, in_dtb + layer * 8, in_alog + layer * 8, cw, cb, in_dsk + layer * 8, in_ng + (size_t)layer * 512, HIN, MIXED, un, tid, lane, wave);
              __syncthreads(); }
            if (args.sub & 2) for (int it = bid * (NWAVES * 64) + tid; it < (int)((long)MROWS * 64); it += G * (NWAVES * 64)) { const int c8 = (int)(it & 63), row = (int)(it >> 6); const int h = c8 >> 3;
                const float l0 = LSE[((size_t)0 * MROWS + row) * 8 + h], l1 = LSE[((size_t)1 * MROWS + row) * 8 + h], l2 = LSE[((size_t)2 * MROWS + row) * 8 + h];
                const float mm = fmaxf(l0, fmaxf(l1, l2)); float w0 = exp2f(l0 - mm), w1 = exp2f(l1 - mm), w2 = exp2f(l2 - mm); const float iw = 1.0f / (w0 + w1 + w2); w0 *= iw; w1 *= iw; w2 *= iw;
                const v4u a0 = *(const v4u*)(OP + ((size_t)0 * MROWS + row) * 512 + c8 * 8), a1 = *(const v4u*)(OP + ((size_t)1 * MROWS + row) * 512 + c8 * 8), a2 = *(const v4u*)(OP + ((size_t)2 * MROWS + row) * 512 + c8 * 8);
                v4u o;
                o.x = pk2(w0 * bflo(a0.x) + w1 * bflo(a1.x) + w2 * bflo(a2.x), w0 * bfhi(a0.x) + w1 * bfhi(a1.x) + w2 * bfhi(a2.x));
                o.y = pk2(w0 * bflo(a0.y) + w1 * bflo(a1.y) + w2 * bflo(a2.y), w0 * bfhi(a0.y) + w1 * bfhi(a1.y) + w2 * bfhi(a2.y));
                o.z = pk2(w0 * bflo(a0.z) + w1 * bflo(a1.z) + w2 * bflo(a2.z), w0 * bfhi(a0.z) + w1 * bfhi(a1.z) + w2 * bfhi(a2.z));
                o.w = pk2(w0 * bflo(a0.w) + w1 * bflo(a1.w) + w2 * bflo(a2.w), w0 * bfhi(a0.w) + w1 * bfhi(a1.w) + w2 * bfhi(a2.w));
                *(v4u*)(MIXED + (size_t)row * MIXW + c8 * 8) = o; }
        }
        SEAM(pb + 3);
        if (IN(pb + 4)) {
            pg8::Gemm g{MIXED, WOUTl, MROWS, DM, MIXW}; pg8::StaticOrder S; S.init(MROWS, DM, G, bid);
            pg8::EpiBf16Plain E{MIXF, DM};
            pg8::gemm_phase<pg8::EpiBf16Plain, pg8::StaticOrder, true, false>(ldsp + RING_OFF, g, S, E);
        }
        SEAM(pb + 4);
        if (IN(pb + 5)) {
            const float* gam = in_ln1g + (size_t)layer * DM; const float* bet = in_ln1b + (size_t)layer * DM;
            for (int m = gw; m < MROWS; m += NGW) { f32x4 v[4];
#pragma unroll
                for (int j = 0; j < 4; ++j) { const v2u a = *(const v2u*)(XB + (size_t)m * DM + 4 * lane + 256 * j); const v2u b = *(const v2u*)(MIXF + (size_t)m * DM + 4 * lane + 256 * j);
                    v[j] = (f32x4){bflo(a.x), bfhi(a.x), bflo(a.y), bfhi(a.y)} * ALPHA + (f32x4){bflo(b.x), bfhi(b.x), bflo(b.y), bfhi(b.y)}; }
                ln_row<true, false>(v, gam, bet, nullptr, XB + (size_t)m * DM, XB8 + (size_t)m * DM, SC_X, lane); }
        }
        SEAM(pb + 5);
        if (IN(pb + 6)) {
            LAS int* lcnt = (LAS int*)(ldsp + L_LCNT); LAS int* lbase = (LAS int*)(ldsp + L_LBASE);
            const bf16* RT = ROUT + (size_t)layer * NEXP * DM; const float* rb = in_rb + (size_t)layer * NEXP;
            for (int blk = bid; blk < MROWS / 128; blk += G) {
                if (tid < 32) lcnt[tid] = 0;
                __syncthreads();
                const int r32 = lane & 31, hi = lane >> 5; const int row = blk * 128 + (wave & 3) * 32 + r32;
                float tv[4]; int te[4]; int lrank[4]; float gate[4];
                if (wave < 4) {
                    f32x16 acc = {};
                    const bf16* ap = RT + (size_t)r32 * DM + 8 * hi; const bf16* bp = XB + (size_t)row * DM + 8 * hi;
#pragma unroll 8
                    for (int s = 0; s < 64; ++s) { const bf16x8 a = *(const bf16x8*)(ap + 16 * s), b = *(const bf16x8*)(bp + 16 * s); acc = __builtin_amdgcn_mfma_f32_32x32x16_bf16(a, b, acc, 0, 0, 0); }
#pragma unroll
                    for (int k = 0; k < 4; ++k) { tv[k] = -INFINITY; te[k] = 1 << 20; }
#pragma unroll
                    for (int i = 0; i < 16; ++i) { const int e = (i & 3) + 8 * (i >> 2) + 4 * hi; float v = acc[i] + rb[e]; int ve = e;
#pragma unroll
                        for (int k = 0; k < 4; ++k) { const bool gt = (v > tv[k]) || (v == tv[k] && ve < te[k]); const float nv = gt ? tv[k] : v; const int ne = gt ? te[k] : ve; tv[k] = gt ? v : tv[k]; te[k] = gt ? ve : te[k]; v = nv; ve = ne; } }
                    float pv[4]; int pe[4];
#pragma unroll
                    for (int k = 0; k < 4; ++k) { pv[k] = __shfl_xor(tv[k], 32); pe[k] = __shfl_xor(te[k], 32); }
#pragma unroll
                    for (int j = 0; j < 4; ++j) { float v = pv[j]; int ve = pe[j];
#pragma unroll
                        for (int k = 0; k < 4; ++k) { const bool gt = (v > tv[k]) || (v == tv[k] && ve < te[k]); const float nv = gt ? tv[k] : v; const int ne = gt ? te[k] : ve; tv[k] = gt ? v : tv[k]; te[k] = gt ? ve : te[k]; v = nv; ve = ne; } }
                    float se = 0.f;
#pragma unroll
                    for (int k = 0; k < 4; ++k) { gate[k] = __expf(tv[k] - tv[0]); se += gate[k]; }
                    const float ise = 1.0f / se;
#pragma unroll
                    for (int k = 0; k < 4; ++k) gate[k] *= ise;
                    if (hi == 0) {
#pragma unroll
                        for (int k = 0; k < 4; ++k) lrank[k] = __hip_atomic_fetch_add(lcnt + te[k], 1, __ATOMIC_RELAXED, __HIP_MEMORY_SCOPE_WORKGROUP);
                    }
                }
                __syncthreads();
                if (tid < 32) lbase[tid] = (int)__hip_atomic_fetch_add(gcnt + tid, (unsigned)lcnt[tid], RLX_AGENT);
                __syncthreads();
                if (wave < 4 && hi == 0) {
#pragma unroll
                    for (int k = 0; k < 4; ++k) { const int r = lbase[te[k]] + lrank[k]; const size_t o = (size_t)te[k] * 32768 + r;
                        ROWTOK[o] = row * 4 + k; ROWGATE[o] = gate[k]; TOPE[(size_t)row * 4 + k] = te[k]; TOPG[(size_t)row * 4 + k] = gate[k]; }
                }
                __syncthreads();
            }
        }
        SEAM(pb + 6);
        if (IN(pb + 7) || IN(pb + 8)) {
            LAS int* tstart = (LAS int*)(ldsp + L_TSTART); LAS int* cntL = (LAS int*)(ldsp + L_CNT); LAS int* units = (LAS int*)(ldsp + L_UNITS); LAS int* unitsn = (LAS int*)(ldsp + L_UNITSN);
            if (tid == 0) { int acc = 0; for (int e = 0; e < 32; ++e) { const int c = (int)__hip_atomic_load(gcnt + e, RLX_AGENT); cntL[e] = c; tstart[e] = acc; acc += (c + 255) >> 8; } tstart[32] = acc; }
            __syncthreads();
            if (IN(pb + 7)) {
                pg8::moe_build_units(units, unitsn, tstart, 8, G, bid, tid);
                __syncthreads();
                pg8::Gemm g{(const pg8::bf16_t*)XB8, (const pg8::bf16_t*)WGUl, 0, 2048, DM / 2};
                pg8::MoeOrder S{units, __builtin_amdgcn_readfirstlane(unitsn[0]), cntL, ROWTOK, 1, (unsigned)DM, (size_t)2048 * DM, ROWGATE, in_bgu + (size_t)layer * NEXP * 2048};
                pg8::EpiSwiglu E{H8, in_bgu + (size_t)layer * NEXP * 2048, ROWGATE, cntL, 1.0f / (SC_X * SC_WGU), SC_H};
                pg8::gemm_phase<pg8::EpiSwiglu, pg8::MoeOrder, true, true, true>(ldsp + RING_OFF, g, S, E);
                __syncthreads();
            }
            SEAM(pb + 7);
            if (IN(pb + 8)) {
                pg8::moe_build_units(units, unitsn, tstart, 4, G, bid, tid);
                __syncthreads();
                pg8::Gemm g{(const pg8::bf16_t*)H8, (const pg8::bf16_t*)WDNl, 0, DM, FF / 2};
                pg8::MoeOrder S{units, __builtin_amdgcn_readfirstlane(unitsn[0]), cntL, ROWTOK, 0, (unsigned)FF, (size_t)DM * FF, nullptr, nullptr};
                pg8::EpiScatter E{YB, ROWTOK, cntL, 1.0f / (SC_H * SC_WDN)};
                pg8::gemm_phase<pg8::EpiScatter, pg8::MoeOrder, true, false, true>(ldsp + RING_OFF, g, S, E);
                __syncthreads();
            }
        }
        SEAM(pb + 8);
        if (IN(pb + 9)) {
            const float* gam = in_ln2g + (size_t)layer * DM; const float* bet = in_ln2b + (size_t)layer * DM; const float* bdn = in_bdn + (size_t)layer * NEXP * DM;
            for (int m = gw; m < MROWS; m += NGW) { f32x4 v[4];
#pragma unroll
                for (int j = 0; j < 4; ++j) { const v2u a = *(const v2u*)(XB + (size_t)m * DM + 4 * lane + 256 * j); v[j] = (f32x4){bflo(a.x), bfhi(a.x), bflo(a.y), bfhi(a.y)} * ALPHA; }
#pragma unroll
                for (int k = 0; k < 4; ++k) { const int e = TOPE[(size_t)m * 4 + k]; const float gk = TOPG[(size_t)m * 4 + k]; const bf16* yr = YB + ((size_t)m * 4 + k) * DM; const float* br = bdn + (size_t)e * DM;
#pragma unroll
                    for (int j = 0; j < 4; ++j) { const v2u w = *(const v2u*)(yr + 4 * lane + 256 * j); const f32x4 b = *(const f32x4*)(br + 4 * lane + 256 * j);
                        v[j][0] += bflo(w.x) + gk * b[0]; v[j][1] += bfhi(w.x) + gk * b[1]; v[j][2] += bflo(w.y) + gk * b[2]; v[j][3] += bfhi(w.y) + gk * b[3]; } }
                ln_row<false, (layer == NLAYER - 1)>(v, gam, bet, args.out + (size_t)m * DM, XB + (size_t)m * DM, nullptr, 1.f, lane);
                if (layer + 1 < NLAYER) row_dt(v, WDT + (size_t)(layer + 1) * 8 * 1024, DT + (size_t)m * 8, lane); }
        }
        SEAM(pb + 9);
    #undef IN
#undef SEAM
}

__global__ void __launch_bounds__(NWAVES * 64, 2) mk_fwd(Args args) {
    extern __shared__ __attribute__((aligned(16))) unsigned char lds[];
    LAS unsigned char* ldsp = (LAS unsigned char*)lds;
    const int tid = threadIdx.x, lane = tid & 63, wave = __builtin_amdgcn_readfirstlane(tid >> 6);
    const int G = gridDim.x, bid = blockIdx.x;
    const int gw = bid * NWAVES + wave, NGW = G * NWAVES;
    gu32* ctl = (gu32*)(args.ws + WS_CTL);

    for (int u = tid; u < (LDS_BYTES - LDSCTL_OFF) / 4; u += NWAVES * 64) ((LAS unsigned*)(ldsp + LDSCTL_OFF))[u] = 0u;
    __syncthreads();
    XcdBarrier bar = xcd_barrier_post((unsigned*)(ctl + CW_BAR), (volatile LAS unsigned*)(ldsp + L_MISC) + 8);

    const int lo = args.ph_lo, hi = args.ph_hi;
#define IN(k) (lo <= (k) && (k) < hi)
#define SEAM(k) do { if (IN(k) && IN((k) + 1)) xcd_barrier(bar); } while (0)

    if (IN(0)) {
        for (int it = bid * (NWAVES * 64) + tid; it < (int)(4096 * 32); it += G * (NWAVES * 64)) { const int t = (int)(it >> 5), i = (int)(it & 31);
            const float inv = powf(10000.0f, -(float)i / 32.0f); const float ang = (float)t * inv; float sn, cs; sincosf(ang, &sn, &cs);
            ROPE[2 * it] = cs; ROPE[2 * it + 1] = sn; }
        LAS float* scr = (LAS float*)(ldsp + RING_OFF + wave * 16384);
        constexpr int I_IN = 16 * 145, I_OUT = 24 * 32, I_R = 16;
        constexpr int NIT = NLAYER * (I_IN + I_OUT + I_R);
        for (int it = gw; it < NIT; it += NGW) {
            int r = it;
            if (r < NLAYER * I_IN) { const int l = r / I_IN; r %= I_IN; p0_transpose_item<1>(in_win + (size_t)l * DM * INW, DM, INW, WIN + (size_t)l * NPROJ * DM, WDT + (size_t)l * 8 * 1024, scr, r / 145, r % 145, lane); continue; } r -= NLAYER * I_IN;
            if (r < NLAYER * I_OUT) { const int l = r / I_OUT; r %= I_OUT; p0_transpose_item<0>(in_wout + (size_t)l * MIXW * DM, MIXW, DM, WOUT + (size_t)l * DM * MIXW, nullptr, scr, r / 32, r % 32, lane); continue; } r -= NLAYER * I_OUT;
            { const int l = r / I_R; r %= I_R; p0_transpose_item<0>(in_rw + (size_t)l * DM * NEXP, DM, NEXP, ROUT + (size_t)l * NEXP * DM, nullptr, scr, r, 0, lane); }
        }
        { constexpr int NIT8 = 64 * 256 + 64 * 128;
          const int nmine = (gw < NIT8) ? (NIT8 - gw + NGW - 1) / NGW : 0; const int J = 2 * nmine;
          f32x4 lda[16], ldb[16];
          if (J > 0) { const SubT t = fp8_subtile(gw, 0, in_wgu, in_wdn, WGU8, WDN8, lane); fp8_sub_load(t, lda); }
#pragma unroll 1
          for (int j = 0; j < J; j += 2) {
              const int item = gw + (j >> 1) * NGW;
              const SubT t0 = fp8_subtile(item, 0, in_wgu, in_wdn, WGU8, WDN8, lane), t1 = fp8_subtile(item, 1, in_wgu, in_wdn, WGU8, WDN8, lane);
              fp8_sub_load(t1, ldb);
              fp8_sub_process(t0, lda, scr, lane);
              if (j + 2 < J) { const SubT t2 = fp8_subtile(item + NGW, 0, in_wgu, in_wdn, WGU8, WDN8, lane); fp8_sub_load(t2, lda); }
              fp8_sub_process(t1, ldb, scr, lane);
          } }
        __syncthreads();
    }
    if (IN(0)) {
        for (int m = gw; m < MROWS; m += NGW) { const float* xr = in_x + (size_t)m * DM; bf16* ob = XB + (size_t)m * DM;
#pragma unroll
            for (int j = 0; j < 4; ++j) { const f32x4 v = *(const f32x4*)(xr + 4 * lane + 256 * j); v2u w; w.x = pk2(v[0], v[1]); w.y = pk2(v[2], v[3]); *(v2u*)(ob + 4 * lane + 256 * j) = w; } }
    }

    SEAM(0);
    run_layer<0>(args, lo, hi, bar);
    run_layer<1>(args, lo, hi, bar);
#undef IN
#undef SEAM
}

extern "C" void kernel_launch(void* const* d_in, const int* in_sizes, int n_in, void* d_out, int out_size, void* d_ws, size_t ws_size, hipStream_t stream) {
    static int grid = 0;
    if (grid == 0) {
        if (n_in != 20 || out_size != MROWS * DM || ws_size < WS_END) { fprintf(stderr, "kernel_launch: unexpected problem (n_in %d, out %d, ws %zu)\n", n_in, out_size, ws_size); grid = -1; return; }
        if (hipFuncSetAttribute((const void*)mk_fwd, hipFuncAttributeMaxDynamicSharedMemorySize, LDS_BYTES) != hipSuccess) { fprintf(stderr, "kernel_launch: hipFuncSetAttribute failed\n"); grid = -1; return; }
        int dev = 0, cus = 0, per_cu = 0;
        (void)hipGetDevice(&dev); (void)hipDeviceGetAttribute(&cus, hipDeviceAttributeMultiprocessorCount, dev);
        if (hipOccupancyMaxActiveBlocksPerMultiprocessor(&per_cu, (const void*)mk_fwd, NWAVES * 64, LDS_BYTES) != hipSuccess || per_cu < 1) fprintf(stderr, "kernel_launch: occupancy query says %d\n", per_cu);
        (void)hipGetLastError();
        grid = cus > 0 ? cus : 256;
    }
    if (grid < 0) return;
    (void)hipMemsetAsync((char*)d_ws + WS_CTL, 0, CTL_ZERO_BYTES, stream);
    Args a{};
    for (int i = 0; i < 20; ++i) a.in[i] = (const float*)d_in[i];
    a.out = (float*)d_out; a.ws = (unsigned char*)d_ws;
    a.ph_lo = 0; a.ph_hi = N_PHASES; a.sub = 7; a.pad = 0;
    hipLaunchKernelGGL(mk_fwd, dim3(grid), dim3(NWAVES * 64), LDS_BYTES, stream, a);
#ifdef PROBE_PH
#ifndef PROBE_SUB
#define PROBE_SUB 7
#endif
    for (int i = 0; i < PROBE_N; ++i) { a.ph_lo = PROBE_PH; a.ph_hi = PROBE_PH + 1; a.sub = PROBE_SUB; hipLaunchKernelGGL(mk_fwd, dim3(grid), dim3(NWAVES * 64), LDS_BYTES, stream, a); }
#endif
}
```

```cpp
#include <hip/hip_runtime.h>
#include <cstdio>
#include <cstdint>
#include <cmath>

namespace pg8 {
#define PG8_LAS __attribute__((address_space(3)))
typedef unsigned short bf16_t;
typedef short bf16x8 __attribute__((ext_vector_type(8)));
typedef float f32x4 __attribute__((ext_vector_type(4)));
typedef float f32x2 __attribute__((ext_vector_type(2)));
typedef unsigned u32x4 __attribute__((ext_vector_type(4)));
constexpr int BM = 256, BK = 64, HALF = 128, HTB = HALF * BK * 2  , STAGE_BYTES = 8 * HTB, NXCD = 8, WGM = 8;

__host__ __device__ __forceinline__ int lds_byte(int r, int c) { const int st = (r >> 4) * 2 + (c >> 5), rr = r & 15, cc = c & 31, ob = rr * 64 + cc * 2; return st * 1024 + (ob ^ (((ob >> 9) & 1) << 5)); }
__host__ __device__ __forceinline__ void stage_rc(int b, int& R, int& C) { const int st = b / 1024, sb = b % 1024, swz = sb ^ (((sb >> 9) & 1) << 5); R = (st >> 1) * 16 + swz / 64; C = (st & 1) * 32 + (swz % 64) / 2; }
__host__ __device__ __forceinline__ int perm32(int rho) { const int n = rho >> 4, i = rho & 15; return 8 * (i >> 2) + 4 * n + (i & 3); }

struct Unit { int pm, pn, e, r0; };
struct Gemm { const bf16_t* A; const bf16_t* Bt; int M, N, K; };

struct StaticOrder {
    int nM, nN, nwg, G, c;
    __device__ void init(int M, int N, int G_, int c_) { nM = M / BM; nN = N / BM; nwg = nM * nN; G = G_; c = c_; }
    __device__ __forceinline__ bool next(int i, Unit& u) const {
        const long L = (long)i * G + c; if (L >= nwg) return false;
        int wgid = (int)L; { const int q = nwg / NXCD, r = nwg % NXCD, xcd = wgid % NXCD, off = wgid / NXCD; wgid = (xcd < r ? xcd * (q + 1) : r * (q + 1) + (xcd - r) * q) + off; }
        const int nig = WGM * nN, gid = wgid / nig, fm = gid * WGM, gsz = (nM - fm) < WGM ? (nM - fm) : WGM;
        u.pm = fm + ((wgid % nig) % gsz); u.pn = (wgid % nig) / gsz; u.e = 0; u.r0 = 0; return true;
    }
    __device__ __forceinline__ const char* abase(const Unit& u, const Gemm& g, size_t tstep) const { return (const char*)g.A + (size_t)u.pm * tstep; }
    __device__ __forceinline__ const char* bbase(const Unit& u, const Gemm& g, size_t tstep) const { return (const char*)g.Bt + (size_t)u.pn * tstep; }
    static constexpr bool SIDE = false;
    __device__ __forceinline__ unsigned arow(const Unit&, int) const { return 0u; }
    __device__ __forceinline__ unsigned arow_side(const Unit&, int, const PG8_LAS unsigned char*) const { return 0u; }
    __device__ __forceinline__ const void* side_src(const Unit&, const Unit&, int, int) const { return nullptr; }
    __device__ __forceinline__ void a_ready(const Unit&) const {}
    __device__ __forceinline__ void done(const Unit&) const {}
};

struct MoeOrder {
    const PG8_LAS int* units;
    int nunits;
    const PG8_LAS int* cnt;
    const int* rowtok;
    int gather;
    unsigned rowbytes;
    size_t bstride;
    __device__ __forceinline__ bool next(int i, Unit& u) const {
        if (i >= nunits) return false;
        u.pm = __builtin_amdgcn_readfirstlane(units[4 * i + 0]); u.pn = __builtin_amdgcn_readfirstlane(units[4 * i + 1]);
        u.e = __builtin_amdgcn_readfirstlane(units[4 * i + 2]); u.r0 = __builtin_amdgcn_readfirstlane(units[4 * i + 3]); return true;
    }
    __device__ __forceinline__ const char* abase(const Unit& u, const Gemm& g, size_t tstep) const { return gather ? (const char*)g.A : (const char*)g.A + (size_t)u.pm * tstep; }
    __device__ __forceinline__ const char* bbase(const Unit& u, const Gemm& g, size_t tstep) const { return (const char*)g.Bt + (size_t)u.e * bstride + (size_t)u.pn * tstep; }
    static constexpr bool SIDE = true;
    const float* rowgate; const float* bgu;
    __device__ __forceinline__ unsigned arow(const Unit& u, int R) const {
        const int r = u.r0 + R; const int idx = (r < cnt[u.e]) ? rowtok[(size_t)u.e * 32768 + r] : 0; return (unsigned)(idx >> 2) * rowbytes; }
    __device__ __forceinline__ unsigned arow_side(const Unit& u, int R, const PG8_LAS unsigned char* sd) const {
        const int r = u.r0 + R; const int v = ((const PG8_LAS int*)sd)[R]; const int idx = (r < cnt[u.e]) ? v : 0; return (unsigned)(idx >> 2) * rowbytes; }
    __device__ __forceinline__ const void* side_src(const Unit& cur, const Unit& rt, int wid, int lane) const {
        if (rowgate != nullptr && wid == 1) return rowgate + (size_t)cur.e * 32768 + cur.r0 + 4 * lane;
        if (bgu != nullptr && wid == 2) return bgu + (size_t)cur.e * 2048 + (lane < 32 ? 0 : 1024 - 128) + cur.pn * 128 + 4 * lane;
        return rowtok + (size_t)rt.e * 32768 + rt.r0 + 4 * lane; }
    __device__ __forceinline__ void a_ready(const Unit&) const {}
    __device__ __forceinline__ void done(const Unit&) const {}
};
__device__ __forceinline__ void moe_build_units(PG8_LAS int* units, PG8_LAS int* units_n, const PG8_LAS int* tstart, int nN, int G, int c, int tid) {
    if (tid < 64) {
        const int nT = tstart[32], nwg = nT * nN; const long L = (long)tid * G + c;
        int pm = 0, pn = 0, e = 0, r0 = 0;
        if (L < nwg) {
            int wgid = (int)L; { const int q = nwg / NXCD, r = nwg % NXCD, xcd = wgid % NXCD, off = wgid / NXCD; wgid = (xcd < r ? xcd * (q + 1) : r * (q + 1) + (xcd - r) * q) + off; }
            const int nig = WGM * nN, gid = wgid / nig, fm = gid * WGM, gsz = (nT - fm) < WGM ? (nT - fm) : WGM;
            pm = fm + ((wgid % nig) % gsz); pn = (wgid % nig) / gsz;
            for (int j = 1; j < 32; ++j) e += (tstart[j] <= pm) ? 1 : 0;
            r0 = (pm - tstart[e]) * 256;
        }
        units[4 * tid + 0] = pm; units[4 * tid + 1] = pn; units[4 * tid + 2] = e; units[4 * tid + 3] = r0;
        if (tid == 0) { int n = 0; if (c < nwg) n = (nwg - c + G - 1) / G; units_n[0] = n < 64 ? n : 64; }
    }
}

typedef int v8i_t __attribute__((ext_vector_type(8)));
typedef int v4i_t __attribute__((ext_vector_type(4)));
__device__ __forceinline__ v8i_t cat8(bf16x8 lo, bf16x8 hi) { const v4i_t a = __builtin_bit_cast(v4i_t, lo), b = __builtin_bit_cast(v4i_t, hi); return __builtin_shufflevector(a, b, 0, 1, 2, 3, 4, 5, 6, 7); }
__device__ __forceinline__ void mfma8(f32x4& acc, v8i_t a, v8i_t b, int scl) { asm volatile("v_mfma_scale_f32_16x16x128_f8f6f4 %0, %1, %2, %0, %3, %3 op_sel_hi:[0,0,0]" : "+v"(acc) : "v"(a), "v"(b), "v"(scl)); }
__device__ __forceinline__ unsigned pk4_fp8(float a, float b, float c, float d) { unsigned w = 0u; w = __builtin_amdgcn_cvt_pk_fp8_f32(a, b, w, false); w = __builtin_amdgcn_cvt_pk_fp8_f32(c, d, w, true); return w; }
__device__ __forceinline__ unsigned cvt_pk_bf16(float lo, float hi) { unsigned r; asm volatile("v_cvt_pk_bf16_f32 %0, %1, %2" : "=v"(r) : "v"(lo), "v"(hi)); return r; }

struct EpiProj {
    static constexpr bool PERM = true, AFTER_DRAIN = false;
    bf16_t* O; int ldc; const float* rope; float qscale;
    __device__ __forceinline__ void operator()(const f32x4 (&acc)[2][2][4][2], const Unit& u, int wr, int wc, int fr, int fq, const PG8_LAS unsigned char* sd) const {
        const int row0 = u.pm * BM + wr * 64 + fr; const int col0 = u.pn * BM + wc * 32 + 8 * fq;
        const bool rot = u.pn < 4; const float sc = u.pn < 2 ? qscale : 1.f; const int gq = 4 * (wc & 1) + fq;
#pragma unroll
        for (int ai = 0; ai < 2; ++ai)
#pragma unroll
            for (int m = 0; m < 4; ++m) { const int row = row0 + ai * HALF + m * 16; bf16_t* rowp = O + (size_t)row * ldc + col0;
                f32x4 cs0 = (f32x4){1.f, 0.f, 1.f, 0.f}, cs1 = cs0;
                if (rot) { const float* rp = rope + ((size_t)(row & 4095) * 32 + 4 * gq) * 2; cs0 = *(const f32x4*)rp; cs1 = *(const f32x4*)(rp + 4); }
#pragma unroll
                for (int bj = 0; bj < 2; ++bj) { f32x4 v0 = acc[ai][bj][m][0], v1 = acc[ai][bj][m][1];
                    if (rot) { f32x4 lo, hi;
                        lo[0] = v0[0] * cs0[0] - v1[0] * cs0[1]; hi[0] = v1[0] * cs0[0] + v0[0] * cs0[1];
                        lo[1] = v0[1] * cs0[2] - v1[1] * cs0[3]; hi[1] = v1[1] * cs0[2] + v0[1] * cs0[3];
                        lo[2] = v0[2] * cs1[0] - v1[2] * cs1[1]; hi[2] = v1[2] * cs1[0] + v0[2] * cs1[1];
                        lo[3] = v0[3] * cs1[2] - v1[3] * cs1[3]; hi[3] = v1[3] * cs1[2] + v0[3] * cs1[3];
                        v0 = lo * sc; v1 = hi * sc; }
                    u32x4 w; w.x = cvt_pk_bf16(v0[0], v0[1]); w.y = cvt_pk_bf16(v0[2], v0[3]); w.z = cvt_pk_bf16(v1[0], v1[1]); w.w = cvt_pk_bf16(v1[2], v1[3]);
                    *(u32x4*)(rowp + bj * HALF) = w; } }
    }
};
struct EpiF32 {
    static constexpr bool PERM = false, AFTER_DRAIN = false;
    float* O; int ldc;
    __device__ __forceinline__ void operator()(const f32x4 (&acc)[2][2][4][2], const Unit& u, int wr, int wc, int fr, int fq, const PG8_LAS unsigned char* sd) const {
        const int row0 = u.pm * BM + wr * 64 + fr; const int col0 = u.pn * BM + wc * 32 + 4 * fq;
#pragma unroll
        for (int ai = 0; ai < 2; ++ai)
#pragma unroll
            for (int m = 0; m < 4; ++m) { float* rowp = O + (size_t)(row0 + ai * HALF + m * 16) * ldc + col0;
#pragma unroll
                for (int bj = 0; bj < 2; ++bj)
#pragma unroll
                    for (int n = 0; n < 2; ++n) *(f32x4*)(rowp + bj * HALF + n * 16) = acc[ai][bj][m][n]; }
    }
};
struct EpiBf16Plain {
    static constexpr bool PERM = true, AFTER_DRAIN = false;
    bf16_t* O; int ldc;
    __device__ __forceinline__ void operator()(const f32x4 (&acc)[2][2][4][2], const Unit& u, int wr, int wc, int fr, int fq, const PG8_LAS unsigned char* sd) const {
        const int row0 = u.pm * BM + wr * 64 + fr; const int col0 = u.pn * BM + wc * 32 + 8 * fq;
#pragma unroll
        for (int ai = 0; ai < 2; ++ai)
#pragma unroll
            for (int m = 0; m < 4; ++m) { bf16_t* rowp = O + (size_t)(row0 + ai * HALF + m * 16) * ldc + col0;
#pragma unroll
                for (int bj = 0; bj < 2; ++bj) { const f32x4 v0 = acc[ai][bj][m][0], v1 = acc[ai][bj][m][1];
                    u32x4 w; w.x = cvt_pk_bf16(v0[0], v0[1]); w.y = cvt_pk_bf16(v0[2], v0[3]); w.z = cvt_pk_bf16(v1[0], v1[1]); w.w = cvt_pk_bf16(v1[2], v1[3]);
                    *(u32x4*)(rowp + bj * HALF) = w; } }
    }
};
struct EpiSwiglu {
    static constexpr bool PERM = true, AFTER_DRAIN = false;
    unsigned char* H; const float* bgu; const float* rowgate; const PG8_LAS int* cnt; float dq, hscale;
    __device__ __forceinline__ void operator()(const f32x4 (&acc)[2][2][4][2], const Unit& u, int wr, int wc, int fr, int fq, const PG8_LAS unsigned char* sd) const {
        const int ff = u.pn * HALF + wc * 32 + 8 * fq; const int n_e = cnt[u.e];
        f32x4 bg[2], bu[2];
#pragma unroll
        for (int n = 0; n < 2; ++n) { bg[n] = *(const PG8_LAS f32x4*)(sd + 2048 + (wc * 32 + 8 * fq + 4 * n) * 4); bu[n] = *(const PG8_LAS f32x4*)(sd + 2048 + 512 + (wc * 32 + 8 * fq + 4 * n) * 4); }
        const int lane = fr + 16 * fq;
#pragma unroll
        for (int ai = 0; ai < 2; ++ai)
#pragma unroll
            for (int mp = 0; mp < 2; ++mp) {
                unsigned pw[2][2];
#pragma unroll
                for (int mm = 0; mm < 2; ++mm) { const int m = 2 * mp + mm; const int r = ai * HALF + wr * 64 + m * 16 + fr; const int er = u.r0 + r;
                    const float rgl = ((const PG8_LAS float*)(sd + 1024))[r]; const float rg = ((er < n_e) ? rgl : 0.f) * hscale;
                    float hv[8];
#pragma unroll
                    for (int n = 0; n < 2; ++n)
#pragma unroll
                        for (int q = 0; q < 4; ++q) { float g = acc[ai][0][m][n][q] * dq + bg[n][q], up = acc[ai][1][m][n][q] * dq + bu[n][q];
                            g = fminf(g, 7.0f); up = fminf(fmaxf(up, -7.0f), 7.0f);
                            const float sg = __builtin_amdgcn_rcpf(1.0f + __builtin_amdgcn_exp2f(-1.702f * 1.4426950408889634f * g));
                            hv[n * 4 + q] = (up + 1.0f) * g * sg * rg; }
                    pw[mm][0] = pk4_fp8(hv[0], hv[1], hv[2], hv[3]); pw[mm][1] = pk4_fp8(hv[4], hv[5], hv[6], hv[7]); }
                const auto s0 = __builtin_amdgcn_permlane16_swap(pw[0][0], pw[1][0], false, false); const auto s1 = __builtin_amdgcn_permlane16_swap(pw[0][1], pw[1][1], false, false);
                const int rr = ai * HALF + wr * 64 + (2 * mp + (fq & 1)) * 16 + fr;
                *(u32x4*)(H + (size_t)(u.pm * BM + rr) * 1024 + u.pn * HALF + wc * 32 + 16 * (fq >> 1)) = (u32x4){s0[0], s1[0], s0[1], s1[1]};
                asm volatile("" ::: "memory"); }
    }
};
struct EpiScatter {
    static constexpr bool PERM = true, AFTER_DRAIN = false;
    unsigned char* Y; const int* rowtok; const PG8_LAS int* cnt; float dq;
    __device__ __forceinline__ void operator()(const f32x4 (&acc)[2][2][4][2], const Unit& u, int wr, int wc, int fr, int fq, const PG8_LAS unsigned char* sd) const {
        const int col0 = u.pn * BM + wc * 32 + 8 * fq; const int n_e = cnt[u.e];
#pragma unroll
        for (int ai = 0; ai < 2; ++ai)
#pragma unroll
            for (int m = 0; m < 4; ++m) { const int er = u.r0 + ai * HALF + wr * 64 + m * 16 + fr;
                const int idx = ((const PG8_LAS int*)sd)[ai * HALF + wr * 64 + m * 16 + fr];
                if (er < n_e) { unsigned char* rowp = Y + (size_t)idx * 1024 + col0;
                    typedef unsigned u32x2 __attribute__((ext_vector_type(2)));
#pragma unroll
                    for (int bj = 0; bj < 2; ++bj) { const f32x4 v0 = acc[ai][bj][m][0] * dq, v1 = acc[ai][bj][m][1] * dq;
                        *(u32x2*)(rowp + bj * HALF) = (u32x2){pk4_fp8(v0[0], v0[1], v0[2], v0[3]), pk4_fp8(v1[0], v1[1], v1[2], v1[3])}; } }
                asm volatile("" ::: "memory"); }
    }
};

template <class Epi, class Sched, bool ALIGN_EPI, bool GATHER, bool FP8 = false>
__device__ __forceinline__ void gemm_phase(PG8_LAS unsigned char* lds, const Gemm g, const Sched& S, const Epi& E) {
    const int tid = threadIdx.x, wid = __builtin_amdgcn_readfirstlane(tid >> 6), lane = tid & 63, wr = wid >> 2, wc = wid & 3, fr = lane & 15, fq = lane >> 4;
    const int K = g.K, nt = K / BK;
    unsigned voffB[2];
#pragma unroll
    for (int i = 0; i < 2; ++i) { int R, C; stage_rc(tid * 16 + i * 8192, R, C); const int Rb = Epi::PERM ? ((R & ~31) + perm32(R & 31)) : R;
        voffB[i] = (unsigned)(Rb * K + C) * 2u; }
    constexpr int SIDE_BYTES = 8192;
    PG8_LAS unsigned char* const side = lds + STAGE_BYTES;
    const size_t kstep = (size_t)(BK * 2);
    const size_t hstep = (size_t)HALF * K * 2;
    const size_t tstep = 2 * hstep;
    const unsigned ldsw = (unsigned)wid * 1024u;
    const int aoff = lds_byte(wr * 64 + fr, fq * 8), boff = lds_byte(wc * 32 + fr, fq * 8);
#define PG8_SA(b, h) (((b) * 2 + (h)) * HTB)
#define PG8_SB(b, h) ((4 + (b) * 2 + (h)) * HTB)
#define PG8_STAGE(bufoff, gbase, voff) do { _Pragma("unroll") for (int _i = 0; _i < 2; ++_i) \
        __builtin_amdgcn_global_load_lds((const unsigned*)((const char*)(gbase) + (voff)[_i]), (PG8_LAS unsigned*)(lds + (bufoff) + ldsw + _i * 8192), 16, 0, 0); } while (0)
#define PG8_LDA(dst, b, h) do { _Pragma("unroll") for (int m = 0; m < 4; ++m) _Pragma("unroll") for (int k = 0; k < 2; ++k) dst[m][k] = *(const PG8_LAS bf16x8*)(lds + PG8_SA(b, h) + aoff + m * 2048 + k * 1024); } while (0)
#define PG8_LDB(dst, b, h) do { _Pragma("unroll") for (int n = 0; n < 2; ++n) _Pragma("unroll") for (int k = 0; k < 2; ++k) dst[n][k] = *(const PG8_LAS bf16x8*)(lds + PG8_SB(b, h) + boff + n * 2048 + k * 1024); } while (0)
#define PG8_MMA(ai, bj, At, Bt) do { __builtin_amdgcn_s_setprio(1); _Pragma("unroll") for (int m = 0; m < 4; ++m) _Pragma("unroll") for (int n = 0; n < 2; ++n) { \
        if constexpr (FP8) mfma8(acc[ai][bj][m][n], cat8(Bt[n][0], Bt[n][1]), cat8(At[m][0], At[m][1]), scl8); \
        else { _Pragma("unroll") for (int k = 0; k < 2; ++k) acc[ai][bj][m][n] = __builtin_amdgcn_mfma_f32_16x16x32_bf16(Bt[n][k], At[m][k], acc[ai][bj][m][n], 0, 0, 0); } } __builtin_amdgcn_s_setprio(0); } while (0)
#define PG8_WAIT_V(n) asm volatile("s_waitcnt vmcnt(" #n ")" ::: "memory")
#define PG8_WAIT_L(n) asm volatile("s_waitcnt lgkmcnt(" #n ")" ::: "memory")
#define PG8_BAR __builtin_amdgcn_s_barrier()
#define PG8_SCHED __builtin_amdgcn_sched_barrier(0)
#define PG8_SETOFFS(o, u) do { _Pragma("unroll") for (int _h = 0; _h < 2; ++_h) _Pragma("unroll") for (int _i = 0; _i < 2; ++_i) { int _R, _C; stage_rc(tid * 16 + _i * 8192, _R, _C); \
        o[_h][_i] = GATHER ? (S.arow(u, _R + HALF * _h) + (unsigned)(_C * 2)) : ((unsigned)((_R + HALF * _h) * K) * 2u + (unsigned)(_C * 2)); } } while (0)
    int scl8 = 0x7F7F7F7F; asm volatile("" : "+v"(scl8));
    Unit cur, nxt; int ui = 0;
    if (!S.next(0, cur)) return;
    f32x4 acc[2][2][4][2];
#pragma unroll
    for (int a = 0; a < 2; ++a)
#pragma unroll
        for (int b = 0; b < 2; ++b)
#pragma unroll
            for (int m = 0; m < 4; ++m)
#pragma unroll
                for (int n = 0; n < 2; ++n) { acc[a][b][m][n] = (f32x4){0.f, 0.f, 0.f, 0.f}; if constexpr (FP8) asm volatile("" : "+v"(acc[a][b][m][n])); }
    bf16x8 At[4][2], B0[2][2], B1[2][2];
    unsigned cAo[2][2];
    PG8_SETOFFS(cAo, cur);
    const char* cA = S.abase(cur, g, tstep); const char* cB = S.bbase(cur, g, tstep);
    S.a_ready(cur);
    PG8_STAGE(PG8_SB(0, 0), cB, voffB); PG8_STAGE(PG8_SB(0, 1), cB + hstep, voffB); PG8_STAGE(PG8_SA(0, 0), cA, cAo[0]); PG8_STAGE(PG8_SA(0, 1), cA, cAo[1]);
    if (wr == 1) PG8_BAR;
    PG8_WAIT_V(2); PG8_BAR;
    PG8_STAGE(PG8_SB(1, 0), cB + kstep, voffB); PG8_STAGE(PG8_SA(1, 0), cA + kstep, cAo[0]); PG8_STAGE(PG8_SB(1, 1), cB + hstep + kstep, voffB);
    PG8_WAIT_V(6); PG8_BAR;
    for (;;) {
        const bool has_next = S.next(ui + 1, nxt);
        const char* nA = has_next ? S.abase(nxt, g, tstep) : cA; const char* nB = has_next ? S.bbase(nxt, g, tstep) : cB;
        if constexpr (Sched::SIDE) {
            const void* ssrc = S.side_src(cur, (GATHER && has_next) ? nxt : cur, wid, lane);
            __builtin_amdgcn_global_load_lds((const unsigned*)ssrc, (PG8_LAS unsigned*)(side + (ui & 1) * SIDE_BYTES + wid * 1024), 16, 0, 0); }
#pragma unroll 1
        for (int t = 0; t < nt; t += 2) {
            const bool last = (t == nt - 2);
            const char* a1 = cA + (size_t)(t + 1) * kstep;
            const char* a2 = last ? nA : cA + (size_t)(t + 2) * kstep; const char* b2 = last ? nB : cB + (size_t)(t + 2) * kstep;
            const char* a3 = a2 + kstep; const char* b3 = b2 + kstep;
            if (last && has_next) S.a_ready(nxt);
            PG8_LDB(B0, 0, 0); PG8_LDB(B1, 0, 1); PG8_SCHED; PG8_LDA(At, 0, 0); PG8_STAGE(PG8_SA(1, 1), a1, cAo[1]);
            if constexpr (GATHER) { if (last && has_next) {
                const PG8_LAS unsigned char* sdn = side + (ui & 1) * SIDE_BYTES;
#pragma unroll
                for (int _h = 0; _h < 2; ++_h)
#pragma unroll
                    for (int _i = 0; _i < 2; ++_i) { int _R, _C; stage_rc(tid * 16 + _i * 8192, _R, _C); cAo[_h][_i] = S.arow_side(nxt, _R + HALF * _h, sdn) + (unsigned)(_C * 2); } } }
            PG8_WAIT_V(8); PG8_WAIT_L(0); PG8_BAR; PG8_MMA(0, 0, At, B0); PG8_MMA(0, 1, At, B1); PG8_BAR; PG8_SCHED;
            PG8_LDA(At, 0, 1); PG8_STAGE(PG8_SB(0, 0), b2, voffB); PG8_STAGE(PG8_SB(0, 1), b2 + hstep, voffB); PG8_STAGE(PG8_SA(0, 0), a2, cAo[0]);
            PG8_WAIT_V(8); PG8_WAIT_L(0); PG8_BAR; PG8_MMA(1, 0, At, B0); PG8_MMA(1, 1, At, B1); PG8_BAR; PG8_SCHED;
            PG8_LDB(B0, 1, 0); PG8_LDB(B1, 1, 1); PG8_SCHED; PG8_LDA(At, 1, 0); PG8_STAGE(PG8_SA(0, 1), a2, cAo[1]);
            PG8_WAIT_V(8); PG8_WAIT_L(0); PG8_BAR; PG8_MMA(0, 0, At, B0); PG8_MMA(0, 1, At, B1); PG8_BAR; PG8_SCHED;
            PG8_LDA(At, 1, 1); PG8_STAGE(PG8_SB(1, 0), b3, voffB); PG8_STAGE(PG8_SB(1, 1), b3 + hstep, voffB); PG8_STAGE(PG8_SA(1, 0), a3, cAo[0]);
            PG8_WAIT_V(8); PG8_WAIT_L(0); PG8_BAR; PG8_MMA(1, 0, At, B0); PG8_MMA(1, 1, At, B1); PG8_BAR; PG8_SCHED;
        }
        if constexpr (ALIGN_EPI) { if (wr == 0) PG8_BAR; }
        if constexpr (FP8) asm volatile("s_nop 15\n\ts_nop 15" ::: "memory");
        PG8_SCHED; E(acc, cur, wr, wc, fr, fq, side + (ui & 1) * SIDE_BYTES); S.done(cur); PG8_SCHED;
        if (!has_next) break;
#pragma unroll
        for (int a = 0; a < 2; ++a)
#pragma unroll
            for (int b = 0; b < 2; ++b)
#pragma unroll
                for (int m = 0; m < 4; ++m)
#pragma unroll
                    for (int n = 0; n < 2; ++n) { acc[a][b][m][n] = (f32x4){0.f, 0.f, 0.f, 0.f}; if constexpr (FP8) asm volatile("" : "+v"(acc[a][b][m][n])); }
        cur = nxt; cA = nA; cB = nB; ++ui;
        if constexpr (ALIGN_EPI) { if (wr == 1) PG8_BAR; }
    }
    PG8_WAIT_V(0);
    if constexpr (!ALIGN_EPI) { if (wr == 0) PG8_BAR; }
    PG8_BAR;
#undef PG8_SA
#undef PG8_SB
#undef PG8_STAGE
#undef PG8_LDA
#undef PG8_LDB
#undef PG8_MMA
#undef PG8_WAIT_V
#undef PG8_WAIT_L
#undef PG8_BAR
#undef PG8_SCHED
#undef PG8_SETOFFS
}
}

constexpr int NB = 8, SEQ = 4096, DM = 1024, MROWS = NB * SEQ, NLAYER = 2;
constexpr int NPROJ = 4608, INW = 4616;
constexpr int C_Q = 0, C_K = 512, C_V = 1024, C_Z = 1536, C_XS = 2048, C_SB = 3072, C_SC = 3584, C_SH = 4096;
constexpr int MIXW = 1536, NEXP = 32, TOPK = 4, FF = 1024;
constexpr float ALPHA = 1.4142135623730951f;
constexpr float LN_EPS = 1e-5f, RMS_EPS = 1e-5f;
constexpr float QSCALE = 0.125f * 1.4426950408889634f;

constexpr size_t MiB = 1u << 20;
constexpr size_t WS_CTL = 0, CTL_ZERO_BYTES = 1 * MiB;
constexpr size_t WS_ROPE = 1 * MiB;
constexpr size_t WS_WDT = 2 * MiB;
constexpr size_t WS_ROUT = 2 * MiB + 65536;
constexpr size_t WS_WIN = 4 * MiB;
constexpr size_t WS_WOUT = 24 * MiB;
constexpr size_t WS_WGU = 32 * MiB;
constexpr size_t WS_WDN = 288 * MiB;
constexpr size_t WS_XB = 416 * MiB;
constexpr size_t WS_XF = 480 * MiB;
constexpr size_t WS_XF2 = 608 * MiB;
constexpr size_t WS_PROJ = 736 * MiB;
constexpr size_t WS_DT = 1024 * MiB;
constexpr size_t WS_DTS = 1025 * MiB;
constexpr size_t WS_ACUM = 1026 * MiB;
constexpr size_t WS_LSE = 1027 * MiB;
constexpr size_t WS_OP = 1030 * MiB;
constexpr size_t WS_U = 1126 * MiB;
constexpr size_t WS_G = 1190 * MiB;
constexpr size_t WS_ST = 1222 * MiB;
constexpr size_t WS_YD = 1286 * MiB;
constexpr size_t WS_MIXED = 1350 * MiB;
constexpr size_t WS_MIXF = 1446 * MiB;
constexpr size_t WS_TOPE = 1574 * MiB;
constexpr size_t WS_TOPG = 1575 * MiB;
constexpr size_t WS_ROWTOK = 1576 * MiB;
constexpr size_t WS_ROWGATE = 1580 * MiB;
constexpr size_t WS_H = 736 * MiB;
constexpr size_t WS_YB = 1030 * MiB;
constexpr size_t WS_END = 1584 * MiB;
constexpr int CW_TMO = 0;
constexpr int CW_CNT = 64;
constexpr int CW_BAR = 4096;

constexpr int RING_OFF = 0, RING_BYTES = 131072;
constexpr int LDSCTL_OFF = 155648;
constexpr int L_MISC = LDSCTL_OFF;
constexpr int L_TSTART = LDSCTL_OFF + 256;
constexpr int L_CNT = LDSCTL_OFF + 512;
constexpr int L_LCNT = LDSCTL_OFF + 640;
constexpr int L_LBASE = LDSCTL_OFF + 768;
constexpr int L_UNITS = LDSCTL_OFF + 1024;
constexpr int L_UNITSN = LDSCTL_OFF + 2048;
constexpr int LDS_BYTES = 163840;

#define GAS __attribute__((address_space(1)))
#define LAS __attribute__((address_space(3)))
typedef unsigned short bf16;
typedef unsigned v4u __attribute__((ext_vector_type(4)));
typedef unsigned v2u __attribute__((ext_vector_type(2)));
typedef float f32x4 __attribute__((ext_vector_type(4)));
typedef float f32x16 __attribute__((ext_vector_type(16)));
typedef short bf16x8 __attribute__((ext_vector_type(8)));
typedef GAS unsigned gu32;
#define RLX_AGENT __ATOMIC_RELAXED, __HIP_MEMORY_SCOPE_AGENT
#define LDS_WAIT() asm volatile("s_waitcnt lgkmcnt(0)" ::: "memory")
#define VM_WAIT() asm volatile("s_waitcnt vmcnt(0)" ::: "memory")
__device__ __forceinline__ unsigned f2bf(float f) { unsigned u = __builtin_bit_cast(unsigned, f); return (u + 0x7fffu + ((u >> 16) & 1u)) >> 16; }
__device__ __forceinline__ unsigned pk2(float lo, float hi) { unsigned r; asm volatile("v_cvt_pk_bf16_f32 %0, %1, %2" : "=v"(r) : "v"(lo), "v"(hi)); return r; }
__device__ __forceinline__ float bf2f(unsigned short b) { return __builtin_bit_cast(float, (unsigned)b << 16); }
__device__ __forceinline__ float bflo(unsigned w) { return __builtin_bit_cast(float, w << 16); }
__device__ __forceinline__ float bfhi(unsigned w) { return __builtin_bit_cast(float, w & 0xffff0000u); }
__device__ __forceinline__ float siluf(float x) { return x * __builtin_amdgcn_rcpf(1.0f + __builtin_amdgcn_exp2f(-1.4426950408889634f * x)); }
#define XB_TMO      128
#define XB_XCNT(j)  (256  + 64 * (j))
#define XB_XSUB(j)  (1280 + 64 * (j))
#define XB_XGEN(j)  (2304 + 64 * (j))
#define XB_TOP      3328
#define XB_TOPGEN   3392
#define XCD_BAR_WORDS 3456
#define XB_SPIN_CAP (1u << 18)

__device__ __forceinline__ unsigned xb_ld(unsigned* p)              { return __hip_atomic_load(p, __ATOMIC_RELAXED, __HIP_MEMORY_SCOPE_AGENT); }
__device__ __forceinline__ unsigned xb_add(unsigned* p, unsigned v) { return __hip_atomic_fetch_add(p, v, __ATOMIC_RELAXED, __HIP_MEMORY_SCOPE_AGENT); }
__device__ __forceinline__ unsigned xb_xcc_id() { return (unsigned)__builtin_amdgcn_s_getreg((3 << 11) | 20) & 0xFu; }
#define XB_SPIN(cond, bar) do { unsigned _sp = 0; while (cond) { __builtin_amdgcn_s_sleep(1); \
    if ((++_sp & 255u) == 0u) { if (xb_ld(&(bar)[XB_TMO])) break; if (_sp > XB_SPIN_CAP) { atomicAdd(&(bar)[XB_TMO], 1u); break; } } } } while (0)

struct XcdBarrier {
    unsigned* bar; unsigned x;
    volatile LAS unsigned* st;
};

__device__ __forceinline__ XcdBarrier xcd_barrier_post(unsigned* bar, volatile LAS unsigned* st) {
    XcdBarrier b; b.bar = bar; b.x = xb_xcc_id(); b.st = st;
    if (threadIdx.x == 0) (void)xb_add(&bar[XB_XCNT(b.x)], 1u);
    return b;
}
__device__ __forceinline__ void xcd_barrier_complete(unsigned* bar, unsigned x, unsigned& nloc, unsigned& nx) {
    const unsigned G = gridDim.x * gridDim.y * gridDim.z;
    unsigned sum, cnt, mine, sp = 0u;
    for (;;) {
        sum = 0u; cnt = 0u; mine = 0u;
#pragma unroll
        for (unsigned j = 0; j < 16; ++j) { const unsigned c = xb_ld(&bar[XB_XCNT(j)]); sum += c; cnt += (c > 0u) ? 1u : 0u; mine = (j == x) ? c : mine; }
        if (sum == G) break;
        __builtin_amdgcn_s_sleep(1);
        if ((++sp & 255u) == 0u) { if (xb_ld(&bar[XB_TMO])) break; if (sp > XB_SPIN_CAP) { atomicAdd(&bar[XB_TMO], 1u); break; } }
    }
    nloc = mine > 0u ? mine : 1u; nx = cnt > 0u ? cnt : 1u;
}

__device__ __forceinline__ void xcd_barrier(const XcdBarrier& b) {
    asm volatile("s_waitcnt vmcnt(0)" ::: "memory");
    __syncthreads();
    if (threadIdx.x == 0) {
        unsigned* bar = b.bar;
        __builtin_amdgcn_s_waitcnt(0);
        unsigned nloc = b.st[0], nx = b.st[1];
        if (nloc == 0u) { xcd_barrier_complete(bar, b.x, nloc, nx); b.st[0] = nloc; b.st[1] = nx; }
        const unsigned old = xb_add(&bar[XB_XSUB(b.x)], 1u);
        const unsigned gen = old / nloc;
        if (old + 1u == (gen + 1u) * nloc) {
            __builtin_amdgcn_fence(__ATOMIC_RELEASE, "agent");
            asm volatile("s_waitcnt vmcnt(0)" ::: "memory");
            const unsigned og = xb_add(&bar[XB_TOP], 1u);
            const unsigned tg = og / nx;
            if (og + 1u == (tg + 1u) * nx) xb_add(&bar[XB_TOPGEN], 1u);
            else XB_SPIN(xb_ld(&bar[XB_TOPGEN]) == tg, bar);
            __builtin_amdgcn_fence(__ATOMIC_ACQUIRE, "agent");
            xb_add(&bar[XB_XGEN(b.x)], 1u);
            asm volatile("s_waitcnt vmcnt(0)" ::: "memory");
        } else {
            XB_SPIN(xb_ld(&bar[XB_XGEN(b.x)]) == gen, bar);
            __builtin_amdgcn_fence(__ATOMIC_ACQUIRE, "agent");
            asm volatile("s_waitcnt vmcnt(0)" ::: "memory");
        }
    }
    __syncthreads();
}

constexpr float SC_X = 4.f, SC_WGU = 32.f, SC_H = 4.f, SC_WDN = 64.f, SC_Y = 16.f;
__device__ __forceinline__ float wave_sum(float v) {
#pragma unroll
    for (int o = 1; o < 64; o <<= 1) v += __shfl_xor(v, o);
    return v;
}
__device__ __forceinline__ int win_dest_row(int n) {
    if (n < 1024) { const int hh = n >> 6, d = n & 63; const int p = (d < 32) ? (8 * (d >> 2) + (d & 3)) : (8 * ((d - 32) >> 2) + 4 + (d & 3)); return hh * 64 + p; }
    if (n < 3072) return n;
    if (n < 3080) return -1;
    return n - 8;
}
__device__ __forceinline__ int wgu_dest_row(int n) { return n < 1024 ? ((n >> 7) * 256 + (n & 127)) : (((n - 1024) >> 7) * 256 + 128 + ((n - 1024) & 127)); }
template <int MAP>
__device__ __forceinline__ void p0_transpose_item(const float* W, int K, int N, bf16* WT, float* wdt, LAS float* scr, int kb, int nb, int lane) {
    const int k0 = 64 * kb, n0 = 32 * nb;
    const int nn = n0 + (lane & 31); const bool nok = nn < N;
#pragma unroll 8
    for (int i = 0; i < 32; ++i) { const int kk = 2 * i + (lane >> 5); scr[kk * 33 + (lane & 31)] = nok ? W[(size_t)(k0 + kk) * N + nn] : 0.f; }
    LDS_WAIT(); asm volatile("" ::: "memory");
    const int c = lane & 7;
#pragma unroll
    for (int j = 0; j < 4; ++j) { const int n = (lane >> 3) + 8 * j; const LAS float* s = scr + (8 * c) * 33 + n;
        const int nsrc = n0 + n; if (nsrc >= N) continue;
        int drow = nsrc; if (MAP == 1) drow = win_dest_row(nsrc); if (MAP == 2) drow = wgu_dest_row(nsrc);
        if (MAP == 1 && drow < 0) { float* d = wdt + (size_t)(nsrc - 3072) * 1024 + k0 + 8 * c;
#pragma unroll
            for (int q = 0; q < 8; ++q) d[q] = s[q * 33]; continue; }
        v4u o; o.x = pk2(s[0 * 33], s[1 * 33]); o.y = pk2(s[2 * 33], s[3 * 33]); o.z = pk2(s[4 * 33], s[5 * 33]); o.w = pk2(s[6 * 33], s[7 * 33]);
        *(GAS v4u*)(WT + (size_t)drow * K + k0 + 8 * c) = o; }
    LDS_WAIT(); asm volatile("" ::: "memory");
}
struct SubT { const float* src; unsigned char* dst; int N; int dmap; float scale; };
__device__ __forceinline__ SubT fp8_subtile(int item, int half, const float* wgu, const float* wdn, unsigned char* WG8, unsigned char* WD8, int lane) {
    SubT t; int kb, nb, n0;
    if (item < 64 * 256) { const int le = item >> 8, r = item & 255; kb = r >> 5; nb = r & 31; n0 = 64 * nb; t.N = 2048; t.dmap = 1; t.scale = SC_WGU;
        t.src = wgu + (size_t)le * 1024 * 2048; t.dst = WG8 + (size_t)le * 2048 * 1024; }
    else { const int it2 = item - 64 * 256; const int le = it2 >> 7, r = it2 & 127; kb = r >> 4; nb = r & 15; n0 = 64 * nb; t.N = 1024; t.dmap = 0; t.scale = SC_WDN;
        t.src = wdn + (size_t)le * 1024 * 1024; t.dst = WD8 + (size_t)le * 1024 * 1024; }
    const int k0 = 128 * kb + 64 * half;
    t.src += (size_t)(k0 + (lane >> 4)) * t.N + n0 + 4 * (lane & 15);
    t.dst += (size_t)k0; t.dmap = t.dmap ? -(n0 + 1) : n0;
    return t;
}
__device__ __forceinline__ void fp8_sub_load(const SubT& t, f32x4 (&ld)[16]) {
#pragma unroll
    for (int i = 0; i < 16; ++i) ld[i] = __builtin_nontemporal_load((const f32x4*)(t.src + (size_t)(4 * i) * t.N));
}
__device__ __forceinline__ void fp8_sub_process(const SubT& t, const f32x4 (&ld)[16], LAS float* scr, int lane) {
#pragma unroll
    for (int i = 0; i < 16; ++i) *(LAS f32x4*)(scr + (4 * i + (lane >> 4)) * 64 + 4 * (lane & 15)) = ld[i];
    LDS_WAIT(); asm volatile("" ::: "memory");
    unsigned w[16];
#pragma unroll
    for (int q = 0; q < 16; ++q) w[q] = pg8::pk4_fp8(scr[(4 * q + 0) * 64 + lane] * t.scale, scr[(4 * q + 1) * 64 + lane] * t.scale, scr[(4 * q + 2) * 64 + lane] * t.scale, scr[(4 * q + 3) * 64 + lane] * t.scale);
    LDS_WAIT(); asm volatile("" ::: "memory");
    LAS unsigned char* t2 = (LAS unsigned char*)scr;
#pragma unroll
    for (int q = 0; q < 4; ++q) *(LAS v4u*)(t2 + lane * 80 + 16 * q) = (v4u){w[4 * q], w[4 * q + 1], w[4 * q + 2], w[4 * q + 3]};
    LDS_WAIT(); asm volatile("" ::: "memory");
#pragma unroll
    for (int q = 0; q < 4; ++q) { const int n = 16 * q + (lane >> 2); const v4u v = *(const LAS v4u*)(t2 + n * 80 + 16 * (lane & 3));
        const int nn = (t.dmap < 0) ? wgu_dest_row(-t.dmap - 1 + n) : (t.dmap + n);
        *(GAS v4u*)(t.dst + (size_t)nn * 1024 + 16 * (lane & 3)) = v; }
    LDS_WAIT(); asm volatile("" ::: "memory");
}
__device__ __forceinline__ void row_dt(const f32x4 (&v)[4], const float* wdt, float* dst, int lane) {
    float r[8];
#pragma unroll
    for (int jj = 0; jj < 8; ++jj) { float s = 0.f;
#pragma unroll
        for (int j = 0; j < 4; ++j) { const f32x4 w = *(const f32x4*)(wdt + jj * 1024 + 4 * lane + 256 * j); s += v[j][0] * w[0] + v[j][1] * w[1] + v[j][2] * w[2] + v[j][3] * w[3]; }
        r[jj] = wave_sum(s); }
    if (lane == 0) { *(f32x4*)dst = (f32x4){r[0], r[1], r[2], r[3]}; *(f32x4*)(dst + 4) = (f32x4){r[4], r[5], r[6], r[7]}; }
}
template <bool W8, bool WF>
__device__ __forceinline__ void ln_row(f32x4 (&v)[4], const float* gam, const float* bet, float* of32, bf16* ob16, unsigned char* o8, float s8, int lane) {
    float s = 0.f;
#pragma unroll
    for (int j = 0; j < 4; ++j) s += (v[j][0] + v[j][1]) + (v[j][2] + v[j][3]);
    const float mean = wave_sum(s) * (1.f / DM); float s2 = 0.f;
#pragma unroll
    for (int j = 0; j < 4; ++j) { v[j] = v[j] - mean; s2 += (v[j][0] * v[j][0] + v[j][1] * v[j][1]) + (v[j][2] * v[j][2] + v[j][3] * v[j][3]); }
    const float rstd = 1.f / sqrtf(wave_sum(s2) * (1.f / DM) + LN_EPS);
#pragma unroll
    for (int j = 0; j < 4; ++j) { const f32x4 g = *(const f32x4*)(gam + 4 * lane + 256 * j), b = *(const f32x4*)(bet + 4 * lane + 256 * j);
        v[j] = v[j] * rstd * g + b;
        if (WF) *(f32x4*)(of32 + 4 * lane + 256 * j) = v[j];
        v2u w; w.x = pk2(v[j][0], v[j][1]); w.y = pk2(v[j][2], v[j][3]); *(v2u*)(ob16 + 4 * lane + 256 * j) = w;
        if (W8) *(unsigned*)(o8 + 4 * lane + 256 * j) = pg8::pk4_fp8(v[j][0] * s8, v[j][1] * s8, v[j][2] * s8, v[j][3] * s8); }
}


typedef short v4i16_t __attribute__((ext_vector_type(4)));
__device__ __forceinline__ bf16x8 tr_pair(const LAS unsigned char* p0, const LAS unsigned char* p1) {
    const v4i16_t a = __builtin_amdgcn_ds_read_tr16_b64_v4i16((LAS v4i16_t*)p0), b = __builtin_amdgcn_ds_read_tr16_b64_v4i16((LAS v4i16_t*)p1);
    return (bf16x8){a[0], a[1], a[2], a[3], b[0], b[1], b[2], b[3]};
}
__device__ __forceinline__ int crow16(int r, int hi) { return (r & 3) + 8 * (r >> 2) + 4 * hi; }
constexpr int AK_PITCH = 144, AV_PITCH = 192, AK_TILE = 32 * AK_PITCH, AV_TILE = 32 * AV_PITCH;
constexpr int AT_K = 0, AT_V = 12 * AK_TILE;
struct AttnItem { int p, b, h, d, r, qt0; };
__device__ __forceinline__ AttnItem attn_item(int I) { AttnItem a; a.p = I >> 10; const int rem = I & 1023; a.b = rem >> 7; a.h = (rem >> 4) & 7; const int grp = rem & 15;
    a.d = (a.p == 0) ? 1 : (a.p == 1) ? 4 : 16; const int tpr = 128 / a.d; const int T = grp * 8; a.r = T / tpr; a.qt0 = T % tpr; return a; }
__device__ __forceinline__ void attn_request(const bf16* PROJ, const AttnItem& a, v4u (&st)[12], int tid) {
    const int rr = tid >> 4, ch = tid & 15; const int col = (ch < 8 ? C_K : C_V - 64) + a.h * 64 + ch * 8;
#pragma unroll
    for (int tl = 0; tl < 12; ++tl) { const int kt = a.qt0 - 4 + tl; st[tl] = (v4u){0u, 0u, 0u, 0u};
        if (kt >= 0) { const size_t row = (size_t)a.b * SEQ + (size_t)(32 * kt + rr) * a.d + a.r; st[tl] = *(const v4u*)(PROJ + row * NPROJ + col); } }
}
__device__ __forceinline__ void attn_deposit(LAS unsigned char* al, const v4u (&st)[12], int tid) {
    const int rr = tid >> 4, ch = tid & 15;
    LAS unsigned char* dst = (ch < 8) ? (al + AT_K + rr * AK_PITCH + ch * 16) : (al + AT_V + rr * AV_PITCH + (ch - 8) * 16); const int tstep = (ch < 8) ? AK_TILE : AV_TILE;
#pragma unroll
    for (int tl = 0; tl < 12; ++tl) *(LAS v4u*)(dst + tl * tstep) = st[tl];
}
__device__ __forceinline__ void attn_wave_compute(const bf16* PROJ, bf16* OPp, float* LSEp, const AttnItem& a, const LAS unsigned char* al, int wave, int lane) {
    const int i = lane & 31, h2 = lane >> 5; const int qt = a.qt0 + wave;
    const size_t rowq = (size_t)a.b * SEQ + (size_t)(32 * qt + i) * a.d + a.r;
    bf16x8 qf[4];
    { const bf16* qp = PROJ + rowq * NPROJ + C_Q + a.h * 64 + 8 * h2;
#pragma unroll
      for (int s = 0; s < 4; ++s) qf[s] = *(const bf16x8*)(qp + 16 * s); }
    f32x16 o0 = {}, o1 = {}; float mrun = -INFINITY, lrun = 0.f;
    const int kt0 = qt > 4 ? qt - 4 : 0;
    const LAS unsigned char* krd = al + AT_K + i * AK_PITCH + 16 * h2;
    const LAS unsigned char* trb = al + AT_V + (4 * h2 + ((lane & 15) >> 2)) * AV_PITCH + (16 * ((lane >> 4) & 1) + 4 * (lane & 3)) * 2;
#pragma unroll 1
    for (int kt = kt0; kt <= qt; ++kt) {
        const int tl = kt - a.qt0 + 4;
        const LAS unsigned char* kp = krd + tl * AK_TILE; const LAS unsigned char* vp = trb + tl * AV_TILE;
        f32x16 sacc = {};
#pragma unroll
        for (int s = 0; s < 4; ++s) sacc = __builtin_amdgcn_mfma_f32_32x32x16_bf16(*(const LAS bf16x8*)(kp + 32 * s), qf[s], sacc, 0, 0, 0);
        if (kt == qt) {
#pragma unroll
            for (int rg = 0; rg < 16; ++rg) if (crow16(rg, h2) > i) sacc[rg] = -INFINITY;
        }
        if (kt + 4 == qt) {
#pragma unroll
            for (int rg = 0; rg < 16; ++rg) if (crow16(rg, h2) < i) sacc[rg] = -INFINITY;
        }
        float mx = sacc[0];
#pragma unroll
        for (int rg = 1; rg < 16; ++rg) mx = fmaxf(mx, sacc[rg]);
        mx = fmaxf(mx, __shfl_xor(mx, 32));
        const float mnew = fmaxf(mrun, mx), alpha = __builtin_amdgcn_exp2f(mrun - mnew); mrun = mnew;
        float ps = 0.f;
#pragma unroll
        for (int rg = 0; rg < 16; ++rg) { sacc[rg] = __builtin_amdgcn_exp2f(sacc[rg] - mnew); ps += sacc[rg]; }
        lrun = lrun * alpha + ps;
#pragma unroll
        for (int rg = 0; rg < 16; ++rg) { o0[rg] *= alpha; o1[rg] *= alpha; }
        bf16x8 pf[2];
#pragma unroll
        for (int ks = 0; ks < 2; ++ks) { v4u w; w.x = pg8::cvt_pk_bf16(sacc[8 * ks + 0], sacc[8 * ks + 1]); w.y = pg8::cvt_pk_bf16(sacc[8 * ks + 2], sacc[8 * ks + 3]); w.z = pg8::cvt_pk_bf16(sacc[8 * ks + 4], sacc[8 * ks + 5]); w.w = pg8::cvt_pk_bf16(sacc[8 * ks + 6], sacc[8 * ks + 7]); pf[ks] = __builtin_bit_cast(bf16x8, w); }
#pragma unroll
        for (int ks = 0; ks < 2; ++ks) {
            const bf16x8 v0 = tr_pair(vp + (16 * ks) * AV_PITCH, vp + (16 * ks + 8) * AV_PITCH);
            const bf16x8 v1 = tr_pair(vp + (16 * ks) * AV_PITCH + 64, vp + (16 * ks + 8) * AV_PITCH + 64);
            o0 = __builtin_amdgcn_mfma_f32_32x32x16_bf16(v0, pf[ks], o0, 0, 0, 0);
            o1 = __builtin_amdgcn_mfma_f32_32x32x16_bf16(v1, pf[ks], o1, 0, 0, 0);
        }
    }
    const float lt = lrun + __shfl_xor(lrun, 32); const float il = 1.0f / lt;
    bf16* op = OPp + rowq * 512 + a.h * 64 + 4 * h2;
#pragma unroll
    for (int g4 = 0; g4 < 4; ++g4) {
        v2u w0, w1; w0.x = pg8::cvt_pk_bf16(o0[4 * g4 + 0] * il, o0[4 * g4 + 1] * il); w0.y = pg8::cvt_pk_bf16(o0[4 * g4 + 2] * il, o0[4 * g4 + 3] * il);
        w1.x = pg8::cvt_pk_bf16(o1[4 * g4 + 0] * il, o1[4 * g4 + 1] * il); w1.y = pg8::cvt_pk_bf16(o1[4 * g4 + 2] * il, o1[4 * g4 + 3] * il);
        *(v2u*)(op + 8 * g4) = w0; *(v2u*)(op + 32 + 8 * g4) = w1; }
    if (h2 == 0) LSEp[rowq * 8 + a.h] = mrun + log2f(lt);
}
__device__ __forceinline__ void attn_phase(LAS unsigned char* al, const bf16* PROJ, bf16* OP, float* LSE, int bid, int G, int tid, int wave, int lane) {
    v4u st[12];
    int I = bid;
    if (I < 3072) { const AttnItem a = attn_item(I); attn_request(PROJ, a, st, tid); }
    for (; I < 3072; I += G) {
        const AttnItem a = attn_item(I);
        __syncthreads();
        attn_deposit(al, st, tid);
        __syncthreads();
        if (I + G < 3072) { const AttnItem n = attn_item(I + G); attn_request(PROJ, n, st, tid); }
        attn_wave_compute(PROJ, OP + (size_t)a.p * MROWS * 512, LSE + (size_t)a.p * MROWS * 8, a, al, wave, lane);
    }
    __syncthreads();
}

constexpr int SS_DTS = 0, SS_ACUM = 2048, SS_TMP = 4096, SS_SSX = 6144, SS_IMG = 8192;
constexpr int S1_PB = 320, S1_PX = 576;
constexpr int S1_B = SS_IMG, S1_X = SS_IMG + 128 * S1_PB;
constexpr int S3_PBC = 272, S3_PX = 576;
constexpr int S3_B = SS_IMG, S3_C = S3_B + 128 * S3_PBC, S3_X = S3_C + 128 * S3_PBC;

__device__ __forceinline__ void ssd_prep(LAS unsigned char* sl, const float* DT, const float* dtb, const float* alog, size_t row0, int g, int tid, int lane, int wave) {
    LAS float* dts = (LAS float*)(sl + SS_DTS); LAS float* acum = (LAS float*)(sl + SS_ACUM); LAS float* tmp = (LAS float*)(sl + SS_TMP);
    { const int l = tid >> 2, hq = tid & 3; const float x = DT[(row0 + l) * 8 + 4 * g + hq] + dtb[4 * g + hq];
      const float dt = x > 20.f ? x : log1pf(__expf(x)); dts[hq * 128 + l] = dt; tmp[hq * 128 + l] = dt * (-__expf(alog[4 * g + hq])); }
    __syncthreads();
    if (wave < 4) { const float v0 = tmp[wave * 128 + 2 * lane], v1 = tmp[wave * 128 + 2 * lane + 1]; float s = v0 + v1;
#pragma unroll
        for (int off = 1; off < 64; off <<= 1) { const float t = __shfl_up(s, off); if (lane >= off) s += t; }
        acum[wave * 128 + 2 * lane] = s - v1; acum[wave * 128 + 2 * lane + 1] = s; }
    __syncthreads();
}
template <int NCOLS, int FACMODE>
__device__ __forceinline__ void conv_tile(const bf16* PROJ, size_t row0, int t0, int pcol0, const float* cw, const float* cb, int cch0, LAS unsigned char* dst, int pitch, const LAS unsigned char* sl, int hq0, int tid) {
    constexpr int NCH8 = NCOLS / 8, NSEG = 512 / NCH8, RPS = 128 / NSEG;
    const int c8 = tid % NCH8, seg = tid / NCH8, l0 = seg * RPS;
    float w[4][8], bias[8], hst[3][8];
#pragma unroll
    for (int k = 0; k < 4; ++k) { const f32x4 a = *(const f32x4*)(cw + k * 1024 + cch0 + c8 * 8), b = *(const f32x4*)(cw + k * 1024 + cch0 + c8 * 8 + 4);
        w[k][0] = a[0]; w[k][1] = a[1]; w[k][2] = a[2]; w[k][3] = a[3]; w[k][4] = b[0]; w[k][5] = b[1]; w[k][6] = b[2]; w[k][7] = b[3]; }
    { const f32x4 a = *(const f32x4*)(cb + cch0 + c8 * 8), b = *(const f32x4*)(cb + cch0 + c8 * 8 + 4);
      bias[0] = a[0]; bias[1] = a[1]; bias[2] = a[2]; bias[3] = a[3]; bias[4] = b[0]; bias[5] = b[1]; bias[6] = b[2]; bias[7] = b[3]; }
    const bf16* src = PROJ + pcol0 + c8 * 8;
#pragma unroll
    for (int k = 0; k < 3; ++k) { const int l = l0 - 3 + k; v4u v = (v4u){0u, 0u, 0u, 0u}; if (t0 + l >= 0) v = *(const v4u*)(src + (size_t)((long)row0 + l) * NPROJ);
        hst[k][0] = bflo(v.x); hst[k][1] = bfhi(v.x); hst[k][2] = bflo(v.y); hst[k][3] = bfhi(v.y); hst[k][4] = bflo(v.z); hst[k][5] = bfhi(v.z); hst[k][6] = bflo(v.w); hst[k][7] = bfhi(v.w); }
    const LAS float* dts = (const LAS float*)(sl + SS_DTS); const LAS float* acum = (const LAS float*)(sl + SS_ACUM);
    const int hq = hq0 + (c8 * 8) / 64;
    const float alast = (FACMODE == 2) ? acum[hq * 128 + 127] : 0.f;
#pragma unroll
    for (int rr = 0; rr < RPS; ++rr) { const int l = l0 + rr; const v4u v = *(const v4u*)(src + (row0 + l) * NPROJ);
        float cur[8]; cur[0] = bflo(v.x); cur[1] = bfhi(v.x); cur[2] = bflo(v.y); cur[3] = bfhi(v.y); cur[4] = bflo(v.z); cur[5] = bfhi(v.z); cur[6] = bflo(v.w); cur[7] = bfhi(v.w);
        float f = 1.f; if (FACMODE >= 1) f = dts[hq * 128 + l]; if (FACMODE == 2) f *= __expf(alast - acum[hq * 128 + l]);
        float o[8];
#pragma unroll
        for (int e = 0; e < 8; ++e) { const float a = bias[e] + w[0][e] * hst[0][e] + w[1][e] * hst[1][e] + w[2][e] * hst[2][e] + w[3][e] * cur[e]; o[e] = siluf(a) * f;
            hst[0][e] = hst[1][e]; hst[1][e] = hst[2][e]; hst[2][e] = cur[e]; }
        v4u ov; ov.x = pk2(o[0], o[1]); ov.y = pk2(o[2], o[3]); ov.z = pk2(o[4], o[5]); ov.w = pk2(o[6], o[7]);
        *(LAS v4u*)(dst + l * pitch + c8 * 16) = ov; }
}
__device__ __forceinline__ void ssd_s1_unit(LAS unsigned char* sl, const bf16* PROJ, const float* DT, const float* dtb, const float* alog, const float* cw, const float* cb, float* ST, float* CDEC, int un, int tid, int lane, int wave) {
    const int g = un & 1, bc = un >> 1; const size_t row0 = (size_t)bc * 128; const int t0 = (bc & 31) * 128;
    __syncthreads();
    ssd_prep(sl, DT, dtb, alog, row0, g, tid, lane, wave);
    conv_tile<128, 0>(PROJ, row0, t0, C_XS + 512 + g * 128, cw, cb, 512 + g * 128, sl + S1_B, S1_PB, sl, 0, tid);
    conv_tile<256, 2>(PROJ, row0, t0, C_XS + g * 256, cw, cb, g * 256, sl + S1_X, S1_PX, sl, 0, tid);
    if (tid < 4) CDEC[(size_t)bc * 8 + 4 * g + tid] = __expf(((const LAS float*)(sl + SS_ACUM))[tid * 128 + 127]);
    __syncthreads();
    const int hq = wave >> 1, pt = wave & 1, h2 = lane >> 5, q = (lane & 15) >> 2, pp = lane & 3, dsel = (lane >> 4) & 1;
    const LAS unsigned char* xb = sl + S1_X + (8 * h2 + q) * S1_PX + (hq * 64 + pt * 32 + 16 * dsel + 4 * pp) * 2;
    const LAS unsigned char* bb = sl + S1_B + (8 * h2 + q) * S1_PB + (16 * dsel + 4 * pp) * 2;
    f32x16 acc[4];
#pragma unroll
    for (int nt = 0; nt < 4; ++nt) acc[nt] = (f32x16){};
#pragma unroll
    for (int ks = 0; ks < 8; ++ks) { const bf16x8 a = tr_pair(xb + (16 * ks) * S1_PX, xb + (16 * ks + 4) * S1_PX);
#pragma unroll
        for (int nt = 0; nt < 4; ++nt) { const bf16x8 b = tr_pair(bb + (16 * ks) * S1_PB + nt * 64, bb + (16 * ks + 4) * S1_PB + nt * 64); acc[nt] = __builtin_amdgcn_mfma_f32_32x32x16_bf16(a, b, acc[nt], 0, 0, 0); } }
    float* sp = ST + ((size_t)(bc * 8 + 4 * g + hq) * 64 + pt * 32) * 128 + (lane & 31);
#pragma unroll
    for (int nt = 0; nt < 4; ++nt)
#pragma unroll
        for (int rg = 0; rg < 16; ++rg) sp[(size_t)crow16(rg, h2) * 128 + 32 * nt] = acc[nt][rg];
}
__device__ __forceinline__ void ssd_s3_unit(LAS unsigned char* sl, const bf16* PROJ, const float* DT, const float* dtb, const float* alog, const float* cw, const float* cb, const float* dsk, const float* ng,
                                            const bf16* HIN, bf16* MIXED, int un, int tid, int lane, int wave) {
    const int g = un & 1, bc = un >> 1; const size_t row0 = (size_t)bc * 128; const int t0 = (bc & 31) * 128;
    const int lt = wave & 3, ph = wave >> 2, lq = lane & 31, hi = lane >> 5, q = (lane & 15) >> 2, pp = lane & 3, dsel = (lane >> 4) & 1;
    const int lrow = 32 * lt + lq;
    const size_t grow = row0 + lrow;
    __syncthreads();
    ssd_prep(sl, DT, dtb, alog, row0, g, tid, lane, wave);
    conv_tile<128, 0>(PROJ, row0, t0, C_XS + 512 + g * 128, cw, cb, 512 + g * 128, sl + S3_B, S3_PBC, sl, 0, tid);
    conv_tile<128, 0>(PROJ, row0, t0, C_XS + 768 + g * 128, cw, cb, 768 + g * 128, sl + S3_C, S3_PBC, sl, 0, tid);
    conv_tile<256, 1>(PROJ, row0, t0, C_XS + g * 256, cw, cb, g * 256, sl + S3_X, S3_PX, sl, 0, tid);
    __syncthreads();
    const LAS float* dts = (const LAS float*)(sl + SS_DTS); const LAS float* acum = (const LAS float*)(sl + SS_ACUM); LAS float* ssx = (LAS float*)(sl + SS_SSX);
    const LAS unsigned char* crd = sl + S3_C + lrow * S3_PBC + 16 * hi;
    f32x16 y[4];
    { bf16x8 hfa[8], hfb[8];
      const bf16* hp0 = HIN + ((size_t)(bc * 8 + 4 * g) * 64 + ph * 32 + lq) * 128 + 8 * hi;
#pragma unroll
      for (int ks = 0; ks < 8; ++ks) hfa[ks] = *(const bf16x8*)(hp0 + 16 * ks);
#pragma unroll
      for (int hq = 0; hq < 4; ++hq) {
          if (hq < 3) {
#pragma unroll
              for (int ks = 0; ks < 8; ++ks) { const bf16x8 v = *(const bf16x8*)(hp0 + (size_t)(hq + 1) * 8192 + 16 * ks); if (hq & 1) hfa[ks] = v; else hfb[ks] = v; } }
          f32x16 t = (f32x16){};
#pragma unroll
          for (int ks = 0; ks < 8; ++ks) t = __builtin_amdgcn_mfma_f32_32x32x16_bf16((hq & 1) ? hfb[ks] : hfa[ks], *(const LAS bf16x8*)(crd + 32 * ks), t, 0, 0, 0);
          const float ea = __expf(acum[hq * 128 + lrow]);
#pragma unroll
          for (int rg = 0; rg < 16; ++rg) t[rg] *= ea;
          y[hq] = t; } }
    v2u zr[4][4];
#pragma unroll
    for (int hq = 0; hq < 4; ++hq)
#pragma unroll
        for (int g4 = 0; g4 < 4; ++g4) zr[hq][g4] = *(const v2u*)(PROJ + grow * NPROJ + C_Z + g * 256 + hq * 64 + ph * 32 + 8 * g4 + 4 * hi);
#pragma unroll
    for (int st = 0; st < 4; ++st) if (st <= lt) {
        f32x16 ag = (f32x16){};
        { const LAS unsigned char* brd = sl + S3_B + (32 * st + lq) * S3_PBC + 16 * hi;
#pragma unroll
          for (int ks = 0; ks < 8; ++ks) ag = __builtin_amdgcn_mfma_f32_32x32x16_bf16(*(const LAS bf16x8*)(brd + 32 * ks), *(const LAS bf16x8*)(crd + 32 * ks), ag, 0, 0, 0); }
#pragma unroll
        for (int hq = 0; hq < 4; ++hq) {
            const float al = acum[hq * 128 + lrow], dd = dsk[4 * g + hq] / dts[hq * 128 + lrow];
            const LAS unsigned char* xb = sl + S3_X + (4 * hi + q) * S3_PX + (hq * 64 + ph * 32 + 16 * dsel + 4 * pp) * 2;
            float pm[16];
#pragma unroll
            for (int g4 = 0; g4 < 4; ++g4) { const f32x4 as4 = *(const LAS f32x4*)(acum + hq * 128 + 32 * st + 8 * g4 + 4 * hi);
#pragma unroll
                for (int e = 0; e < 4; ++e) { const int rg = 4 * g4 + e; float v = ag[rg] * __expf(al - as4[e]);
                    if (st == lt) { const int sl_ = 8 * g4 + 4 * hi + e; if (sl_ > lq) v = 0.f; if (sl_ == lq) v += dd; }
                    pm[rg] = v; } }
#pragma unroll
            for (int ks = 0; ks < 2; ++ks) { v4u wv; wv.x = pg8::cvt_pk_bf16(pm[8 * ks + 0], pm[8 * ks + 1]); wv.y = pg8::cvt_pk_bf16(pm[8 * ks + 2], pm[8 * ks + 3]); wv.z = pg8::cvt_pk_bf16(pm[8 * ks + 4], pm[8 * ks + 5]); wv.w = pg8::cvt_pk_bf16(pm[8 * ks + 6], pm[8 * ks + 7]);
                const bf16x8 xt = tr_pair(xb + (32 * st + 16 * ks) * S3_PX, xb + (32 * st + 16 * ks + 8) * S3_PX);
                y[hq] = __builtin_amdgcn_mfma_f32_32x32x16_bf16(xt, __builtin_bit_cast(bf16x8, wv), y[hq], 0, 0, 0); }
        }
    }
    unsigned ayp[4][8]; float ss = 0.f;
#pragma unroll
    for (int hq = 0; hq < 4; ++hq)
#pragma unroll
        for (int g4 = 0; g4 < 4; ++g4) { const v2u z = zr[hq][g4];
            const float y0 = y[hq][4 * g4 + 0] * siluf(bflo(z.x)), y1 = y[hq][4 * g4 + 1] * siluf(bfhi(z.x)), y2 = y[hq][4 * g4 + 2] * siluf(bflo(z.y)), y3 = y[hq][4 * g4 + 3] * siluf(bfhi(z.y));
            ss += (y0 * y0 + y1 * y1) + (y2 * y2 + y3 * y3);
            ayp[hq][2 * g4] = pg8::cvt_pk_bf16(y0, y1); ayp[hq][2 * g4 + 1] = pg8::cvt_pk_bf16(y2, y3); }
    ss += __shfl_xor(ss, 32);
    if (hi == 0) ssx[ph * 128 + lrow] = ss;
    __syncthreads();
    const float rs = 1.0f / sqrtf((ssx[lrow] + ssx[128 + lrow]) * (1.f / 256.f) + RMS_EPS);
#pragma unroll
    for (int hq = 0; hq < 4; ++hq)
#pragma unroll
        for (int g4 = 0; g4 < 4; ++g4) { const int ch = hq * 64 + ph * 32 + 8 * g4 + 4 * hi; const f32x4 gn = *(const f32x4*)(ng + g * 256 + ch);
            const unsigned p0 = ayp[hq][2 * g4], p1 = ayp[hq][2 * g4 + 1];
            v2u o; o.x = pg8::cvt_pk_bf16(bflo(p0) * rs * gn[0], bfhi(p0) * rs * gn[1]); o.y = pg8::cvt_pk_bf16(bflo(p1) * rs * gn[2], bfhi(p1) * rs * gn[3]);
            *(v2u*)(MIXED + grow * MIXW + 512 + g * 256 + ch) = o; }
}

struct Args { const float* in[20]; float* out; unsigned char* ws; int ph_lo, ph_hi, sub, pad; };
constexpr int NWAVES = 8;
constexpr int PH_PER_LAYER = 10, N_PHASES = 1 + NLAYER * PH_PER_LAYER;

#define in_x (args.in[0])
#define in_win (args.in[1])
#define in_convw (args.in[2])
#define in_convb (args.in[3])
#define in_dtb (args.in[4])
#define in_alog (args.in[5])
#define in_dsk (args.in[6])
#define in_ng (args.in[7])
#define in_scw (args.in[8])
#define in_wout (args.in[9])
#define in_ln1g (args.in[10])
#define in_ln1b (args.in[11])
#define in_rw (args.in[12])
#define in_rb (args.in[13])
#define in_wgu (args.in[14])
#define in_bgu (args.in[15])
#define in_wdn (args.in[16])
#define in_bdn (args.in[17])
#define in_ln2g (args.in[18])
#define in_ln2b (args.in[19])
#define ROPE ((float*)(args.ws + WS_ROPE))
#define WDT ((float*)(args.ws + WS_WDT))
#define ROUT ((bf16*)(args.ws + WS_ROUT))
#define WIN ((bf16*)(args.ws + WS_WIN))
#define WOUT ((bf16*)(args.ws + WS_WOUT))
#define WGU ((bf16*)(args.ws + WS_WGU))
#define WDN ((bf16*)(args.ws + WS_WDN))
#define XB ((bf16*)(args.ws + WS_XB))
#define XF ((float*)(args.ws + WS_XF))
#define XF2 ((float*)(args.ws + WS_XF2))
#define PROJ ((bf16*)(args.ws + WS_PROJ))
#define DT ((float*)(args.ws + WS_DT))
#define DTS ((float*)(args.ws + WS_DTS))
#define ACUM ((float*)(args.ws + WS_ACUM))
#define LSE ((float*)(args.ws + WS_LSE))
#define OP ((bf16*)(args.ws + WS_OP))
#define U ((bf16*)(args.ws + WS_U))
#define GB ((float*)(args.ws + WS_G))
#define ST ((float*)(args.ws + WS_ST))
#define YD ((float*)(args.ws + WS_YD))
#define MIXED ((bf16*)(args.ws + WS_MIXED))
#define MIXF ((bf16*)(args.ws + WS_MIXF))
#define TOPE ((int*)(args.ws + WS_TOPE))
#define TOPG ((float*)(args.ws + WS_TOPG))
#define ROWTOK ((int*)(args.ws + WS_ROWTOK))
#define ROWGATE ((float*)(args.ws + WS_ROWGATE))
#define HB ((bf16*)(args.ws + WS_H))
#define YB ((bf16*)(args.ws + WS_YB))
#define HIN ((bf16*)(args.ws + WS_G))
#define WGU8 ((unsigned char*)(args.ws + WS_WGU))
#define WDN8 ((unsigned char*)(args.ws + WS_WDN))
#define XB8 ((unsigned char*)(args.ws + WS_U))
#define H8 ((unsigned char*)(args.ws + WS_H))
#define YB8 ((unsigned char*)(args.ws + WS_YB))
#define CDEC ((float*)(args.ws + WS_ACUM))
template <int layer>
__device__ __forceinline__ void run_layer(const Args& args, int lo, int hi, const XcdBarrier& bar) {
    extern __shared__ __attribute__((aligned(16))) unsigned char lds[];
    LAS unsigned char* ldsp = (LAS unsigned char*)lds;
    const int tid = threadIdx.x, lane = tid & 63, wave = __builtin_amdgcn_readfirstlane(tid >> 6);
    const int G = gridDim.x, bid = blockIdx.x;
    const int gw = bid * NWAVES + wave, NGW = G * NWAVES;
    gu32* ctl = (gu32*)(args.ws + WS_CTL);

#define IN(k) (lo <= (k) && (k) < hi)
#define SEAM(k) do { if (IN(k) && IN((k) + 1)) xcd_barrier(bar); } while (0)

        const int pb = 1 + layer * PH_PER_LAYER;
        const bf16* WINl = WIN + (size_t)layer * NPROJ * DM; const bf16* WOUTl = WOUT + (size_t)layer * DM * MIXW;
        const unsigned char* WGUl = WGU8 + (size_t)layer * NEXP * 2048 * DM; const unsigned char* WDNl = WDN8 + (size_t)layer * NEXP * DM * FF;
        gu32* gcnt = ctl + CW_CNT + 64 * layer;

        if (IN(pb + 0)) {
            if (layer == 0) {
                for (int m = gw; m < MROWS; m += NGW) { const float* xr = in_x + (size_t)m * DM; f32x4 v[4];
#pragma unroll
                    for (int j = 0; j < 4; ++j) v[j] = *(const f32x4*)(xr + 4 * lane + 256 * j);
                    row_dt(v, WDT, DT + (size_t)m * 8, lane); }
            }
            pg8::Gemm g{XB, WINl, MROWS, NPROJ, DM}; pg8::StaticOrder S; S.init(MROWS, NPROJ, G, bid);
            pg8::EpiProj E{PROJ, NPROJ, ROPE, QSCALE};
            pg8::gemm_phase<pg8::EpiProj, pg8::StaticOrder, true, false>(ldsp + RING_OFF, g, S, E);
        }
        SEAM(pb + 0);
        if (IN(pb + 1)) {
            if (args.sub & 1) attn_phase(ldsp + RING_OFF, PROJ, OP, LSE, bid, G, tid, wave, lane);
            if (args.sub & 2) { const float* cw = in_convw + (size_t)layer * 4 * 1024; const float* cb = in_convb + (size_t)layer * 1024;
              for (int un = bid; un < 512; un += G)
                  ssd_s1_unit(ldsp + RING_OFF, PROJ, DT, in_dtb + layer * 8, in_alog + layer * 8, cw, cb, ST, CDEC, un, tid, lane, wave);
              __syncthreads(); }
            const float* sw = in_scw + (size_t)layer * 3 * 512;
            if (args.sub & 4) for (int it = bid * (NWAVES * 64) + tid; it < (int)((long)MROWS * 64); it += G * (NWAVES * 64)) { const int c8 = (int)(it & 63), row = (int)(it >> 6), t = row & (SEQ - 1); const int ch = c8 * 8;
                float a[8];
#pragma unroll
                for (int q = 0; q < 8; ++q) a[q] = 0.f;
#pragma unroll
                for (int k = 0; k < 3; ++k) { const int tt = t - 2 + k; if (tt >= 0) { const bf16* pr = PROJ + (size_t)(row - 2 + k) * NPROJ; const v4u cc = *(const v4u*)(pr + C_SC + ch), hh = *(const v4u*)(pr + C_SH + ch);
                    const f32x4 w0 = *(const f32x4*)(sw + k * 512 + ch), w1 = *(const f32x4*)(sw + k * 512 + ch + 4);
                    a[0] += w0[0] * bflo(cc.x) * bflo(hh.x); a[1] += w0[1] * bfhi(cc.x) * bfhi(hh.x); a[2] += w0[2] * bflo(cc.y) * bflo(hh.y); a[3] += w0[3] * bfhi(cc.y) * bfhi(hh.y);
                    a[4] += w1[0] * bflo(cc.z) * bflo(hh.z); a[5] += w1[1] * bfhi(cc.z) * bfhi(hh.z); a[6] += w1[2] * bflo(cc.w) * bflo(hh.w); a[7] += w1[3] * bfhi(cc.w) * bfhi(hh.w); } }
                const v4u bb = *(const v4u*)(PROJ + (size_t)row * NPROJ + C_SB + ch);
                v4u o; o.x = pk2(a[0] * bflo(bb.x), a[1] * bfhi(bb.x)); o.y = pk2(a[2] * bflo(bb.y), a[3] * bfhi(bb.y)); o.z = pk2(a[4] * bflo(bb.z), a[5] * bfhi(bb.z)); o.w = pk2(a[6] * bflo(bb.w), a[7] * bfhi(bb.w));
                *(v4u*)(MIXED + (size_t)row * MIXW + 1024 + ch) = o; }
        }
        SEAM(pb + 1);
        if (IN(pb + 2)) {
            for (int it = bid * (NWAVES * 64) + tid; it < (int)(64L * 2048); it += G * (NWAVES * 64)) { const int pn4 = (int)(it & 2047), bh = (int)(it >> 11); const int h = bh & 7, b = bh >> 3; f32x4 hc = (f32x4){0.f, 0.f, 0.f, 0.f};
#pragma unroll 8
                for (int c = 0; c < 32; ++c) { const size_t idx = ((size_t)((b * 32 + c) * 8 + h)) * 8192 + pn4 * 4; const f32x4 st = *(const f32x4*)(ST + idx);
                    v2u o; o.x = pk2(hc[0], hc[1]); o.y = pk2(hc[2], hc[3]); *(v2u*)(HIN + idx) = o;
                    hc = hc * CDEC[(size_t)(b * 32 + c) * 8 + h] + st; } }
        }
        SEAM(pb + 2);
        if (IN(pb + 3)) {
            if (args.sub & 1) { const float* cw = in_convw + (size_t)layer * 4 * 1024; const float* cb = in_convb + (size_t)layer * 1024;
              for (int un = bid; un < 512; un += G)
                  ssd_s3_unit(ldsp + RING_OFF, PROJ, DT, in_dtb + layer * 8, in_alog + layer * 8, cw, cb, in_dsk + layer * 8, in_ng + (size_t)layer * 512, HIN, MIXED, un, tid, lane, wave);
              __syncthreads(); }
            if (args.sub & 2) for (int it = bid * (NWAVES * 64) + tid; it < (int)((long)MROWS * 64); it += G * (NWAVES * 64)) { const int c8 = (int)(it & 63), row = (int)(it >> 6); const int h = c8 >> 3;
                const float l0 = LSE[((size_t)0 * MROWS + row) * 8 + h], l1 = LSE[((size_t)1 * MROWS + row) * 8 + h], l2 = LSE[((size_t)2 * MROWS + row) * 8 + h];
                const float mm = fmaxf(l0, fmaxf(l1, l2)); float w0 = exp2f(l0 - mm), w1 = exp2f(l1 - mm), w2 = exp2f(l2 - mm); const float iw = 1.0f / (w0 + w1 + w2); w0 *= iw; w1 *= iw; w2 *= iw;
                const v4u a0 = *(const v4u*)(OP + ((size_t)0 * MROWS + row) * 512 + c8 * 8), a1 = *(const v4u*)(OP + ((size_t)1 * MROWS + row) * 512 + c8 * 8), a2 = *(const v4u*)(OP + ((size_t)2 * MROWS + row) * 512 + c8 * 8);
                v4u o;
                o.x = pk2(w0 * bflo(a0.x) + w1 * bflo(a1.x) + w2 * bflo(a2.x), w0 * bfhi(a0.x) + w1 * bfhi(a1.x) + w2 * bfhi(a2.x));
                o.y = pk2(w0 * bflo(a0.y) + w1 * bflo(a1.y) + w2 * bflo(a2.y), w0 * bfhi(a0.y) + w1 * bfhi(a1.y) + w2 * bfhi(a2.y));
                o.z = pk2(w0 * bflo(a0.z) + w1 * bflo(a1.z) + w2 * bflo(a2.z), w0 * bfhi(a0.z) + w1 * bfhi(a1.z) + w2 * bfhi(a2.z));
                o.w = pk2(w0 * bflo(a0.w) + w1 * bflo(a1.w) + w2 * bflo(a2.w), w0 * bfhi(a0.w) + w1 * bfhi(a1.w) + w2 * bfhi(a2.w));
                *(v4u*)(MIXED + (size_t)row * MIXW + c8 * 8) = o; }
        }
        SEAM(pb + 3);
        if (IN(pb + 4)) {
            pg8::Gemm g{MIXED, WOUTl, MROWS, DM, MIXW}; pg8::StaticOrder S; S.init(MROWS, DM, G, bid);
            pg8::EpiBf16Plain E{MIXF, DM};
            pg8::gemm_phase<pg8::EpiBf16Plain, pg8::StaticOrder, true, false>(ldsp + RING_OFF, g, S, E);
        }
        SEAM(pb + 4);
        if (IN(pb + 5)) {
            const float* gam = in_ln1g + (size_t)layer * DM; const float* bet = in_ln1b + (size_t)layer * DM;
            for (int m = gw; m < MROWS; m += NGW) { f32x4 v[4];
#pragma unroll
                for (int j = 0; j < 4; ++j) { const v2u a = *(const v2u*)(XB + (size_t)m * DM + 4 * lane + 256 * j); const v2u b = *(const v2u*)(MIXF + (size_t)m * DM + 4 * lane + 256 * j);
                    v[j] = (f32x4){bflo(a.x), bfhi(a.x), bflo(a.y), bfhi(a.y)} * ALPHA + (f32x4){bflo(b.x), bfhi(b.x), bflo(b.y), bfhi(b.y)}; }
                ln_row<true, false>(v, gam, bet, nullptr, XB + (size_t)m * DM, XB8 + (size_t)m * DM, SC_X, lane); }
        }
        SEAM(pb + 5);
        if (IN(pb + 6)) {
            LAS int* lcnt = (LAS int*)(ldsp + L_LCNT); LAS int* lbase = (LAS int*)(ldsp + L_LBASE);
            const bf16* RT = ROUT + (size_t)layer * NEXP * DM; const float* rb = in_rb + (size_t)layer * NEXP;
            for (int blk = bid; blk < MROWS / 128; blk += G) {
                if (tid < 32) lcnt[tid] = 0;
                __syncthreads();
                const int r32 = lane & 31, hi = lane >> 5; const int row = blk * 128 + (wave & 3) * 32 + r32;
                float tv[4]; int te[4]; int lrank[4]; float gate[4];
                if (wave < 4) {
                    f32x16 acc = {};
                    const bf16* ap = RT + (size_t)r32 * DM + 8 * hi; const bf16* bp = XB + (size_t)row * DM + 8 * hi;
#pragma unroll 8
                    for (int s = 0; s < 64; ++s) { const bf16x8 a = *(const bf16x8*)(ap + 16 * s), b = *(const bf16x8*)(bp + 16 * s); acc = __builtin_amdgcn_mfma_f32_32x32x16_bf16(a, b, acc, 0, 0, 0); }
#pragma unroll
                    for (int k = 0; k < 4; ++k) { tv[k] = -INFINITY; te[k] = 1 << 20; }
#pragma unroll
                    for (int i = 0; i < 16; ++i) { const int e = (i & 3) + 8 * (i >> 2) + 4 * hi; float v = acc[i] + rb[e]; int ve = e;
#pragma unroll
                        for (int k = 0; k < 4; ++k) { const bool gt = (v > tv[k]) || (v == tv[k] && ve < te[k]); const float nv = gt ? tv[k] : v; const int ne = gt ? te[k] : ve; tv[k] = gt ? v : tv[k]; te[k] = gt ? ve : te[k]; v = nv; ve = ne; } }
                    float pv[4]; int pe[4];
#pragma unroll
                    for (int k = 0; k < 4; ++k) { pv[k] = __shfl_xor(tv[k], 32); pe[k] = __shfl_xor(te[k], 32); }
#pragma unroll
                    for (int j = 0; j < 4; ++j) { float v = pv[j]; int ve = pe[j];
#pragma unroll
                        for (int k = 0; k < 4; ++k) { const bool gt = (v > tv[k]) || (v == tv[k] && ve < te[k]); const float nv = gt ? tv[k] : v; const int ne = gt ? te[k] : ve; tv[k] = gt ? v : tv[k]; te[k] = gt ? ve : te[k]; v = nv; ve = ne; } }
                    float se = 0.f;
#pragma unroll
                    for (int k = 0; k < 4; ++k) { gate[k] = __expf(tv[k] - tv[0]); se += gate[k]; }
                    const float ise = 1.0f / se;
#pragma unroll
                    for (int k = 0; k < 4; ++k) gate[k] *= ise;
                    if (hi == 0) {
#pragma unroll
                        for (int k = 0; k < 4; ++k) lrank[k] = __hip_atomic_fetch_add(lcnt + te[k], 1, __ATOMIC_RELAXED, __HIP_MEMORY_SCOPE_WORKGROUP);
                    }
                }
                __syncthreads();
                if (tid < 32) lbase[tid] = (int)__hip_atomic_fetch_add(gcnt + tid, (unsigned)lcnt[tid], RLX_AGENT);
                __syncthreads();
                if (wave < 4 && hi == 0) {
#pragma unroll
                    for (int k = 0; k < 4; ++k) { const int r = lbase[te[k]] + lrank[k]; const size_t o = (size_t)te[k] * 32768 + r;
                        ROWTOK[o] = row * 4 + k; ROWGATE[o] = gate[k]; TOPE[(size_t)row * 4 + k] = te[k]; TOPG[(size_t)row * 4 + k] = gate[k]; }
                }
                __syncthreads();
            }
        }
        SEAM(pb + 6);
        if (IN(pb + 7) || IN(pb + 8)) {
            LAS int* tstart = (LAS int*)(ldsp + L_TSTART); LAS int* cntL = (LAS int*)(ldsp + L_CNT); LAS int* units = (LAS int*)(ldsp + L_UNITS); LAS int* unitsn = (LAS int*)(ldsp + L_UNITSN);
            if (tid == 0) { int acc = 0; for (int e = 0; e < 32; ++e) { const int c = (int)__hip_atomic_load(gcnt + e, RLX_AGENT); cntL[e] = c; tstart[e] = acc; acc += (c + 255) >> 8; } tstart[32] = acc; }
            __syncthreads();
            if (IN(pb + 7)) {
                pg8::moe_build_units(units, unitsn, tstart, 8, G, bid, tid);
                __syncthreads();
                pg8::Gemm g{(const pg8::bf16_t*)XB8, (const pg8::bf16_t*)WGUl, 0, 2048, DM / 2};
                pg8::MoeOrder S{units, __builtin_amdgcn_readfirstlane(unitsn[0]), cntL, ROWTOK, 1, (unsigned)DM, (size_t)2048 * DM, ROWGATE, in_bgu + (size_t)layer * NEXP * 2048};
                pg8::EpiSwiglu E{H8, in_bgu + (size_t)layer * NEXP * 2048, ROWGATE, cntL, 1.0f / (SC_X * SC_WGU), SC_H};
                pg8::gemm_phase<pg8::EpiSwiglu, pg8::MoeOrder, true, true, true>(ldsp + RING_OFF, g, S, E);
                __syncthreads();
            }
            SEAM(pb + 7);
            if (IN(pb + 8)) {
                pg8::moe_build_units(units, unitsn, tstart, 4, G, bid, tid);
                __syncthreads();
                pg8::Gemm g{(const pg8::bf16_t*)H8, (const pg8::bf16_t*)WDNl, 0, DM, FF / 2};
                pg8::MoeOrder S{units, __builtin_amdgcn_readfirstlane(unitsn[0]), cntL, ROWTOK, 0, (unsigned)FF, (size_t)DM * FF, nullptr, nullptr};
                pg8::EpiScatter E{YB8, ROWTOK, cntL, SC_Y / (SC_H * SC_WDN)};
                pg8::gemm_phase<pg8::EpiScatter, pg8::MoeOrder, true, false, true>(ldsp + RING_OFF, g, S, E);
                __syncthreads();
            }
        }
        SEAM(pb + 8);
        if (IN(pb + 9)) {
            const float* gam = in_ln2g + (size_t)layer * DM; const float* bet = in_ln2b + (size_t)layer * DM; const float* bdn = in_bdn + (size_t)layer * NEXP * DM;
            for (int m = gw; m < MROWS; m += NGW) { f32x4 v[4];
#pragma unroll
                for (int j = 0; j < 4; ++j) { const v2u a = *(const v2u*)(XB + (size_t)m * DM + 4 * lane + 256 * j); v[j] = (f32x4){bflo(a.x), bfhi(a.x), bflo(a.y), bfhi(a.y)} * ALPHA; }
#pragma unroll
                for (int k = 0; k < 4; ++k) { const int e = TOPE[(size_t)m * 4 + k]; const float gk = TOPG[(size_t)m * 4 + k]; const unsigned char* yr = YB8 + ((size_t)m * 4 + k) * DM; const float* br = bdn + (size_t)e * DM;
#pragma unroll
                    for (int j = 0; j < 4; ++j) { const unsigned w = *(const unsigned*)(yr + 4 * lane + 256 * j); const f32x4 b = *(const f32x4*)(br + 4 * lane + 256 * j);
                        typedef float f32x2_ __attribute__((ext_vector_type(2)));
                        const f32x2_ lo = __builtin_amdgcn_cvt_pk_f32_fp8(w, false), hi = __builtin_amdgcn_cvt_pk_f32_fp8(w, true);
                        v[j][0] += lo[0] * (1.0f / SC_Y) + gk * b[0]; v[j][1] += lo[1] * (1.0f / SC_Y) + gk * b[1]; v[j][2] += hi[0] * (1.0f / SC_Y) + gk * b[2]; v[j][3] += hi[1] * (1.0f / SC_Y) + gk * b[3]; } }
                ln_row<false, (layer == NLAYER - 1)>(v, gam, bet, args.out + (size_t)m * DM, XB + (size_t)m * DM, nullptr, 1.f, lane);
                if (layer + 1 < NLAYER) row_dt(v, WDT + (size_t)(layer + 1) * 8 * 1024, DT + (size_t)m * 8, lane); }
        }
        SEAM(pb + 9);
    #undef IN
#undef SEAM
}

__global__ void __launch_bounds__(NWAVES * 64, 2) mk_fwd(Args args) {
    extern __shared__ __attribute__((aligned(16))) unsigned char lds[];
    LAS unsigned char* ldsp = (LAS unsigned char*)lds;
    const int tid = threadIdx.x, lane = tid & 63, wave = __builtin_amdgcn_readfirstlane(tid >> 6);
    const int G = gridDim.x, bid = blockIdx.x;
    const int gw = bid * NWAVES + wave, NGW = G * NWAVES;
    gu32* ctl = (gu32*)(args.ws + WS_CTL);

    for (int u = tid; u < (LDS_BYTES - LDSCTL_OFF) / 4; u += NWAVES * 64) ((LAS unsigned*)(ldsp + LDSCTL_OFF))[u] = 0u;
    __syncthreads();
    XcdBarrier bar = xcd_barrier_post((unsigned*)(ctl + CW_BAR), (volatile LAS unsigned*)(ldsp + L_MISC) + 8);

    const int lo = args.ph_lo, hi = args.ph_hi;
#define IN(k) (lo <= (k) && (k) < hi)
#define SEAM(k) do { if (IN(k) && IN((k) + 1)) xcd_barrier(bar); } while (0)

    if (IN(0)) {
        for (int it = bid * (NWAVES * 64) + tid; it < (int)(4096 * 32); it += G * (NWAVES * 64)) { const int t = (int)(it >> 5), i = (int)(it & 31);
            const float inv = powf(10000.0f, -(float)i / 32.0f); const float ang = (float)t * inv; float sn, cs; sincosf(ang, &sn, &cs);
            ROPE[2 * it] = cs; ROPE[2 * it + 1] = sn; }
        LAS float* scr = (LAS float*)(ldsp + RING_OFF + wave * 16384);
        constexpr int I_IN = 16 * 145, I_OUT = 24 * 32, I_R = 16;
        constexpr int NIT = NLAYER * (I_IN + I_OUT + I_R);
        for (int it = gw; it < NIT; it += NGW) {
            int r = it;
            if (r < NLAYER * I_IN) { const int l = r / I_IN; r %= I_IN; p0_transpose_item<1>(in_win + (size_t)l * DM * INW, DM, INW, WIN + (size_t)l * NPROJ * DM, WDT + (size_t)l * 8 * 1024, scr, r / 145, r % 145, lane); continue; } r -= NLAYER * I_IN;
            if (r < NLAYER * I_OUT) { const int l = r / I_OUT; r %= I_OUT; p0_transpose_item<0>(in_wout + (size_t)l * MIXW * DM, MIXW, DM, WOUT + (size_t)l * DM * MIXW, nullptr, scr, r / 32, r % 32, lane); continue; } r -= NLAYER * I_OUT;
            { const int l = r / I_R; r %= I_R; p0_transpose_item<0>(in_rw + (size_t)l * DM * NEXP, DM, NEXP, ROUT + (size_t)l * NEXP * DM, nullptr, scr, r, 0, lane); }
        }
        { constexpr int NIT8 = 64 * 256 + 64 * 128;
          const int nmine = (gw < NIT8) ? (NIT8 - gw + NGW - 1) / NGW : 0; const int J = 2 * nmine;
          f32x4 lda[16], ldb[16];
          if (J > 0) { const SubT t = fp8_subtile(gw, 0, in_wgu, in_wdn, WGU8, WDN8, lane); fp8_sub_load(t, lda); }
#pragma unroll 1
          for (int j = 0; j < J; j += 2) {
              const int item = gw + (j >> 1) * NGW;
              const SubT t0 = fp8_subtile(item, 0, in_wgu, in_wdn, WGU8, WDN8, lane), t1 = fp8_subtile(item, 1, in_wgu, in_wdn, WGU8, WDN8, lane);
              fp8_sub_load(t1, ldb);
              fp8_sub_process(t0, lda, scr, lane);
              if (j + 2 < J) { const SubT t2 = fp8_subtile(item + NGW, 0, in_wgu, in_wdn, WGU8, WDN8, lane); fp8_sub_load(t2, lda); }
              fp8_sub_process(t1, ldb, scr, lane);
          } }
        __syncthreads();
    }
    if (IN(0)) {
        for (int m = gw; m < MROWS; m += NGW) { const float* xr = in_x + (size_t)m * DM; bf16* ob = XB + (size_t)m * DM;
#pragma unroll
            for (int j = 0; j < 4; ++j) { const f32x4 v = *(const f32x4*)(xr + 4 * lane + 256 * j); v2u w; w.x = pk2(v[0], v[1]); w.y = pk2(v[2], v[3]); *(v2u*)(ob + 4 * lane + 256 * j) = w; } }
    }

    SEAM(0);
    run_layer<0>(args, lo, hi, bar);
    run_layer<1>(args, lo, hi, bar);
#undef IN
#undef SEAM
}

extern "C" void kernel_launch(void* const* d_in, const int* in_sizes, int n_in, void* d_out, int out_size, void* d_ws, size_t ws_size, hipStream_t stream) {
    static int grid = 0;
    if (grid == 0) {
        if (n_in != 20 || out_size != MROWS * DM || ws_size < WS_END) { fprintf(stderr, "kernel_launch: unexpected problem (n_in %d, out %d, ws %zu)\n", n_in, out_size, ws_size); grid = -1; return; }
        if (hipFuncSetAttribute((const void*)mk_fwd, hipFuncAttributeMaxDynamicSharedMemorySize, LDS_BYTES) != hipSuccess) { fprintf(stderr, "kernel_launch: hipFuncSetAttribute failed\n"); grid = -1; return; }
        int dev = 0, cus = 0, per_cu = 0;
        (void)hipGetDevice(&dev); (void)hipDeviceGetAttribute(&cus, hipDeviceAttributeMultiprocessorCount, dev);
        if (hipOccupancyMaxActiveBlocksPerMultiprocessor(&per_cu, (const void*)mk_fwd, NWAVES * 64, LDS_BYTES) != hipSuccess || per_cu < 1) fprintf(stderr, "kernel_launch: occupancy query says %d\n", per_cu);
        (void)hipGetLastError();
        grid = cus > 0 ? cus : 256;
    }
    if (grid < 0) return;
    (void)hipMemsetAsync((char*)d_ws + WS_CTL, 0, CTL_ZERO_BYTES, stream);
    Args a{};
    for (int i = 0; i < 20; ++i) a.in[i] = (const float*)d_in[i];
    a.out = (float*)d_out; a.ws = (unsigned char*)d_ws;
    a.ph_lo = 0; a.ph_hi = N_PHASES; a.sub = 7; a.pad = 0;
    hipLaunchKernelGGL(mk_fwd, dim3(grid), dim3(NWAVES * 64), LDS_BYTES, stream, a);
#ifdef PROBE_PH
#ifndef PROBE_SUB
#define PROBE_SUB 7
#endif
    for (int i = 0; i < PROBE_N; ++i) { a.ph_lo = PROBE_PH; a.ph_hi = PROBE_PH + 1; a.sub = PROBE_SUB; hipLaunchKernelGGL(mk_fwd, dim3(grid), dim3(NWAVES * 64), LDS_BYTES, stream, a); }
#endif
}
```

```cpp
#include <hip/hip_runtime.h>
#include <cstdio>
#include <cstdint>
#include <cmath>

namespace pg8 {
#define PG8_LAS __attribute__((address_space(3)))
typedef unsigned short bf16_t;
typedef short bf16x8 __attribute__((ext_vector_type(8)));
typedef float f32x4 __attribute__((ext_vector_type(4)));
typedef float f32x2 __attribute__((ext_vector_type(2)));
typedef unsigned u32x4 __attribute__((ext_vector_type(4)));
constexpr int BM = 256, BK = 64, HALF = 128, HTB = HALF * BK * 2  , STAGE_BYTES = 8 * HTB, NXCD = 8, WGM = 8;

__host__ __device__ __forceinline__ int lds_byte(int r, int c) { const int st = (r >> 4) * 2 + (c >> 5), rr = r & 15, cc = c & 31, ob = rr * 64 + cc * 2; return st * 1024 + (ob ^ (((ob >> 9) & 1) << 5)); }
__host__ __device__ __forceinline__ void stage_rc(int b, int& R, int& C) { const int st = b / 1024, sb = b % 1024, swz = sb ^ (((sb >> 9) & 1) << 5); R = (st >> 1) * 16 + swz / 64; C = (st & 1) * 32 + (swz % 64) / 2; }
__host__ __device__ __forceinline__ int perm32(int rho) { const int n = rho >> 4, i = rho & 15; return 8 * (i >> 2) + 4 * n + (i & 3); }

struct Unit { int pm, pn, e, r0; };
struct Gemm { const bf16_t* A; const bf16_t* Bt; int M, N, K; };

struct StaticOrder {
    int nM, nN, nwg, G, c;
    __device__ void init(int M, int N, int G_, int c_) { nM = M / BM; nN = N / BM; nwg = nM * nN; G = G_; c = c_; }
    __device__ __forceinline__ bool next(int i, Unit& u) const {
        const long L = (long)i * G + c; if (L >= nwg) return false;
        int wgid = (int)L; { const int q = nwg / NXCD, r = nwg % NXCD, xcd = wgid % NXCD, off = wgid / NXCD; wgid = (xcd < r ? xcd * (q + 1) : r * (q + 1) + (xcd - r) * q) + off; }
        const int nig = WGM * nN, gid = wgid / nig, fm = gid * WGM, gsz = (nM - fm) < WGM ? (nM - fm) : WGM;
        u.pm = fm + ((wgid % nig) % gsz); u.pn = (wgid % nig) / gsz; u.e = 0; u.r0 = 0; return true;
    }
    __device__ __forceinline__ const char* abase(const Unit& u, const Gemm& g, size_t tstep) const { return (const char*)g.A + (size_t)u.pm * tstep; }
    __device__ __forceinline__ const char* bbase(const Unit& u, const Gemm& g, size_t tstep) const { return (const char*)g.Bt + (size_t)u.pn * tstep; }
    static constexpr bool SIDE = false;
    __device__ __forceinline__ unsigned arow(const Unit&, int) const { return 0u; }
    __device__ __forceinline__ unsigned arow_side(const Unit&, int, const PG8_LAS unsigned char*) const { return 0u; }
    __device__ __forceinline__ const void* side_src(const Unit&, const Unit&, int, int) const { return nullptr; }
    __device__ __forceinline__ void a_ready(const Unit&) const {}
    __device__ __forceinline__ void done(const Unit&) const {}
};

struct MoeOrder {
    const PG8_LAS int* units;
    int nunits;
    const PG8_LAS int* cnt;
    const int* rowtok;
    int gather;
    unsigned rowbytes;
    size_t bstride;
    __device__ __forceinline__ bool next(int i, Unit& u) const {
        if (i >= nunits) return false;
        u.pm = __builtin_amdgcn_readfirstlane(units[4 * i + 0]); u.pn = __builtin_amdgcn_readfirstlane(units[4 * i + 1]);
        u.e = __builtin_amdgcn_readfirstlane(units[4 * i + 2]); u.r0 = __builtin_amdgcn_readfirstlane(units[4 * i + 3]); return true;
    }
    __device__ __forceinline__ const char* abase(const Unit& u, const Gemm& g, size_t tstep) const { return gather ? (const char*)g.A : (const char*)g.A + (size_t)u.pm * tstep; }
    __device__ __forceinline__ const char* bbase(const Unit& u, const Gemm& g, size_t tstep) const { return (const char*)g.Bt + (size_t)u.e * bstride + (size_t)u.pn * tstep; }
    static constexpr bool SIDE = true;
    const float* rowgate; const float* bgu;
    __device__ __forceinline__ unsigned arow(const Unit& u, int R) const {
        const int r = u.r0 + R; const int idx = (r < cnt[u.e]) ? rowtok[(size_t)u.e * 32768 + r] : 0; return (unsigned)(idx >> 2) * rowbytes; }
    __device__ __forceinline__ unsigned arow_side(const Unit& u, int R, const PG8_LAS unsigned char* sd) const {
        const int r = u.r0 + R; const int v = ((const PG8_LAS int*)sd)[R]; const int idx = (r < cnt[u.e]) ? v : 0; return (unsigned)(idx >> 2) * rowbytes; }
    __device__ __forceinline__ const void* side_src(const Unit& cur, const Unit& rt, int wid, int lane) const {
        if (rowgate != nullptr && wid == 1) return rowgate + (size_t)cur.e * 32768 + cur.r0 + 4 * lane;
        if (bgu != nullptr && wid == 2) return gather ? (bgu + (size_t)cur.e * 2048 + (lane < 32 ? 0 : 1024 - 128) + cur.pn * 128 + 4 * lane)
                                                      : (bgu + (size_t)cur.e * 1024 + cur.pn * 256 + 4 * lane);
        return rowtok + (size_t)rt.e * 32768 + rt.r0 + 4 * lane; }
    __device__ __forceinline__ void a_ready(const Unit&) const {}
    __device__ __forceinline__ void done(const Unit&) const {}
};
__device__ __forceinline__ void moe_build_units(PG8_LAS int* units, PG8_LAS int* units_n, const PG8_LAS int* tstart, int nN, int G, int c, int tid) {
    if (tid < 64) {
        const int nT = tstart[32], nwg = nT * nN; const long L = (long)tid * G + c;
        int pm = 0, pn = 0, e = 0, r0 = 0;
        if (L < nwg) {
            int wgid = (int)L; { const int q = nwg / NXCD, r = nwg % NXCD, xcd = wgid % NXCD, off = wgid / NXCD; wgid = (xcd < r ? xcd * (q + 1) : r * (q + 1) + (xcd - r) * q) + off; }
            const int nig = WGM * nN, gid = wgid / nig, fm = gid * WGM, gsz = (nT - fm) < WGM ? (nT - fm) : WGM;
            pm = fm + ((wgid % nig) % gsz); pn = (wgid % nig) / gsz;
            for (int j = 1; j < 32; ++j) e += (tstart[j] <= pm) ? 1 : 0;
            r0 = (pm - tstart[e]) * 256;
        }
        units[4 * tid + 0] = pm; units[4 * tid + 1] = pn; units[4 * tid + 2] = e; units[4 * tid + 3] = r0;
        if (tid == 0) { int n = 0; if (c < nwg) n = (nwg - c + G - 1) / G; units_n[0] = n < 64 ? n : 64; }
    }
}

__host__ __device__ __forceinline__ unsigned hblk_off(int R, int p7) { const int ai = R >> 7, wr = (R >> 6) & 1, m = (R >> 4) & 3, fr = R & 15, wc = p7 >> 1, fq = ((p7 & 1) << 1) | (m & 1), mp = m >> 1;
    return (unsigned)(((((ai * 2 + wr) * 4 + wc) * 2 + mp) * 64 + fr + 16 * fq) * 16); }
typedef int v8i_t __attribute__((ext_vector_type(8)));
typedef int v4i_t __attribute__((ext_vector_type(4)));
__device__ __forceinline__ v8i_t cat8(bf16x8 lo, bf16x8 hi) { const v4i_t a = __builtin_bit_cast(v4i_t, lo), b = __builtin_bit_cast(v4i_t, hi); return __builtin_shufflevector(a, b, 0, 1, 2, 3, 4, 5, 6, 7); }
__device__ __forceinline__ void mfma8(f32x4& acc, v8i_t a, v8i_t b, int scl) { asm volatile("v_mfma_scale_f32_16x16x128_f8f6f4 %0, %1, %2, %0, %3, %3 op_sel_hi:[0,0,0]" : "+v"(acc) : "v"(a), "v"(b), "v"(scl)); }
__device__ __forceinline__ unsigned pk4_fp8(float a, float b, float c, float d) { unsigned w = 0u; w = __builtin_amdgcn_cvt_pk_fp8_f32(a, b, w, false); w = __builtin_amdgcn_cvt_pk_fp8_f32(c, d, w, true); return w; }
__device__ __forceinline__ unsigned cvt_pk_bf16(float lo, float hi) { unsigned r; asm volatile("v_cvt_pk_bf16_f32 %0, %1, %2" : "=v"(r) : "v"(lo), "v"(hi)); return r; }

struct EpiProj {
    static constexpr bool PERM = true, AFTER_DRAIN = false;
    bf16_t* O; int ldc; const float* rope; float qscale;
    __device__ __forceinline__ void operator()(const f32x4 (&acc)[2][2][4][2], const Unit& u, int wr, int wc, int fr, int fq, const PG8_LAS unsigned char* sd) const {
        const int row0 = u.pm * BM + wr * 64 + fr; const int col0 = u.pn * BM + wc * 32 + 8 * fq;
        const bool rot = u.pn < 4; const float sc = u.pn < 2 ? qscale : 1.f; const int gq = 4 * (wc & 1) + fq;
#pragma unroll
        for (int ai = 0; ai < 2; ++ai)
#pragma unroll
            for (int m = 0; m < 4; ++m) { const int row = row0 + ai * HALF + m * 16; bf16_t* rowp = O + (size_t)row * ldc + col0;
                f32x4 cs0 = (f32x4){1.f, 0.f, 1.f, 0.f}, cs1 = cs0;
                if (rot) { const float* rp = rope + ((size_t)(row & 4095) * 32 + 4 * gq) * 2; cs0 = *(const f32x4*)rp; cs1 = *(const f32x4*)(rp + 4); }
#pragma unroll
                for (int bj = 0; bj < 2; ++bj) { f32x4 v0 = acc[ai][bj][m][0], v1 = acc[ai][bj][m][1];
                    if (rot) { f32x4 lo, hi;
                        lo[0] = v0[0] * cs0[0] - v1[0] * cs0[1]; hi[0] = v1[0] * cs0[0] + v0[0] * cs0[1];
                        lo[1] = v0[1] * cs0[2] - v1[1] * cs0[3]; hi[1] = v1[1] * cs0[2] + v0[1] * cs0[3];
                        lo[2] = v0[2] * cs1[0] - v1[2] * cs1[1]; hi[2] = v1[2] * cs1[0] + v0[2] * cs1[1];
                        lo[3] = v0[3] * cs1[2] - v1[3] * cs1[3]; hi[3] = v1[3] * cs1[2] + v0[3] * cs1[3];
                        v0 = lo * sc; v1 = hi * sc; }
                    u32x4 w; w.x = cvt_pk_bf16(v0[0], v0[1]); w.y = cvt_pk_bf16(v0[2], v0[3]); w.z = cvt_pk_bf16(v1[0], v1[1]); w.w = cvt_pk_bf16(v1[2], v1[3]);
                    *(u32x4*)(rowp + bj * HALF) = w; } }
    }
};
struct EpiF32 {
    static constexpr bool PERM = false, AFTER_DRAIN = false;
    float* O; int ldc;
    __device__ __forceinline__ void operator()(const f32x4 (&acc)[2][2][4][2], const Unit& u, int wr, int wc, int fr, int fq, const PG8_LAS unsigned char* sd) const {
        const int row0 = u.pm * BM + wr * 64 + fr; const int col0 = u.pn * BM + wc * 32 + 4 * fq;
#pragma unroll
        for (int ai = 0; ai < 2; ++ai)
#pragma unroll
            for (int m = 0; m < 4; ++m) { float* rowp = O + (size_t)(row0 + ai * HALF + m * 16) * ldc + col0;
#pragma unroll
                for (int bj = 0; bj < 2; ++bj)
#pragma unroll
                    for (int n = 0; n < 2; ++n) *(f32x4*)(rowp + bj * HALF + n * 16) = acc[ai][bj][m][n]; }
    }
};
struct EpiBf16Plain {
    static constexpr bool PERM = true, AFTER_DRAIN = false;
    bf16_t* O; int ldc;
    __device__ __forceinline__ void operator()(const f32x4 (&acc)[2][2][4][2], const Unit& u, int wr, int wc, int fr, int fq, const PG8_LAS unsigned char* sd) const {
        const int row0 = u.pm * BM + wr * 64 + fr; const int col0 = u.pn * BM + wc * 32 + 8 * fq;
#pragma unroll
        for (int ai = 0; ai < 2; ++ai)
#pragma unroll
            for (int m = 0; m < 4; ++m) { bf16_t* rowp = O + (size_t)(row0 + ai * HALF + m * 16) * ldc + col0;
#pragma unroll
                for (int bj = 0; bj < 2; ++bj) { const f32x4 v0 = acc[ai][bj][m][0], v1 = acc[ai][bj][m][1];
                    u32x4 w; w.x = cvt_pk_bf16(v0[0], v0[1]); w.y = cvt_pk_bf16(v0[2], v0[3]); w.z = cvt_pk_bf16(v1[0], v1[1]); w.w = cvt_pk_bf16(v1[2], v1[3]);
                    *(u32x4*)(rowp + bj * HALF) = w; } }
    }
};
struct EpiSwiglu {
    static constexpr bool PERM = true, AFTER_DRAIN = false;
    unsigned char* H; const float* bgu; const float* rowgate; const PG8_LAS int* cnt; float dq, hscale;
    __device__ __forceinline__ void operator()(const f32x4 (&acc)[2][2][4][2], const Unit& u, int wr, int wc, int fr, int fq, const PG8_LAS unsigned char* sd) const {
        const int ff = u.pn * HALF + wc * 32 + 8 * fq; const int n_e = cnt[u.e];
        f32x4 bg[2], bu[2];
#pragma unroll
        for (int n = 0; n < 2; ++n) { bg[n] = *(const PG8_LAS f32x4*)(sd + 2048 + (wc * 32 + 8 * fq + 4 * n) * 4); bu[n] = *(const PG8_LAS f32x4*)(sd + 2048 + 512 + (wc * 32 + 8 * fq + 4 * n) * 4); }
        const int lane = fr + 16 * fq;
#pragma unroll
        for (int ai = 0; ai < 2; ++ai)
#pragma unroll
            for (int mp = 0; mp < 2; ++mp) {
                unsigned pw[2][2];
#pragma unroll
                for (int mm = 0; mm < 2; ++mm) { const int m = 2 * mp + mm; const int r = ai * HALF + wr * 64 + m * 16 + fr; const int er = u.r0 + r;
                    const float rgl = ((const PG8_LAS float*)(sd + 1024))[r]; const float rg = ((er < n_e) ? rgl : 0.f) * hscale;
                    float hv[8];
#pragma unroll
                    for (int n = 0; n < 2; ++n)
#pragma unroll
                        for (int q = 0; q < 4; ++q) { float g = acc[ai][0][m][n][q] * dq + bg[n][q], up = acc[ai][1][m][n][q] * dq + bu[n][q];
                            g = fminf(g, 7.0f); up = fminf(fmaxf(up, -7.0f), 7.0f);
                            const float sg = __builtin_amdgcn_rcpf(1.0f + __builtin_amdgcn_exp2f(-1.702f * 1.4426950408889634f * g));
                            hv[n * 4 + q] = (up + 1.0f) * g * sg * rg; }
                    pw[mm][0] = pk4_fp8(hv[0], hv[1], hv[2], hv[3]); pw[mm][1] = pk4_fp8(hv[4], hv[5], hv[6], hv[7]); }
                const auto s0 = __builtin_amdgcn_permlane16_swap(pw[0][0], pw[1][0], false, false); const auto s1 = __builtin_amdgcn_permlane16_swap(pw[0][1], pw[1][1], false, false);
                *(u32x4*)(H + ((size_t)u.pm * 8 + u.pn) * 32768 + ((((ai * 2 + wr) * 4 + wc) * 2 + mp) * 64 + lane) * 16) = (u32x4){s0[0], s1[0], s0[1], s1[1]};
                asm volatile("" ::: "memory"); }
    }
};
struct EpiScatter {
    static constexpr bool PERM = true, AFTER_DRAIN = false;
    unsigned char* Y; const int* rowtok; const PG8_LAS int* cnt; float dq, ysc;
    __device__ __forceinline__ void operator()(const f32x4 (&acc)[2][2][4][2], const Unit& u, int wr, int wc, int fr, int fq, const PG8_LAS unsigned char* sd) const {
        const int col0 = u.pn * BM + wc * 32 + 8 * fq; const int n_e = cnt[u.e];
        f32x4 bd[2][2];
#pragma unroll
        for (int bj = 0; bj < 2; ++bj)
#pragma unroll
            for (int n = 0; n < 2; ++n) bd[bj][n] = *(const PG8_LAS f32x4*)(sd + 2048 + (bj * HALF + wc * 32 + 8 * fq + 4 * n) * 4);
#pragma unroll
        for (int ai = 0; ai < 2; ++ai)
#pragma unroll
            for (int m = 0; m < 4; ++m) { const int er = u.r0 + ai * HALF + wr * 64 + m * 16 + fr;
                const int idx = ((const PG8_LAS int*)sd)[ai * HALF + wr * 64 + m * 16 + fr];
                if (er < n_e) { unsigned char* rowp = Y + (size_t)idx * 1024 + col0;
                    typedef unsigned u32x2 __attribute__((ext_vector_type(2)));
                    const float rg = ((const PG8_LAS float*)(sd + 1024))[ai * HALF + wr * 64 + m * 16 + fr] * ysc;
#pragma unroll
                    for (int bj = 0; bj < 2; ++bj) { const f32x4 v0 = acc[ai][bj][m][0] * dq + bd[bj][0] * rg, v1 = acc[ai][bj][m][1] * dq + bd[bj][1] * rg;
                        *(u32x2*)(rowp + bj * HALF) = (u32x2){pk4_fp8(v0[0], v0[1], v0[2], v0[3]), pk4_fp8(v1[0], v1[1], v1[2], v1[3])}; } }
                asm volatile("" ::: "memory"); }
    }
};

template <class Epi, class Sched, bool ALIGN_EPI, bool GATHER, bool FP8 = false, bool ABLK = false>
__device__ __forceinline__ void gemm_phase(PG8_LAS unsigned char* lds, const Gemm g, const Sched& S, const Epi& E) {
    const int tid = threadIdx.x, wid = __builtin_amdgcn_readfirstlane(tid >> 6), lane = tid & 63, wr = wid >> 2, wc = wid & 3, fr = lane & 15, fq = lane >> 4;
    const int K = g.K, nt = K / BK;
    unsigned voffB[2];
#pragma unroll
    for (int i = 0; i < 2; ++i) { int R, C; stage_rc(tid * 16 + i * 8192, R, C); const int Rb = Epi::PERM ? ((R & ~31) + perm32(R & 31)) : R;
        voffB[i] = (unsigned)(Rb * K + C) * 2u; }
    constexpr int SIDE_BYTES = 8192;
    PG8_LAS unsigned char* const side = lds + STAGE_BYTES;
    const size_t kstep = (size_t)(BK * 2);
    const size_t kstepA = ABLK ? (size_t)32768 : kstep;
    const size_t hstep = (size_t)HALF * K * 2;
    const size_t tstep = 2 * hstep;
    const unsigned ldsw = (unsigned)wid * 1024u;
    const int aoff = lds_byte(wr * 64 + fr, fq * 8), boff = lds_byte(wc * 32 + fr, fq * 8);
#define PG8_SA(b, h) (((b) * 2 + (h)) * HTB)
#define PG8_SB(b, h) ((4 + (b) * 2 + (h)) * HTB)
#define PG8_STAGE(bufoff, gbase, voff) do { _Pragma("unroll") for (int _i = 0; _i < 2; ++_i) \
        __builtin_amdgcn_global_load_lds((const unsigned*)((const char*)(gbase) + (voff)[_i]), (PG8_LAS unsigned*)(lds + (bufoff) + ldsw + _i * 8192), 16, 0, 0); } while (0)
#define PG8_LDA(dst, b, h) do { _Pragma("unroll") for (int m = 0; m < 4; ++m) _Pragma("unroll") for (int k = 0; k < 2; ++k) dst[m][k] = *(const PG8_LAS bf16x8*)(lds + PG8_SA(b, h) + aoff + m * 2048 + k * 1024); } while (0)
#define PG8_LDB(dst, b, h) do { _Pragma("unroll") for (int n = 0; n < 2; ++n) _Pragma("unroll") for (int k = 0; k < 2; ++k) dst[n][k] = *(const PG8_LAS bf16x8*)(lds + PG8_SB(b, h) + boff + n * 2048 + k * 1024); } while (0)
#define PG8_MMA(ai, bj, At, Bt) do { __builtin_amdgcn_s_setprio(1); _Pragma("unroll") for (int m = 0; m < 4; ++m) _Pragma("unroll") for (int n = 0; n < 2; ++n) { \
        if constexpr (FP8) mfma8(acc[ai][bj][m][n], cat8(Bt[n][0], Bt[n][1]), cat8(At[m][0], At[m][1]), scl8); \
        else { _Pragma("unroll") for (int k = 0; k < 2; ++k) acc[ai][bj][m][n] = __builtin_amdgcn_mfma_f32_16x16x32_bf16(Bt[n][k], At[m][k], acc[ai][bj][m][n], 0, 0, 0); } } __builtin_amdgcn_s_setprio(0); } while (0)
#define PG8_WAIT_V(n) asm volatile("s_waitcnt vmcnt(" #n ")" ::: "memory")
#define PG8_WAIT_L(n) asm volatile("s_waitcnt lgkmcnt(" #n ")" ::: "memory")
#define PG8_BAR __builtin_amdgcn_s_barrier()
#define PG8_SCHED __builtin_amdgcn_sched_barrier(0)
#define PG8_SETOFFS(o, u) do { _Pragma("unroll") for (int _h = 0; _h < 2; ++_h) _Pragma("unroll") for (int _i = 0; _i < 2; ++_i) { int _R, _C; stage_rc(tid * 16 + _i * 8192, _R, _C); \
        o[_h][_i] = GATHER ? (S.arow(u, _R + HALF * _h) + (unsigned)(_C * 2)) : ABLK ? hblk_off(_R + HALF * _h, _C >> 3) : ((unsigned)((_R + HALF * _h) * K) * 2u + (unsigned)(_C * 2)); } } while (0)
    int scl8 = 0x7F7F7F7F; asm volatile("" : "+v"(scl8));
    Unit cur, nxt; int ui = 0;
    if (!S.next(0, cur)) return;
    f32x4 acc[2][2][4][2];
#pragma unroll
    for (int a = 0; a < 2; ++a)
#pragma unroll
        for (int b = 0; b < 2; ++b)
#pragma unroll
            for (int m = 0; m < 4; ++m)
#pragma unroll
                for (int n = 0; n < 2; ++n) { acc[a][b][m][n] = (f32x4){0.f, 0.f, 0.f, 0.f}; if constexpr (FP8) asm volatile("" : "+v"(acc[a][b][m][n])); }
    bf16x8 At[4][2], B0[2][2], B1[2][2];
    unsigned cAo[2][2];
    PG8_SETOFFS(cAo, cur);
    const char* cA = S.abase(cur, g, tstep); const char* cB = S.bbase(cur, g, tstep);
    S.a_ready(cur);
    PG8_STAGE(PG8_SB(0, 0), cB, voffB); PG8_STAGE(PG8_SB(0, 1), cB + hstep, voffB); PG8_STAGE(PG8_SA(0, 0), cA, cAo[0]); PG8_STAGE(PG8_SA(0, 1), cA, cAo[1]);
    if (wr == 1) PG8_BAR;
    PG8_WAIT_V(2); PG8_BAR;
    PG8_STAGE(PG8_SB(1, 0), cB + kstep, voffB); PG8_STAGE(PG8_SA(1, 0), cA + kstepA, cAo[0]); PG8_STAGE(PG8_SB(1, 1), cB + hstep + kstep, voffB);
    PG8_WAIT_V(6); PG8_BAR;
    for (;;) {
        const bool has_next = S.next(ui + 1, nxt);
        const char* nA = has_next ? S.abase(nxt, g, tstep) : cA; const char* nB = has_next ? S.bbase(nxt, g, tstep) : cB;
        if constexpr (Sched::SIDE) {
            const void* ssrc = S.side_src(cur, (GATHER && has_next) ? nxt : cur, wid, lane);
            __builtin_amdgcn_global_load_lds((const unsigned*)ssrc, (PG8_LAS unsigned*)(side + (ui & 1) * SIDE_BYTES + wid * 1024), 16, 0, 0); }
#pragma unroll 1
        for (int t = 0; t < nt; t += 2) {
            const bool last = (t == nt - 2);
            const char* a1 = cA + (size_t)(t + 1) * kstepA;
            const char* a2 = last ? nA : cA + (size_t)(t + 2) * kstepA; const char* b2 = last ? nB : cB + (size_t)(t + 2) * kstep;
            const char* a3 = a2 + kstepA; const char* b3 = b2 + kstep;
            if (last && has_next) S.a_ready(nxt);
            PG8_LDB(B0, 0, 0); PG8_LDB(B1, 0, 1); PG8_SCHED; PG8_LDA(At, 0, 0); PG8_STAGE(PG8_SA(1, 1), a1, cAo[1]);
            if constexpr (GATHER) { if (last && has_next) {
                const PG8_LAS unsigned char* sdn = side + (ui & 1) * SIDE_BYTES;
#pragma unroll
                for (int _h = 0; _h < 2; ++_h)
#pragma unroll
                    for (int _i = 0; _i < 2; ++_i) { int _R, _C; stage_rc(tid * 16 + _i * 8192, _R, _C); cAo[_h][_i] = S.arow_side(nxt, _R + HALF * _h, sdn) + (unsigned)(_C * 2); } } }
            PG8_WAIT_V(8); PG8_WAIT_L(0); PG8_BAR; PG8_MMA(0, 0, At, B0); PG8_MMA(0, 1, At, B1); PG8_BAR; PG8_SCHED;
            PG8_LDA(At, 0, 1); PG8_STAGE(PG8_SB(0, 0), b2, voffB); PG8_STAGE(PG8_SB(0, 1), b2 + hstep, voffB); PG8_STAGE(PG8_SA(0, 0), a2, cAo[0]);
            PG8_WAIT_V(8); PG8_WAIT_L(0); PG8_BAR; PG8_MMA(1, 0, At, B0); PG8_MMA(1, 1, At, B1); PG8_BAR; PG8_SCHED;
            PG8_LDB(B0, 1, 0); PG8_LDB(B1, 1, 1); PG8_SCHED; PG8_LDA(At, 1, 0); PG8_STAGE(PG8_SA(0, 1), a2, cAo[1]);
            PG8_WAIT_V(8); PG8_WAIT_L(0); PG8_BAR; PG8_MMA(0, 0, At, B0); PG8_MMA(0, 1, At, B1); PG8_BAR; PG8_SCHED;
            PG8_LDA(At, 1, 1); PG8_STAGE(PG8_SB(1, 0), b3, voffB); PG8_STAGE(PG8_SB(1, 1), b3 + hstep, voffB); PG8_STAGE(PG8_SA(1, 0), a3, cAo[0]);
            PG8_WAIT_V(8); PG8_WAIT_L(0); PG8_BAR; PG8_MMA(1, 0, At, B0); PG8_MMA(1, 1, At, B1); PG8_BAR; PG8_SCHED;
        }
        if constexpr (ALIGN_EPI) { if (wr == 0) PG8_BAR; }
        if constexpr (FP8) asm volatile("s_nop 15\n\ts_nop 15" ::: "memory");
        PG8_SCHED; E(acc, cur, wr, wc, fr, fq, side + (ui & 1) * SIDE_BYTES); S.done(cur); PG8_SCHED;
        if (!has_next) break;
#pragma unroll
        for (int a = 0; a < 2; ++a)
#pragma unroll
            for (int b = 0; b < 2; ++b)
#pragma unroll
                for (int m = 0; m < 4; ++m)
#pragma unroll
                    for (int n = 0; n < 2; ++n) { acc[a][b][m][n] = (f32x4){0.f, 0.f, 0.f, 0.f}; if constexpr (FP8) asm volatile("" : "+v"(acc[a][b][m][n])); }
        cur = nxt; cA = nA; cB = nB; ++ui;
        if constexpr (ALIGN_EPI) { if (wr == 1) PG8_BAR; }
    }
    PG8_WAIT_V(0);
    if constexpr (!ALIGN_EPI) { if (wr == 0) PG8_BAR; }
    PG8_BAR;
#undef PG8_SA
#undef PG8_SB
#undef PG8_STAGE
#undef PG8_LDA
#undef PG8_LDB
#undef PG8_MMA
#undef PG8_WAIT_V
#undef PG8_WAIT_L
#undef PG8_BAR
#undef PG8_SCHED
#undef PG8_SETOFFS
}
}

constexpr int NB = 8, SEQ = 4096, DM = 1024, MROWS = NB * SEQ, NLAYER = 2;
constexpr int NPROJ = 4608, INW = 4616;
constexpr int C_Q = 0, C_K = 512, C_V = 1024, C_Z = 1536, C_XS = 2048, C_SB = 3072, C_SC = 3584, C_SH = 4096;
constexpr int MIXW = 1536, NEXP = 32, TOPK = 4, FF = 1024;
constexpr float ALPHA = 1.4142135623730951f;
constexpr float LN_EPS = 1e-5f, RMS_EPS = 1e-5f;
constexpr float QSCALE = 0.125f * 1.4426950408889634f;

constexpr size_t MiB = 1u << 20;
constexpr size_t WS_CTL = 0, CTL_ZERO_BYTES = 1 * MiB;
constexpr size_t WS_ROPE = 1 * MiB;
constexpr size_t WS_WDT = 2 * MiB;
constexpr size_t WS_ROUT = 2 * MiB + 65536;
constexpr size_t WS_WIN = 4 * MiB;
constexpr size_t WS_WOUT = 24 * MiB;
constexpr size_t WS_WGU = 32 * MiB;
constexpr size_t WS_WDN = 288 * MiB;
constexpr size_t WS_XB = 416 * MiB;
constexpr size_t WS_XF = 480 * MiB;
constexpr size_t WS_XF2 = 608 * MiB;
constexpr size_t WS_PROJ = 736 * MiB;
constexpr size_t WS_DT = 1024 * MiB;
constexpr size_t WS_DTS = 1025 * MiB;
constexpr size_t WS_ACUM = 1026 * MiB;
constexpr size_t WS_LSE = 1027 * MiB;
constexpr size_t WS_OP = 1030 * MiB;
constexpr size_t WS_U = 1126 * MiB;
constexpr size_t WS_G = 1190 * MiB;
constexpr size_t WS_ST = 1222 * MiB;
constexpr size_t WS_YD = 1286 * MiB;
constexpr size_t WS_MIXED = 1350 * MiB;
constexpr size_t WS_MIXF = 1446 * MiB;
constexpr size_t WS_TOPE = 1574 * MiB;
constexpr size_t WS_TOPG = 1575 * MiB;
constexpr size_t WS_ROWTOK = 1576 * MiB;
constexpr size_t WS_ROWGATE = 1580 * MiB;
constexpr size_t WS_H = 736 * MiB;
constexpr size_t WS_YB = 1030 * MiB;
constexpr size_t WS_END = 1584 * MiB;
constexpr int CW_TMO = 0;
constexpr int CW_CNT = 64;
constexpr int CW_BAR = 4096;

constexpr int RING_OFF = 0, RING_BYTES = 131072;
constexpr int LDSCTL_OFF = 155648;
constexpr int L_MISC = LDSCTL_OFF;
constexpr int L_TSTART = LDSCTL_OFF + 256;
constexpr int L_CNT = LDSCTL_OFF + 512;
constexpr int L_LCNT = LDSCTL_OFF + 640;
constexpr int L_LBASE = LDSCTL_OFF + 768;
constexpr int L_UNITS = LDSCTL_OFF + 1024;
constexpr int L_UNITSN = LDSCTL_OFF + 2048;
constexpr int LDS_BYTES = 163840;

#define GAS __attribute__((address_space(1)))
#define LAS __attribute__((address_space(3)))
typedef unsigned short bf16;
typedef unsigned v4u __attribute__((ext_vector_type(4)));
typedef unsigned v2u __attribute__((ext_vector_type(2)));
typedef float f32x4 __attribute__((ext_vector_type(4)));
typedef float f32x16 __attribute__((ext_vector_type(16)));
typedef short bf16x8 __attribute__((ext_vector_type(8)));
typedef GAS unsigned gu32;
#define RLX_AGENT __ATOMIC_RELAXED, __HIP_MEMORY_SCOPE_AGENT
#define LDS_WAIT() asm volatile("s_waitcnt lgkmcnt(0)" ::: "memory")
#define VM_WAIT() asm volatile("s_waitcnt vmcnt(0)" ::: "memory")
__device__ __forceinline__ unsigned f2bf(float f) { unsigned u = __builtin_bit_cast(unsigned, f); return (u + 0x7fffu + ((u >> 16) & 1u)) >> 16; }
__device__ __forceinline__ unsigned pk2(float lo, float hi) { unsigned r; asm volatile("v_cvt_pk_bf16_f32 %0, %1, %2" : "=v"(r) : "v"(lo), "v"(hi)); return r; }
__device__ __forceinline__ float bf2f(unsigned short b) { return __builtin_bit_cast(float, (unsigned)b << 16); }
__device__ __forceinline__ float bflo(unsigned w) { return __builtin_bit_cast(float, w << 16); }
__device__ __forceinline__ float bfhi(unsigned w) { return __builtin_bit_cast(float, w & 0xffff0000u); }
__device__ __forceinline__ float siluf(float x) { return x * __builtin_amdgcn_rcpf(1.0f + __builtin_amdgcn_exp2f(-1.4426950408889634f * x)); }
#define XB_TMO      128
#define XB_XCNT(j)  (256  + 64 * (j))
#define XB_XSUB(j)  (1280 + 64 * (j))
#define XB_XGEN(j)  (2304 + 64 * (j))
#define XB_TOP      3328
#define XB_TOPGEN   3392
#define XCD_BAR_WORDS 3456
#define XB_SPIN_CAP (1u << 18)

__device__ __forceinline__ unsigned xb_ld(unsigned* p)              { return __hip_atomic_load(p, __ATOMIC_RELAXED, __HIP_MEMORY_SCOPE_AGENT); }
__device__ __forceinline__ unsigned xb_add(unsigned* p, unsigned v) { return __hip_atomic_fetch_add(p, v, __ATOMIC_RELAXED, __HIP_MEMORY_SCOPE_AGENT); }
__device__ __forceinline__ unsigned xb_xcc_id() { return (unsigned)__builtin_amdgcn_s_getreg((3 << 11) | 20) & 0xFu; }
#define XB_SPIN(cond, bar) do { unsigned _sp = 0; while (cond) { __builtin_amdgcn_s_sleep(1); \
    if ((++_sp & 255u) == 0u) { if (xb_ld(&(bar)[XB_TMO])) break; if (_sp > XB_SPIN_CAP) { atomicAdd(&(bar)[XB_TMO], 1u); break; } } } } while (0)

struct XcdBarrier {
    unsigned* bar; unsigned x;
    volatile LAS unsigned* st;
};

__device__ __forceinline__ XcdBarrier xcd_barrier_post(unsigned* bar, volatile LAS unsigned* st) {
    XcdBarrier b; b.bar = bar; b.x = xb_xcc_id(); b.st = st;
    if (threadIdx.x == 0) (void)xb_add(&bar[XB_XCNT(b.x)], 1u);
    return b;
}
__device__ __forceinline__ void xcd_barrier_complete(unsigned* bar, unsigned x, unsigned& nloc, unsigned& nx) {
    const unsigned G = gridDim.x * gridDim.y * gridDim.z;
    unsigned sum, cnt, mine, sp = 0u;
    for (;;) {
        sum = 0u; cnt = 0u; mine = 0u;
#pragma unroll
        for (unsigned j = 0; j < 16; ++j) { const unsigned c = xb_ld(&bar[XB_XCNT(j)]); sum += c; cnt += (c > 0u) ? 1u : 0u; mine = (j == x) ? c : mine; }
        if (sum == G) break;
        __builtin_amdgcn_s_sleep(1);
        if ((++sp & 255u) == 0u) { if (xb_ld(&bar[XB_TMO])) break; if (sp > XB_SPIN_CAP) { atomicAdd(&bar[XB_TMO], 1u); break; } }
    }
    nloc = mine > 0u ? mine : 1u; nx = cnt > 0u ? cnt : 1u;
}

__device__ __forceinline__ void xcd_barrier(const XcdBarrier& b) {
    asm volatile("s_waitcnt vmcnt(0)" ::: "memory");
    __syncthreads();
    if (threadIdx.x == 0) {
        unsigned* bar = b.bar;
        __builtin_amdgcn_s_waitcnt(0);
        unsigned nloc = b.st[0], nx = b.st[1];
        if (nloc == 0u) { xcd_barrier_complete(bar, b.x, nloc, nx); b.st[0] = nloc; b.st[1] = nx; }
        const unsigned old = xb_add(&bar[XB_XSUB(b.x)], 1u);
        const unsigned gen = old / nloc;
        if (old + 1u == (gen + 1u) * nloc) {
            __builtin_amdgcn_fence(__ATOMIC_RELEASE, "agent");
            asm volatile("s_waitcnt vmcnt(0)" ::: "memory");
            const unsigned og = xb_add(&bar[XB_TOP], 1u);
            const unsigned tg = og / nx;
            if (og + 1u == (tg + 1u) * nx) xb_add(&bar[XB_TOPGEN], 1u);
            else XB_SPIN(xb_ld(&bar[XB_TOPGEN]) == tg, bar);
            __builtin_amdgcn_fence(__ATOMIC_ACQUIRE, "agent");
            xb_add(&bar[XB_XGEN(b.x)], 1u);
            asm volatile("s_waitcnt vmcnt(0)" ::: "memory");
        } else {
            XB_SPIN(xb_ld(&bar[XB_XGEN(b.x)]) == gen, bar);
            __builtin_amdgcn_fence(__ATOMIC_ACQUIRE, "agent");
            asm volatile("s_waitcnt vmcnt(0)" ::: "memory");
        }
    }
    __syncthreads();
}

constexpr float SC_X = 4.f, SC_WGU = 32.f, SC_H = 4.f, SC_WDN = 64.f, SC_Y = 16.f;
__device__ __forceinline__ float wave_sum(float v) {
#pragma unroll
    for (int o = 1; o < 64; o <<= 1) v += __shfl_xor(v, o);
    return v;
}
__device__ __forceinline__ int win_dest_row(int n) {
    if (n < 1024) { const int hh = n >> 6, d = n & 63; const int p = (d < 32) ? (8 * (d >> 2) + (d & 3)) : (8 * ((d - 32) >> 2) + 4 + (d & 3)); return hh * 64 + p; }
    if (n < 3072) return n;
    if (n < 3080) return -1;
    return n - 8;
}
__device__ __forceinline__ int wgu_dest_row(int n) { return n < 1024 ? ((n >> 7) * 256 + (n & 127)) : (((n - 1024) >> 7) * 256 + 128 + ((n - 1024) & 127)); }
template <int MAP>
__device__ __forceinline__ void p0_transpose_item(const float* W, int K, int N, bf16* WT, float* wdt, LAS float* scr, int kb, int nb, int lane) {
    const int k0 = 64 * kb, n0 = 32 * nb;
    const int nn = n0 + (lane & 31); const bool nok = nn < N;
#pragma unroll 8
    for (int i = 0; i < 32; ++i) { const int kk = 2 * i + (lane >> 5); scr[kk * 33 + (lane & 31)] = nok ? W[(size_t)(k0 + kk) * N + nn] : 0.f; }
    LDS_WAIT(); asm volatile("" ::: "memory");
    const int c = lane & 7;
#pragma unroll
    for (int j = 0; j < 4; ++j) { const int n = (lane >> 3) + 8 * j; const LAS float* s = scr + (8 * c) * 33 + n;
        const int nsrc = n0 + n; if (nsrc >= N) continue;
        int drow = nsrc; if (MAP == 1) drow = win_dest_row(nsrc); if (MAP == 2) drow = wgu_dest_row(nsrc);
        if (MAP == 1 && drow < 0) { float* d = wdt + (size_t)(nsrc - 3072) * 1024 + k0 + 8 * c;
#pragma unroll
            for (int q = 0; q < 8; ++q) d[q] = s[q * 33]; continue; }
        v4u o; o.x = pk2(s[0 * 33], s[1 * 33]); o.y = pk2(s[2 * 33], s[3 * 33]); o.z = pk2(s[4 * 33], s[5 * 33]); o.w = pk2(s[6 * 33], s[7 * 33]);
        *(GAS v4u*)(WT + (size_t)drow * K + k0 + 8 * c) = o; }
    LDS_WAIT(); asm volatile("" ::: "memory");
}
template <int MAP>
__device__ __forceinline__ void p0_transpose_item64(const float* W, int K, int N, bf16* WT, float* wdt, LAS float* scr, int kb, int nb, int lane) {
    const int k0 = 64 * kb, n0 = 64 * nb;
    const bool lok = (n0 + 4 * (lane & 15) + 3) < N;
    f32x4 ld[16];
#pragma unroll
    for (int i = 0; i < 16; ++i) ld[i] = lok ? *(const f32x4*)(W + (size_t)(k0 + 4 * i + (lane >> 4)) * N + n0 + 4 * (lane & 15)) : (f32x4){0.f, 0.f, 0.f, 0.f};
#pragma unroll
    for (int i = 0; i < 16; ++i) *(LAS f32x4*)(scr + (4 * i + (lane >> 4)) * 64 + 4 * (lane & 15)) = ld[i];
    LDS_WAIT(); asm volatile("" ::: "memory");
    const int nsrc = n0 + lane;
    if (nsrc < N) {
        int drow = nsrc; if (MAP == 1) drow = win_dest_row(nsrc);
        if (MAP == 1 && drow < 0) { float* d = wdt + (size_t)(nsrc - 3072) * 1024 + k0;
#pragma unroll
            for (int q = 0; q < 16; ++q) *(f32x4*)(d + 4 * q) = (f32x4){scr[(4 * q) * 64 + lane], scr[(4 * q + 1) * 64 + lane], scr[(4 * q + 2) * 64 + lane], scr[(4 * q + 3) * 64 + lane]}; }
        else { GAS v4u* d = (GAS v4u*)(WT + (size_t)drow * K + k0);
#pragma unroll
            for (int q = 0; q < 8; ++q) { v4u o; o.x = pk2(scr[(8 * q) * 64 + lane], scr[(8 * q + 1) * 64 + lane]); o.y = pk2(scr[(8 * q + 2) * 64 + lane], scr[(8 * q + 3) * 64 + lane]);
                o.z = pk2(scr[(8 * q + 4) * 64 + lane], scr[(8 * q + 5) * 64 + lane]); o.w = pk2(scr[(8 * q + 6) * 64 + lane], scr[(8 * q + 7) * 64 + lane]); d[q] = o; } } }
    LDS_WAIT(); asm volatile("" ::: "memory");
}
struct SubT { const float* src; unsigned char* dst; int N; int dmap; float scale; };
__device__ __forceinline__ SubT fp8_subtile(int item, int half, const float* wgu, const float* wdn, unsigned char* WG8, unsigned char* WD8, int lane) {
    SubT t; int kb, nb, n0;
    if (item < 64 * 256) { const int le = item >> 8, r = item & 255; kb = r >> 5; nb = r & 31; n0 = 64 * nb; t.N = 2048; t.dmap = 1; t.scale = SC_WGU;
        t.src = wgu + (size_t)le * 1024 * 2048; t.dst = WG8 + (size_t)le * 2048 * 1024; }
    else { const int it2 = item - 64 * 256; const int le = it2 >> 7, r = it2 & 127; kb = r >> 4; nb = r & 15; n0 = 64 * nb; t.N = 1024; t.dmap = 0; t.scale = SC_WDN;
        t.src = wdn + (size_t)le * 1024 * 1024; t.dst = WD8 + (size_t)le * 1024 * 1024; }
    const int k0 = 128 * kb + 64 * half;
    t.src += (size_t)(k0 + (lane >> 4)) * t.N + n0 + 4 * (lane & 15);
    t.dst += (size_t)k0; t.dmap = t.dmap ? -(n0 + 1) : n0;
    return t;
}
__device__ __forceinline__ void fp8_sub_load(const SubT& t, f32x4 (&ld)[16]) {
#pragma unroll
    for (int i = 0; i < 16; ++i) ld[i] = __builtin_nontemporal_load((const f32x4*)(t.src + (size_t)(4 * i) * t.N));
}
__device__ __forceinline__ void fp8_sub_process(const SubT& t, const f32x4 (&ld)[16], LAS float* scr, int lane) {
#pragma unroll
    for (int i = 0; i < 16; ++i) *(LAS f32x4*)(scr + (4 * i + (lane >> 4)) * 64 + 4 * (lane & 15)) = ld[i];
    LDS_WAIT(); asm volatile("" ::: "memory");
    unsigned w[16];
#pragma unroll
    for (int q = 0; q < 16; ++q) w[q] = pg8::pk4_fp8(scr[(4 * q + 0) * 64 + lane] * t.scale, scr[(4 * q + 1) * 64 + lane] * t.scale, scr[(4 * q + 2) * 64 + lane] * t.scale, scr[(4 * q + 3) * 64 + lane] * t.scale);
    LDS_WAIT(); asm volatile("" ::: "memory");
    LAS unsigned char* t2 = (LAS unsigned char*)scr;
#pragma unroll
    for (int q = 0; q < 4; ++q) *(LAS v4u*)(t2 + lane * 80 + 16 * q) = (v4u){w[4 * q], w[4 * q + 1], w[4 * q + 2], w[4 * q + 3]};
    LDS_WAIT(); asm volatile("" ::: "memory");
#pragma unroll
    for (int q = 0; q < 4; ++q) { const int n = 16 * q + (lane >> 2); const v4u v = *(const LAS v4u*)(t2 + n * 80 + 16 * (lane & 3));
        const int nn = (t.dmap < 0) ? wgu_dest_row(-t.dmap - 1 + n) : (t.dmap + n);
        *(GAS v4u*)(t.dst + (size_t)nn * 1024 + 16 * (lane & 3)) = v; }
    LDS_WAIT(); asm volatile("" ::: "memory");
}
__device__ __forceinline__ void row_dt(const f32x4 (&v)[4], const float* wdt, float* dst, int lane) {
    float r[8];
#pragma unroll
    for (int jj = 0; jj < 8; ++jj) { float s = 0.f;
#pragma unroll
        for (int j = 0; j < 4; ++j) { const f32x4 w = *(const f32x4*)(wdt + jj * 1024 + 4 * lane + 256 * j); s += v[j][0] * w[0] + v[j][1] * w[1] + v[j][2] * w[2] + v[j][3] * w[3]; }
        r[jj] = wave_sum(s); }
    if (lane == 0) { *(f32x4*)dst = (f32x4){r[0], r[1], r[2], r[3]}; *(f32x4*)(dst + 4) = (f32x4){r[4], r[5], r[6], r[7]}; }
}
__device__ __forceinline__ void row_dt_win(const f32x4 (&v)[4], const float* win, float* dst, int lane) {
    float r[8];
#pragma unroll
    for (int jj = 0; jj < 8; ++jj) r[jj] = 0.f;
#pragma unroll
    for (int j = 0; j < 4; ++j)
#pragma unroll
        for (int e = 0; e < 4; ++e) { const float* wp = win + (size_t)(4 * lane + 256 * j + e) * INW + 3072; const f32x4 w0 = *(const f32x4*)wp, w1 = *(const f32x4*)(wp + 4); const float x = v[j][e];
            r[0] += x * w0[0]; r[1] += x * w0[1]; r[2] += x * w0[2]; r[3] += x * w0[3]; r[4] += x * w1[0]; r[5] += x * w1[1]; r[6] += x * w1[2]; r[7] += x * w1[3]; }
#pragma unroll
    for (int jj = 0; jj < 8; ++jj) r[jj] = wave_sum(r[jj]);
    if (lane == 0) { *(f32x4*)dst = (f32x4){r[0], r[1], r[2], r[3]}; *(f32x4*)(dst + 4) = (f32x4){r[4], r[5], r[6], r[7]}; }
}
template <bool W8, bool WF>
__device__ __forceinline__ void ln_row(f32x4 (&v)[4], const float* gam, const float* bet, float* of32, bf16* ob16, unsigned char* o8, float s8, int lane) {
    float s = 0.f;
#pragma unroll
    for (int j = 0; j < 4; ++j) s += (v[j][0] + v[j][1]) + (v[j][2] + v[j][3]);
    const float mean = wave_sum(s) * (1.f / DM); float s2 = 0.f;
#pragma unroll
    for (int j = 0; j < 4; ++j) { v[j] = v[j] - mean; s2 += (v[j][0] * v[j][0] + v[j][1] * v[j][1]) + (v[j][2] * v[j][2] + v[j][3] * v[j][3]); }
    const float rstd = 1.f / sqrtf(wave_sum(s2) * (1.f / DM) + LN_EPS);
#pragma unroll
    for (int j = 0; j < 4; ++j) { const f32x4 g = *(const f32x4*)(gam + 4 * lane + 256 * j), b = *(const f32x4*)(bet + 4 * lane + 256 * j);
        v[j] = v[j] * rstd * g + b;
        if (WF) *(f32x4*)(of32 + 4 * lane + 256 * j) = v[j];
        v2u w; w.x = pk2(v[j][0], v[j][1]); w.y = pk2(v[j][2], v[j][3]); *(v2u*)(ob16 + 4 * lane + 256 * j) = w;
        if (W8) *(unsigned*)(o8 + 4 * lane + 256 * j) = pg8::pk4_fp8(v[j][0] * s8, v[j][1] * s8, v[j][2] * s8, v[j][3] * s8); }
}


typedef short v4i16_t __attribute__((ext_vector_type(4)));
__device__ __forceinline__ bf16x8 tr_pair(const LAS unsigned char* p0, const LAS unsigned char* p1) {
    const v4i16_t a = __builtin_amdgcn_ds_read_tr16_b64_v4i16((LAS v4i16_t*)p0), b = __builtin_amdgcn_ds_read_tr16_b64_v4i16((LAS v4i16_t*)p1);
    return (bf16x8){a[0], a[1], a[2], a[3], b[0], b[1], b[2], b[3]};
}
__device__ __forceinline__ int crow16(int r, int hi) { return (r & 3) + 8 * (r >> 2) + 4 * hi; }
constexpr int AK_PITCH = 144, AV_PITCH = 192, AK_TILE = 32 * AK_PITCH, AV_TILE = 32 * AV_PITCH;
constexpr int AT_K = 0, AT_V = 12 * AK_TILE;
struct AttnItem { int p, b, h, d, r, qt0; };
__device__ __forceinline__ AttnItem attn_item(int I) { AttnItem a; a.p = I >> 10; const int rem = I & 1023; a.b = rem >> 7; a.h = (rem >> 4) & 7; const int grp = rem & 15;
    a.d = (a.p == 0) ? 1 : (a.p == 1) ? 4 : 16; const int tpr = 128 / a.d; const int T = grp * 8; a.r = T / tpr; a.qt0 = T % tpr; return a; }
__device__ __forceinline__ void attn_request(const bf16* PROJ, const AttnItem& a, v4u (&st)[12], int tid) {
    const int rr = tid >> 4, ch = tid & 15; const int col = (ch < 8 ? C_K : C_V - 64) + a.h * 64 + ch * 8;
#pragma unroll
    for (int tl = 0; tl < 12; ++tl) { const int kt = a.qt0 - 4 + tl; st[tl] = (v4u){0u, 0u, 0u, 0u};
        if (kt >= 0) { const size_t row = (size_t)a.b * SEQ + (size_t)(32 * kt + rr) * a.d + a.r; st[tl] = *(const v4u*)(PROJ + row * NPROJ + col); } }
}
__device__ __forceinline__ void attn_deposit(LAS unsigned char* al, const v4u (&st)[12], int tid) {
    const int rr = tid >> 4, ch = tid & 15;
    LAS unsigned char* dst = (ch < 8) ? (al + AT_K + rr * AK_PITCH + ch * 16) : (al + AT_V + rr * AV_PITCH + (ch - 8) * 16); const int tstep = (ch < 8) ? AK_TILE : AV_TILE;
#pragma unroll
    for (int tl = 0; tl < 12; ++tl) *(LAS v4u*)(dst + tl * tstep) = st[tl];
}
__device__ __forceinline__ void attn_wave_compute(const bf16* PROJ, bf16* OPp, float* LSEp, const AttnItem& a, const LAS unsigned char* al, int wave, int lane) {
    const int i = lane & 31, h2 = lane >> 5; const int qt = a.qt0 + wave;
    const size_t rowq = (size_t)a.b * SEQ + (size_t)(32 * qt + i) * a.d + a.r;
    bf16x8 qf[4];
    { const bf16* qp = PROJ + rowq * NPROJ + C_Q + a.h * 64 + 8 * h2;
#pragma unroll
      for (int s = 0; s < 4; ++s) qf[s] = *(const bf16x8*)(qp + 16 * s); }
    f32x16 o0 = {}, o1 = {}; float mrun = -INFINITY, lrun = 0.f;
    const int kt0 = qt > 4 ? qt - 4 : 0;
    const LAS unsigned char* krd = al + AT_K + i * AK_PITCH + 16 * h2;
    const LAS unsigned char* trb = al + AT_V + (4 * h2 + ((lane & 15) >> 2)) * AV_PITCH + (16 * ((lane >> 4) & 1) + 4 * (lane & 3)) * 2;
#pragma unroll 1
    for (int kt = kt0; kt <= qt; ++kt) {
        const int tl = kt - a.qt0 + 4;
        const LAS unsigned char* kp = krd + tl * AK_TILE; const LAS unsigned char* vp = trb + tl * AV_TILE;
        f32x16 sacc = {};
#pragma unroll
        for (int s = 0; s < 4; ++s) sacc = __builtin_amdgcn_mfma_f32_32x32x16_bf16(*(const LAS bf16x8*)(kp + 32 * s), qf[s], sacc, 0, 0, 0);
        if (kt == qt) {
#pragma unroll
            for (int rg = 0; rg < 16; ++rg) if (crow16(rg, h2) > i) sacc[rg] = -INFINITY;
        }
        if (kt + 4 == qt) {
#pragma unroll
            for (int rg = 0; rg < 16; ++rg) if (crow16(rg, h2) < i) sacc[rg] = -INFINITY;
        }
        float mx = sacc[0];
#pragma unroll
        for (int rg = 1; rg < 16; ++rg) mx = fmaxf(mx, sacc[rg]);
        mx = fmaxf(mx, __shfl_xor(mx, 32));
        const float mnew = fmaxf(mrun, mx), alpha = __builtin_amdgcn_exp2f(mrun - mnew); mrun = mnew;
        float ps = 0.f;
#pragma unroll
        for (int rg = 0; rg < 16; ++rg) { sacc[rg] = __builtin_amdgcn_exp2f(sacc[rg] - mnew); ps += sacc[rg]; }
        lrun = lrun * alpha + ps;
#pragma unroll
        for (int rg = 0; rg < 16; ++rg) { o0[rg] *= alpha; o1[rg] *= alpha; }
        bf16x8 pf[2];
#pragma unroll
        for (int ks = 0; ks < 2; ++ks) { v4u w; w.x = pg8::cvt_pk_bf16(sacc[8 * ks + 0], sacc[8 * ks + 1]); w.y = pg8::cvt_pk_bf16(sacc[8 * ks + 2], sacc[8 * ks + 3]); w.z = pg8::cvt_pk_bf16(sacc[8 * ks + 4], sacc[8 * ks + 5]); w.w = pg8::cvt_pk_bf16(sacc[8 * ks + 6], sacc[8 * ks + 7]); pf[ks] = __builtin_bit_cast(bf16x8, w); }
#pragma unroll
        for (int ks = 0; ks < 2; ++ks) {
            const bf16x8 v0 = tr_pair(vp + (16 * ks) * AV_PITCH, vp + (16 * ks + 8) * AV_PITCH);
            const bf16x8 v1 = tr_pair(vp + (16 * ks) * AV_PITCH + 64, vp + (16 * ks + 8) * AV_PITCH + 64);
            o0 = __builtin_amdgcn_mfma_f32_32x32x16_bf16(v0, pf[ks], o0, 0, 0, 0);
            o1 = __builtin_amdgcn_mfma_f32_32x32x16_bf16(v1, pf[ks], o1, 0, 0, 0);
        }
    }
    const float lt = lrun + __shfl_xor(lrun, 32); const float il = 1.0f / lt;
    bf16* op = OPp + rowq * 512 + a.h * 64 + 4 * h2;
#pragma unroll
    for (int g4 = 0; g4 < 4; ++g4) {
        v2u w0, w1; w0.x = pg8::cvt_pk_bf16(o0[4 * g4 + 0] * il, o0[4 * g4 + 1] * il); w0.y = pg8::cvt_pk_bf16(o0[4 * g4 + 2] * il, o0[4 * g4 + 3] * il);
        w1.x = pg8::cvt_pk_bf16(o1[4 * g4 + 0] * il, o1[4 * g4 + 1] * il); w1.y = pg8::cvt_pk_bf16(o1[4 * g4 + 2] * il, o1[4 * g4 + 3] * il);
        *(v2u*)(op + 8 * g4) = w0; *(v2u*)(op + 32 + 8 * g4) = w1; }
    if (h2 == 0) LSEp[rowq * 8 + a.h] = mrun + log2f(lt);
}
__device__ __forceinline__ void attn_phase(LAS unsigned char* al, const bf16* PROJ, bf16* OP, float* LSE, int bid, int G, int tid, int wave, int lane) {
    v4u st[12];
    int I = bid;
    if (I < 3072) { const AttnItem a = attn_item(I); attn_request(PROJ, a, st, tid); }
    for (; I < 3072; I += G) {
        const AttnItem a = attn_item(I);
        __syncthreads();
        attn_deposit(al, st, tid);
        __syncthreads();
        if (I + G < 3072) { const AttnItem n = attn_item(I + G); attn_request(PROJ, n, st, tid); }
        attn_wave_compute(PROJ, OP + (size_t)a.p * MROWS * 512, LSE + (size_t)a.p * MROWS * 8, a, al, wave, lane);
    }
    __syncthreads();
}

constexpr int SS_DTS = 0, SS_ACUM = 2048, SS_TMP = 4096, SS_SSX = 6144, SS_IMG = 8192;
constexpr int S1_PB = 320, S1_PX = 576;
constexpr int S1_B = SS_IMG, S1_X = SS_IMG + 128 * S1_PB;
constexpr int S3_PBC = 272, S3_PX = 576;
constexpr int S3_B = SS_IMG, S3_C = S3_B + 128 * S3_PBC, S3_X = S3_C + 128 * S3_PBC;

__device__ __forceinline__ void ssd_prep(LAS unsigned char* sl, const float* DT, const float* dtb, const float* alog, size_t row0, int g, int tid, int lane, int wave) {
    LAS float* dts = (LAS float*)(sl + SS_DTS); LAS float* acum = (LAS float*)(sl + SS_ACUM); LAS float* tmp = (LAS float*)(sl + SS_TMP);
    { const int l = tid >> 2, hq = tid & 3; const float x = DT[(row0 + l) * 8 + 4 * g + hq] + dtb[4 * g + hq];
      const float dt = x > 20.f ? x : log1pf(__expf(x)); dts[hq * 128 + l] = dt; tmp[hq * 128 + l] = dt * (-__expf(alog[4 * g + hq])); }
    __syncthreads();
    if (wave < 4) { const float v0 = tmp[wave * 128 + 2 * lane], v1 = tmp[wave * 128 + 2 * lane + 1]; float s = v0 + v1;
#pragma unroll
        for (int off = 1; off < 64; off <<= 1) { const float t = __shfl_up(s, off); if (lane >= off) s += t; }
        acum[wave * 128 + 2 * lane] = s - v1; acum[wave * 128 + 2 * lane + 1] = s; }
    __syncthreads();
}
template <int NCOLS, int FACMODE>
__device__ __forceinline__ void conv_tile(const bf16* PROJ, size_t row0, int t0, int pcol0, const float* cw, const float* cb, int cch0, LAS unsigned char* dst, int pitch, const LAS unsigned char* sl, int hq0, int tid) {
    constexpr int NCH8 = NCOLS / 8, NSEG = 512 / NCH8, RPS = 128 / NSEG;
    const int c8 = tid % NCH8, seg = tid / NCH8, l0 = seg * RPS;
    float w[4][8], bias[8], hst[3][8];
#pragma unroll
    for (int k = 0; k < 4; ++k) { const f32x4 a = *(const f32x4*)(cw + k * 1024 + cch0 + c8 * 8), b = *(const f32x4*)(cw + k * 1024 + cch0 + c8 * 8 + 4);
        w[k][0] = a[0]; w[k][1] = a[1]; w[k][2] = a[2]; w[k][3] = a[3]; w[k][4] = b[0]; w[k][5] = b[1]; w[k][6] = b[2]; w[k][7] = b[3]; }
    { const f32x4 a = *(const f32x4*)(cb + cch0 + c8 * 8), b = *(const f32x4*)(cb + cch0 + c8 * 8 + 4);
      bias[0] = a[0]; bias[1] = a[1]; bias[2] = a[2]; bias[3] = a[3]; bias[4] = b[0]; bias[5] = b[1]; bias[6] = b[2]; bias[7] = b[3]; }
    const bf16* src = PROJ + pcol0 + c8 * 8;
#pragma unroll
    for (int k = 0; k < 3; ++k) { const int l = l0 - 3 + k; v4u v = (v4u){0u, 0u, 0u, 0u}; if (t0 + l >= 0) v = *(const v4u*)(src + (size_t)((long)row0 + l) * NPROJ);
        hst[k][0] = bflo(v.x); hst[k][1] = bfhi(v.x); hst[k][2] = bflo(v.y); hst[k][3] = bfhi(v.y); hst[k][4] = bflo(v.z); hst[k][5] = bfhi(v.z); hst[k][6] = bflo(v.w); hst[k][7] = bfhi(v.w); }
    const LAS float* dts = (const LAS float*)(sl + SS_DTS); const LAS float* acum = (const LAS float*)(sl + SS_ACUM);
    const int hq = hq0 + (c8 * 8) / 64;
    const float alast = (FACMODE == 2) ? acum[hq * 128 + 127] : 0.f;
#pragma unroll
    for (int rr = 0; rr < RPS; ++rr) { const int l = l0 + rr; const v4u v = *(const v4u*)(src + (row0 + l) * NPROJ);
        float cur[8]; cur[0] = bflo(v.x); cur[1] = bfhi(v.x); cur[2] = bflo(v.y); cur[3] = bfhi(v.y); cur[4] = bflo(v.z); cur[5] = bfhi(v.z); cur[6] = bflo(v.w); cur[7] = bfhi(v.w);
        float f = 1.f; if (FACMODE >= 1) f = dts[hq * 128 + l]; if (FACMODE == 2) f *= __expf(alast - acum[hq * 128 + l]);
        float o[8];
#pragma unroll
        for (int e = 0; e < 8; ++e) { const float a = bias[e] + w[0][e] * hst[0][e] + w[1][e] * hst[1][e] + w[2][e] * hst[2][e] + w[3][e] * cur[e]; o[e] = siluf(a) * f;
            hst[0][e] = hst[1][e]; hst[1][e] = hst[2][e]; hst[2][e] = cur[e]; }
        v4u ov; ov.x = pk2(o[0], o[1]); ov.y = pk2(o[2], o[3]); ov.z = pk2(o[4], o[5]); ov.w = pk2(o[6], o[7]);
        *(LAS v4u*)(dst + l * pitch + c8 * 16) = ov; }
}
__device__ __forceinline__ void ssd_s1_unit(LAS unsigned char* sl, const bf16* PROJ, const float* DT, const float* dtb, const float* alog, const float* cw, const float* cb, float* ST, float* CDEC, int un, int tid, int lane, int wave) {
    const int g = un & 1, bc = un >> 1; const size_t row0 = (size_t)bc * 128; const int t0 = (bc & 31) * 128;
    __syncthreads();
    ssd_prep(sl, DT, dtb, alog, row0, g, tid, lane, wave);
    conv_tile<128, 0>(PROJ, row0, t0, C_XS + 512 + g * 128, cw, cb, 512 + g * 128, sl + S1_B, S1_PB, sl, 0, tid);
    conv_tile<256, 2>(PROJ, row0, t0, C_XS + g * 256, cw, cb, g * 256, sl + S1_X, S1_PX, sl, 0, tid);
    if (tid < 4) CDEC[(size_t)bc * 8 + 4 * g + tid] = __expf(((const LAS float*)(sl + SS_ACUM))[tid * 128 + 127]);
    __syncthreads();
    const int hq = wave >> 1, pt = wave & 1, h2 = lane >> 5, q = (lane & 15) >> 2, pp = lane & 3, dsel = (lane >> 4) & 1;
    const LAS unsigned char* xb = sl + S1_X + (8 * h2 + q) * S1_PX + (hq * 64 + pt * 32 + 16 * dsel + 4 * pp) * 2;
    const LAS unsigned char* bb = sl + S1_B + (8 * h2 + q) * S1_PB + (16 * dsel + 4 * pp) * 2;
    f32x16 acc[4];
#pragma unroll
    for (int nt = 0; nt < 4; ++nt) acc[nt] = (f32x16){};
#pragma unroll
    for (int ks = 0; ks < 8; ++ks) { const bf16x8 a = tr_pair(xb + (16 * ks) * S1_PX, xb + (16 * ks + 4) * S1_PX);
#pragma unroll
        for (int nt = 0; nt < 4; ++nt) { const bf16x8 b = tr_pair(bb + (16 * ks) * S1_PB + nt * 64, bb + (16 * ks + 4) * S1_PB + nt * 64); acc[nt] = __builtin_amdgcn_mfma_f32_32x32x16_bf16(a, b, acc[nt], 0, 0, 0); } }
    float* sp = ST + ((size_t)(bc * 8 + 4 * g + hq) * 64 + pt * 32) * 128 + (lane & 31);
#pragma unroll
    for (int nt = 0; nt < 4; ++nt)
#pragma unroll
        for (int rg = 0; rg < 16; ++rg) sp[(size_t)crow16(rg, h2) * 128 + 32 * nt] = acc[nt][rg];
}
__device__ __forceinline__ void ssd_s3_unit(LAS unsigned char* sl, const bf16* PROJ, const float* DT, const float* dtb, const float* alog, const float* cw, const float* cb, const float* dsk, const float* ng,
                                            const bf16* HIN, bf16* MIXED, int un, int tid, int lane, int wave) {
    const int g = un & 1, bc = un >> 1; const size_t row0 = (size_t)bc * 128; const int t0 = (bc & 31) * 128;
    const int lt = wave & 3, ph = wave >> 2, lq = lane & 31, hi = lane >> 5, q = (lane & 15) >> 2, pp = lane & 3, dsel = (lane >> 4) & 1;
    const int lrow = 32 * lt + lq;
    const size_t grow = row0 + lrow;
    __syncthreads();
    ssd_prep(sl, DT, dtb, alog, row0, g, tid, lane, wave);
    conv_tile<128, 0>(PROJ, row0, t0, C_XS + 512 + g * 128, cw, cb, 512 + g * 128, sl + S3_B, S3_PBC, sl, 0, tid);
    conv_tile<128, 0>(PROJ, row0, t0, C_XS + 768 + g * 128, cw, cb, 768 + g * 128, sl + S3_C, S3_PBC, sl, 0, tid);
    conv_tile<256, 1>(PROJ, row0, t0, C_XS + g * 256, cw, cb, g * 256, sl + S3_X, S3_PX, sl, 0, tid);
    __syncthreads();
    const LAS float* dts = (const LAS float*)(sl + SS_DTS); const LAS float* acum = (const LAS float*)(sl + SS_ACUM); LAS float* ssx = (LAS float*)(sl + SS_SSX);
    const LAS unsigned char* crd = sl + S3_C + lrow * S3_PBC + 16 * hi;
    f32x16 y[4];
    { bf16x8 hfa[8], hfb[8];
      const bf16* hp0 = HIN + ((size_t)(bc * 8 + 4 * g) * 64 + ph * 32 + lq) * 128 + 8 * hi;
#pragma unroll
      for (int ks = 0; ks < 8; ++ks) hfa[ks] = *(const bf16x8*)(hp0 + 16 * ks);
#pragma unroll
      for (int hq = 0; hq < 4; ++hq) {
          if (hq < 3) {
#pragma unroll
              for (int ks = 0; ks < 8; ++ks) { const bf16x8 v = *(const bf16x8*)(hp0 + (size_t)(hq + 1) * 8192 + 16 * ks); if (hq & 1) hfa[ks] = v; else hfb[ks] = v; } }
          f32x16 t = (f32x16){};
#pragma unroll
          for (int ks = 0; ks < 8; ++ks) t = __builtin_amdgcn_mfma_f32_32x32x16_bf16((hq & 1) ? hfb[ks] : hfa[ks], *(const LAS bf16x8*)(crd + 32 * ks), t, 0, 0, 0);
          const float ea = __expf(acum[hq * 128 + lrow]);
#pragma unroll
          for (int rg = 0; rg < 16; ++rg) t[rg] *= ea;
          y[hq] = t; } }
    v2u zr[4][4];
#pragma unroll
    for (int hq = 0; hq < 4; ++hq)
#pragma unroll
        for (int g4 = 0; g4 < 4; ++g4) zr[hq][g4] = *(const v2u*)(PROJ + grow * NPROJ + C_Z + g * 256 + hq * 64 + ph * 32 + 8 * g4 + 4 * hi);
#pragma unroll
    for (int st = 0; st < 4; ++st) if (st <= lt) {
        f32x16 ag = (f32x16){};
        { const LAS unsigned char* brd = sl + S3_B + (32 * st + lq) * S3_PBC + 16 * hi;
#pragma unroll
          for (int ks = 0; ks < 8; ++ks) ag = __builtin_amdgcn_mfma_f32_32x32x16_bf16(*(const LAS bf16x8*)(brd + 32 * ks), *(const LAS bf16x8*)(crd + 32 * ks), ag, 0, 0, 0); }
#pragma unroll
        for (int hq = 0; hq < 4; ++hq) {
            const float al = acum[hq * 128 + lrow], dd = dsk[4 * g + hq] / dts[hq * 128 + lrow];
            const LAS unsigned char* xb = sl + S3_X + (4 * hi + q) * S3_PX + (hq * 64 + ph * 32 + 16 * dsel + 4 * pp) * 2;
            float pm[16];
#pragma unroll
            for (int g4 = 0; g4 < 4; ++g4) { const f32x4 as4 = *(const LAS f32x4*)(acum + hq * 128 + 32 * st + 8 * g4 + 4 * hi);
#pragma unroll
                for (int e = 0; e < 4; ++e) { const int rg = 4 * g4 + e; float v = ag[rg] * __expf(al - as4[e]);
                    if (st == lt) { const int sl_ = 8 * g4 + 4 * hi + e; if (sl_ > lq) v = 0.f; if (sl_ == lq) v += dd; }
                    pm[rg] = v; } }
#pragma unroll
            for (int ks = 0; ks < 2; ++ks) { v4u wv; wv.x = pg8::cvt_pk_bf16(pm[8 * ks + 0], pm[8 * ks + 1]); wv.y = pg8::cvt_pk_bf16(pm[8 * ks + 2], pm[8 * ks + 3]); wv.z = pg8::cvt_pk_bf16(pm[8 * ks + 4], pm[8 * ks + 5]); wv.w = pg8::cvt_pk_bf16(pm[8 * ks + 6], pm[8 * ks + 7]);
                const bf16x8 xt = tr_pair(xb + (32 * st + 16 * ks) * S3_PX, xb + (32 * st + 16 * ks + 8) * S3_PX);
                y[hq] = __builtin_amdgcn_mfma_f32_32x32x16_bf16(xt, __builtin_bit_cast(bf16x8, wv), y[hq], 0, 0, 0); }
        }
    }
    unsigned ayp[4][8]; float ss = 0.f;
#pragma unroll
    for (int hq = 0; hq < 4; ++hq)
#pragma unroll
        for (int g4 = 0; g4 < 4; ++g4) { const v2u z = zr[hq][g4];
            const float y0 = y[hq][4 * g4 + 0] * siluf(bflo(z.x)), y1 = y[hq][4 * g4 + 1] * siluf(bfhi(z.x)), y2 = y[hq][4 * g4 + 2] * siluf(bflo(z.y)), y3 = y[hq][4 * g4 + 3] * siluf(bfhi(z.y));
            ss += (y0 * y0 + y1 * y1) + (y2 * y2 + y3 * y3);
            ayp[hq][2 * g4] = pg8::cvt_pk_bf16(y0, y1); ayp[hq][2 * g4 + 1] = pg8::cvt_pk_bf16(y2, y3); }
    ss += __shfl_xor(ss, 32);
    if (hi == 0) ssx[ph * 128 + lrow] = ss;
    __syncthreads();
    const float rs = 1.0f / sqrtf((ssx[lrow] + ssx[128 + lrow]) * (1.f / 256.f) + RMS_EPS);
#pragma unroll
    for (int hq = 0; hq < 4; ++hq)
#pragma unroll
        for (int g4 = 0; g4 < 4; ++g4) { const int ch = hq * 64 + ph * 32 + 8 * g4 + 4 * hi; const f32x4 gn = *(const f32x4*)(ng + g * 256 + ch);
            const unsigned p0 = ayp[hq][2 * g4], p1 = ayp[hq][2 * g4 + 1];
            v2u o; o.x = pg8::cvt_pk_bf16(bflo(p0) * rs * gn[0], bfhi(p0) * rs * gn[1]); o.y = pg8::cvt_pk_bf16(bflo(p1) * rs * gn[2], bfhi(p1) * rs * gn[3]);
            *(v2u*)(MIXED + grow * MIXW + 512 + g * 256 + ch) = o; }
}

struct Args { const float* in[20]; float* out; unsigned char* ws; int ph_lo, ph_hi, sub, pad; };
constexpr int NWAVES = 8;
constexpr int PH_PER_LAYER = 10, N_PHASES = 1 + NLAYER * PH_PER_LAYER;

#define in_x (args.in[0])
#define in_win (args.in[1])
#define in_convw (args.in[2])
#define in_convb (args.in[3])
#define in_dtb (args.in[4])
#define in_alog (args.in[5])
#define in_dsk (args.in[6])
#define in_ng (args.in[7])
#define in_scw (args.in[8])
#define in_wout (args.in[9])
#define in_ln1g (args.in[10])
#define in_ln1b (args.in[11])
#define in_rw (args.in[12])
#define in_rb (args.in[13])
#define in_wgu (args.in[14])
#define in_bgu (args.in[15])
#define in_wdn (args.in[16])
#define in_bdn (args.in[17])
#define in_ln2g (args.in[18])
#define in_ln2b (args.in[19])
#define ROPE ((float*)(args.ws + WS_ROPE))
#define WDT ((float*)(args.ws + WS_WDT))
#define ROUT ((bf16*)(args.ws + WS_ROUT))
#define WIN ((bf16*)(args.ws + WS_WIN))
#define WOUT ((bf16*)(args.ws + WS_WOUT))
#define WGU ((bf16*)(args.ws + WS_WGU))
#define WDN ((bf16*)(args.ws + WS_WDN))
#define XB ((bf16*)(args.ws + WS_XB))
#define XF ((float*)(args.ws + WS_XF))
#define XF2 ((float*)(args.ws + WS_XF2))
#define PROJ ((bf16*)(args.ws + WS_PROJ))
#define DT ((float*)(args.ws + WS_DT))
#define DTS ((float*)(args.ws + WS_DTS))
#define ACUM ((float*)(args.ws + WS_ACUM))
#define LSE ((float*)(args.ws + WS_LSE))
#define OP ((bf16*)(args.ws + WS_OP))
#define U ((bf16*)(args.ws + WS_U))
#define GB ((float*)(args.ws + WS_G))
#define ST ((float*)(args.ws + WS_ST))
#define YD ((float*)(args.ws + WS_YD))
#define MIXED ((bf16*)(args.ws + WS_MIXED))
#define MIXF ((bf16*)(args.ws + WS_MIXF))
#define TOPE ((int*)(args.ws + WS_TOPE))
#define TOPG ((float*)(args.ws + WS_TOPG))
#define ROWTOK ((int*)(args.ws + WS_ROWTOK))
#define ROWGATE ((float*)(args.ws + WS_ROWGATE))
#define HB ((bf16*)(args.ws + WS_H))
#define YB ((bf16*)(args.ws + WS_YB))
#define HIN ((bf16*)(args.ws + WS_G))
#define WGU8 ((unsigned char*)(args.ws + WS_WGU))
#define WDN8 ((unsigned char*)(args.ws + WS_WDN))
#define XB8 ((unsigned char*)(args.ws + WS_U))
#define H8 ((unsigned char*)(args.ws + WS_H))
#define YB8 ((unsigned char*)(args.ws + WS_YB))
#define CDEC ((float*)(args.ws + WS_ACUM))
template <int layer>
__device__ __forceinline__ void run_layer(const Args& args, int lo, int hi, const XcdBarrier& bar) {
    extern __shared__ __attribute__((aligned(16))) unsigned char lds[];
    LAS unsigned char* ldsp = (LAS unsigned char*)lds;
    const int tid = threadIdx.x, lane = tid & 63, wave = __builtin_amdgcn_readfirstlane(tid >> 6);
    const int G = gridDim.x, bid = blockIdx.x;
    const int gw = bid * NWAVES + wave, NGW = G * NWAVES;
    gu32* ctl = (gu32*)(args.ws + WS_CTL);

#define IN(k) (lo <= (k) && (k) < hi)
#define SEAM(k) do { if (IN(k) && IN((k) + 1)) xcd_barrier(bar); } while (0)

        const int pb = 1 + layer * PH_PER_LAYER;
        const bf16* WINl = WIN + (size_t)layer * NPROJ * DM; const bf16* WOUTl = WOUT + (size_t)layer * DM * MIXW;
        const unsigned char* WGUl = WGU8 + (size_t)layer * NEXP * 2048 * DM; const unsigned char* WDNl = WDN8 + (size_t)layer * NEXP * DM * FF;
        gu32* gcnt = ctl + CW_CNT + 64 * layer;

        if (IN(pb + 0)) {
            if (layer == 0) {
                for (int m = gw; m < MROWS; m += NGW) { const float* xr = in_x + (size_t)m * DM; f32x4 v[4];
#pragma unroll
                    for (int j = 0; j < 4; ++j) v[j] = *(const f32x4*)(xr + 4 * lane + 256 * j);
                    row_dt(v, WDT, DT + (size_t)m * 8, lane); }
            }
            pg8::Gemm g{XB, WINl, MROWS, NPROJ, DM}; pg8::StaticOrder S; S.init(MROWS, NPROJ, G, bid);
            pg8::EpiProj E{PROJ, NPROJ, ROPE, QSCALE};
            pg8::gemm_phase<pg8::EpiProj, pg8::StaticOrder, true, false>(ldsp + RING_OFF, g, S, E);
        }
        SEAM(pb + 0);
        if (IN(pb + 1)) {
            if (args.sub & 1) attn_phase(ldsp + RING_OFF, PROJ, OP, LSE, bid, G, tid, wave, lane);
            if (args.sub & 2) { const float* cw = in_convw + (size_t)layer * 4 * 1024; const float* cb = in_convb + (size_t)layer * 1024;
              for (int un = bid; un < 512; un += G)
                  ssd_s1_unit(ldsp + RING_OFF, PROJ, DT, in_dtb + layer * 8, in_alog + layer * 8, cw, cb, ST, CDEC, un, tid, lane, wave);
              __syncthreads(); }
            const float* sw = in_scw + (size_t)layer * 3 * 512;
            if (args.sub & 4) for (int it = bid * (NWAVES * 64) + tid; it < (int)((long)MROWS * 64); it += G * (NWAVES * 64)) { const int c8 = (int)(it & 63), row = (int)(it >> 6), t = row & (SEQ - 1); const int ch = c8 * 8;
                float a[8];
#pragma unroll
                for (int q = 0; q < 8; ++q) a[q] = 0.f;
#pragma unroll
                for (int k = 0; k < 3; ++k) { const int tt = t - 2 + k; if (tt >= 0) { const bf16* pr = PROJ + (size_t)(row - 2 + k) * NPROJ; const v4u cc = *(const v4u*)(pr + C_SC + ch), hh = *(const v4u*)(pr + C_SH + ch);
                    const f32x4 w0 = *(const f32x4*)(sw + k * 512 + ch), w1 = *(const f32x4*)(sw + k * 512 + ch + 4);
                    a[0] += w0[0] * bflo(cc.x) * bflo(hh.x); a[1] += w0[1] * bfhi(cc.x) * bfhi(hh.x); a[2] += w0[2] * bflo(cc.y) * bflo(hh.y); a[3] += w0[3] * bfhi(cc.y) * bfhi(hh.y);
                    a[4] += w1[0] * bflo(cc.z) * bflo(hh.z); a[5] += w1[1] * bfhi(cc.z) * bfhi(hh.z); a[6] += w1[2] * bflo(cc.w) * bflo(hh.w); a[7] += w1[3] * bfhi(cc.w) * bfhi(hh.w); } }
                const v4u bb = *(const v4u*)(PROJ + (size_t)row * NPROJ + C_SB + ch);
                v4u o; o.x = pk2(a[0] * bflo(bb.x), a[1] * bfhi(bb.x)); o.y = pk2(a[2] * bflo(bb.y), a[3] * bfhi(bb.y)); o.z = pk2(a[4] * bflo(bb.z), a[5] * bfhi(bb.z)); o.w = pk2(a[6] * bflo(bb.w), a[7] * bfhi(bb.w));
                *(v4u*)(MIXED + (size_t)row * MIXW + 1024 + ch) = o; }
        }
        SEAM(pb + 1);
        if (IN(pb + 2)) {
            for (int it = bid * (NWAVES * 64) + tid; it < (int)(64L * 2048); it += G * (NWAVES * 64)) { const int pn4 = (int)(it & 2047), bh = (int)(it >> 11); const int h = bh & 7, b = bh >> 3; f32x4 hc = (f32x4){0.f, 0.f, 0.f, 0.f};
#pragma unroll 8
                for (int c = 0; c < 32; ++c) { const size_t idx = ((size_t)((b * 32 + c) * 8 + h)) * 8192 + pn4 * 4; const f32x4 st = *(const f32x4*)(ST + idx);
                    v2u o; o.x = pk2(hc[0], hc[1]); o.y = pk2(hc[2], hc[3]); *(v2u*)(HIN + idx) = o;
                    hc = hc * CDEC[(size_t)(b * 32 + c) * 8 + h] + st; } }
        }
        SEAM(pb + 2);
        if (IN(pb + 3)) {
            if (args.sub & 1) { const float* cw = in_convw + (size_t)layer * 4 * 1024; const float* cb = in_convb + (size_t)layer * 1024;
              for (int un = bid; un < 512; un += G)
                  ssd_s3_unit(ldsp + RING_OFF, PROJ, DT, in_dtb + layer * 8, in_alog + layer * 8, cw, cb, in_dsk + layer * 8, in_ng + (size_t)layer * 512, HIN, MIXED, un, tid, lane, wave);
              __syncthreads(); }
            if (args.sub & 2) for (int it = bid * (NWAVES * 64) + tid; it < (int)((long)MROWS * 64); it += G * (NWAVES * 64)) { const int c8 = (int)(it & 63), row = (int)(it >> 6); const int h = c8 >> 3;
                const float l0 = LSE[((size_t)0 * MROWS + row) * 8 + h], l1 = LSE[((size_t)1 * MROWS + row) * 8 + h], l2 = LSE[((size_t)2 * MROWS + row) * 8 + h];
                const float mm = fmaxf(l0, fmaxf(l1, l2)); float w0 = exp2f(l0 - mm), w1 = exp2f(l1 - mm), w2 = exp2f(l2 - mm); const float iw = 1.0f / (w0 + w1 + w2); w0 *= iw; w1 *= iw; w2 *= iw;
                const v4u a0 = *(const v4u*)(OP + ((size_t)0 * MROWS + row) * 512 + c8 * 8), a1 = *(const v4u*)(OP + ((size_t)1 * MROWS + row) * 512 + c8 * 8), a2 = *(const v4u*)(OP + ((size_t)2 * MROWS + row) * 512 + c8 * 8);
                v4u o;
                o.x = pk2(w0 * bflo(a0.x) + w1 * bflo(a1.x) + w2 * bflo(a2.x), w0 * bfhi(a0.x) + w1 * bfhi(a1.x) + w2 * bfhi(a2.x));
                o.y = pk2(w0 * bflo(a0.y) + w1 * bflo(a1.y) + w2 * bflo(a2.y), w0 * bfhi(a0.y) + w1 * bfhi(a1.y) + w2 * bfhi(a2.y));
                o.z = pk2(w0 * bflo(a0.z) + w1 * bflo(a1.z) + w2 * bflo(a2.z), w0 * bfhi(a0.z) + w1 * bfhi(a1.z) + w2 * bfhi(a2.z));
                o.w = pk2(w0 * bflo(a0.w) + w1 * bflo(a1.w) + w2 * bflo(a2.w), w0 * bfhi(a0.w) + w1 * bfhi(a1.w) + w2 * bfhi(a2.w));
                *(v4u*)(MIXED + (size_t)row * MIXW + c8 * 8) = o; }
        }
        SEAM(pb + 3);
        if (IN(pb + 4)) {
            pg8::Gemm g{MIXED, WOUTl, MROWS, DM, MIXW}; pg8::StaticOrder S; S.init(MROWS, DM, G, bid);
            pg8::EpiBf16Plain E{MIXF, DM};
            pg8::gemm_phase<pg8::EpiBf16Plain, pg8::StaticOrder, true, false>(ldsp + RING_OFF, g, S, E);
        }
        SEAM(pb + 4);
        if (IN(pb + 5)) {
            const float* gam = in_ln1g + (size_t)layer * DM; const float* bet = in_ln1b + (size_t)layer * DM;
            for (int m = gw; m < MROWS; m += NGW) { f32x4 v[4];
#pragma unroll
                for (int j = 0; j < 4; ++j) { const v2u a = *(const v2u*)(XB + (size_t)m * DM + 4 * lane + 256 * j); const v2u b = *(const v2u*)(MIXF + (size_t)m * DM + 4 * lane + 256 * j);
                    v[j] = (f32x4){bflo(a.x), bfhi(a.x), bflo(a.y), bfhi(a.y)} * ALPHA + (f32x4){bflo(b.x), bfhi(b.x), bflo(b.y), bfhi(b.y)}; }
                ln_row<true, false>(v, gam, bet, nullptr, XB + (size_t)m * DM, XB8 + (size_t)m * DM, SC_X, lane); }
        }
        SEAM(pb + 5);
        if (IN(pb + 6)) {
            LAS int* lcnt = (LAS int*)(ldsp + L_LCNT); LAS int* lbase = (LAS int*)(ldsp + L_LBASE);
            const bf16* RT = ROUT + (size_t)layer * NEXP * DM; const float* rb = in_rb + (size_t)layer * NEXP;
            for (int blk = bid; blk < MROWS / 128; blk += G) {
                if (tid < 32) lcnt[tid] = 0;
                __syncthreads();
                const int r32 = lane & 31, hi = lane >> 5; const int row = blk * 128 + (wave & 3) * 32 + r32;
                float tv[4]; int te[4]; int lrank[4]; float gate[4];
                if (wave < 4) {
                    f32x16 acc = {};
                    const bf16* ap = RT + (size_t)r32 * DM + 8 * hi; const bf16* bp = XB + (size_t)row * DM + 8 * hi;
#pragma unroll 8
                    for (int s = 0; s < 64; ++s) { const bf16x8 a = *(const bf16x8*)(ap + 16 * s), b = *(const bf16x8*)(bp + 16 * s); acc = __builtin_amdgcn_mfma_f32_32x32x16_bf16(a, b, acc, 0, 0, 0); }
#pragma unroll
                    for (int k = 0; k < 4; ++k) { tv[k] = -INFINITY; te[k] = 1 << 20; }
#pragma unroll
                    for (int i = 0; i < 16; ++i) { const int e = (i & 3) + 8 * (i >> 2) + 4 * hi; float v = acc[i] + rb[e]; int ve = e;
#pragma unroll
                        for (int k = 0; k < 4; ++k) { const bool gt = (v > tv[k]) || (v == tv[k] && ve < te[k]); const float nv = gt ? tv[k] : v; const int ne = gt ? te[k] : ve; tv[k] = gt ? v : tv[k]; te[k] = gt ? ve : te[k]; v = nv; ve = ne; } }
                    float pv[4]; int pe[4];
#pragma unroll
                    for (int k = 0; k < 4; ++k) { pv[k] = __shfl_xor(tv[k], 32); pe[k] = __shfl_xor(te[k], 32); }
#pragma unroll
                    for (int j = 0; j < 4; ++j) { float v = pv[j]; int ve = pe[j];
#pragma unroll
                        for (int k = 0; k < 4; ++k) { const bool gt = (v > tv[k]) || (v == tv[k] && ve < te[k]); const float nv = gt ? tv[k] : v; const int ne = gt ? te[k] : ve; tv[k] = gt ? v : tv[k]; te[k] = gt ? ve : te[k]; v = nv; ve = ne; } }
                    float se = 0.f;
#pragma unroll
                    for (int k = 0; k < 4; ++k) { gate[k] = __expf(tv[k] - tv[0]); se += gate[k]; }
                    const float ise = 1.0f / se;
#pragma unroll
                    for (int k = 0; k < 4; ++k) gate[k] *= ise;
                    if (hi == 0) {
#pragma unroll
                        for (int k = 0; k < 4; ++k) lrank[k] = __hip_atomic_fetch_add(lcnt + te[k], 1, __ATOMIC_RELAXED, __HIP_MEMORY_SCOPE_WORKGROUP);
                    }
                }
                __syncthreads();
                if (tid < 32) lbase[tid] = (int)__hip_atomic_fetch_add(gcnt + tid, (unsigned)lcnt[tid], RLX_AGENT);
                __syncthreads();
                if (wave < 4 && hi == 0) {
#pragma unroll
                    for (int k = 0; k < 4; ++k) { const int r = lbase[te[k]] + lrank[k]; const size_t o = (size_t)te[k] * 32768 + r;
                        ROWTOK[o] = row * 4 + k; ROWGATE[o] = gate[k]; TOPE[(size_t)row * 4 + k] = te[k]; TOPG[(size_t)row * 4 + k] = gate[k]; }
                }
                __syncthreads();
            }
        }
        SEAM(pb + 6);
        if (IN(pb + 7) || IN(pb + 8)) {
            LAS int* tstart = (LAS int*)(ldsp + L_TSTART); LAS int* cntL = (LAS int*)(ldsp + L_CNT); LAS int* units = (LAS int*)(ldsp + L_UNITS); LAS int* unitsn = (LAS int*)(ldsp + L_UNITSN);
            if (tid == 0) { int acc = 0; for (int e = 0; e < 32; ++e) { const int c = (int)__hip_atomic_load(gcnt + e, RLX_AGENT); cntL[e] = c; tstart[e] = acc; acc += (c + 255) >> 8; } tstart[32] = acc; }
            __syncthreads();
            if (IN(pb + 7)) {
                pg8::moe_build_units(units, unitsn, tstart, 8, G, bid, tid);
                __syncthreads();
                pg8::Gemm g{(const pg8::bf16_t*)XB8, (const pg8::bf16_t*)WGUl, 0, 2048, DM / 2};
                pg8::MoeOrder S{units, __builtin_amdgcn_readfirstlane(unitsn[0]), cntL, ROWTOK, 1, (unsigned)DM, (size_t)2048 * DM, ROWGATE, in_bgu + (size_t)layer * NEXP * 2048};
                pg8::EpiSwiglu E{H8, in_bgu + (size_t)layer * NEXP * 2048, ROWGATE, cntL, 1.0f / (SC_X * SC_WGU), SC_H};
                pg8::gemm_phase<pg8::EpiSwiglu, pg8::MoeOrder, true, true, true>(ldsp + RING_OFF, g, S, E);
                __syncthreads();
            }
            SEAM(pb + 7);
            if (IN(pb + 8)) {
                pg8::moe_build_units(units, unitsn, tstart, 4, G, bid, tid);
                __syncthreads();
                pg8::Gemm g{(const pg8::bf16_t*)H8, (const pg8::bf16_t*)WDNl, 0, DM, FF / 2};
                pg8::MoeOrder S{units, __builtin_amdgcn_readfirstlane(unitsn[0]), cntL, ROWTOK, 0, (unsigned)FF, (size_t)DM * FF, ROWGATE, in_bdn + (size_t)layer * NEXP * DM};
                pg8::EpiScatter E{YB8, ROWTOK, cntL, SC_Y / (SC_H * SC_WDN), SC_Y};
                pg8::gemm_phase<pg8::EpiScatter, pg8::MoeOrder, true, false, true, true>(ldsp + RING_OFF, g, S, E);
                __syncthreads();
            }
        }
        SEAM(pb + 8);
        if (IN(pb + 9)) {
            const float* gam = in_ln2g + (size_t)layer * DM; const float* bet = in_ln2b + (size_t)layer * DM; const float* bdn = in_bdn + (size_t)layer * NEXP * DM;
            for (int m = gw; m < MROWS; m += NGW) { f32x4 v[4];
#pragma unroll
                for (int j = 0; j < 4; ++j) { const v2u a = *(const v2u*)(XB + (size_t)m * DM + 4 * lane + 256 * j); v[j] = (f32x4){bflo(a.x), bfhi(a.x), bflo(a.y), bfhi(a.y)} * ALPHA; }
#pragma unroll
                for (int k = 0; k < 4; ++k) { const unsigned char* yr = YB8 + ((size_t)m * 4 + k) * DM;
#pragma unroll
                    for (int j = 0; j < 4; ++j) { const unsigned w = *(const unsigned*)(yr + 4 * lane + 256 * j);
                        typedef float f32x2_ __attribute__((ext_vector_type(2)));
                        const f32x2_ lo = __builtin_amdgcn_cvt_pk_f32_fp8(w, false), hi = __builtin_amdgcn_cvt_pk_f32_fp8(w, true);
                        v[j][0] += lo[0] * (1.0f / SC_Y); v[j][1] += lo[1] * (1.0f / SC_Y); v[j][2] += hi[0] * (1.0f / SC_Y); v[j][3] += hi[1] * (1.0f / SC_Y); } }
                ln_row<false, (layer == NLAYER - 1)>(v, gam, bet, args.out + (size_t)m * DM, XB + (size_t)m * DM, nullptr, 1.f, lane);
                if (layer + 1 < NLAYER) row_dt(v, WDT + (size_t)(layer + 1) * 8 * 1024, DT + (size_t)m * 8, lane); }
        }
        SEAM(pb + 9);
    #undef IN
#undef SEAM
}

__global__ void __launch_bounds__(NWAVES * 64, 2) mk_fwd(Args args) {
    extern __shared__ __attribute__((aligned(16))) unsigned char lds[];
    LAS unsigned char* ldsp = (LAS unsigned char*)lds;
    const int tid = threadIdx.x, lane = tid & 63, wave = __builtin_amdgcn_readfirstlane(tid >> 6);
    const int G = gridDim.x, bid = blockIdx.x;
    const int gw = bid * NWAVES + wave, NGW = G * NWAVES;
    gu32* ctl = (gu32*)(args.ws + WS_CTL);

    for (int u = tid; u < (LDS_BYTES - LDSCTL_OFF) / 4; u += NWAVES * 64) ((LAS unsigned*)(ldsp + LDSCTL_OFF))[u] = 0u;
    __syncthreads();
    XcdBarrier bar = xcd_barrier_post((unsigned*)(ctl + CW_BAR), (volatile LAS unsigned*)(ldsp + L_MISC) + 8);

    const int lo = args.ph_lo, hi = args.ph_hi;
#define IN(k) (lo <= (k) && (k) < hi)
#define SEAM(k) do { if (IN(k) && IN((k) + 1)) xcd_barrier(bar); } while (0)

    if (IN(0)) {
        for (int it = bid * (NWAVES * 64) + tid; it < (int)(4096 * 32); it += G * (NWAVES * 64)) { const int t = (int)(it >> 5), i = (int)(it & 31);
            const float inv = powf(10000.0f, -(float)i / 32.0f); const float ang = (float)t * inv; float sn, cs; sincosf(ang, &sn, &cs);
            ROPE[2 * it] = cs; ROPE[2 * it + 1] = sn; }
        LAS float* scr = (LAS float*)(ldsp + RING_OFF + wave * 16384);
        constexpr int I_IN = 16 * 73, I_OUT = 24 * 16, I_R = 16;
        constexpr int NIT = NLAYER * (I_IN + I_OUT + I_R);
        for (int it = gw; it < NIT; it += NGW) {
            int r = it;
            if (r < NLAYER * I_IN) { const int l = r / I_IN; r %= I_IN; p0_transpose_item64<1>(in_win + (size_t)l * DM * INW, DM, INW, WIN + (size_t)l * NPROJ * DM, WDT + (size_t)l * 8 * 1024, scr, r / 73, r % 73, lane); continue; } r -= NLAYER * I_IN;
            if (r < NLAYER * I_OUT) { const int l = r / I_OUT; r %= I_OUT; p0_transpose_item64<0>(in_wout + (size_t)l * MIXW * DM, MIXW, DM, WOUT + (size_t)l * DM * MIXW, nullptr, scr, r / 16, r % 16, lane); continue; } r -= NLAYER * I_OUT;
            { const int l = r / I_R; r %= I_R; p0_transpose_item<0>(in_rw + (size_t)l * DM * NEXP, DM, NEXP, ROUT + (size_t)l * NEXP * DM, nullptr, scr, r, 0, lane); }
        }
        { constexpr int NIT8 = 64 * 256 + 64 * 128;
          const int nmine = (gw < NIT8) ? (NIT8 - gw + NGW - 1) / NGW : 0; const int J = 2 * nmine;
          f32x4 lda[16], ldb[16];
          if (J > 0) { const SubT t = fp8_subtile(gw, 0, in_wgu, in_wdn, WGU8, WDN8, lane); fp8_sub_load(t, lda); }
#pragma unroll 1
          for (int j = 0; j < J; j += 2) {
              const int item = gw + (j >> 1) * NGW;
              const SubT t0 = fp8_subtile(item, 0, in_wgu, in_wdn, WGU8, WDN8, lane), t1 = fp8_subtile(item, 1, in_wgu, in_wdn, WGU8, WDN8, lane);
              fp8_sub_load(t1, ldb);
              fp8_sub_process(t0, lda, scr, lane);
              if (j + 2 < J) { const SubT t2 = fp8_subtile(item + NGW, 0, in_wgu, in_wdn, WGU8, WDN8, lane); fp8_sub_load(t2, lda); }
              fp8_sub_process(t1, ldb, scr, lane);
          } }
        __syncthreads();
    }
    if (IN(0)) {
        for (int m = gw; m < MROWS; m += NGW) { const float* xr = in_x + (size_t)m * DM; bf16* ob = XB + (size_t)m * DM; f32x4 v[4];
#pragma unroll
            for (int j = 0; j < 4; ++j) { v[j] = *(const f32x4*)(xr + 4 * lane + 256 * j); v2u w; w.x = pk2(v[j][0], v[j][1]); w.y = pk2(v[j][2], v[j][3]); *(v2u*)(ob + 4 * lane + 256 * j) = w; }
            }
    }

    SEAM(0);
    run_layer<0>(args, lo, hi, bar);
    run_layer<1>(args, lo, hi, bar);
#undef IN
#undef SEAM
}

extern "C" void kernel_launch(void* const* d_in, const int* in_sizes, int n_in, void* d_out, int out_size, void* d_ws, size_t ws_size, hipStream_t stream) {
    static int grid = 0;
    if (grid == 0) {
        if (n_in != 20 || out_size != MROWS * DM || ws_size < WS_END) { fprintf(stderr, "kernel_launch: unexpected problem (n_in %d, out %d, ws %zu)\n", n_in, out_size, ws_size); grid = -1; return; }
        if (hipFuncSetAttribute((const void*)mk_fwd, hipFuncAttributeMaxDynamicSharedMemorySize, LDS_BYTES) != hipSuccess) { fprintf(stderr, "kernel_launch: hipFuncSetAttribute failed\n"); grid = -1; return; }
        int dev = 0, cus = 0, per_cu = 0;
        (void)hipGetDevice(&dev); (void)hipDeviceGetAttribute(&cus, hipDeviceAttributeMultiprocessorCount, dev);
        if (hipOccupancyMaxActiveBlocksPerMultiprocessor(&per_cu, (const void*)mk_fwd, NWAVES * 64, LDS_BYTES) != hipSuccess || per_cu < 1) fprintf(stderr, "kernel_launch: occupancy query says %d\n", per_cu);
        (void)hipGetLastError();
        grid = cus > 0 ? cus : 256;
    }
    if (grid < 0) return;
    (void)hipMemsetAsync((char*)d_ws + WS_CTL, 0, CTL_ZERO_BYTES, stream);
    Args a{};
    for (int i = 0; i < 20; ++i) a.in[i] = (const float*)d_in[i];
    a.out = (float*)d_out; a.ws = (unsigned char*)d_ws;
    a.ph_lo = 0; a.ph_hi = N_PHASES; a.sub = 7; a.pad = 0;
    hipLaunchKernelGGL(mk_fwd, dim3(grid), dim3(NWAVES * 64), LDS_BYTES, stream, a);
#ifdef PROBE_PH
#ifndef PROBE_SUB
#define PROBE_SUB 7
#endif
    for (int i = 0; i < PROBE_N; ++i) { a.ph_lo = PROBE_PH; a.ph_hi = PROBE_PH + 1; a.sub = PROBE_SUB; hipLaunchKernelGGL(mk_fwd, dim3(grid), dim3(NWAVES * 64), LDS_BYTES, stream, a); }
#endif
}
```

```cpp
#include <hip/hip_runtime.h>
#include <cstdio>
#include <cstdint>
#include <cmath>

namespace pg8 {
#define PG8_LAS __attribute__((address_space(3)))
typedef unsigned short bf16_t;
typedef short bf16x8 __attribute__((ext_vector_type(8)));
typedef float f32x4 __attribute__((ext_vector_type(4)));
typedef float f32x2 __attribute__((ext_vector_type(2)));
typedef unsigned u32x4 __attribute__((ext_vector_type(4)));
constexpr int BM = 256, BK = 64, HALF = 128, HTB = HALF * BK * 2  , STAGE_BYTES = 8 * HTB, NXCD = 8, WGM = 8;

__host__ __device__ __forceinline__ int lds_byte(int r, int c) { const int st = (r >> 4) * 2 + (c >> 5), rr = r & 15, cc = c & 31, ob = rr * 64 + cc * 2; return st * 1024 + (ob ^ (((ob >> 9) & 1) << 5)); }
__host__ __device__ __forceinline__ void stage_rc(int b, int& R, int& C) { const int st = b / 1024, sb = b % 1024, swz = sb ^ (((sb >> 9) & 1) << 5); R = (st >> 1) * 16 + swz / 64; C = (st & 1) * 32 + (swz % 64) / 2; }
__host__ __device__ __forceinline__ int perm32(int rho) { const int n = rho >> 4, i = rho & 15; return 8 * (i >> 2) + 4 * n + (i & 3); }

struct Unit { int pm, pn, e, r0; };
struct Gemm { const bf16_t* A; const bf16_t* Bt; int M, N, K; };

struct StaticOrder {
    int nM, nN, nwg, G, c;
    __device__ void init(int M, int N, int G_, int c_) { nM = M / BM; nN = N / BM; nwg = nM * nN; G = G_; c = c_; }
    __device__ __forceinline__ bool next(int i, Unit& u) const {
        const long L = (long)i * G + c; if (L >= nwg) return false;
        int wgid = (int)L; { const int q = nwg / NXCD, r = nwg % NXCD, xcd = wgid % NXCD, off = wgid / NXCD; wgid = (xcd < r ? xcd * (q + 1) : r * (q + 1) + (xcd - r) * q) + off; }
        const int nig = WGM * nN, gid = wgid / nig, fm = gid * WGM, gsz = (nM - fm) < WGM ? (nM - fm) : WGM;
        u.pm = fm + ((wgid % nig) % gsz); u.pn = (wgid % nig) / gsz; u.e = 0; u.r0 = 0; return true;
    }
    __device__ __forceinline__ const char* abase(const Unit& u, const Gemm& g, size_t tstep) const { return (const char*)g.A + (size_t)u.pm * tstep; }
    __device__ __forceinline__ const char* bbase(const Unit& u, const Gemm& g, size_t tstep) const { return (const char*)g.Bt + (size_t)u.pn * tstep; }
    static constexpr bool SIDE = false;
    __device__ __forceinline__ unsigned arow(const Unit&, int) const { return 0u; }
    __device__ __forceinline__ unsigned arow_side(const Unit&, int, const PG8_LAS unsigned char*) const { return 0u; }
    __device__ __forceinline__ const void* side_src(const Unit&, const Unit&, int, int) const { return nullptr; }
    __device__ __forceinline__ void a_ready(const Unit&) const {}
    __device__ __forceinline__ void done(const Unit&) const {}
};

struct MoeOrder {
    const PG8_LAS int* units;
    int nunits;
    const PG8_LAS int* cnt;
    const int* rowtok;
    int gather;
    unsigned rowbytes;
    size_t bstride;
    __device__ __forceinline__ bool next(int i, Unit& u) const {
        if (i >= nunits) return false;
        u.pm = __builtin_amdgcn_readfirstlane(units[4 * i + 0]); u.pn = __builtin_amdgcn_readfirstlane(units[4 * i + 1]);
        u.e = __builtin_amdgcn_readfirstlane(units[4 * i + 2]); u.r0 = __builtin_amdgcn_readfirstlane(units[4 * i + 3]); return true;
    }
    __device__ __forceinline__ const char* abase(const Unit& u, const Gemm& g, size_t tstep) const { return gather ? (const char*)g.A : (const char*)g.A + (size_t)u.pm * tstep; }
    __device__ __forceinline__ const char* bbase(const Unit& u, const Gemm& g, size_t tstep) const { return (const char*)g.Bt + (size_t)u.e * bstride + (size_t)u.pn * tstep; }
    static constexpr bool SIDE = true;
    const float* rowgate; const float* bgu;
    __device__ __forceinline__ unsigned arow(const Unit& u, int R) const {
        const int r = u.r0 + R; const int idx = (r < cnt[u.e]) ? rowtok[(size_t)u.e * 32768 + r] : 0; return (unsigned)(idx >> 2) * rowbytes; }
    __device__ __forceinline__ unsigned arow_side(const Unit& u, int R, const PG8_LAS unsigned char* sd) const {
        const int r = u.r0 + R; const int v = ((const PG8_LAS int*)sd)[R]; const int idx = (r < cnt[u.e]) ? v : 0; return (unsigned)(idx >> 2) * rowbytes; }
    __device__ __forceinline__ const void* side_src(const Unit& cur, const Unit& rt, int wid, int lane) const {
        if (rowgate != nullptr && wid == 1) return rowgate + (size_t)cur.e * 32768 + cur.r0 + 4 * lane;
        if (bgu != nullptr && wid == 2) return gather ? (bgu + (size_t)cur.e * 2048 + (lane < 32 ? 0 : 1024 - 128) + cur.pn * 128 + 4 * lane)
                                                      : (bgu + (size_t)cur.e * 1024 + cur.pn * 256 + 4 * lane);
        return rowtok + (size_t)rt.e * 32768 + rt.r0 + 4 * lane; }
    __device__ __forceinline__ void a_ready(const Unit&) const {}
    __device__ __forceinline__ void done(const Unit&) const {}
};
__device__ __forceinline__ void moe_build_units(PG8_LAS int* units, PG8_LAS int* units_n, const PG8_LAS int* tstart, int nN, int G, int c, int tid) {
    if (tid < 64) {
        const int nT = tstart[32], nwg = nT * nN; const long L = (long)tid * G + c;
        int pm = 0, pn = 0, e = 0, r0 = 0;
        if (L < nwg) {
            int wgid = (int)L; { const int q = nwg / NXCD, r = nwg % NXCD, xcd = wgid % NXCD, off = wgid / NXCD; wgid = (xcd < r ? xcd * (q + 1) : r * (q + 1) + (xcd - r) * q) + off; }
            const int nig = WGM * nN, gid = wgid / nig, fm = gid * WGM, gsz = (nT - fm) < WGM ? (nT - fm) : WGM;
            pm = fm + ((wgid % nig) % gsz); pn = (wgid % nig) / gsz;
            for (int j = 1; j < 32; ++j) e += (tstart[j] <= pm) ? 1 : 0;
            r0 = (pm - tstart[e]) * 256;
        }
        units[4 * tid + 0] = pm; units[4 * tid + 1] = pn; units[4 * tid + 2] = e; units[4 * tid + 3] = r0;
        if (tid == 0) { int n = 0; if (c < nwg) n = (nwg - c + G - 1) / G; units_n[0] = n < 64 ? n : 64; }
    }
}

__host__ __device__ __forceinline__ unsigned hblk_off(int R, int p7) { const int ai = R >> 7, wr = (R >> 6) & 1, m = (R >> 4) & 3, fr = R & 15, wc = p7 >> 1, fq = ((p7 & 1) << 1) | (m & 1), mp = m >> 1;
    return (unsigned)(((((ai * 2 + wr) * 4 + wc) * 2 + mp) * 64 + fr + 16 * fq) * 16); }
typedef int v8i_t __attribute__((ext_vector_type(8)));
typedef int v4i_t __attribute__((ext_vector_type(4)));
__device__ __forceinline__ v8i_t cat8(bf16x8 lo, bf16x8 hi) { const v4i_t a = __builtin_bit_cast(v4i_t, lo), b = __builtin_bit_cast(v4i_t, hi); return __builtin_shufflevector(a, b, 0, 1, 2, 3, 4, 5, 6, 7); }
__device__ __forceinline__ void mfma8(f32x4& acc, v8i_t a, v8i_t b, int scl) { asm volatile("v_mfma_scale_f32_16x16x128_f8f6f4 %0, %1, %2, %0, %3, %3 op_sel_hi:[0,0,0]" : "+v"(acc) : "v"(a), "v"(b), "v"(scl)); }
__device__ __forceinline__ unsigned pk4_fp8(float a, float b, float c, float d) { unsigned w = 0u; w = __builtin_amdgcn_cvt_pk_fp8_f32(a, b, w, false); w = __builtin_amdgcn_cvt_pk_fp8_f32(c, d, w, true); return w; }
__device__ __forceinline__ unsigned cvt_pk_bf16(float lo, float hi) { unsigned r; asm volatile("v_cvt_pk_bf16_f32 %0, %1, %2" : "=v"(r) : "v"(lo), "v"(hi)); return r; }

struct EpiProj {
    static constexpr bool PERM = true, AFTER_DRAIN = false;
    bf16_t* O; int ldc; const float* rope; float qscale; float dqv; int pn_off;
    __device__ __forceinline__ void operator()(const f32x4 (&acc)[2][2][4][2], const Unit& u, int wr, int wc, int fr, int fq, const PG8_LAS unsigned char* sd) const {
        const int pnn = u.pn + pn_off; const int row0 = u.pm * BM + wr * 64 + fr; const int col0 = pnn * BM + wc * 32 + 8 * fq;
        const bool rot = pnn < 4; const float sc = (pnn < 2 ? qscale : 1.f) * dqv; const int gq = 4 * (wc & 1) + fq;
        float invr[4];
#pragma unroll
        for (int e = 0; e < 4; ++e) invr[e] = __builtin_amdgcn_exp2f(-(float)(4 * gq + e) * 0.41524101186092029f) * 0.15915494309189535f;
#pragma unroll
        for (int ai = 0; ai < 2; ++ai)
#pragma unroll
            for (int m = 0; m < 4; ++m) { const int row = row0 + ai * HALF + m * 16; bf16_t* rowp = O + (size_t)row * ldc + col0;
                f32x4 cs0 = (f32x4){1.f, 0.f, 1.f, 0.f}, cs1 = cs0;
                if (rot) { const float tp = (float)(row & 4095);
                    const float a0 = __builtin_amdgcn_fractf(tp * invr[0]), a1 = __builtin_amdgcn_fractf(tp * invr[1]), a2 = __builtin_amdgcn_fractf(tp * invr[2]), a3 = __builtin_amdgcn_fractf(tp * invr[3]);
                    cs0 = (f32x4){__builtin_amdgcn_cosf(a0), __builtin_amdgcn_sinf(a0), __builtin_amdgcn_cosf(a1), __builtin_amdgcn_sinf(a1)};
                    cs1 = (f32x4){__builtin_amdgcn_cosf(a2), __builtin_amdgcn_sinf(a2), __builtin_amdgcn_cosf(a3), __builtin_amdgcn_sinf(a3)}; }
#pragma unroll
                for (int bj = 0; bj < 2; ++bj) { f32x4 v0 = acc[ai][bj][m][0], v1 = acc[ai][bj][m][1];
                    if (rot) { f32x4 lo, hi;
                        lo[0] = v0[0] * cs0[0] - v1[0] * cs0[1]; hi[0] = v1[0] * cs0[0] + v0[0] * cs0[1];
                        lo[1] = v0[1] * cs0[2] - v1[1] * cs0[3]; hi[1] = v1[1] * cs0[2] + v0[1] * cs0[3];
                        lo[2] = v0[2] * cs1[0] - v1[2] * cs1[1]; hi[2] = v1[2] * cs1[0] + v0[2] * cs1[1];
                        lo[3] = v0[3] * cs1[2] - v1[3] * cs1[3]; hi[3] = v1[3] * cs1[2] + v0[3] * cs1[3];
                        v0 = lo * sc; v1 = hi * sc; }
                    else { v0 = v0 * dqv; v1 = v1 * dqv; }
                    u32x4 w; w.x = cvt_pk_bf16(v0[0], v0[1]); w.y = cvt_pk_bf16(v0[2], v0[3]); w.z = cvt_pk_bf16(v1[0], v1[1]); w.w = cvt_pk_bf16(v1[2], v1[3]);
                    *(u32x4*)(rowp + bj * HALF) = w; } }
    }
};
struct EpiF32 {
    static constexpr bool PERM = false, AFTER_DRAIN = false;
    float* O; int ldc;
    __device__ __forceinline__ void operator()(const f32x4 (&acc)[2][2][4][2], const Unit& u, int wr, int wc, int fr, int fq, const PG8_LAS unsigned char* sd) const {
        const int row0 = u.pm * BM + wr * 64 + fr; const int col0 = u.pn * BM + wc * 32 + 4 * fq;
#pragma unroll
        for (int ai = 0; ai < 2; ++ai)
#pragma unroll
            for (int m = 0; m < 4; ++m) { float* rowp = O + (size_t)(row0 + ai * HALF + m * 16) * ldc + col0;
#pragma unroll
                for (int bj = 0; bj < 2; ++bj)
#pragma unroll
                    for (int n = 0; n < 2; ++n) *(f32x4*)(rowp + bj * HALF + n * 16) = acc[ai][bj][m][n]; }
    }
};
struct EpiBf16Plain {
    static constexpr bool PERM = true, AFTER_DRAIN = false;
    bf16_t* O; int ldc;
    __device__ __forceinline__ void operator()(const f32x4 (&acc)[2][2][4][2], const Unit& u, int wr, int wc, int fr, int fq, const PG8_LAS unsigned char* sd) const {
        const int row0 = u.pm * BM + wr * 64 + fr; const int col0 = u.pn * BM + wc * 32 + 8 * fq;
#pragma unroll
        for (int ai = 0; ai < 2; ++ai)
#pragma unroll
            for (int m = 0; m < 4; ++m) { bf16_t* rowp = O + (size_t)(row0 + ai * HALF + m * 16) * ldc + col0;
#pragma unroll
                for (int bj = 0; bj < 2; ++bj) { const f32x4 v0 = acc[ai][bj][m][0], v1 = acc[ai][bj][m][1];
                    u32x4 w; w.x = cvt_pk_bf16(v0[0], v0[1]); w.y = cvt_pk_bf16(v0[2], v0[3]); w.z = cvt_pk_bf16(v1[0], v1[1]); w.w = cvt_pk_bf16(v1[2], v1[3]);
                    *(u32x4*)(rowp + bj * HALF) = w; } }
    }
};
struct EpiSwiglu {
    static constexpr bool PERM = true, AFTER_DRAIN = false;
    unsigned char* H; const float* bgu; const float* rowgate; const PG8_LAS int* cnt; float dq, hscale;
    __device__ __forceinline__ void operator()(const f32x4 (&acc)[2][2][4][2], const Unit& u, int wr, int wc, int fr, int fq, const PG8_LAS unsigned char* sd) const {
        const int ff = u.pn * HALF + wc * 32 + 8 * fq; const int n_e = cnt[u.e];
        f32x4 bg[2], bu[2];
#pragma unroll
        for (int n = 0; n < 2; ++n) { bg[n] = *(const PG8_LAS f32x4*)(sd + 2048 + (wc * 32 + 8 * fq + 4 * n) * 4); bu[n] = *(const PG8_LAS f32x4*)(sd + 2048 + 512 + (wc * 32 + 8 * fq + 4 * n) * 4); }
        const int lane = fr + 16 * fq;
#pragma unroll
        for (int ai = 0; ai < 2; ++ai)
#pragma unroll
            for (int mp = 0; mp < 2; ++mp) {
                unsigned pw[2][2];
#pragma unroll
                for (int mm = 0; mm < 2; ++mm) { const int m = 2 * mp + mm; const int r = ai * HALF + wr * 64 + m * 16 + fr; const int er = u.r0 + r;
                    const float rgl = ((const PG8_LAS float*)(sd + 1024))[r]; const float rg = ((er < n_e) ? rgl : 0.f) * hscale;
                    float hv[8];
#pragma unroll
                    for (int n = 0; n < 2; ++n)
#pragma unroll
                        for (int q = 0; q < 4; ++q) { float g = acc[ai][0][m][n][q] * dq + bg[n][q], up = acc[ai][1][m][n][q] * dq + bu[n][q];
                            g = fminf(g, 7.0f); up = fminf(fmaxf(up, -7.0f), 7.0f);
                            const float sg = __builtin_amdgcn_rcpf(1.0f + __builtin_amdgcn_exp2f(-1.702f * 1.4426950408889634f * g));
                            hv[n * 4 + q] = (up + 1.0f) * g * sg * rg; }
                    pw[mm][0] = pk4_fp8(hv[0], hv[1], hv[2], hv[3]); pw[mm][1] = pk4_fp8(hv[4], hv[5], hv[6], hv[7]); }
                const auto s0 = __builtin_amdgcn_permlane16_swap(pw[0][0], pw[1][0], false, false); const auto s1 = __builtin_amdgcn_permlane16_swap(pw[0][1], pw[1][1], false, false);
                *(u32x4*)(H + ((size_t)u.pm * 8 + u.pn) * 32768 + ((((ai * 2 + wr) * 4 + wc) * 2 + mp) * 64 + lane) * 16) = (u32x4){s0[0], s1[0], s0[1], s1[1]};
                asm volatile("" ::: "memory"); }
    }
};
struct EpiScatter {
    static constexpr bool PERM = true, AFTER_DRAIN = false;
    unsigned char* Y; const int* rowtok; const PG8_LAS int* cnt; float dq, ysc;
    __device__ __forceinline__ void operator()(const f32x4 (&acc)[2][2][4][2], const Unit& u, int wr, int wc, int fr, int fq, const PG8_LAS unsigned char* sd) const {
        const int col0 = u.pn * BM + wc * 32 + 8 * fq; const int n_e = cnt[u.e];
        f32x4 bd[2][2];
#pragma unroll
        for (int bj = 0; bj < 2; ++bj)
#pragma unroll
            for (int n = 0; n < 2; ++n) bd[bj][n] = *(const PG8_LAS f32x4*)(sd + 2048 + (bj * HALF + wc * 32 + 8 * fq + 4 * n) * 4);
#pragma unroll
        for (int ai = 0; ai < 2; ++ai)
#pragma unroll
            for (int m = 0; m < 4; ++m) { const int er = u.r0 + ai * HALF + wr * 64 + m * 16 + fr;
                const int idx = ((const PG8_LAS int*)sd)[ai * HALF + wr * 64 + m * 16 + fr];
                if (er < n_e) { unsigned char* rowp = Y + (size_t)idx * 1024 + col0;
                    typedef unsigned u32x2 __attribute__((ext_vector_type(2)));
                    const float rg = ((const PG8_LAS float*)(sd + 1024))[ai * HALF + wr * 64 + m * 16 + fr] * ysc;
#pragma unroll
                    for (int bj = 0; bj < 2; ++bj) { const f32x4 v0 = acc[ai][bj][m][0] * dq + bd[bj][0] * rg, v1 = acc[ai][bj][m][1] * dq + bd[bj][1] * rg;
                        *(u32x2*)(rowp + bj * HALF) = (u32x2){pk4_fp8(v0[0], v0[1], v0[2], v0[3]), pk4_fp8(v1[0], v1[1], v1[2], v1[3])}; } }
                asm volatile("" ::: "memory"); }
    }
};

template <class Epi, class Sched, bool ALIGN_EPI, bool GATHER, bool FP8 = false, bool ABLK = false>
__device__ __forceinline__ void gemm_phase(PG8_LAS unsigned char* lds, const Gemm g, const Sched& S, const Epi& E) {
    const int tid = threadIdx.x, wid = __builtin_amdgcn_readfirstlane(tid >> 6), lane = tid & 63, wr = wid >> 2, wc = wid & 3, fr = lane & 15, fq = lane >> 4;
    const int K = g.K, nt = K / BK;
    unsigned voffB[2];
#pragma unroll
    for (int i = 0; i < 2; ++i) { int R, C; stage_rc(tid * 16 + i * 8192, R, C); const int Rb = Epi::PERM ? ((R & ~31) + perm32(R & 31)) : R;
        voffB[i] = (unsigned)(Rb * K + C) * 2u; }
    constexpr int SIDE_BYTES = 8192;
    PG8_LAS unsigned char* const side = lds + STAGE_BYTES;
    const size_t kstep = (size_t)(BK * 2);
    const size_t kstepA = ABLK ? (size_t)32768 : kstep;
    const size_t hstep = (size_t)HALF * K * 2;
    const size_t tstep = 2 * hstep;
    const unsigned ldsw = (unsigned)wid * 1024u;
    const int aoff = lds_byte(wr * 64 + fr, fq * 8), boff = lds_byte(wc * 32 + fr, fq * 8);
#define PG8_SA(b, h) (((b) * 2 + (h)) * HTB)
#define PG8_SB(b, h) ((4 + (b) * 2 + (h)) * HTB)
#define PG8_STAGE(bufoff, gbase, voff) do { _Pragma("unroll") for (int _i = 0; _i < 2; ++_i) \
        __builtin_amdgcn_global_load_lds((const unsigned*)((const char*)(gbase) + (voff)[_i]), (PG8_LAS unsigned*)(lds + (bufoff) + ldsw + _i * 8192), 16, 0, 0); } while (0)
#define PG8_LDA(dst, b, h) do { _Pragma("unroll") for (int m = 0; m < 4; ++m) _Pragma("unroll") for (int k = 0; k < 2; ++k) dst[m][k] = *(const PG8_LAS bf16x8*)(lds + PG8_SA(b, h) + aoff + m * 2048 + k * 1024); } while (0)
#define PG8_LDB(dst, b, h) do { _Pragma("unroll") for (int n = 0; n < 2; ++n) _Pragma("unroll") for (int k = 0; k < 2; ++k) dst[n][k] = *(const PG8_LAS bf16x8*)(lds + PG8_SB(b, h) + boff + n * 2048 + k * 1024); } while (0)
#define PG8_MMA(ai, bj, At, Bt) do { __builtin_amdgcn_s_setprio(1); _Pragma("unroll") for (int m = 0; m < 4; ++m) _Pragma("unroll") for (int n = 0; n < 2; ++n) { \
        if constexpr (FP8) mfma8(acc[ai][bj][m][n], cat8(Bt[n][0], Bt[n][1]), cat8(At[m][0], At[m][1]), scl8); \
        else { _Pragma("unroll") for (int k = 0; k < 2; ++k) acc[ai][bj][m][n] = __builtin_amdgcn_mfma_f32_16x16x32_bf16(Bt[n][k], At[m][k], acc[ai][bj][m][n], 0, 0, 0); } } __builtin_amdgcn_s_setprio(0); } while (0)
#define PG8_WAIT_V(n) asm volatile("s_waitcnt vmcnt(" #n ")" ::: "memory")
#define PG8_WAIT_L(n) asm volatile("s_waitcnt lgkmcnt(" #n ")" ::: "memory")
#define PG8_BAR __builtin_amdgcn_s_barrier()
#define PG8_SCHED __builtin_amdgcn_sched_barrier(0)
#define PG8_SETOFFS(o, u) do { _Pragma("unroll") for (int _h = 0; _h < 2; ++_h) _Pragma("unroll") for (int _i = 0; _i < 2; ++_i) { int _R, _C; stage_rc(tid * 16 + _i * 8192, _R, _C); \
        o[_h][_i] = GATHER ? (S.arow(u, _R + HALF * _h) + (unsigned)(_C * 2)) : ABLK ? hblk_off(_R + HALF * _h, _C >> 3) : ((unsigned)((_R + HALF * _h) * K) * 2u + (unsigned)(_C * 2)); } } while (0)
    int scl8 = 0x7F7F7F7F; asm volatile("" : "+v"(scl8));
    Unit cur, nxt; int ui = 0;
    if (!S.next(0, cur)) return;
    f32x4 acc[2][2][4][2];
#pragma unroll
    for (int a = 0; a < 2; ++a)
#pragma unroll
        for (int b = 0; b < 2; ++b)
#pragma unroll
            for (int m = 0; m < 4; ++m)
#pragma unroll
                for (int n = 0; n < 2; ++n) { acc[a][b][m][n] = (f32x4){0.f, 0.f, 0.f, 0.f}; if constexpr (FP8) asm volatile("" : "+v"(acc[a][b][m][n])); }
    bf16x8 At[4][2], B0[2][2], B1[2][2];
    unsigned cAo[2][2];
    PG8_SETOFFS(cAo, cur);
    const char* cA = S.abase(cur, g, tstep); const char* cB = S.bbase(cur, g, tstep);
    S.a_ready(cur);
    PG8_STAGE(PG8_SB(0, 0), cB, voffB); PG8_STAGE(PG8_SB(0, 1), cB + hstep, voffB); PG8_STAGE(PG8_SA(0, 0), cA, cAo[0]); PG8_STAGE(PG8_SA(0, 1), cA, cAo[1]);
    if (wr == 1) PG8_BAR;
    PG8_WAIT_V(2); PG8_BAR;
    PG8_STAGE(PG8_SB(1, 0), cB + kstep, voffB); PG8_STAGE(PG8_SA(1, 0), cA + kstepA, cAo[0]); PG8_STAGE(PG8_SB(1, 1), cB + hstep + kstep, voffB);
    PG8_WAIT_V(6); PG8_BAR;
    for (;;) {
        const bool has_next = S.next(ui + 1, nxt);
        const char* nA = has_next ? S.abase(nxt, g, tstep) : cA; const char* nB = has_next ? S.bbase(nxt, g, tstep) : cB;
        if constexpr (Sched::SIDE) {
            const void* ssrc = S.side_src(cur, (GATHER && has_next) ? nxt : cur, wid, lane);
            __builtin_amdgcn_global_load_lds((const unsigned*)ssrc, (PG8_LAS unsigned*)(side + (ui & 1) * SIDE_BYTES + wid * 1024), 16, 0, 0); }
#pragma unroll 1
        for (int t = 0; t < nt; t += 2) {
            const bool last = (t == nt - 2);
            const char* a1 = cA + (size_t)(t + 1) * kstepA;
            const char* a2 = last ? nA : cA + (size_t)(t + 2) * kstepA; const char* b2 = last ? nB : cB + (size_t)(t + 2) * kstep;
            const char* a3 = a2 + kstepA; const char* b3 = b2 + kstep;
            if (last && has_next) S.a_ready(nxt);
            PG8_LDB(B0, 0, 0); PG8_LDB(B1, 0, 1); PG8_SCHED; PG8_LDA(At, 0, 0); PG8_STAGE(PG8_SA(1, 1), a1, cAo[1]);
            if constexpr (GATHER) { if (last && has_next) {
                const PG8_LAS unsigned char* sdn = side + (ui & 1) * SIDE_BYTES;
#pragma unroll
                for (int _h = 0; _h < 2; ++_h)
#pragma unroll
                    for (int _i = 0; _i < 2; ++_i) { int _R, _C; stage_rc(tid * 16 + _i * 8192, _R, _C); cAo[_h][_i] = S.arow_side(nxt, _R + HALF * _h, sdn) + (unsigned)(_C * 2); } } }
            PG8_WAIT_V(8); PG8_WAIT_L(0); PG8_BAR; PG8_MMA(0, 0, At, B0); PG8_MMA(0, 1, At, B1); PG8_BAR; PG8_SCHED;
            PG8_LDA(At, 0, 1); PG8_STAGE(PG8_SB(0, 0), b2, voffB); PG8_STAGE(PG8_SB(0, 1), b2 + hstep, voffB); PG8_STAGE(PG8_SA(0, 0), a2, cAo[0]);
            PG8_WAIT_V(8); PG8_WAIT_L(0); PG8_BAR; PG8_MMA(1, 0, At, B0); PG8_MMA(1, 1, At, B1); PG8_BAR; PG8_SCHED;
            PG8_LDB(B0, 1, 0); PG8_LDB(B1, 1, 1); PG8_SCHED; PG8_LDA(At, 1, 0); PG8_STAGE(PG8_SA(0, 1), a2, cAo[1]);
            PG8_WAIT_V(8); PG8_WAIT_L(0); PG8_BAR; PG8_MMA(0, 0, At, B0); PG8_MMA(0, 1, At, B1); PG8_BAR; PG8_SCHED;
            PG8_LDA(At, 1, 1); PG8_STAGE(PG8_SB(1, 0), b3, voffB); PG8_STAGE(PG8_SB(1, 1), b3 + hstep, voffB); PG8_STAGE(PG8_SA(1, 0), a3, cAo[0]);
            PG8_WAIT_V(8); PG8_WAIT_L(0); PG8_BAR; PG8_MMA(1, 0, At, B0); PG8_MMA(1, 1, At, B1); PG8_BAR; PG8_SCHED;
        }
        if constexpr (ALIGN_EPI) { if (wr == 0) PG8_BAR; }
        if constexpr (FP8) asm volatile("s_nop 15\n\ts_nop 15" ::: "memory");
        PG8_SCHED; E(acc, cur, wr, wc, fr, fq, side + (ui & 1) * SIDE_BYTES); S.done(cur); PG8_SCHED;
        if (!has_next) break;
#pragma unroll
        for (int a = 0; a < 2; ++a)
#pragma unroll
            for (int b = 0; b < 2; ++b)
#pragma unroll
                for (int m = 0; m < 4; ++m)
#pragma unroll
                    for (int n = 0; n < 2; ++n) { acc[a][b][m][n] = (f32x4){0.f, 0.f, 0.f, 0.f}; if constexpr (FP8) asm volatile("" : "+v"(acc[a][b][m][n])); }
        cur = nxt; cA = nA; cB = nB; ++ui;
        if constexpr (ALIGN_EPI) { if (wr == 1) PG8_BAR; }
    }
    PG8_WAIT_V(0);
    if constexpr (!ALIGN_EPI) { if (wr == 0) PG8_BAR; }
    PG8_BAR;
#undef PG8_SA
#undef PG8_SB
#undef PG8_STAGE
#undef PG8_LDA
#undef PG8_LDB
#undef PG8_MMA
#undef PG8_WAIT_V
#undef PG8_WAIT_L
#undef PG8_BAR
#undef PG8_SCHED
#undef PG8_SETOFFS
}
}

constexpr int NB = 8, SEQ = 4096, DM = 1024, MROWS = NB * SEQ, NLAYER = 2;
constexpr int NPROJ = 4608, INW = 4616;
constexpr int C_Q = 0, C_K = 512, C_V = 1024, C_Z = 1536, C_XS = 2048, C_SB = 3072, C_SC = 3584, C_SH = 4096;
constexpr int MIXW = 1536, NEXP = 32, TOPK = 4, FF = 1024;
constexpr float ALPHA = 1.4142135623730951f;
constexpr float LN_EPS = 1e-5f, RMS_EPS = 1e-5f;
constexpr float QSCALE = 0.125f * 1.4426950408889634f;

constexpr size_t MiB = 1u << 20;
constexpr size_t WS_CTL = 0, CTL_ZERO_BYTES = 1 * MiB;
constexpr size_t WS_ROPE = 1 * MiB;
constexpr size_t WS_WDT = 2 * MiB;
constexpr size_t WS_ROUT = 2 * MiB + 65536;
constexpr size_t WS_WIN = 4 * MiB;
constexpr size_t WS_WOUT = 24 * MiB;
constexpr size_t WS_WGU = 32 * MiB;
constexpr size_t WS_WDN = 288 * MiB;
constexpr size_t WS_XB = 416 * MiB;
constexpr size_t WS_XF = 480 * MiB;
constexpr size_t WS_XF2 = 608 * MiB;
constexpr size_t WS_PROJ = 736 * MiB;
constexpr size_t WS_DT = 1024 * MiB;
constexpr size_t WS_DTS = 1025 * MiB;
constexpr size_t WS_ACUM = 1026 * MiB;
constexpr size_t WS_LSE = 1027 * MiB;
constexpr size_t WS_OP = 1030 * MiB;
constexpr size_t WS_U = 1126 * MiB;
constexpr size_t WS_G = 1190 * MiB;
constexpr size_t WS_ST = 1222 * MiB;
constexpr size_t WS_YD = 1286 * MiB;
constexpr size_t WS_MIXED = 1350 * MiB;
constexpr size_t WS_MIXF = 1446 * MiB;
constexpr size_t WS_TOPE = 1574 * MiB;
constexpr size_t WS_TOPG = 1575 * MiB;
constexpr size_t WS_ROWTOK = 1576 * MiB;
constexpr size_t WS_ROWGATE = 1580 * MiB;
constexpr size_t WS_H = 736 * MiB;
constexpr size_t WS_YB = 1030 * MiB;
constexpr size_t WS_END = 1584 * MiB;
constexpr int CW_TMO = 0;
constexpr int CW_CNT = 64;
constexpr int CW_BAR = 4096;

constexpr int RING_OFF = 0, RING_BYTES = 131072;
constexpr int LDSCTL_OFF = 155648;
constexpr int L_MISC = LDSCTL_OFF;
constexpr int L_TSTART = LDSCTL_OFF + 256;
constexpr int L_CNT = LDSCTL_OFF + 512;
constexpr int L_LCNT = LDSCTL_OFF + 640;
constexpr int L_LBASE = LDSCTL_OFF + 768;
constexpr int L_UNITS = LDSCTL_OFF + 1024;
constexpr int L_UNITSN = LDSCTL_OFF + 2048;
constexpr int LDS_BYTES = 163840;

#define GAS __attribute__((address_space(1)))
#define LAS __attribute__((address_space(3)))
typedef unsigned short bf16;
typedef unsigned v4u __attribute__((ext_vector_type(4)));
typedef unsigned v2u __attribute__((ext_vector_type(2)));
typedef float f32x4 __attribute__((ext_vector_type(4)));
typedef float f32x16 __attribute__((ext_vector_type(16)));
typedef short bf16x8 __attribute__((ext_vector_type(8)));
typedef GAS unsigned gu32;
#define RLX_AGENT __ATOMIC_RELAXED, __HIP_MEMORY_SCOPE_AGENT
#define LDS_WAIT() asm volatile("s_waitcnt lgkmcnt(0)" ::: "memory")
#define VM_WAIT() asm volatile("s_waitcnt vmcnt(0)" ::: "memory")
__device__ __forceinline__ unsigned f2bf(float f) { unsigned u = __builtin_bit_cast(unsigned, f); return (u + 0x7fffu + ((u >> 16) & 1u)) >> 16; }
__device__ __forceinline__ unsigned pk2(float lo, float hi) { unsigned r; asm volatile("v_cvt_pk_bf16_f32 %0, %1, %2" : "=v"(r) : "v"(lo), "v"(hi)); return r; }
__device__ __forceinline__ float bf2f(unsigned short b) { return __builtin_bit_cast(float, (unsigned)b << 16); }
__device__ __forceinline__ float bflo(unsigned w) { return __builtin_bit_cast(float, w << 16); }
__device__ __forceinline__ float bfhi(unsigned w) { return __builtin_bit_cast(float, w & 0xffff0000u); }
__device__ __forceinline__ float siluf(float x) { return x * __builtin_amdgcn_rcpf(1.0f + __builtin_amdgcn_exp2f(-1.4426950408889634f * x)); }
#define XB_TMO      128
#define XB_XCNT(j)  (256  + 64 * (j))
#define XB_XSUB(j)  (1280 + 64 * (j))
#define XB_XGEN(j)  (2304 + 64 * (j))
#define XB_TOP      3328
#define XB_TOPGEN   3392
#define XCD_BAR_WORDS 3456
#define XB_SPIN_CAP (1u << 18)

__device__ __forceinline__ unsigned xb_ld(unsigned* p)              { return __hip_atomic_load(p, __ATOMIC_RELAXED, __HIP_MEMORY_SCOPE_AGENT); }
__device__ __forceinline__ unsigned xb_add(unsigned* p, unsigned v) { return __hip_atomic_fetch_add(p, v, __ATOMIC_RELAXED, __HIP_MEMORY_SCOPE_AGENT); }
__device__ __forceinline__ unsigned xb_xcc_id() { return (unsigned)__builtin_amdgcn_s_getreg((3 << 11) | 20) & 0xFu; }
#define XB_SPIN(cond, bar) do { unsigned _sp = 0; while (cond) { __builtin_amdgcn_s_sleep(1); \
    if ((++_sp & 255u) == 0u) { if (xb_ld(&(bar)[XB_TMO])) break; if (_sp > XB_SPIN_CAP) { atomicAdd(&(bar)[XB_TMO], 1u); break; } } } } while (0)

struct XcdBarrier {
    unsigned* bar; unsigned x;
    volatile LAS unsigned* st;
};

__device__ __forceinline__ XcdBarrier xcd_barrier_post(unsigned* bar, volatile LAS unsigned* st) {
    XcdBarrier b; b.bar = bar; b.x = xb_xcc_id(); b.st = st;
    if (threadIdx.x == 0) (void)xb_add(&bar[XB_XCNT(b.x)], 1u);
    return b;
}
__device__ __forceinline__ void xcd_barrier_complete(unsigned* bar, unsigned x, unsigned& nloc, unsigned& nx) {
    const unsigned G = gridDim.x * gridDim.y * gridDim.z;
    unsigned sum, cnt, mine, sp = 0u;
    for (;;) {
        sum = 0u; cnt = 0u; mine = 0u;
#pragma unroll
        for (unsigned j = 0; j < 16; ++j) { const unsigned c = xb_ld(&bar[XB_XCNT(j)]); sum += c; cnt += (c > 0u) ? 1u : 0u; mine = (j == x) ? c : mine; }
        if (sum == G) break;
        __builtin_amdgcn_s_sleep(1);
        if ((++sp & 255u) == 0u) { if (xb_ld(&bar[XB_TMO])) break; if (sp > XB_SPIN_CAP) { atomicAdd(&bar[XB_TMO], 1u); break; } }
    }
    nloc = mine > 0u ? mine : 1u; nx = cnt > 0u ? cnt : 1u;
}

__device__ __forceinline__ void xcd_barrier(const XcdBarrier& b) {
    asm volatile("s_waitcnt vmcnt(0)" ::: "memory");
    __syncthreads();
    if (threadIdx.x == 0) {
        unsigned* bar = b.bar;
        __builtin_amdgcn_s_waitcnt(0);
        unsigned nloc = b.st[0], nx = b.st[1];
        if (nloc == 0u) { xcd_barrier_complete(bar, b.x, nloc, nx); b.st[0] = nloc; b.st[1] = nx; }
        const unsigned old = xb_add(&bar[XB_XSUB(b.x)], 1u);
        const unsigned gen = old / nloc;
        if (old + 1u == (gen + 1u) * nloc) {
            __builtin_amdgcn_fence(__ATOMIC_RELEASE, "agent");
            asm volatile("s_waitcnt vmcnt(0)" ::: "memory");
            const unsigned og = xb_add(&bar[XB_TOP], 1u);
            const unsigned tg = og / nx;
            if (og + 1u == (tg + 1u) * nx) xb_add(&bar[XB_TOPGEN], 1u);
            else XB_SPIN(xb_ld(&bar[XB_TOPGEN]) == tg, bar);
            __builtin_amdgcn_fence(__ATOMIC_ACQUIRE, "agent");
            xb_add(&bar[XB_XGEN(b.x)], 1u);
            asm volatile("s_waitcnt vmcnt(0)" ::: "memory");
        } else {
            XB_SPIN(xb_ld(&bar[XB_XGEN(b.x)]) == gen, bar);
            __builtin_amdgcn_fence(__ATOMIC_ACQUIRE, "agent");
            asm volatile("s_waitcnt vmcnt(0)" ::: "memory");
        }
    }
    __syncthreads();
}

constexpr float SC_X = 4.f, SC_WGU = 32.f, SC_H = 4.f, SC_WDN = 64.f, SC_Y = 16.f, SC_WIN = 32.f;
__device__ __forceinline__ float wave_sum(float v) {
#pragma unroll
    for (int o = 1; o < 64; o <<= 1) v += __shfl_xor(v, o);
    return v;
}
__device__ __forceinline__ int win_dest_row(int n) {
    if (n < 1024) { const int hh = n >> 6, d = n & 63; const int p = (d < 32) ? (8 * (d >> 2) + (d & 3)) : (8 * ((d - 32) >> 2) + 4 + (d & 3)); return hh * 64 + p; }
    if (n < 3072) return n;
    if (n < 3080) return -1;
    return n - 8;
}
__device__ __forceinline__ int wgu_dest_row(int n) { return n < 1024 ? ((n >> 7) * 256 + (n & 127)) : (((n - 1024) >> 7) * 256 + 128 + ((n - 1024) & 127)); }
template <int MAP>
__device__ __forceinline__ void p0_transpose_item(const float* W, int K, int N, bf16* WT, float* wdt, LAS float* scr, int kb, int nb, int lane) {
    const int k0 = 64 * kb, n0 = 32 * nb;
    const int nn = n0 + (lane & 31); const bool nok = nn < N;
#pragma unroll 8
    for (int i = 0; i < 32; ++i) { const int kk = 2 * i + (lane >> 5); scr[kk * 33 + (lane & 31)] = nok ? W[(size_t)(k0 + kk) * N + nn] : 0.f; }
    LDS_WAIT(); asm volatile("" ::: "memory");
    const int c = lane & 7;
#pragma unroll
    for (int j = 0; j < 4; ++j) { const int n = (lane >> 3) + 8 * j; const LAS float* s = scr + (8 * c) * 33 + n;
        const int nsrc = n0 + n; if (nsrc >= N) continue;
        int drow = nsrc; if (MAP == 1) drow = win_dest_row(nsrc); if (MAP == 2) drow = wgu_dest_row(nsrc);
        if (MAP == 1 && drow < 0) { float* d = wdt + (size_t)(nsrc - 3072) * 1024 + k0 + 8 * c;
#pragma unroll
            for (int q = 0; q < 8; ++q) d[q] = s[q * 33]; continue; }
        v4u o; o.x = pk2(s[0 * 33], s[1 * 33]); o.y = pk2(s[2 * 33], s[3 * 33]); o.z = pk2(s[4 * 33], s[5 * 33]); o.w = pk2(s[6 * 33], s[7 * 33]);
        *(GAS v4u*)(WT + (size_t)drow * K + k0 + 8 * c) = o; }
    LDS_WAIT(); asm volatile("" ::: "memory");
}
template <int MAP>
__device__ __forceinline__ void p0_transpose_item64(const float* W, int K, int N, bf16* WT, float* wdt, LAS float* scr, int kb, int nb, int lane) {
    const int k0 = 64 * kb, n0 = 64 * nb;
    const bool lok = (n0 + 4 * (lane & 15) + 3) < N;
    f32x4 ld[16];
#pragma unroll
    for (int i = 0; i < 16; ++i) ld[i] = lok ? *(const f32x4*)(W + (size_t)(k0 + 4 * i + (lane >> 4)) * N + n0 + 4 * (lane & 15)) : (f32x4){0.f, 0.f, 0.f, 0.f};
#pragma unroll
    for (int i = 0; i < 16; ++i) *(LAS f32x4*)(scr + (4 * i + (lane >> 4)) * 64 + 4 * (lane & 15)) = ld[i];
    LDS_WAIT(); asm volatile("" ::: "memory");
    const int nsrc = n0 + lane;
    if (nsrc < N) {
        int drow = nsrc; if (MAP == 1) drow = win_dest_row(nsrc);
        if (MAP == 1 && drow < 0) { float* d = wdt + (size_t)(nsrc - 3072) * 1024 + k0;
#pragma unroll
            for (int q = 0; q < 16; ++q) *(f32x4*)(d + 4 * q) = (f32x4){scr[(4 * q) * 64 + lane], scr[(4 * q + 1) * 64 + lane], scr[(4 * q + 2) * 64 + lane], scr[(4 * q + 3) * 64 + lane]}; }
        else { GAS v4u* d = (GAS v4u*)(WT + (size_t)drow * K + k0);
#pragma unroll
            for (int q = 0; q < 8; ++q) { v4u o; o.x = pk2(scr[(8 * q) * 64 + lane], scr[(8 * q + 1) * 64 + lane]); o.y = pk2(scr[(8 * q + 2) * 64 + lane], scr[(8 * q + 3) * 64 + lane]);
                o.z = pk2(scr[(8 * q + 4) * 64 + lane], scr[(8 * q + 5) * 64 + lane]); o.w = pk2(scr[(8 * q + 6) * 64 + lane], scr[(8 * q + 7) * 64 + lane]); d[q] = o; } } }
    LDS_WAIT(); asm volatile("" ::: "memory");
}
struct SubT { const float* src; unsigned char* dst; int N; int n0; int mode; float scale; };
__device__ __forceinline__ SubT fp8_subtile(int item, int half, const float* wgu, const float* wdn, const float* win, unsigned char* WG8, unsigned char* WD8, unsigned char* WI8, int lane) {
    SubT t; int kb, nb;
    if (item < 64 * 256) { const int le = item >> 8, r = item & 255; kb = r >> 5; nb = r & 31; t.N = 2048; t.mode = 1; t.scale = SC_WGU;
        t.src = wgu + (size_t)le * 1024 * 2048; t.dst = WG8 + (size_t)le * 2048 * 1024; }
    else if (item < 64 * 256 + 64 * 128) { const int it2 = item - 64 * 256; const int le = it2 >> 7, r = it2 & 127; kb = r >> 4; nb = r & 15; t.N = 1024; t.mode = 0; t.scale = SC_WDN;
        t.src = wdn + (size_t)le * 1024 * 1024; t.dst = WD8 + (size_t)le * 1024 * 1024; }
    else { const int it3 = item - (64 * 256 + 64 * 128); const int l = it3 / 192, r = it3 % 192; kb = r / 24; nb = r % 24; t.N = INW; t.mode = 2; t.scale = SC_WIN;
        t.src = win + (size_t)l * 1024 * INW; t.dst = WI8 + (size_t)l * 1536 * 1024; }
    const int k0 = 128 * kb + 64 * half; t.n0 = 64 * nb;
    t.src += (size_t)(k0 + (lane >> 4)) * t.N + t.n0 + 4 * (lane & 15);
    t.dst += (size_t)k0;
    return t;
}
__device__ __forceinline__ void fp8_sub_load(const SubT& t, f32x4 (&ld)[16]) {
#pragma unroll
    for (int i = 0; i < 16; ++i) ld[i] = __builtin_nontemporal_load((const f32x4*)(t.src + (size_t)(4 * i) * t.N));
}
__device__ __forceinline__ void fp8_sub_process(const SubT& t, const f32x4 (&ld)[16], LAS float* scr, int lane) {
#pragma unroll
    for (int i = 0; i < 16; ++i) *(LAS f32x4*)(scr + (4 * i + (lane >> 4)) * 64 + 4 * (lane & 15)) = ld[i];
    LDS_WAIT(); asm volatile("" ::: "memory");
    unsigned w[16];
#pragma unroll
    for (int q = 0; q < 16; ++q) w[q] = pg8::pk4_fp8(scr[(4 * q + 0) * 64 + lane] * t.scale, scr[(4 * q + 1) * 64 + lane] * t.scale, scr[(4 * q + 2) * 64 + lane] * t.scale, scr[(4 * q + 3) * 64 + lane] * t.scale);
    LDS_WAIT(); asm volatile("" ::: "memory");
    LAS unsigned char* t2 = (LAS unsigned char*)scr;
#pragma unroll
    for (int q = 0; q < 4; ++q) *(LAS v4u*)(t2 + lane * 80 + 16 * q) = (v4u){w[4 * q], w[4 * q + 1], w[4 * q + 2], w[4 * q + 3]};
    LDS_WAIT(); asm volatile("" ::: "memory");
#pragma unroll
    for (int q = 0; q < 4; ++q) { const int n = 16 * q + (lane >> 2); const v4u v = *(const LAS v4u*)(t2 + n * 80 + 16 * (lane & 3));
        const int nn = (t.mode == 1) ? wgu_dest_row(t.n0 + n) : (t.mode == 2) ? win_dest_row(t.n0 + n) : (t.n0 + n);
        *(GAS v4u*)(t.dst + (size_t)nn * 1024 + 16 * (lane & 3)) = v; }
    LDS_WAIT(); asm volatile("" ::: "memory");
}
__device__ __forceinline__ void row_dt(const f32x4 (&v)[4], const float* wdt, float* dst, int lane) {
    float r[8];
#pragma unroll
    for (int jj = 0; jj < 8; ++jj) { float s = 0.f;
#pragma unroll
        for (int j = 0; j < 4; ++j) { const f32x4 w = *(const f32x4*)(wdt + jj * 1024 + 4 * lane + 256 * j); s += v[j][0] * w[0] + v[j][1] * w[1] + v[j][2] * w[2] + v[j][3] * w[3]; }
        r[jj] = wave_sum(s); }
    if (lane == 0) { *(f32x4*)dst = (f32x4){r[0], r[1], r[2], r[3]}; *(f32x4*)(dst + 4) = (f32x4){r[4], r[5], r[6], r[7]}; }
}
__device__ __forceinline__ void row_dt_win(const f32x4 (&v)[4], const float* win, float* dst, int lane) {
    float r[8];
#pragma unroll
    for (int jj = 0; jj < 8; ++jj) r[jj] = 0.f;
#pragma unroll
    for (int j = 0; j < 4; ++j)
#pragma unroll
        for (int e = 0; e < 4; ++e) { const float* wp = win + (size_t)(4 * lane + 256 * j + e) * INW + 3072; const f32x4 w0 = *(const f32x4*)wp, w1 = *(const f32x4*)(wp + 4); const float x = v[j][e];
            r[0] += x * w0[0]; r[1] += x * w0[1]; r[2] += x * w0[2]; r[3] += x * w0[3]; r[4] += x * w1[0]; r[5] += x * w1[1]; r[6] += x * w1[2]; r[7] += x * w1[3]; }
#pragma unroll
    for (int jj = 0; jj < 8; ++jj) r[jj] = wave_sum(r[jj]);
    if (lane == 0) { *(f32x4*)dst = (f32x4){r[0], r[1], r[2], r[3]}; *(f32x4*)(dst + 4) = (f32x4){r[4], r[5], r[6], r[7]}; }
}
template <bool W8, bool WF>
__device__ __forceinline__ void ln_row(f32x4 (&v)[4], const float* gam, const float* bet, float* of32, bf16* ob16, unsigned char* o8, float s8, int lane) {
    float s = 0.f;
#pragma unroll
    for (int j = 0; j < 4; ++j) s += (v[j][0] + v[j][1]) + (v[j][2] + v[j][3]);
    const float mean = wave_sum(s) * (1.f / DM); float s2 = 0.f;
#pragma unroll
    for (int j = 0; j < 4; ++j) { v[j] = v[j] - mean; s2 += (v[j][0] * v[j][0] + v[j][1] * v[j][1]) + (v[j][2] * v[j][2] + v[j][3] * v[j][3]); }
    const float rstd = 1.f / sqrtf(wave_sum(s2) * (1.f / DM) + LN_EPS);
#pragma unroll
    for (int j = 0; j < 4; ++j) { const f32x4 g = *(const f32x4*)(gam + 4 * lane + 256 * j), b = *(const f32x4*)(bet + 4 * lane + 256 * j);
        v[j] = v[j] * rstd * g + b;
        if (WF) *(f32x4*)(of32 + 4 * lane + 256 * j) = v[j];
        v2u w; w.x = pk2(v[j][0], v[j][1]); w.y = pk2(v[j][2], v[j][3]); *(v2u*)(ob16 + 4 * lane + 256 * j) = w;
        if (W8) *(unsigned*)(o8 + 4 * lane + 256 * j) = pg8::pk4_fp8(v[j][0] * s8, v[j][1] * s8, v[j][2] * s8, v[j][3] * s8); }
}


typedef short v4i16_t __attribute__((ext_vector_type(4)));
__device__ __forceinline__ bf16x8 tr_pair(const LAS unsigned char* p0, const LAS unsigned char* p1) {
    const v4i16_t a = __builtin_amdgcn_ds_read_tr16_b64_v4i16((LAS v4i16_t*)p0), b = __builtin_amdgcn_ds_read_tr16_b64_v4i16((LAS v4i16_t*)p1);
    return (bf16x8){a[0], a[1], a[2], a[3], b[0], b[1], b[2], b[3]};
}
__device__ __forceinline__ int crow16(int r, int hi) { return (r & 3) + 8 * (r >> 2) + 4 * hi; }
constexpr int AK_PITCH = 144, AV_PITCH = 192, AK_TILE = 32 * AK_PITCH, AV_TILE = 32 * AV_PITCH;
constexpr int AT_K = 0, AT_V = 12 * AK_TILE;
struct AttnItem { int p, b, h, d, r, qt0; };
__device__ __forceinline__ AttnItem attn_item(int I) { AttnItem a; a.p = I >> 10; const int rem = I & 1023; a.b = rem >> 7; a.h = (rem >> 4) & 7; const int grp = rem & 15;
    a.d = (a.p == 0) ? 1 : (a.p == 1) ? 4 : 16; const int tpr = 128 / a.d; const int T = grp * 8; a.r = T / tpr; a.qt0 = T % tpr; return a; }
__device__ __forceinline__ void attn_request(const bf16* PROJ, const AttnItem& a, v4u (&st)[12], int tid) {
    const int rr = tid >> 4, ch = tid & 15; const int col = (ch < 8 ? C_K : C_V - 64) + a.h * 64 + ch * 8;
#pragma unroll
    for (int tl = 0; tl < 12; ++tl) { const int kt = a.qt0 - 4 + tl; st[tl] = (v4u){0u, 0u, 0u, 0u};
        if (kt >= 0) { const size_t row = (size_t)a.b * SEQ + (size_t)(32 * kt + rr) * a.d + a.r; st[tl] = *(const v4u*)(PROJ + row * NPROJ + col); } }
}
__device__ __forceinline__ void attn_deposit(LAS unsigned char* al, const v4u (&st)[12], int tid) {
    const int rr = tid >> 4, ch = tid & 15;
    LAS unsigned char* dst = (ch < 8) ? (al + AT_K + rr * AK_PITCH + ch * 16) : (al + AT_V + rr * AV_PITCH + (ch - 8) * 16); const int tstep = (ch < 8) ? AK_TILE : AV_TILE;
#pragma unroll
    for (int tl = 0; tl < 12; ++tl) *(LAS v4u*)(dst + tl * tstep) = st[tl];
}
__device__ __forceinline__ void attn_wave_compute(const bf16* PROJ, bf16* OPp, float* LSEp, const AttnItem& a, const LAS unsigned char* al, int wave, int lane) {
    const int i = lane & 31, h2 = lane >> 5; const int qt = a.qt0 + wave;
    const size_t rowq = (size_t)a.b * SEQ + (size_t)(32 * qt + i) * a.d + a.r;
    bf16x8 qf[4];
    { const bf16* qp = PROJ + rowq * NPROJ + C_Q + a.h * 64 + 8 * h2;
#pragma unroll
      for (int s = 0; s < 4; ++s) qf[s] = *(const bf16x8*)(qp + 16 * s); }
    f32x16 o0 = {}, o1 = {}; float mrun = -INFINITY, lrun = 0.f;
    const int kt0 = qt > 4 ? qt - 4 : 0;
    const LAS unsigned char* krd = al + AT_K + i * AK_PITCH + 16 * h2;
    const LAS unsigned char* trb = al + AT_V + (4 * h2 + ((lane & 15) >> 2)) * AV_PITCH + (16 * ((lane >> 4) & 1) + 4 * (lane & 3)) * 2;
#pragma unroll 1
    for (int kt = kt0; kt <= qt; ++kt) {
        const int tl = kt - a.qt0 + 4;
        const LAS unsigned char* kp = krd + tl * AK_TILE; const LAS unsigned char* vp = trb + tl * AV_TILE;
        f32x16 sacc = {};
#pragma unroll
        for (int s = 0; s < 4; ++s) sacc = __builtin_amdgcn_mfma_f32_32x32x16_bf16(*(const LAS bf16x8*)(kp + 32 * s), qf[s], sacc, 0, 0, 0);
        if (kt == qt) {
#pragma unroll
            for (int rg = 0; rg < 16; ++rg) if (crow16(rg, h2) > i) sacc[rg] = -INFINITY;
        }
        if (kt + 4 == qt) {
#pragma unroll
            for (int rg = 0; rg < 16; ++rg) if (crow16(rg, h2) < i) sacc[rg] = -INFINITY;
        }
        float mx = sacc[0];
#pragma unroll
        for (int rg = 1; rg < 16; ++rg) mx = fmaxf(mx, sacc[rg]);
        mx = fmaxf(mx, __shfl_xor(mx, 32));
        const float mnew = fmaxf(mrun, mx), alpha = __builtin_amdgcn_exp2f(mrun - mnew); mrun = mnew;
        float ps = 0.f;
#pragma unroll
        for (int rg = 0; rg < 16; ++rg) { sacc[rg] = __builtin_amdgcn_exp2f(sacc[rg] - mnew); ps += sacc[rg]; }
        lrun = lrun * alpha + ps;
#pragma unroll
        for (int rg = 0; rg < 16; ++rg) { o0[rg] *= alpha; o1[rg] *= alpha; }
        bf16x8 pf[2];
#pragma unroll
        for (int ks = 0; ks < 2; ++ks) { v4u w; w.x = pg8::cvt_pk_bf16(sacc[8 * ks + 0], sacc[8 * ks + 1]); w.y = pg8::cvt_pk_bf16(sacc[8 * ks + 2], sacc[8 * ks + 3]); w.z = pg8::cvt_pk_bf16(sacc[8 * ks + 4], sacc[8 * ks + 5]); w.w = pg8::cvt_pk_bf16(sacc[8 * ks + 6], sacc[8 * ks + 7]); pf[ks] = __builtin_bit_cast(bf16x8, w); }
#pragma unroll
        for (int ks = 0; ks < 2; ++ks) {
            const bf16x8 v0 = tr_pair(vp + (16 * ks) * AV_PITCH, vp + (16 * ks + 8) * AV_PITCH);
            const bf16x8 v1 = tr_pair(vp + (16 * ks) * AV_PITCH + 64, vp + (16 * ks + 8) * AV_PITCH + 64);
            o0 = __builtin_amdgcn_mfma_f32_32x32x16_bf16(v0, pf[ks], o0, 0, 0, 0);
            o1 = __builtin_amdgcn_mfma_f32_32x32x16_bf16(v1, pf[ks], o1, 0, 0, 0);
        }
    }
    const float lt = lrun + __shfl_xor(lrun, 32); const float il = 1.0f / lt;
    bf16* op = OPp + rowq * 512 + a.h * 64 + 4 * h2;
#pragma unroll
    for (int g4 = 0; g4 < 4; ++g4) {
        v2u w0, w1; w0.x = pg8::cvt_pk_bf16(o0[4 * g4 + 0] * il, o0[4 * g4 + 1] * il); w0.y = pg8::cvt_pk_bf16(o0[4 * g4 + 2] * il, o0[4 * g4 + 3] * il);
        w1.x = pg8::cvt_pk_bf16(o1[4 * g4 + 0] * il, o1[4 * g4 + 1] * il); w1.y = pg8::cvt_pk_bf16(o1[4 * g4 + 2] * il, o1[4 * g4 + 3] * il);
        *(v2u*)(op + 8 * g4) = w0; *(v2u*)(op + 32 + 8 * g4) = w1; }
    if (h2 == 0) LSEp[rowq * 8 + a.h] = mrun + log2f(lt);
}
__device__ __forceinline__ void attn_phase(LAS unsigned char* al, const bf16* PROJ, bf16* OP, float* LSE, int bid, int G, int tid, int wave, int lane) {
    v4u st[12];
    int I = bid;
    if (I < 3072) { const AttnItem a = attn_item(I); attn_request(PROJ, a, st, tid); }
    for (; I < 3072; I += G) {
        const AttnItem a = attn_item(I);
        __syncthreads();
        attn_deposit(al, st, tid);
        __syncthreads();
        if (I + G < 3072) { const AttnItem n = attn_item(I + G); attn_request(PROJ, n, st, tid); }
        attn_wave_compute(PROJ, OP + (size_t)a.p * MROWS * 512, LSE + (size_t)a.p * MROWS * 8, a, al, wave, lane);
    }
    __syncthreads();
}

constexpr int SS_DTS = 0, SS_ACUM = 2048, SS_TMP = 4096, SS_SSX = 6144, SS_IMG = 8192;
constexpr int S1_PB = 320, S1_PX = 576;
constexpr int S1_B = SS_IMG, S1_X = SS_IMG + 128 * S1_PB;
constexpr int S3_PBC = 272, S3_PX = 576;
constexpr int S3_B = SS_IMG, S3_C = S3_B + 128 * S3_PBC, S3_X = S3_C + 128 * S3_PBC;

__device__ __forceinline__ void ssd_prep(LAS unsigned char* sl, const float* DT, const float* dtb, const float* alog, size_t row0, int g, int tid, int lane, int wave) {
    LAS float* dts = (LAS float*)(sl + SS_DTS); LAS float* acum = (LAS float*)(sl + SS_ACUM); LAS float* tmp = (LAS float*)(sl + SS_TMP);
    { const int l = tid >> 2, hq = tid & 3; const float x = DT[(row0 + l) * 8 + 4 * g + hq] + dtb[4 * g + hq];
      const float dt = x > 20.f ? x : log1pf(__expf(x)); dts[hq * 128 + l] = dt; tmp[hq * 128 + l] = dt * (-__expf(alog[4 * g + hq])); }
    __syncthreads();
    if (wave < 4) { const float v0 = tmp[wave * 128 + 2 * lane], v1 = tmp[wave * 128 + 2 * lane + 1]; float s = v0 + v1;
#pragma unroll
        for (int off = 1; off < 64; off <<= 1) { const float t = __shfl_up(s, off); if (lane >= off) s += t; }
        acum[wave * 128 + 2 * lane] = s - v1; acum[wave * 128 + 2 * lane + 1] = s; }
    __syncthreads();
}
template <int NCOLS, int FACMODE>
__device__ __forceinline__ void conv_tile(const bf16* PROJ, size_t row0, int t0, int pcol0, const float* cw, const float* cb, int cch0, LAS unsigned char* dst, int pitch, const LAS unsigned char* sl, int hq0, int tid) {
    constexpr int NCH8 = NCOLS / 8, NSEG = 512 / NCH8, RPS = 128 / NSEG;
    const int c8 = tid % NCH8, seg = tid / NCH8, l0 = seg * RPS;
    float w[4][8], bias[8], hst[3][8];
#pragma unroll
    for (int k = 0; k < 4; ++k) { const f32x4 a = *(const f32x4*)(cw + k * 1024 + cch0 + c8 * 8), b = *(const f32x4*)(cw + k * 1024 + cch0 + c8 * 8 + 4);
        w[k][0] = a[0]; w[k][1] = a[1]; w[k][2] = a[2]; w[k][3] = a[3]; w[k][4] = b[0]; w[k][5] = b[1]; w[k][6] = b[2]; w[k][7] = b[3]; }
    { const f32x4 a = *(const f32x4*)(cb + cch0 + c8 * 8), b = *(const f32x4*)(cb + cch0 + c8 * 8 + 4);
      bias[0] = a[0]; bias[1] = a[1]; bias[2] = a[2]; bias[3] = a[3]; bias[4] = b[0]; bias[5] = b[1]; bias[6] = b[2]; bias[7] = b[3]; }
    const bf16* src = PROJ + pcol0 + c8 * 8;
#pragma unroll
    for (int k = 0; k < 3; ++k) { const int l = l0 - 3 + k; v4u v = (v4u){0u, 0u, 0u, 0u}; if (t0 + l >= 0) v = *(const v4u*)(src + (size_t)((long)row0 + l) * NPROJ);
        hst[k][0] = bflo(v.x); hst[k][1] = bfhi(v.x); hst[k][2] = bflo(v.y); hst[k][3] = bfhi(v.y); hst[k][4] = bflo(v.z); hst[k][5] = bfhi(v.z); hst[k][6] = bflo(v.w); hst[k][7] = bfhi(v.w); }
    const LAS float* dts = (const LAS float*)(sl + SS_DTS); const LAS float* acum = (const LAS float*)(sl + SS_ACUM);
    const int hq = hq0 + (c8 * 8) / 64;
    const float alast = (FACMODE == 2) ? acum[hq * 128 + 127] : 0.f;
#pragma unroll
    for (int rr = 0; rr < RPS; ++rr) { const int l = l0 + rr; const v4u v = *(const v4u*)(src + (row0 + l) * NPROJ);
        float cur[8]; cur[0] = bflo(v.x); cur[1] = bfhi(v.x); cur[2] = bflo(v.y); cur[3] = bfhi(v.y); cur[4] = bflo(v.z); cur[5] = bfhi(v.z); cur[6] = bflo(v.w); cur[7] = bfhi(v.w);
        float f = 1.f; if (FACMODE >= 1) f = dts[hq * 128 + l]; if (FACMODE == 2) f *= __expf(alast - acum[hq * 128 + l]);
        float o[8];
#pragma unroll
        for (int e = 0; e < 8; ++e) { const float a = bias[e] + w[0][e] * hst[0][e] + w[1][e] * hst[1][e] + w[2][e] * hst[2][e] + w[3][e] * cur[e]; o[e] = siluf(a) * f;
            hst[0][e] = hst[1][e]; hst[1][e] = hst[2][e]; hst[2][e] = cur[e]; }
        v4u ov; ov.x = pk2(o[0], o[1]); ov.y = pk2(o[2], o[3]); ov.z = pk2(o[4], o[5]); ov.w = pk2(o[6], o[7]);
        *(LAS v4u*)(dst + l * pitch + c8 * 16) = ov; }
}
__device__ __forceinline__ void ssd_s1_unit(LAS unsigned char* sl, const bf16* PROJ, const float* DT, const float* dtb, const float* alog, const float* cw, const float* cb, float* ST, float* CDEC, int un, int tid, int lane, int wave) {
    const int g = un & 1, bc = un >> 1; const size_t row0 = (size_t)bc * 128; const int t0 = (bc & 31) * 128;
    __syncthreads();
    ssd_prep(sl, DT, dtb, alog, row0, g, tid, lane, wave);
    conv_tile<128, 0>(PROJ, row0, t0, C_XS + 512 + g * 128, cw, cb, 512 + g * 128, sl + S1_B, S1_PB, sl, 0, tid);
    conv_tile<256, 2>(PROJ, row0, t0, C_XS + g * 256, cw, cb, g * 256, sl + S1_X, S1_PX, sl, 0, tid);
    if (tid < 4) CDEC[(size_t)bc * 8 + 4 * g + tid] = __expf(((const LAS float*)(sl + SS_ACUM))[tid * 128 + 127]);
    __syncthreads();
    const int hq = wave >> 1, pt = wave & 1, h2 = lane >> 5, q = (lane & 15) >> 2, pp = lane & 3, dsel = (lane >> 4) & 1;
    const LAS unsigned char* xb = sl + S1_X + (8 * h2 + q) * S1_PX + (hq * 64 + pt * 32 + 16 * dsel + 4 * pp) * 2;
    const LAS unsigned char* bb = sl + S1_B + (8 * h2 + q) * S1_PB + (16 * dsel + 4 * pp) * 2;
    f32x16 acc[4];
#pragma unroll
    for (int nt = 0; nt < 4; ++nt) acc[nt] = (f32x16){};
#pragma unroll
    for (int ks = 0; ks < 8; ++ks) { const bf16x8 a = tr_pair(xb + (16 * ks) * S1_PX, xb + (16 * ks + 4) * S1_PX);
#pragma unroll
        for (int nt = 0; nt < 4; ++nt) { const bf16x8 b = tr_pair(bb + (16 * ks) * S1_PB + nt * 64, bb + (16 * ks + 4) * S1_PB + nt * 64); acc[nt] = __builtin_amdgcn_mfma_f32_32x32x16_bf16(a, b, acc[nt], 0, 0, 0); } }
    float* sp = ST + ((size_t)(bc * 8 + 4 * g + hq) * 64 + pt * 32) * 128 + (lane & 31);
#pragma unroll
    for (int nt = 0; nt < 4; ++nt)
#pragma unroll
        for (int rg = 0; rg < 16; ++rg) sp[(size_t)crow16(rg, h2) * 128 + 32 * nt] = acc[nt][rg];
}
__device__ __forceinline__ void ssd_s3_unit(LAS unsigned char* sl, const bf16* PROJ, const float* DT, const float* dtb, const float* alog, const float* cw, const float* cb, const float* dsk, const float* ng,
                                            const bf16* HIN, bf16* MIXED, int un, int tid, int lane, int wave) {
    const int g = un & 1, bc = un >> 1; const size_t row0 = (size_t)bc * 128; const int t0 = (bc & 31) * 128;
    const int lt = wave & 3, ph = wave >> 2, lq = lane & 31, hi = lane >> 5, q = (lane & 15) >> 2, pp = lane & 3, dsel = (lane >> 4) & 1;
    const int lrow = 32 * lt + lq;
    const size_t grow = row0 + lrow;
    __syncthreads();
    ssd_prep(sl, DT, dtb, alog, row0, g, tid, lane, wave);
    conv_tile<128, 0>(PROJ, row0, t0, C_XS + 512 + g * 128, cw, cb, 512 + g * 128, sl + S3_B, S3_PBC, sl, 0, tid);
    conv_tile<128, 0>(PROJ, row0, t0, C_XS + 768 + g * 128, cw, cb, 768 + g * 128, sl + S3_C, S3_PBC, sl, 0, tid);
    conv_tile<256, 1>(PROJ, row0, t0, C_XS + g * 256, cw, cb, g * 256, sl + S3_X, S3_PX, sl, 0, tid);
    __syncthreads();
    const LAS float* dts = (const LAS float*)(sl + SS_DTS); const LAS float* acum = (const LAS float*)(sl + SS_ACUM); LAS float* ssx = (LAS float*)(sl + SS_SSX);
    const LAS unsigned char* crd = sl + S3_C + lrow * S3_PBC + 16 * hi;
    f32x16 y[4];
    { bf16x8 hfa[8], hfb[8];
      const bf16* hp0 = HIN + ((size_t)(bc * 8 + 4 * g) * 64 + ph * 32 + lq) * 128 + 8 * hi;
#pragma unroll
      for (int ks = 0; ks < 8; ++ks) hfa[ks] = *(const bf16x8*)(hp0 + 16 * ks);
#pragma unroll
      for (int hq = 0; hq < 4; ++hq) {
          if (hq < 3) {
#pragma unroll
              for (int ks = 0; ks < 8; ++ks) { const bf16x8 v = *(const bf16x8*)(hp0 + (size_t)(hq + 1) * 8192 + 16 * ks); if (hq & 1) hfa[ks] = v; else hfb[ks] = v; } }
          f32x16 t = (f32x16){};
#pragma unroll
          for (int ks = 0; ks < 8; ++ks) t = __builtin_amdgcn_mfma_f32_32x32x16_bf16((hq & 1) ? hfb[ks] : hfa[ks], *(const LAS bf16x8*)(crd + 32 * ks), t, 0, 0, 0);
          const float ea = __expf(acum[hq * 128 + lrow]);
#pragma unroll
          for (int rg = 0; rg < 16; ++rg) t[rg] *= ea;
          y[hq] = t; } }
    v2u zr[4][4];
#pragma unroll
    for (int hq = 0; hq < 4; ++hq)
#pragma unroll
        for (int g4 = 0; g4 < 4; ++g4) zr[hq][g4] = *(const v2u*)(PROJ + grow * NPROJ + C_Z + g * 256 + hq * 64 + ph * 32 + 8 * g4 + 4 * hi);
#pragma unroll
    for (int st = 0; st < 4; ++st) if (st <= lt) {
        f32x16 ag = (f32x16){};
        { const LAS unsigned char* brd = sl + S3_B + (32 * st + lq) * S3_PBC + 16 * hi;
#pragma unroll
          for (int ks = 0; ks < 8; ++ks) ag = __builtin_amdgcn_mfma_f32_32x32x16_bf16(*(const LAS bf16x8*)(brd + 32 * ks), *(const LAS bf16x8*)(crd + 32 * ks), ag, 0, 0, 0); }
#pragma unroll
        for (int hq = 0; hq < 4; ++hq) {
            const float al = acum[hq * 128 + lrow], dd = dsk[4 * g + hq] / dts[hq * 128 + lrow];
            const LAS unsigned char* xb = sl + S3_X + (4 * hi + q) * S3_PX + (hq * 64 + ph * 32 + 16 * dsel + 4 * pp) * 2;
            float pm[16];
#pragma unroll
            for (int g4 = 0; g4 < 4; ++g4) { const f32x4 as4 = *(const LAS f32x4*)(acum + hq * 128 + 32 * st + 8 * g4 + 4 * hi);
#pragma unroll
                for (int e = 0; e < 4; ++e) { const int rg = 4 * g4 + e; float v = ag[rg] * __expf(al - as4[e]);
                    if (st == lt) { const int sl_ = 8 * g4 + 4 * hi + e; if (sl_ > lq) v = 0.f; if (sl_ == lq) v += dd; }
                    pm[rg] = v; } }
#pragma unroll
            for (int ks = 0; ks < 2; ++ks) { v4u wv; wv.x = pg8::cvt_pk_bf16(pm[8 * ks + 0], pm[8 * ks + 1]); wv.y = pg8::cvt_pk_bf16(pm[8 * ks + 2], pm[8 * ks + 3]); wv.z = pg8::cvt_pk_bf16(pm[8 * ks + 4], pm[8 * ks + 5]); wv.w = pg8::cvt_pk_bf16(pm[8 * ks + 6], pm[8 * ks + 7]);
                const bf16x8 xt = tr_pair(xb + (32 * st + 16 * ks) * S3_PX, xb + (32 * st + 16 * ks + 8) * S3_PX);
                y[hq] = __builtin_amdgcn_mfma_f32_32x32x16_bf16(xt, __builtin_bit_cast(bf16x8, wv), y[hq], 0, 0, 0); }
        }
    }
    unsigned ayp[4][8]; float ss = 0.f;
#pragma unroll
    for (int hq = 0; hq < 4; ++hq)
#pragma unroll
        for (int g4 = 0; g4 < 4; ++g4) { const v2u z = zr[hq][g4];
            const float y0 = y[hq][4 * g4 + 0] * siluf(bflo(z.x)), y1 = y[hq][4 * g4 + 1] * siluf(bfhi(z.x)), y2 = y[hq][4 * g4 + 2] * siluf(bflo(z.y)), y3 = y[hq][4 * g4 + 3] * siluf(bfhi(z.y));
            ss += (y0 * y0 + y1 * y1) + (y2 * y2 + y3 * y3);
            ayp[hq][2 * g4] = pg8::cvt_pk_bf16(y0, y1); ayp[hq][2 * g4 + 1] = pg8::cvt_pk_bf16(y2, y3); }
    ss += __shfl_xor(ss, 32);
    if (hi == 0) ssx[ph * 128 + lrow] = ss;
    __syncthreads();
    const float rs = 1.0f / sqrtf((ssx[lrow] + ssx[128 + lrow]) * (1.f / 256.f) + RMS_EPS);
#pragma unroll
    for (int hq = 0; hq < 4; ++hq)
#pragma unroll
        for (int g4 = 0; g4 < 4; ++g4) { const int ch = hq * 64 + ph * 32 + 8 * g4 + 4 * hi; const f32x4 gn = *(const f32x4*)(ng + g * 256 + ch);
            const unsigned p0 = ayp[hq][2 * g4], p1 = ayp[hq][2 * g4 + 1];
            v2u o; o.x = pg8::cvt_pk_bf16(bflo(p0) * rs * gn[0], bfhi(p0) * rs * gn[1]); o.y = pg8::cvt_pk_bf16(bflo(p1) * rs * gn[2], bfhi(p1) * rs * gn[3]);
            *(v2u*)(MIXED + grow * MIXW + 512 + g * 256 + ch) = o; }
}

struct Args { const float* in[20]; float* out; unsigned char* ws; int ph_lo, ph_hi, sub, pad; };
constexpr int NWAVES = 8;
constexpr int PH_PER_LAYER = 10, N_PHASES = 1 + NLAYER * PH_PER_LAYER;

#define in_x (args.in[0])
#define in_win (args.in[1])
#define in_convw (args.in[2])
#define in_convb (args.in[3])
#define in_dtb (args.in[4])
#define in_alog (args.in[5])
#define in_dsk (args.in[6])
#define in_ng (args.in[7])
#define in_scw (args.in[8])
#define in_wout (args.in[9])
#define in_ln1g (args.in[10])
#define in_ln1b (args.in[11])
#define in_rw (args.in[12])
#define in_rb (args.in[13])
#define in_wgu (args.in[14])
#define in_bgu (args.in[15])
#define in_wdn (args.in[16])
#define in_bdn (args.in[17])
#define in_ln2g (args.in[18])
#define in_ln2b (args.in[19])
#define ROPE ((float*)(args.ws + WS_ROPE))
#define WDT ((float*)(args.ws + WS_WDT))
#define ROUT ((bf16*)(args.ws + WS_ROUT))
#define WIN ((bf16*)(args.ws + WS_WIN))
#define WOUT ((bf16*)(args.ws + WS_WOUT))
#define WGU ((bf16*)(args.ws + WS_WGU))
#define WDN ((bf16*)(args.ws + WS_WDN))
#define XB ((bf16*)(args.ws + WS_XB))
#define XF ((float*)(args.ws + WS_XF))
#define XF2 ((float*)(args.ws + WS_XF2))
#define PROJ ((bf16*)(args.ws + WS_PROJ))
#define DT ((float*)(args.ws + WS_DT))
#define DTS ((float*)(args.ws + WS_DTS))
#define ACUM ((float*)(args.ws + WS_ACUM))
#define LSE ((float*)(args.ws + WS_LSE))
#define OP ((bf16*)(args.ws + WS_OP))
#define U ((bf16*)(args.ws + WS_U))
#define GB ((float*)(args.ws + WS_G))
#define ST ((float*)(args.ws + WS_ST))
#define YD ((float*)(args.ws + WS_YD))
#define MIXED ((bf16*)(args.ws + WS_MIXED))
#define MIXF ((bf16*)(args.ws + WS_MIXF))
#define TOPE ((int*)(args.ws + WS_TOPE))
#define TOPG ((float*)(args.ws + WS_TOPG))
#define ROWTOK ((int*)(args.ws + WS_ROWTOK))
#define ROWGATE ((float*)(args.ws + WS_ROWGATE))
#define HB ((bf16*)(args.ws + WS_H))
#define YB ((bf16*)(args.ws + WS_YB))
#define HIN ((bf16*)(args.ws + WS_G))
#define WGU8 ((unsigned char*)(args.ws + WS_WGU))
#define WDN8 ((unsigned char*)(args.ws + WS_WDN))
#define XB8 ((unsigned char*)(args.ws + WS_U))
#define H8 ((unsigned char*)(args.ws + WS_H))
#define YB8 ((unsigned char*)(args.ws + WS_YB))
#define WIN8 ((unsigned char*)(args.ws + WS_WGU + 128 * MiB))
#define XP8 ((unsigned char*)(args.ws + WS_WGU + 132 * MiB))
#define CDEC ((float*)(args.ws + WS_ACUM))
template <int layer>
__device__ __forceinline__ void run_layer(const Args& args, int lo, int hi, const XcdBarrier& bar) {
    extern __shared__ __attribute__((aligned(16))) unsigned char lds[];
    LAS unsigned char* ldsp = (LAS unsigned char*)lds;
    const int tid = threadIdx.x, lane = tid & 63, wave = __builtin_amdgcn_readfirstlane(tid >> 6);
    const int G = gridDim.x, bid = blockIdx.x;
    const int gw = bid * NWAVES + wave, NGW = G * NWAVES;
    gu32* ctl = (gu32*)(args.ws + WS_CTL);

#define IN(k) (lo <= (k) && (k) < hi)
#define SEAM(k) do { if (IN(k) && IN((k) + 1)) xcd_barrier(bar); } while (0)

        const int pb = 1 + layer * PH_PER_LAYER;
        const bf16* WINl = WIN + (size_t)layer * NPROJ * DM; const bf16* WOUTl = WOUT + (size_t)layer * DM * MIXW;
        const unsigned char* WGUl = WGU8 + (size_t)layer * NEXP * 2048 * DM; const unsigned char* WDNl = WDN8 + (size_t)layer * NEXP * DM * FF;
        gu32* gcnt = ctl + CW_CNT + 64 * layer;

        if (IN(pb + 0)) {
            if (layer == 0) {
                for (int m = gw; m < MROWS; m += NGW) { const bf16* xr = XB + (size_t)m * DM; f32x4 v[4];
#pragma unroll
                    for (int j = 0; j < 4; ++j) { const v2u a = *(const v2u*)(xr + 4 * lane + 256 * j); v[j] = (f32x4){bflo(a.x), bfhi(a.x), bflo(a.y), bfhi(a.y)}; }
                    row_dt(v, WDT, DT + (size_t)m * 8, lane); }
            }
            {
              pg8::Gemm g{(const pg8::bf16_t*)XP8, (const pg8::bf16_t*)(WIN8 + (size_t)layer * 1536 * DM), MROWS, 1536, DM / 2}; pg8::StaticOrder S; S.init(MROWS, 1536, G, bid);
              pg8::EpiProj E{PROJ, NPROJ, ROPE, QSCALE, 1.0f / (SC_X * SC_WIN), 0};
              pg8::gemm_phase<pg8::EpiProj, pg8::StaticOrder, true, false, true>(ldsp + RING_OFF, g, S, E); }
            __syncthreads();
            { pg8::Gemm g{XB, WINl + (size_t)1536 * DM, MROWS, NPROJ - 1536, DM}; pg8::StaticOrder S; S.init(MROWS, NPROJ - 1536, G, bid);
              pg8::EpiProj E{PROJ, NPROJ, ROPE, QSCALE, 1.0f, 6};
              pg8::gemm_phase<pg8::EpiProj, pg8::StaticOrder, true, false>(ldsp + RING_OFF, g, S, E); }
        }
        SEAM(pb + 0);
        if (IN(pb + 1)) {
            if (args.sub & 1) attn_phase(ldsp + RING_OFF, PROJ, OP, LSE, bid, G, tid, wave, lane);
            if (args.sub & 2) { const float* cw = in_convw + (size_t)layer * 4 * 1024; const float* cb = in_convb + (size_t)layer * 1024;
              for (int un = bid; un < 512; un += G)
                  ssd_s1_unit(ldsp + RING_OFF, PROJ, DT, in_dtb + layer * 8, in_alog + layer * 8, cw, cb, ST, CDEC, un, tid, lane, wave);
              __syncthreads(); }
            const float* sw = in_scw + (size_t)layer * 3 * 512;
            if (args.sub & 4) for (int it = bid * (NWAVES * 64) + tid; it < (int)((long)MROWS * 64); it += G * (NWAVES * 64)) { const int c8 = (int)(it & 63), row = (int)(it >> 6), t = row & (SEQ - 1); const int ch = c8 * 8;
                float a[8];
#pragma unroll
                for (int q = 0; q < 8; ++q) a[q] = 0.f;
#pragma unroll
                for (int k = 0; k < 3; ++k) { const int tt = t - 2 + k; if (tt >= 0) { const bf16* pr = PROJ + (size_t)(row - 2 + k) * NPROJ; const v4u cc = *(const v4u*)(pr + C_SC + ch), hh = *(const v4u*)(pr + C_SH + ch);
                    const f32x4 w0 = *(const f32x4*)(sw + k * 512 + ch), w1 = *(const f32x4*)(sw + k * 512 + ch + 4);
                    a[0] += w0[0] * bflo(cc.x) * bflo(hh.x); a[1] += w0[1] * bfhi(cc.x) * bfhi(hh.x); a[2] += w0[2] * bflo(cc.y) * bflo(hh.y); a[3] += w0[3] * bfhi(cc.y) * bfhi(hh.y);
                    a[4] += w1[0] * bflo(cc.z) * bflo(hh.z); a[5] += w1[1] * bfhi(cc.z) * bfhi(hh.z); a[6] += w1[2] * bflo(cc.w) * bflo(hh.w); a[7] += w1[3] * bfhi(cc.w) * bfhi(hh.w); } }
                const v4u bb = *(const v4u*)(PROJ + (size_t)row * NPROJ + C_SB + ch);
                v4u o; o.x = pk2(a[0] * bflo(bb.x), a[1] * bfhi(bb.x)); o.y = pk2(a[2] * bflo(bb.y), a[3] * bfhi(bb.y)); o.z = pk2(a[4] * bflo(bb.z), a[5] * bfhi(bb.z)); o.w = pk2(a[6] * bflo(bb.w), a[7] * bfhi(bb.w));
                *(v4u*)(MIXED + (size_t)row * MIXW + 1024 + ch) = o; }
        }
        SEAM(pb + 1);
        if (IN(pb + 2)) {
            for (int it = bid * (NWAVES * 64) + tid; it < (int)(64L * 2048); it += G * (NWAVES * 64)) { const int pn4 = (int)(it & 2047), bh = (int)(it >> 11); const int h = bh & 7, b = bh >> 3; f32x4 hc = (f32x4){0.f, 0.f, 0.f, 0.f};
#pragma unroll 8
                for (int c = 0; c < 32; ++c) { const size_t idx = ((size_t)((b * 32 + c) * 8 + h)) * 8192 + pn4 * 4; const f32x4 st = *(const f32x4*)(ST + idx);
                    v2u o; o.x = pk2(hc[0], hc[1]); o.y = pk2(hc[2], hc[3]); *(v2u*)(HIN + idx) = o;
                    hc = hc * CDEC[(size_t)(b * 32 + c) * 8 + h] + st; } }
        }
        SEAM(pb + 2);
        if (IN(pb + 3)) {
            if (args.sub & 1) { const float* cw = in_convw + (size_t)layer * 4 * 1024; const float* cb = in_convb + (size_t)layer * 1024;
              for (int un = bid; un < 512; un += G)
                  ssd_s3_unit(ldsp + RING_OFF, PROJ, DT, in_dtb + layer * 8, in_alog + layer * 8, cw, cb, in_dsk + layer * 8, in_ng + (size_t)layer * 512, HIN, MIXED, un, tid, lane, wave);
              __syncthreads(); }
            if (args.sub & 2) for (int it = bid * (NWAVES * 64) + tid; it < (int)((long)MROWS * 64); it += G * (NWAVES * 64)) { const int c8 = (int)(it & 63), row = (int)(it >> 6); const int h = c8 >> 3;
                const float l0 = LSE[((size_t)0 * MROWS + row) * 8 + h], l1 = LSE[((size_t)1 * MROWS + row) * 8 + h], l2 = LSE[((size_t)2 * MROWS + row) * 8 + h];
                const float mm = fmaxf(l0, fmaxf(l1, l2)); float w0 = exp2f(l0 - mm), w1 = exp2f(l1 - mm), w2 = exp2f(l2 - mm); const float iw = 1.0f / (w0 + w1 + w2); w0 *= iw; w1 *= iw; w2 *= iw;
                const v4u a0 = *(const v4u*)(OP + ((size_t)0 * MROWS + row) * 512 + c8 * 8), a1 = *(const v4u*)(OP + ((size_t)1 * MROWS + row) * 512 + c8 * 8), a2 = *(const v4u*)(OP + ((size_t)2 * MROWS + row) * 512 + c8 * 8);
                v4u o;
                o.x = pk2(w0 * bflo(a0.x) + w1 * bflo(a1.x) + w2 * bflo(a2.x), w0 * bfhi(a0.x) + w1 * bfhi(a1.x) + w2 * bfhi(a2.x));
                o.y = pk2(w0 * bflo(a0.y) + w1 * bflo(a1.y) + w2 * bflo(a2.y), w0 * bfhi(a0.y) + w1 * bfhi(a1.y) + w2 * bfhi(a2.y));
                o.z = pk2(w0 * bflo(a0.z) + w1 * bflo(a1.z) + w2 * bflo(a2.z), w0 * bfhi(a0.z) + w1 * bfhi(a1.z) + w2 * bfhi(a2.z));
                o.w = pk2(w0 * bflo(a0.w) + w1 * bflo(a1.w) + w2 * bflo(a2.w), w0 * bfhi(a0.w) + w1 * bfhi(a1.w) + w2 * bfhi(a2.w));
                *(v4u*)(MIXED + (size_t)row * MIXW + c8 * 8) = o; }
        }
        SEAM(pb + 3);
        if (IN(pb + 4)) {
            pg8::Gemm g{MIXED, WOUTl, MROWS, DM, MIXW}; pg8::StaticOrder S; S.init(MROWS, DM, G, bid);
            pg8::EpiBf16Plain E{MIXF, DM};
            pg8::gemm_phase<pg8::EpiBf16Plain, pg8::StaticOrder, true, false>(ldsp + RING_OFF, g, S, E);
        }
        SEAM(pb + 4);
        if (IN(pb + 5)) {
            const float* gam = in_ln1g + (size_t)layer * DM; const float* bet = in_ln1b + (size_t)layer * DM;
            for (int m = gw; m < MROWS; m += NGW) { f32x4 v[4];
#pragma unroll
                for (int j = 0; j < 4; ++j) { const v2u a = *(const v2u*)(XB + (size_t)m * DM + 4 * lane + 256 * j); const v2u b = *(const v2u*)(MIXF + (size_t)m * DM + 4 * lane + 256 * j);
                    v[j] = (f32x4){bflo(a.x), bfhi(a.x), bflo(a.y), bfhi(a.y)} * ALPHA + (f32x4){bflo(b.x), bfhi(b.x), bflo(b.y), bfhi(b.y)}; }
                ln_row<true, false>(v, gam, bet, nullptr, XB + (size_t)m * DM, XB8 + (size_t)m * DM, SC_X, lane); }
        }
        SEAM(pb + 5);
        if (IN(pb + 6)) {
            LAS int* lcnt = (LAS int*)(ldsp + L_LCNT); LAS int* lbase = (LAS int*)(ldsp + L_LBASE);
            const bf16* RT = ROUT + (size_t)layer * NEXP * DM; const float* rb = in_rb + (size_t)layer * NEXP;
            for (int blk = bid; blk < MROWS / 128; blk += G) {
                if (tid < 32) lcnt[tid] = 0;
                __syncthreads();
                const int r32 = lane & 31, hi = lane >> 5; const int row = blk * 128 + (wave & 3) * 32 + r32;
                float tv[4]; int te[4]; int lrank[4]; float gate[4];
                if (wave < 4) {
                    f32x16 acc = {};
                    const bf16* ap = RT + (size_t)r32 * DM + 8 * hi; const bf16* bp = XB + (size_t)row * DM + 8 * hi;
#pragma unroll 8
                    for (int s = 0; s < 64; ++s) { const bf16x8 a = *(const bf16x8*)(ap + 16 * s), b = *(const bf16x8*)(bp + 16 * s); acc = __builtin_amdgcn_mfma_f32_32x32x16_bf16(a, b, acc, 0, 0, 0); }
#pragma unroll
                    for (int k = 0; k < 4; ++k) { tv[k] = -INFINITY; te[k] = 1 << 20; }
#pragma unroll
                    for (int i = 0; i < 16; ++i) { const int e = (i & 3) + 8 * (i >> 2) + 4 * hi; float v = acc[i] + rb[e]; int ve = e;
#pragma unroll
                        for (int k = 0; k < 4; ++k) { const bool gt = (v > tv[k]) || (v == tv[k] && ve < te[k]); const float nv = gt ? tv[k] : v; const int ne = gt ? te[k] : ve; tv[k] = gt ? v : tv[k]; te[k] = gt ? ve : te[k]; v = nv; ve = ne; } }
                    float pv[4]; int pe[4];
#pragma unroll
                    for (int k = 0; k < 4; ++k) { pv[k] = __shfl_xor(tv[k], 32); pe[k] = __shfl_xor(te[k], 32); }
#pragma unroll
                    for (int j = 0; j < 4; ++j) { float v = pv[j]; int ve = pe[j];
#pragma unroll
                        for (int k = 0; k < 4; ++k) { const bool gt = (v > tv[k]) || (v == tv[k] && ve < te[k]); const float nv = gt ? tv[k] : v; const int ne = gt ? te[k] : ve; tv[k] = gt ? v : tv[k]; te[k] = gt ? ve : te[k]; v = nv; ve = ne; } }
                    float se = 0.f;
#pragma unroll
                    for (int k = 0; k < 4; ++k) { gate[k] = __expf(tv[k] - tv[0]); se += gate[k]; }
                    const float ise = 1.0f / se;
#pragma unroll
                    for (int k = 0; k < 4; ++k) gate[k] *= ise;
                    if (hi == 0) {
#pragma unroll
                        for (int k = 0; k < 4; ++k) lrank[k] = __hip_atomic_fetch_add(lcnt + te[k], 1, __ATOMIC_RELAXED, __HIP_MEMORY_SCOPE_WORKGROUP);
                    }
                }
                __syncthreads();
                if (tid < 32) lbase[tid] = (int)__hip_atomic_fetch_add(gcnt + tid, (unsigned)lcnt[tid], RLX_AGENT);
                __syncthreads();
                if (wave < 4 && hi == 0) {
#pragma unroll
                    for (int k = 0; k < 4; ++k) { const int r = lbase[te[k]] + lrank[k]; const size_t o = (size_t)te[k] * 32768 + r;
                        ROWTOK[o] = row * 4 + k; ROWGATE[o] = gate[k]; TOPE[(size_t)row * 4 + k] = te[k]; TOPG[(size_t)row * 4 + k] = gate[k]; }
                }
                __syncthreads();
            }
        }
        SEAM(pb + 6);
        if (IN(pb + 7) || IN(pb + 8)) {
            LAS int* tstart = (LAS int*)(ldsp + L_TSTART); LAS int* cntL = (LAS int*)(ldsp + L_CNT); LAS int* units = (LAS int*)(ldsp + L_UNITS); LAS int* unitsn = (LAS int*)(ldsp + L_UNITSN);
            if (tid == 0) { int acc = 0; for (int e = 0; e < 32; ++e) { const int c = (int)__hip_atomic_load(gcnt + e, RLX_AGENT); cntL[e] = c; tstart[e] = acc; acc += (c + 255) >> 8; } tstart[32] = acc; }
            __syncthreads();
            if (IN(pb + 7)) {
                pg8::moe_build_units(units, unitsn, tstart, 8, G, bid, tid);
                __syncthreads();
                pg8::Gemm g{(const pg8::bf16_t*)XB8, (const pg8::bf16_t*)WGUl, 0, 2048, DM / 2};
                pg8::MoeOrder S{units, __builtin_amdgcn_readfirstlane(unitsn[0]), cntL, ROWTOK, 1, (unsigned)DM, (size_t)2048 * DM, ROWGATE, in_bgu + (size_t)layer * NEXP * 2048};
                pg8::EpiSwiglu E{H8, in_bgu + (size_t)layer * NEXP * 2048, ROWGATE, cntL, 1.0f / (SC_X * SC_WGU), SC_H};
                pg8::gemm_phase<pg8::EpiSwiglu, pg8::MoeOrder, true, true, true>(ldsp + RING_OFF, g, S, E);
                __syncthreads();
            }
            SEAM(pb + 7);
            if (IN(pb + 8)) {
                pg8::moe_build_units(units, unitsn, tstart, 4, G, bid, tid);
                __syncthreads();
                pg8::Gemm g{(const pg8::bf16_t*)H8, (const pg8::bf16_t*)WDNl, 0, DM, FF / 2};
                pg8::MoeOrder S{units, __builtin_amdgcn_readfirstlane(unitsn[0]), cntL, ROWTOK, 0, (unsigned)FF, (size_t)DM * FF, ROWGATE, in_bdn + (size_t)layer * NEXP * DM};
                pg8::EpiScatter E{YB8, ROWTOK, cntL, SC_Y / (SC_H * SC_WDN), SC_Y};
                pg8::gemm_phase<pg8::EpiScatter, pg8::MoeOrder, true, false, true, true>(ldsp + RING_OFF, g, S, E);
                __syncthreads();
            }
        }
        SEAM(pb + 8);
        if (IN(pb + 9)) {
            const float* gam = in_ln2g + (size_t)layer * DM; const float* bet = in_ln2b + (size_t)layer * DM; const float* bdn = in_bdn + (size_t)layer * NEXP * DM;
            for (int m = gw; m < MROWS; m += NGW) { f32x4 v[4];
#pragma unroll
                for (int j = 0; j < 4; ++j) { const v2u a = *(const v2u*)(XB + (size_t)m * DM + 4 * lane + 256 * j); v[j] = (f32x4){bflo(a.x), bfhi(a.x), bflo(a.y), bfhi(a.y)} * ALPHA; }
#pragma unroll
                for (int k = 0; k < 4; ++k) { const unsigned char* yr = YB8 + ((size_t)m * 4 + k) * DM;
#pragma unroll
                    for (int j = 0; j < 4; ++j) { const unsigned w = *(const unsigned*)(yr + 4 * lane + 256 * j);
                        typedef float f32x2_ __attribute__((ext_vector_type(2)));
                        const f32x2_ lo = __builtin_amdgcn_cvt_pk_f32_fp8(w, false), hi = __builtin_amdgcn_cvt_pk_f32_fp8(w, true);
                        v[j][0] += lo[0] * (1.0f / SC_Y); v[j][1] += lo[1] * (1.0f / SC_Y); v[j][2] += hi[0] * (1.0f / SC_Y); v[j][3] += hi[1] * (1.0f / SC_Y); } }
                ln_row<(layer + 1 < NLAYER), (layer == NLAYER - 1)>(v, gam, bet, args.out + (size_t)m * DM, XB + (size_t)m * DM, XP8 + (size_t)m * DM, SC_X, lane);
                if (layer + 1 < NLAYER) row_dt(v, WDT + (size_t)(layer + 1) * 8 * 1024, DT + (size_t)m * 8, lane); }
        }
        SEAM(pb + 9);
    #undef IN
#undef SEAM
}

__global__ void __launch_bounds__(NWAVES * 64, 2) mk_fwd(Args args) {
    extern __shared__ __attribute__((aligned(16))) unsigned char lds[];
    LAS unsigned char* ldsp = (LAS unsigned char*)lds;
    const int tid = threadIdx.x, lane = tid & 63, wave = __builtin_amdgcn_readfirstlane(tid >> 6);
    const int G = gridDim.x, bid = blockIdx.x;
    const int gw = bid * NWAVES + wave, NGW = G * NWAVES;
    gu32* ctl = (gu32*)(args.ws + WS_CTL);

    for (int u = tid; u < (LDS_BYTES - LDSCTL_OFF) / 4; u += NWAVES * 64) ((LAS unsigned*)(ldsp + LDSCTL_OFF))[u] = 0u;
    __syncthreads();
    XcdBarrier bar = xcd_barrier_post((unsigned*)(ctl + CW_BAR), (volatile LAS unsigned*)(ldsp + L_MISC) + 8);

    const int lo = args.ph_lo, hi = args.ph_hi;
#define IN(k) (lo <= (k) && (k) < hi)
#define SEAM(k) do { if (IN(k) && IN((k) + 1)) xcd_barrier(bar); } while (0)

    if (IN(0)) {
        for (int it = bid * (NWAVES * 64) + tid; it < (int)(4096 * 32); it += G * (NWAVES * 64)) { const int t = (int)(it >> 5), i = (int)(it & 31);
            const float inv = powf(10000.0f, -(float)i / 32.0f); const float ang = (float)t * inv; float sn, cs; sincosf(ang, &sn, &cs);
            ROPE[2 * it] = cs; ROPE[2 * it + 1] = sn; }
        LAS float* scr = (LAS float*)(ldsp + RING_OFF + wave * 16384);
        constexpr int I_IN = 16 * 73, I_OUT = 24 * 16, I_R = 16;
        constexpr int NIT = NLAYER * (I_IN + I_OUT + I_R);
        for (int it = gw; it < NIT; it += NGW) {
            int r = it;
            if (r < NLAYER * I_IN) { const int l = r / I_IN; r %= I_IN; p0_transpose_item64<1>(in_win + (size_t)l * DM * INW, DM, INW, WIN + (size_t)l * NPROJ * DM, WDT + (size_t)l * 8 * 1024, scr, r / 73, r % 73, lane); continue; } r -= NLAYER * I_IN;
            if (r < NLAYER * I_OUT) { const int l = r / I_OUT; r %= I_OUT; p0_transpose_item64<0>(in_wout + (size_t)l * MIXW * DM, MIXW, DM, WOUT + (size_t)l * DM * MIXW, nullptr, scr, r / 16, r % 16, lane); continue; } r -= NLAYER * I_OUT;
            { const int l = r / I_R; r %= I_R; p0_transpose_item<0>(in_rw + (size_t)l * DM * NEXP, DM, NEXP, ROUT + (size_t)l * NEXP * DM, nullptr, scr, r, 0, lane); }
        }
        { constexpr int NIT8 = 64 * 256 + 64 * 128 + NLAYER * 192;
          const int nmine = (gw < NIT8) ? (NIT8 - gw + NGW - 1) / NGW : 0; const int J = 2 * nmine;
          f32x4 lda[16], ldb[16];
          if (J > 0) { const SubT t = fp8_subtile(gw, 0, in_wgu, in_wdn, in_win, WGU8, WDN8, WIN8, lane); fp8_sub_load(t, lda); }
#pragma unroll 1
          for (int j = 0; j < J; j += 2) {
              const int item = gw + (j >> 1) * NGW;
              const SubT t0 = fp8_subtile(item, 0, in_wgu, in_wdn, in_win, WGU8, WDN8, WIN8, lane), t1 = fp8_subtile(item, 1, in_wgu, in_wdn, in_win, WGU8, WDN8, WIN8, lane);
              fp8_sub_load(t1, ldb);
              fp8_sub_process(t0, lda, scr, lane);
              if (j + 2 < J) { const SubT t2 = fp8_subtile(item + NGW, 0, in_wgu, in_wdn, in_win, WGU8, WDN8, WIN8, lane); fp8_sub_load(t2, lda); }
              fp8_sub_process(t1, ldb, scr, lane);
          } }
        __syncthreads();
    }
    if (IN(0)) {
        for (int m = gw; m < MROWS; m += NGW) { const float* xr = in_x + (size_t)m * DM; bf16* ob = XB + (size_t)m * DM; f32x4 v[4];
#pragma unroll
            for (int j = 0; j < 4; ++j) { v[j] = *(const f32x4*)(xr + 4 * lane + 256 * j); v2u w; w.x = pk2(v[j][0], v[j][1]); w.y = pk2(v[j][2], v[j][3]); *(v2u*)(ob + 4 * lane + 256 * j) = w;
                *(unsigned*)(XP8 + (size_t)m * DM + 4 * lane + 256 * j) = pg8::pk4_fp8(v[j][0] * SC_X, v[j][1] * SC_X, v[j][2] * SC_X, v[j][3] * SC_X); }
            }
    }

    SEAM(0);
    run_layer<0>(args, lo, hi, bar);
    run_layer<1>(args, lo, hi, bar);
#undef IN
#undef SEAM
}

extern "C" void kernel_launch(void* const* d_in, const int* in_sizes, int n_in, void* d_out, int out_size, void* d_ws, size_t ws_size, hipStream_t stream) {
    static int grid = 0;
    if (grid == 0) {
        if (n_in != 20 || out_size != MROWS * DM || ws_size < WS_END) { fprintf(stderr, "kernel_launch: unexpected problem (n_in %d, out %d, ws %zu)\n", n_in, out_size, ws_size); grid = -1; return; }
        if (hipFuncSetAttribute((const void*)mk_fwd, hipFuncAttributeMaxDynamicSharedMemorySize, LDS_BYTES) != hipSuccess) { fprintf(stderr, "kernel_launch: hipFuncSetAttribute failed\n"); grid = -1; return; }
        int dev = 0, cus = 0, per_cu = 0;
        (void)hipGetDevice(&dev); (void)hipDeviceGetAttribute(&cus, hipDeviceAttributeMultiprocessorCount, dev);
        if (hipOccupancyMaxActiveBlocksPerMultiprocessor(&per_cu, (const void*)mk_fwd, NWAVES * 64, LDS_BYTES) != hipSuccess || per_cu < 1) fprintf(stderr, "kernel_launch: occupancy query says %d\n", per_cu);
        (void)hipGetLastError();
        grid = cus > 0 ? cus : 256;
    }
    if (grid < 0) return;
    (void)hipMemsetAsync((char*)d_ws + WS_CTL, 0, CTL_ZERO_BYTES, stream);
    Args a{};
    for (int i = 0; i < 20; ++i) a.in[i] = (const float*)d_in[i];
    a.out = (float*)d_out; a.ws = (unsigned char*)d_ws;
    a.ph_lo = 0; a.ph_hi = N_PHASES; a.sub = 7; a.pad = 0;
    hipLaunchKernelGGL(mk_fwd, dim3(grid), dim3(NWAVES * 64), LDS_BYTES, stream, a);
#ifdef PROBE_PH
#ifndef PROBE_SUB
#define PROBE_SUB 7
#endif
    for (int i = 0; i < PROBE_N; ++i) { a.ph_lo = PROBE_PH; a.ph_hi = PROBE_PH + 1; a.sub = PROBE_SUB; hipLaunchKernelGGL(mk_fwd, dim3(grid), dim3(NWAVES * 64), LDS_BYTES, stream, a); }
#endif
}
```

```cpp
#include <hip/hip_runtime.h>
#include <cstdio>
#include <cstdint>
#include <cmath>

namespace pg8 {
#define PG8_LAS __attribute__((address_space(3)))
typedef unsigned short bf16_t;
typedef short bf16x8 __attribute__((ext_vector_type(8)));
typedef float f32x4 __attribute__((ext_vector_type(4)));
typedef float f32x2 __attribute__((ext_vector_type(2)));
typedef unsigned u32x4 __attribute__((ext_vector_type(4)));
constexpr int BM = 256, BK = 64, HALF = 128, HTB = HALF * BK * 2  , STAGE_BYTES = 8 * HTB, NXCD = 8, WGM = 8;

__host__ __device__ __forceinline__ int lds_byte(int r, int c) { const int st = (r >> 4) * 2 + (c >> 5), rr = r & 15, cc = c & 31, ob = rr * 64 + cc * 2; return st * 1024 + (ob ^ (((ob >> 9) & 1) << 5)); }
__host__ __device__ __forceinline__ void stage_rc(int b, int& R, int& C) { const int st = b / 1024, sb = b % 1024, swz = sb ^ (((sb >> 9) & 1) << 5); R = (st >> 1) * 16 + swz / 64; C = (st & 1) * 32 + (swz % 64) / 2; }
__host__ __device__ __forceinline__ int perm32(int rho) { const int n = rho >> 4, i = rho & 15; return 8 * (i >> 2) + 4 * n + (i & 3); }

struct Unit { int pm, pn, e, r0; };
struct Gemm { const bf16_t* A; const bf16_t* Bt; int M, N, K; };

struct StaticOrder {
    int nM, nN, nwg, G, c;
    __device__ void init(int M, int N, int G_, int c_) { nM = M / BM; nN = N / BM; nwg = nM * nN; G = G_; c = c_; }
    __device__ __forceinline__ bool next(int i, Unit& u) const {
        const long L = (long)i * G + c; if (L >= nwg) return false;
        int wgid = (int)L; { const int q = nwg / NXCD, r = nwg % NXCD, xcd = wgid % NXCD, off = wgid / NXCD; wgid = (xcd < r ? xcd * (q + 1) : r * (q + 1) + (xcd - r) * q) + off; }
        const int nig = WGM * nN, gid = wgid / nig, fm = gid * WGM, gsz = (nM - fm) < WGM ? (nM - fm) : WGM;
        u.pm = fm + ((wgid % nig) % gsz); u.pn = (wgid % nig) / gsz; u.e = 0; u.r0 = 0; return true;
    }
    __device__ __forceinline__ const char* abase(const Unit& u, const Gemm& g, size_t tstep) const { return (const char*)g.A + (size_t)u.pm * tstep; }
    __device__ __forceinline__ const char* bbase(const Unit& u, const Gemm& g, size_t tstep) const { return (const char*)g.Bt + (size_t)u.pn * tstep; }
    static constexpr bool SIDE = false;
    __device__ __forceinline__ unsigned arow(const Unit&, int) const { return 0u; }
    __device__ __forceinline__ unsigned arow_side(const Unit&, int, const PG8_LAS unsigned char*) const { return 0u; }
    __device__ __forceinline__ const void* side_src(const Unit&, const Unit&, int, int) const { return nullptr; }
    __device__ __forceinline__ void a_ready(const Unit&) const {}
    __device__ __forceinline__ void done(const Unit&) const {}
};

struct MoeOrder {
    const PG8_LAS int* units;
    int nunits;
    const PG8_LAS int* cnt;
    const int* rowtok;
    int gather;
    unsigned rowbytes;
    size_t bstride;
    __device__ __forceinline__ bool next(int i, Unit& u) const {
        if (i >= nunits) return false;
        u.pm = __builtin_amdgcn_readfirstlane(units[4 * i + 0]); u.pn = __builtin_amdgcn_readfirstlane(units[4 * i + 1]);
        u.e = __builtin_amdgcn_readfirstlane(units[4 * i + 2]); u.r0 = __builtin_amdgcn_readfirstlane(units[4 * i + 3]); return true;
    }
    __device__ __forceinline__ const char* abase(const Unit& u, const Gemm& g, size_t tstep) const { return gather ? (const char*)g.A : (const char*)g.A + (size_t)u.pm * tstep; }
    __device__ __forceinline__ const char* bbase(const Unit& u, const Gemm& g, size_t tstep) const { return (const char*)g.Bt + (size_t)u.e * bstride + (size_t)u.pn * tstep; }
    static constexpr bool SIDE = true;
    const float* rowgate; const float* bgu;
    __device__ __forceinline__ unsigned arow(const Unit& u, int R) const {
        const int r = u.r0 + R; const int idx = (r < cnt[u.e]) ? rowtok[(size_t)u.e * 32768 + r] : 0; return (unsigned)(idx >> 2) * rowbytes; }
    __device__ __forceinline__ unsigned arow_side(const Unit& u, int R, const PG8_LAS unsigned char* sd) const {
        const int r = u.r0 + R; const int v = ((const PG8_LAS int*)sd)[R]; const int idx = (r < cnt[u.e]) ? v : 0; return (unsigned)(idx >> 2) * rowbytes; }
    __device__ __forceinline__ const void* side_src(const Unit& cur, const Unit& rt, int wid, int lane) const {
        if (rowgate != nullptr && wid == 1) return rowgate + (size_t)cur.e * 32768 + cur.r0 + 4 * lane;
        if (bgu != nullptr && wid == 2) return gather ? (bgu + (size_t)cur.e * 2048 + (lane < 32 ? 0 : 1024 - 128) + cur.pn * 128 + 4 * lane)
                                                      : (bgu + (size_t)cur.e * 1024 + cur.pn * 256 + 4 * lane);
        return rowtok + (size_t)rt.e * 32768 + rt.r0 + 4 * lane; }
    __device__ __forceinline__ void a_ready(const Unit&) const {}
    __device__ __forceinline__ void done(const Unit&) const {}
};
__device__ __forceinline__ void moe_build_units(PG8_LAS int* units, PG8_LAS int* units_n, const PG8_LAS int* tstart, int nN, int G, int c, int tid) {
    if (tid < 64) {
        const int nT = tstart[32], nwg = nT * nN; const long L = (long)tid * G + c;
        int pm = 0, pn = 0, e = 0, r0 = 0;
        if (L < nwg) {
            int wgid = (int)L; { const int q = nwg / NXCD, r = nwg % NXCD, xcd = wgid % NXCD, off = wgid / NXCD; wgid = (xcd < r ? xcd * (q + 1) : r * (q + 1) + (xcd - r) * q) + off; }
            const int nig = WGM * nN, gid = wgid / nig, fm = gid * WGM, gsz = (nT - fm) < WGM ? (nT - fm) : WGM;
            pm = fm + ((wgid % nig) % gsz); pn = (wgid % nig) / gsz;
            for (int j = 1; j < 32; ++j) e += (tstart[j] <= pm) ? 1 : 0;
            r0 = (pm - tstart[e]) * 256;
        }
        units[4 * tid + 0] = pm; units[4 * tid + 1] = pn; units[4 * tid + 2] = e; units[4 * tid + 3] = r0;
        if (tid == 0) { int n = 0; if (c < nwg) n = (nwg - c + G - 1) / G; units_n[0] = n < 64 ? n : 64; }
    }
}

__host__ __device__ __forceinline__ unsigned hblk_off(int R, int p7) { const int ai = R >> 7, wr = (R >> 6) & 1, m = (R >> 4) & 3, fr = R & 15, wc = p7 >> 1, fq = ((p7 & 1) << 1) | (m & 1), mp = m >> 1;
    return (unsigned)(((((ai * 2 + wr) * 4 + wc) * 2 + mp) * 64 + fr + 16 * fq) * 16); }
typedef int v8i_t __attribute__((ext_vector_type(8)));
typedef int v4i_t __attribute__((ext_vector_type(4)));
__device__ __forceinline__ v8i_t cat8(bf16x8 lo, bf16x8 hi) { const v4i_t a = __builtin_bit_cast(v4i_t, lo), b = __builtin_bit_cast(v4i_t, hi); return __builtin_shufflevector(a, b, 0, 1, 2, 3, 4, 5, 6, 7); }
__device__ __forceinline__ void mfma8(f32x4& acc, v8i_t a, v8i_t b, int scl) { asm volatile("v_mfma_scale_f32_16x16x128_f8f6f4 %0, %1, %2, %0, %3, %3 op_sel_hi:[0,0,0]" : "+v"(acc) : "v"(a), "v"(b), "v"(scl)); }
__device__ __forceinline__ unsigned pk4_fp8(float a, float b, float c, float d) { unsigned w = 0u; w = __builtin_amdgcn_cvt_pk_fp8_f32(a, b, w, false); w = __builtin_amdgcn_cvt_pk_fp8_f32(c, d, w, true); return w; }
__device__ __forceinline__ unsigned cvt_pk_bf16(float lo, float hi) { unsigned r; asm volatile("v_cvt_pk_bf16_f32 %0, %1, %2" : "=v"(r) : "v"(lo), "v"(hi)); return r; }

struct EpiProj {
    static constexpr bool PERM = true, AFTER_DRAIN = false;
    bf16_t* O; int ldc; const float* rope; float qscale; float dqv; int pn_off;
    __device__ __forceinline__ void operator()(const f32x4 (&acc)[2][2][4][2], const Unit& u, int wr, int wc, int fr, int fq, const PG8_LAS unsigned char* sd) const {
        const int pnn = u.pn + pn_off; const int row0 = u.pm * BM + wr * 64 + fr; const int col0 = pnn * BM + wc * 32 + 8 * fq;
        const bool rot = pnn < 4; const float sc = (pnn < 2 ? qscale : 1.f) * dqv; const int gq = 4 * (wc & 1) + fq;
        float invr[4];
#pragma unroll
        for (int e = 0; e < 4; ++e) invr[e] = __builtin_amdgcn_exp2f(-(float)(4 * gq + e) * 0.41524101186092029f) * 0.15915494309189535f;
#pragma unroll
        for (int ai = 0; ai < 2; ++ai)
#pragma unroll
            for (int m = 0; m < 4; ++m) { const int row = row0 + ai * HALF + m * 16; bf16_t* rowp = O + (size_t)row * ldc + col0;
                f32x4 cs0 = (f32x4){1.f, 0.f, 1.f, 0.f}, cs1 = cs0;
                if (rot) { const float tp = (float)(row & 4095);
                    const float a0 = __builtin_amdgcn_fractf(tp * invr[0]), a1 = __builtin_amdgcn_fractf(tp * invr[1]), a2 = __builtin_amdgcn_fractf(tp * invr[2]), a3 = __builtin_amdgcn_fractf(tp * invr[3]);
                    cs0 = (f32x4){__builtin_amdgcn_cosf(a0), __builtin_amdgcn_sinf(a0), __builtin_amdgcn_cosf(a1), __builtin_amdgcn_sinf(a1)};
                    cs1 = (f32x4){__builtin_amdgcn_cosf(a2), __builtin_amdgcn_sinf(a2), __builtin_amdgcn_cosf(a3), __builtin_amdgcn_sinf(a3)}; }
#pragma unroll
                for (int bj = 0; bj < 2; ++bj) { f32x4 v0 = acc[ai][bj][m][0], v1 = acc[ai][bj][m][1];
                    if (rot) { f32x4 lo, hi;
                        lo[0] = v0[0] * cs0[0] - v1[0] * cs0[1]; hi[0] = v1[0] * cs0[0] + v0[0] * cs0[1];
                        lo[1] = v0[1] * cs0[2] - v1[1] * cs0[3]; hi[1] = v1[1] * cs0[2] + v0[1] * cs0[3];
                        lo[2] = v0[2] * cs1[0] - v1[2] * cs1[1]; hi[2] = v1[2] * cs1[0] + v0[2] * cs1[1];
                        lo[3] = v0[3] * cs1[2] - v1[3] * cs1[3]; hi[3] = v1[3] * cs1[2] + v0[3] * cs1[3];
                        v0 = lo * sc; v1 = hi * sc; }
                    else { v0 = v0 * dqv; v1 = v1 * dqv; }
                    u32x4 w; w.x = cvt_pk_bf16(v0[0], v0[1]); w.y = cvt_pk_bf16(v0[2], v0[3]); w.z = cvt_pk_bf16(v1[0], v1[1]); w.w = cvt_pk_bf16(v1[2], v1[3]);
                    *(u32x4*)(rowp + bj * HALF) = w; } }
    }
};
struct EpiF32 {
    static constexpr bool PERM = false, AFTER_DRAIN = false;
    float* O; int ldc;
    __device__ __forceinline__ void operator()(const f32x4 (&acc)[2][2][4][2], const Unit& u, int wr, int wc, int fr, int fq, const PG8_LAS unsigned char* sd) const {
        const int row0 = u.pm * BM + wr * 64 + fr; const int col0 = u.pn * BM + wc * 32 + 4 * fq;
#pragma unroll
        for (int ai = 0; ai < 2; ++ai)
#pragma unroll
            for (int m = 0; m < 4; ++m) { float* rowp = O + (size_t)(row0 + ai * HALF + m * 16) * ldc + col0;
#pragma unroll
                for (int bj = 0; bj < 2; ++bj)
#pragma unroll
                    for (int n = 0; n < 2; ++n) *(f32x4*)(rowp + bj * HALF + n * 16) = acc[ai][bj][m][n]; }
    }
};
struct EpiBf16Plain {
    static constexpr bool PERM = true, AFTER_DRAIN = false;
    bf16_t* O; int ldc;
    __device__ __forceinline__ void operator()(const f32x4 (&acc)[2][2][4][2], const Unit& u, int wr, int wc, int fr, int fq, const PG8_LAS unsigned char* sd) const {
        const int row0 = u.pm * BM + wr * 64 + fr; const int col0 = u.pn * BM + wc * 32 + 8 * fq;
#pragma unroll
        for (int ai = 0; ai < 2; ++ai)
#pragma unroll
            for (int m = 0; m < 4; ++m) { bf16_t* rowp = O + (size_t)(row0 + ai * HALF + m * 16) * ldc + col0;
#pragma unroll
                for (int bj = 0; bj < 2; ++bj) { const f32x4 v0 = acc[ai][bj][m][0], v1 = acc[ai][bj][m][1];
                    u32x4 w; w.x = cvt_pk_bf16(v0[0], v0[1]); w.y = cvt_pk_bf16(v0[2], v0[3]); w.z = cvt_pk_bf16(v1[0], v1[1]); w.w = cvt_pk_bf16(v1[2], v1[3]);
                    *(u32x4*)(rowp + bj * HALF) = w; } }
    }
};
struct EpiSwiglu {
    static constexpr bool PERM = true, AFTER_DRAIN = false;
    unsigned char* H; const float* bgu; const float* rowgate; const PG8_LAS int* cnt; float dq, hscale;
    __device__ __forceinline__ void operator()(const f32x4 (&acc)[2][2][4][2], const Unit& u, int wr, int wc, int fr, int fq, const PG8_LAS unsigned char* sd) const {
        const int ff = u.pn * HALF + wc * 32 + 8 * fq; const int n_e = cnt[u.e];
        f32x4 bg[2], bu[2];
#pragma unroll
        for (int n = 0; n < 2; ++n) { bg[n] = *(const PG8_LAS f32x4*)(sd + 2048 + (wc * 32 + 8 * fq + 4 * n) * 4); bu[n] = *(const PG8_LAS f32x4*)(sd + 2048 + 512 + (wc * 32 + 8 * fq + 4 * n) * 4); }
        const int lane = fr + 16 * fq;
#pragma unroll
        for (int ai = 0; ai < 2; ++ai)
#pragma unroll
            for (int mp = 0; mp < 2; ++mp) {
                unsigned pw[2][2];
#pragma unroll
                for (int mm = 0; mm < 2; ++mm) { const int m = 2 * mp + mm; const int r = ai * HALF + wr * 64 + m * 16 + fr; const int er = u.r0 + r;
                    const float rgl = ((const PG8_LAS float*)(sd + 1024))[r]; const float rg = ((er < n_e) ? rgl : 0.f) * hscale;
                    float hv[8];
#pragma unroll
                    for (int n = 0; n < 2; ++n)
#pragma unroll
                        for (int q = 0; q < 4; q += 2) {
                            f32x2 g = (f32x2){acc[ai][0][m][n][q], acc[ai][0][m][n][q + 1]} * dq + (f32x2){bg[n][q], bg[n][q + 1]};
                            f32x2 up = (f32x2){acc[ai][1][m][n][q], acc[ai][1][m][n][q + 1]} * dq + (f32x2){bu[n][q], bu[n][q + 1]};
                            g.x = fminf(g.x, 7.0f); g.y = fminf(g.y, 7.0f); up.x = fminf(fmaxf(up.x, -7.0f), 7.0f); up.y = fminf(fmaxf(up.y, -7.0f), 7.0f);
                            const f32x2 ea = g * (-1.702f * 1.4426950408889634f); f32x2 den; den.x = __builtin_amdgcn_exp2f(ea.x); den.y = __builtin_amdgcn_exp2f(ea.y); den = den + 1.0f;
                            f32x2 sg; sg.x = __builtin_amdgcn_rcpf(den.x); sg.y = __builtin_amdgcn_rcpf(den.y);
                            const f32x2 h2 = ((up + 1.0f) * g) * (sg * rg);
                            hv[n * 4 + q] = h2.x; hv[n * 4 + q + 1] = h2.y; }
                    pw[mm][0] = pk4_fp8(hv[0], hv[1], hv[2], hv[3]); pw[mm][1] = pk4_fp8(hv[4], hv[5], hv[6], hv[7]); }
                const auto s0 = __builtin_amdgcn_permlane16_swap(pw[0][0], pw[1][0], false, false); const auto s1 = __builtin_amdgcn_permlane16_swap(pw[0][1], pw[1][1], false, false);
                *(u32x4*)(H + ((size_t)u.pm * 8 + u.pn) * 32768 + ((((ai * 2 + wr) * 4 + wc) * 2 + mp) * 64 + lane) * 16) = (u32x4){s0[0], s1[0], s0[1], s1[1]};
                asm volatile("" ::: "memory"); }
    }
};
struct EpiScatter {
    static constexpr bool PERM = true, AFTER_DRAIN = false;
    unsigned char* Y; const int* rowtok; const PG8_LAS int* cnt; float dq, ysc;
    __device__ __forceinline__ void operator()(const f32x4 (&acc)[2][2][4][2], const Unit& u, int wr, int wc, int fr, int fq, const PG8_LAS unsigned char* sd) const {
        const int col0 = u.pn * BM + wc * 32 + 8 * fq; const int n_e = cnt[u.e];
        f32x4 bd[2][2];
#pragma unroll
        for (int bj = 0; bj < 2; ++bj)
#pragma unroll
            for (int n = 0; n < 2; ++n) bd[bj][n] = *(const PG8_LAS f32x4*)(sd + 2048 + (bj * HALF + wc * 32 + 8 * fq + 4 * n) * 4);
#pragma unroll
        for (int ai = 0; ai < 2; ++ai)
#pragma unroll
            for (int m = 0; m < 4; ++m) { const int er = u.r0 + ai * HALF + wr * 64 + m * 16 + fr;
                const int idx = ((const PG8_LAS int*)sd)[ai * HALF + wr * 64 + m * 16 + fr];
                if (er < n_e) { unsigned char* rowp = Y + (size_t)idx * 1024 + col0;
                    typedef unsigned u32x2 __attribute__((ext_vector_type(2)));
                    const float rg = ((const PG8_LAS float*)(sd + 1024))[ai * HALF + wr * 64 + m * 16 + fr] * ysc;
#pragma unroll
                    for (int bj = 0; bj < 2; ++bj) { const f32x4 v0 = acc[ai][bj][m][0] * dq + bd[bj][0] * rg, v1 = acc[ai][bj][m][1] * dq + bd[bj][1] * rg;
                        *(u32x2*)(rowp + bj * HALF) = (u32x2){pk4_fp8(v0[0], v0[1], v0[2], v0[3]), pk4_fp8(v1[0], v1[1], v1[2], v1[3])}; } }
                asm volatile("" ::: "memory"); }
    }
};

template <class Epi, class Sched, bool ALIGN_EPI, bool GATHER, bool FP8 = false, bool ABLK = false>
__device__ __forceinline__ void gemm_phase(PG8_LAS unsigned char* lds, const Gemm g, const Sched& S, const Epi& E) {
    const int tid = threadIdx.x, wid = __builtin_amdgcn_readfirstlane(tid >> 6), lane = tid & 63, wr = wid >> 2, wc = wid & 3, fr = lane & 15, fq = lane >> 4;
    const int K = g.K, nt = K / BK;
    unsigned voffB[2];
#pragma unroll
    for (int i = 0; i < 2; ++i) { int R, C; stage_rc(tid * 16 + i * 8192, R, C); const int Rb = Epi::PERM ? ((R & ~31) + perm32(R & 31)) : R;
        voffB[i] = (unsigned)(Rb * K + C) * 2u; }
    constexpr int SIDE_BYTES = 8192;
    PG8_LAS unsigned char* const side = lds + STAGE_BYTES;
    const size_t kstep = (size_t)(BK * 2);
    const size_t kstepA = ABLK ? (size_t)32768 : kstep;
    const size_t hstep = (size_t)HALF * K * 2;
    const size_t tstep = 2 * hstep;
    const unsigned ldsw = (unsigned)wid * 1024u;
    const int aoff = lds_byte(wr * 64 + fr, fq * 8), boff = lds_byte(wc * 32 + fr, fq * 8);
#define PG8_SA(b, h) (((b) * 2 + (h)) * HTB)
#define PG8_SB(b, h) ((4 + (b) * 2 + (h)) * HTB)
#define PG8_STAGE(bufoff, gbase, voff) do { _Pragma("unroll") for (int _i = 0; _i < 2; ++_i) \
        __builtin_amdgcn_global_load_lds((const unsigned*)((const char*)(gbase) + (voff)[_i]), (PG8_LAS unsigned*)(lds + (bufoff) + ldsw + _i * 8192), 16, 0, 0); } while (0)
#define PG8_LDA(dst, b, h) do { _Pragma("unroll") for (int m = 0; m < 4; ++m) _Pragma("unroll") for (int k = 0; k < 2; ++k) dst[m][k] = *(const PG8_LAS bf16x8*)(lds + PG8_SA(b, h) + aoff + m * 2048 + k * 1024); } while (0)
#define PG8_LDB(dst, b, h) do { _Pragma("unroll") for (int n = 0; n < 2; ++n) _Pragma("unroll") for (int k = 0; k < 2; ++k) dst[n][k] = *(const PG8_LAS bf16x8*)(lds + PG8_SB(b, h) + boff + n * 2048 + k * 1024); } while (0)
#define PG8_MMA(ai, bj, At, Bt) do { __builtin_amdgcn_s_setprio(1); _Pragma("unroll") for (int m = 0; m < 4; ++m) _Pragma("unroll") for (int n = 0; n < 2; ++n) { \
        if constexpr (FP8) mfma8(acc[ai][bj][m][n], cat8(Bt[n][0], Bt[n][1]), cat8(At[m][0], At[m][1]), scl8); \
        else { _Pragma("unroll") for (int k = 0; k < 2; ++k) acc[ai][bj][m][n] = __builtin_amdgcn_mfma_f32_16x16x32_bf16(Bt[n][k], At[m][k], acc[ai][bj][m][n], 0, 0, 0); } } __builtin_amdgcn_s_setprio(0); } while (0)
#define PG8_WAIT_V(n) asm volatile("s_waitcnt vmcnt(" #n ")" ::: "memory")
#define PG8_WAIT_L(n) asm volatile("s_waitcnt lgkmcnt(" #n ")" ::: "memory")
#define PG8_BAR __builtin_amdgcn_s_barrier()
#define PG8_SCHED __builtin_amdgcn_sched_barrier(0)
#define PG8_SETOFFS(o, u) do { _Pragma("unroll") for (int _h = 0; _h < 2; ++_h) _Pragma("unroll") for (int _i = 0; _i < 2; ++_i) { int _R, _C; stage_rc(tid * 16 + _i * 8192, _R, _C); \
        o[_h][_i] = GATHER ? (S.arow(u, _R + HALF * _h) + (unsigned)(_C * 2)) : ABLK ? hblk_off(_R + HALF * _h, _C >> 3) : ((unsigned)((_R + HALF * _h) * K) * 2u + (unsigned)(_C * 2)); } } while (0)
    int scl8 = 0x7F7F7F7F; asm volatile("" : "+v"(scl8));
    Unit cur, nxt; int ui = 0;
    if (!S.next(0, cur)) return;
    f32x4 acc[2][2][4][2];
#pragma unroll
    for (int a = 0; a < 2; ++a)
#pragma unroll
        for (int b = 0; b < 2; ++b)
#pragma unroll
            for (int m = 0; m < 4; ++m)
#pragma unroll
                for (int n = 0; n < 2; ++n) { acc[a][b][m][n] = (f32x4){0.f, 0.f, 0.f, 0.f}; if constexpr (FP8) asm volatile("" : "+v"(acc[a][b][m][n])); }
    bf16x8 At[4][2], B0[2][2], B1[2][2];
    unsigned cAo[2][2];
    PG8_SETOFFS(cAo, cur);
    const char* cA = S.abase(cur, g, tstep); const char* cB = S.bbase(cur, g, tstep);
    S.a_ready(cur);
    PG8_STAGE(PG8_SB(0, 0), cB, voffB); PG8_STAGE(PG8_SB(0, 1), cB + hstep, voffB); PG8_STAGE(PG8_SA(0, 0), cA, cAo[0]); PG8_STAGE(PG8_SA(0, 1), cA, cAo[1]);
    if (wr == 1) PG8_BAR;
    PG8_WAIT_V(2); PG8_BAR;
    PG8_STAGE(PG8_SB(1, 0), cB + kstep, voffB); PG8_STAGE(PG8_SA(1, 0), cA + kstepA, cAo[0]); PG8_STAGE(PG8_SB(1, 1), cB + hstep + kstep, voffB);
    PG8_WAIT_V(6); PG8_BAR;
    for (;;) {
        const bool has_next = S.next(ui + 1, nxt);
        const char* nA = has_next ? S.abase(nxt, g, tstep) : cA; const char* nB = has_next ? S.bbase(nxt, g, tstep) : cB;
        if constexpr (Sched::SIDE) {
            const void* ssrc = S.side_src(cur, (GATHER && has_next) ? nxt : cur, wid, lane);
            __builtin_amdgcn_global_load_lds((const unsigned*)ssrc, (PG8_LAS unsigned*)(side + (ui & 1) * SIDE_BYTES + wid * 1024), 16, 0, 0); }
#pragma unroll 1
        for (int t = 0; t < nt; t += 2) {
            const bool last = (t == nt - 2);
            const char* a1 = cA + (size_t)(t + 1) * kstepA;
            const char* a2 = last ? nA : cA + (size_t)(t + 2) * kstepA; const char* b2 = last ? nB : cB + (size_t)(t + 2) * kstep;
            const char* a3 = a2 + kstepA; const char* b3 = b2 + kstep;
            if (last && has_next) S.a_ready(nxt);
            PG8_LDB(B0, 0, 0); PG8_LDB(B1, 0, 1); PG8_SCHED; PG8_LDA(At, 0, 0); PG8_STAGE(PG8_SA(1, 1), a1, cAo[1]);
            if constexpr (GATHER) { if (last && has_next) {
                const PG8_LAS unsigned char* sdn = side + (ui & 1) * SIDE_BYTES;
#pragma unroll
                for (int _h = 0; _h < 2; ++_h)
#pragma unroll
                    for (int _i = 0; _i < 2; ++_i) { int _R, _C; stage_rc(tid * 16 + _i * 8192, _R, _C); cAo[_h][_i] = S.arow_side(nxt, _R + HALF * _h, sdn) + (unsigned)(_C * 2); } } }
            PG8_WAIT_V(8); PG8_WAIT_L(0); PG8_BAR; PG8_MMA(0, 0, At, B0); PG8_MMA(0, 1, At, B1); PG8_BAR; PG8_SCHED;
            PG8_LDA(At, 0, 1); PG8_STAGE(PG8_SB(0, 0), b2, voffB); PG8_STAGE(PG8_SB(0, 1), b2 + hstep, voffB); PG8_STAGE(PG8_SA(0, 0), a2, cAo[0]);
            PG8_WAIT_V(8); PG8_WAIT_L(0); PG8_BAR; PG8_MMA(1, 0, At, B0); PG8_MMA(1, 1, At, B1); PG8_BAR; PG8_SCHED;
            PG8_LDB(B0, 1, 0); PG8_LDB(B1, 1, 1); PG8_SCHED; PG8_LDA(At, 1, 0); PG8_STAGE(PG8_SA(0, 1), a2, cAo[1]);
            PG8_WAIT_V(8); PG8_WAIT_L(0); PG8_BAR; PG8_MMA(0, 0, At, B0); PG8_MMA(0, 1, At, B1); PG8_BAR; PG8_SCHED;
            PG8_LDA(At, 1, 1); PG8_STAGE(PG8_SB(1, 0), b3, voffB); PG8_STAGE(PG8_SB(1, 1), b3 + hstep, voffB); PG8_STAGE(PG8_SA(1, 0), a3, cAo[0]);
            PG8_WAIT_V(8); PG8_WAIT_L(0); PG8_BAR; PG8_MMA(1, 0, At, B0); PG8_MMA(1, 1, At, B1); PG8_BAR; PG8_SCHED;
        }
        if constexpr (ALIGN_EPI) { if (wr == 0) PG8_BAR; }
        if constexpr (FP8) asm volatile("s_nop 15\n\ts_nop 15" ::: "memory");
        PG8_SCHED; E(acc, cur, wr, wc, fr, fq, side + (ui & 1) * SIDE_BYTES); S.done(cur); PG8_SCHED;
        if (!has_next) break;
#pragma unroll
        for (int a = 0; a < 2; ++a)
#pragma unroll
            for (int b = 0; b < 2; ++b)
#pragma unroll
                for (int m = 0; m < 4; ++m)
#pragma unroll
                    for (int n = 0; n < 2; ++n) { acc[a][b][m][n] = (f32x4){0.f, 0.f, 0.f, 0.f}; if constexpr (FP8) asm volatile("" : "+v"(acc[a][b][m][n])); }
        cur = nxt; cA = nA; cB = nB; ++ui;
        if constexpr (ALIGN_EPI) { if (wr == 1) PG8_BAR; }
    }
    PG8_WAIT_V(0);
    if constexpr (!ALIGN_EPI) { if (wr == 0) PG8_BAR; }
    PG8_BAR;
#undef PG8_SA
#undef PG8_SB
#undef PG8_STAGE
#undef PG8_LDA
#undef PG8_LDB
#undef PG8_MMA
#undef PG8_WAIT_V
#undef PG8_WAIT_L
#undef PG8_BAR
#undef PG8_SCHED
#undef PG8_SETOFFS
}
}

constexpr int NB = 8, SEQ = 4096, DM = 1024, MROWS = NB * SEQ, NLAYER = 2;
constexpr int NPROJ = 4608, INW = 4616;
constexpr int C_Q = 0, C_K = 512, C_V = 1024, C_Z = 1536, C_XS = 2048, C_SB = 3072, C_SC = 3584, C_SH = 4096;
constexpr int MIXW = 1536, NEXP = 32, TOPK = 4, FF = 1024;
constexpr float ALPHA = 1.4142135623730951f;
constexpr float LN_EPS = 1e-5f, RMS_EPS = 1e-5f;
constexpr float QSCALE = 0.125f * 1.4426950408889634f;

constexpr size_t MiB = 1u << 20;
constexpr size_t WS_CTL = 0, CTL_ZERO_BYTES = 1 * MiB;
constexpr size_t WS_ROPE = 1 * MiB;
constexpr size_t WS_WDT = 2 * MiB;
constexpr size_t WS_ROUT = 2 * MiB + 65536;
constexpr size_t WS_WIN = 4 * MiB;
constexpr size_t WS_WOUT = 24 * MiB;
constexpr size_t WS_WGU = 32 * MiB;
constexpr size_t WS_WDN = 288 * MiB;
constexpr size_t WS_XB = 416 * MiB;
constexpr size_t WS_XF = 480 * MiB;
constexpr size_t WS_XF2 = 608 * MiB;
constexpr size_t WS_PROJ = 736 * MiB;
constexpr size_t WS_DT = 1024 * MiB;
constexpr size_t WS_DTS = 1025 * MiB;
constexpr size_t WS_ACUM = 1026 * MiB;
constexpr size_t WS_LSE = 1027 * MiB;
constexpr size_t WS_OP = 1030 * MiB;
constexpr size_t WS_U = 1126 * MiB;
constexpr size_t WS_G = 1190 * MiB;
constexpr size_t WS_ST = 1222 * MiB;
constexpr size_t WS_YD = 1286 * MiB;
constexpr size_t WS_MIXED = 1350 * MiB;
constexpr size_t WS_MIXF = 1446 * MiB;
constexpr size_t WS_TOPE = 1574 * MiB;
constexpr size_t WS_TOPG = 1575 * MiB;
constexpr size_t WS_ROWTOK = 1576 * MiB;
constexpr size_t WS_ROWGATE = 1580 * MiB;
constexpr size_t WS_H = 736 * MiB;
constexpr size_t WS_YB = 1030 * MiB;
constexpr size_t WS_END = 1584 * MiB;
constexpr int CW_TMO = 0;
constexpr int CW_CNT = 64;
constexpr int CW_BAR = 4096;

constexpr int RING_OFF = 0, RING_BYTES = 131072;
constexpr int LDSCTL_OFF = 155648;
constexpr int L_MISC = LDSCTL_OFF;
constexpr int L_TSTART = LDSCTL_OFF + 256;
constexpr int L_CNT = LDSCTL_OFF + 512;
constexpr int L_LCNT = LDSCTL_OFF + 640;
constexpr int L_LBASE = LDSCTL_OFF + 768;
constexpr int L_UNITS = LDSCTL_OFF + 1024;
constexpr int L_UNITSN = LDSCTL_OFF + 2048;
constexpr int LDS_BYTES = 163840;

#define GAS __attribute__((address_space(1)))
#define LAS __attribute__((address_space(3)))
typedef unsigned short bf16;
typedef unsigned v4u __attribute__((ext_vector_type(4)));
typedef unsigned v2u __attribute__((ext_vector_type(2)));
typedef float f32x4 __attribute__((ext_vector_type(4)));
typedef float f32x16 __attribute__((ext_vector_type(16)));
typedef short bf16x8 __attribute__((ext_vector_type(8)));
typedef GAS unsigned gu32;
#define RLX_AGENT __ATOMIC_RELAXED, __HIP_MEMORY_SCOPE_AGENT
#define LDS_WAIT() asm volatile("s_waitcnt lgkmcnt(0)" ::: "memory")
#define VM_WAIT() asm volatile("s_waitcnt vmcnt(0)" ::: "memory")
__device__ __forceinline__ unsigned f2bf(float f) { unsigned u = __builtin_bit_cast(unsigned, f); return (u + 0x7fffu + ((u >> 16) & 1u)) >> 16; }
__device__ __forceinline__ unsigned pk2(float lo, float hi) { unsigned r; asm volatile("v_cvt_pk_bf16_f32 %0, %1, %2" : "=v"(r) : "v"(lo), "v"(hi)); return r; }
__device__ __forceinline__ float bf2f(unsigned short b) { return __builtin_bit_cast(float, (unsigned)b << 16); }
__device__ __forceinline__ float bflo(unsigned w) { return __builtin_bit_cast(float, w << 16); }
__device__ __forceinline__ float bfhi(unsigned w) { return __builtin_bit_cast(float, w & 0xffff0000u); }
__device__ __forceinline__ float siluf(float x) { return x * __builtin_amdgcn_rcpf(1.0f + __builtin_amdgcn_exp2f(-1.4426950408889634f * x)); }
#define XB_TMO      128
#define XB_XCNT(j)  (256  + 64 * (j))
#define XB_XSUB(j)  (1280 + 64 * (j))
#define XB_XGEN(j)  (2304 + 64 * (j))
#define XB_TOP      3328
#define XB_TOPGEN   3392
#define XCD_BAR_WORDS 3456
#define XB_SPIN_CAP (1u << 18)

__device__ __forceinline__ unsigned xb_ld(unsigned* p)              { return __hip_atomic_load(p, __ATOMIC_RELAXED, __HIP_MEMORY_SCOPE_AGENT); }
__device__ __forceinline__ unsigned xb_add(unsigned* p, unsigned v) { return __hip_atomic_fetch_add(p, v, __ATOMIC_RELAXED, __HIP_MEMORY_SCOPE_AGENT); }
__device__ __forceinline__ unsigned xb_xcc_id() { return (unsigned)__builtin_amdgcn_s_getreg((3 << 11) | 20) & 0xFu; }
#define XB_SPIN(cond, bar) do { unsigned _sp = 0; while (cond) { __builtin_amdgcn_s_sleep(1); \
    if ((++_sp & 255u) == 0u) { if (xb_ld(&(bar)[XB_TMO])) break; if (_sp > XB_SPIN_CAP) { atomicAdd(&(bar)[XB_TMO], 1u); break; } } } } while (0)

struct XcdBarrier {
    unsigned* bar; unsigned x;
    volatile LAS unsigned* st;
};

__device__ __forceinline__ XcdBarrier xcd_barrier_post(unsigned* bar, volatile LAS unsigned* st) {
    XcdBarrier b; b.bar = bar; b.x = xb_xcc_id(); b.st = st;
    if (threadIdx.x == 0) (void)xb_add(&bar[XB_XCNT(b.x)], 1u);
    return b;
}
__device__ __forceinline__ void xcd_barrier_complete(unsigned* bar, unsigned x, unsigned& nloc, unsigned& nx) {
    const unsigned G = gridDim.x * gridDim.y * gridDim.z;
    unsigned sum, cnt, mine, sp = 0u;
    for (;;) {
        sum = 0u; cnt = 0u; mine = 0u;
#pragma unroll
        for (unsigned j = 0; j < 16; ++j) { const unsigned c = xb_ld(&bar[XB_XCNT(j)]); sum += c; cnt += (c > 0u) ? 1u : 0u; mine = (j == x) ? c : mine; }
        if (sum == G) break;
        __builtin_amdgcn_s_sleep(1);
        if ((++sp & 255u) == 0u) { if (xb_ld(&bar[XB_TMO])) break; if (sp > XB_SPIN_CAP) { atomicAdd(&bar[XB_TMO], 1u); break; } }
    }
    nloc = mine > 0u ? mine : 1u; nx = cnt > 0u ? cnt : 1u;
}

__device__ __forceinline__ void xcd_barrier(const XcdBarrier& b) {
    asm volatile("s_waitcnt vmcnt(0)" ::: "memory");
    __syncthreads();
    if (threadIdx.x == 0) {
        unsigned* bar = b.bar;
        __builtin_amdgcn_s_waitcnt(0);
        unsigned nloc = b.st[0], nx = b.st[1];
        if (nloc == 0u) { xcd_barrier_complete(bar, b.x, nloc, nx); b.st[0] = nloc; b.st[1] = nx; }
        const unsigned old = xb_add(&bar[XB_XSUB(b.x)], 1u);
        const unsigned gen = old / nloc;
        if (old + 1u == (gen + 1u) * nloc) {
            __builtin_amdgcn_fence(__ATOMIC_RELEASE, "agent");
            asm volatile("s_waitcnt vmcnt(0)" ::: "memory");
            const unsigned og = xb_add(&bar[XB_TOP], 1u);
            const unsigned tg = og / nx;
            if (og + 1u == (tg + 1u) * nx) xb_add(&bar[XB_TOPGEN], 1u);
            else XB_SPIN(xb_ld(&bar[XB_TOPGEN]) == tg, bar);
            __builtin_amdgcn_fence(__ATOMIC_ACQUIRE, "agent");
            xb_add(&bar[XB_XGEN(b.x)], 1u);
            asm volatile("s_waitcnt vmcnt(0)" ::: "memory");
        } else {
            XB_SPIN(xb_ld(&bar[XB_XGEN(b.x)]) == gen, bar);
            __builtin_amdgcn_fence(__ATOMIC_ACQUIRE, "agent");
            asm volatile("s_waitcnt vmcnt(0)" ::: "memory");
        }
    }
    __syncthreads();
}

constexpr float SC_X = 4.f, SC_WGU = 32.f, SC_H = 4.f, SC_WDN = 64.f, SC_Y = 16.f, SC_WIN = 32.f;
__device__ __forceinline__ float wave_sum(float v) {
#pragma unroll
    for (int o = 1; o < 64; o <<= 1) v += __shfl_xor(v, o);
    return v;
}
__device__ __forceinline__ int win_dest_row(int n) {
    if (n < 1024) { const int hh = n >> 6, d = n & 63; const int p = (d < 32) ? (8 * (d >> 2) + (d & 3)) : (8 * ((d - 32) >> 2) + 4 + (d & 3)); return hh * 64 + p; }
    if (n < 3072) return n;
    if (n < 3080) return -1;
    return n - 8;
}
__device__ __forceinline__ int wgu_dest_row(int n) { return n < 1024 ? ((n >> 7) * 256 + (n & 127)) : (((n - 1024) >> 7) * 256 + 128 + ((n - 1024) & 127)); }
template <int MAP>
__device__ __forceinline__ void p0_transpose_item(const float* W, int K, int N, bf16* WT, float* wdt, LAS float* scr, int kb, int nb, int lane) {
    const int k0 = 64 * kb, n0 = 32 * nb;
    const int nn = n0 + (lane & 31); const bool nok = nn < N;
#pragma unroll 8
    for (int i = 0; i < 32; ++i) { const int kk = 2 * i + (lane >> 5); scr[kk * 33 + (lane & 31)] = nok ? W[(size_t)(k0 + kk) * N + nn] : 0.f; }
    LDS_WAIT(); asm volatile("" ::: "memory");
    const int c = lane & 7;
#pragma unroll
    for (int j = 0; j < 4; ++j) { const int n = (lane >> 3) + 8 * j; const LAS float* s = scr + (8 * c) * 33 + n;
        const int nsrc = n0 + n; if (nsrc >= N) continue;
        int drow = nsrc; if (MAP == 1) drow = win_dest_row(nsrc); if (MAP == 2) drow = wgu_dest_row(nsrc);
        if (MAP == 1 && drow < 0) { float* d = wdt + (size_t)(nsrc - 3072) * 1024 + k0 + 8 * c;
#pragma unroll
            for (int q = 0; q < 8; ++q) d[q] = s[q * 33]; continue; }
        v4u o; o.x = pk2(s[0 * 33], s[1 * 33]); o.y = pk2(s[2 * 33], s[3 * 33]); o.z = pk2(s[4 * 33], s[5 * 33]); o.w = pk2(s[6 * 33], s[7 * 33]);
        *(GAS v4u*)(WT + (size_t)drow * K + k0 + 8 * c) = o; }
    LDS_WAIT(); asm volatile("" ::: "memory");
}
template <int MAP>
__device__ __forceinline__ void p0_transpose_item64(const float* W, int K, int N, bf16* WT, float* wdt, LAS float* scr, int kb, int nb, int lane) {
    const int k0 = 64 * kb, n0 = 64 * nb;
    const bool lok = (n0 + 4 * (lane & 15) + 3) < N;
    f32x4 ld[16];
#pragma unroll
    for (int i = 0; i < 16; ++i) ld[i] = lok ? *(const f32x4*)(W + (size_t)(k0 + 4 * i + (lane >> 4)) * N + n0 + 4 * (lane & 15)) : (f32x4){0.f, 0.f, 0.f, 0.f};
#pragma unroll
    for (int i = 0; i < 16; ++i) *(LAS f32x4*)(scr + (4 * i + (lane >> 4)) * 64 + 4 * (lane & 15)) = ld[i];
    LDS_WAIT(); asm volatile("" ::: "memory");
    const int nsrc = n0 + lane;
    if (nsrc < N) {
        int drow = nsrc; if (MAP == 1) drow = win_dest_row(nsrc);
        if (MAP == 1 && drow < 0) { float* d = wdt + (size_t)(nsrc - 3072) * 1024 + k0;
#pragma unroll
            for (int q = 0; q < 16; ++q) *(f32x4*)(d + 4 * q) = (f32x4){scr[(4 * q) * 64 + lane], scr[(4 * q + 1) * 64 + lane], scr[(4 * q + 2) * 64 + lane], scr[(4 * q + 3) * 64 + lane]}; }
        else { GAS v4u* d = (GAS v4u*)(WT + (size_t)drow * K + k0);
#pragma unroll
            for (int q = 0; q < 8; ++q) { v4u o; o.x = pk2(scr[(8 * q) * 64 + lane], scr[(8 * q + 1) * 64 + lane]); o.y = pk2(scr[(8 * q + 2) * 64 + lane], scr[(8 * q + 3) * 64 + lane]);
                o.z = pk2(scr[(8 * q + 4) * 64 + lane], scr[(8 * q + 5) * 64 + lane]); o.w = pk2(scr[(8 * q + 6) * 64 + lane], scr[(8 * q + 7) * 64 + lane]); d[q] = o; } } }
    LDS_WAIT(); asm volatile("" ::: "memory");
}
struct SubT { const float* src; unsigned char* dst; int N; int n0; int mode; float scale; };
__device__ __forceinline__ SubT fp8_subtile(int item, int half, const float* wgu, const float* wdn, const float* win, unsigned char* WG8, unsigned char* WD8, unsigned char* WI8, int lane) {
    SubT t; int kb, nb;
    if (item < 64 * 256) { const int le = item >> 8, r = item & 255; kb = r >> 5; nb = r & 31; t.N = 2048; t.mode = 1; t.scale = SC_WGU;
        t.src = wgu + (size_t)le * 1024 * 2048; t.dst = WG8 + (size_t)le * 2048 * 1024; }
    else if (item < 64 * 256 + 64 * 128) { const int it2 = item - 64 * 256; const int le = it2 >> 7, r = it2 & 127; kb = r >> 4; nb = r & 15; t.N = 1024; t.mode = 0; t.scale = SC_WDN;
        t.src = wdn + (size_t)le * 1024 * 1024; t.dst = WD8 + (size_t)le * 1024 * 1024; }
    else { const int it3 = item - (64 * 256 + 64 * 128); const int l = it3 / 192, r = it3 % 192; kb = r / 24; nb = r % 24; t.N = INW; t.mode = 2; t.scale = SC_WIN;
        t.src = win + (size_t)l * 1024 * INW; t.dst = WI8 + (size_t)l * 1536 * 1024; }
    const int k0 = 128 * kb + 64 * half; t.n0 = 64 * nb;
    t.src += (size_t)(k0 + (lane >> 4)) * t.N + t.n0 + 4 * (lane & 15);
    t.dst += (size_t)k0;
    return t;
}
__device__ __forceinline__ void fp8_sub_load(const SubT& t, f32x4 (&ld)[16]) {
#pragma unroll
    for (int i = 0; i < 16; ++i) ld[i] = __builtin_nontemporal_load((const f32x4*)(t.src + (size_t)(4 * i) * t.N));
}
__device__ __forceinline__ void fp8_sub_process(const SubT& t, const f32x4 (&ld)[16], LAS float* scr, int lane) {
#pragma unroll
    for (int i = 0; i < 16; ++i) *(LAS f32x4*)(scr + (4 * i + (lane >> 4)) * 64 + 4 * (lane & 15)) = ld[i];
    LDS_WAIT(); asm volatile("" ::: "memory");
    unsigned w[16];
#pragma unroll
    for (int q = 0; q < 16; ++q) w[q] = pg8::pk4_fp8(scr[(4 * q + 0) * 64 + lane] * t.scale, scr[(4 * q + 1) * 64 + lane] * t.scale, scr[(4 * q + 2) * 64 + lane] * t.scale, scr[(4 * q + 3) * 64 + lane] * t.scale);
    LDS_WAIT(); asm volatile("" ::: "memory");
    LAS unsigned char* t2 = (LAS unsigned char*)scr;
#pragma unroll
    for (int q = 0; q < 4; ++q) *(LAS v4u*)(t2 + lane * 80 + 16 * q) = (v4u){w[4 * q], w[4 * q + 1], w[4 * q + 2], w[4 * q + 3]};
    LDS_WAIT(); asm volatile("" ::: "memory");
#pragma unroll
    for (int q = 0; q < 4; ++q) { const int n = 16 * q + (lane >> 2); const v4u v = *(const LAS v4u*)(t2 + n * 80 + 16 * (lane & 3));
        const int nn = (t.mode == 1) ? wgu_dest_row(t.n0 + n) : (t.mode == 2) ? win_dest_row(t.n0 + n) : (t.n0 + n);
        *(GAS v4u*)(t.dst + (size_t)nn * 1024 + 16 * (lane & 3)) = v; }
    LDS_WAIT(); asm volatile("" ::: "memory");
}
__device__ __forceinline__ void row_dt(const f32x4 (&v)[4], const float* wdt, float* dst, int lane) {
    float r[8];
#pragma unroll
    for (int jj = 0; jj < 8; ++jj) { float s = 0.f;
#pragma unroll
        for (int j = 0; j < 4; ++j) { const f32x4 w = *(const f32x4*)(wdt + jj * 1024 + 4 * lane + 256 * j); s += v[j][0] * w[0] + v[j][1] * w[1] + v[j][2] * w[2] + v[j][3] * w[3]; }
        r[jj] = wave_sum(s); }
    if (lane == 0) { *(f32x4*)dst = (f32x4){r[0], r[1], r[2], r[3]}; *(f32x4*)(dst + 4) = (f32x4){r[4], r[5], r[6], r[7]}; }
}
__device__ __forceinline__ void row_dt_win(const f32x4 (&v)[4], const float* win, float* dst, int lane) {
    float r[8];
#pragma unroll
    for (int jj = 0; jj < 8; ++jj) r[jj] = 0.f;
#pragma unroll
    for (int j = 0; j < 4; ++j)
#pragma unroll
        for (int e = 0; e < 4; ++e) { const float* wp = win + (size_t)(4 * lane + 256 * j + e) * INW + 3072; const f32x4 w0 = *(const f32x4*)wp, w1 = *(const f32x4*)(wp + 4); const float x = v[j][e];
            r[0] += x * w0[0]; r[1] += x * w0[1]; r[2] += x * w0[2]; r[3] += x * w0[3]; r[4] += x * w1[0]; r[5] += x * w1[1]; r[6] += x * w1[2]; r[7] += x * w1[3]; }
#pragma unroll
    for (int jj = 0; jj < 8; ++jj) r[jj] = wave_sum(r[jj]);
    if (lane == 0) { *(f32x4*)dst = (f32x4){r[0], r[1], r[2], r[3]}; *(f32x4*)(dst + 4) = (f32x4){r[4], r[5], r[6], r[7]}; }
}
template <bool W8, bool WF>
__device__ __forceinline__ void ln_row(f32x4 (&v)[4], const float* gam, const float* bet, float* of32, bf16* ob16, unsigned char* o8, float s8, int lane) {
    float s = 0.f;
#pragma unroll
    for (int j = 0; j < 4; ++j) s += (v[j][0] + v[j][1]) + (v[j][2] + v[j][3]);
    const float mean = wave_sum(s) * (1.f / DM); float s2 = 0.f;
#pragma unroll
    for (int j = 0; j < 4; ++j) { v[j] = v[j] - mean; s2 += (v[j][0] * v[j][0] + v[j][1] * v[j][1]) + (v[j][2] * v[j][2] + v[j][3] * v[j][3]); }
    const float rstd = 1.f / sqrtf(wave_sum(s2) * (1.f / DM) + LN_EPS);
#pragma unroll
    for (int j = 0; j < 4; ++j) { const f32x4 g = *(const f32x4*)(gam + 4 * lane + 256 * j), b = *(const f32x4*)(bet + 4 * lane + 256 * j);
        v[j] = v[j] * rstd * g + b;
        if (WF) *(f32x4*)(of32 + 4 * lane + 256 * j) = v[j];
        v2u w; w.x = pk2(v[j][0], v[j][1]); w.y = pk2(v[j][2], v[j][3]); *(v2u*)(ob16 + 4 * lane + 256 * j) = w;
        if (W8) *(unsigned*)(o8 + 4 * lane + 256 * j) = pg8::pk4_fp8(v[j][0] * s8, v[j][1] * s8, v[j][2] * s8, v[j][3] * s8); }
}


typedef short v4i16_t __attribute__((ext_vector_type(4)));
__device__ __forceinline__ bf16x8 tr_pair(const LAS unsigned char* p0, const LAS unsigned char* p1) {
    const v4i16_t a = __builtin_amdgcn_ds_read_tr16_b64_v4i16((LAS v4i16_t*)p0), b = __builtin_amdgcn_ds_read_tr16_b64_v4i16((LAS v4i16_t*)p1);
    return (bf16x8){a[0], a[1], a[2], a[3], b[0], b[1], b[2], b[3]};
}
__device__ __forceinline__ int crow16(int r, int hi) { return (r & 3) + 8 * (r >> 2) + 4 * hi; }
constexpr int AK_PITCH = 144, AV_PITCH = 192, AK_TILE = 32 * AK_PITCH, AV_TILE = 32 * AV_PITCH;
constexpr int AT_K = 0, AT_V = 12 * AK_TILE;
struct AttnItem { int p, b, h, d, r, qt0; };
__device__ __forceinline__ AttnItem attn_item(int I) { AttnItem a; a.p = I >> 10; const int rem = I & 1023; a.b = rem >> 7; a.h = (rem >> 4) & 7; const int grp = rem & 15;
    a.d = (a.p == 0) ? 1 : (a.p == 1) ? 4 : 16; const int tpr = 128 / a.d; const int T = grp * 8; a.r = T / tpr; a.qt0 = T % tpr; return a; }
__device__ __forceinline__ void attn_request(const bf16* PROJ, const AttnItem& a, v4u (&st)[12], int tid) {
    const int rr = tid >> 4, ch = tid & 15; const int col = (ch < 8 ? C_K : C_V - 64) + a.h * 64 + ch * 8;
#pragma unroll
    for (int tl = 0; tl < 12; ++tl) { const int kt = a.qt0 - 4 + tl; st[tl] = (v4u){0u, 0u, 0u, 0u};
        if (kt >= 0) { const size_t row = (size_t)a.b * SEQ + (size_t)(32 * kt + rr) * a.d + a.r; st[tl] = *(const v4u*)(PROJ + row * NPROJ + col); } }
}
__device__ __forceinline__ void attn_deposit(LAS unsigned char* al, const v4u (&st)[12], int tid) {
    const int rr = tid >> 4, ch = tid & 15;
    LAS unsigned char* dst = (ch < 8) ? (al + AT_K + rr * AK_PITCH + ch * 16) : (al + AT_V + rr * AV_PITCH + (ch - 8) * 16); const int tstep = (ch < 8) ? AK_TILE : AV_TILE;
#pragma unroll
    for (int tl = 0; tl < 12; ++tl) *(LAS v4u*)(dst + tl * tstep) = st[tl];
}
__device__ __forceinline__ void attn_wave_compute(const bf16* PROJ, bf16* OPp, float* LSEp, const AttnItem& a, const LAS unsigned char* al, int wave, int lane) {
    const int i = lane & 31, h2 = lane >> 5; const int qt = a.qt0 + wave;
    const size_t rowq = (size_t)a.b * SEQ + (size_t)(32 * qt + i) * a.d + a.r;
    bf16x8 qf[4];
    { const bf16* qp = PROJ + rowq * NPROJ + C_Q + a.h * 64 + 8 * h2;
#pragma unroll
      for (int s = 0; s < 4; ++s) qf[s] = *(const bf16x8*)(qp + 16 * s); }
    f32x16 o0 = {}, o1 = {}; float mrun = -INFINITY, lrun = 0.f;
    const int kt0 = qt > 4 ? qt - 4 : 0;
    const LAS unsigned char* krd = al + AT_K + i * AK_PITCH + 16 * h2;
    const LAS unsigned char* trb = al + AT_V + (4 * h2 + ((lane & 15) >> 2)) * AV_PITCH + (16 * ((lane >> 4) & 1) + 4 * (lane & 3)) * 2;
#pragma unroll 1
    for (int kt = kt0; kt <= qt; ++kt) {
        const int tl = kt - a.qt0 + 4;
        const LAS unsigned char* kp = krd + tl * AK_TILE; const LAS unsigned char* vp = trb + tl * AV_TILE;
        f32x16 sacc = {};
#pragma unroll
        for (int s = 0; s < 4; ++s) sacc = __builtin_amdgcn_mfma_f32_32x32x16_bf16(*(const LAS bf16x8*)(kp + 32 * s), qf[s], sacc, 0, 0, 0);
        if (kt == qt) {
#pragma unroll
            for (int rg = 0; rg < 16; ++rg) if (crow16(rg, h2) > i) sacc[rg] = -INFINITY;
        }
        if (kt + 4 == qt) {
#pragma unroll
            for (int rg = 0; rg < 16; ++rg) if (crow16(rg, h2) < i) sacc[rg] = -INFINITY;
        }
        float mx = sacc[0];
#pragma unroll
        for (int rg = 1; rg < 16; ++rg) mx = fmaxf(mx, sacc[rg]);
        mx = fmaxf(mx, __shfl_xor(mx, 32));
        const float mnew = fmaxf(mrun, mx), alpha = __builtin_amdgcn_exp2f(mrun - mnew); mrun = mnew;
        float ps = 0.f;
#pragma unroll
        for (int rg = 0; rg < 16; ++rg) { sacc[rg] = __builtin_amdgcn_exp2f(sacc[rg] - mnew); ps += sacc[rg]; }
        lrun = lrun * alpha + ps;
#pragma unroll
        for (int rg = 0; rg < 16; ++rg) { o0[rg] *= alpha; o1[rg] *= alpha; }
        bf16x8 pf[2];
#pragma unroll
        for (int ks = 0; ks < 2; ++ks) { v4u w; w.x = pg8::cvt_pk_bf16(sacc[8 * ks + 0], sacc[8 * ks + 1]); w.y = pg8::cvt_pk_bf16(sacc[8 * ks + 2], sacc[8 * ks + 3]); w.z = pg8::cvt_pk_bf16(sacc[8 * ks + 4], sacc[8 * ks + 5]); w.w = pg8::cvt_pk_bf16(sacc[8 * ks + 6], sacc[8 * ks + 7]); pf[ks] = __builtin_bit_cast(bf16x8, w); }
#pragma unroll
        for (int ks = 0; ks < 2; ++ks) {
            const bf16x8 v0 = tr_pair(vp + (16 * ks) * AV_PITCH, vp + (16 * ks + 8) * AV_PITCH);
            const bf16x8 v1 = tr_pair(vp + (16 * ks) * AV_PITCH + 64, vp + (16 * ks + 8) * AV_PITCH + 64);
            o0 = __builtin_amdgcn_mfma_f32_32x32x16_bf16(v0, pf[ks], o0, 0, 0, 0);
            o1 = __builtin_amdgcn_mfma_f32_32x32x16_bf16(v1, pf[ks], o1, 0, 0, 0);
        }
    }
    const float lt = lrun + __shfl_xor(lrun, 32); const float il = 1.0f / lt;
    bf16* op = OPp + rowq * 512 + a.h * 64 + 4 * h2;
#pragma unroll
    for (int g4 = 0; g4 < 4; ++g4) {
        v2u w0, w1; w0.x = pg8::cvt_pk_bf16(o0[4 * g4 + 0] * il, o0[4 * g4 + 1] * il); w0.y = pg8::cvt_pk_bf16(o0[4 * g4 + 2] * il, o0[4 * g4 + 3] * il);
        w1.x = pg8::cvt_pk_bf16(o1[4 * g4 + 0] * il, o1[4 * g4 + 1] * il); w1.y = pg8::cvt_pk_bf16(o1[4 * g4 + 2] * il, o1[4 * g4 + 3] * il);
        *(v2u*)(op + 8 * g4) = w0; *(v2u*)(op + 32 + 8 * g4) = w1; }
    if (h2 == 0) LSEp[rowq * 8 + a.h] = mrun + log2f(lt);
}
__device__ __forceinline__ void attn_phase(LAS unsigned char* al, const bf16* PROJ, bf16* OP, float* LSE, int bid, int G, int tid, int wave, int lane) {
    v4u st[12];
    int I = bid;
    if (I < 3072) { const AttnItem a = attn_item(I); attn_request(PROJ, a, st, tid); }
    for (; I < 3072; I += G) {
        const AttnItem a = attn_item(I);
        __syncthreads();
        attn_deposit(al, st, tid);
        __syncthreads();
        if (I + G < 3072) { const AttnItem n = attn_item(I + G); attn_request(PROJ, n, st, tid); }
        attn_wave_compute(PROJ, OP + (size_t)a.p * MROWS * 512, LSE + (size_t)a.p * MROWS * 8, a, al, wave, lane);
    }
    __syncthreads();
}

constexpr int SS_DTS = 0, SS_ACUM = 2048, SS_TMP = 4096, SS_SSX = 6144, SS_IMG = 8192;
constexpr int S1_PB = 320, S1_PX = 576;
constexpr int S1_B = SS_IMG, S1_X = SS_IMG + 128 * S1_PB;
constexpr int S3_PBC = 272, S3_PX = 576;
constexpr int S3_B = SS_IMG, S3_C = S3_B + 128 * S3_PBC, S3_X = S3_C + 128 * S3_PBC;

__device__ __forceinline__ void ssd_prep(LAS unsigned char* sl, const float* DT, const float* dtb, const float* alog, size_t row0, int g, int tid, int lane, int wave) {
    LAS float* dts = (LAS float*)(sl + SS_DTS); LAS float* acum = (LAS float*)(sl + SS_ACUM); LAS float* tmp = (LAS float*)(sl + SS_TMP);
    { const int l = tid >> 2, hq = tid & 3; const float x = DT[(row0 + l) * 8 + 4 * g + hq] + dtb[4 * g + hq];
      const float dt = x > 20.f ? x : log1pf(__expf(x)); dts[hq * 128 + l] = dt; tmp[hq * 128 + l] = dt * (-__expf(alog[4 * g + hq])); }
    __syncthreads();
    if (wave < 4) { const float v0 = tmp[wave * 128 + 2 * lane], v1 = tmp[wave * 128 + 2 * lane + 1]; float s = v0 + v1;
#pragma unroll
        for (int off = 1; off < 64; off <<= 1) { const float t = __shfl_up(s, off); if (lane >= off) s += t; }
        acum[wave * 128 + 2 * lane] = s - v1; acum[wave * 128 + 2 * lane + 1] = s; }
    __syncthreads();
}
template <int NCOLS, int FACMODE>
__device__ __forceinline__ void conv_tile(const bf16* PROJ, size_t row0, int t0, int pcol0, const float* cw, const float* cb, int cch0, LAS unsigned char* dst, int pitch, const LAS unsigned char* sl, int hq0, int tid) {
    constexpr int NCH8 = NCOLS / 8, NSEG = 512 / NCH8, RPS = 128 / NSEG;
    const int c8 = tid % NCH8, seg = tid / NCH8, l0 = seg * RPS;
    float w[4][8], bias[8], hst[3][8];
#pragma unroll
    for (int k = 0; k < 4; ++k) { const f32x4 a = *(const f32x4*)(cw + k * 1024 + cch0 + c8 * 8), b = *(const f32x4*)(cw + k * 1024 + cch0 + c8 * 8 + 4);
        w[k][0] = a[0]; w[k][1] = a[1]; w[k][2] = a[2]; w[k][3] = a[3]; w[k][4] = b[0]; w[k][5] = b[1]; w[k][6] = b[2]; w[k][7] = b[3]; }
    { const f32x4 a = *(const f32x4*)(cb + cch0 + c8 * 8), b = *(const f32x4*)(cb + cch0 + c8 * 8 + 4);
      bias[0] = a[0]; bias[1] = a[1]; bias[2] = a[2]; bias[3] = a[3]; bias[4] = b[0]; bias[5] = b[1]; bias[6] = b[2]; bias[7] = b[3]; }
    const bf16* src = PROJ + pcol0 + c8 * 8;
#pragma unroll
    for (int k = 0; k < 3; ++k) { const int l = l0 - 3 + k; v4u v = (v4u){0u, 0u, 0u, 0u}; if (t0 + l >= 0) v = *(const v4u*)(src + (size_t)((long)row0 + l) * NPROJ);
        hst[k][0] = bflo(v.x); hst[k][1] = bfhi(v.x); hst[k][2] = bflo(v.y); hst[k][3] = bfhi(v.y); hst[k][4] = bflo(v.z); hst[k][5] = bfhi(v.z); hst[k][6] = bflo(v.w); hst[k][7] = bfhi(v.w); }
    const LAS float* dts = (const LAS float*)(sl + SS_DTS); const LAS float* acum = (const LAS float*)(sl + SS_ACUM);
    const int hq = hq0 + (c8 * 8) / 64;
    const float alast = (FACMODE == 2) ? acum[hq * 128 + 127] : 0.f;
#pragma unroll
    for (int rr = 0; rr < RPS; ++rr) { const int l = l0 + rr; const v4u v = *(const v4u*)(src + (row0 + l) * NPROJ);
        float cur[8]; cur[0] = bflo(v.x); cur[1] = bfhi(v.x); cur[2] = bflo(v.y); cur[3] = bfhi(v.y); cur[4] = bflo(v.z); cur[5] = bfhi(v.z); cur[6] = bflo(v.w); cur[7] = bfhi(v.w);
        float f = 1.f; if (FACMODE >= 1) f = dts[hq * 128 + l]; if (FACMODE == 2) f *= __expf(alast - acum[hq * 128 + l]);
        float o[8];
#pragma unroll
        for (int e = 0; e < 8; ++e) { const float a = bias[e] + w[0][e] * hst[0][e] + w[1][e] * hst[1][e] + w[2][e] * hst[2][e] + w[3][e] * cur[e]; o[e] = siluf(a) * f;
            hst[0][e] = hst[1][e]; hst[1][e] = hst[2][e]; hst[2][e] = cur[e]; }
        v4u ov; ov.x = pk2(o[0], o[1]); ov.y = pk2(o[2], o[3]); ov.z = pk2(o[4], o[5]); ov.w = pk2(o[6], o[7]);
        *(LAS v4u*)(dst + l * pitch + c8 * 16) = ov; }
}
__device__ __forceinline__ void ssd_s1_unit(LAS unsigned char* sl, const bf16* PROJ, const float* DT, const float* dtb, const float* alog, const float* cw, const float* cb, float* ST, float* CDEC, int un, int tid, int lane, int wave) {
    const int g = un & 1, bc = un >> 1; const size_t row0 = (size_t)bc * 128; const int t0 = (bc & 31) * 128;
    __syncthreads();
    ssd_prep(sl, DT, dtb, alog, row0, g, tid, lane, wave);
    conv_tile<128, 0>(PROJ, row0, t0, C_XS + 512 + g * 128, cw, cb, 512 + g * 128, sl + S1_B, S1_PB, sl, 0, tid);
    conv_tile<256, 2>(PROJ, row0, t0, C_XS + g * 256, cw, cb, g * 256, sl + S1_X, S1_PX, sl, 0, tid);
    if (tid < 4) CDEC[(size_t)bc * 8 + 4 * g + tid] = __expf(((const LAS float*)(sl + SS_ACUM))[tid * 128 + 127]);
    __syncthreads();
    const int hq = wave >> 1, pt = wave & 1, h2 = lane >> 5, q = (lane & 15) >> 2, pp = lane & 3, dsel = (lane >> 4) & 1;
    const LAS unsigned char* xb = sl + S1_X + (8 * h2 + q) * S1_PX + (hq * 64 + pt * 32 + 16 * dsel + 4 * pp) * 2;
    const LAS unsigned char* bb = sl + S1_B + (8 * h2 + q) * S1_PB + (16 * dsel + 4 * pp) * 2;
    f32x16 acc[4];
#pragma unroll
    for (int nt = 0; nt < 4; ++nt) acc[nt] = (f32x16){};
#pragma unroll
    for (int ks = 0; ks < 8; ++ks) { const bf16x8 a = tr_pair(xb + (16 * ks) * S1_PX, xb + (16 * ks + 4) * S1_PX);
#pragma unroll
        for (int nt = 0; nt < 4; ++nt) { const bf16x8 b = tr_pair(bb + (16 * ks) * S1_PB + nt * 64, bb + (16 * ks + 4) * S1_PB + nt * 64); acc[nt] = __builtin_amdgcn_mfma_f32_32x32x16_bf16(a, b, acc[nt], 0, 0, 0); } }
    float* sp = ST + ((size_t)(bc * 8 + 4 * g + hq) * 64 + pt * 32) * 128 + (lane & 31);
#pragma unroll
    for (int nt = 0; nt < 4; ++nt)
#pragma unroll
        for (int rg = 0; rg < 16; ++rg) sp[(size_t)crow16(rg, h2) * 128 + 32 * nt] = acc[nt][rg];
}
__device__ __forceinline__ void ssd_s3_unit(LAS unsigned char* sl, const bf16* PROJ, const float* DT, const float* dtb, const float* alog, const float* cw, const float* cb, const float* dsk, const float* ng,
                                            const bf16* HIN, bf16* MIXED, int un, int tid, int lane, int wave) {
    const int g = un & 1, bc = un >> 1; const size_t row0 = (size_t)bc * 128; const int t0 = (bc & 31) * 128;
    const int lt = wave & 3, ph = wave >> 2, lq = lane & 31, hi = lane >> 5, q = (lane & 15) >> 2, pp = lane & 3, dsel = (lane >> 4) & 1;
    const int lrow = 32 * lt + lq;
    const size_t grow = row0 + lrow;
    __syncthreads();
    ssd_prep(sl, DT, dtb, alog, row0, g, tid, lane, wave);
    conv_tile<128, 0>(PROJ, row0, t0, C_XS + 512 + g * 128, cw, cb, 512 + g * 128, sl + S3_B, S3_PBC, sl, 0, tid);
    conv_tile<128, 0>(PROJ, row0, t0, C_XS + 768 + g * 128, cw, cb, 768 + g * 128, sl + S3_C, S3_PBC, sl, 0, tid);
    conv_tile<256, 1>(PROJ, row0, t0, C_XS + g * 256, cw, cb, g * 256, sl + S3_X, S3_PX, sl, 0, tid);
    __syncthreads();
    const LAS float* dts = (const LAS float*)(sl + SS_DTS); const LAS float* acum = (const LAS float*)(sl + SS_ACUM); LAS float* ssx = (LAS float*)(sl + SS_SSX);
    const LAS unsigned char* crd = sl + S3_C + lrow * S3_PBC + 16 * hi;
    f32x16 y[4];
    { bf16x8 hfa[8], hfb[8];
      const bf16* hp0 = HIN + ((size_t)(bc * 8 + 4 * g) * 64 + ph * 32 + lq) * 128 + 8 * hi;
#pragma unroll
      for (int ks = 0; ks < 8; ++ks) hfa[ks] = *(const bf16x8*)(hp0 + 16 * ks);
#pragma unroll
      for (int hq = 0; hq < 4; ++hq) {
          if (hq < 3) {
#pragma unroll
              for (int ks = 0; ks < 8; ++ks) { const bf16x8 v = *(const bf16x8*)(hp0 + (size_t)(hq + 1) * 8192 + 16 * ks); if (hq & 1) hfa[ks] = v; else hfb[ks] = v; } }
          f32x16 t = (f32x16){};
#pragma unroll
          for (int ks = 0; ks < 8; ++ks) t = __builtin_amdgcn_mfma_f32_32x32x16_bf16((hq & 1) ? hfb[ks] : hfa[ks], *(const LAS bf16x8*)(crd + 32 * ks), t, 0, 0, 0);
          const float ea = __expf(acum[hq * 128 + lrow]);
#pragma unroll
          for (int rg = 0; rg < 16; ++rg) t[rg] *= ea;
          y[hq] = t; } }
    v2u zr[4][4];
#pragma unroll
    for (int hq = 0; hq < 4; ++hq)
#pragma unroll
        for (int g4 = 0; g4 < 4; ++g4) zr[hq][g4] = *(const v2u*)(PROJ + grow * NPROJ + C_Z + g * 256 + hq * 64 + ph * 32 + 8 * g4 + 4 * hi);
#pragma unroll
    for (int st = 0; st < 4; ++st) if (st <= lt) {
        f32x16 ag = (f32x16){};
        { const LAS unsigned char* brd = sl + S3_B + (32 * st + lq) * S3_PBC + 16 * hi;
#pragma unroll
          for (int ks = 0; ks < 8; ++ks) ag = __builtin_amdgcn_mfma_f32_32x32x16_bf16(*(const LAS bf16x8*)(brd + 32 * ks), *(const LAS bf16x8*)(crd + 32 * ks), ag, 0, 0, 0); }
#pragma unroll
        for (int hq = 0; hq < 4; ++hq) {
            const float al = acum[hq * 128 + lrow], dd = dsk[4 * g + hq] / dts[hq * 128 + lrow];
            const LAS unsigned char* xb = sl + S3_X + (4 * hi + q) * S3_PX + (hq * 64 + ph * 32 + 16 * dsel + 4 * pp) * 2;
            float pm[16];
#pragma unroll
            for (int g4 = 0; g4 < 4; ++g4) { const f32x4 as4 = *(const LAS f32x4*)(acum + hq * 128 + 32 * st + 8 * g4 + 4 * hi);
#pragma unroll
                for (int e = 0; e < 4; ++e) { const int rg = 4 * g4 + e; float v = ag[rg] * __expf(al - as4[e]);
                    if (st == lt) { const int sl_ = 8 * g4 + 4 * hi + e; if (sl_ > lq) v = 0.f; if (sl_ == lq) v += dd; }
                    pm[rg] = v; } }
#pragma unroll
            for (int ks = 0; ks < 2; ++ks) { v4u wv; wv.x = pg8::cvt_pk_bf16(pm[8 * ks + 0], pm[8 * ks + 1]); wv.y = pg8::cvt_pk_bf16(pm[8 * ks + 2], pm[8 * ks + 3]); wv.z = pg8::cvt_pk_bf16(pm[8 * ks + 4], pm[8 * ks + 5]); wv.w = pg8::cvt_pk_bf16(pm[8 * ks + 6], pm[8 * ks + 7]);
                const bf16x8 xt = tr_pair(xb + (32 * st + 16 * ks) * S3_PX, xb + (32 * st + 16 * ks + 8) * S3_PX);
                y[hq] = __builtin_amdgcn_mfma_f32_32x32x16_bf16(xt, __builtin_bit_cast(bf16x8, wv), y[hq], 0, 0, 0); }
        }
    }
    unsigned ayp[4][8]; float ss = 0.f;
#pragma unroll
    for (int hq = 0; hq < 4; ++hq)
#pragma unroll
        for (int g4 = 0; g4 < 4; ++g4) { const v2u z = zr[hq][g4];
            const float y0 = y[hq][4 * g4 + 0] * siluf(bflo(z.x)), y1 = y[hq][4 * g4 + 1] * siluf(bfhi(z.x)), y2 = y[hq][4 * g4 + 2] * siluf(bflo(z.y)), y3 = y[hq][4 * g4 + 3] * siluf(bfhi(z.y));
            ss += (y0 * y0 + y1 * y1) + (y2 * y2 + y3 * y3);
            ayp[hq][2 * g4] = pg8::cvt_pk_bf16(y0, y1); ayp[hq][2 * g4 + 1] = pg8::cvt_pk_bf16(y2, y3); }
    ss += __shfl_xor(ss, 32);
    if (hi == 0) ssx[ph * 128 + lrow] = ss;
    __syncthreads();
    const float rs = 1.0f / sqrtf((ssx[lrow] + ssx[128 + lrow]) * (1.f / 256.f) + RMS_EPS);
#pragma unroll
    for (int hq = 0; hq < 4; ++hq)
#pragma unroll
        for (int g4 = 0; g4 < 4; ++g4) { const int ch = hq * 64 + ph * 32 + 8 * g4 + 4 * hi; const f32x4 gn = *(const f32x4*)(ng + g * 256 + ch);
            const unsigned p0 = ayp[hq][2 * g4], p1 = ayp[hq][2 * g4 + 1];
            v2u o; o.x = pg8::cvt_pk_bf16(bflo(p0) * rs * gn[0], bfhi(p0) * rs * gn[1]); o.y = pg8::cvt_pk_bf16(bflo(p1) * rs * gn[2], bfhi(p1) * rs * gn[3]);
            *(v2u*)(MIXED + grow * MIXW + 512 + g * 256 + ch) = o; }
}

struct Args { const float* in[20]; float* out; unsigned char* ws; int ph_lo, ph_hi, sub, pad; };
constexpr int NWAVES = 8;
constexpr int PH_PER_LAYER = 10, N_PHASES = 1 + NLAYER * PH_PER_LAYER;

#define in_x (args.in[0])
#define in_win (args.in[1])
#define in_convw (args.in[2])
#define in_convb (args.in[3])
#define in_dtb (args.in[4])
#define in_alog (args.in[5])
#define in_dsk (args.in[6])
#define in_ng (args.in[7])
#define in_scw (args.in[8])
#define in_wout (args.in[9])
#define in_ln1g (args.in[10])
#define in_ln1b (args.in[11])
#define in_rw (args.in[12])
#define in_rb (args.in[13])
#define in_wgu (args.in[14])
#define in_bgu (args.in[15])
#define in_wdn (args.in[16])
#define in_bdn (args.in[17])
#define in_ln2g (args.in[18])
#define in_ln2b (args.in[19])
#define ROPE ((float*)(args.ws + WS_ROPE))
#define WDT ((float*)(args.ws + WS_WDT))
#define ROUT ((bf16*)(args.ws + WS_ROUT))
#define WIN ((bf16*)(args.ws + WS_WIN))
#define WOUT ((bf16*)(args.ws + WS_WOUT))
#define WGU ((bf16*)(args.ws + WS_WGU))
#define WDN ((bf16*)(args.ws + WS_WDN))
#define XB ((bf16*)(args.ws + WS_XB))
#define XF ((float*)(args.ws + WS_XF))
#define XF2 ((float*)(args.ws + WS_XF2))
#define PROJ ((bf16*)(args.ws + WS_PROJ))
#define DT ((float*)(args.ws + WS_DT))
#define DTS ((float*)(args.ws + WS_DTS))
#define ACUM ((float*)(args.ws + WS_ACUM))
#define LSE ((float*)(args.ws + WS_LSE))
#define OP ((bf16*)(args.ws + WS_OP))
#define U ((bf16*)(args.ws + WS_U))
#define GB ((float*)(args.ws + WS_G))
#define ST ((float*)(args.ws + WS_ST))
#define YD ((float*)(args.ws + WS_YD))
#define MIXED ((bf16*)(args.ws + WS_MIXED))
#define MIXF ((bf16*)(args.ws + WS_MIXF))
#define TOPE ((int*)(args.ws + WS_TOPE))
#define TOPG ((float*)(args.ws + WS_TOPG))
#define ROWTOK ((int*)(args.ws + WS_ROWTOK))
#define ROWGATE ((float*)(args.ws + WS_ROWGATE))
#define HB ((bf16*)(args.ws + WS_H))
#define YB ((bf16*)(args.ws + WS_YB))
#define HIN ((bf16*)(args.ws + WS_G))
#define WGU8 ((unsigned char*)(args.ws + WS_WGU))
#define WDN8 ((unsigned char*)(args.ws + WS_WDN))
#define XB8 ((unsigned char*)(args.ws + WS_U))
#define H8 ((unsigned char*)(args.ws + WS_H))
#define YB8 ((unsigned char*)(args.ws + WS_YB))
#define WIN8 ((unsigned char*)(args.ws + WS_WGU + 128 * MiB))
#define XP8 ((unsigned char*)(args.ws + WS_WGU + 132 * MiB))
#define CDEC ((float*)(args.ws + WS_ACUM))
template <int layer>
__device__ __forceinline__ void run_layer(const Args& args, int lo, int hi, const XcdBarrier& bar) {
    extern __shared__ __attribute__((aligned(16))) unsigned char lds[];
    LAS unsigned char* ldsp = (LAS unsigned char*)lds;
    const int tid = threadIdx.x, lane = tid & 63, wave = __builtin_amdgcn_readfirstlane(tid >> 6);
    const int G = gridDim.x, bid = blockIdx.x;
    const int gw = bid * NWAVES + wave, NGW = G * NWAVES;
    gu32* ctl = (gu32*)(args.ws + WS_CTL);

#define IN(k) (lo <= (k) && (k) < hi)
#define SEAM(k) do { if (IN(k) && IN((k) + 1)) xcd_barrier(bar); } while (0)

        const int pb = 1 + layer * PH_PER_LAYER;
        const bf16* WINl = WIN + (size_t)layer * NPROJ * DM; const bf16* WOUTl = WOUT + (size_t)layer * DM * MIXW;
        const unsigned char* WGUl = WGU8 + (size_t)layer * NEXP * 2048 * DM; const unsigned char* WDNl = WDN8 + (size_t)layer * NEXP * DM * FF;
        gu32* gcnt = ctl + CW_CNT + 64 * layer;

        if (IN(pb + 0)) {
            if (layer == 0) {
                for (int m = gw; m < MROWS; m += NGW) { const bf16* xr = XB + (size_t)m * DM; f32x4 v[4];
#pragma unroll
                    for (int j = 0; j < 4; ++j) { const v2u a = *(const v2u*)(xr + 4 * lane + 256 * j); v[j] = (f32x4){bflo(a.x), bfhi(a.x), bflo(a.y), bfhi(a.y)}; }
                    row_dt(v, WDT, DT + (size_t)m * 8, lane); }
            }
            {
              pg8::Gemm g{(const pg8::bf16_t*)XP8, (const pg8::bf16_t*)(WIN8 + (size_t)layer * 1536 * DM), MROWS, 1536, DM / 2}; pg8::StaticOrder S; S.init(MROWS, 1536, G, bid);
              pg8::EpiProj E{PROJ, NPROJ, ROPE, QSCALE, 1.0f / (SC_X * SC_WIN), 0};
              pg8::gemm_phase<pg8::EpiProj, pg8::StaticOrder, true, false, true>(ldsp + RING_OFF, g, S, E); }
            __syncthreads();
            { pg8::Gemm g{XB, WINl + (size_t)1536 * DM, MROWS, NPROJ - 1536, DM}; pg8::StaticOrder S; S.init(MROWS, NPROJ - 1536, G, bid);
              pg8::EpiProj E{PROJ, NPROJ, ROPE, QSCALE, 1.0f, 6};
              pg8::gemm_phase<pg8::EpiProj, pg8::StaticOrder, true, false>(ldsp + RING_OFF, g, S, E); }
        }
        SEAM(pb + 0);
        if (IN(pb + 1)) {
            if (args.sub & 1) attn_phase(ldsp + RING_OFF, PROJ, OP, LSE, bid, G, tid, wave, lane);
            if (args.sub & 2) { const float* cw = in_convw + (size_t)layer * 4 * 1024; const float* cb = in_convb + (size_t)layer * 1024;
              for (int un = bid; un < 512; un += G)
                  ssd_s1_unit(ldsp + RING_OFF, PROJ, DT, in_dtb + layer * 8, in_alog + layer * 8, cw, cb, ST, CDEC, un, tid, lane, wave);
              __syncthreads(); }
            const float* sw = in_scw + (size_t)layer * 3 * 512;
            if (args.sub & 4) for (int it = bid * (NWAVES * 64) + tid; it < (int)((long)MROWS * 64); it += G * (NWAVES * 64)) { const int c8 = (int)(it & 63), row = (int)(it >> 6), t = row & (SEQ - 1); const int ch = c8 * 8;
                float a[8];
#pragma unroll
                for (int q = 0; q < 8; ++q) a[q] = 0.f;
#pragma unroll
                for (int k = 0; k < 3; ++k) { const int tt = t - 2 + k; if (tt >= 0) { const bf16* pr = PROJ + (size_t)(row - 2 + k) * NPROJ; const v4u cc = *(const v4u*)(pr + C_SC + ch), hh = *(const v4u*)(pr + C_SH + ch);
                    const f32x4 w0 = *(const f32x4*)(sw + k * 512 + ch), w1 = *(const f32x4*)(sw + k * 512 + ch + 4);
                    a[0] += w0[0] * bflo(cc.x) * bflo(hh.x); a[1] += w0[1] * bfhi(cc.x) * bfhi(hh.x); a[2] += w0[2] * bflo(cc.y) * bflo(hh.y); a[3] += w0[3] * bfhi(cc.y) * bfhi(hh.y);
                    a[4] += w1[0] * bflo(cc.z) * bflo(hh.z); a[5] += w1[1] * bfhi(cc.z) * bfhi(hh.z); a[6] += w1[2] * bflo(cc.w) * bflo(hh.w); a[7] += w1[3] * bfhi(cc.w) * bfhi(hh.w); } }
                const v4u bb = *(const v4u*)(PROJ + (size_t)row * NPROJ + C_SB + ch);
                v4u o; o.x = pk2(a[0] * bflo(bb.x), a[1] * bfhi(bb.x)); o.y = pk2(a[2] * bflo(bb.y), a[3] * bfhi(bb.y)); o.z = pk2(a[4] * bflo(bb.z), a[5] * bfhi(bb.z)); o.w = pk2(a[6] * bflo(bb.w), a[7] * bfhi(bb.w));
                *(v4u*)(MIXED + (size_t)row * MIXW + 1024 + ch) = o; }
        }
        SEAM(pb + 1);
        if (IN(pb + 2)) {
            for (int it = bid * (NWAVES * 64) + tid; it < (int)(64L * 2048); it += G * (NWAVES * 64)) { const int pn4 = (int)(it & 2047), bh = (int)(it >> 11); const int h = bh & 7, b = bh >> 3; f32x4 hc = (f32x4){0.f, 0.f, 0.f, 0.f};
#pragma unroll 8
                for (int c = 0; c < 32; ++c) { const size_t idx = ((size_t)((b * 32 + c) * 8 + h)) * 8192 + pn4 * 4; const f32x4 st = *(const f32x4*)(ST + idx);
                    v2u o; o.x = pk2(hc[0], hc[1]); o.y = pk2(hc[2], hc[3]); *(v2u*)(HIN + idx) = o;
                    hc = hc * CDEC[(size_t)(b * 32 + c) * 8 + h] + st; } }
        }
        SEAM(pb + 2);
        if (IN(pb + 3)) {
            if (args.sub & 1) { const float* cw = in_convw + (size_t)layer * 4 * 1024; const float* cb = in_convb + (size_t)layer * 1024;
              for (int un = bid; un < 512; un += G)
                  ssd_s3_unit(ldsp + RING_OFF, PROJ, DT, in_dtb + layer * 8, in_alog + layer * 8, cw, cb, in_dsk + layer * 8, in_ng + (size_t)layer * 512, HIN, MIXED, un, tid, lane, wave);
              __syncthreads(); }
            if (args.sub & 2) for (int it = bid * (NWAVES * 64) + tid; it < (int)((long)MROWS * 64); it += G * (NWAVES * 64)) { const int c8 = (int)(it & 63), row = (int)(it >> 6); const int h = c8 >> 3;
                const float l0 = LSE[((size_t)0 * MROWS + row) * 8 + h], l1 = LSE[((size_t)1 * MROWS + row) * 8 + h], l2 = LSE[((size_t)2 * MROWS + row) * 8 + h];
                const float mm = fmaxf(l0, fmaxf(l1, l2)); float w0 = exp2f(l0 - mm), w1 = exp2f(l1 - mm), w2 = exp2f(l2 - mm); const float iw = 1.0f / (w0 + w1 + w2); w0 *= iw; w1 *= iw; w2 *= iw;
                const v4u a0 = *(const v4u*)(OP + ((size_t)0 * MROWS + row) * 512 + c8 * 8), a1 = *(const v4u*)(OP + ((size_t)1 * MROWS + row) * 512 + c8 * 8), a2 = *(const v4u*)(OP + ((size_t)2 * MROWS + row) * 512 + c8 * 8);
                v4u o;
                o.x = pk2(w0 * bflo(a0.x) + w1 * bflo(a1.x) + w2 * bflo(a2.x), w0 * bfhi(a0.x) + w1 * bfhi(a1.x) + w2 * bfhi(a2.x));
                o.y = pk2(w0 * bflo(a0.y) + w1 * bflo(a1.y) + w2 * bflo(a2.y), w0 * bfhi(a0.y) + w1 * bfhi(a1.y) + w2 * bfhi(a2.y));
                o.z = pk2(w0 * bflo(a0.z) + w1 * bflo(a1.z) + w2 * bflo(a2.z), w0 * bfhi(a0.z) + w1 * bfhi(a1.z) + w2 * bfhi(a2.z));
                o.w = pk2(w0 * bflo(a0.w) + w1 * bflo(a1.w) + w2 * bflo(a2.w), w0 * bfhi(a0.w) + w1 * bfhi(a1.w) + w2 * bfhi(a2.w));
                *(v4u*)(MIXED + (size_t)row * MIXW + c8 * 8) = o; }
        }
        SEAM(pb + 3);
        if (IN(pb + 4)) {
            pg8::Gemm g{MIXED, WOUTl, MROWS, DM, MIXW}; pg8::StaticOrder S; S.init(MROWS, DM, G, bid);
            pg8::EpiBf16Plain E{MIXF, DM};
            pg8::gemm_phase<pg8::EpiBf16Plain, pg8::StaticOrder, true, false>(ldsp + RING_OFF, g, S, E);
        }
        SEAM(pb + 4);
        if (IN(pb + 5)) {
            const float* gam = in_ln1g + (size_t)layer * DM; const float* bet = in_ln1b + (size_t)layer * DM;
            for (int m = gw; m < MROWS; m += NGW) { f32x4 v[4];
#pragma unroll
                for (int j = 0; j < 4; ++j) { const v2u a = *(const v2u*)(XB + (size_t)m * DM + 4 * lane + 256 * j); const v2u b = *(const v2u*)(MIXF + (size_t)m * DM + 4 * lane + 256 * j);
                    v[j] = (f32x4){bflo(a.x), bfhi(a.x), bflo(a.y), bfhi(a.y)} * ALPHA + (f32x4){bflo(b.x), bfhi(b.x), bflo(b.y), bfhi(b.y)}; }
                ln_row<true, false>(v, gam, bet, nullptr, XB + (size_t)m * DM, XB8 + (size_t)m * DM, SC_X, lane); }
        }
        SEAM(pb + 5);
        if (IN(pb + 6)) {
            LAS int* lcnt = (LAS int*)(ldsp + L_LCNT); LAS int* lbase = (LAS int*)(ldsp + L_LBASE);
            const bf16* RT = ROUT + (size_t)layer * NEXP * DM; const float* rb = in_rb + (size_t)layer * NEXP;
            for (int blk = bid; blk < MROWS / 128; blk += G) {
                if (tid < 32) lcnt[tid] = 0;
                __syncthreads();
                const int r32 = lane & 31, hi = lane >> 5; const int row = blk * 128 + (wave & 3) * 32 + r32;
                float tv[4]; int te[4]; int lrank[4]; float gate[4];
                if (wave < 4) {
                    f32x16 acc = {};
                    const bf16* ap = RT + (size_t)r32 * DM + 8 * hi; const bf16* bp = XB + (size_t)row * DM + 8 * hi;
#pragma unroll 8
                    for (int s = 0; s < 64; ++s) { const bf16x8 a = *(const bf16x8*)(ap + 16 * s), b = *(const bf16x8*)(bp + 16 * s); acc = __builtin_amdgcn_mfma_f32_32x32x16_bf16(a, b, acc, 0, 0, 0); }
#pragma unroll
                    for (int k = 0; k < 4; ++k) { tv[k] = -INFINITY; te[k] = 1 << 20; }
#pragma unroll
                    for (int i = 0; i < 16; ++i) { const int e = (i & 3) + 8 * (i >> 2) + 4 * hi; float v = acc[i] + rb[e]; int ve = e;
#pragma unroll
                        for (int k = 0; k < 4; ++k) { const bool gt = (v > tv[k]) || (v == tv[k] && ve < te[k]); const float nv = gt ? tv[k] : v; const int ne = gt ? te[k] : ve; tv[k] = gt ? v : tv[k]; te[k] = gt ? ve : te[k]; v = nv; ve = ne; } }
                    float pv[4]; int pe[4];
#pragma unroll
                    for (int k = 0; k < 4; ++k) { pv[k] = __shfl_xor(tv[k], 32); pe[k] = __shfl_xor(te[k], 32); }
#pragma unroll
                    for (int j = 0; j < 4; ++j) { float v = pv[j]; int ve = pe[j];
#pragma unroll
                        for (int k = 0; k < 4; ++k) { const bool gt = (v > tv[k]) || (v == tv[k] && ve < te[k]); const float nv = gt ? tv[k] : v; const int ne = gt ? te[k] : ve; tv[k] = gt ? v : tv[k]; te[k] = gt ? ve : te[k]; v = nv; ve = ne; } }
                    float se = 0.f;
#pragma unroll
                    for (int k = 0; k < 4; ++k) { gate[k] = __expf(tv[k] - tv[0]); se += gate[k]; }
                    const float ise = 1.0f / se;
#pragma unroll
                    for (int k = 0; k < 4; ++k) gate[k] *= ise;
                    if (hi == 0) {
#pragma unroll
                        for (int k = 0; k < 4; ++k) lrank[k] = __hip_atomic_fetch_add(lcnt + te[k], 1, __ATOMIC_RELAXED, __HIP_MEMORY_SCOPE_WORKGROUP);
                    }
                }
                __syncthreads();
                if (tid < 32) lbase[tid] = (int)__hip_atomic_fetch_add(gcnt + tid, (unsigned)lcnt[tid], RLX_AGENT);
                __syncthreads();
                if (wave < 4 && hi == 0) {
#pragma unroll
                    for (int k = 0; k < 4; ++k) { const int r = lbase[te[k]] + lrank[k]; const size_t o = (size_t)te[k] * 32768 + r;
                        ROWTOK[o] = row * 4 + k; ROWGATE[o] = gate[k]; }
                }
                __syncthreads();
            }
        }
        SEAM(pb + 6);
        if (IN(pb + 7) || IN(pb + 8)) {
            LAS int* tstart = (LAS int*)(ldsp + L_TSTART); LAS int* cntL = (LAS int*)(ldsp + L_CNT); LAS int* units = (LAS int*)(ldsp + L_UNITS); LAS int* unitsn = (LAS int*)(ldsp + L_UNITSN);
            if (tid == 0) { int acc = 0; for (int e = 0; e < 32; ++e) { const int c = (int)__hip_atomic_load(gcnt + e, RLX_AGENT); cntL[e] = c; tstart[e] = acc; acc += (c + 255) >> 8; } tstart[32] = acc; }
            __syncthreads();
            if (IN(pb + 7)) {
                pg8::moe_build_units(units, unitsn, tstart, 8, G, bid, tid);
                __syncthreads();
                pg8::Gemm g{(const pg8::bf16_t*)XB8, (const pg8::bf16_t*)WGUl, 0, 2048, DM / 2};
                pg8::MoeOrder S{units, __builtin_amdgcn_readfirstlane(unitsn[0]), cntL, ROWTOK, 1, (unsigned)DM, (size_t)2048 * DM, ROWGATE, in_bgu + (size_t)layer * NEXP * 2048};
                pg8::EpiSwiglu E{H8, in_bgu + (size_t)layer * NEXP * 2048, ROWGATE, cntL, 1.0f / (SC_X * SC_WGU), SC_H};
                pg8::gemm_phase<pg8::EpiSwiglu, pg8::MoeOrder, true, true, true>(ldsp + RING_OFF, g, S, E);
                __syncthreads();
            }
            SEAM(pb + 7);
            if (IN(pb + 8)) {
                pg8::moe_build_units(units, unitsn, tstart, 4, G, bid, tid);
                __syncthreads();
                pg8::Gemm g{(const pg8::bf16_t*)H8, (const pg8::bf16_t*)WDNl, 0, DM, FF / 2};
                pg8::MoeOrder S{units, __builtin_amdgcn_readfirstlane(unitsn[0]), cntL, ROWTOK, 0, (unsigned)FF, (size_t)DM * FF, ROWGATE, in_bdn + (size_t)layer * NEXP * DM};
                pg8::EpiScatter E{YB8, ROWTOK, cntL, SC_Y / (SC_H * SC_WDN), SC_Y};
                pg8::gemm_phase<pg8::EpiScatter, pg8::MoeOrder, true, false, true, true>(ldsp + RING_OFF, g, S, E);
                __syncthreads();
            }
        }
        SEAM(pb + 8);
        if (IN(pb + 9)) {
            const float* gam = in_ln2g + (size_t)layer * DM; const float* bet = in_ln2b + (size_t)layer * DM; const float* bdn = in_bdn + (size_t)layer * NEXP * DM;
            for (int m = gw; m < MROWS; m += NGW) { f32x4 v[4];
#pragma unroll
                for (int j = 0; j < 4; ++j) { const v2u a = *(const v2u*)(XB + (size_t)m * DM + 4 * lane + 256 * j); v[j] = (f32x4){bflo(a.x), bfhi(a.x), bflo(a.y), bfhi(a.y)} * ALPHA; }
#pragma unroll
                for (int k = 0; k < 4; ++k) { const unsigned char* yr = YB8 + ((size_t)m * 4 + k) * DM;
#pragma unroll
                    for (int j = 0; j < 4; ++j) { const unsigned w = *(const unsigned*)(yr + 4 * lane + 256 * j);
                        typedef float f32x2_ __attribute__((ext_vector_type(2)));
                        const f32x2_ lo = __builtin_amdgcn_cvt_pk_f32_fp8(w, false), hi = __builtin_amdgcn_cvt_pk_f32_fp8(w, true);
                        v[j][0] += lo[0] * (1.0f / SC_Y); v[j][1] += lo[1] * (1.0f / SC_Y); v[j][2] += hi[0] * (1.0f / SC_Y); v[j][3] += hi[1] * (1.0f / SC_Y); } }
                ln_row<(layer + 1 < NLAYER), (layer == NLAYER - 1)>(v, gam, bet, args.out + (size_t)m * DM, XB + (size_t)m * DM, XP8 + (size_t)m * DM, SC_X, lane);
                if (layer + 1 < NLAYER) row_dt(v, WDT + (size_t)(layer + 1) * 8 * 1024, DT + (size_t)m * 8, lane); }
        }
        SEAM(pb + 9);
    #undef IN
#undef SEAM
}

__global__ void __launch_bounds__(NWAVES * 64, 2) mk_fwd(Args args) {
    extern __shared__ __attribute__((aligned(16))) unsigned char lds[];
    LAS unsigned char* ldsp = (LAS unsigned char*)lds;
    const int tid = threadIdx.x, lane = tid & 63, wave = __builtin_amdgcn_readfirstlane(tid >> 6);
    const int G = gridDim.x, bid = blockIdx.x;
    const int gw = bid * NWAVES + wave, NGW = G * NWAVES;
    gu32* ctl = (gu32*)(args.ws + WS_CTL);

    for (int u = tid; u < (LDS_BYTES - LDSCTL_OFF) / 4; u += NWAVES * 64) ((LAS unsigned*)(ldsp + LDSCTL_OFF))[u] = 0u;
    __syncthreads();
    XcdBarrier bar = xcd_barrier_post((unsigned*)(ctl + CW_BAR), (volatile LAS unsigned*)(ldsp + L_MISC) + 8);

    const int lo = args.ph_lo, hi = args.ph_hi;
#define IN(k) (lo <= (k) && (k) < hi)
#define SEAM(k) do { if (IN(k) && IN((k) + 1)) xcd_barrier(bar); } while (0)

    if (IN(0)) {
        LAS float* scr = (LAS float*)(ldsp + RING_OFF + wave * 16384);
        constexpr int I_IN = 16 * 73, I_OUT = 24 * 16, I_R = 16;
        constexpr int NIT = NLAYER * (I_IN + I_OUT + I_R);
        for (int it = gw; it < NIT; it += NGW) {
            int r = it;
            if (r < NLAYER * I_IN) { const int l = r / I_IN; r %= I_IN; p0_transpose_item64<1>(in_win + (size_t)l * DM * INW, DM, INW, WIN + (size_t)l * NPROJ * DM, WDT + (size_t)l * 8 * 1024, scr, r / 73, r % 73, lane); continue; } r -= NLAYER * I_IN;
            if (r < NLAYER * I_OUT) { const int l = r / I_OUT; r %= I_OUT; p0_transpose_item64<0>(in_wout + (size_t)l * MIXW * DM, MIXW, DM, WOUT + (size_t)l * DM * MIXW, nullptr, scr, r / 16, r % 16, lane); continue; } r -= NLAYER * I_OUT;
            { const int l = r / I_R; r %= I_R; p0_transpose_item<0>(in_rw + (size_t)l * DM * NEXP, DM, NEXP, ROUT + (size_t)l * NEXP * DM, nullptr, scr, r, 0, lane); }
        }
        { constexpr int NIT8 = 64 * 256 + 64 * 128 + NLAYER * 192;
          const int nmine = (gw < NIT8) ? (NIT8 - gw + NGW - 1) / NGW : 0; const int J = 2 * nmine;
          f32x4 lda[16], ldb[16];
          if (J > 0) { const SubT t = fp8_subtile(gw, 0, in_wgu, in_wdn, in_win, WGU8, WDN8, WIN8, lane); fp8_sub_load(t, lda); }
#pragma unroll 1
          for (int j = 0; j < J; j += 2) {
              const int item = gw + (j >> 1) * NGW;
              const SubT t0 = fp8_subtile(item, 0, in_wgu, in_wdn, in_win, WGU8, WDN8, WIN8, lane), t1 = fp8_subtile(item, 1, in_wgu, in_wdn, in_win, WGU8, WDN8, WIN8, lane);
              fp8_sub_load(t1, ldb);
              fp8_sub_process(t0, lda, scr, lane);
              if (j + 2 < J) { const SubT t2 = fp8_subtile(item + NGW, 0, in_wgu, in_wdn, in_win, WGU8, WDN8, WIN8, lane); fp8_sub_load(t2, lda); }
              fp8_sub_process(t1, ldb, scr, lane);
          } }
        __syncthreads();
    }
    if (IN(0)) {
        for (int m = gw; m < MROWS; m += NGW) { const float* xr = in_x + (size_t)m * DM; bf16* ob = XB + (size_t)m * DM; f32x4 v[4];
#pragma unroll
            for (int j = 0; j < 4; ++j) { v[j] = *(const f32x4*)(xr + 4 * lane + 256 * j); v2u w; w.x = pk2(v[j][0], v[j][1]); w.y = pk2(v[j][2], v[j][3]); *(v2u*)(ob + 4 * lane + 256 * j) = w;
                *(unsigned*)(XP8 + (size_t)m * DM + 4 * lane + 256 * j) = pg8::pk4_fp8(v[j][0] * SC_X, v[j][1] * SC_X, v[j][2] * SC_X, v[j][3] * SC_X); }
            }
    }

    SEAM(0);
    run_layer<0>(args, lo, hi, bar);
    run_layer<1>(args, lo, hi, bar);
#undef IN
#undef SEAM
}

extern "C" void kernel_launch(void* const* d_in, const int* in_sizes, int n_in, void* d_out, int out_size, void* d_ws, size_t ws_size, hipStream_t stream) {
    static int grid = 0;
    if (grid == 0) {
        if (n_in != 20 || out_size != MROWS * DM || ws_size < WS_END) { fprintf(stderr, "kernel_launch: unexpected problem (n_in %d, out %d, ws %zu)\n", n_in, out_size, ws_size); grid = -1; return; }
        if (hipFuncSetAttribute((const void*)mk_fwd, hipFuncAttributeMaxDynamicSharedMemorySize, LDS_BYTES) != hipSuccess) { fprintf(stderr, "kernel_launch: hipFuncSetAttribute failed\n"); grid = -1; return; }
        int dev = 0, cus = 0, per_cu = 0;
        (void)hipGetDevice(&dev); (void)hipDeviceGetAttribute(&cus, hipDeviceAttributeMultiprocessorCount, dev);
        if (hipOccupancyMaxActiveBlocksPerMultiprocessor(&per_cu, (const void*)mk_fwd, NWAVES * 64, LDS_BYTES) != hipSuccess || per_cu < 1) fprintf(stderr, "kernel_launch: occupancy query says %d\n", per_cu);
        (void)hipGetLastError();
        grid = cus > 0 ? cus : 256;
    }
    if (grid < 0) return;
    (void)hipMemsetAsync((char*)d_ws + WS_CTL, 0, CTL_ZERO_BYTES, stream);
    Args a{};
    for (int i = 0; i < 20; ++i) a.in[i] = (const float*)d_in[i];
    a.out = (float*)d_out; a.ws = (unsigned char*)d_ws;
    a.ph_lo = 0; a.ph_hi = N_PHASES; a.sub = 7; a.pad = 0;
    hipLaunchKernelGGL(mk_fwd, dim3(grid), dim3(NWAVES * 64), LDS_BYTES, stream, a);
#ifdef PROBE_PH
#ifndef PROBE_SUB
#define PROBE_SUB 7
#endif
    for (int i = 0; i < PROBE_N; ++i) { a.ph_lo = PROBE_PH; a.ph_hi = PROBE_PH + 1; a.sub = PROBE_SUB; hipLaunchKernelGGL(mk_fwd, dim3(grid), dim3(NWAVES * 64), LDS_BYTES, stream, a); }
#endif
}
```

```cpp
#include <hip/hip_runtime.h>
#include <cstdio>
#include <cstdint>
#include <cmath>

namespace pg8 {
#define PG8_LAS __attribute__((address_space(3)))
typedef unsigned short bf16_t;
typedef short bf16x8 __attribute__((ext_vector_type(8)));
typedef float f32x4 __attribute__((ext_vector_type(4)));
typedef float f32x2 __attribute__((ext_vector_type(2)));
typedef unsigned u32x4 __attribute__((ext_vector_type(4)));
constexpr int BM = 256, BK = 64, HALF = 128, HTB = HALF * BK * 2  , STAGE_BYTES = 8 * HTB, NXCD = 8, WGM = 8;

__host__ __device__ __forceinline__ int lds_byte(int r, int c) { const int st = (r >> 4) * 2 + (c >> 5), rr = r & 15, cc = c & 31, ob = rr * 64 + cc * 2; return st * 1024 + (ob ^ (((ob >> 9) & 1) << 5)); }
__host__ __device__ __forceinline__ void stage_rc(int b, int& R, int& C) { const int st = b / 1024, sb = b % 1024, swz = sb ^ (((sb >> 9) & 1) << 5); R = (st >> 1) * 16 + swz / 64; C = (st & 1) * 32 + (swz % 64) / 2; }
__host__ __device__ __forceinline__ int perm32(int rho) { const int n = rho >> 4, i = rho & 15; return 8 * (i >> 2) + 4 * n + (i & 3); }

struct Unit { int pm, pn, e, r0; };
struct Gemm { const bf16_t* A; const bf16_t* Bt; int M, N, K; };

struct StaticOrder {
    int nM, nN, nwg, G, c;
    __device__ void init(int M, int N, int G_, int c_) { nM = M / BM; nN = N / BM; nwg = nM * nN; G = G_; c = c_; }
    __device__ __forceinline__ bool next(int i, Unit& u) const {
        const long L = (long)i * G + c; if (L >= nwg) return false;
        int wgid = (int)L; { const int q = nwg / NXCD, r = nwg % NXCD, xcd = wgid % NXCD, off = wgid / NXCD; wgid = (xcd < r ? xcd * (q + 1) : r * (q + 1) + (xcd - r) * q) + off; }
        const int nig = WGM * nN, gid = wgid / nig, fm = gid * WGM, gsz = (nM - fm) < WGM ? (nM - fm) : WGM;
        u.pm = fm + ((wgid % nig) % gsz); u.pn = (wgid % nig) / gsz; u.e = 0; u.r0 = 0; return true;
    }
    __device__ __forceinline__ const char* abase(const Unit& u, const Gemm& g, size_t tstep) const { return (const char*)g.A + (size_t)u.pm * tstep; }
    __device__ __forceinline__ const char* bbase(const Unit& u, const Gemm& g, size_t tstep) const { return (const char*)g.Bt + (size_t)u.pn * tstep; }
    static constexpr bool SIDE = false;
    __device__ __forceinline__ unsigned arow(const Unit&, int) const { return 0u; }
    __device__ __forceinline__ unsigned arow_side(const Unit&, int, const PG8_LAS unsigned char*) const { return 0u; }
    __device__ __forceinline__ const void* side_src(const Unit&, const Unit&, int, int) const { return nullptr; }
    __device__ __forceinline__ void a_ready(const Unit&) const {}
    __device__ __forceinline__ void done(const Unit&) const {}
};

struct MoeOrder {
    const PG8_LAS int* units;
    int nunits;
    const PG8_LAS int* cnt;
    const int* rowtok;
    int gather;
    unsigned rowbytes;
    size_t bstride;
    __device__ __forceinline__ bool next(int i, Unit& u) const {
        if (i >= nunits) return false;
        u.pm = __builtin_amdgcn_readfirstlane(units[4 * i + 0]); u.pn = __builtin_amdgcn_readfirstlane(units[4 * i + 1]);
        u.e = __builtin_amdgcn_readfirstlane(units[4 * i + 2]); u.r0 = __builtin_amdgcn_readfirstlane(units[4 * i + 3]); return true;
    }
    __device__ __forceinline__ const char* abase(const Unit& u, const Gemm& g, size_t tstep) const { return gather ? (const char*)g.A : (const char*)g.A + (size_t)u.pm * tstep; }
    __device__ __forceinline__ const char* bbase(const Unit& u, const Gemm& g, size_t tstep) const { return (const char*)g.Bt + (size_t)u.e * bstride + (size_t)u.pn * tstep; }
    static constexpr bool SIDE = true;
    const float* rowgate; const float* bgu;
    __device__ __forceinline__ unsigned arow(const Unit& u, int R) const {
        const int r = u.r0 + R; const int idx = (r < cnt[u.e]) ? rowtok[(size_t)u.e * 32768 + r] : 0; return (unsigned)(idx >> 2) * rowbytes; }
    __device__ __forceinline__ unsigned arow_side(const Unit& u, int R, const PG8_LAS unsigned char* sd) const {
        const int r = u.r0 + R; const int v = ((const PG8_LAS int*)sd)[R]; const int idx = (r < cnt[u.e]) ? v : 0; return (unsigned)(idx >> 2) * rowbytes; }
    __device__ __forceinline__ const void* side_src(const Unit& cur, const Unit& rt, int wid, int lane) const {
        if (rowgate != nullptr && wid == 1) return rowgate + (size_t)cur.e * 32768 + cur.r0 + 4 * lane;
        if (bgu != nullptr && wid == 2) return gather ? (bgu + (size_t)cur.e * 2048 + (lane < 32 ? 0 : 1024 - 128) + cur.pn * 128 + 4 * lane)
                                                      : (bgu + (size_t)cur.e * 1024 + cur.pn * 256 + 4 * lane);
        return rowtok + (size_t)rt.e * 32768 + rt.r0 + 4 * lane; }
    __device__ __forceinline__ void a_ready(const Unit&) const {}
    __device__ __forceinline__ void done(const Unit&) const {}
};
__device__ __forceinline__ void moe_build_units(PG8_LAS int* units, PG8_LAS int* units_n, const PG8_LAS int* tstart, int nN, int G, int c, int tid) {
    if (tid < 64) {
        const int nT = tstart[32], nwg = nT * nN; const long L = (long)tid * G + c;
        int pm = 0, pn = 0, e = 0, r0 = 0;
        if (L < nwg) {
            int wgid = (int)L; { const int q = nwg / NXCD, r = nwg % NXCD, xcd = wgid % NXCD, off = wgid / NXCD; wgid = (xcd < r ? xcd * (q + 1) : r * (q + 1) + (xcd - r) * q) + off; }
            const int nig = WGM * nN, gid = wgid / nig, fm = gid * WGM, gsz = (nT - fm) < WGM ? (nT - fm) : WGM;
            pm = fm + ((wgid % nig) % gsz); pn = (wgid % nig) / gsz;
            for (int j = 1; j < 32; ++j) e += (tstart[j] <= pm) ? 1 : 0;
            r0 = (pm - tstart[e]) * 256;
        }
        units[4 * tid + 0] = pm; units[4 * tid + 1] = pn; units[4 * tid + 2] = e; units[4 * tid + 3] = r0;
        if (tid == 0) { int n = 0; if (c < nwg) n = (nwg - c + G - 1) / G; units_n[0] = n < 64 ? n : 64; }
    }
}

__host__ __device__ __forceinline__ unsigned hblk_off(int R, int p7) { const int ai = R >> 7, wr = (R >> 6) & 1, m = (R >> 4) & 3, fr = R & 15, wc = p7 >> 1, fq = ((p7 & 1) << 1) | (m & 1), mp = m >> 1;
    return (unsigned)(((((ai * 2 + wr) * 4 + wc) * 2 + mp) * 64 + fr + 16 * fq) * 16); }
typedef int v8i_t __attribute__((ext_vector_type(8)));
typedef int v4i_t __attribute__((ext_vector_type(4)));
__device__ __forceinline__ v8i_t cat8(bf16x8 lo, bf16x8 hi) { const v4i_t a = __builtin_bit_cast(v4i_t, lo), b = __builtin_bit_cast(v4i_t, hi); return __builtin_shufflevector(a, b, 0, 1, 2, 3, 4, 5, 6, 7); }
__device__ __forceinline__ void mfma8(f32x4& acc, v8i_t a, v8i_t b, int scl) { asm volatile("v_mfma_scale_f32_16x16x128_f8f6f4 %0, %1, %2, %0, %3, %3 op_sel_hi:[0,0,0]" : "+v"(acc) : "v"(a), "v"(b), "v"(scl)); }
__device__ __forceinline__ unsigned pk4_fp8(float a, float b, float c, float d) { unsigned w = 0u; w = __builtin_amdgcn_cvt_pk_fp8_f32(a, b, w, false); w = __builtin_amdgcn_cvt_pk_fp8_f32(c, d, w, true); return w; }
__device__ __forceinline__ unsigned cvt_pk_bf16(float lo, float hi) { unsigned r; asm volatile("v_cvt_pk_bf16_f32 %0, %1, %2" : "=v"(r) : "v"(lo), "v"(hi)); return r; }

struct EpiProj {
    static constexpr bool PERM = true, AFTER_DRAIN = false;
    bf16_t* O; int ldc; const float* rope; float qscale; float dqv; int pn_off;
    __device__ __forceinline__ void operator()(const f32x4 (&acc)[2][2][4][2], const Unit& u, int wr, int wc, int fr, int fq, const PG8_LAS unsigned char* sd) const {
        const int pnn = u.pn + pn_off; const int row0 = u.pm * BM + wr * 64 + fr; const int col0 = pnn * BM + wc * 32 + 8 * fq;
        const bool rot = pnn < 4; const float sc = (pnn < 2 ? qscale : 1.f) * dqv; const int gq = 4 * (wc & 1) + fq;
        float invr[4];
#pragma unroll
        for (int e = 0; e < 4; ++e) invr[e] = __builtin_amdgcn_exp2f(-(float)(4 * gq + e) * 0.41524101186092029f) * 0.15915494309189535f;
#pragma unroll
        for (int ai = 0; ai < 2; ++ai)
#pragma unroll
            for (int m = 0; m < 4; ++m) { const int row = row0 + ai * HALF + m * 16; bf16_t* rowp = O + (size_t)row * ldc + col0;
                f32x4 cs0 = (f32x4){1.f, 0.f, 1.f, 0.f}, cs1 = cs0;
                if (rot) { const float tp = (float)(row & 4095);
                    const float a0 = __builtin_amdgcn_fractf(tp * invr[0]), a1 = __builtin_amdgcn_fractf(tp * invr[1]), a2 = __builtin_amdgcn_fractf(tp * invr[2]), a3 = __builtin_amdgcn_fractf(tp * invr[3]);
                    cs0 = (f32x4){__builtin_amdgcn_cosf(a0), __builtin_amdgcn_sinf(a0), __builtin_amdgcn_cosf(a1), __builtin_amdgcn_sinf(a1)};
                    cs1 = (f32x4){__builtin_amdgcn_cosf(a2), __builtin_amdgcn_sinf(a2), __builtin_amdgcn_cosf(a3), __builtin_amdgcn_sinf(a3)}; }
#pragma unroll
                for (int bj = 0; bj < 2; ++bj) { f32x4 v0 = acc[ai][bj][m][0], v1 = acc[ai][bj][m][1];
                    if (rot) { f32x4 lo, hi;
                        lo[0] = v0[0] * cs0[0] - v1[0] * cs0[1]; hi[0] = v1[0] * cs0[0] + v0[0] * cs0[1];
                        lo[1] = v0[1] * cs0[2] - v1[1] * cs0[3]; hi[1] = v1[1] * cs0[2] + v0[1] * cs0[3];
                        lo[2] = v0[2] * cs1[0] - v1[2] * cs1[1]; hi[2] = v1[2] * cs1[0] + v0[2] * cs1[1];
                        lo[3] = v0[3] * cs1[2] - v1[3] * cs1[3]; hi[3] = v1[3] * cs1[2] + v0[3] * cs1[3];
                        v0 = lo * sc; v1 = hi * sc; }
                    else { v0 = v0 * dqv; v1 = v1 * dqv; }
                    u32x4 w; w.x = cvt_pk_bf16(v0[0], v0[1]); w.y = cvt_pk_bf16(v0[2], v0[3]); w.z = cvt_pk_bf16(v1[0], v1[1]); w.w = cvt_pk_bf16(v1[2], v1[3]);
                    *(u32x4*)(rowp + bj * HALF) = w; } }
    }
};
struct EpiF32 {
    static constexpr bool PERM = false, AFTER_DRAIN = false;
    float* O; int ldc;
    __device__ __forceinline__ void operator()(const f32x4 (&acc)[2][2][4][2], const Unit& u, int wr, int wc, int fr, int fq, const PG8_LAS unsigned char* sd) const {
        const int row0 = u.pm * BM + wr * 64 + fr; const int col0 = u.pn * BM + wc * 32 + 4 * fq;
#pragma unroll
        for (int ai = 0; ai < 2; ++ai)
#pragma unroll
            for (int m = 0; m < 4; ++m) { float* rowp = O + (size_t)(row0 + ai * HALF + m * 16) * ldc + col0;
#pragma unroll
                for (int bj = 0; bj < 2; ++bj)
#pragma unroll
                    for (int n = 0; n < 2; ++n) *(f32x4*)(rowp + bj * HALF + n * 16) = acc[ai][bj][m][n]; }
    }
};
struct EpiBf16Plain {
    static constexpr bool PERM = true, AFTER_DRAIN = false;
    bf16_t* O; int ldc;
    __device__ __forceinline__ void operator()(const f32x4 (&acc)[2][2][4][2], const Unit& u, int wr, int wc, int fr, int fq, const PG8_LAS unsigned char* sd) const {
        const int row0 = u.pm * BM + wr * 64 + fr; const int col0 = u.pn * BM + wc * 32 + 8 * fq;
#pragma unroll
        for (int ai = 0; ai < 2; ++ai)
#pragma unroll
            for (int m = 0; m < 4; ++m) { bf16_t* rowp = O + (size_t)(row0 + ai * HALF + m * 16) * ldc + col0;
#pragma unroll
                for (int bj = 0; bj < 2; ++bj) { const f32x4 v0 = acc[ai][bj][m][0], v1 = acc[ai][bj][m][1];
                    u32x4 w; w.x = cvt_pk_bf16(v0[0], v0[1]); w.y = cvt_pk_bf16(v0[2], v0[3]); w.z = cvt_pk_bf16(v1[0], v1[1]); w.w = cvt_pk_bf16(v1[2], v1[3]);
                    *(u32x4*)(rowp + bj * HALF) = w; } }
    }
};
struct EpiSwiglu {
    static constexpr bool PERM = true, AFTER_DRAIN = false;
    unsigned char* H; const float* bgu; const float* rowgate; const PG8_LAS int* cnt; float dq, hscale;
    __device__ __forceinline__ void operator()(const f32x4 (&acc)[2][2][4][2], const Unit& u, int wr, int wc, int fr, int fq, const PG8_LAS unsigned char* sd) const {
        const int ff = u.pn * HALF + wc * 32 + 8 * fq; const int n_e = cnt[u.e];
        f32x4 bg[2], bu[2];
#pragma unroll
        for (int n = 0; n < 2; ++n) { bg[n] = *(const PG8_LAS f32x4*)(sd + 2048 + (wc * 32 + 8 * fq + 4 * n) * 4); bu[n] = *(const PG8_LAS f32x4*)(sd + 2048 + 512 + (wc * 32 + 8 * fq + 4 * n) * 4); }
        const int lane = fr + 16 * fq;
#pragma unroll
        for (int ai = 0; ai < 2; ++ai)
#pragma unroll
            for (int mp = 0; mp < 2; ++mp) {
                unsigned pw[2][2];
#pragma unroll
                for (int mm = 0; mm < 2; ++mm) { const int m = 2 * mp + mm; const int r = ai * HALF + wr * 64 + m * 16 + fr; const int er = u.r0 + r;
                    const float rgl = ((const PG8_LAS float*)(sd + 1024))[r]; const float rg = ((er < n_e) ? rgl : 0.f) * hscale;
                    float hv[8];
#pragma unroll
                    for (int n = 0; n < 2; ++n)
#pragma unroll
                        for (int q = 0; q < 4; q += 2) {
                            f32x2 g = (f32x2){acc[ai][0][m][n][q], acc[ai][0][m][n][q + 1]} * dq + (f32x2){bg[n][q], bg[n][q + 1]};
                            f32x2 up = (f32x2){acc[ai][1][m][n][q], acc[ai][1][m][n][q + 1]} * dq + (f32x2){bu[n][q], bu[n][q + 1]};
                            g.x = fminf(g.x, 7.0f); g.y = fminf(g.y, 7.0f); up.x = fminf(fmaxf(up.x, -7.0f), 7.0f); up.y = fminf(fmaxf(up.y, -7.0f), 7.0f);
                            const f32x2 ea = g * (-1.702f * 1.4426950408889634f); f32x2 den; den.x = __builtin_amdgcn_exp2f(ea.x); den.y = __builtin_amdgcn_exp2f(ea.y); den = den + 1.0f;
                            f32x2 sg; sg.x = __builtin_amdgcn_rcpf(den.x); sg.y = __builtin_amdgcn_rcpf(den.y);
                            const f32x2 h2 = ((up + 1.0f) * g) * (sg * rg);
                            hv[n * 4 + q] = h2.x; hv[n * 4 + q + 1] = h2.y; }
                    pw[mm][0] = pk4_fp8(hv[0], hv[1], hv[2], hv[3]); pw[mm][1] = pk4_fp8(hv[4], hv[5], hv[6], hv[7]); }
                const auto s0 = __builtin_amdgcn_permlane16_swap(pw[0][0], pw[1][0], false, false); const auto s1 = __builtin_amdgcn_permlane16_swap(pw[0][1], pw[1][1], false, false);
                *(u32x4*)(H + ((size_t)u.pm * 8 + u.pn) * 32768 + ((((ai * 2 + wr) * 4 + wc) * 2 + mp) * 64 + lane) * 16) = (u32x4){s0[0], s1[0], s0[1], s1[1]};
                asm volatile("" ::: "memory"); }
    }
};
struct EpiScatter {
    static constexpr bool PERM = true, AFTER_DRAIN = false;
    unsigned char* Y; const int* rowtok; const PG8_LAS int* cnt; float dq, ysc;
    __device__ __forceinline__ void operator()(const f32x4 (&acc)[2][2][4][2], const Unit& u, int wr, int wc, int fr, int fq, const PG8_LAS unsigned char* sd) const {
        const int col0 = u.pn * BM + wc * 32 + 8 * fq; const int n_e = cnt[u.e];
        f32x4 bd[2][2];
#pragma unroll
        for (int bj = 0; bj < 2; ++bj)
#pragma unroll
            for (int n = 0; n < 2; ++n) bd[bj][n] = *(const PG8_LAS f32x4*)(sd + 2048 + (bj * HALF + wc * 32 + 8 * fq + 4 * n) * 4);
#pragma unroll
        for (int ai = 0; ai < 2; ++ai)
#pragma unroll
            for (int m = 0; m < 4; ++m) { const int er = u.r0 + ai * HALF + wr * 64 + m * 16 + fr;
                const int idx = ((const PG8_LAS int*)sd)[ai * HALF + wr * 64 + m * 16 + fr];
                if (er < n_e) { unsigned char* rowp = Y + (size_t)idx * 1024 + col0;
                    typedef unsigned u32x2 __attribute__((ext_vector_type(2)));
                    const float rg = ((const PG8_LAS float*)(sd + 1024))[ai * HALF + wr * 64 + m * 16 + fr] * ysc;
#pragma unroll
                    for (int bj = 0; bj < 2; ++bj) { const f32x4 v0 = acc[ai][bj][m][0] * dq + bd[bj][0] * rg, v1 = acc[ai][bj][m][1] * dq + bd[bj][1] * rg;
                        *(u32x2*)(rowp + bj * HALF) = (u32x2){pk4_fp8(v0[0], v0[1], v0[2], v0[3]), pk4_fp8(v1[0], v1[1], v1[2], v1[3])}; } }
                asm volatile("" ::: "memory"); }
    }
};

template <class Epi, class Sched, bool ALIGN_EPI, bool GATHER, bool FP8 = false, bool ABLK = false>
__device__ __forceinline__ void gemm_phase(PG8_LAS unsigned char* lds, const Gemm g, const Sched& S, const Epi& E) {
    const int tid = threadIdx.x, wid = __builtin_amdgcn_readfirstlane(tid >> 6), lane = tid & 63, wr = wid >> 2, wc = wid & 3, fr = lane & 15, fq = lane >> 4;
    const int K = g.K, nt = K / BK;
    unsigned voffB[2];
#pragma unroll
    for (int i = 0; i < 2; ++i) { int R, C; stage_rc(tid * 16 + i * 8192, R, C); const int Rb = Epi::PERM ? ((R & ~31) + perm32(R & 31)) : R;
        voffB[i] = (unsigned)(Rb * K + C) * 2u; }
    constexpr int SIDE_BYTES = 8192;
    PG8_LAS unsigned char* const side = lds + STAGE_BYTES;
    const size_t kstep = (size_t)(BK * 2);
    const size_t kstepA = ABLK ? (size_t)32768 : kstep;
    const size_t hstep = (size_t)HALF * K * 2;
    const size_t tstep = 2 * hstep;
    const unsigned ldsw = (unsigned)wid * 1024u;
    const int aoff = lds_byte(wr * 64 + fr, fq * 8), boff = lds_byte(wc * 32 + fr, fq * 8);
#define PG8_SA(b, h) (((b) * 2 + (h)) * HTB)
#define PG8_SB(b, h) ((4 + (b) * 2 + (h)) * HTB)
#define PG8_STAGE(bufoff, gbase, voff) do { _Pragma("unroll") for (int _i = 0; _i < 2; ++_i) \
        __builtin_amdgcn_global_load_lds((const unsigned*)((const char*)(gbase) + (voff)[_i]), (PG8_LAS unsigned*)(lds + (bufoff) + ldsw + _i * 8192), 16, 0, 0); } while (0)
#define PG8_LDA(dst, b, h) do { _Pragma("unroll") for (int m = 0; m < 4; ++m) _Pragma("unroll") for (int k = 0; k < 2; ++k) dst[m][k] = *(const PG8_LAS bf16x8*)(lds + PG8_SA(b, h) + aoff + m * 2048 + k * 1024); } while (0)
#define PG8_LDB(dst, b, h) do { _Pragma("unroll") for (int n = 0; n < 2; ++n) _Pragma("unroll") for (int k = 0; k < 2; ++k) dst[n][k] = *(const PG8_LAS bf16x8*)(lds + PG8_SB(b, h) + boff + n * 2048 + k * 1024); } while (0)
#define PG8_MMA(ai, bj, At, Bt) do { __builtin_amdgcn_s_setprio(1); _Pragma("unroll") for (int m = 0; m < 4; ++m) _Pragma("unroll") for (int n = 0; n < 2; ++n) { \
        if constexpr (FP8) mfma8(acc[ai][bj][m][n], cat8(Bt[n][0], Bt[n][1]), cat8(At[m][0], At[m][1]), scl8); \
        else { _Pragma("unroll") for (int k = 0; k < 2; ++k) acc[ai][bj][m][n] = __builtin_amdgcn_mfma_f32_16x16x32_bf16(Bt[n][k], At[m][k], acc[ai][bj][m][n], 0, 0, 0); } } __builtin_amdgcn_s_setprio(0); } while (0)
#define PG8_WAIT_V(n) asm volatile("s_waitcnt vmcnt(" #n ")" ::: "memory")
#define PG8_WAIT_L(n) asm volatile("s_waitcnt lgkmcnt(" #n ")" ::: "memory")
#define PG8_BAR __builtin_amdgcn_s_barrier()
#define PG8_SCHED __builtin_amdgcn_sched_barrier(0)
#define PG8_SETOFFS(o, u) do { _Pragma("unroll") for (int _h = 0; _h < 2; ++_h) _Pragma("unroll") for (int _i = 0; _i < 2; ++_i) { int _R, _C; stage_rc(tid * 16 + _i * 8192, _R, _C); \
        o[_h][_i] = GATHER ? (S.arow(u, _R + HALF * _h) + (unsigned)(_C * 2)) : ABLK ? hblk_off(_R + HALF * _h, _C >> 3) : ((unsigned)((_R + HALF * _h) * K) * 2u + (unsigned)(_C * 2)); } } while (0)
    int scl8 = 0x7F7F7F7F; asm volatile("" : "+v"(scl8));
    Unit cur, nxt; int ui = 0;
    if (!S.next(0, cur)) return;
    f32x4 acc[2][2][4][2];
#pragma unroll
    for (int a = 0; a < 2; ++a)
#pragma unroll
        for (int b = 0; b < 2; ++b)
#pragma unroll
            for (int m = 0; m < 4; ++m)
#pragma unroll
                for (int n = 0; n < 2; ++n) { acc[a][b][m][n] = (f32x4){0.f, 0.f, 0.f, 0.f}; if constexpr (FP8) asm volatile("" : "+v"(acc[a][b][m][n])); }
    bf16x8 At[4][2], B0[2][2], B1[2][2];
    unsigned cAo[2][2];
    PG8_SETOFFS(cAo, cur);
    const char* cA = S.abase(cur, g, tstep); const char* cB = S.bbase(cur, g, tstep);
    S.a_ready(cur);
    PG8_STAGE(PG8_SB(0, 0), cB, voffB); PG8_STAGE(PG8_SB(0, 1), cB + hstep, voffB); PG8_STAGE(PG8_SA(0, 0), cA, cAo[0]); PG8_STAGE(PG8_SA(0, 1), cA, cAo[1]);
    if (wr == 1) PG8_BAR;
    PG8_WAIT_V(2); PG8_BAR;
    PG8_STAGE(PG8_SB(1, 0), cB + kstep, voffB); PG8_STAGE(PG8_SA(1, 0), cA + kstepA, cAo[0]); PG8_STAGE(PG8_SB(1, 1), cB + hstep + kstep, voffB);
    PG8_WAIT_V(6); PG8_BAR;
    for (;;) {
        const bool has_next = S.next(ui + 1, nxt);
        const char* nA = has_next ? S.abase(nxt, g, tstep) : cA; const char* nB = has_next ? S.bbase(nxt, g, tstep) : cB;
        if constexpr (Sched::SIDE) {
            const void* ssrc = S.side_src(cur, (GATHER && has_next) ? nxt : cur, wid, lane);
            __builtin_amdgcn_global_load_lds((const unsigned*)ssrc, (PG8_LAS unsigned*)(side + (ui & 1) * SIDE_BYTES + wid * 1024), 16, 0, 0); }
#pragma unroll 1
        for (int t = 0; t < nt; t += 2) {
            const bool last = (t == nt - 2);
            const char* a1 = cA + (size_t)(t + 1) * kstepA;
            const char* a2 = last ? nA : cA + (size_t)(t + 2) * kstepA; const char* b2 = last ? nB : cB + (size_t)(t + 2) * kstep;
            const char* a3 = a2 + kstepA; const char* b3 = b2 + kstep;
            if (last && has_next) S.a_ready(nxt);
            PG8_LDB(B0, 0, 0); PG8_LDB(B1, 0, 1); PG8_SCHED; PG8_LDA(At, 0, 0); PG8_STAGE(PG8_SA(1, 1), a1, cAo[1]);
            if constexpr (GATHER) { if (last && has_next) {
                const PG8_LAS unsigned char* sdn = side + (ui & 1) * SIDE_BYTES;
#pragma unroll
                for (int _h = 0; _h < 2; ++_h)
#pragma unroll
                    for (int _i = 0; _i < 2; ++_i) { int _R, _C; stage_rc(tid * 16 + _i * 8192, _R, _C); cAo[_h][_i] = S.arow_side(nxt, _R + HALF * _h, sdn) + (unsigned)(_C * 2); } } }
            PG8_WAIT_V(8); PG8_WAIT_L(0); PG8_BAR; PG8_MMA(0, 0, At, B0); PG8_MMA(0, 1, At, B1); PG8_BAR; PG8_SCHED;
            PG8_LDA(At, 0, 1); PG8_STAGE(PG8_SB(0, 0), b2, voffB); PG8_STAGE(PG8_SB(0, 1), b2 + hstep, voffB); PG8_STAGE(PG8_SA(0, 0), a2, cAo[0]);
            PG8_WAIT_V(8); PG8_WAIT_L(0); PG8_BAR; PG8_MMA(1, 0, At, B0); PG8_MMA(1, 1, At, B1); PG8_BAR; PG8_SCHED;
            PG8_LDB(B0, 1, 0); PG8_LDB(B1, 1, 1); PG8_SCHED; PG8_LDA(At, 1, 0); PG8_STAGE(PG8_SA(0, 1), a2, cAo[1]);
            PG8_WAIT_V(8); PG8_WAIT_L(0); PG8_BAR; PG8_MMA(0, 0, At, B0); PG8_MMA(0, 1, At, B1); PG8_BAR; PG8_SCHED;
            PG8_LDA(At, 1, 1); PG8_STAGE(PG8_SB(1, 0), b3, voffB); PG8_STAGE(PG8_SB(1, 1), b3 + hstep, voffB); PG8_STAGE(PG8_SA(1, 0), a3, cAo[0]);
            PG8_WAIT_V(8); PG8_WAIT_L(0); PG8_BAR; PG8_MMA(1, 0, At, B0); PG8_MMA(1, 1, At, B1); PG8_BAR; PG8_SCHED;
        }
        if constexpr (ALIGN_EPI) { if (wr == 0) PG8_BAR; }
        if constexpr (FP8) asm volatile("s_nop 15\n\ts_nop 15" ::: "memory");
        PG8_SCHED; E(acc, cur, wr, wc, fr, fq, side + (ui & 1) * SIDE_BYTES); S.done(cur); PG8_SCHED;
        if (!has_next) break;
#pragma unroll
        for (int a = 0; a < 2; ++a)
#pragma unroll
            for (int b = 0; b < 2; ++b)
#pragma unroll
                for (int m = 0; m < 4; ++m)
#pragma unroll
                    for (int n = 0; n < 2; ++n) { acc[a][b][m][n] = (f32x4){0.f, 0.f, 0.f, 0.f}; if constexpr (FP8) asm volatile("" : "+v"(acc[a][b][m][n])); }
        cur = nxt; cA = nA; cB = nB; ++ui;
        if constexpr (ALIGN_EPI) { if (wr == 1) PG8_BAR; }
    }
    PG8_WAIT_V(0);
    if constexpr (!ALIGN_EPI) { if (wr == 0) PG8_BAR; }
    PG8_BAR;
#undef PG8_SA
#undef PG8_SB
#undef PG8_STAGE
#undef PG8_LDA
#undef PG8_LDB
#undef PG8_MMA
#undef PG8_WAIT_V
#undef PG8_WAIT_L
#undef PG8_BAR
#undef PG8_SCHED
#undef PG8_SETOFFS
}
}

constexpr int NB = 8, SEQ = 4096, DM = 1024, MROWS = NB * SEQ, NLAYER = 2;
constexpr int NPROJ = 4608, INW = 4616;
constexpr int C_Q = 0, C_K = 512, C_V = 1024, C_Z = 1536, C_XS = 2048, C_SB = 3072, C_SC = 3584, C_SH = 4096;
constexpr int MIXW = 1536, NEXP = 32, TOPK = 4, FF = 1024;
constexpr float ALPHA = 1.4142135623730951f;
constexpr float LN_EPS = 1e-5f, RMS_EPS = 1e-5f;
constexpr float QSCALE = 0.125f * 1.4426950408889634f;

constexpr size_t MiB = 1u << 20;
constexpr size_t WS_CTL = 0, CTL_ZERO_BYTES = 1 * MiB;
constexpr size_t WS_ROPE = 1 * MiB;
constexpr size_t WS_WDT = 2 * MiB;
constexpr size_t WS_ROUT = 2 * MiB + 65536;
constexpr size_t WS_WIN = 4 * MiB;
constexpr size_t WS_WOUT = 24 * MiB;
constexpr size_t WS_WGU = 32 * MiB;
constexpr size_t WS_WDN = 288 * MiB;
constexpr size_t WS_XB = 416 * MiB;
constexpr size_t WS_XF = 480 * MiB;
constexpr size_t WS_XF2 = 608 * MiB;
constexpr size_t WS_PROJ = 736 * MiB;
constexpr size_t WS_DT = 1024 * MiB;
constexpr size_t WS_DTS = 1025 * MiB;
constexpr size_t WS_ACUM = 1026 * MiB;
constexpr size_t WS_LSE = 1027 * MiB;
constexpr size_t WS_OP = 1030 * MiB;
constexpr size_t WS_U = 1126 * MiB;
constexpr size_t WS_G = 1190 * MiB;
constexpr size_t WS_ST = 1222 * MiB;
constexpr size_t WS_YD = 1286 * MiB;
constexpr size_t WS_MIXED = 1350 * MiB;
constexpr size_t WS_MIXF = 1446 * MiB;
constexpr size_t WS_TOPE = 1574 * MiB;
constexpr size_t WS_TOPG = 1575 * MiB;
constexpr size_t WS_ROWTOK = 1576 * MiB;
constexpr size_t WS_ROWGATE = 1580 * MiB;
constexpr size_t WS_H = 736 * MiB;
constexpr size_t WS_YB = 1030 * MiB;
constexpr size_t WS_END = 1584 * MiB;
constexpr int CW_TMO = 0;
constexpr int CW_CNT = 64;
constexpr int CW_BAR = 4096;

constexpr int RING_OFF = 0, RING_BYTES = 131072;
constexpr int LDSCTL_OFF = 155648;
constexpr int L_MISC = LDSCTL_OFF;
constexpr int L_TSTART = LDSCTL_OFF + 256;
constexpr int L_CNT = LDSCTL_OFF + 512;
constexpr int L_LCNT = LDSCTL_OFF + 640;
constexpr int L_LBASE = LDSCTL_OFF + 768;
constexpr int L_UNITS = LDSCTL_OFF + 1024;
constexpr int L_UNITSN = LDSCTL_OFF + 2048;
constexpr int LDS_BYTES = 163840;

#define GAS __attribute__((address_space(1)))
#define LAS __attribute__((address_space(3)))
typedef unsigned short bf16;
typedef unsigned v4u __attribute__((ext_vector_type(4)));
typedef unsigned v2u __attribute__((ext_vector_type(2)));
typedef float f32x4 __attribute__((ext_vector_type(4)));
typedef float f32x16 __attribute__((ext_vector_type(16)));
typedef short bf16x8 __attribute__((ext_vector_type(8)));
typedef GAS unsigned gu32;
#define RLX_AGENT __ATOMIC_RELAXED, __HIP_MEMORY_SCOPE_AGENT
#define LDS_WAIT() asm volatile("s_waitcnt lgkmcnt(0)" ::: "memory")
#define VM_WAIT() asm volatile("s_waitcnt vmcnt(0)" ::: "memory")
__device__ __forceinline__ unsigned f2bf(float f) { unsigned u = __builtin_bit_cast(unsigned, f); return (u + 0x7fffu + ((u >> 16) & 1u)) >> 16; }
__device__ __forceinline__ unsigned pk2(float lo, float hi) { unsigned r; asm volatile("v_cvt_pk_bf16_f32 %0, %1, %2" : "=v"(r) : "v"(lo), "v"(hi)); return r; }
__device__ __forceinline__ float bf2f(unsigned short b) { return __builtin_bit_cast(float, (unsigned)b << 16); }
__device__ __forceinline__ float bflo(unsigned w) { return __builtin_bit_cast(float, w << 16); }
__device__ __forceinline__ float bfhi(unsigned w) { return __builtin_bit_cast(float, w & 0xffff0000u); }
__device__ __forceinline__ float siluf(float x) { return x * __builtin_amdgcn_rcpf(1.0f + __builtin_amdgcn_exp2f(-1.4426950408889634f * x)); }
#define XB_TMO      128
#define XB_XCNT(j)  (256  + 64 * (j))
#define XB_XSUB(j)  (1280 + 64 * (j))
#define XB_XGEN(j)  (2304 + 64 * (j))
#define XB_TOP      3328
#define XB_TOPGEN   3392
#define XCD_BAR_WORDS 3456
#define XB_SPIN_CAP (1u << 18)

__device__ __forceinline__ unsigned xb_ld(unsigned* p)              { return __hip_atomic_load(p, __ATOMIC_RELAXED, __HIP_MEMORY_SCOPE_AGENT); }
__device__ __forceinline__ unsigned xb_add(unsigned* p, unsigned v) { return __hip_atomic_fetch_add(p, v, __ATOMIC_RELAXED, __HIP_MEMORY_SCOPE_AGENT); }
__device__ __forceinline__ unsigned xb_xcc_id() { return (unsigned)__builtin_amdgcn_s_getreg((3 << 11) | 20) & 0xFu; }
#define XB_SPIN(cond, bar) do { unsigned _sp = 0; while (cond) { __builtin_amdgcn_s_sleep(1); \
    if ((++_sp & 255u) == 0u) { if (xb_ld(&(bar)[XB_TMO])) break; if (_sp > XB_SPIN_CAP) { atomicAdd(&(bar)[XB_TMO], 1u); break; } } } } while (0)

struct XcdBarrier {
    unsigned* bar; unsigned x;
    volatile LAS unsigned* st;
};

__device__ __forceinline__ XcdBarrier xcd_barrier_post(unsigned* bar, volatile LAS unsigned* st) {
    XcdBarrier b; b.bar = bar; b.x = xb_xcc_id(); b.st = st;
    if (threadIdx.x == 0) (void)xb_add(&bar[XB_XCNT(b.x)], 1u);
    return b;
}
__device__ __forceinline__ void xcd_barrier_complete(unsigned* bar, unsigned x, unsigned& nloc, unsigned& nx) {
    const unsigned G = gridDim.x * gridDim.y * gridDim.z;
    unsigned sum, cnt, mine, sp = 0u;
    for (;;) {
        sum = 0u; cnt = 0u; mine = 0u;
#pragma unroll
        for (unsigned j = 0; j < 16; ++j) { const unsigned c = xb_ld(&bar[XB_XCNT(j)]); sum += c; cnt += (c > 0u) ? 1u : 0u; mine = (j == x) ? c : mine; }
        if (sum == G) break;
        __builtin_amdgcn_s_sleep(1);
        if ((++sp & 255u) == 0u) { if (xb_ld(&bar[XB_TMO])) break; if (sp > XB_SPIN_CAP) { atomicAdd(&bar[XB_TMO], 1u); break; } }
    }
    nloc = mine > 0u ? mine : 1u; nx = cnt > 0u ? cnt : 1u;
}

__device__ __forceinline__ void xcd_barrier(const XcdBarrier& b) {
    asm volatile("s_waitcnt vmcnt(0)" ::: "memory");
    __syncthreads();
    if (threadIdx.x == 0) {
        unsigned* bar = b.bar;
        __builtin_amdgcn_s_waitcnt(0);
        unsigned nloc = b.st[0], nx = b.st[1];
        if (nloc == 0u) { xcd_barrier_complete(bar, b.x, nloc, nx); b.st[0] = nloc; b.st[1] = nx; }
        const unsigned old = xb_add(&bar[XB_XSUB(b.x)], 1u);
        const unsigned gen = old / nloc;
        if (old + 1u == (gen + 1u) * nloc) {
            __builtin_amdgcn_fence(__ATOMIC_RELEASE, "agent");
            asm volatile("s_waitcnt vmcnt(0)" ::: "memory");
            const unsigned og = xb_add(&bar[XB_TOP], 1u);
            const unsigned tg = og / nx;
            if (og + 1u == (tg + 1u) * nx) xb_add(&bar[XB_TOPGEN], 1u);
            else XB_SPIN(xb_ld(&bar[XB_TOPGEN]) == tg, bar);
            __builtin_amdgcn_fence(__ATOMIC_ACQUIRE, "agent");
            xb_add(&bar[XB_XGEN(b.x)], 1u);
            asm volatile("s_waitcnt vmcnt(0)" ::: "memory");
        } else {
            XB_SPIN(xb_ld(&bar[XB_XGEN(b.x)]) == gen, bar);
            __builtin_amdgcn_fence(__ATOMIC_ACQUIRE, "agent");
            asm volatile("s_waitcnt vmcnt(0)" ::: "memory");
        }
    }
    __syncthreads();
}

constexpr float SC_X = 4.f, SC_WGU = 32.f, SC_H = 4.f, SC_WDN = 64.f, SC_Y = 16.f, SC_WIN = 32.f;
__device__ __forceinline__ float wave_sum(float v) {
#pragma unroll
    for (int o = 1; o < 64; o <<= 1) v += __shfl_xor(v, o);
    return v;
}
__device__ __forceinline__ int win_dest_row(int n) {
    if (n < 1024) { const int hh = n >> 6, d = n & 63; const int p = (d < 32) ? (8 * (d >> 2) + (d & 3)) : (8 * ((d - 32) >> 2) + 4 + (d & 3)); return hh * 64 + p; }
    if (n < 3072) return n;
    if (n < 3080) return -1;
    return n - 8;
}
__device__ __forceinline__ int wgu_dest_row(int n) { return n < 1024 ? ((n >> 7) * 256 + (n & 127)) : (((n - 1024) >> 7) * 256 + 128 + ((n - 1024) & 127)); }
template <int MAP>
__device__ __forceinline__ void p0_transpose_item(const float* W, int K, int N, bf16* WT, float* wdt, LAS float* scr, int kb, int nb, int lane) {
    const int k0 = 64 * kb, n0 = 32 * nb;
    const int nn = n0 + (lane & 31); const bool nok = nn < N;
#pragma unroll 8
    for (int i = 0; i < 32; ++i) { const int kk = 2 * i + (lane >> 5); scr[kk * 33 + (lane & 31)] = nok ? W[(size_t)(k0 + kk) * N + nn] : 0.f; }
    LDS_WAIT(); asm volatile("" ::: "memory");
    const int c = lane & 7;
#pragma unroll
    for (int j = 0; j < 4; ++j) { const int n = (lane >> 3) + 8 * j; const LAS float* s = scr + (8 * c) * 33 + n;
        const int nsrc = n0 + n; if (nsrc >= N) continue;
        int drow = nsrc; if (MAP == 1) drow = win_dest_row(nsrc); if (MAP == 2) drow = wgu_dest_row(nsrc);
        if (MAP == 1 && drow < 0) { float* d = wdt + (size_t)(nsrc - 3072) * 1024 + k0 + 8 * c;
#pragma unroll
            for (int q = 0; q < 8; ++q) d[q] = s[q * 33]; continue; }
        v4u o; o.x = pk2(s[0 * 33], s[1 * 33]); o.y = pk2(s[2 * 33], s[3 * 33]); o.z = pk2(s[4 * 33], s[5 * 33]); o.w = pk2(s[6 * 33], s[7 * 33]);
        *(GAS v4u*)(WT + (size_t)drow * K + k0 + 8 * c) = o; }
    LDS_WAIT(); asm volatile("" ::: "memory");
}
template <int MAP>
__device__ __forceinline__ void p0_transpose_item64(const float* W, int K, int N, bf16* WT, float* wdt, LAS float* scr, int kb, int nb, int lane) {
    const int k0 = 64 * kb, n0 = 64 * nb;
    const bool lok = (n0 + 4 * (lane & 15) + 3) < N;
    f32x4 ld[16];
#pragma unroll
    for (int i = 0; i < 16; ++i) ld[i] = lok ? *(const f32x4*)(W + (size_t)(k0 + 4 * i + (lane >> 4)) * N + n0 + 4 * (lane & 15)) : (f32x4){0.f, 0.f, 0.f, 0.f};
#pragma unroll
    for (int i = 0; i < 16; ++i) *(LAS f32x4*)(scr + (4 * i + (lane >> 4)) * 64 + 4 * (lane & 15)) = ld[i];
    LDS_WAIT(); asm volatile("" ::: "memory");
    const int nsrc = n0 + lane;
    if (nsrc < N) {
        int drow = nsrc; if (MAP == 1) drow = win_dest_row(nsrc);
        if (MAP == 1 && drow < 0) { float* d = wdt + (size_t)(nsrc - 3072) * 1024 + k0;
#pragma unroll
            for (int q = 0; q < 16; ++q) *(f32x4*)(d + 4 * q) = (f32x4){scr[(4 * q) * 64 + lane], scr[(4 * q + 1) * 64 + lane], scr[(4 * q + 2) * 64 + lane], scr[(4 * q + 3) * 64 + lane]}; }
        else { GAS v4u* d = (GAS v4u*)(WT + (size_t)drow * K + k0);
#pragma unroll
            for (int q = 0; q < 8; ++q) { v4u o; o.x = pk2(scr[(8 * q) * 64 + lane], scr[(8 * q + 1) * 64 + lane]); o.y = pk2(scr[(8 * q + 2) * 64 + lane], scr[(8 * q + 3) * 64 + lane]);
                o.z = pk2(scr[(8 * q + 4) * 64 + lane], scr[(8 * q + 5) * 64 + lane]); o.w = pk2(scr[(8 * q + 6) * 64 + lane], scr[(8 * q + 7) * 64 + lane]); d[q] = o; } } }
    LDS_WAIT(); asm volatile("" ::: "memory");
}
struct SubT { const float* src; unsigned char* dst; int N; int n0; int mode; float scale; };
__device__ __forceinline__ SubT fp8_subtile(int item, int half, const float* wgu, const float* wdn, const float* win, unsigned char* WG8, unsigned char* WD8, unsigned char* WI8, int lane) {
    SubT t; int kb, nb;
    if (item < 64 * 256) { const int le = item >> 8, r = item & 255; kb = r >> 5; nb = r & 31; t.N = 2048; t.mode = 1; t.scale = SC_WGU;
        t.src = wgu + (size_t)le * 1024 * 2048; t.dst = WG8 + (size_t)le * 2048 * 1024; }
    else if (item < 64 * 256 + 64 * 128) { const int it2 = item - 64 * 256; const int le = it2 >> 7, r = it2 & 127; kb = r >> 4; nb = r & 15; t.N = 1024; t.mode = 0; t.scale = SC_WDN;
        t.src = wdn + (size_t)le * 1024 * 1024; t.dst = WD8 + (size_t)le * 1024 * 1024; }
    else { const int it3 = item - (64 * 256 + 64 * 128); const int l = it3 / 192, r = it3 % 192; kb = r / 24; nb = r % 24; t.N = INW; t.mode = 2; t.scale = SC_WIN;
        t.src = win + (size_t)l * 1024 * INW; t.dst = WI8 + (size_t)l * 1536 * 1024; }
    const int k0 = 128 * kb + 64 * half; t.n0 = 64 * nb;
    t.src += (size_t)(k0 + (lane >> 4)) * t.N + t.n0 + 4 * (lane & 15);
    t.dst += (size_t)k0;
    return t;
}
__device__ __forceinline__ void fp8_sub_load(const SubT& t, f32x4 (&ld)[16]) {
#pragma unroll
    for (int i = 0; i < 16; ++i) ld[i] = __builtin_nontemporal_load((const f32x4*)(t.src + (size_t)(4 * i) * t.N));
}
__device__ __forceinline__ void fp8_sub_process(const SubT& t, const f32x4 (&ld)[16], LAS float* scr, int lane) {
#pragma unroll
    for (int i = 0; i < 16; ++i) *(LAS f32x4*)(scr + (4 * i + (lane >> 4)) * 64 + 4 * (lane & 15)) = ld[i];
    LDS_WAIT(); asm volatile("" ::: "memory");
    unsigned w[16];
#pragma unroll
    for (int q = 0; q < 16; ++q) w[q] = pg8::pk4_fp8(scr[(4 * q + 0) * 64 + lane] * t.scale, scr[(4 * q + 1) * 64 + lane] * t.scale, scr[(4 * q + 2) * 64 + lane] * t.scale, scr[(4 * q + 3) * 64 + lane] * t.scale);
    LDS_WAIT(); asm volatile("" ::: "memory");
    LAS unsigned char* t2 = (LAS unsigned char*)scr;
#pragma unroll
    for (int q = 0; q < 4; ++q) *(LAS v4u*)(t2 + lane * 80 + 16 * q) = (v4u){w[4 * q], w[4 * q + 1], w[4 * q + 2], w[4 * q + 3]};
    LDS_WAIT(); asm volatile("" ::: "memory");
#pragma unroll
    for (int q = 0; q < 4; ++q) { const int n = 16 * q + (lane >> 2); const v4u v = *(const LAS v4u*)(t2 + n * 80 + 16 * (lane & 3));
        const int nn = (t.mode == 1) ? wgu_dest_row(t.n0 + n) : (t.mode == 2) ? win_dest_row(t.n0 + n) : (t.n0 + n);
        *(GAS v4u*)(t.dst + (size_t)nn * 1024 + 16 * (lane & 3)) = v; }
    LDS_WAIT(); asm volatile("" ::: "memory");
}
__device__ __forceinline__ void row_dt(const f32x4 (&v)[4], const float* wdt, float* dst, int lane) {
    float r[8];
#pragma unroll
    for (int jj = 0; jj < 8; ++jj) { float s = 0.f;
#pragma unroll
        for (int j = 0; j < 4; ++j) { const f32x4 w = *(const f32x4*)(wdt + jj * 1024 + 4 * lane + 256 * j); s += v[j][0] * w[0] + v[j][1] * w[1] + v[j][2] * w[2] + v[j][3] * w[3]; }
        r[jj] = wave_sum(s); }
    if (lane == 0) { *(f32x4*)dst = (f32x4){r[0], r[1], r[2], r[3]}; *(f32x4*)(dst + 4) = (f32x4){r[4], r[5], r[6], r[7]}; }
}
__device__ __forceinline__ void row_dt_win(const f32x4 (&v)[4], const float* win, float* dst, int lane) {
    float r[8];
#pragma unroll
    for (int jj = 0; jj < 8; ++jj) r[jj] = 0.f;
#pragma unroll
    for (int j = 0; j < 4; ++j)
#pragma unroll
        for (int e = 0; e < 4; ++e) { const float* wp = win + (size_t)(4 * lane + 256 * j + e) * INW + 3072; const f32x4 w0 = *(const f32x4*)wp, w1 = *(const f32x4*)(wp + 4); const float x = v[j][e];
            r[0] += x * w0[0]; r[1] += x * w0[1]; r[2] += x * w0[2]; r[3] += x * w0[3]; r[4] += x * w1[0]; r[5] += x * w1[1]; r[6] += x * w1[2]; r[7] += x * w1[3]; }
#pragma unroll
    for (int jj = 0; jj < 8; ++jj) r[jj] = wave_sum(r[jj]);
    if (lane == 0) { *(f32x4*)dst = (f32x4){r[0], r[1], r[2], r[3]}; *(f32x4*)(dst + 4) = (f32x4){r[4], r[5], r[6], r[7]}; }
}
template <bool W8, bool WF>
__device__ __forceinline__ void ln_row(f32x4 (&v)[4], const float* gam, const float* bet, float* of32, bf16* ob16, unsigned char* o8, float s8, int lane) {
    float s = 0.f;
#pragma unroll
    for (int j = 0; j < 4; ++j) s += (v[j][0] + v[j][1]) + (v[j][2] + v[j][3]);
    const float mean = wave_sum(s) * (1.f / DM); float s2 = 0.f;
#pragma unroll
    for (int j = 0; j < 4; ++j) { v[j] = v[j] - mean; s2 += (v[j][0] * v[j][0] + v[j][1] * v[j][1]) + (v[j][2] * v[j][2] + v[j][3] * v[j][3]); }
    const float rstd = 1.f / sqrtf(wave_sum(s2) * (1.f / DM) + LN_EPS);
#pragma unroll
    for (int j = 0; j < 4; ++j) { const f32x4 g = *(const f32x4*)(gam + 4 * lane + 256 * j), b = *(const f32x4*)(bet + 4 * lane + 256 * j);
        v[j] = v[j] * rstd * g + b;
        if (WF) *(f32x4*)(of32 + 4 * lane + 256 * j) = v[j];
        v2u w; w.x = pk2(v[j][0], v[j][1]); w.y = pk2(v[j][2], v[j][3]); *(v2u*)(ob16 + 4 * lane + 256 * j) = w;
        if (W8) *(unsigned*)(o8 + 4 * lane + 256 * j) = pg8::pk4_fp8(v[j][0] * s8, v[j][1] * s8, v[j][2] * s8, v[j][3] * s8); }
}


typedef short v4i16_t __attribute__((ext_vector_type(4)));
__device__ __forceinline__ bf16x8 tr_pair(const LAS unsigned char* p0, const LAS unsigned char* p1) {
    const v4i16_t a = __builtin_amdgcn_ds_read_tr16_b64_v4i16((LAS v4i16_t*)p0), b = __builtin_amdgcn_ds_read_tr16_b64_v4i16((LAS v4i16_t*)p1);
    return (bf16x8){a[0], a[1], a[2], a[3], b[0], b[1], b[2], b[3]};
}
__device__ __forceinline__ int crow16(int r, int hi) { return (r & 3) + 8 * (r >> 2) + 4 * hi; }
constexpr int AK_PITCH = 144, AV_PITCH = 192, AK_TILE = 32 * AK_PITCH, AV_TILE = 32 * AV_PITCH;
constexpr int AT_K = 0, AT_V = 12 * AK_TILE;
struct AttnItem { int p, b, h, d, r, qt0; };
__device__ __forceinline__ AttnItem attn_item(int I) { AttnItem a; a.p = I >> 10; const int rem = I & 1023; a.b = rem >> 7; a.h = (rem >> 4) & 7; const int grp = rem & 15;
    a.d = (a.p == 0) ? 1 : (a.p == 1) ? 4 : 16; const int tpr = 128 / a.d; const int T = grp * 8; a.r = T / tpr; a.qt0 = T % tpr; return a; }
__device__ __forceinline__ void attn_request(const bf16* PROJ, const AttnItem& a, v4u (&st)[12], int tid) {
    const int rr = tid >> 4, ch = tid & 15; const int col = (ch < 8 ? C_K : C_V - 64) + a.h * 64 + ch * 8;
#pragma unroll
    for (int tl = 0; tl < 12; ++tl) { const int kt = a.qt0 - 4 + tl; st[tl] = (v4u){0u, 0u, 0u, 0u};
        if (kt >= 0) { const size_t row = (size_t)a.b * SEQ + (size_t)(32 * kt + rr) * a.d + a.r; st[tl] = *(const v4u*)(PROJ + row * NPROJ + col); } }
}
__device__ __forceinline__ void attn_deposit(LAS unsigned char* al, const v4u (&st)[12], int tid) {
    const int rr = tid >> 4, ch = tid & 15;
    LAS unsigned char* dst = (ch < 8) ? (al + AT_K + rr * AK_PITCH + ch * 16) : (al + AT_V + rr * AV_PITCH + (ch - 8) * 16); const int tstep = (ch < 8) ? AK_TILE : AV_TILE;
#pragma unroll
    for (int tl = 0; tl < 12; ++tl) *(LAS v4u*)(dst + tl * tstep) = st[tl];
}
__device__ __forceinline__ void attn_wave_compute(const bf16* PROJ, bf16* OPp, float* LSEp, const AttnItem& a, const LAS unsigned char* al, int wave, int lane) {
    const int i = lane & 31, h2 = lane >> 5; const int qt = a.qt0 + wave;
    const size_t rowq = (size_t)a.b * SEQ + (size_t)(32 * qt + i) * a.d + a.r;
    bf16x8 qf[4];
    { const bf16* qp = PROJ + rowq * NPROJ + C_Q + a.h * 64 + 8 * h2;
#pragma unroll
      for (int s = 0; s < 4; ++s) qf[s] = *(const bf16x8*)(qp + 16 * s); }
    f32x16 o0 = {}, o1 = {}; float mrun = -INFINITY, lrun = 0.f;
    const int kt0 = qt > 4 ? qt - 4 : 0;
    const LAS unsigned char* krd = al + AT_K + i * AK_PITCH + 16 * h2;
    const LAS unsigned char* trb = al + AT_V + (4 * h2 + ((lane & 15) >> 2)) * AV_PITCH + (16 * ((lane >> 4) & 1) + 4 * (lane & 3)) * 2;
#pragma unroll 1
    for (int kt = kt0; kt <= qt; ++kt) {
        const int tl = kt - a.qt0 + 4;
        const LAS unsigned char* kp = krd + tl * AK_TILE; const LAS unsigned char* vp = trb + tl * AV_TILE;
        f32x16 sacc = {};
#pragma unroll
        for (int s = 0; s < 4; ++s) sacc = __builtin_amdgcn_mfma_f32_32x32x16_bf16(*(const LAS bf16x8*)(kp + 32 * s), qf[s], sacc, 0, 0, 0);
        if (kt == qt) {
#pragma unroll
            for (int rg = 0; rg < 16; ++rg) if (crow16(rg, h2) > i) sacc[rg] = -INFINITY;
        }
        if (kt + 4 == qt) {
#pragma unroll
            for (int rg = 0; rg < 16; ++rg) if (crow16(rg, h2) < i) sacc[rg] = -INFINITY;
        }
        float mx = sacc[0];
#pragma unroll
        for (int rg = 1; rg < 16; ++rg) mx = fmaxf(mx, sacc[rg]);
        mx = fmaxf(mx, __shfl_xor(mx, 32));
        const float mnew = fmaxf(mrun, mx), alpha = __builtin_amdgcn_exp2f(mrun - mnew); mrun = mnew;
        float ps = 0.f;
#pragma unroll
        for (int rg = 0; rg < 16; ++rg) { sacc[rg] = __builtin_amdgcn_exp2f(sacc[rg] - mnew); ps += sacc[rg]; }
        lrun = lrun * alpha + ps;
#pragma unroll
        for (int rg = 0; rg < 16; ++rg) { o0[rg] *= alpha; o1[rg] *= alpha; }
        bf16x8 pf[2];
#pragma unroll
        for (int ks = 0; ks < 2; ++ks) { v4u w; w.x = pg8::cvt_pk_bf16(sacc[8 * ks + 0], sacc[8 * ks + 1]); w.y = pg8::cvt_pk_bf16(sacc[8 * ks + 2], sacc[8 * ks + 3]); w.z = pg8::cvt_pk_bf16(sacc[8 * ks + 4], sacc[8 * ks + 5]); w.w = pg8::cvt_pk_bf16(sacc[8 * ks + 6], sacc[8 * ks + 7]); pf[ks] = __builtin_bit_cast(bf16x8, w); }
#pragma unroll
        for (int ks = 0; ks < 2; ++ks) {
            const bf16x8 v0 = tr_pair(vp + (16 * ks) * AV_PITCH, vp + (16 * ks + 8) * AV_PITCH);
            const bf16x8 v1 = tr_pair(vp + (16 * ks) * AV_PITCH + 64, vp + (16 * ks + 8) * AV_PITCH + 64);
            o0 = __builtin_amdgcn_mfma_f32_32x32x16_bf16(v0, pf[ks], o0, 0, 0, 0);
            o1 = __builtin_amdgcn_mfma_f32_32x32x16_bf16(v1, pf[ks], o1, 0, 0, 0);
        }
    }
    const float lt = lrun + __shfl_xor(lrun, 32); const float il = 1.0f / lt;
    bf16* op = OPp + rowq * 512 + a.h * 64 + 4 * h2;
#pragma unroll
    for (int g4 = 0; g4 < 4; ++g4) {
        v2u w0, w1; w0.x = pg8::cvt_pk_bf16(o0[4 * g4 + 0] * il, o0[4 * g4 + 1] * il); w0.y = pg8::cvt_pk_bf16(o0[4 * g4 + 2] * il, o0[4 * g4 + 3] * il);
        w1.x = pg8::cvt_pk_bf16(o1[4 * g4 + 0] * il, o1[4 * g4 + 1] * il); w1.y = pg8::cvt_pk_bf16(o1[4 * g4 + 2] * il, o1[4 * g4 + 3] * il);
        *(v2u*)(op + 8 * g4) = w0; *(v2u*)(op + 32 + 8 * g4) = w1; }
    if (h2 == 0) LSEp[rowq * 8 + a.h] = mrun + log2f(lt);
}
__device__ __forceinline__ void attn_phase(LAS unsigned char* al, const bf16* PROJ, bf16* OP, float* LSE, int bid, int G, int tid, int wave, int lane) {
    v4u st[12];
    int I = bid;
    if (I < 3072) { const AttnItem a = attn_item(I); attn_request(PROJ, a, st, tid); }
    for (; I < 3072; I += G) {
        const AttnItem a = attn_item(I);
        __syncthreads();
        attn_deposit(al, st, tid);
        __syncthreads();
        if (I + G < 3072) { const AttnItem n = attn_item(I + G); attn_request(PROJ, n, st, tid); }
        attn_wave_compute(PROJ, OP + (size_t)a.p * MROWS * 512, LSE + (size_t)a.p * MROWS * 8, a, al, wave, lane);
    }
    __syncthreads();
}

constexpr int SS_DTS = 0, SS_ACUM = 2048, SS_TMP = 4096, SS_SSX = 6144, SS_IMG = 8192;
constexpr int S1_PB = 320, S1_PX = 576;
constexpr int S1_B = SS_IMG, S1_X = SS_IMG + 128 * S1_PB;
constexpr int S3_PBC = 272, S3_PX = 576;
constexpr int S3_B = SS_IMG, S3_C = S3_B + 128 * S3_PBC, S3_X = S3_C + 128 * S3_PBC;

__device__ __forceinline__ void ssd_prep(LAS unsigned char* sl, const float* DT, const float* dtb, const float* alog, size_t row0, int g, int tid, int lane, int wave) {
    LAS float* dts = (LAS float*)(sl + SS_DTS); LAS float* acum = (LAS float*)(sl + SS_ACUM); LAS float* tmp = (LAS float*)(sl + SS_TMP);
    { const int l = tid >> 2, hq = tid & 3; const float x = DT[(row0 + l) * 8 + 4 * g + hq] + dtb[4 * g + hq];
      const float dt = x > 20.f ? x : log1pf(__expf(x)); dts[hq * 128 + l] = dt; tmp[hq * 128 + l] = dt * (-__expf(alog[4 * g + hq])); }
    __syncthreads();
    if (wave < 4) { const float v0 = tmp[wave * 128 + 2 * lane], v1 = tmp[wave * 128 + 2 * lane + 1]; float s = v0 + v1;
#pragma unroll
        for (int off = 1; off < 64; off <<= 1) { const float t = __shfl_up(s, off); if (lane >= off) s += t; }
        acum[wave * 128 + 2 * lane] = s - v1; acum[wave * 128 + 2 * lane + 1] = s; }
    __syncthreads();
}
template <int NCOLS, int FACMODE>
__device__ __forceinline__ void conv_tile(const bf16* PROJ, size_t row0, int t0, int pcol0, const float* cw, const float* cb, int cch0, LAS unsigned char* dst, int pitch, const LAS unsigned char* sl, int hq0, int tid) {
    constexpr int NCH8 = NCOLS / 8, NSEG = 512 / NCH8, RPS = 128 / NSEG;
    const int c8 = tid % NCH8, seg = tid / NCH8, l0 = seg * RPS;
    float w[4][8], bias[8], hst[3][8];
#pragma unroll
    for (int k = 0; k < 4; ++k) { const f32x4 a = *(const f32x4*)(cw + k * 1024 + cch0 + c8 * 8), b = *(const f32x4*)(cw + k * 1024 + cch0 + c8 * 8 + 4);
        w[k][0] = a[0]; w[k][1] = a[1]; w[k][2] = a[2]; w[k][3] = a[3]; w[k][4] = b[0]; w[k][5] = b[1]; w[k][6] = b[2]; w[k][7] = b[3]; }
    { const f32x4 a = *(const f32x4*)(cb + cch0 + c8 * 8), b = *(const f32x4*)(cb + cch0 + c8 * 8 + 4);
      bias[0] = a[0]; bias[1] = a[1]; bias[2] = a[2]; bias[3] = a[3]; bias[4] = b[0]; bias[5] = b[1]; bias[6] = b[2]; bias[7] = b[3]; }
    const bf16* src = PROJ + pcol0 + c8 * 8;
#pragma unroll
    for (int k = 0; k < 3; ++k) { const int l = l0 - 3 + k; v4u v = (v4u){0u, 0u, 0u, 0u}; if (t0 + l >= 0) v = *(const v4u*)(src + (size_t)((long)row0 + l) * NPROJ);
        hst[k][0] = bflo(v.x); hst[k][1] = bfhi(v.x); hst[k][2] = bflo(v.y); hst[k][3] = bfhi(v.y); hst[k][4] = bflo(v.z); hst[k][5] = bfhi(v.z); hst[k][6] = bflo(v.w); hst[k][7] = bfhi(v.w); }
    const LAS float* dts = (const LAS float*)(sl + SS_DTS); const LAS float* acum = (const LAS float*)(sl + SS_ACUM);
    const int hq = hq0 + (c8 * 8) / 64;
    const float alast = (FACMODE == 2) ? acum[hq * 128 + 127] : 0.f;
#pragma unroll
    for (int rr = 0; rr < RPS; ++rr) { const int l = l0 + rr; const v4u v = *(const v4u*)(src + (row0 + l) * NPROJ);
        float cur[8]; cur[0] = bflo(v.x); cur[1] = bfhi(v.x); cur[2] = bflo(v.y); cur[3] = bfhi(v.y); cur[4] = bflo(v.z); cur[5] = bfhi(v.z); cur[6] = bflo(v.w); cur[7] = bfhi(v.w);
        float f = 1.f; if (FACMODE >= 1) f = dts[hq * 128 + l]; if (FACMODE == 2) f *= __expf(alast - acum[hq * 128 + l]);
        float o[8];
#pragma unroll
        for (int e = 0; e < 8; ++e) { const float a = bias[e] + w[0][e] * hst[0][e] + w[1][e] * hst[1][e] + w[2][e] * hst[2][e] + w[3][e] * cur[e]; o[e] = siluf(a) * f;
            hst[0][e] = hst[1][e]; hst[1][e] = hst[2][e]; hst[2][e] = cur[e]; }
        v4u ov; ov.x = pk2(o[0], o[1]); ov.y = pk2(o[2], o[3]); ov.z = pk2(o[4], o[5]); ov.w = pk2(o[6], o[7]);
        *(LAS v4u*)(dst + l * pitch + c8 * 16) = ov; }
}
__device__ __forceinline__ void ssd_s1_unit(LAS unsigned char* sl, const bf16* PROJ, const float* DT, const float* dtb, const float* alog, const float* cw, const float* cb, float* ST, float* CDEC, int un, int tid, int lane, int wave) {
    const int g = un & 1, bc = un >> 1; const size_t row0 = (size_t)bc * 128; const int t0 = (bc & 31) * 128;
    __syncthreads();
    ssd_prep(sl, DT, dtb, alog, row0, g, tid, lane, wave);
    conv_tile<128, 0>(PROJ, row0, t0, C_XS + 512 + g * 128, cw, cb, 512 + g * 128, sl + S1_B, S1_PB, sl, 0, tid);
    conv_tile<256, 2>(PROJ, row0, t0, C_XS + g * 256, cw, cb, g * 256, sl + S1_X, S1_PX, sl, 0, tid);
    if (tid < 4) CDEC[(size_t)bc * 8 + 4 * g + tid] = __expf(((const LAS float*)(sl + SS_ACUM))[tid * 128 + 127]);
    __syncthreads();
    const int hq = wave >> 1, pt = wave & 1, h2 = lane >> 5, q = (lane & 15) >> 2, pp = lane & 3, dsel = (lane >> 4) & 1;
    const LAS unsigned char* xb = sl + S1_X + (8 * h2 + q) * S1_PX + (hq * 64 + pt * 32 + 16 * dsel + 4 * pp) * 2;
    const LAS unsigned char* bb = sl + S1_B + (8 * h2 + q) * S1_PB + (16 * dsel + 4 * pp) * 2;
    f32x16 acc[4];
#pragma unroll
    for (int nt = 0; nt < 4; ++nt) acc[nt] = (f32x16){};
#pragma unroll
    for (int ks = 0; ks < 8; ++ks) { const bf16x8 a = tr_pair(xb + (16 * ks) * S1_PX, xb + (16 * ks + 4) * S1_PX);
#pragma unroll
        for (int nt = 0; nt < 4; ++nt) { const bf16x8 b = tr_pair(bb + (16 * ks) * S1_PB + nt * 64, bb + (16 * ks + 4) * S1_PB + nt * 64); acc[nt] = __builtin_amdgcn_mfma_f32_32x32x16_bf16(a, b, acc[nt], 0, 0, 0); } }
    float* sp = ST + ((size_t)(bc * 8 + 4 * g + hq) * 64 + pt * 32) * 128 + (lane & 31);
#pragma unroll
    for (int nt = 0; nt < 4; ++nt)
#pragma unroll
        for (int rg = 0; rg < 16; ++rg) sp[(size_t)crow16(rg, h2) * 128 + 32 * nt] = acc[nt][rg];
}
__device__ __forceinline__ void ssd_s3_unit(LAS unsigned char* sl, const bf16* PROJ, const float* DT, const float* dtb, const float* alog, const float* cw, const float* cb, const float* dsk, const float* ng,
                                            const bf16* HIN, bf16* MIXED, int un, int tid, int lane, int wave) {
    const int g = un & 1, bc = un >> 1; const size_t row0 = (size_t)bc * 128; const int t0 = (bc & 31) * 128;
    const int lt = wave & 3, ph = wave >> 2, lq = lane & 31, hi = lane >> 5, q = (lane & 15) >> 2, pp = lane & 3, dsel = (lane >> 4) & 1;
    const int lrow = 32 * lt + lq;
    const size_t grow = row0 + lrow;
    __syncthreads();
    ssd_prep(sl, DT, dtb, alog, row0, g, tid, lane, wave);
    conv_tile<128, 0>(PROJ, row0, t0, C_XS + 512 + g * 128, cw, cb, 512 + g * 128, sl + S3_B, S3_PBC, sl, 0, tid);
    conv_tile<128, 0>(PROJ, row0, t0, C_XS + 768 + g * 128, cw, cb, 768 + g * 128, sl + S3_C, S3_PBC, sl, 0, tid);
    conv_tile<256, 1>(PROJ, row0, t0, C_XS + g * 256, cw, cb, g * 256, sl + S3_X, S3_PX, sl, 0, tid);
    __syncthreads();
    const LAS float* dts = (const LAS float*)(sl + SS_DTS); const LAS float* acum = (const LAS float*)(sl + SS_ACUM); LAS float* ssx = (LAS float*)(sl + SS_SSX);
    const LAS unsigned char* crd = sl + S3_C + lrow * S3_PBC + 16 * hi;
    f32x16 y[4];
    { bf16x8 hfa[8], hfb[8];
      const bf16* hp0 = HIN + ((size_t)(bc * 8 + 4 * g) * 64 + ph * 32 + lq) * 128 + 8 * hi;
#pragma unroll
      for (int ks = 0; ks < 8; ++ks) hfa[ks] = *(const bf16x8*)(hp0 + 16 * ks);
#pragma unroll
      for (int hq = 0; hq < 4; ++hq) {
          if (hq < 3) {
#pragma unroll
              for (int ks = 0; ks < 8; ++ks) { const bf16x8 v = *(const bf16x8*)(hp0 + (size_t)(hq + 1) * 8192 + 16 * ks); if (hq & 1) hfa[ks] = v; else hfb[ks] = v; } }
          f32x16 t = (f32x16){};
#pragma unroll
          for (int ks = 0; ks < 8; ++ks) t = __builtin_amdgcn_mfma_f32_32x32x16_bf16((hq & 1) ? hfb[ks] : hfa[ks], *(const LAS bf16x8*)(crd + 32 * ks), t, 0, 0, 0);
          const float ea = __expf(acum[hq * 128 + lrow]);
#pragma unroll
          for (int rg = 0; rg < 16; ++rg) t[rg] *= ea;
          y[hq] = t; } }
    v2u zr[4][4];
#pragma unroll
    for (int hq = 0; hq < 4; ++hq)
#pragma unroll
        for (int g4 = 0; g4 < 4; ++g4) zr[hq][g4] = *(const v2u*)(PROJ + grow * NPROJ + C_Z + g * 256 + hq * 64 + ph * 32 + 8 * g4 + 4 * hi);
#pragma unroll
    for (int st = 0; st < 4; ++st) if (st <= lt) {
        f32x16 ag = (f32x16){};
        { const LAS unsigned char* brd = sl + S3_B + (32 * st + lq) * S3_PBC + 16 * hi;
#pragma unroll
          for (int ks = 0; ks < 8; ++ks) ag = __builtin_amdgcn_mfma_f32_32x32x16_bf16(*(const LAS bf16x8*)(brd + 32 * ks), *(const LAS bf16x8*)(crd + 32 * ks), ag, 0, 0, 0); }
#pragma unroll
        for (int hq = 0; hq < 4; ++hq) {
            const float al = acum[hq * 128 + lrow], dd = dsk[4 * g + hq] / dts[hq * 128 + lrow];
            const LAS unsigned char* xb = sl + S3_X + (4 * hi + q) * S3_PX + (hq * 64 + ph * 32 + 16 * dsel + 4 * pp) * 2;
            float pm[16];
#pragma unroll
            for (int g4 = 0; g4 < 4; ++g4) { const f32x4 as4 = *(const LAS f32x4*)(acum + hq * 128 + 32 * st + 8 * g4 + 4 * hi);
#pragma unroll
                for (int e = 0; e < 4; ++e) { const int rg = 4 * g4 + e; float v = ag[rg] * __expf(al - as4[e]);
                    if (st == lt) { const int sl_ = 8 * g4 + 4 * hi + e; if (sl_ > lq) v = 0.f; if (sl_ == lq) v += dd; }
                    pm[rg] = v; } }
#pragma unroll
            for (int ks = 0; ks < 2; ++ks) { v4u wv; wv.x = pg8::cvt_pk_bf16(pm[8 * ks + 0], pm[8 * ks + 1]); wv.y = pg8::cvt_pk_bf16(pm[8 * ks + 2], pm[8 * ks + 3]); wv.z = pg8::cvt_pk_bf16(pm[8 * ks + 4], pm[8 * ks + 5]); wv.w = pg8::cvt_pk_bf16(pm[8 * ks + 6], pm[8 * ks + 7]);
                const bf16x8 xt = tr_pair(xb + (32 * st + 16 * ks) * S3_PX, xb + (32 * st + 16 * ks + 8) * S3_PX);
                y[hq] = __builtin_amdgcn_mfma_f32_32x32x16_bf16(xt, __builtin_bit_cast(bf16x8, wv), y[hq], 0, 0, 0); }
        }
    }
    unsigned ayp[4][8]; float ss = 0.f;
#pragma unroll
    for (int hq = 0; hq < 4; ++hq)
#pragma unroll
        for (int g4 = 0; g4 < 4; ++g4) { const v2u z = zr[hq][g4];
            const float y0 = y[hq][4 * g4 + 0] * siluf(bflo(z.x)), y1 = y[hq][4 * g4 + 1] * siluf(bfhi(z.x)), y2 = y[hq][4 * g4 + 2] * siluf(bflo(z.y)), y3 = y[hq][4 * g4 + 3] * siluf(bfhi(z.y));
            ss += (y0 * y0 + y1 * y1) + (y2 * y2 + y3 * y3);
            ayp[hq][2 * g4] = pg8::cvt_pk_bf16(y0, y1); ayp[hq][2 * g4 + 1] = pg8::cvt_pk_bf16(y2, y3); }
    ss += __shfl_xor(ss, 32);
    if (hi == 0) ssx[ph * 128 + lrow] = ss;
    __syncthreads();
    const float rs = 1.0f / sqrtf((ssx[lrow] + ssx[128 + lrow]) * (1.f / 256.f) + RMS_EPS);
#pragma unroll
    for (int hq = 0; hq < 4; ++hq)
#pragma unroll
        for (int g4 = 0; g4 < 4; ++g4) { const int ch = hq * 64 + ph * 32 + 8 * g4 + 4 * hi; const f32x4 gn = *(const f32x4*)(ng + g * 256 + ch);
            const unsigned p0 = ayp[hq][2 * g4], p1 = ayp[hq][2 * g4 + 1];
            v2u o; o.x = pg8::cvt_pk_bf16(bflo(p0) * rs * gn[0], bfhi(p0) * rs * gn[1]); o.y = pg8::cvt_pk_bf16(bflo(p1) * rs * gn[2], bfhi(p1) * rs * gn[3]);
            *(v2u*)(MIXED + grow * MIXW + 512 + g * 256 + ch) = o; }
}

struct Args { const float* in[20]; float* out; unsigned char* ws; int ph_lo, ph_hi, sub, pad; };
constexpr int NWAVES = 8;
constexpr int PH_PER_LAYER = 10, N_PHASES = 1 + NLAYER * PH_PER_LAYER;

#define in_x (args.in[0])
#define in_win (args.in[1])
#define in_convw (args.in[2])
#define in_convb (args.in[3])
#define in_dtb (args.in[4])
#define in_alog (args.in[5])
#define in_dsk (args.in[6])
#define in_ng (args.in[7])
#define in_scw (args.in[8])
#define in_wout (args.in[9])
#define in_ln1g (args.in[10])
#define in_ln1b (args.in[11])
#define in_rw (args.in[12])
#define in_rb (args.in[13])
#define in_wgu (args.in[14])
#define in_bgu (args.in[15])
#define in_wdn (args.in[16])
#define in_bdn (args.in[17])
#define in_ln2g (args.in[18])
#define in_ln2b (args.in[19])
#define ROPE ((float*)(args.ws + WS_ROPE))
#define WDT ((float*)(args.ws + WS_WDT))
#define ROUT ((bf16*)(args.ws + WS_ROUT))
#define WIN ((bf16*)(args.ws + WS_WIN))
#define WOUT ((bf16*)(args.ws + WS_WOUT))
#define WGU ((bf16*)(args.ws + WS_WGU))
#define WDN ((bf16*)(args.ws + WS_WDN))
#define XB ((bf16*)(args.ws + WS_XB))
#define XF ((float*)(args.ws + WS_XF))
#define XF2 ((float*)(args.ws + WS_XF2))
#define PROJ ((bf16*)(args.ws + WS_PROJ))
#define DT ((float*)(args.ws + WS_DT))
#define DTS ((float*)(args.ws + WS_DTS))
#define ACUM ((float*)(args.ws + WS_ACUM))
#define LSE ((float*)(args.ws + WS_LSE))
#define OP ((bf16*)(args.ws + WS_OP))
#define U ((bf16*)(args.ws + WS_U))
#define GB ((float*)(args.ws + WS_G))
#define ST ((float*)(args.ws + WS_ST))
#define YD ((float*)(args.ws + WS_YD))
#define MIXED ((bf16*)(args.ws + WS_MIXED))
#define MIXF ((bf16*)(args.ws + WS_MIXF))
#define TOPE ((int*)(args.ws + WS_TOPE))
#define TOPG ((float*)(args.ws + WS_TOPG))
#define ROWTOK ((int*)(args.ws + WS_ROWTOK))
#define ROWGATE ((float*)(args.ws + WS_ROWGATE))
#define HB ((bf16*)(args.ws + WS_H))
#define YB ((bf16*)(args.ws + WS_YB))
#define HIN ((bf16*)(args.ws + WS_G))
#define WGU8 ((unsigned char*)(args.ws + WS_WGU))
#define WDN8 ((unsigned char*)(args.ws + WS_WDN))
#define XB8 ((unsigned char*)(args.ws + WS_U))
#define H8 ((unsigned char*)(args.ws + WS_H))
#define YB8 ((unsigned char*)(args.ws + WS_YB))
#define WIN8 ((unsigned char*)(args.ws + WS_WGU + 128 * MiB))
#define XP8 ((unsigned char*)(args.ws + WS_WGU + 132 * MiB))
#define CDEC ((float*)(args.ws + WS_ACUM))
template <int layer>
__device__ __forceinline__ void run_layer(const Args& args, int lo, int hi, const XcdBarrier& bar) {
    extern __shared__ __attribute__((aligned(16))) unsigned char lds[];
    LAS unsigned char* ldsp = (LAS unsigned char*)lds;
    const int tid = threadIdx.x, lane = tid & 63, wave = __builtin_amdgcn_readfirstlane(tid >> 6);
    const int G = gridDim.x, bid = blockIdx.x;
    const int gw = bid * NWAVES + wave, NGW = G * NWAVES;
    gu32* ctl = (gu32*)(args.ws + WS_CTL);

#define IN(k) (lo <= (k) && (k) < hi)
#define SEAM(k) do { if (IN(k) && IN((k) + 1)) xcd_barrier(bar); } while (0)

        const int pb = 1 + layer * PH_PER_LAYER;
        const bf16* WINl = WIN + (size_t)layer * NPROJ * DM; const bf16* WOUTl = WOUT + (size_t)layer * DM * MIXW;
        const unsigned char* WGUl = WGU8 + (size_t)layer * NEXP * 2048 * DM; const unsigned char* WDNl = WDN8 + (size_t)layer * NEXP * DM * FF;
        gu32* gcnt = ctl + CW_CNT + 64 * layer;

        if (IN(pb + 0)) {
            if (layer == 0) {
                for (int m = gw; m < MROWS; m += NGW) { const bf16* xr = XB + (size_t)m * DM; f32x4 v[4];
#pragma unroll
                    for (int j = 0; j < 4; ++j) { const v2u a = *(const v2u*)(xr + 4 * lane + 256 * j); v[j] = (f32x4){bflo(a.x), bfhi(a.x), bflo(a.y), bfhi(a.y)}; }
                    row_dt(v, WDT, DT + (size_t)m * 8, lane); }
            }
            {
              pg8::Gemm g{(const pg8::bf16_t*)XP8, (const pg8::bf16_t*)(WIN8 + (size_t)layer * 1536 * DM), MROWS, 1536, DM / 2}; pg8::StaticOrder S; S.init(MROWS, 1536, G, bid);
              pg8::EpiProj E{PROJ, NPROJ, ROPE, QSCALE, 1.0f / (SC_X * SC_WIN), 0};
              pg8::gemm_phase<pg8::EpiProj, pg8::StaticOrder, true, false, true>(ldsp + RING_OFF, g, S, E); }
            __syncthreads();
            { pg8::Gemm g{XB, WINl + (size_t)1536 * DM, MROWS, NPROJ - 1536, DM}; pg8::StaticOrder S; S.init(MROWS, NPROJ - 1536, G, bid);
              pg8::EpiProj E{PROJ, NPROJ, ROPE, QSCALE, 1.0f, 6};
              pg8::gemm_phase<pg8::EpiProj, pg8::StaticOrder, true, false>(ldsp + RING_OFF, g, S, E); }
        }
        SEAM(pb + 0);
        if (IN(pb + 1)) {
            if (args.sub & 1) attn_phase(ldsp + RING_OFF, PROJ, OP, LSE, bid, G, tid, wave, lane);
            if (args.sub & 2) { const float* cw = in_convw + (size_t)layer * 4 * 1024; const float* cb = in_convb + (size_t)layer * 1024;
              for (int un = bid; un < 512; un += G)
                  ssd_s1_unit(ldsp + RING_OFF, PROJ, DT, in_dtb + layer * 8, in_alog + layer * 8, cw, cb, ST, CDEC, un, tid, lane, wave);
              __syncthreads(); }
            const float* sw = in_scw + (size_t)layer * 3 * 512;
            if (args.sub & 4)
#pragma unroll 2
            for (int it = bid * (NWAVES * 64) + tid; it < (int)((long)MROWS * 64); it += G * (NWAVES * 64)) { const int c8 = (int)(it & 63), row = (int)(it >> 6), t = row & (SEQ - 1); const int ch = c8 * 8;
                float a[8];
#pragma unroll
                for (int q = 0; q < 8; ++q) a[q] = 0.f;
#pragma unroll
                for (int k = 0; k < 3; ++k) { const int tt = t - 2 + k; if (tt >= 0) { const bf16* pr = PROJ + (size_t)(row - 2 + k) * NPROJ; const v4u cc = *(const v4u*)(pr + C_SC + ch), hh = *(const v4u*)(pr + C_SH + ch);
                    const f32x4 w0 = *(const f32x4*)(sw + k * 512 + ch), w1 = *(const f32x4*)(sw + k * 512 + ch + 4);
                    a[0] += w0[0] * bflo(cc.x) * bflo(hh.x); a[1] += w0[1] * bfhi(cc.x) * bfhi(hh.x); a[2] += w0[2] * bflo(cc.y) * bflo(hh.y); a[3] += w0[3] * bfhi(cc.y) * bfhi(hh.y);
                    a[4] += w1[0] * bflo(cc.z) * bflo(hh.z); a[5] += w1[1] * bfhi(cc.z) * bfhi(hh.z); a[6] += w1[2] * bflo(cc.w) * bflo(hh.w); a[7] += w1[3] * bfhi(cc.w) * bfhi(hh.w); } }
                const v4u bb = *(const v4u*)(PROJ + (size_t)row * NPROJ + C_SB + ch);
                v4u o; o.x = pk2(a[0] * bflo(bb.x), a[1] * bfhi(bb.x)); o.y = pk2(a[2] * bflo(bb.y), a[3] * bfhi(bb.y)); o.z = pk2(a[4] * bflo(bb.z), a[5] * bfhi(bb.z)); o.w = pk2(a[6] * bflo(bb.w), a[7] * bfhi(bb.w));
                *(v4u*)(MIXED + (size_t)row * MIXW + 1024 + ch) = o; }
        }
        SEAM(pb + 1);
        if (IN(pb + 2)) {
            for (int it = bid * (NWAVES * 64) + tid; it < (int)(64L * 2048); it += G * (NWAVES * 64)) { const int pn4 = (int)(it & 2047), bh = (int)(it >> 11); const int h = bh & 7, b = bh >> 3; f32x4 hc = (f32x4){0.f, 0.f, 0.f, 0.f};
#pragma unroll 16
                for (int c = 0; c < 32; ++c) { const size_t idx = ((size_t)((b * 32 + c) * 8 + h)) * 8192 + pn4 * 4; const f32x4 st = *(const f32x4*)(ST + idx);
                    v2u o; o.x = pk2(hc[0], hc[1]); o.y = pk2(hc[2], hc[3]); *(v2u*)(HIN + idx) = o;
                    hc = hc * CDEC[(size_t)(b * 32 + c) * 8 + h] + st; } }
        }
        SEAM(pb + 2);
        if (IN(pb + 3)) {
            if (args.sub & 1) { const float* cw = in_convw + (size_t)layer * 4 * 1024; const float* cb = in_convb + (size_t)layer * 1024;
              for (int un = bid; un < 512; un += G)
                  ssd_s3_unit(ldsp + RING_OFF, PROJ, DT, in_dtb + layer * 8, in_alog + layer * 8, cw, cb, in_dsk + layer * 8, in_ng + (size_t)layer * 512, HIN, MIXED, un, tid, lane, wave);
              __syncthreads(); }
            if (args.sub & 2)
#pragma unroll 2
            for (int it = bid * (NWAVES * 64) + tid; it < (int)((long)MROWS * 64); it += G * (NWAVES * 64)) { const int c8 = (int)(it & 63), row = (int)(it >> 6); const int h = c8 >> 3;
                const float l0 = LSE[((size_t)0 * MROWS + row) * 8 + h], l1 = LSE[((size_t)1 * MROWS + row) * 8 + h], l2 = LSE[((size_t)2 * MROWS + row) * 8 + h];
                const float mm = fmaxf(l0, fmaxf(l1, l2)); float w0 = exp2f(l0 - mm), w1 = exp2f(l1 - mm), w2 = exp2f(l2 - mm); const float iw = 1.0f / (w0 + w1 + w2); w0 *= iw; w1 *= iw; w2 *= iw;
                const v4u a0 = *(const v4u*)(OP + ((size_t)0 * MROWS + row) * 512 + c8 * 8), a1 = *(const v4u*)(OP + ((size_t)1 * MROWS + row) * 512 + c8 * 8), a2 = *(const v4u*)(OP + ((size_t)2 * MROWS + row) * 512 + c8 * 8);
                v4u o;
                o.x = pk2(w0 * bflo(a0.x) + w1 * bflo(a1.x) + w2 * bflo(a2.x), w0 * bfhi(a0.x) + w1 * bfhi(a1.x) + w2 * bfhi(a2.x));
                o.y = pk2(w0 * bflo(a0.y) + w1 * bflo(a1.y) + w2 * bflo(a2.y), w0 * bfhi(a0.y) + w1 * bfhi(a1.y) + w2 * bfhi(a2.y));
                o.z = pk2(w0 * bflo(a0.z) + w1 * bflo(a1.z) + w2 * bflo(a2.z), w0 * bfhi(a0.z) + w1 * bfhi(a1.z) + w2 * bfhi(a2.z));
                o.w = pk2(w0 * bflo(a0.w) + w1 * bflo(a1.w) + w2 * bflo(a2.w), w0 * bfhi(a0.w) + w1 * bfhi(a1.w) + w2 * bfhi(a2.w));
                *(v4u*)(MIXED + (size_t)row * MIXW + c8 * 8) = o; }
        }
        SEAM(pb + 3);
        if (IN(pb + 4)) {
            pg8::Gemm g{MIXED, WOUTl, MROWS, DM, MIXW}; pg8::StaticOrder S; S.init(MROWS, DM, G, bid);
            pg8::EpiBf16Plain E{MIXF, DM};
            pg8::gemm_phase<pg8::EpiBf16Plain, pg8::StaticOrder, true, false>(ldsp + RING_OFF, g, S, E);
        }
        SEAM(pb + 4);
        if (IN(pb + 5)) {
            const float* gam = in_ln1g + (size_t)layer * DM; const float* bet = in_ln1b + (size_t)layer * DM;
            for (int m = gw; m < MROWS; m += NGW) { f32x4 v[4];
#pragma unroll
                for (int j = 0; j < 4; ++j) { const v2u a = *(const v2u*)(XB + (size_t)m * DM + 4 * lane + 256 * j); const v2u b = *(const v2u*)(MIXF + (size_t)m * DM + 4 * lane + 256 * j);
                    v[j] = (f32x4){bflo(a.x), bfhi(a.x), bflo(a.y), bfhi(a.y)} * ALPHA + (f32x4){bflo(b.x), bfhi(b.x), bflo(b.y), bfhi(b.y)}; }
                ln_row<true, false>(v, gam, bet, nullptr, XB + (size_t)m * DM, XB8 + (size_t)m * DM, SC_X, lane); }
        }
        SEAM(pb + 5);
        if (IN(pb + 6)) {
            LAS int* lcnt = (LAS int*)(ldsp + L_LCNT); LAS int* lbase = (LAS int*)(ldsp + L_LBASE);
            const bf16* RT = ROUT + (size_t)layer * NEXP * DM; const float* rb = in_rb + (size_t)layer * NEXP;
            for (int blk = bid; blk < MROWS / 128; blk += G) {
                if (tid < 32) lcnt[tid] = 0;
                __syncthreads();
                const int r32 = lane & 31, hi = lane >> 5; const int row = blk * 128 + (wave & 3) * 32 + r32;
                float tv[4]; int te[4]; int lrank[4]; float gate[4];
                f32x16 acc = {};
                { const int kh = wave >> 2;
                  const bf16* ap = RT + (size_t)r32 * DM + 8 * hi + 512 * kh; const bf16* bp = XB + (size_t)row * DM + 8 * hi + 512 * kh;
#pragma unroll 16
                  for (int s = 0; s < 32; ++s) { const bf16x8 a = *(const bf16x8*)(ap + 16 * s), b = *(const bf16x8*)(bp + 16 * s); acc = __builtin_amdgcn_mfma_f32_32x32x16_bf16(a, b, acc, 0, 0, 0); }
                  LAS float* part = (LAS float*)(ldsp + RING_OFF) + (wave & 3) * 1024;
                  if (kh) {
#pragma unroll
                      for (int i = 0; i < 16; ++i) part[i * 64 + lane] = acc[i]; }
                  __syncthreads();
                  if (!kh) {
#pragma unroll
                      for (int i = 0; i < 16; ++i) acc[i] += part[i * 64 + lane]; } }
                if (wave < 4) {
#pragma unroll
                    for (int k = 0; k < 4; ++k) { tv[k] = -INFINITY; te[k] = 1 << 20; }
#pragma unroll
                    for (int i = 0; i < 16; ++i) { const int e = (i & 3) + 8 * (i >> 2) + 4 * hi; float v = acc[i] + rb[e]; int ve = e;
#pragma unroll
                        for (int k = 0; k < 4; ++k) { const bool gt = (v > tv[k]) || (v == tv[k] && ve < te[k]); const float nv = gt ? tv[k] : v; const int ne = gt ? te[k] : ve; tv[k] = gt ? v : tv[k]; te[k] = gt ? ve : te[k]; v = nv; ve = ne; } }
                    float pv[4]; int pe[4];
#pragma unroll
                    for (int k = 0; k < 4; ++k) { pv[k] = __shfl_xor(tv[k], 32); pe[k] = __shfl_xor(te[k], 32); }
#pragma unroll
                    for (int j = 0; j < 4; ++j) { float v = pv[j]; int ve = pe[j];
#pragma unroll
                        for (int k = 0; k < 4; ++k) { const bool gt = (v > tv[k]) || (v == tv[k] && ve < te[k]); const float nv = gt ? tv[k] : v; const int ne = gt ? te[k] : ve; tv[k] = gt ? v : tv[k]; te[k] = gt ? ve : te[k]; v = nv; ve = ne; } }
                    float se = 0.f;
#pragma unroll
                    for (int k = 0; k < 4; ++k) { gate[k] = __expf(tv[k] - tv[0]); se += gate[k]; }
                    const float ise = 1.0f / se;
#pragma unroll
                    for (int k = 0; k < 4; ++k) gate[k] *= ise;
                    if (hi == 0) {
#pragma unroll
                        for (int k = 0; k < 4; ++k) lrank[k] = __hip_atomic_fetch_add(lcnt + te[k], 1, __ATOMIC_RELAXED, __HIP_MEMORY_SCOPE_WORKGROUP);
                    }
                }
                __syncthreads();
                if (tid < 32) lbase[tid] = (int)__hip_atomic_fetch_add(gcnt + tid, (unsigned)lcnt[tid], RLX_AGENT);
                __syncthreads();
                if (wave < 4 && hi == 0) {
#pragma unroll
                    for (int k = 0; k < 4; ++k) { const int r = lbase[te[k]] + lrank[k]; const size_t o = (size_t)te[k] * 32768 + r;
                        ROWTOK[o] = row * 4 + k; ROWGATE[o] = gate[k]; }
                }
                __syncthreads();
            }
        }
        SEAM(pb + 6);
        if (IN(pb + 7) || IN(pb + 8)) {
            LAS int* tstart = (LAS int*)(ldsp + L_TSTART); LAS int* cntL = (LAS int*)(ldsp + L_CNT); LAS int* units = (LAS int*)(ldsp + L_UNITS); LAS int* unitsn = (LAS int*)(ldsp + L_UNITSN);
            if (tid == 0) { int acc = 0; for (int e = 0; e < 32; ++e) { const int c = (int)__hip_atomic_load(gcnt + e, RLX_AGENT); cntL[e] = c; tstart[e] = acc; acc += (c + 255) >> 8; } tstart[32] = acc; }
            __syncthreads();
            if (IN(pb + 7)) {
                pg8::moe_build_units(units, unitsn, tstart, 8, G, bid, tid);
                __syncthreads();
                pg8::Gemm g{(const pg8::bf16_t*)XB8, (const pg8::bf16_t*)WGUl, 0, 2048, DM / 2};
                pg8::MoeOrder S{units, __builtin_amdgcn_readfirstlane(unitsn[0]), cntL, ROWTOK, 1, (unsigned)DM, (size_t)2048 * DM, ROWGATE, in_bgu + (size_t)layer * NEXP * 2048};
                pg8::EpiSwiglu E{H8, in_bgu + (size_t)layer * NEXP * 2048, ROWGATE, cntL, 1.0f / (SC_X * SC_WGU), SC_H};
                pg8::gemm_phase<pg8::EpiSwiglu, pg8::MoeOrder, true, true, true>(ldsp + RING_OFF, g, S, E);
                __syncthreads();
            }
            SEAM(pb + 7);
            if (IN(pb + 8)) {
                pg8::moe_build_units(units, unitsn, tstart, 4, G, bid, tid);
                __syncthreads();
                pg8::Gemm g{(const pg8::bf16_t*)H8, (const pg8::bf16_t*)WDNl, 0, DM, FF / 2};
                pg8::MoeOrder S{units, __builtin_amdgcn_readfirstlane(unitsn[0]), cntL, ROWTOK, 0, (unsigned)FF, (size_t)DM * FF, ROWGATE, in_bdn + (size_t)layer * NEXP * DM};
                pg8::EpiScatter E{YB8, ROWTOK, cntL, SC_Y / (SC_H * SC_WDN), SC_Y};
                pg8::gemm_phase<pg8::EpiScatter, pg8::MoeOrder, true, false, true, true>(ldsp + RING_OFF, g, S, E);
                __syncthreads();
            }
        }
        SEAM(pb + 8);
        if (IN(pb + 9)) {
            const float* gam = in_ln2g + (size_t)layer * DM; const float* bet = in_ln2b + (size_t)layer * DM; const float* bdn = in_bdn + (size_t)layer * NEXP * DM;
            for (int m = gw; m < MROWS; m += NGW) { f32x4 v[4];
#pragma unroll
                for (int j = 0; j < 4; ++j) { const v2u a = *(const v2u*)(XB + (size_t)m * DM + 4 * lane + 256 * j); v[j] = (f32x4){bflo(a.x), bfhi(a.x), bflo(a.y), bfhi(a.y)} * ALPHA; }
#pragma unroll
                for (int k = 0; k < 4; ++k) { const unsigned char* yr = YB8 + ((size_t)m * 4 + k) * DM;
#pragma unroll
                    for (int j = 0; j < 4; ++j) { const unsigned w = *(const unsigned*)(yr + 4 * lane + 256 * j);
                        typedef float f32x2_ __attribute__((ext_vector_type(2)));
                        const f32x2_ lo = __builtin_amdgcn_cvt_pk_f32_fp8(w, false), hi = __builtin_amdgcn_cvt_pk_f32_fp8(w, true);
                        v[j][0] += lo[0] * (1.0f / SC_Y); v[j][1] += lo[1] * (1.0f / SC_Y); v[j][2] += hi[0] * (1.0f / SC_Y); v[j][3] += hi[1] * (1.0f / SC_Y); } }
                ln_row<(layer + 1 < NLAYER), (layer == NLAYER - 1)>(v, gam, bet, args.out + (size_t)m * DM, XB + (size_t)m * DM, XP8 + (size_t)m * DM, SC_X, lane);
                if (layer + 1 < NLAYER) row_dt(v, WDT + (size_t)(layer + 1) * 8 * 1024, DT + (size_t)m * 8, lane); }
        }
        SEAM(pb + 9);
    #undef IN
#undef SEAM
}

__global__ void __launch_bounds__(NWAVES * 64, 2) mk_fwd(Args args) {
    extern __shared__ __attribute__((aligned(16))) unsigned char lds[];
    LAS unsigned char* ldsp = (LAS unsigned char*)lds;
    const int tid = threadIdx.x, lane = tid & 63, wave = __builtin_amdgcn_readfirstlane(tid >> 6);
    const int G = gridDim.x, bid = blockIdx.x;
    const int gw = bid * NWAVES + wave, NGW = G * NWAVES;
    gu32* ctl = (gu32*)(args.ws + WS_CTL);

    for (int u = tid; u < (LDS_BYTES - LDSCTL_OFF) / 4; u += NWAVES * 64) ((LAS unsigned*)(ldsp + LDSCTL_OFF))[u] = 0u;
    __syncthreads();
    XcdBarrier bar = xcd_barrier_post((unsigned*)(ctl + CW_BAR), (volatile LAS unsigned*)(ldsp + L_MISC) + 8);

    const int lo = args.ph_lo, hi = args.ph_hi;
#define IN(k) (lo <= (k) && (k) < hi)
#define SEAM(k) do { if (IN(k) && IN((k) + 1)) xcd_barrier(bar); } while (0)

    if (IN(0)) {
        LAS float* scr = (LAS float*)(ldsp + RING_OFF + wave * 16384);
        constexpr int I_IN = 16 * 73, I_OUT = 24 * 16, I_R = 16;
        constexpr int NIT = NLAYER * (I_IN + I_OUT + I_R);
        for (int it = gw; it < NIT; it += NGW) {
            int r = it;
            if (r < NLAYER * I_IN) { const int l = r / I_IN; r %= I_IN; p0_transpose_item64<1>(in_win + (size_t)l * DM * INW, DM, INW, WIN + (size_t)l * NPROJ * DM, WDT + (size_t)l * 8 * 1024, scr, r / 73, r % 73, lane); continue; } r -= NLAYER * I_IN;
            if (r < NLAYER * I_OUT) { const int l = r / I_OUT; r %= I_OUT; p0_transpose_item64<0>(in_wout + (size_t)l * MIXW * DM, MIXW, DM, WOUT + (size_t)l * DM * MIXW, nullptr, scr, r / 16, r % 16, lane); continue; } r -= NLAYER * I_OUT;
            { const int l = r / I_R; r %= I_R; p0_transpose_item<0>(in_rw + (size_t)l * DM * NEXP, DM, NEXP, ROUT + (size_t)l * NEXP * DM, nullptr, scr, r, 0, lane); }
        }
        { constexpr int NIT8 = 64 * 256 + 64 * 128 + NLAYER * 192;
          const int nmine = (gw < NIT8) ? (NIT8 - gw + NGW - 1) / NGW : 0; const int J = 2 * nmine;
          f32x4 lda[16], ldb[16];
          if (J > 0) { const SubT t = fp8_subtile(gw, 0, in_wgu, in_wdn, in_win, WGU8, WDN8, WIN8, lane); fp8_sub_load(t, lda); }
#pragma unroll 1
          for (int j = 0; j < J; j += 2) {
              const int item = gw + (j >> 1) * NGW;
              const SubT t0 = fp8_subtile(item, 0, in_wgu, in_wdn, in_win, WGU8, WDN8, WIN8, lane), t1 = fp8_subtile(item, 1, in_wgu, in_wdn, in_win, WGU8, WDN8, WIN8, lane);
              fp8_sub_load(t1, ldb);
              fp8_sub_process(t0, lda, scr, lane);
              if (j + 2 < J) { const SubT t2 = fp8_subtile(item + NGW, 0, in_wgu, in_wdn, in_win, WGU8, WDN8, WIN8, lane); fp8_sub_load(t2, lda); }
              fp8_sub_process(t1, ldb, scr, lane);
          } }
        __syncthreads();
    }
    if (IN(0)) {
        for (int m = gw; m < MROWS; m += NGW) { const float* xr = in_x + (size_t)m * DM; bf16* ob = XB + (size_t)m * DM; f32x4 v[4];
#pragma unroll
            for (int j = 0; j < 4; ++j) { v[j] = *(const f32x4*)(xr + 4 * lane + 256 * j); v2u w; w.x = pk2(v[j][0], v[j][1]); w.y = pk2(v[j][2], v[j][3]); *(v2u*)(ob + 4 * lane + 256 * j) = w;
                *(unsigned*)(XP8 + (size_t)m * DM + 4 * lane + 256 * j) = pg8::pk4_fp8(v[j][0] * SC_X, v[j][1] * SC_X, v[j][2] * SC_X, v[j][3] * SC_X); }
            }
    }

    SEAM(0);
    run_layer<0>(args, lo, hi, bar);
    run_layer<1>(args, lo, hi, bar);
#undef IN
#undef SEAM
}

extern "C" void kernel_launch(void* const* d_in, const int* in_sizes, int n_in, void* d_out, int out_size, void* d_ws, size_t ws_size, hipStream_t stream) {
    static int grid = 0;
    if (grid == 0) {
        if (n_in != 20 || out_size != MROWS * DM || ws_size < WS_END) { fprintf(stderr, "kernel_launch: unexpected problem (n_in %d, out %d, ws %zu)\n", n_in, out_size, ws_size); grid = -1; return; }
        if (hipFuncSetAttribute((const void*)mk_fwd, hipFuncAttributeMaxDynamicSharedMemorySize, LDS_BYTES) != hipSuccess) { fprintf(stderr, "kernel_launch: hipFuncSetAttribute failed\n"); grid = -1; return; }
        int dev = 0, cus = 0, per_cu = 0;
        (void)hipGetDevice(&dev); (void)hipDeviceGetAttribute(&cus, hipDeviceAttributeMultiprocessorCount, dev);
        if (hipOccupancyMaxActiveBlocksPerMultiprocessor(&per_cu, (const void*)mk_fwd, NWAVES * 64, LDS_BYTES) != hipSuccess || per_cu < 1) fprintf(stderr, "kernel_launch: occupancy query says %d\n", per_cu);
        (void)hipGetLastError();
        grid = cus > 0 ? cus : 256;
    }
    if (grid < 0) return;
    (void)hipMemsetAsync((char*)d_ws + WS_CTL, 0, CTL_ZERO_BYTES, stream);
    Args a{};
    for (int i = 0; i < 20; ++i) a.in[i] = (const float*)d_in[i];
    a.out = (float*)d_out; a.ws = (unsigned char*)d_ws;
    a.ph_lo = 0; a.ph_hi = N_PHASES; a.sub = 7; a.pad = 0;
    hipLaunchKernelGGL(mk_fwd, dim3(grid), dim3(NWAVES * 64), LDS_BYTES, stream, a);
#ifdef PROBE_PH
#ifndef PROBE_SUB
#define PROBE_SUB 7
#endif
    for (int i = 0; i < PROBE_N; ++i) { a.ph_lo = PROBE_PH; a.ph_hi = PROBE_PH + 1; a.sub = PROBE_SUB; hipLaunchKernelGGL(mk_fwd, dim3(grid), dim3(NWAVES * 64), LDS_BYTES, stream, a); }
#endif
}
```

```cpp
#include <hip/hip_runtime.h>
#include <cstdio>
#include <cstdint>
#include <cmath>

namespace pg8 {
#define PG8_LAS __attribute__((address_space(3)))
typedef unsigned short bf16_t;
typedef short bf16x8 __attribute__((ext_vector_type(8)));
typedef float f32x4 __attribute__((ext_vector_type(4)));
typedef float f32x2 __attribute__((ext_vector_type(2)));
typedef unsigned u32x4 __attribute__((ext_vector_type(4)));
constexpr int BM = 256, BK = 64, HALF = 128, HTB = HALF * BK * 2  , STAGE_BYTES = 8 * HTB, NXCD = 8, WGM = 8;

__host__ __device__ __forceinline__ int lds_byte(int r, int c) { const int st = (r >> 4) * 2 + (c >> 5), rr = r & 15, cc = c & 31, ob = rr * 64 + cc * 2; return st * 1024 + (ob ^ (((ob >> 9) & 1) << 5)); }
__host__ __device__ __forceinline__ void stage_rc(int b, int& R, int& C) { const int st = b / 1024, sb = b % 1024, swz = sb ^ (((sb >> 9) & 1) << 5); R = (st >> 1) * 16 + swz / 64; C = (st & 1) * 32 + (swz % 64) / 2; }
__host__ __device__ __forceinline__ int perm32(int rho) { const int n = rho >> 4, i = rho & 15; return 8 * (i >> 2) + 4 * n + (i & 3); }

struct Unit { int pm, pn, e, r0; };
struct Gemm { const bf16_t* A; const bf16_t* Bt; int M, N, K; };

struct StaticOrder {
    int nM, nN, nwg, G, c, base, lim;
    __device__ void init(int M, int N, int G_, int c_) { nM = M / BM; nN = N / BM; nwg = nM * nN; G = G_; c = c_; base = 0; lim = nwg; }
    __device__ __forceinline__ bool next(int i, Unit& u) const {
        const long L = (long)i * G + c + base; if (L >= lim) return false;
        int wgid = (int)L; { const int q = nwg / NXCD, r = nwg % NXCD, xcd = wgid % NXCD, off = wgid / NXCD; wgid = (xcd < r ? xcd * (q + 1) : r * (q + 1) + (xcd - r) * q) + off; }
        const int nig = WGM * nN, gid = wgid / nig, fm = gid * WGM, gsz = (nM - fm) < WGM ? (nM - fm) : WGM;
        u.pm = fm + ((wgid % nig) % gsz); u.pn = (wgid % nig) / gsz; u.e = 0; u.r0 = 0; return true;
    }
    __device__ __forceinline__ const char* abase(const Unit& u, const Gemm& g, size_t tstep) const { return (const char*)g.A + (size_t)u.pm * tstep; }
    __device__ __forceinline__ const char* bbase(const Unit& u, const Gemm& g, size_t tstep) const { return (const char*)g.Bt + (size_t)u.pn * tstep; }
    static constexpr bool SIDE = false;
    __device__ __forceinline__ unsigned arow(const Unit&, int) const { return 0u; }
    __device__ __forceinline__ unsigned arow_side(const Unit&, int, const PG8_LAS unsigned char*) const { return 0u; }
    __device__ __forceinline__ const void* side_src(const Unit&, const Unit&, int, int) const { return nullptr; }
    __device__ __forceinline__ void a_ready(const Unit&) const {}
    __device__ __forceinline__ void done(const Unit&) const {}
};

struct MoeOrder {
    const PG8_LAS int* units;
    int nunits;
    const PG8_LAS int* cnt;
    const int* rowtok;
    int gather;
    unsigned rowbytes;
    size_t bstride;
    __device__ __forceinline__ bool next(int i, Unit& u) const {
        if (i >= nunits) return false;
        u.pm = __builtin_amdgcn_readfirstlane(units[4 * i + 0]); u.pn = __builtin_amdgcn_readfirstlane(units[4 * i + 1]);
        u.e = __builtin_amdgcn_readfirstlane(units[4 * i + 2]); u.r0 = __builtin_amdgcn_readfirstlane(units[4 * i + 3]); return true;
    }
    __device__ __forceinline__ const char* abase(const Unit& u, const Gemm& g, size_t tstep) const { return gather ? (const char*)g.A : (const char*)g.A + (size_t)u.pm * tstep; }
    __device__ __forceinline__ const char* bbase(const Unit& u, const Gemm& g, size_t tstep) const { return (const char*)g.Bt + (size_t)u.e * bstride + (size_t)u.pn * tstep; }
    static constexpr bool SIDE = true;
    const float* rowgate; const float* bgu;
    __device__ __forceinline__ unsigned arow(const Unit& u, int R) const {
        const int r = u.r0 + R; const int idx = (r < cnt[u.e]) ? rowtok[(size_t)u.e * 32768 + r] : 0; return (unsigned)(idx >> 2) * rowbytes; }
    __device__ __forceinline__ unsigned arow_side(const Unit& u, int R, const PG8_LAS unsigned char* sd) const {
        const int r = u.r0 + R; const int v = ((const PG8_LAS int*)sd)[R]; const int idx = (r < cnt[u.e]) ? v : 0; return (unsigned)(idx >> 2) * rowbytes; }
    __device__ __forceinline__ const void* side_src(const Unit& cur, const Unit& rt, int wid, int lane) const {
        if (rowgate != nullptr && wid == 1) return rowgate + (size_t)cur.e * 32768 + cur.r0 + 4 * lane;
        if (bgu != nullptr && wid == 2) return gather ? (bgu + (size_t)cur.e * 2048 + (lane < 32 ? 0 : 1024 - 128) + cur.pn * 128 + 4 * lane)
                                                      : (bgu + (size_t)cur.e * 1024 + cur.pn * 256 + 4 * lane);
        return rowtok + (size_t)rt.e * 32768 + rt.r0 + 4 * lane; }
    __device__ __forceinline__ void a_ready(const Unit&) const {}
    __device__ __forceinline__ void done(const Unit&) const {}
};
__device__ __forceinline__ void moe_build_units(PG8_LAS int* units, PG8_LAS int* units_n, const PG8_LAS int* tstart, int nN, int G, int c, int tid) {
    if (tid < 64) {
        const int nT = tstart[32], nwg = nT * nN; const long L = (long)tid * G + c;
        int pm = 0, pn = 0, e = 0, r0 = 0;
        if (L < nwg) {
            int wgid = (int)L; { const int q = nwg / NXCD, r = nwg % NXCD, xcd = wgid % NXCD, off = wgid / NXCD; wgid = (xcd < r ? xcd * (q + 1) : r * (q + 1) + (xcd - r) * q) + off; }
            const int nig = WGM * nN, gid = wgid / nig, fm = gid * WGM, gsz = (nT - fm) < WGM ? (nT - fm) : WGM;
            pm = fm + ((wgid % nig) % gsz); pn = (wgid % nig) / gsz;
            for (int j = 1; j < 32; ++j) e += (tstart[j] <= pm) ? 1 : 0;
            r0 = (pm - tstart[e]) * 256;
        }
        units[4 * tid + 0] = pm; units[4 * tid + 1] = pn; units[4 * tid + 2] = e; units[4 * tid + 3] = r0;
        if (tid == 0) { int n = 0; if (c < nwg) n = (nwg - c + G - 1) / G; units_n[0] = n < 64 ? n : 64; }
    }
}

__host__ __device__ __forceinline__ unsigned hblk_off(int R, int p7) { const int ai = R >> 7, wr = (R >> 6) & 1, m = (R >> 4) & 3, fr = R & 15, wc = p7 >> 1, fq = ((p7 & 1) << 1) | (m & 1), mp = m >> 1;
    return (unsigned)(((((ai * 2 + wr) * 4 + wc) * 2 + mp) * 64 + fr + 16 * fq) * 16); }
typedef int v8i_t __attribute__((ext_vector_type(8)));
typedef int v4i_t __attribute__((ext_vector_type(4)));
__device__ __forceinline__ v8i_t cat8(bf16x8 lo, bf16x8 hi) { const v4i_t a = __builtin_bit_cast(v4i_t, lo), b = __builtin_bit_cast(v4i_t, hi); return __builtin_shufflevector(a, b, 0, 1, 2, 3, 4, 5, 6, 7); }
__device__ __forceinline__ void mfma8(f32x4& acc, v8i_t a, v8i_t b, int scl) { asm volatile("v_mfma_scale_f32_16x16x128_f8f6f4 %0, %1, %2, %0, %3, %3 op_sel_hi:[0,0,0]" : "+v"(acc) : "v"(a), "v"(b), "v"(scl)); }
__device__ __forceinline__ unsigned pk4_fp8(float a, float b, float c, float d) { unsigned w = 0u; w = __builtin_amdgcn_cvt_pk_fp8_f32(a, b, w, false); w = __builtin_amdgcn_cvt_pk_fp8_f32(c, d, w, true); return w; }
__device__ __forceinline__ unsigned cvt_pk_bf16(float lo, float hi) { unsigned r; asm volatile("v_cvt_pk_bf16_f32 %0, %1, %2" : "=v"(r) : "v"(lo), "v"(hi)); return r; }

struct EpiProj {
    static constexpr bool PERM = true, AFTER_DRAIN = false;
    bf16_t* O; int ldc; const float* rope; float qscale; float dqv; int pn_off;
    __device__ __forceinline__ void operator()(const f32x4 (&acc)[2][2][4][2], const Unit& u, int wr, int wc, int fr, int fq, const PG8_LAS unsigned char* sd) const {
        const int pnn = u.pn + pn_off; const int row0 = u.pm * BM + wr * 64 + fr; const int col0 = pnn * BM + wc * 32 + 8 * fq;
        const bool rot = pnn < 4; const float sc = (pnn < 2 ? qscale : 1.f) * dqv; const int gq = 4 * (wc & 1) + fq;
        float invr[4];
#pragma unroll
        for (int e = 0; e < 4; ++e) invr[e] = __builtin_amdgcn_exp2f(-(float)(4 * gq + e) * 0.41524101186092029f) * 0.15915494309189535f;
#pragma unroll
        for (int ai = 0; ai < 2; ++ai)
#pragma unroll
            for (int m = 0; m < 4; ++m) { const int row = row0 + ai * HALF + m * 16; bf16_t* rowp = O + (size_t)row * ldc + col0;
                f32x4 cs0 = (f32x4){1.f, 0.f, 1.f, 0.f}, cs1 = cs0;
                if (rot) { const float tp = (float)(row & 4095);
                    const float a0 = __builtin_amdgcn_fractf(tp * invr[0]), a1 = __builtin_amdgcn_fractf(tp * invr[1]), a2 = __builtin_amdgcn_fractf(tp * invr[2]), a3 = __builtin_amdgcn_fractf(tp * invr[3]);
                    cs0 = (f32x4){__builtin_amdgcn_cosf(a0), __builtin_amdgcn_sinf(a0), __builtin_amdgcn_cosf(a1), __builtin_amdgcn_sinf(a1)};
                    cs1 = (f32x4){__builtin_amdgcn_cosf(a2), __builtin_amdgcn_sinf(a2), __builtin_amdgcn_cosf(a3), __builtin_amdgcn_sinf(a3)}; }
#pragma unroll
                for (int bj = 0; bj < 2; ++bj) { f32x4 v0 = acc[ai][bj][m][0], v1 = acc[ai][bj][m][1];
                    if (rot) { f32x4 lo, hi;
                        lo[0] = v0[0] * cs0[0] - v1[0] * cs0[1]; hi[0] = v1[0] * cs0[0] + v0[0] * cs0[1];
                        lo[1] = v0[1] * cs0[2] - v1[1] * cs0[3]; hi[1] = v1[1] * cs0[2] + v0[1] * cs0[3];
                        lo[2] = v0[2] * cs1[0] - v1[2] * cs1[1]; hi[2] = v1[2] * cs1[0] + v0[2] * cs1[1];
                        lo[3] = v0[3] * cs1[2] - v1[3] * cs1[3]; hi[3] = v1[3] * cs1[2] + v0[3] * cs1[3];
                        v0 = lo * sc; v1 = hi * sc; }
                    else { v0 = v0 * dqv; v1 = v1 * dqv; }
                    u32x4 w; w.x = cvt_pk_bf16(v0[0], v0[1]); w.y = cvt_pk_bf16(v0[2], v0[3]); w.z = cvt_pk_bf16(v1[0], v1[1]); w.w = cvt_pk_bf16(v1[2], v1[3]);
                    *(u32x4*)(rowp + bj * HALF) = w; } }
    }
};
struct EpiF32 {
    static constexpr bool PERM = false, AFTER_DRAIN = false;
    float* O; int ldc;
    __device__ __forceinline__ void operator()(const f32x4 (&acc)[2][2][4][2], const Unit& u, int wr, int wc, int fr, int fq, const PG8_LAS unsigned char* sd) const {
        const int row0 = u.pm * BM + wr * 64 + fr; const int col0 = u.pn * BM + wc * 32 + 4 * fq;
#pragma unroll
        for (int ai = 0; ai < 2; ++ai)
#pragma unroll
            for (int m = 0; m < 4; ++m) { float* rowp = O + (size_t)(row0 + ai * HALF + m * 16) * ldc + col0;
#pragma unroll
                for (int bj = 0; bj < 2; ++bj)
#pragma unroll
                    for (int n = 0; n < 2; ++n) *(f32x4*)(rowp + bj * HALF + n * 16) = acc[ai][bj][m][n]; }
    }
};
struct EpiBf16Plain {
    static constexpr bool PERM = true, AFTER_DRAIN = false;
    bf16_t* O; int ldc;
    __device__ __forceinline__ void operator()(const f32x4 (&acc)[2][2][4][2], const Unit& u, int wr, int wc, int fr, int fq, const PG8_LAS unsigned char* sd) const {
        const int row0 = u.pm * BM + wr * 64 + fr; const int col0 = u.pn * BM + wc * 32 + 8 * fq;
#pragma unroll
        for (int ai = 0; ai < 2; ++ai)
#pragma unroll
            for (int m = 0; m < 4; ++m) { bf16_t* rowp = O + (size_t)(row0 + ai * HALF + m * 16) * ldc + col0;
#pragma unroll
                for (int bj = 0; bj < 2; ++bj) { const f32x4 v0 = acc[ai][bj][m][0], v1 = acc[ai][bj][m][1];
                    u32x4 w; w.x = cvt_pk_bf16(v0[0], v0[1]); w.y = cvt_pk_bf16(v0[2], v0[3]); w.z = cvt_pk_bf16(v1[0], v1[1]); w.w = cvt_pk_bf16(v1[2], v1[3]);
                    *(u32x4*)(rowp + bj * HALF) = w; } }
    }
};
struct EpiSwiglu {
    static constexpr bool PERM = true, AFTER_DRAIN = false;
    unsigned char* H; const float* bgu; const float* rowgate; const PG8_LAS int* cnt; float dq, hscale;
    __device__ __forceinline__ void operator()(const f32x4 (&acc)[2][2][4][2], const Unit& u, int wr, int wc, int fr, int fq, const PG8_LAS unsigned char* sd) const {
        const int ff = u.pn * HALF + wc * 32 + 8 * fq; const int n_e = cnt[u.e];
        f32x4 bg[2], bu[2];
#pragma unroll
        for (int n = 0; n < 2; ++n) { bg[n] = *(const PG8_LAS f32x4*)(sd + 2048 + (wc * 32 + 8 * fq + 4 * n) * 4); bu[n] = *(const PG8_LAS f32x4*)(sd + 2048 + 512 + (wc * 32 + 8 * fq + 4 * n) * 4); }
        const int lane = fr + 16 * fq;
#pragma unroll
        for (int ai = 0; ai < 2; ++ai)
#pragma unroll
            for (int mp = 0; mp < 2; ++mp) {
                unsigned pw[2][2];
#pragma unroll
                for (int mm = 0; mm < 2; ++mm) { const int m = 2 * mp + mm; const int r = ai * HALF + wr * 64 + m * 16 + fr; const int er = u.r0 + r;
                    const float rgl = ((const PG8_LAS float*)(sd + 1024))[r]; const float rg = ((er < n_e) ? rgl : 0.f) * hscale;
                    float hv[8];
#pragma unroll
                    for (int n = 0; n < 2; ++n)
#pragma unroll
                        for (int q = 0; q < 4; q += 2) {
                            f32x2 g = (f32x2){acc[ai][0][m][n][q], acc[ai][0][m][n][q + 1]} * dq + (f32x2){bg[n][q], bg[n][q + 1]};
                            f32x2 up = (f32x2){acc[ai][1][m][n][q], acc[ai][1][m][n][q + 1]} * dq + (f32x2){bu[n][q], bu[n][q + 1]};
                            g.x = fminf(g.x, 7.0f); g.y = fminf(g.y, 7.0f); up.x = fminf(fmaxf(up.x, -7.0f), 7.0f); up.y = fminf(fmaxf(up.y, -7.0f), 7.0f);
                            const f32x2 ea = g * (-1.702f * 1.4426950408889634f); f32x2 den; den.x = __builtin_amdgcn_exp2f(ea.x); den.y = __builtin_amdgcn_exp2f(ea.y); den = den + 1.0f;
                            f32x2 sg; sg.x = __builtin_amdgcn_rcpf(den.x); sg.y = __builtin_amdgcn_rcpf(den.y);
                            const f32x2 h2 = ((up + 1.0f) * g) * (sg * rg);
                            hv[n * 4 + q] = h2.x; hv[n * 4 + q + 1] = h2.y; }
                    pw[mm][0] = pk4_fp8(hv[0], hv[1], hv[2], hv[3]); pw[mm][1] = pk4_fp8(hv[4], hv[5], hv[6], hv[7]); }
                const auto s0 = __builtin_amdgcn_permlane16_swap(pw[0][0], pw[1][0], false, false); const auto s1 = __builtin_amdgcn_permlane16_swap(pw[0][1], pw[1][1], false, false);
                *(u32x4*)(H + ((size_t)u.pm * 8 + u.pn) * 32768 + ((((ai * 2 + wr) * 4 + wc) * 2 + mp) * 64 + lane) * 16) = (u32x4){s0[0], s1[0], s0[1], s1[1]};
                asm volatile("" ::: "memory"); }
    }
};
struct EpiScatter {
    static constexpr bool PERM = true, AFTER_DRAIN = false;
    unsigned char* Y; const int* rowtok; const PG8_LAS int* cnt; float dq, ysc;
    __device__ __forceinline__ void operator()(const f32x4 (&acc)[2][2][4][2], const Unit& u, int wr, int wc, int fr, int fq, const PG8_LAS unsigned char* sd) const {
        const int col0 = u.pn * BM + wc * 32 + 8 * fq; const int n_e = cnt[u.e];
        f32x4 bd[2][2];
#pragma unroll
        for (int bj = 0; bj < 2; ++bj)
#pragma unroll
            for (int n = 0; n < 2; ++n) bd[bj][n] = *(const PG8_LAS f32x4*)(sd + 2048 + (bj * HALF + wc * 32 + 8 * fq + 4 * n) * 4);
#pragma unroll
        for (int ai = 0; ai < 2; ++ai)
#pragma unroll
            for (int m = 0; m < 4; ++m) { const int er = u.r0 + ai * HALF + wr * 64 + m * 16 + fr;
                const int idx = ((const PG8_LAS int*)sd)[ai * HALF + wr * 64 + m * 16 + fr];
                if (er < n_e) { unsigned char* rowp = Y + (size_t)idx * 1024 + col0;
                    typedef unsigned u32x2 __attribute__((ext_vector_type(2)));
                    const float rg = ((const PG8_LAS float*)(sd + 1024))[ai * HALF + wr * 64 + m * 16 + fr] * ysc;
#pragma unroll
                    for (int bj = 0; bj < 2; ++bj) { const f32x4 v0 = acc[ai][bj][m][0] * dq + bd[bj][0] * rg, v1 = acc[ai][bj][m][1] * dq + bd[bj][1] * rg;
                        *(u32x2*)(rowp + bj * HALF) = (u32x2){pk4_fp8(v0[0], v0[1], v0[2], v0[3]), pk4_fp8(v1[0], v1[1], v1[2], v1[3])}; } }
                asm volatile("" ::: "memory"); }
    }
};

struct PanelStats {
    unsigned* xbuf;
    unsigned* cnt;
    unsigned* tmo;
    int ntn; float eps;
    unsigned code;
    __device__ __forceinline__ bool run(const f32x4 (&v)[2][2][4][2], const Unit& u, int wr, int wc, int fr, int fq, PG8_LAS unsigned char* lds, int wid, int lane) const {
        typedef float f32x2v __attribute__((ext_vector_type(2)));
        PG8_LAS f32x2v* P = (PG8_LAS f32x2v*)lds;
        PG8_LAS f32x2v* S = (PG8_LAS f32x2v*)(lds + 8192);
        PG8_LAS unsigned* flag = (PG8_LAS unsigned*)(lds + 8192 + 2048);
#pragma unroll
        for (int ai = 0; ai < 2; ++ai)
#pragma unroll
            for (int m = 0; m < 4; ++m) {
                float s = 0.f;
#pragma unroll
                for (int bj = 0; bj < 2; ++bj)
#pragma unroll
                    for (int n = 0; n < 2; ++n) { const f32x4 x = v[ai][bj][m][n]; s += (x[0] + x[1]) + (x[2] + x[3]); }
                s += __shfl_xor(s, 16); s += __shfl_xor(s, 32);
                const float mw = s * (1.0f / 64.0f); float q = 0.f;
#pragma unroll
                for (int bj = 0; bj < 2; ++bj)
#pragma unroll
                    for (int n = 0; n < 2; ++n) { const f32x4 d = v[ai][bj][m][n] - mw; q += (d[0] * d[0] + d[1] * d[1]) + (d[2] * d[2] + d[3] * d[3]); }
                q += __shfl_xor(q, 16); q += __shfl_xor(q, 32);
                if (fq == 0) P[(ai * HALF + wr * 64 + m * 16 + fr) * 4 + wc] = (f32x2v){mw, q};
            }
        asm volatile("s_waitcnt lgkmcnt(0)" ::: "memory"); __builtin_amdgcn_s_barrier(); asm volatile("" ::: "memory");
#if defined(BROKEN_EXCHANGE_NO_WAIT)
#warning BROKEN CONTROL BUILD: the row-statistics exchange does not wait; results are wrong by design
        if (blockIdx.x >= 64) { const long long t0_ = clock64(); while (clock64() - t0_ < 60000) __builtin_amdgcn_s_sleep(8); }
#endif
        const int row = wid * 32 + (lane & 31);
        if (lane < 32) {
            const f32x2v a = P[row * 4 + 0], b = P[row * 4 + 1], c = P[row * 4 + 2], d = P[row * 4 + 3];
            const float mt = (a.x + b.x + c.x + d.x) * 0.25f;
            const float da = a.x - mt, db = b.x - mt, dc = c.x - mt, dd = d.x - mt;
            const float m2 = (a.y + b.y) + (c.y + d.y) + 64.0f * ((da * da + db * db) + (dc * dc + dd * dd));
            unsigned long long* slot = (unsigned long long*)xbuf + ((size_t)(u.pm * BM + row) * 4 + u.pn);
            __hip_atomic_store(slot, ((unsigned long long)__float_as_uint(m2) << 32) | __float_as_uint(mt), __ATOMIC_RELAXED, __HIP_MEMORY_SCOPE_AGENT);
        }
        asm volatile("s_waitcnt vmcnt(0)" ::: "memory");
        if (lane == 0) __hip_atomic_fetch_add(cnt + 64 * u.pm, 1u, __ATOMIC_RELAXED, __HIP_MEMORY_SCOPE_AGENT);
        if (wid == 0) {
            const unsigned want = 8u * (unsigned)ntn; unsigned sp = 0u;
            while ((unsigned)__builtin_amdgcn_readfirstlane(__hip_atomic_load(cnt + 64 * u.pm, __ATOMIC_RELAXED, __HIP_MEMORY_SCOPE_AGENT)) < want) { __builtin_amdgcn_s_sleep(2); if (++sp > (1u << 20)) break; }
            __builtin_amdgcn_fence(__ATOMIC_ACQUIRE, "agent");
        }
        asm volatile("s_waitcnt vmcnt(0) lgkmcnt(0)" ::: "memory"); __builtin_amdgcn_s_barrier(); asm volatile("" ::: "memory");
        const bool bad = false;
        if (lane < 32) {
            const unsigned long long* slot = (const unsigned long long*)xbuf + (size_t)(u.pm * BM + row) * 4; float mt[4], m2[4]; float ms = 0.f;
#pragma unroll
            for (int t = 0; t < 4; ++t) { if (t < ntn) { const unsigned long long w = __hip_atomic_load(slot + t, __ATOMIC_RELAXED, __HIP_MEMORY_SCOPE_AGENT); mt[t] = __uint_as_float((unsigned)w); m2[t] = __uint_as_float((unsigned)(w >> 32)); } else { mt[t] = 0.f; m2[t] = 0.f; } ms += mt[t]; }
            const float mean = ms / (float)ntn; float q = 0.f;
#pragma unroll
            for (int t = 0; t < 4; ++t) if (t < ntn) { const float dm = mt[t] - mean; q += m2[t] + 256.0f * dm * dm; }
            S[row] = (f32x2v){mean, 1.0f / sqrtf(q / (256.0f * (float)ntn) + eps)};
        }
        asm volatile("s_waitcnt lgkmcnt(0)" ::: "memory"); __builtin_amdgcn_s_barrier(); asm volatile("" ::: "memory");
        return bad;
    }
};

struct EpiLn1 {
    static constexpr bool PERM = true, AFTER_DRAIN = true;
    unsigned char* ws; const float* gam; const float* bet; size_t o_xb, o_x8, o_xbuf, o_cnt, o_tmo; float alpha, s8, eps; unsigned code;
    __device__ __forceinline__ void operator()(const f32x4 (&)[2][2][4][2], const Unit&, int, int, int, int, const PG8_LAS unsigned char*) const {}
    __device__ __forceinline__ void fused(f32x4 (&acc)[2][2][4][2], const Unit& u, int wr, int wc, int fr, int fq, PG8_LAS unsigned char* lds, int wid, int lane) const {
        typedef float f32x2v __attribute__((ext_vector_type(2))); typedef unsigned u32x2 __attribute__((ext_vector_type(2)));
        bf16_t* const XBp = (bf16_t*)(ws + o_xb); unsigned char* const X8 = ws + o_x8;
        const PanelStats st{(unsigned*)(ws + o_xbuf), (unsigned*)(ws + o_cnt), (unsigned*)(ws + o_tmo), 4, eps, code};
        const int col0 = u.pn * BM + wc * 32 + 8 * fq;
#pragma unroll
        for (int ai = 0; ai < 2; ++ai)
#pragma unroll
            for (int m = 0; m < 4; ++m) { const bf16_t* xr = XBp + (size_t)(u.pm * BM + ai * HALF + wr * 64 + m * 16 + fr) * 1024 + col0;
#pragma unroll
                for (int bj = 0; bj < 2; ++bj) { const u32x4 x = *(const u32x4*)(xr + bj * HALF);
                    acc[ai][bj][m][0] += (f32x4){__builtin_bit_cast(float, x.x << 16), __builtin_bit_cast(float, x.x & 0xffff0000u), __builtin_bit_cast(float, x.y << 16), __builtin_bit_cast(float, x.y & 0xffff0000u)} * alpha;
                    acc[ai][bj][m][1] += (f32x4){__builtin_bit_cast(float, x.z << 16), __builtin_bit_cast(float, x.z & 0xffff0000u), __builtin_bit_cast(float, x.w << 16), __builtin_bit_cast(float, x.w & 0xffff0000u)} * alpha; }
                asm volatile("" ::: "memory"); }
        (void)st.run(acc, u, wr, wc, fr, fq, lds, wid, lane);
        const PG8_LAS f32x2v* S = (const PG8_LAS f32x2v*)(lds + 8192);
#pragma unroll
        for (int bj = 0; bj < 2; ++bj) {
            const f32x4 g0 = *(const f32x4*)(gam + col0 + bj * HALF), g1 = *(const f32x4*)(gam + col0 + bj * HALF + 4), b0 = *(const f32x4*)(bet + col0 + bj * HALF), b1 = *(const f32x4*)(bet + col0 + bj * HALF + 4);
#pragma unroll
            for (int ai = 0; ai < 2; ++ai)
#pragma unroll
                for (int m = 0; m < 4; ++m) { const int r = ai * HALF + wr * 64 + m * 16 + fr; const f32x2v sr = S[r]; const size_t off = (size_t)(u.pm * BM + r) * 1024 + col0 + bj * HALF;
                    const f32x4 o0 = (acc[ai][bj][m][0] - sr.x) * sr.y * g0 + b0, o1 = (acc[ai][bj][m][1] - sr.x) * sr.y * g1 + b1;
                    u32x4 w; w.x = cvt_pk_bf16(o0[0], o0[1]); w.y = cvt_pk_bf16(o0[2], o0[3]); w.z = cvt_pk_bf16(o1[0], o1[1]); w.w = cvt_pk_bf16(o1[2], o1[3]);
                    *(u32x4*)(XBp + off) = w;
                    *(u32x2*)(X8 + off) = (u32x2){pk4_fp8(o0[0] * s8, o0[1] * s8, o0[2] * s8, o0[3] * s8), pk4_fp8(o1[0] * s8, o1[1] * s8, o1[2] * s8, o1[3] * s8)};
                    asm volatile("" ::: "memory"); } }
    }
};

template <class Epi, class Sched, bool ALIGN_EPI, bool GATHER, bool FP8 = false, bool ABLK = false>
__device__ __forceinline__ void gemm_phase(PG8_LAS unsigned char* lds, const Gemm g, const Sched& S, const Epi& E) {
    const int tid = threadIdx.x, wid = __builtin_amdgcn_readfirstlane(tid >> 6), lane = tid & 63, wr = wid >> 2, wc = wid & 3, fr = lane & 15, fq = lane >> 4;
    const int K = g.K, nt = K / BK;
    unsigned voffB[2];
#pragma unroll
    for (int i = 0; i < 2; ++i) { int R, C; stage_rc(tid * 16 + i * 8192, R, C); const int Rb = Epi::PERM ? ((R & ~31) + perm32(R & 31)) : R;
        voffB[i] = (unsigned)(Rb * K + C) * 2u; }
    constexpr int SIDE_BYTES = 8192;
    PG8_LAS unsigned char* const side = lds + STAGE_BYTES;
    const size_t kstep = (size_t)(BK * 2);
    const size_t kstepA = ABLK ? (size_t)32768 : kstep;
    const size_t hstep = (size_t)HALF * K * 2;
    const size_t tstep = 2 * hstep;
    const unsigned ldsw = (unsigned)wid * 1024u;
    const int aoff = lds_byte(wr * 64 + fr, fq * 8), boff = lds_byte(wc * 32 + fr, fq * 8);
#define PG8_SA(b, h) (((b) * 2 + (h)) * HTB)
#define PG8_SB(b, h) ((4 + (b) * 2 + (h)) * HTB)
#define PG8_STAGE(bufoff, gbase, voff) do { _Pragma("unroll") for (int _i = 0; _i < 2; ++_i) \
        __builtin_amdgcn_global_load_lds((const unsigned*)((const char*)(gbase) + (voff)[_i]), (PG8_LAS unsigned*)(lds + (bufoff) + ldsw + _i * 8192), 16, 0, 0); } while (0)
#define PG8_LDA(dst, b, h) do { _Pragma("unroll") for (int m = 0; m < 4; ++m) _Pragma("unroll") for (int k = 0; k < 2; ++k) dst[m][k] = *(const PG8_LAS bf16x8*)(lds + PG8_SA(b, h) + aoff + m * 2048 + k * 1024); } while (0)
#define PG8_LDB(dst, b, h) do { _Pragma("unroll") for (int n = 0; n < 2; ++n) _Pragma("unroll") for (int k = 0; k < 2; ++k) dst[n][k] = *(const PG8_LAS bf16x8*)(lds + PG8_SB(b, h) + boff + n * 2048 + k * 1024); } while (0)
#define PG8_MMA(ai, bj, At, Bt) do { __builtin_amdgcn_s_setprio(1); _Pragma("unroll") for (int m = 0; m < 4; ++m) _Pragma("unroll") for (int n = 0; n < 2; ++n) { \
        if constexpr (FP8) mfma8(acc[ai][bj][m][n], cat8(Bt[n][0], Bt[n][1]), cat8(At[m][0], At[m][1]), scl8); \
        else { _Pragma("unroll") for (int k = 0; k < 2; ++k) acc[ai][bj][m][n] = __builtin_amdgcn_mfma_f32_16x16x32_bf16(Bt[n][k], At[m][k], acc[ai][bj][m][n], 0, 0, 0); } } __builtin_amdgcn_s_setprio(0); } while (0)
#define PG8_WAIT_V(n) asm volatile("s_waitcnt vmcnt(" #n ")" ::: "memory")
#define PG8_WAIT_L(n) asm volatile("s_waitcnt lgkmcnt(" #n ")" ::: "memory")
#define PG8_BAR __builtin_amdgcn_s_barrier()
#define PG8_SCHED __builtin_amdgcn_sched_barrier(0)
#define PG8_SETOFFS(o, u) do { _Pragma("unroll") for (int _h = 0; _h < 2; ++_h) _Pragma("unroll") for (int _i = 0; _i < 2; ++_i) { int _R, _C; stage_rc(tid * 16 + _i * 8192, _R, _C); \
        o[_h][_i] = GATHER ? (S.arow(u, _R + HALF * _h) + (unsigned)(_C * 2)) : ABLK ? hblk_off(_R + HALF * _h, _C >> 3) : ((unsigned)((_R + HALF * _h) * K) * 2u + (unsigned)(_C * 2)); } } while (0)
    int scl8 = 0x7F7F7F7F; asm volatile("" : "+v"(scl8));
    Unit cur, nxt; int ui = 0;
    if (!S.next(0, cur)) return;
    f32x4 acc[2][2][4][2];
#pragma unroll
    for (int a = 0; a < 2; ++a)
#pragma unroll
        for (int b = 0; b < 2; ++b)
#pragma unroll
            for (int m = 0; m < 4; ++m)
#pragma unroll
                for (int n = 0; n < 2; ++n) { acc[a][b][m][n] = (f32x4){0.f, 0.f, 0.f, 0.f}; if constexpr (FP8) asm volatile("" : "+v"(acc[a][b][m][n])); }
    bf16x8 At[4][2], B0[2][2], B1[2][2];
    unsigned cAo[2][2];
    PG8_SETOFFS(cAo, cur);
    const char* cA = S.abase(cur, g, tstep); const char* cB = S.bbase(cur, g, tstep);
    S.a_ready(cur);
    PG8_STAGE(PG8_SB(0, 0), cB, voffB); PG8_STAGE(PG8_SB(0, 1), cB + hstep, voffB); PG8_STAGE(PG8_SA(0, 0), cA, cAo[0]); PG8_STAGE(PG8_SA(0, 1), cA, cAo[1]);
    if (wr == 1) PG8_BAR;
    PG8_WAIT_V(2); PG8_BAR;
    PG8_STAGE(PG8_SB(1, 0), cB + kstep, voffB); PG8_STAGE(PG8_SA(1, 0), cA + kstepA, cAo[0]); PG8_STAGE(PG8_SB(1, 1), cB + hstep + kstep, voffB);
    PG8_WAIT_V(6); PG8_BAR;
    for (;;) {
        const bool has_next = S.next(ui + 1, nxt);
        const char* nA = has_next ? S.abase(nxt, g, tstep) : cA; const char* nB = has_next ? S.bbase(nxt, g, tstep) : cB;
        if constexpr (Sched::SIDE) {
            const void* ssrc = S.side_src(cur, (GATHER && has_next) ? nxt : cur, wid, lane);
            __builtin_amdgcn_global_load_lds((const unsigned*)ssrc, (PG8_LAS unsigned*)(side + (ui & 1) * SIDE_BYTES + wid * 1024), 16, 0, 0); }
#pragma unroll 1
        for (int t = 0; t < nt; t += 2) {
            const bool last = (t == nt - 2);
            const char* a1 = cA + (size_t)(t + 1) * kstepA;
            const char* a2 = last ? nA : cA + (size_t)(t + 2) * kstepA; const char* b2 = last ? nB : cB + (size_t)(t + 2) * kstep;
            const char* a3 = a2 + kstepA; const char* b3 = b2 + kstep;
            if (last && has_next) S.a_ready(nxt);
            PG8_LDB(B0, 0, 0); PG8_LDB(B1, 0, 1); PG8_SCHED; PG8_LDA(At, 0, 0); PG8_STAGE(PG8_SA(1, 1), a1, cAo[1]);
            if constexpr (GATHER) { if (last && has_next) {
                const PG8_LAS unsigned char* sdn = side + (ui & 1) * SIDE_BYTES;
#pragma unroll
                for (int _h = 0; _h < 2; ++_h)
#pragma unroll
                    for (int _i = 0; _i < 2; ++_i) { int _R, _C; stage_rc(tid * 16 + _i * 8192, _R, _C); cAo[_h][_i] = S.arow_side(nxt, _R + HALF * _h, sdn) + (unsigned)(_C * 2); } } }
            PG8_WAIT_V(8); PG8_WAIT_L(0); PG8_BAR; PG8_MMA(0, 0, At, B0); PG8_MMA(0, 1, At, B1); PG8_BAR; PG8_SCHED;
            PG8_LDA(At, 0, 1); PG8_STAGE(PG8_SB(0, 0), b2, voffB); PG8_STAGE(PG8_SB(0, 1), b2 + hstep, voffB); PG8_STAGE(PG8_SA(0, 0), a2, cAo[0]);
            PG8_WAIT_V(8); PG8_WAIT_L(0); PG8_BAR; PG8_MMA(1, 0, At, B0); PG8_MMA(1, 1, At, B1); PG8_BAR; PG8_SCHED;
            PG8_LDB(B0, 1, 0); PG8_LDB(B1, 1, 1); PG8_SCHED; PG8_LDA(At, 1, 0); PG8_STAGE(PG8_SA(0, 1), a2, cAo[1]);
            PG8_WAIT_V(8); PG8_WAIT_L(0); PG8_BAR; PG8_MMA(0, 0, At, B0); PG8_MMA(0, 1, At, B1); PG8_BAR; PG8_SCHED;
            PG8_LDA(At, 1, 1); PG8_STAGE(PG8_SB(1, 0), b3, voffB); PG8_STAGE(PG8_SB(1, 1), b3 + hstep, voffB); PG8_STAGE(PG8_SA(1, 0), a3, cAo[0]);
            PG8_WAIT_V(8); PG8_WAIT_L(0); PG8_BAR; PG8_MMA(1, 0, At, B0); PG8_MMA(1, 1, At, B1); PG8_BAR; PG8_SCHED;
        }
        if constexpr (ALIGN_EPI) { if (wr == 0) PG8_BAR; }
        if constexpr (FP8) asm volatile("s_nop 15\n\ts_nop 15" ::: "memory");
        if constexpr (!Epi::AFTER_DRAIN) { PG8_SCHED; E(acc, cur, wr, wc, fr, fq, side + (ui & 1) * SIDE_BYTES); S.done(cur); PG8_SCHED; }
        if (!has_next) break;
#pragma unroll
        for (int a = 0; a < 2; ++a)
#pragma unroll
            for (int b = 0; b < 2; ++b)
#pragma unroll
                for (int m = 0; m < 4; ++m)
#pragma unroll
                    for (int n = 0; n < 2; ++n) { acc[a][b][m][n] = (f32x4){0.f, 0.f, 0.f, 0.f}; if constexpr (FP8) asm volatile("" : "+v"(acc[a][b][m][n])); }
        cur = nxt; cA = nA; cB = nB; ++ui;
        if constexpr (ALIGN_EPI) { if (wr == 1) PG8_BAR; }
    }
    PG8_WAIT_V(0);
    if constexpr (!ALIGN_EPI) { if (wr == 0) PG8_BAR; }
    PG8_BAR;
    if constexpr (Epi::AFTER_DRAIN) { E.fused(acc, cur, wr, wc, fr, fq, lds, wid, lane); S.done(cur); }
#undef PG8_SA
#undef PG8_SB
#undef PG8_STAGE
#undef PG8_LDA
#undef PG8_LDB
#undef PG8_MMA
#undef PG8_WAIT_V
#undef PG8_WAIT_L
#undef PG8_BAR
#undef PG8_SCHED
#undef PG8_SETOFFS
}
}

constexpr int NB = 8, SEQ = 4096, DM = 1024, MROWS = NB * SEQ, NLAYER = 2;
constexpr int NPROJ = 4608, INW = 4616;
constexpr int C_Q = 0, C_K = 512, C_V = 1024, C_Z = 1536, C_XS = 2048, C_SB = 3072, C_SC = 3584, C_SH = 4096;
constexpr int MIXW = 1536, NEXP = 32, TOPK = 4, FF = 1024;
constexpr float ALPHA = 1.4142135623730951f;
constexpr float LN_EPS = 1e-5f, RMS_EPS = 1e-5f;
constexpr float QSCALE = 0.125f * 1.4426950408889634f;

constexpr size_t MiB = 1u << 20;
constexpr size_t WS_CTL = 0, CTL_ZERO_BYTES = 1 * MiB;
constexpr size_t WS_ROPE = 1 * MiB;
constexpr size_t WS_WDT = 2 * MiB;
constexpr size_t WS_ROUT = 2 * MiB + 65536;
constexpr size_t WS_WIN = 4 * MiB;
constexpr size_t WS_WOUT = 24 * MiB;
constexpr size_t WS_WGU = 32 * MiB;
constexpr size_t WS_WDN = 288 * MiB;
constexpr size_t WS_XB = 416 * MiB;
constexpr size_t WS_XF = 480 * MiB;
constexpr size_t WS_XF2 = 608 * MiB;
constexpr size_t WS_PROJ = 736 * MiB;
constexpr size_t WS_DT = 1024 * MiB;
constexpr size_t WS_DTS = 1025 * MiB;
constexpr size_t WS_ACUM = 1026 * MiB;
constexpr size_t WS_LSE = 1027 * MiB;
constexpr size_t WS_OP = 1030 * MiB;
constexpr size_t WS_U = 1126 * MiB;
constexpr size_t WS_G = 1190 * MiB;
constexpr size_t WS_ST = 1222 * MiB;
constexpr size_t WS_YD = 1286 * MiB;
constexpr size_t WS_MIXED = 1350 * MiB;
constexpr size_t WS_MIXF = 1446 * MiB;
constexpr size_t WS_TOPE = 1574 * MiB;
constexpr size_t WS_TOPG = 1575 * MiB;
constexpr size_t WS_ROWTOK = 1576 * MiB;
constexpr size_t WS_ROWGATE = 1580 * MiB;
constexpr size_t WS_H = 736 * MiB;
constexpr size_t WS_YB = 1030 * MiB;
constexpr size_t WS_END = 1584 * MiB;
constexpr int CW_TMO = 0;
constexpr int CW_CNT = 64;
constexpr int CW_BAR = 4096;
constexpr int CW_SEAM = 16384;

constexpr int RING_OFF = 0, RING_BYTES = 131072;
constexpr int LDSCTL_OFF = 155648;
constexpr int L_MISC = LDSCTL_OFF;
constexpr int L_TSTART = LDSCTL_OFF + 256;
constexpr int L_CNT = LDSCTL_OFF + 512;
constexpr int L_LCNT = LDSCTL_OFF + 640;
constexpr int L_LBASE = LDSCTL_OFF + 768;
constexpr int L_UNITS = LDSCTL_OFF + 1024;
constexpr int L_UNITSN = LDSCTL_OFF + 2048;
constexpr int LDS_BYTES = 163840;

#define GAS __attribute__((address_space(1)))
#define LAS __attribute__((address_space(3)))
typedef unsigned short bf16;
typedef unsigned v4u __attribute__((ext_vector_type(4)));
typedef unsigned v2u __attribute__((ext_vector_type(2)));
typedef float f32x4 __attribute__((ext_vector_type(4)));
typedef float f32x16 __attribute__((ext_vector_type(16)));
typedef short bf16x8 __attribute__((ext_vector_type(8)));
typedef GAS unsigned gu32;
#define RLX_AGENT __ATOMIC_RELAXED, __HIP_MEMORY_SCOPE_AGENT
#define LDS_WAIT() asm volatile("s_waitcnt lgkmcnt(0)" ::: "memory")
#define VM_WAIT() asm volatile("s_waitcnt vmcnt(0)" ::: "memory")
__device__ __forceinline__ unsigned f2bf(float f) { unsigned u = __builtin_bit_cast(unsigned, f); return (u + 0x7fffu + ((u >> 16) & 1u)) >> 16; }
__device__ __forceinline__ unsigned pk2(float lo, float hi) { unsigned r; asm volatile("v_cvt_pk_bf16_f32 %0, %1, %2" : "=v"(r) : "v"(lo), "v"(hi)); return r; }
__device__ __forceinline__ float bf2f(unsigned short b) { return __builtin_bit_cast(float, (unsigned)b << 16); }
__device__ __forceinline__ float bflo(unsigned w) { return __builtin_bit_cast(float, w << 16); }
__device__ __forceinline__ float bfhi(unsigned w) { return __builtin_bit_cast(float, w & 0xffff0000u); }
__device__ __forceinline__ float siluf(float x) { return x * __builtin_amdgcn_rcpf(1.0f + __builtin_amdgcn_exp2f(-1.4426950408889634f * x)); }
#define XB_TMO      128
#define XB_XCNT(j)  (256  + 64 * (j))
#define XB_XSUB(j)  (1280 + 64 * (j))
#define XB_XGEN(j)  (2304 + 64 * (j))
#define XB_TOP      3328
#define XB_TOPGEN   3392
#define XCD_BAR_WORDS 3456
#define XB_SPIN_CAP (1u << 18)

__device__ __forceinline__ unsigned xb_ld(unsigned* p)              { return __hip_atomic_load(p, __ATOMIC_RELAXED, __HIP_MEMORY_SCOPE_AGENT); }
__device__ __forceinline__ unsigned xb_add(unsigned* p, unsigned v) { return __hip_atomic_fetch_add(p, v, __ATOMIC_RELAXED, __HIP_MEMORY_SCOPE_AGENT); }
__device__ __forceinline__ unsigned xb_xcc_id() { return (unsigned)__builtin_amdgcn_s_getreg((3 << 11) | 20) & 0xFu; }
#define XB_SPIN(cond, bar) do { unsigned _sp = 0; while (cond) { __builtin_amdgcn_s_sleep(1); \
    if ((++_sp & 255u) == 0u) { if (xb_ld(&(bar)[XB_TMO])) break; if (_sp > XB_SPIN_CAP) { atomicAdd(&(bar)[XB_TMO], 1u); break; } } } } while (0)

struct XcdBarrier {
    unsigned* bar; unsigned x;
    volatile LAS unsigned* st;
};

__device__ __forceinline__ XcdBarrier xcd_barrier_post(unsigned* bar, volatile LAS unsigned* st) {
    XcdBarrier b; b.bar = bar; b.x = xb_xcc_id(); b.st = st;
    if (threadIdx.x == 0) (void)xb_add(&bar[XB_XCNT(b.x)], 1u);
    return b;
}
__device__ __forceinline__ void xcd_barrier_complete(unsigned* bar, unsigned x, unsigned& nloc, unsigned& nx) {
    const unsigned G = gridDim.x * gridDim.y * gridDim.z;
    unsigned sum, cnt, mine, sp = 0u;
    for (;;) {
        sum = 0u; cnt = 0u; mine = 0u;
#pragma unroll
        for (unsigned j = 0; j < 16; ++j) { const unsigned c = xb_ld(&bar[XB_XCNT(j)]); sum += c; cnt += (c > 0u) ? 1u : 0u; mine = (j == x) ? c : mine; }
        if (sum == G) break;
        __builtin_amdgcn_s_sleep(1);
        if ((++sp & 255u) == 0u) { if (xb_ld(&bar[XB_TMO])) break; if (sp > XB_SPIN_CAP) { atomicAdd(&bar[XB_TMO], 1u); break; } }
    }
    nloc = mine > 0u ? mine : 1u; nx = cnt > 0u ? cnt : 1u;
}

__device__ __forceinline__ void xcd_barrier(const XcdBarrier& b) {
    asm volatile("s_waitcnt vmcnt(0)" ::: "memory");
    __syncthreads();
    if (threadIdx.x == 0) {
        unsigned* bar = b.bar;
        __builtin_amdgcn_s_waitcnt(0);
        unsigned nloc = b.st[0], nx = b.st[1];
        if (nloc == 0u) { xcd_barrier_complete(bar, b.x, nloc, nx); b.st[0] = nloc; b.st[1] = nx; }
        const unsigned old = xb_add(&bar[XB_XSUB(b.x)], 1u);
        const unsigned gen = old / nloc;
        if (old + 1u == (gen + 1u) * nloc) {
            __builtin_amdgcn_fence(__ATOMIC_RELEASE, "agent");
            asm volatile("s_waitcnt vmcnt(0)" ::: "memory");
            const unsigned og = xb_add(&bar[XB_TOP], 1u);
            const unsigned tg = og / nx;
            if (og + 1u == (tg + 1u) * nx) xb_add(&bar[XB_TOPGEN], 1u);
            else XB_SPIN(xb_ld(&bar[XB_TOPGEN]) == tg, bar);
            __builtin_amdgcn_fence(__ATOMIC_ACQUIRE, "agent");
            xb_add(&bar[XB_XGEN(b.x)], 1u);
            asm volatile("s_waitcnt vmcnt(0)" ::: "memory");
        } else {
            XB_SPIN(xb_ld(&bar[XB_XGEN(b.x)]) == gen, bar);
            __builtin_amdgcn_fence(__ATOMIC_ACQUIRE, "agent");
            asm volatile("s_waitcnt vmcnt(0)" ::: "memory");
        }
    }
    __syncthreads();
}

constexpr float SC_X = 4.f, SC_WGU = 32.f, SC_H = 4.f, SC_WDN = 64.f, SC_Y = 16.f, SC_WIN = 32.f;
__device__ __forceinline__ float wave_sum(float v) {
#pragma unroll
    for (int o = 1; o < 64; o <<= 1) v += __shfl_xor(v, o);
    return v;
}
__device__ __forceinline__ int win_dest_row(int n) {
    if (n < 1024) { const int hh = n >> 6, d = n & 63; const int p = (d < 32) ? (8 * (d >> 2) + (d & 3)) : (8 * ((d - 32) >> 2) + 4 + (d & 3)); return hh * 64 + p; }
    if (n < 3072) return n;
    if (n < 3080) return -1;
    return n - 8;
}
__device__ __forceinline__ int wgu_dest_row(int n) { return n < 1024 ? ((n >> 7) * 256 + (n & 127)) : (((n - 1024) >> 7) * 256 + 128 + ((n - 1024) & 127)); }
template <int MAP>
__device__ __forceinline__ void p0_transpose_item(const float* W, int K, int N, bf16* WT, float* wdt, LAS float* scr, int kb, int nb, int lane) {
    const int k0 = 64 * kb, n0 = 32 * nb;
    const int nn = n0 + (lane & 31); const bool nok = nn < N;
#pragma unroll 8
    for (int i = 0; i < 32; ++i) { const int kk = 2 * i + (lane >> 5); scr[kk * 33 + (lane & 31)] = nok ? W[(size_t)(k0 + kk) * N + nn] : 0.f; }
    LDS_WAIT(); asm volatile("" ::: "memory");
    const int c = lane & 7;
#pragma unroll
    for (int j = 0; j < 4; ++j) { const int n = (lane >> 3) + 8 * j; const LAS float* s = scr + (8 * c) * 33 + n;
        const int nsrc = n0 + n; if (nsrc >= N) continue;
        int drow = nsrc; if (MAP == 1) drow = win_dest_row(nsrc); if (MAP == 2) drow = wgu_dest_row(nsrc);
        if (MAP == 1 && drow < 0) { float* d = wdt + (size_t)(nsrc - 3072) * 1024 + k0 + 8 * c;
#pragma unroll
            for (int q = 0; q < 8; ++q) d[q] = s[q * 33]; continue; }
        v4u o; o.x = pk2(s[0 * 33], s[1 * 33]); o.y = pk2(s[2 * 33], s[3 * 33]); o.z = pk2(s[4 * 33], s[5 * 33]); o.w = pk2(s[6 * 33], s[7 * 33]);
        *(GAS v4u*)(WT + (size_t)drow * K + k0 + 8 * c) = o; }
    LDS_WAIT(); asm volatile("" ::: "memory");
}
template <int MAP>
__device__ __forceinline__ void p0_transpose_item64(const float* W, int K, int N, bf16* WT, float* wdt, LAS float* scr, int kb, int nb, int lane) {
    const int k0 = 64 * kb, n0 = 64 * nb;
    const bool lok = (n0 + 4 * (lane & 15) + 3) < N;
    f32x4 ld[16];
#pragma unroll
    for (int i = 0; i < 16; ++i) ld[i] = lok ? *(const f32x4*)(W + (size_t)(k0 + 4 * i + (lane >> 4)) * N + n0 + 4 * (lane & 15)) : (f32x4){0.f, 0.f, 0.f, 0.f};
#pragma unroll
    for (int i = 0; i < 16; ++i) *(LAS f32x4*)(scr + (4 * i + (lane >> 4)) * 64 + 4 * (lane & 15)) = ld[i];
    LDS_WAIT(); asm volatile("" ::: "memory");
    const int nsrc = n0 + lane;
    if (nsrc < N) {
        int drow = nsrc; if (MAP == 1) drow = win_dest_row(nsrc);
        if (MAP == 1 && drow < 0) { float* d = wdt + (size_t)(nsrc - 3072) * 1024 + k0;
#pragma unroll
            for (int q = 0; q < 16; ++q) *(f32x4*)(d + 4 * q) = (f32x4){scr[(4 * q) * 64 + lane], scr[(4 * q + 1) * 64 + lane], scr[(4 * q + 2) * 64 + lane], scr[(4 * q + 3) * 64 + lane]}; }
        else { GAS v4u* d = (GAS v4u*)(WT + (size_t)drow * K + k0);
#pragma unroll
            for (int q = 0; q < 8; ++q) { v4u o; o.x = pk2(scr[(8 * q) * 64 + lane], scr[(8 * q + 1) * 64 + lane]); o.y = pk2(scr[(8 * q + 2) * 64 + lane], scr[(8 * q + 3) * 64 + lane]);
                o.z = pk2(scr[(8 * q + 4) * 64 + lane], scr[(8 * q + 5) * 64 + lane]); o.w = pk2(scr[(8 * q + 6) * 64 + lane], scr[(8 * q + 7) * 64 + lane]); d[q] = o; } } }
    LDS_WAIT(); asm volatile("" ::: "memory");
}
struct SubT { const float* src; unsigned char* dst; int N; int n0; int mode; float scale; };
__device__ __forceinline__ SubT fp8_subtile(int item, int half, const float* wgu, const float* wdn, const float* win, unsigned char* WG8, unsigned char* WD8, unsigned char* WI8, int lane) {
    SubT t; int kb, nb;
    if (item < 64 * 256) { const int le = item >> 8, r = item & 255; kb = r >> 5; nb = r & 31; t.N = 2048; t.mode = 1; t.scale = SC_WGU;
        t.src = wgu + (size_t)le * 1024 * 2048; t.dst = WG8 + (size_t)le * 2048 * 1024; }
    else if (item < 64 * 256 + 64 * 128) { const int it2 = item - 64 * 256; const int le = it2 >> 7, r = it2 & 127; kb = r >> 4; nb = r & 15; t.N = 1024; t.mode = 0; t.scale = SC_WDN;
        t.src = wdn + (size_t)le * 1024 * 1024; t.dst = WD8 + (size_t)le * 1024 * 1024; }
    else { const int it3 = item - (64 * 256 + 64 * 128); const int l = it3 / 192, r = it3 % 192; kb = r / 24; nb = r % 24; t.N = INW; t.mode = 2; t.scale = SC_WIN;
        t.src = win + (size_t)l * 1024 * INW; t.dst = WI8 + (size_t)l * 1536 * 1024; }
    const int k0 = 128 * kb + 64 * half; t.n0 = 64 * nb;
    t.src += (size_t)(k0 + (lane >> 4)) * t.N + t.n0 + 4 * (lane & 15);
    t.dst += (size_t)k0;
    return t;
}
__device__ __forceinline__ void fp8_sub_load(const SubT& t, f32x4 (&ld)[16]) {
#pragma unroll
    for (int i = 0; i < 16; ++i) ld[i] = __builtin_nontemporal_load((const f32x4*)(t.src + (size_t)(4 * i) * t.N));
}
__device__ __forceinline__ void fp8_sub_process(const SubT& t, const f32x4 (&ld)[16], LAS float* scr, int lane) {
#pragma unroll
    for (int i = 0; i < 16; ++i) *(LAS f32x4*)(scr + (4 * i + (lane >> 4)) * 64 + 4 * (lane & 15)) = ld[i];
    LDS_WAIT(); asm volatile("" ::: "memory");
    unsigned w[16];
#pragma unroll
    for (int q = 0; q < 16; ++q) w[q] = pg8::pk4_fp8(scr[(4 * q + 0) * 64 + lane] * t.scale, scr[(4 * q + 1) * 64 + lane] * t.scale, scr[(4 * q + 2) * 64 + lane] * t.scale, scr[(4 * q + 3) * 64 + lane] * t.scale);
    LDS_WAIT(); asm volatile("" ::: "memory");
    LAS unsigned char* t2 = (LAS unsigned char*)scr;
#pragma unroll
    for (int q = 0; q < 4; ++q) *(LAS v4u*)(t2 + lane * 80 + 16 * q) = (v4u){w[4 * q], w[4 * q + 1], w[4 * q + 2], w[4 * q + 3]};
    LDS_WAIT(); asm volatile("" ::: "memory");
#pragma unroll
    for (int q = 0; q < 4; ++q) { const int n = 16 * q + (lane >> 2); const v4u v = *(const LAS v4u*)(t2 + n * 80 + 16 * (lane & 3));
        const int nn = (t.mode == 1) ? wgu_dest_row(t.n0 + n) : (t.mode == 2) ? win_dest_row(t.n0 + n) : (t.n0 + n);
        *(GAS v4u*)(t.dst + (size_t)nn * 1024 + 16 * (lane & 3)) = v; }
    LDS_WAIT(); asm volatile("" ::: "memory");
}
__device__ __forceinline__ void row_dt(const f32x4 (&v)[4], const float* wdt, float* dst, int lane) {
    float r[8];
#pragma unroll
    for (int jj = 0; jj < 8; ++jj) { float s = 0.f;
#pragma unroll
        for (int j = 0; j < 4; ++j) { const f32x4 w = *(const f32x4*)(wdt + jj * 1024 + 4 * lane + 256 * j); s += v[j][0] * w[0] + v[j][1] * w[1] + v[j][2] * w[2] + v[j][3] * w[3]; }
        r[jj] = wave_sum(s); }
    if (lane == 0) { *(f32x4*)dst = (f32x4){r[0], r[1], r[2], r[3]}; *(f32x4*)(dst + 4) = (f32x4){r[4], r[5], r[6], r[7]}; }
}
__device__ __forceinline__ void row_dt_win(const f32x4 (&v)[4], const float* win, float* dst, int lane) {
    float r[8];
#pragma unroll
    for (int jj = 0; jj < 8; ++jj) r[jj] = 0.f;
#pragma unroll
    for (int j = 0; j < 4; ++j)
#pragma unroll
        for (int e = 0; e < 4; ++e) { const float* wp = win + (size_t)(4 * lane + 256 * j + e) * INW + 3072; const f32x4 w0 = *(const f32x4*)wp, w1 = *(const f32x4*)(wp + 4); const float x = v[j][e];
            r[0] += x * w0[0]; r[1] += x * w0[1]; r[2] += x * w0[2]; r[3] += x * w0[3]; r[4] += x * w1[0]; r[5] += x * w1[1]; r[6] += x * w1[2]; r[7] += x * w1[3]; }
#pragma unroll
    for (int jj = 0; jj < 8; ++jj) r[jj] = wave_sum(r[jj]);
    if (lane == 0) { *(f32x4*)dst = (f32x4){r[0], r[1], r[2], r[3]}; *(f32x4*)(dst + 4) = (f32x4){r[4], r[5], r[6], r[7]}; }
}
template <bool W8, bool WF>
__device__ __forceinline__ void ln_row(f32x4 (&v)[4], const float* gam, const float* bet, float* of32, bf16* ob16, unsigned char* o8, float s8, int lane) {
    float s = 0.f;
#pragma unroll
    for (int j = 0; j < 4; ++j) s += (v[j][0] + v[j][1]) + (v[j][2] + v[j][3]);
    const float mean = wave_sum(s) * (1.f / DM); float s2 = 0.f;
#pragma unroll
    for (int j = 0; j < 4; ++j) { v[j] = v[j] - mean; s2 += (v[j][0] * v[j][0] + v[j][1] * v[j][1]) + (v[j][2] * v[j][2] + v[j][3] * v[j][3]); }
    const float rstd = 1.f / sqrtf(wave_sum(s2) * (1.f / DM) + LN_EPS);
#pragma unroll
    for (int j = 0; j < 4; ++j) { const f32x4 g = *(const f32x4*)(gam + 4 * lane + 256 * j), b = *(const f32x4*)(bet + 4 * lane + 256 * j);
        v[j] = v[j] * rstd * g + b;
        if (WF) *(f32x4*)(of32 + 4 * lane + 256 * j) = v[j];
        v2u w; w.x = pk2(v[j][0], v[j][1]); w.y = pk2(v[j][2], v[j][3]); *(v2u*)(ob16 + 4 * lane + 256 * j) = w;
        if (W8) *(unsigned*)(o8 + 4 * lane + 256 * j) = pg8::pk4_fp8(v[j][0] * s8, v[j][1] * s8, v[j][2] * s8, v[j][3] * s8); }
}


typedef short v4i16_t __attribute__((ext_vector_type(4)));
__device__ __forceinline__ bf16x8 tr_pair(const LAS unsigned char* p0, const LAS unsigned char* p1) {
    const v4i16_t a = __builtin_amdgcn_ds_read_tr16_b64_v4i16((LAS v4i16_t*)p0), b = __builtin_amdgcn_ds_read_tr16_b64_v4i16((LAS v4i16_t*)p1);
    return (bf16x8){a[0], a[1], a[2], a[3], b[0], b[1], b[2], b[3]};
}
__device__ __forceinline__ int crow16(int r, int hi) { return (r & 3) + 8 * (r >> 2) + 4 * hi; }
constexpr int AK_PITCH = 144, AV_PITCH = 192, AK_TILE = 32 * AK_PITCH, AV_TILE = 32 * AV_PITCH;
constexpr int AT_K = 0, AT_V = 12 * AK_TILE;
struct AttnItem { int p, b, h, d, r, qt0; };
__device__ __forceinline__ AttnItem attn_item(int I) { AttnItem a; a.p = I >> 10; const int rem = I & 1023; a.b = rem >> 7; a.h = (rem >> 4) & 7; const int grp = rem & 15;
    a.d = (a.p == 0) ? 1 : (a.p == 1) ? 4 : 16; const int tpr = 128 / a.d; const int T = grp * 8; a.r = T / tpr; a.qt0 = T % tpr; return a; }
__device__ __forceinline__ void attn_request(const bf16* PROJ, const AttnItem& a, v4u (&st)[12], int tid) {
    const int rr = tid >> 4, ch = tid & 15; const int col = (ch < 8 ? C_K : C_V - 64) + a.h * 64 + ch * 8;
#pragma unroll
    for (int tl = 0; tl < 12; ++tl) { const int kt = a.qt0 - 4 + tl; st[tl] = (v4u){0u, 0u, 0u, 0u};
        if (kt >= 0) { const size_t row = (size_t)a.b * SEQ + (size_t)(32 * kt + rr) * a.d + a.r; st[tl] = *(const v4u*)(PROJ + row * NPROJ + col); } }
}
__device__ __forceinline__ void attn_deposit(LAS unsigned char* al, const v4u (&st)[12], int tid) {
    const int rr = tid >> 4, ch = tid & 15;
    LAS unsigned char* dst = (ch < 8) ? (al + AT_K + rr * AK_PITCH + ch * 16) : (al + AT_V + rr * AV_PITCH + (ch - 8) * 16); const int tstep = (ch < 8) ? AK_TILE : AV_TILE;
#pragma unroll
    for (int tl = 0; tl < 12; ++tl) *(LAS v4u*)(dst + tl * tstep) = st[tl];
}
__device__ __forceinline__ void attn_wave_compute(const bf16* PROJ, bf16* OPp, float* LSEp, const AttnItem& a, const LAS unsigned char* al, int wave, int lane) {
    const int i = lane & 31, h2 = lane >> 5; const int qt = a.qt0 + wave;
    const size_t rowq = (size_t)a.b * SEQ + (size_t)(32 * qt + i) * a.d + a.r;
    bf16x8 qf[4];
    { const bf16* qp = PROJ + rowq * NPROJ + C_Q + a.h * 64 + 8 * h2;
#pragma unroll
      for (int s = 0; s < 4; ++s) qf[s] = *(const bf16x8*)(qp + 16 * s); }
    f32x16 o0 = {}, o1 = {}; float mrun = -INFINITY, lrun = 0.f;
    const int kt0 = qt > 4 ? qt - 4 : 0;
    const LAS unsigned char* krd = al + AT_K + i * AK_PITCH + 16 * h2;
    const LAS unsigned char* trb = al + AT_V + (4 * h2 + ((lane & 15) >> 2)) * AV_PITCH + (16 * ((lane >> 4) & 1) + 4 * (lane & 3)) * 2;
#pragma unroll 1
    for (int kt = kt0; kt <= qt; ++kt) {
        const int tl = kt - a.qt0 + 4;
        const LAS unsigned char* kp = krd + tl * AK_TILE; const LAS unsigned char* vp = trb + tl * AV_TILE;
        f32x16 sacc = {};
#pragma unroll
        for (int s = 0; s < 4; ++s) sacc = __builtin_amdgcn_mfma_f32_32x32x16_bf16(*(const LAS bf16x8*)(kp + 32 * s), qf[s], sacc, 0, 0, 0);
        if (kt == qt) {
#pragma unroll
            for (int rg = 0; rg < 16; ++rg) if (crow16(rg, h2) > i) sacc[rg] = -INFINITY;
        }
        if (kt + 4 == qt) {
#pragma unroll
            for (int rg = 0; rg < 16; ++rg) if (crow16(rg, h2) < i) sacc[rg] = -INFINITY;
        }
        float mx = sacc[0];
#pragma unroll
        for (int rg = 1; rg < 16; ++rg) mx = fmaxf(mx, sacc[rg]);
        mx = fmaxf(mx, __shfl_xor(mx, 32));
        const float mnew = fmaxf(mrun, mx), alpha = __builtin_amdgcn_exp2f(mrun - mnew); mrun = mnew;
        float ps = 0.f;
#pragma unroll
        for (int rg = 0; rg < 16; ++rg) { sacc[rg] = __builtin_amdgcn_exp2f(sacc[rg] - mnew); ps += sacc[rg]; }
        lrun = lrun * alpha + ps;
#pragma unroll
        for (int rg = 0; rg < 16; ++rg) { o0[rg] *= alpha; o1[rg] *= alpha; }
        bf16x8 pf[2];
#pragma unroll
        for (int ks = 0; ks < 2; ++ks) { v4u w; w.x = pg8::cvt_pk_bf16(sacc[8 * ks + 0], sacc[8 * ks + 1]); w.y = pg8::cvt_pk_bf16(sacc[8 * ks + 2], sacc[8 * ks + 3]); w.z = pg8::cvt_pk_bf16(sacc[8 * ks + 4], sacc[8 * ks + 5]); w.w = pg8::cvt_pk_bf16(sacc[8 * ks + 6], sacc[8 * ks + 7]); pf[ks] = __builtin_bit_cast(bf16x8, w); }
#pragma unroll
        for (int ks = 0; ks < 2; ++ks) {
            const bf16x8 v0 = tr_pair(vp + (16 * ks) * AV_PITCH, vp + (16 * ks + 8) * AV_PITCH);
            const bf16x8 v1 = tr_pair(vp + (16 * ks) * AV_PITCH + 64, vp + (16 * ks + 8) * AV_PITCH + 64);
            o0 = __builtin_amdgcn_mfma_f32_32x32x16_bf16(v0, pf[ks], o0, 0, 0, 0);
            o1 = __builtin_amdgcn_mfma_f32_32x32x16_bf16(v1, pf[ks], o1, 0, 0, 0);
        }
    }
    const float lt = lrun + __shfl_xor(lrun, 32); const float il = 1.0f / lt;
    bf16* op = OPp + rowq * 512 + a.h * 64 + 4 * h2;
#pragma unroll
    for (int g4 = 0; g4 < 4; ++g4) {
        v2u w0, w1; w0.x = pg8::cvt_pk_bf16(o0[4 * g4 + 0] * il, o0[4 * g4 + 1] * il); w0.y = pg8::cvt_pk_bf16(o0[4 * g4 + 2] * il, o0[4 * g4 + 3] * il);
        w1.x = pg8::cvt_pk_bf16(o1[4 * g4 + 0] * il, o1[4 * g4 + 1] * il); w1.y = pg8::cvt_pk_bf16(o1[4 * g4 + 2] * il, o1[4 * g4 + 3] * il);
        *(v2u*)(op + 8 * g4) = w0; *(v2u*)(op + 32 + 8 * g4) = w1; }
    if (h2 == 0) LSEp[rowq * 8 + a.h] = mrun + log2f(lt);
}
__device__ __forceinline__ void attn_phase(LAS unsigned char* al, const bf16* PROJ, bf16* OP, float* LSE, int bid, int G, int tid, int wave, int lane) {
    v4u st[12];
    int I = bid;
    if (I < 3072) { const AttnItem a = attn_item(I); attn_request(PROJ, a, st, tid); }
    for (; I < 3072; I += G) {
        const AttnItem a = attn_item(I);
        __syncthreads();
        attn_deposit(al, st, tid);
        __syncthreads();
        if (I + G < 3072) { const AttnItem n = attn_item(I + G); attn_request(PROJ, n, st, tid); }
        attn_wave_compute(PROJ, OP + (size_t)a.p * MROWS * 512, LSE + (size_t)a.p * MROWS * 8, a, al, wave, lane);
    }
    __syncthreads();
}

constexpr int SS_DTS = 0, SS_ACUM = 2048, SS_TMP = 4096, SS_SSX = 6144, SS_IMG = 8192;
constexpr int S1_PB = 320, S1_PX = 576;
constexpr int S1_B = SS_IMG, S1_X = SS_IMG + 128 * S1_PB;
constexpr int S3_PBC = 272, S3_PX = 576;
constexpr int S3_B = SS_IMG, S3_C = S3_B + 128 * S3_PBC, S3_X = S3_C + 128 * S3_PBC;

__device__ __forceinline__ void ssd_prep(LAS unsigned char* sl, const float* DT, const float* dtb, const float* alog, size_t row0, int g, int tid, int lane, int wave) {
    LAS float* dts = (LAS float*)(sl + SS_DTS); LAS float* acum = (LAS float*)(sl + SS_ACUM); LAS float* tmp = (LAS float*)(sl + SS_TMP);
    { const int l = tid >> 2, hq = tid & 3; const float x = DT[(row0 + l) * 8 + 4 * g + hq] + dtb[4 * g + hq];
      const float dt = x > 20.f ? x : log1pf(__expf(x)); dts[hq * 128 + l] = dt; tmp[hq * 128 + l] = dt * (-__expf(alog[4 * g + hq])); }
    __syncthreads();
    if (wave < 4) { const float v0 = tmp[wave * 128 + 2 * lane], v1 = tmp[wave * 128 + 2 * lane + 1]; float s = v0 + v1;
#pragma unroll
        for (int off = 1; off < 64; off <<= 1) { const float t = __shfl_up(s, off); if (lane >= off) s += t; }
        acum[wave * 128 + 2 * lane] = s - v1; acum[wave * 128 + 2 * lane + 1] = s; }
    __syncthreads();
}
template <int NCOLS, int FACMODE>
__device__ __forceinline__ void conv_tile(const bf16* PROJ, size_t row0, int t0, int pcol0, const float* cw, const float* cb, int cch0, LAS unsigned char* dst, int pitch, const LAS unsigned char* sl, int hq0, int tid) {
    constexpr int NCH8 = NCOLS / 8, NSEG = 512 / NCH8, RPS = 128 / NSEG;
    const int c8 = tid % NCH8, seg = tid / NCH8, l0 = seg * RPS;
    float w[4][8], bias[8], hst[3][8];
#pragma unroll
    for (int k = 0; k < 4; ++k) { const f32x4 a = *(const f32x4*)(cw + k * 1024 + cch0 + c8 * 8), b = *(const f32x4*)(cw + k * 1024 + cch0 + c8 * 8 + 4);
        w[k][0] = a[0]; w[k][1] = a[1]; w[k][2] = a[2]; w[k][3] = a[3]; w[k][4] = b[0]; w[k][5] = b[1]; w[k][6] = b[2]; w[k][7] = b[3]; }
    { const f32x4 a = *(const f32x4*)(cb + cch0 + c8 * 8), b = *(const f32x4*)(cb + cch0 + c8 * 8 + 4);
      bias[0] = a[0]; bias[1] = a[1]; bias[2] = a[2]; bias[3] = a[3]; bias[4] = b[0]; bias[5] = b[1]; bias[6] = b[2]; bias[7] = b[3]; }
    const bf16* src = PROJ + pcol0 + c8 * 8;
#pragma unroll
    for (int k = 0; k < 3; ++k) { const int l = l0 - 3 + k; v4u v = (v4u){0u, 0u, 0u, 0u}; if (t0 + l >= 0) v = *(const v4u*)(src + (size_t)((long)row0 + l) * NPROJ);
        hst[k][0] = bflo(v.x); hst[k][1] = bfhi(v.x); hst[k][2] = bflo(v.y); hst[k][3] = bfhi(v.y); hst[k][4] = bflo(v.z); hst[k][5] = bfhi(v.z); hst[k][6] = bflo(v.w); hst[k][7] = bfhi(v.w); }
    const LAS float* dts = (const LAS float*)(sl + SS_DTS); const LAS float* acum = (const LAS float*)(sl + SS_ACUM);
    const int hq = hq0 + (c8 * 8) / 64;
    const float alast = (FACMODE == 2) ? acum[hq * 128 + 127] : 0.f;
#pragma unroll
    for (int rr = 0; rr < RPS; ++rr) { const int l = l0 + rr; const v4u v = *(const v4u*)(src + (row0 + l) * NPROJ);
        float cur[8]; cur[0] = bflo(v.x); cur[1] = bfhi(v.x); cur[2] = bflo(v.y); cur[3] = bfhi(v.y); cur[4] = bflo(v.z); cur[5] = bfhi(v.z); cur[6] = bflo(v.w); cur[7] = bfhi(v.w);
        float f = 1.f; if (FACMODE >= 1) f = dts[hq * 128 + l]; if (FACMODE == 2) f *= __expf(alast - acum[hq * 128 + l]);
        float o[8];
#pragma unroll
        for (int e = 0; e < 8; ++e) { const float a = bias[e] + w[0][e] * hst[0][e] + w[1][e] * hst[1][e] + w[2][e] * hst[2][e] + w[3][e] * cur[e]; o[e] = siluf(a) * f;
            hst[0][e] = hst[1][e]; hst[1][e] = hst[2][e]; hst[2][e] = cur[e]; }
        v4u ov; ov.x = pk2(o[0], o[1]); ov.y = pk2(o[2], o[3]); ov.z = pk2(o[4], o[5]); ov.w = pk2(o[6], o[7]);
        *(LAS v4u*)(dst + l * pitch + c8 * 16) = ov; }
}
__device__ __forceinline__ void ssd_s1_unit(LAS unsigned char* sl, const bf16* PROJ, const float* DT, const float* dtb, const float* alog, const float* cw, const float* cb, float* ST, float* CDEC, int un, int tid, int lane, int wave) {
    const int g = un & 1, bc = un >> 1; const size_t row0 = (size_t)bc * 128; const int t0 = (bc & 31) * 128;
    __syncthreads();
    ssd_prep(sl, DT, dtb, alog, row0, g, tid, lane, wave);
    conv_tile<128, 0>(PROJ, row0, t0, C_XS + 512 + g * 128, cw, cb, 512 + g * 128, sl + S1_B, S1_PB, sl, 0, tid);
    conv_tile<256, 2>(PROJ, row0, t0, C_XS + g * 256, cw, cb, g * 256, sl + S1_X, S1_PX, sl, 0, tid);
    if (tid < 4) CDEC[(size_t)bc * 8 + 4 * g + tid] = __expf(((const LAS float*)(sl + SS_ACUM))[tid * 128 + 127]);
    __syncthreads();
    const int hq = wave >> 1, pt = wave & 1, h2 = lane >> 5, q = (lane & 15) >> 2, pp = lane & 3, dsel = (lane >> 4) & 1;
    const LAS unsigned char* xb = sl + S1_X + (8 * h2 + q) * S1_PX + (hq * 64 + pt * 32 + 16 * dsel + 4 * pp) * 2;
    const LAS unsigned char* bb = sl + S1_B + (8 * h2 + q) * S1_PB + (16 * dsel + 4 * pp) * 2;
    f32x16 acc[4];
#pragma unroll
    for (int nt = 0; nt < 4; ++nt) acc[nt] = (f32x16){};
#pragma unroll
    for (int ks = 0; ks < 8; ++ks) { const bf16x8 a = tr_pair(xb + (16 * ks) * S1_PX, xb + (16 * ks + 4) * S1_PX);
#pragma unroll
        for (int nt = 0; nt < 4; ++nt) { const bf16x8 b = tr_pair(bb + (16 * ks) * S1_PB + nt * 64, bb + (16 * ks + 4) * S1_PB + nt * 64); acc[nt] = __builtin_amdgcn_mfma_f32_32x32x16_bf16(a, b, acc[nt], 0, 0, 0); } }
    float* sp = ST + ((size_t)(bc * 8 + 4 * g + hq) * 64 + pt * 32) * 128 + (lane & 31);
#pragma unroll
    for (int nt = 0; nt < 4; ++nt)
#pragma unroll
        for (int rg = 0; rg < 16; ++rg) sp[(size_t)crow16(rg, h2) * 128 + 32 * nt] = acc[nt][rg];
}
__device__ __forceinline__ void ssd_s3_unit(LAS unsigned char* sl, const bf16* PROJ, const float* DT, const float* dtb, const float* alog, const float* cw, const float* cb, const float* dsk, const float* ng,
                                            const bf16* HIN, bf16* MIXED, int un, int tid, int lane, int wave) {
    const int g = un & 1, bc = un >> 1; const size_t row0 = (size_t)bc * 128; const int t0 = (bc & 31) * 128;
    const int lt = wave & 3, ph = wave >> 2, lq = lane & 31, hi = lane >> 5, q = (lane & 15) >> 2, pp = lane & 3, dsel = (lane >> 4) & 1;
    const int lrow = 32 * lt + lq;
    const size_t grow = row0 + lrow;
    __syncthreads();
    ssd_prep(sl, DT, dtb, alog, row0, g, tid, lane, wave);
    conv_tile<128, 0>(PROJ, row0, t0, C_XS + 512 + g * 128, cw, cb, 512 + g * 128, sl + S3_B, S3_PBC, sl, 0, tid);
    conv_tile<128, 0>(PROJ, row0, t0, C_XS + 768 + g * 128, cw, cb, 768 + g * 128, sl + S3_C, S3_PBC, sl, 0, tid);
    conv_tile<256, 1>(PROJ, row0, t0, C_XS + g * 256, cw, cb, g * 256, sl + S3_X, S3_PX, sl, 0, tid);
    __syncthreads();
    const LAS float* dts = (const LAS float*)(sl + SS_DTS); const LAS float* acum = (const LAS float*)(sl + SS_ACUM); LAS float* ssx = (LAS float*)(sl + SS_SSX);
    const LAS unsigned char* crd = sl + S3_C + lrow * S3_PBC + 16 * hi;
    f32x16 y[4];
    { bf16x8 hfa[8], hfb[8];
      const bf16* hp0 = HIN + ((size_t)(bc * 8 + 4 * g) * 64 + ph * 32 + lq) * 128 + 8 * hi;
#pragma unroll
      for (int ks = 0; ks < 8; ++ks) hfa[ks] = *(const bf16x8*)(hp0 + 16 * ks);
#pragma unroll
      for (int hq = 0; hq < 4; ++hq) {
          if (hq < 3) {
#pragma unroll
              for (int ks = 0; ks < 8; ++ks) { const bf16x8 v = *(const bf16x8*)(hp0 + (size_t)(hq + 1) * 8192 + 16 * ks); if (hq & 1) hfa[ks] = v; else hfb[ks] = v; } }
          f32x16 t = (f32x16){};
#pragma unroll
          for (int ks = 0; ks < 8; ++ks) t = __builtin_amdgcn_mfma_f32_32x32x16_bf16((hq & 1) ? hfb[ks] : hfa[ks], *(const LAS bf16x8*)(crd + 32 * ks), t, 0, 0, 0);
          const float ea = __expf(acum[hq * 128 + lrow]);
#pragma unroll
          for (int rg = 0; rg < 16; ++rg) t[rg] *= ea;
          y[hq] = t; } }
    v2u zr[4][4];
#pragma unroll
    for (int hq = 0; hq < 4; ++hq)
#pragma unroll
        for (int g4 = 0; g4 < 4; ++g4) zr[hq][g4] = *(const v2u*)(PROJ + grow * NPROJ + C_Z + g * 256 + hq * 64 + ph * 32 + 8 * g4 + 4 * hi);
#pragma unroll
    for (int st = 0; st < 4; ++st) if (st <= lt) {
        f32x16 ag = (f32x16){};
        { const LAS unsigned char* brd = sl + S3_B + (32 * st + lq) * S3_PBC + 16 * hi;
#pragma unroll
          for (int ks = 0; ks < 8; ++ks) ag = __builtin_amdgcn_mfma_f32_32x32x16_bf16(*(const LAS bf16x8*)(brd + 32 * ks), *(const LAS bf16x8*)(crd + 32 * ks), ag, 0, 0, 0); }
#pragma unroll
        for (int hq = 0; hq < 4; ++hq) {
            const float al = acum[hq * 128 + lrow], dd = dsk[4 * g + hq] / dts[hq * 128 + lrow];
            const LAS unsigned char* xb = sl + S3_X + (4 * hi + q) * S3_PX + (hq * 64 + ph * 32 + 16 * dsel + 4 * pp) * 2;
            float pm[16];
#pragma unroll
            for (int g4 = 0; g4 < 4; ++g4) { const f32x4 as4 = *(const LAS f32x4*)(acum + hq * 128 + 32 * st + 8 * g4 + 4 * hi);
#pragma unroll
                for (int e = 0; e < 4; ++e) { const int rg = 4 * g4 + e; float v = ag[rg] * __expf(al - as4[e]);
                    if (st == lt) { const int sl_ = 8 * g4 + 4 * hi + e; if (sl_ > lq) v = 0.f; if (sl_ == lq) v += dd; }
                    pm[rg] = v; } }
#pragma unroll
            for (int ks = 0; ks < 2; ++ks) { v4u wv; wv.x = pg8::cvt_pk_bf16(pm[8 * ks + 0], pm[8 * ks + 1]); wv.y = pg8::cvt_pk_bf16(pm[8 * ks + 2], pm[8 * ks + 3]); wv.z = pg8::cvt_pk_bf16(pm[8 * ks + 4], pm[8 * ks + 5]); wv.w = pg8::cvt_pk_bf16(pm[8 * ks + 6], pm[8 * ks + 7]);
                const bf16x8 xt = tr_pair(xb + (32 * st + 16 * ks) * S3_PX, xb + (32 * st + 16 * ks + 8) * S3_PX);
                y[hq] = __builtin_amdgcn_mfma_f32_32x32x16_bf16(xt, __builtin_bit_cast(bf16x8, wv), y[hq], 0, 0, 0); }
        }
    }
    unsigned ayp[4][8]; float ss = 0.f;
#pragma unroll
    for (int hq = 0; hq < 4; ++hq)
#pragma unroll
        for (int g4 = 0; g4 < 4; ++g4) { const v2u z = zr[hq][g4];
            const float y0 = y[hq][4 * g4 + 0] * siluf(bflo(z.x)), y1 = y[hq][4 * g4 + 1] * siluf(bfhi(z.x)), y2 = y[hq][4 * g4 + 2] * siluf(bflo(z.y)), y3 = y[hq][4 * g4 + 3] * siluf(bfhi(z.y));
            ss += (y0 * y0 + y1 * y1) + (y2 * y2 + y3 * y3);
            ayp[hq][2 * g4] = pg8::cvt_pk_bf16(y0, y1); ayp[hq][2 * g4 + 1] = pg8::cvt_pk_bf16(y2, y3); }
    ss += __shfl_xor(ss, 32);
    if (hi == 0) ssx[ph * 128 + lrow] = ss;
    __syncthreads();
    const float rs = 1.0f / sqrtf((ssx[lrow] + ssx[128 + lrow]) * (1.f / 256.f) + RMS_EPS);
#pragma unroll
    for (int hq = 0; hq < 4; ++hq)
#pragma unroll
        for (int g4 = 0; g4 < 4; ++g4) { const int ch = hq * 64 + ph * 32 + 8 * g4 + 4 * hi; const f32x4 gn = *(const f32x4*)(ng + g * 256 + ch);
            const unsigned p0 = ayp[hq][2 * g4], p1 = ayp[hq][2 * g4 + 1];
            v2u o; o.x = pg8::cvt_pk_bf16(bflo(p0) * rs * gn[0], bfhi(p0) * rs * gn[1]); o.y = pg8::cvt_pk_bf16(bflo(p1) * rs * gn[2], bfhi(p1) * rs * gn[3]);
            *(v2u*)(MIXED + grow * MIXW + 512 + g * 256 + ch) = o; }
}

struct Args { const float* in[20]; float* out; unsigned char* ws; int ph_lo, ph_hi, sub, pad; };
constexpr int NWAVES = 8;
constexpr int PH_PER_LAYER = 10, N_PHASES = 1 + NLAYER * PH_PER_LAYER;

#define in_x (args.in[0])
#define in_win (args.in[1])
#define in_convw (args.in[2])
#define in_convb (args.in[3])
#define in_dtb (args.in[4])
#define in_alog (args.in[5])
#define in_dsk (args.in[6])
#define in_ng (args.in[7])
#define in_scw (args.in[8])
#define in_wout (args.in[9])
#define in_ln1g (args.in[10])
#define in_ln1b (args.in[11])
#define in_rw (args.in[12])
#define in_rb (args.in[13])
#define in_wgu (args.in[14])
#define in_bgu (args.in[15])
#define in_wdn (args.in[16])
#define in_bdn (args.in[17])
#define in_ln2g (args.in[18])
#define in_ln2b (args.in[19])
#define ROPE ((float*)(args.ws + WS_ROPE))
#define WDT ((float*)(args.ws + WS_WDT))
#define ROUT ((bf16*)(args.ws + WS_ROUT))
#define WIN ((bf16*)(args.ws + WS_WIN))
#define WOUT ((bf16*)(args.ws + WS_WOUT))
#define WGU ((bf16*)(args.ws + WS_WGU))
#define WDN ((bf16*)(args.ws + WS_WDN))
#define XB ((bf16*)(args.ws + WS_XB))
#define XF ((float*)(args.ws + WS_XF))
#define XF2 ((float*)(args.ws + WS_XF2))
#define PROJ ((bf16*)(args.ws + WS_PROJ))
#define DT ((float*)(args.ws + WS_DT))
#define DTS ((float*)(args.ws + WS_DTS))
#define ACUM ((float*)(args.ws + WS_ACUM))
#define LSE ((float*)(args.ws + WS_LSE))
#define OP ((bf16*)(args.ws + WS_OP))
#define U ((bf16*)(args.ws + WS_U))
#define GB ((float*)(args.ws + WS_G))
#define ST ((float*)(args.ws + WS_ST))
#define YD ((float*)(args.ws + WS_YD))
#define MIXED ((bf16*)(args.ws + WS_MIXED))
#define MIXF ((bf16*)(args.ws + WS_MIXF))
#define TOPE ((int*)(args.ws + WS_TOPE))
#define TOPG ((float*)(args.ws + WS_TOPG))
#define ROWTOK ((int*)(args.ws + WS_ROWTOK))
#define ROWGATE ((float*)(args.ws + WS_ROWGATE))
#define HB ((bf16*)(args.ws + WS_H))
#define YB ((bf16*)(args.ws + WS_YB))
#define HIN ((bf16*)(args.ws + WS_G))
#define WGU8 ((unsigned char*)(args.ws + WS_WGU))
#define WDN8 ((unsigned char*)(args.ws + WS_WDN))
#define XB8 ((unsigned char*)(args.ws + WS_U))
#define H8 ((unsigned char*)(args.ws + WS_H))
#define YB8 ((unsigned char*)(args.ws + WS_YB))
#define WIN8 ((unsigned char*)(args.ws + WS_WGU + 128 * MiB))
#define XP8 ((unsigned char*)(args.ws + WS_WGU + 132 * MiB))
#define CDEC ((float*)(args.ws + WS_ACUM))
template <int layer>
__device__ __forceinline__ void run_layer(const Args& args, int lo, int hi, const XcdBarrier& bar) {
    extern __shared__ __attribute__((aligned(16))) unsigned char lds[];
    LAS unsigned char* ldsp = (LAS unsigned char*)lds;
    const int tid = threadIdx.x, lane = tid & 63, wave = __builtin_amdgcn_readfirstlane(tid >> 6);
    const int G = gridDim.x, bid = blockIdx.x;
    const int gw = bid * NWAVES + wave, NGW = G * NWAVES;
    gu32* ctl = (gu32*)(args.ws + WS_CTL);

#define IN(k) (lo <= (k) && (k) < hi)
#define SEAM(k) do { if (IN(k) && IN((k) + 1)) xcd_barrier(bar); } while (0)

        const int pb = 1 + layer * PH_PER_LAYER;
        const bf16* WINl = WIN + (size_t)layer * NPROJ * DM; const bf16* WOUTl = WOUT + (size_t)layer * DM * MIXW;
        const unsigned char* WGUl = WGU8 + (size_t)layer * NEXP * 2048 * DM; const unsigned char* WDNl = WDN8 + (size_t)layer * NEXP * DM * FF;
        gu32* gcnt = ctl + CW_CNT + 64 * layer;

        if (IN(pb + 0)) {
            if (layer == 0) {
                for (int m = gw; m < MROWS; m += NGW) { const bf16* xr = XB + (size_t)m * DM; f32x4 v[4];
#pragma unroll
                    for (int j = 0; j < 4; ++j) { const v2u a = *(const v2u*)(xr + 4 * lane + 256 * j); v[j] = (f32x4){bflo(a.x), bfhi(a.x), bflo(a.y), bfhi(a.y)}; }
                    row_dt(v, WDT, DT + (size_t)m * 8, lane); }
            }
            {
              pg8::Gemm g{(const pg8::bf16_t*)XP8, (const pg8::bf16_t*)(WIN8 + (size_t)layer * 1536 * DM), MROWS, 1536, DM / 2}; pg8::StaticOrder S; S.init(MROWS, 1536, G, bid);
              pg8::EpiProj E{PROJ, NPROJ, ROPE, QSCALE, 1.0f / (SC_X * SC_WIN), 0};
              pg8::gemm_phase<pg8::EpiProj, pg8::StaticOrder, true, false, true>(ldsp + RING_OFF, g, S, E); }
            __syncthreads();
            { pg8::Gemm g{XB, WINl + (size_t)1536 * DM, MROWS, NPROJ - 1536, DM}; pg8::StaticOrder S; S.init(MROWS, NPROJ - 1536, G, bid);
              pg8::EpiProj E{PROJ, NPROJ, ROPE, QSCALE, 1.0f, 6};
              pg8::gemm_phase<pg8::EpiProj, pg8::StaticOrder, true, false>(ldsp + RING_OFF, g, S, E); }
        }
        SEAM(pb + 0);
        if (IN(pb + 1)) {
            if (args.sub & 1) attn_phase(ldsp + RING_OFF, PROJ, OP, LSE, bid, G, tid, wave, lane);
            if (args.sub & 2) { const float* cw = in_convw + (size_t)layer * 4 * 1024; const float* cb = in_convb + (size_t)layer * 1024;
              for (int un = bid; un < 512; un += G)
                  ssd_s1_unit(ldsp + RING_OFF, PROJ, DT, in_dtb + layer * 8, in_alog + layer * 8, cw, cb, ST, CDEC, un, tid, lane, wave);
              __syncthreads(); }
            const float* sw = in_scw + (size_t)layer * 3 * 512;
            if (args.sub & 4)
#pragma unroll 2
            for (int it = bid * (NWAVES * 64) + tid; it < (int)((long)MROWS * 64); it += G * (NWAVES * 64)) { const int c8 = (int)(it & 63), row = (int)(it >> 6), t = row & (SEQ - 1); const int ch = c8 * 8;
                float a[8];
#pragma unroll
                for (int q = 0; q < 8; ++q) a[q] = 0.f;
#pragma unroll
                for (int k = 0; k < 3; ++k) { const int tt = t - 2 + k; if (tt >= 0) { const bf16* pr = PROJ + (size_t)(row - 2 + k) * NPROJ; const v4u cc = *(const v4u*)(pr + C_SC + ch), hh = *(const v4u*)(pr + C_SH + ch);
                    const f32x4 w0 = *(const f32x4*)(sw + k * 512 + ch), w1 = *(const f32x4*)(sw + k * 512 + ch + 4);
                    a[0] += w0[0] * bflo(cc.x) * bflo(hh.x); a[1] += w0[1] * bfhi(cc.x) * bfhi(hh.x); a[2] += w0[2] * bflo(cc.y) * bflo(hh.y); a[3] += w0[3] * bfhi(cc.y) * bfhi(hh.y);
                    a[4] += w1[0] * bflo(cc.z) * bflo(hh.z); a[5] += w1[1] * bfhi(cc.z) * bfhi(hh.z); a[6] += w1[2] * bflo(cc.w) * bflo(hh.w); a[7] += w1[3] * bfhi(cc.w) * bfhi(hh.w); } }
                const v4u bb = *(const v4u*)(PROJ + (size_t)row * NPROJ + C_SB + ch);
                v4u o; o.x = pk2(a[0] * bflo(bb.x), a[1] * bfhi(bb.x)); o.y = pk2(a[2] * bflo(bb.y), a[3] * bfhi(bb.y)); o.z = pk2(a[4] * bflo(bb.z), a[5] * bfhi(bb.z)); o.w = pk2(a[6] * bflo(bb.w), a[7] * bfhi(bb.w));
                *(v4u*)(MIXED + (size_t)row * MIXW + 1024 + ch) = o; }
        }
        SEAM(pb + 1);
        if (IN(pb + 2)) {
            for (int it = bid * (NWAVES * 64) + tid; it < (int)(64L * 2048); it += G * (NWAVES * 64)) { const int pn4 = (int)(it & 2047), bh = (int)(it >> 11); const int h = bh & 7, b = bh >> 3; f32x4 hc = (f32x4){0.f, 0.f, 0.f, 0.f};
#pragma unroll 16
                for (int c = 0; c < 32; ++c) { const size_t idx = ((size_t)((b * 32 + c) * 8 + h)) * 8192 + pn4 * 4; const f32x4 st = *(const f32x4*)(ST + idx);
                    v2u o; o.x = pk2(hc[0], hc[1]); o.y = pk2(hc[2], hc[3]); *(v2u*)(HIN + idx) = o;
                    hc = hc * CDEC[(size_t)(b * 32 + c) * 8 + h] + st; } }
        }
        SEAM(pb + 2);
        if (IN(pb + 3)) {
            if (args.sub & 1) { const float* cw = in_convw + (size_t)layer * 4 * 1024; const float* cb = in_convb + (size_t)layer * 1024;
              for (int un = bid; un < 512; un += G)
                  ssd_s3_unit(ldsp + RING_OFF, PROJ, DT, in_dtb + layer * 8, in_alog + layer * 8, cw, cb, in_dsk + layer * 8, in_ng + (size_t)layer * 512, HIN, MIXED, un, tid, lane, wave);
              __syncthreads(); }
            if (args.sub & 2)
#pragma unroll 2
            for (int it = bid * (NWAVES * 64) + tid; it < (int)((long)MROWS * 64); it += G * (NWAVES * 64)) { const int c8 = (int)(it & 63), row = (int)(it >> 6); const int h = c8 >> 3;
                const float l0 = LSE[((size_t)0 * MROWS + row) * 8 + h], l1 = LSE[((size_t)1 * MROWS + row) * 8 + h], l2 = LSE[((size_t)2 * MROWS + row) * 8 + h];
                const float mm = fmaxf(l0, fmaxf(l1, l2)); float w0 = exp2f(l0 - mm), w1 = exp2f(l1 - mm), w2 = exp2f(l2 - mm); const float iw = 1.0f / (w0 + w1 + w2); w0 *= iw; w1 *= iw; w2 *= iw;
                const v4u a0 = *(const v4u*)(OP + ((size_t)0 * MROWS + row) * 512 + c8 * 8), a1 = *(const v4u*)(OP + ((size_t)1 * MROWS + row) * 512 + c8 * 8), a2 = *(const v4u*)(OP + ((size_t)2 * MROWS + row) * 512 + c8 * 8);
                v4u o;
                o.x = pk2(w0 * bflo(a0.x) + w1 * bflo(a1.x) + w2 * bflo(a2.x), w0 * bfhi(a0.x) + w1 * bfhi(a1.x) + w2 * bfhi(a2.x));
                o.y = pk2(w0 * bflo(a0.y) + w1 * bflo(a1.y) + w2 * bflo(a2.y), w0 * bfhi(a0.y) + w1 * bfhi(a1.y) + w2 * bfhi(a2.y));
                o.z = pk2(w0 * bflo(a0.z) + w1 * bflo(a1.z) + w2 * bflo(a2.z), w0 * bfhi(a0.z) + w1 * bfhi(a1.z) + w2 * bfhi(a2.z));
                o.w = pk2(w0 * bflo(a0.w) + w1 * bflo(a1.w) + w2 * bflo(a2.w), w0 * bfhi(a0.w) + w1 * bfhi(a1.w) + w2 * bfhi(a2.w));
                *(v4u*)(MIXED + (size_t)row * MIXW + c8 * 8) = o; }
        }
        SEAM(pb + 3);
        if (IN(pb + 4)) {
#define FUSED_LN1_CALL(BASE, LIM) { pg8::Gemm g{MIXED, WOUTl, MROWS, DM, MIXW}; \
              pg8::EpiLn1 E{args.ws, in_ln1g + (size_t)layer * DM, in_ln1b + (size_t)layer * DM, WS_XB, WS_U, (layer ? WS_ROPE : WS_DTS), WS_CTL + (size_t)(CW_SEAM + layer * 8192) * 4, WS_CTL + (size_t)CW_TMO * 4, ALPHA, SC_X, LN_EPS, 0x700u + (unsigned)layer * 0x80u}; \
              pg8::StaticOrder S; S.init(MROWS, DM, G, bid); S.base = (BASE); S.lim = (LIM); \
              pg8::gemm_phase<pg8::EpiLn1, pg8::StaticOrder, false, false>(ldsp + RING_OFF, g, S, E); }
            FUSED_LN1_CALL(0, 256)
            __syncthreads();
            FUSED_LN1_CALL(256, 512)
            __syncthreads();
#undef FUSED_LN1_CALL
        }
        SEAM(pb + 4);
        if (IN(pb + 6)) {
            LAS int* lcnt = (LAS int*)(ldsp + L_LCNT); LAS int* lbase = (LAS int*)(ldsp + L_LBASE);
            const bf16* RT = ROUT + (size_t)layer * NEXP * DM; const float* rb = in_rb + (size_t)layer * NEXP;
            for (int blk = bid; blk < MROWS / 128; blk += G) {
                if (tid < 32) lcnt[tid] = 0;
                __syncthreads();
                const int r32 = lane & 31, hi = lane >> 5; const int row = blk * 128 + (wave & 3) * 32 + r32;
                float tv[4]; int te[4]; int lrank[4]; float gate[4];
                f32x16 acc = {};
                { const int kh = wave >> 2;
                  const bf16* ap = RT + (size_t)r32 * DM + 8 * hi + 512 * kh; const bf16* bp = XB + (size_t)row * DM + 8 * hi + 512 * kh;
#pragma unroll 16
                  for (int s = 0; s < 32; ++s) { const bf16x8 a = *(const bf16x8*)(ap + 16 * s), b = *(const bf16x8*)(bp + 16 * s); acc = __builtin_amdgcn_mfma_f32_32x32x16_bf16(a, b, acc, 0, 0, 0); }
                  LAS float* part = (LAS float*)(ldsp + RING_OFF) + (wave & 3) * 1024;
                  if (kh) {
#pragma unroll
                      for (int i = 0; i < 16; ++i) part[i * 64 + lane] = acc[i]; }
                  __syncthreads();
                  if (!kh) {
#pragma unroll
                      for (int i = 0; i < 16; ++i) acc[i] += part[i * 64 + lane]; } }
                if (wave < 4) {
#pragma unroll
                    for (int k = 0; k < 4; ++k) { tv[k] = -INFINITY; te[k] = 1 << 20; }
#pragma unroll
                    for (int i = 0; i < 16; ++i) { const int e = (i & 3) + 8 * (i >> 2) + 4 * hi; float v = acc[i] + rb[e]; int ve = e;
#pragma unroll
                        for (int k = 0; k < 4; ++k) { const bool gt = (v > tv[k]) || (v == tv[k] && ve < te[k]); const float nv = gt ? tv[k] : v; const int ne = gt ? te[k] : ve; tv[k] = gt ? v : tv[k]; te[k] = gt ? ve : te[k]; v = nv; ve = ne; } }
                    float pv[4]; int pe[4];
#pragma unroll
                    for (int k = 0; k < 4; ++k) { pv[k] = __shfl_xor(tv[k], 32); pe[k] = __shfl_xor(te[k], 32); }
#pragma unroll
                    for (int j = 0; j < 4; ++j) { float v = pv[j]; int ve = pe[j];
#pragma unroll
                        for (int k = 0; k < 4; ++k) { const bool gt = (v > tv[k]) || (v == tv[k] && ve < te[k]); const float nv = gt ? tv[k] : v; const int ne = gt ? te[k] : ve; tv[k] = gt ? v : tv[k]; te[k] = gt ? ve : te[k]; v = nv; ve = ne; } }
                    float se = 0.f;
#pragma unroll
                    for (int k = 0; k < 4; ++k) { gate[k] = __expf(tv[k] - tv[0]); se += gate[k]; }
                    const float ise = 1.0f / se;
#pragma unroll
                    for (int k = 0; k < 4; ++k) gate[k] *= ise;
                    if (hi == 0) {
#pragma unroll
                        for (int k = 0; k < 4; ++k) lrank[k] = __hip_atomic_fetch_add(lcnt + te[k], 1, __ATOMIC_RELAXED, __HIP_MEMORY_SCOPE_WORKGROUP);
                    }
                }
                __syncthreads();
                if (tid < 32) lbase[tid] = (int)__hip_atomic_fetch_add(gcnt + tid, (unsigned)lcnt[tid], RLX_AGENT);
                __syncthreads();
                if (wave < 4 && hi == 0) {
#pragma unroll
                    for (int k = 0; k < 4; ++k) { const int r = lbase[te[k]] + lrank[k]; const size_t o = (size_t)te[k] * 32768 + r;
                        ROWTOK[o] = row * 4 + k; ROWGATE[o] = gate[k]; }
                }
                __syncthreads();
            }
        }
        SEAM(pb + 6);
        if (IN(pb + 7) || IN(pb + 8)) {
            LAS int* tstart = (LAS int*)(ldsp + L_TSTART); LAS int* cntL = (LAS int*)(ldsp + L_CNT); LAS int* units = (LAS int*)(ldsp + L_UNITS); LAS int* unitsn = (LAS int*)(ldsp + L_UNITSN);
            if (tid == 0) { int acc = 0; for (int e = 0; e < 32; ++e) { const int c = (int)__hip_atomic_load(gcnt + e, RLX_AGENT); cntL[e] = c; tstart[e] = acc; acc += (c + 255) >> 8; } tstart[32] = acc; }
            __syncthreads();
            if (IN(pb + 7)) {
                pg8::moe_build_units(units, unitsn, tstart, 8, G, bid, tid);
                __syncthreads();
                pg8::Gemm g{(const pg8::bf16_t*)XB8, (const pg8::bf16_t*)WGUl, 0, 2048, DM / 2};
                pg8::MoeOrder S{units, __builtin_amdgcn_readfirstlane(unitsn[0]), cntL, ROWTOK, 1, (unsigned)DM, (size_t)2048 * DM, ROWGATE, in_bgu + (size_t)layer * NEXP * 2048};
                pg8::EpiSwiglu E{H8, in_bgu + (size_t)layer * NEXP * 2048, ROWGATE, cntL, 1.0f / (SC_X * SC_WGU), SC_H};
                pg8::gemm_phase<pg8::EpiSwiglu, pg8::MoeOrder, true, true, true>(ldsp + RING_OFF, g, S, E);
                __syncthreads();
            }
            SEAM(pb + 7);
            if (IN(pb + 8)) {
                pg8::moe_build_units(units, unitsn, tstart, 4, G, bid, tid);
                __syncthreads();
                pg8::Gemm g{(const pg8::bf16_t*)H8, (const pg8::bf16_t*)WDNl, 0, DM, FF / 2};
                pg8::MoeOrder S{units, __builtin_amdgcn_readfirstlane(unitsn[0]), cntL, ROWTOK, 0, (unsigned)FF, (size_t)DM * FF, ROWGATE, in_bdn + (size_t)layer * NEXP * DM};
                pg8::EpiScatter E{YB8, ROWTOK, cntL, SC_Y / (SC_H * SC_WDN), SC_Y};
                pg8::gemm_phase<pg8::EpiScatter, pg8::MoeOrder, true, false, true, true>(ldsp + RING_OFF, g, S, E);
                __syncthreads();
            }
        }
        SEAM(pb + 8);
        if (IN(pb + 9)) {
            const float* gam = in_ln2g + (size_t)layer * DM; const float* bet = in_ln2b + (size_t)layer * DM; const float* bdn = in_bdn + (size_t)layer * NEXP * DM;
            for (int m = gw; m < MROWS; m += NGW) { f32x4 v[4];
#pragma unroll
                for (int j = 0; j < 4; ++j) { const v2u a = *(const v2u*)(XB + (size_t)m * DM + 4 * lane + 256 * j); v[j] = (f32x4){bflo(a.x), bfhi(a.x), bflo(a.y), bfhi(a.y)} * ALPHA; }
#pragma unroll
                for (int k = 0; k < 4; ++k) { const unsigned char* yr = YB8 + ((size_t)m * 4 + k) * DM;
#pragma unroll
                    for (int j = 0; j < 4; ++j) { const unsigned w = *(const unsigned*)(yr + 4 * lane + 256 * j);
                        typedef float f32x2_ __attribute__((ext_vector_type(2)));
                        const f32x2_ lo = __builtin_amdgcn_cvt_pk_f32_fp8(w, false), hi = __builtin_amdgcn_cvt_pk_f32_fp8(w, true);
                        v[j][0] += lo[0] * (1.0f / SC_Y); v[j][1] += lo[1] * (1.0f / SC_Y); v[j][2] += hi[0] * (1.0f / SC_Y); v[j][3] += hi[1] * (1.0f / SC_Y); } }
                ln_row<(layer + 1 < NLAYER), (layer == NLAYER - 1)>(v, gam, bet, args.out + (size_t)m * DM, XB + (size_t)m * DM, XP8 + (size_t)m * DM, SC_X, lane);
                if (layer + 1 < NLAYER) row_dt(v, WDT + (size_t)(layer + 1) * 8 * 1024, DT + (size_t)m * 8, lane); }
        }
        SEAM(pb + 9);
    #undef IN
#undef SEAM
}

__global__ void __launch_bounds__(NWAVES * 64, 2) mk_fwd(Args args) {
    extern __shared__ __attribute__((aligned(16))) unsigned char lds[];
    LAS unsigned char* ldsp = (LAS unsigned char*)lds;
    const int tid = threadIdx.x, lane = tid & 63, wave = __builtin_amdgcn_readfirstlane(tid >> 6);
    const int G = gridDim.x, bid = blockIdx.x;
    const int gw = bid * NWAVES + wave, NGW = G * NWAVES;
    gu32* ctl = (gu32*)(args.ws + WS_CTL);

    for (int u = tid; u < (LDS_BYTES - LDSCTL_OFF) / 4; u += NWAVES * 64) ((LAS unsigned*)(ldsp + LDSCTL_OFF))[u] = 0u;
    __syncthreads();
    XcdBarrier bar = xcd_barrier_post((unsigned*)(ctl + CW_BAR), (volatile LAS unsigned*)(ldsp + L_MISC) + 8);

    const int lo = args.ph_lo, hi = args.ph_hi;
#define IN(k) (lo <= (k) && (k) < hi)
#define SEAM(k) do { if (IN(k) && IN((k) + 1)) xcd_barrier(bar); } while (0)

    if (IN(0)) {
        LAS float* scr = (LAS float*)(ldsp + RING_OFF + wave * 16384);
        constexpr int I_IN = 16 * 73, I_OUT = 24 * 16, I_R = 16;
        constexpr int NIT = NLAYER * (I_IN + I_OUT + I_R);
        for (int it = gw; it < NIT; it += NGW) {
            int r = it;
            if (r < NLAYER * I_IN) { const int l = r / I_IN; r %= I_IN; p0_transpose_item64<1>(in_win + (size_t)l * DM * INW, DM, INW, WIN + (size_t)l * NPROJ * DM, WDT + (size_t)l * 8 * 1024, scr, r / 73, r % 73, lane); continue; } r -= NLAYER * I_IN;
            if (r < NLAYER * I_OUT) { const int l = r / I_OUT; r %= I_OUT; p0_transpose_item64<0>(in_wout + (size_t)l * MIXW * DM, MIXW, DM, WOUT + (size_t)l * DM * MIXW, nullptr, scr, r / 16, r % 16, lane); continue; } r -= NLAYER * I_OUT;
            { const int l = r / I_R; r %= I_R; p0_transpose_item<0>(in_rw + (size_t)l * DM * NEXP, DM, NEXP, ROUT + (size_t)l * NEXP * DM, nullptr, scr, r, 0, lane); }
        }
        { constexpr int NIT8 = 64 * 256 + 64 * 128 + NLAYER * 192;
          const int nmine = (gw < NIT8) ? (NIT8 - gw + NGW - 1) / NGW : 0; const int J = 2 * nmine;
          f32x4 lda[16], ldb[16];
          if (J > 0) { const SubT t = fp8_subtile(gw, 0, in_wgu, in_wdn, in_win, WGU8, WDN8, WIN8, lane); fp8_sub_load(t, lda); }
#pragma unroll 1
          for (int j = 0; j < J; j += 2) {
              const int item = gw + (j >> 1) * NGW;
              const SubT t0 = fp8_subtile(item, 0, in_wgu, in_wdn, in_win, WGU8, WDN8, WIN8, lane), t1 = fp8_subtile(item, 1, in_wgu, in_wdn, in_win, WGU8, WDN8, WIN8, lane);
              fp8_sub_load(t1, ldb);
              fp8_sub_process(t0, lda, scr, lane);
              if (j + 2 < J) { const SubT t2 = fp8_subtile(item + NGW, 0, in_wgu, in_wdn, in_win, WGU8, WDN8, WIN8, lane); fp8_sub_load(t2, lda); }
              fp8_sub_process(t1, ldb, scr, lane);
          } }
        __syncthreads();
    }
    if (IN(0)) {
        for (int m = gw; m < MROWS; m += NGW) { const float* xr = in_x + (size_t)m * DM; bf16* ob = XB + (size_t)m * DM; f32x4 v[4];
#pragma unroll
            for (int j = 0; j < 4; ++j) { v[j] = *(const f32x4*)(xr + 4 * lane + 256 * j); v2u w; w.x = pk2(v[j][0], v[j][1]); w.y = pk2(v[j][2], v[j][3]); *(v2u*)(ob + 4 * lane + 256 * j) = w;
                *(unsigned*)(XP8 + (size_t)m * DM + 4 * lane + 256 * j) = pg8::pk4_fp8(v[j][0] * SC_X, v[j][1] * SC_X, v[j][2] * SC_X, v[j][3] * SC_X); }
            }
    }

    SEAM(0);
    run_layer<0>(args, lo, hi, bar);
    run_layer<1>(args, lo, hi, bar);
#undef IN
#undef SEAM
}

extern "C" void kernel_launch(void* const* d_in, const int* in_sizes, int n_in, void* d_out, int out_size, void* d_ws, size_t ws_size, hipStream_t stream) {
    static int grid = 0;
    if (grid == 0) {
        if (n_in != 20 || out_size != MROWS * DM || ws_size < WS_END) { fprintf(stderr, "kernel_launch: unexpected problem (n_in %d, out %d, ws %zu)\n", n_in, out_size, ws_size); grid = -1; return; }
        if (hipFuncSetAttribute((const void*)mk_fwd, hipFuncAttributeMaxDynamicSharedMemorySize, LDS_BYTES) != hipSuccess) { fprintf(stderr, "kernel_launch: hipFuncSetAttribute failed\n"); grid = -1; return; }
        int dev = 0, cus = 0, per_cu = 0;
        (void)hipGetDevice(&dev); (void)hipDeviceGetAttribute(&cus, hipDeviceAttributeMultiprocessorCount, dev);
        if (hipOccupancyMaxActiveBlocksPerMultiprocessor(&per_cu, (const void*)mk_fwd, NWAVES * 64, LDS_BYTES) != hipSuccess || per_cu < 1) fprintf(stderr, "kernel_launch: occupancy query says %d\n", per_cu);
        (void)hipGetLastError();
        grid = cus > 0 ? cus : 256;
    }
    if (grid < 0) return;
    (void)hipMemsetAsync((char*)d_ws + WS_CTL, 0, CTL_ZERO_BYTES, stream);
    Args a{};
    for (int i = 0; i < 20; ++i) a.in[i] = (const float*)d_in[i];
    a.out = (float*)d_out; a.ws = (unsigned char*)d_ws;
    a.ph_lo = 0; a.ph_hi = N_PHASES; a.sub = 7; a.pad = 0;
    hipLaunchKernelGGL(mk_fwd, dim3(grid), dim3(NWAVES * 64), LDS_BYTES, stream, a);
#ifdef PROBE_PH
#ifndef PROBE_SUB
#define PROBE_SUB 7
#endif
    for (int i = 0; i < PROBE_N; ++i) { a.ph_lo = PROBE_PH; a.ph_hi = PROBE_PH + 1; a.sub = PROBE_SUB; hipLaunchKernelGGL(mk_fwd, dim3(grid), dim3(NWAVES * 64), LDS_BYTES, stream, a); }
#endif
}
```

```cpp
#include <hip/hip_runtime.h>
#include <cstdio>
#include <cstdint>
#include <cmath>

namespace pg8 {
#define PG8_LAS __attribute__((address_space(3)))
typedef unsigned short bf16_t;
typedef short bf16x8 __attribute__((ext_vector_type(8)));
typedef float f32x4 __attribute__((ext_vector_type(4)));
typedef float f32x2 __attribute__((ext_vector_type(2)));
typedef unsigned u32x4 __attribute__((ext_vector_type(4)));
constexpr int BM = 256, BK = 64, HALF = 128, HTB = HALF * BK * 2  , STAGE_BYTES = 8 * HTB, NXCD = 8, WGM = 8;

__host__ __device__ __forceinline__ int lds_byte(int r, int c) { const int st = (r >> 4) * 2 + (c >> 5), rr = r & 15, cc = c & 31, ob = rr * 64 + cc * 2; return st * 1024 + (ob ^ (((ob >> 9) & 1) << 5)); }
__host__ __device__ __forceinline__ void stage_rc(int b, int& R, int& C) { const int st = b / 1024, sb = b % 1024, swz = sb ^ (((sb >> 9) & 1) << 5); R = (st >> 1) * 16 + swz / 64; C = (st & 1) * 32 + (swz % 64) / 2; }
__host__ __device__ __forceinline__ int perm32(int rho) { const int n = rho >> 4, i = rho & 15; return 8 * (i >> 2) + 4 * n + (i & 3); }

struct Unit { int pm, pn, e, r0; };
struct Gemm { const bf16_t* A; const bf16_t* Bt; int M, N, K; };

struct StaticOrder {
    int nM, nN, nwg, G, c, base, lim;
    __device__ void init(int M, int N, int G_, int c_) { nM = M / BM; nN = N / BM; nwg = nM * nN; G = G_; c = c_; base = 0; lim = nwg; }
    __device__ __forceinline__ bool next(int i, Unit& u) const {
        const long L = (long)i * G + c + base; if (L >= lim) return false;
        int wgid = (int)L; { const int q = nwg / NXCD, r = nwg % NXCD, xcd = wgid % NXCD, off = wgid / NXCD; wgid = (xcd < r ? xcd * (q + 1) : r * (q + 1) + (xcd - r) * q) + off; }
        const int nig = WGM * nN, gid = wgid / nig, fm = gid * WGM, gsz = (nM - fm) < WGM ? (nM - fm) : WGM;
        u.pm = fm + ((wgid % nig) % gsz); u.pn = (wgid % nig) / gsz; u.e = 0; u.r0 = 0; return true;
    }
    __device__ __forceinline__ const char* abase(const Unit& u, const Gemm& g, size_t tstep) const { return (const char*)g.A + (size_t)u.pm * tstep; }
    __device__ __forceinline__ const char* bbase(const Unit& u, const Gemm& g, size_t tstep) const { return (const char*)g.Bt + (size_t)u.pn * tstep; }
    static constexpr bool SIDE = false;
    __device__ __forceinline__ unsigned arow(const Unit&, int) const { return 0u; }
    __device__ __forceinline__ unsigned arow_side(const Unit&, int, const PG8_LAS unsigned char*) const { return 0u; }
    __device__ __forceinline__ const void* side_src(const Unit&, const Unit&, int, int) const { return nullptr; }
    __device__ __forceinline__ void a_ready(const Unit&) const {}
    __device__ __forceinline__ void done(const Unit&) const {}
};

struct MoeOrder {
    const PG8_LAS int* units;
    int nunits;
    const PG8_LAS int* cnt;
    const int* rowtok;
    int gather;
    unsigned rowbytes;
    size_t bstride;
    __device__ __forceinline__ bool next(int i, Unit& u) const {
        if (i >= nunits) return false;
        u.pm = __builtin_amdgcn_readfirstlane(units[4 * i + 0]); u.pn = __builtin_amdgcn_readfirstlane(units[4 * i + 1]);
        u.e = __builtin_amdgcn_readfirstlane(units[4 * i + 2]); u.r0 = __builtin_amdgcn_readfirstlane(units[4 * i + 3]); return true;
    }
    __device__ __forceinline__ const char* abase(const Unit& u, const Gemm& g, size_t tstep) const { return gather ? (const char*)g.A : (const char*)g.A + (size_t)u.pm * tstep; }
    __device__ __forceinline__ const char* bbase(const Unit& u, const Gemm& g, size_t tstep) const { return (const char*)g.Bt + (size_t)u.e * bstride + (size_t)u.pn * tstep; }
    static constexpr bool SIDE = true;
    const float* rowgate; const float* bgu;
    __device__ __forceinline__ unsigned arow(const Unit& u, int R) const {
        const int r = u.r0 + R; const int idx = (r < cnt[u.e]) ? rowtok[(size_t)u.e * 32768 + r] : 0; return (unsigned)(idx >> 2) * rowbytes; }
    __device__ __forceinline__ unsigned arow_side(const Unit& u, int R, const PG8_LAS unsigned char* sd) const {
        const int r = u.r0 + R; const int v = ((const PG8_LAS int*)sd)[R]; const int idx = (r < cnt[u.e]) ? v : 0; return (unsigned)(idx >> 2) * rowbytes; }
    __device__ __forceinline__ const void* side_src(const Unit& cur, const Unit& rt, int wid, int lane) const {
        if (rowgate != nullptr && wid == 1) return rowgate + (size_t)cur.e * 32768 + cur.r0 + 4 * lane;
        if (bgu != nullptr && wid == 2) return gather ? (bgu + (size_t)cur.e * 2048 + (lane < 32 ? 0 : 1024 - 128) + cur.pn * 128 + 4 * lane)
                                                      : (bgu + (size_t)cur.e * 1024 + cur.pn * 256 + 4 * lane);
        return rowtok + (size_t)rt.e * 32768 + rt.r0 + 4 * lane; }
    __device__ __forceinline__ void a_ready(const Unit&) const {}
    __device__ __forceinline__ void done(const Unit&) const {}
};
__device__ __forceinline__ void moe_build_units(PG8_LAS int* units, PG8_LAS int* units_n, const PG8_LAS int* tstart, int nN, int G, int c, int tid) {
    if (tid < 64) {
        const int nT = tstart[32], nwg = nT * nN; const long L = (long)tid * G + c;
        int pm = 0, pn = 0, e = 0, r0 = 0;
        if (L < nwg) {
            int wgid = (int)L; { const int q = nwg / NXCD, r = nwg % NXCD, xcd = wgid % NXCD, off = wgid / NXCD; wgid = (xcd < r ? xcd * (q + 1) : r * (q + 1) + (xcd - r) * q) + off; }
            const int nig = WGM * nN, gid = wgid / nig, fm = gid * WGM, gsz = (nT - fm) < WGM ? (nT - fm) : WGM;
            pm = fm + ((wgid % nig) % gsz); pn = (wgid % nig) / gsz;
            for (int j = 1; j < 32; ++j) e += (tstart[j] <= pm) ? 1 : 0;
            r0 = (pm - tstart[e]) * 256;
        }
        units[4 * tid + 0] = pm; units[4 * tid + 1] = pn; units[4 * tid + 2] = e; units[4 * tid + 3] = r0;
        if (tid == 0) { int n = 0; if (c < nwg) n = (nwg - c + G - 1) / G; units_n[0] = n < 64 ? n : 64; }
    }
}

__host__ __device__ __forceinline__ unsigned hblk_off(int R, int p7) { const int ai = R >> 7, wr = (R >> 6) & 1, m = (R >> 4) & 3, fr = R & 15, wc = p7 >> 1, fq = ((p7 & 1) << 1) | (m & 1), mp = m >> 1;
    return (unsigned)(((((ai * 2 + wr) * 4 + wc) * 2 + mp) * 64 + fr + 16 * fq) * 16); }
typedef int v8i_t __attribute__((ext_vector_type(8)));
typedef int v4i_t __attribute__((ext_vector_type(4)));
__device__ __forceinline__ v8i_t cat8(bf16x8 lo, bf16x8 hi) { const v4i_t a = __builtin_bit_cast(v4i_t, lo), b = __builtin_bit_cast(v4i_t, hi); return __builtin_shufflevector(a, b, 0, 1, 2, 3, 4, 5, 6, 7); }
__device__ __forceinline__ void mfma8(f32x4& acc, v8i_t a, v8i_t b, int scl) { asm volatile("v_mfma_scale_f32_16x16x128_f8f6f4 %0, %1, %2, %0, %3, %3 op_sel_hi:[0,0,0]" : "+v"(acc) : "v"(a), "v"(b), "v"(scl)); }
__device__ __forceinline__ unsigned pk4_fp8(float a, float b, float c, float d) { unsigned w = 0u; w = __builtin_amdgcn_cvt_pk_fp8_f32(a, b, w, false); w = __builtin_amdgcn_cvt_pk_fp8_f32(c, d, w, true); return w; }
__device__ __forceinline__ unsigned cvt_pk_bf16(float lo, float hi) { unsigned r; asm volatile("v_cvt_pk_bf16_f32 %0, %1, %2" : "=v"(r) : "v"(lo), "v"(hi)); return r; }

struct EpiProj {
    static constexpr bool PERM = true, AFTER_DRAIN = false;
    bf16_t* O; int ldc; const float* rope; float qscale; float dqv; int pn_off;
    __device__ __forceinline__ void operator()(const f32x4 (&acc)[2][2][4][2], const Unit& u, int wr, int wc, int fr, int fq, const PG8_LAS unsigned char* sd) const {
        const int pnn = u.pn + pn_off; const int row0 = u.pm * BM + wr * 64 + fr; const int col0 = pnn * BM + wc * 32 + 8 * fq;
        const bool rot = pnn < 4; const float sc = (pnn < 2 ? qscale : 1.f) * dqv; const int gq = 4 * (wc & 1) + fq;
        float invr[4];
#pragma unroll
        for (int e = 0; e < 4; ++e) invr[e] = __builtin_amdgcn_exp2f(-(float)(4 * gq + e) * 0.41524101186092029f) * 0.15915494309189535f;
#pragma unroll
        for (int ai = 0; ai < 2; ++ai)
#pragma unroll
            for (int m = 0; m < 4; ++m) { const int row = row0 + ai * HALF + m * 16; bf16_t* rowp = O + (size_t)row * ldc + col0;
                f32x4 cs0 = (f32x4){1.f, 0.f, 1.f, 0.f}, cs1 = cs0;
                if (rot) { const float tp = (float)(row & 4095);
                    const float a0 = __builtin_amdgcn_fractf(tp * invr[0]), a1 = __builtin_amdgcn_fractf(tp * invr[1]), a2 = __builtin_amdgcn_fractf(tp * invr[2]), a3 = __builtin_amdgcn_fractf(tp * invr[3]);
                    cs0 = (f32x4){__builtin_amdgcn_cosf(a0), __builtin_amdgcn_sinf(a0), __builtin_amdgcn_cosf(a1), __builtin_amdgcn_sinf(a1)};
                    cs1 = (f32x4){__builtin_amdgcn_cosf(a2), __builtin_amdgcn_sinf(a2), __builtin_amdgcn_cosf(a3), __builtin_amdgcn_sinf(a3)}; }
#pragma unroll
                for (int bj = 0; bj < 2; ++bj) { f32x4 v0 = acc[ai][bj][m][0], v1 = acc[ai][bj][m][1];
                    if (rot) { f32x4 lo, hi;
                        lo[0] = v0[0] * cs0[0] - v1[0] * cs0[1]; hi[0] = v1[0] * cs0[0] + v0[0] * cs0[1];
                        lo[1] = v0[1] * cs0[2] - v1[1] * cs0[3]; hi[1] = v1[1] * cs0[2] + v0[1] * cs0[3];
                        lo[2] = v0[2] * cs1[0] - v1[2] * cs1[1]; hi[2] = v1[2] * cs1[0] + v0[2] * cs1[1];
                        lo[3] = v0[3] * cs1[2] - v1[3] * cs1[3]; hi[3] = v1[3] * cs1[2] + v0[3] * cs1[3];
                        v0 = lo * sc; v1 = hi * sc; }
                    else { v0 = v0 * dqv; v1 = v1 * dqv; }
                    u32x4 w; w.x = cvt_pk_bf16(v0[0], v0[1]); w.y = cvt_pk_bf16(v0[2], v0[3]); w.z = cvt_pk_bf16(v1[0], v1[1]); w.w = cvt_pk_bf16(v1[2], v1[3]);
                    *(u32x4*)(rowp + bj * HALF) = w; } }
    }
};
struct EpiF32 {
    static constexpr bool PERM = false, AFTER_DRAIN = false;
    float* O; int ldc;
    __device__ __forceinline__ void operator()(const f32x4 (&acc)[2][2][4][2], const Unit& u, int wr, int wc, int fr, int fq, const PG8_LAS unsigned char* sd) const {
        const int row0 = u.pm * BM + wr * 64 + fr; const int col0 = u.pn * BM + wc * 32 + 4 * fq;
#pragma unroll
        for (int ai = 0; ai < 2; ++ai)
#pragma unroll
            for (int m = 0; m < 4; ++m) { float* rowp = O + (size_t)(row0 + ai * HALF + m * 16) * ldc + col0;
#pragma unroll
                for (int bj = 0; bj < 2; ++bj)
#pragma unroll
                    for (int n = 0; n < 2; ++n) *(f32x4*)(rowp + bj * HALF + n * 16) = acc[ai][bj][m][n]; }
    }
};
struct EpiBf16Plain {
    static constexpr bool PERM = true, AFTER_DRAIN = false;
    bf16_t* O; int ldc;
    __device__ __forceinline__ void operator()(const f32x4 (&acc)[2][2][4][2], const Unit& u, int wr, int wc, int fr, int fq, const PG8_LAS unsigned char* sd) const {
        const int row0 = u.pm * BM + wr * 64 + fr; const int col0 = u.pn * BM + wc * 32 + 8 * fq;
#pragma unroll
        for (int ai = 0; ai < 2; ++ai)
#pragma unroll
            for (int m = 0; m < 4; ++m) { bf16_t* rowp = O + (size_t)(row0 + ai * HALF + m * 16) * ldc + col0;
#pragma unroll
                for (int bj = 0; bj < 2; ++bj) { const f32x4 v0 = acc[ai][bj][m][0], v1 = acc[ai][bj][m][1];
                    u32x4 w; w.x = cvt_pk_bf16(v0[0], v0[1]); w.y = cvt_pk_bf16(v0[2], v0[3]); w.z = cvt_pk_bf16(v1[0], v1[1]); w.w = cvt_pk_bf16(v1[2], v1[3]);
                    *(u32x4*)(rowp + bj * HALF) = w; } }
    }
};
struct EpiSwiglu {
    static constexpr bool PERM = true, AFTER_DRAIN = false;
    unsigned char* H; const float* bgu; const float* rowgate; const PG8_LAS int* cnt; float dq, hscale;
    __device__ __forceinline__ void operator()(const f32x4 (&acc)[2][2][4][2], const Unit& u, int wr, int wc, int fr, int fq, const PG8_LAS unsigned char* sd) const {
        const int ff = u.pn * HALF + wc * 32 + 8 * fq; const int n_e = cnt[u.e];
        f32x4 bg[2], bu[2];
#pragma unroll
        for (int n = 0; n < 2; ++n) { bg[n] = *(const PG8_LAS f32x4*)(sd + 2048 + (wc * 32 + 8 * fq + 4 * n) * 4); bu[n] = *(const PG8_LAS f32x4*)(sd + 2048 + 512 + (wc * 32 + 8 * fq + 4 * n) * 4); }
        const int lane = fr + 16 * fq;
#pragma unroll
        for (int ai = 0; ai < 2; ++ai)
#pragma unroll
            for (int mp = 0; mp < 2; ++mp) {
                unsigned pw[2][2];
#pragma unroll
                for (int mm = 0; mm < 2; ++mm) { const int m = 2 * mp + mm; const int r = ai * HALF + wr * 64 + m * 16 + fr; const int er = u.r0 + r;
                    const float rgl = ((const PG8_LAS float*)(sd + 1024))[r]; const float rg = ((er < n_e) ? rgl : 0.f) * hscale;
                    float hv[8];
#pragma unroll
                    for (int n = 0; n < 2; ++n)
#pragma unroll
                        for (int q = 0; q < 4; q += 2) {
                            f32x2 g = (f32x2){acc[ai][0][m][n][q], acc[ai][0][m][n][q + 1]} * dq + (f32x2){bg[n][q], bg[n][q + 1]};
                            f32x2 up = (f32x2){acc[ai][1][m][n][q], acc[ai][1][m][n][q + 1]} * dq + (f32x2){bu[n][q], bu[n][q + 1]};
                            g.x = fminf(g.x, 7.0f); g.y = fminf(g.y, 7.0f); up.x = fminf(fmaxf(up.x, -7.0f), 7.0f); up.y = fminf(fmaxf(up.y, -7.0f), 7.0f);
                            const f32x2 ea = g * (-1.702f * 1.4426950408889634f); f32x2 den; den.x = __builtin_amdgcn_exp2f(ea.x); den.y = __builtin_amdgcn_exp2f(ea.y); den = den + 1.0f;
                            f32x2 sg; sg.x = __builtin_amdgcn_rcpf(den.x); sg.y = __builtin_amdgcn_rcpf(den.y);
                            const f32x2 h2 = ((up + 1.0f) * g) * (sg * rg);
                            hv[n * 4 + q] = h2.x; hv[n * 4 + q + 1] = h2.y; }
                    pw[mm][0] = pk4_fp8(hv[0], hv[1], hv[2], hv[3]); pw[mm][1] = pk4_fp8(hv[4], hv[5], hv[6], hv[7]); }
                const auto s0 = __builtin_amdgcn_permlane16_swap(pw[0][0], pw[1][0], false, false); const auto s1 = __builtin_amdgcn_permlane16_swap(pw[0][1], pw[1][1], false, false);
                *(u32x4*)(H + ((size_t)u.pm * 8 + u.pn) * 32768 + ((((ai * 2 + wr) * 4 + wc) * 2 + mp) * 64 + lane) * 16) = (u32x4){s0[0], s1[0], s0[1], s1[1]};
                asm volatile("" ::: "memory"); }
    }
};
struct EpiScatter {
    static constexpr bool PERM = true, AFTER_DRAIN = false;
    unsigned char* Y; const int* rowtok; const PG8_LAS int* cnt; float dq, ysc;
    __device__ __forceinline__ void operator()(const f32x4 (&acc)[2][2][4][2], const Unit& u, int wr, int wc, int fr, int fq, const PG8_LAS unsigned char* sd) const {
        const int col0 = u.pn * BM + wc * 32 + 8 * fq; const int n_e = cnt[u.e];
        f32x4 bd[2][2];
#pragma unroll
        for (int bj = 0; bj < 2; ++bj)
#pragma unroll
            for (int n = 0; n < 2; ++n) bd[bj][n] = *(const PG8_LAS f32x4*)(sd + 2048 + (bj * HALF + wc * 32 + 8 * fq + 4 * n) * 4);
#pragma unroll
        for (int ai = 0; ai < 2; ++ai)
#pragma unroll
            for (int m = 0; m < 4; ++m) { const int er = u.r0 + ai * HALF + wr * 64 + m * 16 + fr;
                const int idx = ((const PG8_LAS int*)sd)[ai * HALF + wr * 64 + m * 16 + fr];
                if (er < n_e) { unsigned char* rowp = Y + (size_t)idx * 1024 + col0;
                    typedef unsigned u32x2 __attribute__((ext_vector_type(2)));
                    const float rg = ((const PG8_LAS float*)(sd + 1024))[ai * HALF + wr * 64 + m * 16 + fr] * ysc;
#pragma unroll
                    for (int bj = 0; bj < 2; ++bj) { const f32x4 v0 = acc[ai][bj][m][0] * dq + bd[bj][0] * rg, v1 = acc[ai][bj][m][1] * dq + bd[bj][1] * rg;
                        *(u32x2*)(rowp + bj * HALF) = (u32x2){pk4_fp8(v0[0], v0[1], v0[2], v0[3]), pk4_fp8(v1[0], v1[1], v1[2], v1[3])}; } }
                asm volatile("" ::: "memory"); }
    }
};

struct PanelStats {
    unsigned* xbuf;
    unsigned* cnt;
    unsigned* tmo;
    int ntn; float eps;
    unsigned code;
    __device__ __forceinline__ bool run(const f32x4 (&v)[2][2][4][2], const Unit& u, int wr, int wc, int fr, int fq, PG8_LAS unsigned char* lds, int wid, int lane) const {
        typedef float f32x2v __attribute__((ext_vector_type(2)));
        PG8_LAS f32x2v* P = (PG8_LAS f32x2v*)lds;
        PG8_LAS f32x2v* S = (PG8_LAS f32x2v*)(lds + 8192);
        PG8_LAS unsigned* flag = (PG8_LAS unsigned*)(lds + 8192 + 2048);
#pragma unroll
        for (int ai = 0; ai < 2; ++ai)
#pragma unroll
            for (int m = 0; m < 4; ++m) {
                float s = 0.f;
#pragma unroll
                for (int bj = 0; bj < 2; ++bj)
#pragma unroll
                    for (int n = 0; n < 2; ++n) { const f32x4 x = v[ai][bj][m][n]; s += (x[0] + x[1]) + (x[2] + x[3]); }
                s += __shfl_xor(s, 16); s += __shfl_xor(s, 32);
                const float mw = s * (1.0f / 64.0f); float q = 0.f;
#pragma unroll
                for (int bj = 0; bj < 2; ++bj)
#pragma unroll
                    for (int n = 0; n < 2; ++n) { const f32x4 d = v[ai][bj][m][n] - mw; q += (d[0] * d[0] + d[1] * d[1]) + (d[2] * d[2] + d[3] * d[3]); }
                q += __shfl_xor(q, 16); q += __shfl_xor(q, 32);
                if (fq == 0) P[(ai * HALF + wr * 64 + m * 16 + fr) * 4 + wc] = (f32x2v){mw, q};
            }
        asm volatile("s_waitcnt lgkmcnt(0)" ::: "memory"); __builtin_amdgcn_s_barrier(); asm volatile("" ::: "memory");
#if defined(BROKEN_EXCHANGE_NO_WAIT)
#warning BROKEN CONTROL BUILD: the row-statistics exchange does not wait; results are wrong by design
        if (blockIdx.x >= 64) { const long long t0_ = clock64(); while (clock64() - t0_ < 60000) __builtin_amdgcn_s_sleep(8); }
#endif
        const int row = wid * 32 + (lane & 31);
        if (lane < 32) {
            const f32x2v a = P[row * 4 + 0], b = P[row * 4 + 1], c = P[row * 4 + 2], d = P[row * 4 + 3];
            const float mt = (a.x + b.x + c.x + d.x) * 0.25f;
            const float da = a.x - mt, db = b.x - mt, dc = c.x - mt, dd = d.x - mt;
            const float m2 = (a.y + b.y) + (c.y + d.y) + 64.0f * ((da * da + db * db) + (dc * dc + dd * dd));
            unsigned long long* slot = (unsigned long long*)xbuf + ((size_t)(u.pm * BM + row) * 4 + u.pn);
            __hip_atomic_store(slot, ((unsigned long long)__float_as_uint(m2) << 32) | __float_as_uint(mt), __ATOMIC_RELAXED, __HIP_MEMORY_SCOPE_AGENT);
        }
        asm volatile("s_waitcnt vmcnt(0)" ::: "memory");
        if (lane == 0) __hip_atomic_fetch_add(cnt + 64 * u.pm, 1u, __ATOMIC_RELAXED, __HIP_MEMORY_SCOPE_AGENT);
        if (wid == 0) {
            const unsigned want = 8u * (unsigned)ntn; unsigned sp = 0u;
            while ((unsigned)__builtin_amdgcn_readfirstlane(__hip_atomic_load(cnt + 64 * u.pm, __ATOMIC_RELAXED, __HIP_MEMORY_SCOPE_AGENT)) < want) { __builtin_amdgcn_s_sleep(2); if (++sp > (1u << 20)) break; }
            __builtin_amdgcn_fence(__ATOMIC_ACQUIRE, "agent");
        }
        asm volatile("s_waitcnt vmcnt(0) lgkmcnt(0)" ::: "memory"); __builtin_amdgcn_s_barrier(); asm volatile("" ::: "memory");
        const bool bad = false;
        if (lane < 32) {
            const unsigned long long* slot = (const unsigned long long*)xbuf + (size_t)(u.pm * BM + row) * 4; float mt[4], m2[4]; float ms = 0.f;
#pragma unroll
            for (int t = 0; t < 4; ++t) { if (t < ntn) { const unsigned long long w = __hip_atomic_load(slot + t, __ATOMIC_RELAXED, __HIP_MEMORY_SCOPE_AGENT); mt[t] = __uint_as_float((unsigned)w); m2[t] = __uint_as_float((unsigned)(w >> 32)); } else { mt[t] = 0.f; m2[t] = 0.f; } ms += mt[t]; }
            const float mean = ms / (float)ntn; float q = 0.f;
#pragma unroll
            for (int t = 0; t < 4; ++t) if (t < ntn) { const float dm = mt[t] - mean; q += m2[t] + 256.0f * dm * dm; }
            S[row] = (f32x2v){mean, 1.0f / sqrtf(q / (256.0f * (float)ntn) + eps)};
        }
        asm volatile("s_waitcnt lgkmcnt(0)" ::: "memory"); __builtin_amdgcn_s_barrier(); asm volatile("" ::: "memory");
        return bad;
    }
};

struct EpiLn1 {
    static constexpr bool PERM = true, AFTER_DRAIN = true;
    unsigned char* ws; const float* gam; const float* bet; size_t o_xb, o_x8, o_xbuf, o_cnt, o_tmo; float alpha, s8, eps; unsigned code;
    __device__ __forceinline__ void operator()(const f32x4 (&)[2][2][4][2], const Unit&, int, int, int, int, const PG8_LAS unsigned char*) const {}
    __device__ __forceinline__ void fused(f32x4 (&acc)[2][2][4][2], const Unit& u, int wr, int wc, int fr, int fq, PG8_LAS unsigned char* lds, int wid, int lane) const {
        typedef float f32x2v __attribute__((ext_vector_type(2))); typedef unsigned u32x2 __attribute__((ext_vector_type(2)));
        bf16_t* const XBp = (bf16_t*)(ws + o_xb); unsigned char* const X8 = ws + o_x8;
        const PanelStats st{(unsigned*)(ws + o_xbuf), (unsigned*)(ws + o_cnt), (unsigned*)(ws + o_tmo), 4, eps, code};
        const int col0 = u.pn * BM + wc * 32 + 8 * fq;
#pragma unroll
        for (int ai = 0; ai < 2; ++ai)
#pragma unroll
            for (int m = 0; m < 4; ++m) { const bf16_t* xr = XBp + (size_t)(u.pm * BM + ai * HALF + wr * 64 + m * 16 + fr) * 1024 + col0;
#pragma unroll
                for (int bj = 0; bj < 2; ++bj) { const u32x4 x = *(const u32x4*)(xr + bj * HALF);
                    acc[ai][bj][m][0] += (f32x4){__builtin_bit_cast(float, x.x << 16), __builtin_bit_cast(float, x.x & 0xffff0000u), __builtin_bit_cast(float, x.y << 16), __builtin_bit_cast(float, x.y & 0xffff0000u)} * alpha;
                    acc[ai][bj][m][1] += (f32x4){__builtin_bit_cast(float, x.z << 16), __builtin_bit_cast(float, x.z & 0xffff0000u), __builtin_bit_cast(float, x.w << 16), __builtin_bit_cast(float, x.w & 0xffff0000u)} * alpha; }
                asm volatile("" ::: "memory"); }
        (void)st.run(acc, u, wr, wc, fr, fq, lds, wid, lane);
        const PG8_LAS f32x2v* S = (const PG8_LAS f32x2v*)(lds + 8192);
#pragma unroll
        for (int bj = 0; bj < 2; ++bj) {
            const f32x4 g0 = *(const f32x4*)(gam + col0 + bj * HALF), g1 = *(const f32x4*)(gam + col0 + bj * HALF + 4), b0 = *(const f32x4*)(bet + col0 + bj * HALF), b1 = *(const f32x4*)(bet + col0 + bj * HALF + 4);
#pragma unroll
            for (int ai = 0; ai < 2; ++ai)
#pragma unroll
                for (int m = 0; m < 4; ++m) { const int r = ai * HALF + wr * 64 + m * 16 + fr; const f32x2v sr = S[r]; const size_t off = (size_t)(u.pm * BM + r) * 1024 + col0 + bj * HALF;
                    const f32x4 o0 = (acc[ai][bj][m][0] - sr.x) * sr.y * g0 + b0, o1 = (acc[ai][bj][m][1] - sr.x) * sr.y * g1 + b1;
                    u32x4 w; w.x = cvt_pk_bf16(o0[0], o0[1]); w.y = cvt_pk_bf16(o0[2], o0[3]); w.z = cvt_pk_bf16(o1[0], o1[1]); w.w = cvt_pk_bf16(o1[2], o1[3]);
                    *(u32x4*)(XBp + off) = w;
                    *(u32x2*)(X8 + off) = (u32x2){pk4_fp8(o0[0] * s8, o0[1] * s8, o0[2] * s8, o0[3] * s8), pk4_fp8(o1[0] * s8, o1[1] * s8, o1[2] * s8, o1[3] * s8)};
                    asm volatile("" ::: "memory"); } }
    }
};

template <class Epi, class Sched, bool ALIGN_EPI, bool GATHER, bool FP8 = false, bool ABLK = false>
__device__ __forceinline__ void gemm_phase(PG8_LAS unsigned char* lds, const Gemm g, const Sched& S, const Epi& E) {
    const int tid = threadIdx.x, wid = __builtin_amdgcn_readfirstlane(tid >> 6), lane = tid & 63, wr = wid >> 2, wc = wid & 3, fr = lane & 15, fq = lane >> 4;
    const int K = g.K, nt = K / BK;
    unsigned voffB[2];
#pragma unroll
    for (int i = 0; i < 2; ++i) { int R, C; stage_rc(tid * 16 + i * 8192, R, C); const int Rb = Epi::PERM ? ((R & ~31) + perm32(R & 31)) : R;
        voffB[i] = (unsigned)(Rb * K + C) * 2u; }
    constexpr int SIDE_BYTES = 8192;
    PG8_LAS unsigned char* const side = lds + STAGE_BYTES;
    const size_t kstep = (size_t)(BK * 2);
    const size_t kstepA = ABLK ? (size_t)32768 : kstep;
    const size_t hstep = (size_t)HALF * K * 2;
    const size_t tstep = 2 * hstep;
    const unsigned ldsw = (unsigned)wid * 1024u;
    const int aoff = lds_byte(wr * 64 + fr, fq * 8), boff = lds_byte(wc * 32 + fr, fq * 8);
#define PG8_SA(b, h) (((b) * 2 + (h)) * HTB)
#define PG8_SB(b, h) ((4 + (b) * 2 + (h)) * HTB)
#define PG8_STAGE(bufoff, gbase, voff) do { _Pragma("unroll") for (int _i = 0; _i < 2; ++_i) \
        __builtin_amdgcn_global_load_lds((const unsigned*)((const char*)(gbase) + (voff)[_i]), (PG8_LAS unsigned*)(lds + (bufoff) + ldsw + _i * 8192), 16, 0, 0); } while (0)
#define PG8_LDA(dst, b, h) do { _Pragma("unroll") for (int m = 0; m < 4; ++m) _Pragma("unroll") for (int k = 0; k < 2; ++k) dst[m][k] = *(const PG8_LAS bf16x8*)(lds + PG8_SA(b, h) + aoff + m * 2048 + k * 1024); } while (0)
#define PG8_LDB(dst, b, h) do { _Pragma("unroll") for (int n = 0; n < 2; ++n) _Pragma("unroll") for (int k = 0; k < 2; ++k) dst[n][k] = *(const PG8_LAS bf16x8*)(lds + PG8_SB(b, h) + boff + n * 2048 + k * 1024); } while (0)
#define PG8_MMA(ai, bj, At, Bt) do { __builtin_amdgcn_s_setprio(1); _Pragma("unroll") for (int m = 0; m < 4; ++m) _Pragma("unroll") for (int n = 0; n < 2; ++n) { \
        if constexpr (FP8) mfma8(acc[ai][bj][m][n], cat8(Bt[n][0], Bt[n][1]), cat8(At[m][0], At[m][1]), scl8); \
        else { _Pragma("unroll") for (int k = 0; k < 2; ++k) acc[ai][bj][m][n] = __builtin_amdgcn_mfma_f32_16x16x32_bf16(Bt[n][k], At[m][k], acc[ai][bj][m][n], 0, 0, 0); } } __builtin_amdgcn_s_setprio(0); } while (0)
#define PG8_WAIT_V(n) asm volatile("s_waitcnt vmcnt(" #n ")" ::: "memory")
#define PG8_WAIT_L(n) asm volatile("s_waitcnt lgkmcnt(" #n ")" ::: "memory")
#define PG8_BAR __builtin_amdgcn_s_barrier()
#define PG8_SCHED __builtin_amdgcn_sched_barrier(0)
#define PG8_SETOFFS(o, u) do { _Pragma("unroll") for (int _h = 0; _h < 2; ++_h) _Pragma("unroll") for (int _i = 0; _i < 2; ++_i) { int _R, _C; stage_rc(tid * 16 + _i * 8192, _R, _C); \
        o[_h][_i] = GATHER ? (S.arow(u, _R + HALF * _h) + (unsigned)(_C * 2)) : ABLK ? hblk_off(_R + HALF * _h, _C >> 3) : ((unsigned)((_R + HALF * _h) * K) * 2u + (unsigned)(_C * 2)); } } while (0)
    int scl8 = 0x7F7F7F7F; asm volatile("" : "+v"(scl8));
    Unit cur, nxt; int ui = 0;
    if (!S.next(0, cur)) return;
    f32x4 acc[2][2][4][2];
#pragma unroll
    for (int a = 0; a < 2; ++a)
#pragma unroll
        for (int b = 0; b < 2; ++b)
#pragma unroll
            for (int m = 0; m < 4; ++m)
#pragma unroll
                for (int n = 0; n < 2; ++n) { acc[a][b][m][n] = (f32x4){0.f, 0.f, 0.f, 0.f}; if constexpr (FP8) asm volatile("" : "+v"(acc[a][b][m][n])); }
    bf16x8 At[4][2], B0[2][2], B1[2][2];
    unsigned cAo[2][2];
    PG8_SETOFFS(cAo, cur);
    const char* cA = S.abase(cur, g, tstep); const char* cB = S.bbase(cur, g, tstep);
    S.a_ready(cur);
    PG8_STAGE(PG8_SB(0, 0), cB, voffB); PG8_STAGE(PG8_SB(0, 1), cB + hstep, voffB); PG8_STAGE(PG8_SA(0, 0), cA, cAo[0]); PG8_STAGE(PG8_SA(0, 1), cA, cAo[1]);
    if (wr == 1) PG8_BAR;
    PG8_WAIT_V(2); PG8_BAR;
    PG8_STAGE(PG8_SB(1, 0), cB + kstep, voffB); PG8_STAGE(PG8_SA(1, 0), cA + kstepA, cAo[0]); PG8_STAGE(PG8_SB(1, 1), cB + hstep + kstep, voffB);
    PG8_WAIT_V(6); PG8_BAR;
    for (;;) {
        const bool has_next = S.next(ui + 1, nxt);
        const char* nA = has_next ? S.abase(nxt, g, tstep) : cA; const char* nB = has_next ? S.bbase(nxt, g, tstep) : cB;
        if constexpr (Sched::SIDE) {
            const void* ssrc = S.side_src(cur, (GATHER && has_next) ? nxt : cur, wid, lane);
            __builtin_amdgcn_global_load_lds((const unsigned*)ssrc, (PG8_LAS unsigned*)(side + (ui & 1) * SIDE_BYTES + wid * 1024), 16, 0, 0); }
#pragma unroll 1
        for (int t = 0; t < nt; t += 2) {
            const bool last = (t == nt - 2);
            const char* a1 = cA + (size_t)(t + 1) * kstepA;
            const char* a2 = last ? nA : cA + (size_t)(t + 2) * kstepA; const char* b2 = last ? nB : cB + (size_t)(t + 2) * kstep;
            const char* a3 = a2 + kstepA; const char* b3 = b2 + kstep;
            if (last && has_next) S.a_ready(nxt);
            PG8_LDB(B0, 0, 0); PG8_LDB(B1, 0, 1); PG8_SCHED; PG8_LDA(At, 0, 0); PG8_STAGE(PG8_SA(1, 1), a1, cAo[1]);
            if constexpr (GATHER) { if (last && has_next) {
                const PG8_LAS unsigned char* sdn = side + (ui & 1) * SIDE_BYTES;
#pragma unroll
                for (int _h = 0; _h < 2; ++_h)
#pragma unroll
                    for (int _i = 0; _i < 2; ++_i) { int _R, _C; stage_rc(tid * 16 + _i * 8192, _R, _C); cAo[_h][_i] = S.arow_side(nxt, _R + HALF * _h, sdn) + (unsigned)(_C * 2); } } }
            PG8_WAIT_V(8); PG8_WAIT_L(0); PG8_BAR; PG8_MMA(0, 0, At, B0); PG8_MMA(0, 1, At, B1); PG8_BAR; PG8_SCHED;
            PG8_LDA(At, 0, 1); PG8_STAGE(PG8_SB(0, 0), b2, voffB); PG8_STAGE(PG8_SB(0, 1), b2 + hstep, voffB); PG8_STAGE(PG8_SA(0, 0), a2, cAo[0]);
            PG8_WAIT_V(8); PG8_WAIT_L(0); PG8_BAR; PG8_MMA(1, 0, At, B0); PG8_MMA(1, 1, At, B1); PG8_BAR; PG8_SCHED;
            PG8_LDB(B0, 1, 0); PG8_LDB(B1, 1, 1); PG8_SCHED; PG8_LDA(At, 1, 0); PG8_STAGE(PG8_SA(0, 1), a2, cAo[1]);
            PG8_WAIT_V(8); PG8_WAIT_L(0); PG8_BAR; PG8_MMA(0, 0, At, B0); PG8_MMA(0, 1, At, B1); PG8_BAR; PG8_SCHED;
            PG8_LDA(At, 1, 1); PG8_STAGE(PG8_SB(1, 0), b3, voffB); PG8_STAGE(PG8_SB(1, 1), b3 + hstep, voffB); PG8_STAGE(PG8_SA(1, 0), a3, cAo[0]);
            PG8_WAIT_V(8); PG8_WAIT_L(0); PG8_BAR; PG8_MMA(1, 0, At, B0); PG8_MMA(1, 1, At, B1); PG8_BAR; PG8_SCHED;
        }
        if constexpr (ALIGN_EPI) { if (wr == 0) PG8_BAR; }
        if constexpr (FP8) asm volatile("s_nop 15\n\ts_nop 15" ::: "memory");
        if constexpr (!Epi::AFTER_DRAIN) { PG8_SCHED; E(acc, cur, wr, wc, fr, fq, side + (ui & 1) * SIDE_BYTES); S.done(cur); PG8_SCHED; }
        if (!has_next) break;
#pragma unroll
        for (int a = 0; a < 2; ++a)
#pragma unroll
            for (int b = 0; b < 2; ++b)
#pragma unroll
                for (int m = 0; m < 4; ++m)
#pragma unroll
                    for (int n = 0; n < 2; ++n) { acc[a][b][m][n] = (f32x4){0.f, 0.f, 0.f, 0.f}; if constexpr (FP8) asm volatile("" : "+v"(acc[a][b][m][n])); }
        cur = nxt; cA = nA; cB = nB; ++ui;
        if constexpr (ALIGN_EPI) { if (wr == 1) PG8_BAR; }
    }
    PG8_WAIT_V(0);
    if constexpr (!ALIGN_EPI) { if (wr == 0) PG8_BAR; }
    PG8_BAR;
    if constexpr (Epi::AFTER_DRAIN) { E.fused(acc, cur, wr, wc, fr, fq, lds, wid, lane); S.done(cur); }
#undef PG8_SA
#undef PG8_SB
#undef PG8_STAGE
#undef PG8_LDA
#undef PG8_LDB
#undef PG8_MMA
#undef PG8_WAIT_V
#undef PG8_WAIT_L
#undef PG8_BAR
#undef PG8_SCHED
#undef PG8_SETOFFS
}
}

constexpr int NB = 8, SEQ = 4096, DM = 1024, MROWS = NB * SEQ, NLAYER = 2;
constexpr int NPROJ = 4608, INW = 4616;
constexpr int C_Q = 0, C_K = 512, C_V = 1024, C_Z = 1536, C_XS = 2048, C_SB = 3072, C_SC = 3584, C_SH = 4096;
constexpr int MIXW = 1536, NEXP = 32, TOPK = 4, FF = 1024;
constexpr float ALPHA = 1.4142135623730951f;
constexpr float LN_EPS = 1e-5f, RMS_EPS = 1e-5f;
constexpr float QSCALE = 0.125f * 1.4426950408889634f;

constexpr size_t MiB = 1u << 20;
constexpr size_t WS_CTL = 0, CTL_ZERO_BYTES = 1 * MiB;
constexpr size_t WS_ROPE = 1 * MiB;
constexpr size_t WS_WDT = 2 * MiB;
constexpr size_t WS_ROUT = 2 * MiB + 65536;
constexpr size_t WS_WIN = 4 * MiB;
constexpr size_t WS_WOUT = 24 * MiB;
constexpr size_t WS_WGU = 32 * MiB;
constexpr size_t WS_WDN = 288 * MiB;
constexpr size_t WS_XB = 416 * MiB;
constexpr size_t WS_XF = 480 * MiB;
constexpr size_t WS_XF2 = 608 * MiB;
constexpr size_t WS_PROJ = 736 * MiB;
constexpr size_t WS_DT = 1024 * MiB;
constexpr size_t WS_DTS = 1025 * MiB;
constexpr size_t WS_ACUM = 1026 * MiB;
constexpr size_t WS_LSE = 1027 * MiB;
constexpr size_t WS_OP = 1030 * MiB;
constexpr size_t WS_U = 1126 * MiB;
constexpr size_t WS_G = 1190 * MiB;
constexpr size_t WS_ST = 1222 * MiB;
constexpr size_t WS_YD = 1286 * MiB;
constexpr size_t WS_MIXED = 1350 * MiB;
constexpr size_t WS_MIXF = 1446 * MiB;
constexpr size_t WS_TOPE = 1574 * MiB;
constexpr size_t WS_TOPG = 1575 * MiB;
constexpr size_t WS_ROWTOK = 1576 * MiB;
constexpr size_t WS_ROWGATE = 1580 * MiB;
constexpr size_t WS_H = 736 * MiB;
constexpr size_t WS_YB = 1030 * MiB;
constexpr size_t WS_END = 1584 * MiB;
constexpr int CW_TMO = 0;
constexpr int CW_CNT = 64;
constexpr int CW_BAR = 4096;
constexpr int CW_SEAM = 16384;

constexpr int RING_OFF = 0, RING_BYTES = 131072;
constexpr int LDSCTL_OFF = 155648;
constexpr int L_MISC = LDSCTL_OFF;
constexpr int L_TSTART = LDSCTL_OFF + 256;
constexpr int L_CNT = LDSCTL_OFF + 512;
constexpr int L_LCNT = LDSCTL_OFF + 640;
constexpr int L_LBASE = LDSCTL_OFF + 768;
constexpr int L_UNITS = LDSCTL_OFF + 1024;
constexpr int L_UNITSN = LDSCTL_OFF + 2048;
constexpr int LDS_BYTES = 163840;

#define GAS __attribute__((address_space(1)))
#define LAS __attribute__((address_space(3)))
typedef unsigned short bf16;
typedef unsigned v4u __attribute__((ext_vector_type(4)));
typedef unsigned v2u __attribute__((ext_vector_type(2)));
typedef float f32x4 __attribute__((ext_vector_type(4)));
typedef float f32x16 __attribute__((ext_vector_type(16)));
typedef short bf16x8 __attribute__((ext_vector_type(8)));
typedef GAS unsigned gu32;
#define RLX_AGENT __ATOMIC_RELAXED, __HIP_MEMORY_SCOPE_AGENT
#define LDS_WAIT() asm volatile("s_waitcnt lgkmcnt(0)" ::: "memory")
#define VM_WAIT() asm volatile("s_waitcnt vmcnt(0)" ::: "memory")
__device__ __forceinline__ unsigned f2bf(float f) { unsigned u = __builtin_bit_cast(unsigned, f); return (u + 0x7fffu + ((u >> 16) & 1u)) >> 16; }
__device__ __forceinline__ unsigned pk2(float lo, float hi) { unsigned r; asm volatile("v_cvt_pk_bf16_f32 %0, %1, %2" : "=v"(r) : "v"(lo), "v"(hi)); return r; }
__device__ __forceinline__ float bf2f(unsigned short b) { return __builtin_bit_cast(float, (unsigned)b << 16); }
__device__ __forceinline__ float bflo(unsigned w) { return __builtin_bit_cast(float, w << 16); }
__device__ __forceinline__ float bfhi(unsigned w) { return __builtin_bit_cast(float, w & 0xffff0000u); }
__device__ __forceinline__ float siluf(float x) { return x * __builtin_amdgcn_rcpf(1.0f + __builtin_amdgcn_exp2f(-1.4426950408889634f * x)); }
#define XB_TMO      128
#define XB_XCNT(j)  (256  + 64 * (j))
#define XB_XSUB(j)  (1280 + 64 * (j))
#define XB_XGEN(j)  (2304 + 64 * (j))
#define XB_TOP      3328
#define XB_TOPGEN   3392
#define XCD_BAR_WORDS 3456
#define XB_SPIN_CAP (1u << 18)

__device__ __forceinline__ unsigned xb_ld(unsigned* p)              { return __hip_atomic_load(p, __ATOMIC_RELAXED, __HIP_MEMORY_SCOPE_AGENT); }
__device__ __forceinline__ unsigned xb_add(unsigned* p, unsigned v) { return __hip_atomic_fetch_add(p, v, __ATOMIC_RELAXED, __HIP_MEMORY_SCOPE_AGENT); }
__device__ __forceinline__ unsigned xb_xcc_id() { return (unsigned)__builtin_amdgcn_s_getreg((3 << 11) | 20) & 0xFu; }
#define XB_SPIN(cond, bar) do { unsigned _sp = 0; while (cond) { __builtin_amdgcn_s_sleep(1); \
    if ((++_sp & 255u) == 0u) { if (xb_ld(&(bar)[XB_TMO])) break; if (_sp > XB_SPIN_CAP) { atomicAdd(&(bar)[XB_TMO], 1u); break; } } } } while (0)

struct XcdBarrier {
    unsigned* bar; unsigned x;
    volatile LAS unsigned* st;
};

__device__ __forceinline__ XcdBarrier xcd_barrier_post(unsigned* bar, volatile LAS unsigned* st) {
    XcdBarrier b; b.bar = bar; b.x = xb_xcc_id(); b.st = st;
    if (threadIdx.x == 0) (void)xb_add(&bar[XB_XCNT(b.x)], 1u);
    return b;
}
__device__ __forceinline__ void xcd_barrier_complete(unsigned* bar, unsigned x, unsigned& nloc, unsigned& nx) {
    const unsigned G = gridDim.x * gridDim.y * gridDim.z;
    unsigned sum, cnt, mine, sp = 0u;
    for (;;) {
        sum = 0u; cnt = 0u; mine = 0u;
#pragma unroll
        for (unsigned j = 0; j < 16; ++j) { const unsigned c = xb_ld(&bar[XB_XCNT(j)]); sum += c; cnt += (c > 0u) ? 1u : 0u; mine = (j == x) ? c : mine; }
        if (sum == G) break;
        __builtin_amdgcn_s_sleep(1);
        if ((++sp & 255u) == 0u) { if (xb_ld(&bar[XB_TMO])) break; if (sp > XB_SPIN_CAP) { atomicAdd(&bar[XB_TMO], 1u); break; } }
    }
    nloc = mine > 0u ? mine : 1u; nx = cnt > 0u ? cnt : 1u;
}

__device__ __forceinline__ void xcd_barrier(const XcdBarrier& b) {
    asm volatile("s_waitcnt vmcnt(0)" ::: "memory");
    __syncthreads();
    if (threadIdx.x == 0) {
        unsigned* bar = b.bar;
        __builtin_amdgcn_s_waitcnt(0);
        unsigned nloc = b.st[0], nx = b.st[1];
        if (nloc == 0u) { xcd_barrier_complete(bar, b.x, nloc, nx); b.st[0] = nloc; b.st[1] = nx; }
        const unsigned old = xb_add(&bar[XB_XSUB(b.x)], 1u);
        const unsigned gen = old / nloc;
        if (old + 1u == (gen + 1u) * nloc) {
            __builtin_amdgcn_fence(__ATOMIC_RELEASE, "agent");
            asm volatile("s_waitcnt vmcnt(0)" ::: "memory");
            const unsigned og = xb_add(&bar[XB_TOP], 1u);
            const unsigned tg = og / nx;
            if (og + 1u == (tg + 1u) * nx) xb_add(&bar[XB_TOPGEN], 1u);
            else XB_SPIN(xb_ld(&bar[XB_TOPGEN]) == tg, bar);
            __builtin_amdgcn_fence(__ATOMIC_ACQUIRE, "agent");
            xb_add(&bar[XB_XGEN(b.x)], 1u);
            asm volatile("s_waitcnt vmcnt(0)" ::: "memory");
        } else {
            XB_SPIN(xb_ld(&bar[XB_XGEN(b.x)]) == gen, bar);
            __builtin_amdgcn_fence(__ATOMIC_ACQUIRE, "agent");
            asm volatile("s_waitcnt vmcnt(0)" ::: "memory");
        }
    }
    __syncthreads();
}

constexpr float SC_X = 4.f, SC_WGU = 32.f, SC_H = 4.f, SC_WDN = 64.f, SC_Y = 16.f, SC_WIN = 32.f, SC_O = 32.f;
__device__ __forceinline__ float wave_sum(float v) {
#pragma unroll
    for (int o = 1; o < 64; o <<= 1) v += __shfl_xor(v, o);
    return v;
}
__device__ __forceinline__ int win_dest_row(int n) {
    if (n < 1024) { const int hh = n >> 6, d = n & 63; const int p = (d < 32) ? (8 * (d >> 2) + (d & 3)) : (8 * ((d - 32) >> 2) + 4 + (d & 3)); return hh * 64 + p; }
    if (n < 3072) return n;
    if (n < 3080) return -1;
    return n - 8;
}
__device__ __forceinline__ int wgu_dest_row(int n) { return n < 1024 ? ((n >> 7) * 256 + (n & 127)) : (((n - 1024) >> 7) * 256 + 128 + ((n - 1024) & 127)); }
template <int MAP>
__device__ __forceinline__ void p0_transpose_item(const float* W, int K, int N, bf16* WT, float* wdt, LAS float* scr, int kb, int nb, int lane) {
    const int k0 = 64 * kb, n0 = 32 * nb;
    const int nn = n0 + (lane & 31); const bool nok = nn < N;
#pragma unroll 8
    for (int i = 0; i < 32; ++i) { const int kk = 2 * i + (lane >> 5); scr[kk * 33 + (lane & 31)] = nok ? W[(size_t)(k0 + kk) * N + nn] : 0.f; }
    LDS_WAIT(); asm volatile("" ::: "memory");
    const int c = lane & 7;
#pragma unroll
    for (int j = 0; j < 4; ++j) { const int n = (lane >> 3) + 8 * j; const LAS float* s = scr + (8 * c) * 33 + n;
        const int nsrc = n0 + n; if (nsrc >= N) continue;
        int drow = nsrc; if (MAP == 1) drow = win_dest_row(nsrc); if (MAP == 2) drow = wgu_dest_row(nsrc);
        if (MAP == 1 && drow < 0) { float* d = wdt + (size_t)(nsrc - 3072) * 1024 + k0 + 8 * c;
#pragma unroll
            for (int q = 0; q < 8; ++q) d[q] = s[q * 33]; continue; }
        v4u o; o.x = pk2(s[0 * 33], s[1 * 33]); o.y = pk2(s[2 * 33], s[3 * 33]); o.z = pk2(s[4 * 33], s[5 * 33]); o.w = pk2(s[6 * 33], s[7 * 33]);
        *(GAS v4u*)(WT + (size_t)drow * K + k0 + 8 * c) = o; }
    LDS_WAIT(); asm volatile("" ::: "memory");
}
template <int MAP>
__device__ __forceinline__ void p0_transpose_item64(const float* W, int K, int N, bf16* WT, float* wdt, LAS float* scr, int kb, int nb, int lane) {
    const int k0 = 64 * kb, n0 = 64 * nb;
    const bool lok = (n0 + 4 * (lane & 15) + 3) < N;
    f32x4 ld[16];
#pragma unroll
    for (int i = 0; i < 16; ++i) ld[i] = lok ? *(const f32x4*)(W + (size_t)(k0 + 4 * i + (lane >> 4)) * N + n0 + 4 * (lane & 15)) : (f32x4){0.f, 0.f, 0.f, 0.f};
#pragma unroll
    for (int i = 0; i < 16; ++i) *(LAS f32x4*)(scr + (4 * i + (lane >> 4)) * 64 + 4 * (lane & 15)) = ld[i];
    LDS_WAIT(); asm volatile("" ::: "memory");
    const int nsrc = n0 + lane;
    if (nsrc < N) {
        int drow = nsrc; if (MAP == 1) drow = win_dest_row(nsrc);
        if (MAP == 1 && drow < 0) { float* d = wdt + (size_t)(nsrc - 3072) * 1024 + k0;
#pragma unroll
            for (int q = 0; q < 16; ++q) *(f32x4*)(d + 4 * q) = (f32x4){scr[(4 * q) * 64 + lane], scr[(4 * q + 1) * 64 + lane], scr[(4 * q + 2) * 64 + lane], scr[(4 * q + 3) * 64 + lane]}; }
        else { GAS v4u* d = (GAS v4u*)(WT + (size_t)drow * K + k0);
#pragma unroll
            for (int q = 0; q < 8; ++q) { v4u o; o.x = pk2(scr[(8 * q) * 64 + lane], scr[(8 * q + 1) * 64 + lane]); o.y = pk2(scr[(8 * q + 2) * 64 + lane], scr[(8 * q + 3) * 64 + lane]);
                o.z = pk2(scr[(8 * q + 4) * 64 + lane], scr[(8 * q + 5) * 64 + lane]); o.w = pk2(scr[(8 * q + 6) * 64 + lane], scr[(8 * q + 7) * 64 + lane]); d[q] = o; } } }
    LDS_WAIT(); asm volatile("" ::: "memory");
}
struct SubT { const float* src; unsigned char* dst; int N; int n0; int mode; float scale; };
__device__ __forceinline__ SubT fp8_subtile(int item, int half, const float* wgu, const float* wdn, const float* win, unsigned char* WG8, unsigned char* WD8, unsigned char* WI8, int lane) {
    SubT t; int kb, nb;
    if (item < 64 * 256) { const int le = item >> 8, r = item & 255; kb = r >> 5; nb = r & 31; t.N = 2048; t.mode = 1; t.scale = SC_WGU;
        t.src = wgu + (size_t)le * 1024 * 2048; t.dst = WG8 + (size_t)le * 2048 * 1024; }
    else if (item < 64 * 256 + 64 * 128) { const int it2 = item - 64 * 256; const int le = it2 >> 7, r = it2 & 127; kb = r >> 4; nb = r & 15; t.N = 1024; t.mode = 0; t.scale = SC_WDN;
        t.src = wdn + (size_t)le * 1024 * 1024; t.dst = WD8 + (size_t)le * 1024 * 1024; }
    else { const int it3 = item - (64 * 256 + 64 * 128); const int l = it3 / 192, r = it3 % 192; kb = r / 24; nb = r % 24; t.N = INW; t.mode = 2; t.scale = SC_WIN;
        t.src = win + (size_t)l * 1024 * INW; t.dst = WI8 + (size_t)l * 1536 * 1024; }
    const int k0 = 128 * kb + 64 * half; t.n0 = 64 * nb;
    t.src += (size_t)(k0 + (lane >> 4)) * t.N + t.n0 + 4 * (lane & 15);
    t.dst += (size_t)k0;
    return t;
}
__device__ __forceinline__ void fp8_sub_load(const SubT& t, f32x4 (&ld)[16]) {
#pragma unroll
    for (int i = 0; i < 16; ++i) ld[i] = __builtin_nontemporal_load((const f32x4*)(t.src + (size_t)(4 * i) * t.N));
}
__device__ __forceinline__ void fp8_sub_process(const SubT& t, const f32x4 (&ld)[16], LAS float* scr, int lane) {
#pragma unroll
    for (int i = 0; i < 16; ++i) *(LAS f32x4*)(scr + (4 * i + (lane >> 4)) * 64 + 4 * (lane & 15)) = ld[i];
    LDS_WAIT(); asm volatile("" ::: "memory");
    unsigned w[16];
#pragma unroll
    for (int q = 0; q < 16; ++q) w[q] = pg8::pk4_fp8(scr[(4 * q + 0) * 64 + lane] * t.scale, scr[(4 * q + 1) * 64 + lane] * t.scale, scr[(4 * q + 2) * 64 + lane] * t.scale, scr[(4 * q + 3) * 64 + lane] * t.scale);
    LDS_WAIT(); asm volatile("" ::: "memory");
    LAS unsigned char* t2 = (LAS unsigned char*)scr;
#pragma unroll
    for (int q = 0; q < 4; ++q) *(LAS v4u*)(t2 + lane * 80 + 16 * q) = (v4u){w[4 * q], w[4 * q + 1], w[4 * q + 2], w[4 * q + 3]};
    LDS_WAIT(); asm volatile("" ::: "memory");
#pragma unroll
    for (int q = 0; q < 4; ++q) { const int n = 16 * q + (lane >> 2); const v4u v = *(const LAS v4u*)(t2 + n * 80 + 16 * (lane & 3));
        const int nn = (t.mode == 1) ? wgu_dest_row(t.n0 + n) : (t.mode == 2) ? win_dest_row(t.n0 + n) : (t.n0 + n);
        *(GAS v4u*)(t.dst + (size_t)nn * 1024 + 16 * (lane & 3)) = v; }
    LDS_WAIT(); asm volatile("" ::: "memory");
}
__device__ __forceinline__ void row_dt(const f32x4 (&v)[4], const float* wdt, float* dst, int lane) {
    float r[8];
#pragma unroll
    for (int jj = 0; jj < 8; ++jj) { float s = 0.f;
#pragma unroll
        for (int j = 0; j < 4; ++j) { const f32x4 w = *(const f32x4*)(wdt + jj * 1024 + 4 * lane + 256 * j); s += v[j][0] * w[0] + v[j][1] * w[1] + v[j][2] * w[2] + v[j][3] * w[3]; }
        r[jj] = wave_sum(s); }
    if (lane == 0) { *(f32x4*)dst = (f32x4){r[0], r[1], r[2], r[3]}; *(f32x4*)(dst + 4) = (f32x4){r[4], r[5], r[6], r[7]}; }
}
__device__ __forceinline__ void row_dt_win(const f32x4 (&v)[4], const float* win, float* dst, int lane) {
    float r[8];
#pragma unroll
    for (int jj = 0; jj < 8; ++jj) r[jj] = 0.f;
#pragma unroll
    for (int j = 0; j < 4; ++j)
#pragma unroll
        for (int e = 0; e < 4; ++e) { const float* wp = win + (size_t)(4 * lane + 256 * j + e) * INW + 3072; const f32x4 w0 = *(const f32x4*)wp, w1 = *(const f32x4*)(wp + 4); const float x = v[j][e];
            r[0] += x * w0[0]; r[1] += x * w0[1]; r[2] += x * w0[2]; r[3] += x * w0[3]; r[4] += x * w1[0]; r[5] += x * w1[1]; r[6] += x * w1[2]; r[7] += x * w1[3]; }
#pragma unroll
    for (int jj = 0; jj < 8; ++jj) r[jj] = wave_sum(r[jj]);
    if (lane == 0) { *(f32x4*)dst = (f32x4){r[0], r[1], r[2], r[3]}; *(f32x4*)(dst + 4) = (f32x4){r[4], r[5], r[6], r[7]}; }
}
template <bool W8, bool WF>
__device__ __forceinline__ void ln_row(f32x4 (&v)[4], const float* gam, const float* bet, float* of32, bf16* ob16, unsigned char* o8, float s8, int lane) {
    float s = 0.f;
#pragma unroll
    for (int j = 0; j < 4; ++j) s += (v[j][0] + v[j][1]) + (v[j][2] + v[j][3]);
    const float mean = wave_sum(s) * (1.f / DM); float s2 = 0.f;
#pragma unroll
    for (int j = 0; j < 4; ++j) { v[j] = v[j] - mean; s2 += (v[j][0] * v[j][0] + v[j][1] * v[j][1]) + (v[j][2] * v[j][2] + v[j][3] * v[j][3]); }
    const float rstd = 1.f / sqrtf(wave_sum(s2) * (1.f / DM) + LN_EPS);
#pragma unroll
    for (int j = 0; j < 4; ++j) { const f32x4 g = *(const f32x4*)(gam + 4 * lane + 256 * j), b = *(const f32x4*)(bet + 4 * lane + 256 * j);
        v[j] = v[j] * rstd * g + b;
        if (WF) *(f32x4*)(of32 + 4 * lane + 256 * j) = v[j];
        v2u w; w.x = pk2(v[j][0], v[j][1]); w.y = pk2(v[j][2], v[j][3]); *(v2u*)(ob16 + 4 * lane + 256 * j) = w;
        if (W8) *(unsigned*)(o8 + 4 * lane + 256 * j) = pg8::pk4_fp8(v[j][0] * s8, v[j][1] * s8, v[j][2] * s8, v[j][3] * s8); }
}


typedef short v4i16_t __attribute__((ext_vector_type(4)));
__device__ __forceinline__ bf16x8 tr_pair(const LAS unsigned char* p0, const LAS unsigned char* p1) {
    const v4i16_t a = __builtin_amdgcn_ds_read_tr16_b64_v4i16((LAS v4i16_t*)p0), b = __builtin_amdgcn_ds_read_tr16_b64_v4i16((LAS v4i16_t*)p1);
    return (bf16x8){a[0], a[1], a[2], a[3], b[0], b[1], b[2], b[3]};
}
__device__ __forceinline__ int crow16(int r, int hi) { return (r & 3) + 8 * (r >> 2) + 4 * hi; }
constexpr int AK_PITCH = 144, AV_PITCH = 192, AK_TILE = 32 * AK_PITCH, AV_TILE = 32 * AV_PITCH;
constexpr int AT_K = 0, AT_V = 12 * AK_TILE;
struct AttnItem { int p, b, h, d, r, qt0; };
__device__ __forceinline__ AttnItem attn_item(int I) { AttnItem a; a.p = I >> 10; const int rem = I & 1023; a.b = rem >> 7; a.h = (rem >> 4) & 7; const int grp = rem & 15;
    a.d = (a.p == 0) ? 1 : (a.p == 1) ? 4 : 16; const int tpr = 128 / a.d; const int T = grp * 8; a.r = T / tpr; a.qt0 = T % tpr; return a; }
__device__ __forceinline__ void attn_request(const bf16* PROJ, const AttnItem& a, v4u (&st)[12], int tid) {
    const int rr = tid >> 4, ch = tid & 15; const int col = (ch < 8 ? C_K : C_V - 64) + a.h * 64 + ch * 8;
#pragma unroll
    for (int tl = 0; tl < 12; ++tl) { const int kt = a.qt0 - 4 + tl; st[tl] = (v4u){0u, 0u, 0u, 0u};
        if (kt >= 0) { const size_t row = (size_t)a.b * SEQ + (size_t)(32 * kt + rr) * a.d + a.r; st[tl] = *(const v4u*)(PROJ + row * NPROJ + col); } }
}
__device__ __forceinline__ void attn_deposit(LAS unsigned char* al, const v4u (&st)[12], int tid) {
    const int rr = tid >> 4, ch = tid & 15;
    LAS unsigned char* dst = (ch < 8) ? (al + AT_K + rr * AK_PITCH + ch * 16) : (al + AT_V + rr * AV_PITCH + (ch - 8) * 16); const int tstep = (ch < 8) ? AK_TILE : AV_TILE;
#pragma unroll
    for (int tl = 0; tl < 12; ++tl) *(LAS v4u*)(dst + tl * tstep) = st[tl];
}
__device__ __forceinline__ void attn_wave_compute(const bf16* PROJ, bf16* OPp, float* LSEp, const AttnItem& a, const LAS unsigned char* al, int wave, int lane) {
    const int i = lane & 31, h2 = lane >> 5; const int qt = a.qt0 + wave;
    const size_t rowq = (size_t)a.b * SEQ + (size_t)(32 * qt + i) * a.d + a.r;
    bf16x8 qf[4];
    { const bf16* qp = PROJ + rowq * NPROJ + C_Q + a.h * 64 + 8 * h2;
#pragma unroll
      for (int s = 0; s < 4; ++s) qf[s] = *(const bf16x8*)(qp + 16 * s); }
    f32x16 o0 = {}, o1 = {}; float mrun = -INFINITY, lrun = 0.f;
    const int kt0 = qt > 4 ? qt - 4 : 0;
    const LAS unsigned char* krd = al + AT_K + i * AK_PITCH + 16 * h2;
    const LAS unsigned char* trb = al + AT_V + (4 * h2 + ((lane & 15) >> 2)) * AV_PITCH + (16 * ((lane >> 4) & 1) + 4 * (lane & 3)) * 2;
#pragma unroll 1
    for (int kt = kt0; kt <= qt; ++kt) {
        const int tl = kt - a.qt0 + 4;
        const LAS unsigned char* kp = krd + tl * AK_TILE; const LAS unsigned char* vp = trb + tl * AV_TILE;
        f32x16 sacc = {};
#pragma unroll
        for (int s = 0; s < 4; ++s) sacc = __builtin_amdgcn_mfma_f32_32x32x16_bf16(*(const LAS bf16x8*)(kp + 32 * s), qf[s], sacc, 0, 0, 0);
        if (kt == qt) {
#pragma unroll
            for (int rg = 0; rg < 16; ++rg) if (crow16(rg, h2) > i) sacc[rg] = -INFINITY;
        }
        if (kt + 4 == qt) {
#pragma unroll
            for (int rg = 0; rg < 16; ++rg) if (crow16(rg, h2) < i) sacc[rg] = -INFINITY;
        }
        float mx = sacc[0];
#pragma unroll
        for (int rg = 1; rg < 16; ++rg) mx = fmaxf(mx, sacc[rg]);
        mx = fmaxf(mx, __shfl_xor(mx, 32));
        const float mnew = fmaxf(mrun, mx), alpha = __builtin_amdgcn_exp2f(mrun - mnew); mrun = mnew;
        float ps = 0.f;
#pragma unroll
        for (int rg = 0; rg < 16; ++rg) { sacc[rg] = __builtin_amdgcn_exp2f(sacc[rg] - mnew); ps += sacc[rg]; }
        lrun = lrun * alpha + ps;
#pragma unroll
        for (int rg = 0; rg < 16; ++rg) { o0[rg] *= alpha; o1[rg] *= alpha; }
        bf16x8 pf[2];
#pragma unroll
        for (int ks = 0; ks < 2; ++ks) { v4u w; w.x = pg8::cvt_pk_bf16(sacc[8 * ks + 0], sacc[8 * ks + 1]); w.y = pg8::cvt_pk_bf16(sacc[8 * ks + 2], sacc[8 * ks + 3]); w.z = pg8::cvt_pk_bf16(sacc[8 * ks + 4], sacc[8 * ks + 5]); w.w = pg8::cvt_pk_bf16(sacc[8 * ks + 6], sacc[8 * ks + 7]); pf[ks] = __builtin_bit_cast(bf16x8, w); }
#pragma unroll
        for (int ks = 0; ks < 2; ++ks) {
            const bf16x8 v0 = tr_pair(vp + (16 * ks) * AV_PITCH, vp + (16 * ks + 8) * AV_PITCH);
            const bf16x8 v1 = tr_pair(vp + (16 * ks) * AV_PITCH + 64, vp + (16 * ks + 8) * AV_PITCH + 64);
            o0 = __builtin_amdgcn_mfma_f32_32x32x16_bf16(v0, pf[ks], o0, 0, 0, 0);
            o1 = __builtin_amdgcn_mfma_f32_32x32x16_bf16(v1, pf[ks], o1, 0, 0, 0);
        }
    }
    const float lt = lrun + __shfl_xor(lrun, 32); const float il = 1.0f / lt;
    unsigned char* op = (unsigned char*)OPp + rowq * 512 + a.h * 64 + 4 * h2;
    const float ils = il * SC_O;
#pragma unroll
    for (int g4 = 0; g4 < 4; ++g4) {
        *(unsigned*)(op + 8 * g4) = pg8::pk4_fp8(o0[4 * g4 + 0] * ils, o0[4 * g4 + 1] * ils, o0[4 * g4 + 2] * ils, o0[4 * g4 + 3] * ils);
        *(unsigned*)(op + 32 + 8 * g4) = pg8::pk4_fp8(o1[4 * g4 + 0] * ils, o1[4 * g4 + 1] * ils, o1[4 * g4 + 2] * ils, o1[4 * g4 + 3] * ils); }
    if (h2 == 0) LSEp[rowq * 8 + a.h] = mrun + log2f(lt);
}
__device__ __forceinline__ void attn_phase(LAS unsigned char* al, const bf16* PROJ, bf16* OP, float* LSE, int bid, int G, int tid, int wave, int lane) {
    v4u st[12];
    int I = bid;
    if (I < 3072) { const AttnItem a = attn_item(I); attn_request(PROJ, a, st, tid); }
    for (; I < 3072; I += G) {
        const AttnItem a = attn_item(I);
        __syncthreads();
        attn_deposit(al, st, tid);
        __syncthreads();
        if (I + G < 3072) { const AttnItem n = attn_item(I + G); attn_request(PROJ, n, st, tid); }
        attn_wave_compute(PROJ, (bf16*)((unsigned char*)OP + (size_t)a.p * MROWS * 512), LSE + (size_t)a.p * MROWS * 8, a, al, wave, lane);
    }
    __syncthreads();
}

constexpr int SS_DTS = 0, SS_ACUM = 2048, SS_TMP = 4096, SS_SSX = 6144, SS_IMG = 8192;
constexpr int S1_PB = 320, S1_PX = 576;
constexpr int S1_B = SS_IMG, S1_X = SS_IMG + 128 * S1_PB;
constexpr int S3_PBC = 272, S3_PX = 576;
constexpr int S3_B = SS_IMG, S3_C = S3_B + 128 * S3_PBC, S3_X = S3_C + 128 * S3_PBC;

__device__ __forceinline__ void ssd_prep(LAS unsigned char* sl, const float* DT, const float* dtb, const float* alog, size_t row0, int g, int tid, int lane, int wave) {
    LAS float* dts = (LAS float*)(sl + SS_DTS); LAS float* acum = (LAS float*)(sl + SS_ACUM); LAS float* tmp = (LAS float*)(sl + SS_TMP);
    { const int l = tid >> 2, hq = tid & 3; const float x = DT[(row0 + l) * 8 + 4 * g + hq] + dtb[4 * g + hq];
      const float dt = x > 20.f ? x : log1pf(__expf(x)); dts[hq * 128 + l] = dt; tmp[hq * 128 + l] = dt * (-__expf(alog[4 * g + hq])); }
    __syncthreads();
    if (wave < 4) { const float v0 = tmp[wave * 128 + 2 * lane], v1 = tmp[wave * 128 + 2 * lane + 1]; float s = v0 + v1;
#pragma unroll
        for (int off = 1; off < 64; off <<= 1) { const float t = __shfl_up(s, off); if (lane >= off) s += t; }
        acum[wave * 128 + 2 * lane] = s - v1; acum[wave * 128 + 2 * lane + 1] = s; }
    __syncthreads();
}
template <int NCOLS, int FACMODE>
__device__ __forceinline__ void conv_tile(const bf16* PROJ, size_t row0, int t0, int pcol0, const float* cw, const float* cb, int cch0, LAS unsigned char* dst, int pitch, const LAS unsigned char* sl, int hq0, int tid) {
    constexpr int NCH8 = NCOLS / 8, NSEG = 512 / NCH8, RPS = 128 / NSEG;
    const int c8 = tid % NCH8, seg = tid / NCH8, l0 = seg * RPS;
    float w[4][8], bias[8], hst[3][8];
#pragma unroll
    for (int k = 0; k < 4; ++k) { const f32x4 a = *(const f32x4*)(cw + k * 1024 + cch0 + c8 * 8), b = *(const f32x4*)(cw + k * 1024 + cch0 + c8 * 8 + 4);
        w[k][0] = a[0]; w[k][1] = a[1]; w[k][2] = a[2]; w[k][3] = a[3]; w[k][4] = b[0]; w[k][5] = b[1]; w[k][6] = b[2]; w[k][7] = b[3]; }
    { const f32x4 a = *(const f32x4*)(cb + cch0 + c8 * 8), b = *(const f32x4*)(cb + cch0 + c8 * 8 + 4);
      bias[0] = a[0]; bias[1] = a[1]; bias[2] = a[2]; bias[3] = a[3]; bias[4] = b[0]; bias[5] = b[1]; bias[6] = b[2]; bias[7] = b[3]; }
    const bf16* src = PROJ + pcol0 + c8 * 8;
#pragma unroll
    for (int k = 0; k < 3; ++k) { const int l = l0 - 3 + k; v4u v = (v4u){0u, 0u, 0u, 0u}; if (t0 + l >= 0) v = *(const v4u*)(src + (size_t)((long)row0 + l) * NPROJ);
        hst[k][0] = bflo(v.x); hst[k][1] = bfhi(v.x); hst[k][2] = bflo(v.y); hst[k][3] = bfhi(v.y); hst[k][4] = bflo(v.z); hst[k][5] = bfhi(v.z); hst[k][6] = bflo(v.w); hst[k][7] = bfhi(v.w); }
    const LAS float* dts = (const LAS float*)(sl + SS_DTS); const LAS float* acum = (const LAS float*)(sl + SS_ACUM);
    const int hq = hq0 + (c8 * 8) / 64;
    const float alast = (FACMODE == 2) ? acum[hq * 128 + 127] : 0.f;
#pragma unroll
    for (int rr = 0; rr < RPS; ++rr) { const int l = l0 + rr; const v4u v = *(const v4u*)(src + (row0 + l) * NPROJ);
        float cur[8]; cur[0] = bflo(v.x); cur[1] = bfhi(v.x); cur[2] = bflo(v.y); cur[3] = bfhi(v.y); cur[4] = bflo(v.z); cur[5] = bfhi(v.z); cur[6] = bflo(v.w); cur[7] = bfhi(v.w);
        float f = 1.f; if (FACMODE >= 1) f = dts[hq * 128 + l]; if (FACMODE == 2) f *= __expf(alast - acum[hq * 128 + l]);
        float o[8];
#pragma unroll
        for (int e = 0; e < 8; ++e) { const float a = bias[e] + w[0][e] * hst[0][e] + w[1][e] * hst[1][e] + w[2][e] * hst[2][e] + w[3][e] * cur[e]; o[e] = siluf(a) * f;
            hst[0][e] = hst[1][e]; hst[1][e] = hst[2][e]; hst[2][e] = cur[e]; }
        v4u ov; ov.x = pk2(o[0], o[1]); ov.y = pk2(o[2], o[3]); ov.z = pk2(o[4], o[5]); ov.w = pk2(o[6], o[7]);
        *(LAS v4u*)(dst + l * pitch + c8 * 16) = ov; }
}
__device__ __forceinline__ void ssd_s1_unit(LAS unsigned char* sl, const bf16* PROJ, const float* DT, const float* dtb, const float* alog, const float* cw, const float* cb, float* ST, float* CDEC, int un, int tid, int lane, int wave) {
    const int g = un & 1, bc = un >> 1; const size_t row0 = (size_t)bc * 128; const int t0 = (bc & 31) * 128;
    __syncthreads();
    ssd_prep(sl, DT, dtb, alog, row0, g, tid, lane, wave);
    conv_tile<128, 0>(PROJ, row0, t0, C_XS + 512 + g * 128, cw, cb, 512 + g * 128, sl + S1_B, S1_PB, sl, 0, tid);
    conv_tile<256, 2>(PROJ, row0, t0, C_XS + g * 256, cw, cb, g * 256, sl + S1_X, S1_PX, sl, 0, tid);
    if (tid < 4) CDEC[(size_t)bc * 8 + 4 * g + tid] = __expf(((const LAS float*)(sl + SS_ACUM))[tid * 128 + 127]);
    __syncthreads();
    const int hq = wave >> 1, pt = wave & 1, h2 = lane >> 5, q = (lane & 15) >> 2, pp = lane & 3, dsel = (lane >> 4) & 1;
    const LAS unsigned char* xb = sl + S1_X + (8 * h2 + q) * S1_PX + (hq * 64 + pt * 32 + 16 * dsel + 4 * pp) * 2;
    const LAS unsigned char* bb = sl + S1_B + (8 * h2 + q) * S1_PB + (16 * dsel + 4 * pp) * 2;
    f32x16 acc[4];
#pragma unroll
    for (int nt = 0; nt < 4; ++nt) acc[nt] = (f32x16){};
#pragma unroll
    for (int ks = 0; ks < 8; ++ks) { const bf16x8 a = tr_pair(xb + (16 * ks) * S1_PX, xb + (16 * ks + 4) * S1_PX);
#pragma unroll
        for (int nt = 0; nt < 4; ++nt) { const bf16x8 b = tr_pair(bb + (16 * ks) * S1_PB + nt * 64, bb + (16 * ks + 4) * S1_PB + nt * 64); acc[nt] = __builtin_amdgcn_mfma_f32_32x32x16_bf16(a, b, acc[nt], 0, 0, 0); } }
    float* sp = ST + ((size_t)(bc * 8 + 4 * g + hq) * 64 + pt * 32) * 128 + (lane & 31);
#pragma unroll
    for (int nt = 0; nt < 4; ++nt)
#pragma unroll
        for (int rg = 0; rg < 16; ++rg) sp[(size_t)crow16(rg, h2) * 128 + 32 * nt] = acc[nt][rg];
}
__device__ __forceinline__ void ssd_s3_unit(LAS unsigned char* sl, const bf16* PROJ, const float* DT, const float* dtb, const float* alog, const float* cw, const float* cb, const float* dsk, const float* ng,
                                            const bf16* HIN, bf16* MIXED, int un, int tid, int lane, int wave) {
    const int g = un & 1, bc = un >> 1; const size_t row0 = (size_t)bc * 128; const int t0 = (bc & 31) * 128;
    const int lt = wave & 3, ph = wave >> 2, lq = lane & 31, hi = lane >> 5, q = (lane & 15) >> 2, pp = lane & 3, dsel = (lane >> 4) & 1;
    const int lrow = 32 * lt + lq;
    const size_t grow = row0 + lrow;
    __syncthreads();
    ssd_prep(sl, DT, dtb, alog, row0, g, tid, lane, wave);
    conv_tile<128, 0>(PROJ, row0, t0, C_XS + 512 + g * 128, cw, cb, 512 + g * 128, sl + S3_B, S3_PBC, sl, 0, tid);
    conv_tile<128, 0>(PROJ, row0, t0, C_XS + 768 + g * 128, cw, cb, 768 + g * 128, sl + S3_C, S3_PBC, sl, 0, tid);
    conv_tile<256, 1>(PROJ, row0, t0, C_XS + g * 256, cw, cb, g * 256, sl + S3_X, S3_PX, sl, 0, tid);
    __syncthreads();
    const LAS float* dts = (const LAS float*)(sl + SS_DTS); const LAS float* acum = (const LAS float*)(sl + SS_ACUM); LAS float* ssx = (LAS float*)(sl + SS_SSX);
    const LAS unsigned char* crd = sl + S3_C + lrow * S3_PBC + 16 * hi;
    f32x16 y[4];
    { bf16x8 hfa[8], hfb[8];
      const bf16* hp0 = HIN + ((size_t)(bc * 8 + 4 * g) * 64 + ph * 32 + lq) * 128 + 8 * hi;
#pragma unroll
      for (int ks = 0; ks < 8; ++ks) hfa[ks] = *(const bf16x8*)(hp0 + 16 * ks);
#pragma unroll
      for (int hq = 0; hq < 4; ++hq) {
          if (hq < 3) {
#pragma unroll
              for (int ks = 0; ks < 8; ++ks) { const bf16x8 v = *(const bf16x8*)(hp0 + (size_t)(hq + 1) * 8192 + 16 * ks); if (hq & 1) hfa[ks] = v; else hfb[ks] = v; } }
          f32x16 t = (f32x16){};
#pragma unroll
          for (int ks = 0; ks < 8; ++ks) t = __builtin_amdgcn_mfma_f32_32x32x16_bf16((hq & 1) ? hfb[ks] : hfa[ks], *(const LAS bf16x8*)(crd + 32 * ks), t, 0, 0, 0);
          const float ea = __expf(acum[hq * 128 + lrow]);
#pragma unroll
          for (int rg = 0; rg < 16; ++rg) t[rg] *= ea;
          y[hq] = t; } }
    v2u zr[4][4];
#pragma unroll
    for (int hq = 0; hq < 4; ++hq)
#pragma unroll
        for (int g4 = 0; g4 < 4; ++g4) zr[hq][g4] = *(const v2u*)(PROJ + grow * NPROJ + C_Z + g * 256 + hq * 64 + ph * 32 + 8 * g4 + 4 * hi);
#pragma unroll
    for (int st = 0; st < 4; ++st) if (st <= lt) {
        f32x16 ag = (f32x16){};
        { const LAS unsigned char* brd = sl + S3_B + (32 * st + lq) * S3_PBC + 16 * hi;
#pragma unroll
          for (int ks = 0; ks < 8; ++ks) ag = __builtin_amdgcn_mfma_f32_32x32x16_bf16(*(const LAS bf16x8*)(brd + 32 * ks), *(const LAS bf16x8*)(crd + 32 * ks), ag, 0, 0, 0); }
#pragma unroll
        for (int hq = 0; hq < 4; ++hq) {
            const float al = acum[hq * 128 + lrow], dd = dsk[4 * g + hq] / dts[hq * 128 + lrow];
            const LAS unsigned char* xb = sl + S3_X + (4 * hi + q) * S3_PX + (hq * 64 + ph * 32 + 16 * dsel + 4 * pp) * 2;
            float pm[16];
#pragma unroll
            for (int g4 = 0; g4 < 4; ++g4) { const f32x4 as4 = *(const LAS f32x4*)(acum + hq * 128 + 32 * st + 8 * g4 + 4 * hi);
#pragma unroll
                for (int e = 0; e < 4; ++e) { const int rg = 4 * g4 + e; float v = ag[rg] * __expf(al - as4[e]);
                    if (st == lt) { const int sl_ = 8 * g4 + 4 * hi + e; if (sl_ > lq) v = 0.f; if (sl_ == lq) v += dd; }
                    pm[rg] = v; } }
#pragma unroll
            for (int ks = 0; ks < 2; ++ks) { v4u wv; wv.x = pg8::cvt_pk_bf16(pm[8 * ks + 0], pm[8 * ks + 1]); wv.y = pg8::cvt_pk_bf16(pm[8 * ks + 2], pm[8 * ks + 3]); wv.z = pg8::cvt_pk_bf16(pm[8 * ks + 4], pm[8 * ks + 5]); wv.w = pg8::cvt_pk_bf16(pm[8 * ks + 6], pm[8 * ks + 7]);
                const bf16x8 xt = tr_pair(xb + (32 * st + 16 * ks) * S3_PX, xb + (32 * st + 16 * ks + 8) * S3_PX);
                y[hq] = __builtin_amdgcn_mfma_f32_32x32x16_bf16(xt, __builtin_bit_cast(bf16x8, wv), y[hq], 0, 0, 0); }
        }
    }
    unsigned ayp[4][8]; float ss = 0.f;
#pragma unroll
    for (int hq = 0; hq < 4; ++hq)
#pragma unroll
        for (int g4 = 0; g4 < 4; ++g4) { const v2u z = zr[hq][g4];
            const float y0 = y[hq][4 * g4 + 0] * siluf(bflo(z.x)), y1 = y[hq][4 * g4 + 1] * siluf(bfhi(z.x)), y2 = y[hq][4 * g4 + 2] * siluf(bflo(z.y)), y3 = y[hq][4 * g4 + 3] * siluf(bfhi(z.y));
            ss += (y0 * y0 + y1 * y1) + (y2 * y2 + y3 * y3);
            ayp[hq][2 * g4] = pg8::cvt_pk_bf16(y0, y1); ayp[hq][2 * g4 + 1] = pg8::cvt_pk_bf16(y2, y3); }
    ss += __shfl_xor(ss, 32);
    if (hi == 0) ssx[ph * 128 + lrow] = ss;
    __syncthreads();
    const float rs = 1.0f / sqrtf((ssx[lrow] + ssx[128 + lrow]) * (1.f / 256.f) + RMS_EPS);
#pragma unroll
    for (int hq = 0; hq < 4; ++hq)
#pragma unroll
        for (int g4 = 0; g4 < 4; ++g4) { const int ch = hq * 64 + ph * 32 + 8 * g4 + 4 * hi; const f32x4 gn = *(const f32x4*)(ng + g * 256 + ch);
            const unsigned p0 = ayp[hq][2 * g4], p1 = ayp[hq][2 * g4 + 1];
            v2u o; o.x = pg8::cvt_pk_bf16(bflo(p0) * rs * gn[0], bfhi(p0) * rs * gn[1]); o.y = pg8::cvt_pk_bf16(bflo(p1) * rs * gn[2], bfhi(p1) * rs * gn[3]);
            *(v2u*)(MIXED + grow * MIXW + 512 + g * 256 + ch) = o; }
}

struct Args { const float* in[20]; float* out; unsigned char* ws; int ph_lo, ph_hi, sub, pad; };
constexpr int NWAVES = 8;
constexpr int PH_PER_LAYER = 10, N_PHASES = 1 + NLAYER * PH_PER_LAYER;

#define in_x (args.in[0])
#define in_win (args.in[1])
#define in_convw (args.in[2])
#define in_convb (args.in[3])
#define in_dtb (args.in[4])
#define in_alog (args.in[5])
#define in_dsk (args.in[6])
#define in_ng (args.in[7])
#define in_scw (args.in[8])
#define in_wout (args.in[9])
#define in_ln1g (args.in[10])
#define in_ln1b (args.in[11])
#define in_rw (args.in[12])
#define in_rb (args.in[13])
#define in_wgu (args.in[14])
#define in_bgu (args.in[15])
#define in_wdn (args.in[16])
#define in_bdn (args.in[17])
#define in_ln2g (args.in[18])
#define in_ln2b (args.in[19])
#define ROPE ((float*)(args.ws + WS_ROPE))
#define WDT ((float*)(args.ws + WS_WDT))
#define ROUT ((bf16*)(args.ws + WS_ROUT))
#define WIN ((bf16*)(args.ws + WS_WIN))
#define WOUT ((bf16*)(args.ws + WS_WOUT))
#define WGU ((bf16*)(args.ws + WS_WGU))
#define WDN ((bf16*)(args.ws + WS_WDN))
#define XB ((bf16*)(args.ws + WS_XB))
#define XF ((float*)(args.ws + WS_XF))
#define XF2 ((float*)(args.ws + WS_XF2))
#define PROJ ((bf16*)(args.ws + WS_PROJ))
#define DT ((float*)(args.ws + WS_DT))
#define DTS ((float*)(args.ws + WS_DTS))
#define ACUM ((float*)(args.ws + WS_ACUM))
#define LSE ((float*)(args.ws + WS_LSE))
#define OP ((bf16*)(args.ws + WS_OP))
#define U ((bf16*)(args.ws + WS_U))
#define GB ((float*)(args.ws + WS_G))
#define ST ((float*)(args.ws + WS_ST))
#define YD ((float*)(args.ws + WS_YD))
#define MIXED ((bf16*)(args.ws + WS_MIXED))
#define MIXF ((bf16*)(args.ws + WS_MIXF))
#define TOPE ((int*)(args.ws + WS_TOPE))
#define TOPG ((float*)(args.ws + WS_TOPG))
#define ROWTOK ((int*)(args.ws + WS_ROWTOK))
#define ROWGATE ((float*)(args.ws + WS_ROWGATE))
#define HB ((bf16*)(args.ws + WS_H))
#define YB ((bf16*)(args.ws + WS_YB))
#define HIN ((bf16*)(args.ws + WS_G))
#define WGU8 ((unsigned char*)(args.ws + WS_WGU))
#define WDN8 ((unsigned char*)(args.ws + WS_WDN))
#define XB8 ((unsigned char*)(args.ws + WS_U))
#define H8 ((unsigned char*)(args.ws + WS_H))
#define YB8 ((unsigned char*)(args.ws + WS_YB))
#define WIN8 ((unsigned char*)(args.ws + WS_WGU + 128 * MiB))
#define XP8 ((unsigned char*)(args.ws + WS_WGU + 132 * MiB))
#define CDEC ((float*)(args.ws + WS_ACUM))
template <int layer>
__device__ __forceinline__ void run_layer(const Args& args, int lo, int hi, const XcdBarrier& bar) {
    extern __shared__ __attribute__((aligned(16))) unsigned char lds[];
    LAS unsigned char* ldsp = (LAS unsigned char*)lds;
    const int tid = threadIdx.x, lane = tid & 63, wave = __builtin_amdgcn_readfirstlane(tid >> 6);
    const int G = gridDim.x, bid = blockIdx.x;
    const int gw = bid * NWAVES + wave, NGW = G * NWAVES;
    gu32* ctl = (gu32*)(args.ws + WS_CTL);

#define IN(k) (lo <= (k) && (k) < hi)
#define SEAM(k) do { if (IN(k) && IN((k) + 1)) xcd_barrier(bar); } while (0)

        const int pb = 1 + layer * PH_PER_LAYER;
        const bf16* WINl = WIN + (size_t)layer * NPROJ * DM; const bf16* WOUTl = WOUT + (size_t)layer * DM * MIXW;
        const unsigned char* WGUl = WGU8 + (size_t)layer * NEXP * 2048 * DM; const unsigned char* WDNl = WDN8 + (size_t)layer * NEXP * DM * FF;
        gu32* gcnt = ctl + CW_CNT + 64 * layer;

        if (IN(pb + 0)) {
            if (layer == 0) {
                for (int m = gw; m < MROWS; m += NGW) { const bf16* xr = XB + (size_t)m * DM; f32x4 v[4];
#pragma unroll
                    for (int j = 0; j < 4; ++j) { const v2u a = *(const v2u*)(xr + 4 * lane + 256 * j); v[j] = (f32x4){bflo(a.x), bfhi(a.x), bflo(a.y), bfhi(a.y)}; }
                    row_dt(v, WDT, DT + (size_t)m * 8, lane); }
            }
            {
              pg8::Gemm g{(const pg8::bf16_t*)XP8, (const pg8::bf16_t*)(WIN8 + (size_t)layer * 1536 * DM), MROWS, 1536, DM / 2}; pg8::StaticOrder S; S.init(MROWS, 1536, G, bid);
              pg8::EpiProj E{PROJ, NPROJ, ROPE, QSCALE, 1.0f / (SC_X * SC_WIN), 0};
              pg8::gemm_phase<pg8::EpiProj, pg8::StaticOrder, true, false, true>(ldsp + RING_OFF, g, S, E); }
            __syncthreads();
            { pg8::Gemm g{XB, WINl + (size_t)1536 * DM, MROWS, NPROJ - 1536, DM}; pg8::StaticOrder S; S.init(MROWS, NPROJ - 1536, G, bid);
              pg8::EpiProj E{PROJ, NPROJ, ROPE, QSCALE, 1.0f, 6};
              pg8::gemm_phase<pg8::EpiProj, pg8::StaticOrder, true, false>(ldsp + RING_OFF, g, S, E); }
        }
        SEAM(pb + 0);
        if (IN(pb + 1)) {
            if (args.sub & 1) attn_phase(ldsp + RING_OFF, PROJ, OP, LSE, bid, G, tid, wave, lane);
            if (args.sub & 2) { const float* cw = in_convw + (size_t)layer * 4 * 1024; const float* cb = in_convb + (size_t)layer * 1024;
              for (int un = bid; un < 512; un += G)
                  ssd_s1_unit(ldsp + RING_OFF, PROJ, DT, in_dtb + layer * 8, in_alog + layer * 8, cw, cb, ST, CDEC, un, tid, lane, wave);
              __syncthreads(); }
            const float* sw = in_scw + (size_t)layer * 3 * 512;
            if (args.sub & 4)
#pragma unroll 2
            for (int it = bid * (NWAVES * 64) + tid; it < (int)((long)MROWS * 64); it += G * (NWAVES * 64)) { const int c8 = (int)(it & 63), row = (int)(it >> 6), t = row & (SEQ - 1); const int ch = c8 * 8;
                float a[8];
#pragma unroll
                for (int q = 0; q < 8; ++q) a[q] = 0.f;
#pragma unroll
                for (int k = 0; k < 3; ++k) { const int tt = t - 2 + k; if (tt >= 0) { const bf16* pr = PROJ + (size_t)(row - 2 + k) * NPROJ; const v4u cc = *(const v4u*)(pr + C_SC + ch), hh = *(const v4u*)(pr + C_SH + ch);
                    const f32x4 w0 = *(const f32x4*)(sw + k * 512 + ch), w1 = *(const f32x4*)(sw + k * 512 + ch + 4);
                    a[0] += w0[0] * bflo(cc.x) * bflo(hh.x); a[1] += w0[1] * bfhi(cc.x) * bfhi(hh.x); a[2] += w0[2] * bflo(cc.y) * bflo(hh.y); a[3] += w0[3] * bfhi(cc.y) * bfhi(hh.y);
                    a[4] += w1[0] * bflo(cc.z) * bflo(hh.z); a[5] += w1[1] * bfhi(cc.z) * bfhi(hh.z); a[6] += w1[2] * bflo(cc.w) * bflo(hh.w); a[7] += w1[3] * bfhi(cc.w) * bfhi(hh.w); } }
                const v4u bb = *(const v4u*)(PROJ + (size_t)row * NPROJ + C_SB + ch);
                v4u o; o.x = pk2(a[0] * bflo(bb.x), a[1] * bfhi(bb.x)); o.y = pk2(a[2] * bflo(bb.y), a[3] * bfhi(bb.y)); o.z = pk2(a[4] * bflo(bb.z), a[5] * bfhi(bb.z)); o.w = pk2(a[6] * bflo(bb.w), a[7] * bfhi(bb.w));
                *(v4u*)(MIXED + (size_t)row * MIXW + 1024 + ch) = o; }
        }
        SEAM(pb + 1);
        if (IN(pb + 2)) {
            for (int it = bid * (NWAVES * 64) + tid; it < (int)(64L * 2048); it += G * (NWAVES * 64)) { const int pn4 = (int)(it & 2047), bh = (int)(it >> 11); const int h = bh & 7, b = bh >> 3; f32x4 hc = (f32x4){0.f, 0.f, 0.f, 0.f};
#pragma unroll 16
                for (int c = 0; c < 32; ++c) { const size_t idx = ((size_t)((b * 32 + c) * 8 + h)) * 8192 + pn4 * 4; const f32x4 st = *(const f32x4*)(ST + idx);
                    v2u o; o.x = pk2(hc[0], hc[1]); o.y = pk2(hc[2], hc[3]); *(v2u*)(HIN + idx) = o;
                    hc = hc * CDEC[(size_t)(b * 32 + c) * 8 + h] + st; } }
        }
        SEAM(pb + 2);
        if (IN(pb + 3)) {
            if (args.sub & 1) { const float* cw = in_convw + (size_t)layer * 4 * 1024; const float* cb = in_convb + (size_t)layer * 1024;
              for (int un = bid; un < 512; un += G)
                  ssd_s3_unit(ldsp + RING_OFF, PROJ, DT, in_dtb + layer * 8, in_alog + layer * 8, cw, cb, in_dsk + layer * 8, in_ng + (size_t)layer * 512, HIN, MIXED, un, tid, lane, wave);
              __syncthreads(); }
            if (args.sub & 2)
#pragma unroll 2
            for (int it = bid * (NWAVES * 64) + tid; it < (int)((long)MROWS * 64); it += G * (NWAVES * 64)) { const int c8 = (int)(it & 63), row = (int)(it >> 6); const int h = c8 >> 3;
                const float l0 = LSE[((size_t)0 * MROWS + row) * 8 + h], l1 = LSE[((size_t)1 * MROWS + row) * 8 + h], l2 = LSE[((size_t)2 * MROWS + row) * 8 + h];
                const float mm = fmaxf(l0, fmaxf(l1, l2)); float w0 = exp2f(l0 - mm), w1 = exp2f(l1 - mm), w2 = exp2f(l2 - mm); const float iw = 1.0f / (w0 + w1 + w2); w0 *= iw; w1 *= iw; w2 *= iw;
                const unsigned char* OP8 = (const unsigned char*)OP; typedef float f32x2_ __attribute__((ext_vector_type(2)));
                const v2u a0 = *(const v2u*)(OP8 + ((size_t)0 * MROWS + row) * 512 + c8 * 8), a1 = *(const v2u*)(OP8 + ((size_t)1 * MROWS + row) * 512 + c8 * 8), a2 = *(const v2u*)(OP8 + ((size_t)2 * MROWS + row) * 512 + c8 * 8);
                w0 *= (1.0f / SC_O); w1 *= (1.0f / SC_O); w2 *= (1.0f / SC_O);
                v4u o;
                { const f32x2_ p0 = __builtin_amdgcn_cvt_pk_f32_fp8(a0.x, false), p1 = __builtin_amdgcn_cvt_pk_f32_fp8(a1.x, false), p2 = __builtin_amdgcn_cvt_pk_f32_fp8(a2.x, false); o.x = pk2(w0 * p0[0] + w1 * p1[0] + w2 * p2[0], w0 * p0[1] + w1 * p1[1] + w2 * p2[1]); }
                { const f32x2_ p0 = __builtin_amdgcn_cvt_pk_f32_fp8(a0.x, true), p1 = __builtin_amdgcn_cvt_pk_f32_fp8(a1.x, true), p2 = __builtin_amdgcn_cvt_pk_f32_fp8(a2.x, true); o.y = pk2(w0 * p0[0] + w1 * p1[0] + w2 * p2[0], w0 * p0[1] + w1 * p1[1] + w2 * p2[1]); }
                { const f32x2_ p0 = __builtin_amdgcn_cvt_pk_f32_fp8(a0.y, false), p1 = __builtin_amdgcn_cvt_pk_f32_fp8(a1.y, false), p2 = __builtin_amdgcn_cvt_pk_f32_fp8(a2.y, false); o.z = pk2(w0 * p0[0] + w1 * p1[0] + w2 * p2[0], w0 * p0[1] + w1 * p1[1] + w2 * p2[1]); }
                { const f32x2_ p0 = __builtin_amdgcn_cvt_pk_f32_fp8(a0.y, true), p1 = __builtin_amdgcn_cvt_pk_f32_fp8(a1.y, true), p2 = __builtin_amdgcn_cvt_pk_f32_fp8(a2.y, true); o.w = pk2(w0 * p0[0] + w1 * p1[0] + w2 * p2[0], w0 * p0[1] + w1 * p1[1] + w2 * p2[1]); }
                *(v4u*)(MIXED + (size_t)row * MIXW + c8 * 8) = o; }
        }
        SEAM(pb + 3);
        if (IN(pb + 4)) {
#define FUSED_LN1_CALL(BASE, LIM) { pg8::Gemm g{MIXED, WOUTl, MROWS, DM, MIXW}; \
              pg8::EpiLn1 E{args.ws, in_ln1g + (size_t)layer * DM, in_ln1b + (size_t)layer * DM, WS_XB, WS_U, (layer ? WS_ROPE : WS_DTS), WS_CTL + (size_t)(CW_SEAM + layer * 8192) * 4, WS_CTL + (size_t)CW_TMO * 4, ALPHA, SC_X, LN_EPS, 0x700u + (unsigned)layer * 0x80u}; \
              pg8::StaticOrder S; S.init(MROWS, DM, G, bid); S.base = (BASE); S.lim = (LIM); \
              pg8::gemm_phase<pg8::EpiLn1, pg8::StaticOrder, false, false>(ldsp + RING_OFF, g, S, E); }
            FUSED_LN1_CALL(0, 256)
            __syncthreads();
            FUSED_LN1_CALL(256, 512)
            __syncthreads();
#undef FUSED_LN1_CALL
        }
        SEAM(pb + 4);
        if (IN(pb + 6)) {
            LAS int* lcnt = (LAS int*)(ldsp + L_LCNT); LAS int* lbase = (LAS int*)(ldsp + L_LBASE);
            const bf16* RT = ROUT + (size_t)layer * NEXP * DM; const float* rb = in_rb + (size_t)layer * NEXP;
            for (int blk = bid; blk < MROWS / 128; blk += G) {
                if (tid < 32) lcnt[tid] = 0;
                __syncthreads();
                const int r32 = lane & 31, hi = lane >> 5; const int row = blk * 128 + (wave & 3) * 32 + r32;
                float tv[4]; int te[4]; int lrank[4]; float gate[4];
                f32x16 acc = {};
                { const int kh = wave >> 2;
                  const bf16* ap = RT + (size_t)r32 * DM + 8 * hi + 512 * kh; const bf16* bp = XB + (size_t)row * DM + 8 * hi + 512 * kh;
#pragma unroll 16
                  for (int s = 0; s < 32; ++s) { const bf16x8 a = *(const bf16x8*)(ap + 16 * s), b = *(const bf16x8*)(bp + 16 * s); acc = __builtin_amdgcn_mfma_f32_32x32x16_bf16(a, b, acc, 0, 0, 0); }
                  LAS float* part = (LAS float*)(ldsp + RING_OFF) + (wave & 3) * 1024;
                  if (kh) {
#pragma unroll
                      for (int i = 0; i < 16; ++i) part[i * 64 + lane] = acc[i]; }
                  __syncthreads();
                  if (!kh) {
#pragma unroll
                      for (int i = 0; i < 16; ++i) acc[i] += part[i * 64 + lane]; } }
                if (wave < 4) {
#pragma unroll
                    for (int k = 0; k < 4; ++k) { tv[k] = -INFINITY; te[k] = 1 << 20; }
#pragma unroll
                    for (int i = 0; i < 16; ++i) { const int e = (i & 3) + 8 * (i >> 2) + 4 * hi; float v = acc[i] + rb[e]; int ve = e;
#pragma unroll
                        for (int k = 0; k < 4; ++k) { const bool gt = (v > tv[k]) || (v == tv[k] && ve < te[k]); const float nv = gt ? tv[k] : v; const int ne = gt ? te[k] : ve; tv[k] = gt ? v : tv[k]; te[k] = gt ? ve : te[k]; v = nv; ve = ne; } }
                    float pv[4]; int pe[4];
#pragma unroll
                    for (int k = 0; k < 4; ++k) { pv[k] = __shfl_xor(tv[k], 32); pe[k] = __shfl_xor(te[k], 32); }
#pragma unroll
                    for (int j = 0; j < 4; ++j) { float v = pv[j]; int ve = pe[j];
#pragma unroll
                        for (int k = 0; k < 4; ++k) { const bool gt = (v > tv[k]) || (v == tv[k] && ve < te[k]); const float nv = gt ? tv[k] : v; const int ne = gt ? te[k] : ve; tv[k] = gt ? v : tv[k]; te[k] = gt ? ve : te[k]; v = nv; ve = ne; } }
                    float se = 0.f;
#pragma unroll
                    for (int k = 0; k < 4; ++k) { gate[k] = __expf(tv[k] - tv[0]); se += gate[k]; }
                    const float ise = 1.0f / se;
#pragma unroll
                    for (int k = 0; k < 4; ++k) gate[k] *= ise;
                    if (hi == 0) {
#pragma unroll
                        for (int k = 0; k < 4; ++k) lrank[k] = __hip_atomic_fetch_add(lcnt + te[k], 1, __ATOMIC_RELAXED, __HIP_MEMORY_SCOPE_WORKGROUP);
                    }
                }
                __syncthreads();
                if (tid < 32) lbase[tid] = (int)__hip_atomic_fetch_add(gcnt + tid, (unsigned)lcnt[tid], RLX_AGENT);
                __syncthreads();
                if (wave < 4 && hi == 0) {
#pragma unroll
                    for (int k = 0; k < 4; ++k) { const int r = lbase[te[k]] + lrank[k]; const size_t o = (size_t)te[k] * 32768 + r;
                        ROWTOK[o] = row * 4 + k; ROWGATE[o] = gate[k]; }
                }
                __syncthreads();
            }
        }
        SEAM(pb + 6);
        if (IN(pb + 7) || IN(pb + 8)) {
            LAS int* tstart = (LAS int*)(ldsp + L_TSTART); LAS int* cntL = (LAS int*)(ldsp + L_CNT); LAS int* units = (LAS int*)(ldsp + L_UNITS); LAS int* unitsn = (LAS int*)(ldsp + L_UNITSN);
            if (tid == 0) { int acc = 0; for (int e = 0; e < 32; ++e) { const int c = (int)__hip_atomic_load(gcnt + e, RLX_AGENT); cntL[e] = c; tstart[e] = acc; acc += (c + 255) >> 8; } tstart[32] = acc; }
            __syncthreads();
            if (IN(pb + 7)) {
                pg8::moe_build_units(units, unitsn, tstart, 8, G, bid, tid);
                __syncthreads();
                pg8::Gemm g{(const pg8::bf16_t*)XB8, (const pg8::bf16_t*)WGUl, 0, 2048, DM / 2};
                pg8::MoeOrder S{units, __builtin_amdgcn_readfirstlane(unitsn[0]), cntL, ROWTOK, 1, (unsigned)DM, (size_t)2048 * DM, ROWGATE, in_bgu + (size_t)layer * NEXP * 2048};
                pg8::EpiSwiglu E{H8, in_bgu + (size_t)layer * NEXP * 2048, ROWGATE, cntL, 1.0f / (SC_X * SC_WGU), SC_H};
                pg8::gemm_phase<pg8::EpiSwiglu, pg8::MoeOrder, true, true, true>(ldsp + RING_OFF, g, S, E);
                __syncthreads();
            }
            SEAM(pb + 7);
            if (IN(pb + 8)) {
                pg8::moe_build_units(units, unitsn, tstart, 4, G, bid, tid);
                __syncthreads();
                pg8::Gemm g{(const pg8::bf16_t*)H8, (const pg8::bf16_t*)WDNl, 0, DM, FF / 2};
                pg8::MoeOrder S{units, __builtin_amdgcn_readfirstlane(unitsn[0]), cntL, ROWTOK, 0, (unsigned)FF, (size_t)DM * FF, ROWGATE, in_bdn + (size_t)layer * NEXP * DM};
                pg8::EpiScatter E{YB8, ROWTOK, cntL, SC_Y / (SC_H * SC_WDN), SC_Y};
                pg8::gemm_phase<pg8::EpiScatter, pg8::MoeOrder, true, false, true, true>(ldsp + RING_OFF, g, S, E);
                __syncthreads();
            }
        }
        SEAM(pb + 8);
        if (IN(pb + 9)) {
            const float* gam = in_ln2g + (size_t)layer * DM; const float* bet = in_ln2b + (size_t)layer * DM; const float* bdn = in_bdn + (size_t)layer * NEXP * DM;
            for (int m = gw; m < MROWS; m += NGW) { f32x4 v[4];
#pragma unroll
                for (int j = 0; j < 4; ++j) { const v2u a = *(const v2u*)(XB + (size_t)m * DM + 4 * lane + 256 * j); v[j] = (f32x4){bflo(a.x), bfhi(a.x), bflo(a.y), bfhi(a.y)} * ALPHA; }
#pragma unroll
                for (int k = 0; k < 4; ++k) { const unsigned char* yr = YB8 + ((size_t)m * 4 + k) * DM;
#pragma unroll
                    for (int j = 0; j < 4; ++j) { const unsigned w = *(const unsigned*)(yr + 4 * lane + 256 * j);
                        typedef float f32x2_ __attribute__((ext_vector_type(2)));
                        const f32x2_ lo = __builtin_amdgcn_cvt_pk_f32_fp8(w, false), hi = __builtin_amdgcn_cvt_pk_f32_fp8(w, true);
                        v[j][0] += lo[0] * (1.0f / SC_Y); v[j][1] += lo[1] * (1.0f / SC_Y); v[j][2] += hi[0] * (1.0f / SC_Y); v[j][3] += hi[1] * (1.0f / SC_Y); } }
                ln_row<(layer + 1 < NLAYER), (layer == NLAYER - 1)>(v, gam, bet, args.out + (size_t)m * DM, XB + (size_t)m * DM, XP8 + (size_t)m * DM, SC_X, lane);
                if (layer + 1 < NLAYER) row_dt(v, WDT + (size_t)(layer + 1) * 8 * 1024, DT + (size_t)m * 8, lane); }
        }
        SEAM(pb + 9);
    #undef IN
#undef SEAM
}

__global__ void __launch_bounds__(NWAVES * 64, 2) mk_fwd(Args args) {
    extern __shared__ __attribute__((aligned(16))) unsigned char lds[];
    LAS unsigned char* ldsp = (LAS unsigned char*)lds;
    const int tid = threadIdx.x, lane = tid & 63, wave = __builtin_amdgcn_readfirstlane(tid >> 6);
    const int G = gridDim.x, bid = blockIdx.x;
    const int gw = bid * NWAVES + wave, NGW = G * NWAVES;
    gu32* ctl = (gu32*)(args.ws + WS_CTL);

    for (int u = tid; u < (LDS_BYTES - LDSCTL_OFF) / 4; u += NWAVES * 64) ((LAS unsigned*)(ldsp + LDSCTL_OFF))[u] = 0u;
    __syncthreads();
    XcdBarrier bar = xcd_barrier_post((unsigned*)(ctl + CW_BAR), (volatile LAS unsigned*)(ldsp + L_MISC) + 8);

    const int lo = args.ph_lo, hi = args.ph_hi;
#define IN(k) (lo <= (k) && (k) < hi)
#define SEAM(k) do { if (IN(k) && IN((k) + 1)) xcd_barrier(bar); } while (0)

    if (IN(0)) {
        LAS float* scr = (LAS float*)(ldsp + RING_OFF + wave * 16384);
        constexpr int I_IN = 16 * 73, I_OUT = 24 * 16, I_R = 16;
        constexpr int NIT = NLAYER * (I_IN + I_OUT + I_R);
        for (int it = gw; it < NIT; it += NGW) {
            int r = it;
            if (r < NLAYER * I_IN) { const int l = r / I_IN; r %= I_IN; p0_transpose_item64<1>(in_win + (size_t)l * DM * INW, DM, INW, WIN + (size_t)l * NPROJ * DM, WDT + (size_t)l * 8 * 1024, scr, r / 73, r % 73, lane); continue; } r -= NLAYER * I_IN;
            if (r < NLAYER * I_OUT) { const int l = r / I_OUT; r %= I_OUT; p0_transpose_item64<0>(in_wout + (size_t)l * MIXW * DM, MIXW, DM, WOUT + (size_t)l * DM * MIXW, nullptr, scr, r / 16, r % 16, lane); continue; } r -= NLAYER * I_OUT;
            { const int l = r / I_R; r %= I_R; p0_transpose_item<0>(in_rw + (size_t)l * DM * NEXP, DM, NEXP, ROUT + (size_t)l * NEXP * DM, nullptr, scr, r, 0, lane); }
        }
        { constexpr int NIT8 = 64 * 256 + 64 * 128 + NLAYER * 192;
          const int nmine = (gw < NIT8) ? (NIT8 - gw + NGW - 1) / NGW : 0; const int J = 2 * nmine;
          f32x4 lda[16], ldb[16];
          if (J > 0) { const SubT t = fp8_subtile(gw, 0, in_wgu, in_wdn, in_win, WGU8, WDN8, WIN8, lane); fp8_sub_load(t, lda); }
#pragma unroll 1
          for (int j = 0; j < J; j += 2) {
              const int item = gw + (j >> 1) * NGW;
              const SubT t0 = fp8_subtile(item, 0, in_wgu, in_wdn, in_win, WGU8, WDN8, WIN8, lane), t1 = fp8_subtile(item, 1, in_wgu, in_wdn, in_win, WGU8, WDN8, WIN8, lane);
              fp8_sub_load(t1, ldb);
              fp8_sub_process(t0, lda, scr, lane);
              if (j + 2 < J) { const SubT t2 = fp8_subtile(item + NGW, 0, in_wgu, in_wdn, in_win, WGU8, WDN8, WIN8, lane); fp8_sub_load(t2, lda); }
              fp8_sub_process(t1, ldb, scr, lane);
          } }
        __syncthreads();
    }
    if (IN(0)) {
        for (int m = gw; m < MROWS; m += NGW) { const float* xr = in_x + (size_t)m * DM; bf16* ob = XB + (size_t)m * DM; f32x4 v[4];
#pragma unroll
            for (int j = 0; j < 4; ++j) { v[j] = *(const f32x4*)(xr + 4 * lane + 256 * j); v2u w; w.x = pk2(v[j][0], v[j][1]); w.y = pk2(v[j][2], v[j][3]); *(v2u*)(ob + 4 * lane + 256 * j) = w;
                *(unsigned*)(XP8 + (size_t)m * DM + 4 * lane + 256 * j) = pg8::pk4_fp8(v[j][0] * SC_X, v[j][1] * SC_X, v[j][2] * SC_X, v[j][3] * SC_X); }
            }
    }

    SEAM(0);
    run_layer<0>(args, lo, hi, bar);
    run_layer<1>(args, lo, hi, bar);
#undef IN
#undef SEAM
}

extern "C" void kernel_launch(void* const* d_in, const int* in_sizes, int n_in, void* d_out, int out_size, void* d_ws, size_t ws_size, hipStream_t stream) {
    static int grid = 0;
    if (grid == 0) {
        if (n_in != 20 || out_size != MROWS * DM || ws_size < WS_END) { fprintf(stderr, "kernel_launch: unexpected problem (n_in %d, out %d, ws %zu)\n", n_in, out_size, ws_size); grid = -1; return; }
        if (hipFuncSetAttribute((const void*)mk_fwd, hipFuncAttributeMaxDynamicSharedMemorySize, LDS_BYTES) != hipSuccess) { fprintf(stderr, "kernel_launch: hipFuncSetAttribute failed\n"); grid = -1; return; }
        int dev = 0, cus = 0, per_cu = 0;
        (void)hipGetDevice(&dev); (void)hipDeviceGetAttribute(&cus, hipDeviceAttributeMultiprocessorCount, dev);
        if (hipOccupancyMaxActiveBlocksPerMultiprocessor(&per_cu, (const void*)mk_fwd, NWAVES * 64, LDS_BYTES) != hipSuccess || per_cu < 1) fprintf(stderr, "kernel_launch: occupancy query says %d\n", per_cu);
        (void)hipGetLastError();
        grid = cus > 0 ? cus : 256;
    }
    if (grid < 0) return;
    (void)hipMemsetAsync((char*)d_ws + WS_CTL, 0, CTL_ZERO_BYTES, stream);
    Args a{};
    for (int i = 0; i < 20; ++i) a.in[i] = (const float*)d_in[i];
    a.out = (float*)d_out; a.ws = (unsigned char*)d_ws;
    a.ph_lo = 0; a.ph_hi = N_PHASES; a.sub = 7; a.pad = 0;
    hipLaunchKernelGGL(mk_fwd, dim3(grid), dim3(NWAVES * 64), LDS_BYTES, stream, a);
#ifdef PROBE_PH
#ifndef PROBE_SUB
#define PROBE_SUB 7
#endif
    for (int i = 0; i < PROBE_N; ++i) { a.ph_lo = PROBE_PH; a.ph_hi = PROBE_PH + 1; a.sub = PROBE_SUB; hipLaunchKernelGGL(mk_fwd, dim3(grid), dim3(NWAVES * 64), LDS_BYTES, stream, a); }
#endif
}
```

```cpp
#include <hip/hip_runtime.h>
#include <cstdio>
#include <cstdint>
#include <cmath>

namespace pg8 {
#define PG8_LAS __attribute__((address_space(3)))
typedef unsigned short bf16_t;
typedef short bf16x8 __attribute__((ext_vector_type(8)));
typedef float f32x4 __attribute__((ext_vector_type(4)));
typedef float f32x2 __attribute__((ext_vector_type(2)));
typedef unsigned u32x4 __attribute__((ext_vector_type(4)));
constexpr int BM = 256, BK = 64, HALF = 128, HTB = HALF * BK * 2  , STAGE_BYTES = 8 * HTB, NXCD = 8, WGM = 8;

__host__ __device__ __forceinline__ int lds_byte(int r, int c) { const int st = (r >> 4) * 2 + (c >> 5), rr = r & 15, cc = c & 31, ob = rr * 64 + cc * 2; return st * 1024 + (ob ^ (((ob >> 9) & 1) << 5)); }
__host__ __device__ __forceinline__ void stage_rc(int b, int& R, int& C) { const int st = b / 1024, sb = b % 1024, swz = sb ^ (((sb >> 9) & 1) << 5); R = (st >> 1) * 16 + swz / 64; C = (st & 1) * 32 + (swz % 64) / 2; }
__host__ __device__ __forceinline__ int perm32(int rho) { const int n = rho >> 4, i = rho & 15; return 8 * (i >> 2) + 4 * n + (i & 3); }

struct Unit { int pm, pn, e, r0; };
struct Gemm { const bf16_t* A; const bf16_t* Bt; int M, N, K; };

struct StaticOrder {
    int nM, nN, nwg, G, c, base, lim;
    __device__ void init(int M, int N, int G_, int c_) { nM = M / BM; nN = N / BM; nwg = nM * nN; G = G_; c = c_; base = 0; lim = nwg; }
    __device__ __forceinline__ bool next(int i, Unit& u) const {
        const long L = (long)i * G + c + base; if (L >= lim) return false;
        int wgid = (int)L; { const int q = nwg / NXCD, r = nwg % NXCD, xcd = wgid % NXCD, off = wgid / NXCD; wgid = (xcd < r ? xcd * (q + 1) : r * (q + 1) + (xcd - r) * q) + off; }
        const int nig = WGM * nN, gid = wgid / nig, fm = gid * WGM, gsz = (nM - fm) < WGM ? (nM - fm) : WGM;
        u.pm = fm + ((wgid % nig) % gsz); u.pn = (wgid % nig) / gsz; u.e = 0; u.r0 = 0; return true;
    }
    __device__ __forceinline__ const char* abase(const Unit& u, const Gemm& g, size_t tstep) const { return (const char*)g.A + (size_t)u.pm * tstep; }
    __device__ __forceinline__ const char* bbase(const Unit& u, const Gemm& g, size_t tstep) const { return (const char*)g.Bt + (size_t)u.pn * tstep; }
    static constexpr bool SIDE = false;
    __device__ __forceinline__ unsigned arow(const Unit&, int) const { return 0u; }
    __device__ __forceinline__ unsigned arow_side(const Unit&, int, const PG8_LAS unsigned char*) const { return 0u; }
    __device__ __forceinline__ const void* side_src(const Unit&, const Unit&, int, int) const { return nullptr; }
    __device__ __forceinline__ void a_ready(const Unit&) const {}
    __device__ __forceinline__ void done(const Unit&) const {}
};

struct MoeOrder {
    const PG8_LAS int* units;
    int nunits;
    const PG8_LAS int* cnt;
    const int* rowtok;
    int gather;
    unsigned rowbytes;
    size_t bstride;
    __device__ __forceinline__ bool next(int i, Unit& u) const {
        if (i >= nunits) return false;
        u.pm = __builtin_amdgcn_readfirstlane(units[4 * i + 0]); u.pn = __builtin_amdgcn_readfirstlane(units[4 * i + 1]);
        u.e = __builtin_amdgcn_readfirstlane(units[4 * i + 2]); u.r0 = __builtin_amdgcn_readfirstlane(units[4 * i + 3]); return true;
    }
    __device__ __forceinline__ const char* abase(const Unit& u, const Gemm& g, size_t tstep) const { return gather ? (const char*)g.A : (const char*)g.A + (size_t)u.pm * tstep; }
    __device__ __forceinline__ const char* bbase(const Unit& u, const Gemm& g, size_t tstep) const { return (const char*)g.Bt + (size_t)u.e * bstride + (size_t)u.pn * tstep; }
    static constexpr bool SIDE = true;
    const float* rowgate; const float* bgu;
    __device__ __forceinline__ unsigned arow(const Unit& u, int R) const {
        const int r = u.r0 + R; const int idx = (r < cnt[u.e]) ? rowtok[(size_t)u.e * 32768 + r] : 0; return (unsigned)(idx >> 2) * rowbytes; }
    __device__ __forceinline__ unsigned arow_side(const Unit& u, int R, const PG8_LAS unsigned char* sd) const {
        const int r = u.r0 + R; const int v = ((const PG8_LAS int*)sd)[R]; const int idx = (r < cnt[u.e]) ? v : 0; return (unsigned)(idx >> 2) * rowbytes; }
    __device__ __forceinline__ const void* side_src(const Unit& cur, const Unit& rt, int wid, int lane) const {
        if (rowgate != nullptr && wid == 1) return rowgate + (size_t)cur.e * 32768 + cur.r0 + 4 * lane;
        if (bgu != nullptr && wid == 2) return gather ? (bgu + (size_t)cur.e * 2048 + (lane < 32 ? 0 : 1024 - 128) + cur.pn * 128 + 4 * lane)
                                                      : (bgu + (size_t)cur.e * 1024 + cur.pn * 256 + 4 * lane);
        return rowtok + (size_t)rt.e * 32768 + rt.r0 + 4 * lane; }
    __device__ __forceinline__ void a_ready(const Unit&) const {}
    __device__ __forceinline__ void done(const Unit&) const {}
};
__device__ __forceinline__ void moe_build_units(PG8_LAS int* units, PG8_LAS int* units_n, const PG8_LAS int* tstart, int nN, int G, int c, int tid) {
    if (tid < 64) {
        const int nT = tstart[32], nwg = nT * nN; const long L = (long)tid * G + c;
        int pm = 0, pn = 0, e = 0, r0 = 0;
        if (L < nwg) {
            int wgid = (int)L; { const int q = nwg / NXCD, r = nwg % NXCD, xcd = wgid % NXCD, off = wgid / NXCD; wgid = (xcd < r ? xcd * (q + 1) : r * (q + 1) + (xcd - r) * q) + off; }
            const int nig = WGM * nN, gid = wgid / nig, fm = gid * WGM, gsz = (nT - fm) < WGM ? (nT - fm) : WGM;
            pm = fm + ((wgid % nig) % gsz); pn = (wgid % nig) / gsz;
            for (int j = 1; j < 32; ++j) e += (tstart[j] <= pm) ? 1 : 0;
            r0 = (pm - tstart[e]) * 256;
        }
        units[4 * tid + 0] = pm; units[4 * tid + 1] = pn; units[4 * tid + 2] = e; units[4 * tid + 3] = r0;
        if (tid == 0) { int n = 0; if (c < nwg) n = (nwg - c + G - 1) / G; units_n[0] = n < 64 ? n : 64; }
    }
}

__host__ __device__ __forceinline__ unsigned hblk_off(int R, int p7) { const int ai = R >> 7, wr = (R >> 6) & 1, m = (R >> 4) & 3, fr = R & 15, wc = p7 >> 1, fq = ((p7 & 1) << 1) | (m & 1), mp = m >> 1;
    return (unsigned)(((((ai * 2 + wr) * 4 + wc) * 2 + mp) * 64 + fr + 16 * fq) * 16); }
typedef int v8i_t __attribute__((ext_vector_type(8)));
typedef int v4i_t __attribute__((ext_vector_type(4)));
__device__ __forceinline__ v8i_t cat8(bf16x8 lo, bf16x8 hi) { const v4i_t a = __builtin_bit_cast(v4i_t, lo), b = __builtin_bit_cast(v4i_t, hi); return __builtin_shufflevector(a, b, 0, 1, 2, 3, 4, 5, 6, 7); }
__device__ __forceinline__ void mfma8(f32x4& acc, v8i_t a, v8i_t b, int scl) { asm volatile("v_mfma_scale_f32_16x16x128_f8f6f4 %0, %1, %2, %0, %3, %3 op_sel_hi:[0,0,0]" : "+v"(acc) : "v"(a), "v"(b), "v"(scl)); }
__device__ __forceinline__ unsigned pk4_fp8(float a, float b, float c, float d) { unsigned w = 0u; w = __builtin_amdgcn_cvt_pk_fp8_f32(a, b, w, false); w = __builtin_amdgcn_cvt_pk_fp8_f32(c, d, w, true); return w; }
__device__ __forceinline__ unsigned cvt_pk_bf16(float lo, float hi) { unsigned r; asm volatile("v_cvt_pk_bf16_f32 %0, %1, %2" : "=v"(r) : "v"(lo), "v"(hi)); return r; }

struct EpiProj {
    static constexpr bool PERM = true, AFTER_DRAIN = false;
    bf16_t* O; int ldc; const float* rope; float qscale; float dqv; int pn_off;
    __device__ __forceinline__ void operator()(const f32x4 (&acc)[2][2][4][2], const Unit& u, int wr, int wc, int fr, int fq, const PG8_LAS unsigned char* sd) const {
        const int pnn = u.pn + pn_off; const int row0 = u.pm * BM + wr * 64 + fr; const int col0 = pnn * BM + wc * 32 + 8 * fq;
        const bool rot = pnn < 4; const float sc = (pnn < 2 ? qscale : 1.f) * dqv; const int gq = 4 * (wc & 1) + fq;
        float invr[4];
#pragma unroll
        for (int e = 0; e < 4; ++e) invr[e] = __builtin_amdgcn_exp2f(-(float)(4 * gq + e) * 0.41524101186092029f) * 0.15915494309189535f;
#pragma unroll
        for (int ai = 0; ai < 2; ++ai)
#pragma unroll
            for (int m = 0; m < 4; ++m) { const int row = row0 + ai * HALF + m * 16; bf16_t* rowp = O + (size_t)row * ldc + col0;
                f32x4 cs0 = (f32x4){1.f, 0.f, 1.f, 0.f}, cs1 = cs0;
                if (rot) { const float tp = (float)(row & 4095);
                    const float a0 = __builtin_amdgcn_fractf(tp * invr[0]), a1 = __builtin_amdgcn_fractf(tp * invr[1]), a2 = __builtin_amdgcn_fractf(tp * invr[2]), a3 = __builtin_amdgcn_fractf(tp * invr[3]);
                    cs0 = (f32x4){__builtin_amdgcn_cosf(a0), __builtin_amdgcn_sinf(a0), __builtin_amdgcn_cosf(a1), __builtin_amdgcn_sinf(a1)};
                    cs1 = (f32x4){__builtin_amdgcn_cosf(a2), __builtin_amdgcn_sinf(a2), __builtin_amdgcn_cosf(a3), __builtin_amdgcn_sinf(a3)}; }
#pragma unroll
                for (int bj = 0; bj < 2; ++bj) { f32x4 v0 = acc[ai][bj][m][0], v1 = acc[ai][bj][m][1];
                    if (rot) { f32x4 lo, hi;
                        lo[0] = v0[0] * cs0[0] - v1[0] * cs0[1]; hi[0] = v1[0] * cs0[0] + v0[0] * cs0[1];
                        lo[1] = v0[1] * cs0[2] - v1[1] * cs0[3]; hi[1] = v1[1] * cs0[2] + v0[1] * cs0[3];
                        lo[2] = v0[2] * cs1[0] - v1[2] * cs1[1]; hi[2] = v1[2] * cs1[0] + v0[2] * cs1[1];
                        lo[3] = v0[3] * cs1[2] - v1[3] * cs1[3]; hi[3] = v1[3] * cs1[2] + v0[3] * cs1[3];
                        v0 = lo * sc; v1 = hi * sc; }
                    else { v0 = v0 * dqv; v1 = v1 * dqv; }
                    u32x4 w; w.x = cvt_pk_bf16(v0[0], v0[1]); w.y = cvt_pk_bf16(v0[2], v0[3]); w.z = cvt_pk_bf16(v1[0], v1[1]); w.w = cvt_pk_bf16(v1[2], v1[3]);
                    *(u32x4*)(rowp + bj * HALF) = w; } }
    }
};
struct EpiF32 {
    static constexpr bool PERM = false, AFTER_DRAIN = false;
    float* O; int ldc;
    __device__ __forceinline__ void operator()(const f32x4 (&acc)[2][2][4][2], const Unit& u, int wr, int wc, int fr, int fq, const PG8_LAS unsigned char* sd) const {
        const int row0 = u.pm * BM + wr * 64 + fr; const int col0 = u.pn * BM + wc * 32 + 4 * fq;
#pragma unroll
        for (int ai = 0; ai < 2; ++ai)
#pragma unroll
            for (int m = 0; m < 4; ++m) { float* rowp = O + (size_t)(row0 + ai * HALF + m * 16) * ldc + col0;
#pragma unroll
                for (int bj = 0; bj < 2; ++bj)
#pragma unroll
                    for (int n = 0; n < 2; ++n) *(f32x4*)(rowp + bj * HALF + n * 16) = acc[ai][bj][m][n]; }
    }
};
struct EpiBf16Plain {
    static constexpr bool PERM = true, AFTER_DRAIN = false;
    bf16_t* O; int ldc;
    __device__ __forceinline__ void operator()(const f32x4 (&acc)[2][2][4][2], const Unit& u, int wr, int wc, int fr, int fq, const PG8_LAS unsigned char* sd) const {
        const int row0 = u.pm * BM + wr * 64 + fr; const int col0 = u.pn * BM + wc * 32 + 8 * fq;
#pragma unroll
        for (int ai = 0; ai < 2; ++ai)
#pragma unroll
            for (int m = 0; m < 4; ++m) { bf16_t* rowp = O + (size_t)(row0 + ai * HALF + m * 16) * ldc + col0;
#pragma unroll
                for (int bj = 0; bj < 2; ++bj) { const f32x4 v0 = acc[ai][bj][m][0], v1 = acc[ai][bj][m][1];
                    u32x4 w; w.x = cvt_pk_bf16(v0[0], v0[1]); w.y = cvt_pk_bf16(v0[2], v0[3]); w.z = cvt_pk_bf16(v1[0], v1[1]); w.w = cvt_pk_bf16(v1[2], v1[3]);
                    *(u32x4*)(rowp + bj * HALF) = w; } }
    }
};
struct EpiSwiglu {
    static constexpr bool PERM = true, AFTER_DRAIN = false;
    unsigned char* H; const float* bgu; const float* rowgate; const PG8_LAS int* cnt; float dq, hscale;
    __device__ __forceinline__ void operator()(const f32x4 (&acc)[2][2][4][2], const Unit& u, int wr, int wc, int fr, int fq, const PG8_LAS unsigned char* sd) const {
        const int ff = u.pn * HALF + wc * 32 + 8 * fq; const int n_e = cnt[u.e];
        f32x4 bg[2], bu[2];
#pragma unroll
        for (int n = 0; n < 2; ++n) { bg[n] = *(const PG8_LAS f32x4*)(sd + 2048 + (wc * 32 + 8 * fq + 4 * n) * 4); bu[n] = *(const PG8_LAS f32x4*)(sd + 2048 + 512 + (wc * 32 + 8 * fq + 4 * n) * 4); }
        const int lane = fr + 16 * fq;
#pragma unroll
        for (int ai = 0; ai < 2; ++ai)
#pragma unroll
            for (int mp = 0; mp < 2; ++mp) {
                unsigned pw[2][2];
#pragma unroll
                for (int mm = 0; mm < 2; ++mm) { const int m = 2 * mp + mm; const int r = ai * HALF + wr * 64 + m * 16 + fr; const int er = u.r0 + r;
                    const float rgl = ((const PG8_LAS float*)(sd + 1024))[r]; const float rg = ((er < n_e) ? rgl : 0.f) * hscale;
                    float hv[8];
#pragma unroll
                    for (int n = 0; n < 2; ++n)
#pragma unroll
                        for (int q = 0; q < 4; q += 2) {
                            f32x2 g = (f32x2){acc[ai][0][m][n][q], acc[ai][0][m][n][q + 1]} * dq + (f32x2){bg[n][q], bg[n][q + 1]};
                            f32x2 up = (f32x2){acc[ai][1][m][n][q], acc[ai][1][m][n][q + 1]} * dq + (f32x2){bu[n][q], bu[n][q + 1]};
                            g.x = fminf(g.x, 7.0f); g.y = fminf(g.y, 7.0f); up.x = fminf(fmaxf(up.x, -7.0f), 7.0f); up.y = fminf(fmaxf(up.y, -7.0f), 7.0f);
                            const f32x2 ea = g * (-1.702f * 1.4426950408889634f); f32x2 den; den.x = __builtin_amdgcn_exp2f(ea.x); den.y = __builtin_amdgcn_exp2f(ea.y); den = den + 1.0f;
                            f32x2 sg; sg.x = __builtin_amdgcn_rcpf(den.x); sg.y = __builtin_amdgcn_rcpf(den.y);
                            const f32x2 h2 = ((up + 1.0f) * g) * (sg * rg);
                            hv[n * 4 + q] = h2.x; hv[n * 4 + q + 1] = h2.y; }
                    pw[mm][0] = pk4_fp8(hv[0], hv[1], hv[2], hv[3]); pw[mm][1] = pk4_fp8(hv[4], hv[5], hv[6], hv[7]); }
                const auto s0 = __builtin_amdgcn_permlane16_swap(pw[0][0], pw[1][0], false, false); const auto s1 = __builtin_amdgcn_permlane16_swap(pw[0][1], pw[1][1], false, false);
                *(u32x4*)(H + ((size_t)u.pm * 8 + u.pn) * 32768 + ((((ai * 2 + wr) * 4 + wc) * 2 + mp) * 64 + lane) * 16) = (u32x4){s0[0], s1[0], s0[1], s1[1]};
                asm volatile("" ::: "memory"); }
    }
};
struct EpiScatter {
    static constexpr bool PERM = true, AFTER_DRAIN = false;
    unsigned char* Y; const int* rowtok; const PG8_LAS int* cnt; float dq, ysc;
    __device__ __forceinline__ void operator()(const f32x4 (&acc)[2][2][4][2], const Unit& u, int wr, int wc, int fr, int fq, const PG8_LAS unsigned char* sd) const {
        const int col0 = u.pn * BM + wc * 32 + 8 * fq; const int n_e = cnt[u.e];
        f32x4 bd[2][2];
#pragma unroll
        for (int bj = 0; bj < 2; ++bj)
#pragma unroll
            for (int n = 0; n < 2; ++n) bd[bj][n] = *(const PG8_LAS f32x4*)(sd + 2048 + (bj * HALF + wc * 32 + 8 * fq + 4 * n) * 4);
#pragma unroll
        for (int ai = 0; ai < 2; ++ai)
#pragma unroll
            for (int m = 0; m < 4; ++m) { const int er = u.r0 + ai * HALF + wr * 64 + m * 16 + fr;
                const int idx = ((const PG8_LAS int*)sd)[ai * HALF + wr * 64 + m * 16 + fr];
                if (er < n_e) { unsigned char* rowp = Y + (size_t)idx * 1024 + col0;
                    typedef unsigned u32x2 __attribute__((ext_vector_type(2)));
                    const float rg = ((const PG8_LAS float*)(sd + 1024))[ai * HALF + wr * 64 + m * 16 + fr] * ysc;
#pragma unroll
                    for (int bj = 0; bj < 2; ++bj) { const f32x4 v0 = acc[ai][bj][m][0] * dq + bd[bj][0] * rg, v1 = acc[ai][bj][m][1] * dq + bd[bj][1] * rg;
                        *(u32x2*)(rowp + bj * HALF) = (u32x2){pk4_fp8(v0[0], v0[1], v0[2], v0[3]), pk4_fp8(v1[0], v1[1], v1[2], v1[3])}; } }
                asm volatile("" ::: "memory"); }
    }
};

struct PanelStats {
    unsigned* xbuf;
    unsigned* cnt;
    unsigned* tmo;
    int ntn; float eps;
    unsigned code;
    __device__ __forceinline__ bool run(const f32x4 (&v)[2][2][4][2], const Unit& u, int wr, int wc, int fr, int fq, PG8_LAS unsigned char* lds, int wid, int lane) const {
        typedef float f32x2v __attribute__((ext_vector_type(2)));
        PG8_LAS f32x2v* P = (PG8_LAS f32x2v*)lds;
        PG8_LAS f32x2v* S = (PG8_LAS f32x2v*)(lds + 8192);
        PG8_LAS unsigned* flag = (PG8_LAS unsigned*)(lds + 8192 + 2048);
#pragma unroll
        for (int ai = 0; ai < 2; ++ai)
#pragma unroll
            for (int m = 0; m < 4; ++m) {
                float s = 0.f;
#pragma unroll
                for (int bj = 0; bj < 2; ++bj)
#pragma unroll
                    for (int n = 0; n < 2; ++n) { const f32x4 x = v[ai][bj][m][n]; s += (x[0] + x[1]) + (x[2] + x[3]); }
                s += __shfl_xor(s, 16); s += __shfl_xor(s, 32);
                const float mw = s * (1.0f / 64.0f); float q = 0.f;
#pragma unroll
                for (int bj = 0; bj < 2; ++bj)
#pragma unroll
                    for (int n = 0; n < 2; ++n) { const f32x4 d = v[ai][bj][m][n] - mw; q += (d[0] * d[0] + d[1] * d[1]) + (d[2] * d[2] + d[3] * d[3]); }
                q += __shfl_xor(q, 16); q += __shfl_xor(q, 32);
                if (fq == 0) P[(ai * HALF + wr * 64 + m * 16 + fr) * 4 + wc] = (f32x2v){mw, q};
            }
        asm volatile("s_waitcnt lgkmcnt(0)" ::: "memory"); __builtin_amdgcn_s_barrier(); asm volatile("" ::: "memory");
#if defined(BROKEN_EXCHANGE_NO_WAIT)
#warning BROKEN CONTROL BUILD: the row-statistics exchange does not wait; results are wrong by design
        if (blockIdx.x >= 64) { const long long t0_ = clock64(); while (clock64() - t0_ < 60000) __builtin_amdgcn_s_sleep(8); }
#endif
        const int row = wid * 32 + (lane & 31);
        if (lane < 32) {
            const f32x2v a = P[row * 4 + 0], b = P[row * 4 + 1], c = P[row * 4 + 2], d = P[row * 4 + 3];
            const float mt = (a.x + b.x + c.x + d.x) * 0.25f;
            const float da = a.x - mt, db = b.x - mt, dc = c.x - mt, dd = d.x - mt;
            const float m2 = (a.y + b.y) + (c.y + d.y) + 64.0f * ((da * da + db * db) + (dc * dc + dd * dd));
            unsigned long long* slot = (unsigned long long*)xbuf + ((size_t)(u.pm * BM + row) * 4 + u.pn);
            __hip_atomic_store(slot, ((unsigned long long)__float_as_uint(m2) << 32) | __float_as_uint(mt), __ATOMIC_RELAXED, __HIP_MEMORY_SCOPE_AGENT);
        }
        asm volatile("s_waitcnt vmcnt(0)" ::: "memory");
        if (lane == 0) __hip_atomic_fetch_add(cnt + 64 * u.pm, 1u, __ATOMIC_RELAXED, __HIP_MEMORY_SCOPE_AGENT);
        if (wid == 0) {
            const unsigned want = 8u * (unsigned)ntn; unsigned sp = 0u;
            while ((unsigned)__builtin_amdgcn_readfirstlane(__hip_atomic_load(cnt + 64 * u.pm, __ATOMIC_RELAXED, __HIP_MEMORY_SCOPE_AGENT)) < want) { __builtin_amdgcn_s_sleep(2); if (++sp > (1u << 20)) break; }
            __builtin_amdgcn_fence(__ATOMIC_ACQUIRE, "agent");
        }
        asm volatile("s_waitcnt vmcnt(0) lgkmcnt(0)" ::: "memory"); __builtin_amdgcn_s_barrier(); asm volatile("" ::: "memory");
        const bool bad = false;
        if (lane < 32) {
            const unsigned long long* slot = (const unsigned long long*)xbuf + (size_t)(u.pm * BM + row) * 4; float mt[4], m2[4]; float ms = 0.f;
#pragma unroll
            for (int t = 0; t < 4; ++t) { if (t < ntn) { const unsigned long long w = __hip_atomic_load(slot + t, __ATOMIC_RELAXED, __HIP_MEMORY_SCOPE_AGENT); mt[t] = __uint_as_float((unsigned)w); m2[t] = __uint_as_float((unsigned)(w >> 32)); } else { mt[t] = 0.f; m2[t] = 0.f; } ms += mt[t]; }
            const float mean = ms / (float)ntn; float q = 0.f;
#pragma unroll
            for (int t = 0; t < 4; ++t) if (t < ntn) { const float dm = mt[t] - mean; q += m2[t] + 256.0f * dm * dm; }
            S[row] = (f32x2v){mean, 1.0f / sqrtf(q / (256.0f * (float)ntn) + eps)};
        }
        asm volatile("s_waitcnt lgkmcnt(0)" ::: "memory"); __builtin_amdgcn_s_barrier(); asm volatile("" ::: "memory");
        return bad;
    }
};

struct EpiLn1 {
    static constexpr bool PERM = true, AFTER_DRAIN = true;
    unsigned char* ws; const float* gam; const float* bet; size_t o_xb, o_x8, o_xbuf, o_cnt, o_tmo; float alpha, s8, eps; unsigned code;
    __device__ __forceinline__ void operator()(const f32x4 (&)[2][2][4][2], const Unit&, int, int, int, int, const PG8_LAS unsigned char*) const {}
    __device__ __forceinline__ void fused(f32x4 (&acc)[2][2][4][2], const Unit& u, int wr, int wc, int fr, int fq, PG8_LAS unsigned char* lds, int wid, int lane) const {
        typedef float f32x2v __attribute__((ext_vector_type(2))); typedef unsigned u32x2 __attribute__((ext_vector_type(2)));
        bf16_t* const XBp = (bf16_t*)(ws + o_xb); unsigned char* const X8 = ws + o_x8;
        const PanelStats st{(unsigned*)(ws + o_xbuf), (unsigned*)(ws + o_cnt), (unsigned*)(ws + o_tmo), 4, eps, code};
        const int col0 = u.pn * BM + wc * 32 + 8 * fq;
#pragma unroll
        for (int ai = 0; ai < 2; ++ai)
#pragma unroll
            for (int m = 0; m < 4; ++m) { const bf16_t* xr = XBp + (size_t)(u.pm * BM + ai * HALF + wr * 64 + m * 16 + fr) * 1024 + col0;
#pragma unroll
                for (int bj = 0; bj < 2; ++bj) { const u32x4 x = *(const u32x4*)(xr + bj * HALF);
                    acc[ai][bj][m][0] += (f32x4){__builtin_bit_cast(float, x.x << 16), __builtin_bit_cast(float, x.x & 0xffff0000u), __builtin_bit_cast(float, x.y << 16), __builtin_bit_cast(float, x.y & 0xffff0000u)} * alpha;
                    acc[ai][bj][m][1] += (f32x4){__builtin_bit_cast(float, x.z << 16), __builtin_bit_cast(float, x.z & 0xffff0000u), __builtin_bit_cast(float, x.w << 16), __builtin_bit_cast(float, x.w & 0xffff0000u)} * alpha; }
                asm volatile("" ::: "memory"); }
        (void)st.run(acc, u, wr, wc, fr, fq, lds, wid, lane);
        const PG8_LAS f32x2v* S = (const PG8_LAS f32x2v*)(lds + 8192);
#pragma unroll
        for (int bj = 0; bj < 2; ++bj) {
            const f32x4 g0 = *(const f32x4*)(gam + col0 + bj * HALF), g1 = *(const f32x4*)(gam + col0 + bj * HALF + 4), b0 = *(const f32x4*)(bet + col0 + bj * HALF), b1 = *(const f32x4*)(bet + col0 + bj * HALF + 4);
#pragma unroll
            for (int ai = 0; ai < 2; ++ai)
#pragma unroll
                for (int m = 0; m < 4; ++m) { const int r = ai * HALF + wr * 64 + m * 16 + fr; const f32x2v sr = S[r]; const size_t off = (size_t)(u.pm * BM + r) * 1024 + col0 + bj * HALF;
                    const f32x4 o0 = (acc[ai][bj][m][0] - sr.x) * sr.y * g0 + b0, o1 = (acc[ai][bj][m][1] - sr.x) * sr.y * g1 + b1;
                    u32x4 w; w.x = cvt_pk_bf16(o0[0], o0[1]); w.y = cvt_pk_bf16(o0[2], o0[3]); w.z = cvt_pk_bf16(o1[0], o1[1]); w.w = cvt_pk_bf16(o1[2], o1[3]);
                    *(u32x4*)(XBp + off) = w;
                    *(u32x2*)(X8 + off) = (u32x2){pk4_fp8(o0[0] * s8, o0[1] * s8, o0[2] * s8, o0[3] * s8), pk4_fp8(o1[0] * s8, o1[1] * s8, o1[2] * s8, o1[3] * s8)};
                    asm volatile("" ::: "memory"); } }
    }
};

template <class Epi, class Sched, bool ALIGN_EPI, bool GATHER, bool FP8 = false, bool ABLK = false>
__device__ __forceinline__ void gemm_phase(PG8_LAS unsigned char* lds, const Gemm g, const Sched& S, const Epi& E) {
    const int tid = threadIdx.x, wid = __builtin_amdgcn_readfirstlane(tid >> 6), lane = tid & 63, wr = wid >> 2, wc = wid & 3, fr = lane & 15, fq = lane >> 4;
    const int K = g.K, nt = K / BK;
    unsigned voffB[2];
#pragma unroll
    for (int i = 0; i < 2; ++i) { int R, C; stage_rc(tid * 16 + i * 8192, R, C); const int Rb = Epi::PERM ? ((R & ~31) + perm32(R & 31)) : R;
        voffB[i] = (unsigned)(Rb * K + C) * 2u; }
    constexpr int SIDE_BYTES = 8192;
    PG8_LAS unsigned char* const side = lds + STAGE_BYTES;
    const size_t kstep = (size_t)(BK * 2);
    const size_t kstepA = ABLK ? (size_t)32768 : kstep;
    const size_t hstep = (size_t)HALF * K * 2;
    const size_t tstep = 2 * hstep;
    const unsigned ldsw = (unsigned)wid * 1024u;
    const int aoff = lds_byte(wr * 64 + fr, fq * 8), boff = lds_byte(wc * 32 + fr, fq * 8);
#define PG8_SA(b, h) (((b) * 2 + (h)) * HTB)
#define PG8_SB(b, h) ((4 + (b) * 2 + (h)) * HTB)
#define PG8_STAGE(bufoff, gbase, voff) do { _Pragma("unroll") for (int _i = 0; _i < 2; ++_i) \
        __builtin_amdgcn_global_load_lds((const unsigned*)((const char*)(gbase) + (voff)[_i]), (PG8_LAS unsigned*)(lds + (bufoff) + ldsw + _i * 8192), 16, 0, 0); } while (0)
#define PG8_LDA(dst, b, h) do { _Pragma("unroll") for (int m = 0; m < 4; ++m) _Pragma("unroll") for (int k = 0; k < 2; ++k) dst[m][k] = *(const PG8_LAS bf16x8*)(lds + PG8_SA(b, h) + aoff + m * 2048 + k * 1024); } while (0)
#define PG8_LDB(dst, b, h) do { _Pragma("unroll") for (int n = 0; n < 2; ++n) _Pragma("unroll") for (int k = 0; k < 2; ++k) dst[n][k] = *(const PG8_LAS bf16x8*)(lds + PG8_SB(b, h) + boff + n * 2048 + k * 1024); } while (0)
#define PG8_MMA(ai, bj, At, Bt) do { __builtin_amdgcn_s_setprio(1); _Pragma("unroll") for (int m = 0; m < 4; ++m) _Pragma("unroll") for (int n = 0; n < 2; ++n) { \
        if constexpr (FP8) mfma8(acc[ai][bj][m][n], cat8(Bt[n][0], Bt[n][1]), cat8(At[m][0], At[m][1]), scl8); \
        else { _Pragma("unroll") for (int k = 0; k < 2; ++k) acc[ai][bj][m][n] = __builtin_amdgcn_mfma_f32_16x16x32_bf16(Bt[n][k], At[m][k], acc[ai][bj][m][n], 0, 0, 0); } } __builtin_amdgcn_s_setprio(0); } while (0)
#define PG8_WAIT_V(n) asm volatile("s_waitcnt vmcnt(" #n ")" ::: "memory")
#define PG8_WAIT_L(n) asm volatile("s_waitcnt lgkmcnt(" #n ")" ::: "memory")
#define PG8_BAR __builtin_amdgcn_s_barrier()
#define PG8_SCHED __builtin_amdgcn_sched_barrier(0)
#define PG8_SETOFFS(o, u) do { _Pragma("unroll") for (int _h = 0; _h < 2; ++_h) _Pragma("unroll") for (int _i = 0; _i < 2; ++_i) { int _R, _C; stage_rc(tid * 16 + _i * 8192, _R, _C); \
        o[_h][_i] = GATHER ? (S.arow(u, _R + HALF * _h) + (unsigned)(_C * 2)) : ABLK ? hblk_off(_R + HALF * _h, _C >> 3) : ((unsigned)((_R + HALF * _h) * K) * 2u + (unsigned)(_C * 2)); } } while (0)
    int scl8 = 0x7F7F7F7F; asm volatile("" : "+v"(scl8));
    Unit cur, nxt; int ui = 0;
    if (!S.next(0, cur)) return;
    f32x4 acc[2][2][4][2];
#pragma unroll
    for (int a = 0; a < 2; ++a)
#pragma unroll
        for (int b = 0; b < 2; ++b)
#pragma unroll
            for (int m = 0; m < 4; ++m)
#pragma unroll
                for (int n = 0; n < 2; ++n) { acc[a][b][m][n] = (f32x4){0.f, 0.f, 0.f, 0.f}; if constexpr (FP8) asm volatile("" : "+v"(acc[a][b][m][n])); }
    bf16x8 At[4][2], B0[2][2], B1[2][2];
    unsigned cAo[2][2];
    PG8_SETOFFS(cAo, cur);
    const char* cA = S.abase(cur, g, tstep); const char* cB = S.bbase(cur, g, tstep);
    S.a_ready(cur);
    PG8_STAGE(PG8_SB(0, 0), cB, voffB); PG8_STAGE(PG8_SB(0, 1), cB + hstep, voffB); PG8_STAGE(PG8_SA(0, 0), cA, cAo[0]); PG8_STAGE(PG8_SA(0, 1), cA, cAo[1]);
    if (wr == 1) PG8_BAR;
    PG8_WAIT_V(2); PG8_BAR;
    PG8_STAGE(PG8_SB(1, 0), cB + kstep, voffB); PG8_STAGE(PG8_SA(1, 0), cA + kstepA, cAo[0]); PG8_STAGE(PG8_SB(1, 1), cB + hstep + kstep, voffB);
    PG8_WAIT_V(6); PG8_BAR;
    for (;;) {
        const bool has_next = S.next(ui + 1, nxt);
        const char* nA = has_next ? S.abase(nxt, g, tstep) : cA; const char* nB = has_next ? S.bbase(nxt, g, tstep) : cB;
        if constexpr (Sched::SIDE) {
            const void* ssrc = S.side_src(cur, (GATHER && has_next) ? nxt : cur, wid, lane);
            __builtin_amdgcn_global_load_lds((const unsigned*)ssrc, (PG8_LAS unsigned*)(side + (ui & 1) * SIDE_BYTES + wid * 1024), 16, 0, 0); }
#pragma unroll 1
        for (int t = 0; t < nt; t += 2) {
            const bool last = (t == nt - 2);
            const char* a1 = cA + (size_t)(t + 1) * kstepA;
            const char* a2 = last ? nA : cA + (size_t)(t + 2) * kstepA; const char* b2 = last ? nB : cB + (size_t)(t + 2) * kstep;
            const char* a3 = a2 + kstepA; const char* b3 = b2 + kstep;
            if (last && has_next) S.a_ready(nxt);
            PG8_LDB(B0, 0, 0); PG8_LDB(B1, 0, 1); PG8_SCHED; PG8_LDA(At, 0, 0); PG8_STAGE(PG8_SA(1, 1), a1, cAo[1]);
            if constexpr (GATHER) { if (last && has_next) {
                const PG8_LAS unsigned char* sdn = side + (ui & 1) * SIDE_BYTES;
#pragma unroll
                for (int _h = 0; _h < 2; ++_h)
#pragma unroll
                    for (int _i = 0; _i < 2; ++_i) { int _R, _C; stage_rc(tid * 16 + _i * 8192, _R, _C); cAo[_h][_i] = S.arow_side(nxt, _R + HALF * _h, sdn) + (unsigned)(_C * 2); } } }
            PG8_WAIT_V(8); PG8_WAIT_L(0); PG8_BAR; PG8_MMA(0, 0, At, B0); PG8_MMA(0, 1, At, B1); PG8_BAR; PG8_SCHED;
            PG8_LDA(At, 0, 1); PG8_STAGE(PG8_SB(0, 0), b2, voffB); PG8_STAGE(PG8_SB(0, 1), b2 + hstep, voffB); PG8_STAGE(PG8_SA(0, 0), a2, cAo[0]);
            PG8_WAIT_V(8); PG8_WAIT_L(0); PG8_BAR; PG8_MMA(1, 0, At, B0); PG8_MMA(1, 1, At, B1); PG8_BAR; PG8_SCHED;
            PG8_LDB(B0, 1, 0); PG8_LDB(B1, 1, 1); PG8_SCHED; PG8_LDA(At, 1, 0); PG8_STAGE(PG8_SA(0, 1), a2, cAo[1]);
            PG8_WAIT_V(8); PG8_WAIT_L(0); PG8_BAR; PG8_MMA(0, 0, At, B0); PG8_MMA(0, 1, At, B1); PG8_BAR; PG8_SCHED;
            PG8_LDA(At, 1, 1); PG8_STAGE(PG8_SB(1, 0), b3, voffB); PG8_STAGE(PG8_SB(1, 1), b3 + hstep, voffB); PG8_STAGE(PG8_SA(1, 0), a3, cAo[0]);
            PG8_WAIT_V(8); PG8_WAIT_L(0); PG8_BAR; PG8_MMA(1, 0, At, B0); PG8_MMA(1, 1, At, B1); PG8_BAR; PG8_SCHED;
        }
        if constexpr (ALIGN_EPI) { if (wr == 0) PG8_BAR; }
        if constexpr (FP8) asm volatile("s_nop 15\n\ts_nop 15" ::: "memory");
        if constexpr (!Epi::AFTER_DRAIN) { PG8_SCHED; E(acc, cur, wr, wc, fr, fq, side + (ui & 1) * SIDE_BYTES); S.done(cur); PG8_SCHED; }
        if (!has_next) break;
#pragma unroll
        for (int a = 0; a < 2; ++a)
#pragma unroll
            for (int b = 0; b < 2; ++b)
#pragma unroll
                for (int m = 0; m < 4; ++m)
#pragma unroll
                    for (int n = 0; n < 2; ++n) { acc[a][b][m][n] = (f32x4){0.f, 0.f, 0.f, 0.f}; if constexpr (FP8) asm volatile("" : "+v"(acc[a][b][m][n])); }
        cur = nxt; cA = nA; cB = nB; ++ui;
        if constexpr (ALIGN_EPI) { if (wr == 1) PG8_BAR; }
    }
    PG8_WAIT_V(0);
    if constexpr (!ALIGN_EPI) { if (wr == 0) PG8_BAR; }
    PG8_BAR;
    if constexpr (Epi::AFTER_DRAIN) { E.fused(acc, cur, wr, wc, fr, fq, lds, wid, lane); S.done(cur); }
#undef PG8_SA
#undef PG8_SB
#undef PG8_STAGE
#undef PG8_LDA
#undef PG8_LDB
#undef PG8_MMA
#undef PG8_WAIT_V
#undef PG8_WAIT_L
#undef PG8_BAR
#undef PG8_SCHED
#undef PG8_SETOFFS
}
}

constexpr int NB = 8, SEQ = 4096, DM = 1024, MROWS = NB * SEQ, NLAYER = 2;
constexpr int NPROJ = 4608, INW = 4616;
constexpr int C_Q = 0, C_K = 512, C_V = 1024, C_Z = 1536, C_XS = 2048, C_SB = 3072, C_SC = 3584, C_SH = 4096;
constexpr int MIXW = 1536, NEXP = 32, TOPK = 4, FF = 1024;
constexpr float ALPHA = 1.4142135623730951f;
constexpr float LN_EPS = 1e-5f, RMS_EPS = 1e-5f;
constexpr float QSCALE = 0.125f * 1.4426950408889634f;

constexpr size_t MiB = 1u << 20;
constexpr size_t WS_CTL = 0, CTL_ZERO_BYTES = 1 * MiB;
constexpr size_t WS_ROPE = 1 * MiB;
constexpr size_t WS_WDT = 2 * MiB;
constexpr size_t WS_ROUT = 2 * MiB + 65536;
constexpr size_t WS_WIN = 4 * MiB;
constexpr size_t WS_WOUT = 24 * MiB;
constexpr size_t WS_WGU = 32 * MiB;
constexpr size_t WS_WDN = 288 * MiB;
constexpr size_t WS_XB = 416 * MiB;
constexpr size_t WS_XF = 480 * MiB;
constexpr size_t WS_XF2 = 608 * MiB;
constexpr size_t WS_PROJ = 736 * MiB;
constexpr size_t WS_DT = 1024 * MiB;
constexpr size_t WS_DTS = 1025 * MiB;
constexpr size_t WS_ACUM = 1026 * MiB;
constexpr size_t WS_LSE = 1027 * MiB;
constexpr size_t WS_OP = 1030 * MiB;
constexpr size_t WS_U = 1126 * MiB;
constexpr size_t WS_G = 1190 * MiB;
constexpr size_t WS_ST = 1222 * MiB;
constexpr size_t WS_YD = 1286 * MiB;
constexpr size_t WS_MIXED = 1350 * MiB;
constexpr size_t WS_MIXF = 1446 * MiB;
constexpr size_t WS_TOPE = 1574 * MiB;
constexpr size_t WS_TOPG = 1575 * MiB;
constexpr size_t WS_ROWTOK = 1576 * MiB;
constexpr size_t WS_ROWGATE = 1580 * MiB;
constexpr size_t WS_H = 736 * MiB;
constexpr size_t WS_YB = 1030 * MiB;
constexpr size_t WS_END = 1584 * MiB;
constexpr int CW_TMO = 0;
constexpr int CW_CNT = 64;
constexpr int CW_BAR = 4096;
constexpr int CW_SEAM = 16384;

constexpr int RING_OFF = 0, RING_BYTES = 131072;
constexpr int LDSCTL_OFF = 155648;
constexpr int L_MISC = LDSCTL_OFF;
constexpr int L_TSTART = LDSCTL_OFF + 256;
constexpr int L_CNT = LDSCTL_OFF + 512;
constexpr int L_LCNT = LDSCTL_OFF + 640;
constexpr int L_LBASE = LDSCTL_OFF + 768;
constexpr int L_UNITS = LDSCTL_OFF + 1024;
constexpr int L_UNITSN = LDSCTL_OFF + 2048;
constexpr int LDS_BYTES = 163840;

#define GAS __attribute__((address_space(1)))
#define LAS __attribute__((address_space(3)))
typedef unsigned short bf16;
typedef unsigned v4u __attribute__((ext_vector_type(4)));
typedef unsigned v2u __attribute__((ext_vector_type(2)));
typedef float f32x4 __attribute__((ext_vector_type(4)));
typedef float f32x16 __attribute__((ext_vector_type(16)));
typedef short bf16x8 __attribute__((ext_vector_type(8)));
typedef GAS unsigned gu32;
#define RLX_AGENT __ATOMIC_RELAXED, __HIP_MEMORY_SCOPE_AGENT
#define LDS_WAIT() asm volatile("s_waitcnt lgkmcnt(0)" ::: "memory")
#define VM_WAIT() asm volatile("s_waitcnt vmcnt(0)" ::: "memory")
__device__ __forceinline__ unsigned f2bf(float f) { unsigned u = __builtin_bit_cast(unsigned, f); return (u + 0x7fffu + ((u >> 16) & 1u)) >> 16; }
__device__ __forceinline__ unsigned pk2(float lo, float hi) { unsigned r; asm volatile("v_cvt_pk_bf16_f32 %0, %1, %2" : "=v"(r) : "v"(lo), "v"(hi)); return r; }
__device__ __forceinline__ float bf2f(unsigned short b) { return __builtin_bit_cast(float, (unsigned)b << 16); }
__device__ __forceinline__ float bflo(unsigned w) { return __builtin_bit_cast(float, w << 16); }
__device__ __forceinline__ float bfhi(unsigned w) { return __builtin_bit_cast(float, w & 0xffff0000u); }
__device__ __forceinline__ float siluf(float x) { return x * __builtin_amdgcn_rcpf(1.0f + __builtin_amdgcn_exp2f(-1.4426950408889634f * x)); }
#define XB_TMO      128
#define XB_XCNT(j)  (256  + 64 * (j))
#define XB_XSUB(j)  (1280 + 64 * (j))
#define XB_XGEN(j)  (2304 + 64 * (j))
#define XB_TOP      3328
#define XB_TOPGEN   3392
#define XCD_BAR_WORDS 3456
#define XB_SPIN_CAP (1u << 18)

__device__ __forceinline__ unsigned xb_ld(unsigned* p)              { return __hip_atomic_load(p, __ATOMIC_RELAXED, __HIP_MEMORY_SCOPE_AGENT); }
__device__ __forceinline__ unsigned xb_add(unsigned* p, unsigned v) { return __hip_atomic_fetch_add(p, v, __ATOMIC_RELAXED, __HIP_MEMORY_SCOPE_AGENT); }
__device__ __forceinline__ unsigned xb_xcc_id() { return (unsigned)__builtin_amdgcn_s_getreg((3 << 11) | 20) & 0xFu; }
#define XB_SPIN(cond, bar) do { unsigned _sp = 0; while (cond) { __builtin_amdgcn_s_sleep(1); \
    if ((++_sp & 255u) == 0u) { if (xb_ld(&(bar)[XB_TMO])) break; if (_sp > XB_SPIN_CAP) { atomicAdd(&(bar)[XB_TMO], 1u); break; } } } } while (0)

struct XcdBarrier {
    unsigned* bar; unsigned x;
    volatile LAS unsigned* st;
};

__device__ __forceinline__ XcdBarrier xcd_barrier_post(unsigned* bar, volatile LAS unsigned* st) {
    XcdBarrier b; b.bar = bar; b.x = xb_xcc_id(); b.st = st;
    if (threadIdx.x == 0) (void)xb_add(&bar[XB_XCNT(b.x)], 1u);
    return b;
}
__device__ __forceinline__ void xcd_barrier_complete(unsigned* bar, unsigned x, unsigned& nloc, unsigned& nx) {
    const unsigned G = gridDim.x * gridDim.y * gridDim.z;
    unsigned sum, cnt, mine, sp = 0u;
    for (;;) {
        sum = 0u; cnt = 0u; mine = 0u;
#pragma unroll
        for (unsigned j = 0; j < 16; ++j) { const unsigned c = xb_ld(&bar[XB_XCNT(j)]); sum += c; cnt += (c > 0u) ? 1u : 0u; mine = (j == x) ? c : mine; }
        if (sum == G) break;
        __builtin_amdgcn_s_sleep(1);
        if ((++sp & 255u) == 0u) { if (xb_ld(&bar[XB_TMO])) break; if (sp > XB_SPIN_CAP) { atomicAdd(&bar[XB_TMO], 1u); break; } }
    }
    nloc = mine > 0u ? mine : 1u; nx = cnt > 0u ? cnt : 1u;
}

__device__ __forceinline__ void xcd_barrier(const XcdBarrier& b) {
    asm volatile("s_waitcnt vmcnt(0)" ::: "memory");
    __syncthreads();
    if (threadIdx.x == 0) {
        unsigned* bar = b.bar;
        __builtin_amdgcn_s_waitcnt(0);
        unsigned nloc = b.st[0], nx = b.st[1];
        if (nloc == 0u) { xcd_barrier_complete(bar, b.x, nloc, nx); b.st[0] = nloc; b.st[1] = nx; }
        const unsigned old = xb_add(&bar[XB_XSUB(b.x)], 1u);
        const unsigned gen = old / nloc;
        if (old + 1u == (gen + 1u) * nloc) {
            __builtin_amdgcn_fence(__ATOMIC_RELEASE, "agent");
            asm volatile("s_waitcnt vmcnt(0)" ::: "memory");
            const unsigned og = xb_add(&bar[XB_TOP], 1u);
            const unsigned tg = og / nx;
            if (og + 1u == (tg + 1u) * nx) xb_add(&bar[XB_TOPGEN], 1u);
            else XB_SPIN(xb_ld(&bar[XB_TOPGEN]) == tg, bar);
            __builtin_amdgcn_fence(__ATOMIC_ACQUIRE, "agent");
            xb_add(&bar[XB_XGEN(b.x)], 1u);
            asm volatile("s_waitcnt vmcnt(0)" ::: "memory");
        } else {
            XB_SPIN(xb_ld(&bar[XB_XGEN(b.x)]) == gen, bar);
            __builtin_amdgcn_fence(__ATOMIC_ACQUIRE, "agent");
            asm volatile("s_waitcnt vmcnt(0)" ::: "memory");
        }
    }
    __syncthreads();
}

constexpr float SC_X = 4.f, SC_WGU = 32.f, SC_H = 4.f, SC_WDN = 64.f, SC_Y = 16.f, SC_WIN = 32.f, SC_O = 32.f;
__device__ __forceinline__ float wave_sum(float v) {
#pragma unroll
    for (int o = 1; o < 64; o <<= 1) v += __shfl_xor(v, o);
    return v;
}
__device__ __forceinline__ int win_dest_row(int n) {
    if (n < 1024) { const int hh = n >> 6, d = n & 63; const int p = (d < 32) ? (8 * (d >> 2) + (d & 3)) : (8 * ((d - 32) >> 2) + 4 + (d & 3)); return hh * 64 + p; }
    if (n < 3072) return n;
    if (n < 3080) return -1;
    return n - 8;
}
__device__ __forceinline__ int wgu_dest_row(int n) { return n < 1024 ? ((n >> 7) * 256 + (n & 127)) : (((n - 1024) >> 7) * 256 + 128 + ((n - 1024) & 127)); }
template <int MAP>
__device__ __forceinline__ void p0_transpose_item(const float* W, int K, int N, bf16* WT, float* wdt, LAS float* scr, int kb, int nb, int lane) {
    const int k0 = 64 * kb, n0 = 32 * nb;
    const int nn = n0 + (lane & 31); const bool nok = nn < N;
#pragma unroll 8
    for (int i = 0; i < 32; ++i) { const int kk = 2 * i + (lane >> 5); scr[kk * 33 + (lane & 31)] = nok ? W[(size_t)(k0 + kk) * N + nn] : 0.f; }
    LDS_WAIT(); asm volatile("" ::: "memory");
    const int c = lane & 7;
#pragma unroll
    for (int j = 0; j < 4; ++j) { const int n = (lane >> 3) + 8 * j; const LAS float* s = scr + (8 * c) * 33 + n;
        const int nsrc = n0 + n; if (nsrc >= N) continue;
        int drow = nsrc; if (MAP == 1) drow = win_dest_row(nsrc); if (MAP == 2) drow = wgu_dest_row(nsrc);
        if (MAP == 1 && drow < 0) { float* d = wdt + (size_t)(nsrc - 3072) * 1024 + k0 + 8 * c;
#pragma unroll
            for (int q = 0; q < 8; ++q) d[q] = s[q * 33]; continue; }
        v4u o; o.x = pk2(s[0 * 33], s[1 * 33]); o.y = pk2(s[2 * 33], s[3 * 33]); o.z = pk2(s[4 * 33], s[5 * 33]); o.w = pk2(s[6 * 33], s[7 * 33]);
        *(GAS v4u*)(WT + (size_t)drow * K + k0 + 8 * c) = o; }
    LDS_WAIT(); asm volatile("" ::: "memory");
}
template <int MAP>
__device__ __forceinline__ void p0_transpose_item64(const float* W, int K, int N, bf16* WT, float* wdt, LAS float* scr, int kb, int nb, int lane) {
    const int k0 = 64 * kb, n0 = 64 * nb;
    const bool lok = (n0 + 4 * (lane & 15) + 3) < N;
    f32x4 ld[16];
#pragma unroll
    for (int i = 0; i < 16; ++i) ld[i] = lok ? *(const f32x4*)(W + (size_t)(k0 + 4 * i + (lane >> 4)) * N + n0 + 4 * (lane & 15)) : (f32x4){0.f, 0.f, 0.f, 0.f};
#pragma unroll
    for (int i = 0; i < 16; ++i) *(LAS f32x4*)(scr + (4 * i + (lane >> 4)) * 64 + 4 * (lane & 15)) = ld[i];
    LDS_WAIT(); asm volatile("" ::: "memory");
    const int nsrc = n0 + lane;
    if (nsrc < N) {
        int drow = nsrc; if (MAP == 1) drow = win_dest_row(nsrc);
        if (MAP == 1 && drow < 0) { float* d = wdt + (size_t)(nsrc - 3072) * 1024 + k0;
#pragma unroll
            for (int q = 0; q < 16; ++q) *(f32x4*)(d + 4 * q) = (f32x4){scr[(4 * q) * 64 + lane], scr[(4 * q + 1) * 64 + lane], scr[(4 * q + 2) * 64 + lane], scr[(4 * q + 3) * 64 + lane]}; }
        else { GAS v4u* d = (GAS v4u*)(WT + (size_t)drow * K + k0);
#pragma unroll
            for (int q = 0; q < 8; ++q) { v4u o; o.x = pk2(scr[(8 * q) * 64 + lane], scr[(8 * q + 1) * 64 + lane]); o.y = pk2(scr[(8 * q + 2) * 64 + lane], scr[(8 * q + 3) * 64 + lane]);
                o.z = pk2(scr[(8 * q + 4) * 64 + lane], scr[(8 * q + 5) * 64 + lane]); o.w = pk2(scr[(8 * q + 6) * 64 + lane], scr[(8 * q + 7) * 64 + lane]); d[q] = o; } } }
    LDS_WAIT(); asm volatile("" ::: "memory");
}
struct SubT { const float* src; unsigned char* dst; int N; int n0; int mode; float scale; };
__device__ __forceinline__ SubT fp8_subtile(int item, int half, const float* wgu, const float* wdn, const float* win, unsigned char* WG8, unsigned char* WD8, unsigned char* WI8, int lane) {
    SubT t; int kb, nb;
    if (item < 64 * 256) { const int le = item >> 8, r = item & 255; kb = r >> 5; nb = r & 31; t.N = 2048; t.mode = 1; t.scale = SC_WGU;
        t.src = wgu + (size_t)le * 1024 * 2048; t.dst = WG8 + (size_t)le * 2048 * 1024; }
    else if (item < 64 * 256 + 64 * 128) { const int it2 = item - 64 * 256; const int le = it2 >> 7, r = it2 & 127; kb = r >> 4; nb = r & 15; t.N = 1024; t.mode = 0; t.scale = SC_WDN;
        t.src = wdn + (size_t)le * 1024 * 1024; t.dst = WD8 + (size_t)le * 1024 * 1024; }
    else { const int it3 = item - (64 * 256 + 64 * 128); const int l = it3 / 192, r = it3 % 192; kb = r / 24; nb = r % 24; t.N = INW; t.mode = 2; t.scale = SC_WIN;
        t.src = win + (size_t)l * 1024 * INW; t.dst = WI8 + (size_t)l * 1536 * 1024; }
    const int k0 = 128 * kb + 64 * half; t.n0 = 64 * nb;
    t.src += (size_t)(k0 + (lane >> 4)) * t.N + t.n0 + 4 * (lane & 15);
    t.dst += (size_t)k0;
    return t;
}
__device__ __forceinline__ void fp8_sub_load(const SubT& t, f32x4 (&ld)[16]) {
#pragma unroll
    for (int i = 0; i < 16; ++i) ld[i] = __builtin_nontemporal_load((const f32x4*)(t.src + (size_t)(4 * i) * t.N));
}
__device__ __forceinline__ void fp8_sub_process(const SubT& t, const f32x4 (&ld)[16], LAS float* scr, int lane) {
#pragma unroll
    for (int i = 0; i < 16; ++i) *(LAS f32x4*)(scr + (4 * i + (lane >> 4)) * 64 + 4 * (lane & 15)) = ld[i];
    LDS_WAIT(); asm volatile("" ::: "memory");
    unsigned w[16];
#pragma unroll
    for (int q = 0; q < 16; ++q) w[q] = pg8::pk4_fp8(scr[(4 * q + 0) * 64 + lane] * t.scale, scr[(4 * q + 1) * 64 + lane] * t.scale, scr[(4 * q + 2) * 64 + lane] * t.scale, scr[(4 * q + 3) * 64 + lane] * t.scale);
    LDS_WAIT(); asm volatile("" ::: "memory");
    LAS unsigned char* t2 = (LAS unsigned char*)scr;
#pragma unroll
    for (int q = 0; q < 4; ++q) *(LAS v4u*)(t2 + lane * 80 + 16 * q) = (v4u){w[4 * q], w[4 * q + 1], w[4 * q + 2], w[4 * q + 3]};
    LDS_WAIT(); asm volatile("" ::: "memory");
#pragma unroll
    for (int q = 0; q < 4; ++q) { const int n = 16 * q + (lane >> 2); const v4u v = *(const LAS v4u*)(t2 + n * 80 + 16 * (lane & 3));
        const int nn = (t.mode == 1) ? wgu_dest_row(t.n0 + n) : (t.mode == 2) ? win_dest_row(t.n0 + n) : (t.n0 + n);
        *(GAS v4u*)(t.dst + (size_t)nn * 1024 + 16 * (lane & 3)) = v; }
    LDS_WAIT(); asm volatile("" ::: "memory");
}
__device__ __forceinline__ void row_dt(const f32x4 (&v)[4], const float* wdt, float* dst, int lane) {
    float r[8];
#pragma unroll
    for (int jj = 0; jj < 8; ++jj) { float s = 0.f;
#pragma unroll
        for (int j = 0; j < 4; ++j) { const f32x4 w = *(const f32x4*)(wdt + jj * 1024 + 4 * lane + 256 * j); s += v[j][0] * w[0] + v[j][1] * w[1] + v[j][2] * w[2] + v[j][3] * w[3]; }
        r[jj] = wave_sum(s); }
    if (lane == 0) { *(f32x4*)dst = (f32x4){r[0], r[1], r[2], r[3]}; *(f32x4*)(dst + 4) = (f32x4){r[4], r[5], r[6], r[7]}; }
}
__device__ __forceinline__ void row_dt_win(const f32x4 (&v)[4], const float* win, float* dst, int lane) {
    float r[8];
#pragma unroll
    for (int jj = 0; jj < 8; ++jj) r[jj] = 0.f;
#pragma unroll
    for (int j = 0; j < 4; ++j)
#pragma unroll
        for (int e = 0; e < 4; ++e) { const float* wp = win + (size_t)(4 * lane + 256 * j + e) * INW + 3072; const f32x4 w0 = *(const f32x4*)wp, w1 = *(const f32x4*)(wp + 4); const float x = v[j][e];
            r[0] += x * w0[0]; r[1] += x * w0[1]; r[2] += x * w0[2]; r[3] += x * w0[3]; r[4] += x * w1[0]; r[5] += x * w1[1]; r[6] += x * w1[2]; r[7] += x * w1[3]; }
#pragma unroll
    for (int jj = 0; jj < 8; ++jj) r[jj] = wave_sum(r[jj]);
    if (lane == 0) { *(f32x4*)dst = (f32x4){r[0], r[1], r[2], r[3]}; *(f32x4*)(dst + 4) = (f32x4){r[4], r[5], r[6], r[7]}; }
}
template <bool W8, bool WF>
__device__ __forceinline__ void ln_row(f32x4 (&v)[4], const float* gam, const float* bet, float* of32, bf16* ob16, unsigned char* o8, float s8, int lane) {
    float s = 0.f;
#pragma unroll
    for (int j = 0; j < 4; ++j) s += (v[j][0] + v[j][1]) + (v[j][2] + v[j][3]);
    const float mean = wave_sum(s) * (1.f / DM); float s2 = 0.f;
#pragma unroll
    for (int j = 0; j < 4; ++j) { v[j] = v[j] - mean; s2 += (v[j][0] * v[j][0] + v[j][1] * v[j][1]) + (v[j][2] * v[j][2] + v[j][3] * v[j][3]); }
    const float rstd = 1.f / sqrtf(wave_sum(s2) * (1.f / DM) + LN_EPS);
#pragma unroll
    for (int j = 0; j < 4; ++j) { const f32x4 g = *(const f32x4*)(gam + 4 * lane + 256 * j), b = *(const f32x4*)(bet + 4 * lane + 256 * j);
        v[j] = v[j] * rstd * g + b;
        if (WF) *(f32x4*)(of32 + 4 * lane + 256 * j) = v[j];
        v2u w; w.x = pk2(v[j][0], v[j][1]); w.y = pk2(v[j][2], v[j][3]); *(v2u*)(ob16 + 4 * lane + 256 * j) = w;
        if (W8) *(unsigned*)(o8 + 4 * lane + 256 * j) = pg8::pk4_fp8(v[j][0] * s8, v[j][1] * s8, v[j][2] * s8, v[j][3] * s8); }
}


typedef short v4i16_t __attribute__((ext_vector_type(4)));
__device__ __forceinline__ bf16x8 tr_pair(const LAS unsigned char* p0, const LAS unsigned char* p1) {
    const v4i16_t a = __builtin_amdgcn_ds_read_tr16_b64_v4i16((LAS v4i16_t*)p0), b = __builtin_amdgcn_ds_read_tr16_b64_v4i16((LAS v4i16_t*)p1);
    return (bf16x8){a[0], a[1], a[2], a[3], b[0], b[1], b[2], b[3]};
}
__device__ __forceinline__ int crow16(int r, int hi) { return (r & 3) + 8 * (r >> 2) + 4 * hi; }
constexpr int AK_PITCH = 144, AV_PITCH = 192, AK_TILE = 32 * AK_PITCH, AV_TILE = 32 * AV_PITCH;
constexpr int AT_K = 0, AT_V = 12 * AK_TILE;
struct AttnItem { int p, b, h, d, r, qt0; };
__device__ __forceinline__ AttnItem attn_item(int I) { AttnItem a; a.p = I >> 10; const int rem = I & 1023; a.b = rem >> 7; a.h = (rem >> 4) & 7; const int grp = rem & 15;
    a.d = (a.p == 0) ? 1 : (a.p == 1) ? 4 : 16; const int tpr = 128 / a.d; const int T = grp * 8; a.r = T / tpr; a.qt0 = T % tpr; return a; }
__device__ __forceinline__ void attn_request(const bf16* PROJ, const AttnItem& a, v4u (&st)[12], int tid) {
    const int rr = tid >> 4, ch = tid & 15; const int col = (ch < 8 ? C_K : C_V - 64) + a.h * 64 + ch * 8;
#pragma unroll
    for (int tl = 0; tl < 12; ++tl) { const int kt = a.qt0 - 4 + tl; st[tl] = (v4u){0u, 0u, 0u, 0u};
        if (kt >= 0) { const size_t row = (size_t)a.b * SEQ + (size_t)(32 * kt + rr) * a.d + a.r; st[tl] = *(const v4u*)(PROJ + row * NPROJ + col); } }
}
__device__ __forceinline__ void attn_deposit(LAS unsigned char* al, const v4u (&st)[12], int tid) {
    const int rr = tid >> 4, ch = tid & 15;
    LAS unsigned char* dst = (ch < 8) ? (al + AT_K + rr * AK_PITCH + ch * 16) : (al + AT_V + rr * AV_PITCH + (ch - 8) * 16); const int tstep = (ch < 8) ? AK_TILE : AV_TILE;
#pragma unroll
    for (int tl = 0; tl < 12; ++tl) *(LAS v4u*)(dst + tl * tstep) = st[tl];
}
__device__ __forceinline__ void attn_wave_compute(const bf16* PROJ, bf16* OPp, float* LSEp, const AttnItem& a, const LAS unsigned char* al, int wave, int lane) {
    const int i = lane & 31, h2 = lane >> 5; const int qt = a.qt0 + wave;
    const size_t rowq = (size_t)a.b * SEQ + (size_t)(32 * qt + i) * a.d + a.r;
    bf16x8 qf[4];
    { const bf16* qp = PROJ + rowq * NPROJ + C_Q + a.h * 64 + 8 * h2;
#pragma unroll
      for (int s = 0; s < 4; ++s) qf[s] = *(const bf16x8*)(qp + 16 * s); }
    f32x16 o0 = {}, o1 = {}; float mrun = -INFINITY, lrun = 0.f;
    const int kt0 = qt > 4 ? qt - 4 : 0;
    const LAS unsigned char* krd = al + AT_K + i * AK_PITCH + 16 * h2;
    const LAS unsigned char* trb = al + AT_V + (4 * h2 + ((lane & 15) >> 2)) * AV_PITCH + (16 * ((lane >> 4) & 1) + 4 * (lane & 3)) * 2;
    f32x16 snext = {};
    { const LAS unsigned char* kp = krd + (kt0 - a.qt0 + 4) * AK_TILE;
#pragma unroll
      for (int s = 0; s < 4; ++s) snext = __builtin_amdgcn_mfma_f32_32x32x16_bf16(*(const LAS bf16x8*)(kp + 32 * s), qf[s], snext, 0, 0, 0); }
#pragma unroll 1
    for (int kt = kt0; kt <= qt; ++kt) {
        const int tl = kt - a.qt0 + 4;
        const LAS unsigned char* vp = trb + tl * AV_TILE;
        f32x16 sacc = snext;
        if (kt < qt) { const LAS unsigned char* kp = krd + (tl + 1) * AK_TILE; snext = (f32x16){};
#pragma unroll
            for (int s = 0; s < 4; ++s) snext = __builtin_amdgcn_mfma_f32_32x32x16_bf16(*(const LAS bf16x8*)(kp + 32 * s), qf[s], snext, 0, 0, 0); }
        if (kt == qt) {
#pragma unroll
            for (int rg = 0; rg < 16; ++rg) if (crow16(rg, h2) > i) sacc[rg] = -INFINITY;
        }
        if (kt + 4 == qt) {
#pragma unroll
            for (int rg = 0; rg < 16; ++rg) if (crow16(rg, h2) < i) sacc[rg] = -INFINITY;
        }
        float mx = sacc[0];
#pragma unroll
        for (int rg = 1; rg < 16; ++rg) mx = fmaxf(mx, sacc[rg]);
        mx = fmaxf(mx, __shfl_xor(mx, 32));
        const float mnew = fmaxf(mrun, mx), alpha = __builtin_amdgcn_exp2f(mrun - mnew); mrun = mnew;
        float ps = 0.f;
#pragma unroll
        for (int rg = 0; rg < 16; ++rg) { sacc[rg] = __builtin_amdgcn_exp2f(sacc[rg] - mnew); ps += sacc[rg]; }
        lrun = lrun * alpha + ps;
#pragma unroll
        for (int rg = 0; rg < 16; ++rg) { o0[rg] *= alpha; o1[rg] *= alpha; }
        bf16x8 pf[2];
#pragma unroll
        for (int ks = 0; ks < 2; ++ks) { v4u w; w.x = pg8::cvt_pk_bf16(sacc[8 * ks + 0], sacc[8 * ks + 1]); w.y = pg8::cvt_pk_bf16(sacc[8 * ks + 2], sacc[8 * ks + 3]); w.z = pg8::cvt_pk_bf16(sacc[8 * ks + 4], sacc[8 * ks + 5]); w.w = pg8::cvt_pk_bf16(sacc[8 * ks + 6], sacc[8 * ks + 7]); pf[ks] = __builtin_bit_cast(bf16x8, w); }
#pragma unroll
        for (int ks = 0; ks < 2; ++ks) {
            const bf16x8 v0 = tr_pair(vp + (16 * ks) * AV_PITCH, vp + (16 * ks + 8) * AV_PITCH);
            const bf16x8 v1 = tr_pair(vp + (16 * ks) * AV_PITCH + 64, vp + (16 * ks + 8) * AV_PITCH + 64);
            o0 = __builtin_amdgcn_mfma_f32_32x32x16_bf16(v0, pf[ks], o0, 0, 0, 0);
            o1 = __builtin_amdgcn_mfma_f32_32x32x16_bf16(v1, pf[ks], o1, 0, 0, 0);
        }
    }
    const float lt = lrun + __shfl_xor(lrun, 32); const float il = 1.0f / lt;
    unsigned char* op = (unsigned char*)OPp + rowq * 512 + a.h * 64 + 4 * h2;
    const float ils = il * SC_O;
#pragma unroll
    for (int g4 = 0; g4 < 4; ++g4) {
        *(unsigned*)(op + 8 * g4) = pg8::pk4_fp8(o0[4 * g4 + 0] * ils, o0[4 * g4 + 1] * ils, o0[4 * g4 + 2] * ils, o0[4 * g4 + 3] * ils);
        *(unsigned*)(op + 32 + 8 * g4) = pg8::pk4_fp8(o1[4 * g4 + 0] * ils, o1[4 * g4 + 1] * ils, o1[4 * g4 + 2] * ils, o1[4 * g4 + 3] * ils); }
    if (h2 == 0) LSEp[rowq * 8 + a.h] = mrun + log2f(lt);
}
__device__ __forceinline__ void attn_phase(LAS unsigned char* al, const bf16* PROJ, bf16* OP, float* LSE, int bid, int G, int tid, int wave, int lane) {
    v4u st[12];
    int I = bid;
    if (I < 3072) { const AttnItem a = attn_item(I); attn_request(PROJ, a, st, tid); }
    for (; I < 3072; I += G) {
        const AttnItem a = attn_item(I);
        __syncthreads();
        attn_deposit(al, st, tid);
        __syncthreads();
        if (I + G < 3072) { const AttnItem n = attn_item(I + G); attn_request(PROJ, n, st, tid); }
        attn_wave_compute(PROJ, (bf16*)((unsigned char*)OP + (size_t)a.p * MROWS * 512), LSE + (size_t)a.p * MROWS * 8, a, al, wave, lane);
    }
    __syncthreads();
}

constexpr int SS_DTS = 0, SS_ACUM = 2048, SS_TMP = 4096, SS_SSX = 6144, SS_IMG = 8192;
constexpr int S1_PB = 320, S1_PX = 576;
constexpr int S1_B = SS_IMG, S1_X = SS_IMG + 128 * S1_PB;
constexpr int S3_PBC = 272, S3_PX = 576;
constexpr int S3_B = SS_IMG, S3_C = S3_B + 128 * S3_PBC, S3_X = S3_C + 128 * S3_PBC;

__device__ __forceinline__ void ssd_prep(LAS unsigned char* sl, const float* DT, const float* dtb, const float* alog, size_t row0, int g, int tid, int lane, int wave) {
    LAS float* dts = (LAS float*)(sl + SS_DTS); LAS float* acum = (LAS float*)(sl + SS_ACUM); LAS float* tmp = (LAS float*)(sl + SS_TMP);
    { const int l = tid >> 2, hq = tid & 3; const float x = DT[(row0 + l) * 8 + 4 * g + hq] + dtb[4 * g + hq];
      const float dt = x > 20.f ? x : log1pf(__expf(x)); dts[hq * 128 + l] = dt; tmp[hq * 128 + l] = dt * (-__expf(alog[4 * g + hq])); }
    __syncthreads();
    if (wave < 4) { const float v0 = tmp[wave * 128 + 2 * lane], v1 = tmp[wave * 128 + 2 * lane + 1]; float s = v0 + v1;
#pragma unroll
        for (int off = 1; off < 64; off <<= 1) { const float t = __shfl_up(s, off); if (lane >= off) s += t; }
        acum[wave * 128 + 2 * lane] = s - v1; acum[wave * 128 + 2 * lane + 1] = s; }
    __syncthreads();
}
template <int NCOLS, int FACMODE>
__device__ __forceinline__ void conv_tile(const bf16* PROJ, size_t row0, int t0, int pcol0, const float* cw, const float* cb, int cch0, LAS unsigned char* dst, int pitch, const LAS unsigned char* sl, int hq0, int tid) {
    constexpr int NCH8 = NCOLS / 8, NSEG = 512 / NCH8, RPS = 128 / NSEG;
    const int c8 = tid % NCH8, seg = tid / NCH8, l0 = seg * RPS;
    float w[4][8], bias[8], hst[3][8];
#pragma unroll
    for (int k = 0; k < 4; ++k) { const f32x4 a = *(const f32x4*)(cw + k * 1024 + cch0 + c8 * 8), b = *(const f32x4*)(cw + k * 1024 + cch0 + c8 * 8 + 4);
        w[k][0] = a[0]; w[k][1] = a[1]; w[k][2] = a[2]; w[k][3] = a[3]; w[k][4] = b[0]; w[k][5] = b[1]; w[k][6] = b[2]; w[k][7] = b[3]; }
    { const f32x4 a = *(const f32x4*)(cb + cch0 + c8 * 8), b = *(const f32x4*)(cb + cch0 + c8 * 8 + 4);
      bias[0] = a[0]; bias[1] = a[1]; bias[2] = a[2]; bias[3] = a[3]; bias[4] = b[0]; bias[5] = b[1]; bias[6] = b[2]; bias[7] = b[3]; }
    const bf16* src = PROJ + pcol0 + c8 * 8;
#pragma unroll
    for (int k = 0; k < 3; ++k) { const int l = l0 - 3 + k; v4u v = (v4u){0u, 0u, 0u, 0u}; if (t0 + l >= 0) v = *(const v4u*)(src + (size_t)((long)row0 + l) * NPROJ);
        hst[k][0] = bflo(v.x); hst[k][1] = bfhi(v.x); hst[k][2] = bflo(v.y); hst[k][3] = bfhi(v.y); hst[k][4] = bflo(v.z); hst[k][5] = bfhi(v.z); hst[k][6] = bflo(v.w); hst[k][7] = bfhi(v.w); }
    const LAS float* dts = (const LAS float*)(sl + SS_DTS); const LAS float* acum = (const LAS float*)(sl + SS_ACUM);
    const int hq = hq0 + (c8 * 8) / 64;
    const float alast = (FACMODE == 2) ? acum[hq * 128 + 127] : 0.f;
#pragma unroll
    for (int rr = 0; rr < RPS; ++rr) { const int l = l0 + rr; const v4u v = *(const v4u*)(src + (row0 + l) * NPROJ);
        float cur[8]; cur[0] = bflo(v.x); cur[1] = bfhi(v.x); cur[2] = bflo(v.y); cur[3] = bfhi(v.y); cur[4] = bflo(v.z); cur[5] = bfhi(v.z); cur[6] = bflo(v.w); cur[7] = bfhi(v.w);
        float f = 1.f; if (FACMODE >= 1) f = dts[hq * 128 + l]; if (FACMODE == 2) f *= __expf(alast - acum[hq * 128 + l]);
        float o[8];
#pragma unroll
        for (int e = 0; e < 8; ++e) { const float a = bias[e] + w[0][e] * hst[0][e] + w[1][e] * hst[1][e] + w[2][e] * hst[2][e] + w[3][e] * cur[e]; o[e] = siluf(a) * f;
            hst[0][e] = hst[1][e]; hst[1][e] = hst[2][e]; hst[2][e] = cur[e]; }
        v4u ov; ov.x = pk2(o[0], o[1]); ov.y = pk2(o[2], o[3]); ov.z = pk2(o[4], o[5]); ov.w = pk2(o[6], o[7]);
        *(LAS v4u*)(dst + l * pitch + c8 * 16) = ov; }
}
__device__ __forceinline__ void ssd_s1_unit(LAS unsigned char* sl, const bf16* PROJ, const float* DT, const float* dtb, const float* alog, const float* cw, const float* cb, float* ST, float* CDEC, int un, int tid, int lane, int wave) {
    const int g = un & 1, bc = un >> 1; const size_t row0 = (size_t)bc * 128; const int t0 = (bc & 31) * 128;
    __syncthreads();
    ssd_prep(sl, DT, dtb, alog, row0, g, tid, lane, wave);
    conv_tile<128, 0>(PROJ, row0, t0, C_XS + 512 + g * 128, cw, cb, 512 + g * 128, sl + S1_B, S1_PB, sl, 0, tid);
    conv_tile<256, 2>(PROJ, row0, t0, C_XS + g * 256, cw, cb, g * 256, sl + S1_X, S1_PX, sl, 0, tid);
    if (tid < 4) CDEC[(size_t)bc * 8 + 4 * g + tid] = __expf(((const LAS float*)(sl + SS_ACUM))[tid * 128 + 127]);
    __syncthreads();
    const int hq = wave >> 1, pt = wave & 1, h2 = lane >> 5, q = (lane & 15) >> 2, pp = lane & 3, dsel = (lane >> 4) & 1;
    const LAS unsigned char* xb = sl + S1_X + (8 * h2 + q) * S1_PX + (hq * 64 + pt * 32 + 16 * dsel + 4 * pp) * 2;
    const LAS unsigned char* bb = sl + S1_B + (8 * h2 + q) * S1_PB + (16 * dsel + 4 * pp) * 2;
    f32x16 acc[4];
#pragma unroll
    for (int nt = 0; nt < 4; ++nt) acc[nt] = (f32x16){};
#pragma unroll
    for (int ks = 0; ks < 8; ++ks) { const bf16x8 a = tr_pair(xb + (16 * ks) * S1_PX, xb + (16 * ks + 4) * S1_PX);
#pragma unroll
        for (int nt = 0; nt < 4; ++nt) { const bf16x8 b = tr_pair(bb + (16 * ks) * S1_PB + nt * 64, bb + (16 * ks + 4) * S1_PB + nt * 64); acc[nt] = __builtin_amdgcn_mfma_f32_32x32x16_bf16(a, b, acc[nt], 0, 0, 0); } }
    float* sp = ST + ((size_t)(bc * 8 + 4 * g + hq) * 64 + pt * 32) * 128 + (lane & 31);
#pragma unroll
    for (int nt = 0; nt < 4; ++nt)
#pragma unroll
        for (int rg = 0; rg < 16; ++rg) sp[(size_t)crow16(rg, h2) * 128 + 32 * nt] = acc[nt][rg];
}
__device__ __forceinline__ void ssd_s3_unit(LAS unsigned char* sl, const bf16* PROJ, const float* DT, const float* dtb, const float* alog, const float* cw, const float* cb, const float* dsk, const float* ng,
                                            const bf16* HIN, bf16* MIXED, int un, int tid, int lane, int wave) {
    const int g = un & 1, bc = un >> 1; const size_t row0 = (size_t)bc * 128; const int t0 = (bc & 31) * 128;
    const int lt = wave & 3, ph = wave >> 2, lq = lane & 31, hi = lane >> 5, q = (lane & 15) >> 2, pp = lane & 3, dsel = (lane >> 4) & 1;
    const int lrow = 32 * lt + lq;
    const size_t grow = row0 + lrow;
    __syncthreads();
    ssd_prep(sl, DT, dtb, alog, row0, g, tid, lane, wave);
    conv_tile<128, 0>(PROJ, row0, t0, C_XS + 512 + g * 128, cw, cb, 512 + g * 128, sl + S3_B, S3_PBC, sl, 0, tid);
    conv_tile<128, 0>(PROJ, row0, t0, C_XS + 768 + g * 128, cw, cb, 768 + g * 128, sl + S3_C, S3_PBC, sl, 0, tid);
    conv_tile<256, 1>(PROJ, row0, t0, C_XS + g * 256, cw, cb, g * 256, sl + S3_X, S3_PX, sl, 0, tid);
    __syncthreads();
    const LAS float* dts = (const LAS float*)(sl + SS_DTS); const LAS float* acum = (const LAS float*)(sl + SS_ACUM); LAS float* ssx = (LAS float*)(sl + SS_SSX);
    const LAS unsigned char* crd = sl + S3_C + lrow * S3_PBC + 16 * hi;
    f32x16 y[4];
    { bf16x8 hfa[8], hfb[8];
      const bf16* hp0 = HIN + ((size_t)(bc * 8 + 4 * g) * 64 + ph * 32 + lq) * 128 + 8 * hi;
#pragma unroll
      for (int ks = 0; ks < 8; ++ks) hfa[ks] = *(const bf16x8*)(hp0 + 16 * ks);
#pragma unroll
      for (int hq = 0; hq < 4; ++hq) {
          if (hq < 3) {
#pragma unroll
              for (int ks = 0; ks < 8; ++ks) { const bf16x8 v = *(const bf16x8*)(hp0 + (size_t)(hq + 1) * 8192 + 16 * ks); if (hq & 1) hfa[ks] = v; else hfb[ks] = v; } }
          f32x16 t = (f32x16){};
#pragma unroll
          for (int ks = 0; ks < 8; ++ks) t = __builtin_amdgcn_mfma_f32_32x32x16_bf16((hq & 1) ? hfb[ks] : hfa[ks], *(const LAS bf16x8*)(crd + 32 * ks), t, 0, 0, 0);
          const float ea = __expf(acum[hq * 128 + lrow]);
#pragma unroll
          for (int rg = 0; rg < 16; ++rg) t[rg] *= ea;
          y[hq] = t; } }
    v2u zr[4][4];
#pragma unroll
    for (int hq = 0; hq < 4; ++hq)
#pragma unroll
        for (int g4 = 0; g4 < 4; ++g4) zr[hq][g4] = *(const v2u*)(PROJ + grow * NPROJ + C_Z + g * 256 + hq * 64 + ph * 32 + 8 * g4 + 4 * hi);
#pragma unroll
    for (int st = 0; st < 4; ++st) if (st <= lt) {
        f32x16 ag = (f32x16){};
        { const LAS unsigned char* brd = sl + S3_B + (32 * st + lq) * S3_PBC + 16 * hi;
#pragma unroll
          for (int ks = 0; ks < 8; ++ks) ag = __builtin_amdgcn_mfma_f32_32x32x16_bf16(*(const LAS bf16x8*)(brd + 32 * ks), *(const LAS bf16x8*)(crd + 32 * ks), ag, 0, 0, 0); }
#pragma unroll
        for (int hq = 0; hq < 4; ++hq) {
            const float al = acum[hq * 128 + lrow], dd = dsk[4 * g + hq] / dts[hq * 128 + lrow];
            const LAS unsigned char* xb = sl + S3_X + (4 * hi + q) * S3_PX + (hq * 64 + ph * 32 + 16 * dsel + 4 * pp) * 2;
            float pm[16];
#pragma unroll
            for (int g4 = 0; g4 < 4; ++g4) { const f32x4 as4 = *(const LAS f32x4*)(acum + hq * 128 + 32 * st + 8 * g4 + 4 * hi);
#pragma unroll
                for (int e = 0; e < 4; ++e) { const int rg = 4 * g4 + e; float v = ag[rg] * __expf(al - as4[e]);
                    if (st == lt) { const int sl_ = 8 * g4 + 4 * hi + e; if (sl_ > lq) v = 0.f; if (sl_ == lq) v += dd; }
                    pm[rg] = v; } }
#pragma unroll
            for (int ks = 0; ks < 2; ++ks) { v4u wv; wv.x = pg8::cvt_pk_bf16(pm[8 * ks + 0], pm[8 * ks + 1]); wv.y = pg8::cvt_pk_bf16(pm[8 * ks + 2], pm[8 * ks + 3]); wv.z = pg8::cvt_pk_bf16(pm[8 * ks + 4], pm[8 * ks + 5]); wv.w = pg8::cvt_pk_bf16(pm[8 * ks + 6], pm[8 * ks + 7]);
                const bf16x8 xt = tr_pair(xb + (32 * st + 16 * ks) * S3_PX, xb + (32 * st + 16 * ks + 8) * S3_PX);
                y[hq] = __builtin_amdgcn_mfma_f32_32x32x16_bf16(xt, __builtin_bit_cast(bf16x8, wv), y[hq], 0, 0, 0); }
        }
    }
    unsigned ayp[4][8]; float ss = 0.f;
#pragma unroll
    for (int hq = 0; hq < 4; ++hq)
#pragma unroll
        for (int g4 = 0; g4 < 4; ++g4) { const v2u z = zr[hq][g4];
            const float y0 = y[hq][4 * g4 + 0] * siluf(bflo(z.x)), y1 = y[hq][4 * g4 + 1] * siluf(bfhi(z.x)), y2 = y[hq][4 * g4 + 2] * siluf(bflo(z.y)), y3 = y[hq][4 * g4 + 3] * siluf(bfhi(z.y));
            ss += (y0 * y0 + y1 * y1) + (y2 * y2 + y3 * y3);
            ayp[hq][2 * g4] = pg8::cvt_pk_bf16(y0, y1); ayp[hq][2 * g4 + 1] = pg8::cvt_pk_bf16(y2, y3); }
    ss += __shfl_xor(ss, 32);
    if (hi == 0) ssx[ph * 128 + lrow] = ss;
    __syncthreads();
    const float rs = 1.0f / sqrtf((ssx[lrow] + ssx[128 + lrow]) * (1.f / 256.f) + RMS_EPS);
#pragma unroll
    for (int hq = 0; hq < 4; ++hq)
#pragma unroll
        for (int g4 = 0; g4 < 4; ++g4) { const int ch = hq * 64 + ph * 32 + 8 * g4 + 4 * hi; const f32x4 gn = *(const f32x4*)(ng + g * 256 + ch);
            const unsigned p0 = ayp[hq][2 * g4], p1 = ayp[hq][2 * g4 + 1];
            v2u o; o.x = pg8::cvt_pk_bf16(bflo(p0) * rs * gn[0], bfhi(p0) * rs * gn[1]); o.y = pg8::cvt_pk_bf16(bflo(p1) * rs * gn[2], bfhi(p1) * rs * gn[3]);
            *(v2u*)(MIXED + grow * MIXW + 512 + g * 256 + ch) = o; }
}

struct Args { const float* in[20]; float* out; unsigned char* ws; int ph_lo, ph_hi, sub, pad; };
constexpr int NWAVES = 8;
constexpr int PH_PER_LAYER = 10, N_PHASES = 1 + NLAYER * PH_PER_LAYER;

#define in_x (args.in[0])
#define in_win (args.in[1])
#define in_convw (args.in[2])
#define in_convb (args.in[3])
#define in_dtb (args.in[4])
#define in_alog (args.in[5])
#define in_dsk (args.in[6])
#define in_ng (args.in[7])
#define in_scw (args.in[8])
#define in_wout (args.in[9])
#define in_ln1g (args.in[10])
#define in_ln1b (args.in[11])
#define in_rw (args.in[12])
#define in_rb (args.in[13])
#define in_wgu (args.in[14])
#define in_bgu (args.in[15])
#define in_wdn (args.in[16])
#define in_bdn (args.in[17])
#define in_ln2g (args.in[18])
#define in_ln2b (args.in[19])
#define ROPE ((float*)(args.ws + WS_ROPE))
#define WDT ((float*)(args.ws + WS_WDT))
#define ROUT ((bf16*)(args.ws + WS_ROUT))
#define WIN ((bf16*)(args.ws + WS_WIN))
#define WOUT ((bf16*)(args.ws + WS_WOUT))
#define WGU ((bf16*)(args.ws + WS_WGU))
#define WDN ((bf16*)(args.ws + WS_WDN))
#define XB ((bf16*)(args.ws + WS_XB))
#define XF ((float*)(args.ws + WS_XF))
#define XF2 ((float*)(args.ws + WS_XF2))
#define PROJ ((bf16*)(args.ws + WS_PROJ))
#define DT ((float*)(args.ws + WS_DT))
#define DTS ((float*)(args.ws + WS_DTS))
#define ACUM ((float*)(args.ws + WS_ACUM))
#define LSE ((float*)(args.ws + WS_LSE))
#define OP ((bf16*)(args.ws + WS_OP))
#define U ((bf16*)(args.ws + WS_U))
#define GB ((float*)(args.ws + WS_G))
#define ST ((float*)(args.ws + WS_ST))
#define YD ((float*)(args.ws + WS_YD))
#define MIXED ((bf16*)(args.ws + WS_MIXED))
#define MIXF ((bf16*)(args.ws + WS_MIXF))
#define TOPE ((int*)(args.ws + WS_TOPE))
#define TOPG ((float*)(args.ws + WS_TOPG))
#define ROWTOK ((int*)(args.ws + WS_ROWTOK))
#define ROWGATE ((float*)(args.ws + WS_ROWGATE))
#define HB ((bf16*)(args.ws + WS_H))
#define YB ((bf16*)(args.ws + WS_YB))
#define HIN ((bf16*)(args.ws + WS_G))
#define WGU8 ((unsigned char*)(args.ws + WS_WGU))
#define WDN8 ((unsigned char*)(args.ws + WS_WDN))
#define XB8 ((unsigned char*)(args.ws + WS_U))
#define H8 ((unsigned char*)(args.ws + WS_H))
#define YB8 ((unsigned char*)(args.ws + WS_YB))
#define WIN8 ((unsigned char*)(args.ws + WS_WGU + 128 * MiB))
#define XP8 ((unsigned char*)(args.ws + WS_WGU + 132 * MiB))
#define CDEC ((float*)(args.ws + WS_ACUM))
template <int layer>
__device__ __forceinline__ void run_layer(const Args& args, int lo, int hi, const XcdBarrier& bar) {
    extern __shared__ __attribute__((aligned(16))) unsigned char lds[];
    LAS unsigned char* ldsp = (LAS unsigned char*)lds;
    const int tid = threadIdx.x, lane = tid & 63, wave = __builtin_amdgcn_readfirstlane(tid >> 6);
    const int G = gridDim.x, bid = blockIdx.x;
    const int gw = bid * NWAVES + wave, NGW = G * NWAVES;
    gu32* ctl = (gu32*)(args.ws + WS_CTL);

#define IN(k) (lo <= (k) && (k) < hi)
#define SEAM(k) do { if (IN(k) && IN((k) + 1)) xcd_barrier(bar); } while (0)

        const int pb = 1 + layer * PH_PER_LAYER;
        const bf16* WINl = WIN + (size_t)layer * NPROJ * DM; const bf16* WOUTl = WOUT + (size_t)layer * DM * MIXW;
        const unsigned char* WGUl = WGU8 + (size_t)layer * NEXP * 2048 * DM; const unsigned char* WDNl = WDN8 + (size_t)layer * NEXP * DM * FF;
        gu32* gcnt = ctl + CW_CNT + 64 * layer;

        if (IN(pb + 0)) {
            if (layer == 0) {
                for (int m = gw; m < MROWS; m += NGW) { const bf16* xr = XB + (size_t)m * DM; f32x4 v[4];
#pragma unroll
                    for (int j = 0; j < 4; ++j) { const v2u a = *(const v2u*)(xr + 4 * lane + 256 * j); v[j] = (f32x4){bflo(a.x), bfhi(a.x), bflo(a.y), bfhi(a.y)}; }
                    row_dt(v, WDT, DT + (size_t)m * 8, lane); }
            }
            {
              pg8::Gemm g{(const pg8::bf16_t*)XP8, (const pg8::bf16_t*)(WIN8 + (size_t)layer * 1536 * DM), MROWS, 1536, DM / 2}; pg8::StaticOrder S; S.init(MROWS, 1536, G, bid);
              pg8::EpiProj E{PROJ, NPROJ, ROPE, QSCALE, 1.0f / (SC_X * SC_WIN), 0};
              pg8::gemm_phase<pg8::EpiProj, pg8::StaticOrder, true, false, true>(ldsp + RING_OFF, g, S, E); }
            __syncthreads();
            { pg8::Gemm g{XB, WINl + (size_t)1536 * DM, MROWS, NPROJ - 1536, DM}; pg8::StaticOrder S; S.init(MROWS, NPROJ - 1536, G, bid);
              pg8::EpiProj E{PROJ, NPROJ, ROPE, QSCALE, 1.0f, 6};
              pg8::gemm_phase<pg8::EpiProj, pg8::StaticOrder, true, false>(ldsp + RING_OFF, g, S, E); }
        }
        SEAM(pb + 0);
        if (IN(pb + 1)) {
            if (args.sub & 1) attn_phase(ldsp + RING_OFF, PROJ, OP, LSE, bid, G, tid, wave, lane);
            if (args.sub & 2) { const float* cw = in_convw + (size_t)layer * 4 * 1024; const float* cb = in_convb + (size_t)layer * 1024;
              for (int un = bid; un < 512; un += G)
                  ssd_s1_unit(ldsp + RING_OFF, PROJ, DT, in_dtb + layer * 8, in_alog + layer * 8, cw, cb, ST, CDEC, un, tid, lane, wave);
              __syncthreads(); }
            const float* sw = in_scw + (size_t)layer * 3 * 512;
            if (args.sub & 4)
#pragma unroll 2
            for (int it = bid * (NWAVES * 64) + tid; it < (int)((long)MROWS * 64); it += G * (NWAVES * 64)) { const int c8 = (int)(it & 63), row = (int)(it >> 6), t = row & (SEQ - 1); const int ch = c8 * 8;
                float a[8];
#pragma unroll
                for (int q = 0; q < 8; ++q) a[q] = 0.f;
#pragma unroll
                for (int k = 0; k < 3; ++k) { const int tt = t - 2 + k; if (tt >= 0) { const bf16* pr = PROJ + (size_t)(row - 2 + k) * NPROJ; const v4u cc = *(const v4u*)(pr + C_SC + ch), hh = *(const v4u*)(pr + C_SH + ch);
                    const f32x4 w0 = *(const f32x4*)(sw + k * 512 + ch), w1 = *(const f32x4*)(sw + k * 512 + ch + 4);
                    a[0] += w0[0] * bflo(cc.x) * bflo(hh.x); a[1] += w0[1] * bfhi(cc.x) * bfhi(hh.x); a[2] += w0[2] * bflo(cc.y) * bflo(hh.y); a[3] += w0[3] * bfhi(cc.y) * bfhi(hh.y);
                    a[4] += w1[0] * bflo(cc.z) * bflo(hh.z); a[5] += w1[1] * bfhi(cc.z) * bfhi(hh.z); a[6] += w1[2] * bflo(cc.w) * bflo(hh.w); a[7] += w1[3] * bfhi(cc.w) * bfhi(hh.w); } }
                const v4u bb = *(const v4u*)(PROJ + (size_t)row * NPROJ + C_SB + ch);
                v4u o; o.x = pk2(a[0] * bflo(bb.x), a[1] * bfhi(bb.x)); o.y = pk2(a[2] * bflo(bb.y), a[3] * bfhi(bb.y)); o.z = pk2(a[4] * bflo(bb.z), a[5] * bfhi(bb.z)); o.w = pk2(a[6] * bflo(bb.w), a[7] * bfhi(bb.w));
                *(v4u*)(MIXED + (size_t)row * MIXW + 1024 + ch) = o; }
        }
        SEAM(pb + 1);
        if (IN(pb + 2)) {
            for (int it = bid * (NWAVES * 64) + tid; it < (int)(64L * 2048); it += G * (NWAVES * 64)) { const int pn4 = (int)(it & 2047), bh = (int)(it >> 11); const int h = bh & 7, b = bh >> 3; f32x4 hc = (f32x4){0.f, 0.f, 0.f, 0.f};
#pragma unroll 16
                for (int c = 0; c < 32; ++c) { const size_t idx = ((size_t)((b * 32 + c) * 8 + h)) * 8192 + pn4 * 4; const f32x4 st = *(const f32x4*)(ST + idx);
                    v2u o; o.x = pk2(hc[0], hc[1]); o.y = pk2(hc[2], hc[3]); *(v2u*)(HIN + idx) = o;
                    hc = hc * CDEC[(size_t)(b * 32 + c) * 8 + h] + st; } }
        }
        SEAM(pb + 2);
        if (IN(pb + 3)) {
            if (args.sub & 1) { const float* cw = in_convw + (size_t)layer * 4 * 1024; const float* cb = in_convb + (size_t)layer * 1024;
              for (int un = bid; un < 512; un += G)
                  ssd_s3_unit(ldsp + RING_OFF, PROJ, DT, in_dtb + layer * 8, in_alog + layer * 8, cw, cb, in_dsk + layer * 8, in_ng + (size_t)layer * 512, HIN, MIXED, un, tid, lane, wave);
              __syncthreads(); }
            if (args.sub & 2)
#pragma unroll 2
            for (int it = bid * (NWAVES * 64) + tid; it < (int)((long)MROWS * 64); it += G * (NWAVES * 64)) { const int c8 = (int)(it & 63), row = (int)(it >> 6); const int h = c8 >> 3;
                const float l0 = LSE[((size_t)0 * MROWS + row) * 8 + h], l1 = LSE[((size_t)1 * MROWS + row) * 8 + h], l2 = LSE[((size_t)2 * MROWS + row) * 8 + h];
                const float mm = fmaxf(l0, fmaxf(l1, l2)); float w0 = exp2f(l0 - mm), w1 = exp2f(l1 - mm), w2 = exp2f(l2 - mm); const float iw = 1.0f / (w0 + w1 + w2); w0 *= iw; w1 *= iw; w2 *= iw;
                const unsigned char* OP8 = (const unsigned char*)OP; typedef float f32x2_ __attribute__((ext_vector_type(2)));
                const v2u a0 = *(const v2u*)(OP8 + ((size_t)0 * MROWS + row) * 512 + c8 * 8), a1 = *(const v2u*)(OP8 + ((size_t)1 * MROWS + row) * 512 + c8 * 8), a2 = *(const v2u*)(OP8 + ((size_t)2 * MROWS + row) * 512 + c8 * 8);
                w0 *= (1.0f / SC_O); w1 *= (1.0f / SC_O); w2 *= (1.0f / SC_O);
                v4u o;
                { const f32x2_ p0 = __builtin_amdgcn_cvt_pk_f32_fp8(a0.x, false), p1 = __builtin_amdgcn_cvt_pk_f32_fp8(a1.x, false), p2 = __builtin_amdgcn_cvt_pk_f32_fp8(a2.x, false); o.x = pk2(w0 * p0[0] + w1 * p1[0] + w2 * p2[0], w0 * p0[1] + w1 * p1[1] + w2 * p2[1]); }
                { const f32x2_ p0 = __builtin_amdgcn_cvt_pk_f32_fp8(a0.x, true), p1 = __builtin_amdgcn_cvt_pk_f32_fp8(a1.x, true), p2 = __builtin_amdgcn_cvt_pk_f32_fp8(a2.x, true); o.y = pk2(w0 * p0[0] + w1 * p1[0] + w2 * p2[0], w0 * p0[1] + w1 * p1[1] + w2 * p2[1]); }
                { const f32x2_ p0 = __builtin_amdgcn_cvt_pk_f32_fp8(a0.y, false), p1 = __builtin_amdgcn_cvt_pk_f32_fp8(a1.y, false), p2 = __builtin_amdgcn_cvt_pk_f32_fp8(a2.y, false); o.z = pk2(w0 * p0[0] + w1 * p1[0] + w2 * p2[0], w0 * p0[1] + w1 * p1[1] + w2 * p2[1]); }
                { const f32x2_ p0 = __builtin_amdgcn_cvt_pk_f32_fp8(a0.y, true), p1 = __builtin_amdgcn_cvt_pk_f32_fp8(a1.y, true), p2 = __builtin_amdgcn_cvt_pk_f32_fp8(a2.y, true); o.w = pk2(w0 * p0[0] + w1 * p1[0] + w2 * p2[0], w0 * p0[1] + w1 * p1[1] + w2 * p2[1]); }
                *(v4u*)(MIXED + (size_t)row * MIXW + c8 * 8) = o; }
        }
        SEAM(pb + 3);
        if (IN(pb + 4)) {
#define FUSED_LN1_CALL(BASE, LIM) { pg8::Gemm g{MIXED, WOUTl, MROWS, DM, MIXW}; \
              pg8::EpiLn1 E{args.ws, in_ln1g + (size_t)layer * DM, in_ln1b + (size_t)layer * DM, WS_XB, WS_U, (layer ? WS_ROPE : WS_DTS), WS_CTL + (size_t)(CW_SEAM + layer * 8192) * 4, WS_CTL + (size_t)CW_TMO * 4, ALPHA, SC_X, LN_EPS, 0x700u + (unsigned)layer * 0x80u}; \
              pg8::StaticOrder S; S.init(MROWS, DM, G, bid); S.base = (BASE); S.lim = (LIM); \
              pg8::gemm_phase<pg8::EpiLn1, pg8::StaticOrder, false, false>(ldsp + RING_OFF, g, S, E); }
            FUSED_LN1_CALL(0, 256)
            __syncthreads();
            FUSED_LN1_CALL(256, 512)
            __syncthreads();
#undef FUSED_LN1_CALL
        }
        SEAM(pb + 4);
        if (IN(pb + 6)) {
            LAS int* lcnt = (LAS int*)(ldsp + L_LCNT); LAS int* lbase = (LAS int*)(ldsp + L_LBASE);
            const bf16* RT = ROUT + (size_t)layer * NEXP * DM; const float* rb = in_rb + (size_t)layer * NEXP;
            for (int blk = bid; blk < MROWS / 128; blk += G) {
                if (tid < 32) lcnt[tid] = 0;
                __syncthreads();
                const int r32 = lane & 31, hi = lane >> 5; const int row = blk * 128 + (wave & 3) * 32 + r32;
                float tv[4]; int te[4]; int lrank[4]; float gate[4];
                f32x16 acc = {};
                { const int kh = wave >> 2;
                  const bf16* ap = RT + (size_t)r32 * DM + 8 * hi + 512 * kh; const bf16* bp = XB + (size_t)row * DM + 8 * hi + 512 * kh;
#pragma unroll 16
                  for (int s = 0; s < 32; ++s) { const bf16x8 a = *(const bf16x8*)(ap + 16 * s), b = *(const bf16x8*)(bp + 16 * s); acc = __builtin_amdgcn_mfma_f32_32x32x16_bf16(a, b, acc, 0, 0, 0); }
                  LAS float* part = (LAS float*)(ldsp + RING_OFF) + (wave & 3) * 1024;
                  if (kh) {
#pragma unroll
                      for (int i = 0; i < 16; ++i) part[i * 64 + lane] = acc[i]; }
                  __syncthreads();
                  if (!kh) {
#pragma unroll
                      for (int i = 0; i < 16; ++i) acc[i] += part[i * 64 + lane]; } }
                if (wave < 4) {
#pragma unroll
                    for (int k = 0; k < 4; ++k) { tv[k] = -INFINITY; te[k] = 1 << 20; }
#pragma unroll
                    for (int i = 0; i < 16; ++i) { const int e = (i & 3) + 8 * (i >> 2) + 4 * hi; float v = acc[i] + rb[e]; int ve = e;
#pragma unroll
                        for (int k = 0; k < 4; ++k) { const bool gt = (v > tv[k]) || (v == tv[k] && ve < te[k]); const float nv = gt ? tv[k] : v; const int ne = gt ? te[k] : ve; tv[k] = gt ? v : tv[k]; te[k] = gt ? ve : te[k]; v = nv; ve = ne; } }
                    float pv[4]; int pe[4];
#pragma unroll
                    for (int k = 0; k < 4; ++k) { pv[k] = __shfl_xor(tv[k], 32); pe[k] = __shfl_xor(te[k], 32); }
#pragma unroll
                    for (int j = 0; j < 4; ++j) { float v = pv[j]; int ve = pe[j];
#pragma unroll
                        for (int k = 0; k < 4; ++k) { const bool gt = (v > tv[k]) || (v == tv[k] && ve < te[k]); const float nv = gt ? tv[k] : v; const int ne = gt ? te[k] : ve; tv[k] = gt ? v : tv[k]; te[k] = gt ? ve : te[k]; v = nv; ve = ne; } }
                    float se = 0.f;
#pragma unroll
                    for (int k = 0; k < 4; ++k) { gate[k] = __expf(tv[k] - tv[0]); se += gate[k]; }
                    const float ise = 1.0f / se;
#pragma unroll
                    for (int k = 0; k < 4; ++k) gate[k] *= ise;
                    if (hi == 0) {
#pragma unroll
                        for (int k = 0; k < 4; ++k) lrank[k] = __hip_atomic_fetch_add(lcnt + te[k], 1, __ATOMIC_RELAXED, __HIP_MEMORY_SCOPE_WORKGROUP);
                    }
                }
                __syncthreads();
                if (tid < 32) lbase[tid] = (int)__hip_atomic_fetch_add(gcnt + tid, (unsigned)lcnt[tid], RLX_AGENT);
                __syncthreads();
                if (wave < 4 && hi == 0) {
#pragma unroll
                    for (int k = 0; k < 4; ++k) { const int r = lbase[te[k]] + lrank[k]; const size_t o = (size_t)te[k] * 32768 + r;
                        ROWTOK[o] = row * 4 + k; ROWGATE[o] = gate[k]; }
                }
                __syncthreads();
            }
        }
        SEAM(pb + 6);
        if (IN(pb + 7) || IN(pb + 8)) {
            LAS int* tstart = (LAS int*)(ldsp + L_TSTART); LAS int* cntL = (LAS int*)(ldsp + L_CNT); LAS int* units = (LAS int*)(ldsp + L_UNITS); LAS int* unitsn = (LAS int*)(ldsp + L_UNITSN);
            if (tid == 0) { int acc = 0; for (int e = 0; e < 32; ++e) { const int c = (int)__hip_atomic_load(gcnt + e, RLX_AGENT); cntL[e] = c; tstart[e] = acc; acc += (c + 255) >> 8; } tstart[32] = acc; }
            __syncthreads();
            if (IN(pb + 7)) {
                pg8::moe_build_units(units, unitsn, tstart, 8, G, bid, tid);
                __syncthreads();
                pg8::Gemm g{(const pg8::bf16_t*)XB8, (const pg8::bf16_t*)WGUl, 0, 2048, DM / 2};
                pg8::MoeOrder S{units, __builtin_amdgcn_readfirstlane(unitsn[0]), cntL, ROWTOK, 1, (unsigned)DM, (size_t)2048 * DM, ROWGATE, in_bgu + (size_t)layer * NEXP * 2048};
                pg8::EpiSwiglu E{H8, in_bgu + (size_t)layer * NEXP * 2048, ROWGATE, cntL, 1.0f / (SC_X * SC_WGU), SC_H};
                pg8::gemm_phase<pg8::EpiSwiglu, pg8::MoeOrder, true, true, true>(ldsp + RING_OFF, g, S, E);
                __syncthreads();
            }
            SEAM(pb + 7);
            if (IN(pb + 8)) {
                pg8::moe_build_units(units, unitsn, tstart, 4, G, bid, tid);
                __syncthreads();
                pg8::Gemm g{(const pg8::bf16_t*)H8, (const pg8::bf16_t*)WDNl, 0, DM, FF / 2};
                pg8::MoeOrder S{units, __builtin_amdgcn_readfirstlane(unitsn[0]), cntL, ROWTOK, 0, (unsigned)FF, (size_t)DM * FF, ROWGATE, in_bdn + (size_t)layer * NEXP * DM};
                pg8::EpiScatter E{YB8, ROWTOK, cntL, SC_Y / (SC_H * SC_WDN), SC_Y};
                pg8::gemm_phase<pg8::EpiScatter, pg8::MoeOrder, true, false, true, true>(ldsp + RING_OFF, g, S, E);
                __syncthreads();
            }
        }
        SEAM(pb + 8);
        if (IN(pb + 9)) {
            const float* gam = in_ln2g + (size_t)layer * DM; const float* bet = in_ln2b + (size_t)layer * DM; const float* bdn = in_bdn + (size_t)layer * NEXP * DM;
            for (int m = gw; m < MROWS; m += NGW) { f32x4 v[4];
#pragma unroll
                for (int j = 0; j < 4; ++j) { const v2u a = *(const v2u*)(XB + (size_t)m * DM + 4 * lane + 256 * j); v[j] = (f32x4){bflo(a.x), bfhi(a.x), bflo(a.y), bfhi(a.y)} * ALPHA; }
#pragma unroll
                for (int k = 0; k < 4; ++k) { const unsigned char* yr = YB8 + ((size_t)m * 4 + k) * DM;
#pragma unroll
                    for (int j = 0; j < 4; ++j) { const unsigned w = *(const unsigned*)(yr + 4 * lane + 256 * j);
                        typedef float f32x2_ __attribute__((ext_vector_type(2)));
                        const f32x2_ lo = __builtin_amdgcn_cvt_pk_f32_fp8(w, false), hi = __builtin_amdgcn_cvt_pk_f32_fp8(w, true);
                        v[j][0] += lo[0] * (1.0f / SC_Y); v[j][1] += lo[1] * (1.0f / SC_Y); v[j][2] += hi[0] * (1.0f / SC_Y); v[j][3] += hi[1] * (1.0f / SC_Y); } }
                ln_row<(layer + 1 < NLAYER), (layer == NLAYER - 1)>(v, gam, bet, args.out + (size_t)m * DM, XB + (size_t)m * DM, XP8 + (size_t)m * DM, SC_X, lane);
                if (layer + 1 < NLAYER) row_dt(v, WDT + (size_t)(layer + 1) * 8 * 1024, DT + (size_t)m * 8, lane); }
        }
        SEAM(pb + 9);
    #undef IN
#undef SEAM
}

__global__ void __launch_bounds__(NWAVES * 64, 2) mk_fwd(Args args) {
    extern __shared__ __attribute__((aligned(16))) unsigned char lds[];
    LAS unsigned char* ldsp = (LAS unsigned char*)lds;
    const int tid = threadIdx.x, lane = tid & 63, wave = __builtin_amdgcn_readfirstlane(tid >> 6);
    const int G = gridDim.x, bid = blockIdx.x;
    const int gw = bid * NWAVES + wave, NGW = G * NWAVES;
    gu32* ctl = (gu32*)(args.ws + WS_CTL);

    for (int u = tid; u < (LDS_BYTES - LDSCTL_OFF) / 4; u += NWAVES * 64) ((LAS unsigned*)(ldsp + LDSCTL_OFF))[u] = 0u;
    __syncthreads();
    XcdBarrier bar = xcd_barrier_post((unsigned*)(ctl + CW_BAR), (volatile LAS unsigned*)(ldsp + L_MISC) + 8);

    const int lo = args.ph_lo, hi = args.ph_hi;
#define IN(k) (lo <= (k) && (k) < hi)
#define SEAM(k) do { if (IN(k) && IN((k) + 1)) xcd_barrier(bar); } while (0)

    if (IN(0)) {
        LAS float* scr = (LAS float*)(ldsp + RING_OFF + wave * 16384);
        constexpr int I_IN = 16 * 73, I_OUT = 24 * 16, I_R = 16;
        constexpr int NIT = NLAYER * (I_IN + I_OUT + I_R);
        for (int it = gw; it < NIT; it += NGW) {
            int r = it;
            if (r < NLAYER * I_IN) { const int l = r / I_IN; r %= I_IN; p0_transpose_item64<1>(in_win + (size_t)l * DM * INW, DM, INW, WIN + (size_t)l * NPROJ * DM, WDT + (size_t)l * 8 * 1024, scr, r / 73, r % 73, lane); continue; } r -= NLAYER * I_IN;
            if (r < NLAYER * I_OUT) { const int l = r / I_OUT; r %= I_OUT; p0_transpose_item64<0>(in_wout + (size_t)l * MIXW * DM, MIXW, DM, WOUT + (size_t)l * DM * MIXW, nullptr, scr, r / 16, r % 16, lane); continue; } r -= NLAYER * I_OUT;
            { const int l = r / I_R; r %= I_R; p0_transpose_item<0>(in_rw + (size_t)l * DM * NEXP, DM, NEXP, ROUT + (size_t)l * NEXP * DM, nullptr, scr, r, 0, lane); }
        }
        { constexpr int NIT8 = 64 * 256 + 64 * 128 + NLAYER * 192;
          const int nmine = (gw < NIT8) ? (NIT8 - gw + NGW - 1) / NGW : 0; const int J = 2 * nmine;
          f32x4 lda[16], ldb[16];
          if (J > 0) { const SubT t = fp8_subtile(gw, 0, in_wgu, in_wdn, in_win, WGU8, WDN8, WIN8, lane); fp8_sub_load(t, lda); }
#pragma unroll 1
          for (int j = 0; j < J; j += 2) {
              const int item = gw + (j >> 1) * NGW;
              const SubT t0 = fp8_subtile(item, 0, in_wgu, in_wdn, in_win, WGU8, WDN8, WIN8, lane), t1 = fp8_subtile(item, 1, in_wgu, in_wdn, in_win, WGU8, WDN8, WIN8, lane);
              fp8_sub_load(t1, ldb);
              fp8_sub_process(t0, lda, scr, lane);
              if (j + 2 < J) { const SubT t2 = fp8_subtile(item + NGW, 0, in_wgu, in_wdn, in_win, WGU8, WDN8, WIN8, lane); fp8_sub_load(t2, lda); }
              fp8_sub_process(t1, ldb, scr, lane);
          } }
        __syncthreads();
    }
    if (IN(0)) {
        for (int m = gw; m < MROWS; m += NGW) { const float* xr = in_x + (size_t)m * DM; bf16* ob = XB + (size_t)m * DM; f32x4 v[4];
#pragma unroll
            for (int j = 0; j < 4; ++j) { v[j] = *(const f32x4*)(xr + 4 * lane + 256 * j); v2u w; w.x = pk2(v[j][0], v[j][1]); w.y = pk2(v[j][2], v[j][3]); *(v2u*)(ob + 4 * lane + 256 * j) = w;
                *(unsigned*)(XP8 + (size_t)m * DM + 4 * lane + 256 * j) = pg8::pk4_fp8(v[j][0] * SC_X, v[j][1] * SC_X, v[j][2] * SC_X, v[j][3] * SC_X); }
            }
    }

    SEAM(0);
    run_layer<0>(args, lo, hi, bar);
    run_layer<1>(args, lo, hi, bar);
#undef IN
#undef SEAM
}

extern "C" void kernel_launch(void* const* d_in, const int* in_sizes, int n_in, void* d_out, int out_size, void* d_ws, size_t ws_size, hipStream_t stream) {
    static int grid = 0;
    if (grid == 0) {
        if (n_in != 20 || out_size != MROWS * DM || ws_size < WS_END) { fprintf(stderr, "kernel_launch: unexpected problem (n_in %d, out %d, ws %zu)\n", n_in, out_size, ws_size); grid = -1; return; }
        if (hipFuncSetAttribute((const void*)mk_fwd, hipFuncAttributeMaxDynamicSharedMemorySize, LDS_BYTES) != hipSuccess) { fprintf(stderr, "kernel_launch: hipFuncSetAttribute failed\n"); grid = -1; return; }
        int dev = 0, cus = 0, per_cu = 0;
        (void)hipGetDevice(&dev); (void)hipDeviceGetAttribute(&cus, hipDeviceAttributeMultiprocessorCount, dev);
        if (hipOccupancyMaxActiveBlocksPerMultiprocessor(&per_cu, (const void*)mk_fwd, NWAVES * 64, LDS_BYTES) != hipSuccess || per_cu < 1) fprintf(stderr, "kernel_launch: occupancy query says %d\n", per_cu);
        (void)hipGetLastError();
        grid = cus > 0 ? cus : 256;
    }
    if (grid < 0) return;
    (void)hipMemsetAsync((char*)d_ws + WS_CTL, 0, CTL_ZERO_BYTES, stream);
    Args a{};
    for (int i = 0; i < 20; ++i) a.in[i] = (const float*)d_in[i];
    a.out = (float*)d_out; a.ws = (unsigned char*)d_ws;
    a.ph_lo = 0; a.ph_hi = N_PHASES; a.sub = 7; a.pad = 0;
    hipLaunchKernelGGL(mk_fwd, dim3(grid), dim3(NWAVES * 64), LDS_BYTES, stream, a);
#ifdef PROBE_PH
#ifndef PROBE_SUB
#define PROBE_SUB 7
#endif
    for (int i = 0; i < PROBE_N; ++i) { a.ph_lo = PROBE_PH; a.ph_hi = PROBE_PH + 1; a.sub = PROBE_SUB; hipLaunchKernelGGL(mk_fwd, dim3(grid), dim3(NWAVES * 64), LDS_BYTES, stream, a); }
#endif
}
```

```cpp
#include <hip/hip_runtime.h>
#include <cstdio>
#include <cstdint>
#include <cmath>

namespace pg8 {
#define PG8_LAS __attribute__((address_space(3)))
typedef unsigned short bf16_t;
typedef short bf16x8 __attribute__((ext_vector_type(8)));
typedef float f32x4 __attribute__((ext_vector_type(4)));
typedef float f32x2 __attribute__((ext_vector_type(2)));
typedef unsigned u32x4 __attribute__((ext_vector_type(4)));
constexpr int BM = 256, BK = 64, HALF = 128, HTB = HALF * BK * 2  , STAGE_BYTES = 8 * HTB, NXCD = 8, WGM = 8;

__host__ __device__ __forceinline__ int lds_byte(int r, int c) { const int st = (r >> 4) * 2 + (c >> 5), rr = r & 15, cc = c & 31, ob = rr * 64 + cc * 2; return st * 1024 + (ob ^ (((ob >> 9) & 1) << 5)); }
__host__ __device__ __forceinline__ void stage_rc(int b, int& R, int& C) { const int st = b / 1024, sb = b % 1024, swz = sb ^ (((sb >> 9) & 1) << 5); R = (st >> 1) * 16 + swz / 64; C = (st & 1) * 32 + (swz % 64) / 2; }
__host__ __device__ __forceinline__ int perm32(int rho) { const int n = rho >> 4, i = rho & 15; return 8 * (i >> 2) + 4 * n + (i & 3); }

struct Unit { int pm, pn, e, r0; };
struct Gemm { const bf16_t* A; const bf16_t* Bt; int M, N, K; };

struct StaticOrder {
    int nM, nN, nwg, G, c, base, lim;
    __device__ void init(int M, int N, int G_, int c_) { nM = M / BM; nN = N / BM; nwg = nM * nN; G = G_; c = c_; base = 0; lim = nwg; }
    __device__ __forceinline__ bool next(int i, Unit& u) const {
        const long L = (long)i * G + c + base; if (L >= lim) return false;
        int wgid = (int)L; { const int q = nwg / NXCD, r = nwg % NXCD, xcd = wgid % NXCD, off = wgid / NXCD; wgid = (xcd < r ? xcd * (q + 1) : r * (q + 1) + (xcd - r) * q) + off; }
        const int nig = WGM * nN, gid = wgid / nig, fm = gid * WGM, gsz = (nM - fm) < WGM ? (nM - fm) : WGM;
        u.pm = fm + ((wgid % nig) % gsz); u.pn = (wgid % nig) / gsz; u.e = 0; u.r0 = 0; return true;
    }
    __device__ __forceinline__ const char* abase(const Unit& u, const Gemm& g, size_t tstep) const { return (const char*)g.A + (size_t)u.pm * tstep; }
    __device__ __forceinline__ const char* bbase(const Unit& u, const Gemm& g, size_t tstep) const { return (const char*)g.Bt + (size_t)u.pn * tstep; }
    static constexpr bool SIDE = false;
    __device__ __forceinline__ unsigned arow(const Unit&, int) const { return 0u; }
    __device__ __forceinline__ unsigned arow_side(const Unit&, int, const PG8_LAS unsigned char*) const { return 0u; }
    __device__ __forceinline__ const void* side_src(const Unit&, const Unit&, int, int) const { return nullptr; }
    __device__ __forceinline__ void a_ready(const Unit&) const {}
    __device__ __forceinline__ void done(const Unit&) const {}
};

struct MoeOrder {
    const PG8_LAS int* units;
    int nunits;
    const PG8_LAS int* cnt;
    const int* rowtok;
    int gather;
    unsigned rowbytes;
    size_t bstride;
    __device__ __forceinline__ bool next(int i, Unit& u) const {
        if (i >= nunits) return false;
        u.pm = __builtin_amdgcn_readfirstlane(units[4 * i + 0]); u.pn = __builtin_amdgcn_readfirstlane(units[4 * i + 1]);
        u.e = __builtin_amdgcn_readfirstlane(units[4 * i + 2]); u.r0 = __builtin_amdgcn_readfirstlane(units[4 * i + 3]); return true;
    }
    __device__ __forceinline__ const char* abase(const Unit& u, const Gemm& g, size_t tstep) const { return gather ? (const char*)g.A : (const char*)g.A + (size_t)u.pm * tstep; }
    __device__ __forceinline__ const char* bbase(const Unit& u, const Gemm& g, size_t tstep) const { return (const char*)g.Bt + (size_t)u.e * bstride + (size_t)u.pn * tstep; }
    static constexpr bool SIDE = true;
    const float* rowgate; const float* bgu;
    __device__ __forceinline__ unsigned arow(const Unit& u, int R) const {
        const int r = u.r0 + R; const int idx = (r < cnt[u.e]) ? rowtok[(size_t)u.e * 32768 + r] : 0; return (unsigned)(idx >> 2) * rowbytes; }
    __device__ __forceinline__ unsigned arow_side(const Unit& u, int R, const PG8_LAS unsigned char* sd) const {
        const int r = u.r0 + R; const int v = ((const PG8_LAS int*)sd)[R]; const int idx = (r < cnt[u.e]) ? v : 0; return (unsigned)(idx >> 2) * rowbytes; }
    __device__ __forceinline__ const void* side_src(const Unit& cur, const Unit& rt, int wid, int lane) const {
        if (rowgate != nullptr && wid == 1) return rowgate + (size_t)cur.e * 32768 + cur.r0 + 4 * lane;
        if (bgu != nullptr && wid == 2) return gather ? (bgu + (size_t)cur.e * 2048 + (lane < 32 ? 0 : 1024 - 128) + cur.pn * 128 + 4 * lane)
                                                      : (bgu + (size_t)cur.e * 1024 + cur.pn * 256 + 4 * lane);
        return rowtok + (size_t)rt.e * 32768 + rt.r0 + 4 * lane; }
    __device__ __forceinline__ void a_ready(const Unit&) const {}
    __device__ __forceinline__ void done(const Unit&) const {}
};
__device__ __forceinline__ void moe_build_units(PG8_LAS int* units, PG8_LAS int* units_n, const PG8_LAS int* tstart, int nN, int G, int c, int tid) {
    if (tid < 64) {
        const int nT = tstart[32], nwg = nT * nN; const long L = (long)tid * G + c;
        int pm = 0, pn = 0, e = 0, r0 = 0;
        if (L < nwg) {
            int wgid = (int)L; { const int q = nwg / NXCD, r = nwg % NXCD, xcd = wgid % NXCD, off = wgid / NXCD; wgid = (xcd < r ? xcd * (q + 1) : r * (q + 1) + (xcd - r) * q) + off; }
            const int nig = WGM * nN, gid = wgid / nig, fm = gid * WGM, gsz = (nT - fm) < WGM ? (nT - fm) : WGM;
            pm = fm + ((wgid % nig) % gsz); pn = (wgid % nig) / gsz;
            for (int j = 1; j < 32; ++j) e += (tstart[j] <= pm) ? 1 : 0;
            r0 = (pm - tstart[e]) * 256;
        }
        units[4 * tid + 0] = pm; units[4 * tid + 1] = pn; units[4 * tid + 2] = e; units[4 * tid + 3] = r0;
        if (tid == 0) { int n = 0; if (c < nwg) n = (nwg - c + G - 1) / G; units_n[0] = n < 64 ? n : 64; }
    }
}

__host__ __device__ __forceinline__ unsigned hblk_off(int R, int p7) { const int ai = R >> 7, wr = (R >> 6) & 1, m = (R >> 4) & 3, fr = R & 15, wc = p7 >> 1, fq = ((p7 & 1) << 1) | (m & 1), mp = m >> 1;
    return (unsigned)(((((ai * 2 + wr) * 4 + wc) * 2 + mp) * 64 + fr + 16 * fq) * 16); }
typedef int v8i_t __attribute__((ext_vector_type(8)));
typedef int v4i_t __attribute__((ext_vector_type(4)));
__device__ __forceinline__ v8i_t cat8(bf16x8 lo, bf16x8 hi) { const v4i_t a = __builtin_bit_cast(v4i_t, lo), b = __builtin_bit_cast(v4i_t, hi); return __builtin_shufflevector(a, b, 0, 1, 2, 3, 4, 5, 6, 7); }
__device__ __forceinline__ void mfma8(f32x4& acc, v8i_t a, v8i_t b, int scl) { asm volatile("v_mfma_scale_f32_16x16x128_f8f6f4 %0, %1, %2, %0, %3, %3 op_sel_hi:[0,0,0]" : "+v"(acc) : "v"(a), "v"(b), "v"(scl)); }
__device__ __forceinline__ unsigned pk4_fp8(float a, float b, float c, float d) { unsigned w = 0u; w = __builtin_amdgcn_cvt_pk_fp8_f32(a, b, w, false); w = __builtin_amdgcn_cvt_pk_fp8_f32(c, d, w, true); return w; }
__device__ __forceinline__ unsigned cvt_pk_bf16(float lo, float hi) { unsigned r; asm volatile("v_cvt_pk_bf16_f32 %0, %1, %2" : "=v"(r) : "v"(lo), "v"(hi)); return r; }

struct EpiProj {
    static constexpr bool PERM = true, AFTER_DRAIN = false;
    bf16_t* O; int ldc; const float* rope; float qscale; float dqv; int pn_off;
    __device__ __forceinline__ void operator()(const f32x4 (&acc)[2][2][4][2], const Unit& u, int wr, int wc, int fr, int fq, const PG8_LAS unsigned char* sd) const {
        const int pnn = u.pn + pn_off; const int row0 = u.pm * BM + wr * 64 + fr; const int col0 = pnn * BM + wc * 32 + 8 * fq;
        const bool rot = pnn < 4; const float sc = (pnn < 2 ? qscale : 1.f) * dqv; const int gq = 4 * (wc & 1) + fq;
        float invr[4];
#pragma unroll
        for (int e = 0; e < 4; ++e) invr[e] = __builtin_amdgcn_exp2f(-(float)(4 * gq + e) * 0.41524101186092029f) * 0.15915494309189535f;
#pragma unroll
        for (int ai = 0; ai < 2; ++ai)
#pragma unroll
            for (int m = 0; m < 4; ++m) { const int row = row0 + ai * HALF + m * 16; bf16_t* rowp = O + (size_t)row * ldc + col0;
                f32x4 cs0 = (f32x4){1.f, 0.f, 1.f, 0.f}, cs1 = cs0;
                if (rot) { const float tp = (float)(row & 4095);
                    const float a0 = __builtin_amdgcn_fractf(tp * invr[0]), a1 = __builtin_amdgcn_fractf(tp * invr[1]), a2 = __builtin_amdgcn_fractf(tp * invr[2]), a3 = __builtin_amdgcn_fractf(tp * invr[3]);
                    cs0 = (f32x4){__builtin_amdgcn_cosf(a0), __builtin_amdgcn_sinf(a0), __builtin_amdgcn_cosf(a1), __builtin_amdgcn_sinf(a1)};
                    cs1 = (f32x4){__builtin_amdgcn_cosf(a2), __builtin_amdgcn_sinf(a2), __builtin_amdgcn_cosf(a3), __builtin_amdgcn_sinf(a3)}; }
#pragma unroll
                for (int bj = 0; bj < 2; ++bj) { f32x4 v0 = acc[ai][bj][m][0], v1 = acc[ai][bj][m][1];
                    if (rot) { f32x4 lo, hi;
                        lo[0] = v0[0] * cs0[0] - v1[0] * cs0[1]; hi[0] = v1[0] * cs0[0] + v0[0] * cs0[1];
                        lo[1] = v0[1] * cs0[2] - v1[1] * cs0[3]; hi[1] = v1[1] * cs0[2] + v0[1] * cs0[3];
                        lo[2] = v0[2] * cs1[0] - v1[2] * cs1[1]; hi[2] = v1[2] * cs1[0] + v0[2] * cs1[1];
                        lo[3] = v0[3] * cs1[2] - v1[3] * cs1[3]; hi[3] = v1[3] * cs1[2] + v0[3] * cs1[3];
                        v0 = lo * sc; v1 = hi * sc; }
                    else { v0 = v0 * dqv; v1 = v1 * dqv; }
                    u32x4 w; w.x = cvt_pk_bf16(v0[0], v0[1]); w.y = cvt_pk_bf16(v0[2], v0[3]); w.z = cvt_pk_bf16(v1[0], v1[1]); w.w = cvt_pk_bf16(v1[2], v1[3]);
                    *(u32x4*)(rowp + bj * HALF) = w; } }
    }
};
struct EpiF32 {
    static constexpr bool PERM = false, AFTER_DRAIN = false;
    float* O; int ldc;
    __device__ __forceinline__ void operator()(const f32x4 (&acc)[2][2][4][2], const Unit& u, int wr, int wc, int fr, int fq, const PG8_LAS unsigned char* sd) const {
        const int row0 = u.pm * BM + wr * 64 + fr; const int col0 = u.pn * BM + wc * 32 + 4 * fq;
#pragma unroll
        for (int ai = 0; ai < 2; ++ai)
#pragma unroll
            for (int m = 0; m < 4; ++m) { float* rowp = O + (size_t)(row0 + ai * HALF + m * 16) * ldc + col0;
#pragma unroll
                for (int bj = 0; bj < 2; ++bj)
#pragma unroll
                    for (int n = 0; n < 2; ++n) *(f32x4*)(rowp + bj * HALF + n * 16) = acc[ai][bj][m][n]; }
    }
};
struct EpiBf16Plain {
    static constexpr bool PERM = true, AFTER_DRAIN = false;
    bf16_t* O; int ldc;
    __device__ __forceinline__ void operator()(const f32x4 (&acc)[2][2][4][2], const Unit& u, int wr, int wc, int fr, int fq, const PG8_LAS unsigned char* sd) const {
        const int row0 = u.pm * BM + wr * 64 + fr; const int col0 = u.pn * BM + wc * 32 + 8 * fq;
#pragma unroll
        for (int ai = 0; ai < 2; ++ai)
#pragma unroll
            for (int m = 0; m < 4; ++m) { bf16_t* rowp = O + (size_t)(row0 + ai * HALF + m * 16) * ldc + col0;
#pragma unroll
                for (int bj = 0; bj < 2; ++bj) { const f32x4 v0 = acc[ai][bj][m][0], v1 = acc[ai][bj][m][1];
                    u32x4 w; w.x = cvt_pk_bf16(v0[0], v0[1]); w.y = cvt_pk_bf16(v0[2], v0[3]); w.z = cvt_pk_bf16(v1[0], v1[1]); w.w = cvt_pk_bf16(v1[2], v1[3]);
                    *(u32x4*)(rowp + bj * HALF) = w; } }
    }
};
struct EpiSwiglu {
    static constexpr bool PERM = true, AFTER_DRAIN = false;
    unsigned char* H; const float* bgu; const float* rowgate; const PG8_LAS int* cnt; float dq, hscale;
    __device__ __forceinline__ void operator()(const f32x4 (&acc)[2][2][4][2], const Unit& u, int wr, int wc, int fr, int fq, const PG8_LAS unsigned char* sd) const {
        const int n_e = cnt[u.e];
        constexpr float CS = -1.702f * 1.4426950408889634f;
        const float kk = hscale / CS, dqc = dq * CS, dqk = dq * kk, glo = 7.0f * CS, ub0 = -6.0f * kk, ub1 = 8.0f * kk;
        f32x4 bg[2], bu[2];
#pragma unroll
        for (int n = 0; n < 2; ++n) { bg[n] = *(const PG8_LAS f32x4*)(sd + 2048 + (wc * 32 + 8 * fq + 4 * n) * 4) * CS; bu[n] = (*(const PG8_LAS f32x4*)(sd + 2048 + 512 + (wc * 32 + 8 * fq + 4 * n) * 4) + 1.0f) * kk; }
        const int lane = fr + 16 * fq;
#pragma unroll
        for (int ai = 0; ai < 2; ++ai)
#pragma unroll
            for (int mp = 0; mp < 2; ++mp) {
                unsigned pw[2][2];
#pragma unroll
                for (int mm = 0; mm < 2; ++mm) { const int m = 2 * mp + mm; const int r = ai * HALF + wr * 64 + m * 16 + fr; const int er = u.r0 + r;
                    const float rgl = ((const PG8_LAS float*)(sd + 1024))[r]; const float irg = (er < n_e) ? __builtin_amdgcn_rcpf(rgl) : 1e30f;
                    float hv[8];
#pragma unroll
                    for (int n = 0; n < 2; ++n)
#pragma unroll
                        for (int q = 0; q < 4; q += 2) {
                            f32x2 g = (f32x2){acc[ai][0][m][n][q], acc[ai][0][m][n][q + 1]} * dqc + (f32x2){bg[n][q], bg[n][q + 1]};
                            f32x2 up = (f32x2){acc[ai][1][m][n][q], acc[ai][1][m][n][q + 1]} * dqk + (f32x2){bu[n][q], bu[n][q + 1]};
                            g.x = fmaxf(g.x, glo); g.y = fmaxf(g.y, glo); up.x = __builtin_amdgcn_fmed3f(up.x, ub0, ub1); up.y = __builtin_amdgcn_fmed3f(up.y, ub0, ub1);
                            f32x2 den; den.x = __builtin_amdgcn_exp2f(g.x); den.y = __builtin_amdgcn_exp2f(g.y); den = den * irg + irg;
                            f32x2 sg; sg.x = __builtin_amdgcn_rcpf(den.x); sg.y = __builtin_amdgcn_rcpf(den.y);
                            const f32x2 h2 = (up * g) * sg;
                            hv[n * 4 + q] = h2.x; hv[n * 4 + q + 1] = h2.y; }
                    pw[mm][0] = pk4_fp8(hv[0], hv[1], hv[2], hv[3]); pw[mm][1] = pk4_fp8(hv[4], hv[5], hv[6], hv[7]); }
                const auto s0 = __builtin_amdgcn_permlane16_swap(pw[0][0], pw[1][0], false, false); const auto s1 = __builtin_amdgcn_permlane16_swap(pw[0][1], pw[1][1], false, false);
                *(u32x4*)(H + ((size_t)u.pm * 8 + u.pn) * 32768 + ((((ai * 2 + wr) * 4 + wc) * 2 + mp) * 64 + lane) * 16) = (u32x4){s0[0], s1[0], s0[1], s1[1]};
                asm volatile("" ::: "memory"); }
    }
};
struct EpiScatter {
    static constexpr bool PERM = true, AFTER_DRAIN = false;
    unsigned char* Y; const int* rowtok; const PG8_LAS int* cnt; float dq, ysc;
    __device__ __forceinline__ void operator()(const f32x4 (&acc)[2][2][4][2], const Unit& u, int wr, int wc, int fr, int fq, const PG8_LAS unsigned char* sd) const {
        const int col0 = u.pn * BM + wc * 32 + 8 * fq; const int n_e = cnt[u.e];
        f32x4 bd[2][2];
#pragma unroll
        for (int bj = 0; bj < 2; ++bj)
#pragma unroll
            for (int n = 0; n < 2; ++n) bd[bj][n] = *(const PG8_LAS f32x4*)(sd + 2048 + (bj * HALF + wc * 32 + 8 * fq + 4 * n) * 4);
#pragma unroll
        for (int ai = 0; ai < 2; ++ai)
#pragma unroll
            for (int m = 0; m < 4; ++m) { const int er = u.r0 + ai * HALF + wr * 64 + m * 16 + fr;
                const int idx = ((const PG8_LAS int*)sd)[ai * HALF + wr * 64 + m * 16 + fr];
                if (er < n_e) { unsigned char* rowp = Y + (size_t)idx * 1024 + col0;
                    typedef unsigned u32x2 __attribute__((ext_vector_type(2)));
                    const float rg = ((const PG8_LAS float*)(sd + 1024))[ai * HALF + wr * 64 + m * 16 + fr] * ysc;
#pragma unroll
                    for (int bj = 0; bj < 2; ++bj) { const f32x4 v0 = acc[ai][bj][m][0] * dq + bd[bj][0] * rg, v1 = acc[ai][bj][m][1] * dq + bd[bj][1] * rg;
                        *(u32x2*)(rowp + bj * HALF) = (u32x2){pk4_fp8(v0[0], v0[1], v0[2], v0[3]), pk4_fp8(v1[0], v1[1], v1[2], v1[3])}; } }
                asm volatile("" ::: "memory"); }
    }
};

struct PanelStats {
    unsigned* xbuf;
    unsigned* cnt;
    unsigned* tmo;
    int ntn; float eps;
    unsigned code;
    __device__ __forceinline__ bool run(const f32x4 (&v)[2][2][4][2], const Unit& u, int wr, int wc, int fr, int fq, PG8_LAS unsigned char* lds, int wid, int lane) const {
        typedef float f32x2v __attribute__((ext_vector_type(2)));
        PG8_LAS f32x2v* P = (PG8_LAS f32x2v*)lds;
        PG8_LAS f32x2v* S = (PG8_LAS f32x2v*)(lds + 8192);
        PG8_LAS unsigned* flag = (PG8_LAS unsigned*)(lds + 8192 + 2048);
#pragma unroll
        for (int ai = 0; ai < 2; ++ai)
#pragma unroll
            for (int m = 0; m < 4; ++m) {
                float s = 0.f;
#pragma unroll
                for (int bj = 0; bj < 2; ++bj)
#pragma unroll
                    for (int n = 0; n < 2; ++n) { const f32x4 x = v[ai][bj][m][n]; s += (x[0] + x[1]) + (x[2] + x[3]); }
                s += __shfl_xor(s, 16); s += __shfl_xor(s, 32);
                const float mw = s * (1.0f / 64.0f); float q = 0.f;
#pragma unroll
                for (int bj = 0; bj < 2; ++bj)
#pragma unroll
                    for (int n = 0; n < 2; ++n) { const f32x4 d = v[ai][bj][m][n] - mw; q += (d[0] * d[0] + d[1] * d[1]) + (d[2] * d[2] + d[3] * d[3]); }
                q += __shfl_xor(q, 16); q += __shfl_xor(q, 32);
                if (fq == 0) P[(ai * HALF + wr * 64 + m * 16 + fr) * 4 + wc] = (f32x2v){mw, q};
            }
        asm volatile("s_waitcnt lgkmcnt(0)" ::: "memory"); __builtin_amdgcn_s_barrier(); asm volatile("" ::: "memory");
        const int row = wid * 32 + (lane & 31);
        bool bad = false;
        if (lane < 32) {
            const f32x2v a = P[row * 4 + 0], b = P[row * 4 + 1], c = P[row * 4 + 2], d = P[row * 4 + 3];
            const float mt0 = (a.x + b.x + c.x + d.x) * 0.25f;
            const float da = a.x - mt0, db = b.x - mt0, dc = c.x - mt0, dd = d.x - mt0;
            const float m20 = (a.y + b.y) + (c.y + d.y) + 64.0f * ((da * da + db * db) + (dc * dc + dd * dd));
            unsigned long long* slot = (unsigned long long*)xbuf + (size_t)(u.pm * BM + row) * 4;
            __hip_atomic_store(slot + u.pn, ((unsigned long long)__float_as_uint(m20) << 32) | (__float_as_uint(mt0) | 1u), __ATOMIC_RELAXED, __HIP_MEMORY_SCOPE_AGENT);
            unsigned long long w[4]; unsigned sp = 0u;
            for (;;) { bool all = true;
#pragma unroll
                for (int t = 0; t < 4; ++t) { w[t] = (t < ntn) ? __hip_atomic_load(slot + t, __ATOMIC_RELAXED, __HIP_MEMORY_SCOPE_AGENT) : 1ull; all = all && (w[t] != 0ull); }
                if (all) break;
                __builtin_amdgcn_s_sleep(1); if (++sp > (1u << 20)) { bad = true; break; } }
            float mt[4], m2[4]; float ms = 0.f;
#pragma unroll
            for (int t = 0; t < 4; ++t) { if (t < ntn) { mt[t] = __uint_as_float((unsigned)w[t]); m2[t] = __uint_as_float((unsigned)(w[t] >> 32)); } else { mt[t] = 0.f; m2[t] = 0.f; } ms += mt[t]; }
            const float mean = ms / (float)ntn; float q = 0.f;
#pragma unroll
            for (int t = 0; t < 4; ++t) if (t < ntn) { const float dm = mt[t] - mean; q += m2[t] + 256.0f * dm * dm; }
            S[row] = (f32x2v){mean, 1.0f / sqrtf(q / (256.0f * (float)ntn) + eps)};
            if (bad) { __hip_atomic_store(tmo, 1u, __ATOMIC_RELAXED, __HIP_MEMORY_SCOPE_AGENT); }
        }
        asm volatile("s_waitcnt lgkmcnt(0)" ::: "memory"); __builtin_amdgcn_s_barrier(); asm volatile("" ::: "memory");
        return bad;
    }
};

struct EpiLn1 {
    static constexpr bool PERM = true, AFTER_DRAIN = true;
    unsigned char* ws; const float* gam; const float* bet; size_t o_xb, o_x8, o_xbuf, o_cnt, o_tmo; float alpha, s8, eps; unsigned code;
    __device__ __forceinline__ void operator()(const f32x4 (&)[2][2][4][2], const Unit&, int, int, int, int, const PG8_LAS unsigned char*) const {}
    __device__ __forceinline__ void fused(f32x4 (&acc)[2][2][4][2], const Unit& u, int wr, int wc, int fr, int fq, PG8_LAS unsigned char* lds, int wid, int lane) const {
        typedef float f32x2v __attribute__((ext_vector_type(2))); typedef unsigned u32x2 __attribute__((ext_vector_type(2)));
        bf16_t* const XBp = (bf16_t*)(ws + o_xb); unsigned char* const X8 = ws + o_x8;
        const PanelStats st{(unsigned*)(ws + o_xbuf), (unsigned*)(ws + o_cnt), (unsigned*)(ws + o_tmo), 4, eps, code};
        const int col0 = u.pn * BM + wc * 32 + 8 * fq;
#pragma unroll
        for (int ai = 0; ai < 2; ++ai)
#pragma unroll
            for (int m = 0; m < 4; ++m) { const bf16_t* xr = XBp + (size_t)(u.pm * BM + ai * HALF + wr * 64 + m * 16 + fr) * 1024 + col0;
#pragma unroll
                for (int bj = 0; bj < 2; ++bj) { const u32x4 x = *(const u32x4*)(xr + bj * HALF);
                    acc[ai][bj][m][0] += (f32x4){__builtin_bit_cast(float, x.x << 16), __builtin_bit_cast(float, x.x & 0xffff0000u), __builtin_bit_cast(float, x.y << 16), __builtin_bit_cast(float, x.y & 0xffff0000u)} * alpha;
                    acc[ai][bj][m][1] += (f32x4){__builtin_bit_cast(float, x.z << 16), __builtin_bit_cast(float, x.z & 0xffff0000u), __builtin_bit_cast(float, x.w << 16), __builtin_bit_cast(float, x.w & 0xffff0000u)} * alpha; }
                asm volatile("" ::: "memory"); }
        (void)st.run(acc, u, wr, wc, fr, fq, lds, wid, lane);
        const PG8_LAS f32x2v* S = (const PG8_LAS f32x2v*)(lds + 8192);
#pragma unroll
        for (int bj = 0; bj < 2; ++bj) {
            const f32x4 g0 = *(const f32x4*)(gam + col0 + bj * HALF), g1 = *(const f32x4*)(gam + col0 + bj * HALF + 4), b0 = *(const f32x4*)(bet + col0 + bj * HALF), b1 = *(const f32x4*)(bet + col0 + bj * HALF + 4);
#pragma unroll
            for (int ai = 0; ai < 2; ++ai)
#pragma unroll
                for (int m = 0; m < 4; ++m) { const int r = ai * HALF + wr * 64 + m * 16 + fr; const f32x2v sr = S[r]; const size_t off = (size_t)(u.pm * BM + r) * 1024 + col0 + bj * HALF;
                    const f32x4 o0 = (acc[ai][bj][m][0] - sr.x) * sr.y * g0 + b0, o1 = (acc[ai][bj][m][1] - sr.x) * sr.y * g1 + b1;
                    u32x4 w; w.x = cvt_pk_bf16(o0[0], o0[1]); w.y = cvt_pk_bf16(o0[2], o0[3]); w.z = cvt_pk_bf16(o1[0], o1[1]); w.w = cvt_pk_bf16(o1[2], o1[3]);
                    *(u32x4*)(XBp + off) = w;
                    *(u32x2*)(X8 + off) = (u32x2){pk4_fp8(o0[0] * s8, o0[1] * s8, o0[2] * s8, o0[3] * s8), pk4_fp8(o1[0] * s8, o1[1] * s8, o1[2] * s8, o1[3] * s8)};
                    asm volatile("" ::: "memory"); } }
    }
};

template <class Epi, class Sched, bool ALIGN_EPI, bool GATHER, bool FP8 = false, bool ABLK = false>
__device__ __forceinline__ void gemm_phase(PG8_LAS unsigned char* lds, const Gemm g, const Sched& S, const Epi& E) {
    const int tid = threadIdx.x, wid = __builtin_amdgcn_readfirstlane(tid >> 6), lane = tid & 63, wr = wid >> 2, wc = wid & 3, fr = lane & 15, fq = lane >> 4;
    const int K = g.K, nt = K / BK;
    unsigned voffB[2];
#pragma unroll
    for (int i = 0; i < 2; ++i) { int R, C; stage_rc(tid * 16 + i * 8192, R, C); const int Rb = Epi::PERM ? ((R & ~31) + perm32(R & 31)) : R;
        voffB[i] = (unsigned)(Rb * K + C) * 2u; }
    constexpr int SIDE_BYTES = 8192;
    PG8_LAS unsigned char* const side = lds + STAGE_BYTES;
    const size_t kstep = (size_t)(BK * 2);
    const size_t kstepA = ABLK ? (size_t)32768 : kstep;
    const size_t hstep = (size_t)HALF * K * 2;
    const size_t tstep = 2 * hstep;
    const unsigned ldsw = (unsigned)wid * 1024u;
    const int aoff = lds_byte(wr * 64 + fr, fq * 8), boff = lds_byte(wc * 32 + fr, fq * 8);
#define PG8_SA(b, h) (((b) * 2 + (h)) * HTB)
#define PG8_SB(b, h) ((4 + (b) * 2 + (h)) * HTB)
#define PG8_STAGE(bufoff, gbase, voff) do { _Pragma("unroll") for (int _i = 0; _i < 2; ++_i) \
        __builtin_amdgcn_global_load_lds((const unsigned*)((const char*)(gbase) + (voff)[_i]), (PG8_LAS unsigned*)(lds + (bufoff) + ldsw + _i * 8192), 16, 0, 0); } while (0)
#define PG8_LDA(dst, b, h) do { _Pragma("unroll") for (int m = 0; m < 4; ++m) _Pragma("unroll") for (int k = 0; k < 2; ++k) dst[m][k] = *(const PG8_LAS bf16x8*)(lds + PG8_SA(b, h) + aoff + m * 2048 + k * 1024); } while (0)
#define PG8_LDB(dst, b, h) do { _Pragma("unroll") for (int n = 0; n < 2; ++n) _Pragma("unroll") for (int k = 0; k < 2; ++k) dst[n][k] = *(const PG8_LAS bf16x8*)(lds + PG8_SB(b, h) + boff + n * 2048 + k * 1024); } while (0)
#define PG8_MMA(ai, bj, At, Bt) do { __builtin_amdgcn_s_setprio(1); _Pragma("unroll") for (int m = 0; m < 4; ++m) _Pragma("unroll") for (int n = 0; n < 2; ++n) { \
        if constexpr (FP8) mfma8(acc[ai][bj][m][n], cat8(Bt[n][0], Bt[n][1]), cat8(At[m][0], At[m][1]), scl8); \
        else { _Pragma("unroll") for (int k = 0; k < 2; ++k) acc[ai][bj][m][n] = __builtin_amdgcn_mfma_f32_16x16x32_bf16(Bt[n][k], At[m][k], acc[ai][bj][m][n], 0, 0, 0); } } __builtin_amdgcn_s_setprio(0); } while (0)
#define PG8_WAIT_V(n) asm volatile("s_waitcnt vmcnt(" #n ")" ::: "memory")
#define PG8_WAIT_L(n) asm volatile("s_waitcnt lgkmcnt(" #n ")" ::: "memory")
#define PG8_BAR __builtin_amdgcn_s_barrier()
#define PG8_SCHED __builtin_amdgcn_sched_barrier(0)
#define PG8_SETOFFS(o, u) do { _Pragma("unroll") for (int _h = 0; _h < 2; ++_h) _Pragma("unroll") for (int _i = 0; _i < 2; ++_i) { int _R, _C; stage_rc(tid * 16 + _i * 8192, _R, _C); \
        o[_h][_i] = GATHER ? (S.arow(u, _R + HALF * _h) + (unsigned)(_C * 2)) : ABLK ? hblk_off(_R + HALF * _h, _C >> 3) : ((unsigned)((_R + HALF * _h) * K) * 2u + (unsigned)(_C * 2)); } } while (0)
    int scl8 = 0x7F7F7F7F; asm volatile("" : "+v"(scl8));
    Unit cur, nxt; int ui = 0;
    if (!S.next(0, cur)) return;
    f32x4 acc[2][2][4][2];
#pragma unroll
    for (int a = 0; a < 2; ++a)
#pragma unroll
        for (int b = 0; b < 2; ++b)
#pragma unroll
            for (int m = 0; m < 4; ++m)
#pragma unroll
                for (int n = 0; n < 2; ++n) { acc[a][b][m][n] = (f32x4){0.f, 0.f, 0.f, 0.f}; if constexpr (FP8) asm volatile("" : "+v"(acc[a][b][m][n])); }
    bf16x8 At[4][2], B0[2][2], B1[2][2];
    unsigned cAo[2][2];
    PG8_SETOFFS(cAo, cur);
    const char* cA = S.abase(cur, g, tstep); const char* cB = S.bbase(cur, g, tstep);
    S.a_ready(cur);
    PG8_STAGE(PG8_SB(0, 0), cB, voffB); PG8_STAGE(PG8_SB(0, 1), cB + hstep, voffB); PG8_STAGE(PG8_SA(0, 0), cA, cAo[0]); PG8_STAGE(PG8_SA(0, 1), cA, cAo[1]);
    if (wr == 1) PG8_BAR;
    PG8_WAIT_V(2); PG8_BAR;
    PG8_STAGE(PG8_SB(1, 0), cB + kstep, voffB); PG8_STAGE(PG8_SA(1, 0), cA + kstepA, cAo[0]); PG8_STAGE(PG8_SB(1, 1), cB + hstep + kstep, voffB);
    PG8_WAIT_V(6); PG8_BAR;
    for (;;) {
        const bool has_next = S.next(ui + 1, nxt);
        const char* nA = has_next ? S.abase(nxt, g, tstep) : cA; const char* nB = has_next ? S.bbase(nxt, g, tstep) : cB;
        if constexpr (Sched::SIDE) {
            const void* ssrc = S.side_src(cur, (GATHER && has_next) ? nxt : cur, wid, lane);
            __builtin_amdgcn_global_load_lds((const unsigned*)ssrc, (PG8_LAS unsigned*)(side + (ui & 1) * SIDE_BYTES + wid * 1024), 16, 0, 0); }
#pragma unroll 1
        for (int t = 0; t < nt; t += 2) {
            const bool last = (t == nt - 2);
            const char* a1 = cA + (size_t)(t + 1) * kstepA;
            const char* a2 = last ? nA : cA + (size_t)(t + 2) * kstepA; const char* b2 = last ? nB : cB + (size_t)(t + 2) * kstep;
            const char* a3 = a2 + kstepA; const char* b3 = b2 + kstep;
            if (last && has_next) S.a_ready(nxt);
            PG8_LDB(B0, 0, 0); PG8_LDB(B1, 0, 1); PG8_SCHED; PG8_LDA(At, 0, 0); PG8_STAGE(PG8_SA(1, 1), a1, cAo[1]);
            if constexpr (GATHER) { if (last && has_next) {
                const PG8_LAS unsigned char* sdn = side + (ui & 1) * SIDE_BYTES;
#pragma unroll
                for (int _h = 0; _h < 2; ++_h)
#pragma unroll
                    for (int _i = 0; _i < 2; ++_i) { int _R, _C; stage_rc(tid * 16 + _i * 8192, _R, _C); cAo[_h][_i] = S.arow_side(nxt, _R + HALF * _h, sdn) + (unsigned)(_C * 2); } } }
            PG8_WAIT_V(8); PG8_WAIT_L(0); PG8_BAR; PG8_MMA(0, 0, At, B0); PG8_MMA(0, 1, At, B1); PG8_BAR; PG8_SCHED;
            PG8_LDA(At, 0, 1); PG8_STAGE(PG8_SB(0, 0), b2, voffB); PG8_STAGE(PG8_SB(0, 1), b2 + hstep, voffB); PG8_STAGE(PG8_SA(0, 0), a2, cAo[0]);
            PG8_WAIT_V(8); PG8_WAIT_L(0); PG8_BAR; PG8_MMA(1, 0, At, B0); PG8_MMA(1, 1, At, B1); PG8_BAR; PG8_SCHED;
            PG8_LDB(B0, 1, 0); PG8_LDB(B1, 1, 1); PG8_SCHED; PG8_LDA(At, 1, 0); PG8_STAGE(PG8_SA(0, 1), a2, cAo[1]);
            PG8_WAIT_V(8); PG8_WAIT_L(0); PG8_BAR; PG8_MMA(0, 0, At, B0); PG8_MMA(0, 1, At, B1); PG8_BAR; PG8_SCHED;
            PG8_LDA(At, 1, 1); PG8_STAGE(PG8_SB(1, 0), b3, voffB); PG8_STAGE(PG8_SB(1, 1), b3 + hstep, voffB); PG8_STAGE(PG8_SA(1, 0), a3, cAo[0]);
            PG8_WAIT_V(8); PG8_WAIT_L(0); PG8_BAR; PG8_MMA(1, 0, At, B0); PG8_MMA(1, 1, At, B1); PG8_BAR; PG8_SCHED;
        }
        if constexpr (ALIGN_EPI) { if (wr == 0) PG8_BAR; }
        if constexpr (FP8) asm volatile("s_nop 15\n\ts_nop 15" ::: "memory");
        if constexpr (!Epi::AFTER_DRAIN) { PG8_SCHED; E(acc, cur, wr, wc, fr, fq, side + (ui & 1) * SIDE_BYTES); S.done(cur); PG8_SCHED; }
        if (!has_next) break;
#pragma unroll
        for (int a = 0; a < 2; ++a)
#pragma unroll
            for (int b = 0; b < 2; ++b)
#pragma unroll
                for (int m = 0; m < 4; ++m)
#pragma unroll
                    for (int n = 0; n < 2; ++n) { acc[a][b][m][n] = (f32x4){0.f, 0.f, 0.f, 0.f}; if constexpr (FP8) asm volatile("" : "+v"(acc[a][b][m][n])); }
        cur = nxt; cA = nA; cB = nB; ++ui;
        if constexpr (ALIGN_EPI) { if (wr == 1) PG8_BAR; }
    }
    PG8_WAIT_V(0);
    if constexpr (!ALIGN_EPI) { if (wr == 0) PG8_BAR; }
    PG8_BAR;
    if constexpr (Epi::AFTER_DRAIN) { E.fused(acc, cur, wr, wc, fr, fq, lds, wid, lane); S.done(cur); }
#undef PG8_SA
#undef PG8_SB
#undef PG8_STAGE
#undef PG8_LDA
#undef PG8_LDB
#undef PG8_MMA
#undef PG8_WAIT_V
#undef PG8_WAIT_L
#undef PG8_BAR
#undef PG8_SCHED
#undef PG8_SETOFFS
}
}

constexpr int NB = 8, SEQ = 4096, DM = 1024, MROWS = NB * SEQ, NLAYER = 2;
constexpr int NPROJ = 4608, INW = 4616;
constexpr int C_Q = 0, C_K = 512, C_V = 1024, C_Z = 1536, C_XS = 2048, C_SB = 3072, C_SC = 3584, C_SH = 4096;
constexpr int MIXW = 1536, NEXP = 32, TOPK = 4, FF = 1024;
constexpr float ALPHA = 1.4142135623730951f;
constexpr float LN_EPS = 1e-5f, RMS_EPS = 1e-5f;
constexpr float QSCALE = 0.125f * 1.4426950408889634f;

constexpr size_t MiB = 1u << 20;
constexpr size_t WS_CTL = 0, CTL_ZERO_BYTES = 1 * MiB;
constexpr size_t WS_ROPE = 1 * MiB;
constexpr size_t WS_WDT = 2 * MiB;
constexpr size_t WS_ROUT = 2 * MiB + 65536;
constexpr size_t WS_WIN = 4 * MiB;
constexpr size_t WS_WOUT = 24 * MiB;
constexpr size_t WS_WGU = 32 * MiB;
constexpr size_t WS_WDN = 288 * MiB;
constexpr size_t WS_XB = 416 * MiB;
constexpr size_t WS_XF = 480 * MiB;
constexpr size_t WS_XF2 = 608 * MiB;
constexpr size_t WS_PROJ = 736 * MiB;
constexpr size_t WS_DT = 1024 * MiB;
constexpr size_t WS_DTS = 1025 * MiB;
constexpr size_t WS_ACUM = 1026 * MiB;
constexpr size_t WS_LSE = 1027 * MiB;
constexpr size_t WS_OP = 1030 * MiB;
constexpr size_t WS_U = 1126 * MiB;
constexpr size_t WS_G = 1190 * MiB;
constexpr size_t WS_ST = 1222 * MiB;
constexpr size_t WS_YD = 1286 * MiB;
constexpr size_t WS_MIXED = 1350 * MiB;
constexpr size_t WS_MIXF = 1446 * MiB;
constexpr size_t WS_TOPE = 1574 * MiB;
constexpr size_t WS_TOPG = 1575 * MiB;
constexpr size_t WS_ROWTOK = 1576 * MiB;
constexpr size_t WS_ROWGATE = 1580 * MiB;
constexpr size_t WS_H = 736 * MiB;
constexpr size_t WS_YB = 1030 * MiB;
constexpr size_t WS_END = 1584 * MiB;
constexpr int CW_TMO = 0;
constexpr int CW_CNT = 64;
constexpr int CW_BAR = 4096;
constexpr int CW_SEAM = 16384;

constexpr int RING_OFF = 0, RING_BYTES = 131072;
constexpr int LDSCTL_OFF = 155648;
constexpr int L_MISC = LDSCTL_OFF;
constexpr int L_TSTART = LDSCTL_OFF + 256;
constexpr int L_CNT = LDSCTL_OFF + 512;
constexpr int L_LCNT = LDSCTL_OFF + 640;
constexpr int L_LBASE = LDSCTL_OFF + 768;
constexpr int L_UNITS = LDSCTL_OFF + 1024;
constexpr int L_UNITSN = LDSCTL_OFF + 2048;
constexpr int LDS_BYTES = 163840;

#define GAS __attribute__((address_space(1)))
#define LAS __attribute__((address_space(3)))
typedef unsigned short bf16;
typedef unsigned v4u __attribute__((ext_vector_type(4)));
typedef unsigned v2u __attribute__((ext_vector_type(2)));
typedef float f32x4 __attribute__((ext_vector_type(4)));
typedef float f32x16 __attribute__((ext_vector_type(16)));
typedef short bf16x8 __attribute__((ext_vector_type(8)));
typedef GAS unsigned gu32;
#define RLX_AGENT __ATOMIC_RELAXED, __HIP_MEMORY_SCOPE_AGENT
#define LDS_WAIT() asm volatile("s_waitcnt lgkmcnt(0)" ::: "memory")
#define VM_WAIT() asm volatile("s_waitcnt vmcnt(0)" ::: "memory")
__device__ __forceinline__ unsigned f2bf(float f) { unsigned u = __builtin_bit_cast(unsigned, f); return (u + 0x7fffu + ((u >> 16) & 1u)) >> 16; }
__device__ __forceinline__ unsigned pk2(float lo, float hi) { unsigned r; asm volatile("v_cvt_pk_bf16_f32 %0, %1, %2" : "=v"(r) : "v"(lo), "v"(hi)); return r; }
__device__ __forceinline__ float bf2f(unsigned short b) { return __builtin_bit_cast(float, (unsigned)b << 16); }
__device__ __forceinline__ float bflo(unsigned w) { return __builtin_bit_cast(float, w << 16); }
__device__ __forceinline__ float bfhi(unsigned w) { return __builtin_bit_cast(float, w & 0xffff0000u); }
__device__ __forceinline__ float siluf(float x) { return x * __builtin_amdgcn_rcpf(1.0f + __builtin_amdgcn_exp2f(-1.4426950408889634f * x)); }
#define XB_TMO      128
#define XB_XCNT(j)  (256  + 64 * (j))
#define XB_XSUB(j)  (1280 + 64 * (j))
#define XB_XGEN(j)  (2304 + 64 * (j))
#define XB_TOP      3328
#define XB_TOPGEN   3392
#define XCD_BAR_WORDS 3456
#define XB_SPIN_CAP (1u << 18)

__device__ __forceinline__ unsigned xb_ld(unsigned* p)              { return __hip_atomic_load(p, __ATOMIC_RELAXED, __HIP_MEMORY_SCOPE_AGENT); }
__device__ __forceinline__ unsigned xb_add(unsigned* p, unsigned v) { return __hip_atomic_fetch_add(p, v, __ATOMIC_RELAXED, __HIP_MEMORY_SCOPE_AGENT); }
__device__ __forceinline__ unsigned xb_xcc_id() { return (unsigned)__builtin_amdgcn_s_getreg((3 << 11) | 20) & 0xFu; }
#define XB_SPIN(cond, bar) do { unsigned _sp = 0; while (cond) { __builtin_amdgcn_s_sleep(1); \
    if ((++_sp & 255u) == 0u) { if (xb_ld(&(bar)[XB_TMO])) break; if (_sp > XB_SPIN_CAP) { atomicAdd(&(bar)[XB_TMO], 1u); break; } } } } while (0)

struct XcdBarrier {
    unsigned* bar; unsigned x;
    volatile LAS unsigned* st;
};

__device__ __forceinline__ XcdBarrier xcd_barrier_post(unsigned* bar, volatile LAS unsigned* st) {
    XcdBarrier b; b.bar = bar; b.x = xb_xcc_id(); b.st = st;
    if (threadIdx.x == 0) (void)xb_add(&bar[XB_XCNT(b.x)], 1u);
    return b;
}
__device__ __forceinline__ void xcd_barrier_complete(unsigned* bar, unsigned x, unsigned& nloc, unsigned& nx) {
    const unsigned G = gridDim.x * gridDim.y * gridDim.z;
    unsigned sum, cnt, mine, sp = 0u;
    for (;;) {
        sum = 0u; cnt = 0u; mine = 0u;
#pragma unroll
        for (unsigned j = 0; j < 16; ++j) { const unsigned c = xb_ld(&bar[XB_XCNT(j)]); sum += c; cnt += (c > 0u) ? 1u : 0u; mine = (j == x) ? c : mine; }
        if (sum == G) break;
        __builtin_amdgcn_s_sleep(1);
        if ((++sp & 255u) == 0u) { if (xb_ld(&bar[XB_TMO])) break; if (sp > XB_SPIN_CAP) { atomicAdd(&bar[XB_TMO], 1u); break; } }
    }
    nloc = mine > 0u ? mine : 1u; nx = cnt > 0u ? cnt : 1u;
}

__device__ __forceinline__ void xcd_barrier(const XcdBarrier& b) {
    asm volatile("s_waitcnt vmcnt(0)" ::: "memory");
    __syncthreads();
    if (threadIdx.x == 0) {
        unsigned* bar = b.bar;
        __builtin_amdgcn_s_waitcnt(0);
        unsigned nloc = b.st[0], nx = b.st[1];
        if (nloc == 0u) { xcd_barrier_complete(bar, b.x, nloc, nx); b.st[0] = nloc; b.st[1] = nx; }
        const unsigned old = xb_add(&bar[XB_XSUB(b.x)], 1u);
        const unsigned gen = old / nloc;
        if (old + 1u == (gen + 1u) * nloc) {
            __builtin_amdgcn_fence(__ATOMIC_RELEASE, "agent");
            asm volatile("s_waitcnt vmcnt(0)" ::: "memory");
            const unsigned og = xb_add(&bar[XB_TOP], 1u);
            const unsigned tg = og / nx;
            if (og + 1u == (tg + 1u) * nx) xb_add(&bar[XB_TOPGEN], 1u);
            else XB_SPIN(xb_ld(&bar[XB_TOPGEN]) == tg, bar);
            __builtin_amdgcn_fence(__ATOMIC_ACQUIRE, "agent");
            xb_add(&bar[XB_XGEN(b.x)], 1u);
            asm volatile("s_waitcnt vmcnt(0)" ::: "memory");
        } else {
            XB_SPIN(xb_ld(&bar[XB_XGEN(b.x)]) == gen, bar);
            __builtin_amdgcn_fence(__ATOMIC_ACQUIRE, "agent");
            asm volatile("s_waitcnt vmcnt(0)" ::: "memory");
        }
    }
    __syncthreads();
}

constexpr float SC_X = 4.f, SC_WGU = 32.f, SC_H = 4.f, SC_WDN = 4.f, SC_Y = 16.f, SC_WIN = 32.f, SC_O = 32.f;
__device__ __forceinline__ float wave_sum(float v) {
#pragma unroll
    for (int o = 1; o < 64; o <<= 1) v += __shfl_xor(v, o);
    return v;
}
__device__ __forceinline__ int win_dest_row(int n) {
    if (n < 1024) { const int hh = n >> 6, d = n & 63; const int p = (d < 32) ? (8 * (d >> 2) + (d & 3)) : (8 * ((d - 32) >> 2) + 4 + (d & 3)); return hh * 64 + p; }
    if (n < 3072) return n;
    if (n < 3080) return -1;
    return n - 8;
}
__device__ __forceinline__ int wgu_dest_row(int n) { return n < 1024 ? ((n >> 7) * 256 + (n & 127)) : (((n - 1024) >> 7) * 256 + 128 + ((n - 1024) & 127)); }
template <int MAP>
__device__ __forceinline__ void p0_transpose_item(const float* W, int K, int N, bf16* WT, float* wdt, LAS float* scr, int kb, int nb, int lane) {
    const int k0 = 64 * kb, n0 = 32 * nb;
    const int nn = n0 + (lane & 31); const bool nok = nn < N;
#pragma unroll 8
    for (int i = 0; i < 32; ++i) { const int kk = 2 * i + (lane >> 5); scr[kk * 33 + (lane & 31)] = nok ? W[(size_t)(k0 + kk) * N + nn] : 0.f; }
    LDS_WAIT(); asm volatile("" ::: "memory");
    const int c = lane & 7;
#pragma unroll
    for (int j = 0; j < 4; ++j) { const int n = (lane >> 3) + 8 * j; const LAS float* s = scr + (8 * c) * 33 + n;
        const int nsrc = n0 + n; if (nsrc >= N) continue;
        int drow = nsrc; if (MAP == 1) drow = win_dest_row(nsrc); if (MAP == 2) drow = wgu_dest_row(nsrc);
        if (MAP == 1 && drow < 0) { float* d = wdt + (size_t)(nsrc - 3072) * 1024 + k0 + 8 * c;
#pragma unroll
            for (int q = 0; q < 8; ++q) d[q] = s[q * 33]; continue; }
        v4u o; o.x = pk2(s[0 * 33], s[1 * 33]); o.y = pk2(s[2 * 33], s[3 * 33]); o.z = pk2(s[4 * 33], s[5 * 33]); o.w = pk2(s[6 * 33], s[7 * 33]);
        *(GAS v4u*)(WT + (size_t)drow * K + k0 + 8 * c) = o; }
    LDS_WAIT(); asm volatile("" ::: "memory");
}
template <int MAP>
__device__ __forceinline__ void p0_transpose_item64(const float* W, int K, int N, bf16* WT, float* wdt, LAS float* scr, int kb, int nb, int lane) {
    const int k0 = 64 * kb, n0 = 64 * nb;
    const bool lok = (n0 + 4 * (lane & 15) + 3) < N;
    f32x4 ld[16];
#pragma unroll
    for (int i = 0; i < 16; ++i) ld[i] = lok ? *(const f32x4*)(W + (size_t)(k0 + 4 * i + (lane >> 4)) * N + n0 + 4 * (lane & 15)) : (f32x4){0.f, 0.f, 0.f, 0.f};
#pragma unroll
    for (int i = 0; i < 16; ++i) *(LAS f32x4*)(scr + (4 * i + (lane >> 4)) * 64 + 4 * (lane & 15)) = ld[i];
    LDS_WAIT(); asm volatile("" ::: "memory");
    const int nsrc = n0 + lane;
    if (nsrc < N) {
        int drow = nsrc; if (MAP == 1) drow = win_dest_row(nsrc);
        if (MAP == 1 && drow < 0) { float* d = wdt + (size_t)(nsrc - 3072) * 1024 + k0;
#pragma unroll
            for (int q = 0; q < 16; ++q) *(f32x4*)(d + 4 * q) = (f32x4){scr[(4 * q) * 64 + lane], scr[(4 * q + 1) * 64 + lane], scr[(4 * q + 2) * 64 + lane], scr[(4 * q + 3) * 64 + lane]}; }
        else { GAS v4u* d = (GAS v4u*)(WT + (size_t)drow * K + k0);
#pragma unroll
            for (int q = 0; q < 8; ++q) { v4u o; o.x = pk2(scr[(8 * q) * 64 + lane], scr[(8 * q + 1) * 64 + lane]); o.y = pk2(scr[(8 * q + 2) * 64 + lane], scr[(8 * q + 3) * 64 + lane]);
                o.z = pk2(scr[(8 * q + 4) * 64 + lane], scr[(8 * q + 5) * 64 + lane]); o.w = pk2(scr[(8 * q + 6) * 64 + lane], scr[(8 * q + 7) * 64 + lane]); d[q] = o; } } }
    LDS_WAIT(); asm volatile("" ::: "memory");
}
struct SubT { const float* src; unsigned char* dst; int N; int n0; int mode; float scale; };
__device__ __forceinline__ SubT fp8_subtile(int item, int half, const float* wgu, const float* wdn, const float* win, unsigned char* WG8, unsigned char* WD8, unsigned char* WI8, int lane) {
    SubT t; int kb, nb;
    if (item < 64 * 256) { const int le = item >> 8, r = item & 255; kb = r >> 5; nb = r & 31; t.N = 2048; t.mode = 1; t.scale = SC_WGU;
        t.src = wgu + (size_t)le * 1024 * 2048; t.dst = WG8 + (size_t)le * 2048 * 1024; }
    else if (item < 64 * 256 + 64 * 128) { const int it2 = item - 64 * 256; const int le = it2 >> 7, r = it2 & 127; kb = r >> 4; nb = r & 15; t.N = 1024; t.mode = 0; t.scale = SC_WDN;
        t.src = wdn + (size_t)le * 1024 * 1024; t.dst = WD8 + (size_t)le * 1024 * 1024; }
    else { const int it3 = item - (64 * 256 + 64 * 128); const int l = it3 / 192, r = it3 % 192; kb = r / 24; nb = r % 24; t.N = INW; t.mode = 2; t.scale = SC_WIN;
        t.src = win + (size_t)l * 1024 * INW; t.dst = WI8 + (size_t)l * 1536 * 1024; }
    const int k0 = 128 * kb + 64 * half; t.n0 = 64 * nb;
    t.src += (size_t)(k0 + (lane >> 4)) * t.N + t.n0 + 4 * (lane & 15);
    t.dst += (size_t)k0;
    return t;
}
__device__ __forceinline__ void fp8_sub_load(const SubT& t, f32x4 (&ld)[16]) {
#pragma unroll
    for (int i = 0; i < 16; ++i) ld[i] = __builtin_nontemporal_load((const f32x4*)(t.src + (size_t)(4 * i) * t.N));
}
__device__ __forceinline__ void fp8_sub_process(const SubT& t, const f32x4 (&ld)[16], LAS float* scr, int lane) {
#pragma unroll
    for (int i = 0; i < 16; ++i) *(LAS f32x4*)(scr + (4 * i + (lane >> 4)) * 64 + 4 * (lane & 15)) = ld[i];
    LDS_WAIT(); asm volatile("" ::: "memory");
    unsigned w[16];
#pragma unroll
    for (int q = 0; q < 16; ++q) w[q] = pg8::pk4_fp8(scr[(4 * q + 0) * 64 + lane] * t.scale, scr[(4 * q + 1) * 64 + lane] * t.scale, scr[(4 * q + 2) * 64 + lane] * t.scale, scr[(4 * q + 3) * 64 + lane] * t.scale);
    LDS_WAIT(); asm volatile("" ::: "memory");
    LAS unsigned char* t2 = (LAS unsigned char*)scr;
#pragma unroll
    for (int q = 0; q < 4; ++q) *(LAS v4u*)(t2 + lane * 80 + 16 * q) = (v4u){w[4 * q], w[4 * q + 1], w[4 * q + 2], w[4 * q + 3]};
    LDS_WAIT(); asm volatile("" ::: "memory");
#pragma unroll
    for (int q = 0; q < 4; ++q) { const int n = 16 * q + (lane >> 2); const v4u v = *(const LAS v4u*)(t2 + n * 80 + 16 * (lane & 3));
        const int nn = (t.mode == 1) ? wgu_dest_row(t.n0 + n) : (t.mode == 2) ? win_dest_row(t.n0 + n) : (t.n0 + n);
        *(GAS v4u*)(t.dst + (size_t)nn * 1024 + 16 * (lane & 3)) = v; }
    LDS_WAIT(); asm volatile("" ::: "memory");
}
__device__ __forceinline__ void row_dt(const f32x4 (&v)[4], const float* wdt, float* dst, int lane) {
    float r[8];
#pragma unroll
    for (int jj = 0; jj < 8; ++jj) { float s = 0.f;
#pragma unroll
        for (int j = 0; j < 4; ++j) { const f32x4 w = *(const f32x4*)(wdt + jj * 1024 + 4 * lane + 256 * j); s += v[j][0] * w[0] + v[j][1] * w[1] + v[j][2] * w[2] + v[j][3] * w[3]; }
        r[jj] = wave_sum(s); }
    if (lane == 0) { *(f32x4*)dst = (f32x4){r[0], r[1], r[2], r[3]}; *(f32x4*)(dst + 4) = (f32x4){r[4], r[5], r[6], r[7]}; }
}
__device__ __forceinline__ void row_dt_win(const f32x4 (&v)[4], const float* win, float* dst, int lane) {
    float r[8];
#pragma unroll
    for (int jj = 0; jj < 8; ++jj) r[jj] = 0.f;
#pragma unroll
    for (int j = 0; j < 4; ++j)
#pragma unroll
        for (int e = 0; e < 4; ++e) { const float* wp = win + (size_t)(4 * lane + 256 * j + e) * INW + 3072; const f32x4 w0 = *(const f32x4*)wp, w1 = *(const f32x4*)(wp + 4); const float x = v[j][e];
            r[0] += x * w0[0]; r[1] += x * w0[1]; r[2] += x * w0[2]; r[3] += x * w0[3]; r[4] += x * w1[0]; r[5] += x * w1[1]; r[6] += x * w1[2]; r[7] += x * w1[3]; }
#pragma unroll
    for (int jj = 0; jj < 8; ++jj) r[jj] = wave_sum(r[jj]);
    if (lane == 0) { *(f32x4*)dst = (f32x4){r[0], r[1], r[2], r[3]}; *(f32x4*)(dst + 4) = (f32x4){r[4], r[5], r[6], r[7]}; }
}
template <bool W8, bool WF>
__device__ __forceinline__ void ln_row(f32x4 (&v)[4], const float* gam, const float* bet, float* of32, bf16* ob16, unsigned char* o8, float s8, int lane) {
    float s = 0.f;
#pragma unroll
    for (int j = 0; j < 4; ++j) s += (v[j][0] + v[j][1]) + (v[j][2] + v[j][3]);
    const float mean = wave_sum(s) * (1.f / DM); float s2 = 0.f;
#pragma unroll
    for (int j = 0; j < 4; ++j) { v[j] = v[j] - mean; s2 += (v[j][0] * v[j][0] + v[j][1] * v[j][1]) + (v[j][2] * v[j][2] + v[j][3] * v[j][3]); }
    const float rstd = 1.f / sqrtf(wave_sum(s2) * (1.f / DM) + LN_EPS);
#pragma unroll
    for (int j = 0; j < 4; ++j) { const f32x4 g = *(const f32x4*)(gam + 4 * lane + 256 * j), b = *(const f32x4*)(bet + 4 * lane + 256 * j);
        v[j] = v[j] * rstd * g + b;
        if (WF) *(f32x4*)(of32 + 4 * lane + 256 * j) = v[j];
        v2u w; w.x = pk2(v[j][0], v[j][1]); w.y = pk2(v[j][2], v[j][3]); *(v2u*)(ob16 + 4 * lane + 256 * j) = w;
        if (W8) *(unsigned*)(o8 + 4 * lane + 256 * j) = pg8::pk4_fp8(v[j][0] * s8, v[j][1] * s8, v[j][2] * s8, v[j][3] * s8); }
}


typedef short v4i16_t __attribute__((ext_vector_type(4)));
__device__ __forceinline__ bf16x8 tr_pair(const LAS unsigned char* p0, const LAS unsigned char* p1) {
    const v4i16_t a = __builtin_amdgcn_ds_read_tr16_b64_v4i16((LAS v4i16_t*)p0), b = __builtin_amdgcn_ds_read_tr16_b64_v4i16((LAS v4i16_t*)p1);
    return (bf16x8){a[0], a[1], a[2], a[3], b[0], b[1], b[2], b[3]};
}
__device__ __forceinline__ int crow16(int r, int hi) { return (r & 3) + 8 * (r >> 2) + 4 * hi; }
constexpr int AK_PITCH = 144, AV_PITCH = 192, AK_TILE = 32 * AK_PITCH, AV_TILE = 32 * AV_PITCH;
constexpr int AT_K = 0, AT_V = 12 * AK_TILE;
struct AttnItem { int p, b, h, d, r, qt0; };
__device__ __forceinline__ AttnItem attn_item(int I) { AttnItem a; a.p = I >> 10; const int rem = I & 1023; a.b = rem >> 7; a.h = (rem >> 4) & 7; const int grp = rem & 15;
    a.d = (a.p == 0) ? 1 : (a.p == 1) ? 4 : 16; const int tpr = 128 / a.d; const int T = grp * 8; a.r = T / tpr; a.qt0 = T % tpr; return a; }
__device__ __forceinline__ void attn_request(const bf16* PROJ, const AttnItem& a, v4u (&st)[12], int tid) {
    const int rr = tid >> 4, ch = tid & 15; const int col = (ch < 8 ? C_K : C_V - 64) + a.h * 64 + ch * 8;
#pragma unroll
    for (int tl = 0; tl < 12; ++tl) { const int kt = a.qt0 - 4 + tl; st[tl] = (v4u){0u, 0u, 0u, 0u};
        if (kt >= 0) { const size_t row = (size_t)a.b * SEQ + (size_t)(32 * kt + rr) * a.d + a.r; st[tl] = *(const v4u*)(PROJ + row * NPROJ + col); } }
}
__device__ __forceinline__ void attn_deposit(LAS unsigned char* al, const v4u (&st)[12], int tid) {
    const int rr = tid >> 4, ch = tid & 15;
    LAS unsigned char* dst = (ch < 8) ? (al + AT_K + rr * AK_PITCH + ch * 16) : (al + AT_V + rr * AV_PITCH + (ch - 8) * 16); const int tstep = (ch < 8) ? AK_TILE : AV_TILE;
#pragma unroll
    for (int tl = 0; tl < 12; ++tl) *(LAS v4u*)(dst + tl * tstep) = st[tl];
}
__device__ __forceinline__ void attn_wave_compute(const bf16* PROJ, bf16* OPp, float* LSEp, const AttnItem& a, const LAS unsigned char* al, int wave, int lane) {
    const int i = lane & 31, h2 = lane >> 5; const int qt = a.qt0 + wave;
    const size_t rowq = (size_t)a.b * SEQ + (size_t)(32 * qt + i) * a.d + a.r;
    bf16x8 qf[4];
    { const bf16* qp = PROJ + rowq * NPROJ + C_Q + a.h * 64 + 8 * h2;
#pragma unroll
      for (int s = 0; s < 4; ++s) qf[s] = *(const bf16x8*)(qp + 16 * s); }
    f32x16 o0 = {}, o1 = {}; float mrun = -INFINITY, lrun = 0.f;
    const int kt0 = qt > 4 ? qt - 4 : 0;
    const LAS unsigned char* krd = al + AT_K + i * AK_PITCH + 16 * h2;
    const LAS unsigned char* trb = al + AT_V + (4 * h2 + ((lane & 15) >> 2)) * AV_PITCH + (16 * ((lane >> 4) & 1) + 4 * (lane & 3)) * 2;
    f32x16 snext = {};
    { const LAS unsigned char* kp = krd + (kt0 - a.qt0 + 4) * AK_TILE;
#pragma unroll
      for (int s = 0; s < 4; ++s) snext = __builtin_amdgcn_mfma_f32_32x32x16_bf16(*(const LAS bf16x8*)(kp + 32 * s), qf[s], snext, 0, 0, 0); }
#pragma unroll 1
    for (int kt = kt0; kt <= qt; ++kt) {
        const int tl = kt - a.qt0 + 4;
        const LAS unsigned char* vp = trb + tl * AV_TILE;
        f32x16 sacc = snext;
        if (kt < qt) { const LAS unsigned char* kp = krd + (tl + 1) * AK_TILE; snext = (f32x16){};
#pragma unroll
            for (int s = 0; s < 4; ++s) snext = __builtin_amdgcn_mfma_f32_32x32x16_bf16(*(const LAS bf16x8*)(kp + 32 * s), qf[s], snext, 0, 0, 0); }
        if (kt == qt) {
#pragma unroll
            for (int rg = 0; rg < 16; ++rg) if (crow16(rg, h2) > i) sacc[rg] = -INFINITY;
        }
        if (kt + 4 == qt) {
#pragma unroll
            for (int rg = 0; rg < 16; ++rg) if (crow16(rg, h2) < i) sacc[rg] = -INFINITY;
        }
        float mx = sacc[0];
#pragma unroll
        for (int rg = 1; rg < 16; ++rg) mx = fmaxf(mx, sacc[rg]);
        mx = fmaxf(mx, __shfl_xor(mx, 32));
        const float mnew = fmaxf(mrun, mx), alpha = __builtin_amdgcn_exp2f(mrun - mnew); mrun = mnew;
        float ps = 0.f;
#pragma unroll
        for (int rg = 0; rg < 16; ++rg) { sacc[rg] = __builtin_amdgcn_exp2f(sacc[rg] - mnew); ps += sacc[rg]; }
        lrun = lrun * alpha + ps;
#pragma unroll
        for (int rg = 0; rg < 16; ++rg) { o0[rg] *= alpha; o1[rg] *= alpha; }
        bf16x8 pf[2];
#pragma unroll
        for (int ks = 0; ks < 2; ++ks) { v4u w; w.x = pg8::cvt_pk_bf16(sacc[8 * ks + 0], sacc[8 * ks + 1]); w.y = pg8::cvt_pk_bf16(sacc[8 * ks + 2], sacc[8 * ks + 3]); w.z = pg8::cvt_pk_bf16(sacc[8 * ks + 4], sacc[8 * ks + 5]); w.w = pg8::cvt_pk_bf16(sacc[8 * ks + 6], sacc[8 * ks + 7]); pf[ks] = __builtin_bit_cast(bf16x8, w); }
#pragma unroll
        for (int ks = 0; ks < 2; ++ks) {
            const bf16x8 v0 = tr_pair(vp + (16 * ks) * AV_PITCH, vp + (16 * ks + 8) * AV_PITCH);
            const bf16x8 v1 = tr_pair(vp + (16 * ks) * AV_PITCH + 64, vp + (16 * ks + 8) * AV_PITCH + 64);
            o0 = __builtin_amdgcn_mfma_f32_32x32x16_bf16(v0, pf[ks], o0, 0, 0, 0);
            o1 = __builtin_amdgcn_mfma_f32_32x32x16_bf16(v1, pf[ks], o1, 0, 0, 0);
        }
    }
    const float lt = lrun + __shfl_xor(lrun, 32); const float il = 1.0f / lt;
    unsigned char* op = (unsigned char*)OPp + rowq * 512 + a.h * 64 + 4 * h2;
    const float ils = il * SC_O;
#pragma unroll
    for (int g4 = 0; g4 < 4; ++g4) {
        *(unsigned*)(op + 8 * g4) = pg8::pk4_fp8(o0[4 * g4 + 0] * ils, o0[4 * g4 + 1] * ils, o0[4 * g4 + 2] * ils, o0[4 * g4 + 3] * ils);
        *(unsigned*)(op + 32 + 8 * g4) = pg8::pk4_fp8(o1[4 * g4 + 0] * ils, o1[4 * g4 + 1] * ils, o1[4 * g4 + 2] * ils, o1[4 * g4 + 3] * ils); }
    if (h2 == 0) LSEp[rowq * 8 + a.h] = mrun + log2f(lt);
}
__device__ __forceinline__ void attn_phase(LAS unsigned char* al, const bf16* PROJ, bf16* OP, float* LSE, int bid, int G, int tid, int wave, int lane) {
    v4u st[12];
    int I = bid;
    if (I < 3072) { const AttnItem a = attn_item(I); attn_request(PROJ, a, st, tid); }
    for (; I < 3072; I += G) {
        const AttnItem a = attn_item(I);
        __syncthreads();
        attn_deposit(al, st, tid);
        __syncthreads();
        if (I + G < 3072) { const AttnItem n = attn_item(I + G); attn_request(PROJ, n, st, tid); }
        attn_wave_compute(PROJ, (bf16*)((unsigned char*)OP + (size_t)a.p * MROWS * 512), LSE + (size_t)a.p * MROWS * 8, a, al, wave, lane);
    }
    __syncthreads();
}

constexpr int SS_DTS = 0, SS_ACUM = 2048, SS_TMP = 4096, SS_SSX = 6144, SS_IMG = 8192;
constexpr int S1_PB = 320, S1_PX = 576;
constexpr int S1_B = SS_IMG, S1_X = SS_IMG + 128 * S1_PB;
constexpr int S3_PBC = 272, S3_PX = 576;
constexpr int S3_B = SS_IMG, S3_C = S3_B + 128 * S3_PBC, S3_X = S3_C + 128 * S3_PBC;

__device__ __forceinline__ void ssd_prep(LAS unsigned char* sl, const float* DT, const float* dtb, const float* alog, size_t row0, int g, int tid, int lane, int wave) {
    LAS float* dts = (LAS float*)(sl + SS_DTS); LAS float* acum = (LAS float*)(sl + SS_ACUM); LAS float* tmp = (LAS float*)(sl + SS_TMP);
    { const int l = tid >> 2, hq = tid & 3; const float x = DT[(row0 + l) * 8 + 4 * g + hq] + dtb[4 * g + hq];
      const float dt = x > 20.f ? x : log1pf(__expf(x)); dts[hq * 128 + l] = dt; tmp[hq * 128 + l] = dt * (-__expf(alog[4 * g + hq])); }
    __syncthreads();
    if (wave < 4) { const float v0 = tmp[wave * 128 + 2 * lane], v1 = tmp[wave * 128 + 2 * lane + 1]; float s = v0 + v1;
#pragma unroll
        for (int off = 1; off < 64; off <<= 1) { const float t = __shfl_up(s, off); if (lane >= off) s += t; }
        acum[wave * 128 + 2 * lane] = s - v1; acum[wave * 128 + 2 * lane + 1] = s; }
    __syncthreads();
}
template <int NCOLS, int FACMODE>
__device__ __forceinline__ void conv_tile(const bf16* PROJ, size_t row0, int t0, int pcol0, const float* cw, const float* cb, int cch0, LAS unsigned char* dst, int pitch, const LAS unsigned char* sl, int hq0, int tid) {
    constexpr int NCH8 = NCOLS / 8, NSEG = 512 / NCH8, RPS = 128 / NSEG;
    const int c8 = tid % NCH8, seg = tid / NCH8, l0 = seg * RPS;
    float w[4][8], bias[8], hst[3][8];
#pragma unroll
    for (int k = 0; k < 4; ++k) { const f32x4 a = *(const f32x4*)(cw + k * 1024 + cch0 + c8 * 8), b = *(const f32x4*)(cw + k * 1024 + cch0 + c8 * 8 + 4);
        w[k][0] = a[0]; w[k][1] = a[1]; w[k][2] = a[2]; w[k][3] = a[3]; w[k][4] = b[0]; w[k][5] = b[1]; w[k][6] = b[2]; w[k][7] = b[3]; }
    { const f32x4 a = *(const f32x4*)(cb + cch0 + c8 * 8), b = *(const f32x4*)(cb + cch0 + c8 * 8 + 4);
      bias[0] = a[0]; bias[1] = a[1]; bias[2] = a[2]; bias[3] = a[3]; bias[4] = b[0]; bias[5] = b[1]; bias[6] = b[2]; bias[7] = b[3]; }
    const bf16* src = PROJ + pcol0 + c8 * 8;
#pragma unroll
    for (int k = 0; k < 3; ++k) { const int l = l0 - 3 + k; v4u v = (v4u){0u, 0u, 0u, 0u}; if (t0 + l >= 0) v = *(const v4u*)(src + (size_t)((long)row0 + l) * NPROJ);
        hst[k][0] = bflo(v.x); hst[k][1] = bfhi(v.x); hst[k][2] = bflo(v.y); hst[k][3] = bfhi(v.y); hst[k][4] = bflo(v.z); hst[k][5] = bfhi(v.z); hst[k][6] = bflo(v.w); hst[k][7] = bfhi(v.w); }
    const LAS float* dts = (const LAS float*)(sl + SS_DTS); const LAS float* acum = (const LAS float*)(sl + SS_ACUM);
    const int hq = hq0 + (c8 * 8) / 64;
    const float alast = (FACMODE == 2) ? acum[hq * 128 + 127] : 0.f;
#pragma unroll
    for (int rr = 0; rr < RPS; ++rr) { const int l = l0 + rr; const v4u v = *(const v4u*)(src + (row0 + l) * NPROJ);
        float cur[8]; cur[0] = bflo(v.x); cur[1] = bfhi(v.x); cur[2] = bflo(v.y); cur[3] = bfhi(v.y); cur[4] = bflo(v.z); cur[5] = bfhi(v.z); cur[6] = bflo(v.w); cur[7] = bfhi(v.w);
        float f = 1.f; if (FACMODE >= 1) f = dts[hq * 128 + l]; if (FACMODE == 2) f *= __expf(alast - acum[hq * 128 + l]);
        float o[8];
#pragma unroll
        for (int e = 0; e < 8; ++e) { const float a = bias[e] + w[0][e] * hst[0][e] + w[1][e] * hst[1][e] + w[2][e] * hst[2][e] + w[3][e] * cur[e]; o[e] = siluf(a) * f;
            hst[0][e] = hst[1][e]; hst[1][e] = hst[2][e]; hst[2][e] = cur[e]; }
        v4u ov; ov.x = pk2(o[0], o[1]); ov.y = pk2(o[2], o[3]); ov.z = pk2(o[4], o[5]); ov.w = pk2(o[6], o[7]);
        *(LAS v4u*)(dst + l * pitch + c8 * 16) = ov; }
}
__device__ __forceinline__ void ssd_s1_unit(LAS unsigned char* sl, const bf16* PROJ, const float* DT, const float* dtb, const float* alog, const float* cw, const float* cb, float* ST, float* CDEC, int un, int tid, int lane, int wave) {
    const int g = un & 1, bc = un >> 1; const size_t row0 = (size_t)bc * 128; const int t0 = (bc & 31) * 128;
    __syncthreads();
    ssd_prep(sl, DT, dtb, alog, row0, g, tid, lane, wave);
    conv_tile<128, 0>(PROJ, row0, t0, C_XS + 512 + g * 128, cw, cb, 512 + g * 128, sl + S1_B, S1_PB, sl, 0, tid);
    conv_tile<256, 2>(PROJ, row0, t0, C_XS + g * 256, cw, cb, g * 256, sl + S1_X, S1_PX, sl, 0, tid);
    if (tid < 4) CDEC[(size_t)bc * 8 + 4 * g + tid] = __expf(((const LAS float*)(sl + SS_ACUM))[tid * 128 + 127]);
    __syncthreads();
    const int hq = wave >> 1, pt = wave & 1, h2 = lane >> 5, q = (lane & 15) >> 2, pp = lane & 3, dsel = (lane >> 4) & 1;
    const LAS unsigned char* xb = sl + S1_X + (8 * h2 + q) * S1_PX + (hq * 64 + pt * 32 + 16 * dsel + 4 * pp) * 2;
    const LAS unsigned char* bb = sl + S1_B + (8 * h2 + q) * S1_PB + (16 * dsel + 4 * pp) * 2;
    f32x16 acc[4];
#pragma unroll
    for (int nt = 0; nt < 4; ++nt) acc[nt] = (f32x16){};
#pragma unroll
    for (int ks = 0; ks < 8; ++ks) { const bf16x8 a = tr_pair(xb + (16 * ks) * S1_PX, xb + (16 * ks + 4) * S1_PX);
#pragma unroll
        for (int nt = 0; nt < 4; ++nt) { const bf16x8 b = tr_pair(bb + (16 * ks) * S1_PB + nt * 64, bb + (16 * ks + 4) * S1_PB + nt * 64); acc[nt] = __builtin_amdgcn_mfma_f32_32x32x16_bf16(a, b, acc[nt], 0, 0, 0); } }
    float* sp = ST + ((size_t)(bc * 8 + 4 * g + hq) * 64 + pt * 32) * 128 + (lane & 31);
#pragma unroll
    for (int nt = 0; nt < 4; ++nt)
#pragma unroll
        for (int rg = 0; rg < 16; ++rg) sp[(size_t)crow16(rg, h2) * 128 + 32 * nt] = acc[nt][rg];
}
__device__ __forceinline__ void ssd_s3_unit(LAS unsigned char* sl, const bf16* PROJ, const float* DT, const float* dtb, const float* alog, const float* cw, const float* cb, const float* dsk, const float* ng,
                                            const bf16* HIN, bf16* MIXED, int un, int tid, int lane, int wave) {
    const int g = un & 1, bc = un >> 1; const size_t row0 = (size_t)bc * 128; const int t0 = (bc & 31) * 128;
    const int lt = wave & 3, ph = wave >> 2, lq = lane & 31, hi = lane >> 5, q = (lane & 15) >> 2, pp = lane & 3, dsel = (lane >> 4) & 1;
    const int lrow = 32 * lt + lq;
    const size_t grow = row0 + lrow;
    __syncthreads();
    ssd_prep(sl, DT, dtb, alog, row0, g, tid, lane, wave);
    conv_tile<128, 0>(PROJ, row0, t0, C_XS + 512 + g * 128, cw, cb, 512 + g * 128, sl + S3_B, S3_PBC, sl, 0, tid);
    conv_tile<128, 0>(PROJ, row0, t0, C_XS + 768 + g * 128, cw, cb, 768 + g * 128, sl + S3_C, S3_PBC, sl, 0, tid);
    conv_tile<256, 1>(PROJ, row0, t0, C_XS + g * 256, cw, cb, g * 256, sl + S3_X, S3_PX, sl, 0, tid);
    __syncthreads();
    const LAS float* dts = (const LAS float*)(sl + SS_DTS); const LAS float* acum = (const LAS float*)(sl + SS_ACUM); LAS float* ssx = (LAS float*)(sl + SS_SSX);
    const LAS unsigned char* crd = sl + S3_C + lrow * S3_PBC + 16 * hi;
    f32x16 y[4];
    { bf16x8 hfa[8], hfb[8];
      const bf16* hp0 = HIN + ((size_t)(bc * 8 + 4 * g) * 64 + ph * 32 + lq) * 128 + 8 * hi;
#pragma unroll
      for (int ks = 0; ks < 8; ++ks) hfa[ks] = *(const bf16x8*)(hp0 + 16 * ks);
#pragma unroll
      for (int hq = 0; hq < 4; ++hq) {
          if (hq < 3) {
#pragma unroll
              for (int ks = 0; ks < 8; ++ks) { const bf16x8 v = *(const bf16x8*)(hp0 + (size_t)(hq + 1) * 8192 + 16 * ks); if (hq & 1) hfa[ks] = v; else hfb[ks] = v; } }
          f32x16 t = (f32x16){};
#pragma unroll
          for (int ks = 0; ks < 8; ++ks) t = __builtin_amdgcn_mfma_f32_32x32x16_bf16((hq & 1) ? hfb[ks] : hfa[ks], *(const LAS bf16x8*)(crd + 32 * ks), t, 0, 0, 0);
          const float ea = __expf(acum[hq * 128 + lrow]);
#pragma unroll
          for (int rg = 0; rg < 16; ++rg) t[rg] *= ea;
          y[hq] = t; } }
    v2u zr[4][4];
#pragma unroll
    for (int hq = 0; hq < 4; ++hq)
#pragma unroll
        for (int g4 = 0; g4 < 4; ++g4) zr[hq][g4] = *(const v2u*)(PROJ + grow * NPROJ + C_Z + g * 256 + hq * 64 + ph * 32 + 8 * g4 + 4 * hi);
#pragma unroll
    for (int st = 0; st < 4; ++st) if (st <= lt) {
        f32x16 ag = (f32x16){};
        { const LAS unsigned char* brd = sl + S3_B + (32 * st + lq) * S3_PBC + 16 * hi;
#pragma unroll
          for (int ks = 0; ks < 8; ++ks) ag = __builtin_amdgcn_mfma_f32_32x32x16_bf16(*(const LAS bf16x8*)(brd + 32 * ks), *(const LAS bf16x8*)(crd + 32 * ks), ag, 0, 0, 0); }
#pragma unroll
        for (int hq = 0; hq < 4; ++hq) {
            const float al = acum[hq * 128 + lrow], dd = dsk[4 * g + hq] / dts[hq * 128 + lrow];
            const LAS unsigned char* xb = sl + S3_X + (4 * hi + q) * S3_PX + (hq * 64 + ph * 32 + 16 * dsel + 4 * pp) * 2;
            float pm[16];
#pragma unroll
            for (int g4 = 0; g4 < 4; ++g4) { const f32x4 as4 = *(const LAS f32x4*)(acum + hq * 128 + 32 * st + 8 * g4 + 4 * hi);
#pragma unroll
                for (int e = 0; e < 4; ++e) { const int rg = 4 * g4 + e; float v = ag[rg] * __expf(al - as4[e]);
                    if (st == lt) { const int sl_ = 8 * g4 + 4 * hi + e; if (sl_ > lq) v = 0.f; if (sl_ == lq) v += dd; }
                    pm[rg] = v; } }
#pragma unroll
            for (int ks = 0; ks < 2; ++ks) { v4u wv; wv.x = pg8::cvt_pk_bf16(pm[8 * ks + 0], pm[8 * ks + 1]); wv.y = pg8::cvt_pk_bf16(pm[8 * ks + 2], pm[8 * ks + 3]); wv.z = pg8::cvt_pk_bf16(pm[8 * ks + 4], pm[8 * ks + 5]); wv.w = pg8::cvt_pk_bf16(pm[8 * ks + 6], pm[8 * ks + 7]);
                const bf16x8 xt = tr_pair(xb + (32 * st + 16 * ks) * S3_PX, xb + (32 * st + 16 * ks + 8) * S3_PX);
                y[hq] = __builtin_amdgcn_mfma_f32_32x32x16_bf16(xt, __builtin_bit_cast(bf16x8, wv), y[hq], 0, 0, 0); }
        }
    }
    unsigned ayp[4][8]; float ss = 0.f;
#pragma unroll
    for (int hq = 0; hq < 4; ++hq)
#pragma unroll
        for (int g4 = 0; g4 < 4; ++g4) { const v2u z = zr[hq][g4];
            const float y0 = y[hq][4 * g4 + 0] * siluf(bflo(z.x)), y1 = y[hq][4 * g4 + 1] * siluf(bfhi(z.x)), y2 = y[hq][4 * g4 + 2] * siluf(bflo(z.y)), y3 = y[hq][4 * g4 + 3] * siluf(bfhi(z.y));
            ss += (y0 * y0 + y1 * y1) + (y2 * y2 + y3 * y3);
            ayp[hq][2 * g4] = pg8::cvt_pk_bf16(y0, y1); ayp[hq][2 * g4 + 1] = pg8::cvt_pk_bf16(y2, y3); }
    ss += __shfl_xor(ss, 32);
    if (hi == 0) ssx[ph * 128 + lrow] = ss;
    __syncthreads();
    const float rs = 1.0f / sqrtf((ssx[lrow] + ssx[128 + lrow]) * (1.f / 256.f) + RMS_EPS);
#pragma unroll
    for (int hq = 0; hq < 4; ++hq)
#pragma unroll
        for (int g4 = 0; g4 < 4; ++g4) { const int ch = hq * 64 + ph * 32 + 8 * g4 + 4 * hi; const f32x4 gn = *(const f32x4*)(ng + g * 256 + ch);
            const unsigned p0 = ayp[hq][2 * g4], p1 = ayp[hq][2 * g4 + 1];
            v2u o; o.x = pg8::cvt_pk_bf16(bflo(p0) * rs * gn[0], bfhi(p0) * rs * gn[1]); o.y = pg8::cvt_pk_bf16(bflo(p1) * rs * gn[2], bfhi(p1) * rs * gn[3]);
            *(v2u*)(MIXED + grow * MIXW + 512 + g * 256 + ch) = o; }
}

struct Args { const float* in[20]; float* out; unsigned char* ws; int ph_lo, ph_hi, sub, pad; };
constexpr int NWAVES = 8;
constexpr int PH_PER_LAYER = 10, N_PHASES = 1 + NLAYER * PH_PER_LAYER;

#define in_x (args.in[0])
#define in_win (args.in[1])
#define in_convw (args.in[2])
#define in_convb (args.in[3])
#define in_dtb (args.in[4])
#define in_alog (args.in[5])
#define in_dsk (args.in[6])
#define in_ng (args.in[7])
#define in_scw (args.in[8])
#define in_wout (args.in[9])
#define in_ln1g (args.in[10])
#define in_ln1b (args.in[11])
#define in_rw (args.in[12])
#define in_rb (args.in[13])
#define in_wgu (args.in[14])
#define in_bgu (args.in[15])
#define in_wdn (args.in[16])
#define in_bdn (args.in[17])
#define in_ln2g (args.in[18])
#define in_ln2b (args.in[19])
#define ROPE ((float*)(args.ws + WS_ROPE))
#define WDT ((float*)(args.ws + WS_WDT))
#define ROUT ((bf16*)(args.ws + WS_ROUT))
#define WIN ((bf16*)(args.ws + WS_WIN))
#define WOUT ((bf16*)(args.ws + WS_WOUT))
#define WGU ((bf16*)(args.ws + WS_WGU))
#define WDN ((bf16*)(args.ws + WS_WDN))
#define XB ((bf16*)(args.ws + WS_XB))
#define XF ((float*)(args.ws + WS_XF))
#define XF2 ((float*)(args.ws + WS_XF2))
#define PROJ ((bf16*)(args.ws + WS_PROJ))
#define DT ((float*)(args.ws + WS_DT))
#define DTS ((float*)(args.ws + WS_DTS))
#define ACUM ((float*)(args.ws + WS_ACUM))
#define LSE ((float*)(args.ws + WS_LSE))
#define OP ((bf16*)(args.ws + WS_OP))
#define U ((bf16*)(args.ws + WS_U))
#define GB ((float*)(args.ws + WS_G))
#define ST ((float*)(args.ws + WS_ST))
#define YD ((float*)(args.ws + WS_YD))
#define MIXED ((bf16*)(args.ws + WS_MIXED))
#define MIXF ((bf16*)(args.ws + WS_MIXF))
#define TOPE ((int*)(args.ws + WS_TOPE))
#define TOPG ((float*)(args.ws + WS_TOPG))
#define ROWTOK ((int*)(args.ws + WS_ROWTOK))
#define ROWGATE ((float*)(args.ws + WS_ROWGATE))
#define HB ((bf16*)(args.ws + WS_H))
#define YB ((bf16*)(args.ws + WS_YB))
#define HIN ((bf16*)(args.ws + WS_G))
#define WGU8 ((unsigned char*)(args.ws + WS_WGU))
#define WDN8 ((unsigned char*)(args.ws + WS_WDN))
#define XB8 ((unsigned char*)(args.ws + WS_U))
#define H8 ((unsigned char*)(args.ws + WS_H))
#define YB8 ((unsigned char*)(args.ws + WS_YB))
#define WIN8 ((unsigned char*)(args.ws + WS_WGU + 128 * MiB))
#define XP8 ((unsigned char*)(args.ws + WS_WGU + 132 * MiB))
#define CDEC ((float*)(args.ws + WS_ACUM))
template <int layer>
__device__ __forceinline__ void run_layer(const Args& args, int lo, int hi, const XcdBarrier& bar) {
    extern __shared__ __attribute__((aligned(16))) unsigned char lds[];
    LAS unsigned char* ldsp = (LAS unsigned char*)lds;
    const int tid = threadIdx.x, lane = tid & 63, wave = __builtin_amdgcn_readfirstlane(tid >> 6);
    const int G = gridDim.x, bid = blockIdx.x;
    const int gw = bid * NWAVES + wave, NGW = G * NWAVES;
    gu32* ctl = (gu32*)(args.ws + WS_CTL);

#define IN(k) (lo <= (k) && (k) < hi)
#define SEAM(k) do { if (IN(k) && IN((k) + 1)) xcd_barrier(bar); } while (0)

        const int pb = 1 + layer * PH_PER_LAYER;
        const bf16* WINl = WIN + (size_t)layer * NPROJ * DM; const bf16* WOUTl = WOUT + (size_t)layer * DM * MIXW;
        const unsigned char* WGUl = WGU8 + (size_t)layer * NEXP * 2048 * DM; const unsigned char* WDNl = WDN8 + (size_t)layer * NEXP * DM * FF;
        gu32* gcnt = ctl + CW_CNT + 64 * layer;

        if (IN(pb + 0)) {
            if (layer == 0) {
                for (int m = gw; m < MROWS; m += NGW) { const bf16* xr = XB + (size_t)m * DM; f32x4 v[4];
#pragma unroll
                    for (int j = 0; j < 4; ++j) { const v2u a = *(const v2u*)(xr + 4 * lane + 256 * j); v[j] = (f32x4){bflo(a.x), bfhi(a.x), bflo(a.y), bfhi(a.y)}; }
                    row_dt(v, WDT, DT + (size_t)m * 8, lane); }
            }
            {
              pg8::Gemm g{(const pg8::bf16_t*)XP8, (const pg8::bf16_t*)(WIN8 + (size_t)layer * 1536 * DM), MROWS, 1536, DM / 2}; pg8::StaticOrder S; S.init(MROWS, 1536, G, bid);
              pg8::EpiProj E{PROJ, NPROJ, ROPE, QSCALE, 1.0f / (SC_X * SC_WIN), 0};
              pg8::gemm_phase<pg8::EpiProj, pg8::StaticOrder, true, false, true>(ldsp + RING_OFF, g, S, E); }
            __syncthreads();
            { pg8::Gemm g{XB, WINl + (size_t)1536 * DM, MROWS, NPROJ - 1536, DM}; pg8::StaticOrder S; S.init(MROWS, NPROJ - 1536, G, bid);
              pg8::EpiProj E{PROJ, NPROJ, ROPE, QSCALE, 1.0f, 6};
              pg8::gemm_phase<pg8::EpiProj, pg8::StaticOrder, true, false>(ldsp + RING_OFF, g, S, E); }
        }
        SEAM(pb + 0);
        if (IN(pb + 1)) {
            if (args.sub & 1) attn_phase(ldsp + RING_OFF, PROJ, OP, LSE, bid, G, tid, wave, lane);
            if (args.sub & 2) { const float* cw = in_convw + (size_t)layer * 4 * 1024; const float* cb = in_convb + (size_t)layer * 1024;
              for (int un = bid; un < 512; un += G)
                  ssd_s1_unit(ldsp + RING_OFF, PROJ, DT, in_dtb + layer * 8, in_alog + layer * 8, cw, cb, ST, CDEC, un, tid, lane, wave);
              __syncthreads(); }
            const float* sw = in_scw + (size_t)layer * 3 * 512;
            if (args.sub & 4)
#pragma unroll 2
            for (int it = bid * (NWAVES * 64) + tid; it < (int)((long)MROWS * 64); it += G * (NWAVES * 64)) { const int c8 = (int)(it & 63), row = (int)(it >> 6), t = row & (SEQ - 1); const int ch = c8 * 8;
                float a[8];
#pragma unroll
                for (int q = 0; q < 8; ++q) a[q] = 0.f;
#pragma unroll
                for (int k = 0; k < 3; ++k) { const int tt = t - 2 + k; if (tt >= 0) { const bf16* pr = PROJ + (size_t)(row - 2 + k) * NPROJ; const v4u cc = *(const v4u*)(pr + C_SC + ch), hh = *(const v4u*)(pr + C_SH + ch);
                    const f32x4 w0 = *(const f32x4*)(sw + k * 512 + ch), w1 = *(const f32x4*)(sw + k * 512 + ch + 4);
                    a[0] += w0[0] * bflo(cc.x) * bflo(hh.x); a[1] += w0[1] * bfhi(cc.x) * bfhi(hh.x); a[2] += w0[2] * bflo(cc.y) * bflo(hh.y); a[3] += w0[3] * bfhi(cc.y) * bfhi(hh.y);
                    a[4] += w1[0] * bflo(cc.z) * bflo(hh.z); a[5] += w1[1] * bfhi(cc.z) * bfhi(hh.z); a[6] += w1[2] * bflo(cc.w) * bflo(hh.w); a[7] += w1[3] * bfhi(cc.w) * bfhi(hh.w); } }
                const v4u bb = *(const v4u*)(PROJ + (size_t)row * NPROJ + C_SB + ch);
                v4u o; o.x = pk2(a[0] * bflo(bb.x), a[1] * bfhi(bb.x)); o.y = pk2(a[2] * bflo(bb.y), a[3] * bfhi(bb.y)); o.z = pk2(a[4] * bflo(bb.z), a[5] * bfhi(bb.z)); o.w = pk2(a[6] * bflo(bb.w), a[7] * bfhi(bb.w));
                *(v4u*)(MIXED + (size_t)row * MIXW + 1024 + ch) = o; }
        }
        SEAM(pb + 1);
        if (IN(pb + 2)) {
            for (int it = bid * (NWAVES * 64) + tid; it < (int)(64L * 2048); it += G * (NWAVES * 64)) { const int pn4 = (int)(it & 2047), bh = (int)(it >> 11); const int h = bh & 7, b = bh >> 3; f32x4 hc = (f32x4){0.f, 0.f, 0.f, 0.f};
#pragma unroll 16
                for (int c = 0; c < 32; ++c) { const size_t idx = ((size_t)((b * 32 + c) * 8 + h)) * 8192 + pn4 * 4; const f32x4 st = *(const f32x4*)(ST + idx);
                    v2u o; o.x = pk2(hc[0], hc[1]); o.y = pk2(hc[2], hc[3]); *(v2u*)(HIN + idx) = o;
                    hc = hc * CDEC[(size_t)(b * 32 + c) * 8 + h] + st; } }
        }
        SEAM(pb + 2);
        if (IN(pb + 3)) {
            if (args.sub & 1) { const float* cw = in_convw + (size_t)layer * 4 * 1024; const float* cb = in_convb + (size_t)layer * 1024;
              for (int un = bid; un < 512; un += G)
                  ssd_s3_unit(ldsp + RING_OFF, PROJ, DT, in_dtb + layer * 8, in_alog + layer * 8, cw, cb, in_dsk + layer * 8, in_ng + (size_t)layer * 512, HIN, MIXED, un, tid, lane, wave);
              __syncthreads(); }
            if (args.sub & 2)
#pragma unroll 2
            for (int it = bid * (NWAVES * 64) + tid; it < (int)((long)MROWS * 64); it += G * (NWAVES * 64)) { const int c8 = (int)(it & 63), row = (int)(it >> 6); const int h = c8 >> 3;
                const float l0 = LSE[((size_t)0 * MROWS + row) * 8 + h], l1 = LSE[((size_t)1 * MROWS + row) * 8 + h], l2 = LSE[((size_t)2 * MROWS + row) * 8 + h];
                const float mm = fmaxf(l0, fmaxf(l1, l2)); float w0 = exp2f(l0 - mm), w1 = exp2f(l1 - mm), w2 = exp2f(l2 - mm); const float iw = 1.0f / (w0 + w1 + w2); w0 *= iw; w1 *= iw; w2 *= iw;
                const unsigned char* OP8 = (const unsigned char*)OP; typedef float f32x2_ __attribute__((ext_vector_type(2)));
                const v2u a0 = *(const v2u*)(OP8 + ((size_t)0 * MROWS + row) * 512 + c8 * 8), a1 = *(const v2u*)(OP8 + ((size_t)1 * MROWS + row) * 512 + c8 * 8), a2 = *(const v2u*)(OP8 + ((size_t)2 * MROWS + row) * 512 + c8 * 8);
                w0 *= (1.0f / SC_O); w1 *= (1.0f / SC_O); w2 *= (1.0f / SC_O);
                v4u o;
                { const f32x2_ p0 = __builtin_amdgcn_cvt_pk_f32_fp8(a0.x, false), p1 = __builtin_amdgcn_cvt_pk_f32_fp8(a1.x, false), p2 = __builtin_amdgcn_cvt_pk_f32_fp8(a2.x, false); o.x = pk2(w0 * p0[0] + w1 * p1[0] + w2 * p2[0], w0 * p0[1] + w1 * p1[1] + w2 * p2[1]); }
                { const f32x2_ p0 = __builtin_amdgcn_cvt_pk_f32_fp8(a0.x, true), p1 = __builtin_amdgcn_cvt_pk_f32_fp8(a1.x, true), p2 = __builtin_amdgcn_cvt_pk_f32_fp8(a2.x, true); o.y = pk2(w0 * p0[0] + w1 * p1[0] + w2 * p2[0], w0 * p0[1] + w1 * p1[1] + w2 * p2[1]); }
                { const f32x2_ p0 = __builtin_amdgcn_cvt_pk_f32_fp8(a0.y, false), p1 = __builtin_amdgcn_cvt_pk_f32_fp8(a1.y, false), p2 = __builtin_amdgcn_cvt_pk_f32_fp8(a2.y, false); o.z = pk2(w0 * p0[0] + w1 * p1[0] + w2 * p2[0], w0 * p0[1] + w1 * p1[1] + w2 * p2[1]); }
                { const f32x2_ p0 = __builtin_amdgcn_cvt_pk_f32_fp8(a0.y, true), p1 = __builtin_amdgcn_cvt_pk_f32_fp8(a1.y, true), p2 = __builtin_amdgcn_cvt_pk_f32_fp8(a2.y, true); o.w = pk2(w0 * p0[0] + w1 * p1[0] + w2 * p2[0], w0 * p0[1] + w1 * p1[1] + w2 * p2[1]); }
                *(v4u*)(MIXED + (size_t)row * MIXW + c8 * 8) = o; }
        }
        SEAM(pb + 3);
        if (IN(pb + 4)) {
#define FUSED_LN1_CALL(BASE, LIM) { pg8::Gemm g{MIXED, WOUTl, MROWS, DM, MIXW}; \
              pg8::EpiLn1 E{args.ws, in_ln1g + (size_t)layer * DM, in_ln1b + (size_t)layer * DM, WS_XB, WS_U, (layer ? WS_ROPE : WS_DTS), WS_CTL + (size_t)(CW_SEAM + layer * 8192) * 4, WS_CTL + (size_t)CW_TMO * 4, ALPHA, SC_X, LN_EPS, 0x700u + (unsigned)layer * 0x80u}; \
              pg8::StaticOrder S; S.init(MROWS, DM, G, bid); S.base = (BASE); S.lim = (LIM); \
              pg8::gemm_phase<pg8::EpiLn1, pg8::StaticOrder, false, false>(ldsp + RING_OFF, g, S, E); }
            FUSED_LN1_CALL(0, 256)
            __syncthreads();
            FUSED_LN1_CALL(256, 512)
            __syncthreads();
#undef FUSED_LN1_CALL
        }
        SEAM(pb + 4);
        if (IN(pb + 6)) {
            LAS int* lcnt = (LAS int*)(ldsp + L_LCNT); LAS int* lbase = (LAS int*)(ldsp + L_LBASE);
            const bf16* RT = ROUT + (size_t)layer * NEXP * DM; const float* rb = in_rb + (size_t)layer * NEXP;
            for (int blk = bid; blk < MROWS / 128; blk += G) {
                if (tid < 32) lcnt[tid] = 0;
                __syncthreads();
                const int r32 = lane & 31, hi = lane >> 5; const int row = blk * 128 + (wave & 3) * 32 + r32;
                float tv[4]; int te[4]; int lrank[4]; float gate[4];
                f32x16 acc = {};
                { const int kh = wave >> 2;
                  const bf16* ap = RT + (size_t)r32 * DM + 8 * hi + 512 * kh; const bf16* bp = XB + (size_t)row * DM + 8 * hi + 512 * kh;
#pragma unroll 16
                  for (int s = 0; s < 32; ++s) { const bf16x8 a = *(const bf16x8*)(ap + 16 * s), b = *(const bf16x8*)(bp + 16 * s); acc = __builtin_amdgcn_mfma_f32_32x32x16_bf16(a, b, acc, 0, 0, 0); }
                  LAS float* part = (LAS float*)(ldsp + RING_OFF) + (wave & 3) * 1024;
                  if (kh) {
#pragma unroll
                      for (int i = 0; i < 16; ++i) part[i * 64 + lane] = acc[i]; }
                  __syncthreads();
                  if (!kh) {
#pragma unroll
                      for (int i = 0; i < 16; ++i) acc[i] += part[i * 64 + lane]; } }
                if (wave < 4) {
#pragma unroll
                    for (int k = 0; k < 4; ++k) { tv[k] = -INFINITY; te[k] = 1 << 20; }
#pragma unroll
                    for (int i = 0; i < 16; ++i) { const int e = (i & 3) + 8 * (i >> 2) + 4 * hi; float v = acc[i] + rb[e]; int ve = e;
#pragma unroll
                        for (int k = 0; k < 4; ++k) { const bool gt = (v > tv[k]) || (v == tv[k] && ve < te[k]); const float nv = gt ? tv[k] : v; const int ne = gt ? te[k] : ve; tv[k] = gt ? v : tv[k]; te[k] = gt ? ve : te[k]; v = nv; ve = ne; } }
                    float pv[4]; int pe[4];
#pragma unroll
                    for (int k = 0; k < 4; ++k) { pv[k] = __shfl_xor(tv[k], 32); pe[k] = __shfl_xor(te[k], 32); }
#pragma unroll
                    for (int j = 0; j < 4; ++j) { float v = pv[j]; int ve = pe[j];
#pragma unroll
                        for (int k = 0; k < 4; ++k) { const bool gt = (v > tv[k]) || (v == tv[k] && ve < te[k]); const float nv = gt ? tv[k] : v; const int ne = gt ? te[k] : ve; tv[k] = gt ? v : tv[k]; te[k] = gt ? ve : te[k]; v = nv; ve = ne; } }
                    float se = 0.f;
#pragma unroll
                    for (int k = 0; k < 4; ++k) { gate[k] = __expf(tv[k] - tv[0]); se += gate[k]; }
                    const float ise = 1.0f / se;
#pragma unroll
                    for (int k = 0; k < 4; ++k) gate[k] *= ise;
                    if (hi == 0) {
#pragma unroll
                        for (int k = 0; k < 4; ++k) lrank[k] = __hip_atomic_fetch_add(lcnt + te[k], 1, __ATOMIC_RELAXED, __HIP_MEMORY_SCOPE_WORKGROUP);
                    }
                }
                __syncthreads();
                if (tid < 32) lbase[tid] = (int)__hip_atomic_fetch_add(gcnt + tid, (unsigned)lcnt[tid], RLX_AGENT);
                __syncthreads();
                if (wave < 4 && hi == 0) {
#pragma unroll
                    for (int k = 0; k < 4; ++k) { const int r = lbase[te[k]] + lrank[k]; const size_t o = (size_t)te[k] * 32768 + r;
                        ROWTOK[o] = row * 4 + k; ROWGATE[o] = gate[k]; }
                }
                __syncthreads();
            }
        }
        SEAM(pb + 6);
        if (IN(pb + 7) || IN(pb + 8)) {
            LAS int* tstart = (LAS int*)(ldsp + L_TSTART); LAS int* cntL = (LAS int*)(ldsp + L_CNT); LAS int* units = (LAS int*)(ldsp + L_UNITS); LAS int* unitsn = (LAS int*)(ldsp + L_UNITSN);
            if (tid == 0) { int acc = 0; for (int e = 0; e < 32; ++e) { const int c = (int)__hip_atomic_load(gcnt + e, RLX_AGENT); cntL[e] = c; tstart[e] = acc; acc += (c + 255) >> 8; } tstart[32] = acc; }
            __syncthreads();
            if (IN(pb + 7)) {
                pg8::moe_build_units(units, unitsn, tstart, 8, G, bid, tid);
                __syncthreads();
                pg8::Gemm g{(const pg8::bf16_t*)XB8, (const pg8::bf16_t*)WGUl, 0, 2048, DM / 2};
                pg8::MoeOrder S{units, __builtin_amdgcn_readfirstlane(unitsn[0]), cntL, ROWTOK, 1, (unsigned)DM, (size_t)2048 * DM, ROWGATE, in_bgu + (size_t)layer * NEXP * 2048};
                pg8::EpiSwiglu E{H8, in_bgu + (size_t)layer * NEXP * 2048, ROWGATE, cntL, 1.0f / (SC_X * SC_WGU), SC_H};
                pg8::gemm_phase<pg8::EpiSwiglu, pg8::MoeOrder, true, true, true>(ldsp + RING_OFF, g, S, E);
                __syncthreads();
            }
            SEAM(pb + 7);
            if (IN(pb + 8)) {
                pg8::moe_build_units(units, unitsn, tstart, 4, G, bid, tid);
                __syncthreads();
                pg8::Gemm g{(const pg8::bf16_t*)H8, (const pg8::bf16_t*)WDNl, 0, DM, FF / 2};
                pg8::MoeOrder S{units, __builtin_amdgcn_readfirstlane(unitsn[0]), cntL, ROWTOK, 0, (unsigned)FF, (size_t)DM * FF, ROWGATE, in_bdn + (size_t)layer * NEXP * DM};
                pg8::EpiScatter E{YB8, ROWTOK, cntL, SC_Y / (SC_H * SC_WDN), SC_Y};
                pg8::gemm_phase<pg8::EpiScatter, pg8::MoeOrder, true, false, true, true>(ldsp + RING_OFF, g, S, E);
                __syncthreads();
            }
        }
        SEAM(pb + 8);
        if (IN(pb + 9)) {
            const float* gam = in_ln2g + (size_t)layer * DM; const float* bet = in_ln2b + (size_t)layer * DM; const float* bdn = in_bdn + (size_t)layer * NEXP * DM;
            for (int m = gw; m < MROWS; m += NGW) { f32x4 v[4];
#pragma unroll
                for (int j = 0; j < 4; ++j) { const v2u a = *(const v2u*)(XB + (size_t)m * DM + 4 * lane + 256 * j); v[j] = (f32x4){bflo(a.x), bfhi(a.x), bflo(a.y), bfhi(a.y)} * ALPHA; }
#pragma unroll
                for (int k = 0; k < 4; ++k) { const unsigned char* yr = YB8 + ((size_t)m * 4 + k) * DM;
#pragma unroll
                    for (int j = 0; j < 4; ++j) { const unsigned w = *(const unsigned*)(yr + 4 * lane + 256 * j);
                        typedef float f32x2_ __attribute__((ext_vector_type(2)));
                        const f32x2_ lo = __builtin_amdgcn_cvt_pk_f32_fp8(w, false), hi = __builtin_amdgcn_cvt_pk_f32_fp8(w, true);
                        v[j][0] += lo[0] * (1.0f / SC_Y); v[j][1] += lo[1] * (1.0f / SC_Y); v[j][2] += hi[0] * (1.0f / SC_Y); v[j][3] += hi[1] * (1.0f / SC_Y); } }
                ln_row<(layer + 1 < NLAYER), (layer == NLAYER - 1)>(v, gam, bet, args.out + (size_t)m * DM, XB + (size_t)m * DM, XP8 + (size_t)m * DM, SC_X, lane);
                if (layer + 1 < NLAYER) row_dt(v, WDT + (size_t)(layer + 1) * 8 * 1024, DT + (size_t)m * 8, lane); }
        }
        SEAM(pb + 9);
    #undef IN
#undef SEAM
}

__global__ void __launch_bounds__(NWAVES * 64, 2) mk_fwd(Args args) {
    extern __shared__ __attribute__((aligned(16))) unsigned char lds[];
    LAS unsigned char* ldsp = (LAS unsigned char*)lds;
    const int tid = threadIdx.x, lane = tid & 63, wave = __builtin_amdgcn_readfirstlane(tid >> 6);
    const int G = gridDim.x, bid = blockIdx.x;
    const int gw = bid * NWAVES + wave, NGW = G * NWAVES;
    gu32* ctl = (gu32*)(args.ws + WS_CTL);

    for (int u = tid; u < (LDS_BYTES - LDSCTL_OFF) / 4; u += NWAVES * 64) ((LAS unsigned*)(ldsp + LDSCTL_OFF))[u] = 0u;
    __syncthreads();
    XcdBarrier bar = xcd_barrier_post((unsigned*)(ctl + CW_BAR), (volatile LAS unsigned*)(ldsp + L_MISC) + 8);

    const int lo = args.ph_lo, hi = args.ph_hi;
#define IN(k) (lo <= (k) && (k) < hi)
#define SEAM(k) do { if (IN(k) && IN((k) + 1)) xcd_barrier(bar); } while (0)

    if (IN(0)) {
        LAS float* scr = (LAS float*)(ldsp + RING_OFF + wave * 16384);
        constexpr int I_IN = 16 * 73, I_OUT = 24 * 16, I_R = 16;
        constexpr int NIT = NLAYER * (I_IN + I_OUT + I_R);
        for (int it = gw; it < NIT; it += NGW) {
            int r = it;
            if (r < NLAYER * I_IN) { const int l = r / I_IN; r %= I_IN; p0_transpose_item64<1>(in_win + (size_t)l * DM * INW, DM, INW, WIN + (size_t)l * NPROJ * DM, WDT + (size_t)l * 8 * 1024, scr, r / 73, r % 73, lane); continue; } r -= NLAYER * I_IN;
            if (r < NLAYER * I_OUT) { const int l = r / I_OUT; r %= I_OUT; p0_transpose_item64<0>(in_wout + (size_t)l * MIXW * DM, MIXW, DM, WOUT + (size_t)l * DM * MIXW, nullptr, scr, r / 16, r % 16, lane); continue; } r -= NLAYER * I_OUT;
            { const int l = r / I_R; r %= I_R; p0_transpose_item<0>(in_rw + (size_t)l * DM * NEXP, DM, NEXP, ROUT + (size_t)l * NEXP * DM, nullptr, scr, r, 0, lane); }
        }
        { constexpr int NIT8 = 64 * 256 + 64 * 128 + NLAYER * 192;
          const int nmine = (gw < NIT8) ? (NIT8 - gw + NGW - 1) / NGW : 0; const int J = 2 * nmine;
          f32x4 lda[16], ldb[16];
          if (J > 0) { const SubT t = fp8_subtile(gw, 0, in_wgu, in_wdn, in_win, WGU8, WDN8, WIN8, lane); fp8_sub_load(t, lda); }
#pragma unroll 1
          for (int j = 0; j < J; j += 2) {
              const int item = gw + (j >> 1) * NGW;
              const SubT t0 = fp8_subtile(item, 0, in_wgu, in_wdn, in_win, WGU8, WDN8, WIN8, lane), t1 = fp8_subtile(item, 1, in_wgu, in_wdn, in_win, WGU8, WDN8, WIN8, lane);
              fp8_sub_load(t1, ldb);
              fp8_sub_process(t0, lda, scr, lane);
              if (j + 2 < J) { const SubT t2 = fp8_subtile(item + NGW, 0, in_wgu, in_wdn, in_win, WGU8, WDN8, WIN8, lane); fp8_sub_load(t2, lda); }
              fp8_sub_process(t1, ldb, scr, lane);
          } }
        __syncthreads();
    }
    if (IN(0)) {
        for (int i = bid * 512 + tid; i < 65536; i += G * 512) { *(v4u*)(args.ws + WS_DTS + (size_t)i * 16) = (v4u){0u, 0u, 0u, 0u}; *(v4u*)(args.ws + WS_ROPE + (size_t)i * 16) = (v4u){0u, 0u, 0u, 0u}; }
    }
    if (IN(0)) {
        for (int m = gw; m < MROWS; m += NGW) { const float* xr = in_x + (size_t)m * DM; bf16* ob = XB + (size_t)m * DM; f32x4 v[4];
#pragma unroll
            for (int j = 0; j < 4; ++j) { v[j] = *(const f32x4*)(xr + 4 * lane + 256 * j); v2u w; w.x = pk2(v[j][0], v[j][1]); w.y = pk2(v[j][2], v[j][3]); *(v2u*)(ob + 4 * lane + 256 * j) = w;
                *(unsigned*)(XP8 + (size_t)m * DM + 4 * lane + 256 * j) = pg8::pk4_fp8(v[j][0] * SC_X, v[j][1] * SC_X, v[j][2] * SC_X, v[j][3] * SC_X); }
            }
    }

    SEAM(0);
    run_layer<0>(args, lo, hi, bar);
    run_layer<1>(args, lo, hi, bar);
#undef IN
#undef SEAM
}

extern "C" void kernel_launch(void* const* d_in, const int* in_sizes, int n_in, void* d_out, int out_size, void* d_ws, size_t ws_size, hipStream_t stream) {
    static int grid = 0;
    if (grid == 0) {
        if (n_in != 20 || out_size != MROWS * DM || ws_size < WS_END) { fprintf(stderr, "kernel_launch: unexpected problem (n_in %d, out %d, ws %zu)\n", n_in, out_size, ws_size); grid = -1; return; }
        if (hipFuncSetAttribute((const void*)mk_fwd, hipFuncAttributeMaxDynamicSharedMemorySize, LDS_BYTES) != hipSuccess) { fprintf(stderr, "kernel_launch: hipFuncSetAttribute failed\n"); grid = -1; return; }
        int dev = 0, cus = 0, per_cu = 0;
        (void)hipGetDevice(&dev); (void)hipDeviceGetAttribute(&cus, hipDeviceAttributeMultiprocessorCount, dev);
        if (hipOccupancyMaxActiveBlocksPerMultiprocessor(&per_cu, (const void*)mk_fwd, NWAVES * 64, LDS_BYTES) != hipSuccess || per_cu < 1) fprintf(stderr, "kernel_launch: occupancy query says %d\n", per_cu);
        (void)hipGetLastError();
        grid = cus > 0 ? cus : 256;
    }
    if (grid < 0) return;
    (void)hipMemsetAsync((char*)d_ws + WS_CTL, 0, CTL_ZERO_BYTES, stream);
    Args a{};
    for (int i = 0; i < 20; ++i) a.in[i] = (const float*)d_in[i];
    a.out = (float*)d_out; a.ws = (unsigned char*)d_ws;
    a.ph_lo = 0; a.ph_hi = N_PHASES; a.sub = 7; a.pad = 0;
    hipLaunchKernelGGL(mk_fwd, dim3(grid), dim3(NWAVES * 64), LDS_BYTES, stream, a);
#ifdef PROBE_PH
#ifndef PROBE_SUB
#define PROBE_SUB 7
#endif
    for (int i = 0; i < PROBE_N; ++i) { a.ph_lo = PROBE_PH; a.ph_hi = PROBE_PH + 1; a.sub = PROBE_SUB; hipLaunchKernelGGL(mk_fwd, dim3(grid), dim3(NWAVES * 64), LDS_BYTES, stream, a); }
#endif
}
```

```cpp
#include <hip/hip_runtime.h>
#include <cstdio>
#include <cstdint>
#include <cmath>

namespace pg8 {
#define PG8_LAS __attribute__((address_space(3)))
typedef unsigned short bf16_t;
typedef short bf16x8 __attribute__((ext_vector_type(8)));
typedef float f32x4 __attribute__((ext_vector_type(4)));
typedef float f32x2 __attribute__((ext_vector_type(2)));
typedef unsigned u32x4 __attribute__((ext_vector_type(4)));
constexpr int BM = 256, BK = 64, HALF = 128, HTB = HALF * BK * 2  , STAGE_BYTES = 8 * HTB, NXCD = 8, WGM = 8;

__host__ __device__ __forceinline__ int lds_byte(int r, int c) { const int st = (r >> 4) * 2 + (c >> 5), rr = r & 15, cc = c & 31, ob = rr * 64 + cc * 2; return st * 1024 + (ob ^ (((ob >> 9) & 1) << 5)); }
__host__ __device__ __forceinline__ void stage_rc(int b, int& R, int& C) { const int st = b / 1024, sb = b % 1024, swz = sb ^ (((sb >> 9) & 1) << 5); R = (st >> 1) * 16 + swz / 64; C = (st & 1) * 32 + (swz % 64) / 2; }
__host__ __device__ __forceinline__ int perm32(int rho) { const int n = rho >> 4, i = rho & 15; return 8 * (i >> 2) + 4 * n + (i & 3); }

struct Unit { int pm, pn, e, r0; };
struct Gemm { const bf16_t* A; const bf16_t* Bt; int M, N, K; };

struct StaticOrder {
    int nM, nN, nwg, G, c, base, lim;
    __device__ void init(int M, int N, int G_, int c_) { nM = M / BM; nN = N / BM; nwg = nM * nN; G = G_; c = c_; base = 0; lim = nwg; }
    __device__ __forceinline__ bool next(int i, Unit& u) const {
        const long L = (long)i * G + c + base; if (L >= lim) return false;
        int wgid = (int)L; { const int q = nwg / NXCD, r = nwg % NXCD, xcd = wgid % NXCD, off = wgid / NXCD; wgid = (xcd < r ? xcd * (q + 1) : r * (q + 1) + (xcd - r) * q) + off; }
        const int nig = WGM * nN, gid = wgid / nig, fm = gid * WGM, gsz = (nM - fm) < WGM ? (nM - fm) : WGM;
        u.pm = fm + ((wgid % nig) % gsz); u.pn = (wgid % nig) / gsz; u.e = 0; u.r0 = 0; return true;
    }
    __device__ __forceinline__ const char* abase(const Unit& u, const Gemm& g, size_t tstep) const { return (const char*)g.A + (size_t)u.pm * tstep; }
    __device__ __forceinline__ const char* bbase(const Unit& u, const Gemm& g, size_t tstep) const { return (const char*)g.Bt + (size_t)u.pn * tstep; }
    static constexpr bool SIDE = false;
    __device__ __forceinline__ unsigned arow(const Unit&, int) const { return 0u; }
    __device__ __forceinline__ unsigned arow_side(const Unit&, int, const PG8_LAS unsigned char*) const { return 0u; }
    __device__ __forceinline__ const void* side_src(const Unit&, const Unit&, int, int) const { return nullptr; }
    __device__ __forceinline__ void a_ready(const Unit&) const {}
    __device__ __forceinline__ void done(const Unit&) const {}
};

struct MoeOrder {
    const PG8_LAS int* units;
    int nunits;
    const PG8_LAS int* cnt;
    const int* rowtok;
    int gather;
    unsigned rowbytes;
    size_t bstride;
    __device__ __forceinline__ bool next(int i, Unit& u) const {
        if (i >= nunits) return false;
        u.pm = __builtin_amdgcn_readfirstlane(units[4 * i + 0]); u.pn = __builtin_amdgcn_readfirstlane(units[4 * i + 1]);
        u.e = __builtin_amdgcn_readfirstlane(units[4 * i + 2]); u.r0 = __builtin_amdgcn_readfirstlane(units[4 * i + 3]); return true;
    }
    __device__ __forceinline__ const char* abase(const Unit& u, const Gemm& g, size_t tstep) const { return gather ? (const char*)g.A : (const char*)g.A + (size_t)u.pm * tstep; }
    __device__ __forceinline__ const char* bbase(const Unit& u, const Gemm& g, size_t tstep) const { return (const char*)g.Bt + (size_t)u.e * bstride + (size_t)u.pn * tstep; }
    static constexpr bool SIDE = true;
    const float* rowgate; const float* bgu;
    __device__ __forceinline__ unsigned arow(const Unit& u, int R) const {
        const int r = u.r0 + R; const int idx = (r < cnt[u.e]) ? rowtok[(size_t)u.e * 32768 + r] : 0; return (unsigned)(idx >> 2) * rowbytes; }
    __device__ __forceinline__ unsigned arow_side(const Unit& u, int R, const PG8_LAS unsigned char* sd) const {
        const int r = u.r0 + R; const int v = ((const PG8_LAS int*)sd)[R]; const int idx = (r < cnt[u.e]) ? v : 0; return (unsigned)(idx >> 2) * rowbytes; }
    __device__ __forceinline__ const void* side_src(const Unit& cur, const Unit& rt, int wid, int lane) const {
        if (rowgate != nullptr && wid == 1) return rowgate + (size_t)cur.e * 32768 + cur.r0 + 4 * lane;
        if (bgu != nullptr && wid == 2) return gather ? (bgu + (size_t)cur.e * 2048 + (lane < 32 ? 0 : 1024 - 128) + cur.pn * 128 + 4 * lane)
                                                      : (bgu + (size_t)cur.e * 1024 + cur.pn * 256 + 4 * lane);
        return rowtok + (size_t)rt.e * 32768 + rt.r0 + 4 * lane; }
    __device__ __forceinline__ void a_ready(const Unit&) const {}
    __device__ __forceinline__ void done(const Unit&) const {}
};
__device__ __forceinline__ void moe_build_units(PG8_LAS int* units, PG8_LAS int* units_n, const PG8_LAS int* tstart, int nN, int G, int c, int tid) {
    if (tid < 64) {
        const int nT = tstart[32], nwg = nT * nN; const long L = (long)tid * G + c;
        int pm = 0, pn = 0, e = 0, r0 = 0;
        if (L < nwg) {
            int wgid = (int)L; { const int q = nwg / NXCD, r = nwg % NXCD, xcd = wgid % NXCD, off = wgid / NXCD; wgid = (xcd < r ? xcd * (q + 1) : r * (q + 1) + (xcd - r) * q) + off; }
            const int nig = WGM * nN, gid = wgid / nig, fm = gid * WGM, gsz = (nT - fm) < WGM ? (nT - fm) : WGM;
            pm = fm + ((wgid % nig) % gsz); pn = (wgid % nig) / gsz;
            for (int j = 1; j < 32; ++j) e += (tstart[j] <= pm) ? 1 : 0;
            r0 = (pm - tstart[e]) * 256;
        }
        units[4 * tid + 0] = pm; units[4 * tid + 1] = pn; units[4 * tid + 2] = e; units[4 * tid + 3] = r0;
        if (tid == 0) { int n = 0; if (c < nwg) n = (nwg - c + G - 1) / G; units_n[0] = n < 64 ? n : 64; }
    }
}

__host__ __device__ __forceinline__ unsigned hblk_off(int R, int p7) { const int ai = R >> 7, wr = (R >> 6) & 1, m = (R >> 4) & 3, fr = R & 15, wc = p7 >> 1, fq = ((p7 & 1) << 1) | (m & 1), mp = m >> 1;
    return (unsigned)(((((ai * 2 + wr) * 4 + wc) * 2 + mp) * 64 + fr + 16 * fq) * 16); }
typedef int v8i_t __attribute__((ext_vector_type(8)));
typedef int v4i_t __attribute__((ext_vector_type(4)));
__device__ __forceinline__ v8i_t cat8(bf16x8 lo, bf16x8 hi) { const v4i_t a = __builtin_bit_cast(v4i_t, lo), b = __builtin_bit_cast(v4i_t, hi); return __builtin_shufflevector(a, b, 0, 1, 2, 3, 4, 5, 6, 7); }
__device__ __forceinline__ void mfma8(f32x4& acc, v8i_t a, v8i_t b, int scl) { asm volatile("v_mfma_scale_f32_16x16x128_f8f6f4 %0, %1, %2, %0, %3, %3 op_sel_hi:[0,0,0]" : "+v"(acc) : "v"(a), "v"(b), "v"(scl)); }
__device__ __forceinline__ unsigned pk4_fp8(float a, float b, float c, float d) { unsigned w = 0u; w = __builtin_amdgcn_cvt_pk_fp8_f32(a, b, w, false); w = __builtin_amdgcn_cvt_pk_fp8_f32(c, d, w, true); return w; }
__device__ __forceinline__ unsigned cvt_pk_bf16(float lo, float hi) { unsigned r; asm volatile("v_cvt_pk_bf16_f32 %0, %1, %2" : "=v"(r) : "v"(lo), "v"(hi)); return r; }

struct EpiProj {
    static constexpr bool PERM = true, AFTER_DRAIN = false;
    bf16_t* O; int ldc; const float* rope; float qscale; float dqv; int pn_off;
    __device__ __forceinline__ void operator()(const f32x4 (&acc)[2][2][4][2], const Unit& u, int wr, int wc, int fr, int fq, const PG8_LAS unsigned char* sd) const {
        const int pnn = u.pn + pn_off; const int row0 = u.pm * BM + wr * 64 + fr; const int col0 = pnn * BM + wc * 32 + 8 * fq;
        const bool rot = pnn < 4; const float sc = (pnn < 2 ? qscale : 1.f) * dqv; const int gq = 4 * (wc & 1) + fq;
        float invr[4];
#pragma unroll
        for (int e = 0; e < 4; ++e) invr[e] = __builtin_amdgcn_exp2f(-(float)(4 * gq + e) * 0.41524101186092029f) * 0.15915494309189535f;
#pragma unroll
        for (int ai = 0; ai < 2; ++ai)
#pragma unroll
            for (int m = 0; m < 4; ++m) { const int row = row0 + ai * HALF + m * 16; bf16_t* rowp = O + (size_t)row * ldc + col0;
                f32x4 cs0 = (f32x4){1.f, 0.f, 1.f, 0.f}, cs1 = cs0;
                if (rot) { const float tp = (float)(row & 4095);
                    const float a0 = __builtin_amdgcn_fractf(tp * invr[0]), a1 = __builtin_amdgcn_fractf(tp * invr[1]), a2 = __builtin_amdgcn_fractf(tp * invr[2]), a3 = __builtin_amdgcn_fractf(tp * invr[3]);
                    cs0 = (f32x4){__builtin_amdgcn_cosf(a0), __builtin_amdgcn_sinf(a0), __builtin_amdgcn_cosf(a1), __builtin_amdgcn_sinf(a1)};
                    cs1 = (f32x4){__builtin_amdgcn_cosf(a2), __builtin_amdgcn_sinf(a2), __builtin_amdgcn_cosf(a3), __builtin_amdgcn_sinf(a3)}; }
#pragma unroll
                for (int bj = 0; bj < 2; ++bj) { f32x4 v0 = acc[ai][bj][m][0], v1 = acc[ai][bj][m][1];
                    if (rot) { f32x4 lo, hi;
                        lo[0] = v0[0] * cs0[0] - v1[0] * cs0[1]; hi[0] = v1[0] * cs0[0] + v0[0] * cs0[1];
                        lo[1] = v0[1] * cs0[2] - v1[1] * cs0[3]; hi[1] = v1[1] * cs0[2] + v0[1] * cs0[3];
                        lo[2] = v0[2] * cs1[0] - v1[2] * cs1[1]; hi[2] = v1[2] * cs1[0] + v0[2] * cs1[1];
                        lo[3] = v0[3] * cs1[2] - v1[3] * cs1[3]; hi[3] = v1[3] * cs1[2] + v0[3] * cs1[3];
                        v0 = lo * sc; v1 = hi * sc; }
                    else { v0 = v0 * dqv; v1 = v1 * dqv; }
                    u32x4 w; w.x = cvt_pk_bf16(v0[0], v0[1]); w.y = cvt_pk_bf16(v0[2], v0[3]); w.z = cvt_pk_bf16(v1[0], v1[1]); w.w = cvt_pk_bf16(v1[2], v1[3]);
                    *(u32x4*)(rowp + bj * HALF) = w; } }
    }
};
struct EpiF32 {
    static constexpr bool PERM = false, AFTER_DRAIN = false;
    float* O; int ldc;
    __device__ __forceinline__ void operator()(const f32x4 (&acc)[2][2][4][2], const Unit& u, int wr, int wc, int fr, int fq, const PG8_LAS unsigned char* sd) const {
        const int row0 = u.pm * BM + wr * 64 + fr; const int col0 = u.pn * BM + wc * 32 + 4 * fq;
#pragma unroll
        for (int ai = 0; ai < 2; ++ai)
#pragma unroll
            for (int m = 0; m < 4; ++m) { float* rowp = O + (size_t)(row0 + ai * HALF + m * 16) * ldc + col0;
#pragma unroll
                for (int bj = 0; bj < 2; ++bj)
#pragma unroll
                    for (int n = 0; n < 2; ++n) *(f32x4*)(rowp + bj * HALF + n * 16) = acc[ai][bj][m][n]; }
    }
};
struct EpiBf16Plain {
    static constexpr bool PERM = true, AFTER_DRAIN = false;
    bf16_t* O; int ldc;
    __device__ __forceinline__ void operator()(const f32x4 (&acc)[2][2][4][2], const Unit& u, int wr, int wc, int fr, int fq, const PG8_LAS unsigned char* sd) const {
        const int row0 = u.pm * BM + wr * 64 + fr; const int col0 = u.pn * BM + wc * 32 + 8 * fq;
#pragma unroll
        for (int ai = 0; ai < 2; ++ai)
#pragma unroll
            for (int m = 0; m < 4; ++m) { bf16_t* rowp = O + (size_t)(row0 + ai * HALF + m * 16) * ldc + col0;
#pragma unroll
                for (int bj = 0; bj < 2; ++bj) { const f32x4 v0 = acc[ai][bj][m][0], v1 = acc[ai][bj][m][1];
                    u32x4 w; w.x = cvt_pk_bf16(v0[0], v0[1]); w.y = cvt_pk_bf16(v0[2], v0[3]); w.z = cvt_pk_bf16(v1[0], v1[1]); w.w = cvt_pk_bf16(v1[2], v1[3]);
                    *(u32x4*)(rowp + bj * HALF) = w; } }
    }
};
struct EpiSwiglu {
    static constexpr bool PERM = true, AFTER_DRAIN = false;
    unsigned char* H; const float* bgu; const float* rowgate; const PG8_LAS int* cnt; float dq, hscale;
    __device__ __forceinline__ void operator()(const f32x4 (&acc)[2][2][4][2], const Unit& u, int wr, int wc, int fr, int fq, const PG8_LAS unsigned char* sd) const {
        const int n_e = cnt[u.e];
        constexpr float CS = -1.702f * 1.4426950408889634f;
        const float kk = hscale / CS, dqc = dq * CS, dqk = dq * kk, glo = 7.0f * CS, ub0 = -6.0f * kk, ub1 = 8.0f * kk;
        f32x4 bg[2], bu[2];
#pragma unroll
        for (int n = 0; n < 2; ++n) { bg[n] = *(const PG8_LAS f32x4*)(sd + 2048 + (wc * 32 + 8 * fq + 4 * n) * 4) * CS; bu[n] = (*(const PG8_LAS f32x4*)(sd + 2048 + 512 + (wc * 32 + 8 * fq + 4 * n) * 4) + 1.0f) * kk; }
        const int lane = fr + 16 * fq;
        float rgls[2][4];
#pragma unroll
        for (int ai = 0; ai < 2; ++ai)
#pragma unroll
            for (int m = 0; m < 4; ++m) rgls[ai][m] = ((const PG8_LAS float*)(sd + 1024))[ai * HALF + wr * 64 + m * 16 + fr];
#pragma unroll
        for (int ai = 0; ai < 2; ++ai)
#pragma unroll
            for (int mp = 0; mp < 2; ++mp) {
                unsigned pw[2][2];
#pragma unroll
                for (int mm = 0; mm < 2; ++mm) { const int m = 2 * mp + mm; const int r = ai * HALF + wr * 64 + m * 16 + fr; const int er = u.r0 + r;
                    const float rgl = rgls[ai][m]; const float irg = (er < n_e) ? __builtin_amdgcn_rcpf(rgl) : 1e30f;
                    float hv[8];
#pragma unroll
                    for (int n = 0; n < 2; ++n)
#pragma unroll
                        for (int q = 0; q < 4; q += 2) {
                            f32x2 g = (f32x2){acc[ai][0][m][n][q], acc[ai][0][m][n][q + 1]} * dqc + (f32x2){bg[n][q], bg[n][q + 1]};
                            f32x2 up = (f32x2){acc[ai][1][m][n][q], acc[ai][1][m][n][q + 1]} * dqk + (f32x2){bu[n][q], bu[n][q + 1]};
                            g.x = fmaxf(g.x, glo); g.y = fmaxf(g.y, glo); up.x = __builtin_amdgcn_fmed3f(up.x, ub0, ub1); up.y = __builtin_amdgcn_fmed3f(up.y, ub0, ub1);
                            f32x2 den; den.x = __builtin_amdgcn_exp2f(g.x); den.y = __builtin_amdgcn_exp2f(g.y); den = den * irg + irg;
                            f32x2 sg; sg.x = __builtin_amdgcn_rcpf(den.x); sg.y = __builtin_amdgcn_rcpf(den.y);
                            const f32x2 h2 = (up * g) * sg;
                            hv[n * 4 + q] = h2.x; hv[n * 4 + q + 1] = h2.y; }
                    pw[mm][0] = pk4_fp8(hv[0], hv[1], hv[2], hv[3]); pw[mm][1] = pk4_fp8(hv[4], hv[5], hv[6], hv[7]); }
                const auto s0 = __builtin_amdgcn_permlane16_swap(pw[0][0], pw[1][0], false, false); const auto s1 = __builtin_amdgcn_permlane16_swap(pw[0][1], pw[1][1], false, false);
                *(u32x4*)(H + ((size_t)u.pm * 8 + u.pn) * 32768 + ((((ai * 2 + wr) * 4 + wc) * 2 + mp) * 64 + lane) * 16) = (u32x4){s0[0], s1[0], s0[1], s1[1]};
                asm volatile("" ::: "memory"); }
    }
};
struct EpiScatter {
    static constexpr bool PERM = true, AFTER_DRAIN = false;
    unsigned char* Y; const int* rowtok; const PG8_LAS int* cnt; float dq, ysc;
    __device__ __forceinline__ void operator()(const f32x4 (&acc)[2][2][4][2], const Unit& u, int wr, int wc, int fr, int fq, const PG8_LAS unsigned char* sd) const {
        const int col0 = u.pn * BM + wc * 32 + 8 * fq; const int n_e = cnt[u.e];
        f32x4 bd[2][2];
#pragma unroll
        for (int bj = 0; bj < 2; ++bj)
#pragma unroll
            for (int n = 0; n < 2; ++n) bd[bj][n] = *(const PG8_LAS f32x4*)(sd + 2048 + (bj * HALF + wc * 32 + 8 * fq + 4 * n) * 4);
        int idxs[2][4]; float rgs[2][4];
#pragma unroll
        for (int ai = 0; ai < 2; ++ai)
#pragma unroll
            for (int m = 0; m < 4; ++m) { idxs[ai][m] = ((const PG8_LAS int*)sd)[ai * HALF + wr * 64 + m * 16 + fr]; rgs[ai][m] = ((const PG8_LAS float*)(sd + 1024))[ai * HALF + wr * 64 + m * 16 + fr]; }
#pragma unroll
        for (int ai = 0; ai < 2; ++ai)
#pragma unroll
            for (int m = 0; m < 4; ++m) { const int er = u.r0 + ai * HALF + wr * 64 + m * 16 + fr;
                const int idx = idxs[ai][m];
                if (er < n_e) { unsigned char* rowp = Y + (size_t)idx * 1024 + col0;
                    typedef unsigned u32x2 __attribute__((ext_vector_type(2)));
                    const float rg = rgs[ai][m] * ysc;
#pragma unroll
                    for (int bj = 0; bj < 2; ++bj) { const f32x4 v0 = acc[ai][bj][m][0] * dq + bd[bj][0] * rg, v1 = acc[ai][bj][m][1] * dq + bd[bj][1] * rg;
                        *(u32x2*)(rowp + bj * HALF) = (u32x2){pk4_fp8(v0[0], v0[1], v0[2], v0[3]), pk4_fp8(v1[0], v1[1], v1[2], v1[3])}; } } }
    }
};

struct PanelStats {
    unsigned* xbuf;
    unsigned* cnt;
    unsigned* tmo;
    int ntn; float eps;
    unsigned code;
    __device__ __forceinline__ bool run(const f32x4 (&v)[2][2][4][2], const Unit& u, int wr, int wc, int fr, int fq, PG8_LAS unsigned char* lds, int wid, int lane) const {
        typedef float f32x2v __attribute__((ext_vector_type(2)));
        PG8_LAS f32x2v* P = (PG8_LAS f32x2v*)lds;
        PG8_LAS f32x2v* S = (PG8_LAS f32x2v*)(lds + 8192);
        PG8_LAS unsigned* flag = (PG8_LAS unsigned*)(lds + 8192 + 2048);
#pragma unroll
        for (int ai = 0; ai < 2; ++ai)
#pragma unroll
            for (int m = 0; m < 4; ++m) {
                float s = 0.f;
#pragma unroll
                for (int bj = 0; bj < 2; ++bj)
#pragma unroll
                    for (int n = 0; n < 2; ++n) { const f32x4 x = v[ai][bj][m][n]; s += (x[0] + x[1]) + (x[2] + x[3]); }
                s += __shfl_xor(s, 16); s += __shfl_xor(s, 32);
                const float mw = s * (1.0f / 64.0f); float q = 0.f;
#pragma unroll
                for (int bj = 0; bj < 2; ++bj)
#pragma unroll
                    for (int n = 0; n < 2; ++n) { const f32x4 d = v[ai][bj][m][n] - mw; q += (d[0] * d[0] + d[1] * d[1]) + (d[2] * d[2] + d[3] * d[3]); }
                q += __shfl_xor(q, 16); q += __shfl_xor(q, 32);
                if (fq == 0) P[(ai * HALF + wr * 64 + m * 16 + fr) * 4 + wc] = (f32x2v){mw, q};
            }
        asm volatile("s_waitcnt lgkmcnt(0)" ::: "memory"); __builtin_amdgcn_s_barrier(); asm volatile("" ::: "memory");
#if defined(BROKEN_EXCHANGE_NO_WAIT)
#warning BROKEN CONTROL BUILD: the row-statistics exchange does not wait; results are wrong by design
        if (blockIdx.x >= 64) { const long long t0_ = clock64(); while (clock64() - t0_ < 60000) __builtin_amdgcn_s_sleep(8); }
#endif
        const int row = wid * 32 + (lane & 31);
        if (lane < 32) {
            const f32x2v a = P[row * 4 + 0], b = P[row * 4 + 1], c = P[row * 4 + 2], d = P[row * 4 + 3];
            const float mt = (a.x + b.x + c.x + d.x) * 0.25f;
            const float da = a.x - mt, db = b.x - mt, dc = c.x - mt, dd = d.x - mt;
            const float m2 = (a.y + b.y) + (c.y + d.y) + 64.0f * ((da * da + db * db) + (dc * dc + dd * dd));
            unsigned long long* slot = (unsigned long long*)xbuf + ((size_t)(u.pm * BM + row) * 4 + u.pn);
            __hip_atomic_store(slot, ((unsigned long long)__float_as_uint(m2) << 32) | __float_as_uint(mt), __ATOMIC_RELAXED, __HIP_MEMORY_SCOPE_AGENT);
        }
        asm volatile("s_waitcnt vmcnt(0)" ::: "memory");
        if (lane == 0) __hip_atomic_fetch_add(cnt + 64 * u.pm, 1u, __ATOMIC_RELAXED, __HIP_MEMORY_SCOPE_AGENT);
        if (wid == 0) {
            const unsigned want = 8u * (unsigned)ntn; unsigned sp = 0u;
            while ((unsigned)__builtin_amdgcn_readfirstlane(__hip_atomic_load(cnt + 64 * u.pm, __ATOMIC_RELAXED, __HIP_MEMORY_SCOPE_AGENT)) < want) { __builtin_amdgcn_s_sleep(2); if (++sp > (1u << 20)) break; }
            __builtin_amdgcn_fence(__ATOMIC_ACQUIRE, "agent");
        }
        asm volatile("s_waitcnt vmcnt(0) lgkmcnt(0)" ::: "memory"); __builtin_amdgcn_s_barrier(); asm volatile("" ::: "memory");
        const bool bad = false;
        if (lane < 32) {
            const unsigned long long* slot = (const unsigned long long*)xbuf + (size_t)(u.pm * BM + row) * 4; float mt[4], m2[4]; float ms = 0.f;
#pragma unroll
            for (int t = 0; t < 4; ++t) { if (t < ntn) { const unsigned long long w = __hip_atomic_load(slot + t, __ATOMIC_RELAXED, __HIP_MEMORY_SCOPE_AGENT); mt[t] = __uint_as_float((unsigned)w); m2[t] = __uint_as_float((unsigned)(w >> 32)); } else { mt[t] = 0.f; m2[t] = 0.f; } ms += mt[t]; }
            const float mean = ms / (float)ntn; float q = 0.f;
#pragma unroll
            for (int t = 0; t < 4; ++t) if (t < ntn) { const float dm = mt[t] - mean; q += m2[t] + 256.0f * dm * dm; }
            S[row] = (f32x2v){mean, 1.0f / sqrtf(q / (256.0f * (float)ntn) + eps)};
        }
        asm volatile("s_waitcnt lgkmcnt(0)" ::: "memory"); __builtin_amdgcn_s_barrier(); asm volatile("" ::: "memory");
        return bad;
    }
};

struct EpiLn1 {
    static constexpr bool PERM = true, AFTER_DRAIN = true;
    unsigned char* ws; const float* gam; const float* bet; size_t o_xb, o_x8, o_xbuf, o_cnt, o_tmo; float alpha, s8, eps; unsigned code;
    __device__ __forceinline__ void operator()(const f32x4 (&)[2][2][4][2], const Unit&, int, int, int, int, const PG8_LAS unsigned char*) const {}
    __device__ __forceinline__ void fused(f32x4 (&acc)[2][2][4][2], const Unit& u, int wr, int wc, int fr, int fq, PG8_LAS unsigned char* lds, int wid, int lane) const {
        typedef float f32x2v __attribute__((ext_vector_type(2))); typedef unsigned u32x2 __attribute__((ext_vector_type(2)));
        bf16_t* const XBp = (bf16_t*)(ws + o_xb); unsigned char* const X8 = ws + o_x8;
        const PanelStats st{(unsigned*)(ws + o_xbuf), (unsigned*)(ws + o_cnt), (unsigned*)(ws + o_tmo), 4, eps, code};
        const int col0 = u.pn * BM + wc * 32 + 8 * fq;
#pragma unroll
        for (int ai = 0; ai < 2; ++ai)
#pragma unroll
            for (int m = 0; m < 4; ++m) { const bf16_t* xr = XBp + (size_t)(u.pm * BM + ai * HALF + wr * 64 + m * 16 + fr) * 1024 + col0;
#pragma unroll
                for (int bj = 0; bj < 2; ++bj) { const u32x4 x = *(const u32x4*)(xr + bj * HALF);
                    acc[ai][bj][m][0] += (f32x4){__builtin_bit_cast(float, x.x << 16), __builtin_bit_cast(float, x.x & 0xffff0000u), __builtin_bit_cast(float, x.y << 16), __builtin_bit_cast(float, x.y & 0xffff0000u)} * alpha;
                    acc[ai][bj][m][1] += (f32x4){__builtin_bit_cast(float, x.z << 16), __builtin_bit_cast(float, x.z & 0xffff0000u), __builtin_bit_cast(float, x.w << 16), __builtin_bit_cast(float, x.w & 0xffff0000u)} * alpha; }
                asm volatile("" ::: "memory"); }
        (void)st.run(acc, u, wr, wc, fr, fq, lds, wid, lane);
        const PG8_LAS f32x2v* S = (const PG8_LAS f32x2v*)(lds + 8192);
#pragma unroll
        for (int bj = 0; bj < 2; ++bj) {
            const f32x4 g0 = *(const f32x4*)(gam + col0 + bj * HALF), g1 = *(const f32x4*)(gam + col0 + bj * HALF + 4), b0 = *(const f32x4*)(bet + col0 + bj * HALF), b1 = *(const f32x4*)(bet + col0 + bj * HALF + 4);
#pragma unroll
            for (int ai = 0; ai < 2; ++ai)
#pragma unroll
                for (int m = 0; m < 4; ++m) { const int r = ai * HALF + wr * 64 + m * 16 + fr; const f32x2v sr = S[r]; const size_t off = (size_t)(u.pm * BM + r) * 1024 + col0 + bj * HALF;
                    const f32x4 o0 = (acc[ai][bj][m][0] - sr.x) * sr.y * g0 + b0, o1 = (acc[ai][bj][m][1] - sr.x) * sr.y * g1 + b1;
                    u32x4 w; w.x = cvt_pk_bf16(o0[0], o0[1]); w.y = cvt_pk_bf16(o0[2], o0[3]); w.z = cvt_pk_bf16(o1[0], o1[1]); w.w = cvt_pk_bf16(o1[2], o1[3]);
                    *(u32x4*)(XBp + off) = w;
                    *(u32x2*)(X8 + off) = (u32x2){pk4_fp8(o0[0] * s8, o0[1] * s8, o0[2] * s8, o0[3] * s8), pk4_fp8(o1[0] * s8, o1[1] * s8, o1[2] * s8, o1[3] * s8)};
                    asm volatile("" ::: "memory"); } }
    }
};

template <class Epi, class Sched, bool ALIGN_EPI, bool GATHER, bool FP8 = false, bool ABLK = false>
__device__ __forceinline__ void gemm_phase(PG8_LAS unsigned char* lds, const Gemm g, const Sched& S, const Epi& E) {
    const int tid = threadIdx.x, wid = __builtin_amdgcn_readfirstlane(tid >> 6), lane = tid & 63, wr = wid >> 2, wc = wid & 3, fr = lane & 15, fq = lane >> 4;
    const int K = g.K, nt = K / BK;
    unsigned voffB[2];
#pragma unroll
    for (int i = 0; i < 2; ++i) { int R, C; stage_rc(tid * 16 + i * 8192, R, C); const int Rb = Epi::PERM ? ((R & ~31) + perm32(R & 31)) : R;
        voffB[i] = (unsigned)(Rb * K + C) * 2u; }
    constexpr int SIDE_BYTES = 8192;
    PG8_LAS unsigned char* const side = lds + STAGE_BYTES;
    const size_t kstep = (size_t)(BK * 2);
    const size_t kstepA = ABLK ? (size_t)32768 : kstep;
    const size_t hstep = (size_t)HALF * K * 2;
    const size_t tstep = 2 * hstep;
    const unsigned ldsw = (unsigned)wid * 1024u;
    const int aoff = lds_byte(wr * 64 + fr, fq * 8), boff = lds_byte(wc * 32 + fr, fq * 8);
#define PG8_SA(b, h) (((b) * 2 + (h)) * HTB)
#define PG8_SB(b, h) ((4 + (b) * 2 + (h)) * HTB)
#define PG8_STAGE(bufoff, gbase, voff) do { _Pragma("unroll") for (int _i = 0; _i < 2; ++_i) \
        __builtin_amdgcn_global_load_lds((const unsigned*)((const char*)(gbase) + (voff)[_i]), (PG8_LAS unsigned*)(lds + (bufoff) + ldsw + _i * 8192), 16, 0, 0); } while (0)
#define PG8_LDA(dst, b, h) do { _Pragma("unroll") for (int m = 0; m < 4; ++m) _Pragma("unroll") for (int k = 0; k < 2; ++k) dst[m][k] = *(const PG8_LAS bf16x8*)(lds + PG8_SA(b, h) + aoff + m * 2048 + k * 1024); } while (0)
#define PG8_LDB(dst, b, h) do { _Pragma("unroll") for (int n = 0; n < 2; ++n) _Pragma("unroll") for (int k = 0; k < 2; ++k) dst[n][k] = *(const PG8_LAS bf16x8*)(lds + PG8_SB(b, h) + boff + n * 2048 + k * 1024); } while (0)
#define PG8_MMA(ai, bj, At, Bt) do { __builtin_amdgcn_s_setprio(1); _Pragma("unroll") for (int m = 0; m < 4; ++m) _Pragma("unroll") for (int n = 0; n < 2; ++n) { \
        if constexpr (FP8) mfma8(acc[ai][bj][m][n], cat8(Bt[n][0], Bt[n][1]), cat8(At[m][0], At[m][1]), scl8); \
        else { _Pragma("unroll") for (int k = 0; k < 2; ++k) acc[ai][bj][m][n] = __builtin_amdgcn_mfma_f32_16x16x32_bf16(Bt[n][k], At[m][k], acc[ai][bj][m][n], 0, 0, 0); } } __builtin_amdgcn_s_setprio(0); } while (0)
#define PG8_WAIT_V(n) asm volatile("s_waitcnt vmcnt(" #n ")" ::: "memory")
#define PG8_WAIT_L(n) asm volatile("s_waitcnt lgkmcnt(" #n ")" ::: "memory")
#define PG8_BAR __builtin_amdgcn_s_barrier()
#define PG8_SCHED __builtin_amdgcn_sched_barrier(0)
#define PG8_SETOFFS(o, u) do { _Pragma("unroll") for (int _h = 0; _h < 2; ++_h) _Pragma("unroll") for (int _i = 0; _i < 2; ++_i) { int _R, _C; stage_rc(tid * 16 + _i * 8192, _R, _C); \
        o[_h][_i] = GATHER ? (S.arow(u, _R + HALF * _h) + (unsigned)(_C * 2)) : ABLK ? hblk_off(_R + HALF * _h, _C >> 3) : ((unsigned)((_R + HALF * _h) * K) * 2u + (unsigned)(_C * 2)); } } while (0)
    int scl8 = 0x7F7F7F7F; asm volatile("" : "+v"(scl8));
    Unit cur, nxt; int ui = 0;
    if (!S.next(0, cur)) return;
    f32x4 acc[2][2][4][2];
#pragma unroll
    for (int a = 0; a < 2; ++a)
#pragma unroll
        for (int b = 0; b < 2; ++b)
#pragma unroll
            for (int m = 0; m < 4; ++m)
#pragma unroll
                for (int n = 0; n < 2; ++n) { acc[a][b][m][n] = (f32x4){0.f, 0.f, 0.f, 0.f}; if constexpr (FP8) asm volatile("" : "+v"(acc[a][b][m][n])); }
    bf16x8 At[4][2], B0[2][2], B1[2][2];
    unsigned cAo[2][2];
    PG8_SETOFFS(cAo, cur);
    const char* cA = S.abase(cur, g, tstep); const char* cB = S.bbase(cur, g, tstep);
    S.a_ready(cur);
    PG8_STAGE(PG8_SB(0, 0), cB, voffB); PG8_STAGE(PG8_SB(0, 1), cB + hstep, voffB); PG8_STAGE(PG8_SA(0, 0), cA, cAo[0]); PG8_STAGE(PG8_SA(0, 1), cA, cAo[1]);
    if (wr == 1) PG8_BAR;
    PG8_WAIT_V(2); PG8_BAR;
    PG8_STAGE(PG8_SB(1, 0), cB + kstep, voffB); PG8_STAGE(PG8_SA(1, 0), cA + kstepA, cAo[0]); PG8_STAGE(PG8_SB(1, 1), cB + hstep + kstep, voffB);
    PG8_WAIT_V(6); PG8_BAR;
    for (;;) {
        const bool has_next = S.next(ui + 1, nxt);
        const char* nA = has_next ? S.abase(nxt, g, tstep) : cA; const char* nB = has_next ? S.bbase(nxt, g, tstep) : cB;
        if constexpr (Sched::SIDE) {
            const void* ssrc = S.side_src(cur, (GATHER && has_next) ? nxt : cur, wid, lane);
            __builtin_amdgcn_global_load_lds((const unsigned*)ssrc, (PG8_LAS unsigned*)(side + (ui & 1) * SIDE_BYTES + wid * 1024), 16, 0, 0); }
#pragma unroll 1
        for (int t = 0; t < nt; t += 2) {
            const bool last = (t == nt - 2);
            const char* a1 = cA + (size_t)(t + 1) * kstepA;
            const char* a2 = last ? nA : cA + (size_t)(t + 2) * kstepA; const char* b2 = last ? nB : cB + (size_t)(t + 2) * kstep;
            const char* a3 = a2 + kstepA; const char* b3 = b2 + kstep;
            if (last && has_next) S.a_ready(nxt);
            PG8_LDB(B0, 0, 0); PG8_LDB(B1, 0, 1); PG8_SCHED; PG8_LDA(At, 0, 0); PG8_STAGE(PG8_SA(1, 1), a1, cAo[1]);
            if constexpr (GATHER) { if (last && has_next) {
                const PG8_LAS unsigned char* sdn = side + (ui & 1) * SIDE_BYTES;
#pragma unroll
                for (int _h = 0; _h < 2; ++_h)
#pragma unroll
                    for (int _i = 0; _i < 2; ++_i) { int _R, _C; stage_rc(tid * 16 + _i * 8192, _R, _C); cAo[_h][_i] = S.arow_side(nxt, _R + HALF * _h, sdn) + (unsigned)(_C * 2); } } }
            PG8_WAIT_V(8); PG8_WAIT_L(0); PG8_BAR; PG8_MMA(0, 0, At, B0); PG8_MMA(0, 1, At, B1); PG8_BAR; PG8_SCHED;
            PG8_LDA(At, 0, 1); PG8_STAGE(PG8_SB(0, 0), b2, voffB); PG8_STAGE(PG8_SB(0, 1), b2 + hstep, voffB); PG8_STAGE(PG8_SA(0, 0), a2, cAo[0]);
            PG8_WAIT_V(8); PG8_WAIT_L(0); PG8_BAR; PG8_MMA(1, 0, At, B0); PG8_MMA(1, 1, At, B1); PG8_BAR; PG8_SCHED;
            PG8_LDB(B0, 1, 0); PG8_LDB(B1, 1, 1); PG8_SCHED; PG8_LDA(At, 1, 0); PG8_STAGE(PG8_SA(0, 1), a2, cAo[1]);
            PG8_WAIT_V(8); PG8_WAIT_L(0); PG8_BAR; PG8_MMA(0, 0, At, B0); PG8_MMA(0, 1, At, B1); PG8_BAR; PG8_SCHED;
            PG8_LDA(At, 1, 1); PG8_STAGE(PG8_SB(1, 0), b3, voffB); PG8_STAGE(PG8_SB(1, 1), b3 + hstep, voffB); PG8_STAGE(PG8_SA(1, 0), a3, cAo[0]);
            PG8_WAIT_V(8); PG8_WAIT_L(0); PG8_BAR; PG8_MMA(1, 0, At, B0); PG8_MMA(1, 1, At, B1); PG8_BAR; PG8_SCHED;
        }
        if constexpr (ALIGN_EPI) { if (wr == 0) PG8_BAR; }
        if constexpr (FP8) asm volatile("s_nop 15\n\ts_nop 15" ::: "memory");
        if constexpr (!Epi::AFTER_DRAIN) { PG8_SCHED; E(acc, cur, wr, wc, fr, fq, side + (ui & 1) * SIDE_BYTES); S.done(cur); PG8_SCHED; }
        if (!has_next) break;
#pragma unroll
        for (int a = 0; a < 2; ++a)
#pragma unroll
            for (int b = 0; b < 2; ++b)
#pragma unroll
                for (int m = 0; m < 4; ++m)
#pragma unroll
                    for (int n = 0; n < 2; ++n) { acc[a][b][m][n] = (f32x4){0.f, 0.f, 0.f, 0.f}; if constexpr (FP8) asm volatile("" : "+v"(acc[a][b][m][n])); }
        cur = nxt; cA = nA; cB = nB; ++ui;
        if constexpr (ALIGN_EPI) { if (wr == 1) PG8_BAR; }
    }
    PG8_WAIT_V(0);
    if constexpr (!ALIGN_EPI) { if (wr == 0) PG8_BAR; }
    PG8_BAR;
    if constexpr (Epi::AFTER_DRAIN) { E.fused(acc, cur, wr, wc, fr, fq, lds, wid, lane); S.done(cur); }
#undef PG8_SA
#undef PG8_SB
#undef PG8_STAGE
#undef PG8_LDA
#undef PG8_LDB
#undef PG8_MMA
#undef PG8_WAIT_V
#undef PG8_WAIT_L
#undef PG8_BAR
#undef PG8_SCHED
#undef PG8_SETOFFS
}
}

constexpr int NB = 8, SEQ = 4096, DM = 1024, MROWS = NB * SEQ, NLAYER = 2;
constexpr int NPROJ = 4608, INW = 4616;
constexpr int C_Q = 0, C_K = 512, C_V = 1024, C_Z = 1536, C_XS = 2048, C_SB = 3072, C_SC = 3584, C_SH = 4096;
constexpr int MIXW = 1536, NEXP = 32, TOPK = 4, FF = 1024;
constexpr float ALPHA = 1.4142135623730951f;
constexpr float LN_EPS = 1e-5f, RMS_EPS = 1e-5f;
constexpr float QSCALE = 0.125f * 1.4426950408889634f;

constexpr size_t MiB = 1u << 20;
constexpr size_t WS_CTL = 0, CTL_ZERO_BYTES = 1 * MiB;
constexpr size_t WS_ROPE = 1 * MiB;
constexpr size_t WS_WDT = 2 * MiB;
constexpr size_t WS_ROUT = 2 * MiB + 65536;
constexpr size_t WS_WIN = 4 * MiB;
constexpr size_t WS_WOUT = 24 * MiB;
constexpr size_t WS_WGU = 32 * MiB;
constexpr size_t WS_WDN = 288 * MiB;
constexpr size_t WS_XB = 416 * MiB;
constexpr size_t WS_XF = 480 * MiB;
constexpr size_t WS_XF2 = 608 * MiB;
constexpr size_t WS_PROJ = 736 * MiB;
constexpr size_t WS_DT = 1024 * MiB;
constexpr size_t WS_DTS = 1025 * MiB;
constexpr size_t WS_ACUM = 1026 * MiB;
constexpr size_t WS_LSE = 1027 * MiB;
constexpr size_t WS_OP = 1030 * MiB;
constexpr size_t WS_U = 1126 * MiB;
constexpr size_t WS_G = 1190 * MiB;
constexpr size_t WS_ST = 1222 * MiB;
constexpr size_t WS_YD = 1286 * MiB;
constexpr size_t WS_MIXED = 1350 * MiB;
constexpr size_t WS_MIXF = 1446 * MiB;
constexpr size_t WS_TOPE = 1574 * MiB;
constexpr size_t WS_TOPG = 1575 * MiB;
constexpr size_t WS_ROWTOK = 1576 * MiB;
constexpr size_t WS_ROWGATE = 1580 * MiB;
constexpr size_t WS_H = 736 * MiB;
constexpr size_t WS_YB = 1030 * MiB;
constexpr size_t WS_END = 1584 * MiB;
constexpr int CW_TMO = 0;
constexpr int CW_CNT = 64;
constexpr int CW_BAR = 4096;
constexpr int CW_SEAM = 16384;

constexpr int RING_OFF = 0, RING_BYTES = 131072;
constexpr int LDSCTL_OFF = 155648;
constexpr int L_MISC = LDSCTL_OFF;
constexpr int L_TSTART = LDSCTL_OFF + 256;
constexpr int L_CNT = LDSCTL_OFF + 512;
constexpr int L_LCNT = LDSCTL_OFF + 640;
constexpr int L_LBASE = LDSCTL_OFF + 768;
constexpr int L_UNITS = LDSCTL_OFF + 1024;
constexpr int L_UNITSN = LDSCTL_OFF + 2048;
constexpr int LDS_BYTES = 163840;

#define GAS __attribute__((address_space(1)))
#define LAS __attribute__((address_space(3)))
typedef unsigned short bf16;
typedef unsigned v4u __attribute__((ext_vector_type(4)));
typedef unsigned v2u __attribute__((ext_vector_type(2)));
typedef float f32x4 __attribute__((ext_vector_type(4)));
typedef float f32x16 __attribute__((ext_vector_type(16)));
typedef short bf16x8 __attribute__((ext_vector_type(8)));
typedef GAS unsigned gu32;
#define RLX_AGENT __ATOMIC_RELAXED, __HIP_MEMORY_SCOPE_AGENT
#define LDS_WAIT() asm volatile("s_waitcnt lgkmcnt(0)" ::: "memory")
#define VM_WAIT() asm volatile("s_waitcnt vmcnt(0)" ::: "memory")
__device__ __forceinline__ unsigned f2bf(float f) { unsigned u = __builtin_bit_cast(unsigned, f); return (u + 0x7fffu + ((u >> 16) & 1u)) >> 16; }
__device__ __forceinline__ unsigned pk2(float lo, float hi) { unsigned r; asm volatile("v_cvt_pk_bf16_f32 %0, %1, %2" : "=v"(r) : "v"(lo), "v"(hi)); return r; }
__device__ __forceinline__ float bf2f(unsigned short b) { return __builtin_bit_cast(float, (unsigned)b << 16); }
__device__ __forceinline__ float bflo(unsigned w) { return __builtin_bit_cast(float, w << 16); }
__device__ __forceinline__ float bfhi(unsigned w) { return __builtin_bit_cast(float, w & 0xffff0000u); }
__device__ __forceinline__ float siluf(float x) { return x * __builtin_amdgcn_rcpf(1.0f + __builtin_amdgcn_exp2f(-1.4426950408889634f * x)); }
#define XB_TMO      128
#define XB_XCNT(j)  (256  + 64 * (j))
#define XB_XSUB(j)  (1280 + 64 * (j))
#define XB_XGEN(j)  (2304 + 64 * (j))
#define XB_TOP      3328
#define XB_TOPGEN   3392
#define XCD_BAR_WORDS 3456
#define XB_SPIN_CAP (1u << 18)

__device__ __forceinline__ unsigned xb_ld(unsigned* p)              { return __hip_atomic_load(p, __ATOMIC_RELAXED, __HIP_MEMORY_SCOPE_AGENT); }
__device__ __forceinline__ unsigned xb_add(unsigned* p, unsigned v) { return __hip_atomic_fetch_add(p, v, __ATOMIC_RELAXED, __HIP_MEMORY_SCOPE_AGENT); }
__device__ __forceinline__ unsigned xb_xcc_id() { return (unsigned)__builtin_amdgcn_s_getreg((3 << 11) | 20) & 0xFu; }
#define XB_SPIN(cond, bar) do { unsigned _sp = 0; while (cond) { __builtin_amdgcn_s_sleep(1); \
    if ((++_sp & 255u) == 0u) { if (xb_ld(&(bar)[XB_TMO])) break; if (_sp > XB_SPIN_CAP) { atomicAdd(&(bar)[XB_TMO], 1u); break; } } } } while (0)

struct XcdBarrier {
    unsigned* bar; unsigned x;
    volatile LAS unsigned* st;
};

__device__ __forceinline__ XcdBarrier xcd_barrier_post(unsigned* bar, volatile LAS unsigned* st) {
    XcdBarrier b; b.bar = bar; b.x = xb_xcc_id(); b.st = st;
    if (threadIdx.x == 0) (void)xb_add(&bar[XB_XCNT(b.x)], 1u);
    return b;
}
__device__ __forceinline__ void xcd_barrier_complete(unsigned* bar, unsigned x, unsigned& nloc, unsigned& nx) {
    const unsigned G = gridDim.x * gridDim.y * gridDim.z;
    unsigned sum, cnt, mine, sp = 0u;
    for (;;) {
        sum = 0u; cnt = 0u; mine = 0u;
#pragma unroll
        for (unsigned j = 0; j < 16; ++j) { const unsigned c = xb_ld(&bar[XB_XCNT(j)]); sum += c; cnt += (c > 0u) ? 1u : 0u; mine = (j == x) ? c : mine; }
        if (sum == G) break;
        __builtin_amdgcn_s_sleep(1);
        if ((++sp & 255u) == 0u) { if (xb_ld(&bar[XB_TMO])) break; if (sp > XB_SPIN_CAP) { atomicAdd(&bar[XB_TMO], 1u); break; } }
    }
    nloc = mine > 0u ? mine : 1u; nx = cnt > 0u ? cnt : 1u;
}

__device__ __forceinline__ void xcd_barrier(const XcdBarrier& b) {
    asm volatile("s_waitcnt vmcnt(0)" ::: "memory");
    __syncthreads();
    if (threadIdx.x == 0) {
        unsigned* bar = b.bar;
        __builtin_amdgcn_s_waitcnt(0);
        unsigned nloc = b.st[0], nx = b.st[1];
        if (nloc == 0u) { xcd_barrier_complete(bar, b.x, nloc, nx); b.st[0] = nloc; b.st[1] = nx; }
        const unsigned old = xb_add(&bar[XB_XSUB(b.x)], 1u);
        const unsigned gen = old / nloc;
        if (old + 1u == (gen + 1u) * nloc) {
            __builtin_amdgcn_fence(__ATOMIC_RELEASE, "agent");
            asm volatile("s_waitcnt vmcnt(0)" ::: "memory");
            const unsigned og = xb_add(&bar[XB_TOP], 1u);
            const unsigned tg = og / nx;
            if (og + 1u == (tg + 1u) * nx) xb_add(&bar[XB_TOPGEN], 1u);
            else XB_SPIN(xb_ld(&bar[XB_TOPGEN]) == tg, bar);
            __builtin_amdgcn_fence(__ATOMIC_ACQUIRE, "agent");
            xb_add(&bar[XB_XGEN(b.x)], 1u);
            asm volatile("s_waitcnt vmcnt(0)" ::: "memory");
        } else {
            XB_SPIN(xb_ld(&bar[XB_XGEN(b.x)]) == gen, bar);
            __builtin_amdgcn_fence(__ATOMIC_ACQUIRE, "agent");
            asm volatile("s_waitcnt vmcnt(0)" ::: "memory");
        }
    }
    __syncthreads();
}

constexpr float SC_X = 4.f, SC_WGU = 32.f, SC_H = 4.f, SC_WDN = 4.f, SC_Y = 16.f, SC_WIN = 32.f, SC_O = 32.f;
__device__ __forceinline__ float wave_sum(float v) {
#pragma unroll
    for (int o = 1; o < 64; o <<= 1) v += __shfl_xor(v, o);
    return v;
}
__device__ __forceinline__ int win_dest_row(int n) {
    if (n < 1024) { const int hh = n >> 6, d = n & 63; const int p = (d < 32) ? (8 * (d >> 2) + (d & 3)) : (8 * ((d - 32) >> 2) + 4 + (d & 3)); return hh * 64 + p; }
    if (n < 3072) return n;
    if (n < 3080) return -1;
    return n - 8;
}
__device__ __forceinline__ int wgu_dest_row(int n) { return n < 1024 ? ((n >> 7) * 256 + (n & 127)) : (((n - 1024) >> 7) * 256 + 128 + ((n - 1024) & 127)); }
template <int MAP>
__device__ __forceinline__ void p0_transpose_item(const float* W, int K, int N, bf16* WT, float* wdt, LAS float* scr, int kb, int nb, int lane) {
    const int k0 = 64 * kb, n0 = 32 * nb;
    const int nn = n0 + (lane & 31); const bool nok = nn < N;
#pragma unroll 8
    for (int i = 0; i < 32; ++i) { const int kk = 2 * i + (lane >> 5); scr[kk * 33 + (lane & 31)] = nok ? W[(size_t)(k0 + kk) * N + nn] : 0.f; }
    LDS_WAIT(); asm volatile("" ::: "memory");
    const int c = lane & 7;
#pragma unroll
    for (int j = 0; j < 4; ++j) { const int n = (lane >> 3) + 8 * j; const LAS float* s = scr + (8 * c) * 33 + n;
        const int nsrc = n0 + n; if (nsrc >= N) continue;
        int drow = nsrc; if (MAP == 1) drow = win_dest_row(nsrc); if (MAP == 2) drow = wgu_dest_row(nsrc);
        if (MAP == 1 && drow < 0) { float* d = wdt + (size_t)(nsrc - 3072) * 1024 + k0 + 8 * c;
#pragma unroll
            for (int q = 0; q < 8; ++q) d[q] = s[q * 33]; continue; }
        v4u o; o.x = pk2(s[0 * 33], s[1 * 33]); o.y = pk2(s[2 * 33], s[3 * 33]); o.z = pk2(s[4 * 33], s[5 * 33]); o.w = pk2(s[6 * 33], s[7 * 33]);
        *(GAS v4u*)(WT + (size_t)drow * K + k0 + 8 * c) = o; }
    LDS_WAIT(); asm volatile("" ::: "memory");
}
template <int MAP>
__device__ __forceinline__ void p0_transpose_item64(const float* W, int K, int N, bf16* WT, float* wdt, LAS float* scr, int kb, int nb, int lane) {
    const int k0 = 64 * kb, n0 = 64 * nb;
    const bool lok = (n0 + 4 * (lane & 15) + 3) < N;
    f32x4 ld[16];
#pragma unroll
    for (int i = 0; i < 16; ++i) ld[i] = lok ? *(const f32x4*)(W + (size_t)(k0 + 4 * i + (lane >> 4)) * N + n0 + 4 * (lane & 15)) : (f32x4){0.f, 0.f, 0.f, 0.f};
#pragma unroll
    for (int i = 0; i < 16; ++i) *(LAS f32x4*)(scr + (4 * i + (lane >> 4)) * 64 + 4 * (lane & 15)) = ld[i];
    LDS_WAIT(); asm volatile("" ::: "memory");
    const int nsrc = n0 + lane;
    if (nsrc < N) {
        int drow = nsrc; if (MAP == 1) drow = win_dest_row(nsrc);
        if (MAP == 1 && drow < 0) { float* d = wdt + (size_t)(nsrc - 3072) * 1024 + k0;
#pragma unroll
            for (int q = 0; q < 16; ++q) *(f32x4*)(d + 4 * q) = (f32x4){scr[(4 * q) * 64 + lane], scr[(4 * q + 1) * 64 + lane], scr[(4 * q + 2) * 64 + lane], scr[(4 * q + 3) * 64 + lane]}; }
        else { GAS v4u* d = (GAS v4u*)(WT + (size_t)drow * K + k0);
#pragma unroll
            for (int q = 0; q < 8; ++q) { v4u o; o.x = pk2(scr[(8 * q) * 64 + lane], scr[(8 * q + 1) * 64 + lane]); o.y = pk2(scr[(8 * q + 2) * 64 + lane], scr[(8 * q + 3) * 64 + lane]);
                o.z = pk2(scr[(8 * q + 4) * 64 + lane], scr[(8 * q + 5) * 64 + lane]); o.w = pk2(scr[(8 * q + 6) * 64 + lane], scr[(8 * q + 7) * 64 + lane]); d[q] = o; } } }
    LDS_WAIT(); asm volatile("" ::: "memory");
}
struct SubT { const float* src; unsigned char* dst; int N; int n0; int mode; float scale; };
__device__ __forceinline__ SubT fp8_subtile(int item, int half, const float* wgu, const float* wdn, const float* win, unsigned char* WG8, unsigned char* WD8, unsigned char* WI8, int lane) {
    SubT t; int kb, nb;
    if (item < 64 * 256) { const int le = item >> 8, r = item & 255; kb = r >> 5; nb = r & 31; t.N = 2048; t.mode = 1; t.scale = SC_WGU;
        t.src = wgu + (size_t)le * 1024 * 2048; t.dst = WG8 + (size_t)le * 2048 * 1024; }
    else if (item < 64 * 256 + 64 * 128) { const int it2 = item - 64 * 256; const int le = it2 >> 7, r = it2 & 127; kb = r >> 4; nb = r & 15; t.N = 1024; t.mode = 0; t.scale = SC_WDN;
        t.src = wdn + (size_t)le * 1024 * 1024; t.dst = WD8 + (size_t)le * 1024 * 1024; }
    else { const int it3 = item - (64 * 256 + 64 * 128); const int l = it3 / 192, r = it3 % 192; kb = r / 24; nb = r % 24; t.N = INW; t.mode = 2; t.scale = SC_WIN;
        t.src = win + (size_t)l * 1024 * INW; t.dst = WI8 + (size_t)l * 1536 * 1024; }
    const int k0 = 128 * kb + 64 * half; t.n0 = 64 * nb;
    t.src += (size_t)(k0 + (lane >> 4)) * t.N + t.n0 + 4 * (lane & 15);
    t.dst += (size_t)k0;
    return t;
}
__device__ __forceinline__ void fp8_sub_load(const SubT& t, f32x4 (&ld)[16]) {
#pragma unroll
    for (int i = 0; i < 16; ++i) ld[i] = __builtin_nontemporal_load((const f32x4*)(t.src + (size_t)(4 * i) * t.N));
}
__device__ __forceinline__ void fp8_sub_process(const SubT& t, const f32x4 (&ld)[16], LAS float* scr, int lane) {
#pragma unroll
    for (int i = 0; i < 16; ++i) *(LAS f32x4*)(scr + (4 * i + (lane >> 4)) * 64 + 4 * (lane & 15)) = ld[i];
    LDS_WAIT(); asm volatile("" ::: "memory");
    unsigned w[16];
#pragma unroll
    for (int q = 0; q < 16; ++q) w[q] = pg8::pk4_fp8(scr[(4 * q + 0) * 64 + lane] * t.scale, scr[(4 * q + 1) * 64 + lane] * t.scale, scr[(4 * q + 2) * 64 + lane] * t.scale, scr[(4 * q + 3) * 64 + lane] * t.scale);
    LDS_WAIT(); asm volatile("" ::: "memory");
    LAS unsigned char* t2 = (LAS unsigned char*)scr;
#pragma unroll
    for (int q = 0; q < 4; ++q) *(LAS v4u*)(t2 + lane * 80 + 16 * q) = (v4u){w[4 * q], w[4 * q + 1], w[4 * q + 2], w[4 * q + 3]};
    LDS_WAIT(); asm volatile("" ::: "memory");
#pragma unroll
    for (int q = 0; q < 4; ++q) { const int n = 16 * q + (lane >> 2); const v4u v = *(const LAS v4u*)(t2 + n * 80 + 16 * (lane & 3));
        const int nn = (t.mode == 1) ? wgu_dest_row(t.n0 + n) : (t.mode == 2) ? win_dest_row(t.n0 + n) : (t.n0 + n);
        *(GAS v4u*)(t.dst + (size_t)nn * 1024 + 16 * (lane & 3)) = v; }
    LDS_WAIT(); asm volatile("" ::: "memory");
}
__device__ __forceinline__ void row_dt(const f32x4 (&v)[4], const float* wdt, float* dst, int lane) {
    float r[8];
#pragma unroll
    for (int jj = 0; jj < 8; ++jj) { float s = 0.f;
#pragma unroll
        for (int j = 0; j < 4; ++j) { const f32x4 w = *(const f32x4*)(wdt + jj * 1024 + 4 * lane + 256 * j); s += v[j][0] * w[0] + v[j][1] * w[1] + v[j][2] * w[2] + v[j][3] * w[3]; }
        r[jj] = wave_sum(s); }
    if (lane == 0) { *(f32x4*)dst = (f32x4){r[0], r[1], r[2], r[3]}; *(f32x4*)(dst + 4) = (f32x4){r[4], r[5], r[6], r[7]}; }
}
__device__ __forceinline__ void load_wdt(const float* wdt, f32x4 (&w)[8][4], int lane) {
#pragma unroll
    for (int jj = 0; jj < 8; ++jj)
#pragma unroll
        for (int j = 0; j < 4; ++j) w[jj][j] = *(const f32x4*)(wdt + jj * 1024 + 4 * lane + 256 * j);
}
__device__ __forceinline__ void row_dt_w(const f32x4 (&v)[4], const f32x4 (&w)[8][4], float* dst, int lane) {
    float r[8];
#pragma unroll
    for (int jj = 0; jj < 8; ++jj) { float s = 0.f;
#pragma unroll
        for (int j = 0; j < 4; ++j) s += v[j][0] * w[jj][j][0] + v[j][1] * w[jj][j][1] + v[j][2] * w[jj][j][2] + v[j][3] * w[jj][j][3];
        r[jj] = wave_sum(s); }
    if (lane == 0) { *(f32x4*)dst = (f32x4){r[0], r[1], r[2], r[3]}; *(f32x4*)(dst + 4) = (f32x4){r[4], r[5], r[6], r[7]}; }
}
__device__ __forceinline__ void row_dt_win(const f32x4 (&v)[4], const float* win, float* dst, int lane) {
    float r[8];
#pragma unroll
    for (int jj = 0; jj < 8; ++jj) r[jj] = 0.f;
#pragma unroll
    for (int j = 0; j < 4; ++j)
#pragma unroll
        for (int e = 0; e < 4; ++e) { const float* wp = win + (size_t)(4 * lane + 256 * j + e) * INW + 3072; const f32x4 w0 = *(const f32x4*)wp, w1 = *(const f32x4*)(wp + 4); const float x = v[j][e];
            r[0] += x * w0[0]; r[1] += x * w0[1]; r[2] += x * w0[2]; r[3] += x * w0[3]; r[4] += x * w1[0]; r[5] += x * w1[1]; r[6] += x * w1[2]; r[7] += x * w1[3]; }
#pragma unroll
    for (int jj = 0; jj < 8; ++jj) r[jj] = wave_sum(r[jj]);
    if (lane == 0) { *(f32x4*)dst = (f32x4){r[0], r[1], r[2], r[3]}; *(f32x4*)(dst + 4) = (f32x4){r[4], r[5], r[6], r[7]}; }
}
template <bool W8, bool WF>
__device__ __forceinline__ void ln_row(f32x4 (&v)[4], const float* gam, const float* bet, float* of32, bf16* ob16, unsigned char* o8, float s8, int lane) {
    float s = 0.f;
#pragma unroll
    for (int j = 0; j < 4; ++j) s += (v[j][0] + v[j][1]) + (v[j][2] + v[j][3]);
    const float mean = wave_sum(s) * (1.f / DM); float s2 = 0.f;
#pragma unroll
    for (int j = 0; j < 4; ++j) { v[j] = v[j] - mean; s2 += (v[j][0] * v[j][0] + v[j][1] * v[j][1]) + (v[j][2] * v[j][2] + v[j][3] * v[j][3]); }
    const float rstd = 1.f / sqrtf(wave_sum(s2) * (1.f / DM) + LN_EPS);
#pragma unroll
    for (int j = 0; j < 4; ++j) { const f32x4 g = *(const f32x4*)(gam + 4 * lane + 256 * j), b = *(const f32x4*)(bet + 4 * lane + 256 * j);
        v[j] = v[j] * rstd * g + b;
        if (WF) *(f32x4*)(of32 + 4 * lane + 256 * j) = v[j];
        v2u w; w.x = pk2(v[j][0], v[j][1]); w.y = pk2(v[j][2], v[j][3]); *(v2u*)(ob16 + 4 * lane + 256 * j) = w;
        if (W8) *(unsigned*)(o8 + 4 * lane + 256 * j) = pg8::pk4_fp8(v[j][0] * s8, v[j][1] * s8, v[j][2] * s8, v[j][3] * s8); }
}


typedef short v4i16_t __attribute__((ext_vector_type(4)));
__device__ __forceinline__ bf16x8 tr_pair(const LAS unsigned char* p0, const LAS unsigned char* p1) {
    const v4i16_t a = __builtin_amdgcn_ds_read_tr16_b64_v4i16((LAS v4i16_t*)p0), b = __builtin_amdgcn_ds_read_tr16_b64_v4i16((LAS v4i16_t*)p1);
    return (bf16x8){a[0], a[1], a[2], a[3], b[0], b[1], b[2], b[3]};
}
__device__ __forceinline__ int crow16(int r, int hi) { return (r & 3) + 8 * (r >> 2) + 4 * hi; }
constexpr int AK_PITCH = 144, AV_PITCH = 192, AK_TILE = 32 * AK_PITCH, AV_TILE = 32 * AV_PITCH;
constexpr int AT_K = 0, AT_V = 12 * AK_TILE;
struct AttnItem { int p, b, h, d, r, qt0; };
__device__ __forceinline__ AttnItem attn_item(int I) { AttnItem a; a.p = I >> 10; const int rem = I & 1023; a.b = rem >> 7; a.h = (rem >> 4) & 7; const int grp = rem & 15;
    a.d = (a.p == 0) ? 1 : (a.p == 1) ? 4 : 16; const int tpr = 128 / a.d; const int T = grp * 8; a.r = T / tpr; a.qt0 = T % tpr; return a; }
__device__ __forceinline__ void attn_request(const bf16* PROJ, const AttnItem& a, v4u (&st)[12], int tid) {
    const int rr = tid >> 4, ch = tid & 15; const int col = (ch < 8 ? C_K : C_V - 64) + a.h * 64 + ch * 8;
#pragma unroll
    for (int tl = 0; tl < 12; ++tl) { const int kt = a.qt0 - 4 + tl; st[tl] = (v4u){0u, 0u, 0u, 0u};
        if (kt >= 0) { const size_t row = (size_t)a.b * SEQ + (size_t)(32 * kt + rr) * a.d + a.r; st[tl] = *(const v4u*)(PROJ + row * NPROJ + col); } }
}
__device__ __forceinline__ void attn_deposit(LAS unsigned char* al, const v4u (&st)[12], int tid) {
    const int rr = tid >> 4, ch = tid & 15;
    LAS unsigned char* dst = (ch < 8) ? (al + AT_K + rr * AK_PITCH + ch * 16) : (al + AT_V + rr * AV_PITCH + (ch - 8) * 16); const int tstep = (ch < 8) ? AK_TILE : AV_TILE;
#pragma unroll
    for (int tl = 0; tl < 12; ++tl) *(LAS v4u*)(dst + tl * tstep) = st[tl];
}
__device__ __forceinline__ void attn_wave_compute(const bf16* PROJ, bf16* OPp, float* LSEp, const AttnItem& a, const LAS unsigned char* al, int wave, int lane) {
    const int i = lane & 31, h2 = lane >> 5; const int qt = a.qt0 + wave;
    const size_t rowq = (size_t)a.b * SEQ + (size_t)(32 * qt + i) * a.d + a.r;
    bf16x8 qf[4];
    { const bf16* qp = PROJ + rowq * NPROJ + C_Q + a.h * 64 + 8 * h2;
#pragma unroll
      for (int s = 0; s < 4; ++s) qf[s] = *(const bf16x8*)(qp + 16 * s); }
    f32x16 o0 = {}, o1 = {}; float mrun = -INFINITY, lrun = 0.f;
    const int kt0 = qt > 4 ? qt - 4 : 0;
    const LAS unsigned char* krd = al + AT_K + i * AK_PITCH + 16 * h2;
    const LAS unsigned char* trb = al + AT_V + (4 * h2 + ((lane & 15) >> 2)) * AV_PITCH + (16 * ((lane >> 4) & 1) + 4 * (lane & 3)) * 2;
    f32x16 snext = {};
    { const LAS unsigned char* kp = krd + (kt0 - a.qt0 + 4) * AK_TILE;
#pragma unroll
      for (int s = 0; s < 4; ++s) snext = __builtin_amdgcn_mfma_f32_32x32x16_bf16(*(const LAS bf16x8*)(kp + 32 * s), qf[s], snext, 0, 0, 0); }
#pragma unroll 1
    for (int kt = kt0; kt <= qt; ++kt) {
        const int tl = kt - a.qt0 + 4;
        const LAS unsigned char* vp = trb + tl * AV_TILE;
        f32x16 sacc = snext;
        if (kt < qt) { const LAS unsigned char* kp = krd + (tl + 1) * AK_TILE; snext = (f32x16){};
#pragma unroll
            for (int s = 0; s < 4; ++s) snext = __builtin_amdgcn_mfma_f32_32x32x16_bf16(*(const LAS bf16x8*)(kp + 32 * s), qf[s], snext, 0, 0, 0); }
        if (kt == qt) {
#pragma unroll
            for (int rg = 0; rg < 16; ++rg) if (crow16(rg, h2) > i) sacc[rg] = -INFINITY;
        }
        if (kt + 4 == qt) {
#pragma unroll
            for (int rg = 0; rg < 16; ++rg) if (crow16(rg, h2) < i) sacc[rg] = -INFINITY;
        }
        float mx = sacc[0];
#pragma unroll
        for (int rg = 1; rg < 16; ++rg) mx = fmaxf(mx, sacc[rg]);
        mx = fmaxf(mx, __shfl_xor(mx, 32));
        const float mnew = fmaxf(mrun, mx), alpha = __builtin_amdgcn_exp2f(mrun - mnew); mrun = mnew;
        float ps = 0.f;
#pragma unroll
        for (int rg = 0; rg < 16; ++rg) { sacc[rg] = __builtin_amdgcn_exp2f(sacc[rg] - mnew); ps += sacc[rg]; }
        lrun = lrun * alpha + ps;
#pragma unroll
        for (int rg = 0; rg < 16; ++rg) { o0[rg] *= alpha; o1[rg] *= alpha; }
        bf16x8 pf[2];
#pragma unroll
        for (int ks = 0; ks < 2; ++ks) { v4u w; w.x = pg8::cvt_pk_bf16(sacc[8 * ks + 0], sacc[8 * ks + 1]); w.y = pg8::cvt_pk_bf16(sacc[8 * ks + 2], sacc[8 * ks + 3]); w.z = pg8::cvt_pk_bf16(sacc[8 * ks + 4], sacc[8 * ks + 5]); w.w = pg8::cvt_pk_bf16(sacc[8 * ks + 6], sacc[8 * ks + 7]); pf[ks] = __builtin_bit_cast(bf16x8, w); }
#pragma unroll
        for (int ks = 0; ks < 2; ++ks) {
            const bf16x8 v0 = tr_pair(vp + (16 * ks) * AV_PITCH, vp + (16 * ks + 8) * AV_PITCH);
            const bf16x8 v1 = tr_pair(vp + (16 * ks) * AV_PITCH + 64, vp + (16 * ks + 8) * AV_PITCH + 64);
            o0 = __builtin_amdgcn_mfma_f32_32x32x16_bf16(v0, pf[ks], o0, 0, 0, 0);
            o1 = __builtin_amdgcn_mfma_f32_32x32x16_bf16(v1, pf[ks], o1, 0, 0, 0);
        }
    }
    const float lt = lrun + __shfl_xor(lrun, 32); const float il = 1.0f / lt;
    unsigned char* op = (unsigned char*)OPp + rowq * 512 + a.h * 64 + 4 * h2;
    const float ils = il * SC_O;
#pragma unroll
    for (int g4 = 0; g4 < 4; ++g4) {
        *(unsigned*)(op + 8 * g4) = pg8::pk4_fp8(o0[4 * g4 + 0] * ils, o0[4 * g4 + 1] * ils, o0[4 * g4 + 2] * ils, o0[4 * g4 + 3] * ils);
        *(unsigned*)(op + 32 + 8 * g4) = pg8::pk4_fp8(o1[4 * g4 + 0] * ils, o1[4 * g4 + 1] * ils, o1[4 * g4 + 2] * ils, o1[4 * g4 + 3] * ils); }
    if (h2 == 0) LSEp[rowq * 8 + a.h] = mrun + log2f(lt);
}
__device__ __forceinline__ void attn_phase(LAS unsigned char* al, const bf16* PROJ, bf16* OP, float* LSE, int bid, int G, int tid, int wave, int lane) {
    v4u st[12];
    int I = bid;
    if (I < 3072) { const AttnItem a = attn_item(I); attn_request(PROJ, a, st, tid); }
    for (; I < 3072; I += G) {
        const AttnItem a = attn_item(I);
        __syncthreads();
        attn_deposit(al, st, tid);
        __syncthreads();
        if (I + G < 3072) { const AttnItem n = attn_item(I + G); attn_request(PROJ, n, st, tid); }
        attn_wave_compute(PROJ, (bf16*)((unsigned char*)OP + (size_t)a.p * MROWS * 512), LSE + (size_t)a.p * MROWS * 8, a, al, wave, lane);
    }
    __syncthreads();
}

constexpr int SS_DTS = 0, SS_ACUM = 2048, SS_TMP = 4096, SS_SSX = 6144, SS_IMG = 8192;
constexpr int S1_PB = 320, S1_PX = 576;
constexpr int S1_B = SS_IMG, S1_X = SS_IMG + 128 * S1_PB;
constexpr int S3_PBC = 272, S3_PX = 576;
constexpr int S3_B = SS_IMG, S3_C = S3_B + 128 * S3_PBC, S3_X = S3_C + 128 * S3_PBC;

__device__ __forceinline__ void ssd_prep(LAS unsigned char* sl, const float* DT, const float* dtb, const float* alog, size_t row0, int g, int tid, int lane, int wave) {
    LAS float* dts = (LAS float*)(sl + SS_DTS); LAS float* acum = (LAS float*)(sl + SS_ACUM); LAS float* tmp = (LAS float*)(sl + SS_TMP);
    { const int l = tid >> 2, hq = tid & 3; const float x = DT[(row0 + l) * 8 + 4 * g + hq] + dtb[4 * g + hq];
      const float dt = x > 20.f ? x : log1pf(__expf(x)); dts[hq * 128 + l] = dt; tmp[hq * 128 + l] = dt * (-__expf(alog[4 * g + hq])); }
    __syncthreads();
    if (wave < 4) { const float v0 = tmp[wave * 128 + 2 * lane], v1 = tmp[wave * 128 + 2 * lane + 1]; float s = v0 + v1;
#pragma unroll
        for (int off = 1; off < 64; off <<= 1) { const float t = __shfl_up(s, off); if (lane >= off) s += t; }
        acum[wave * 128 + 2 * lane] = s - v1; acum[wave * 128 + 2 * lane + 1] = s; }
    __syncthreads();
}
template <int NCOLS, int FACMODE>
__device__ __forceinline__ void conv_tile(const bf16* PROJ, size_t row0, int t0, int pcol0, const float* cw, const float* cb, int cch0, LAS unsigned char* dst, int pitch, const LAS unsigned char* sl, int hq0, int tid) {
    constexpr int NCH8 = NCOLS / 8, NSEG = 512 / NCH8, RPS = 128 / NSEG;
    const int c8 = tid % NCH8, seg = tid / NCH8, l0 = seg * RPS;
    float w[4][8], bias[8], hst[3][8];
#pragma unroll
    for (int k = 0; k < 4; ++k) { const f32x4 a = *(const f32x4*)(cw + k * 1024 + cch0 + c8 * 8), b = *(const f32x4*)(cw + k * 1024 + cch0 + c8 * 8 + 4);
        w[k][0] = a[0]; w[k][1] = a[1]; w[k][2] = a[2]; w[k][3] = a[3]; w[k][4] = b[0]; w[k][5] = b[1]; w[k][6] = b[2]; w[k][7] = b[3]; }
    { const f32x4 a = *(const f32x4*)(cb + cch0 + c8 * 8), b = *(const f32x4*)(cb + cch0 + c8 * 8 + 4);
      bias[0] = a[0]; bias[1] = a[1]; bias[2] = a[2]; bias[3] = a[3]; bias[4] = b[0]; bias[5] = b[1]; bias[6] = b[2]; bias[7] = b[3]; }
    const bf16* src = PROJ + pcol0 + c8 * 8;
#pragma unroll
    for (int k = 0; k < 3; ++k) { const int l = l0 - 3 + k; v4u v = (v4u){0u, 0u, 0u, 0u}; if (t0 + l >= 0) v = *(const v4u*)(src + (size_t)((long)row0 + l) * NPROJ);
        hst[k][0] = bflo(v.x); hst[k][1] = bfhi(v.x); hst[k][2] = bflo(v.y); hst[k][3] = bfhi(v.y); hst[k][4] = bflo(v.z); hst[k][5] = bfhi(v.z); hst[k][6] = bflo(v.w); hst[k][7] = bfhi(v.w); }
    const LAS float* dts = (const LAS float*)(sl + SS_DTS); const LAS float* acum = (const LAS float*)(sl + SS_ACUM);
    const int hq = hq0 + (c8 * 8) / 64;
    const float alast = (FACMODE == 2) ? acum[hq * 128 + 127] : 0.f;
#pragma unroll
    for (int rr = 0; rr < RPS; ++rr) { const int l = l0 + rr; const v4u v = *(const v4u*)(src + (row0 + l) * NPROJ);
        float cur[8]; cur[0] = bflo(v.x); cur[1] = bfhi(v.x); cur[2] = bflo(v.y); cur[3] = bfhi(v.y); cur[4] = bflo(v.z); cur[5] = bfhi(v.z); cur[6] = bflo(v.w); cur[7] = bfhi(v.w);
        float f = 1.f; if (FACMODE >= 1) f = dts[hq * 128 + l]; if (FACMODE == 2) f *= __expf(alast - acum[hq * 128 + l]);
        float o[8];
#pragma unroll
        for (int e = 0; e < 8; ++e) { const float a = bias[e] + w[0][e] * hst[0][e] + w[1][e] * hst[1][e] + w[2][e] * hst[2][e] + w[3][e] * cur[e]; o[e] = siluf(a) * f;
            hst[0][e] = hst[1][e]; hst[1][e] = hst[2][e]; hst[2][e] = cur[e]; }
        v4u ov; ov.x = pk2(o[0], o[1]); ov.y = pk2(o[2], o[3]); ov.z = pk2(o[4], o[5]); ov.w = pk2(o[6], o[7]);
        *(LAS v4u*)(dst + l * pitch + c8 * 16) = ov; }
}
template <int NCOLS>
__device__ __forceinline__ void conv_load(const bf16* PROJ, size_t row0, int t0, int pcol0, int tid, v4u (&hv)[3], v4u (&rv)[128 / (512 / (NCOLS / 8))]) {
    constexpr int NCH8 = NCOLS / 8, NSEG = 512 / NCH8, RPS = 128 / NSEG;
    const int c8 = tid % NCH8, seg = tid / NCH8, l0 = seg * RPS;
    const bf16* src = PROJ + pcol0 + c8 * 8;
#pragma unroll
    for (int k = 0; k < 3; ++k) { const int l = l0 - 3 + k; hv[k] = (v4u){0u, 0u, 0u, 0u}; if (t0 + l >= 0) hv[k] = *(const v4u*)(src + (size_t)((long)row0 + l) * NPROJ); }
#pragma unroll
    for (int rr = 0; rr < RPS; ++rr) rv[rr] = *(const v4u*)(src + (row0 + l0 + rr) * NPROJ);
}
template <int NCOLS, int FACMODE>
__device__ __forceinline__ void conv_apply(const v4u (&hv)[3], const v4u (&rv)[128 / (512 / (NCOLS / 8))], const float* cw, const float* cb, int cch0, LAS unsigned char* dst, int pitch, const LAS unsigned char* sl, int hq0, int tid) {
    constexpr int NCH8 = NCOLS / 8, NSEG = 512 / NCH8, RPS = 128 / NSEG;
    const int c8 = tid % NCH8, seg = tid / NCH8, l0 = seg * RPS;
    float w[4][8], bias[8], hst[3][8];
#pragma unroll
    for (int k = 0; k < 4; ++k) { const f32x4 a = *(const f32x4*)(cw + k * 1024 + cch0 + c8 * 8), b = *(const f32x4*)(cw + k * 1024 + cch0 + c8 * 8 + 4);
        w[k][0] = a[0]; w[k][1] = a[1]; w[k][2] = a[2]; w[k][3] = a[3]; w[k][4] = b[0]; w[k][5] = b[1]; w[k][6] = b[2]; w[k][7] = b[3]; }
    { const f32x4 a = *(const f32x4*)(cb + cch0 + c8 * 8), b = *(const f32x4*)(cb + cch0 + c8 * 8 + 4);
      bias[0] = a[0]; bias[1] = a[1]; bias[2] = a[2]; bias[3] = a[3]; bias[4] = b[0]; bias[5] = b[1]; bias[6] = b[2]; bias[7] = b[3]; }
#pragma unroll
    for (int k = 0; k < 3; ++k) { const v4u v = hv[k];
        hst[k][0] = bflo(v.x); hst[k][1] = bfhi(v.x); hst[k][2] = bflo(v.y); hst[k][3] = bfhi(v.y); hst[k][4] = bflo(v.z); hst[k][5] = bfhi(v.z); hst[k][6] = bflo(v.w); hst[k][7] = bfhi(v.w); }
    const LAS float* dts = (const LAS float*)(sl + SS_DTS); const LAS float* acum = (const LAS float*)(sl + SS_ACUM);
    const int hq = hq0 + (c8 * 8) / 64;
    const float alast = (FACMODE == 2) ? acum[hq * 128 + 127] : 0.f;
#pragma unroll
    for (int rr = 0; rr < RPS; ++rr) { const int l = l0 + rr; const v4u v = rv[rr];
        float cur[8]; cur[0] = bflo(v.x); cur[1] = bfhi(v.x); cur[2] = bflo(v.y); cur[3] = bfhi(v.y); cur[4] = bflo(v.z); cur[5] = bfhi(v.z); cur[6] = bflo(v.w); cur[7] = bfhi(v.w);
        float f = 1.f; if (FACMODE >= 1) f = dts[hq * 128 + l]; if (FACMODE == 2) f *= __expf(alast - acum[hq * 128 + l]);
        float o[8];
#pragma unroll
        for (int e = 0; e < 8; ++e) { const float a = bias[e] + w[0][e] * hst[0][e] + w[1][e] * hst[1][e] + w[2][e] * hst[2][e] + w[3][e] * cur[e]; o[e] = siluf(a) * f;
            hst[0][e] = hst[1][e]; hst[1][e] = hst[2][e]; hst[2][e] = cur[e]; }
        v4u ov; ov.x = pk2(o[0], o[1]); ov.y = pk2(o[2], o[3]); ov.z = pk2(o[4], o[5]); ov.w = pk2(o[6], o[7]);
        *(LAS v4u*)(dst + l * pitch + c8 * 16) = ov; }
}
__device__ __forceinline__ void ssd_s1_unit(LAS unsigned char* sl, const bf16* PROJ, const float* DT, const float* dtb, const float* alog, const float* cw, const float* cb, float* ST, float* CDEC, int un, int tid, int lane, int wave) {
    const int g = un & 1, bc = un >> 1; const size_t row0 = (size_t)bc * 128; const int t0 = (bc & 31) * 128;
    v4u hvB[3], rvB[4], hvX[3], rvX[8];
    conv_load<128>(PROJ, row0, t0, C_XS + 512 + g * 128, tid, hvB, rvB);
    conv_load<256>(PROJ, row0, t0, C_XS + g * 256, tid, hvX, rvX);
    __syncthreads();
    ssd_prep(sl, DT, dtb, alog, row0, g, tid, lane, wave);
    conv_apply<128, 0>(hvB, rvB, cw, cb, 512 + g * 128, sl + S1_B, S1_PB, sl, 0, tid);
    conv_apply<256, 2>(hvX, rvX, cw, cb, g * 256, sl + S1_X, S1_PX, sl, 0, tid);
    if (tid < 4) CDEC[(size_t)bc * 8 + 4 * g + tid] = __expf(((const LAS float*)(sl + SS_ACUM))[tid * 128 + 127]);
    __syncthreads();
    const int hq = wave >> 1, pt = wave & 1, h2 = lane >> 5, q = (lane & 15) >> 2, pp = lane & 3, dsel = (lane >> 4) & 1;
    const LAS unsigned char* xb = sl + S1_X + (8 * h2 + q) * S1_PX + (hq * 64 + pt * 32 + 16 * dsel + 4 * pp) * 2;
    const LAS unsigned char* bb = sl + S1_B + (8 * h2 + q) * S1_PB + (16 * dsel + 4 * pp) * 2;
    f32x16 acc[4];
#pragma unroll
    for (int nt = 0; nt < 4; ++nt) acc[nt] = (f32x16){};
#pragma unroll
    for (int ks = 0; ks < 8; ++ks) { const bf16x8 a = tr_pair(xb + (16 * ks) * S1_PX, xb + (16 * ks + 4) * S1_PX);
#pragma unroll
        for (int nt = 0; nt < 4; ++nt) { const bf16x8 b = tr_pair(bb + (16 * ks) * S1_PB + nt * 64, bb + (16 * ks + 4) * S1_PB + nt * 64); acc[nt] = __builtin_amdgcn_mfma_f32_32x32x16_bf16(a, b, acc[nt], 0, 0, 0); } }
    float* sp = ST + ((size_t)(bc * 8 + 4 * g + hq) * 64 + pt * 32) * 128 + (lane & 31);
#pragma unroll
    for (int nt = 0; nt < 4; ++nt)
#pragma unroll
        for (int rg = 0; rg < 16; ++rg) sp[(size_t)crow16(rg, h2) * 128 + 32 * nt] = acc[nt][rg];
}
__device__ __forceinline__ void ssd_s3_unit(LAS unsigned char* sl, const bf16* PROJ, const float* DT, const float* dtb, const float* alog, const float* cw, const float* cb, const float* dsk, const float* ng,
                                            const bf16* HIN, bf16* MIXED, int un, int tid, int lane, int wave) {
    const int g = un & 1, bc = un >> 1; const size_t row0 = (size_t)bc * 128; const int t0 = (bc & 31) * 128;
    const int lt = wave & 3, ph = wave >> 2, lq = lane & 31, hi = lane >> 5, q = (lane & 15) >> 2, pp = lane & 3, dsel = (lane >> 4) & 1;
    const int lrow = 32 * lt + lq;
    const size_t grow = row0 + lrow;
    v4u hvB[3], rvB[4], hvC[3], rvC[4], hvX[3], rvX[8];
    conv_load<128>(PROJ, row0, t0, C_XS + 512 + g * 128, tid, hvB, rvB);
    conv_load<128>(PROJ, row0, t0, C_XS + 768 + g * 128, tid, hvC, rvC);
    conv_load<256>(PROJ, row0, t0, C_XS + g * 256, tid, hvX, rvX);
    __syncthreads();
    ssd_prep(sl, DT, dtb, alog, row0, g, tid, lane, wave);
    conv_apply<128, 0>(hvB, rvB, cw, cb, 512 + g * 128, sl + S3_B, S3_PBC, sl, 0, tid);
    conv_apply<128, 0>(hvC, rvC, cw, cb, 768 + g * 128, sl + S3_C, S3_PBC, sl, 0, tid);
    conv_apply<256, 1>(hvX, rvX, cw, cb, g * 256, sl + S3_X, S3_PX, sl, 0, tid);
    bf16x8 hf[2][8];
    const bf16* hp0 = HIN + ((size_t)(bc * 8 + 4 * g) * 64 + ph * 32 + lq) * 128 + 8 * hi;
#pragma unroll
    for (int hq = 0; hq < 2; ++hq)
#pragma unroll
        for (int ks = 0; ks < 8; ++ks) hf[hq][ks] = *(const bf16x8*)(hp0 + (size_t)hq * 8192 + 16 * ks);
    __syncthreads();
    const LAS float* dts = (const LAS float*)(sl + SS_DTS); const LAS float* acum = (const LAS float*)(sl + SS_ACUM); LAS float* ssx = (LAS float*)(sl + SS_SSX);
    const LAS unsigned char* crd = sl + S3_C + lrow * S3_PBC + 16 * hi;
    f32x16 y[4];
#pragma unroll
    for (int hq = 0; hq < 4; ++hq) {
        f32x16 t = (f32x16){};
#pragma unroll
        for (int ks = 0; ks < 8; ++ks) t = __builtin_amdgcn_mfma_f32_32x32x16_bf16(hf[hq & 1][ks], *(const LAS bf16x8*)(crd + 32 * ks), t, 0, 0, 0);
        if (hq < 2) {
#pragma unroll
            for (int ks = 0; ks < 8; ++ks) hf[hq & 1][ks] = *(const bf16x8*)(hp0 + (size_t)(hq + 2) * 8192 + 16 * ks); }
        const float ea = __expf(acum[hq * 128 + lrow]);
#pragma unroll
        for (int rg = 0; rg < 16; ++rg) t[rg] *= ea;
        y[hq] = t; }
    v2u zr[4][4];
#pragma unroll
    for (int hq = 0; hq < 4; ++hq)
#pragma unroll
        for (int g4 = 0; g4 < 4; ++g4) zr[hq][g4] = *(const v2u*)(PROJ + grow * NPROJ + C_Z + g * 256 + hq * 64 + ph * 32 + 8 * g4 + 4 * hi);
#pragma unroll
    for (int st = 0; st < 4; ++st) if (st <= lt) {
        f32x16 ag = (f32x16){};
        { const LAS unsigned char* brd = sl + S3_B + (32 * st + lq) * S3_PBC + 16 * hi;
#pragma unroll
          for (int ks = 0; ks < 8; ++ks) ag = __builtin_amdgcn_mfma_f32_32x32x16_bf16(*(const LAS bf16x8*)(brd + 32 * ks), *(const LAS bf16x8*)(crd + 32 * ks), ag, 0, 0, 0); }
#pragma unroll
        for (int hq = 0; hq < 4; ++hq) {
            const float al = acum[hq * 128 + lrow], dd = dsk[4 * g + hq] / dts[hq * 128 + lrow];
            const LAS unsigned char* xb = sl + S3_X + (4 * hi + q) * S3_PX + (hq * 64 + ph * 32 + 16 * dsel + 4 * pp) * 2;
            float pm[16];
#pragma unroll
            for (int g4 = 0; g4 < 4; ++g4) { const f32x4 as4 = *(const LAS f32x4*)(acum + hq * 128 + 32 * st + 8 * g4 + 4 * hi);
#pragma unroll
                for (int e = 0; e < 4; ++e) { const int rg = 4 * g4 + e; float v = ag[rg] * __expf(al - as4[e]);
                    if (st == lt) { const int sl_ = 8 * g4 + 4 * hi + e; if (sl_ > lq) v = 0.f; if (sl_ == lq) v += dd; }
                    pm[rg] = v; } }
#pragma unroll
            for (int ks = 0; ks < 2; ++ks) { v4u wv; wv.x = pg8::cvt_pk_bf16(pm[8 * ks + 0], pm[8 * ks + 1]); wv.y = pg8::cvt_pk_bf16(pm[8 * ks + 2], pm[8 * ks + 3]); wv.z = pg8::cvt_pk_bf16(pm[8 * ks + 4], pm[8 * ks + 5]); wv.w = pg8::cvt_pk_bf16(pm[8 * ks + 6], pm[8 * ks + 7]);
                const bf16x8 xt = tr_pair(xb + (32 * st + 16 * ks) * S3_PX, xb + (32 * st + 16 * ks + 8) * S3_PX);
                y[hq] = __builtin_amdgcn_mfma_f32_32x32x16_bf16(xt, __builtin_bit_cast(bf16x8, wv), y[hq], 0, 0, 0); }
        }
    }
    unsigned ayp[4][8]; float ss = 0.f;
#pragma unroll
    for (int hq = 0; hq < 4; ++hq)
#pragma unroll
        for (int g4 = 0; g4 < 4; ++g4) { const v2u z = zr[hq][g4];
            const float y0 = y[hq][4 * g4 + 0] * siluf(bflo(z.x)), y1 = y[hq][4 * g4 + 1] * siluf(bfhi(z.x)), y2 = y[hq][4 * g4 + 2] * siluf(bflo(z.y)), y3 = y[hq][4 * g4 + 3] * siluf(bfhi(z.y));
            ss += (y0 * y0 + y1 * y1) + (y2 * y2 + y3 * y3);
            ayp[hq][2 * g4] = pg8::cvt_pk_bf16(y0, y1); ayp[hq][2 * g4 + 1] = pg8::cvt_pk_bf16(y2, y3); }
    ss += __shfl_xor(ss, 32);
    if (hi == 0) ssx[ph * 128 + lrow] = ss;
    f32x4 gnr[4][4];
#pragma unroll
    for (int hq = 0; hq < 4; ++hq)
#pragma unroll
        for (int g4 = 0; g4 < 4; ++g4) gnr[hq][g4] = *(const f32x4*)(ng + g * 256 + hq * 64 + ph * 32 + 8 * g4 + 4 * hi);
    __syncthreads();
    const float rs = 1.0f / sqrtf((ssx[lrow] + ssx[128 + lrow]) * (1.f / 256.f) + RMS_EPS);
#pragma unroll
    for (int hq = 0; hq < 4; ++hq)
#pragma unroll
        for (int g4 = 0; g4 < 4; ++g4) { const int ch = hq * 64 + ph * 32 + 8 * g4 + 4 * hi; const f32x4 gn = gnr[hq][g4];
            const unsigned p0 = ayp[hq][2 * g4], p1 = ayp[hq][2 * g4 + 1];
            v2u o; o.x = pg8::cvt_pk_bf16(bflo(p0) * rs * gn[0], bfhi(p0) * rs * gn[1]); o.y = pg8::cvt_pk_bf16(bflo(p1) * rs * gn[2], bfhi(p1) * rs * gn[3]);
            *(v2u*)(MIXED + grow * MIXW + 512 + g * 256 + ch) = o; }
}

struct Args { const float* in[20]; float* out; unsigned char* ws; int ph_lo, ph_hi, sub, pad; };
constexpr int NWAVES = 8;
constexpr int PH_PER_LAYER = 10, N_PHASES = 1 + NLAYER * PH_PER_LAYER;

#define in_x (args.in[0])
#define in_win (args.in[1])
#define in_convw (args.in[2])
#define in_convb (args.in[3])
#define in_dtb (args.in[4])
#define in_alog (args.in[5])
#define in_dsk (args.in[6])
#define in_ng (args.in[7])
#define in_scw (args.in[8])
#define in_wout (args.in[9])
#define in_ln1g (args.in[10])
#define in_ln1b (args.in[11])
#define in_rw (args.in[12])
#define in_rb (args.in[13])
#define in_wgu (args.in[14])
#define in_bgu (args.in[15])
#define in_wdn (args.in[16])
#define in_bdn (args.in[17])
#define in_ln2g (args.in[18])
#define in_ln2b (args.in[19])
#define ROPE ((float*)(args.ws + WS_ROPE))
#define WDT ((float*)(args.ws + WS_WDT))
#define ROUT ((bf16*)(args.ws + WS_ROUT))
#define WIN ((bf16*)(args.ws + WS_WIN))
#define WOUT ((bf16*)(args.ws + WS_WOUT))
#define WGU ((bf16*)(args.ws + WS_WGU))
#define WDN ((bf16*)(args.ws + WS_WDN))
#define XB ((bf16*)(args.ws + WS_XB))
#define XF ((float*)(args.ws + WS_XF))
#define XF2 ((float*)(args.ws + WS_XF2))
#define PROJ ((bf16*)(args.ws + WS_PROJ))
#define DT ((float*)(args.ws + WS_DT))
#define DTS ((float*)(args.ws + WS_DTS))
#define ACUM ((float*)(args.ws + WS_ACUM))
#define LSE ((float*)(args.ws + WS_LSE))
#define OP ((bf16*)(args.ws + WS_OP))
#define U ((bf16*)(args.ws + WS_U))
#define GB ((float*)(args.ws + WS_G))
#define ST ((float*)(args.ws + WS_ST))
#define YD ((float*)(args.ws + WS_YD))
#define MIXED ((bf16*)(args.ws + WS_MIXED))
#define MIXF ((bf16*)(args.ws + WS_MIXF))
#define TOPE ((int*)(args.ws + WS_TOPE))
#define TOPG ((float*)(args.ws + WS_TOPG))
#define ROWTOK ((int*)(args.ws + WS_ROWTOK))
#define ROWGATE ((float*)(args.ws + WS_ROWGATE))
#define HB ((bf16*)(args.ws + WS_H))
#define YB ((bf16*)(args.ws + WS_YB))
#define HIN ((bf16*)(args.ws + WS_G))
#define WGU8 ((unsigned char*)(args.ws + WS_WGU))
#define WDN8 ((unsigned char*)(args.ws + WS_WDN))
#define XB8 ((unsigned char*)(args.ws + WS_U))
#define H8 ((unsigned char*)(args.ws + WS_H))
#define YB8 ((unsigned char*)(args.ws + WS_YB))
#define WIN8 ((unsigned char*)(args.ws + WS_WGU + 128 * MiB))
#define XP8 ((unsigned char*)(args.ws + WS_WGU + 132 * MiB))
#define CDEC ((float*)(args.ws + WS_ACUM))
template <int layer>
__device__ __forceinline__ void run_layer(const Args& args, int lo, int hi, const XcdBarrier& bar) {
    extern __shared__ __attribute__((aligned(16))) unsigned char lds[];
    LAS unsigned char* ldsp = (LAS unsigned char*)lds;
    const int tid = threadIdx.x, lane = tid & 63, wave = __builtin_amdgcn_readfirstlane(tid >> 6);
    const int G = gridDim.x, bid = blockIdx.x;
    const int gw = bid * NWAVES + wave, NGW = G * NWAVES;
    gu32* ctl = (gu32*)(args.ws + WS_CTL);

#define IN(k) (lo <= (k) && (k) < hi)
#define SEAM(k) do { if (IN(k) && IN((k) + 1)) xcd_barrier(bar); } while (0)

        const int pb = 1 + layer * PH_PER_LAYER;
        const bf16* WINl = WIN + (size_t)layer * NPROJ * DM; const bf16* WOUTl = WOUT + (size_t)layer * DM * MIXW;
        const unsigned char* WGUl = WGU8 + (size_t)layer * NEXP * 2048 * DM; const unsigned char* WDNl = WDN8 + (size_t)layer * NEXP * DM * FF;
        gu32* gcnt = ctl + CW_CNT + 64 * layer;

        if (IN(pb + 0)) {
            {
              pg8::Gemm g{(const pg8::bf16_t*)XP8, (const pg8::bf16_t*)(WIN8 + (size_t)layer * 1536 * DM), MROWS, 1536, DM / 2}; pg8::StaticOrder S; S.init(MROWS, 1536, G, bid);
              pg8::EpiProj E{PROJ, NPROJ, ROPE, QSCALE, 1.0f / (SC_X * SC_WIN), 0};
              pg8::gemm_phase<pg8::EpiProj, pg8::StaticOrder, true, false, true>(ldsp + RING_OFF, g, S, E); }
            __syncthreads();
            { pg8::Gemm g{XB, WINl + (size_t)1536 * DM, MROWS, NPROJ - 1536, DM}; pg8::StaticOrder S; S.init(MROWS, NPROJ - 1536, G, bid);
              pg8::EpiProj E{PROJ, NPROJ, ROPE, QSCALE, 1.0f, 6};
              pg8::gemm_phase<pg8::EpiProj, pg8::StaticOrder, true, false>(ldsp + RING_OFF, g, S, E); }
        }
        SEAM(pb + 0);
        if (IN(pb + 1)) {
            if (args.sub & 1) attn_phase(ldsp + RING_OFF, PROJ, OP, LSE, bid, G, tid, wave, lane);
            if (args.sub & 2) { const float* cw = in_convw + (size_t)layer * 4 * 1024; const float* cb = in_convb + (size_t)layer * 1024;
              for (int un = bid; un < 512; un += G)
                  ssd_s1_unit(ldsp + RING_OFF, PROJ, DT, in_dtb + layer * 8, in_alog + layer * 8, cw, cb, ST, CDEC, un, tid, lane, wave);
              __syncthreads(); }
            const float* sw = in_scw + (size_t)layer * 3 * 512;
            if (args.sub & 4) {
                const int ch = (tid & 63) * 8;
                f32x4 wk[3][2];
#pragma unroll
                for (int k = 0; k < 3; ++k) { wk[k][0] = *(const f32x4*)(sw + k * 512 + ch); wk[k][1] = *(const f32x4*)(sw + k * 512 + ch + 4); }
#pragma unroll 1
                for (int it = bid * (NWAVES * 64) + tid; it < (MROWS / 4) * 64; it += G * (NWAVES * 64)) { const int row0 = (it >> 6) * 4; const bool head = (row0 & (SEQ - 1)) == 0;
                    v4u cc[6], hh[6], bb[4];
#pragma unroll
                    for (int i = 0; i < 6; ++i) { cc[i] = (v4u){0u, 0u, 0u, 0u}; hh[i] = cc[i];
                        if (i >= 2 || !head) { const bf16* pr = PROJ + (size_t)(row0 - 2 + i) * NPROJ; cc[i] = *(const v4u*)(pr + C_SC + ch); hh[i] = *(const v4u*)(pr + C_SH + ch); } }
#pragma unroll
                    for (int r = 0; r < 4; ++r) bb[r] = *(const v4u*)(PROJ + (size_t)(row0 + r) * NPROJ + C_SB + ch);
                    float p[6][8];
#pragma unroll
                    for (int i = 0; i < 6; ++i) { p[i][0] = bflo(cc[i].x) * bflo(hh[i].x); p[i][1] = bfhi(cc[i].x) * bfhi(hh[i].x); p[i][2] = bflo(cc[i].y) * bflo(hh[i].y); p[i][3] = bfhi(cc[i].y) * bfhi(hh[i].y);
                        p[i][4] = bflo(cc[i].z) * bflo(hh[i].z); p[i][5] = bfhi(cc[i].z) * bfhi(hh[i].z); p[i][6] = bflo(cc[i].w) * bflo(hh[i].w); p[i][7] = bfhi(cc[i].w) * bfhi(hh[i].w); }
#pragma unroll
                    for (int r = 0; r < 4; ++r) { float a[8];
#pragma unroll
                        for (int q = 0; q < 8; ++q) a[q] = wk[0][q >> 2][q & 3] * p[r][q] + wk[1][q >> 2][q & 3] * p[r + 1][q] + wk[2][q >> 2][q & 3] * p[r + 2][q];
                        const v4u b4 = bb[r];
                        v4u o; o.x = pk2(a[0] * bflo(b4.x), a[1] * bfhi(b4.x)); o.y = pk2(a[2] * bflo(b4.y), a[3] * bfhi(b4.y)); o.z = pk2(a[4] * bflo(b4.z), a[5] * bfhi(b4.z)); o.w = pk2(a[6] * bflo(b4.w), a[7] * bfhi(b4.w));
                        *(v4u*)(MIXED + (size_t)(row0 + r) * MIXW + 1024 + ch) = o; } }
            }
        }
        SEAM(pb + 1);
        if (IN(pb + 2)) {
            for (int it = bid * (NWAVES * 64) + tid; it < (int)(64L * 2048); it += G * (NWAVES * 64)) { const int pn4 = (int)(it & 2047), bh = (int)(it >> 11); const int h = bh & 7, b = bh >> 3; f32x4 hc = (f32x4){0.f, 0.f, 0.f, 0.f};
#pragma unroll 16
                for (int c = 0; c < 32; ++c) { const size_t idx = ((size_t)((b * 32 + c) * 8 + h)) * 8192 + pn4 * 4; const f32x4 st = *(const f32x4*)(ST + idx);
                    v2u o; o.x = pk2(hc[0], hc[1]); o.y = pk2(hc[2], hc[3]); *(v2u*)(HIN + idx) = o;
                    hc = hc * CDEC[(size_t)(b * 32 + c) * 8 + h] + st; } }
        }
        SEAM(pb + 2);
        if (IN(pb + 3)) {
            if (args.sub & 1) { const float* cw = in_convw + (size_t)layer * 4 * 1024; const float* cb = in_convb + (size_t)layer * 1024;
              for (int un = bid; un < 512; un += G)
                  ssd_s3_unit(ldsp + RING_OFF, PROJ, DT, in_dtb + layer * 8, in_alog + layer * 8, cw, cb, in_dsk + layer * 8, in_ng + (size_t)layer * 512, HIN, MIXED, un, tid, lane, wave);
              __syncthreads(); }
            if (args.sub & 2)
#pragma unroll 2
            for (int it = bid * (NWAVES * 64) + tid; it < (int)((long)MROWS * 32); it += G * (NWAVES * 64)) { const int c16 = (int)(it & 31), row = (int)(it >> 5); const int h = c16 >> 2;
                const float l0 = LSE[((size_t)0 * MROWS + row) * 8 + h], l1 = LSE[((size_t)1 * MROWS + row) * 8 + h], l2 = LSE[((size_t)2 * MROWS + row) * 8 + h];
                const float mm = fmaxf(l0, fmaxf(l1, l2)); float w0 = exp2f(l0 - mm), w1 = exp2f(l1 - mm), w2 = exp2f(l2 - mm); const float iw = (1.0f / SC_O) / (w0 + w1 + w2); w0 *= iw; w1 *= iw; w2 *= iw;
                const unsigned char* OP8 = (const unsigned char*)OP; typedef float f32x2_ __attribute__((ext_vector_type(2)));
                const v4u a0 = *(const v4u*)(OP8 + ((size_t)0 * MROWS + row) * 512 + c16 * 16), a1 = *(const v4u*)(OP8 + ((size_t)1 * MROWS + row) * 512 + c16 * 16), a2 = *(const v4u*)(OP8 + ((size_t)2 * MROWS + row) * 512 + c16 * 16);
                unsigned ow[8];
#pragma unroll
                for (int q = 0; q < 4; ++q) {
                    { const f32x2_ p0 = __builtin_amdgcn_cvt_pk_f32_fp8(a0[q], false), p1 = __builtin_amdgcn_cvt_pk_f32_fp8(a1[q], false), p2 = __builtin_amdgcn_cvt_pk_f32_fp8(a2[q], false); ow[2 * q] = pk2(w0 * p0[0] + w1 * p1[0] + w2 * p2[0], w0 * p0[1] + w1 * p1[1] + w2 * p2[1]); }
                    { const f32x2_ p0 = __builtin_amdgcn_cvt_pk_f32_fp8(a0[q], true), p1 = __builtin_amdgcn_cvt_pk_f32_fp8(a1[q], true), p2 = __builtin_amdgcn_cvt_pk_f32_fp8(a2[q], true); ow[2 * q + 1] = pk2(w0 * p0[0] + w1 * p1[0] + w2 * p2[0], w0 * p0[1] + w1 * p1[1] + w2 * p2[1]); } }
                bf16* op_ = MIXED + (size_t)row * MIXW + c16 * 16;
                *(v4u*)op_ = (v4u){ow[0], ow[1], ow[2], ow[3]}; *(v4u*)(op_ + 8) = (v4u){ow[4], ow[5], ow[6], ow[7]}; }
        }
        SEAM(pb + 3);
        if (IN(pb + 4)) {
#define FUSED_LN1_CALL(BASE, LIM) { pg8::Gemm g{MIXED, WOUTl, MROWS, DM, MIXW}; \
              pg8::EpiLn1 E{args.ws, in_ln1g + (size_t)layer * DM, in_ln1b + (size_t)layer * DM, WS_XB, WS_U, (layer ? WS_ROPE : WS_DTS), WS_CTL + (size_t)(CW_SEAM + layer * 8192) * 4, WS_CTL + (size_t)CW_TMO * 4, ALPHA, SC_X, LN_EPS, 0x700u + (unsigned)layer * 0x80u}; \
              pg8::StaticOrder S; S.init(MROWS, DM, G, bid); S.base = (BASE); S.lim = (LIM); \
              pg8::gemm_phase<pg8::EpiLn1, pg8::StaticOrder, false, false>(ldsp + RING_OFF, g, S, E); }
            FUSED_LN1_CALL(0, 256)
            __syncthreads();
            FUSED_LN1_CALL(256, 512)
            __syncthreads();
#undef FUSED_LN1_CALL
        }
        SEAM(pb + 4);
        if (IN(pb + 6)) {
            LAS int* lcnt = (LAS int*)(ldsp + L_LCNT); LAS int* lbase = (LAS int*)(ldsp + L_LBASE);
            const bf16* RT = ROUT + (size_t)layer * NEXP * DM; const float* rb = in_rb + (size_t)layer * NEXP;
            for (int blk = bid; blk < MROWS / 128; blk += G) {
                if (tid < 32) lcnt[tid] = 0;
                __syncthreads();
                const int r32 = lane & 31, hi = lane >> 5; const int row = blk * 128 + (wave & 3) * 32 + r32;
                float tv[4]; int te[4]; int lrank[4]; float gate[4];
                f32x16 acc = {};
                { const int kh = wave >> 2;
                  const bf16* ap = RT + (size_t)r32 * DM + 8 * hi + 512 * kh; const bf16* bp = XB + (size_t)row * DM + 8 * hi + 512 * kh;
#pragma unroll 16
                  for (int s = 0; s < 32; ++s) { const bf16x8 a = *(const bf16x8*)(ap + 16 * s), b = *(const bf16x8*)(bp + 16 * s); acc = __builtin_amdgcn_mfma_f32_32x32x16_bf16(a, b, acc, 0, 0, 0); }
                  LAS float* part = (LAS float*)(ldsp + RING_OFF) + (wave & 3) * 1024;
                  if (kh) {
#pragma unroll
                      for (int i = 0; i < 16; ++i) part[i * 64 + lane] = acc[i]; }
                  __syncthreads();
                  if (!kh) {
#pragma unroll
                      for (int i = 0; i < 16; ++i) acc[i] += part[i * 64 + lane]; } }
                if (wave < 4) {
#pragma unroll
                    for (int k = 0; k < 4; ++k) { tv[k] = -INFINITY; te[k] = 1 << 20; }
#pragma unroll
                    for (int i = 0; i < 16; ++i) { const int e = (i & 3) + 8 * (i >> 2) + 4 * hi; float v = acc[i] + rb[e]; int ve = e;
#pragma unroll
                        for (int k = 0; k < 4; ++k) { const bool gt = (v > tv[k]) || (v == tv[k] && ve < te[k]); const float nv = gt ? tv[k] : v; const int ne = gt ? te[k] : ve; tv[k] = gt ? v : tv[k]; te[k] = gt ? ve : te[k]; v = nv; ve = ne; } }
                    float pv[4]; int pe[4];
#pragma unroll
                    for (int k = 0; k < 4; ++k) { pv[k] = __shfl_xor(tv[k], 32); pe[k] = __shfl_xor(te[k], 32); }
#pragma unroll
                    for (int j = 0; j < 4; ++j) { float v = pv[j]; int ve = pe[j];
#pragma unroll
                        for (int k = 0; k < 4; ++k) { const bool gt = (v > tv[k]) || (v == tv[k] && ve < te[k]); const float nv = gt ? tv[k] : v; const int ne = gt ? te[k] : ve; tv[k] = gt ? v : tv[k]; te[k] = gt ? ve : te[k]; v = nv; ve = ne; } }
                    float se = 0.f;
#pragma unroll
                    for (int k = 0; k < 4; ++k) { gate[k] = __expf(tv[k] - tv[0]); se += gate[k]; }
                    const float ise = 1.0f / se;
#pragma unroll
                    for (int k = 0; k < 4; ++k) gate[k] *= ise;
                    if (hi == 0) {
#pragma unroll
                        for (int k = 0; k < 4; ++k) lrank[k] = __hip_atomic_fetch_add(lcnt + te[k], 1, __ATOMIC_RELAXED, __HIP_MEMORY_SCOPE_WORKGROUP);
                    }
                }
                __syncthreads();
                if (tid < 32) lbase[tid] = (int)__hip_atomic_fetch_add(gcnt + tid, (unsigned)lcnt[tid], RLX_AGENT);
                __syncthreads();
                if (wave < 4 && hi == 0) {
#pragma unroll
                    for (int k = 0; k < 4; ++k) { const int r = lbase[te[k]] + lrank[k]; const size_t o = (size_t)te[k] * 32768 + r;
                        ROWTOK[o] = row * 4 + k; ROWGATE[o] = gate[k]; }
                }
                __syncthreads();
            }
        }
        SEAM(pb + 6);
        if (IN(pb + 7) || IN(pb + 8)) {
            LAS int* tstart = (LAS int*)(ldsp + L_TSTART); LAS int* cntL = (LAS int*)(ldsp + L_CNT); LAS int* units = (LAS int*)(ldsp + L_UNITS); LAS int* unitsn = (LAS int*)(ldsp + L_UNITSN);
            if (tid < 64) {
                const int c = (tid < 32) ? (int)__hip_atomic_load(gcnt + tid, RLX_AGENT) : 0; const int t = (c + 255) >> 8; int incl = t;
#pragma unroll
                for (int d = 1; d < 32; d <<= 1) { const int v = __shfl_up(incl, d); if (tid >= d) incl += v; }
                if (tid < 32) { cntL[tid] = c; tstart[tid] = incl - t; }
                if (tid == 31) tstart[32] = incl; }
            __syncthreads();
            if (IN(pb + 7)) {
                pg8::moe_build_units(units, unitsn, tstart, 8, G, bid, tid);
                __syncthreads();
                pg8::Gemm g{(const pg8::bf16_t*)XB8, (const pg8::bf16_t*)WGUl, 0, 2048, DM / 2};
                pg8::MoeOrder S{units, __builtin_amdgcn_readfirstlane(unitsn[0]), cntL, ROWTOK, 1, (unsigned)DM, (size_t)2048 * DM, ROWGATE, in_bgu + (size_t)layer * NEXP * 2048};
                pg8::EpiSwiglu E{H8, in_bgu + (size_t)layer * NEXP * 2048, ROWGATE, cntL, 1.0f / (SC_X * SC_WGU), SC_H};
                pg8::gemm_phase<pg8::EpiSwiglu, pg8::MoeOrder, true, true, true>(ldsp + RING_OFF, g, S, E);
                __syncthreads();
            }
            SEAM(pb + 7);
            if (IN(pb + 8)) {
                pg8::moe_build_units(units, unitsn, tstart, 4, G, bid, tid);
                __syncthreads();
                pg8::Gemm g{(const pg8::bf16_t*)H8, (const pg8::bf16_t*)WDNl, 0, DM, FF / 2};
                pg8::MoeOrder S{units, __builtin_amdgcn_readfirstlane(unitsn[0]), cntL, ROWTOK, 0, (unsigned)FF, (size_t)DM * FF, ROWGATE, in_bdn + (size_t)layer * NEXP * DM};
                pg8::EpiScatter E{YB8, ROWTOK, cntL, SC_Y / (SC_H * SC_WDN), SC_Y};
                pg8::gemm_phase<pg8::EpiScatter, pg8::MoeOrder, true, false, true, true>(ldsp + RING_OFF, g, S, E);
                __syncthreads();
            }
        }
        SEAM(pb + 8);
        if (IN(pb + 9)) {
            constexpr bool NEXT = (layer + 1 < NLAYER);
            const float* gam = in_ln2g + (size_t)layer * DM; const float* bet = in_ln2b + (size_t)layer * DM;
            f32x4 gq[4], bq[4], wq[8][4];
#pragma unroll
            for (int q = 0; q < 4; ++q) { gq[q] = *(const f32x4*)(gam + 16 * lane + 4 * q); bq[q] = *(const f32x4*)(bet + 16 * lane + 4 * q); }
            if (NEXT) {
#pragma unroll
                for (int jj = 0; jj < 8; ++jj)
#pragma unroll
                    for (int q = 0; q < 4; ++q) wq[jj][q] = *(const f32x4*)(WDT + (size_t)(layer + 1) * 8 * 1024 + jj * 1024 + 16 * lane + 4 * q); }
            v4u nx0, nx1, ny[4];
            constexpr bool PF = !NEXT;
            if (PF && gw < MROWS) { nx0 = *(const v4u*)(XB + (size_t)gw * DM + 16 * lane); nx1 = *(const v4u*)(XB + (size_t)gw * DM + 16 * lane + 8);
#pragma unroll
                for (int k = 0; k < 4; ++k) ny[k] = *(const v4u*)(YB8 + ((size_t)gw * 4 + k) * DM + 16 * lane); }
#pragma unroll 1
            for (int m = gw; m < MROWS; m += NGW) {
                if (!PF) { nx0 = *(const v4u*)(XB + (size_t)m * DM + 16 * lane); nx1 = *(const v4u*)(XB + (size_t)m * DM + 16 * lane + 8);
#pragma unroll
                    for (int k = 0; k < 4; ++k) ny[k] = *(const v4u*)(YB8 + ((size_t)m * 4 + k) * DM + 16 * lane); }
                const v4u x0 = nx0, x1 = nx1; v4u yk[4];
#pragma unroll
                for (int k = 0; k < 4; ++k) yk[k] = ny[k];
                if (PF && m + NGW < MROWS) { const int mn = m + NGW; nx0 = *(const v4u*)(XB + (size_t)mn * DM + 16 * lane); nx1 = *(const v4u*)(XB + (size_t)mn * DM + 16 * lane + 8);
#pragma unroll
                    for (int k = 0; k < 4; ++k) ny[k] = *(const v4u*)(YB8 + ((size_t)mn * 4 + k) * DM + 16 * lane); }
                f32x4 v[4];
                v[0] = (f32x4){bflo(x0.x), bfhi(x0.x), bflo(x0.y), bfhi(x0.y)} * ALPHA; v[1] = (f32x4){bflo(x0.z), bfhi(x0.z), bflo(x0.w), bfhi(x0.w)} * ALPHA;
                v[2] = (f32x4){bflo(x1.x), bfhi(x1.x), bflo(x1.y), bfhi(x1.y)} * ALPHA; v[3] = (f32x4){bflo(x1.z), bfhi(x1.z), bflo(x1.w), bfhi(x1.w)} * ALPHA;
#pragma unroll
                for (int k = 0; k < 4; ++k)
#pragma unroll
                    for (int q = 0; q < 4; ++q) { typedef float f32x2_ __attribute__((ext_vector_type(2)));
                        const f32x2_ lo = __builtin_amdgcn_cvt_pk_f32_fp8(yk[k][q], false), hi = __builtin_amdgcn_cvt_pk_f32_fp8(yk[k][q], true);
                        v[q][0] += lo[0] * (1.0f / SC_Y); v[q][1] += lo[1] * (1.0f / SC_Y); v[q][2] += hi[0] * (1.0f / SC_Y); v[q][3] += hi[1] * (1.0f / SC_Y); }
                float s = 0.f;
#pragma unroll
                for (int q = 0; q < 4; ++q) s += (v[q][0] + v[q][1]) + (v[q][2] + v[q][3]);
                const float mean = wave_sum(s) * (1.f / DM); float s2 = 0.f;
#pragma unroll
                for (int q = 0; q < 4; ++q) { v[q] = v[q] - mean; s2 += (v[q][0] * v[q][0] + v[q][1] * v[q][1]) + (v[q][2] * v[q][2] + v[q][3] * v[q][3]); }
                const float rstd = 1.f / sqrtf(wave_sum(s2) * (1.f / DM) + LN_EPS);
#pragma unroll
                for (int q = 0; q < 4; ++q) { v[q] = v[q] * rstd * gq[q] + bq[q];
                    if (!NEXT) *(f32x4*)(args.out + (size_t)m * DM + 16 * lane + 4 * q) = v[q]; }
                if (NEXT) {
                    v4u w0, w1; w0.x = pk2(v[0][0], v[0][1]); w0.y = pk2(v[0][2], v[0][3]); w0.z = pk2(v[1][0], v[1][1]); w0.w = pk2(v[1][2], v[1][3]);
                    w1.x = pk2(v[2][0], v[2][1]); w1.y = pk2(v[2][2], v[2][3]); w1.z = pk2(v[3][0], v[3][1]); w1.w = pk2(v[3][2], v[3][3]);
                    *(v4u*)(XB + (size_t)m * DM + 16 * lane) = w0; *(v4u*)(XB + (size_t)m * DM + 16 * lane + 8) = w1;
                    v4u w; w.x = pg8::pk4_fp8(v[0][0] * SC_X, v[0][1] * SC_X, v[0][2] * SC_X, v[0][3] * SC_X); w.y = pg8::pk4_fp8(v[1][0] * SC_X, v[1][1] * SC_X, v[1][2] * SC_X, v[1][3] * SC_X);
                    w.z = pg8::pk4_fp8(v[2][0] * SC_X, v[2][1] * SC_X, v[2][2] * SC_X, v[2][3] * SC_X); w.w = pg8::pk4_fp8(v[3][0] * SC_X, v[3][1] * SC_X, v[3][2] * SC_X, v[3][3] * SC_X);
                    *(v4u*)(XP8 + (size_t)m * DM + 16 * lane) = w;
                    float r[8];
#pragma unroll
                    for (int jj = 0; jj < 8; ++jj) { float sd = 0.f;
#pragma unroll
                        for (int q = 0; q < 4; ++q) sd += v[q][0] * wq[jj][q][0] + v[q][1] * wq[jj][q][1] + v[q][2] * wq[jj][q][2] + v[q][3] * wq[jj][q][3];
                        r[jj] = wave_sum(sd); }
                    if (lane == 0) { float* dst = DT + (size_t)m * 8; *(f32x4*)dst = (f32x4){r[0], r[1], r[2], r[3]}; *(f32x4*)(dst + 4) = (f32x4){r[4], r[5], r[6], r[7]}; } }
            }
        }
        SEAM(pb + 9);
    #undef IN
#undef SEAM
}

__global__ void __launch_bounds__(NWAVES * 64, 2) mk_fwd(Args args) {
    extern __shared__ __attribute__((aligned(16))) unsigned char lds[];
    LAS unsigned char* ldsp = (LAS unsigned char*)lds;
    const int tid = threadIdx.x, lane = tid & 63, wave = __builtin_amdgcn_readfirstlane(tid >> 6);
    const int G = gridDim.x, bid = blockIdx.x;
    const int gw = bid * NWAVES + wave, NGW = G * NWAVES;
    gu32* ctl = (gu32*)(args.ws + WS_CTL);

    for (int u = tid; u < (LDS_BYTES - LDSCTL_OFF) / 4; u += NWAVES * 64) ((LAS unsigned*)(ldsp + LDSCTL_OFF))[u] = 0u;
    __syncthreads();
    XcdBarrier bar = xcd_barrier_post((unsigned*)(ctl + CW_BAR), (volatile LAS unsigned*)(ldsp + L_MISC) + 8);

    const int lo = args.ph_lo, hi = args.ph_hi;
#define IN(k) (lo <= (k) && (k) < hi)
#define SEAM(k) do { if (IN(k) && IN((k) + 1)) xcd_barrier(bar); } while (0)

    if (IN(0)) {
        LAS float* scr = (LAS float*)(ldsp + RING_OFF + wave * 16384);
        constexpr int I_IN = 16 * 73, I_OUT = 24 * 16, I_R = 16;
        constexpr int NIT = NLAYER * (I_IN + I_OUT + I_R);
        for (int it = gw; it < NIT; it += NGW) {
            int r = it;
            if (r < NLAYER * I_IN) { const int l = r / I_IN; r %= I_IN; p0_transpose_item64<1>(in_win + (size_t)l * DM * INW, DM, INW, WIN + (size_t)l * NPROJ * DM, WDT + (size_t)l * 8 * 1024, scr, r / 73, r % 73, lane); continue; } r -= NLAYER * I_IN;
            if (r < NLAYER * I_OUT) { const int l = r / I_OUT; r %= I_OUT; p0_transpose_item64<0>(in_wout + (size_t)l * MIXW * DM, MIXW, DM, WOUT + (size_t)l * DM * MIXW, nullptr, scr, r / 16, r % 16, lane); continue; } r -= NLAYER * I_OUT;
            { const int l = r / I_R; r %= I_R; p0_transpose_item<0>(in_rw + (size_t)l * DM * NEXP, DM, NEXP, ROUT + (size_t)l * NEXP * DM, nullptr, scr, r, 0, lane); }
        }
        { constexpr int NIT8 = 64 * 256 + 64 * 128 + NLAYER * 192;
          const int nmine = (gw < NIT8) ? (NIT8 - gw + NGW - 1) / NGW : 0; const int J = 2 * nmine;
          f32x4 lda[16], ldb[16];
          if (J > 0) { const SubT t = fp8_subtile(gw, 0, in_wgu, in_wdn, in_win, WGU8, WDN8, WIN8, lane); fp8_sub_load(t, lda); }
#pragma unroll 1
          for (int j = 0; j < J; j += 2) {
              const int item = gw + (j >> 1) * NGW;
              const SubT t0 = fp8_subtile(item, 0, in_wgu, in_wdn, in_win, WGU8, WDN8, WIN8, lane), t1 = fp8_subtile(item, 1, in_wgu, in_wdn, in_win, WGU8, WDN8, WIN8, lane);
              fp8_sub_load(t1, ldb);
              fp8_sub_process(t0, lda, scr, lane);
              if (j + 2 < J) { const SubT t2 = fp8_subtile(item + NGW, 0, in_wgu, in_wdn, in_win, WGU8, WDN8, WIN8, lane); fp8_sub_load(t2, lda); }
              fp8_sub_process(t1, ldb, scr, lane);
          } }
        __syncthreads();
    }
    if (IN(0)) {
        f32x4 wq[8][4];
#pragma unroll
        for (int j = 0; j < 4; ++j)
#pragma unroll
            for (int e = 0; e < 4; ++e) { const float* wp = in_win + (size_t)(4 * lane + 256 * j + e) * INW + 3072; const f32x4 w0 = *(const f32x4*)wp, w1 = *(const f32x4*)(wp + 4);
                wq[0][j][e] = w0[0]; wq[1][j][e] = w0[1]; wq[2][j][e] = w0[2]; wq[3][j][e] = w0[3]; wq[4][j][e] = w1[0]; wq[5][j][e] = w1[1]; wq[6][j][e] = w1[2]; wq[7][j][e] = w1[3]; }
        f32x4 nv[4];
        if (gw < MROWS) {
#pragma unroll
            for (int j = 0; j < 4; ++j) nv[j] = *(const f32x4*)(in_x + (size_t)gw * DM + 4 * lane + 256 * j); }
#pragma unroll 1
        for (int m = gw; m < MROWS; m += NGW) { bf16* ob = XB + (size_t)m * DM; f32x4 v[4];
#pragma unroll
            for (int j = 0; j < 4; ++j) v[j] = nv[j];
            if (m + NGW < MROWS) {
#pragma unroll
                for (int j = 0; j < 4; ++j) nv[j] = *(const f32x4*)(in_x + (size_t)(m + NGW) * DM + 4 * lane + 256 * j); }
#pragma unroll
            for (int j = 0; j < 4; ++j) { v2u w; w.x = pk2(v[j][0], v[j][1]); w.y = pk2(v[j][2], v[j][3]); *(v2u*)(ob + 4 * lane + 256 * j) = w;
                *(unsigned*)(XP8 + (size_t)m * DM + 4 * lane + 256 * j) = pg8::pk4_fp8(v[j][0] * SC_X, v[j][1] * SC_X, v[j][2] * SC_X, v[j][3] * SC_X); }
            row_dt_w(v, wq, DT + (size_t)m * 8, lane); }
    }

    SEAM(0);
    run_layer<0>(args, lo, hi, bar);
    run_layer<1>(args, lo, hi, bar);
#undef IN
#undef SEAM
}

extern "C" void kernel_launch(void* const* d_in, const int* in_sizes, int n_in, void* d_out, int out_size, void* d_ws, size_t ws_size, hipStream_t stream) {
    static int grid = 0;
    if (grid == 0) {
        if (n_in != 20 || out_size != MROWS * DM || ws_size < WS_END) { fprintf(stderr, "kernel_launch: unexpected problem (n_in %d, out %d, ws %zu)\n", n_in, out_size, ws_size); grid = -1; return; }
        if (hipFuncSetAttribute((const void*)mk_fwd, hipFuncAttributeMaxDynamicSharedMemorySize, LDS_BYTES) != hipSuccess) { fprintf(stderr, "kernel_launch: hipFuncSetAttribute failed\n"); grid = -1; return; }
        int dev = 0, cus = 0, per_cu = 0;
        (void)hipGetDevice(&dev); (void)hipDeviceGetAttribute(&cus, hipDeviceAttributeMultiprocessorCount, dev);
        if (hipOccupancyMaxActiveBlocksPerMultiprocessor(&per_cu, (const void*)mk_fwd, NWAVES * 64, LDS_BYTES) != hipSuccess || per_cu < 1) fprintf(stderr, "kernel_launch: occupancy query says %d\n", per_cu);
        (void)hipGetLastError();
        grid = cus > 0 ? cus : 256;
    }
    if (grid < 0) return;
    (void)hipMemsetAsync((char*)d_ws + WS_CTL, 0, CTL_ZERO_BYTES, stream);
    Args a{};
    for (int i = 0; i < 20; ++i) a.in[i] = (const float*)d_in[i];
    a.out = (float*)d_out; a.ws = (unsigned char*)d_ws;
    a.ph_lo = 0; a.ph_hi = N_PHASES; a.sub = 7; a.pad = 0;
    hipLaunchKernelGGL(mk_fwd, dim3(grid), dim3(NWAVES * 64), LDS_BYTES, stream, a);
#ifdef PROBE_PH
#ifndef PROBE_SUB
#define PROBE_SUB 7
#endif
    for (int i = 0; i < PROBE_N; ++i) { a.ph_lo = PROBE_PH; a.ph_hi = PROBE_PH + 1; a.sub = PROBE_SUB; hipLaunchKernelGGL(mk_fwd, dim3(grid), dim3(NWAVES * 64), LDS_BYTES, stream, a); }
#endif
}
```

```cpp
#include <hip/hip_runtime.h>
#include <cstdio>
#include <cstdint>
#include <cmath>

namespace pg8 {
#define PG8_LAS __attribute__((address_space(3)))
typedef unsigned short bf16_t;
typedef short bf16x8 __attribute__((ext_vector_type(8)));
typedef float f32x4 __attribute__((ext_vector_type(4)));
typedef float f32x2 __attribute__((ext_vector_type(2)));
typedef unsigned u32x4 __attribute__((ext_vector_type(4)));
constexpr int BM = 256, BK = 64, HALF = 128, HTB = HALF * BK * 2  , STAGE_BYTES = 8 * HTB, NXCD = 8, WGM = 8;

__host__ __device__ __forceinline__ int lds_byte(int r, int c) { const int st = (r >> 4) * 2 + (c >> 5), rr = r & 15, cc = c & 31, ob = rr * 64 + cc * 2; return st * 1024 + (ob ^ (((ob >> 9) & 1) << 5)); }
__host__ __device__ __forceinline__ void stage_rc(int b, int& R, int& C) { const int st = b / 1024, sb = b % 1024, swz = sb ^ (((sb >> 9) & 1) << 5); R = (st >> 1) * 16 + swz / 64; C = (st & 1) * 32 + (swz % 64) / 2; }
__host__ __device__ __forceinline__ int perm32(int rho) { const int n = rho >> 4, i = rho & 15; return 8 * (i >> 2) + 4 * n + (i & 3); }

struct Unit { int pm, pn, e, r0; };
struct Gemm { const bf16_t* A; const bf16_t* Bt; int M, N, K; };

struct StaticOrder {
    int nM, nN, nwg, G, c, base, lim;
    __device__ void init(int M, int N, int G_, int c_) { nM = M / BM; nN = N / BM; nwg = nM * nN; G = G_; c = c_; base = 0; lim = nwg; }
    __device__ __forceinline__ bool next(int i, Unit& u) const {
        const long L = (long)i * G + c + base; if (L >= lim) return false;
        int wgid = (int)L; { const int q = nwg / NXCD, r = nwg % NXCD, xcd = wgid % NXCD, off = wgid / NXCD; wgid = (xcd < r ? xcd * (q + 1) : r * (q + 1) + (xcd - r) * q) + off; }
        const int nig = WGM * nN, gid = wgid / nig, fm = gid * WGM, gsz = (nM - fm) < WGM ? (nM - fm) : WGM;
        u.pm = fm + ((wgid % nig) % gsz); u.pn = (wgid % nig) / gsz; u.e = 0; u.r0 = 0; return true;
    }
    __device__ __forceinline__ const char* abase(const Unit& u, const Gemm& g, size_t tstep) const { return (const char*)g.A + (size_t)u.pm * tstep; }
    __device__ __forceinline__ const char* bbase(const Unit& u, const Gemm& g, size_t tstep) const { return (const char*)g.Bt + (size_t)u.pn * tstep; }
    static constexpr bool SIDE = false;
    __device__ __forceinline__ unsigned arow(const Unit&, int) const { return 0u; }
    __device__ __forceinline__ unsigned arow_side(const Unit&, int, const PG8_LAS unsigned char*) const { return 0u; }
    __device__ __forceinline__ const void* side_src(const Unit&, const Unit&, int, int) const { return nullptr; }
    __device__ __forceinline__ void a_ready(const Unit&) const {}
    __device__ __forceinline__ void done(const Unit&) const {}
};

struct MoeOrder {
    const PG8_LAS int* units;
    int nunits;
    const PG8_LAS int* cnt;
    const int* rowtok;
    int gather;
    unsigned rowbytes;
    size_t bstride;
    __device__ __forceinline__ bool next(int i, Unit& u) const {
        if (i >= nunits) return false;
        u.pm = __builtin_amdgcn_readfirstlane(units[4 * i + 0]); u.pn = __builtin_amdgcn_readfirstlane(units[4 * i + 1]);
        u.e = __builtin_amdgcn_readfirstlane(units[4 * i + 2]); u.r0 = __builtin_amdgcn_readfirstlane(units[4 * i + 3]); return true;
    }
    __device__ __forceinline__ const char* abase(const Unit& u, const Gemm& g, size_t tstep) const { return gather ? (const char*)g.A : (const char*)g.A + (size_t)u.pm * tstep; }
    __device__ __forceinline__ const char* bbase(const Unit& u, const Gemm& g, size_t tstep) const { return (const char*)g.Bt + (size_t)u.e * bstride + (size_t)u.pn * tstep; }
    static constexpr bool SIDE = true;
    const float* rowgate; const float* bgu;
    __device__ __forceinline__ unsigned arow(const Unit& u, int R) const {
        const int r = u.r0 + R; const int idx = (r < cnt[u.e]) ? rowtok[(size_t)u.e * 32768 + r] : 0; return (unsigned)(idx >> 2) * rowbytes; }
    __device__ __forceinline__ unsigned arow_side(const Unit& u, int R, const PG8_LAS unsigned char* sd) const {
        const int r = u.r0 + R; const int v = ((const PG8_LAS int*)sd)[R]; const int idx = (r < cnt[u.e]) ? v : 0; return (unsigned)(idx >> 2) * rowbytes; }
    __device__ __forceinline__ const void* side_src(const Unit& cur, const Unit& rt, int wid, int lane) const {
        if (rowgate != nullptr && wid == 1) return rowgate + (size_t)cur.e * 32768 + cur.r0 + 4 * lane;
        if (bgu != nullptr && wid == 2) return gather ? (bgu + (size_t)cur.e * 2048 + (lane < 32 ? 0 : 1024 - 128) + cur.pn * 128 + 4 * lane)
                                                      : (bgu + (size_t)cur.e * 1024 + cur.pn * 256 + 4 * lane);
        return rowtok + (size_t)rt.e * 32768 + rt.r0 + 4 * lane; }
    __device__ __forceinline__ void a_ready(const Unit&) const {}
    __device__ __forceinline__ void done(const Unit&) const {}
};
__device__ __forceinline__ void moe_build_units(PG8_LAS int* units, PG8_LAS int* units_n, const PG8_LAS int* tstart, int nN, int G, int c, int tid) {
    if (tid < 64) {
        const int nT = tstart[32], nwg = nT * nN; const long L = (long)tid * G + c;
        int pm = 0, pn = 0, e = 0, r0 = 0;
        if (L < nwg) {
            int wgid = (int)L; { const int q = nwg / NXCD, r = nwg % NXCD, xcd = wgid % NXCD, off = wgid / NXCD; wgid = (xcd < r ? xcd * (q + 1) : r * (q + 1) + (xcd - r) * q) + off; }
            const int nig = WGM * nN, gid = wgid / nig, fm = gid * WGM, gsz = (nT - fm) < WGM ? (nT - fm) : WGM;
            pm = fm + ((wgid % nig) % gsz); pn = (wgid % nig) / gsz;
            for (int j = 1; j < 32; ++j) e += (tstart[j] <= pm) ? 1 : 0;
            r0 = (pm - tstart[e]) * 256;
        }
        units[4 * tid + 0] = pm; units[4 * tid + 1] = pn; units[4 * tid + 2] = e; units[4 * tid + 3] = r0;
        if (tid == 0) { int n = 0; if (c < nwg) n = (nwg - c + G - 1) / G; units_n[0] = n < 64 ? n : 64; }
    }
}

__host__ __device__ __forceinline__ unsigned hblk_off(int R, int p7) { const int ai = R >> 7, wr = (R >> 6) & 1, m = (R >> 4) & 3, fr = R & 15, wc = p7 >> 1, fq = ((p7 & 1) << 1) | (m & 1), mp = m >> 1;
    return (unsigned)(((((ai * 2 + wr) * 4 + wc) * 2 + mp) * 64 + fr + 16 * fq) * 16); }
typedef int v8i_t __attribute__((ext_vector_type(8)));
typedef int v4i_t __attribute__((ext_vector_type(4)));
__device__ __forceinline__ v8i_t cat8(bf16x8 lo, bf16x8 hi) { const v4i_t a = __builtin_bit_cast(v4i_t, lo), b = __builtin_bit_cast(v4i_t, hi); return __builtin_shufflevector(a, b, 0, 1, 2, 3, 4, 5, 6, 7); }
__device__ __forceinline__ void mfma8(f32x4& acc, v8i_t a, v8i_t b, int scl) { asm volatile("v_mfma_scale_f32_16x16x128_f8f6f4 %0, %1, %2, %0, %3, %3 op_sel_hi:[0,0,0]" : "+v"(acc) : "v"(a), "v"(b), "v"(scl)); }
__device__ __forceinline__ unsigned pk4_fp8(float a, float b, float c, float d) { unsigned w = 0u; w = __builtin_amdgcn_cvt_pk_fp8_f32(a, b, w, false); w = __builtin_amdgcn_cvt_pk_fp8_f32(c, d, w, true); return w; }
__device__ __forceinline__ unsigned cvt_pk_bf16(float lo, float hi) { unsigned r; asm volatile("v_cvt_pk_bf16_f32 %0, %1, %2" : "=v"(r) : "v"(lo), "v"(hi)); return r; }

struct EpiProj {
    static constexpr bool PERM = true, AFTER_DRAIN = false;
    bf16_t* O; int ldc; const float* rope; float qscale; float dqv; int pn_off;
    __device__ __forceinline__ void operator()(const f32x4 (&acc)[2][2][4][2], const Unit& u, int wr, int wc, int fr, int fq, const PG8_LAS unsigned char* sd) const {
        const int pnn = u.pn + pn_off; const int row0 = u.pm * BM + wr * 64 + fr; const int col0 = pnn * BM + wc * 32 + 8 * fq;
        const bool rot = pnn < 4; const float sc = (pnn < 2 ? qscale : 1.f) * dqv; const int gq = 4 * (wc & 1) + fq;
        float invr[4];
#pragma unroll
        for (int e = 0; e < 4; ++e) invr[e] = __builtin_amdgcn_exp2f(-(float)(4 * gq + e) * 0.41524101186092029f) * 0.15915494309189535f;
#pragma unroll
        for (int ai = 0; ai < 2; ++ai)
#pragma unroll
            for (int m = 0; m < 4; ++m) { const int row = row0 + ai * HALF + m * 16; bf16_t* rowp = O + (size_t)row * ldc + col0;
                f32x4 cs0 = (f32x4){1.f, 0.f, 1.f, 0.f}, cs1 = cs0;
                if (rot) { const float tp = (float)(row & 4095);
                    const float a0 = __builtin_amdgcn_fractf(tp * invr[0]), a1 = __builtin_amdgcn_fractf(tp * invr[1]), a2 = __builtin_amdgcn_fractf(tp * invr[2]), a3 = __builtin_amdgcn_fractf(tp * invr[3]);
                    cs0 = (f32x4){__builtin_amdgcn_cosf(a0), __builtin_amdgcn_sinf(a0), __builtin_amdgcn_cosf(a1), __builtin_amdgcn_sinf(a1)};
                    cs1 = (f32x4){__builtin_amdgcn_cosf(a2), __builtin_amdgcn_sinf(a2), __builtin_amdgcn_cosf(a3), __builtin_amdgcn_sinf(a3)}; }
#pragma unroll
                for (int bj = 0; bj < 2; ++bj) { f32x4 v0 = acc[ai][bj][m][0], v1 = acc[ai][bj][m][1];
                    if (rot) { f32x4 lo, hi;
                        lo[0] = v0[0] * cs0[0] - v1[0] * cs0[1]; hi[0] = v1[0] * cs0[0] + v0[0] * cs0[1];
                        lo[1] = v0[1] * cs0[2] - v1[1] * cs0[3]; hi[1] = v1[1] * cs0[2] + v0[1] * cs0[3];
                        lo[2] = v0[2] * cs1[0] - v1[2] * cs1[1]; hi[2] = v1[2] * cs1[0] + v0[2] * cs1[1];
                        lo[3] = v0[3] * cs1[2] - v1[3] * cs1[3]; hi[3] = v1[3] * cs1[2] + v0[3] * cs1[3];
                        v0 = lo * sc; v1 = hi * sc; }
                    else { v0 = v0 * dqv; v1 = v1 * dqv; }
                    u32x4 w; w.x = cvt_pk_bf16(v0[0], v0[1]); w.y = cvt_pk_bf16(v0[2], v0[3]); w.z = cvt_pk_bf16(v1[0], v1[1]); w.w = cvt_pk_bf16(v1[2], v1[3]);
                    *(u32x4*)(rowp + bj * HALF) = w; } }
    }
};
struct EpiF32 {
    static constexpr bool PERM = false, AFTER_DRAIN = false;
    float* O; int ldc;
    __device__ __forceinline__ void operator()(const f32x4 (&acc)[2][2][4][2], const Unit& u, int wr, int wc, int fr, int fq, const PG8_LAS unsigned char* sd) const {
        const int row0 = u.pm * BM + wr * 64 + fr; const int col0 = u.pn * BM + wc * 32 + 4 * fq;
#pragma unroll
        for (int ai = 0; ai < 2; ++ai)
#pragma unroll
            for (int m = 0; m < 4; ++m) { float* rowp = O + (size_t)(row0 + ai * HALF + m * 16) * ldc + col0;
#pragma unroll
                for (int bj = 0; bj < 2; ++bj)
#pragma unroll
                    for (int n = 0; n < 2; ++n) *(f32x4*)(rowp + bj * HALF + n * 16) = acc[ai][bj][m][n]; }
    }
};
struct EpiBf16Plain {
    static constexpr bool PERM = true, AFTER_DRAIN = false;
    bf16_t* O; int ldc;
    __device__ __forceinline__ void operator()(const f32x4 (&acc)[2][2][4][2], const Unit& u, int wr, int wc, int fr, int fq, const PG8_LAS unsigned char* sd) const {
        const int row0 = u.pm * BM + wr * 64 + fr; const int col0 = u.pn * BM + wc * 32 + 8 * fq;
#pragma unroll
        for (int ai = 0; ai < 2; ++ai)
#pragma unroll
            for (int m = 0; m < 4; ++m) { bf16_t* rowp = O + (size_t)(row0 + ai * HALF + m * 16) * ldc + col0;
#pragma unroll
                for (int bj = 0; bj < 2; ++bj) { const f32x4 v0 = acc[ai][bj][m][0], v1 = acc[ai][bj][m][1];
                    u32x4 w; w.x = cvt_pk_bf16(v0[0], v0[1]); w.y = cvt_pk_bf16(v0[2], v0[3]); w.z = cvt_pk_bf16(v1[0], v1[1]); w.w = cvt_pk_bf16(v1[2], v1[3]);
                    *(u32x4*)(rowp + bj * HALF) = w; } }
    }
};
struct EpiSwiglu {
    static constexpr bool PERM = true, AFTER_DRAIN = false;
    unsigned char* H; const float* bgu; const float* rowgate; const PG8_LAS int* cnt; float dq, hscale;
    __device__ __forceinline__ void operator()(const f32x4 (&acc)[2][2][4][2], const Unit& u, int wr, int wc, int fr, int fq, const PG8_LAS unsigned char* sd) const {
        const int n_e = cnt[u.e];
        constexpr float CS = -1.702f * 1.4426950408889634f;
        const float kk = hscale / CS, dqc = dq * CS, dqk = dq * kk, glo = 7.0f * CS, ub0 = -6.0f * kk, ub1 = 8.0f * kk;
        f32x4 bg[2], bu[2];
#pragma unroll
        for (int n = 0; n < 2; ++n) { bg[n] = *(const PG8_LAS f32x4*)(sd + 2048 + (wc * 32 + 8 * fq + 4 * n) * 4) * CS; bu[n] = (*(const PG8_LAS f32x4*)(sd + 2048 + 512 + (wc * 32 + 8 * fq + 4 * n) * 4) + 1.0f) * kk; }
        const int lane = fr + 16 * fq;
        float rgls[2][4];
#pragma unroll
        for (int ai = 0; ai < 2; ++ai)
#pragma unroll
            for (int m = 0; m < 4; ++m) rgls[ai][m] = ((const PG8_LAS float*)(sd + 1024))[ai * HALF + wr * 64 + m * 16 + fr];
#pragma unroll
        for (int ai = 0; ai < 2; ++ai)
#pragma unroll
            for (int mp = 0; mp < 2; ++mp) {
                unsigned pw[2][2];
#pragma unroll
                for (int mm = 0; mm < 2; ++mm) { const int m = 2 * mp + mm; const int r = ai * HALF + wr * 64 + m * 16 + fr; const int er = u.r0 + r;
                    const float rgl = rgls[ai][m]; const float irg = (er < n_e) ? __builtin_amdgcn_rcpf(rgl) : 1e30f;
                    float hv[8];
#pragma unroll
                    for (int n = 0; n < 2; ++n)
#pragma unroll
                        for (int q = 0; q < 4; q += 2) {
                            f32x2 g = (f32x2){acc[ai][0][m][n][q], acc[ai][0][m][n][q + 1]} * dqc + (f32x2){bg[n][q], bg[n][q + 1]};
                            f32x2 up = (f32x2){acc[ai][1][m][n][q], acc[ai][1][m][n][q + 1]} * dqk + (f32x2){bu[n][q], bu[n][q + 1]};
                            g.x = fmaxf(g.x, glo); g.y = fmaxf(g.y, glo); up.x = __builtin_amdgcn_fmed3f(up.x, ub0, ub1); up.y = __builtin_amdgcn_fmed3f(up.y, ub0, ub1);
                            f32x2 den; den.x = __builtin_amdgcn_exp2f(g.x); den.y = __builtin_amdgcn_exp2f(g.y); den = den * irg + irg;
                            f32x2 sg; sg.x = __builtin_amdgcn_rcpf(den.x); sg.y = __builtin_amdgcn_rcpf(den.y);
                            const f32x2 h2 = (up * g) * sg;
                            hv[n * 4 + q] = h2.x; hv[n * 4 + q + 1] = h2.y; }
                    pw[mm][0] = pk4_fp8(hv[0], hv[1], hv[2], hv[3]); pw[mm][1] = pk4_fp8(hv[4], hv[5], hv[6], hv[7]); }
                const auto s0 = __builtin_amdgcn_permlane16_swap(pw[0][0], pw[1][0], false, false); const auto s1 = __builtin_amdgcn_permlane16_swap(pw[0][1], pw[1][1], false, false);
                *(u32x4*)(H + ((size_t)u.pm * 8 + u.pn) * 32768 + ((((ai * 2 + wr) * 4 + wc) * 2 + mp) * 64 + lane) * 16) = (u32x4){s0[0], s1[0], s0[1], s1[1]};
                asm volatile("" ::: "memory"); }
    }
};
struct EpiScatter {
    static constexpr bool PERM = true, AFTER_DRAIN = false;
    unsigned char* Y; const int* rowtok; const PG8_LAS int* cnt; float dq, ysc;
    __device__ __forceinline__ void operator()(const f32x4 (&acc)[2][2][4][2], const Unit& u, int wr, int wc, int fr, int fq, const PG8_LAS unsigned char* sd) const {
        const int col0 = u.pn * BM + wc * 32 + 8 * fq; const int n_e = cnt[u.e];
        f32x4 bd[2][2];
#pragma unroll
        for (int bj = 0; bj < 2; ++bj)
#pragma unroll
            for (int n = 0; n < 2; ++n) bd[bj][n] = *(const PG8_LAS f32x4*)(sd + 2048 + (bj * HALF + wc * 32 + 8 * fq + 4 * n) * 4);
        int idxs[2][4]; float rgs[2][4];
#pragma unroll
        for (int ai = 0; ai < 2; ++ai)
#pragma unroll
            for (int m = 0; m < 4; ++m) { idxs[ai][m] = ((const PG8_LAS int*)sd)[ai * HALF + wr * 64 + m * 16 + fr]; rgs[ai][m] = ((const PG8_LAS float*)(sd + 1024))[ai * HALF + wr * 64 + m * 16 + fr]; }
#pragma unroll
        for (int ai = 0; ai < 2; ++ai)
#pragma unroll
            for (int m = 0; m < 4; ++m) { const int er = u.r0 + ai * HALF + wr * 64 + m * 16 + fr;
                const int idx = idxs[ai][m];
                if (er < n_e) { unsigned char* rowp = Y + (size_t)idx * 1024 + col0;
                    typedef unsigned u32x2 __attribute__((ext_vector_type(2)));
                    const float rg = rgs[ai][m] * ysc;
#pragma unroll
                    for (int bj = 0; bj < 2; ++bj) { const f32x4 v0 = acc[ai][bj][m][0] * dq + bd[bj][0] * rg, v1 = acc[ai][bj][m][1] * dq + bd[bj][1] * rg;
                        *(u32x2*)(rowp + bj * HALF) = (u32x2){pk4_fp8(v0[0], v0[1], v0[2], v0[3]), pk4_fp8(v1[0], v1[1], v1[2], v1[3])}; } } }
    }
};

struct PanelStats {
    unsigned* xbuf;
    unsigned* cnt;
    unsigned* tmo;
    int ntn; float eps;
    unsigned code;
    __device__ __forceinline__ bool run(const f32x4 (&v)[2][2][4][2], const Unit& u, int wr, int wc, int fr, int fq, PG8_LAS unsigned char* lds, int wid, int lane) const {
        typedef float f32x2v __attribute__((ext_vector_type(2)));
        PG8_LAS f32x2v* P = (PG8_LAS f32x2v*)lds;
        PG8_LAS f32x2v* S = (PG8_LAS f32x2v*)(lds + 8192);
        PG8_LAS unsigned* flag = (PG8_LAS unsigned*)(lds + 8192 + 2048);
#pragma unroll
        for (int ai = 0; ai < 2; ++ai)
#pragma unroll
            for (int m = 0; m < 4; ++m) {
                float s = 0.f;
#pragma unroll
                for (int bj = 0; bj < 2; ++bj)
#pragma unroll
                    for (int n = 0; n < 2; ++n) { const f32x4 x = v[ai][bj][m][n]; s += (x[0] + x[1]) + (x[2] + x[3]); }
                s += __shfl_xor(s, 16); s += __shfl_xor(s, 32);
                const float mw = s * (1.0f / 64.0f); float q = 0.f;
#pragma unroll
                for (int bj = 0; bj < 2; ++bj)
#pragma unroll
                    for (int n = 0; n < 2; ++n) { const f32x4 d = v[ai][bj][m][n] - mw; q += (d[0] * d[0] + d[1] * d[1]) + (d[2] * d[2] + d[3] * d[3]); }
                q += __shfl_xor(q, 16); q += __shfl_xor(q, 32);
                if (fq == 0) P[(ai * HALF + wr * 64 + m * 16 + fr) * 4 + wc] = (f32x2v){mw, q};
            }
        asm volatile("s_waitcnt lgkmcnt(0)" ::: "memory"); __builtin_amdgcn_s_barrier(); asm volatile("" ::: "memory");
#if defined(BROKEN_EXCHANGE_NO_WAIT)
#warning BROKEN CONTROL BUILD: the row-statistics exchange does not wait; results are wrong by design
        if (blockIdx.x >= 64) { const long long t0_ = clock64(); while (clock64() - t0_ < 60000) __builtin_amdgcn_s_sleep(8); }
#endif
        const int row = wid * 32 + (lane & 31);
        if (lane < 32) {
            const f32x2v a = P[row * 4 + 0], b = P[row * 4 + 1], c = P[row * 4 + 2], d = P[row * 4 + 3];
            const float mt = (a.x + b.x + c.x + d.x) * 0.25f;
            const float da = a.x - mt, db = b.x - mt, dc = c.x - mt, dd = d.x - mt;
            const float m2 = (a.y + b.y) + (c.y + d.y) + 64.0f * ((da * da + db * db) + (dc * dc + dd * dd));
            unsigned long long* slot = (unsigned long long*)xbuf + ((size_t)(u.pm * BM + row) * 4 + u.pn);
            __hip_atomic_store(slot, ((unsigned long long)__float_as_uint(m2) << 32) | __float_as_uint(mt), __ATOMIC_RELAXED, __HIP_MEMORY_SCOPE_AGENT);
        }
        asm volatile("s_waitcnt vmcnt(0)" ::: "memory");
        if (lane == 0) __hip_atomic_fetch_add(cnt + 64 * u.pm, 1u, __ATOMIC_RELAXED, __HIP_MEMORY_SCOPE_AGENT);
        if (wid == 0) {
            const unsigned want = 8u * (unsigned)ntn; unsigned sp = 0u;
            while ((unsigned)__builtin_amdgcn_readfirstlane(__hip_atomic_load(cnt + 64 * u.pm, __ATOMIC_RELAXED, __HIP_MEMORY_SCOPE_AGENT)) < want) { __builtin_amdgcn_s_sleep(2); if (++sp > (1u << 20)) break; }
            __builtin_amdgcn_fence(__ATOMIC_ACQUIRE, "agent");
        }
        asm volatile("s_waitcnt vmcnt(0) lgkmcnt(0)" ::: "memory"); __builtin_amdgcn_s_barrier(); asm volatile("" ::: "memory");
        const bool bad = false;
        if (lane < 32) {
            const unsigned long long* slot = (const unsigned long long*)xbuf + (size_t)(u.pm * BM + row) * 4; float mt[4], m2[4]; float ms = 0.f;
#pragma unroll
            for (int t = 0; t < 4; ++t) { if (t < ntn) { const unsigned long long w = __hip_atomic_load(slot + t, __ATOMIC_RELAXED, __HIP_MEMORY_SCOPE_AGENT); mt[t] = __uint_as_float((unsigned)w); m2[t] = __uint_as_float((unsigned)(w >> 32)); } else { mt[t] = 0.f; m2[t] = 0.f; } ms += mt[t]; }
            const float mean = ms / (float)ntn; float q = 0.f;
#pragma unroll
            for (int t = 0; t < 4; ++t) if (t < ntn) { const float dm = mt[t] - mean; q += m2[t] + 256.0f * dm * dm; }
            S[row] = (f32x2v){mean, 1.0f / sqrtf(q / (256.0f * (float)ntn) + eps)};
        }
        asm volatile("s_waitcnt lgkmcnt(0)" ::: "memory"); __builtin_amdgcn_s_barrier(); asm volatile("" ::: "memory");
        return bad;
    }
};

struct EpiLn1 {
    static constexpr bool PERM = true, AFTER_DRAIN = true;
    unsigned char* ws; const float* gam; const float* bet; size_t o_xb, o_x8, o_xbuf, o_cnt, o_tmo; float alpha, s8, eps; unsigned code;
    __device__ __forceinline__ void operator()(const f32x4 (&)[2][2][4][2], const Unit&, int, int, int, int, const PG8_LAS unsigned char*) const {}
    __device__ __forceinline__ void fused(f32x4 (&acc)[2][2][4][2], const Unit& u, int wr, int wc, int fr, int fq, PG8_LAS unsigned char* lds, int wid, int lane) const {
        typedef float f32x2v __attribute__((ext_vector_type(2))); typedef unsigned u32x2 __attribute__((ext_vector_type(2)));
        bf16_t* const XBp = (bf16_t*)(ws + o_xb); unsigned char* const X8 = ws + o_x8;
        const PanelStats st{(unsigned*)(ws + o_xbuf), (unsigned*)(ws + o_cnt), (unsigned*)(ws + o_tmo), 4, eps, code};
        const int col0 = u.pn * BM + wc * 32 + 8 * fq;
#pragma unroll
        for (int ai = 0; ai < 2; ++ai)
#pragma unroll
            for (int m = 0; m < 4; ++m) { const bf16_t* xr = XBp + (size_t)(u.pm * BM + ai * HALF + wr * 64 + m * 16 + fr) * 1024 + col0;
#pragma unroll
                for (int bj = 0; bj < 2; ++bj) { const u32x4 x = *(const u32x4*)(xr + bj * HALF);
                    acc[ai][bj][m][0] += (f32x4){__builtin_bit_cast(float, x.x << 16), __builtin_bit_cast(float, x.x & 0xffff0000u), __builtin_bit_cast(float, x.y << 16), __builtin_bit_cast(float, x.y & 0xffff0000u)} * alpha;
                    acc[ai][bj][m][1] += (f32x4){__builtin_bit_cast(float, x.z << 16), __builtin_bit_cast(float, x.z & 0xffff0000u), __builtin_bit_cast(float, x.w << 16), __builtin_bit_cast(float, x.w & 0xffff0000u)} * alpha; }
                asm volatile("" ::: "memory"); }
        (void)st.run(acc, u, wr, wc, fr, fq, lds, wid, lane);
        const PG8_LAS f32x2v* S = (const PG8_LAS f32x2v*)(lds + 8192);
#pragma unroll
        for (int bj = 0; bj < 2; ++bj) {
            const f32x4 g0 = *(const f32x4*)(gam + col0 + bj * HALF), g1 = *(const f32x4*)(gam + col0 + bj * HALF + 4), b0 = *(const f32x4*)(bet + col0 + bj * HALF), b1 = *(const f32x4*)(bet + col0 + bj * HALF + 4);
#pragma unroll
            for (int ai = 0; ai < 2; ++ai)
#pragma unroll
                for (int m = 0; m < 4; ++m) { const int r = ai * HALF + wr * 64 + m * 16 + fr; const f32x2v sr = S[r]; const size_t off = (size_t)(u.pm * BM + r) * 1024 + col0 + bj * HALF;
                    const f32x4 o0 = (acc[ai][bj][m][0] - sr.x) * sr.y * g0 + b0, o1 = (acc[ai][bj][m][1] - sr.x) * sr.y * g1 + b1;
                    u32x4 w; w.x = cvt_pk_bf16(o0[0], o0[1]); w.y = cvt_pk_bf16(o0[2], o0[3]); w.z = cvt_pk_bf16(o1[0], o1[1]); w.w = cvt_pk_bf16(o1[2], o1[3]);
                    *(u32x4*)(XBp + off) = w;
                    *(u32x2*)(X8 + off) = (u32x2){pk4_fp8(o0[0] * s8, o0[1] * s8, o0[2] * s8, o0[3] * s8), pk4_fp8(o1[0] * s8, o1[1] * s8, o1[2] * s8, o1[3] * s8)};
                    asm volatile("" ::: "memory"); } }
    }
};

template <class Epi, class Sched, bool ALIGN_EPI, bool GATHER, bool FP8 = false, bool ABLK = false>
__device__ __forceinline__ void gemm_phase(PG8_LAS unsigned char* lds, const Gemm g, const Sched& S, const Epi& E) {
    const int tid = threadIdx.x, wid = __builtin_amdgcn_readfirstlane(tid >> 6), lane = tid & 63, wr = wid >> 2, wc = wid & 3, fr = lane & 15, fq = lane >> 4;
    const int K = g.K, nt = K / BK;
    unsigned voffB[2];
#pragma unroll
    for (int i = 0; i < 2; ++i) { int R, C; stage_rc(tid * 16 + i * 8192, R, C); const int Rb = Epi::PERM ? ((R & ~31) + perm32(R & 31)) : R;
        voffB[i] = (unsigned)(Rb * K + C) * 2u; }
    constexpr int SIDE_BYTES = 8192;
    PG8_LAS unsigned char* const side = lds + STAGE_BYTES;
    const size_t kstep = (size_t)(BK * 2);
    const size_t kstepA = ABLK ? (size_t)32768 : kstep;
    const size_t hstep = (size_t)HALF * K * 2;
    const size_t tstep = 2 * hstep;
    const unsigned ldsw = (unsigned)wid * 1024u;
    const int aoff = lds_byte(wr * 64 + fr, fq * 8), boff = lds_byte(wc * 32 + fr, fq * 8);
#define PG8_SA(b, h) (((b) * 2 + (h)) * HTB)
#define PG8_SB(b, h) ((4 + (b) * 2 + (h)) * HTB)
#define PG8_STAGE(bufoff, gbase, voff) do { _Pragma("unroll") for (int _i = 0; _i < 2; ++_i) \
        __builtin_amdgcn_global_load_lds((const unsigned*)((const char*)(gbase) + (voff)[_i]), (PG8_LAS unsigned*)(lds + (bufoff) + ldsw + _i * 8192), 16, 0, 0); } while (0)
#define PG8_LDA(dst, b, h) do { _Pragma("unroll") for (int m = 0; m < 4; ++m) _Pragma("unroll") for (int k = 0; k < 2; ++k) dst[m][k] = *(const PG8_LAS bf16x8*)(lds + PG8_SA(b, h) + aoff + m * 2048 + k * 1024); } while (0)
#define PG8_LDB(dst, b, h) do { _Pragma("unroll") for (int n = 0; n < 2; ++n) _Pragma("unroll") for (int k = 0; k < 2; ++k) dst[n][k] = *(const PG8_LAS bf16x8*)(lds + PG8_SB(b, h) + boff + n * 2048 + k * 1024); } while (0)
#define PG8_MMA(ai, bj, At, Bt) do { __builtin_amdgcn_s_setprio(1); _Pragma("unroll") for (int m = 0; m < 4; ++m) _Pragma("unroll") for (int n = 0; n < 2; ++n) { \
        if constexpr (FP8) mfma8(acc[ai][bj][m][n], cat8(Bt[n][0], Bt[n][1]), cat8(At[m][0], At[m][1]), scl8); \
        else { _Pragma("unroll") for (int k = 0; k < 2; ++k) acc[ai][bj][m][n] = __builtin_amdgcn_mfma_f32_16x16x32_bf16(Bt[n][k], At[m][k], acc[ai][bj][m][n], 0, 0, 0); } } __builtin_amdgcn_s_setprio(0); } while (0)
#define PG8_WAIT_V(n) asm volatile("s_waitcnt vmcnt(" #n ")" ::: "memory")
#define PG8_WAIT_L(n) asm volatile("s_waitcnt lgkmcnt(" #n ")" ::: "memory")
#define PG8_BAR __builtin_amdgcn_s_barrier()
#define PG8_SCHED __builtin_amdgcn_sched_barrier(0)
#define PG8_SETOFFS(o, u) do { _Pragma("unroll") for (int _h = 0; _h < 2; ++_h) _Pragma("unroll") for (int _i = 0; _i < 2; ++_i) { int _R, _C; stage_rc(tid * 16 + _i * 8192, _R, _C); \
        o[_h][_i] = GATHER ? (S.arow(u, _R + HALF * _h) + (unsigned)(_C * 2)) : ABLK ? hblk_off(_R + HALF * _h, _C >> 3) : ((unsigned)((_R + HALF * _h) * K) * 2u + (unsigned)(_C * 2)); } } while (0)
    int scl8 = 0x7F7F7F7F; asm volatile("" : "+v"(scl8));
    Unit cur, nxt; int ui = 0;
    if (!S.next(0, cur)) return;
    f32x4 acc[2][2][4][2];
#pragma unroll
    for (int a = 0; a < 2; ++a)
#pragma unroll
        for (int b = 0; b < 2; ++b)
#pragma unroll
            for (int m = 0; m < 4; ++m)
#pragma unroll
                for (int n = 0; n < 2; ++n) { acc[a][b][m][n] = (f32x4){0.f, 0.f, 0.f, 0.f}; if constexpr (FP8) asm volatile("" : "+v"(acc[a][b][m][n])); }
    bf16x8 At[4][2], B0[2][2], B1[2][2];
    unsigned cAo[2][2];
    PG8_SETOFFS(cAo, cur);
    const char* cA = S.abase(cur, g, tstep); const char* cB = S.bbase(cur, g, tstep);
    S.a_ready(cur);
    PG8_STAGE(PG8_SB(0, 0), cB, voffB); PG8_STAGE(PG8_SB(0, 1), cB + hstep, voffB); PG8_STAGE(PG8_SA(0, 0), cA, cAo[0]); PG8_STAGE(PG8_SA(0, 1), cA, cAo[1]);
    if (wr == 1) PG8_BAR;
    PG8_WAIT_V(2); PG8_BAR;
    PG8_STAGE(PG8_SB(1, 0), cB + kstep, voffB); PG8_STAGE(PG8_SA(1, 0), cA + kstepA, cAo[0]); PG8_STAGE(PG8_SB(1, 1), cB + hstep + kstep, voffB);
    PG8_WAIT_V(6); PG8_BAR;
    for (;;) {
        const bool has_next = S.next(ui + 1, nxt);
        const char* nA = has_next ? S.abase(nxt, g, tstep) : cA; const char* nB = has_next ? S.bbase(nxt, g, tstep) : cB;
        if constexpr (Sched::SIDE) {
            const void* ssrc = S.side_src(cur, (GATHER && has_next) ? nxt : cur, wid, lane);
            __builtin_amdgcn_global_load_lds((const unsigned*)ssrc, (PG8_LAS unsigned*)(side + (ui & 1) * SIDE_BYTES + wid * 1024), 16, 0, 0); }
#pragma unroll 1
        for (int t = 0; t < nt; t += 2) {
            const bool last = (t == nt - 2);
            const char* a1 = cA + (size_t)(t + 1) * kstepA;
            const char* a2 = last ? nA : cA + (size_t)(t + 2) * kstepA; const char* b2 = last ? nB : cB + (size_t)(t + 2) * kstep;
            const char* a3 = a2 + kstepA; const char* b3 = b2 + kstep;
            if (last && has_next) S.a_ready(nxt);
            PG8_LDB(B0, 0, 0); PG8_LDB(B1, 0, 1); PG8_SCHED; PG8_LDA(At, 0, 0); PG8_STAGE(PG8_SA(1, 1), a1, cAo[1]);
            if constexpr (GATHER) { if (last && has_next) {
                const PG8_LAS unsigned char* sdn = side + (ui & 1) * SIDE_BYTES;
#pragma unroll
                for (int _h = 0; _h < 2; ++_h)
#pragma unroll
                    for (int _i = 0; _i < 2; ++_i) { int _R, _C; stage_rc(tid * 16 + _i * 8192, _R, _C); cAo[_h][_i] = S.arow_side(nxt, _R + HALF * _h, sdn) + (unsigned)(_C * 2); } } }
            PG8_WAIT_V(8); PG8_WAIT_L(0); PG8_BAR; PG8_MMA(0, 0, At, B0); PG8_MMA(0, 1, At, B1); PG8_BAR; PG8_SCHED;
            PG8_LDA(At, 0, 1); PG8_STAGE(PG8_SB(0, 0), b2, voffB); PG8_STAGE(PG8_SB(0, 1), b2 + hstep, voffB); PG8_STAGE(PG8_SA(0, 0), a2, cAo[0]);
            PG8_WAIT_V(8); PG8_WAIT_L(0); PG8_BAR; PG8_MMA(1, 0, At, B0); PG8_MMA(1, 1, At, B1); PG8_BAR; PG8_SCHED;
            PG8_LDB(B0, 1, 0); PG8_LDB(B1, 1, 1); PG8_SCHED; PG8_LDA(At, 1, 0); PG8_STAGE(PG8_SA(0, 1), a2, cAo[1]);
            PG8_WAIT_V(8); PG8_WAIT_L(0); PG8_BAR; PG8_MMA(0, 0, At, B0); PG8_MMA(0, 1, At, B1); PG8_BAR; PG8_SCHED;
            PG8_LDA(At, 1, 1); PG8_STAGE(PG8_SB(1, 0), b3, voffB); PG8_STAGE(PG8_SB(1, 1), b3 + hstep, voffB); PG8_STAGE(PG8_SA(1, 0), a3, cAo[0]);
            PG8_WAIT_V(8); PG8_WAIT_L(0); PG8_BAR; PG8_MMA(1, 0, At, B0); PG8_MMA(1, 1, At, B1); PG8_BAR; PG8_SCHED;
        }
        if constexpr (ALIGN_EPI) { if (wr == 0) PG8_BAR; }
        if constexpr (FP8) asm volatile("s_nop 15\n\ts_nop 15" ::: "memory");
        if constexpr (!Epi::AFTER_DRAIN) { PG8_SCHED; E(acc, cur, wr, wc, fr, fq, side + (ui & 1) * SIDE_BYTES); S.done(cur); PG8_SCHED; }
        if (!has_next) break;
#pragma unroll
        for (int a = 0; a < 2; ++a)
#pragma unroll
            for (int b = 0; b < 2; ++b)
#pragma unroll
                for (int m = 0; m < 4; ++m)
#pragma unroll
                    for (int n = 0; n < 2; ++n) { acc[a][b][m][n] = (f32x4){0.f, 0.f, 0.f, 0.f}; if constexpr (FP8) asm volatile("" : "+v"(acc[a][b][m][n])); }
        cur = nxt; cA = nA; cB = nB; ++ui;
        if constexpr (ALIGN_EPI) { if (wr == 1) PG8_BAR; }
    }
    PG8_WAIT_V(0);
    if constexpr (!ALIGN_EPI) { if (wr == 0) PG8_BAR; }
    PG8_BAR;
    if constexpr (Epi::AFTER_DRAIN) { E.fused(acc, cur, wr, wc, fr, fq, lds, wid, lane); S.done(cur); }
#undef PG8_SA
#undef PG8_SB
#undef PG8_STAGE
#undef PG8_LDA
#undef PG8_LDB
#undef PG8_MMA
#undef PG8_WAIT_V
#undef PG8_WAIT_L
#undef PG8_BAR
#undef PG8_SCHED
#undef PG8_SETOFFS
}
}

constexpr int NB = 8, SEQ = 4096, DM = 1024, MROWS = NB * SEQ, NLAYER = 2;
constexpr int NPROJ = 4608, INW = 4616;
constexpr int C_Q = 0, C_K = 512, C_V = 1024, C_Z = 1536, C_XS = 2048, C_SB = 3072, C_SC = 3584, C_SH = 4096;
constexpr int MIXW = 1536, NEXP = 32, TOPK = 4, FF = 1024;
constexpr float ALPHA = 1.4142135623730951f;
constexpr float LN_EPS = 1e-5f, RMS_EPS = 1e-5f;
constexpr float QSCALE = 0.125f * 1.4426950408889634f;

constexpr size_t MiB = 1u << 20;
constexpr size_t WS_CTL = 0, CTL_ZERO_BYTES = 1 * MiB;
constexpr size_t WS_ROPE = 1 * MiB;
constexpr size_t WS_WDT = 2 * MiB;
constexpr size_t WS_ROUT = 2 * MiB + 65536;
constexpr size_t WS_WIN = 4 * MiB;
constexpr size_t WS_WOUT = 24 * MiB;
constexpr size_t WS_WGU = 32 * MiB;
constexpr size_t WS_WDN = 288 * MiB;
constexpr size_t WS_XB = 416 * MiB;
constexpr size_t WS_XF = 480 * MiB;
constexpr size_t WS_XF2 = 608 * MiB;
constexpr size_t WS_PROJ = 736 * MiB;
constexpr size_t WS_DT = 1024 * MiB;
constexpr size_t WS_DTS = 1025 * MiB;
constexpr size_t WS_ACUM = 1026 * MiB;
constexpr size_t WS_LSE = 1027 * MiB;
constexpr size_t WS_OP = 1030 * MiB;
constexpr size_t WS_U = 1126 * MiB;
constexpr size_t WS_G = 1190 * MiB;
constexpr size_t WS_ST = 1222 * MiB;
constexpr size_t WS_YD = 1286 * MiB;
constexpr size_t WS_MIXED = 1350 * MiB;
constexpr size_t WS_MIXF = 1446 * MiB;
constexpr size_t WS_TOPE = 1574 * MiB;
constexpr size_t WS_TOPG = 1575 * MiB;
constexpr size_t WS_ROWTOK = 1576 * MiB;
constexpr size_t WS_ROWGATE = 1580 * MiB;
constexpr size_t WS_H = 736 * MiB;
constexpr size_t WS_YB = 1030 * MiB;
constexpr size_t WS_END = 1584 * MiB;
constexpr int CW_TMO = 0;
constexpr int CW_CNT = 64;
constexpr int CW_BAR = 4096;
constexpr int CW_SEAM = 16384;

constexpr int RING_OFF = 0, RING_BYTES = 131072;
constexpr int LDSCTL_OFF = 155648;
constexpr int L_MISC = LDSCTL_OFF;
constexpr int L_TSTART = LDSCTL_OFF + 256;
constexpr int L_CNT = LDSCTL_OFF + 512;
constexpr int L_LCNT = LDSCTL_OFF + 640;
constexpr int L_LBASE = LDSCTL_OFF + 768;
constexpr int L_UNITS = LDSCTL_OFF + 1024;
constexpr int L_UNITSN = LDSCTL_OFF + 2048;
constexpr int LDS_BYTES = 163840;

#define GAS __attribute__((address_space(1)))
#define LAS __attribute__((address_space(3)))
typedef unsigned short bf16;
typedef unsigned v4u __attribute__((ext_vector_type(4)));
typedef unsigned v2u __attribute__((ext_vector_type(2)));
typedef float f32x4 __attribute__((ext_vector_type(4)));
typedef float f32x16 __attribute__((ext_vector_type(16)));
typedef short bf16x8 __attribute__((ext_vector_type(8)));
typedef GAS unsigned gu32;
#define RLX_AGENT __ATOMIC_RELAXED, __HIP_MEMORY_SCOPE_AGENT
#define LDS_WAIT() asm volatile("s_waitcnt lgkmcnt(0)" ::: "memory")
#define VM_WAIT() asm volatile("s_waitcnt vmcnt(0)" ::: "memory")
__device__ __forceinline__ unsigned f2bf(float f) { unsigned u = __builtin_bit_cast(unsigned, f); return (u + 0x7fffu + ((u >> 16) & 1u)) >> 16; }
__device__ __forceinline__ unsigned pk2(float lo, float hi) { unsigned r; asm volatile("v_cvt_pk_bf16_f32 %0, %1, %2" : "=v"(r) : "v"(lo), "v"(hi)); return r; }
__device__ __forceinline__ float bf2f(unsigned short b) { return __builtin_bit_cast(float, (unsigned)b << 16); }
__device__ __forceinline__ float bflo(unsigned w) { return __builtin_bit_cast(float, w << 16); }
__device__ __forceinline__ float bfhi(unsigned w) { return __builtin_bit_cast(float, w & 0xffff0000u); }
__device__ __forceinline__ float siluf(float x) { return x * __builtin_amdgcn_rcpf(1.0f + __builtin_amdgcn_exp2f(-1.4426950408889634f * x)); }
#define XB_TMO      128
#define XB_XCNT(j)  (256  + 64 * (j))
#define XB_XSUB(j)  (1280 + 64 * (j))
#define XB_XGEN(j)  (2304 + 64 * (j))
#define XB_TOP      3328
#define XB_TOPGEN   3392
#define XCD_BAR_WORDS 3456
#define XB_SPIN_CAP (1u << 18)

__device__ __forceinline__ unsigned xb_ld(unsigned* p)              { return __hip_atomic_load(p, __ATOMIC_RELAXED, __HIP_MEMORY_SCOPE_AGENT); }
__device__ __forceinline__ unsigned xb_add(unsigned* p, unsigned v) { return __hip_atomic_fetch_add(p, v, __ATOMIC_RELAXED, __HIP_MEMORY_SCOPE_AGENT); }
__device__ __forceinline__ unsigned xb_xcc_id() { return (unsigned)__builtin_amdgcn_s_getreg((3 << 11) | 20) & 0xFu; }
#define XB_SPIN(cond, bar) do { unsigned _sp = 0; while (cond) { __builtin_amdgcn_s_sleep(1); \
    if ((++_sp & 255u) == 0u) { if (xb_ld(&(bar)[XB_TMO])) break; if (_sp > XB_SPIN_CAP) { atomicAdd(&(bar)[XB_TMO], 1u); break; } } } } while (0)

struct XcdBarrier {
    unsigned* bar; unsigned x;
    volatile LAS unsigned* st;
};

__device__ __forceinline__ XcdBarrier xcd_barrier_post(unsigned* bar, volatile LAS unsigned* st) {
    XcdBarrier b; b.bar = bar; b.x = xb_xcc_id(); b.st = st;
    if (threadIdx.x == 0) (void)xb_add(&bar[XB_XCNT(b.x)], 1u);
    return b;
}
__device__ __forceinline__ void xcd_barrier_complete(unsigned* bar, unsigned x, unsigned& nloc, unsigned& nx) {
    const unsigned G = gridDim.x * gridDim.y * gridDim.z;
    unsigned sum, cnt, mine, sp = 0u;
    for (;;) {
        sum = 0u; cnt = 0u; mine = 0u;
#pragma unroll
        for (unsigned j = 0; j < 16; ++j) { const unsigned c = xb_ld(&bar[XB_XCNT(j)]); sum += c; cnt += (c > 0u) ? 1u : 0u; mine = (j == x) ? c : mine; }
        if (sum == G) break;
        __builtin_amdgcn_s_sleep(1);
        if ((++sp & 255u) == 0u) { if (xb_ld(&bar[XB_TMO])) break; if (sp > XB_SPIN_CAP) { atomicAdd(&bar[XB_TMO], 1u); break; } }
    }
    nloc = mine > 0u ? mine : 1u; nx = cnt > 0u ? cnt : 1u;
}

__device__ __forceinline__ void xcd_barrier(const XcdBarrier& b) {
    asm volatile("s_waitcnt vmcnt(0)" ::: "memory");
    __syncthreads();
    if (threadIdx.x == 0) {
        unsigned* bar = b.bar;
        __builtin_amdgcn_s_waitcnt(0);
        unsigned nloc = b.st[0], nx = b.st[1];
        if (nloc == 0u) { xcd_barrier_complete(bar, b.x, nloc, nx); b.st[0] = nloc; b.st[1] = nx; }
        const unsigned old = xb_add(&bar[XB_XSUB(b.x)], 1u);
        const unsigned gen = old / nloc;
        if (old + 1u == (gen + 1u) * nloc) {
            __builtin_amdgcn_fence(__ATOMIC_RELEASE, "agent");
            asm volatile("s_waitcnt vmcnt(0)" ::: "memory");
            const unsigned og = xb_add(&bar[XB_TOP], 1u);
            const unsigned tg = og / nx;
            if (og + 1u == (tg + 1u) * nx) xb_add(&bar[XB_TOPGEN], 1u);
            else XB_SPIN(xb_ld(&bar[XB_TOPGEN]) == tg, bar);
            __builtin_amdgcn_fence(__ATOMIC_ACQUIRE, "agent");
            xb_add(&bar[XB_XGEN(b.x)], 1u);
            asm volatile("s_waitcnt vmcnt(0)" ::: "memory");
        } else {
            XB_SPIN(xb_ld(&bar[XB_XGEN(b.x)]) == gen, bar);
            __builtin_amdgcn_fence(__ATOMIC_ACQUIRE, "agent");
            asm volatile("s_waitcnt vmcnt(0)" ::: "memory");
        }
    }
    __syncthreads();
}

constexpr float SC_X = 4.f, SC_WGU = 32.f, SC_H = 4.f, SC_WDN = 4.f, SC_Y = 16.f, SC_WIN = 32.f, SC_O = 32.f;
__device__ __forceinline__ float wave_sum(float v) {
#pragma unroll
    for (int o = 1; o < 64; o <<= 1) v += __shfl_xor(v, o);
    return v;
}
__device__ __forceinline__ int win_dest_row(int n) {
    if (n < 1024) { const int hh = n >> 6, d = n & 63; const int p = (d < 32) ? (8 * (d >> 2) + (d & 3)) : (8 * ((d - 32) >> 2) + 4 + (d & 3)); return hh * 64 + p; }
    if (n < 3072) return n;
    if (n < 3080) return -1;
    return n - 8;
}
__device__ __forceinline__ int wgu_dest_row(int n) { return n < 1024 ? ((n >> 7) * 256 + (n & 127)) : (((n - 1024) >> 7) * 256 + 128 + ((n - 1024) & 127)); }
template <int MAP>
__device__ __forceinline__ void p0_transpose_item(const float* W, int K, int N, bf16* WT, float* wdt, LAS float* scr, int kb, int nb, int lane) {
    const int k0 = 64 * kb, n0 = 32 * nb;
    const int nn = n0 + (lane & 31); const bool nok = nn < N;
#pragma unroll 8
    for (int i = 0; i < 32; ++i) { const int kk = 2 * i + (lane >> 5); scr[kk * 33 + (lane & 31)] = nok ? W[(size_t)(k0 + kk) * N + nn] : 0.f; }
    LDS_WAIT(); asm volatile("" ::: "memory");
    const int c = lane & 7;
#pragma unroll
    for (int j = 0; j < 4; ++j) { const int n = (lane >> 3) + 8 * j; const LAS float* s = scr + (8 * c) * 33 + n;
        const int nsrc = n0 + n; if (nsrc >= N) continue;
        int drow = nsrc; if (MAP == 1) drow = win_dest_row(nsrc); if (MAP == 2) drow = wgu_dest_row(nsrc);
        if (MAP == 1 && drow < 0) { float* d = wdt + (size_t)(nsrc - 3072) * 1024 + k0 + 8 * c;
#pragma unroll
            for (int q = 0; q < 8; ++q) d[q] = s[q * 33]; continue; }
        v4u o; o.x = pk2(s[0 * 33], s[1 * 33]); o.y = pk2(s[2 * 33], s[3 * 33]); o.z = pk2(s[4 * 33], s[5 * 33]); o.w = pk2(s[6 * 33], s[7 * 33]);
        *(GAS v4u*)(WT + (size_t)drow * K + k0 + 8 * c) = o; }
    LDS_WAIT(); asm volatile("" ::: "memory");
}
template <int MAP>
__device__ __forceinline__ void p0_transpose_item64(const float* W, int K, int N, bf16* WT, float* wdt, LAS float* scr, int kb, int nb, int lane) {
    const int k0 = 64 * kb, n0 = 64 * nb;
    const bool lok = (n0 + 4 * (lane & 15) + 3) < N;
    f32x4 ld[16];
#pragma unroll
    for (int i = 0; i < 16; ++i) ld[i] = lok ? *(const f32x4*)(W + (size_t)(k0 + 4 * i + (lane >> 4)) * N + n0 + 4 * (lane & 15)) : (f32x4){0.f, 0.f, 0.f, 0.f};
#pragma unroll
    for (int i = 0; i < 16; ++i) *(LAS f32x4*)(scr + (4 * i + (lane >> 4)) * 64 + 4 * (lane & 15)) = ld[i];
    LDS_WAIT(); asm volatile("" ::: "memory");
    const int nsrc = n0 + lane;
    if (nsrc < N) {
        int drow = nsrc; if (MAP == 1) drow = win_dest_row(nsrc);
        if (MAP == 1 && drow < 0) { float* d = wdt + (size_t)(nsrc - 3072) * 1024 + k0;
#pragma unroll
            for (int q = 0; q < 16; ++q) *(f32x4*)(d + 4 * q) = (f32x4){scr[(4 * q) * 64 + lane], scr[(4 * q + 1) * 64 + lane], scr[(4 * q + 2) * 64 + lane], scr[(4 * q + 3) * 64 + lane]}; }
        else { GAS v4u* d = (GAS v4u*)(WT + (size_t)drow * K + k0);
#pragma unroll
            for (int q = 0; q < 8; ++q) { v4u o; o.x = pk2(scr[(8 * q) * 64 + lane], scr[(8 * q + 1) * 64 + lane]); o.y = pk2(scr[(8 * q + 2) * 64 + lane], scr[(8 * q + 3) * 64 + lane]);
                o.z = pk2(scr[(8 * q + 4) * 64 + lane], scr[(8 * q + 5) * 64 + lane]); o.w = pk2(scr[(8 * q + 6) * 64 + lane], scr[(8 * q + 7) * 64 + lane]); d[q] = o; } } }
    LDS_WAIT(); asm volatile("" ::: "memory");
}
struct SubT { const float* src; unsigned char* dst; int N; int n0; int mode; float scale; };
__device__ __forceinline__ SubT fp8_subtile(int item, int half, const float* wgu, const float* wdn, const float* win, unsigned char* WG8, unsigned char* WD8, unsigned char* WI8, int lane) {
    SubT t; int kb, nb;
    if (item < 64 * 256) { const int le = item >> 8, r = item & 255; kb = r >> 5; nb = r & 31; t.N = 2048; t.mode = 1; t.scale = SC_WGU;
        t.src = wgu + (size_t)le * 1024 * 2048; t.dst = WG8 + (size_t)le * 2048 * 1024; }
    else if (item < 64 * 256 + 64 * 128) { const int it2 = item - 64 * 256; const int le = it2 >> 7, r = it2 & 127; kb = r >> 4; nb = r & 15; t.N = 1024; t.mode = 0; t.scale = SC_WDN;
        t.src = wdn + (size_t)le * 1024 * 1024; t.dst = WD8 + (size_t)le * 1024 * 1024; }
    else { const int it3 = item - (64 * 256 + 64 * 128); const int l = it3 / 192, r = it3 % 192; kb = r / 24; nb = r % 24; t.N = INW; t.mode = 2; t.scale = SC_WIN;
        t.src = win + (size_t)l * 1024 * INW; t.dst = WI8 + (size_t)l * 1536 * 1024; }
    const int k0 = 128 * kb + 64 * half; t.n0 = 64 * nb;
    t.src += (size_t)(k0 + (lane >> 4)) * t.N + t.n0 + 4 * (lane & 15);
    t.dst += (size_t)k0;
    return t;
}
__device__ __forceinline__ void fp8_sub_load(const SubT& t, f32x4 (&ld)[16]) {
#pragma unroll
    for (int i = 0; i < 16; ++i) ld[i] = __builtin_nontemporal_load((const f32x4*)(t.src + (size_t)(4 * i) * t.N));
}
__device__ __forceinline__ void fp8_sub_process(const SubT& t, const f32x4 (&ld)[16], LAS float* scr, int lane) {
#pragma unroll
    for (int i = 0; i < 16; ++i) *(LAS f32x4*)(scr + (4 * i + (lane >> 4)) * 64 + 4 * (lane & 15)) = ld[i];
    LDS_WAIT(); asm volatile("" ::: "memory");
    unsigned w[16];
#pragma unroll
    for (int q = 0; q < 16; ++q) w[q] = pg8::pk4_fp8(scr[(4 * q + 0) * 64 + lane] * t.scale, scr[(4 * q + 1) * 64 + lane] * t.scale, scr[(4 * q + 2) * 64 + lane] * t.scale, scr[(4 * q + 3) * 64 + lane] * t.scale);
    LDS_WAIT(); asm volatile("" ::: "memory");
    LAS unsigned char* t2 = (LAS unsigned char*)scr;
#pragma unroll
    for (int q = 0; q < 4; ++q) *(LAS v4u*)(t2 + lane * 80 + 16 * q) = (v4u){w[4 * q], w[4 * q + 1], w[4 * q + 2], w[4 * q + 3]};
    LDS_WAIT(); asm volatile("" ::: "memory");
#pragma unroll
    for (int q = 0; q < 4; ++q) { const int n = 16 * q + (lane >> 2); const v4u v = *(const LAS v4u*)(t2 + n * 80 + 16 * (lane & 3));
        const int nn = (t.mode == 1) ? wgu_dest_row(t.n0 + n) : (t.mode == 2) ? win_dest_row(t.n0 + n) : (t.n0 + n);
        *(GAS v4u*)(t.dst + (size_t)nn * 1024 + 16 * (lane & 3)) = v; }
    LDS_WAIT(); asm volatile("" ::: "memory");
}
__device__ __forceinline__ void row_dt(const f32x4 (&v)[4], const float* wdt, float* dst, int lane) {
    float r[8];
#pragma unroll
    for (int jj = 0; jj < 8; ++jj) { float s = 0.f;
#pragma unroll
        for (int j = 0; j < 4; ++j) { const f32x4 w = *(const f32x4*)(wdt + jj * 1024 + 4 * lane + 256 * j); s += v[j][0] * w[0] + v[j][1] * w[1] + v[j][2] * w[2] + v[j][3] * w[3]; }
        r[jj] = wave_sum(s); }
    if (lane == 0) { *(f32x4*)dst = (f32x4){r[0], r[1], r[2], r[3]}; *(f32x4*)(dst + 4) = (f32x4){r[4], r[5], r[6], r[7]}; }
}
__device__ __forceinline__ void load_wdt(const float* wdt, f32x4 (&w)[8][4], int lane) {
#pragma unroll
    for (int jj = 0; jj < 8; ++jj)
#pragma unroll
        for (int j = 0; j < 4; ++j) w[jj][j] = *(const f32x4*)(wdt + jj * 1024 + 4 * lane + 256 * j);
}
__device__ __forceinline__ void row_dt_w(const f32x4 (&v)[4], const f32x4 (&w)[8][4], float* dst, int lane) {
    float r[8];
#pragma unroll
    for (int jj = 0; jj < 8; ++jj) { float s = 0.f;
#pragma unroll
        for (int j = 0; j < 4; ++j) s += v[j][0] * w[jj][j][0] + v[j][1] * w[jj][j][1] + v[j][2] * w[jj][j][2] + v[j][3] * w[jj][j][3];
        r[jj] = wave_sum(s); }
    if (lane == 0) { *(f32x4*)dst = (f32x4){r[0], r[1], r[2], r[3]}; *(f32x4*)(dst + 4) = (f32x4){r[4], r[5], r[6], r[7]}; }
}
__device__ __forceinline__ void row_dt_win(const f32x4 (&v)[4], const float* win, float* dst, int lane) {
    float r[8];
#pragma unroll
    for (int jj = 0; jj < 8; ++jj) r[jj] = 0.f;
#pragma unroll
    for (int j = 0; j < 4; ++j)
#pragma unroll
        for (int e = 0; e < 4; ++e) { const float* wp = win + (size_t)(4 * lane + 256 * j + e) * INW + 3072; const f32x4 w0 = *(const f32x4*)wp, w1 = *(const f32x4*)(wp + 4); const float x = v[j][e];
            r[0] += x * w0[0]; r[1] += x * w0[1]; r[2] += x * w0[2]; r[3] += x * w0[3]; r[4] += x * w1[0]; r[5] += x * w1[1]; r[6] += x * w1[2]; r[7] += x * w1[3]; }
#pragma unroll
    for (int jj = 0; jj < 8; ++jj) r[jj] = wave_sum(r[jj]);
    if (lane == 0) { *(f32x4*)dst = (f32x4){r[0], r[1], r[2], r[3]}; *(f32x4*)(dst + 4) = (f32x4){r[4], r[5], r[6], r[7]}; }
}
template <bool W8, bool WF>
__device__ __forceinline__ void ln_row(f32x4 (&v)[4], const float* gam, const float* bet, float* of32, bf16* ob16, unsigned char* o8, float s8, int lane) {
    float s = 0.f;
#pragma unroll
    for (int j = 0; j < 4; ++j) s += (v[j][0] + v[j][1]) + (v[j][2] + v[j][3]);
    const float mean = wave_sum(s) * (1.f / DM); float s2 = 0.f;
#pragma unroll
    for (int j = 0; j < 4; ++j) { v[j] = v[j] - mean; s2 += (v[j][0] * v[j][0] + v[j][1] * v[j][1]) + (v[j][2] * v[j][2] + v[j][3] * v[j][3]); }
    const float rstd = 1.f / sqrtf(wave_sum(s2) * (1.f / DM) + LN_EPS);
#pragma unroll
    for (int j = 0; j < 4; ++j) { const f32x4 g = *(const f32x4*)(gam + 4 * lane + 256 * j), b = *(const f32x4*)(bet + 4 * lane + 256 * j);
        v[j] = v[j] * rstd * g + b;
        if (WF) *(f32x4*)(of32 + 4 * lane + 256 * j) = v[j];
        v2u w; w.x = pk2(v[j][0], v[j][1]); w.y = pk2(v[j][2], v[j][3]); *(v2u*)(ob16 + 4 * lane + 256 * j) = w;
        if (W8) *(unsigned*)(o8 + 4 * lane + 256 * j) = pg8::pk4_fp8(v[j][0] * s8, v[j][1] * s8, v[j][2] * s8, v[j][3] * s8); }
}


typedef short v4i16_t __attribute__((ext_vector_type(4)));
__device__ __forceinline__ bf16x8 tr_pair(const LAS unsigned char* p0, const LAS unsigned char* p1) {
    const v4i16_t a = __builtin_amdgcn_ds_read_tr16_b64_v4i16((LAS v4i16_t*)p0), b = __builtin_amdgcn_ds_read_tr16_b64_v4i16((LAS v4i16_t*)p1);
    return (bf16x8){a[0], a[1], a[2], a[3], b[0], b[1], b[2], b[3]};
}
__device__ __forceinline__ int crow16(int r, int hi) { return (r & 3) + 8 * (r >> 2) + 4 * hi; }
constexpr int AK_PITCH = 144, AV_PITCH = 192, AK_TILE = 32 * AK_PITCH, AV_TILE = 32 * AV_PITCH;
constexpr int AT_K = 0, AT_V = 12 * AK_TILE;
struct AttnItem { int p, b, h, d, r, qt0; };
__device__ __forceinline__ AttnItem attn_item(int I) { AttnItem a; a.p = I >> 10; const int rem = I & 1023; a.b = rem >> 7; a.h = (rem >> 4) & 7; const int grp = rem & 15;
    a.d = (a.p == 0) ? 1 : (a.p == 1) ? 4 : 16; const int tpr = 128 / a.d; const int T = grp * 8; a.r = T / tpr; a.qt0 = T % tpr; return a; }
__device__ __forceinline__ void attn_request(const bf16* PROJ, const AttnItem& a, v4u (&st)[12], int tid) {
    const int rr = tid >> 4, ch = tid & 15; const int col = (ch < 8 ? C_K : C_V - 64) + a.h * 64 + ch * 8;
#pragma unroll
    for (int tl = 0; tl < 12; ++tl) { const int kt = a.qt0 - 4 + tl; st[tl] = (v4u){0u, 0u, 0u, 0u};
        if (kt >= 0) { const size_t row = (size_t)a.b * SEQ + (size_t)(32 * kt + rr) * a.d + a.r; st[tl] = *(const v4u*)(PROJ + row * NPROJ + col); } }
}
__device__ __forceinline__ void attn_deposit(LAS unsigned char* al, const v4u (&st)[12], int tid) {
    const int rr = tid >> 4, ch = tid & 15;
    LAS unsigned char* dst = (ch < 8) ? (al + AT_K + rr * AK_PITCH + ch * 16) : (al + AT_V + rr * AV_PITCH + (ch - 8) * 16); const int tstep = (ch < 8) ? AK_TILE : AV_TILE;
#pragma unroll
    for (int tl = 0; tl < 12; ++tl) *(LAS v4u*)(dst + tl * tstep) = st[tl];
}
__device__ __forceinline__ void attn_wave_compute(const bf16* PROJ, bf16* OPp, float* LSEp, const AttnItem& a, const LAS unsigned char* al, int wave, int lane) {
    const int i = lane & 31, h2 = lane >> 5; const int qt = a.qt0 + wave;
    const size_t rowq = (size_t)a.b * SEQ + (size_t)(32 * qt + i) * a.d + a.r;
    bf16x8 qf[4];
    { const bf16* qp = PROJ + rowq * NPROJ + C_Q + a.h * 64 + 8 * h2;
#pragma unroll
      for (int s = 0; s < 4; ++s) qf[s] = *(const bf16x8*)(qp + 16 * s); }
    f32x16 o0 = {}, o1 = {}; float mrun = -INFINITY, lrun = 0.f;
    const int kt0 = qt > 4 ? qt - 4 : 0;
    const LAS unsigned char* krd = al + AT_K + i * AK_PITCH + 16 * h2;
    const LAS unsigned char* trb = al + AT_V + (4 * h2 + ((lane & 15) >> 2)) * AV_PITCH + (16 * ((lane >> 4) & 1) + 4 * (lane & 3)) * 2;
    f32x16 snext = {};
    { const LAS unsigned char* kp = krd + (kt0 - a.qt0 + 4) * AK_TILE;
#pragma unroll
      for (int s = 0; s < 4; ++s) snext = __builtin_amdgcn_mfma_f32_32x32x16_bf16(*(const LAS bf16x8*)(kp + 32 * s), qf[s], snext, 0, 0, 0); }
#pragma unroll 1
    for (int kt = kt0; kt <= qt; ++kt) {
        const int tl = kt - a.qt0 + 4;
        const LAS unsigned char* vp = trb + tl * AV_TILE;
        f32x16 sacc = snext;
        if (kt < qt) { const LAS unsigned char* kp = krd + (tl + 1) * AK_TILE; snext = (f32x16){};
#pragma unroll
            for (int s = 0; s < 4; ++s) snext = __builtin_amdgcn_mfma_f32_32x32x16_bf16(*(const LAS bf16x8*)(kp + 32 * s), qf[s], snext, 0, 0, 0); }
        if (kt == qt) {
#pragma unroll
            for (int rg = 0; rg < 16; ++rg) if (crow16(rg, h2) > i) sacc[rg] = -INFINITY;
        }
        if (kt + 4 == qt) {
#pragma unroll
            for (int rg = 0; rg < 16; ++rg) if (crow16(rg, h2) < i) sacc[rg] = -INFINITY;
        }
        float mx = sacc[0];
#pragma unroll
        for (int rg = 1; rg < 16; ++rg) mx = fmaxf(mx, sacc[rg]);
        mx = fmaxf(mx, __shfl_xor(mx, 32));
        const float mnew = fmaxf(mrun, mx), alpha = __builtin_amdgcn_exp2f(mrun - mnew); mrun = mnew;
        float ps = 0.f;
#pragma unroll
        for (int rg = 0; rg < 16; ++rg) { sacc[rg] = __builtin_amdgcn_exp2f(sacc[rg] - mnew); ps += sacc[rg]; }
        lrun = lrun * alpha + ps;
#pragma unroll
        for (int rg = 0; rg < 16; ++rg) { o0[rg] *= alpha; o1[rg] *= alpha; }
        bf16x8 pf[2];
#pragma unroll
        for (int ks = 0; ks < 2; ++ks) { v4u w; w.x = pg8::cvt_pk_bf16(sacc[8 * ks + 0], sacc[8 * ks + 1]); w.y = pg8::cvt_pk_bf16(sacc[8 * ks + 2], sacc[8 * ks + 3]); w.z = pg8::cvt_pk_bf16(sacc[8 * ks + 4], sacc[8 * ks + 5]); w.w = pg8::cvt_pk_bf16(sacc[8 * ks + 6], sacc[8 * ks + 7]); pf[ks] = __builtin_bit_cast(bf16x8, w); }
#pragma unroll
        for (int ks = 0; ks < 2; ++ks) {
            const bf16x8 v0 = tr_pair(vp + (16 * ks) * AV_PITCH, vp + (16 * ks + 8) * AV_PITCH);
            const bf16x8 v1 = tr_pair(vp + (16 * ks) * AV_PITCH + 64, vp + (16 * ks + 8) * AV_PITCH + 64);
            o0 = __builtin_amdgcn_mfma_f32_32x32x16_bf16(v0, pf[ks], o0, 0, 0, 0);
            o1 = __builtin_amdgcn_mfma_f32_32x32x16_bf16(v1, pf[ks], o1, 0, 0, 0);
        }
    }
    const float lt = lrun + __shfl_xor(lrun, 32); const float il = 1.0f / lt;
    unsigned char* op = (unsigned char*)OPp + rowq * 512 + a.h * 64 + 4 * h2;
    const float ils = il * SC_O;
#pragma unroll
    for (int g4 = 0; g4 < 4; ++g4) {
        *(unsigned*)(op + 8 * g4) = pg8::pk4_fp8(o0[4 * g4 + 0] * ils, o0[4 * g4 + 1] * ils, o0[4 * g4 + 2] * ils, o0[4 * g4 + 3] * ils);
        *(unsigned*)(op + 32 + 8 * g4) = pg8::pk4_fp8(o1[4 * g4 + 0] * ils, o1[4 * g4 + 1] * ils, o1[4 * g4 + 2] * ils, o1[4 * g4 + 3] * ils); }
    if (h2 == 0) LSEp[rowq * 8 + a.h] = mrun + log2f(lt);
}
__device__ __forceinline__ void attn_phase(LAS unsigned char* al, const bf16* PROJ, bf16* OP, float* LSE, int bid, int G, int tid, int wave, int lane) {
    v4u st[12];
    int I = bid;
    if (I < 3072) { const AttnItem a = attn_item(I); attn_request(PROJ, a, st, tid); }
    for (; I < 3072; I += G) {
        const AttnItem a = attn_item(I);
        __syncthreads();
        attn_deposit(al, st, tid);
        __syncthreads();
        if (I + G < 3072) { const AttnItem n = attn_item(I + G); attn_request(PROJ, n, st, tid); }
        attn_wave_compute(PROJ, (bf16*)((unsigned char*)OP + (size_t)a.p * MROWS * 512), LSE + (size_t)a.p * MROWS * 8, a, al, wave, lane);
    }
    __syncthreads();
}

constexpr int SS_DTS = 0, SS_ACUM = 2048, SS_TMP = 4096, SS_SSX = 6144, SS_IMG = 8192;
constexpr int S1_PB = 320, S1_PX = 576;
constexpr int S1_B = SS_IMG, S1_X = SS_IMG + 128 * S1_PB;
constexpr int S3_PBC = 272, S3_PX = 576;
constexpr int S3_B = SS_IMG, S3_C = S3_B + 128 * S3_PBC, S3_X = S3_C + 128 * S3_PBC;

__device__ __forceinline__ void ssd_prep(LAS unsigned char* sl, const float* DT, const float* dtb, const float* alog, size_t row0, int g, int tid, int lane, int wave) {
    LAS float* dts = (LAS float*)(sl + SS_DTS); LAS float* acum = (LAS float*)(sl + SS_ACUM); LAS float* tmp = (LAS float*)(sl + SS_TMP);
    { const int l = tid >> 2, hq = tid & 3; const float x = DT[(row0 + l) * 8 + 4 * g + hq] + dtb[4 * g + hq];
      const float dt = x > 20.f ? x : log1pf(__expf(x)); dts[hq * 128 + l] = dt; tmp[hq * 128 + l] = dt * (-__expf(alog[4 * g + hq])); }
    __syncthreads();
    if (wave < 4) { const float v0 = tmp[wave * 128 + 2 * lane], v1 = tmp[wave * 128 + 2 * lane + 1]; float s = v0 + v1;
#pragma unroll
        for (int off = 1; off < 64; off <<= 1) { const float t = __shfl_up(s, off); if (lane >= off) s += t; }
        acum[wave * 128 + 2 * lane] = s - v1; acum[wave * 128 + 2 * lane + 1] = s; }
    __syncthreads();
}
template <int NCOLS, int FACMODE>
__device__ __forceinline__ void conv_tile(const bf16* PROJ, size_t row0, int t0, int pcol0, const float* cw, const float* cb, int cch0, LAS unsigned char* dst, int pitch, const LAS unsigned char* sl, int hq0, int tid) {
    constexpr int NCH8 = NCOLS / 8, NSEG = 512 / NCH8, RPS = 128 / NSEG;
    const int c8 = tid % NCH8, seg = tid / NCH8, l0 = seg * RPS;
    float w[4][8], bias[8], hst[3][8];
#pragma unroll
    for (int k = 0; k < 4; ++k) { const f32x4 a = *(const f32x4*)(cw + k * 1024 + cch0 + c8 * 8), b = *(const f32x4*)(cw + k * 1024 + cch0 + c8 * 8 + 4);
        w[k][0] = a[0]; w[k][1] = a[1]; w[k][2] = a[2]; w[k][3] = a[3]; w[k][4] = b[0]; w[k][5] = b[1]; w[k][6] = b[2]; w[k][7] = b[3]; }
    { const f32x4 a = *(const f32x4*)(cb + cch0 + c8 * 8), b = *(const f32x4*)(cb + cch0 + c8 * 8 + 4);
      bias[0] = a[0]; bias[1] = a[1]; bias[2] = a[2]; bias[3] = a[3]; bias[4] = b[0]; bias[5] = b[1]; bias[6] = b[2]; bias[7] = b[3]; }
    const bf16* src = PROJ + pcol0 + c8 * 8;
#pragma unroll
    for (int k = 0; k < 3; ++k) { const int l = l0 - 3 + k; v4u v = (v4u){0u, 0u, 0u, 0u}; if (t0 + l >= 0) v = *(const v4u*)(src + (size_t)((long)row0 + l) * NPROJ);
        hst[k][0] = bflo(v.x); hst[k][1] = bfhi(v.x); hst[k][2] = bflo(v.y); hst[k][3] = bfhi(v.y); hst[k][4] = bflo(v.z); hst[k][5] = bfhi(v.z); hst[k][6] = bflo(v.w); hst[k][7] = bfhi(v.w); }
    const LAS float* dts = (const LAS float*)(sl + SS_DTS); const LAS float* acum = (const LAS float*)(sl + SS_ACUM);
    const int hq = hq0 + (c8 * 8) / 64;
    const float alast = (FACMODE == 2) ? acum[hq * 128 + 127] : 0.f;
#pragma unroll
    for (int rr = 0; rr < RPS; ++rr) { const int l = l0 + rr; const v4u v = *(const v4u*)(src + (row0 + l) * NPROJ);
        float cur[8]; cur[0] = bflo(v.x); cur[1] = bfhi(v.x); cur[2] = bflo(v.y); cur[3] = bfhi(v.y); cur[4] = bflo(v.z); cur[5] = bfhi(v.z); cur[6] = bflo(v.w); cur[7] = bfhi(v.w);
        float f = 1.f; if (FACMODE >= 1) f = dts[hq * 128 + l]; if (FACMODE == 2) f *= __expf(alast - acum[hq * 128 + l]);
        float o[8];
#pragma unroll
        for (int e = 0; e < 8; ++e) { const float a = bias[e] + w[0][e] * hst[0][e] + w[1][e] * hst[1][e] + w[2][e] * hst[2][e] + w[3][e] * cur[e]; o[e] = siluf(a) * f;
            hst[0][e] = hst[1][e]; hst[1][e] = hst[2][e]; hst[2][e] = cur[e]; }
        v4u ov; ov.x = pk2(o[0], o[1]); ov.y = pk2(o[2], o[3]); ov.z = pk2(o[4], o[5]); ov.w = pk2(o[6], o[7]);
        *(LAS v4u*)(dst + l * pitch + c8 * 16) = ov; }
}
template <int NCOLS>
__device__ __forceinline__ void conv_load(const bf16* PROJ, size_t row0, int t0, int pcol0, int tid, v4u (&hv)[3], v4u (&rv)[128 / (512 / (NCOLS / 8))]) {
    constexpr int NCH8 = NCOLS / 8, NSEG = 512 / NCH8, RPS = 128 / NSEG;
    const int c8 = tid % NCH8, seg = tid / NCH8, l0 = seg * RPS;
    const bf16* src = PROJ + pcol0 + c8 * 8;
#pragma unroll
    for (int k = 0; k < 3; ++k) { const int l = l0 - 3 + k; hv[k] = (v4u){0u, 0u, 0u, 0u}; if (t0 + l >= 0) hv[k] = *(const v4u*)(src + (size_t)((long)row0 + l) * NPROJ); }
#pragma unroll
    for (int rr = 0; rr < RPS; ++rr) rv[rr] = *(const v4u*)(src + (row0 + l0 + rr) * NPROJ);
}
template <int NCOLS, int FACMODE>
__device__ __forceinline__ void conv_apply(const v4u (&hv)[3], const v4u (&rv)[128 / (512 / (NCOLS / 8))], const float* cw, const float* cb, int cch0, LAS unsigned char* dst, int pitch, const LAS unsigned char* sl, int hq0, int tid) {
    constexpr int NCH8 = NCOLS / 8, NSEG = 512 / NCH8, RPS = 128 / NSEG;
    const int c8 = tid % NCH8, seg = tid / NCH8, l0 = seg * RPS;
    float w[4][8], bias[8], hst[3][8];
#pragma unroll
    for (int k = 0; k < 4; ++k) { const f32x4 a = *(const f32x4*)(cw + k * 1024 + cch0 + c8 * 8), b = *(const f32x4*)(cw + k * 1024 + cch0 + c8 * 8 + 4);
        w[k][0] = a[0]; w[k][1] = a[1]; w[k][2] = a[2]; w[k][3] = a[3]; w[k][4] = b[0]; w[k][5] = b[1]; w[k][6] = b[2]; w[k][7] = b[3]; }
    { const f32x4 a = *(const f32x4*)(cb + cch0 + c8 * 8), b = *(const f32x4*)(cb + cch0 + c8 * 8 + 4);
      bias[0] = a[0]; bias[1] = a[1]; bias[2] = a[2]; bias[3] = a[3]; bias[4] = b[0]; bias[5] = b[1]; bias[6] = b[2]; bias[7] = b[3]; }
#pragma unroll
    for (int k = 0; k < 3; ++k) { const v4u v = hv[k];
        hst[k][0] = bflo(v.x); hst[k][1] = bfhi(v.x); hst[k][2] = bflo(v.y); hst[k][3] = bfhi(v.y); hst[k][4] = bflo(v.z); hst[k][5] = bfhi(v.z); hst[k][6] = bflo(v.w); hst[k][7] = bfhi(v.w); }
    const LAS float* dts = (const LAS float*)(sl + SS_DTS); const LAS float* acum = (const LAS float*)(sl + SS_ACUM);
    const int hq = hq0 + (c8 * 8) / 64;
    const float alast = (FACMODE == 2) ? acum[hq * 128 + 127] : 0.f;
#pragma unroll
    for (int rr = 0; rr < RPS; ++rr) { const int l = l0 + rr; const v4u v = rv[rr];
        float cur[8]; cur[0] = bflo(v.x); cur[1] = bfhi(v.x); cur[2] = bflo(v.y); cur[3] = bfhi(v.y); cur[4] = bflo(v.z); cur[5] = bfhi(v.z); cur[6] = bflo(v.w); cur[7] = bfhi(v.w);
        float f = 1.f; if (FACMODE >= 1) f = dts[hq * 128 + l]; if (FACMODE == 2) f *= __expf(alast - acum[hq * 128 + l]);
        float o[8];
#pragma unroll
        for (int e = 0; e < 8; ++e) { const float a = bias[e] + w[0][e] * hst[0][e] + w[1][e] * hst[1][e] + w[2][e] * hst[2][e] + w[3][e] * cur[e]; o[e] = siluf(a) * f;
            hst[0][e] = hst[1][e]; hst[1][e] = hst[2][e]; hst[2][e] = cur[e]; }
        v4u ov; ov.x = pk2(o[0], o[1]); ov.y = pk2(o[2], o[3]); ov.z = pk2(o[4], o[5]); ov.w = pk2(o[6], o[7]);
        *(LAS v4u*)(dst + l * pitch + c8 * 16) = ov; }
}
__device__ __forceinline__ void ssd_s1_unit(LAS unsigned char* sl, const bf16* PROJ, const float* DT, const float* dtb, const float* alog, const float* cw, const float* cb, float* ST, float* CDEC, int un, int tid, int lane, int wave) {
    const int g = un & 1, bc = un >> 1; const size_t row0 = (size_t)bc * 128; const int t0 = (bc & 31) * 128;
    v4u hvB[3], rvB[4], hvX[3], rvX[8];
    conv_load<128>(PROJ, row0, t0, C_XS + 512 + g * 128, tid, hvB, rvB);
    conv_load<256>(PROJ, row0, t0, C_XS + g * 256, tid, hvX, rvX);
    __syncthreads();
    ssd_prep(sl, DT, dtb, alog, row0, g, tid, lane, wave);
    conv_apply<128, 0>(hvB, rvB, cw, cb, 512 + g * 128, sl + S1_B, S1_PB, sl, 0, tid);
    conv_apply<256, 2>(hvX, rvX, cw, cb, g * 256, sl + S1_X, S1_PX, sl, 0, tid);
    if (tid < 4) CDEC[(size_t)bc * 8 + 4 * g + tid] = __expf(((const LAS float*)(sl + SS_ACUM))[tid * 128 + 127]);
    __syncthreads();
    const int hq = wave >> 1, pt = wave & 1, h2 = lane >> 5, q = (lane & 15) >> 2, pp = lane & 3, dsel = (lane >> 4) & 1;
    const LAS unsigned char* xb = sl + S1_X + (8 * h2 + q) * S1_PX + (hq * 64 + pt * 32 + 16 * dsel + 4 * pp) * 2;
    const LAS unsigned char* bb = sl + S1_B + (8 * h2 + q) * S1_PB + (16 * dsel + 4 * pp) * 2;
    f32x16 acc[4];
#pragma unroll
    for (int nt = 0; nt < 4; ++nt) acc[nt] = (f32x16){};
#pragma unroll
    for (int ks = 0; ks < 8; ++ks) { const bf16x8 a = tr_pair(xb + (16 * ks) * S1_PX, xb + (16 * ks + 4) * S1_PX);
#pragma unroll
        for (int nt = 0; nt < 4; ++nt) { const bf16x8 b = tr_pair(bb + (16 * ks) * S1_PB + nt * 64, bb + (16 * ks + 4) * S1_PB + nt * 64); acc[nt] = __builtin_amdgcn_mfma_f32_32x32x16_bf16(a, b, acc[nt], 0, 0, 0); } }
    float* sp = ST + ((size_t)(bc * 8 + 4 * g + hq) * 64 + pt * 32) * 128 + (lane & 31);
#pragma unroll
    for (int nt = 0; nt < 4; ++nt)
#pragma unroll
        for (int rg = 0; rg < 16; ++rg) sp[(size_t)crow16(rg, h2) * 128 + 32 * nt] = acc[nt][rg];
}
__device__ __forceinline__ void ssd_s3_unit(LAS unsigned char* sl, const bf16* PROJ, const float* DT, const float* dtb, const float* alog, const float* cw, const float* cb, const float* dsk, const float* ng,
                                            const bf16* HIN, bf16* MIXED, int un, int tid, int lane, int wave) {
    const int g = un & 1, bc = un >> 1; const size_t row0 = (size_t)bc * 128; const int t0 = (bc & 31) * 128;
    const int lt = wave & 3, ph = wave >> 2, lq = lane & 31, hi = lane >> 5, q = (lane & 15) >> 2, pp = lane & 3, dsel = (lane >> 4) & 1;
    const int lrow = 32 * lt + lq;
    const size_t grow = row0 + lrow;
    v4u hvB[3], rvB[4], hvC[3], rvC[4], hvX[3], rvX[8];
    conv_load<128>(PROJ, row0, t0, C_XS + 512 + g * 128, tid, hvB, rvB);
    conv_load<128>(PROJ, row0, t0, C_XS + 768 + g * 128, tid, hvC, rvC);
    conv_load<256>(PROJ, row0, t0, C_XS + g * 256, tid, hvX, rvX);
    __syncthreads();
    ssd_prep(sl, DT, dtb, alog, row0, g, tid, lane, wave);
    conv_apply<128, 0>(hvB, rvB, cw, cb, 512 + g * 128, sl + S3_B, S3_PBC, sl, 0, tid);
    conv_apply<128, 0>(hvC, rvC, cw, cb, 768 + g * 128, sl + S3_C, S3_PBC, sl, 0, tid);
    conv_apply<256, 1>(hvX, rvX, cw, cb, g * 256, sl + S3_X, S3_PX, sl, 0, tid);
    bf16x8 hf[2][8];
    const bf16* hp0 = HIN + ((size_t)(bc * 8 + 4 * g) * 64 + ph * 32 + lq) * 128 + 8 * hi;
#pragma unroll
    for (int hq = 0; hq < 2; ++hq)
#pragma unroll
        for (int ks = 0; ks < 8; ++ks) hf[hq][ks] = *(const bf16x8*)(hp0 + (size_t)hq * 8192 + 16 * ks);
    __syncthreads();
    const LAS float* dts = (const LAS float*)(sl + SS_DTS); const LAS float* acum = (const LAS float*)(sl + SS_ACUM); LAS float* ssx = (LAS float*)(sl + SS_SSX);
    const LAS unsigned char* crd = sl + S3_C + lrow * S3_PBC + 16 * hi;
    f32x16 y[4];
#pragma unroll
    for (int hq = 0; hq < 4; ++hq) {
        f32x16 t = (f32x16){};
#pragma unroll
        for (int ks = 0; ks < 8; ++ks) t = __builtin_amdgcn_mfma_f32_32x32x16_bf16(hf[hq & 1][ks], *(const LAS bf16x8*)(crd + 32 * ks), t, 0, 0, 0);
        if (hq < 2) {
#pragma unroll
            for (int ks = 0; ks < 8; ++ks) hf[hq & 1][ks] = *(const bf16x8*)(hp0 + (size_t)(hq + 2) * 8192 + 16 * ks); }
        const float ea = __expf(acum[hq * 128 + lrow]);
#pragma unroll
        for (int rg = 0; rg < 16; ++rg) t[rg] *= ea;
        y[hq] = t; }
    v2u zr[4][4];
#pragma unroll
    for (int hq = 0; hq < 4; ++hq)
#pragma unroll
        for (int g4 = 0; g4 < 4; ++g4) zr[hq][g4] = *(const v2u*)(PROJ + grow * NPROJ + C_Z + g * 256 + hq * 64 + ph * 32 + 8 * g4 + 4 * hi);
#pragma unroll
    for (int st = 0; st < 4; ++st) if (st <= lt) {
        f32x16 ag = (f32x16){};
        { const LAS unsigned char* brd = sl + S3_B + (32 * st + lq) * S3_PBC + 16 * hi;
#pragma unroll
          for (int ks = 0; ks < 8; ++ks) ag = __builtin_amdgcn_mfma_f32_32x32x16_bf16(*(const LAS bf16x8*)(brd + 32 * ks), *(const LAS bf16x8*)(crd + 32 * ks), ag, 0, 0, 0); }
#pragma unroll
        for (int hq = 0; hq < 4; ++hq) {
            const float al = acum[hq * 128 + lrow], dd = dsk[4 * g + hq] / dts[hq * 128 + lrow];
            const LAS unsigned char* xb = sl + S3_X + (4 * hi + q) * S3_PX + (hq * 64 + ph * 32 + 16 * dsel + 4 * pp) * 2;
            float pm[16];
#pragma unroll
            for (int g4 = 0; g4 < 4; ++g4) { const f32x4 as4 = *(const LAS f32x4*)(acum + hq * 128 + 32 * st + 8 * g4 + 4 * hi);
#pragma unroll
                for (int e = 0; e < 4; ++e) { const int rg = 4 * g4 + e; float v = ag[rg] * __expf(al - as4[e]);
                    if (st == lt) { const int sl_ = 8 * g4 + 4 * hi + e; if (sl_ > lq) v = 0.f; if (sl_ == lq) v += dd; }
                    pm[rg] = v; } }
#pragma unroll
            for (int ks = 0; ks < 2; ++ks) { v4u wv; wv.x = pg8::cvt_pk_bf16(pm[8 * ks + 0], pm[8 * ks + 1]); wv.y = pg8::cvt_pk_bf16(pm[8 * ks + 2], pm[8 * ks + 3]); wv.z = pg8::cvt_pk_bf16(pm[8 * ks + 4], pm[8 * ks + 5]); wv.w = pg8::cvt_pk_bf16(pm[8 * ks + 6], pm[8 * ks + 7]);
                const bf16x8 xt = tr_pair(xb + (32 * st + 16 * ks) * S3_PX, xb + (32 * st + 16 * ks + 8) * S3_PX);
                y[hq] = __builtin_amdgcn_mfma_f32_32x32x16_bf16(xt, __builtin_bit_cast(bf16x8, wv), y[hq], 0, 0, 0); }
        }
    }
    unsigned ayp[4][8]; float ss = 0.f;
#pragma unroll
    for (int hq = 0; hq < 4; ++hq)
#pragma unroll
        for (int g4 = 0; g4 < 4; ++g4) { const v2u z = zr[hq][g4];
            const float y0 = y[hq][4 * g4 + 0] * siluf(bflo(z.x)), y1 = y[hq][4 * g4 + 1] * siluf(bfhi(z.x)), y2 = y[hq][4 * g4 + 2] * siluf(bflo(z.y)), y3 = y[hq][4 * g4 + 3] * siluf(bfhi(z.y));
            ss += (y0 * y0 + y1 * y1) + (y2 * y2 + y3 * y3);
            ayp[hq][2 * g4] = pg8::cvt_pk_bf16(y0, y1); ayp[hq][2 * g4 + 1] = pg8::cvt_pk_bf16(y2, y3); }
    ss += __shfl_xor(ss, 32);
    if (hi == 0) ssx[ph * 128 + lrow] = ss;
    __syncthreads();
    const float rs = 1.0f / sqrtf((ssx[lrow] + ssx[128 + lrow]) * (1.f / 256.f) + RMS_EPS);
#pragma unroll
    for (int hq = 0; hq < 4; ++hq)
#pragma unroll
        for (int g4 = 0; g4 < 4; ++g4) { const int ch = hq * 64 + ph * 32 + 8 * g4 + 4 * hi; const f32x4 gn = *(const f32x4*)(ng + g * 256 + ch);
            const unsigned p0 = ayp[hq][2 * g4], p1 = ayp[hq][2 * g4 + 1];
            v2u o; o.x = pg8::cvt_pk_bf16(bflo(p0) * rs * gn[0], bfhi(p0) * rs * gn[1]); o.y = pg8::cvt_pk_bf16(bflo(p1) * rs * gn[2], bfhi(p1) * rs * gn[3]);
            *(v2u*)(MIXED + grow * MIXW + 512 + g * 256 + ch) = o; }
}

struct Args { const float* in[20]; float* out; unsigned char* ws; int ph_lo, ph_hi, sub, pad; };
constexpr int NWAVES = 8;
constexpr int PH_PER_LAYER = 10, N_PHASES = 1 + NLAYER * PH_PER_LAYER;

#define in_x (args.in[0])
#define in_win (args.in[1])
#define in_convw (args.in[2])
#define in_convb (args.in[3])
#define in_dtb (args.in[4])
#define in_alog (args.in[5])
#define in_dsk (args.in[6])
#define in_ng (args.in[7])
#define in_scw (args.in[8])
#define in_wout (args.in[9])
#define in_ln1g (args.in[10])
#define in_ln1b (args.in[11])
#define in_rw (args.in[12])
#define in_rb (args.in[13])
#define in_wgu (args.in[14])
#define in_bgu (args.in[15])
#define in_wdn (args.in[16])
#define in_bdn (args.in[17])
#define in_ln2g (args.in[18])
#define in_ln2b (args.in[19])
#define ROPE ((float*)(args.ws + WS_ROPE))
#define WDT ((float*)(args.ws + WS_WDT))
#define ROUT ((bf16*)(args.ws + WS_ROUT))
#define WIN ((bf16*)(args.ws + WS_WIN))
#define WOUT ((bf16*)(args.ws + WS_WOUT))
#define WGU ((bf16*)(args.ws + WS_WGU))
#define WDN ((bf16*)(args.ws + WS_WDN))
#define XB ((bf16*)(args.ws + WS_XB))
#define XF ((float*)(args.ws + WS_XF))
#define XF2 ((float*)(args.ws + WS_XF2))
#define PROJ ((bf16*)(args.ws + WS_PROJ))
#define DT ((float*)(args.ws + WS_DT))
#define DTS ((float*)(args.ws + WS_DTS))
#define ACUM ((float*)(args.ws + WS_ACUM))
#define LSE ((float*)(args.ws + WS_LSE))
#define OP ((bf16*)(args.ws + WS_OP))
#define U ((bf16*)(args.ws + WS_U))
#define GB ((float*)(args.ws + WS_G))
#define ST ((float*)(args.ws + WS_ST))
#define YD ((float*)(args.ws + WS_YD))
#define MIXED ((bf16*)(args.ws + WS_MIXED))
#define MIXF ((bf16*)(args.ws + WS_MIXF))
#define TOPE ((int*)(args.ws + WS_TOPE))
#define TOPG ((float*)(args.ws + WS_TOPG))
#define ROWTOK ((int*)(args.ws + WS_ROWTOK))
#define ROWGATE ((float*)(args.ws + WS_ROWGATE))
#define HB ((bf16*)(args.ws + WS_H))
#define YB ((bf16*)(args.ws + WS_YB))
#define HIN ((bf16*)(args.ws + WS_G))
#define WGU8 ((unsigned char*)(args.ws + WS_WGU))
#define WDN8 ((unsigned char*)(args.ws + WS_WDN))
#define XB8 ((unsigned char*)(args.ws + WS_U))
#define H8 ((unsigned char*)(args.ws + WS_H))
#define YB8 ((unsigned char*)(args.ws + WS_YB))
#define WIN8 ((unsigned char*)(args.ws + WS_WGU + 128 * MiB))
#define XP8 ((unsigned char*)(args.ws + WS_WGU + 132 * MiB))
#define CDEC ((float*)(args.ws + WS_ACUM))
template <int layer>
__device__ __forceinline__ void run_layer(const Args& args, int lo, int hi, const XcdBarrier& bar) {
    extern __shared__ __attribute__((aligned(16))) unsigned char lds[];
    LAS unsigned char* ldsp = (LAS unsigned char*)lds;
    const int tid = threadIdx.x, lane = tid & 63, wave = __builtin_amdgcn_readfirstlane(tid >> 6);
    const int G = gridDim.x, bid = blockIdx.x;
    const int gw = bid * NWAVES + wave, NGW = G * NWAVES;
    gu32* ctl = (gu32*)(args.ws + WS_CTL);

#define IN(k) (lo <= (k) && (k) < hi)
#define SEAM(k) do { if (IN(k) && IN((k) + 1)) xcd_barrier(bar); } while (0)

        const int pb = 1 + layer * PH_PER_LAYER;
        const bf16* WINl = WIN + (size_t)layer * NPROJ * DM; const bf16* WOUTl = WOUT + (size_t)layer * DM * MIXW;
        const unsigned char* WGUl = WGU8 + (size_t)layer * NEXP * 2048 * DM; const unsigned char* WDNl = WDN8 + (size_t)layer * NEXP * DM * FF;
        gu32* gcnt = ctl + CW_CNT + 64 * layer;

        if (IN(pb + 0)) {
            {
              pg8::Gemm g{(const pg8::bf16_t*)XP8, (const pg8::bf16_t*)(WIN8 + (size_t)layer * 1536 * DM), MROWS, 1536, DM / 2}; pg8::StaticOrder S; S.init(MROWS, 1536, G, bid);
              pg8::EpiProj E{PROJ, NPROJ, ROPE, QSCALE, 1.0f / (SC_X * SC_WIN), 0};
              pg8::gemm_phase<pg8::EpiProj, pg8::StaticOrder, true, false, true>(ldsp + RING_OFF, g, S, E); }
            __syncthreads();
            { pg8::Gemm g{XB, WINl + (size_t)1536 * DM, MROWS, NPROJ - 1536, DM}; pg8::StaticOrder S; S.init(MROWS, NPROJ - 1536, G, bid);
              pg8::EpiProj E{PROJ, NPROJ, ROPE, QSCALE, 1.0f, 6};
              pg8::gemm_phase<pg8::EpiProj, pg8::StaticOrder, true, false>(ldsp + RING_OFF, g, S, E); }
        }
        SEAM(pb + 0);
        if (IN(pb + 1)) {
            if (args.sub & 1) attn_phase(ldsp + RING_OFF, PROJ, OP, LSE, bid, G, tid, wave, lane);
            if (args.sub & 2) { const float* cw = in_convw + (size_t)layer * 4 * 1024; const float* cb = in_convb + (size_t)layer * 1024;
              for (int un = bid; un < 512; un += G)
                  ssd_s1_unit(ldsp + RING_OFF, PROJ, DT, in_dtb + layer * 8, in_alog + layer * 8, cw, cb, ST, CDEC, un, tid, lane, wave);
              __syncthreads(); }
            const float* sw = in_scw + (size_t)layer * 3 * 512;
            if (args.sub & 4) {
                const int ch = (tid & 63) * 8;
                f32x4 wk[3][2];
#pragma unroll
                for (int k = 0; k < 3; ++k) { wk[k][0] = *(const f32x4*)(sw + k * 512 + ch); wk[k][1] = *(const f32x4*)(sw + k * 512 + ch + 4); }
#pragma unroll 1
                for (int it = bid * (NWAVES * 64) + tid; it < (MROWS / 4) * 64; it += G * (NWAVES * 64)) { const int row0 = (it >> 6) * 4; const bool head = (row0 & (SEQ - 1)) == 0;
                    v4u cc[6], hh[6], bb[4];
#pragma unroll
                    for (int i = 0; i < 6; ++i) { cc[i] = (v4u){0u, 0u, 0u, 0u}; hh[i] = cc[i];
                        if (i >= 2 || !head) { const bf16* pr = PROJ + (size_t)(row0 - 2 + i) * NPROJ; cc[i] = *(const v4u*)(pr + C_SC + ch); hh[i] = *(const v4u*)(pr + C_SH + ch); } }
#pragma unroll
                    for (int r = 0; r < 4; ++r) bb[r] = *(const v4u*)(PROJ + (size_t)(row0 + r) * NPROJ + C_SB + ch);
                    float p[6][8];
#pragma unroll
                    for (int i = 0; i < 6; ++i) { p[i][0] = bflo(cc[i].x) * bflo(hh[i].x); p[i][1] = bfhi(cc[i].x) * bfhi(hh[i].x); p[i][2] = bflo(cc[i].y) * bflo(hh[i].y); p[i][3] = bfhi(cc[i].y) * bfhi(hh[i].y);
                        p[i][4] = bflo(cc[i].z) * bflo(hh[i].z); p[i][5] = bfhi(cc[i].z) * bfhi(hh[i].z); p[i][6] = bflo(cc[i].w) * bflo(hh[i].w); p[i][7] = bfhi(cc[i].w) * bfhi(hh[i].w); }
#pragma unroll
                    for (int r = 0; r < 4; ++r) { float a[8];
#pragma unroll
                        for (int q = 0; q < 8; ++q) a[q] = wk[0][q >> 2][q & 3] * p[r][q] + wk[1][q >> 2][q & 3] * p[r + 1][q] + wk[2][q >> 2][q & 3] * p[r + 2][q];
                        const v4u b4 = bb[r];
                        v4u o; o.x = pk2(a[0] * bflo(b4.x), a[1] * bfhi(b4.x)); o.y = pk2(a[2] * bflo(b4.y), a[3] * bfhi(b4.y)); o.z = pk2(a[4] * bflo(b4.z), a[5] * bfhi(b4.z)); o.w = pk2(a[6] * bflo(b4.w), a[7] * bfhi(b4.w));
                        *(v4u*)(MIXED + (size_t)(row0 + r) * MIXW + 1024 + ch) = o; } }
            }
        }
        SEAM(pb + 1);
        if (IN(pb + 2)) {
            for (int it = bid * (NWAVES * 64) + tid; it < (int)(64L * 2048); it += G * (NWAVES * 64)) { const int pn4 = (int)(it & 2047), bh = (int)(it >> 11); const int h = bh & 7, b = bh >> 3; f32x4 hc = (f32x4){0.f, 0.f, 0.f, 0.f};
#pragma unroll 16
                for (int c = 0; c < 32; ++c) { const size_t idx = ((size_t)((b * 32 + c) * 8 + h)) * 8192 + pn4 * 4; const f32x4 st = *(const f32x4*)(ST + idx);
                    v2u o; o.x = pk2(hc[0], hc[1]); o.y = pk2(hc[2], hc[3]); *(v2u*)(HIN + idx) = o;
                    hc = hc * CDEC[(size_t)(b * 32 + c) * 8 + h] + st; } }
        }
        SEAM(pb + 2);
        if (IN(pb + 3)) {
            if (args.sub & 1) { const float* cw = in_convw + (size_t)layer * 4 * 1024; const float* cb = in_convb + (size_t)layer * 1024;
              for (int un = bid; un < 512; un += G)
                  ssd_s3_unit(ldsp + RING_OFF, PROJ, DT, in_dtb + layer * 8, in_alog + layer * 8, cw, cb, in_dsk + layer * 8, in_ng + (size_t)layer * 512, HIN, MIXED, un, tid, lane, wave);
              __syncthreads(); }
            if (args.sub & 2)
#pragma unroll 2
            for (int it = bid * (NWAVES * 64) + tid; it < (int)((long)MROWS * 32); it += G * (NWAVES * 64)) { const int c16 = (int)(it & 31), row = (int)(it >> 5); const int h = c16 >> 2;
                const float l0 = LSE[((size_t)0 * MROWS + row) * 8 + h], l1 = LSE[((size_t)1 * MROWS + row) * 8 + h], l2 = LSE[((size_t)2 * MROWS + row) * 8 + h];
                const float mm = fmaxf(l0, fmaxf(l1, l2)); float w0 = exp2f(l0 - mm), w1 = exp2f(l1 - mm), w2 = exp2f(l2 - mm); const float iw = (1.0f / SC_O) / (w0 + w1 + w2); w0 *= iw; w1 *= iw; w2 *= iw;
                const unsigned char* OP8 = (const unsigned char*)OP; typedef float f32x2_ __attribute__((ext_vector_type(2)));
                const v4u a0 = *(const v4u*)(OP8 + ((size_t)0 * MROWS + row) * 512 + c16 * 16), a1 = *(const v4u*)(OP8 + ((size_t)1 * MROWS + row) * 512 + c16 * 16), a2 = *(const v4u*)(OP8 + ((size_t)2 * MROWS + row) * 512 + c16 * 16);
                unsigned ow[8];
#pragma unroll
                for (int q = 0; q < 4; ++q) {
                    { const f32x2_ p0 = __builtin_amdgcn_cvt_pk_f32_fp8(a0[q], false), p1 = __builtin_amdgcn_cvt_pk_f32_fp8(a1[q], false), p2 = __builtin_amdgcn_cvt_pk_f32_fp8(a2[q], false); ow[2 * q] = pk2(w0 * p0[0] + w1 * p1[0] + w2 * p2[0], w0 * p0[1] + w1 * p1[1] + w2 * p2[1]); }
                    { const f32x2_ p0 = __builtin_amdgcn_cvt_pk_f32_fp8(a0[q], true), p1 = __builtin_amdgcn_cvt_pk_f32_fp8(a1[q], true), p2 = __builtin_amdgcn_cvt_pk_f32_fp8(a2[q], true); ow[2 * q + 1] = pk2(w0 * p0[0] + w1 * p1[0] + w2 * p2[0], w0 * p0[1] + w1 * p1[1] + w2 * p2[1]); } }
                bf16* op_ = MIXED + (size_t)row * MIXW + c16 * 16;
                *(v4u*)op_ = (v4u){ow[0], ow[1], ow[2], ow[3]}; *(v4u*)(op_ + 8) = (v4u){ow[4], ow[5], ow[6], ow[7]}; }
        }
        SEAM(pb + 3);
        if (IN(pb + 4)) {
#define FUSED_LN1_CALL(BASE, LIM) { pg8::Gemm g{MIXED, WOUTl, MROWS, DM, MIXW}; \
              pg8::EpiLn1 E{args.ws, in_ln1g + (size_t)layer * DM, in_ln1b + (size_t)layer * DM, WS_XB, WS_U, (layer ? WS_ROPE : WS_DTS), WS_CTL + (size_t)(CW_SEAM + layer * 8192) * 4, WS_CTL + (size_t)CW_TMO * 4, ALPHA, SC_X, LN_EPS, 0x700u + (unsigned)layer * 0x80u}; \
              pg8::StaticOrder S; S.init(MROWS, DM, G, bid); S.base = (BASE); S.lim = (LIM); \
              pg8::gemm_phase<pg8::EpiLn1, pg8::StaticOrder, false, false>(ldsp + RING_OFF, g, S, E); }
            FUSED_LN1_CALL(0, 256)
            __syncthreads();
            FUSED_LN1_CALL(256, 512)
            __syncthreads();
#undef FUSED_LN1_CALL
        }
        SEAM(pb + 4);
        if (IN(pb + 6)) {
            LAS int* lcnt = (LAS int*)(ldsp + L_LCNT); LAS int* lbase = (LAS int*)(ldsp + L_LBASE);
            const bf16* RT = ROUT + (size_t)layer * NEXP * DM; const float* rb = in_rb + (size_t)layer * NEXP;
            for (int blk = bid; blk < MROWS / 128; blk += G) {
                if (tid < 32) lcnt[tid] = 0;
                __syncthreads();
                const int r32 = lane & 31, hi = lane >> 5; const int row = blk * 128 + (wave & 3) * 32 + r32;
                float tv[4]; int te[4]; int lrank[4]; float gate[4];
                f32x16 acc = {};
                { const int kh = wave >> 2;
                  const bf16* ap = RT + (size_t)r32 * DM + 8 * hi + 512 * kh; const bf16* bp = XB + (size_t)row * DM + 8 * hi + 512 * kh;
#pragma unroll 16
                  for (int s = 0; s < 32; ++s) { const bf16x8 a = *(const bf16x8*)(ap + 16 * s), b = *(const bf16x8*)(bp + 16 * s); acc = __builtin_amdgcn_mfma_f32_32x32x16_bf16(a, b, acc, 0, 0, 0); }
                  LAS float* part = (LAS float*)(ldsp + RING_OFF) + (wave & 3) * 1024;
                  if (kh) {
#pragma unroll
                      for (int i = 0; i < 16; ++i) part[i * 64 + lane] = acc[i]; }
                  __syncthreads();
                  if (!kh) {
#pragma unroll
                      for (int i = 0; i < 16; ++i) acc[i] += part[i * 64 + lane]; } }
                if (wave < 4) {
#pragma unroll
                    for (int k = 0; k < 4; ++k) { tv[k] = -INFINITY; te[k] = 1 << 20; }
#pragma unroll
                    for (int i = 0; i < 16; ++i) { const int e = (i & 3) + 8 * (i >> 2) + 4 * hi; float v = acc[i] + rb[e]; int ve = e;
#pragma unroll
                        for (int k = 0; k < 4; ++k) { const bool gt = (v > tv[k]) || (v == tv[k] && ve < te[k]); const float nv = gt ? tv[k] : v; const int ne = gt ? te[k] : ve; tv[k] = gt ? v : tv[k]; te[k] = gt ? ve : te[k]; v = nv; ve = ne; } }
                    float pv[4]; int pe[4];
#pragma unroll
                    for (int k = 0; k < 4; ++k) { pv[k] = __shfl_xor(tv[k], 32); pe[k] = __shfl_xor(te[k], 32); }
#pragma unroll
                    for (int j = 0; j < 4; ++j) { float v = pv[j]; int ve = pe[j];
#pragma unroll
                        for (int k = 0; k < 4; ++k) { const bool gt = (v > tv[k]) || (v == tv[k] && ve < te[k]); const float nv = gt ? tv[k] : v; const int ne = gt ? te[k] : ve; tv[k] = gt ? v : tv[k]; te[k] = gt ? ve : te[k]; v = nv; ve = ne; } }
                    float se = 0.f;
#pragma unroll
                    for (int k = 0; k < 4; ++k) { gate[k] = __expf(tv[k] - tv[0]); se += gate[k]; }
                    const float ise = 1.0f / se;
#pragma unroll
                    for (int k = 0; k < 4; ++k) gate[k] *= ise;
                    if (hi == 0) {
#pragma unroll
                        for (int k = 0; k < 4; ++k) lrank[k] = __hip_atomic_fetch_add(lcnt + te[k], 1, __ATOMIC_RELAXED, __HIP_MEMORY_SCOPE_WORKGROUP);
                    }
                }
                __syncthreads();
                if (tid < 32) lbase[tid] = (int)__hip_atomic_fetch_add(gcnt + tid, (unsigned)lcnt[tid], RLX_AGENT);
                __syncthreads();
                if (wave < 4 && hi == 0) {
#pragma unroll
                    for (int k = 0; k < 4; ++k) { const int r = lbase[te[k]] + lrank[k]; const size_t o = (size_t)te[k] * 32768 + r;
                        ROWTOK[o] = row * 4 + k; ROWGATE[o] = gate[k]; }
                }
                __syncthreads();
            }
        }
        SEAM(pb + 6);
        if (IN(pb + 7) || IN(pb + 8)) {
            LAS int* tstart = (LAS int*)(ldsp + L_TSTART); LAS int* cntL = (LAS int*)(ldsp + L_CNT); LAS int* units = (LAS int*)(ldsp + L_UNITS); LAS int* unitsn = (LAS int*)(ldsp + L_UNITSN);
            if (tid < 64) {
                const int c = (tid < 32) ? (int)__hip_atomic_load(gcnt + tid, RLX_AGENT) : 0; const int t = (c + 255) >> 8; int incl = t;
#pragma unroll
                for (int d = 1; d < 32; d <<= 1) { const int v = __shfl_up(incl, d); if (tid >= d) incl += v; }
                if (tid < 32) { cntL[tid] = c; tstart[tid] = incl - t; }
                if (tid == 31) tstart[32] = incl; }
            __syncthreads();
            if (IN(pb + 7)) {
                pg8::moe_build_units(units, unitsn, tstart, 8, G, bid, tid);
                __syncthreads();
                pg8::Gemm g{(const pg8::bf16_t*)XB8, (const pg8::bf16_t*)WGUl, 0, 2048, DM / 2};
                pg8::MoeOrder S{units, __builtin_amdgcn_readfirstlane(unitsn[0]), cntL, ROWTOK, 1, (unsigned)DM, (size_t)2048 * DM, ROWGATE, in_bgu + (size_t)layer * NEXP * 2048};
                pg8::EpiSwiglu E{H8, in_bgu + (size_t)layer * NEXP * 2048, ROWGATE, cntL, 1.0f / (SC_X * SC_WGU), SC_H};
                pg8::gemm_phase<pg8::EpiSwiglu, pg8::MoeOrder, true, true, true>(ldsp + RING_OFF, g, S, E);
                __syncthreads();
            }
            SEAM(pb + 7);
            if (IN(pb + 8)) {
                pg8::moe_build_units(units, unitsn, tstart, 4, G, bid, tid);
                __syncthreads();
                pg8::Gemm g{(const pg8::bf16_t*)H8, (const pg8::bf16_t*)WDNl, 0, DM, FF / 2};
                pg8::MoeOrder S{units, __builtin_amdgcn_readfirstlane(unitsn[0]), cntL, ROWTOK, 0, (unsigned)FF, (size_t)DM * FF, ROWGATE, in_bdn + (size_t)layer * NEXP * DM};
                pg8::EpiScatter E{YB8, ROWTOK, cntL, SC_Y / (SC_H * SC_WDN), SC_Y};
                pg8::gemm_phase<pg8::EpiScatter, pg8::MoeOrder, true, false, true, true>(ldsp + RING_OFF, g, S, E);
                __syncthreads();
            }
        }
        SEAM(pb + 8);
        if (IN(pb + 9)) {
            constexpr bool NEXT = (layer + 1 < NLAYER);
            const float* gam = in_ln2g + (size_t)layer * DM; const float* bet = in_ln2b + (size_t)layer * DM;
            f32x4 gq[4], bq[4], wq[8][4];
#pragma unroll
            for (int q = 0; q < 4; ++q) { gq[q] = *(const f32x4*)(gam + 16 * lane + 4 * q); bq[q] = *(const f32x4*)(bet + 16 * lane + 4 * q); }
            if (NEXT) {
#pragma unroll
                for (int jj = 0; jj < 8; ++jj)
#pragma unroll
                    for (int q = 0; q < 4; ++q) wq[jj][q] = *(const f32x4*)(WDT + (size_t)(layer + 1) * 8 * 1024 + jj * 1024 + 16 * lane + 4 * q); }
            v4u nx0, nx1, ny[4];
            constexpr bool PF = !NEXT;
            if (PF && gw < MROWS) { nx0 = *(const v4u*)(XB + (size_t)gw * DM + 16 * lane); nx1 = *(const v4u*)(XB + (size_t)gw * DM + 16 * lane + 8);
#pragma unroll
                for (int k = 0; k < 4; ++k) ny[k] = *(const v4u*)(YB8 + ((size_t)gw * 4 + k) * DM + 16 * lane); }
#pragma unroll 1
            for (int m = gw; m < MROWS; m += NGW) {
                if (!PF) { nx0 = *(const v4u*)(XB + (size_t)m * DM + 16 * lane); nx1 = *(const v4u*)(XB + (size_t)m * DM + 16 * lane + 8);
#pragma unroll
                    for (int k = 0; k < 4; ++k) ny[k] = *(const v4u*)(YB8 + ((size_t)m * 4 + k) * DM + 16 * lane); }
                const v4u x0 = nx0, x1 = nx1; v4u yk[4];
#pragma unroll
                for (int k = 0; k < 4; ++k) yk[k] = ny[k];
                if (PF && m + NGW < MROWS) { const int mn = m + NGW; nx0 = *(const v4u*)(XB + (size_t)mn * DM + 16 * lane); nx1 = *(const v4u*)(XB + (size_t)mn * DM + 16 * lane + 8);
#pragma unroll
                    for (int k = 0; k < 4; ++k) ny[k] = *(const v4u*)(YB8 + ((size_t)mn * 4 + k) * DM + 16 * lane); }
                f32x4 v[4];
                v[0] = (f32x4){bflo(x0.x), bfhi(x0.x), bflo(x0.y), bfhi(x0.y)} * ALPHA; v[1] = (f32x4){bflo(x0.z), bfhi(x0.z), bflo(x0.w), bfhi(x0.w)} * ALPHA;
                v[2] = (f32x4){bflo(x1.x), bfhi(x1.x), bflo(x1.y), bfhi(x1.y)} * ALPHA; v[3] = (f32x4){bflo(x1.z), bfhi(x1.z), bflo(x1.w), bfhi(x1.w)} * ALPHA;
#pragma unroll
                for (int k = 0; k < 4; ++k)
#pragma unroll
                    for (int q = 0; q < 4; ++q) { typedef float f32x2_ __attribute__((ext_vector_type(2)));
                        const f32x2_ lo = __builtin_amdgcn_cvt_pk_f32_fp8(yk[k][q], false), hi = __builtin_amdgcn_cvt_pk_f32_fp8(yk[k][q], true);
                        v[q][0] += lo[0] * (1.0f / SC_Y); v[q][1] += lo[1] * (1.0f / SC_Y); v[q][2] += hi[0] * (1.0f / SC_Y); v[q][3] += hi[1] * (1.0f / SC_Y); }
                float s = 0.f;
#pragma unroll
                for (int q = 0; q < 4; ++q) s += (v[q][0] + v[q][1]) + (v[q][2] + v[q][3]);
                const float mean = wave_sum(s) * (1.f / DM); float s2 = 0.f;
#pragma unroll
                for (int q = 0; q < 4; ++q) { v[q] = v[q] - mean; s2 += (v[q][0] * v[q][0] + v[q][1] * v[q][1]) + (v[q][2] * v[q][2] + v[q][3] * v[q][3]); }
                const float rstd = 1.f / sqrtf(wave_sum(s2) * (1.f / DM) + LN_EPS);
#pragma unroll
                for (int q = 0; q < 4; ++q) { v[q] = v[q] * rstd * gq[q] + bq[q];
                    if (!NEXT) *(f32x4*)(args.out + (size_t)m * DM + 16 * lane + 4 * q) = v[q]; }
                if (NEXT) {
                    v4u w0, w1; w0.x = pk2(v[0][0], v[0][1]); w0.y = pk2(v[0][2], v[0][3]); w0.z = pk2(v[1][0], v[1][1]); w0.w = pk2(v[1][2], v[1][3]);
                    w1.x = pk2(v[2][0], v[2][1]); w1.y = pk2(v[2][2], v[2][3]); w1.z = pk2(v[3][0], v[3][1]); w1.w = pk2(v[3][2], v[3][3]);
                    *(v4u*)(XB + (size_t)m * DM + 16 * lane) = w0; *(v4u*)(XB + (size_t)m * DM + 16 * lane + 8) = w1;
                    v4u w; w.x = pg8::pk4_fp8(v[0][0] * SC_X, v[0][1] * SC_X, v[0][2] * SC_X, v[0][3] * SC_X); w.y = pg8::pk4_fp8(v[1][0] * SC_X, v[1][1] * SC_X, v[1][2] * SC_X, v[1][3] * SC_X);
                    w.z = pg8::pk4_fp8(v[2][0] * SC_X, v[2][1] * SC_X, v[2][2] * SC_X, v[2][3] * SC_X); w.w = pg8::pk4_fp8(v[3][0] * SC_X, v[3][1] * SC_X, v[3][2] * SC_X, v[3][3] * SC_X);
                    *(v4u*)(XP8 + (size_t)m * DM + 16 * lane) = w;
                    float r[8];
#pragma unroll
                    for (int jj = 0; jj < 8; ++jj) { float sd = 0.f;
#pragma unroll
                        for (int q = 0; q < 4; ++q) sd += v[q][0] * wq[jj][q][0] + v[q][1] * wq[jj][q][1] + v[q][2] * wq[jj][q][2] + v[q][3] * wq[jj][q][3];
                        r[jj] = wave_sum(sd); }
                    if (lane == 0) { float* dst = DT + (size_t)m * 8; *(f32x4*)dst = (f32x4){r[0], r[1], r[2], r[3]}; *(f32x4*)(dst + 4) = (f32x4){r[4], r[5], r[6], r[7]}; } }
            }
        }
        SEAM(pb + 9);
    #undef IN
#undef SEAM
}

__global__ void __launch_bounds__(NWAVES * 64, 2) mk_fwd(Args args) {
    extern __shared__ __attribute__((aligned(16))) unsigned char lds[];
    LAS unsigned char* ldsp = (LAS unsigned char*)lds;
    const int tid = threadIdx.x, lane = tid & 63, wave = __builtin_amdgcn_readfirstlane(tid >> 6);
    const int G = gridDim.x, bid = blockIdx.x;
    const int gw = bid * NWAVES + wave, NGW = G * NWAVES;
    gu32* ctl = (gu32*)(args.ws + WS_CTL);

    for (int u = tid; u < (LDS_BYTES - LDSCTL_OFF) / 4; u += NWAVES * 64) ((LAS unsigned*)(ldsp + LDSCTL_OFF))[u] = 0u;
    __syncthreads();
    XcdBarrier bar = xcd_barrier_post((unsigned*)(ctl + CW_BAR), (volatile LAS unsigned*)(ldsp + L_MISC) + 8);

    const int lo = args.ph_lo, hi = args.ph_hi;
#define IN(k) (lo <= (k) && (k) < hi)
#define SEAM(k) do { if (IN(k) && IN((k) + 1)) xcd_barrier(bar); } while (0)

    if (IN(0)) {
        LAS float* scr = (LAS float*)(ldsp + RING_OFF + wave * 16384);
        constexpr int I_IN = 16 * 73, I_OUT = 24 * 16, I_R = 16;
        constexpr int NIT = NLAYER * (I_IN + I_OUT + I_R);
        for (int it = gw; it < NIT; it += NGW) {
            int r = it;
            if (r < NLAYER * I_IN) { const int l = r / I_IN; r %= I_IN; p0_transpose_item64<1>(in_win + (size_t)l * DM * INW, DM, INW, WIN + (size_t)l * NPROJ * DM, WDT + (size_t)l * 8 * 1024, scr, r / 73, r % 73, lane); continue; } r -= NLAYER * I_IN;
            if (r < NLAYER * I_OUT) { const int l = r / I_OUT; r %= I_OUT; p0_transpose_item64<0>(in_wout + (size_t)l * MIXW * DM, MIXW, DM, WOUT + (size_t)l * DM * MIXW, nullptr, scr, r / 16, r % 16, lane); continue; } r -= NLAYER * I_OUT;
            { const int l = r / I_R; r %= I_R; p0_transpose_item<0>(in_rw + (size_t)l * DM * NEXP, DM, NEXP, ROUT + (size_t)l * NEXP * DM, nullptr, scr, r, 0, lane); }
        }
        { constexpr int NIT8 = 64 * 256 + 64 * 128 + NLAYER * 192;
          const int nmine = (gw < NIT8) ? (NIT8 - gw + NGW - 1) / NGW : 0; const int J = 2 * nmine;
          f32x4 lda[16], ldb[16];
          if (J > 0) { const SubT t = fp8_subtile(gw, 0, in_wgu, in_wdn, in_win, WGU8, WDN8, WIN8, lane); fp8_sub_load(t, lda); }
#pragma unroll 1
          for (int j = 0; j < J; j += 2) {
              const int item = gw + (j >> 1) * NGW;
              const SubT t0 = fp8_subtile(item, 0, in_wgu, in_wdn, in_win, WGU8, WDN8, WIN8, lane), t1 = fp8_subtile(item, 1, in_wgu, in_wdn, in_win, WGU8, WDN8, WIN8, lane);
              fp8_sub_load(t1, ldb);
              fp8_sub_process(t0, lda, scr, lane);
              if (j + 2 < J) { const SubT t2 = fp8_subtile(item + NGW, 0, in_wgu, in_wdn, in_win, WGU8, WDN8, WIN8, lane); fp8_sub_load(t2, lda); }
              fp8_sub_process(t1, ldb, scr, lane);
          } }
        __syncthreads();
    }
    if (IN(0)) {
        f32x4 wq[8][4];
#pragma unroll
        for (int j = 0; j < 4; ++j)
#pragma unroll
            for (int e = 0; e < 4; ++e) { const float* wp = in_win + (size_t)(4 * lane + 256 * j + e) * INW + 3072; const f32x4 w0 = *(const f32x4*)wp, w1 = *(const f32x4*)(wp + 4);
                wq[0][j][e] = w0[0]; wq[1][j][e] = w0[1]; wq[2][j][e] = w0[2]; wq[3][j][e] = w0[3]; wq[4][j][e] = w1[0]; wq[5][j][e] = w1[1]; wq[6][j][e] = w1[2]; wq[7][j][e] = w1[3]; }
        f32x4 nv[4];
        if (gw < MROWS) {
#pragma unroll
            for (int j = 0; j < 4; ++j) nv[j] = *(const f32x4*)(in_x + (size_t)gw * DM + 4 * lane + 256 * j); }
#pragma unroll 1
        for (int m = gw; m < MROWS; m += NGW) { bf16* ob = XB + (size_t)m * DM; f32x4 v[4];
#pragma unroll
            for (int j = 0; j < 4; ++j) v[j] = nv[j];
            if (m + NGW < MROWS) {
#pragma unroll
                for (int j = 0; j < 4; ++j) nv[j] = *(const f32x4*)(in_x + (size_t)(m + NGW) * DM + 4 * lane + 256 * j); }
#pragma unroll
            for (int j = 0; j < 4; ++j) { v2u w; w.x = pk2(v[j][0], v[j][1]); w.y = pk2(v[j][2], v[j][3]); *(v2u*)(ob + 4 * lane + 256 * j) = w;
                *(unsigned*)(XP8 + (size_t)m * DM + 4 * lane + 256 * j) = pg8::pk4_fp8(v[j][0] * SC_X, v[j][1] * SC_X, v[j][2] * SC_X, v[j][3] * SC_X); }
            row_dt_w(v, wq, DT + (size_t)m * 8, lane); }
    }

    SEAM(0);
    run_layer<0>(args, lo, hi, bar);
    run_layer<1>(args, lo, hi, bar);
#undef IN
#undef SEAM
}

extern "C" void kernel_launch(void* const* d_in, const int* in_sizes, int n_in, void* d_out, int out_size, void* d_ws, size_t ws_size, hipStream_t stream) {
    static int grid = 0;
    if (grid == 0) {
        if (n_in != 20 || out_size != MROWS * DM || ws_size < WS_END) { fprintf(stderr, "kernel_launch: unexpected problem (n_in %d, out %d, ws %zu)\n", n_in, out_size, ws_size); grid = -1; return; }
        if (hipFuncSetAttribute((const void*)mk_fwd, hipFuncAttributeMaxDynamicSharedMemorySize, LDS_BYTES) != hipSuccess) { fprintf(stderr, "kernel_launch: hipFuncSetAttribute failed\n"); grid = -1; return; }
        int dev = 0, cus = 0, per_cu = 0;
        (void)hipGetDevice(&dev); (void)hipDeviceGetAttribute(&cus, hipDeviceAttributeMultiprocessorCount, dev);
        if (hipOccupancyMaxActiveBlocksPerMultiprocessor(&per_cu, (const void*)mk_fwd, NWAVES * 64, LDS_BYTES) != hipSuccess || per_cu < 1) fprintf(stderr, "kernel_launch: occupancy query says %d\n", per_cu);
        (void)hipGetLastError();
        grid = cus > 0 ? cus : 256;
    }
    if (grid < 0) return;
    (void)hipMemsetAsync((char*)d_ws + WS_CTL, 0, CTL_ZERO_BYTES, stream);
    Args a{};
    for (int i = 0; i < 20; ++i) a.in[i] = (const float*)d_in[i];
    a.out = (float*)d_out; a.ws = (unsigned char*)d_ws;
    a.ph_lo = 0; a.ph_hi = N_PHASES; a.sub = 7; a.pad = 0;
    hipLaunchKernelGGL(mk_fwd, dim3(grid), dim3(NWAVES * 64), LDS_BYTES, stream, a);
#ifdef PROBE_PH
#ifndef PROBE_SUB
#define PROBE_SUB 7
#endif
    for (int i = 0; i < PROBE_N; ++i) { a.ph_lo = PROBE_PH; a.ph_hi = PROBE_PH + 1; a.sub = PROBE_SUB; hipLaunchKernelGGL(mk_fwd, dim3(grid), dim3(NWAVES * 64), LDS_BYTES, stream, a); }
#endif
}
```

```cpp
#include <hip/hip_runtime.h>
#include <cstdio>
#include <cstdint>
#include <cmath>

namespace pg8 {
#define PG8_LAS __attribute__((address_space(3)))
typedef unsigned short bf16_t;
typedef short bf16x8 __attribute__((ext_vector_type(8)));
typedef float f32x4 __attribute__((ext_vector_type(4)));
typedef float f32x2 __attribute__((ext_vector_type(2)));
typedef unsigned u32x4 __attribute__((ext_vector_type(4)));
constexpr int BM = 256, BK = 64, HALF = 128, HTB = HALF * BK * 2  , STAGE_BYTES = 8 * HTB, NXCD = 8, WGM = 8;

__host__ __device__ __forceinline__ int lds_byte(int r, int c) { const int st = (r >> 4) * 2 + (c >> 5), rr = r & 15, cc = c & 31, ob = rr * 64 + cc * 2; return st * 1024 + (ob ^ (((ob >> 9) & 1) << 5)); }
__host__ __device__ __forceinline__ void stage_rc(int b, int& R, int& C) { const int st = b / 1024, sb = b % 1024, swz = sb ^ (((sb >> 9) & 1) << 5); R = (st >> 1) * 16 + swz / 64; C = (st & 1) * 32 + (swz % 64) / 2; }
__host__ __device__ __forceinline__ int perm32(int rho) { const int n = rho >> 4, i = rho & 15; return 8 * (i >> 2) + 4 * n + (i & 3); }

struct Unit { int pm, pn, e, r0; };
struct Gemm { const bf16_t* A; const bf16_t* Bt; int M, N, K; };

struct StaticOrder {
    int nM, nN, nwg, G, c, base, lim;
    __device__ void init(int M, int N, int G_, int c_) { nM = M / BM; nN = N / BM; nwg = nM * nN; G = G_; c = c_; base = 0; lim = nwg; }
    __device__ __forceinline__ bool next(int i, Unit& u) const {
        const long L = (long)i * G + c + base; if (L >= lim) return false;
        int wgid = (int)L; { const int q = nwg / NXCD, r = nwg % NXCD, xcd = wgid % NXCD, off = wgid / NXCD; wgid = (xcd < r ? xcd * (q + 1) : r * (q + 1) + (xcd - r) * q) + off; }
        const int nig = WGM * nN, gid = wgid / nig, fm = gid * WGM, gsz = (nM - fm) < WGM ? (nM - fm) : WGM;
        u.pm = fm + ((wgid % nig) % gsz); u.pn = (wgid % nig) / gsz; u.e = 0; u.r0 = 0; return true;
    }
    __device__ __forceinline__ const char* abase(const Unit& u, const Gemm& g, size_t tstep) const { return (const char*)g.A + (size_t)u.pm * tstep; }
    __device__ __forceinline__ const char* bbase(const Unit& u, const Gemm& g, size_t tstep) const { return (const char*)g.Bt + (size_t)u.pn * tstep; }
    static constexpr bool SIDE = false;
    __device__ __forceinline__ unsigned arow(const Unit&, int) const { return 0u; }
    __device__ __forceinline__ unsigned arow_side(const Unit&, int, const PG8_LAS unsigned char*) const { return 0u; }
    __device__ __forceinline__ const void* side_src(const Unit&, const Unit&, int, int) const { return nullptr; }
    __device__ __forceinline__ void a_ready(const Unit&) const {}
    __device__ __forceinline__ void done(const Unit&) const {}
};

struct MoeOrder {
    const PG8_LAS int* units;
    int nunits;
    const PG8_LAS int* cnt;
    const int* rowtok;
    int gather;
    unsigned rowbytes;
    size_t bstride;
    __device__ __forceinline__ bool next(int i, Unit& u) const {
        if (i >= nunits) return false;
        u.pm = __builtin_amdgcn_readfirstlane(units[4 * i + 0]); u.pn = __builtin_amdgcn_readfirstlane(units[4 * i + 1]);
        u.e = __builtin_amdgcn_readfirstlane(units[4 * i + 2]); u.r0 = __builtin_amdgcn_readfirstlane(units[4 * i + 3]); return true;
    }
    __device__ __forceinline__ const char* abase(const Unit& u, const Gemm& g, size_t tstep) const { return gather ? (const char*)g.A : (const char*)g.A + (size_t)u.pm * tstep; }
    __device__ __forceinline__ const char* bbase(const Unit& u, const Gemm& g, size_t tstep) const { return (const char*)g.Bt + (size_t)u.e * bstride + (size_t)u.pn * tstep; }
    static constexpr bool SIDE = true;
    const float* rowgate; const float* bgu;
    __device__ __forceinline__ unsigned arow(const Unit& u, int R) const {
        const int r = u.r0 + R; const int idx = (r < cnt[u.e]) ? rowtok[(size_t)u.e * 32768 + r] : 0; return (unsigned)(idx >> 2) * rowbytes; }
    __device__ __forceinline__ unsigned arow_side(const Unit& u, int R, const PG8_LAS unsigned char* sd) const {
        const int r = u.r0 + R; const int v = ((const PG8_LAS int*)sd)[R]; const int idx = (r < cnt[u.e]) ? v : 0; return (unsigned)(idx >> 2) * rowbytes; }
    __device__ __forceinline__ const void* side_src(const Unit& cur, const Unit& rt, int wid, int lane) const {
        if (rowgate != nullptr && wid == 1) return rowgate + (size_t)cur.e * 32768 + cur.r0 + 4 * lane;
        if (bgu != nullptr && wid == 2) return gather ? (bgu + (size_t)cur.e * 2048 + (lane < 32 ? 0 : 1024 - 128) + cur.pn * 128 + 4 * lane)
                                                      : (bgu + (size_t)cur.e * 1024 + cur.pn * 256 + 4 * lane);
        return rowtok + (size_t)rt.e * 32768 + rt.r0 + 4 * lane; }
    __device__ __forceinline__ void a_ready(const Unit&) const {}
    __device__ __forceinline__ void done(const Unit&) const {}
};
__device__ __forceinline__ void moe_build_units(PG8_LAS int* units, PG8_LAS int* units_n, const PG8_LAS int* tstart, int nN, int G, int c, int tid) {
    if (tid < 64) {
        const int nT = tstart[32], nwg = nT * nN; const long L = (long)tid * G + c;
        int pm = 0, pn = 0, e = 0, r0 = 0;
        if (L < nwg) {
            int wgid = (int)L; { const int q = nwg / NXCD, r = nwg % NXCD, xcd = wgid % NXCD, off = wgid / NXCD; wgid = (xcd < r ? xcd * (q + 1) : r * (q + 1) + (xcd - r) * q) + off; }
            const int nig = WGM * nN, gid = wgid / nig, fm = gid * WGM, gsz = (nT - fm) < WGM ? (nT - fm) : WGM;
            pm = fm + ((wgid % nig) % gsz); pn = (wgid % nig) / gsz;
            for (int j = 1; j < 32; ++j) e += (tstart[j] <= pm) ? 1 : 0;
            r0 = (pm - tstart[e]) * 256;
        }
        units[4 * tid + 0] = pm; units[4 * tid + 1] = pn; units[4 * tid + 2] = e; units[4 * tid + 3] = r0;
        if (tid == 0) { int n = 0; if (c < nwg) n = (nwg - c + G - 1) / G; units_n[0] = n < 64 ? n : 64; }
    }
}

__host__ __device__ __forceinline__ unsigned hblk_off(int R, int p7) { const int ai = R >> 7, wr = (R >> 6) & 1, m = (R >> 4) & 3, fr = R & 15, wc = p7 >> 1, fq = ((p7 & 1) << 1) | (m & 1), mp = m >> 1;
    return (unsigned)(((((ai * 2 + wr) * 4 + wc) * 2 + mp) * 64 + fr + 16 * fq) * 16); }
typedef int v8i_t __attribute__((ext_vector_type(8)));
typedef int v4i_t __attribute__((ext_vector_type(4)));
__device__ __forceinline__ v8i_t cat8(bf16x8 lo, bf16x8 hi) { const v4i_t a = __builtin_bit_cast(v4i_t, lo), b = __builtin_bit_cast(v4i_t, hi); return __builtin_shufflevector(a, b, 0, 1, 2, 3, 4, 5, 6, 7); }
__device__ __forceinline__ void mfma8(f32x4& acc, v8i_t a, v8i_t b, int scl) { asm volatile("v_mfma_scale_f32_16x16x128_f8f6f4 %0, %1, %2, %0, %3, %3 op_sel_hi:[0,0,0]" : "+v"(acc) : "v"(a), "v"(b), "v"(scl)); }
__device__ __forceinline__ unsigned pk4_fp8(float a, float b, float c, float d) { unsigned w = 0u; w = __builtin_amdgcn_cvt_pk_fp8_f32(a, b, w, false); w = __builtin_amdgcn_cvt_pk_fp8_f32(c, d, w, true); return w; }
__device__ __forceinline__ unsigned cvt_pk_bf16(float lo, float hi) { unsigned r; asm volatile("v_cvt_pk_bf16_f32 %0, %1, %2" : "=v"(r) : "v"(lo), "v"(hi)); return r; }

struct EpiProj {
    static constexpr bool PERM = true, AFTER_DRAIN = false;
    bf16_t* O; int ldc; const float* rope; float qscale; float dqv; int pn_off;
    __device__ __forceinline__ void operator()(const f32x4 (&acc)[2][2][4][2], const Unit& u, int wr, int wc, int fr, int fq, const PG8_LAS unsigned char* sd) const {
        const int pnn = u.pn + pn_off; const int row0 = u.pm * BM + wr * 64 + fr; const int col0 = pnn * BM + wc * 32 + 8 * fq;
        const bool rot = pnn < 4; const float sc = (pnn < 2 ? qscale : 1.f) * dqv; const int gq = 4 * (wc & 1) + fq;
        float invr[4];
#pragma unroll
        for (int e = 0; e < 4; ++e) invr[e] = __builtin_amdgcn_exp2f(-(float)(4 * gq + e) * 0.41524101186092029f) * 0.15915494309189535f;
#pragma unroll
        for (int ai = 0; ai < 2; ++ai)
#pragma unroll
            for (int m = 0; m < 4; ++m) { const int row = row0 + ai * HALF + m * 16; bf16_t* rowp = O + (size_t)row * ldc + col0;
                f32x4 cs0 = (f32x4){1.f, 0.f, 1.f, 0.f}, cs1 = cs0;
                if (rot) { const float tp = (float)(row & 4095);
                    const float a0 = __builtin_amdgcn_fractf(tp * invr[0]), a1 = __builtin_amdgcn_fractf(tp * invr[1]), a2 = __builtin_amdgcn_fractf(tp * invr[2]), a3 = __builtin_amdgcn_fractf(tp * invr[3]);
                    cs0 = (f32x4){__builtin_amdgcn_cosf(a0), __builtin_amdgcn_sinf(a0), __builtin_amdgcn_cosf(a1), __builtin_amdgcn_sinf(a1)};
                    cs1 = (f32x4){__builtin_amdgcn_cosf(a2), __builtin_amdgcn_sinf(a2), __builtin_amdgcn_cosf(a3), __builtin_amdgcn_sinf(a3)}; }
#pragma unroll
                for (int bj = 0; bj < 2; ++bj) { f32x4 v0 = acc[ai][bj][m][0], v1 = acc[ai][bj][m][1];
                    if (rot) { f32x4 lo, hi;
                        lo[0] = v0[0] * cs0[0] - v1[0] * cs0[1]; hi[0] = v1[0] * cs0[0] + v0[0] * cs0[1];
                        lo[1] = v0[1] * cs0[2] - v1[1] * cs0[3]; hi[1] = v1[1] * cs0[2] + v0[1] * cs0[3];
                        lo[2] = v0[2] * cs1[0] - v1[2] * cs1[1]; hi[2] = v1[2] * cs1[0] + v0[2] * cs1[1];
                        lo[3] = v0[3] * cs1[2] - v1[3] * cs1[3]; hi[3] = v1[3] * cs1[2] + v0[3] * cs1[3];
                        v0 = lo * sc; v1 = hi * sc; }
                    else { v0 = v0 * dqv; v1 = v1 * dqv; }
                    u32x4 w; w.x = cvt_pk_bf16(v0[0], v0[1]); w.y = cvt_pk_bf16(v0[2], v0[3]); w.z = cvt_pk_bf16(v1[0], v1[1]); w.w = cvt_pk_bf16(v1[2], v1[3]);
                    *(u32x4*)(rowp + bj * HALF) = w; } }
    }
};
struct EpiF32 {
    static constexpr bool PERM = false, AFTER_DRAIN = false;
    float* O; int ldc;
    __device__ __forceinline__ void operator()(const f32x4 (&acc)[2][2][4][2], const Unit& u, int wr, int wc, int fr, int fq, const PG8_LAS unsigned char* sd) const {
        const int row0 = u.pm * BM + wr * 64 + fr; const int col0 = u.pn * BM + wc * 32 + 4 * fq;
#pragma unroll
        for (int ai = 0; ai < 2; ++ai)
#pragma unroll
            for (int m = 0; m < 4; ++m) { float* rowp = O + (size_t)(row0 + ai * HALF + m * 16) * ldc + col0;
#pragma unroll
                for (int bj = 0; bj < 2; ++bj)
#pragma unroll
                    for (int n = 0; n < 2; ++n) *(f32x4*)(rowp + bj * HALF + n * 16) = acc[ai][bj][m][n]; }
    }
};
struct EpiBf16Plain {
    static constexpr bool PERM = true, AFTER_DRAIN = false;
    bf16_t* O; int ldc;
    __device__ __forceinline__ void operator()(const f32x4 (&acc)[2][2][4][2], const Unit& u, int wr, int wc, int fr, int fq, const PG8_LAS unsigned char* sd) const {
        const int row0 = u.pm * BM + wr * 64 + fr; const int col0 = u.pn * BM + wc * 32 + 8 * fq;
#pragma unroll
        for (int ai = 0; ai < 2; ++ai)
#pragma unroll
            for (int m = 0; m < 4; ++m) { bf16_t* rowp = O + (size_t)(row0 + ai * HALF + m * 16) * ldc + col0;
#pragma unroll
                for (int bj = 0; bj < 2; ++bj) { const f32x4 v0 = acc[ai][bj][m][0], v1 = acc[ai][bj][m][1];
                    u32x4 w; w.x = cvt_pk_bf16(v0[0], v0[1]); w.y = cvt_pk_bf16(v0[2], v0[3]); w.z = cvt_pk_bf16(v1[0], v1[1]); w.w = cvt_pk_bf16(v1[2], v1[3]);
                    *(u32x4*)(rowp + bj * HALF) = w; } }
    }
};
struct EpiSwiglu {
    static constexpr bool PERM = true, AFTER_DRAIN = false;
    unsigned char* H; const float* bgu; const float* rowgate; const PG8_LAS int* cnt; float dq, hscale;
    __device__ __forceinline__ void operator()(const f32x4 (&acc)[2][2][4][2], const Unit& u, int wr, int wc, int fr, int fq, const PG8_LAS unsigned char* sd) const {
        const int n_e = cnt[u.e];
        constexpr float CS = -1.702f * 1.4426950408889634f;
        const float kk = hscale / CS, dqc = dq * CS, dqk = dq * kk, glo = 7.0f * CS, ub0 = -6.0f * kk, ub1 = 8.0f * kk;
        f32x4 bg[2], bu[2];
#pragma unroll
        for (int n = 0; n < 2; ++n) { bg[n] = *(const PG8_LAS f32x4*)(sd + 2048 + (wc * 32 + 8 * fq + 4 * n) * 4) * CS; bu[n] = (*(const PG8_LAS f32x4*)(sd + 2048 + 512 + (wc * 32 + 8 * fq + 4 * n) * 4) + 1.0f) * kk; }
        const int lane = fr + 16 * fq;
        float rgls[2][4];
#pragma unroll
        for (int ai = 0; ai < 2; ++ai)
#pragma unroll
            for (int m = 0; m < 4; ++m) rgls[ai][m] = ((const PG8_LAS float*)(sd + 1024))[ai * HALF + wr * 64 + m * 16 + fr];
#pragma unroll
        for (int ai = 0; ai < 2; ++ai)
#pragma unroll
            for (int mp = 0; mp < 2; ++mp) {
                unsigned pw[2][2];
#pragma unroll
                for (int mm = 0; mm < 2; ++mm) { const int m = 2 * mp + mm; const int r = ai * HALF + wr * 64 + m * 16 + fr; const int er = u.r0 + r;
                    const float rgl = rgls[ai][m]; const float irg = (er < n_e) ? __builtin_amdgcn_rcpf(rgl) : 1e30f;
                    float hv[8];
#pragma unroll
                    for (int n = 0; n < 2; ++n)
#pragma unroll
                        for (int q = 0; q < 4; q += 2) {
                            f32x2 g = (f32x2){acc[ai][0][m][n][q], acc[ai][0][m][n][q + 1]} * dqc + (f32x2){bg[n][q], bg[n][q + 1]};
                            f32x2 up = (f32x2){acc[ai][1][m][n][q], acc[ai][1][m][n][q + 1]} * dqk + (f32x2){bu[n][q], bu[n][q + 1]};
                            g.x = fmaxf(g.x, glo); g.y = fmaxf(g.y, glo); up.x = __builtin_amdgcn_fmed3f(up.x, ub0, ub1); up.y = __builtin_amdgcn_fmed3f(up.y, ub0, ub1);
                            f32x2 den; den.x = __builtin_amdgcn_exp2f(g.x); den.y = __builtin_amdgcn_exp2f(g.y); den = den * irg + irg;
                            f32x2 sg; sg.x = __builtin_amdgcn_rcpf(den.x); sg.y = __builtin_amdgcn_rcpf(den.y);
                            const f32x2 h2 = (up * g) * sg;
                            hv[n * 4 + q] = h2.x; hv[n * 4 + q + 1] = h2.y; }
                    pw[mm][0] = pk4_fp8(hv[0], hv[1], hv[2], hv[3]); pw[mm][1] = pk4_fp8(hv[4], hv[5], hv[6], hv[7]); }
                const auto s0 = __builtin_amdgcn_permlane16_swap(pw[0][0], pw[1][0], false, false); const auto s1 = __builtin_amdgcn_permlane16_swap(pw[0][1], pw[1][1], false, false);
                *(u32x4*)(H + ((size_t)u.pm * 8 + u.pn) * 32768 + ((((ai * 2 + wr) * 4 + wc) * 2 + mp) * 64 + lane) * 16) = (u32x4){s0[0], s1[0], s0[1], s1[1]};
                asm volatile("" ::: "memory"); }
    }
};
struct EpiScatter {
    static constexpr bool PERM = true, AFTER_DRAIN = false;
    unsigned char* Y; const int* rowtok; const PG8_LAS int* cnt; float dq, ysc;
    __device__ __forceinline__ void operator()(const f32x4 (&acc)[2][2][4][2], const Unit& u, int wr, int wc, int fr, int fq, const PG8_LAS unsigned char* sd) const {
        const int col0 = u.pn * BM + wc * 32 + 8 * fq; const int n_e = cnt[u.e];
        f32x4 bd[2][2];
#pragma unroll
        for (int bj = 0; bj < 2; ++bj)
#pragma unroll
            for (int n = 0; n < 2; ++n) bd[bj][n] = *(const PG8_LAS f32x4*)(sd + 2048 + (bj * HALF + wc * 32 + 8 * fq + 4 * n) * 4);
        int idxs[2][4]; float rgs[2][4];
#pragma unroll
        for (int ai = 0; ai < 2; ++ai)
#pragma unroll
            for (int m = 0; m < 4; ++m) { idxs[ai][m] = ((const PG8_LAS int*)sd)[ai * HALF + wr * 64 + m * 16 + fr]; rgs[ai][m] = ((const PG8_LAS float*)(sd + 1024))[ai * HALF + wr * 64 + m * 16 + fr]; }
#pragma unroll
        for (int ai = 0; ai < 2; ++ai)
#pragma unroll
            for (int m = 0; m < 4; ++m) { const int er = u.r0 + ai * HALF + wr * 64 + m * 16 + fr;
                const int idx = idxs[ai][m];
                if (er < n_e) { unsigned char* rowp = Y + (size_t)idx * 1024 + col0;
                    typedef unsigned u32x2 __attribute__((ext_vector_type(2)));
                    const float rg = rgs[ai][m] * ysc;
#pragma unroll
                    for (int bj = 0; bj < 2; ++bj) { const f32x4 v0 = acc[ai][bj][m][0] * dq + bd[bj][0] * rg, v1 = acc[ai][bj][m][1] * dq + bd[bj][1] * rg;
                        *(u32x2*)(rowp + bj * HALF) = (u32x2){pk4_fp8(v0[0], v0[1], v0[2], v0[3]), pk4_fp8(v1[0], v1[1], v1[2], v1[3])}; } } }
    }
};

struct PanelStats {
    unsigned* xbuf;
    unsigned* cnt;
    unsigned* tmo;
    int ntn; float eps;
    unsigned code;
    __device__ __forceinline__ bool run(const f32x4 (&v)[2][2][4][2], const Unit& u, int wr, int wc, int fr, int fq, PG8_LAS unsigned char* lds, int wid, int lane) const {
        typedef float f32x2v __attribute__((ext_vector_type(2)));
        PG8_LAS f32x2v* P = (PG8_LAS f32x2v*)lds;
        PG8_LAS f32x2v* S = (PG8_LAS f32x2v*)(lds + 8192);
        PG8_LAS unsigned* flag = (PG8_LAS unsigned*)(lds + 8192 + 2048);
#pragma unroll
        for (int ai = 0; ai < 2; ++ai)
#pragma unroll
            for (int m = 0; m < 4; ++m) {
                float s = 0.f;
#pragma unroll
                for (int bj = 0; bj < 2; ++bj)
#pragma unroll
                    for (int n = 0; n < 2; ++n) { const f32x4 x = v[ai][bj][m][n]; s += (x[0] + x[1]) + (x[2] + x[3]); }
                s += __shfl_xor(s, 16); s += __shfl_xor(s, 32);
                const float mw = s * (1.0f / 64.0f); float q = 0.f;
#pragma unroll
                for (int bj = 0; bj < 2; ++bj)
#pragma unroll
                    for (int n = 0; n < 2; ++n) { const f32x4 d = v[ai][bj][m][n] - mw; q += (d[0] * d[0] + d[1] * d[1]) + (d[2] * d[2] + d[3] * d[3]); }
                q += __shfl_xor(q, 16); q += __shfl_xor(q, 32);
                if (fq == 0) P[(ai * HALF + wr * 64 + m * 16 + fr) * 4 + wc] = (f32x2v){mw, q};
            }
        asm volatile("s_waitcnt lgkmcnt(0)" ::: "memory"); __builtin_amdgcn_s_barrier(); asm volatile("" ::: "memory");
#if defined(BROKEN_EXCHANGE_NO_WAIT)
#warning BROKEN CONTROL BUILD: the row-statistics exchange does not wait; results are wrong by design
        if (blockIdx.x >= 64) { const long long t0_ = clock64(); while (clock64() - t0_ < 60000) __builtin_amdgcn_s_sleep(8); }
#endif
        const int row = wid * 32 + (lane & 31);
        if (lane < 32) {
            const f32x2v a = P[row * 4 + 0], b = P[row * 4 + 1], c = P[row * 4 + 2], d = P[row * 4 + 3];
            const float mt = (a.x + b.x + c.x + d.x) * 0.25f;
            const float da = a.x - mt, db = b.x - mt, dc = c.x - mt, dd = d.x - mt;
            const float m2 = (a.y + b.y) + (c.y + d.y) + 64.0f * ((da * da + db * db) + (dc * dc + dd * dd));
            unsigned long long* slot = (unsigned long long*)xbuf + ((size_t)(u.pm * BM + row) * 4 + u.pn);
            __hip_atomic_store(slot, ((unsigned long long)__float_as_uint(m2) << 32) | __float_as_uint(mt), __ATOMIC_RELAXED, __HIP_MEMORY_SCOPE_AGENT);
        }
        asm volatile("s_waitcnt vmcnt(0)" ::: "memory");
        if (lane == 0) __hip_atomic_fetch_add(cnt + 64 * u.pm, 1u, __ATOMIC_RELAXED, __HIP_MEMORY_SCOPE_AGENT);
        if (wid == 0) {
            const unsigned want = 8u * (unsigned)ntn; unsigned sp = 0u;
            while ((unsigned)__builtin_amdgcn_readfirstlane(__hip_atomic_load(cnt + 64 * u.pm, __ATOMIC_RELAXED, __HIP_MEMORY_SCOPE_AGENT)) < want) { __builtin_amdgcn_s_sleep(2); if (++sp > (1u << 20)) break; }
            __builtin_amdgcn_fence(__ATOMIC_ACQUIRE, "agent");
        }
        asm volatile("s_waitcnt vmcnt(0) lgkmcnt(0)" ::: "memory"); __builtin_amdgcn_s_barrier(); asm volatile("" ::: "memory");
        const bool bad = false;
        if (lane < 32) {
            const unsigned long long* slot = (const unsigned long long*)xbuf + (size_t)(u.pm * BM + row) * 4; float mt[4], m2[4]; float ms = 0.f;
#pragma unroll
            for (int t = 0; t < 4; ++t) { if (t < ntn) { const unsigned long long w = __hip_atomic_load(slot + t, __ATOMIC_RELAXED, __HIP_MEMORY_SCOPE_AGENT); mt[t] = __uint_as_float((unsigned)w); m2[t] = __uint_as_float((unsigned)(w >> 32)); } else { mt[t] = 0.f; m2[t] = 0.f; } ms += mt[t]; }
            const float mean = ms / (float)ntn; float q = 0.f;
#pragma unroll
            for (int t = 0; t < 4; ++t) if (t < ntn) { const float dm = mt[t] - mean; q += m2[t] + 256.0f * dm * dm; }
            S[row] = (f32x2v){mean, 1.0f / sqrtf(q / (256.0f * (float)ntn) + eps)};
        }
        asm volatile("s_waitcnt lgkmcnt(0)" ::: "memory"); __builtin_amdgcn_s_barrier(); asm volatile("" ::: "memory");
        return bad;
    }
};

struct EpiLn1 {
    static constexpr bool PERM = true, AFTER_DRAIN = true;
    unsigned char* ws; const float* gam; const float* bet; size_t o_xb, o_x8, o_xbuf, o_cnt, o_tmo; float alpha, s8, eps; unsigned code;
    __device__ __forceinline__ void operator()(const f32x4 (&)[2][2][4][2], const Unit&, int, int, int, int, const PG8_LAS unsigned char*) const {}
    __device__ __forceinline__ void fused(f32x4 (&acc)[2][2][4][2], const Unit& u, int wr, int wc, int fr, int fq, PG8_LAS unsigned char* lds, int wid, int lane) const {
        typedef float f32x2v __attribute__((ext_vector_type(2))); typedef unsigned u32x2 __attribute__((ext_vector_type(2)));
        bf16_t* const XBp = (bf16_t*)(ws + o_xb); unsigned char* const X8 = ws + o_x8;
        const PanelStats st{(unsigned*)(ws + o_xbuf), (unsigned*)(ws + o_cnt), (unsigned*)(ws + o_tmo), 4, eps, code};
        const int col0 = u.pn * BM + wc * 32 + 8 * fq;
#pragma unroll
        for (int ai = 0; ai < 2; ++ai)
#pragma unroll
            for (int m = 0; m < 4; ++m) { const bf16_t* xr = XBp + (size_t)(u.pm * BM + ai * HALF + wr * 64 + m * 16 + fr) * 1024 + col0;
#pragma unroll
                for (int bj = 0; bj < 2; ++bj) { const u32x4 x = *(const u32x4*)(xr + bj * HALF);
                    acc[ai][bj][m][0] += (f32x4){__builtin_bit_cast(float, x.x << 16), __builtin_bit_cast(float, x.x & 0xffff0000u), __builtin_bit_cast(float, x.y << 16), __builtin_bit_cast(float, x.y & 0xffff0000u)} * alpha;
                    acc[ai][bj][m][1] += (f32x4){__builtin_bit_cast(float, x.z << 16), __builtin_bit_cast(float, x.z & 0xffff0000u), __builtin_bit_cast(float, x.w << 16), __builtin_bit_cast(float, x.w & 0xffff0000u)} * alpha; }
                asm volatile("" ::: "memory"); }
        (void)st.run(acc, u, wr, wc, fr, fq, lds, wid, lane);
        const PG8_LAS f32x2v* S = (const PG8_LAS f32x2v*)(lds + 8192);
#pragma unroll
        for (int bj = 0; bj < 2; ++bj) {
            const f32x4 g0 = *(const f32x4*)(gam + col0 + bj * HALF), g1 = *(const f32x4*)(gam + col0 + bj * HALF + 4), b0 = *(const f32x4*)(bet + col0 + bj * HALF), b1 = *(const f32x4*)(bet + col0 + bj * HALF + 4);
#pragma unroll
            for (int ai = 0; ai < 2; ++ai)
#pragma unroll
                for (int m = 0; m < 4; ++m) { const int r = ai * HALF + wr * 64 + m * 16 + fr; const f32x2v sr = S[r]; const size_t off = (size_t)(u.pm * BM + r) * 1024 + col0 + bj * HALF;
                    const f32x4 o0 = (acc[ai][bj][m][0] - sr.x) * sr.y * g0 + b0, o1 = (acc[ai][bj][m][1] - sr.x) * sr.y * g1 + b1;
                    u32x4 w; w.x = cvt_pk_bf16(o0[0], o0[1]); w.y = cvt_pk_bf16(o0[2], o0[3]); w.z = cvt_pk_bf16(o1[0], o1[1]); w.w = cvt_pk_bf16(o1[2], o1[3]);
                    *(u32x4*)(XBp + off) = w;
                    *(u32x2*)(X8 + off) = (u32x2){pk4_fp8(o0[0] * s8, o0[1] * s8, o0[2] * s8, o0[3] * s8), pk4_fp8(o1[0] * s8, o1[1] * s8, o1[2] * s8, o1[3] * s8)};
                    asm volatile("" ::: "memory"); } }
    }
};

template <class Epi, class Sched, bool ALIGN_EPI, bool GATHER, bool FP8 = false, bool ABLK = false>
__device__ __forceinline__ void gemm_phase(PG8_LAS unsigned char* lds, const Gemm g, const Sched& S, const Epi& E) {
    const int tid = threadIdx.x, wid = __builtin_amdgcn_readfirstlane(tid >> 6), lane = tid & 63, wr = wid >> 2, wc = wid & 3, fr = lane & 15, fq = lane >> 4;
    const int K = g.K, nt = K / BK;
    unsigned voffB[2];
#pragma unroll
    for (int i = 0; i < 2; ++i) { int R, C; stage_rc(tid * 16 + i * 8192, R, C); const int Rb = Epi::PERM ? ((R & ~31) + perm32(R & 31)) : R;
        voffB[i] = (unsigned)(Rb * K + C) * 2u; }
    constexpr int SIDE_BYTES = 8192;
    PG8_LAS unsigned char* const side = lds + STAGE_BYTES;
    const size_t kstep = (size_t)(BK * 2);
    const size_t kstepA = ABLK ? (size_t)32768 : kstep;
    const size_t hstep = (size_t)HALF * K * 2;
    const size_t tstep = 2 * hstep;
    const unsigned ldsw = (unsigned)wid * 1024u;
    const int aoff = lds_byte(wr * 64 + fr, fq * 8), boff = lds_byte(wc * 32 + fr, fq * 8);
#define PG8_SA(b, h) (((b) * 2 + (h)) * HTB)
#define PG8_SB(b, h) ((4 + (b) * 2 + (h)) * HTB)
#define PG8_STAGE(bufoff, gbase, voff) do { _Pragma("unroll") for (int _i = 0; _i < 2; ++_i) \
        __builtin_amdgcn_global_load_lds((const unsigned*)((const char*)(gbase) + (voff)[_i]), (PG8_LAS unsigned*)(lds + (bufoff) + ldsw + _i * 8192), 16, 0, 0); } while (0)
#define PG8_LDA(dst, b, h) do { _Pragma("unroll") for (int m = 0; m < 4; ++m) _Pragma("unroll") for (int k = 0; k < 2; ++k) dst[m][k] = *(const PG8_LAS bf16x8*)(lds + PG8_SA(b, h) + aoff + m * 2048 + k * 1024); } while (0)
#define PG8_LDB(dst, b, h) do { _Pragma("unroll") for (int n = 0; n < 2; ++n) _Pragma("unroll") for (int k = 0; k < 2; ++k) dst[n][k] = *(const PG8_LAS bf16x8*)(lds + PG8_SB(b, h) + boff + n * 2048 + k * 1024); } while (0)
#define PG8_MMA(ai, bj, At, Bt) do { __builtin_amdgcn_s_setprio(1); _Pragma("unroll") for (int m = 0; m < 4; ++m) _Pragma("unroll") for (int n = 0; n < 2; ++n) { \
        if constexpr (FP8) mfma8(acc[ai][bj][m][n], cat8(Bt[n][0], Bt[n][1]), cat8(At[m][0], At[m][1]), scl8); \
        else { _Pragma("unroll") for (int k = 0; k < 2; ++k) acc[ai][bj][m][n] = __builtin_amdgcn_mfma_f32_16x16x32_bf16(Bt[n][k], At[m][k], acc[ai][bj][m][n], 0, 0, 0); } } __builtin_amdgcn_s_setprio(0); } while (0)
#define PG8_WAIT_V(n) asm volatile("s_waitcnt vmcnt(" #n ")" ::: "memory")
#define PG8_WAIT_L(n) asm volatile("s_waitcnt lgkmcnt(" #n ")" ::: "memory")
#define PG8_BAR __builtin_amdgcn_s_barrier()
#define PG8_SCHED __builtin_amdgcn_sched_barrier(0)
#define PG8_SETOFFS(o, u) do { _Pragma("unroll") for (int _h = 0; _h < 2; ++_h) _Pragma("unroll") for (int _i = 0; _i < 2; ++_i) { int _R, _C; stage_rc(tid * 16 + _i * 8192, _R, _C); \
        o[_h][_i] = GATHER ? (S.arow(u, _R + HALF * _h) + (unsigned)(_C * 2)) : ABLK ? hblk_off(_R + HALF * _h, _C >> 3) : ((unsigned)((_R + HALF * _h) * K) * 2u + (unsigned)(_C * 2)); } } while (0)
    int scl8 = 0x7F7F7F7F; asm volatile("" : "+v"(scl8));
    Unit cur, nxt; int ui = 0;
    if (!S.next(0, cur)) return;
    f32x4 acc[2][2][4][2];
#pragma unroll
    for (int a = 0; a < 2; ++a)
#pragma unroll
        for (int b = 0; b < 2; ++b)
#pragma unroll
            for (int m = 0; m < 4; ++m)
#pragma unroll
                for (int n = 0; n < 2; ++n) { acc[a][b][m][n] = (f32x4){0.f, 0.f, 0.f, 0.f}; if constexpr (FP8) asm volatile("" : "+v"(acc[a][b][m][n])); }
    bf16x8 At[4][2], B0[2][2], B1[2][2];
    unsigned cAo[2][2];
    PG8_SETOFFS(cAo, cur);
    const char* cA = S.abase(cur, g, tstep); const char* cB = S.bbase(cur, g, tstep);
    S.a_ready(cur);
    PG8_STAGE(PG8_SB(0, 0), cB, voffB); PG8_STAGE(PG8_SB(0, 1), cB + hstep, voffB); PG8_STAGE(PG8_SA(0, 0), cA, cAo[0]); PG8_STAGE(PG8_SA(0, 1), cA, cAo[1]);
    if (wr == 1) PG8_BAR;
    PG8_WAIT_V(2); PG8_BAR;
    PG8_STAGE(PG8_SB(1, 0), cB + kstep, voffB); PG8_STAGE(PG8_SA(1, 0), cA + kstepA, cAo[0]); PG8_STAGE(PG8_SB(1, 1), cB + hstep + kstep, voffB);
    PG8_WAIT_V(6); PG8_BAR;
    for (;;) {
        const bool has_next = S.next(ui + 1, nxt);
        const char* nA = has_next ? S.abase(nxt, g, tstep) : cA; const char* nB = has_next ? S.bbase(nxt, g, tstep) : cB;
        if constexpr (Sched::SIDE) {
            const void* ssrc = S.side_src(cur, (GATHER && has_next) ? nxt : cur, wid, lane);
            __builtin_amdgcn_global_load_lds((const unsigned*)ssrc, (PG8_LAS unsigned*)(side + (ui & 1) * SIDE_BYTES + wid * 1024), 16, 0, 0); }
#pragma unroll 1
        for (int t = 0; t < nt; t += 2) {
            const bool last = (t == nt - 2);
            const char* a1 = cA + (size_t)(t + 1) * kstepA;
            const char* a2 = last ? nA : cA + (size_t)(t + 2) * kstepA; const char* b2 = last ? nB : cB + (size_t)(t + 2) * kstep;
            const char* a3 = a2 + kstepA; const char* b3 = b2 + kstep;
            if (last && has_next) S.a_ready(nxt);
            PG8_LDB(B0, 0, 0); PG8_LDB(B1, 0, 1); PG8_SCHED; PG8_LDA(At, 0, 0); PG8_STAGE(PG8_SA(1, 1), a1, cAo[1]);
            if constexpr (GATHER) { if (last && has_next) {
                const PG8_LAS unsigned char* sdn = side + (ui & 1) * SIDE_BYTES;
#pragma unroll
                for (int _h = 0; _h < 2; ++_h)
#pragma unroll
                    for (int _i = 0; _i < 2; ++_i) { int _R, _C; stage_rc(tid * 16 + _i * 8192, _R, _C); cAo[_h][_i] = S.arow_side(nxt, _R + HALF * _h, sdn) + (unsigned)(_C * 2); } } }
            PG8_WAIT_V(8); PG8_WAIT_L(0); PG8_BAR; PG8_MMA(0, 0, At, B0); PG8_MMA(0, 1, At, B1); PG8_BAR; PG8_SCHED;
            PG8_LDA(At, 0, 1); PG8_STAGE(PG8_SB(0, 0), b2, voffB); PG8_STAGE(PG8_SB(0, 1), b2 + hstep, voffB); PG8_STAGE(PG8_SA(0, 0), a2, cAo[0]);
            PG8_WAIT_V(8); PG8_WAIT_L(0); PG8_BAR; PG8_MMA(1, 0, At, B0); PG8_MMA(1, 1, At, B1); PG8_BAR; PG8_SCHED;
            PG8_LDB(B0, 1, 0); PG8_LDB(B1, 1, 1); PG8_SCHED; PG8_LDA(At, 1, 0); PG8_STAGE(PG8_SA(0, 1), a2, cAo[1]);
            PG8_WAIT_V(8); PG8_WAIT_L(0); PG8_BAR; PG8_MMA(0, 0, At, B0); PG8_MMA(0, 1, At, B1); PG8_BAR; PG8_SCHED;
            PG8_LDA(At, 1, 1); PG8_STAGE(PG8_SB(1, 0), b3, voffB); PG8_STAGE(PG8_SB(1, 1), b3 + hstep, voffB); PG8_STAGE(PG8_SA(1, 0), a3, cAo[0]);
            PG8_WAIT_V(8); PG8_WAIT_L(0); PG8_BAR; PG8_MMA(1, 0, At, B0); PG8_MMA(1, 1, At, B1); PG8_BAR; PG8_SCHED;
        }
        if constexpr (ALIGN_EPI) { if (wr == 0) PG8_BAR; }
        if constexpr (FP8) asm volatile("s_nop 15\n\ts_nop 15" ::: "memory");
        if constexpr (!Epi::AFTER_DRAIN) { PG8_SCHED; E(acc, cur, wr, wc, fr, fq, side + (ui & 1) * SIDE_BYTES); S.done(cur); PG8_SCHED; }
        if (!has_next) break;
#pragma unroll
        for (int a = 0; a < 2; ++a)
#pragma unroll
            for (int b = 0; b < 2; ++b)
#pragma unroll
                for (int m = 0; m < 4; ++m)
#pragma unroll
                    for (int n = 0; n < 2; ++n) { acc[a][b][m][n] = (f32x4){0.f, 0.f, 0.f, 0.f}; if constexpr (FP8) asm volatile("" : "+v"(acc[a][b][m][n])); }
        cur = nxt; cA = nA; cB = nB; ++ui;
        if constexpr (ALIGN_EPI) { if (wr == 1) PG8_BAR; }
    }
    PG8_WAIT_V(0);
    if constexpr (!ALIGN_EPI) { if (wr == 0) PG8_BAR; }
    PG8_BAR;
    if constexpr (Epi::AFTER_DRAIN) { E.fused(acc, cur, wr, wc, fr, fq, lds, wid, lane); S.done(cur); }
#undef PG8_SA
#undef PG8_SB
#undef PG8_STAGE
#undef PG8_LDA
#undef PG8_LDB
#undef PG8_MMA
#undef PG8_WAIT_V
#undef PG8_WAIT_L
#undef PG8_BAR
#undef PG8_SCHED
#undef PG8_SETOFFS
}
}

constexpr int NB = 8, SEQ = 4096, DM = 1024, MROWS = NB * SEQ, NLAYER = 2;
constexpr int NPROJ = 4608, INW = 4616;
constexpr int C_Q = 0, C_K = 512, C_V = 1024, C_Z = 1536, C_XS = 2048, C_SB = 3072, C_SC = 3584, C_SH = 4096;
constexpr int MIXW = 1536, NEXP = 32, TOPK = 4, FF = 1024;
constexpr float ALPHA = 1.4142135623730951f;
constexpr float LN_EPS = 1e-5f, RMS_EPS = 1e-5f;
constexpr float QSCALE = 0.125f * 1.4426950408889634f;

constexpr size_t MiB = 1u << 20;
constexpr size_t WS_CTL = 0, CTL_ZERO_BYTES = 1 * MiB;
constexpr size_t WS_ROPE = 1 * MiB;
constexpr size_t WS_WDT = 2 * MiB;
constexpr size_t WS_ROUT = 2 * MiB + 65536;
constexpr size_t WS_WIN = 4 * MiB;
constexpr size_t WS_WOUT = 24 * MiB;
constexpr size_t WS_WGU = 32 * MiB;
constexpr size_t WS_WDN = 288 * MiB;
constexpr size_t WS_XB = 416 * MiB;
constexpr size_t WS_XF = 480 * MiB;
constexpr size_t WS_XF2 = 608 * MiB;
constexpr size_t WS_PROJ = 736 * MiB;
constexpr size_t WS_DT = 1024 * MiB;
constexpr size_t WS_DTS = 1025 * MiB;
constexpr size_t WS_ACUM = 1026 * MiB;
constexpr size_t WS_LSE = 1027 * MiB;
constexpr size_t WS_OP = 1030 * MiB;
constexpr size_t WS_U = 1126 * MiB;
constexpr size_t WS_G = 1190 * MiB;
constexpr size_t WS_ST = 1222 * MiB;
constexpr size_t WS_YD = 1286 * MiB;
constexpr size_t WS_MIXED = 1350 * MiB;
constexpr size_t WS_MIXF = 1446 * MiB;
constexpr size_t WS_TOPE = 1574 * MiB;
constexpr size_t WS_TOPG = 1575 * MiB;
constexpr size_t WS_ROWTOK = 1576 * MiB;
constexpr size_t WS_ROWGATE = 1580 * MiB;
constexpr size_t WS_H = 736 * MiB;
constexpr size_t WS_YB = 1030 * MiB;
constexpr size_t WS_END = 1584 * MiB;
constexpr int CW_TMO = 0;
constexpr int CW_CNT = 64;
constexpr int CW_BAR = 4096;
constexpr int CW_SEAM = 16384;

constexpr int RING_OFF = 0, RING_BYTES = 131072;
constexpr int LDSCTL_OFF = 155648;
constexpr int L_MISC = LDSCTL_OFF;
constexpr int L_TSTART = LDSCTL_OFF + 256;
constexpr int L_CNT = LDSCTL_OFF + 512;
constexpr int L_LCNT = LDSCTL_OFF + 640;
constexpr int L_LBASE = LDSCTL_OFF + 768;
constexpr int L_UNITS = LDSCTL_OFF + 1024;
constexpr int L_UNITSN = LDSCTL_OFF + 2048;
constexpr int LDS_BYTES = 163840;

#define GAS __attribute__((address_space(1)))
#define LAS __attribute__((address_space(3)))
typedef unsigned short bf16;
typedef unsigned v4u __attribute__((ext_vector_type(4)));
typedef unsigned v2u __attribute__((ext_vector_type(2)));
typedef float f32x4 __attribute__((ext_vector_type(4)));
typedef float f32x16 __attribute__((ext_vector_type(16)));
typedef short bf16x8 __attribute__((ext_vector_type(8)));
typedef GAS unsigned gu32;
#define RLX_AGENT __ATOMIC_RELAXED, __HIP_MEMORY_SCOPE_AGENT
#define LDS_WAIT() asm volatile("s_waitcnt lgkmcnt(0)" ::: "memory")
#define VM_WAIT() asm volatile("s_waitcnt vmcnt(0)" ::: "memory")
__device__ __forceinline__ unsigned f2bf(float f) { unsigned u = __builtin_bit_cast(unsigned, f); return (u + 0x7fffu + ((u >> 16) & 1u)) >> 16; }
__device__ __forceinline__ unsigned pk2(float lo, float hi) { unsigned r; asm volatile("v_cvt_pk_bf16_f32 %0, %1, %2" : "=v"(r) : "v"(lo), "v"(hi)); return r; }
__device__ __forceinline__ float bf2f(unsigned short b) { return __builtin_bit_cast(float, (unsigned)b << 16); }
__device__ __forceinline__ float bflo(unsigned w) { return __builtin_bit_cast(float, w << 16); }
__device__ __forceinline__ float bfhi(unsigned w) { return __builtin_bit_cast(float, w & 0xffff0000u); }
__device__ __forceinline__ float siluf(float x) { return x * __builtin_amdgcn_rcpf(1.0f + __builtin_amdgcn_exp2f(-1.4426950408889634f * x)); }
#define XB_TMO      128
#define XB_XCNT(j)  (256  + 64 * (j))
#define XB_XSUB(j)  (1280 + 64 * (j))
#define XB_XGEN(j)  (2304 + 64 * (j))
#define XB_TOP      3328
#define XB_TOPGEN   3392
#define XCD_BAR_WORDS 3456
#define XB_SPIN_CAP (1u << 18)

__device__ __forceinline__ unsigned xb_ld(unsigned* p)              { return __hip_atomic_load(p, __ATOMIC_RELAXED, __HIP_MEMORY_SCOPE_AGENT); }
__device__ __forceinline__ unsigned xb_add(unsigned* p, unsigned v) { return __hip_atomic_fetch_add(p, v, __ATOMIC_RELAXED, __HIP_MEMORY_SCOPE_AGENT); }
__device__ __forceinline__ unsigned xb_xcc_id() { return (unsigned)__builtin_amdgcn_s_getreg((3 << 11) | 20) & 0xFu; }
#define XB_SPIN(cond, bar) do { unsigned _sp = 0; while (cond) { __builtin_amdgcn_s_sleep(1); \
    if ((++_sp & 255u) == 0u) { if (xb_ld(&(bar)[XB_TMO])) break; if (_sp > XB_SPIN_CAP) { atomicAdd(&(bar)[XB_TMO], 1u); break; } } } } while (0)

struct XcdBarrier {
    unsigned* bar; unsigned x;
    volatile LAS unsigned* st;
};

__device__ __forceinline__ XcdBarrier xcd_barrier_post(unsigned* bar, volatile LAS unsigned* st) {
    XcdBarrier b; b.bar = bar; b.x = xb_xcc_id(); b.st = st;
    if (threadIdx.x == 0) (void)xb_add(&bar[XB_XCNT(b.x)], 1u);
    return b;
}
__device__ __forceinline__ void xcd_barrier_complete(unsigned* bar, unsigned x, unsigned& nloc, unsigned& nx) {
    const unsigned G = gridDim.x * gridDim.y * gridDim.z;
    unsigned sum, cnt, mine, sp = 0u;
    for (;;) {
        sum = 0u; cnt = 0u; mine = 0u;
#pragma unroll
        for (unsigned j = 0; j < 16; ++j) { const unsigned c = xb_ld(&bar[XB_XCNT(j)]); sum += c; cnt += (c > 0u) ? 1u : 0u; mine = (j == x) ? c : mine; }
        if (sum == G) break;
        __builtin_amdgcn_s_sleep(1);
        if ((++sp & 255u) == 0u) { if (xb_ld(&bar[XB_TMO])) break; if (sp > XB_SPIN_CAP) { atomicAdd(&bar[XB_TMO], 1u); break; } }
    }
    nloc = mine > 0u ? mine : 1u; nx = cnt > 0u ? cnt : 1u;
}

__device__ __forceinline__ void xcd_barrier(const XcdBarrier& b) {
    asm volatile("s_waitcnt vmcnt(0)" ::: "memory");
    __syncthreads();
    if (threadIdx.x == 0) {
        unsigned* bar = b.bar;
        __builtin_amdgcn_s_waitcnt(0);
        unsigned nloc = b.st[0], nx = b.st[1];
        if (nloc == 0u) { xcd_barrier_complete(bar, b.x, nloc, nx); b.st[0] = nloc; b.st[1] = nx; }
        const unsigned old = xb_add(&bar[XB_XSUB(b.x)], 1u);
        const unsigned gen = old / nloc;
        if (old + 1u == (gen + 1u) * nloc) {
            __builtin_amdgcn_fence(__ATOMIC_RELEASE, "agent");
            asm volatile("s_waitcnt vmcnt(0)" ::: "memory");
            const unsigned og = xb_add(&bar[XB_TOP], 1u);
            const unsigned tg = og / nx;
            if (og + 1u == (tg + 1u) * nx) xb_add(&bar[XB_TOPGEN], 1u);
            else XB_SPIN(xb_ld(&bar[XB_TOPGEN]) == tg, bar);
            __builtin_amdgcn_fence(__ATOMIC_ACQUIRE, "agent");
            xb_add(&bar[XB_XGEN(b.x)], 1u);
            asm volatile("s_waitcnt vmcnt(0)" ::: "memory");
        } else {
            XB_SPIN(xb_ld(&bar[XB_XGEN(b.x)]) == gen, bar);
            __builtin_amdgcn_fence(__ATOMIC_ACQUIRE, "agent");
            asm volatile("s_waitcnt vmcnt(0)" ::: "memory");
        }
    }
    __syncthreads();
}

constexpr float SC_X = 4.f, SC_WGU = 32.f, SC_H = 4.f, SC_WDN = 4.f, SC_Y = 16.f, SC_WIN = 32.f, SC_O = 32.f;
__device__ __forceinline__ float wave_sum(float v) {
#pragma unroll
    for (int o = 1; o < 64; o <<= 1) v += __shfl_xor(v, o);
    return v;
}
__device__ __forceinline__ int win_dest_row(int n) {
    if (n < 1024) { const int hh = n >> 6, d = n & 63; const int p = (d < 32) ? (8 * (d >> 2) + (d & 3)) : (8 * ((d - 32) >> 2) + 4 + (d & 3)); return hh * 64 + p; }
    if (n < 3072) return n;
    if (n < 3080) return -1;
    return n - 8;
}
__device__ __forceinline__ int wgu_dest_row(int n) { return n < 1024 ? ((n >> 7) * 256 + (n & 127)) : (((n - 1024) >> 7) * 256 + 128 + ((n - 1024) & 127)); }
template <int MAP>
__device__ __forceinline__ void p0_transpose_item(const float* W, int K, int N, bf16* WT, float* wdt, LAS float* scr, int kb, int nb, int lane) {
    const int k0 = 64 * kb, n0 = 32 * nb;
    const int nn = n0 + (lane & 31); const bool nok = nn < N;
#pragma unroll 8
    for (int i = 0; i < 32; ++i) { const int kk = 2 * i + (lane >> 5); scr[kk * 33 + (lane & 31)] = nok ? W[(size_t)(k0 + kk) * N + nn] : 0.f; }
    LDS_WAIT(); asm volatile("" ::: "memory");
    const int c = lane & 7;
#pragma unroll
    for (int j = 0; j < 4; ++j) { const int n = (lane >> 3) + 8 * j; const LAS float* s = scr + (8 * c) * 33 + n;
        const int nsrc = n0 + n; if (nsrc >= N) continue;
        int drow = nsrc; if (MAP == 1) drow = win_dest_row(nsrc); if (MAP == 2) drow = wgu_dest_row(nsrc);
        if (MAP == 1 && drow < 0) { float* d = wdt + (size_t)(nsrc - 3072) * 1024 + k0 + 8 * c;
#pragma unroll
            for (int q = 0; q < 8; ++q) d[q] = s[q * 33]; continue; }
        v4u o; o.x = pk2(s[0 * 33], s[1 * 33]); o.y = pk2(s[2 * 33], s[3 * 33]); o.z = pk2(s[4 * 33], s[5 * 33]); o.w = pk2(s[6 * 33], s[7 * 33]);
        *(GAS v4u*)(WT + (size_t)drow * K + k0 + 8 * c) = o; }
    LDS_WAIT(); asm volatile("" ::: "memory");
}
template <int MAP>
__device__ __forceinline__ void p0_transpose_item64(const float* W, int K, int N, bf16* WT, float* wdt, LAS float* scr, int kb, int nb, int lane) {
    const int k0 = 64 * kb, n0 = 64 * nb;
    const bool lok = (n0 + 4 * (lane & 15) + 3) < N;
    f32x4 ld[16];
#pragma unroll
    for (int i = 0; i < 16; ++i) ld[i] = lok ? *(const f32x4*)(W + (size_t)(k0 + 4 * i + (lane >> 4)) * N + n0 + 4 * (lane & 15)) : (f32x4){0.f, 0.f, 0.f, 0.f};
#pragma unroll
    for (int i = 0; i < 16; ++i) *(LAS f32x4*)(scr + (4 * i + (lane >> 4)) * 64 + 4 * (lane & 15)) = ld[i];
    LDS_WAIT(); asm volatile("" ::: "memory");
    const int nsrc = n0 + lane;
    if (nsrc < N) {
        int drow = nsrc; if (MAP == 1) drow = win_dest_row(nsrc);
        if (MAP == 1 && drow < 0) { float* d = wdt + (size_t)(nsrc - 3072) * 1024 + k0;
#pragma unroll
            for (int q = 0; q < 16; ++q) *(f32x4*)(d + 4 * q) = (f32x4){scr[(4 * q) * 64 + lane], scr[(4 * q + 1) * 64 + lane], scr[(4 * q + 2) * 64 + lane], scr[(4 * q + 3) * 64 + lane]}; }
        else { GAS v4u* d = (GAS v4u*)(WT + (size_t)drow * K + k0);
#pragma unroll
            for (int q = 0; q < 8; ++q) { v4u o; o.x = pk2(scr[(8 * q) * 64 + lane], scr[(8 * q + 1) * 64 + lane]); o.y = pk2(scr[(8 * q + 2) * 64 + lane], scr[(8 * q + 3) * 64 + lane]);
                o.z = pk2(scr[(8 * q + 4) * 64 + lane], scr[(8 * q + 5) * 64 + lane]); o.w = pk2(scr[(8 * q + 6) * 64 + lane], scr[(8 * q + 7) * 64 + lane]); d[q] = o; } } }
    LDS_WAIT(); asm volatile("" ::: "memory");
}
struct SubT { const float* src; unsigned char* dst; int N; int n0; int mode; float scale; };
__device__ __forceinline__ SubT fp8_subtile(int item, int half, const float* wgu, const float* wdn, const float* win, unsigned char* WG8, unsigned char* WD8, unsigned char* WI8, int lane) {
    SubT t; int kb, nb;
    if (item < 64 * 256) { const int le = item >> 8, r = item & 255; kb = r >> 5; nb = r & 31; t.N = 2048; t.mode = 1; t.scale = SC_WGU;
        t.src = wgu + (size_t)le * 1024 * 2048; t.dst = WG8 + (size_t)le * 2048 * 1024; }
    else if (item < 64 * 256 + 64 * 128) { const int it2 = item - 64 * 256; const int le = it2 >> 7, r = it2 & 127; kb = r >> 4; nb = r & 15; t.N = 1024; t.mode = 0; t.scale = SC_WDN;
        t.src = wdn + (size_t)le * 1024 * 1024; t.dst = WD8 + (size_t)le * 1024 * 1024; }
    else { const int it3 = item - (64 * 256 + 64 * 128); const int l = it3 / 192, r = it3 % 192; kb = r / 24; nb = r % 24; t.N = INW; t.mode = 2; t.scale = SC_WIN;
        t.src = win + (size_t)l * 1024 * INW; t.dst = WI8 + (size_t)l * 1536 * 1024; }
    const int k0 = 128 * kb + 64 * half; t.n0 = 64 * nb;
    t.src += (size_t)(k0 + (lane >> 4)) * t.N + t.n0 + 4 * (lane & 15);
    t.dst += (size_t)k0;
    return t;
}
__device__ __forceinline__ void fp8_sub_load(const SubT& t, f32x4 (&ld)[16]) {
#pragma unroll
    for (int i = 0; i < 16; ++i) ld[i] = __builtin_nontemporal_load((const f32x4*)(t.src + (size_t)(4 * i) * t.N));
}
__device__ __forceinline__ void fp8_sub_process(const SubT& t, const f32x4 (&ld)[16], LAS float* scr, int lane) {
#pragma unroll
    for (int i = 0; i < 16; ++i) *(LAS f32x4*)(scr + (4 * i + (lane >> 4)) * 64 + 4 * (lane & 15)) = ld[i];
    LDS_WAIT(); asm volatile("" ::: "memory");
    unsigned w[16];
#pragma unroll
    for (int q = 0; q < 16; ++q) w[q] = pg8::pk4_fp8(scr[(4 * q + 0) * 64 + lane] * t.scale, scr[(4 * q + 1) * 64 + lane] * t.scale, scr[(4 * q + 2) * 64 + lane] * t.scale, scr[(4 * q + 3) * 64 + lane] * t.scale);
    LDS_WAIT(); asm volatile("" ::: "memory");
    LAS unsigned char* t2 = (LAS unsigned char*)scr;
#pragma unroll
    for (int q = 0; q < 4; ++q) *(LAS v4u*)(t2 + lane * 80 + 16 * q) = (v4u){w[4 * q], w[4 * q + 1], w[4 * q + 2], w[4 * q + 3]};
    LDS_WAIT(); asm volatile("" ::: "memory");
#pragma unroll
    for (int q = 0; q < 4; ++q) { const int n = 16 * q + (lane >> 2); const v4u v = *(const LAS v4u*)(t2 + n * 80 + 16 * (lane & 3));
        const int nn = (t.mode == 1) ? wgu_dest_row(t.n0 + n) : (t.mode == 2) ? win_dest_row(t.n0 + n) : (t.n0 + n);
        *(GAS v4u*)(t.dst + (size_t)nn * 1024 + 16 * (lane & 3)) = v; }
    LDS_WAIT(); asm volatile("" ::: "memory");
}
__device__ __forceinline__ void row_dt(const f32x4 (&v)[4], const float* wdt, float* dst, int lane) {
    float r[8];
#pragma unroll
    for (int jj = 0; jj < 8; ++jj) { float s = 0.f;
#pragma unroll
        for (int j = 0; j < 4; ++j) { const f32x4 w = *(const f32x4*)(wdt + jj * 1024 + 4 * lane + 256 * j); s += v[j][0] * w[0] + v[j][1] * w[1] + v[j][2] * w[2] + v[j][3] * w[3]; }
        r[jj] = wave_sum(s); }
    if (lane == 0) { *(f32x4*)dst = (f32x4){r[0], r[1], r[2], r[3]}; *(f32x4*)(dst + 4) = (f32x4){r[4], r[5], r[6], r[7]}; }
}
__device__ __forceinline__ void load_wdt(const float* wdt, f32x4 (&w)[8][4], int lane) {
#pragma unroll
    for (int jj = 0; jj < 8; ++jj)
#pragma unroll
        for (int j = 0; j < 4; ++j) w[jj][j] = *(const f32x4*)(wdt + jj * 1024 + 4 * lane + 256 * j);
}
__device__ __forceinline__ void row_dt_w(const f32x4 (&v)[4], const f32x4 (&w)[8][4], float* dst, int lane) {
    float r[8];
#pragma unroll
    for (int jj = 0; jj < 8; ++jj) { float s = 0.f;
#pragma unroll
        for (int j = 0; j < 4; ++j) s += v[j][0] * w[jj][j][0] + v[j][1] * w[jj][j][1] + v[j][2] * w[jj][j][2] + v[j][3] * w[jj][j][3];
        r[jj] = wave_sum(s); }
    if (lane == 0) { *(f32x4*)dst = (f32x4){r[0], r[1], r[2], r[3]}; *(f32x4*)(dst + 4) = (f32x4){r[4], r[5], r[6], r[7]}; }
}
__device__ __forceinline__ void row_dt_win(const f32x4 (&v)[4], const float* win, float* dst, int lane) {
    float r[8];
#pragma unroll
    for (int jj = 0; jj < 8; ++jj) r[jj] = 0.f;
#pragma unroll
    for (int j = 0; j < 4; ++j)
#pragma unroll
        for (int e = 0; e < 4; ++e) { const float* wp = win + (size_t)(4 * lane + 256 * j + e) * INW + 3072; const f32x4 w0 = *(const f32x4*)wp, w1 = *(const f32x4*)(wp + 4); const float x = v[j][e];
            r[0] += x * w0[0]; r[1] += x * w0[1]; r[2] += x * w0[2]; r[3] += x * w0[3]; r[4] += x * w1[0]; r[5] += x * w1[1]; r[6] += x * w1[2]; r[7] += x * w1[3]; }
#pragma unroll
    for (int jj = 0; jj < 8; ++jj) r[jj] = wave_sum(r[jj]);
    if (lane == 0) { *(f32x4*)dst = (f32x4){r[0], r[1], r[2], r[3]}; *(f32x4*)(dst + 4) = (f32x4){r[4], r[5], r[6], r[7]}; }
}
template <bool W8, bool WF>
__device__ __forceinline__ void ln_row(f32x4 (&v)[4], const float* gam, const float* bet, float* of32, bf16* ob16, unsigned char* o8, float s8, int lane) {
    float s = 0.f;
#pragma unroll
    for (int j = 0; j < 4; ++j) s += (v[j][0] + v[j][1]) + (v[j][2] + v[j][3]);
    const float mean = wave_sum(s) * (1.f / DM); float s2 = 0.f;
#pragma unroll
    for (int j = 0; j < 4; ++j) { v[j] = v[j] - mean; s2 += (v[j][0] * v[j][0] + v[j][1] * v[j][1]) + (v[j][2] * v[j][2] + v[j][3] * v[j][3]); }
    const float rstd = 1.f / sqrtf(wave_sum(s2) * (1.f / DM) + LN_EPS);
#pragma unroll
    for (int j = 0; j < 4; ++j) { const f32x4 g = *(const f32x4*)(gam + 4 * lane + 256 * j), b = *(const f32x4*)(bet + 4 * lane + 256 * j);
        v[j] = v[j] * rstd * g + b;
        if (WF) *(f32x4*)(of32 + 4 * lane + 256 * j) = v[j];
        v2u w; w.x = pk2(v[j][0], v[j][1]); w.y = pk2(v[j][2], v[j][3]); *(v2u*)(ob16 + 4 * lane + 256 * j) = w;
        if (W8) *(unsigned*)(o8 + 4 * lane + 256 * j) = pg8::pk4_fp8(v[j][0] * s8, v[j][1] * s8, v[j][2] * s8, v[j][3] * s8); }
}


typedef short v4i16_t __attribute__((ext_vector_type(4)));
__device__ __forceinline__ bf16x8 tr_pair(const LAS unsigned char* p0, const LAS unsigned char* p1) {
    const v4i16_t a = __builtin_amdgcn_ds_read_tr16_b64_v4i16((LAS v4i16_t*)p0), b = __builtin_amdgcn_ds_read_tr16_b64_v4i16((LAS v4i16_t*)p1);
    return (bf16x8){a[0], a[1], a[2], a[3], b[0], b[1], b[2], b[3]};
}
__device__ __forceinline__ int crow16(int r, int hi) { return (r & 3) + 8 * (r >> 2) + 4 * hi; }
constexpr int AK_PITCH = 144, AV_PITCH = 192, AK_TILE = 32 * AK_PITCH, AV_TILE = 32 * AV_PITCH;
constexpr int AT_K = 0, AT_V = 12 * AK_TILE;
struct AttnItem { int p, b, h, d, r, qt0; };
__device__ __forceinline__ AttnItem attn_item(int I) { AttnItem a; a.p = I >> 10; const int rem = I & 1023; a.b = rem >> 7; a.h = (rem >> 4) & 7; const int grp = rem & 15;
    a.d = (a.p == 0) ? 1 : (a.p == 1) ? 4 : 16; const int tpr = 128 / a.d; const int T = grp * 8; a.r = T / tpr; a.qt0 = T % tpr; return a; }
__device__ __forceinline__ void attn_request(const bf16* PROJ, const AttnItem& a, v4u (&st)[12], int tid) {
    const int rr = tid >> 4, ch = tid & 15; const int col = (ch < 8 ? C_K : C_V - 64) + a.h * 64 + ch * 8;
#pragma unroll
    for (int tl = 0; tl < 12; ++tl) { const int kt = a.qt0 - 4 + tl; st[tl] = (v4u){0u, 0u, 0u, 0u};
        if (kt >= 0) { const size_t row = (size_t)a.b * SEQ + (size_t)(32 * kt + rr) * a.d + a.r; st[tl] = *(const v4u*)(PROJ + row * NPROJ + col); } }
}
__device__ __forceinline__ void attn_deposit(LAS unsigned char* al, const v4u (&st)[12], int tid) {
    const int rr = tid >> 4, ch = tid & 15;
    LAS unsigned char* dst = (ch < 8) ? (al + AT_K + rr * AK_PITCH + ch * 16) : (al + AT_V + rr * AV_PITCH + (ch - 8) * 16); const int tstep = (ch < 8) ? AK_TILE : AV_TILE;
#pragma unroll
    for (int tl = 0; tl < 12; ++tl) *(LAS v4u*)(dst + tl * tstep) = st[tl];
}
__device__ __forceinline__ void attn_wave_compute(const bf16* PROJ, bf16* OPp, float* LSEp, const AttnItem& a, const LAS unsigned char* al, int wave, int lane) {
    const int i = lane & 31, h2 = lane >> 5; const int qt = a.qt0 + wave;
    const size_t rowq = (size_t)a.b * SEQ + (size_t)(32 * qt + i) * a.d + a.r;
    bf16x8 qf[4];
    { const bf16* qp = PROJ + rowq * NPROJ + C_Q + a.h * 64 + 8 * h2;
#pragma unroll
      for (int s = 0; s < 4; ++s) qf[s] = *(const bf16x8*)(qp + 16 * s); }
    f32x16 o0 = {}, o1 = {}; float mrun = -INFINITY, lrun = 0.f;
    const int kt0 = qt > 4 ? qt - 4 : 0;
    const LAS unsigned char* krd = al + AT_K + i * AK_PITCH + 16 * h2;
    const LAS unsigned char* trb = al + AT_V + (4 * h2 + ((lane & 15) >> 2)) * AV_PITCH + (16 * ((lane >> 4) & 1) + 4 * (lane & 3)) * 2;
#define ATT_QK(S, ktx) do { const LAS unsigned char* kp_ = krd + ((ktx) - a.qt0 + 4) * AK_TILE; \
        S = __builtin_amdgcn_mfma_f32_32x32x16_bf16(*(const LAS bf16x8*)(kp_), qf[0], (f32x16){}, 0, 0, 0); \
        _Pragma("unroll") for (int s = 1; s < 4; ++s) S = __builtin_amdgcn_mfma_f32_32x32x16_bf16(*(const LAS bf16x8*)(kp_ + 32 * s), qf[s], S, 0, 0, 0); } while (0)
#define ATT_STEP(S, ktx) do { const LAS unsigned char* vp = trb + ((ktx) - a.qt0 + 4) * AV_TILE; \
        if ((ktx) == qt) { asm volatile("; causal mask"); _Pragma("unroll") for (int rg = 0; rg < 16; ++rg) if (crow16(rg, h2) > i) S[rg] = -INFINITY; } \
        if ((ktx) + 4 == qt) { asm volatile("; window mask"); _Pragma("unroll") for (int rg = 0; rg < 16; ++rg) if (crow16(rg, h2) < i) S[rg] = -INFINITY; } \
        float mx = S[0]; \
        _Pragma("unroll") for (int rg = 1; rg < 16; ++rg) mx = fmaxf(mx, S[rg]); \
        mx = fmaxf(mx, __shfl_xor(mx, 32)); \
        const float mnew = fmaxf(mrun, mx), alpha = __builtin_amdgcn_exp2f(mrun - mnew); mrun = mnew; \
        float ps = 0.f; \
        _Pragma("unroll") for (int rg = 0; rg < 16; ++rg) { S[rg] = __builtin_amdgcn_exp2f(S[rg] - mnew); ps += S[rg]; } \
        lrun = lrun * alpha + ps; \
        _Pragma("unroll") for (int rg = 0; rg < 16; ++rg) { o0[rg] *= alpha; o1[rg] *= alpha; } \
        bf16x8 pf[2]; \
        _Pragma("unroll") for (int ks = 0; ks < 2; ++ks) { v4u w; w.x = pg8::cvt_pk_bf16(S[8 * ks + 0], S[8 * ks + 1]); w.y = pg8::cvt_pk_bf16(S[8 * ks + 2], S[8 * ks + 3]); w.z = pg8::cvt_pk_bf16(S[8 * ks + 4], S[8 * ks + 5]); w.w = pg8::cvt_pk_bf16(S[8 * ks + 6], S[8 * ks + 7]); pf[ks] = __builtin_bit_cast(bf16x8, w); } \
        _Pragma("unroll") for (int ks = 0; ks < 2; ++ks) { \
            const bf16x8 v0 = tr_pair(vp + (16 * ks) * AV_PITCH, vp + (16 * ks + 8) * AV_PITCH); \
            const bf16x8 v1 = tr_pair(vp + (16 * ks) * AV_PITCH + 64, vp + (16 * ks + 8) * AV_PITCH + 64); \
            o0 = __builtin_amdgcn_mfma_f32_32x32x16_bf16(v0, pf[ks], o0, 0, 0, 0); \
            o1 = __builtin_amdgcn_mfma_f32_32x32x16_bf16(v1, pf[ks], o1, 0, 0, 0); } } while (0)
    f32x16 sA, sB;
    ATT_QK(sA, kt0);
#pragma unroll 1
    for (int kt = kt0; ; kt += 2) {
        if (kt < qt) ATT_QK(sB, kt + 1);
        ATT_STEP(sA, kt);
        if (kt >= qt) break;
        if (kt + 1 < qt) ATT_QK(sA, kt + 2);
        ATT_STEP(sB, kt + 1);
        if (kt + 1 >= qt) break;
    }
#undef ATT_QK
#undef ATT_STEP
    const float lt = lrun + __shfl_xor(lrun, 32); const float il = 1.0f / lt;
    unsigned char* op = (unsigned char*)OPp + rowq * 512 + a.h * 64 + 4 * h2;
    const float ils = il * SC_O;
#pragma unroll
    for (int g4 = 0; g4 < 4; ++g4) {
        *(unsigned*)(op + 8 * g4) = pg8::pk4_fp8(o0[4 * g4 + 0] * ils, o0[4 * g4 + 1] * ils, o0[4 * g4 + 2] * ils, o0[4 * g4 + 3] * ils);
        *(unsigned*)(op + 32 + 8 * g4) = pg8::pk4_fp8(o1[4 * g4 + 0] * ils, o1[4 * g4 + 1] * ils, o1[4 * g4 + 2] * ils, o1[4 * g4 + 3] * ils); }
    if (h2 == 0) LSEp[rowq * 8 + a.h] = mrun + log2f(lt);
}
__device__ __forceinline__ void attn_phase(LAS unsigned char* al, const bf16* PROJ, bf16* OP, float* LSE, int bid, int G, int tid, int wave, int lane) {
    v4u st[12];
    int I = bid;
    if (I < 3072) { const AttnItem a = attn_item(I); attn_request(PROJ, a, st, tid); }
    for (; I < 3072; I += G) {
        const AttnItem a = attn_item(I);
        __syncthreads();
        attn_deposit(al, st, tid);
        __syncthreads();
        if (I + G < 3072) { const AttnItem n = attn_item(I + G); attn_request(PROJ, n, st, tid); }
        attn_wave_compute(PROJ, (bf16*)((unsigned char*)OP + (size_t)a.p * MROWS * 512), LSE + (size_t)a.p * MROWS * 8, a, al, wave, lane);
    }
    __syncthreads();
}

constexpr int SS_DTS = 0, SS_ACUM = 2048, SS_TMP = 4096, SS_SSX = 6144, SS_IMG = 8192;
constexpr int S1_PB = 320, S1_PX = 576;
constexpr int S1_B = SS_IMG, S1_X = SS_IMG + 128 * S1_PB;
constexpr int S3_PBC = 272, S3_PX = 576;
constexpr int S3_B = SS_IMG, S3_C = S3_B + 128 * S3_PBC, S3_X = S3_C + 128 * S3_PBC;

__device__ __forceinline__ void ssd_prep(LAS unsigned char* sl, const float* DT, const float* dtb, const float* alog, size_t row0, int g, int tid, int lane, int wave) {
    LAS float* dts = (LAS float*)(sl + SS_DTS); LAS float* acum = (LAS float*)(sl + SS_ACUM); LAS float* tmp = (LAS float*)(sl + SS_TMP);
    { const int l = tid >> 2, hq = tid & 3; const float x = DT[(row0 + l) * 8 + 4 * g + hq] + dtb[4 * g + hq];
      const float dt = x > 20.f ? x : log1pf(__expf(x)); dts[hq * 128 + l] = dt; tmp[hq * 128 + l] = dt * (-__expf(alog[4 * g + hq])); }
    __syncthreads();
    if (wave < 4) { const float v0 = tmp[wave * 128 + 2 * lane], v1 = tmp[wave * 128 + 2 * lane + 1]; float s = v0 + v1;
#pragma unroll
        for (int off = 1; off < 64; off <<= 1) { const float t = __shfl_up(s, off); if (lane >= off) s += t; }
        acum[wave * 128 + 2 * lane] = s - v1; acum[wave * 128 + 2 * lane + 1] = s; }
    __syncthreads();
}
template <int NCOLS, int FACMODE>
__device__ __forceinline__ void conv_tile(const bf16* PROJ, size_t row0, int t0, int pcol0, const float* cw, const float* cb, int cch0, LAS unsigned char* dst, int pitch, const LAS unsigned char* sl, int hq0, int tid) {
    constexpr int NCH8 = NCOLS / 8, NSEG = 512 / NCH8, RPS = 128 / NSEG;
    const int c8 = tid % NCH8, seg = tid / NCH8, l0 = seg * RPS;
    float w[4][8], bias[8], hst[3][8];
#pragma unroll
    for (int k = 0; k < 4; ++k) { const f32x4 a = *(const f32x4*)(cw + k * 1024 + cch0 + c8 * 8), b = *(const f32x4*)(cw + k * 1024 + cch0 + c8 * 8 + 4);
        w[k][0] = a[0]; w[k][1] = a[1]; w[k][2] = a[2]; w[k][3] = a[3]; w[k][4] = b[0]; w[k][5] = b[1]; w[k][6] = b[2]; w[k][7] = b[3]; }
    { const f32x4 a = *(const f32x4*)(cb + cch0 + c8 * 8), b = *(const f32x4*)(cb + cch0 + c8 * 8 + 4);
      bias[0] = a[0]; bias[1] = a[1]; bias[2] = a[2]; bias[3] = a[3]; bias[4] = b[0]; bias[5] = b[1]; bias[6] = b[2]; bias[7] = b[3]; }
    const bf16* src = PROJ + pcol0 + c8 * 8;
#pragma unroll
    for (int k = 0; k < 3; ++k) { const int l = l0 - 3 + k; v4u v = (v4u){0u, 0u, 0u, 0u}; if (t0 + l >= 0) v = *(const v4u*)(src + (size_t)((long)row0 + l) * NPROJ);
        hst[k][0] = bflo(v.x); hst[k][1] = bfhi(v.x); hst[k][2] = bflo(v.y); hst[k][3] = bfhi(v.y); hst[k][4] = bflo(v.z); hst[k][5] = bfhi(v.z); hst[k][6] = bflo(v.w); hst[k][7] = bfhi(v.w); }
    const LAS float* dts = (const LAS float*)(sl + SS_DTS); const LAS float* acum = (const LAS float*)(sl + SS_ACUM);
    const int hq = hq0 + (c8 * 8) / 64;
    const float alast = (FACMODE == 2) ? acum[hq * 128 + 127] : 0.f;
#pragma unroll
    for (int rr = 0; rr < RPS; ++rr) { const int l = l0 + rr; const v4u v = *(const v4u*)(src + (row0 + l) * NPROJ);
        float cur[8]; cur[0] = bflo(v.x); cur[1] = bfhi(v.x); cur[2] = bflo(v.y); cur[3] = bfhi(v.y); cur[4] = bflo(v.z); cur[5] = bfhi(v.z); cur[6] = bflo(v.w); cur[7] = bfhi(v.w);
        float f = 1.f; if (FACMODE >= 1) f = dts[hq * 128 + l]; if (FACMODE == 2) f *= __expf(alast - acum[hq * 128 + l]);
        float o[8];
#pragma unroll
        for (int e = 0; e < 8; ++e) { const float a = bias[e] + w[0][e] * hst[0][e] + w[1][e] * hst[1][e] + w[2][e] * hst[2][e] + w[3][e] * cur[e]; o[e] = siluf(a) * f;
            hst[0][e] = hst[1][e]; hst[1][e] = hst[2][e]; hst[2][e] = cur[e]; }
        v4u ov; ov.x = pk2(o[0], o[1]); ov.y = pk2(o[2], o[3]); ov.z = pk2(o[4], o[5]); ov.w = pk2(o[6], o[7]);
        *(LAS v4u*)(dst + l * pitch + c8 * 16) = ov; }
}
template <int NCOLS>
__device__ __forceinline__ void conv_load(const bf16* PROJ, size_t row0, int t0, int pcol0, int tid, v4u (&hv)[3], v4u (&rv)[128 / (512 / (NCOLS / 8))]) {
    constexpr int NCH8 = NCOLS / 8, NSEG = 512 / NCH8, RPS = 128 / NSEG;
    const int c8 = tid % NCH8, seg = tid / NCH8, l0 = seg * RPS;
    const bf16* src = PROJ + pcol0 + c8 * 8;
#pragma unroll
    for (int k = 0; k < 3; ++k) { const int l = l0 - 3 + k; hv[k] = (v4u){0u, 0u, 0u, 0u}; if (t0 + l >= 0) hv[k] = *(const v4u*)(src + (size_t)((long)row0 + l) * NPROJ); }
#pragma unroll
    for (int rr = 0; rr < RPS; ++rr) rv[rr] = *(const v4u*)(src + (row0 + l0 + rr) * NPROJ);
}
template <int NCOLS, int FACMODE>
__device__ __forceinline__ void conv_apply(const v4u (&hv)[3], const v4u (&rv)[128 / (512 / (NCOLS / 8))], const float* cw, const float* cb, int cch0, LAS unsigned char* dst, int pitch, const LAS unsigned char* sl, int hq0, int tid) {
    constexpr int NCH8 = NCOLS / 8, NSEG = 512 / NCH8, RPS = 128 / NSEG;
    const int c8 = tid % NCH8, seg = tid / NCH8, l0 = seg * RPS;
    float w[4][8], bias[8], hst[3][8];
#pragma unroll
    for (int k = 0; k < 4; ++k) { const f32x4 a = *(const f32x4*)(cw + k * 1024 + cch0 + c8 * 8), b = *(const f32x4*)(cw + k * 1024 + cch0 + c8 * 8 + 4);
        w[k][0] = a[0]; w[k][1] = a[1]; w[k][2] = a[2]; w[k][3] = a[3]; w[k][4] = b[0]; w[k][5] = b[1]; w[k][6] = b[2]; w[k][7] = b[3]; }
    { const f32x4 a = *(const f32x4*)(cb + cch0 + c8 * 8), b = *(const f32x4*)(cb + cch0 + c8 * 8 + 4);
      bias[0] = a[0]; bias[1] = a[1]; bias[2] = a[2]; bias[3] = a[3]; bias[4] = b[0]; bias[5] = b[1]; bias[6] = b[2]; bias[7] = b[3]; }
#pragma unroll
    for (int k = 0; k < 3; ++k) { const v4u v = hv[k];
        hst[k][0] = bflo(v.x); hst[k][1] = bfhi(v.x); hst[k][2] = bflo(v.y); hst[k][3] = bfhi(v.y); hst[k][4] = bflo(v.z); hst[k][5] = bfhi(v.z); hst[k][6] = bflo(v.w); hst[k][7] = bfhi(v.w); }
    const LAS float* dts = (const LAS float*)(sl + SS_DTS); const LAS float* acum = (const LAS float*)(sl + SS_ACUM);
    const int hq = hq0 + (c8 * 8) / 64;
    const float alast = (FACMODE == 2) ? acum[hq * 128 + 127] : 0.f;
#pragma unroll
    for (int rr = 0; rr < RPS; ++rr) { const int l = l0 + rr; const v4u v = rv[rr];
        float cur[8]; cur[0] = bflo(v.x); cur[1] = bfhi(v.x); cur[2] = bflo(v.y); cur[3] = bfhi(v.y); cur[4] = bflo(v.z); cur[5] = bfhi(v.z); cur[6] = bflo(v.w); cur[7] = bfhi(v.w);
        float f = 1.f; if (FACMODE >= 1) f = dts[hq * 128 + l]; if (FACMODE == 2) f *= __expf(alast - acum[hq * 128 + l]);
        float o[8];
#pragma unroll
        for (int e = 0; e < 8; ++e) { const float a = bias[e] + w[0][e] * hst[0][e] + w[1][e] * hst[1][e] + w[2][e] * hst[2][e] + w[3][e] * cur[e]; o[e] = siluf(a) * f;
            hst[0][e] = hst[1][e]; hst[1][e] = hst[2][e]; hst[2][e] = cur[e]; }
        v4u ov; ov.x = pk2(o[0], o[1]); ov.y = pk2(o[2], o[3]); ov.z = pk2(o[4], o[5]); ov.w = pk2(o[6], o[7]);
        *(LAS v4u*)(dst + l * pitch + c8 * 16) = ov; }
}
__device__ __forceinline__ void ssd_s1_unit(LAS unsigned char* sl, const bf16* PROJ, const float* DT, const float* dtb, const float* alog, const float* cw, const float* cb, float* ST, float* CDEC, int un, int tid, int lane, int wave) {
    const int g = un & 1, bc = un >> 1; const size_t row0 = (size_t)bc * 128; const int t0 = (bc & 31) * 128;
    v4u hvB[3], rvB[4], hvX[3], rvX[8];
    conv_load<128>(PROJ, row0, t0, C_XS + 512 + g * 128, tid, hvB, rvB);
    conv_load<256>(PROJ, row0, t0, C_XS + g * 256, tid, hvX, rvX);
    __syncthreads();
    ssd_prep(sl, DT, dtb, alog, row0, g, tid, lane, wave);
    conv_apply<128, 0>(hvB, rvB, cw, cb, 512 + g * 128, sl + S1_B, S1_PB, sl, 0, tid);
    conv_apply<256, 2>(hvX, rvX, cw, cb, g * 256, sl + S1_X, S1_PX, sl, 0, tid);
    if (tid < 4) CDEC[(size_t)bc * 8 + 4 * g + tid] = __expf(((const LAS float*)(sl + SS_ACUM))[tid * 128 + 127]);
    __syncthreads();
    const int hq = wave >> 1, pt = wave & 1, h2 = lane >> 5, q = (lane & 15) >> 2, pp = lane & 3, dsel = (lane >> 4) & 1;
    const LAS unsigned char* xb = sl + S1_X + (8 * h2 + q) * S1_PX + (hq * 64 + pt * 32 + 16 * dsel + 4 * pp) * 2;
    const LAS unsigned char* bb = sl + S1_B + (8 * h2 + q) * S1_PB + (16 * dsel + 4 * pp) * 2;
    f32x16 acc[4];
#pragma unroll
    for (int nt = 0; nt < 4; ++nt) acc[nt] = (f32x16){};
#pragma unroll
    for (int ks = 0; ks < 8; ++ks) { const bf16x8 a = tr_pair(xb + (16 * ks) * S1_PX, xb + (16 * ks + 4) * S1_PX);
#pragma unroll
        for (int nt = 0; nt < 4; ++nt) { const bf16x8 b = tr_pair(bb + (16 * ks) * S1_PB + nt * 64, bb + (16 * ks + 4) * S1_PB + nt * 64); acc[nt] = __builtin_amdgcn_mfma_f32_32x32x16_bf16(a, b, acc[nt], 0, 0, 0); } }
    float* sp = ST + ((size_t)(bc * 8 + 4 * g + hq) * 64 + pt * 32) * 128 + (lane & 31);
#pragma unroll
    for (int nt = 0; nt < 4; ++nt)
#pragma unroll
        for (int rg = 0; rg < 16; ++rg) sp[(size_t)crow16(rg, h2) * 128 + 32 * nt] = acc[nt][rg];
}
__device__ __forceinline__ void ssd_s3_unit(LAS unsigned char* sl, const bf16* PROJ, const float* DT, const float* dtb, const float* alog, const float* cw, const float* cb, const float* dsk, const float* ng,
                                            const bf16* HIN, bf16* MIXED, int un, int tid, int lane, int wave) {
    const int g = un & 1, bc = un >> 1; const size_t row0 = (size_t)bc * 128; const int t0 = (bc & 31) * 128;
    const int lt = wave & 3, ph = wave >> 2, lq = lane & 31, hi = lane >> 5, q = (lane & 15) >> 2, pp = lane & 3, dsel = (lane >> 4) & 1;
    const int lrow = 32 * lt + lq;
    const size_t grow = row0 + lrow;
    v4u hvB[3], rvB[4], hvC[3], rvC[4], hvX[3], rvX[8];
    conv_load<128>(PROJ, row0, t0, C_XS + 512 + g * 128, tid, hvB, rvB);
    conv_load<128>(PROJ, row0, t0, C_XS + 768 + g * 128, tid, hvC, rvC);
    conv_load<256>(PROJ, row0, t0, C_XS + g * 256, tid, hvX, rvX);
    __syncthreads();
    ssd_prep(sl, DT, dtb, alog, row0, g, tid, lane, wave);
    conv_apply<128, 0>(hvB, rvB, cw, cb, 512 + g * 128, sl + S3_B, S3_PBC, sl, 0, tid);
    conv_apply<128, 0>(hvC, rvC, cw, cb, 768 + g * 128, sl + S3_C, S3_PBC, sl, 0, tid);
    conv_apply<256, 1>(hvX, rvX, cw, cb, g * 256, sl + S3_X, S3_PX, sl, 0, tid);
    bf16x8 hf[2][8];
    const bf16* hp0 = HIN + ((size_t)(bc * 8 + 4 * g) * 64 + ph * 32 + lq) * 128 + 8 * hi;
#pragma unroll
    for (int hq = 0; hq < 2; ++hq)
#pragma unroll
        for (int ks = 0; ks < 8; ++ks) hf[hq][ks] = *(const bf16x8*)(hp0 + (size_t)hq * 8192 + 16 * ks);
    __syncthreads();
    const LAS float* dts = (const LAS float*)(sl + SS_DTS); const LAS float* acum = (const LAS float*)(sl + SS_ACUM); LAS float* ssx = (LAS float*)(sl + SS_SSX);
    const LAS unsigned char* crd = sl + S3_C + lrow * S3_PBC + 16 * hi;
    f32x16 y[4];
#pragma unroll
    for (int hq = 0; hq < 4; ++hq) {
        f32x16 t = (f32x16){};
#pragma unroll
        for (int ks = 0; ks < 8; ++ks) t = __builtin_amdgcn_mfma_f32_32x32x16_bf16(hf[hq & 1][ks], *(const LAS bf16x8*)(crd + 32 * ks), t, 0, 0, 0);
        if (hq < 2) {
#pragma unroll
            for (int ks = 0; ks < 8; ++ks) hf[hq & 1][ks] = *(const bf16x8*)(hp0 + (size_t)(hq + 2) * 8192 + 16 * ks); }
        const float ea = __expf(acum[hq * 128 + lrow]);
#pragma unroll
        for (int rg = 0; rg < 16; ++rg) t[rg] *= ea;
        y[hq] = t; }
    v2u zr[4][4];
#pragma unroll
    for (int hq = 0; hq < 4; ++hq)
#pragma unroll
        for (int g4 = 0; g4 < 4; ++g4) zr[hq][g4] = *(const v2u*)(PROJ + grow * NPROJ + C_Z + g * 256 + hq * 64 + ph * 32 + 8 * g4 + 4 * hi);
#pragma unroll
    for (int st = 0; st < 4; ++st) if (st <= lt) {
        f32x16 ag = (f32x16){};
        { const LAS unsigned char* brd = sl + S3_B + (32 * st + lq) * S3_PBC + 16 * hi;
#pragma unroll
          for (int ks = 0; ks < 8; ++ks) ag = __builtin_amdgcn_mfma_f32_32x32x16_bf16(*(const LAS bf16x8*)(brd + 32 * ks), *(const LAS bf16x8*)(crd + 32 * ks), ag, 0, 0, 0); }
#pragma unroll
        for (int hq = 0; hq < 4; ++hq) {
            const float al = acum[hq * 128 + lrow], dd = dsk[4 * g + hq] / dts[hq * 128 + lrow];
            const LAS unsigned char* xb = sl + S3_X + (4 * hi + q) * S3_PX + (hq * 64 + ph * 32 + 16 * dsel + 4 * pp) * 2;
            float pm[16];
#pragma unroll
            for (int g4 = 0; g4 < 4; ++g4) { const f32x4 as4 = *(const LAS f32x4*)(acum + hq * 128 + 32 * st + 8 * g4 + 4 * hi);
#pragma unroll
                for (int e = 0; e < 4; ++e) { const int rg = 4 * g4 + e; float v = ag[rg] * __expf(al - as4[e]);
                    if (st == lt) { const int sl_ = 8 * g4 + 4 * hi + e; if (sl_ > lq) v = 0.f; if (sl_ == lq) v += dd; }
                    pm[rg] = v; } }
#pragma unroll
            for (int ks = 0; ks < 2; ++ks) { v4u wv; wv.x = pg8::cvt_pk_bf16(pm[8 * ks + 0], pm[8 * ks + 1]); wv.y = pg8::cvt_pk_bf16(pm[8 * ks + 2], pm[8 * ks + 3]); wv.z = pg8::cvt_pk_bf16(pm[8 * ks + 4], pm[8 * ks + 5]); wv.w = pg8::cvt_pk_bf16(pm[8 * ks + 6], pm[8 * ks + 7]);
                const bf16x8 xt = tr_pair(xb + (32 * st + 16 * ks) * S3_PX, xb + (32 * st + 16 * ks + 8) * S3_PX);
                y[hq] = __builtin_amdgcn_mfma_f32_32x32x16_bf16(xt, __builtin_bit_cast(bf16x8, wv), y[hq], 0, 0, 0); }
        }
    }
    unsigned ayp[4][8]; float ss = 0.f;
#pragma unroll
    for (int hq = 0; hq < 4; ++hq)
#pragma unroll
        for (int g4 = 0; g4 < 4; ++g4) { const v2u z = zr[hq][g4];
            const float y0 = y[hq][4 * g4 + 0] * siluf(bflo(z.x)), y1 = y[hq][4 * g4 + 1] * siluf(bfhi(z.x)), y2 = y[hq][4 * g4 + 2] * siluf(bflo(z.y)), y3 = y[hq][4 * g4 + 3] * siluf(bfhi(z.y));
            ss += (y0 * y0 + y1 * y1) + (y2 * y2 + y3 * y3);
            ayp[hq][2 * g4] = pg8::cvt_pk_bf16(y0, y1); ayp[hq][2 * g4 + 1] = pg8::cvt_pk_bf16(y2, y3); }
    ss += __shfl_xor(ss, 32);
    if (hi == 0) ssx[ph * 128 + lrow] = ss;
    __syncthreads();
    const float rs = 1.0f / sqrtf((ssx[lrow] + ssx[128 + lrow]) * (1.f / 256.f) + RMS_EPS);
#pragma unroll
    for (int hq = 0; hq < 4; ++hq)
#pragma unroll
        for (int g4 = 0; g4 < 4; ++g4) { const int ch = hq * 64 + ph * 32 + 8 * g4 + 4 * hi; const f32x4 gn = *(const f32x4*)(ng + g * 256 + ch);
            const unsigned p0 = ayp[hq][2 * g4], p1 = ayp[hq][2 * g4 + 1];
            v2u o; o.x = pg8::cvt_pk_bf16(bflo(p0) * rs * gn[0], bfhi(p0) * rs * gn[1]); o.y = pg8::cvt_pk_bf16(bflo(p1) * rs * gn[2], bfhi(p1) * rs * gn[3]);
            *(v2u*)(MIXED + grow * MIXW + 512 + g * 256 + ch) = o; }
}

struct Args { const float* in[20]; float* out; unsigned char* ws; int ph_lo, ph_hi, sub, pad; };
constexpr int NWAVES = 8;
constexpr int PH_PER_LAYER = 10, N_PHASES = 1 + NLAYER * PH_PER_LAYER;

#define in_x (args.in[0])
#define in_win (args.in[1])
#define in_convw (args.in[2])
#define in_convb (args.in[3])
#define in_dtb (args.in[4])
#define in_alog (args.in[5])
#define in_dsk (args.in[6])
#define in_ng (args.in[7])
#define in_scw (args.in[8])
#define in_wout (args.in[9])
#define in_ln1g (args.in[10])
#define in_ln1b (args.in[11])
#define in_rw (args.in[12])
#define in_rb (args.in[13])
#define in_wgu (args.in[14])
#define in_bgu (args.in[15])
#define in_wdn (args.in[16])
#define in_bdn (args.in[17])
#define in_ln2g (args.in[18])
#define in_ln2b (args.in[19])
#define ROPE ((float*)(args.ws + WS_ROPE))
#define WDT ((float*)(args.ws + WS_WDT))
#define ROUT ((bf16*)(args.ws + WS_ROUT))
#define WIN ((bf16*)(args.ws + WS_WIN))
#define WOUT ((bf16*)(args.ws + WS_WOUT))
#define WGU ((bf16*)(args.ws + WS_WGU))
#define WDN ((bf16*)(args.ws + WS_WDN))
#define XB ((bf16*)(args.ws + WS_XB))
#define XF ((float*)(args.ws + WS_XF))
#define XF2 ((float*)(args.ws + WS_XF2))
#define PROJ ((bf16*)(args.ws + WS_PROJ))
#define DT ((float*)(args.ws + WS_DT))
#define DTS ((float*)(args.ws + WS_DTS))
#define ACUM ((float*)(args.ws + WS_ACUM))
#define LSE ((float*)(args.ws + WS_LSE))
#define OP ((bf16*)(args.ws + WS_OP))
#define U ((bf16*)(args.ws + WS_U))
#define GB ((float*)(args.ws + WS_G))
#define ST ((float*)(args.ws + WS_ST))
#define YD ((float*)(args.ws + WS_YD))
#define MIXED ((bf16*)(args.ws + WS_MIXED))
#define MIXF ((bf16*)(args.ws + WS_MIXF))
#define TOPE ((int*)(args.ws + WS_TOPE))
#define TOPG ((float*)(args.ws + WS_TOPG))
#define ROWTOK ((int*)(args.ws + WS_ROWTOK))
#define ROWGATE ((float*)(args.ws + WS_ROWGATE))
#define HB ((bf16*)(args.ws + WS_H))
#define YB ((bf16*)(args.ws + WS_YB))
#define HIN ((bf16*)(args.ws + WS_G))
#define WGU8 ((unsigned char*)(args.ws + WS_WGU))
#define WDN8 ((unsigned char*)(args.ws + WS_WDN))
#define XB8 ((unsigned char*)(args.ws + WS_U))
#define H8 ((unsigned char*)(args.ws + WS_H))
#define YB8 ((unsigned char*)(args.ws + WS_YB))
#define WIN8 ((unsigned char*)(args.ws + WS_WGU + 128 * MiB))
#define XP8 ((unsigned char*)(args.ws + WS_WGU + 132 * MiB))
#define CDEC ((float*)(args.ws + WS_ACUM))
template <int layer>
__device__ __forceinline__ void run_layer(const Args& args, int lo, int hi, const XcdBarrier& bar) {
    extern __shared__ __attribute__((aligned(16))) unsigned char lds[];
    LAS unsigned char* ldsp = (LAS unsigned char*)lds;
    const int tid = threadIdx.x, lane = tid & 63, wave = __builtin_amdgcn_readfirstlane(tid >> 6);
    const int G = gridDim.x, bid = blockIdx.x;
    const int gw = bid * NWAVES + wave, NGW = G * NWAVES;
    gu32* ctl = (gu32*)(args.ws + WS_CTL);

#define IN(k) (lo <= (k) && (k) < hi)
#define SEAM(k) do { if (IN(k) && IN((k) + 1)) xcd_barrier(bar); } while (0)

        const int pb = 1 + layer * PH_PER_LAYER;
        const bf16* WINl = WIN + (size_t)layer * NPROJ * DM; const bf16* WOUTl = WOUT + (size_t)layer * DM * MIXW;
        const unsigned char* WGUl = WGU8 + (size_t)layer * NEXP * 2048 * DM; const unsigned char* WDNl = WDN8 + (size_t)layer * NEXP * DM * FF;
        gu32* gcnt = ctl + CW_CNT + 64 * layer;

        if (IN(pb + 0)) {
            {
              pg8::Gemm g{(const pg8::bf16_t*)XP8, (const pg8::bf16_t*)(WIN8 + (size_t)layer * 1536 * DM), MROWS, 1536, DM / 2}; pg8::StaticOrder S; S.init(MROWS, 1536, G, bid);
              pg8::EpiProj E{PROJ, NPROJ, ROPE, QSCALE, 1.0f / (SC_X * SC_WIN), 0};
              pg8::gemm_phase<pg8::EpiProj, pg8::StaticOrder, true, false, true>(ldsp + RING_OFF, g, S, E); }
            __syncthreads();
            { pg8::Gemm g{XB, WINl + (size_t)1536 * DM, MROWS, NPROJ - 1536, DM}; pg8::StaticOrder S; S.init(MROWS, NPROJ - 1536, G, bid);
              pg8::EpiProj E{PROJ, NPROJ, ROPE, QSCALE, 1.0f, 6};
              pg8::gemm_phase<pg8::EpiProj, pg8::StaticOrder, true, false>(ldsp + RING_OFF, g, S, E); }
        }
        SEAM(pb + 0);
        if (IN(pb + 1)) {
            if (args.sub & 1) attn_phase(ldsp + RING_OFF, PROJ, OP, LSE, bid, G, tid, wave, lane);
            if (args.sub & 2) { const float* cw = in_convw + (size_t)layer * 4 * 1024; const float* cb = in_convb + (size_t)layer * 1024;
              for (int un = bid; un < 512; un += G)
                  ssd_s1_unit(ldsp + RING_OFF, PROJ, DT, in_dtb + layer * 8, in_alog + layer * 8, cw, cb, ST, CDEC, un, tid, lane, wave);
              __syncthreads(); }
            const float* sw = in_scw + (size_t)layer * 3 * 512;
            if (args.sub & 4) {
                const int ch = (tid & 63) * 8;
                f32x4 wk[3][2];
#pragma unroll
                for (int k = 0; k < 3; ++k) { wk[k][0] = *(const f32x4*)(sw + k * 512 + ch); wk[k][1] = *(const f32x4*)(sw + k * 512 + ch + 4); }
#pragma unroll 1
                for (int it = bid * (NWAVES * 64) + tid; it < (MROWS / 4) * 64; it += G * (NWAVES * 64)) { const int row0 = (it >> 6) * 4; const bool head = (row0 & (SEQ - 1)) == 0;
                    v4u cc[6], hh[6], bb[4];
#pragma unroll
                    for (int i = 0; i < 6; ++i) { cc[i] = (v4u){0u, 0u, 0u, 0u}; hh[i] = cc[i];
                        if (i >= 2 || !head) { const bf16* pr = PROJ + (size_t)(row0 - 2 + i) * NPROJ; cc[i] = *(const v4u*)(pr + C_SC + ch); hh[i] = *(const v4u*)(pr + C_SH + ch); } }
#pragma unroll
                    for (int r = 0; r < 4; ++r) bb[r] = *(const v4u*)(PROJ + (size_t)(row0 + r) * NPROJ + C_SB + ch);
                    float p[6][8];
#pragma unroll
                    for (int i = 0; i < 6; ++i) { p[i][0] = bflo(cc[i].x) * bflo(hh[i].x); p[i][1] = bfhi(cc[i].x) * bfhi(hh[i].x); p[i][2] = bflo(cc[i].y) * bflo(hh[i].y); p[i][3] = bfhi(cc[i].y) * bfhi(hh[i].y);
                        p[i][4] = bflo(cc[i].z) * bflo(hh[i].z); p[i][5] = bfhi(cc[i].z) * bfhi(hh[i].z); p[i][6] = bflo(cc[i].w) * bflo(hh[i].w); p[i][7] = bfhi(cc[i].w) * bfhi(hh[i].w); }
#pragma unroll
                    for (int r = 0; r < 4; ++r) { float a[8];
#pragma unroll
                        for (int q = 0; q < 8; ++q) a[q] = wk[0][q >> 2][q & 3] * p[r][q] + wk[1][q >> 2][q & 3] * p[r + 1][q] + wk[2][q >> 2][q & 3] * p[r + 2][q];
                        const v4u b4 = bb[r];
                        v4u o; o.x = pk2(a[0] * bflo(b4.x), a[1] * bfhi(b4.x)); o.y = pk2(a[2] * bflo(b4.y), a[3] * bfhi(b4.y)); o.z = pk2(a[4] * bflo(b4.z), a[5] * bfhi(b4.z)); o.w = pk2(a[6] * bflo(b4.w), a[7] * bfhi(b4.w));
                        *(v4u*)(MIXED + (size_t)(row0 + r) * MIXW + 1024 + ch) = o; } }
            }
        }
        SEAM(pb + 1);
        if (IN(pb + 2)) {
            for (int it = bid * (NWAVES * 64) + tid; it < (int)(64L * 2048); it += G * (NWAVES * 64)) { const int pn4 = (int)(it & 2047), bh = (int)(it >> 11); const int h = bh & 7, b = bh >> 3; f32x4 hc = (f32x4){0.f, 0.f, 0.f, 0.f};
#pragma unroll 16
                for (int c = 0; c < 32; ++c) { const size_t idx = ((size_t)((b * 32 + c) * 8 + h)) * 8192 + pn4 * 4; const f32x4 st = *(const f32x4*)(ST + idx);
                    v2u o; o.x = pk2(hc[0], hc[1]); o.y = pk2(hc[2], hc[3]); *(v2u*)(HIN + idx) = o;
                    hc = hc * CDEC[(size_t)(b * 32 + c) * 8 + h] + st; } }
        }
        SEAM(pb + 2);
        if (IN(pb + 3)) {
            if (args.sub & 1) { const float* cw = in_convw + (size_t)layer * 4 * 1024; const float* cb = in_convb + (size_t)layer * 1024;
              for (int un = bid; un < 512; un += G)
                  ssd_s3_unit(ldsp + RING_OFF, PROJ, DT, in_dtb + layer * 8, in_alog + layer * 8, cw, cb, in_dsk + layer * 8, in_ng + (size_t)layer * 512, HIN, MIXED, un, tid, lane, wave);
              __syncthreads(); }
            if (args.sub & 2)
#pragma unroll 2
            for (int it = bid * (NWAVES * 64) + tid; it < (int)((long)MROWS * 32); it += G * (NWAVES * 64)) { const int c16 = (int)(it & 31), row = (int)(it >> 5); const int h = c16 >> 2;
                const float l0 = LSE[((size_t)0 * MROWS + row) * 8 + h], l1 = LSE[((size_t)1 * MROWS + row) * 8 + h], l2 = LSE[((size_t)2 * MROWS + row) * 8 + h];
                const float mm = fmaxf(l0, fmaxf(l1, l2)); float w0 = exp2f(l0 - mm), w1 = exp2f(l1 - mm), w2 = exp2f(l2 - mm); const float iw = (1.0f / SC_O) / (w0 + w1 + w2); w0 *= iw; w1 *= iw; w2 *= iw;
                const unsigned char* OP8 = (const unsigned char*)OP; typedef float f32x2_ __attribute__((ext_vector_type(2)));
                const v4u a0 = *(const v4u*)(OP8 + ((size_t)0 * MROWS + row) * 512 + c16 * 16), a1 = *(const v4u*)(OP8 + ((size_t)1 * MROWS + row) * 512 + c16 * 16), a2 = *(const v4u*)(OP8 + ((size_t)2 * MROWS + row) * 512 + c16 * 16);
                unsigned ow[8];
#pragma unroll
                for (int q = 0; q < 4; ++q) {
                    { const f32x2_ p0 = __builtin_amdgcn_cvt_pk_f32_fp8(a0[q], false), p1 = __builtin_amdgcn_cvt_pk_f32_fp8(a1[q], false), p2 = __builtin_amdgcn_cvt_pk_f32_fp8(a2[q], false); ow[2 * q] = pk2(w0 * p0[0] + w1 * p1[0] + w2 * p2[0], w0 * p0[1] + w1 * p1[1] + w2 * p2[1]); }
                    { const f32x2_ p0 = __builtin_amdgcn_cvt_pk_f32_fp8(a0[q], true), p1 = __builtin_amdgcn_cvt_pk_f32_fp8(a1[q], true), p2 = __builtin_amdgcn_cvt_pk_f32_fp8(a2[q], true); ow[2 * q + 1] = pk2(w0 * p0[0] + w1 * p1[0] + w2 * p2[0], w0 * p0[1] + w1 * p1[1] + w2 * p2[1]); } }
                bf16* op_ = MIXED + (size_t)row * MIXW + c16 * 16;
                *(v4u*)op_ = (v4u){ow[0], ow[1], ow[2], ow[3]}; *(v4u*)(op_ + 8) = (v4u){ow[4], ow[5], ow[6], ow[7]}; }
        }
        SEAM(pb + 3);
        if (IN(pb + 4)) {
#define FUSED_LN1_CALL(BASE, LIM) { pg8::Gemm g{MIXED, WOUTl, MROWS, DM, MIXW}; \
              pg8::EpiLn1 E{args.ws, in_ln1g + (size_t)layer * DM, in_ln1b + (size_t)layer * DM, WS_XB, WS_U, (layer ? WS_ROPE : WS_DTS), WS_CTL + (size_t)(CW_SEAM + layer * 8192) * 4, WS_CTL + (size_t)CW_TMO * 4, ALPHA, SC_X, LN_EPS, 0x700u + (unsigned)layer * 0x80u}; \
              pg8::StaticOrder S; S.init(MROWS, DM, G, bid); S.base = (BASE); S.lim = (LIM); \
              pg8::gemm_phase<pg8::EpiLn1, pg8::StaticOrder, false, false>(ldsp + RING_OFF, g, S, E); }
            FUSED_LN1_CALL(0, 256)
            __syncthreads();
            FUSED_LN1_CALL(256, 512)
            __syncthreads();
#undef FUSED_LN1_CALL
        }
        SEAM(pb + 4);
        if (IN(pb + 6)) {
            LAS int* lcnt = (LAS int*)(ldsp + L_LCNT); LAS int* lbase = (LAS int*)(ldsp + L_LBASE);
            const bf16* RT = ROUT + (size_t)layer * NEXP * DM; const float* rb = in_rb + (size_t)layer * NEXP;
            for (int blk = bid; blk < MROWS / 128; blk += G) {
                if (tid < 32) lcnt[tid] = 0;
                __syncthreads();
                const int r32 = lane & 31, hi = lane >> 5; const int row = blk * 128 + (wave & 3) * 32 + r32;
                float tv[4]; int te[4]; int lrank[4]; float gate[4];
                f32x16 acc = {};
                { const int kh = wave >> 2;
                  const bf16* ap = RT + (size_t)r32 * DM + 8 * hi + 512 * kh; const bf16* bp = XB + (size_t)row * DM + 8 * hi + 512 * kh;
#pragma unroll 16
                  for (int s = 0; s < 32; ++s) { const bf16x8 a = *(const bf16x8*)(ap + 16 * s), b = *(const bf16x8*)(bp + 16 * s); acc = __builtin_amdgcn_mfma_f32_32x32x16_bf16(a, b, acc, 0, 0, 0); }
                  LAS float* part = (LAS float*)(ldsp + RING_OFF) + (wave & 3) * 1024;
                  if (kh) {
#pragma unroll
                      for (int i = 0; i < 16; ++i) part[i * 64 + lane] = acc[i]; }
                  __syncthreads();
                  if (!kh) {
#pragma unroll
                      for (int i = 0; i < 16; ++i) acc[i] += part[i * 64 + lane]; } }
                if (wave < 4) {
#pragma unroll
                    for (int k = 0; k < 4; ++k) { tv[k] = -INFINITY; te[k] = 1 << 20; }
#pragma unroll
                    for (int i = 0; i < 16; ++i) { const int e = (i & 3) + 8 * (i >> 2) + 4 * hi; float v = acc[i] + rb[e]; int ve = e;
#pragma unroll
                        for (int k = 0; k < 4; ++k) { const bool gt = (v > tv[k]) || (v == tv[k] && ve < te[k]); const float nv = gt ? tv[k] : v; const int ne = gt ? te[k] : ve; tv[k] = gt ? v : tv[k]; te[k] = gt ? ve : te[k]; v = nv; ve = ne; } }
                    float pv[4]; int pe[4];
#pragma unroll
                    for (int k = 0; k < 4; ++k) { pv[k] = __shfl_xor(tv[k], 32); pe[k] = __shfl_xor(te[k], 32); }
#pragma unroll
                    for (int j = 0; j < 4; ++j) { float v = pv[j]; int ve = pe[j];
#pragma unroll
                        for (int k = 0; k < 4; ++k) { const bool gt = (v > tv[k]) || (v == tv[k] && ve < te[k]); const float nv = gt ? tv[k] : v; const int ne = gt ? te[k] : ve; tv[k] = gt ? v : tv[k]; te[k] = gt ? ve : te[k]; v = nv; ve = ne; } }
                    float se = 0.f;
#pragma unroll
                    for (int k = 0; k < 4; ++k) { gate[k] = __expf(tv[k] - tv[0]); se += gate[k]; }
                    const float ise = 1.0f / se;
#pragma unroll
                    for (int k = 0; k < 4; ++k) gate[k] *= ise;
                    if (hi == 0) {
#pragma unroll
                        for (int k = 0; k < 4; ++k) lrank[k] = __hip_atomic_fetch_add(lcnt + te[k], 1, __ATOMIC_RELAXED, __HIP_MEMORY_SCOPE_WORKGROUP);
                    }
                }
                __syncthreads();
                if (tid < 32) lbase[tid] = (int)__hip_atomic_fetch_add(gcnt + tid, (unsigned)lcnt[tid], RLX_AGENT);
                __syncthreads();
                if (wave < 4 && hi == 0) {
#pragma unroll
                    for (int k = 0; k < 4; ++k) { const int r = lbase[te[k]] + lrank[k]; const size_t o = (size_t)te[k] * 32768 + r;
                        ROWTOK[o] = row * 4 + k; ROWGATE[o] = gate[k]; }
                }
                __syncthreads();
            }
        }
        SEAM(pb + 6);
        if (IN(pb + 7) || IN(pb + 8)) {
            LAS int* tstart = (LAS int*)(ldsp + L_TSTART); LAS int* cntL = (LAS int*)(ldsp + L_CNT); LAS int* units = (LAS int*)(ldsp + L_UNITS); LAS int* unitsn = (LAS int*)(ldsp + L_UNITSN);
            if (tid < 64) {
                const int c = (tid < 32) ? (int)__hip_atomic_load(gcnt + tid, RLX_AGENT) : 0; const int t = (c + 255) >> 8; int incl = t;
#pragma unroll
                for (int d = 1; d < 32; d <<= 1) { const int v = __shfl_up(incl, d); if (tid >= d) incl += v; }
                if (tid < 32) { cntL[tid] = c; tstart[tid] = incl - t; }
                if (tid == 31) tstart[32] = incl; }
            __syncthreads();
            if (IN(pb + 7)) {
                pg8::moe_build_units(units, unitsn, tstart, 8, G, bid, tid);
                __syncthreads();
                pg8::Gemm g{(const pg8::bf16_t*)XB8, (const pg8::bf16_t*)WGUl, 0, 2048, DM / 2};
                pg8::MoeOrder S{units, __builtin_amdgcn_readfirstlane(unitsn[0]), cntL, ROWTOK, 1, (unsigned)DM, (size_t)2048 * DM, ROWGATE, in_bgu + (size_t)layer * NEXP * 2048};
                pg8::EpiSwiglu E{H8, in_bgu + (size_t)layer * NEXP * 2048, ROWGATE, cntL, 1.0f / (SC_X * SC_WGU), SC_H};
                pg8::gemm_phase<pg8::EpiSwiglu, pg8::MoeOrder, true, true, true>(ldsp + RING_OFF, g, S, E);
                __syncthreads();
            }
            SEAM(pb + 7);
            if (IN(pb + 8)) {
                pg8::moe_build_units(units, unitsn, tstart, 4, G, bid, tid);
                __syncthreads();
                pg8::Gemm g{(const pg8::bf16_t*)H8, (const pg8::bf16_t*)WDNl, 0, DM, FF / 2};
                pg8::MoeOrder S{units, __builtin_amdgcn_readfirstlane(unitsn[0]), cntL, ROWTOK, 0, (unsigned)FF, (size_t)DM * FF, ROWGATE, in_bdn + (size_t)layer * NEXP * DM};
                pg8::EpiScatter E{YB8, ROWTOK, cntL, SC_Y / (SC_H * SC_WDN), SC_Y};
                pg8::gemm_phase<pg8::EpiScatter, pg8::MoeOrder, true, false, true, true>(ldsp + RING_OFF, g, S, E);
                __syncthreads();
            }
        }
        SEAM(pb + 8);
        if (IN(pb + 9)) {
            constexpr bool NEXT = (layer + 1 < NLAYER);
            const float* gam = in_ln2g + (size_t)layer * DM; const float* bet = in_ln2b + (size_t)layer * DM;
            f32x4 gq[4], bq[4], wq[8][4];
#pragma unroll
            for (int q = 0; q < 4; ++q) { gq[q] = *(const f32x4*)(gam + 16 * lane + 4 * q); bq[q] = *(const f32x4*)(bet + 16 * lane + 4 * q); }
            if (NEXT) {
#pragma unroll
                for (int jj = 0; jj < 8; ++jj)
#pragma unroll
                    for (int q = 0; q < 4; ++q) wq[jj][q] = *(const f32x4*)(WDT + (size_t)(layer + 1) * 8 * 1024 + jj * 1024 + 16 * lane + 4 * q); }
            v4u nx0, nx1, ny[4];
            constexpr bool PF = !NEXT;
            if (PF && gw < MROWS) { nx0 = *(const v4u*)(XB + (size_t)gw * DM + 16 * lane); nx1 = *(const v4u*)(XB + (size_t)gw * DM + 16 * lane + 8);
#pragma unroll
                for (int k = 0; k < 4; ++k) ny[k] = *(const v4u*)(YB8 + ((size_t)gw * 4 + k) * DM + 16 * lane); }
#pragma unroll 1
            for (int m = gw; m < MROWS; m += NGW) {
                if (!PF) { nx0 = *(const v4u*)(XB + (size_t)m * DM + 16 * lane); nx1 = *(const v4u*)(XB + (size_t)m * DM + 16 * lane + 8);
#pragma unroll
                    for (int k = 0; k < 4; ++k) ny[k] = *(const v4u*)(YB8 + ((size_t)m * 4 + k) * DM + 16 * lane); }
                const v4u x0 = nx0, x1 = nx1; v4u yk[4];
#pragma unroll
                for (int k = 0; k < 4; ++k) yk[k] = ny[k];
                if (PF && m + NGW < MROWS) { const int mn = m + NGW; nx0 = *(const v4u*)(XB + (size_t)mn * DM + 16 * lane); nx1 = *(const v4u*)(XB + (size_t)mn * DM + 16 * lane + 8);
#pragma unroll
                    for (int k = 0; k < 4; ++k) ny[k] = *(const v4u*)(YB8 + ((size_t)mn * 4 + k) * DM + 16 * lane); }
                f32x4 v[4];
                v[0] = (f32x4){bflo(x0.x), bfhi(x0.x), bflo(x0.y), bfhi(x0.y)} * ALPHA; v[1] = (f32x4){bflo(x0.z), bfhi(x0.z), bflo(x0.w), bfhi(x0.w)} * ALPHA;
                v[2] = (f32x4){bflo(x1.x), bfhi(x1.x), bflo(x1.y), bfhi(x1.y)} * ALPHA; v[3] = (f32x4){bflo(x1.z), bfhi(x1.z), bflo(x1.w), bfhi(x1.w)} * ALPHA;
#pragma unroll
                for (int k = 0; k < 4; ++k)
#pragma unroll
                    for (int q = 0; q < 4; ++q) { typedef float f32x2_ __attribute__((ext_vector_type(2)));
                        const f32x2_ lo = __builtin_amdgcn_cvt_pk_f32_fp8(yk[k][q], false), hi = __builtin_amdgcn_cvt_pk_f32_fp8(yk[k][q], true);
                        v[q][0] += lo[0] * (1.0f / SC_Y); v[q][1] += lo[1] * (1.0f / SC_Y); v[q][2] += hi[0] * (1.0f / SC_Y); v[q][3] += hi[1] * (1.0f / SC_Y); }
                float s = 0.f;
#pragma unroll
                for (int q = 0; q < 4; ++q) s += (v[q][0] + v[q][1]) + (v[q][2] + v[q][3]);
                const float mean = wave_sum(s) * (1.f / DM); float s2 = 0.f;
#pragma unroll
                for (int q = 0; q < 4; ++q) { v[q] = v[q] - mean; s2 += (v[q][0] * v[q][0] + v[q][1] * v[q][1]) + (v[q][2] * v[q][2] + v[q][3] * v[q][3]); }
                const float rstd = 1.f / sqrtf(wave_sum(s2) * (1.f / DM) + LN_EPS);
#pragma unroll
                for (int q = 0; q < 4; ++q) { v[q] = v[q] * rstd * gq[q] + bq[q];
                    if (!NEXT) *(f32x4*)(args.out + (size_t)m * DM + 16 * lane + 4 * q) = v[q]; }
                if (NEXT) {
                    v4u w0, w1; w0.x = pk2(v[0][0], v[0][1]); w0.y = pk2(v[0][2], v[0][3]); w0.z = pk2(v[1][0], v[1][1]); w0.w = pk2(v[1][2], v[1][3]);
                    w1.x = pk2(v[2][0], v[2][1]); w1.y = pk2(v[2][2], v[2][3]); w1.z = pk2(v[3][0], v[3][1]); w1.w = pk2(v[3][2], v[3][3]);
                    *(v4u*)(XB + (size_t)m * DM + 16 * lane) = w0; *(v4u*)(XB + (size_t)m * DM + 16 * lane + 8) = w1;
                    v4u w; w.x = pg8::pk4_fp8(v[0][0] * SC_X, v[0][1] * SC_X, v[0][2] * SC_X, v[0][3] * SC_X); w.y = pg8::pk4_fp8(v[1][0] * SC_X, v[1][1] * SC_X, v[1][2] * SC_X, v[1][3] * SC_X);
                    w.z = pg8::pk4_fp8(v[2][0] * SC_X, v[2][1] * SC_X, v[2][2] * SC_X, v[2][3] * SC_X); w.w = pg8::pk4_fp8(v[3][0] * SC_X, v[3][1] * SC_X, v[3][2] * SC_X, v[3][3] * SC_X);
                    *(v4u*)(XP8 + (size_t)m * DM + 16 * lane) = w;
                    float r[8];
#pragma unroll
                    for (int jj = 0; jj < 8; ++jj) { float sd = 0.f;
#pragma unroll
                        for (int q = 0; q < 4; ++q) sd += v[q][0] * wq[jj][q][0] + v[q][1] * wq[jj][q][1] + v[q][2] * wq[jj][q][2] + v[q][3] * wq[jj][q][3];
                        r[jj] = wave_sum(sd); }
                    if (lane == 0) { float* dst = DT + (size_t)m * 8; *(f32x4*)dst = (f32x4){r[0], r[1], r[2], r[3]}; *(f32x4*)(dst + 4) = (f32x4){r[4], r[5], r[6], r[7]}; } }
            }
        }
        SEAM(pb + 9);
    #undef IN
#undef SEAM
}

__global__ void __launch_bounds__(NWAVES * 64, 2) mk_fwd(Args args) {
    extern __shared__ __attribute__((aligned(16))) unsigned char lds[];
    LAS unsigned char* ldsp = (LAS unsigned char*)lds;
    const int tid = threadIdx.x, lane = tid & 63, wave = __builtin_amdgcn_readfirstlane(tid >> 6);
    const int G = gridDim.x, bid = blockIdx.x;
    const int gw = bid * NWAVES + wave, NGW = G * NWAVES;
    gu32* ctl = (gu32*)(args.ws + WS_CTL);

    for (int u = tid; u < (LDS_BYTES - LDSCTL_OFF) / 4; u += NWAVES * 64) ((LAS unsigned*)(ldsp + LDSCTL_OFF))[u] = 0u;
    __syncthreads();
    XcdBarrier bar = xcd_barrier_post((unsigned*)(ctl + CW_BAR), (volatile LAS unsigned*)(ldsp + L_MISC) + 8);

    const int lo = args.ph_lo, hi = args.ph_hi;
#define IN(k) (lo <= (k) && (k) < hi)
#define SEAM(k) do { if (IN(k) && IN((k) + 1)) xcd_barrier(bar); } while (0)

    if (IN(0)) {
        LAS float* scr = (LAS float*)(ldsp + RING_OFF + wave * 16384);
        constexpr int I_IN = 16 * 73, I_OUT = 24 * 16, I_R = 16;
        constexpr int NIT = NLAYER * (I_IN + I_OUT + I_R);
        for (int it = gw; it < NIT; it += NGW) {
            int r = it;
            if (r < NLAYER * I_IN) { const int l = r / I_IN; r %= I_IN; p0_transpose_item64<1>(in_win + (size_t)l * DM * INW, DM, INW, WIN + (size_t)l * NPROJ * DM, WDT + (size_t)l * 8 * 1024, scr, r / 73, r % 73, lane); continue; } r -= NLAYER * I_IN;
            if (r < NLAYER * I_OUT) { const int l = r / I_OUT; r %= I_OUT; p0_transpose_item64<0>(in_wout + (size_t)l * MIXW * DM, MIXW, DM, WOUT + (size_t)l * DM * MIXW, nullptr, scr, r / 16, r % 16, lane); continue; } r -= NLAYER * I_OUT;
            { const int l = r / I_R; r %= I_R; p0_transpose_item<0>(in_rw + (size_t)l * DM * NEXP, DM, NEXP, ROUT + (size_t)l * NEXP * DM, nullptr, scr, r, 0, lane); }
        }
        { constexpr int NIT8 = 64 * 256 + 64 * 128 + NLAYER * 192;
          const int nmine = (gw < NIT8) ? (NIT8 - gw + NGW - 1) / NGW : 0; const int J = 2 * nmine;
          f32x4 lda[16], ldb[16];
          if (J > 0) { const SubT t = fp8_subtile(gw, 0, in_wgu, in_wdn, in_win, WGU8, WDN8, WIN8, lane); fp8_sub_load(t, lda); }
#pragma unroll 1
          for (int j = 0; j < J; j += 2) {
              const int item = gw + (j >> 1) * NGW;
              const SubT t0 = fp8_subtile(item, 0, in_wgu, in_wdn, in_win, WGU8, WDN8, WIN8, lane), t1 = fp8_subtile(item, 1, in_wgu, in_wdn, in_win, WGU8, WDN8, WIN8, lane);
              fp8_sub_load(t1, ldb);
              fp8_sub_process(t0, lda, scr, lane);
              if (j + 2 < J) { const SubT t2 = fp8_subtile(item + NGW, 0, in_wgu, in_wdn, in_win, WGU8, WDN8, WIN8, lane); fp8_sub_load(t2, lda); }
              fp8_sub_process(t1, ldb, scr, lane);
          } }
        __syncthreads();
    }
    if (IN(0)) {
        f32x4 wq[8][4];
#pragma unroll
        for (int j = 0; j < 4; ++j)
#pragma unroll
            for (int e = 0; e < 4; ++e) { const float* wp = in_win + (size_t)(4 * lane + 256 * j + e) * INW + 3072; const f32x4 w0 = *(const f32x4*)wp, w1 = *(const f32x4*)(wp + 4);
                wq[0][j][e] = w0[0]; wq[1][j][e] = w0[1]; wq[2][j][e] = w0[2]; wq[3][j][e] = w0[3]; wq[4][j][e] = w1[0]; wq[5][j][e] = w1[1]; wq[6][j][e] = w1[2]; wq[7][j][e] = w1[3]; }
        f32x4 nv[4];
        if (gw < MROWS) {
#pragma unroll
            for (int j = 0; j < 4; ++j) nv[j] = *(const f32x4*)(in_x + (size_t)gw * DM + 4 * lane + 256 * j); }
#pragma unroll 1
        for (int m = gw; m < MROWS; m += NGW) { bf16* ob = XB + (size_t)m * DM; f32x4 v[4];
#pragma unroll
            for (int j = 0; j < 4; ++j) v[j] = nv[j];
            if (m + NGW < MROWS) {
#pragma unroll
                for (int j = 0; j < 4; ++j) nv[j] = *(const f32x4*)(in_x + (size_t)(m + NGW) * DM + 4 * lane + 256 * j); }
#pragma unroll
            for (int j = 0; j < 4; ++j) { v2u w; w.x = pk2(v[j][0], v[j][1]); w.y = pk2(v[j][2], v[j][3]); *(v2u*)(ob + 4 * lane + 256 * j) = w;
                *(unsigned*)(XP8 + (size_t)m * DM + 4 * lane + 256 * j) = pg8::pk4_fp8(v[j][0] * SC_X, v[j][1] * SC_X, v[j][2] * SC_X, v[j][3] * SC_X); }
            row_dt_w(v, wq, DT + (size_t)m * 8, lane); }
    }

    SEAM(0);
    run_layer<0>(args, lo, hi, bar);
    run_layer<1>(args, lo, hi, bar);
#undef IN
#undef SEAM
}

extern "C" void kernel_launch(void* const* d_in, const int* in_sizes, int n_in, void* d_out, int out_size, void* d_ws, size_t ws_size, hipStream_t stream) {
    static int grid = 0;
    if (grid == 0) {
        if (n_in != 20 || out_size != MROWS * DM || ws_size < WS_END) { fprintf(stderr, "kernel_launch: unexpected problem (n_in %d, out %d, ws %zu)\n", n_in, out_size, ws_size); grid = -1; return; }
        if (hipFuncSetAttribute((const void*)mk_fwd, hipFuncAttributeMaxDynamicSharedMemorySize, LDS_BYTES) != hipSuccess) { fprintf(stderr, "kernel_launch: hipFuncSetAttribute failed\n"); grid = -1; return; }
        int dev = 0, cus = 0, per_cu = 0;
        (void)hipGetDevice(&dev); (void)hipDeviceGetAttribute(&cus, hipDeviceAttributeMultiprocessorCount, dev);
        if (hipOccupancyMaxActiveBlocksPerMultiprocessor(&per_cu, (const void*)mk_fwd, NWAVES * 64, LDS_BYTES) != hipSuccess || per_cu < 1) fprintf(stderr, "kernel_launch: occupancy query says %d\n", per_cu);
        (void)hipGetLastError();
        grid = cus > 0 ? cus : 256;
    }
    if (grid < 0) return;
    (void)hipMemsetAsync((char*)d_ws + WS_CTL, 0, CTL_ZERO_BYTES, stream);
    Args a{};
    for (int i = 0; i < 20; ++i) a.in[i] = (const float*)d_in[i];
    a.out = (float*)d_out; a.ws = (unsigned char*)d_ws;
    a.ph_lo = 0; a.ph_hi = N_PHASES; a.sub = 7; a.pad = 0;
    hipLaunchKernelGGL(mk_fwd, dim3(grid), dim3(NWAVES * 64), LDS_BYTES, stream, a);
#ifdef PROBE_PH
#ifndef PROBE_SUB
#define PROBE_SUB 7
#endif
    for (int i = 0; i < PROBE_N; ++i) { a.ph_lo = PROBE_PH; a.ph_hi = PROBE_PH + 1; a.sub = PROBE_SUB; hipLaunchKernelGGL(mk_fwd, dim3(grid), dim3(NWAVES * 64), LDS_BYTES, stream, a); }
#endif
}
```

```cpp
#include <hip/hip_runtime.h>
#include <cstdio>
#include <cstdint>
#include <cmath>

namespace pg8 {
#define PG8_LAS __attribute__((address_space(3)))
typedef unsigned short bf16_t;
typedef short bf16x8 __attribute__((ext_vector_type(8)));
typedef float f32x4 __attribute__((ext_vector_type(4)));
typedef float f32x2 __attribute__((ext_vector_type(2)));
typedef unsigned u32x4 __attribute__((ext_vector_type(4)));
constexpr int BM = 256, BK = 64, HALF = 128, HTB = HALF * BK * 2  , STAGE_BYTES = 8 * HTB, NXCD = 8, WGM = 8;

__host__ __device__ __forceinline__ int lds_byte(int r, int c) { const int st = (r >> 4) * 2 + (c >> 5), rr = r & 15, cc = c & 31, ob = rr * 64 + cc * 2; return st * 1024 + (ob ^ (((ob >> 9) & 1) << 5)); }
__host__ __device__ __forceinline__ void stage_rc(int b, int& R, int& C) { const int st = b / 1024, sb = b % 1024, swz = sb ^ (((sb >> 9) & 1) << 5); R = (st >> 1) * 16 + swz / 64; C = (st & 1) * 32 + (swz % 64) / 2; }
__host__ __device__ __forceinline__ int perm32(int rho) { const int n = rho >> 4, i = rho & 15; return 8 * (i >> 2) + 4 * n + (i & 3); }

struct Unit { int pm, pn, e, r0; };
struct Gemm { const bf16_t* A; const bf16_t* Bt; int M, N, K; };

struct StaticOrder {
    int nM, nN, nwg, G, c, base, lim;
    __device__ void init(int M, int N, int G_, int c_) { nM = M / BM; nN = N / BM; nwg = nM * nN; G = G_; c = c_; base = 0; lim = nwg; }
    __device__ __forceinline__ bool next(int i, Unit& u) const {
        const long L = (long)i * G + c + base; if (L >= lim) return false;
        int wgid = (int)L; { const int q = nwg / NXCD, r = nwg % NXCD, xcd = wgid % NXCD, off = wgid / NXCD; wgid = (xcd < r ? xcd * (q + 1) : r * (q + 1) + (xcd - r) * q) + off; }
        const int nig = WGM * nN, gid = wgid / nig, fm = gid * WGM, gsz = (nM - fm) < WGM ? (nM - fm) : WGM;
        u.pm = fm + ((wgid % nig) % gsz); u.pn = (wgid % nig) / gsz; u.e = 0; u.r0 = 0; return true;
    }
    __device__ __forceinline__ const char* abase(const Unit& u, const Gemm& g, size_t tstep) const { return (const char*)g.A + (size_t)u.pm * tstep; }
    __device__ __forceinline__ const char* bbase(const Unit& u, const Gemm& g, size_t tstep) const { return (const char*)g.Bt + (size_t)u.pn * tstep; }
    static constexpr bool SIDE = false;
    __device__ __forceinline__ unsigned arow(const Unit&, int) const { return 0u; }
    __device__ __forceinline__ unsigned arow_side(const Unit&, int, const PG8_LAS unsigned char*) const { return 0u; }
    __device__ __forceinline__ const void* side_src(const Unit&, const Unit&, int, int) const { return nullptr; }
    __device__ __forceinline__ void a_ready(const Unit&) const {}
    __device__ __forceinline__ void done(const Unit&) const {}
};

struct MoeOrder {
    const PG8_LAS int* units;
    int nunits;
    const PG8_LAS int* cnt;
    const int* rowtok;
    int gather;
    unsigned rowbytes;
    size_t bstride;
    __device__ __forceinline__ bool next(int i, Unit& u) const {
        if (i >= nunits) return false;
        u.pm = __builtin_amdgcn_readfirstlane(units[4 * i + 0]); u.pn = __builtin_amdgcn_readfirstlane(units[4 * i + 1]);
        u.e = __builtin_amdgcn_readfirstlane(units[4 * i + 2]); u.r0 = __builtin_amdgcn_readfirstlane(units[4 * i + 3]); return true;
    }
    __device__ __forceinline__ const char* abase(const Unit& u, const Gemm& g, size_t tstep) const { return gather ? (const char*)g.A : (const char*)g.A + (size_t)u.pm * tstep; }
    __device__ __forceinline__ const char* bbase(const Unit& u, const Gemm& g, size_t tstep) const { return (const char*)g.Bt + (size_t)u.e * bstride + (size_t)u.pn * tstep; }
    static constexpr bool SIDE = true;
    const float* rowgate; const float* bgu;
    __device__ __forceinline__ unsigned arow(const Unit& u, int R) const {
        const int r = u.r0 + R; const int idx = (r < cnt[u.e]) ? rowtok[(size_t)u.e * 32768 + r] : 0; return (unsigned)(idx >> 2) * rowbytes; }
    __device__ __forceinline__ unsigned arow_side(const Unit& u, int R, const PG8_LAS unsigned char* sd) const {
        const int r = u.r0 + R; const int v = ((const PG8_LAS int*)sd)[R]; const int idx = (r < cnt[u.e]) ? v : 0; return (unsigned)(idx >> 2) * rowbytes; }
    __device__ __forceinline__ const void* side_src(const Unit& cur, const Unit& rt, int wid, int lane) const {
        if (rowgate != nullptr && wid == 1) return rowgate + (size_t)cur.e * 32768 + cur.r0 + 4 * lane;
        if (bgu != nullptr && wid == 2) return gather ? (bgu + (size_t)cur.e * 2048 + (lane < 32 ? 0 : 1024 - 128) + cur.pn * 128 + 4 * lane)
                                                      : (bgu + (size_t)cur.e * 1024 + cur.pn * 256 + 4 * lane);
        return rowtok + (size_t)rt.e * 32768 + rt.r0 + 4 * lane; }
    __device__ __forceinline__ void a_ready(const Unit&) const {}
    __device__ __forceinline__ void done(const Unit&) const {}
};
__device__ __forceinline__ void moe_build_units(PG8_LAS int* units, PG8_LAS int* units_n, const PG8_LAS int* tstart, int nN, int G, int c, int tid) {
    if (tid < 64) {
        const int nT = tstart[32], nwg = nT * nN; const long L = (long)tid * G + c;
        int pm = 0, pn = 0, e = 0, r0 = 0;
        if (L < nwg) {
            int wgid = (int)L; { const int q = nwg / NXCD, r = nwg % NXCD, xcd = wgid % NXCD, off = wgid / NXCD; wgid = (xcd < r ? xcd * (q + 1) : r * (q + 1) + (xcd - r) * q) + off; }
            const int nig = WGM * nN, gid = wgid / nig, fm = gid * WGM, gsz = (nT - fm) < WGM ? (nT - fm) : WGM;
            pm = fm + ((wgid % nig) % gsz); pn = (wgid % nig) / gsz;
            for (int j = 1; j < 32; ++j) e += (tstart[j] <= pm) ? 1 : 0;
            r0 = (pm - tstart[e]) * 256;
        }
        units[4 * tid + 0] = pm; units[4 * tid + 1] = pn; units[4 * tid + 2] = e; units[4 * tid + 3] = r0;
        if (tid == 0) { int n = 0; if (c < nwg) n = (nwg - c + G - 1) / G; units_n[0] = n < 64 ? n : 64; }
    }
}

__host__ __device__ __forceinline__ unsigned hblk_off(int R, int p7) { const int ai = R >> 7, wr = (R >> 6) & 1, m = (R >> 4) & 3, fr = R & 15, wc = p7 >> 1, fq = ((p7 & 1) << 1) | (m & 1), mp = m >> 1;
    return (unsigned)(((((ai * 2 + wr) * 4 + wc) * 2 + mp) * 64 + fr + 16 * fq) * 16); }
typedef int v8i_t __attribute__((ext_vector_type(8)));
typedef int v4i_t __attribute__((ext_vector_type(4)));
__device__ __forceinline__ v8i_t cat8(bf16x8 lo, bf16x8 hi) { const v4i_t a = __builtin_bit_cast(v4i_t, lo), b = __builtin_bit_cast(v4i_t, hi); return __builtin_shufflevector(a, b, 0, 1, 2, 3, 4, 5, 6, 7); }
__device__ __forceinline__ void mfma8(f32x4& acc, v8i_t a, v8i_t b, int scl) { asm volatile("v_mfma_scale_f32_16x16x128_f8f6f4 %0, %1, %2, %0, %3, %3 op_sel_hi:[0,0,0]" : "+v"(acc) : "v"(a), "v"(b), "v"(scl)); }
__device__ __forceinline__ unsigned pk4_fp8(float a, float b, float c, float d) { unsigned w = 0u; w = __builtin_amdgcn_cvt_pk_fp8_f32(a, b, w, false); w = __builtin_amdgcn_cvt_pk_fp8_f32(c, d, w, true); return w; }
__device__ __forceinline__ unsigned cvt_pk_bf16(float lo, float hi) { unsigned r; asm volatile("v_cvt_pk_bf16_f32 %0, %1, %2" : "=v"(r) : "v"(lo), "v"(hi)); return r; }

struct EpiProj {
    static constexpr bool PERM = true, AFTER_DRAIN = false;
    bf16_t* O; int ldc; const float* rope; float qscale; float dqv; int pn_off;
    __device__ __forceinline__ void operator()(const f32x4 (&acc)[2][2][4][2], const Unit& u, int wr, int wc, int fr, int fq, const PG8_LAS unsigned char* sd) const {
        const int pnn = u.pn + pn_off; const int row0 = u.pm * BM + wr * 64 + fr; const int col0 = pnn * BM + wc * 32 + 8 * fq;
        const bool rot = pnn < 4; const float sc = (pnn < 2 ? qscale : 1.f) * dqv; const int gq = 4 * (wc & 1) + fq;
        float invr[4];
#pragma unroll
        for (int e = 0; e < 4; ++e) invr[e] = __builtin_amdgcn_exp2f(-(float)(4 * gq + e) * 0.41524101186092029f) * 0.15915494309189535f;
#pragma unroll
        for (int ai = 0; ai < 2; ++ai)
#pragma unroll
            for (int m = 0; m < 4; ++m) { const int row = row0 + ai * HALF + m * 16; bf16_t* rowp = O + (size_t)row * ldc + col0;
                f32x4 cs0 = (f32x4){1.f, 0.f, 1.f, 0.f}, cs1 = cs0;
                if (rot) { const float tp = (float)(row & 4095);
                    const float a0 = __builtin_amdgcn_fractf(tp * invr[0]), a1 = __builtin_amdgcn_fractf(tp * invr[1]), a2 = __builtin_amdgcn_fractf(tp * invr[2]), a3 = __builtin_amdgcn_fractf(tp * invr[3]);
                    cs0 = (f32x4){__builtin_amdgcn_cosf(a0), __builtin_amdgcn_sinf(a0), __builtin_amdgcn_cosf(a1), __builtin_amdgcn_sinf(a1)};
                    cs1 = (f32x4){__builtin_amdgcn_cosf(a2), __builtin_amdgcn_sinf(a2), __builtin_amdgcn_cosf(a3), __builtin_amdgcn_sinf(a3)}; }
#pragma unroll
                for (int bj = 0; bj < 2; ++bj) { f32x4 v0 = acc[ai][bj][m][0], v1 = acc[ai][bj][m][1];
                    if (rot) { f32x4 lo, hi;
                        lo[0] = v0[0] * cs0[0] - v1[0] * cs0[1]; hi[0] = v1[0] * cs0[0] + v0[0] * cs0[1];
                        lo[1] = v0[1] * cs0[2] - v1[1] * cs0[3]; hi[1] = v1[1] * cs0[2] + v0[1] * cs0[3];
                        lo[2] = v0[2] * cs1[0] - v1[2] * cs1[1]; hi[2] = v1[2] * cs1[0] + v0[2] * cs1[1];
                        lo[3] = v0[3] * cs1[2] - v1[3] * cs1[3]; hi[3] = v1[3] * cs1[2] + v0[3] * cs1[3];
                        v0 = lo * sc; v1 = hi * sc; }
                    else { v0 = v0 * dqv; v1 = v1 * dqv; }
                    u32x4 w; w.x = cvt_pk_bf16(v0[0], v0[1]); w.y = cvt_pk_bf16(v0[2], v0[3]); w.z = cvt_pk_bf16(v1[0], v1[1]); w.w = cvt_pk_bf16(v1[2], v1[3]);
                    *(u32x4*)(rowp + bj * HALF) = w; } }
    }
};
struct EpiF32 {
    static constexpr bool PERM = false, AFTER_DRAIN = false;
    float* O; int ldc;
    __device__ __forceinline__ void operator()(const f32x4 (&acc)[2][2][4][2], const Unit& u, int wr, int wc, int fr, int fq, const PG8_LAS unsigned char* sd) const {
        const int row0 = u.pm * BM + wr * 64 + fr; const int col0 = u.pn * BM + wc * 32 + 4 * fq;
#pragma unroll
        for (int ai = 0; ai < 2; ++ai)
#pragma unroll
            for (int m = 0; m < 4; ++m) { float* rowp = O + (size_t)(row0 + ai * HALF + m * 16) * ldc + col0;
#pragma unroll
                for (int bj = 0; bj < 2; ++bj)
#pragma unroll
                    for (int n = 0; n < 2; ++n) *(f32x4*)(rowp + bj * HALF + n * 16) = acc[ai][bj][m][n]; }
    }
};
struct EpiBf16Plain {
    static constexpr bool PERM = true, AFTER_DRAIN = false;
    bf16_t* O; int ldc;
    __device__ __forceinline__ void operator()(const f32x4 (&acc)[2][2][4][2], const Unit& u, int wr, int wc, int fr, int fq, const PG8_LAS unsigned char* sd) const {
        const int row0 = u.pm * BM + wr * 64 + fr; const int col0 = u.pn * BM + wc * 32 + 8 * fq;
#pragma unroll
        for (int ai = 0; ai < 2; ++ai)
#pragma unroll
            for (int m = 0; m < 4; ++m) { bf16_t* rowp = O + (size_t)(row0 + ai * HALF + m * 16) * ldc + col0;
#pragma unroll
                for (int bj = 0; bj < 2; ++bj) { const f32x4 v0 = acc[ai][bj][m][0], v1 = acc[ai][bj][m][1];
                    u32x4 w; w.x = cvt_pk_bf16(v0[0], v0[1]); w.y = cvt_pk_bf16(v0[2], v0[3]); w.z = cvt_pk_bf16(v1[0], v1[1]); w.w = cvt_pk_bf16(v1[2], v1[3]);
                    *(u32x4*)(rowp + bj * HALF) = w; } }
    }
};
struct EpiSwiglu {
    static constexpr bool PERM = true, AFTER_DRAIN = false;
    unsigned char* H; const float* bgu; const float* rowgate; const PG8_LAS int* cnt; float dq, hscale;
    __device__ __forceinline__ void operator()(const f32x4 (&acc)[2][2][4][2], const Unit& u, int wr, int wc, int fr, int fq, const PG8_LAS unsigned char* sd) const {
        const int n_e = cnt[u.e];
        constexpr float CS = -1.702f * 1.4426950408889634f;
        const float kk = hscale / CS, dqc = dq * CS, dqk = dq * kk, glo = 7.0f * CS, ub0 = -6.0f * kk, ub1 = 8.0f * kk;
        f32x4 bg[2], bu[2];
#pragma unroll
        for (int n = 0; n < 2; ++n) { bg[n] = *(const PG8_LAS f32x4*)(sd + 2048 + (wc * 32 + 8 * fq + 4 * n) * 4) * CS; bu[n] = (*(const PG8_LAS f32x4*)(sd + 2048 + 512 + (wc * 32 + 8 * fq + 4 * n) * 4) + 1.0f) * kk; }
        const int lane = fr + 16 * fq;
        float rgls[2][4];
#pragma unroll
        for (int ai = 0; ai < 2; ++ai)
#pragma unroll
            for (int m = 0; m < 4; ++m) rgls[ai][m] = ((const PG8_LAS float*)(sd + 1024))[ai * HALF + wr * 64 + m * 16 + fr];
#pragma unroll
        for (int ai = 0; ai < 2; ++ai)
#pragma unroll
            for (int mp = 0; mp < 2; ++mp) {
                unsigned pw[2][2];
#pragma unroll
                for (int mm = 0; mm < 2; ++mm) { const int m = 2 * mp + mm; const int r = ai * HALF + wr * 64 + m * 16 + fr; const int er = u.r0 + r;
                    const float rgl = rgls[ai][m]; const float irg = (er < n_e) ? __builtin_amdgcn_rcpf(rgl) : 1e30f;
                    float hv[8];
#pragma unroll
                    for (int n = 0; n < 2; ++n)
#pragma unroll
                        for (int q = 0; q < 4; q += 2) {
                            f32x2 g = (f32x2){acc[ai][0][m][n][q], acc[ai][0][m][n][q + 1]} * dqc + (f32x2){bg[n][q], bg[n][q + 1]};
                            f32x2 up = (f32x2){acc[ai][1][m][n][q], acc[ai][1][m][n][q + 1]} * dqk + (f32x2){bu[n][q], bu[n][q + 1]};
                            g.x = fmaxf(g.x, glo); g.y = fmaxf(g.y, glo); up.x = __builtin_amdgcn_fmed3f(up.x, ub0, ub1); up.y = __builtin_amdgcn_fmed3f(up.y, ub0, ub1);
                            f32x2 den; den.x = __builtin_amdgcn_exp2f(g.x); den.y = __builtin_amdgcn_exp2f(g.y); den = den * irg + irg;
                            f32x2 sg; sg.x = __builtin_amdgcn_rcpf(den.x); sg.y = __builtin_amdgcn_rcpf(den.y);
                            const f32x2 h2 = (up * g) * sg;
                            hv[n * 4 + q] = h2.x; hv[n * 4 + q + 1] = h2.y; }
                    pw[mm][0] = pk4_fp8(hv[0], hv[1], hv[2], hv[3]); pw[mm][1] = pk4_fp8(hv[4], hv[5], hv[6], hv[7]); }
                const auto s0 = __builtin_amdgcn_permlane16_swap(pw[0][0], pw[1][0], false, false); const auto s1 = __builtin_amdgcn_permlane16_swap(pw[0][1], pw[1][1], false, false);
                *(u32x4*)(H + ((size_t)u.pm * 8 + u.pn) * 32768 + ((((ai * 2 + wr) * 4 + wc) * 2 + mp) * 64 + lane) * 16) = (u32x4){s0[0], s1[0], s0[1], s1[1]};
                asm volatile("" ::: "memory"); }
    }
};
struct EpiScatter {
    static constexpr bool PERM = true, AFTER_DRAIN = false;
    unsigned char* Y; const int* rowtok; const PG8_LAS int* cnt; float dq, ysc;
    __device__ __forceinline__ void operator()(const f32x4 (&acc)[2][2][4][2], const Unit& u, int wr, int wc, int fr, int fq, const PG8_LAS unsigned char* sd) const {
        const int col0 = u.pn * BM + wc * 32 + 8 * fq; const int n_e = cnt[u.e];
        f32x4 bd[2][2];
#pragma unroll
        for (int bj = 0; bj < 2; ++bj)
#pragma unroll
            for (int n = 0; n < 2; ++n) bd[bj][n] = *(const PG8_LAS f32x4*)(sd + 2048 + (bj * HALF + wc * 32 + 8 * fq + 4 * n) * 4);
        int idxs[2][4]; float rgs[2][4];
#pragma unroll
        for (int ai = 0; ai < 2; ++ai)
#pragma unroll
            for (int m = 0; m < 4; ++m) { idxs[ai][m] = ((const PG8_LAS int*)sd)[ai * HALF + wr * 64 + m * 16 + fr]; rgs[ai][m] = ((const PG8_LAS float*)(sd + 1024))[ai * HALF + wr * 64 + m * 16 + fr]; }
#pragma unroll
        for (int ai = 0; ai < 2; ++ai)
#pragma unroll
            for (int m = 0; m < 4; ++m) { const int er = u.r0 + ai * HALF + wr * 64 + m * 16 + fr;
                const int idx = idxs[ai][m];
                if (er < n_e) { unsigned char* rowp = Y + (size_t)idx * 1024 + col0;
                    typedef unsigned u32x2 __attribute__((ext_vector_type(2)));
                    const float rg = rgs[ai][m] * ysc;
#pragma unroll
                    for (int bj = 0; bj < 2; ++bj) { const f32x4 v0 = acc[ai][bj][m][0] * dq + bd[bj][0] * rg, v1 = acc[ai][bj][m][1] * dq + bd[bj][1] * rg;
                        *(u32x2*)(rowp + bj * HALF) = (u32x2){pk4_fp8(v0[0], v0[1], v0[2], v0[3]), pk4_fp8(v1[0], v1[1], v1[2], v1[3])}; } } }
    }
};

struct PanelStats {
    unsigned* xbuf;
    unsigned* cnt;
    unsigned* tmo;
    int ntn; float eps;
    unsigned code;
    __device__ __forceinline__ bool run(const f32x4 (&v)[2][2][4][2], const Unit& u, int wr, int wc, int fr, int fq, PG8_LAS unsigned char* lds, int wid, int lane) const {
        typedef float f32x2v __attribute__((ext_vector_type(2)));
        PG8_LAS f32x2v* P = (PG8_LAS f32x2v*)lds;
        PG8_LAS f32x2v* S = (PG8_LAS f32x2v*)(lds + 8192);
        PG8_LAS unsigned* flag = (PG8_LAS unsigned*)(lds + 8192 + 2048);
#pragma unroll
        for (int ai = 0; ai < 2; ++ai)
#pragma unroll
            for (int m = 0; m < 4; ++m) {
                float s = 0.f;
#pragma unroll
                for (int bj = 0; bj < 2; ++bj)
#pragma unroll
                    for (int n = 0; n < 2; ++n) { const f32x4 x = v[ai][bj][m][n]; s += (x[0] + x[1]) + (x[2] + x[3]); }
                s += __shfl_xor(s, 16); s += __shfl_xor(s, 32);
                const float mw = s * (1.0f / 64.0f); float q = 0.f;
#pragma unroll
                for (int bj = 0; bj < 2; ++bj)
#pragma unroll
                    for (int n = 0; n < 2; ++n) { const f32x4 d = v[ai][bj][m][n] - mw; q += (d[0] * d[0] + d[1] * d[1]) + (d[2] * d[2] + d[3] * d[3]); }
                q += __shfl_xor(q, 16); q += __shfl_xor(q, 32);
                if (fq == 0) P[(ai * HALF + wr * 64 + m * 16 + fr) * 4 + wc] = (f32x2v){mw, q};
            }
        asm volatile("s_waitcnt lgkmcnt(0)" ::: "memory"); __builtin_amdgcn_s_barrier(); asm volatile("" ::: "memory");
#if defined(BROKEN_EXCHANGE_NO_WAIT)
#warning BROKEN CONTROL BUILD: the row-statistics exchange does not wait; results are wrong by design
        if (blockIdx.x >= 64) { const long long t0_ = clock64(); while (clock64() - t0_ < 60000) __builtin_amdgcn_s_sleep(8); }
#endif
        const int row = wid * 32 + (lane & 31);
        if (lane < 32) {
            const f32x2v a = P[row * 4 + 0], b = P[row * 4 + 1], c = P[row * 4 + 2], d = P[row * 4 + 3];
            const float mt = (a.x + b.x + c.x + d.x) * 0.25f;
            const float da = a.x - mt, db = b.x - mt, dc = c.x - mt, dd = d.x - mt;
            const float m2 = (a.y + b.y) + (c.y + d.y) + 64.0f * ((da * da + db * db) + (dc * dc + dd * dd));
            unsigned long long* slot = (unsigned long long*)xbuf + ((size_t)(u.pm * BM + row) * 4 + u.pn);
            __hip_atomic_store(slot, ((unsigned long long)__float_as_uint(m2) << 32) | __float_as_uint(mt), __ATOMIC_RELAXED, __HIP_MEMORY_SCOPE_AGENT);
        }
        asm volatile("s_waitcnt vmcnt(0)" ::: "memory");
        if (lane == 0) __hip_atomic_fetch_add(cnt + 64 * u.pm, 1u, __ATOMIC_RELAXED, __HIP_MEMORY_SCOPE_AGENT);
        if (wid == 0) {
            const unsigned want = 8u * (unsigned)ntn; unsigned sp = 0u;
            while ((unsigned)__builtin_amdgcn_readfirstlane(__hip_atomic_load(cnt + 64 * u.pm, __ATOMIC_RELAXED, __HIP_MEMORY_SCOPE_AGENT)) < want) { __builtin_amdgcn_s_sleep(2); if (++sp > (1u << 20)) break; }
            __builtin_amdgcn_fence(__ATOMIC_ACQUIRE, "agent");
        }
        asm volatile("s_waitcnt vmcnt(0) lgkmcnt(0)" ::: "memory"); __builtin_amdgcn_s_barrier(); asm volatile("" ::: "memory");
        const bool bad = false;
        if (lane < 32) {
            const unsigned long long* slot = (const unsigned long long*)xbuf + (size_t)(u.pm * BM + row) * 4; float mt[4], m2[4]; float ms = 0.f;
#pragma unroll
            for (int t = 0; t < 4; ++t) { if (t < ntn) { const unsigned long long w = __hip_atomic_load(slot + t, __ATOMIC_RELAXED, __HIP_MEMORY_SCOPE_AGENT); mt[t] = __uint_as_float((unsigned)w); m2[t] = __uint_as_float((unsigned)(w >> 32)); } else { mt[t] = 0.f; m2[t] = 0.f; } ms += mt[t]; }
            const float mean = ms / (float)ntn; float q = 0.f;
#pragma unroll
            for (int t = 0; t < 4; ++t) if (t < ntn) { const float dm = mt[t] - mean; q += m2[t] + 256.0f * dm * dm; }
            S[row] = (f32x2v){mean, 1.0f / sqrtf(q / (256.0f * (float)ntn) + eps)};
        }
        asm volatile("s_waitcnt lgkmcnt(0)" ::: "memory"); __builtin_amdgcn_s_barrier(); asm volatile("" ::: "memory");
        return bad;
    }
};

struct EpiLn1 {
    static constexpr bool PERM = true, AFTER_DRAIN = true;
    unsigned char* ws; const float* gam; const float* bet; size_t o_xb, o_x8, o_xbuf, o_cnt, o_tmo; float alpha, s8, eps; unsigned code;
    __device__ __forceinline__ void operator()(const f32x4 (&)[2][2][4][2], const Unit&, int, int, int, int, const PG8_LAS unsigned char*) const {}
    __device__ __forceinline__ void fused(f32x4 (&acc)[2][2][4][2], const Unit& u, int wr, int wc, int fr, int fq, PG8_LAS unsigned char* lds, int wid, int lane) const {
        typedef float f32x2v __attribute__((ext_vector_type(2))); typedef unsigned u32x2 __attribute__((ext_vector_type(2)));
        bf16_t* const XBp = (bf16_t*)(ws + o_xb); unsigned char* const X8 = ws + o_x8;
        const PanelStats st{(unsigned*)(ws + o_xbuf), (unsigned*)(ws + o_cnt), (unsigned*)(ws + o_tmo), 4, eps, code};
        const int col0 = u.pn * BM + wc * 32 + 8 * fq;
#pragma unroll
        for (int ai = 0; ai < 2; ++ai)
#pragma unroll
            for (int m = 0; m < 4; ++m) { const bf16_t* xr = XBp + (size_t)(u.pm * BM + ai * HALF + wr * 64 + m * 16 + fr) * 1024 + col0;
#pragma unroll
                for (int bj = 0; bj < 2; ++bj) { const u32x4 x = *(const u32x4*)(xr + bj * HALF);
                    acc[ai][bj][m][0] += (f32x4){__builtin_bit_cast(float, x.x << 16), __builtin_bit_cast(float, x.x & 0xffff0000u), __builtin_bit_cast(float, x.y << 16), __builtin_bit_cast(float, x.y & 0xffff0000u)} * alpha;
                    acc[ai][bj][m][1] += (f32x4){__builtin_bit_cast(float, x.z << 16), __builtin_bit_cast(float, x.z & 0xffff0000u), __builtin_bit_cast(float, x.w << 16), __builtin_bit_cast(float, x.w & 0xffff0000u)} * alpha; }
                asm volatile("" ::: "memory"); }
        (void)st.run(acc, u, wr, wc, fr, fq, lds, wid, lane);
        const PG8_LAS f32x2v* S = (const PG8_LAS f32x2v*)(lds + 8192);
#pragma unroll
        for (int bj = 0; bj < 2; ++bj) {
            const f32x4 g0 = *(const f32x4*)(gam + col0 + bj * HALF), g1 = *(const f32x4*)(gam + col0 + bj * HALF + 4), b0 = *(const f32x4*)(bet + col0 + bj * HALF), b1 = *(const f32x4*)(bet + col0 + bj * HALF + 4);
#pragma unroll
            for (int ai = 0; ai < 2; ++ai)
#pragma unroll
                for (int m = 0; m < 4; ++m) { const int r = ai * HALF + wr * 64 + m * 16 + fr; const f32x2v sr = S[r]; const size_t off = (size_t)(u.pm * BM + r) * 1024 + col0 + bj * HALF;
                    const f32x4 o0 = (acc[ai][bj][m][0] - sr.x) * sr.y * g0 + b0, o1 = (acc[ai][bj][m][1] - sr.x) * sr.y * g1 + b1;
                    u32x4 w; w.x = cvt_pk_bf16(o0[0], o0[1]); w.y = cvt_pk_bf16(o0[2], o0[3]); w.z = cvt_pk_bf16(o1[0], o1[1]); w.w = cvt_pk_bf16(o1[2], o1[3]);
                    *(u32x4*)(XBp + off) = w;
                    *(u32x2*)(X8 + off) = (u32x2){pk4_fp8(o0[0] * s8, o0[1] * s8, o0[2] * s8, o0[3] * s8), pk4_fp8(o1[0] * s8, o1[1] * s8, o1[2] * s8, o1[3] * s8)};
                    asm volatile("" ::: "memory"); } }
    }
};

template <class Epi, class Sched, bool ALIGN_EPI, bool GATHER, bool FP8 = false, bool ABLK = false>
__device__ __forceinline__ void gemm_phase(PG8_LAS unsigned char* lds, const Gemm g, const Sched& S, const Epi& E) {
    const int tid = threadIdx.x, wid = __builtin_amdgcn_readfirstlane(tid >> 6), lane = tid & 63, wr = wid >> 2, wc = wid & 3, fr = lane & 15, fq = lane >> 4;
    const int K = g.K, nt = K / BK;
    unsigned voffB[2];
#pragma unroll
    for (int i = 0; i < 2; ++i) { int R, C; stage_rc(tid * 16 + i * 8192, R, C); const int Rb = Epi::PERM ? ((R & ~31) + perm32(R & 31)) : R;
        voffB[i] = (unsigned)(Rb * K + C) * 2u; }
    constexpr int SIDE_BYTES = 8192;
    PG8_LAS unsigned char* const side = lds + STAGE_BYTES;
    const size_t kstep = (size_t)(BK * 2);
    const size_t kstepA = ABLK ? (size_t)32768 : kstep;
    const size_t hstep = (size_t)HALF * K * 2;
    const size_t tstep = 2 * hstep;
    const unsigned ldsw = (unsigned)wid * 1024u;
    const int aoff = lds_byte(wr * 64 + fr, fq * 8), boff = lds_byte(wc * 32 + fr, fq * 8);
#define PG8_SA(b, h) (((b) * 2 + (h)) * HTB)
#define PG8_SB(b, h) ((4 + (b) * 2 + (h)) * HTB)
#define PG8_STAGE(bufoff, gbase, voff) do { _Pragma("unroll") for (int _i = 0; _i < 2; ++_i) \
        __builtin_amdgcn_global_load_lds((const unsigned*)((const char*)(gbase) + (voff)[_i]), (PG8_LAS unsigned*)(lds + (bufoff) + ldsw + _i * 8192), 16, 0, 0); } while (0)
#define PG8_LDA(dst, b, h) do { _Pragma("unroll") for (int m = 0; m < 4; ++m) _Pragma("unroll") for (int k = 0; k < 2; ++k) dst[m][k] = *(const PG8_LAS bf16x8*)(lds + PG8_SA(b, h) + aoff + m * 2048 + k * 1024); } while (0)
#define PG8_LDB(dst, b, h) do { _Pragma("unroll") for (int n = 0; n < 2; ++n) _Pragma("unroll") for (int k = 0; k < 2; ++k) dst[n][k] = *(const PG8_LAS bf16x8*)(lds + PG8_SB(b, h) + boff + n * 2048 + k * 1024); } while (0)
#define PG8_MMA(ai, bj, At, Bt) do { __builtin_amdgcn_s_setprio(1); _Pragma("unroll") for (int m = 0; m < 4; ++m) _Pragma("unroll") for (int n = 0; n < 2; ++n) { \
        if constexpr (FP8) mfma8(acc[ai][bj][m][n], cat8(Bt[n][0], Bt[n][1]), cat8(At[m][0], At[m][1]), scl8); \
        else { _Pragma("unroll") for (int k = 0; k < 2; ++k) acc[ai][bj][m][n] = __builtin_amdgcn_mfma_f32_16x16x32_bf16(Bt[n][k], At[m][k], acc[ai][bj][m][n], 0, 0, 0); } } __builtin_amdgcn_s_setprio(0); } while (0)
#define PG8_WAIT_V(n) asm volatile("s_waitcnt vmcnt(" #n ")" ::: "memory")
#define PG8_WAIT_L(n) asm volatile("s_waitcnt lgkmcnt(" #n ")" ::: "memory")
#define PG8_BAR __builtin_amdgcn_s_barrier()
#define PG8_SCHED __builtin_amdgcn_sched_barrier(0)
#define PG8_SETOFFS(o, u) do { _Pragma("unroll") for (int _h = 0; _h < 2; ++_h) _Pragma("unroll") for (int _i = 0; _i < 2; ++_i) { int _R, _C; stage_rc(tid * 16 + _i * 8192, _R, _C); \
        o[_h][_i] = GATHER ? (S.arow(u, _R + HALF * _h) + (unsigned)(_C * 2)) : ABLK ? hblk_off(_R + HALF * _h, _C >> 3) : ((unsigned)((_R + HALF * _h) * K) * 2u + (unsigned)(_C * 2)); } } while (0)
    int scl8 = 0x7F7F7F7F; asm volatile("" : "+v"(scl8));
    Unit cur, nxt; int ui = 0;
    if (!S.next(0, cur)) return;
    f32x4 acc[2][2][4][2];
#pragma unroll
    for (int a = 0; a < 2; ++a)
#pragma unroll
        for (int b = 0; b < 2; ++b)
#pragma unroll
            for (int m = 0; m < 4; ++m)
#pragma unroll
                for (int n = 0; n < 2; ++n) { acc[a][b][m][n] = (f32x4){0.f, 0.f, 0.f, 0.f}; if constexpr (FP8) asm volatile("" : "+v"(acc[a][b][m][n])); }
    bf16x8 At[4][2], B0[2][2], B1[2][2];
    unsigned cAo[2][2];
    PG8_SETOFFS(cAo, cur);
    const char* cA = S.abase(cur, g, tstep); const char* cB = S.bbase(cur, g, tstep);
    S.a_ready(cur);
    PG8_STAGE(PG8_SB(0, 0), cB, voffB); PG8_STAGE(PG8_SB(0, 1), cB + hstep, voffB); PG8_STAGE(PG8_SA(0, 0), cA, cAo[0]); PG8_STAGE(PG8_SA(0, 1), cA, cAo[1]);
    if (wr == 1) PG8_BAR;
    PG8_WAIT_V(2); PG8_BAR;
    PG8_STAGE(PG8_SB(1, 0), cB + kstep, voffB); PG8_STAGE(PG8_SA(1, 0), cA + kstepA, cAo[0]); PG8_STAGE(PG8_SB(1, 1), cB + hstep + kstep, voffB);
    PG8_WAIT_V(6); PG8_BAR;
    for (;;) {
        const bool has_next = S.next(ui + 1, nxt);
        const char* nA = has_next ? S.abase(nxt, g, tstep) : cA; const char* nB = has_next ? S.bbase(nxt, g, tstep) : cB;
        if constexpr (Sched::SIDE) {
            const void* ssrc = S.side_src(cur, (GATHER && has_next) ? nxt : cur, wid, lane);
            __builtin_amdgcn_global_load_lds((const unsigned*)ssrc, (PG8_LAS unsigned*)(side + (ui & 1) * SIDE_BYTES + wid * 1024), 16, 0, 0); }
#pragma unroll 1
        for (int t = 0; t < nt; t += 2) {
            const bool last = (t == nt - 2);
            const char* a1 = cA + (size_t)(t + 1) * kstepA;
            const char* a2 = last ? nA : cA + (size_t)(t + 2) * kstepA; const char* b2 = last ? nB : cB + (size_t)(t + 2) * kstep;
            const char* a3 = a2 + kstepA; const char* b3 = b2 + kstep;
            if (last && has_next) S.a_ready(nxt);
            PG8_LDB(B0, 0, 0); PG8_LDB(B1, 0, 1); PG8_SCHED; PG8_LDA(At, 0, 0); PG8_STAGE(PG8_SA(1, 1), a1, cAo[1]);
            if constexpr (GATHER) { if (last && has_next) {
                const PG8_LAS unsigned char* sdn = side + (ui & 1) * SIDE_BYTES;
#pragma unroll
                for (int _h = 0; _h < 2; ++_h)
#pragma unroll
                    for (int _i = 0; _i < 2; ++_i) { int _R, _C; stage_rc(tid * 16 + _i * 8192, _R, _C); cAo[_h][_i] = S.arow_side(nxt, _R + HALF * _h, sdn) + (unsigned)(_C * 2); } } }
            PG8_WAIT_V(8); PG8_WAIT_L(0); PG8_BAR; PG8_MMA(0, 0, At, B0); PG8_MMA(0, 1, At, B1); PG8_BAR; PG8_SCHED;
            PG8_LDA(At, 0, 1); PG8_STAGE(PG8_SB(0, 0), b2, voffB); PG8_STAGE(PG8_SB(0, 1), b2 + hstep, voffB); PG8_STAGE(PG8_SA(0, 0), a2, cAo[0]);
            PG8_WAIT_V(8); PG8_WAIT_L(0); PG8_BAR; PG8_MMA(1, 0, At, B0); PG8_MMA(1, 1, At, B1); PG8_BAR; PG8_SCHED;
            PG8_LDB(B0, 1, 0); PG8_LDB(B1, 1, 1); PG8_SCHED; PG8_LDA(At, 1, 0); PG8_STAGE(PG8_SA(0, 1), a2, cAo[1]);
            PG8_WAIT_V(8); PG8_WAIT_L(0); PG8_BAR; PG8_MMA(0, 0, At, B0); PG8_MMA(0, 1, At, B1); PG8_BAR; PG8_SCHED;
            PG8_LDA(At, 1, 1); PG8_STAGE(PG8_SB(1, 0), b3, voffB); PG8_STAGE(PG8_SB(1, 1), b3 + hstep, voffB); PG8_STAGE(PG8_SA(1, 0), a3, cAo[0]);
            PG8_WAIT_V(8); PG8_WAIT_L(0); PG8_BAR; PG8_MMA(1, 0, At, B0); PG8_MMA(1, 1, At, B1); PG8_BAR; PG8_SCHED;
        }
        if constexpr (ALIGN_EPI) { if (wr == 0) PG8_BAR; }
        if constexpr (FP8) asm volatile("s_nop 15\n\ts_nop 15" ::: "memory");
        if constexpr (!Epi::AFTER_DRAIN) { PG8_SCHED; E(acc, cur, wr, wc, fr, fq, side + (ui & 1) * SIDE_BYTES); S.done(cur); PG8_SCHED; }
        if (!has_next) break;
#pragma unroll
        for (int a = 0; a < 2; ++a)
#pragma unroll
            for (int b = 0; b < 2; ++b)
#pragma unroll
                for (int m = 0; m < 4; ++m)
#pragma unroll
                    for (int n = 0; n < 2; ++n) { acc[a][b][m][n] = (f32x4){0.f, 0.f, 0.f, 0.f}; if constexpr (FP8) asm volatile("" : "+v"(acc[a][b][m][n])); }
        cur = nxt; cA = nA; cB = nB; ++ui;
        if constexpr (ALIGN_EPI) { if (wr == 1) PG8_BAR; }
    }
    PG8_WAIT_V(0);
    if constexpr (!ALIGN_EPI) { if (wr == 0) PG8_BAR; }
    PG8_BAR;
    if constexpr (Epi::AFTER_DRAIN) { E.fused(acc, cur, wr, wc, fr, fq, lds, wid, lane); S.done(cur); }
#undef PG8_SA
#undef PG8_SB
#undef PG8_STAGE
#undef PG8_LDA
#undef PG8_LDB
#undef PG8_MMA
#undef PG8_WAIT_V
#undef PG8_WAIT_L
#undef PG8_BAR
#undef PG8_SCHED
#undef PG8_SETOFFS
}
}

constexpr int NB = 8, SEQ = 4096, DM = 1024, MROWS = NB * SEQ, NLAYER = 2;
constexpr int NPROJ = 4608, INW = 4616;
constexpr int C_Q = 0, C_K = 512, C_V = 1024, C_Z = 1536, C_XS = 2048, C_SB = 3072, C_SC = 3584, C_SH = 4096;
constexpr int MIXW = 1536, NEXP = 32, TOPK = 4, FF = 1024;
constexpr float ALPHA = 1.4142135623730951f;
constexpr float LN_EPS = 1e-5f, RMS_EPS = 1e-5f;
constexpr float QSCALE = 0.125f * 1.4426950408889634f;

constexpr size_t MiB = 1u << 20;
constexpr size_t WS_CTL = 0, CTL_ZERO_BYTES = 1 * MiB;
constexpr size_t WS_ROPE = 1 * MiB;
constexpr size_t WS_WDT = 2 * MiB;
constexpr size_t WS_ROUT = 2 * MiB + 65536;
constexpr size_t WS_WIN = 4 * MiB;
constexpr size_t WS_WOUT = 24 * MiB;
constexpr size_t WS_WGU = 32 * MiB;
constexpr size_t WS_WDN = 288 * MiB;
constexpr size_t WS_XB = 416 * MiB;
constexpr size_t WS_XF = 480 * MiB;
constexpr size_t WS_XF2 = 608 * MiB;
constexpr size_t WS_PROJ = 736 * MiB;
constexpr size_t WS_DT = 1024 * MiB;
constexpr size_t WS_DTS = 1025 * MiB;
constexpr size_t WS_ACUM = 1026 * MiB;
constexpr size_t WS_LSE = 1027 * MiB;
constexpr size_t WS_OP = 1030 * MiB;
constexpr size_t WS_U = 1126 * MiB;
constexpr size_t WS_G = 1190 * MiB;
constexpr size_t WS_ST = 1222 * MiB;
constexpr size_t WS_YD = 1286 * MiB;
constexpr size_t WS_MIXED = 1350 * MiB;
constexpr size_t WS_MIXF = 1446 * MiB;
constexpr size_t WS_TOPE = 1574 * MiB;
constexpr size_t WS_TOPG = 1575 * MiB;
constexpr size_t WS_ROWTOK = 1576 * MiB;
constexpr size_t WS_ROWGATE = 1580 * MiB;
constexpr size_t WS_H = 736 * MiB;
constexpr size_t WS_YB = 1030 * MiB;
constexpr size_t WS_END = 1584 * MiB;
constexpr int CW_TMO = 0;
constexpr int CW_CNT = 64;
constexpr int CW_BAR = 4096;
constexpr int CW_SEAM = 16384;

constexpr int RING_OFF = 0, RING_BYTES = 131072;
constexpr int LDSCTL_OFF = 155648;
constexpr int L_MISC = LDSCTL_OFF;
constexpr int L_TSTART = LDSCTL_OFF + 256;
constexpr int L_CNT = LDSCTL_OFF + 512;
constexpr int L_LCNT = LDSCTL_OFF + 640;
constexpr int L_LBASE = LDSCTL_OFF + 768;
constexpr int L_UNITS = LDSCTL_OFF + 1024;
constexpr int L_UNITSN = LDSCTL_OFF + 2048;
constexpr int LDS_BYTES = 163840;

#define GAS __attribute__((address_space(1)))
#define LAS __attribute__((address_space(3)))
typedef unsigned short bf16;
typedef unsigned v4u __attribute__((ext_vector_type(4)));
typedef unsigned v2u __attribute__((ext_vector_type(2)));
typedef float f32x4 __attribute__((ext_vector_type(4)));
typedef float f32x16 __attribute__((ext_vector_type(16)));
typedef short bf16x8 __attribute__((ext_vector_type(8)));
typedef GAS unsigned gu32;
#define RLX_AGENT __ATOMIC_RELAXED, __HIP_MEMORY_SCOPE_AGENT
#define LDS_WAIT() asm volatile("s_waitcnt lgkmcnt(0)" ::: "memory")
#define VM_WAIT() asm volatile("s_waitcnt vmcnt(0)" ::: "memory")
__device__ __forceinline__ unsigned f2bf(float f) { unsigned u = __builtin_bit_cast(unsigned, f); return (u + 0x7fffu + ((u >> 16) & 1u)) >> 16; }
__device__ __forceinline__ unsigned pk2(float lo, float hi) { unsigned r; asm volatile("v_cvt_pk_bf16_f32 %0, %1, %2" : "=v"(r) : "v"(lo), "v"(hi)); return r; }
__device__ __forceinline__ float bf2f(unsigned short b) { return __builtin_bit_cast(float, (unsigned)b << 16); }
__device__ __forceinline__ float bflo(unsigned w) { return __builtin_bit_cast(float, w << 16); }
__device__ __forceinline__ float bfhi(unsigned w) { return __builtin_bit_cast(float, w & 0xffff0000u); }
__device__ __forceinline__ float siluf(float x) { return x * __builtin_amdgcn_rcpf(1.0f + __builtin_amdgcn_exp2f(-1.4426950408889634f * x)); }
#define XB_TMO      128
#define XB_XCNT(j)  (256  + 64 * (j))
#define XB_XSUB(j)  (1280 + 64 * (j))
#define XB_XGEN(j)  (2304 + 64 * (j))
#define XB_TOP      3328
#define XB_TOPGEN   3392
#define XCD_BAR_WORDS 3456
#define XB_SPIN_CAP (1u << 18)

__device__ __forceinline__ unsigned xb_ld(unsigned* p)              { return __hip_atomic_load(p, __ATOMIC_RELAXED, __HIP_MEMORY_SCOPE_AGENT); }
__device__ __forceinline__ unsigned xb_add(unsigned* p, unsigned v) { return __hip_atomic_fetch_add(p, v, __ATOMIC_RELAXED, __HIP_MEMORY_SCOPE_AGENT); }
__device__ __forceinline__ unsigned xb_xcc_id() { return (unsigned)__builtin_amdgcn_s_getreg((3 << 11) | 20) & 0xFu; }
#define XB_SPIN(cond, bar) do { unsigned _sp = 0; while (cond) { __builtin_amdgcn_s_sleep(1); \
    if ((++_sp & 255u) == 0u) { if (xb_ld(&(bar)[XB_TMO])) break; if (_sp > XB_SPIN_CAP) { atomicAdd(&(bar)[XB_TMO], 1u); break; } } } } while (0)

struct XcdBarrier {
    unsigned* bar; unsigned x;
    volatile LAS unsigned* st;
};

__device__ __forceinline__ XcdBarrier xcd_barrier_post(unsigned* bar, volatile LAS unsigned* st) {
    XcdBarrier b; b.bar = bar; b.x = xb_xcc_id(); b.st = st;
    if (threadIdx.x == 0) (void)xb_add(&bar[XB_XCNT(b.x)], 1u);
    return b;
}
__device__ __forceinline__ void xcd_barrier_complete(unsigned* bar, unsigned x, unsigned& nloc, unsigned& nx) {
    const unsigned G = gridDim.x * gridDim.y * gridDim.z;
    unsigned sum, cnt, mine, sp = 0u;
    for (;;) {
        sum = 0u; cnt = 0u; mine = 0u;
#pragma unroll
        for (unsigned j = 0; j < 16; ++j) { const unsigned c = xb_ld(&bar[XB_XCNT(j)]); sum += c; cnt += (c > 0u) ? 1u : 0u; mine = (j == x) ? c : mine; }
        if (sum == G) break;
        __builtin_amdgcn_s_sleep(1);
        if ((++sp & 255u) == 0u) { if (xb_ld(&bar[XB_TMO])) break; if (sp > XB_SPIN_CAP) { atomicAdd(&bar[XB_TMO], 1u); break; } }
    }
    nloc = mine > 0u ? mine : 1u; nx = cnt > 0u ? cnt : 1u;
}

__device__ __forceinline__ void xcd_barrier(const XcdBarrier& b) {
    asm volatile("s_waitcnt vmcnt(0)" ::: "memory");
    __syncthreads();
    if (threadIdx.x == 0) {
        unsigned* bar = b.bar;
        __builtin_amdgcn_s_waitcnt(0);
        unsigned nloc = b.st[0], nx = b.st[1];
        if (nloc == 0u) { xcd_barrier_complete(bar, b.x, nloc, nx); b.st[0] = nloc; b.st[1] = nx; }
        const unsigned old = xb_add(&bar[XB_XSUB(b.x)], 1u);
        const unsigned gen = old / nloc;
        if (old + 1u == (gen + 1u) * nloc) {
            __builtin_amdgcn_fence(__ATOMIC_RELEASE, "agent");
            asm volatile("s_waitcnt vmcnt(0)" ::: "memory");
            const unsigned og = xb_add(&bar[XB_TOP], 1u);
            const unsigned tg = og / nx;
            if (og + 1u == (tg + 1u) * nx) xb_add(&bar[XB_TOPGEN], 1u);
            else XB_SPIN(xb_ld(&bar[XB_TOPGEN]) == tg, bar);
            __builtin_amdgcn_fence(__ATOMIC_ACQUIRE, "agent");
            xb_add(&bar[XB_XGEN(b.x)], 1u);
            asm volatile("s_waitcnt vmcnt(0)" ::: "memory");
        } else {
            XB_SPIN(xb_ld(&bar[XB_XGEN(b.x)]) == gen, bar);
            __builtin_amdgcn_fence(__ATOMIC_ACQUIRE, "agent");
            asm volatile("s_waitcnt vmcnt(0)" ::: "memory");
        }
    }
    __syncthreads();
}

constexpr float SC_X = 4.f, SC_WGU = 32.f, SC_H = 4.f, SC_WDN = 4.f, SC_Y = 16.f, SC_WIN = 32.f, SC_O = 32.f;
__device__ __forceinline__ float wave_sum(float v) {
#pragma unroll
    for (int o = 1; o < 64; o <<= 1) v += __shfl_xor(v, o);
    return v;
}
__device__ __forceinline__ int win_dest_row(int n) {
    if (n < 1024) { const int hh = n >> 6, d = n & 63; const int p = (d < 32) ? (8 * (d >> 2) + (d & 3)) : (8 * ((d - 32) >> 2) + 4 + (d & 3)); return hh * 64 + p; }
    if (n < 3072) return n;
    if (n < 3080) return -1;
    return n - 8;
}
__device__ __forceinline__ int wgu_dest_row(int n) { return n < 1024 ? ((n >> 7) * 256 + (n & 127)) : (((n - 1024) >> 7) * 256 + 128 + ((n - 1024) & 127)); }
template <int MAP>
__device__ __forceinline__ void p0_transpose_item(const float* W, int K, int N, bf16* WT, float* wdt, LAS float* scr, int kb, int nb, int lane) {
    const int k0 = 64 * kb, n0 = 32 * nb;
    const int nn = n0 + (lane & 31); const bool nok = nn < N;
#pragma unroll 8
    for (int i = 0; i < 32; ++i) { const int kk = 2 * i + (lane >> 5); scr[kk * 33 + (lane & 31)] = nok ? W[(size_t)(k0 + kk) * N + nn] : 0.f; }
    LDS_WAIT(); asm volatile("" ::: "memory");
    const int c = lane & 7;
#pragma unroll
    for (int j = 0; j < 4; ++j) { const int n = (lane >> 3) + 8 * j; const LAS float* s = scr + (8 * c) * 33 + n;
        const int nsrc = n0 + n; if (nsrc >= N) continue;
        int drow = nsrc; if (MAP == 1) drow = win_dest_row(nsrc); if (MAP == 2) drow = wgu_dest_row(nsrc);
        if (MAP == 1 && drow < 0) { float* d = wdt + (size_t)(nsrc - 3072) * 1024 + k0 + 8 * c;
#pragma unroll
            for (int q = 0; q < 8; ++q) d[q] = s[q * 33]; continue; }
        v4u o; o.x = pk2(s[0 * 33], s[1 * 33]); o.y = pk2(s[2 * 33], s[3 * 33]); o.z = pk2(s[4 * 33], s[5 * 33]); o.w = pk2(s[6 * 33], s[7 * 33]);
        *(GAS v4u*)(WT + (size_t)drow * K + k0 + 8 * c) = o; }
    LDS_WAIT(); asm volatile("" ::: "memory");
}
template <int MAP>
__device__ __forceinline__ void p0_transpose_item64(const float* W, int K, int N, bf16* WT, float* wdt, LAS float* scr, int kb, int nb, int lane) {
    const int k0 = 64 * kb, n0 = 64 * nb;
    const bool lok = (n0 + 4 * (lane & 15) + 3) < N;
    f32x4 ld[16];
#pragma unroll
    for (int i = 0; i < 16; ++i) ld[i] = lok ? *(const f32x4*)(W + (size_t)(k0 + 4 * i + (lane >> 4)) * N + n0 + 4 * (lane & 15)) : (f32x4){0.f, 0.f, 0.f, 0.f};
#pragma unroll
    for (int i = 0; i < 16; ++i) *(LAS f32x4*)(scr + (4 * i + (lane >> 4)) * 64 + 4 * (lane & 15)) = ld[i];
    LDS_WAIT(); asm volatile("" ::: "memory");
    const int nsrc = n0 + lane;
    if (nsrc < N) {
        int drow = nsrc; if (MAP == 1) drow = win_dest_row(nsrc);
        if (MAP == 1 && drow < 0) { float* d = wdt + (size_t)(nsrc - 3072) * 1024 + k0;
#pragma unroll
            for (int q = 0; q < 16; ++q) *(f32x4*)(d + 4 * q) = (f32x4){scr[(4 * q) * 64 + lane], scr[(4 * q + 1) * 64 + lane], scr[(4 * q + 2) * 64 + lane], scr[(4 * q + 3) * 64 + lane]}; }
        else { GAS v4u* d = (GAS v4u*)(WT + (size_t)drow * K + k0);
#pragma unroll
            for (int q = 0; q < 8; ++q) { v4u o; o.x = pk2(scr[(8 * q) * 64 + lane], scr[(8 * q + 1) * 64 + lane]); o.y = pk2(scr[(8 * q + 2) * 64 + lane], scr[(8 * q + 3) * 64 + lane]);
                o.z = pk2(scr[(8 * q + 4) * 64 + lane], scr[(8 * q + 5) * 64 + lane]); o.w = pk2(scr[(8 * q + 6) * 64 + lane], scr[(8 * q + 7) * 64 + lane]); d[q] = o; } } }
    LDS_WAIT(); asm volatile("" ::: "memory");
}
struct SubT { const float* src; unsigned char* dst; int N; int n0; int mode; float scale; };
__device__ __forceinline__ SubT fp8_subtile(int item, int half, const float* wgu, const float* wdn, const float* win, unsigned char* WG8, unsigned char* WD8, unsigned char* WI8, int lane) {
    SubT t; int kb, nb;
    if (item < 64 * 256) { const int le = item >> 8, r = item & 255; kb = r >> 5; nb = r & 31; t.N = 2048; t.mode = 1; t.scale = SC_WGU;
        t.src = wgu + (size_t)le * 1024 * 2048; t.dst = WG8 + (size_t)le * 2048 * 1024; }
    else if (item < 64 * 256 + 64 * 128) { const int it2 = item - 64 * 256; const int le = it2 >> 7, r = it2 & 127; kb = r >> 4; nb = r & 15; t.N = 1024; t.mode = 0; t.scale = SC_WDN;
        t.src = wdn + (size_t)le * 1024 * 1024; t.dst = WD8 + (size_t)le * 1024 * 1024; }
    else { const int it3 = item - (64 * 256 + 64 * 128); const int l = it3 / 192, r = it3 % 192; kb = r / 24; nb = r % 24; t.N = INW; t.mode = 2; t.scale = SC_WIN;
        t.src = win + (size_t)l * 1024 * INW; t.dst = WI8 + (size_t)l * 1536 * 1024; }
    const int k0 = 128 * kb + 64 * half; t.n0 = 64 * nb;
    t.src += (size_t)(k0 + (lane >> 4)) * t.N + t.n0 + 4 * (lane & 15);
    t.dst += (size_t)k0;
    return t;
}
__device__ __forceinline__ void fp8_sub_load(const SubT& t, f32x4 (&ld)[16]) {
#pragma unroll
    for (int i = 0; i < 16; ++i) ld[i] = __builtin_nontemporal_load((const f32x4*)(t.src + (size_t)(4 * i) * t.N));
}
__device__ __forceinline__ void fp8_sub_process(const SubT& t, const f32x4 (&ld)[16], LAS float* scr, int lane) {
#pragma unroll
    for (int i = 0; i < 16; ++i) *(LAS f32x4*)(scr + (4 * i + (lane >> 4)) * 64 + 4 * (lane & 15)) = ld[i];
    LDS_WAIT(); asm volatile("" ::: "memory");
    unsigned w[16];
#pragma unroll
    for (int q = 0; q < 16; ++q) w[q] = pg8::pk4_fp8(scr[(4 * q + 0) * 64 + lane] * t.scale, scr[(4 * q + 1) * 64 + lane] * t.scale, scr[(4 * q + 2) * 64 + lane] * t.scale, scr[(4 * q + 3) * 64 + lane] * t.scale);
    LDS_WAIT(); asm volatile("" ::: "memory");
    LAS unsigned char* t2 = (LAS unsigned char*)scr;
#pragma unroll
    for (int q = 0; q < 4; ++q) *(LAS v4u*)(t2 + lane * 80 + 16 * q) = (v4u){w[4 * q], w[4 * q + 1], w[4 * q + 2], w[4 * q + 3]};
    LDS_WAIT(); asm volatile("" ::: "memory");
#pragma unroll
    for (int q = 0; q < 4; ++q) { const int n = 16 * q + (lane >> 2); const v4u v = *(const LAS v4u*)(t2 + n * 80 + 16 * (lane & 3));
        const int nn = (t.mode == 1) ? wgu_dest_row(t.n0 + n) : (t.mode == 2) ? win_dest_row(t.n0 + n) : (t.n0 + n);
        *(GAS v4u*)(t.dst + (size_t)nn * 1024 + 16 * (lane & 3)) = v; }
    LDS_WAIT(); asm volatile("" ::: "memory");
}
__device__ __forceinline__ void row_dt(const f32x4 (&v)[4], const float* wdt, float* dst, int lane) {
    float r[8];
#pragma unroll
    for (int jj = 0; jj < 8; ++jj) { float s = 0.f;
#pragma unroll
        for (int j = 0; j < 4; ++j) { const f32x4 w = *(const f32x4*)(wdt + jj * 1024 + 4 * lane + 256 * j); s += v[j][0] * w[0] + v[j][1] * w[1] + v[j][2] * w[2] + v[j][3] * w[3]; }
        r[jj] = wave_sum(s); }
    if (lane == 0) { *(f32x4*)dst = (f32x4){r[0], r[1], r[2], r[3]}; *(f32x4*)(dst + 4) = (f32x4){r[4], r[5], r[6], r[7]}; }
}
__device__ __forceinline__ void load_wdt(const float* wdt, f32x4 (&w)[8][4], int lane) {
#pragma unroll
    for (int jj = 0; jj < 8; ++jj)
#pragma unroll
        for (int j = 0; j < 4; ++j) w[jj][j] = *(const f32x4*)(wdt + jj * 1024 + 4 * lane + 256 * j);
}
__device__ __forceinline__ void row_dt_w(const f32x4 (&v)[4], const f32x4 (&w)[8][4], float* dst, int lane) {
    float r[8];
#pragma unroll
    for (int jj = 0; jj < 8; ++jj) { float s = 0.f;
#pragma unroll
        for (int j = 0; j < 4; ++j) s += v[j][0] * w[jj][j][0] + v[j][1] * w[jj][j][1] + v[j][2] * w[jj][j][2] + v[j][3] * w[jj][j][3];
        r[jj] = wave_sum(s); }
    if (lane == 0) { *(f32x4*)dst = (f32x4){r[0], r[1], r[2], r[3]}; *(f32x4*)(dst + 4) = (f32x4){r[4], r[5], r[6], r[7]}; }
}
__device__ __forceinline__ void row_dt_win(const f32x4 (&v)[4], const float* win, float* dst, int lane) {
    float r[8];
#pragma unroll
    for (int jj = 0; jj < 8; ++jj) r[jj] = 0.f;
#pragma unroll
    for (int j = 0; j < 4; ++j)
#pragma unroll
        for (int e = 0; e < 4; ++e) { const float* wp = win + (size_t)(4 * lane + 256 * j + e) * INW + 3072; const f32x4 w0 = *(const f32x4*)wp, w1 = *(const f32x4*)(wp + 4); const float x = v[j][e];
            r[0] += x * w0[0]; r[1] += x * w0[1]; r[2] += x * w0[2]; r[3] += x * w0[3]; r[4] += x * w1[0]; r[5] += x * w1[1]; r[6] += x * w1[2]; r[7] += x * w1[3]; }
#pragma unroll
    for (int jj = 0; jj < 8; ++jj) r[jj] = wave_sum(r[jj]);
    if (lane == 0) { *(f32x4*)dst = (f32x4){r[0], r[1], r[2], r[3]}; *(f32x4*)(dst + 4) = (f32x4){r[4], r[5], r[6], r[7]}; }
}
template <bool W8, bool WF>
__device__ __forceinline__ void ln_row(f32x4 (&v)[4], const float* gam, const float* bet, float* of32, bf16* ob16, unsigned char* o8, float s8, int lane) {
    float s = 0.f;
#pragma unroll
    for (int j = 0; j < 4; ++j) s += (v[j][0] + v[j][1]) + (v[j][2] + v[j][3]);
    const float mean = wave_sum(s) * (1.f / DM); float s2 = 0.f;
#pragma unroll
    for (int j = 0; j < 4; ++j) { v[j] = v[j] - mean; s2 += (v[j][0] * v[j][0] + v[j][1] * v[j][1]) + (v[j][2] * v[j][2] + v[j][3] * v[j][3]); }
    const float rstd = 1.f / sqrtf(wave_sum(s2) * (1.f / DM) + LN_EPS);
#pragma unroll
    for (int j = 0; j < 4; ++j) { const f32x4 g = *(const f32x4*)(gam + 4 * lane + 256 * j), b = *(const f32x4*)(bet + 4 * lane + 256 * j);
        v[j] = v[j] * rstd * g + b;
        if (WF) *(f32x4*)(of32 + 4 * lane + 256 * j) = v[j];
        v2u w; w.x = pk2(v[j][0], v[j][1]); w.y = pk2(v[j][2], v[j][3]); *(v2u*)(ob16 + 4 * lane + 256 * j) = w;
        if (W8) *(unsigned*)(o8 + 4 * lane + 256 * j) = pg8::pk4_fp8(v[j][0] * s8, v[j][1] * s8, v[j][2] * s8, v[j][3] * s8); }
}


typedef short v4i16_t __attribute__((ext_vector_type(4)));
__device__ __forceinline__ bf16x8 tr_pair(const LAS unsigned char* p0, const LAS unsigned char* p1) {
    const v4i16_t a = __builtin_amdgcn_ds_read_tr16_b64_v4i16((LAS v4i16_t*)p0), b = __builtin_amdgcn_ds_read_tr16_b64_v4i16((LAS v4i16_t*)p1);
    return (bf16x8){a[0], a[1], a[2], a[3], b[0], b[1], b[2], b[3]};
}
__device__ __forceinline__ int crow16(int r, int hi) { return (r & 3) + 8 * (r >> 2) + 4 * hi; }
constexpr int AK_PITCH = 144, AV_PITCH = 192, AK_TILE = 32 * AK_PITCH, AV_TILE = 32 * AV_PITCH;
constexpr int AT_K = 0, AT_V = 12 * AK_TILE;
struct AttnItem { int p, b, h, d, r, qt0; };
__device__ __forceinline__ AttnItem attn_item(int I) { AttnItem a; a.p = I >> 10; const int rem = I & 1023; a.b = rem >> 7; a.h = (rem >> 4) & 7; const int grp = rem & 15;
    a.d = (a.p == 0) ? 1 : (a.p == 1) ? 4 : 16; const int tpr = 128 / a.d; const int T = grp * 8; a.r = T / tpr; a.qt0 = T % tpr; return a; }
__device__ __forceinline__ void attn_request(const bf16* PROJ, const AttnItem& a, v4u (&st)[12], int tid) {
    const int rr = tid >> 4, ch = tid & 15; const int col = (ch < 8 ? C_K : C_V - 64) + a.h * 64 + ch * 8;
#pragma unroll
    for (int tl = 0; tl < 12; ++tl) { const int kt = a.qt0 - 4 + tl; st[tl] = (v4u){0u, 0u, 0u, 0u};
        if (kt >= 0) { const size_t row = (size_t)a.b * SEQ + (size_t)(32 * kt + rr) * a.d + a.r; st[tl] = *(const v4u*)(PROJ + row * NPROJ + col); } }
}
__device__ __forceinline__ void attn_deposit(LAS unsigned char* al, const v4u (&st)[12], int tid) {
    const int rr = tid >> 4, ch = tid & 15;
    LAS unsigned char* dst = (ch < 8) ? (al + AT_K + rr * AK_PITCH + ch * 16) : (al + AT_V + rr * AV_PITCH + (ch - 8) * 16); const int tstep = (ch < 8) ? AK_TILE : AV_TILE;
#pragma unroll
    for (int tl = 0; tl < 12; ++tl) *(LAS v4u*)(dst + tl * tstep) = st[tl];
}
__device__ __forceinline__ void attn_wave_compute(const bf16* PROJ, bf16* OPp, float* LSEp, const AttnItem& a, const LAS unsigned char* al, int wave, int lane) {
    const int i = lane & 31, h2 = lane >> 5; const int qt = a.qt0 + wave;
    const size_t rowq = (size_t)a.b * SEQ + (size_t)(32 * qt + i) * a.d + a.r;
    bf16x8 qf[4];
    { const bf16* qp = PROJ + rowq * NPROJ + C_Q + a.h * 64 + 8 * h2;
#pragma unroll
      for (int s = 0; s < 4; ++s) qf[s] = *(const bf16x8*)(qp + 16 * s); }
    f32x16 o0 = {}, o1 = {}; float mrun = -INFINITY, lrun = 0.f;
    const int kt0 = qt > 4 ? qt - 4 : 0;
    const LAS unsigned char* krd = al + AT_K + i * AK_PITCH + 16 * h2;
    const LAS unsigned char* trb = al + AT_V + (4 * h2 + ((lane & 15) >> 2)) * AV_PITCH + (16 * ((lane >> 4) & 1) + 4 * (lane & 3)) * 2;
#define ATT_QK(S, ktx) do { const LAS unsigned char* kp_ = krd + ((ktx) - a.qt0 + 4) * AK_TILE; \
        S = __builtin_amdgcn_mfma_f32_32x32x16_bf16(*(const LAS bf16x8*)(kp_), qf[0], (f32x16){}, 0, 0, 0); \
        _Pragma("unroll") for (int s = 1; s < 4; ++s) S = __builtin_amdgcn_mfma_f32_32x32x16_bf16(*(const LAS bf16x8*)(kp_ + 32 * s), qf[s], S, 0, 0, 0); } while (0)
#define ATT_STEP(S, ktx) do { const LAS unsigned char* vp = trb + ((ktx) - a.qt0 + 4) * AV_TILE; \
        if ((ktx) == qt) { asm volatile("; causal mask"); _Pragma("unroll") for (int rg = 0; rg < 16; ++rg) if (crow16(rg, h2) > i) S[rg] = -INFINITY; } \
        if ((ktx) + 4 == qt) { asm volatile("; window mask"); _Pragma("unroll") for (int rg = 0; rg < 16; ++rg) if (crow16(rg, h2) < i) S[rg] = -INFINITY; } \
        float mx = S[0]; \
        _Pragma("unroll") for (int rg = 1; rg < 16; ++rg) mx = fmaxf(mx, S[rg]); \
        mx = fmaxf(mx, __shfl_xor(mx, 32)); \
        const float mnew = fmaxf(mrun, mx), alpha = __builtin_amdgcn_exp2f(mrun - mnew); mrun = mnew; \
        float ps = 0.f; \
        _Pragma("unroll") for (int rg = 0; rg < 16; ++rg) { S[rg] = __builtin_amdgcn_exp2f(S[rg] - mnew); ps += S[rg]; } \
        lrun = lrun * alpha + ps; \
        _Pragma("unroll") for (int rg = 0; rg < 16; ++rg) { o0[rg] *= alpha; o1[rg] *= alpha; } \
        bf16x8 pf[2]; \
        _Pragma("unroll") for (int ks = 0; ks < 2; ++ks) { v4u w; w.x = pg8::cvt_pk_bf16(S[8 * ks + 0], S[8 * ks + 1]); w.y = pg8::cvt_pk_bf16(S[8 * ks + 2], S[8 * ks + 3]); w.z = pg8::cvt_pk_bf16(S[8 * ks + 4], S[8 * ks + 5]); w.w = pg8::cvt_pk_bf16(S[8 * ks + 6], S[8 * ks + 7]); pf[ks] = __builtin_bit_cast(bf16x8, w); } \
        _Pragma("unroll") for (int ks = 0; ks < 2; ++ks) { \
            const bf16x8 v0 = tr_pair(vp + (16 * ks) * AV_PITCH, vp + (16 * ks + 8) * AV_PITCH); \
            const bf16x8 v1 = tr_pair(vp + (16 * ks) * AV_PITCH + 64, vp + (16 * ks + 8) * AV_PITCH + 64); \
            o0 = __builtin_amdgcn_mfma_f32_32x32x16_bf16(v0, pf[ks], o0, 0, 0, 0); \
            o1 = __builtin_amdgcn_mfma_f32_32x32x16_bf16(v1, pf[ks], o1, 0, 0, 0); } } while (0)
    f32x16 sA, sB;
    ATT_QK(sA, kt0);
#pragma unroll 1
    for (int kt = kt0; ; kt += 2) {
        if (kt < qt) ATT_QK(sB, kt + 1);
        ATT_STEP(sA, kt);
        if (kt >= qt) break;
        if (kt + 1 < qt) ATT_QK(sA, kt + 2);
        ATT_STEP(sB, kt + 1);
        if (kt + 1 >= qt) break;
    }
#undef ATT_QK
#undef ATT_STEP
    const float lt = lrun + __shfl_xor(lrun, 32); const float il = 1.0f / lt;
    unsigned char* op = (unsigned char*)OPp + rowq * 512 + a.h * 64 + 4 * h2;
    const float ils = il * SC_O;
#pragma unroll
    for (int g4 = 0; g4 < 4; ++g4) {
        *(unsigned*)(op + 8 * g4) = pg8::pk4_fp8(o0[4 * g4 + 0] * ils, o0[4 * g4 + 1] * ils, o0[4 * g4 + 2] * ils, o0[4 * g4 + 3] * ils);
        *(unsigned*)(op + 32 + 8 * g4) = pg8::pk4_fp8(o1[4 * g4 + 0] * ils, o1[4 * g4 + 1] * ils, o1[4 * g4 + 2] * ils, o1[4 * g4 + 3] * ils); }
    if (h2 == 0) LSEp[rowq * 8 + a.h] = mrun + log2f(lt);
}
__device__ __forceinline__ void attn_phase(LAS unsigned char* al, const bf16* PROJ, bf16* OP, float* LSE, int bid, int G, int tid, int wave, int lane) {
    v4u st[12];
    int I = bid;
    if (I < 3072) { const AttnItem a = attn_item(I); attn_request(PROJ, a, st, tid); }
    for (; I < 3072; I += G) {
        const AttnItem a = attn_item(I);
        __syncthreads();
        attn_deposit(al, st, tid);
        __syncthreads();
        if (I + G < 3072) { const AttnItem n = attn_item(I + G); attn_request(PROJ, n, st, tid); }
        attn_wave_compute(PROJ, (bf16*)((unsigned char*)OP + (size_t)a.p * MROWS * 512), LSE + (size_t)a.p * MROWS * 8, a, al, wave, lane);
    }
    __syncthreads();
}

constexpr int SS_DTS = 0, SS_ACUM = 2048, SS_TMP = 4096, SS_SSX = 6144, SS_IMG = 8192;
constexpr int S1_PB = 320, S1_PX = 576;
constexpr int S1_B = SS_IMG, S1_X = SS_IMG + 128 * S1_PB;
constexpr int S3_PBC = 272, S3_PX = 576;
constexpr int S3_B = SS_IMG, S3_C = S3_B + 128 * S3_PBC, S3_X = S3_C + 128 * S3_PBC;

__device__ __forceinline__ void ssd_prep(LAS unsigned char* sl, const float* DT, const float* dtb, const float* alog, size_t row0, int g, int tid, int lane, int wave) {
    LAS float* dts = (LAS float*)(sl + SS_DTS); LAS float* acum = (LAS float*)(sl + SS_ACUM); LAS float* tmp = (LAS float*)(sl + SS_TMP);
    { const int l = tid >> 2, hq = tid & 3; const float x = DT[(row0 + l) * 8 + 4 * g + hq] + dtb[4 * g + hq];
      const float dt = x > 20.f ? x : log1pf(__expf(x)); dts[hq * 128 + l] = dt; tmp[hq * 128 + l] = dt * (-__expf(alog[4 * g + hq]) * 1.4426950408889634f); }
    __syncthreads();
    if (wave < 4) { const float v0 = tmp[wave * 128 + 2 * lane], v1 = tmp[wave * 128 + 2 * lane + 1]; float s = v0 + v1;
#pragma unroll
        for (int off = 1; off < 64; off <<= 1) { const float t = __shfl_up(s, off); if (lane >= off) s += t; }
        acum[wave * 128 + 2 * lane] = s - v1; acum[wave * 128 + 2 * lane + 1] = s; }
    __syncthreads();
}
template <int NCOLS, int FACMODE>
__device__ __forceinline__ void conv_tile(const bf16* PROJ, size_t row0, int t0, int pcol0, const float* cw, const float* cb, int cch0, LAS unsigned char* dst, int pitch, const LAS unsigned char* sl, int hq0, int tid) {
    constexpr int NCH8 = NCOLS / 8, NSEG = 512 / NCH8, RPS = 128 / NSEG;
    const int c8 = tid % NCH8, seg = tid / NCH8, l0 = seg * RPS;
    float w[4][8], bias[8], hst[3][8];
#pragma unroll
    for (int k = 0; k < 4; ++k) { const f32x4 a = *(const f32x4*)(cw + k * 1024 + cch0 + c8 * 8), b = *(const f32x4*)(cw + k * 1024 + cch0 + c8 * 8 + 4);
        w[k][0] = a[0]; w[k][1] = a[1]; w[k][2] = a[2]; w[k][3] = a[3]; w[k][4] = b[0]; w[k][5] = b[1]; w[k][6] = b[2]; w[k][7] = b[3]; }
    { const f32x4 a = *(const f32x4*)(cb + cch0 + c8 * 8), b = *(const f32x4*)(cb + cch0 + c8 * 8 + 4);
      bias[0] = a[0]; bias[1] = a[1]; bias[2] = a[2]; bias[3] = a[3]; bias[4] = b[0]; bias[5] = b[1]; bias[6] = b[2]; bias[7] = b[3]; }
    const bf16* src = PROJ + pcol0 + c8 * 8;
#pragma unroll
    for (int k = 0; k < 3; ++k) { const int l = l0 - 3 + k; v4u v = (v4u){0u, 0u, 0u, 0u}; if (t0 + l >= 0) v = *(const v4u*)(src + (size_t)((long)row0 + l) * NPROJ);
        hst[k][0] = bflo(v.x); hst[k][1] = bfhi(v.x); hst[k][2] = bflo(v.y); hst[k][3] = bfhi(v.y); hst[k][4] = bflo(v.z); hst[k][5] = bfhi(v.z); hst[k][6] = bflo(v.w); hst[k][7] = bfhi(v.w); }
    const LAS float* dts = (const LAS float*)(sl + SS_DTS); const LAS float* acum = (const LAS float*)(sl + SS_ACUM);
    const int hq = hq0 + (c8 * 8) / 64;
    const float alast = (FACMODE == 2) ? acum[hq * 128 + 127] : 0.f;
#pragma unroll
    for (int rr = 0; rr < RPS; ++rr) { const int l = l0 + rr; const v4u v = *(const v4u*)(src + (row0 + l) * NPROJ);
        float cur[8]; cur[0] = bflo(v.x); cur[1] = bfhi(v.x); cur[2] = bflo(v.y); cur[3] = bfhi(v.y); cur[4] = bflo(v.z); cur[5] = bfhi(v.z); cur[6] = bflo(v.w); cur[7] = bfhi(v.w);
        float f = 1.f; if (FACMODE >= 1) f = dts[hq * 128 + l]; if (FACMODE == 2) f *= __builtin_amdgcn_exp2f(alast - acum[hq * 128 + l]);
        float o[8];
#pragma unroll
        for (int e = 0; e < 8; ++e) { const float a = bias[e] + w[0][e] * hst[0][e] + w[1][e] * hst[1][e] + w[2][e] * hst[2][e] + w[3][e] * cur[e]; o[e] = siluf(a) * f;
            hst[0][e] = hst[1][e]; hst[1][e] = hst[2][e]; hst[2][e] = cur[e]; }
        v4u ov; ov.x = pk2(o[0], o[1]); ov.y = pk2(o[2], o[3]); ov.z = pk2(o[4], o[5]); ov.w = pk2(o[6], o[7]);
        *(LAS v4u*)(dst + l * pitch + c8 * 16) = ov; }
}
template <int NCOLS>
__device__ __forceinline__ void conv_load(const bf16* PROJ, size_t row0, int t0, int pcol0, int tid, v4u (&hv)[3], v4u (&rv)[128 / (512 / (NCOLS / 8))]) {
    constexpr int NCH8 = NCOLS / 8, NSEG = 512 / NCH8, RPS = 128 / NSEG;
    const int c8 = tid % NCH8, seg = tid / NCH8, l0 = seg * RPS;
    const bf16* src = PROJ + pcol0 + c8 * 8;
#pragma unroll
    for (int k = 0; k < 3; ++k) { const int l = l0 - 3 + k; hv[k] = (v4u){0u, 0u, 0u, 0u}; if (t0 + l >= 0) hv[k] = *(const v4u*)(src + (size_t)((long)row0 + l) * NPROJ); }
#pragma unroll
    for (int rr = 0; rr < RPS; ++rr) rv[rr] = *(const v4u*)(src + (row0 + l0 + rr) * NPROJ);
}
template <int NCOLS, int FACMODE>
__device__ __forceinline__ void conv_apply(const v4u (&hv)[3], const v4u (&rv)[128 / (512 / (NCOLS / 8))], const float* cw, const float* cb, int cch0, LAS unsigned char* dst, int pitch, const LAS unsigned char* sl, int hq0, int tid) {
    constexpr int NCH8 = NCOLS / 8, NSEG = 512 / NCH8, RPS = 128 / NSEG;
    const int c8 = tid % NCH8, seg = tid / NCH8, l0 = seg * RPS;
    float w[4][8], bias[8], hst[3][8];
#pragma unroll
    for (int k = 0; k < 4; ++k) { const f32x4 a = *(const f32x4*)(cw + k * 1024 + cch0 + c8 * 8), b = *(const f32x4*)(cw + k * 1024 + cch0 + c8 * 8 + 4);
        w[k][0] = a[0]; w[k][1] = a[1]; w[k][2] = a[2]; w[k][3] = a[3]; w[k][4] = b[0]; w[k][5] = b[1]; w[k][6] = b[2]; w[k][7] = b[3]; }
    { const f32x4 a = *(const f32x4*)(cb + cch0 + c8 * 8), b = *(const f32x4*)(cb + cch0 + c8 * 8 + 4);
      bias[0] = a[0]; bias[1] = a[1]; bias[2] = a[2]; bias[3] = a[3]; bias[4] = b[0]; bias[5] = b[1]; bias[6] = b[2]; bias[7] = b[3]; }
#pragma unroll
    for (int k = 0; k < 3; ++k) { const v4u v = hv[k];
        hst[k][0] = bflo(v.x); hst[k][1] = bfhi(v.x); hst[k][2] = bflo(v.y); hst[k][3] = bfhi(v.y); hst[k][4] = bflo(v.z); hst[k][5] = bfhi(v.z); hst[k][6] = bflo(v.w); hst[k][7] = bfhi(v.w); }
    const LAS float* dts = (const LAS float*)(sl + SS_DTS); const LAS float* acum = (const LAS float*)(sl + SS_ACUM);
    const int hq = hq0 + (c8 * 8) / 64;
    const float alast = (FACMODE == 2) ? acum[hq * 128 + 127] : 0.f;
#pragma unroll
    for (int rr = 0; rr < RPS; ++rr) { const int l = l0 + rr; const v4u v = rv[rr];
        float cur[8]; cur[0] = bflo(v.x); cur[1] = bfhi(v.x); cur[2] = bflo(v.y); cur[3] = bfhi(v.y); cur[4] = bflo(v.z); cur[5] = bfhi(v.z); cur[6] = bflo(v.w); cur[7] = bfhi(v.w);
        float f = 1.f; if (FACMODE >= 1) f = dts[hq * 128 + l]; if (FACMODE == 2) f *= __builtin_amdgcn_exp2f(alast - acum[hq * 128 + l]);
        float o[8];
#pragma unroll
        for (int e = 0; e < 8; ++e) { const float a = bias[e] + w[0][e] * hst[0][e] + w[1][e] * hst[1][e] + w[2][e] * hst[2][e] + w[3][e] * cur[e]; o[e] = siluf(a) * f;
            hst[0][e] = hst[1][e]; hst[1][e] = hst[2][e]; hst[2][e] = cur[e]; }
        v4u ov; ov.x = pk2(o[0], o[1]); ov.y = pk2(o[2], o[3]); ov.z = pk2(o[4], o[5]); ov.w = pk2(o[6], o[7]);
        *(LAS v4u*)(dst + l * pitch + c8 * 16) = ov; }
}
__device__ __forceinline__ void ssd_s1_unit(LAS unsigned char* sl, const bf16* PROJ, const float* DT, const float* dtb, const float* alog, const float* cw, const float* cb, float* ST, float* CDEC, int un, int tid, int lane, int wave) {
    const int g = un & 1, bc = un >> 1; const size_t row0 = (size_t)bc * 128; const int t0 = (bc & 31) * 128;
    v4u hvB[3], rvB[4], hvX[3], rvX[8];
    conv_load<128>(PROJ, row0, t0, C_XS + 512 + g * 128, tid, hvB, rvB);
    conv_load<256>(PROJ, row0, t0, C_XS + g * 256, tid, hvX, rvX);
    __syncthreads();
    ssd_prep(sl, DT, dtb, alog, row0, g, tid, lane, wave);
    conv_apply<128, 0>(hvB, rvB, cw, cb, 512 + g * 128, sl + S1_B, S1_PB, sl, 0, tid);
    conv_apply<256, 2>(hvX, rvX, cw, cb, g * 256, sl + S1_X, S1_PX, sl, 0, tid);
    if (tid < 4) CDEC[(size_t)bc * 8 + 4 * g + tid] = __builtin_amdgcn_exp2f(((const LAS float*)(sl + SS_ACUM))[tid * 128 + 127]);
    __syncthreads();
    const int hq = wave >> 1, pt = wave & 1, h2 = lane >> 5, q = (lane & 15) >> 2, pp = lane & 3, dsel = (lane >> 4) & 1;
    const LAS unsigned char* xb = sl + S1_X + (8 * h2 + q) * S1_PX + (hq * 64 + pt * 32 + 16 * dsel + 4 * pp) * 2;
    const LAS unsigned char* bb = sl + S1_B + (8 * h2 + q) * S1_PB + (16 * dsel + 4 * pp) * 2;
    f32x16 acc[4];
#pragma unroll
    for (int nt = 0; nt < 4; ++nt) acc[nt] = (f32x16){};
#pragma unroll
    for (int ks = 0; ks < 8; ++ks) { const bf16x8 a = tr_pair(xb + (16 * ks) * S1_PX, xb + (16 * ks + 4) * S1_PX);
#pragma unroll
        for (int nt = 0; nt < 4; ++nt) { const bf16x8 b = tr_pair(bb + (16 * ks) * S1_PB + nt * 64, bb + (16 * ks + 4) * S1_PB + nt * 64); acc[nt] = __builtin_amdgcn_mfma_f32_32x32x16_bf16(a, b, acc[nt], 0, 0, 0); } }
    float* sp = ST + ((size_t)(bc * 8 + 4 * g + hq) * 64 + pt * 32) * 128 + (lane & 31);
#pragma unroll
    for (int nt = 0; nt < 4; ++nt)
#pragma unroll
        for (int rg = 0; rg < 16; ++rg) sp[(size_t)crow16(rg, h2) * 128 + 32 * nt] = acc[nt][rg];
}
__device__ __forceinline__ void ssd_s3_unit(LAS unsigned char* sl, const bf16* PROJ, const float* DT, const float* dtb, const float* alog, const float* cw, const float* cb, const float* dsk, const float* ng,
                                            const bf16* HIN, bf16* MIXED, int un, int tid, int lane, int wave) {
    const int g = un & 1, bc = un >> 1; const size_t row0 = (size_t)bc * 128; const int t0 = (bc & 31) * 128;
    const int lt = wave & 3, ph = wave >> 2, lq = lane & 31, hi = lane >> 5, q = (lane & 15) >> 2, pp = lane & 3, dsel = (lane >> 4) & 1;
    const int lrow = 32 * lt + lq;
    const size_t grow = row0 + lrow;
    v4u hvB[3], rvB[4], hvC[3], rvC[4], hvX[3], rvX[8];
    conv_load<128>(PROJ, row0, t0, C_XS + 512 + g * 128, tid, hvB, rvB);
    conv_load<128>(PROJ, row0, t0, C_XS + 768 + g * 128, tid, hvC, rvC);
    conv_load<256>(PROJ, row0, t0, C_XS + g * 256, tid, hvX, rvX);
    __syncthreads();
    ssd_prep(sl, DT, dtb, alog, row0, g, tid, lane, wave);
    conv_apply<128, 0>(hvB, rvB, cw, cb, 512 + g * 128, sl + S3_B, S3_PBC, sl, 0, tid);
    conv_apply<128, 0>(hvC, rvC, cw, cb, 768 + g * 128, sl + S3_C, S3_PBC, sl, 0, tid);
    conv_apply<256, 1>(hvX, rvX, cw, cb, g * 256, sl + S3_X, S3_PX, sl, 0, tid);
    bf16x8 hf[2][8];
    const bf16* hp0 = HIN + ((size_t)(bc * 8 + 4 * g) * 64 + ph * 32 + lq) * 128 + 8 * hi;
#pragma unroll
    for (int hq = 0; hq < 2; ++hq)
#pragma unroll
        for (int ks = 0; ks < 8; ++ks) hf[hq][ks] = *(const bf16x8*)(hp0 + (size_t)hq * 8192 + 16 * ks);
    __syncthreads();
    const LAS float* dts = (const LAS float*)(sl + SS_DTS); const LAS float* acum = (const LAS float*)(sl + SS_ACUM); LAS float* ssx = (LAS float*)(sl + SS_SSX);
    const LAS unsigned char* crd = sl + S3_C + lrow * S3_PBC + 16 * hi;
    f32x16 y[4];
#pragma unroll
    for (int hq = 0; hq < 4; ++hq) {
        f32x16 t = (f32x16){};
#pragma unroll
        for (int ks = 0; ks < 8; ++ks) t = __builtin_amdgcn_mfma_f32_32x32x16_bf16(hf[hq & 1][ks], *(const LAS bf16x8*)(crd + 32 * ks), t, 0, 0, 0);
        if (hq < 2) {
#pragma unroll
            for (int ks = 0; ks < 8; ++ks) hf[hq & 1][ks] = *(const bf16x8*)(hp0 + (size_t)(hq + 2) * 8192 + 16 * ks); }
        const float ea = __builtin_amdgcn_exp2f(acum[hq * 128 + lrow]);
#pragma unroll
        for (int rg = 0; rg < 16; ++rg) t[rg] *= ea;
        y[hq] = t; }
    v2u zr[4][4];
#pragma unroll
    for (int hq = 0; hq < 4; ++hq)
#pragma unroll
        for (int g4 = 0; g4 < 4; ++g4) zr[hq][g4] = *(const v2u*)(PROJ + grow * NPROJ + C_Z + g * 256 + hq * 64 + ph * 32 + 8 * g4 + 4 * hi);
#pragma unroll
    for (int st = 0; st < 4; ++st) if (st <= lt) {
        f32x16 ag = (f32x16){};
        { const LAS unsigned char* brd = sl + S3_B + (32 * st + lq) * S3_PBC + 16 * hi;
#pragma unroll
          for (int ks = 0; ks < 8; ++ks) ag = __builtin_amdgcn_mfma_f32_32x32x16_bf16(*(const LAS bf16x8*)(brd + 32 * ks), *(const LAS bf16x8*)(crd + 32 * ks), ag, 0, 0, 0); }
#pragma unroll
        for (int hq = 0; hq < 4; ++hq) {
            const float al = acum[hq * 128 + lrow], dd = dsk[4 * g + hq] * __builtin_amdgcn_rcpf(dts[hq * 128 + lrow]);
            const LAS unsigned char* xb = sl + S3_X + (4 * hi + q) * S3_PX + (hq * 64 + ph * 32 + 16 * dsel + 4 * pp) * 2;
            float pm[16];
#pragma unroll
            for (int g4 = 0; g4 < 4; ++g4) { const f32x4 as4 = *(const LAS f32x4*)(acum + hq * 128 + 32 * st + 8 * g4 + 4 * hi);
#pragma unroll
                for (int e = 0; e < 4; ++e) { const int rg = 4 * g4 + e; float v = ag[rg] * __builtin_amdgcn_exp2f(al - as4[e]);
                    if (st == lt) { const int sl_ = 8 * g4 + 4 * hi + e; if (sl_ > lq) v = 0.f; if (sl_ == lq) v += dd; }
                    pm[rg] = v; } }
#pragma unroll
            for (int ks = 0; ks < 2; ++ks) { v4u wv; wv.x = pg8::cvt_pk_bf16(pm[8 * ks + 0], pm[8 * ks + 1]); wv.y = pg8::cvt_pk_bf16(pm[8 * ks + 2], pm[8 * ks + 3]); wv.z = pg8::cvt_pk_bf16(pm[8 * ks + 4], pm[8 * ks + 5]); wv.w = pg8::cvt_pk_bf16(pm[8 * ks + 6], pm[8 * ks + 7]);
                const bf16x8 xt = tr_pair(xb + (32 * st + 16 * ks) * S3_PX, xb + (32 * st + 16 * ks + 8) * S3_PX);
                y[hq] = __builtin_amdgcn_mfma_f32_32x32x16_bf16(xt, __builtin_bit_cast(bf16x8, wv), y[hq], 0, 0, 0); }
        }
    }
    unsigned ayp[4][8]; float ss = 0.f;
#pragma unroll
    for (int hq = 0; hq < 4; ++hq)
#pragma unroll
        for (int g4 = 0; g4 < 4; ++g4) { const v2u z = zr[hq][g4];
            const float y0 = y[hq][4 * g4 + 0] * siluf(bflo(z.x)), y1 = y[hq][4 * g4 + 1] * siluf(bfhi(z.x)), y2 = y[hq][4 * g4 + 2] * siluf(bflo(z.y)), y3 = y[hq][4 * g4 + 3] * siluf(bfhi(z.y));
            ss += (y0 * y0 + y1 * y1) + (y2 * y2 + y3 * y3);
            ayp[hq][2 * g4] = pg8::cvt_pk_bf16(y0, y1); ayp[hq][2 * g4 + 1] = pg8::cvt_pk_bf16(y2, y3); }
    ss += __shfl_xor(ss, 32);
    if (hi == 0) ssx[ph * 128 + lrow] = ss;
    __syncthreads();
    const float rs = 1.0f / sqrtf((ssx[lrow] + ssx[128 + lrow]) * (1.f / 256.f) + RMS_EPS);
#pragma unroll
    for (int hq = 0; hq < 4; ++hq)
#pragma unroll
        for (int g4 = 0; g4 < 4; ++g4) { const int ch = hq * 64 + ph * 32 + 8 * g4 + 4 * hi; const f32x4 gn = *(const f32x4*)(ng + g * 256 + ch);
            const unsigned p0 = ayp[hq][2 * g4], p1 = ayp[hq][2 * g4 + 1];
            v2u o; o.x = pg8::cvt_pk_bf16(bflo(p0) * rs * gn[0], bfhi(p0) * rs * gn[1]); o.y = pg8::cvt_pk_bf16(bflo(p1) * rs * gn[2], bfhi(p1) * rs * gn[3]);
            *(v2u*)(MIXED + grow * MIXW + 512 + g * 256 + ch) = o; }
}

struct Args { const float* in[20]; float* out; unsigned char* ws; int ph_lo, ph_hi, sub, pad; };
constexpr int NWAVES = 8;
constexpr int PH_PER_LAYER = 10, N_PHASES = 1 + NLAYER * PH_PER_LAYER;

#define in_x (args.in[0])
#define in_win (args.in[1])
#define in_convw (args.in[2])
#define in_convb (args.in[3])
#define in_dtb (args.in[4])
#define in_alog (args.in[5])
#define in_dsk (args.in[6])
#define in_ng (args.in[7])
#define in_scw (args.in[8])
#define in_wout (args.in[9])
#define in_ln1g (args.in[10])
#define in_ln1b (args.in[11])
#define in_rw (args.in[12])
#define in_rb (args.in[13])
#define in_wgu (args.in[14])
#define in_bgu (args.in[15])
#define in_wdn (args.in[16])
#define in_bdn (args.in[17])
#define in_ln2g (args.in[18])
#define in_ln2b (args.in[19])
#define ROPE ((float*)(args.ws + WS_ROPE))
#define WDT ((float*)(args.ws + WS_WDT))
#define ROUT ((bf16*)(args.ws + WS_ROUT))
#define WIN ((bf16*)(args.ws + WS_WIN))
#define WOUT ((bf16*)(args.ws + WS_WOUT))
#define WGU ((bf16*)(args.ws + WS_WGU))
#define WDN ((bf16*)(args.ws + WS_WDN))
#define XB ((bf16*)(args.ws + WS_XB))
#define XF ((float*)(args.ws + WS_XF))
#define XF2 ((float*)(args.ws + WS_XF2))
#define PROJ ((bf16*)(args.ws + WS_PROJ))
#define DT ((float*)(args.ws + WS_DT))
#define DTS ((float*)(args.ws + WS_DTS))
#define ACUM ((float*)(args.ws + WS_ACUM))
#define LSE ((float*)(args.ws + WS_LSE))
#define OP ((bf16*)(args.ws + WS_OP))
#define U ((bf16*)(args.ws + WS_U))
#define GB ((float*)(args.ws + WS_G))
#define ST ((float*)(args.ws + WS_ST))
#define YD ((float*)(args.ws + WS_YD))
#define MIXED ((bf16*)(args.ws + WS_MIXED))
#define MIXF ((bf16*)(args.ws + WS_MIXF))
#define TOPE ((int*)(args.ws + WS_TOPE))
#define TOPG ((float*)(args.ws + WS_TOPG))
#define ROWTOK ((int*)(args.ws + WS_ROWTOK))
#define ROWGATE ((float*)(args.ws + WS_ROWGATE))
#define HB ((bf16*)(args.ws + WS_H))
#define YB ((bf16*)(args.ws + WS_YB))
#define HIN ((bf16*)(args.ws + WS_G))
#define WGU8 ((unsigned char*)(args.ws + WS_WGU))
#define WDN8 ((unsigned char*)(args.ws + WS_WDN))
#define XB8 ((unsigned char*)(args.ws + WS_U))
#define H8 ((unsigned char*)(args.ws + WS_H))
#define YB8 ((unsigned char*)(args.ws + WS_YB))
#define WIN8 ((unsigned char*)(args.ws + WS_WGU + 128 * MiB))
#define XP8 ((unsigned char*)(args.ws + WS_WGU + 132 * MiB))
#define CDEC ((float*)(args.ws + WS_ACUM))
template <int layer>
__device__ __forceinline__ void run_layer(const Args& args, int lo, int hi, const XcdBarrier& bar) {
    extern __shared__ __attribute__((aligned(16))) unsigned char lds[];
    LAS unsigned char* ldsp = (LAS unsigned char*)lds;
    const int tid = threadIdx.x, lane = tid & 63, wave = __builtin_amdgcn_readfirstlane(tid >> 6);
    const int G = gridDim.x, bid = blockIdx.x;
    const int gw = bid * NWAVES + wave, NGW = G * NWAVES;
    gu32* ctl = (gu32*)(args.ws + WS_CTL);

#define IN(k) (lo <= (k) && (k) < hi)
#define SEAM(k) do { if (IN(k) && IN((k) + 1)) xcd_barrier(bar); } while (0)

        const int pb = 1 + layer * PH_PER_LAYER;
        const bf16* WINl = WIN + (size_t)layer * NPROJ * DM; const bf16* WOUTl = WOUT + (size_t)layer * DM * MIXW;
        const unsigned char* WGUl = WGU8 + (size_t)layer * NEXP * 2048 * DM; const unsigned char* WDNl = WDN8 + (size_t)layer * NEXP * DM * FF;
        gu32* gcnt = ctl + CW_CNT + 64 * layer;

        if (IN(pb + 0)) {
            {
              pg8::Gemm g{(const pg8::bf16_t*)XP8, (const pg8::bf16_t*)(WIN8 + (size_t)layer * 1536 * DM), MROWS, 1536, DM / 2}; pg8::StaticOrder S; S.init(MROWS, 1536, G, bid);
              pg8::EpiProj E{PROJ, NPROJ, ROPE, QSCALE, 1.0f / (SC_X * SC_WIN), 0};
              pg8::gemm_phase<pg8::EpiProj, pg8::StaticOrder, true, false, true>(ldsp + RING_OFF, g, S, E); }
            __syncthreads();
            { pg8::Gemm g{XB, WINl + (size_t)1536 * DM, MROWS, NPROJ - 1536, DM}; pg8::StaticOrder S; S.init(MROWS, NPROJ - 1536, G, bid);
              pg8::EpiProj E{PROJ, NPROJ, ROPE, QSCALE, 1.0f, 6};
              pg8::gemm_phase<pg8::EpiProj, pg8::StaticOrder, true, false>(ldsp + RING_OFF, g, S, E); }
        }
        SEAM(pb + 0);
        if (IN(pb + 1)) {
            if (args.sub & 1) attn_phase(ldsp + RING_OFF, PROJ, OP, LSE, bid, G, tid, wave, lane);
            if (args.sub & 2) { const float* cw = in_convw + (size_t)layer * 4 * 1024; const float* cb = in_convb + (size_t)layer * 1024;
              for (int un = bid; un < 512; un += G)
                  ssd_s1_unit(ldsp + RING_OFF, PROJ, DT, in_dtb + layer * 8, in_alog + layer * 8, cw, cb, ST, CDEC, un, tid, lane, wave);
              __syncthreads(); }
            const float* sw = in_scw + (size_t)layer * 3 * 512;
            if (args.sub & 4) {
                const int ch = (tid & 63) * 8;
                f32x4 wk[3][2];
#pragma unroll
                for (int k = 0; k < 3; ++k) { wk[k][0] = *(const f32x4*)(sw + k * 512 + ch); wk[k][1] = *(const f32x4*)(sw + k * 512 + ch + 4); }
#pragma unroll 1
                for (int it = bid * (NWAVES * 64) + tid; it < (MROWS / 4) * 64; it += G * (NWAVES * 64)) { const int row0 = (it >> 6) * 4; const bool head = (row0 & (SEQ - 1)) == 0;
                    v4u cc[6], hh[6], bb[4];
#pragma unroll
                    for (int i = 0; i < 6; ++i) { cc[i] = (v4u){0u, 0u, 0u, 0u}; hh[i] = cc[i];
                        if (i >= 2 || !head) { const bf16* pr = PROJ + (size_t)(row0 - 2 + i) * NPROJ; cc[i] = *(const v4u*)(pr + C_SC + ch); hh[i] = *(const v4u*)(pr + C_SH + ch); } }
#pragma unroll
                    for (int r = 0; r < 4; ++r) bb[r] = *(const v4u*)(PROJ + (size_t)(row0 + r) * NPROJ + C_SB + ch);
                    float p[6][8];
#pragma unroll
                    for (int i = 0; i < 6; ++i) { p[i][0] = bflo(cc[i].x) * bflo(hh[i].x); p[i][1] = bfhi(cc[i].x) * bfhi(hh[i].x); p[i][2] = bflo(cc[i].y) * bflo(hh[i].y); p[i][3] = bfhi(cc[i].y) * bfhi(hh[i].y);
                        p[i][4] = bflo(cc[i].z) * bflo(hh[i].z); p[i][5] = bfhi(cc[i].z) * bfhi(hh[i].z); p[i][6] = bflo(cc[i].w) * bflo(hh[i].w); p[i][7] = bfhi(cc[i].w) * bfhi(hh[i].w); }
#pragma unroll
                    for (int r = 0; r < 4; ++r) { float a[8];
#pragma unroll
                        for (int q = 0; q < 8; ++q) a[q] = wk[0][q >> 2][q & 3] * p[r][q] + wk[1][q >> 2][q & 3] * p[r + 1][q] + wk[2][q >> 2][q & 3] * p[r + 2][q];
                        const v4u b4 = bb[r];
                        v4u o; o.x = pk2(a[0] * bflo(b4.x), a[1] * bfhi(b4.x)); o.y = pk2(a[2] * bflo(b4.y), a[3] * bfhi(b4.y)); o.z = pk2(a[4] * bflo(b4.z), a[5] * bfhi(b4.z)); o.w = pk2(a[6] * bflo(b4.w), a[7] * bfhi(b4.w));
                        *(v4u*)(MIXED + (size_t)(row0 + r) * MIXW + 1024 + ch) = o; } }
            }
        }
        SEAM(pb + 1);
        if (IN(pb + 2)) {
            for (int it = bid * (NWAVES * 64) + tid; it < (int)(64L * 2048); it += G * (NWAVES * 64)) { const int pn4 = (int)(it & 2047), bh = (int)(it >> 11); const int h = bh & 7, b = bh >> 3; f32x4 hc = (f32x4){0.f, 0.f, 0.f, 0.f};
#pragma unroll 16
                for (int c = 0; c < 32; ++c) { const size_t idx = ((size_t)((b * 32 + c) * 8 + h)) * 8192 + pn4 * 4; const f32x4 st = *(const f32x4*)(ST + idx);
                    v2u o; o.x = pk2(hc[0], hc[1]); o.y = pk2(hc[2], hc[3]); *(v2u*)(HIN + idx) = o;
                    hc = hc * CDEC[(size_t)(b * 32 + c) * 8 + h] + st; } }
        }
        SEAM(pb + 2);
        if (IN(pb + 3)) {
            if (args.sub & 1) { const float* cw = in_convw + (size_t)layer * 4 * 1024; const float* cb = in_convb + (size_t)layer * 1024;
              for (int un = bid; un < 512; un += G)
                  ssd_s3_unit(ldsp + RING_OFF, PROJ, DT, in_dtb + layer * 8, in_alog + layer * 8, cw, cb, in_dsk + layer * 8, in_ng + (size_t)layer * 512, HIN, MIXED, un, tid, lane, wave);
              __syncthreads(); }
            if (args.sub & 2)
#pragma unroll 2
            for (int it = bid * (NWAVES * 64) + tid; it < (int)((long)MROWS * 32); it += G * (NWAVES * 64)) { const int c16 = (int)(it & 31), row = (int)(it >> 5); const int h = c16 >> 2;
                const float l0 = LSE[((size_t)0 * MROWS + row) * 8 + h], l1 = LSE[((size_t)1 * MROWS + row) * 8 + h], l2 = LSE[((size_t)2 * MROWS + row) * 8 + h];
                const float mm = fmaxf(l0, fmaxf(l1, l2)); float w0 = exp2f(l0 - mm), w1 = exp2f(l1 - mm), w2 = exp2f(l2 - mm); const float iw = (1.0f / SC_O) / (w0 + w1 + w2); w0 *= iw; w1 *= iw; w2 *= iw;
                const unsigned char* OP8 = (const unsigned char*)OP; typedef float f32x2_ __attribute__((ext_vector_type(2)));
                const v4u a0 = *(const v4u*)(OP8 + ((size_t)0 * MROWS + row) * 512 + c16 * 16), a1 = *(const v4u*)(OP8 + ((size_t)1 * MROWS + row) * 512 + c16 * 16), a2 = *(const v4u*)(OP8 + ((size_t)2 * MROWS + row) * 512 + c16 * 16);
                unsigned ow[8];
#pragma unroll
                for (int q = 0; q < 4; ++q) {
                    { const f32x2_ p0 = __builtin_amdgcn_cvt_pk_f32_fp8(a0[q], false), p1 = __builtin_amdgcn_cvt_pk_f32_fp8(a1[q], false), p2 = __builtin_amdgcn_cvt_pk_f32_fp8(a2[q], false); ow[2 * q] = pk2(w0 * p0[0] + w1 * p1[0] + w2 * p2[0], w0 * p0[1] + w1 * p1[1] + w2 * p2[1]); }
                    { const f32x2_ p0 = __builtin_amdgcn_cvt_pk_f32_fp8(a0[q], true), p1 = __builtin_amdgcn_cvt_pk_f32_fp8(a1[q], true), p2 = __builtin_amdgcn_cvt_pk_f32_fp8(a2[q], true); ow[2 * q + 1] = pk2(w0 * p0[0] + w1 * p1[0] + w2 * p2[0], w0 * p0[1] + w1 * p1[1] + w2 * p2[1]); } }
                bf16* op_ = MIXED + (size_t)row * MIXW + c16 * 16;
                *(v4u*)op_ = (v4u){ow[0], ow[1], ow[2], ow[3]}; *(v4u*)(op_ + 8) = (v4u){ow[4], ow[5], ow[6], ow[7]}; }
        }
        SEAM(pb + 3);
        if (IN(pb + 4)) {
#define FUSED_LN1_CALL(BASE, LIM) { pg8::Gemm g{MIXED, WOUTl, MROWS, DM, MIXW}; \
              pg8::EpiLn1 E{args.ws, in_ln1g + (size_t)layer * DM, in_ln1b + (size_t)layer * DM, WS_XB, WS_U, (layer ? WS_ROPE : WS_DTS), WS_CTL + (size_t)(CW_SEAM + layer * 8192) * 4, WS_CTL + (size_t)CW_TMO * 4, ALPHA, SC_X, LN_EPS, 0x700u + (unsigned)layer * 0x80u}; \
              pg8::StaticOrder S; S.init(MROWS, DM, G, bid); S.base = (BASE); S.lim = (LIM); \
              pg8::gemm_phase<pg8::EpiLn1, pg8::StaticOrder, false, false>(ldsp + RING_OFF, g, S, E); }
            FUSED_LN1_CALL(0, 256)
            __syncthreads();
            FUSED_LN1_CALL(256, 512)
            __syncthreads();
#undef FUSED_LN1_CALL
        }
        SEAM(pb + 4);
        if (IN(pb + 6)) {
            LAS int* lcnt = (LAS int*)(ldsp + L_LCNT); LAS int* lbase = (LAS int*)(ldsp + L_LBASE);
            const bf16* RT = ROUT + (size_t)layer * NEXP * DM; const float* rb = in_rb + (size_t)layer * NEXP;
            for (int blk = bid; blk < MROWS / 128; blk += G) {
                if (tid < 32) lcnt[tid] = 0;
                __syncthreads();
                const int r32 = lane & 31, hi = lane >> 5; const int row = blk * 128 + (wave & 3) * 32 + r32;
                float tv[4]; int te[4]; int lrank[4]; float gate[4];
                f32x16 acc = {};
                { const int kh = wave >> 2;
                  const bf16* ap = RT + (size_t)r32 * DM + 8 * hi + 512 * kh; const bf16* bp = XB + (size_t)row * DM + 8 * hi + 512 * kh;
#pragma unroll 16
                  for (int s = 0; s < 32; ++s) { const bf16x8 a = *(const bf16x8*)(ap + 16 * s), b = *(const bf16x8*)(bp + 16 * s); acc = __builtin_amdgcn_mfma_f32_32x32x16_bf16(a, b, acc, 0, 0, 0); }
                  LAS float* part = (LAS float*)(ldsp + RING_OFF) + (wave & 3) * 1024;
                  if (kh) {
#pragma unroll
                      for (int i = 0; i < 16; ++i) part[i * 64 + lane] = acc[i]; }
                  __syncthreads();
                  if (!kh) {
#pragma unroll
                      for (int i = 0; i < 16; ++i) acc[i] += part[i * 64 + lane]; } }
                if (wave < 4) {
#pragma unroll
                    for (int k = 0; k < 4; ++k) { tv[k] = -INFINITY; te[k] = 1 << 20; }
#pragma unroll
                    for (int i = 0; i < 16; ++i) { const int e = (i & 3) + 8 * (i >> 2) + 4 * hi; float v = acc[i] + rb[e]; int ve = e;
#pragma unroll
                        for (int k = 0; k < 4; ++k) { const bool gt = (v > tv[k]) || (v == tv[k] && ve < te[k]); const float nv = gt ? tv[k] : v; const int ne = gt ? te[k] : ve; tv[k] = gt ? v : tv[k]; te[k] = gt ? ve : te[k]; v = nv; ve = ne; } }
                    float pv[4]; int pe[4];
#pragma unroll
                    for (int k = 0; k < 4; ++k) { pv[k] = __shfl_xor(tv[k], 32); pe[k] = __shfl_xor(te[k], 32); }
#pragma unroll
                    for (int j = 0; j < 4; ++j) { float v = pv[j]; int ve = pe[j];
#pragma unroll
                        for (int k = 0; k < 4; ++k) { const bool gt = (v > tv[k]) || (v == tv[k] && ve < te[k]); const float nv = gt ? tv[k] : v; const int ne = gt ? te[k] : ve; tv[k] = gt ? v : tv[k]; te[k] = gt ? ve : te[k]; v = nv; ve = ne; } }
                    float se = 0.f;
#pragma unroll
                    for (int k = 0; k < 4; ++k) { gate[k] = __expf(tv[k] - tv[0]); se += gate[k]; }
                    const float ise = 1.0f / se;
#pragma unroll
                    for (int k = 0; k < 4; ++k) gate[k] *= ise;
                    if (hi == 0) {
#pragma unroll
                        for (int k = 0; k < 4; ++k) lrank[k] = __hip_atomic_fetch_add(lcnt + te[k], 1, __ATOMIC_RELAXED, __HIP_MEMORY_SCOPE_WORKGROUP);
                    }
                }
                __syncthreads();
                if (tid < 32) lbase[tid] = (int)__hip_atomic_fetch_add(gcnt + tid, (unsigned)lcnt[tid], RLX_AGENT);
                __syncthreads();
                if (wave < 4 && hi == 0) {
#pragma unroll
                    for (int k = 0; k < 4; ++k) { const int r = lbase[te[k]] + lrank[k]; const size_t o = (size_t)te[k] * 32768 + r;
                        ROWTOK[o] = row * 4 + k; ROWGATE[o] = gate[k]; }
                }
                __syncthreads();
            }
        }
        SEAM(pb + 6);
        if (IN(pb + 7) || IN(pb + 8)) {
            LAS int* tstart = (LAS int*)(ldsp + L_TSTART); LAS int* cntL = (LAS int*)(ldsp + L_CNT); LAS int* units = (LAS int*)(ldsp + L_UNITS); LAS int* unitsn = (LAS int*)(ldsp + L_UNITSN);
            if (tid < 64) {
                const int c = (tid < 32) ? (int)__hip_atomic_load(gcnt + tid, RLX_AGENT) : 0; const int t = (c + 255) >> 8; int incl = t;
#pragma unroll
                for (int d = 1; d < 32; d <<= 1) { const int v = __shfl_up(incl, d); if (tid >= d) incl += v; }
                if (tid < 32) { cntL[tid] = c; tstart[tid] = incl - t; }
                if (tid == 31) tstart[32] = incl; }
            __syncthreads();
            if (IN(pb + 7)) {
                pg8::moe_build_units(units, unitsn, tstart, 8, G, bid, tid);
                __syncthreads();
                pg8::Gemm g{(const pg8::bf16_t*)XB8, (const pg8::bf16_t*)WGUl, 0, 2048, DM / 2};
                pg8::MoeOrder S{units, __builtin_amdgcn_readfirstlane(unitsn[0]), cntL, ROWTOK, 1, (unsigned)DM, (size_t)2048 * DM, ROWGATE, in_bgu + (size_t)layer * NEXP * 2048};
                pg8::EpiSwiglu E{H8, in_bgu + (size_t)layer * NEXP * 2048, ROWGATE, cntL, 1.0f / (SC_X * SC_WGU), SC_H};
                pg8::gemm_phase<pg8::EpiSwiglu, pg8::MoeOrder, true, true, true>(ldsp + RING_OFF, g, S, E);
                __syncthreads();
            }
            SEAM(pb + 7);
            if (IN(pb + 8)) {
                pg8::moe_build_units(units, unitsn, tstart, 4, G, bid, tid);
                __syncthreads();
                pg8::Gemm g{(const pg8::bf16_t*)H8, (const pg8::bf16_t*)WDNl, 0, DM, FF / 2};
                pg8::MoeOrder S{units, __builtin_amdgcn_readfirstlane(unitsn[0]), cntL, ROWTOK, 0, (unsigned)FF, (size_t)DM * FF, ROWGATE, in_bdn + (size_t)layer * NEXP * DM};
                pg8::EpiScatter E{YB8, ROWTOK, cntL, SC_Y / (SC_H * SC_WDN), SC_Y};
                pg8::gemm_phase<pg8::EpiScatter, pg8::MoeOrder, true, false, true, true>(ldsp + RING_OFF, g, S, E);
                __syncthreads();
            }
        }
        SEAM(pb + 8);
        if (IN(pb + 9)) {
            constexpr bool NEXT = (layer + 1 < NLAYER);
            const float* gam = in_ln2g + (size_t)layer * DM; const float* bet = in_ln2b + (size_t)layer * DM;
            f32x4 gq[4], bq[4], wq[8][4];
#pragma unroll
            for (int q = 0; q < 4; ++q) { gq[q] = *(const f32x4*)(gam + 16 * lane + 4 * q); bq[q] = *(const f32x4*)(bet + 16 * lane + 4 * q); }
            if (NEXT) {
#pragma unroll
                for (int jj = 0; jj < 8; ++jj)
#pragma unroll
                    for (int q = 0; q < 4; ++q) wq[jj][q] = *(const f32x4*)(WDT + (size_t)(layer + 1) * 8 * 1024 + jj * 1024 + 16 * lane + 4 * q); }
            v4u nx0, nx1, ny[4];
            constexpr bool PF = !NEXT;
            if (PF && gw < MROWS) { nx0 = *(const v4u*)(XB + (size_t)gw * DM + 16 * lane); nx1 = *(const v4u*)(XB + (size_t)gw * DM + 16 * lane + 8);
#pragma unroll
                for (int k = 0; k < 4; ++k) ny[k] = *(const v4u*)(YB8 + ((size_t)gw * 4 + k) * DM + 16 * lane); }
#pragma unroll 1
            for (int m = gw; m < MROWS; m += NGW) {
                if (!PF) { nx0 = *(const v4u*)(XB + (size_t)m * DM + 16 * lane); nx1 = *(const v4u*)(XB + (size_t)m * DM + 16 * lane + 8);
#pragma unroll
                    for (int k = 0; k < 4; ++k) ny[k] = *(const v4u*)(YB8 + ((size_t)m * 4 + k) * DM + 16 * lane); }
                const v4u x0 = nx0, x1 = nx1; v4u yk[4];
#pragma unroll
                for (int k = 0; k < 4; ++k) yk[k] = ny[k];
                if (PF && m + NGW < MROWS) { const int mn = m + NGW; nx0 = *(const v4u*)(XB + (size_t)mn * DM + 16 * lane); nx1 = *(const v4u*)(XB + (size_t)mn * DM + 16 * lane + 8);
#pragma unroll
                    for (int k = 0; k < 4; ++k) ny[k] = *(const v4u*)(YB8 + ((size_t)mn * 4 + k) * DM + 16 * lane); }
                f32x4 v[4];
                v[0] = (f32x4){bflo(x0.x), bfhi(x0.x), bflo(x0.y), bfhi(x0.y)} * ALPHA; v[1] = (f32x4){bflo(x0.z), bfhi(x0.z), bflo(x0.w), bfhi(x0.w)} * ALPHA;
                v[2] = (f32x4){bflo(x1.x), bfhi(x1.x), bflo(x1.y), bfhi(x1.y)} * ALPHA; v[3] = (f32x4){bflo(x1.z), bfhi(x1.z), bflo(x1.w), bfhi(x1.w)} * ALPHA;
#pragma unroll
                for (int k = 0; k < 4; ++k)
#pragma unroll
                    for (int q = 0; q < 4; ++q) { typedef float f32x2_ __attribute__((ext_vector_type(2)));
                        const f32x2_ lo = __builtin_amdgcn_cvt_pk_f32_fp8(yk[k][q], false), hi = __builtin_amdgcn_cvt_pk_f32_fp8(yk[k][q], true);
                        v[q][0] += lo[0] * (1.0f / SC_Y); v[q][1] += lo[1] * (1.0f / SC_Y); v[q][2] += hi[0] * (1.0f / SC_Y); v[q][3] += hi[1] * (1.0f / SC_Y); }
                float s = 0.f;
#pragma unroll
                for (int q = 0; q < 4; ++q) s += (v[q][0] + v[q][1]) + (v[q][2] + v[q][3]);
                const float mean = wave_sum(s) * (1.f / DM); float s2 = 0.f;
#pragma unroll
                for (int q = 0; q < 4; ++q) { v[q] = v[q] - mean; s2 += (v[q][0] * v[q][0] + v[q][1] * v[q][1]) + (v[q][2] * v[q][2] + v[q][3] * v[q][3]); }
                const float rstd = 1.f / sqrtf(wave_sum(s2) * (1.f / DM) + LN_EPS);
#pragma unroll
                for (int q = 0; q < 4; ++q) { v[q] = v[q] * rstd * gq[q] + bq[q];
                    if (!NEXT) *(f32x4*)(args.out + (size_t)m * DM + 16 * lane + 4 * q) = v[q]; }
                if (NEXT) {
                    v4u w0, w1; w0.x = pk2(v[0][0], v[0][1]); w0.y = pk2(v[0][2], v[0][3]); w0.z = pk2(v[1][0], v[1][1]); w0.w = pk2(v[1][2], v[1][3]);
                    w1.x = pk2(v[2][0], v[2][1]); w1.y = pk2(v[2][2], v[2][3]); w1.z = pk2(v[3][0], v[3][1]); w1.w = pk2(v[3][2], v[3][3]);
                    *(v4u*)(XB + (size_t)m * DM + 16 * lane) = w0; *(v4u*)(XB + (size_t)m * DM + 16 * lane + 8) = w1;
                    v4u w; w.x = pg8::pk4_fp8(v[0][0] * SC_X, v[0][1] * SC_X, v[0][2] * SC_X, v[0][3] * SC_X); w.y = pg8::pk4_fp8(v[1][0] * SC_X, v[1][1] * SC_X, v[1][2] * SC_X, v[1][3] * SC_X);
                    w.z = pg8::pk4_fp8(v[2][0] * SC_X, v[2][1] * SC_X, v[2][2] * SC_X, v[2][3] * SC_X); w.w = pg8::pk4_fp8(v[3][0] * SC_X, v[3][1] * SC_X, v[3][2] * SC_X, v[3][3] * SC_X);
                    *(v4u*)(XP8 + (size_t)m * DM + 16 * lane) = w;
                    float r[8];
#pragma unroll
                    for (int jj = 0; jj < 8; ++jj) { float sd = 0.f;
#pragma unroll
                        for (int q = 0; q < 4; ++q) sd += v[q][0] * wq[jj][q][0] + v[q][1] * wq[jj][q][1] + v[q][2] * wq[jj][q][2] + v[q][3] * wq[jj][q][3];
                        r[jj] = wave_sum(sd); }
                    if (lane == 0) { float* dst = DT + (size_t)m * 8; *(f32x4*)dst = (f32x4){r[0], r[1], r[2], r[3]}; *(f32x4*)(dst + 4) = (f32x4){r[4], r[5], r[6], r[7]}; } }
            }
        }
        SEAM(pb + 9);
    #undef IN
#undef SEAM
}

__global__ void __launch_bounds__(NWAVES * 64, 2) mk_fwd(Args args) {
    extern __shared__ __attribute__((aligned(16))) unsigned char lds[];
    LAS unsigned char* ldsp = (LAS unsigned char*)lds;
    const int tid = threadIdx.x, lane = tid & 63, wave = __builtin_amdgcn_readfirstlane(tid >> 6);
    const int G = gridDim.x, bid = blockIdx.x;
    const int gw = bid * NWAVES + wave, NGW = G * NWAVES;
    gu32* ctl = (gu32*)(args.ws + WS_CTL);

    for (int u = tid; u < (LDS_BYTES - LDSCTL_OFF) / 4; u += NWAVES * 64) ((LAS unsigned*)(ldsp + LDSCTL_OFF))[u] = 0u;
    __syncthreads();
    XcdBarrier bar = xcd_barrier_post((unsigned*)(ctl + CW_BAR), (volatile LAS unsigned*)(ldsp + L_MISC) + 8);

    const int lo = args.ph_lo, hi = args.ph_hi;
#define IN(k) (lo <= (k) && (k) < hi)
#define SEAM(k) do { if (IN(k) && IN((k) + 1)) xcd_barrier(bar); } while (0)

    if (IN(0)) {
        LAS float* scr = (LAS float*)(ldsp + RING_OFF + wave * 16384);
        constexpr int I_IN = 16 * 73, I_OUT = 24 * 16, I_R = 16;
        constexpr int NIT = NLAYER * (I_IN + I_OUT + I_R);
        for (int it = gw; it < NIT; it += NGW) {
            int r = it;
            if (r < NLAYER * I_IN) { const int l = r / I_IN; r %= I_IN; p0_transpose_item64<1>(in_win + (size_t)l * DM * INW, DM, INW, WIN + (size_t)l * NPROJ * DM, WDT + (size_t)l * 8 * 1024, scr, r / 73, r % 73, lane); continue; } r -= NLAYER * I_IN;
            if (r < NLAYER * I_OUT) { const int l = r / I_OUT; r %= I_OUT; p0_transpose_item64<0>(in_wout + (size_t)l * MIXW * DM, MIXW, DM, WOUT + (size_t)l * DM * MIXW, nullptr, scr, r / 16, r % 16, lane); continue; } r -= NLAYER * I_OUT;
            { const int l = r / I_R; r %= I_R; p0_transpose_item<0>(in_rw + (size_t)l * DM * NEXP, DM, NEXP, ROUT + (size_t)l * NEXP * DM, nullptr, scr, r, 0, lane); }
        }
        { constexpr int NIT8 = 64 * 256 + 64 * 128 + NLAYER * 192;
          const int nmine = (gw < NIT8) ? (NIT8 - gw + NGW - 1) / NGW : 0; const int J = 2 * nmine;
          f32x4 lda[16], ldb[16];
          if (J > 0) { const SubT t = fp8_subtile(gw, 0, in_wgu, in_wdn, in_win, WGU8, WDN8, WIN8, lane); fp8_sub_load(t, lda); }
#pragma unroll 1
          for (int j = 0; j < J; j += 2) {
              const int item = gw + (j >> 1) * NGW;
              const SubT t0 = fp8_subtile(item, 0, in_wgu, in_wdn, in_win, WGU8, WDN8, WIN8, lane), t1 = fp8_subtile(item, 1, in_wgu, in_wdn, in_win, WGU8, WDN8, WIN8, lane);
              fp8_sub_load(t1, ldb);
              fp8_sub_process(t0, lda, scr, lane);
              if (j + 2 < J) { const SubT t2 = fp8_subtile(item + NGW, 0, in_wgu, in_wdn, in_win, WGU8, WDN8, WIN8, lane); fp8_sub_load(t2, lda); }
              fp8_sub_process(t1, ldb, scr, lane);
          } }
        __syncthreads();
    }
    if (IN(0)) {
        f32x4 wq[8][4];
#pragma unroll
        for (int j = 0; j < 4; ++j)
#pragma unroll
            for (int e = 0; e < 4; ++e) { const float* wp = in_win + (size_t)(4 * lane + 256 * j + e) * INW + 3072; const f32x4 w0 = *(const f32x4*)wp, w1 = *(const f32x4*)(wp + 4);
                wq[0][j][e] = w0[0]; wq[1][j][e] = w0[1]; wq[2][j][e] = w0[2]; wq[3][j][e] = w0[3]; wq[4][j][e] = w1[0]; wq[5][j][e] = w1[1]; wq[6][j][e] = w1[2]; wq[7][j][e] = w1[3]; }
        f32x4 nv[4];
        if (gw < MROWS) {
#pragma unroll
            for (int j = 0; j < 4; ++j) nv[j] = *(const f32x4*)(in_x + (size_t)gw * DM + 4 * lane + 256 * j); }
#pragma unroll 1
        for (int m = gw; m < MROWS; m += NGW) { bf16* ob = XB + (size_t)m * DM; f32x4 v[4];
#pragma unroll
            for (int j = 0; j < 4; ++j) v[j] = nv[j];
            if (m + NGW < MROWS) {
#pragma unroll
                for (int j = 0; j < 4; ++j) nv[j] = *(const f32x4*)(in_x + (size_t)(m + NGW) * DM + 4 * lane + 256 * j); }
#pragma unroll
            for (int j = 0; j < 4; ++j) { v2u w; w.x = pk2(v[j][0], v[j][1]); w.y = pk2(v[j][2], v[j][3]); *(v2u*)(ob + 4 * lane + 256 * j) = w;
                *(unsigned*)(XP8 + (size_t)m * DM + 4 * lane + 256 * j) = pg8::pk4_fp8(v[j][0] * SC_X, v[j][1] * SC_X, v[j][2] * SC_X, v[j][3] * SC_X); }
            row_dt_w(v, wq, DT + (size_t)m * 8, lane); }
    }

    SEAM(0);
    run_layer<0>(args, lo, hi, bar);
    run_layer<1>(args, lo, hi, bar);
#undef IN
#undef SEAM
}

extern "C" void kernel_launch(void* const* d_in, const int* in_sizes, int n_in, void* d_out, int out_size, void* d_ws, size_t ws_size, hipStream_t stream) {
    static int grid = 0;
    if (grid == 0) {
        if (n_in != 20 || out_size != MROWS * DM || ws_size < WS_END) { fprintf(stderr, "kernel_launch: unexpected problem (n_in %d, out %d, ws %zu)\n", n_in, out_size, ws_size); grid = -1; return; }
        if (hipFuncSetAttribute((const void*)mk_fwd, hipFuncAttributeMaxDynamicSharedMemorySize, LDS_BYTES) != hipSuccess) { fprintf(stderr, "kernel_launch: hipFuncSetAttribute failed\n"); grid = -1; return; }
        int dev = 0, cus = 0, per_cu = 0;
        (void)hipGetDevice(&dev); (void)hipDeviceGetAttribute(&cus, hipDeviceAttributeMultiprocessorCount, dev);
        if (hipOccupancyMaxActiveBlocksPerMultiprocessor(&per_cu, (const void*)mk_fwd, NWAVES * 64, LDS_BYTES) != hipSuccess || per_cu < 1) fprintf(stderr, "kernel_launch: occupancy query says %d\n", per_cu);
        (void)hipGetLastError();
        grid = cus > 0 ? cus : 256;
    }
    if (grid < 0) return;
    (void)hipMemsetAsync((char*)d_ws + WS_CTL, 0, CTL_ZERO_BYTES, stream);
    Args a{};
    for (int i = 0; i < 20; ++i) a.in[i] = (const float*)d_in[i];
    a.out = (float*)d_out; a.ws = (unsigned char*)d_ws;
    a.ph_lo = 0; a.ph_hi = N_PHASES; a.sub = 7; a.pad = 0;
    hipLaunchKernelGGL(mk_fwd, dim3(grid), dim3(NWAVES * 64), LDS_BYTES, stream, a);
#ifdef PROBE_PH
#ifndef PROBE_SUB
#define PROBE_SUB 7
#endif
    for (int i = 0; i < PROBE_N; ++i) { a.ph_lo = PROBE_PH; a.ph_hi = PROBE_PH + 1; a.sub = PROBE_SUB; hipLaunchKernelGGL(mk_fwd, dim3(grid), dim3(NWAVES * 64), LDS_BYTES, stream, a); }
#endif
}
```

```cpp
#include <hip/hip_runtime.h>
#include <cstdio>
#include <cstdint>
#include <cmath>

namespace pg8 {
#define PG8_LAS __attribute__((address_space(3)))
typedef unsigned short bf16_t;
typedef short bf16x8 __attribute__((ext_vector_type(8)));
typedef float f32x4 __attribute__((ext_vector_type(4)));
typedef float f32x2 __attribute__((ext_vector_type(2)));
typedef unsigned u32x4 __attribute__((ext_vector_type(4)));
constexpr int BM = 256, BK = 64, HALF = 128, HTB = HALF * BK * 2  , STAGE_BYTES = 8 * HTB, NXCD = 8, WGM = 8;

__host__ __device__ __forceinline__ int lds_byte(int r, int c) { const int st = (r >> 4) * 2 + (c >> 5), rr = r & 15, cc = c & 31, ob = rr * 64 + cc * 2; return st * 1024 + (ob ^ (((ob >> 9) & 1) << 5)); }
__host__ __device__ __forceinline__ void stage_rc(int b, int& R, int& C) { const int st = b / 1024, sb = b % 1024, swz = sb ^ (((sb >> 9) & 1) << 5); R = (st >> 1) * 16 + swz / 64; C = (st & 1) * 32 + (swz % 64) / 2; }
__host__ __device__ __forceinline__ int perm32(int rho) { const int n = rho >> 4, i = rho & 15; return 8 * (i >> 2) + 4 * n + (i & 3); }

struct Unit { int pm, pn, e, r0; };
struct Gemm { const bf16_t* A; const bf16_t* Bt; int M, N, K; };

struct StaticOrder {
    int nM, nN, nwg, G, c, base, lim;
    __device__ void init(int M, int N, int G_, int c_) { nM = M / BM; nN = N / BM; nwg = nM * nN; G = G_; c = c_; base = 0; lim = nwg; }
    __device__ __forceinline__ bool next(int i, Unit& u) const {
        const long L = (long)i * G + c + base; if (L >= lim) return false;
        int wgid = (int)L; { const int q = nwg / NXCD, r = nwg % NXCD, xcd = wgid % NXCD, off = wgid / NXCD; wgid = (xcd < r ? xcd * (q + 1) : r * (q + 1) + (xcd - r) * q) + off; }
        const int nig = WGM * nN, gid = wgid / nig, fm = gid * WGM, gsz = (nM - fm) < WGM ? (nM - fm) : WGM;
        u.pm = fm + ((wgid % nig) % gsz); u.pn = (wgid % nig) / gsz; u.e = 0; u.r0 = 0; return true;
    }
    __device__ __forceinline__ const char* abase(const Unit& u, const Gemm& g, size_t tstep) const { return (const char*)g.A + (size_t)u.pm * tstep; }
    __device__ __forceinline__ const char* bbase(const Unit& u, const Gemm& g, size_t tstep) const { return (const char*)g.Bt + (size_t)u.pn * tstep; }
    static constexpr bool SIDE = false;
    __device__ __forceinline__ unsigned arow(const Unit&, int) const { return 0u; }
    __device__ __forceinline__ unsigned arow_side(const Unit&, int, const PG8_LAS unsigned char*) const { return 0u; }
    __device__ __forceinline__ const void* side_src(const Unit&, const Unit&, int, int) const { return nullptr; }
    __device__ __forceinline__ void a_ready(const Unit&) const {}
    __device__ __forceinline__ void done(const Unit&) const {}
};

struct MoeOrder {
    const PG8_LAS int* units;
    int nunits;
    const PG8_LAS int* cnt;
    const int* rowtok;
    int gather;
    unsigned rowbytes;
    size_t bstride;
    __device__ __forceinline__ bool next(int i, Unit& u) const {
        if (i >= nunits) return false;
        u.pm = __builtin_amdgcn_readfirstlane(units[4 * i + 0]); u.pn = __builtin_amdgcn_readfirstlane(units[4 * i + 1]);
        u.e = __builtin_amdgcn_readfirstlane(units[4 * i + 2]); u.r0 = __builtin_amdgcn_readfirstlane(units[4 * i + 3]); return true;
    }
    __device__ __forceinline__ const char* abase(const Unit& u, const Gemm& g, size_t tstep) const { return gather ? (const char*)g.A : (const char*)g.A + (size_t)u.pm * tstep; }
    __device__ __forceinline__ const char* bbase(const Unit& u, const Gemm& g, size_t tstep) const { return (const char*)g.Bt + (size_t)u.e * bstride + (size_t)u.pn * tstep; }
    static constexpr bool SIDE = true;
    const float* rowgate; const float* bgu;
    __device__ __forceinline__ unsigned arow(const Unit& u, int R) const {
        const int r = u.r0 + R; const int idx = (r < cnt[u.e]) ? rowtok[(size_t)u.e * 32768 + r] : 0; return (unsigned)(idx >> 2) * rowbytes; }
    __device__ __forceinline__ unsigned arow_side(const Unit& u, int R, const PG8_LAS unsigned char* sd) const {
        const int r = u.r0 + R; const int v = ((const PG8_LAS int*)sd)[R]; const int idx = (r < cnt[u.e]) ? v : 0; return (unsigned)(idx >> 2) * rowbytes; }
    __device__ __forceinline__ const void* side_src(const Unit& cur, const Unit& rt, int wid, int lane) const {
        if (rowgate != nullptr && wid == 1) return rowgate + (size_t)cur.e * 32768 + cur.r0 + 4 * lane;
        if (bgu != nullptr && wid == 2) return gather ? (bgu + (size_t)cur.e * 2048 + (lane < 32 ? 0 : 1024 - 128) + cur.pn * 128 + 4 * lane)
                                                      : (bgu + (size_t)cur.e * 1024 + cur.pn * 256 + 4 * lane);
        return rowtok + (size_t)rt.e * 32768 + rt.r0 + 4 * lane; }
    __device__ __forceinline__ void a_ready(const Unit&) const {}
    __device__ __forceinline__ void done(const Unit&) const {}
};
__device__ __forceinline__ void moe_build_units(PG8_LAS int* units, PG8_LAS int* units_n, const PG8_LAS int* tstart, int nN, int G, int c, int tid) {
    if (tid < 64) {
        const int nT = tstart[32], nwg = nT * nN; const long L = (long)tid * G + c;
        int pm = 0, pn = 0, e = 0, r0 = 0;
        if (L < nwg) {
            int wgid = (int)L; { const int q = nwg / NXCD, r = nwg % NXCD, xcd = wgid % NXCD, off = wgid / NXCD; wgid = (xcd < r ? xcd * (q + 1) : r * (q + 1) + (xcd - r) * q) + off; }
            const int nig = WGM * nN, gid = wgid / nig, fm = gid * WGM, gsz = (nT - fm) < WGM ? (nT - fm) : WGM;
            pm = fm + ((wgid % nig) % gsz); pn = (wgid % nig) / gsz;
            for (int j = 1; j < 32; ++j) e += (tstart[j] <= pm) ? 1 : 0;
            r0 = (pm - tstart[e]) * 256;
        }
        units[4 * tid + 0] = pm; units[4 * tid + 1] = pn; units[4 * tid + 2] = e; units[4 * tid + 3] = r0;
        if (tid == 0) { int n = 0; if (c < nwg) n = (nwg - c + G - 1) / G; units_n[0] = n < 64 ? n : 64; }
    }
}

__host__ __device__ __forceinline__ unsigned hblk_off(int R, int p7) { const int ai = R >> 7, wr = (R >> 6) & 1, m = (R >> 4) & 3, fr = R & 15, wc = p7 >> 1, fq = ((p7 & 1) << 1) | (m & 1), mp = m >> 1;
    return (unsigned)(((((ai * 2 + wr) * 4 + wc) * 2 + mp) * 64 + fr + 16 * fq) * 16); }
typedef int v8i_t __attribute__((ext_vector_type(8)));
typedef int v4i_t __attribute__((ext_vector_type(4)));
__device__ __forceinline__ v8i_t cat8(bf16x8 lo, bf16x8 hi) { const v4i_t a = __builtin_bit_cast(v4i_t, lo), b = __builtin_bit_cast(v4i_t, hi); return __builtin_shufflevector(a, b, 0, 1, 2, 3, 4, 5, 6, 7); }
__device__ __forceinline__ void mfma8(f32x4& acc, v8i_t a, v8i_t b, int scl) { asm volatile("v_mfma_scale_f32_16x16x128_f8f6f4 %0, %1, %2, %0, %3, %3 op_sel_hi:[0,0,0]" : "+v"(acc) : "v"(a), "v"(b), "v"(scl)); }
__device__ __forceinline__ unsigned pk4_fp8(float a, float b, float c, float d) { unsigned w = 0u; w = __builtin_amdgcn_cvt_pk_fp8_f32(a, b, w, false); w = __builtin_amdgcn_cvt_pk_fp8_f32(c, d, w, true); return w; }
__device__ __forceinline__ unsigned cvt_pk_bf16(float lo, float hi) { unsigned r; asm volatile("v_cvt_pk_bf16_f32 %0, %1, %2" : "=v"(r) : "v"(lo), "v"(hi)); return r; }

struct EpiProj {
    static constexpr bool PERM = true, AFTER_DRAIN = false;
    bf16_t* O; int ldc; const float* rope; float qscale; float dqv; int pn_off;
    __device__ __forceinline__ void operator()(const f32x4 (&acc)[2][2][4][2], const Unit& u, int wr, int wc, int fr, int fq, const PG8_LAS unsigned char* sd) const {
        const int pnn = u.pn + pn_off; const int row0 = u.pm * BM + wr * 64 + fr; const int col0 = pnn * BM + wc * 32 + 8 * fq;
        const bool rot = pnn < 4; const float sc = (pnn < 2 ? qscale : 1.f) * dqv; const int gq = 4 * (wc & 1) + fq;
        float invr[4];
#pragma unroll
        for (int e = 0; e < 4; ++e) invr[e] = __builtin_amdgcn_exp2f(-(float)(4 * gq + e) * 0.41524101186092029f) * 0.15915494309189535f;
#pragma unroll
        for (int ai = 0; ai < 2; ++ai)
#pragma unroll
            for (int m = 0; m < 4; ++m) { const int row = row0 + ai * HALF + m * 16; bf16_t* rowp = O + (size_t)row * ldc + col0;
                f32x4 cs0 = (f32x4){1.f, 0.f, 1.f, 0.f}, cs1 = cs0;
                if (rot) { const float tp = (float)(row & 4095);
                    const float a0 = __builtin_amdgcn_fractf(tp * invr[0]), a1 = __builtin_amdgcn_fractf(tp * invr[1]), a2 = __builtin_amdgcn_fractf(tp * invr[2]), a3 = __builtin_amdgcn_fractf(tp * invr[3]);
                    cs0 = (f32x4){__builtin_amdgcn_cosf(a0), __builtin_amdgcn_sinf(a0), __builtin_amdgcn_cosf(a1), __builtin_amdgcn_sinf(a1)};
                    cs1 = (f32x4){__builtin_amdgcn_cosf(a2), __builtin_amdgcn_sinf(a2), __builtin_amdgcn_cosf(a3), __builtin_amdgcn_sinf(a3)}; }
#pragma unroll
                for (int bj = 0; bj < 2; ++bj) { f32x4 v0 = acc[ai][bj][m][0], v1 = acc[ai][bj][m][1];
                    if (rot) { f32x4 lo, hi;
                        lo[0] = v0[0] * cs0[0] - v1[0] * cs0[1]; hi[0] = v1[0] * cs0[0] + v0[0] * cs0[1];
                        lo[1] = v0[1] * cs0[2] - v1[1] * cs0[3]; hi[1] = v1[1] * cs0[2] + v0[1] * cs0[3];
                        lo[2] = v0[2] * cs1[0] - v1[2] * cs1[1]; hi[2] = v1[2] * cs1[0] + v0[2] * cs1[1];
                        lo[3] = v0[3] * cs1[2] - v1[3] * cs1[3]; hi[3] = v1[3] * cs1[2] + v0[3] * cs1[3];
                        v0 = lo * sc; v1 = hi * sc; }
                    else { v0 = v0 * dqv; v1 = v1 * dqv; }
                    u32x4 w; w.x = cvt_pk_bf16(v0[0], v0[1]); w.y = cvt_pk_bf16(v0[2], v0[3]); w.z = cvt_pk_bf16(v1[0], v1[1]); w.w = cvt_pk_bf16(v1[2], v1[3]);
                    *(u32x4*)(rowp + bj * HALF) = w; } }
    }
};
struct EpiF32 {
    static constexpr bool PERM = false, AFTER_DRAIN = false;
    float* O; int ldc;
    __device__ __forceinline__ void operator()(const f32x4 (&acc)[2][2][4][2], const Unit& u, int wr, int wc, int fr, int fq, const PG8_LAS unsigned char* sd) const {
        const int row0 = u.pm * BM + wr * 64 + fr; const int col0 = u.pn * BM + wc * 32 + 4 * fq;
#pragma unroll
        for (int ai = 0; ai < 2; ++ai)
#pragma unroll
            for (int m = 0; m < 4; ++m) { float* rowp = O + (size_t)(row0 + ai * HALF + m * 16) * ldc + col0;
#pragma unroll
                for (int bj = 0; bj < 2; ++bj)
#pragma unroll
                    for (int n = 0; n < 2; ++n) *(f32x4*)(rowp + bj * HALF + n * 16) = acc[ai][bj][m][n]; }
    }
};
struct EpiBf16Plain {
    static constexpr bool PERM = true, AFTER_DRAIN = false;
    bf16_t* O; int ldc;
    __device__ __forceinline__ void operator()(const f32x4 (&acc)[2][2][4][2], const Unit& u, int wr, int wc, int fr, int fq, const PG8_LAS unsigned char* sd) const {
        const int row0 = u.pm * BM + wr * 64 + fr; const int col0 = u.pn * BM + wc * 32 + 8 * fq;
#pragma unroll
        for (int ai = 0; ai < 2; ++ai)
#pragma unroll
            for (int m = 0; m < 4; ++m) { bf16_t* rowp = O + (size_t)(row0 + ai * HALF + m * 16) * ldc + col0;
#pragma unroll
                for (int bj = 0; bj < 2; ++bj) { const f32x4 v0 = acc[ai][bj][m][0], v1 = acc[ai][bj][m][1];
                    u32x4 w; w.x = cvt_pk_bf16(v0[0], v0[1]); w.y = cvt_pk_bf16(v0[2], v0[3]); w.z = cvt_pk_bf16(v1[0], v1[1]); w.w = cvt_pk_bf16(v1[2], v1[3]);
                    *(u32x4*)(rowp + bj * HALF) = w; } }
    }
};
struct EpiSwiglu {
    static constexpr bool PERM = true, AFTER_DRAIN = false;
    unsigned char* H; const float* bgu; const float* rowgate; const PG8_LAS int* cnt; float dq, hscale;
    __device__ __forceinline__ void operator()(const f32x4 (&acc)[2][2][4][2], const Unit& u, int wr, int wc, int fr, int fq, const PG8_LAS unsigned char* sd) const {
        const int n_e = cnt[u.e];
        constexpr float CS = -1.702f * 1.4426950408889634f;
        const float kk = hscale / CS, dqc = dq * CS, dqk = dq * kk, glo = 7.0f * CS, ub0 = -6.0f * kk, ub1 = 8.0f * kk;
        f32x4 bg[2], bu[2];
#pragma unroll
        for (int n = 0; n < 2; ++n) { bg[n] = *(const PG8_LAS f32x4*)(sd + 2048 + (wc * 32 + 8 * fq + 4 * n) * 4) * CS; bu[n] = (*(const PG8_LAS f32x4*)(sd + 2048 + 512 + (wc * 32 + 8 * fq + 4 * n) * 4) + 1.0f) * kk; }
        const int lane = fr + 16 * fq;
        float rgls[2][4];
#pragma unroll
        for (int ai = 0; ai < 2; ++ai)
#pragma unroll
            for (int m = 0; m < 4; ++m) rgls[ai][m] = ((const PG8_LAS float*)(sd + 1024))[ai * HALF + wr * 64 + m * 16 + fr];
#pragma unroll
        for (int ai = 0; ai < 2; ++ai)
#pragma unroll
            for (int mp = 0; mp < 2; ++mp) {
                unsigned pw[2][2];
#pragma unroll
                for (int mm = 0; mm < 2; ++mm) { const int m = 2 * mp + mm; const int r = ai * HALF + wr * 64 + m * 16 + fr; const int er = u.r0 + r;
                    const float rgl = rgls[ai][m]; const float irg = (er < n_e) ? __builtin_amdgcn_rcpf(rgl) : 1e30f;
                    float hv[8];
#pragma unroll
                    for (int n = 0; n < 2; ++n)
#pragma unroll
                        for (int q = 0; q < 4; q += 2) {
                            f32x2 g = (f32x2){acc[ai][0][m][n][q], acc[ai][0][m][n][q + 1]} * dqc + (f32x2){bg[n][q], bg[n][q + 1]};
                            f32x2 up = (f32x2){acc[ai][1][m][n][q], acc[ai][1][m][n][q + 1]} * dqk + (f32x2){bu[n][q], bu[n][q + 1]};
                            g.x = fmaxf(g.x, glo); g.y = fmaxf(g.y, glo); up.x = __builtin_amdgcn_fmed3f(up.x, ub0, ub1); up.y = __builtin_amdgcn_fmed3f(up.y, ub0, ub1);
                            f32x2 den; den.x = __builtin_amdgcn_exp2f(g.x); den.y = __builtin_amdgcn_exp2f(g.y); den = den * irg + irg;
                            f32x2 sg; sg.x = __builtin_amdgcn_rcpf(den.x); sg.y = __builtin_amdgcn_rcpf(den.y);
                            const f32x2 h2 = (up * g) * sg;
                            hv[n * 4 + q] = h2.x; hv[n * 4 + q + 1] = h2.y; }
                    pw[mm][0] = pk4_fp8(hv[0], hv[1], hv[2], hv[3]); pw[mm][1] = pk4_fp8(hv[4], hv[5], hv[6], hv[7]); }
                const auto s0 = __builtin_amdgcn_permlane16_swap(pw[0][0], pw[1][0], false, false); const auto s1 = __builtin_amdgcn_permlane16_swap(pw[0][1], pw[1][1], false, false);
                *(u32x4*)(H + ((size_t)u.pm * 8 + u.pn) * 32768 + ((((ai * 2 + wr) * 4 + wc) * 2 + mp) * 64 + lane) * 16) = (u32x4){s0[0], s1[0], s0[1], s1[1]};
                asm volatile("" ::: "memory"); }
    }
};
struct EpiScatter {
    static constexpr bool PERM = true, AFTER_DRAIN = false;
    unsigned char* Y; const int* rowtok; const PG8_LAS int* cnt; float dq, ysc;
    __device__ __forceinline__ void operator()(const f32x4 (&acc)[2][2][4][2], const Unit& u, int wr, int wc, int fr, int fq, const PG8_LAS unsigned char* sd) const {
        const int col0 = u.pn * BM + wc * 32 + 8 * fq; const int n_e = cnt[u.e];
        f32x4 bd[2][2];
#pragma unroll
        for (int bj = 0; bj < 2; ++bj)
#pragma unroll
            for (int n = 0; n < 2; ++n) bd[bj][n] = *(const PG8_LAS f32x4*)(sd + 2048 + (bj * HALF + wc * 32 + 8 * fq + 4 * n) * 4);
        int idxs[2][4]; float rgs[2][4];
#pragma unroll
        for (int ai = 0; ai < 2; ++ai)
#pragma unroll
            for (int m = 0; m < 4; ++m) { idxs[ai][m] = ((const PG8_LAS int*)sd)[ai * HALF + wr * 64 + m * 16 + fr]; rgs[ai][m] = ((const PG8_LAS float*)(sd + 1024))[ai * HALF + wr * 64 + m * 16 + fr]; }
#pragma unroll
        for (int ai = 0; ai < 2; ++ai)
#pragma unroll
            for (int m = 0; m < 4; ++m) { const int er = u.r0 + ai * HALF + wr * 64 + m * 16 + fr;
                const int idx = idxs[ai][m];
                if (er < n_e) { unsigned char* rowp = Y + (size_t)idx * 1024 + col0;
                    typedef unsigned u32x2 __attribute__((ext_vector_type(2)));
                    const float rg = rgs[ai][m] * ysc;
#pragma unroll
                    for (int bj = 0; bj < 2; ++bj) { const f32x4 v0 = acc[ai][bj][m][0] * dq + bd[bj][0] * rg, v1 = acc[ai][bj][m][1] * dq + bd[bj][1] * rg;
                        *(u32x2*)(rowp + bj * HALF) = (u32x2){pk4_fp8(v0[0], v0[1], v0[2], v0[3]), pk4_fp8(v1[0], v1[1], v1[2], v1[3])}; } } }
    }
};

struct PanelStats {
    unsigned* xbuf;
    unsigned* cnt;
    unsigned* tmo;
    int ntn; float eps;
    unsigned code;
    __device__ __forceinline__ bool run(const f32x4 (&v)[2][2][4][2], const Unit& u, int wr, int wc, int fr, int fq, PG8_LAS unsigned char* lds, int wid, int lane) const {
        typedef float f32x2v __attribute__((ext_vector_type(2)));
        PG8_LAS f32x2v* P = (PG8_LAS f32x2v*)lds;
        PG8_LAS f32x2v* S = (PG8_LAS f32x2v*)(lds + 8192);
        PG8_LAS unsigned* flag = (PG8_LAS unsigned*)(lds + 8192 + 2048);
#pragma unroll
        for (int ai = 0; ai < 2; ++ai)
#pragma unroll
            for (int m = 0; m < 4; ++m) {
                float s = 0.f;
#pragma unroll
                for (int bj = 0; bj < 2; ++bj)
#pragma unroll
                    for (int n = 0; n < 2; ++n) { const f32x4 x = v[ai][bj][m][n]; s += (x[0] + x[1]) + (x[2] + x[3]); }
                s += __shfl_xor(s, 16); s += __shfl_xor(s, 32);
                const float mw = s * (1.0f / 64.0f); float q = 0.f;
#pragma unroll
                for (int bj = 0; bj < 2; ++bj)
#pragma unroll
                    for (int n = 0; n < 2; ++n) { const f32x4 d = v[ai][bj][m][n] - mw; q += (d[0] * d[0] + d[1] * d[1]) + (d[2] * d[2] + d[3] * d[3]); }
                q += __shfl_xor(q, 16); q += __shfl_xor(q, 32);
                if (fq == 0) P[(ai * HALF + wr * 64 + m * 16 + fr) * 4 + wc] = (f32x2v){mw, q};
            }
        asm volatile("s_waitcnt lgkmcnt(0)" ::: "memory"); __builtin_amdgcn_s_barrier(); asm volatile("" ::: "memory");
#if defined(BROKEN_EXCHANGE_NO_WAIT)
#warning BROKEN CONTROL BUILD: the row-statistics exchange does not wait; results are wrong by design
        if (blockIdx.x >= 64) { const long long t0_ = clock64(); while (clock64() - t0_ < 60000) __builtin_amdgcn_s_sleep(8); }
#endif
        const int row = wid * 32 + (lane & 31);
        if (lane < 32) {
            const f32x2v a = P[row * 4 + 0], b = P[row * 4 + 1], c = P[row * 4 + 2], d = P[row * 4 + 3];
            const float mt = (a.x + b.x + c.x + d.x) * 0.25f;
            const float da = a.x - mt, db = b.x - mt, dc = c.x - mt, dd = d.x - mt;
            const float m2 = (a.y + b.y) + (c.y + d.y) + 64.0f * ((da * da + db * db) + (dc * dc + dd * dd));
            unsigned long long* slot = (unsigned long long*)xbuf + ((size_t)(u.pm * BM + row) * 4 + u.pn);
            __hip_atomic_store(slot, ((unsigned long long)__float_as_uint(m2) << 32) | __float_as_uint(mt), __ATOMIC_RELAXED, __HIP_MEMORY_SCOPE_AGENT);
        }
        asm volatile("s_waitcnt vmcnt(0)" ::: "memory");
        if (lane == 0) __hip_atomic_fetch_add(cnt + 64 * u.pm, 1u, __ATOMIC_RELAXED, __HIP_MEMORY_SCOPE_AGENT);
        if (wid == 0) {
            const unsigned want = 8u * (unsigned)ntn; unsigned sp = 0u;
            while ((unsigned)__builtin_amdgcn_readfirstlane(__hip_atomic_load(cnt + 64 * u.pm, __ATOMIC_RELAXED, __HIP_MEMORY_SCOPE_AGENT)) < want) { __builtin_amdgcn_s_sleep(2); if (++sp > (1u << 20)) break; }
            __builtin_amdgcn_fence(__ATOMIC_ACQUIRE, "agent");
        }
        asm volatile("s_waitcnt vmcnt(0) lgkmcnt(0)" ::: "memory"); __builtin_amdgcn_s_barrier(); asm volatile("" ::: "memory");
        const bool bad = false;
        if (lane < 32) {
            const unsigned long long* slot = (const unsigned long long*)xbuf + (size_t)(u.pm * BM + row) * 4; float mt[4], m2[4]; float ms = 0.f;
#pragma unroll
            for (int t = 0; t < 4; ++t) { if (t < ntn) { const unsigned long long w = __hip_atomic_load(slot + t, __ATOMIC_RELAXED, __HIP_MEMORY_SCOPE_AGENT); mt[t] = __uint_as_float((unsigned)w); m2[t] = __uint_as_float((unsigned)(w >> 32)); } else { mt[t] = 0.f; m2[t] = 0.f; } ms += mt[t]; }
            const float mean = ms / (float)ntn; float q = 0.f;
#pragma unroll
            for (int t = 0; t < 4; ++t) if (t < ntn) { const float dm = mt[t] - mean; q += m2[t] + 256.0f * dm * dm; }
            S[row] = (f32x2v){mean, 1.0f / sqrtf(q / (256.0f * (float)ntn) + eps)};
        }
        asm volatile("s_waitcnt lgkmcnt(0)" ::: "memory"); __builtin_amdgcn_s_barrier(); asm volatile("" ::: "memory");
        return bad;
    }
};

struct EpiLn1 {
    static constexpr bool PERM = true, AFTER_DRAIN = true;
    unsigned char* ws; const float* gam; const float* bet; size_t o_xb, o_x8, o_xbuf, o_cnt, o_tmo; float alpha, s8, eps; unsigned code;
    __device__ __forceinline__ void operator()(const f32x4 (&)[2][2][4][2], const Unit&, int, int, int, int, const PG8_LAS unsigned char*) const {}
    __device__ __forceinline__ void fused(f32x4 (&acc)[2][2][4][2], const Unit& u, int wr, int wc, int fr, int fq, PG8_LAS unsigned char* lds, int wid, int lane) const {
        typedef float f32x2v __attribute__((ext_vector_type(2))); typedef unsigned u32x2 __attribute__((ext_vector_type(2)));
        bf16_t* const XBp = (bf16_t*)(ws + o_xb); unsigned char* const X8 = ws + o_x8;
        const PanelStats st{(unsigned*)(ws + o_xbuf), (unsigned*)(ws + o_cnt), (unsigned*)(ws + o_tmo), 4, eps, code};
        const int col0 = u.pn * BM + wc * 32 + 8 * fq;
#pragma unroll
        for (int ai = 0; ai < 2; ++ai)
#pragma unroll
            for (int m = 0; m < 4; ++m) { const bf16_t* xr = XBp + (size_t)(u.pm * BM + ai * HALF + wr * 64 + m * 16 + fr) * 1024 + col0;
#pragma unroll
                for (int bj = 0; bj < 2; ++bj) { const u32x4 x = *(const u32x4*)(xr + bj * HALF);
                    acc[ai][bj][m][0] += (f32x4){__builtin_bit_cast(float, x.x << 16), __builtin_bit_cast(float, x.x & 0xffff0000u), __builtin_bit_cast(float, x.y << 16), __builtin_bit_cast(float, x.y & 0xffff0000u)} * alpha;
                    acc[ai][bj][m][1] += (f32x4){__builtin_bit_cast(float, x.z << 16), __builtin_bit_cast(float, x.z & 0xffff0000u), __builtin_bit_cast(float, x.w << 16), __builtin_bit_cast(float, x.w & 0xffff0000u)} * alpha; }
                asm volatile("" ::: "memory"); }
        (void)st.run(acc, u, wr, wc, fr, fq, lds, wid, lane);
        const PG8_LAS f32x2v* S = (const PG8_LAS f32x2v*)(lds + 8192);
#pragma unroll
        for (int bj = 0; bj < 2; ++bj) {
            const f32x4 g0 = *(const f32x4*)(gam + col0 + bj * HALF), g1 = *(const f32x4*)(gam + col0 + bj * HALF + 4), b0 = *(const f32x4*)(bet + col0 + bj * HALF), b1 = *(const f32x4*)(bet + col0 + bj * HALF + 4);
#pragma unroll
            for (int ai = 0; ai < 2; ++ai)
#pragma unroll
                for (int m = 0; m < 4; ++m) { const int r = ai * HALF + wr * 64 + m * 16 + fr; const f32x2v sr = S[r]; const size_t off = (size_t)(u.pm * BM + r) * 1024 + col0 + bj * HALF;
                    const f32x4 o0 = (acc[ai][bj][m][0] - sr.x) * sr.y * g0 + b0, o1 = (acc[ai][bj][m][1] - sr.x) * sr.y * g1 + b1;
                    u32x4 w; w.x = cvt_pk_bf16(o0[0], o0[1]); w.y = cvt_pk_bf16(o0[2], o0[3]); w.z = cvt_pk_bf16(o1[0], o1[1]); w.w = cvt_pk_bf16(o1[2], o1[3]);
                    *(u32x4*)(XBp + off) = w;
                    *(u32x2*)(X8 + off) = (u32x2){pk4_fp8(o0[0] * s8, o0[1] * s8, o0[2] * s8, o0[3] * s8), pk4_fp8(o1[0] * s8, o1[1] * s8, o1[2] * s8, o1[3] * s8)};
                    asm volatile("" ::: "memory"); } }
    }
};

template <class Epi, class Sched, bool ALIGN_EPI, bool GATHER, bool FP8 = false, bool ABLK = false>
__device__ __forceinline__ void gemm_phase(PG8_LAS unsigned char* lds, const Gemm g, const Sched& S, const Epi& E) {
    int lane; asm volatile("v_mbcnt_lo_u32_b32 %0, -1, 0\n\tv_mbcnt_hi_u32_b32 %0, -1, %0" : "=v"(lane));
    int tid = threadIdx.x; asm volatile("" : "+v"(tid));
    const int wid = __builtin_amdgcn_readfirstlane(tid >> 6), wr = wid >> 2, wc = wid & 3, fr = lane & 15, fq = lane >> 4;
    const int K = g.K, nt = K / BK;
    unsigned voffB[2];
#pragma unroll
    for (int i = 0; i < 2; ++i) { int R, C; stage_rc(tid * 16 + i * 8192, R, C); const int Rb = Epi::PERM ? ((R & ~31) + perm32(R & 31)) : R;
        voffB[i] = (unsigned)(Rb * K + C) * 2u; }
    constexpr int SIDE_BYTES = 8192;
    PG8_LAS unsigned char* const side = lds + STAGE_BYTES;
    const size_t kstep = (size_t)(BK * 2);
    const size_t kstepA = ABLK ? (size_t)32768 : kstep;
    const size_t hstep = (size_t)HALF * K * 2;
    const size_t tstep = 2 * hstep;
    const unsigned ldsw = (unsigned)wid * 1024u;
    const int aoff = lds_byte(wr * 64 + fr, fq * 8), boff = lds_byte(wc * 32 + fr, fq * 8);
#define PG8_SA(b, h) (((b) * 2 + (h)) * HTB)
#define PG8_SB(b, h) ((4 + (b) * 2 + (h)) * HTB)
#define PG8_STAGE(bufoff, gbase, voff) do { _Pragma("unroll") for (int _i = 0; _i < 2; ++_i) \
        __builtin_amdgcn_global_load_lds((const unsigned*)((const char*)(gbase) + (voff)[_i]), (PG8_LAS unsigned*)(lds + (bufoff) + ldsw + _i * 8192), 16, 0, 0); } while (0)
#define PG8_LDA(dst, b, h) do { _Pragma("unroll") for (int m = 0; m < 4; ++m) _Pragma("unroll") for (int k = 0; k < 2; ++k) dst[m][k] = *(const PG8_LAS bf16x8*)(lds + PG8_SA(b, h) + aoff + m * 2048 + k * 1024); } while (0)
#define PG8_LDB(dst, b, h) do { _Pragma("unroll") for (int n = 0; n < 2; ++n) _Pragma("unroll") for (int k = 0; k < 2; ++k) dst[n][k] = *(const PG8_LAS bf16x8*)(lds + PG8_SB(b, h) + boff + n * 2048 + k * 1024); } while (0)
#define PG8_MMA(ai, bj, At, Bt) do { __builtin_amdgcn_s_setprio(1); _Pragma("unroll") for (int m = 0; m < 4; ++m) _Pragma("unroll") for (int n = 0; n < 2; ++n) { \
        if constexpr (FP8) mfma8(acc[ai][bj][m][n], cat8(Bt[n][0], Bt[n][1]), cat8(At[m][0], At[m][1]), scl8); \
        else { _Pragma("unroll") for (int k = 0; k < 2; ++k) acc[ai][bj][m][n] = __builtin_amdgcn_mfma_f32_16x16x32_bf16(Bt[n][k], At[m][k], acc[ai][bj][m][n], 0, 0, 0); } } __builtin_amdgcn_s_setprio(0); } while (0)
#define PG8_WAIT_V(n) asm volatile("s_waitcnt vmcnt(" #n ")" ::: "memory")
#define PG8_WAIT_L(n) asm volatile("s_waitcnt lgkmcnt(" #n ")" ::: "memory")
#define PG8_BAR __builtin_amdgcn_s_barrier()
#define PG8_SCHED __builtin_amdgcn_sched_barrier(0)
#define PG8_SETOFFS(o, u) do { _Pragma("unroll") for (int _h = 0; _h < 2; ++_h) _Pragma("unroll") for (int _i = 0; _i < 2; ++_i) { int _R, _C; stage_rc(tid * 16 + _i * 8192, _R, _C); \
        o[_h][_i] = GATHER ? (S.arow(u, _R + HALF * _h) + (unsigned)(_C * 2)) : ABLK ? hblk_off(_R + HALF * _h, _C >> 3) : ((unsigned)((_R + HALF * _h) * K) * 2u + (unsigned)(_C * 2)); } } while (0)
    int scl8 = 0x7F7F7F7F; asm volatile("" : "+v"(scl8));
    Unit cur, nxt; int ui = 0;
    if (!S.next(0, cur)) return;
    f32x4 acc[2][2][4][2];
#pragma unroll
    for (int a = 0; a < 2; ++a)
#pragma unroll
        for (int b = 0; b < 2; ++b)
#pragma unroll
            for (int m = 0; m < 4; ++m)
#pragma unroll
                for (int n = 0; n < 2; ++n) { acc[a][b][m][n] = (f32x4){0.f, 0.f, 0.f, 0.f}; if constexpr (FP8) asm volatile("" : "+v"(acc[a][b][m][n])); }
    bf16x8 At[4][2], B0[2][2], B1[2][2];
    unsigned cAo[2][2];
    PG8_SETOFFS(cAo, cur);
    const char* cA = S.abase(cur, g, tstep); const char* cB = S.bbase(cur, g, tstep);
    S.a_ready(cur);
    PG8_STAGE(PG8_SB(0, 0), cB, voffB); PG8_STAGE(PG8_SB(0, 1), cB + hstep, voffB); PG8_STAGE(PG8_SA(0, 0), cA, cAo[0]); PG8_STAGE(PG8_SA(0, 1), cA, cAo[1]);
    if (wr == 1) PG8_BAR;
    PG8_WAIT_V(2); PG8_BAR;
    PG8_STAGE(PG8_SB(1, 0), cB + kstep, voffB); PG8_STAGE(PG8_SA(1, 0), cA + kstepA, cAo[0]); PG8_STAGE(PG8_SB(1, 1), cB + hstep + kstep, voffB);
    PG8_WAIT_V(6); PG8_BAR;
    for (;;) {
        const bool has_next = S.next(ui + 1, nxt);
        const char* nA = has_next ? S.abase(nxt, g, tstep) : cA; const char* nB = has_next ? S.bbase(nxt, g, tstep) : cB;
        if constexpr (Sched::SIDE) {
            const void* ssrc = S.side_src(cur, (GATHER && has_next) ? nxt : cur, wid, lane);
            __builtin_amdgcn_global_load_lds((const unsigned*)ssrc, (PG8_LAS unsigned*)(side + (ui & 1) * SIDE_BYTES + wid * 1024), 16, 0, 0); }
#pragma unroll 1
        for (int t = 0; t < nt; t += 2) {
            const bool last = (t == nt - 2);
            const char* a1 = cA + (size_t)(t + 1) * kstepA;
            const char* a2 = last ? nA : cA + (size_t)(t + 2) * kstepA; const char* b2 = last ? nB : cB + (size_t)(t + 2) * kstep;
            const char* a3 = a2 + kstepA; const char* b3 = b2 + kstep;
            if (last && has_next) S.a_ready(nxt);
            PG8_LDB(B0, 0, 0); PG8_LDB(B1, 0, 1); PG8_SCHED; PG8_LDA(At, 0, 0); PG8_STAGE(PG8_SA(1, 1), a1, cAo[1]);
            if constexpr (GATHER) { if (last && has_next) {
                const PG8_LAS unsigned char* sdn = side + (ui & 1) * SIDE_BYTES;
#pragma unroll
                for (int _h = 0; _h < 2; ++_h)
#pragma unroll
                    for (int _i = 0; _i < 2; ++_i) { int _R, _C; stage_rc(tid * 16 + _i * 8192, _R, _C); cAo[_h][_i] = S.arow_side(nxt, _R + HALF * _h, sdn) + (unsigned)(_C * 2); } } }
            PG8_WAIT_V(8); PG8_WAIT_L(0); PG8_BAR; PG8_MMA(0, 0, At, B0); PG8_MMA(0, 1, At, B1); PG8_BAR; PG8_SCHED;
            PG8_LDA(At, 0, 1); PG8_STAGE(PG8_SB(0, 0), b2, voffB); PG8_STAGE(PG8_SB(0, 1), b2 + hstep, voffB); PG8_STAGE(PG8_SA(0, 0), a2, cAo[0]);
            PG8_WAIT_V(8); PG8_WAIT_L(0); PG8_BAR; PG8_MMA(1, 0, At, B0); PG8_MMA(1, 1, At, B1); PG8_BAR; PG8_SCHED;
            PG8_LDB(B0, 1, 0); PG8_LDB(B1, 1, 1); PG8_SCHED; PG8_LDA(At, 1, 0); PG8_STAGE(PG8_SA(0, 1), a2, cAo[1]);
            PG8_WAIT_V(8); PG8_WAIT_L(0); PG8_BAR; PG8_MMA(0, 0, At, B0); PG8_MMA(0, 1, At, B1); PG8_BAR; PG8_SCHED;
            PG8_LDA(At, 1, 1); PG8_STAGE(PG8_SB(1, 0), b3, voffB); PG8_STAGE(PG8_SB(1, 1), b3 + hstep, voffB); PG8_STAGE(PG8_SA(1, 0), a3, cAo[0]);
            PG8_WAIT_V(8); PG8_WAIT_L(0); PG8_BAR; PG8_MMA(1, 0, At, B0); PG8_MMA(1, 1, At, B1); PG8_BAR; PG8_SCHED;
        }
        if constexpr (ALIGN_EPI) { if (wr == 0) PG8_BAR; }
        if constexpr (FP8) asm volatile("s_nop 15\n\ts_nop 15" ::: "memory");
        if constexpr (!Epi::AFTER_DRAIN) { PG8_SCHED; E(acc, cur, wr, wc, fr, fq, side + (ui & 1) * SIDE_BYTES); S.done(cur); PG8_SCHED; }
        if (!has_next) break;
#pragma unroll
        for (int a = 0; a < 2; ++a)
#pragma unroll
            for (int b = 0; b < 2; ++b)
#pragma unroll
                for (int m = 0; m < 4; ++m)
#pragma unroll
                    for (int n = 0; n < 2; ++n) { acc[a][b][m][n] = (f32x4){0.f, 0.f, 0.f, 0.f}; if constexpr (FP8) asm volatile("" : "+v"(acc[a][b][m][n])); }
        cur = nxt; cA = nA; cB = nB; ++ui;
        if constexpr (ALIGN_EPI) { if (wr == 1) PG8_BAR; }
    }
    PG8_WAIT_V(0);
    if constexpr (!ALIGN_EPI) { if (wr == 0) PG8_BAR; }
    PG8_BAR;
    if constexpr (Epi::AFTER_DRAIN) { E.fused(acc, cur, wr, wc, fr, fq, lds, wid, lane); S.done(cur); }
#undef PG8_SA
#undef PG8_SB
#undef PG8_STAGE
#undef PG8_LDA
#undef PG8_LDB
#undef PG8_MMA
#undef PG8_WAIT_V
#undef PG8_WAIT_L
#undef PG8_BAR
#undef PG8_SCHED
#undef PG8_SETOFFS
}
}

constexpr int NB = 8, SEQ = 4096, DM = 1024, MROWS = NB * SEQ, NLAYER = 2;
constexpr int NPROJ = 4608, INW = 4616;
constexpr int C_Q = 0, C_K = 512, C_V = 1024, C_Z = 1536, C_XS = 2048, C_SB = 3072, C_SC = 3584, C_SH = 4096;
constexpr int MIXW = 1536, NEXP = 32, TOPK = 4, FF = 1024;
constexpr float ALPHA = 1.4142135623730951f;
constexpr float LN_EPS = 1e-5f, RMS_EPS = 1e-5f;
constexpr float QSCALE = 0.125f * 1.4426950408889634f;

constexpr size_t MiB = 1u << 20;
constexpr size_t WS_CTL = 0, CTL_ZERO_BYTES = 1 * MiB;
constexpr size_t WS_ROPE = 1 * MiB;
constexpr size_t WS_WDT = 2 * MiB;
constexpr size_t WS_ROUT = 2 * MiB + 65536;
constexpr size_t WS_WIN = 4 * MiB;
constexpr size_t WS_WOUT = 24 * MiB;
constexpr size_t WS_WGU = 32 * MiB;
constexpr size_t WS_WDN = 288 * MiB;
constexpr size_t WS_XB = 416 * MiB;
constexpr size_t WS_XF = 480 * MiB;
constexpr size_t WS_XF2 = 608 * MiB;
constexpr size_t WS_PROJ = 736 * MiB;
constexpr size_t WS_DT = 1024 * MiB;
constexpr size_t WS_DTS = 1025 * MiB;
constexpr size_t WS_ACUM = 1026 * MiB;
constexpr size_t WS_LSE = 1027 * MiB;
constexpr size_t WS_OP = 1030 * MiB;
constexpr size_t WS_U = 1126 * MiB;
constexpr size_t WS_G = 1190 * MiB;
constexpr size_t WS_ST = 1222 * MiB;
constexpr size_t WS_YD = 1286 * MiB;
constexpr size_t WS_MIXED = 1350 * MiB;
constexpr size_t WS_MIXF = 1446 * MiB;
constexpr size_t WS_TOPE = 1574 * MiB;
constexpr size_t WS_TOPG = 1575 * MiB;
constexpr size_t WS_ROWTOK = 1576 * MiB;
constexpr size_t WS_ROWGATE = 1580 * MiB;
constexpr size_t WS_H = 736 * MiB;
constexpr size_t WS_YB = 1030 * MiB;
constexpr size_t WS_END = 1584 * MiB;
constexpr int CW_TMO = 0;
constexpr int CW_CNT = 64;
constexpr int CW_BAR = 4096;
constexpr int CW_SEAM = 16384;

constexpr int RING_OFF = 0, RING_BYTES = 131072;
constexpr int LDSCTL_OFF = 155648;
constexpr int L_MISC = LDSCTL_OFF;
constexpr int L_TSTART = LDSCTL_OFF + 256;
constexpr int L_CNT = LDSCTL_OFF + 512;
constexpr int L_LCNT = LDSCTL_OFF + 640;
constexpr int L_LBASE = LDSCTL_OFF + 768;
constexpr int L_UNITS = LDSCTL_OFF + 1024;
constexpr int L_UNITSN = LDSCTL_OFF + 2048;
constexpr int LDS_BYTES = 163840;

#define GAS __attribute__((address_space(1)))
#define LAS __attribute__((address_space(3)))
typedef unsigned short bf16;
typedef unsigned v4u __attribute__((ext_vector_type(4)));
typedef unsigned v2u __attribute__((ext_vector_type(2)));
typedef float f32x4 __attribute__((ext_vector_type(4)));
typedef float f32x16 __attribute__((ext_vector_type(16)));
typedef short bf16x8 __attribute__((ext_vector_type(8)));
typedef GAS unsigned gu32;
#define RLX_AGENT __ATOMIC_RELAXED, __HIP_MEMORY_SCOPE_AGENT
#define LDS_WAIT() asm volatile("s_waitcnt lgkmcnt(0)" ::: "memory")
#define VM_WAIT() asm volatile("s_waitcnt vmcnt(0)" ::: "memory")
__device__ __forceinline__ unsigned f2bf(float f) { unsigned u = __builtin_bit_cast(unsigned, f); return (u + 0x7fffu + ((u >> 16) & 1u)) >> 16; }
__device__ __forceinline__ unsigned pk2(float lo, float hi) { unsigned r; asm volatile("v_cvt_pk_bf16_f32 %0, %1, %2" : "=v"(r) : "v"(lo), "v"(hi)); return r; }
__device__ __forceinline__ float bf2f(unsigned short b) { return __builtin_bit_cast(float, (unsigned)b << 16); }
__device__ __forceinline__ float bflo(unsigned w) { return __builtin_bit_cast(float, w << 16); }
__device__ __forceinline__ float bfhi(unsigned w) { return __builtin_bit_cast(float, w & 0xffff0000u); }
__device__ __forceinline__ float siluf(float x) { return x * __builtin_amdgcn_rcpf(1.0f + __builtin_amdgcn_exp2f(-1.4426950408889634f * x)); }
#define XB_TMO      128
#define XB_XCNT(j)  (256  + 64 * (j))
#define XB_XSUB(j)  (1280 + 64 * (j))
#define XB_XGEN(j)  (2304 + 64 * (j))
#define XB_TOP      3328
#define XB_TOPGEN   3392
#define XCD_BAR_WORDS 3456
#define XB_SPIN_CAP (1u << 18)

__device__ __forceinline__ unsigned xb_ld(unsigned* p)              { return __hip_atomic_load(p, __ATOMIC_RELAXED, __HIP_MEMORY_SCOPE_AGENT); }
__device__ __forceinline__ unsigned xb_add(unsigned* p, unsigned v) { return __hip_atomic_fetch_add(p, v, __ATOMIC_RELAXED, __HIP_MEMORY_SCOPE_AGENT); }
__device__ __forceinline__ unsigned xb_xcc_id() { return (unsigned)__builtin_amdgcn_s_getreg((3 << 11) | 20) & 0xFu; }
#define XB_SPIN(cond, bar) do { unsigned _sp = 0; while (cond) { __builtin_amdgcn_s_sleep(1); \
    if ((++_sp & 255u) == 0u) { if (xb_ld(&(bar)[XB_TMO])) break; if (_sp > XB_SPIN_CAP) { atomicAdd(&(bar)[XB_TMO], 1u); break; } } } } while (0)

struct XcdBarrier {
    unsigned* bar; unsigned x;
    volatile LAS unsigned* st;
};

__device__ __forceinline__ XcdBarrier xcd_barrier_post(unsigned* bar, volatile LAS unsigned* st) {
    XcdBarrier b; b.bar = bar; b.x = xb_xcc_id(); b.st = st;
    if (threadIdx.x == 0) (void)xb_add(&bar[XB_XCNT(b.x)], 1u);
    return b;
}
__device__ __forceinline__ void xcd_barrier_complete(unsigned* bar, unsigned x, unsigned& nloc, unsigned& nx) {
    const unsigned G = gridDim.x * gridDim.y * gridDim.z;
    unsigned sum, cnt, mine, sp = 0u;
    for (;;) {
        sum = 0u; cnt = 0u; mine = 0u;
#pragma unroll
        for (unsigned j = 0; j < 16; ++j) { const unsigned c = xb_ld(&bar[XB_XCNT(j)]); sum += c; cnt += (c > 0u) ? 1u : 0u; mine = (j == x) ? c : mine; }
        if (sum == G) break;
        __builtin_amdgcn_s_sleep(1);
        if ((++sp & 255u) == 0u) { if (xb_ld(&bar[XB_TMO])) break; if (sp > XB_SPIN_CAP) { atomicAdd(&bar[XB_TMO], 1u); break; } }
    }
    nloc = mine > 0u ? mine : 1u; nx = cnt > 0u ? cnt : 1u;
}

__device__ __forceinline__ void xcd_barrier(const XcdBarrier& b) {
    asm volatile("s_waitcnt vmcnt(0)" ::: "memory");
    __syncthreads();
    if (threadIdx.x == 0) {
        unsigned* bar = b.bar;
        __builtin_amdgcn_s_waitcnt(0);
        unsigned nloc = b.st[0], nx = b.st[1];
        if (nloc == 0u) { xcd_barrier_complete(bar, b.x, nloc, nx); b.st[0] = nloc; b.st[1] = nx; }
        const unsigned old = xb_add(&bar[XB_XSUB(b.x)], 1u);
        const unsigned gen = old / nloc;
        if (old + 1u == (gen + 1u) * nloc) {
            __builtin_amdgcn_fence(__ATOMIC_RELEASE, "agent");
            asm volatile("s_waitcnt vmcnt(0)" ::: "memory");
            const unsigned og = xb_add(&bar[XB_TOP], 1u);
            const unsigned tg = og / nx;
            if (og + 1u == (tg + 1u) * nx) xb_add(&bar[XB_TOPGEN], 1u);
            else XB_SPIN(xb_ld(&bar[XB_TOPGEN]) == tg, bar);
            __builtin_amdgcn_fence(__ATOMIC_ACQUIRE, "agent");
            xb_add(&bar[XB_XGEN(b.x)], 1u);
            asm volatile("s_waitcnt vmcnt(0)" ::: "memory");
        } else {
            XB_SPIN(xb_ld(&bar[XB_XGEN(b.x)]) == gen, bar);
            __builtin_amdgcn_fence(__ATOMIC_ACQUIRE, "agent");
            asm volatile("s_waitcnt vmcnt(0)" ::: "memory");
        }
    }
    __syncthreads();
}

constexpr float SC_X = 4.f, SC_WGU = 32.f, SC_H = 4.f, SC_WDN = 4.f, SC_Y = 16.f, SC_WIN = 32.f, SC_O = 32.f;
__device__ __forceinline__ float wave_sum(float v) {
#pragma unroll
    for (int o = 1; o < 64; o <<= 1) v += __shfl_xor(v, o);
    return v;
}
__device__ __forceinline__ int win_dest_row(int n) {
    if (n < 1024) { const int hh = n >> 6, d = n & 63; const int p = (d < 32) ? (8 * (d >> 2) + (d & 3)) : (8 * ((d - 32) >> 2) + 4 + (d & 3)); return hh * 64 + p; }
    if (n < 3072) return n;
    if (n < 3080) return -1;
    return n - 8;
}
__device__ __forceinline__ int wgu_dest_row(int n) { return n < 1024 ? ((n >> 7) * 256 + (n & 127)) : (((n - 1024) >> 7) * 256 + 128 + ((n - 1024) & 127)); }
template <int MAP>
__device__ __forceinline__ void p0_transpose_item(const float* W, int K, int N, bf16* WT, float* wdt, LAS float* scr, int kb, int nb, int lane) {
    const int k0 = 64 * kb, n0 = 32 * nb;
    const int nn = n0 + (lane & 31); const bool nok = nn < N;
#pragma unroll 8
    for (int i = 0; i < 32; ++i) { const int kk = 2 * i + (lane >> 5); scr[kk * 33 + (lane & 31)] = nok ? W[(size_t)(k0 + kk) * N + nn] : 0.f; }
    LDS_WAIT(); asm volatile("" ::: "memory");
    const int c = lane & 7;
#pragma unroll
    for (int j = 0; j < 4; ++j) { const int n = (lane >> 3) + 8 * j; const LAS float* s = scr + (8 * c) * 33 + n;
        const int nsrc = n0 + n; if (nsrc >= N) continue;
        int drow = nsrc; if (MAP == 1) drow = win_dest_row(nsrc); if (MAP == 2) drow = wgu_dest_row(nsrc);
        if (MAP == 1 && drow < 0) { float* d = wdt + (size_t)(nsrc - 3072) * 1024 + k0 + 8 * c;
#pragma unroll
            for (int q = 0; q < 8; ++q) d[q] = s[q * 33]; continue; }
        v4u o; o.x = pk2(s[0 * 33], s[1 * 33]); o.y = pk2(s[2 * 33], s[3 * 33]); o.z = pk2(s[4 * 33], s[5 * 33]); o.w = pk2(s[6 * 33], s[7 * 33]);
        *(GAS v4u*)(WT + (size_t)drow * K + k0 + 8 * c) = o; }
    LDS_WAIT(); asm volatile("" ::: "memory");
}
template <int MAP>
__device__ __forceinline__ void p0_transpose_item64(const float* W, int K, int N, bf16* WT, float* wdt, LAS float* scr, int kb, int nb, int lane) {
    const int k0 = 64 * kb, n0 = 64 * nb;
    const bool lok = (n0 + 4 * (lane & 15) + 3) < N;
    f32x4 ld[16];
#pragma unroll
    for (int i = 0; i < 16; ++i) ld[i] = lok ? *(const f32x4*)(W + (size_t)(k0 + 4 * i + (lane >> 4)) * N + n0 + 4 * (lane & 15)) : (f32x4){0.f, 0.f, 0.f, 0.f};
#pragma unroll
    for (int i = 0; i < 16; ++i) *(LAS f32x4*)(scr + (4 * i + (lane >> 4)) * 64 + 4 * (lane & 15)) = ld[i];
    LDS_WAIT(); asm volatile("" ::: "memory");
    const int nsrc = n0 + lane;
    if (nsrc < N) {
        int drow = nsrc; if (MAP == 1) drow = win_dest_row(nsrc);
        if (MAP == 1 && drow < 0) { float* d = wdt + (size_t)(nsrc - 3072) * 1024 + k0;
#pragma unroll
            for (int q = 0; q < 16; ++q) *(f32x4*)(d + 4 * q) = (f32x4){scr[(4 * q) * 64 + lane], scr[(4 * q + 1) * 64 + lane], scr[(4 * q + 2) * 64 + lane], scr[(4 * q + 3) * 64 + lane]}; }
        else { GAS v4u* d = (GAS v4u*)(WT + (size_t)drow * K + k0);
#pragma unroll
            for (int q = 0; q < 8; ++q) { v4u o; o.x = pk2(scr[(8 * q) * 64 + lane], scr[(8 * q + 1) * 64 + lane]); o.y = pk2(scr[(8 * q + 2) * 64 + lane], scr[(8 * q + 3) * 64 + lane]);
                o.z = pk2(scr[(8 * q + 4) * 64 + lane], scr[(8 * q + 5) * 64 + lane]); o.w = pk2(scr[(8 * q + 6) * 64 + lane], scr[(8 * q + 7) * 64 + lane]); d[q] = o; } } }
    LDS_WAIT(); asm volatile("" ::: "memory");
}
struct SubT { const float* src; unsigned char* dst; int N; int n0; int mode; float scale; };
__device__ __forceinline__ SubT fp8_subtile(int item, int half, const float* wgu, const float* wdn, const float* win, unsigned char* WG8, unsigned char* WD8, unsigned char* WI8, int lane) {
    SubT t; int kb, nb;
    if (item < 64 * 256) { const int le = item >> 8, r = item & 255; kb = r >> 5; nb = r & 31; t.N = 2048; t.mode = 1; t.scale = SC_WGU;
        t.src = wgu + (size_t)le * 1024 * 2048; t.dst = WG8 + (size_t)le * 2048 * 1024; }
    else if (item < 64 * 256 + 64 * 128) { const int it2 = item - 64 * 256; const int le = it2 >> 7, r = it2 & 127; kb = r >> 4; nb = r & 15; t.N = 1024; t.mode = 0; t.scale = SC_WDN;
        t.src = wdn + (size_t)le * 1024 * 1024; t.dst = WD8 + (size_t)le * 1024 * 1024; }
    else { const int it3 = item - (64 * 256 + 64 * 128); const int l = it3 / 192, r = it3 % 192; kb = r / 24; nb = r % 24; t.N = INW; t.mode = 2; t.scale = SC_WIN;
        t.src = win + (size_t)l * 1024 * INW; t.dst = WI8 + (size_t)l * 1536 * 1024; }
    const int k0 = 128 * kb + 64 * half; t.n0 = 64 * nb;
    t.src += (size_t)(k0 + (lane >> 4)) * t.N + t.n0 + 4 * (lane & 15);
    t.dst += (size_t)k0;
    return t;
}
__device__ __forceinline__ void fp8_sub_load(const SubT& t, f32x4 (&ld)[16]) {
#pragma unroll
    for (int i = 0; i < 16; ++i) ld[i] = __builtin_nontemporal_load((const f32x4*)(t.src + (size_t)(4 * i) * t.N));
}
__device__ __forceinline__ void fp8_sub_process(const SubT& t, const f32x4 (&ld)[16], LAS float* scr, int lane) {
#pragma unroll
    for (int i = 0; i < 16; ++i) *(LAS f32x4*)(scr + (4 * i + (lane >> 4)) * 64 + 4 * (lane & 15)) = ld[i];
    LDS_WAIT(); asm volatile("" ::: "memory");
    unsigned w[16];
#pragma unroll
    for (int q = 0; q < 16; ++q) w[q] = pg8::pk4_fp8(scr[(4 * q + 0) * 64 + lane] * t.scale, scr[(4 * q + 1) * 64 + lane] * t.scale, scr[(4 * q + 2) * 64 + lane] * t.scale, scr[(4 * q + 3) * 64 + lane] * t.scale);
    LDS_WAIT(); asm volatile("" ::: "memory");
    LAS unsigned char* t2 = (LAS unsigned char*)scr;
#pragma unroll
    for (int q = 0; q < 4; ++q) *(LAS v4u*)(t2 + lane * 80 + 16 * q) = (v4u){w[4 * q], w[4 * q + 1], w[4 * q + 2], w[4 * q + 3]};
    LDS_WAIT(); asm volatile("" ::: "memory");
#pragma unroll
    for (int q = 0; q < 4; ++q) { const int n = 16 * q + (lane >> 2); const v4u v = *(const LAS v4u*)(t2 + n * 80 + 16 * (lane & 3));
        const int nn = (t.mode == 1) ? wgu_dest_row(t.n0 + n) : (t.mode == 2) ? win_dest_row(t.n0 + n) : (t.n0 + n);
        *(GAS v4u*)(t.dst + (size_t)nn * 1024 + 16 * (lane & 3)) = v; }
    LDS_WAIT(); asm volatile("" ::: "memory");
}
__device__ __forceinline__ void row_dt(const f32x4 (&v)[4], const float* wdt, float* dst, int lane) {
    float r[8];
#pragma unroll
    for (int jj = 0; jj < 8; ++jj) { float s = 0.f;
#pragma unroll
        for (int j = 0; j < 4; ++j) { const f32x4 w = *(const f32x4*)(wdt + jj * 1024 + 4 * lane + 256 * j); s += v[j][0] * w[0] + v[j][1] * w[1] + v[j][2] * w[2] + v[j][3] * w[3]; }
        r[jj] = wave_sum(s); }
    if (lane == 0) { *(f32x4*)dst = (f32x4){r[0], r[1], r[2], r[3]}; *(f32x4*)(dst + 4) = (f32x4){r[4], r[5], r[6], r[7]}; }
}
__device__ __forceinline__ void load_wdt(const float* wdt, f32x4 (&w)[8][4], int lane) {
#pragma unroll
    for (int jj = 0; jj < 8; ++jj)
#pragma unroll
        for (int j = 0; j < 4; ++j) w[jj][j] = *(const f32x4*)(wdt + jj * 1024 + 4 * lane + 256 * j);
}
__device__ __forceinline__ void row_dt_w(const f32x4 (&v)[4], const f32x4 (&w)[8][4], float* dst, int lane) {
    float r[8];
#pragma unroll
    for (int jj = 0; jj < 8; ++jj) { float s = 0.f;
#pragma unroll
        for (int j = 0; j < 4; ++j) s += v[j][0] * w[jj][j][0] + v[j][1] * w[jj][j][1] + v[j][2] * w[jj][j][2] + v[j][3] * w[jj][j][3];
        r[jj] = wave_sum(s); }
    if (lane == 0) { *(f32x4*)dst = (f32x4){r[0], r[1], r[2], r[3]}; *(f32x4*)(dst + 4) = (f32x4){r[4], r[5], r[6], r[7]}; }
}
__device__ __forceinline__ void row_dt_win(const f32x4 (&v)[4], const float* win, float* dst, int lane) {
    float r[8];
#pragma unroll
    for (int jj = 0; jj < 8; ++jj) r[jj] = 0.f;
#pragma unroll
    for (int j = 0; j < 4; ++j)
#pragma unroll
        for (int e = 0; e < 4; ++e) { const float* wp = win + (size_t)(4 * lane + 256 * j + e) * INW + 3072; const f32x4 w0 = *(const f32x4*)wp, w1 = *(const f32x4*)(wp + 4); const float x = v[j][e];
            r[0] += x * w0[0]; r[1] += x * w0[1]; r[2] += x * w0[2]; r[3] += x * w0[3]; r[4] += x * w1[0]; r[5] += x * w1[1]; r[6] += x * w1[2]; r[7] += x * w1[3]; }
#pragma unroll
    for (int jj = 0; jj < 8; ++jj) r[jj] = wave_sum(r[jj]);
    if (lane == 0) { *(f32x4*)dst = (f32x4){r[0], r[1], r[2], r[3]}; *(f32x4*)(dst + 4) = (f32x4){r[4], r[5], r[6], r[7]}; }
}
template <bool W8, bool WF>
__device__ __forceinline__ void ln_row(f32x4 (&v)[4], const float* gam, const float* bet, float* of32, bf16* ob16, unsigned char* o8, float s8, int lane) {
    float s = 0.f;
#pragma unroll
    for (int j = 0; j < 4; ++j) s += (v[j][0] + v[j][1]) + (v[j][2] + v[j][3]);
    const float mean = wave_sum(s) * (1.f / DM); float s2 = 0.f;
#pragma unroll
    for (int j = 0; j < 4; ++j) { v[j] = v[j] - mean; s2 += (v[j][0] * v[j][0] + v[j][1] * v[j][1]) + (v[j][2] * v[j][2] + v[j][3] * v[j][3]); }
    const float rstd = 1.f / sqrtf(wave_sum(s2) * (1.f / DM) + LN_EPS);
#pragma unroll
    for (int j = 0; j < 4; ++j) { const f32x4 g = *(const f32x4*)(gam + 4 * lane + 256 * j), b = *(const f32x4*)(bet + 4 * lane + 256 * j);
        v[j] = v[j] * rstd * g + b;
        if (WF) *(f32x4*)(of32 + 4 * lane + 256 * j) = v[j];
        v2u w; w.x = pk2(v[j][0], v[j][1]); w.y = pk2(v[j][2], v[j][3]); *(v2u*)(ob16 + 4 * lane + 256 * j) = w;
        if (W8) *(unsigned*)(o8 + 4 * lane + 256 * j) = pg8::pk4_fp8(v[j][0] * s8, v[j][1] * s8, v[j][2] * s8, v[j][3] * s8); }
}


typedef short v4i16_t __attribute__((ext_vector_type(4)));
__device__ __forceinline__ bf16x8 tr_pair(const LAS unsigned char* p0, const LAS unsigned char* p1) {
    const v4i16_t a = __builtin_amdgcn_ds_read_tr16_b64_v4i16((LAS v4i16_t*)p0), b = __builtin_amdgcn_ds_read_tr16_b64_v4i16((LAS v4i16_t*)p1);
    return (bf16x8){a[0], a[1], a[2], a[3], b[0], b[1], b[2], b[3]};
}
__device__ __forceinline__ int crow16(int r, int hi) { return (r & 3) + 8 * (r >> 2) + 4 * hi; }
constexpr int AK_PITCH = 144, AV_PITCH = 192, AK_TILE = 32 * AK_PITCH, AV_TILE = 32 * AV_PITCH;
constexpr int AT_K = 0, AT_V = 12 * AK_TILE;
struct AttnItem { int p, b, h, d, r, qt0; };
__device__ __forceinline__ AttnItem attn_item(int I) { AttnItem a; a.p = I >> 10; const int rem = I & 1023; a.b = rem >> 7; a.h = (rem >> 4) & 7; const int grp = rem & 15;
    a.d = (a.p == 0) ? 1 : (a.p == 1) ? 4 : 16; const int tpr = 128 / a.d; const int T = grp * 8; a.r = T / tpr; a.qt0 = T % tpr; return a; }
__device__ __forceinline__ void attn_request(const bf16* PROJ, const AttnItem& a, v4u (&st)[12], int tid) {
    const int rr = tid >> 4, ch = tid & 15; const int col = (ch < 8 ? C_K : C_V - 64) + a.h * 64 + ch * 8;
#pragma unroll
    for (int tl = 0; tl < 12; ++tl) { const int kt = a.qt0 - 4 + tl; st[tl] = (v4u){0u, 0u, 0u, 0u};
        if (kt >= 0) { const size_t row = (size_t)a.b * SEQ + (size_t)(32 * kt + rr) * a.d + a.r; st[tl] = *(const v4u*)(PROJ + row * NPROJ + col); } }
}
__device__ __forceinline__ void attn_deposit(LAS unsigned char* al, const v4u (&st)[12], int tid) {
    const int rr = tid >> 4, ch = tid & 15;
    LAS unsigned char* dst = (ch < 8) ? (al + AT_K + rr * AK_PITCH + ch * 16) : (al + AT_V + rr * AV_PITCH + (ch - 8) * 16); const int tstep = (ch < 8) ? AK_TILE : AV_TILE;
#pragma unroll
    for (int tl = 0; tl < 12; ++tl) *(LAS v4u*)(dst + tl * tstep) = st[tl];
}
__device__ __forceinline__ void attn_wave_compute(const bf16* PROJ, bf16* OPp, float* LSEp, const AttnItem& a, const LAS unsigned char* al, int wave, int lane) {
    const int i = lane & 31, h2 = lane >> 5; const int qt = a.qt0 + wave;
    const size_t rowq = (size_t)a.b * SEQ + (size_t)(32 * qt + i) * a.d + a.r;
    bf16x8 qf[4];
    { const bf16* qp = PROJ + rowq * NPROJ + C_Q + a.h * 64 + 8 * h2;
#pragma unroll
      for (int s = 0; s < 4; ++s) qf[s] = *(const bf16x8*)(qp + 16 * s); }
    f32x16 o0 = {}, o1 = {}; float mrun = -INFINITY, lrun = 0.f;
    const int kt0 = qt > 4 ? qt - 4 : 0;
    const LAS unsigned char* krd = al + AT_K + i * AK_PITCH + 16 * h2;
    const LAS unsigned char* trb = al + AT_V + (4 * h2 + ((lane & 15) >> 2)) * AV_PITCH + (16 * ((lane >> 4) & 1) + 4 * (lane & 3)) * 2;
#define ATT_QK(S, ktx) do { const LAS unsigned char* kp_ = krd + ((ktx) - a.qt0 + 4) * AK_TILE; \
        S = __builtin_amdgcn_mfma_f32_32x32x16_bf16(*(const LAS bf16x8*)(kp_), qf[0], (f32x16){}, 0, 0, 0); \
        _Pragma("unroll") for (int s = 1; s < 4; ++s) S = __builtin_amdgcn_mfma_f32_32x32x16_bf16(*(const LAS bf16x8*)(kp_ + 32 * s), qf[s], S, 0, 0, 0); } while (0)
#define ATT_STEP(S, ktx) do { const LAS unsigned char* vp = trb + ((ktx) - a.qt0 + 4) * AV_TILE; \
        if ((ktx) == qt) { asm volatile("; causal mask"); _Pragma("unroll") for (int rg = 0; rg < 16; ++rg) if (crow16(rg, h2) > i) S[rg] = -INFINITY; } \
        if ((ktx) + 4 == qt) { asm volatile("; window mask"); _Pragma("unroll") for (int rg = 0; rg < 16; ++rg) if (crow16(rg, h2) < i) S[rg] = -INFINITY; } \
        float mx = S[0]; \
        _Pragma("unroll") for (int rg = 1; rg < 16; ++rg) mx = fmaxf(mx, S[rg]); \
        mx = fmaxf(mx, __shfl_xor(mx, 32)); \
        const float mnew = fmaxf(mrun, mx), alpha = __builtin_amdgcn_exp2f(mrun - mnew); mrun = mnew; \
        float ps = 0.f; \
        _Pragma("unroll") for (int rg = 0; rg < 16; ++rg) { S[rg] = __builtin_amdgcn_exp2f(S[rg] - mnew); ps += S[rg]; } \
        lrun = lrun * alpha + ps; \
        _Pragma("unroll") for (int rg = 0; rg < 16; ++rg) { o0[rg] *= alpha; o1[rg] *= alpha; } \
        bf16x8 pf[2]; \
        _Pragma("unroll") for (int ks = 0; ks < 2; ++ks) { v4u w; w.x = pg8::cvt_pk_bf16(S[8 * ks + 0], S[8 * ks + 1]); w.y = pg8::cvt_pk_bf16(S[8 * ks + 2], S[8 * ks + 3]); w.z = pg8::cvt_pk_bf16(S[8 * ks + 4], S[8 * ks + 5]); w.w = pg8::cvt_pk_bf16(S[8 * ks + 6], S[8 * ks + 7]); pf[ks] = __builtin_bit_cast(bf16x8, w); } \
        _Pragma("unroll") for (int ks = 0; ks < 2; ++ks) { \
            const bf16x8 v0 = tr_pair(vp + (16 * ks) * AV_PITCH, vp + (16 * ks + 8) * AV_PITCH); \
            const bf16x8 v1 = tr_pair(vp + (16 * ks) * AV_PITCH + 64, vp + (16 * ks + 8) * AV_PITCH + 64); \
            o0 = __builtin_amdgcn_mfma_f32_32x32x16_bf16(v0, pf[ks], o0, 0, 0, 0); \
            o1 = __builtin_amdgcn_mfma_f32_32x32x16_bf16(v1, pf[ks], o1, 0, 0, 0); } } while (0)
    f32x16 sA, sB;
    ATT_QK(sA, kt0);
#pragma unroll 1
    for (int kt = kt0; ; kt += 2) {
        if (kt < qt) ATT_QK(sB, kt + 1);
        ATT_STEP(sA, kt);
        if (kt >= qt) break;
        if (kt + 1 < qt) ATT_QK(sA, kt + 2);
        ATT_STEP(sB, kt + 1);
        if (kt + 1 >= qt) break;
    }
#undef ATT_QK
#undef ATT_STEP
    const float lt = lrun + __shfl_xor(lrun, 32); const float il = 1.0f / lt;
    unsigned char* op = (unsigned char*)OPp + rowq * 512 + a.h * 64 + 4 * h2;
    const float ils = il * SC_O;
#pragma unroll
    for (int g4 = 0; g4 < 4; ++g4) {
        *(unsigned*)(op + 8 * g4) = pg8::pk4_fp8(o0[4 * g4 + 0] * ils, o0[4 * g4 + 1] * ils, o0[4 * g4 + 2] * ils, o0[4 * g4 + 3] * ils);
        *(unsigned*)(op + 32 + 8 * g4) = pg8::pk4_fp8(o1[4 * g4 + 0] * ils, o1[4 * g4 + 1] * ils, o1[4 * g4 + 2] * ils, o1[4 * g4 + 3] * ils); }
    if (h2 == 0) LSEp[rowq * 8 + a.h] = mrun + log2f(lt);
}
__device__ __forceinline__ void attn_phase(LAS unsigned char* al, const bf16* PROJ, bf16* OP, float* LSE, int bid, int G, int tid, int wave, int lane) {
    v4u st[12];
    int I = bid;
    if (I < 3072) { const AttnItem a = attn_item(I); attn_request(PROJ, a, st, tid); }
    for (; I < 3072; I += G) {
        const AttnItem a = attn_item(I);
        __syncthreads();
        attn_deposit(al, st, tid);
        __syncthreads();
        if (I + G < 3072) { const AttnItem n = attn_item(I + G); attn_request(PROJ, n, st, tid); }
        attn_wave_compute(PROJ, (bf16*)((unsigned char*)OP + (size_t)a.p * MROWS * 512), LSE + (size_t)a.p * MROWS * 8, a, al, wave, lane);
    }
    __syncthreads();
}

constexpr int SS_DTS = 0, SS_ACUM = 2048, SS_TMP = 4096, SS_SSX = 6144, SS_IMG = 8192;
constexpr int S1_PB = 320, S1_PX = 576;
constexpr int S1_B = SS_IMG, S1_X = SS_IMG + 128 * S1_PB;
constexpr int S3_PBC = 272, S3_PX = 576;
constexpr int S3_B = SS_IMG, S3_C = S3_B + 128 * S3_PBC, S3_X = S3_C + 128 * S3_PBC;

__device__ __forceinline__ void ssd_prep(LAS unsigned char* sl, const float* DT, const float* dtb, const float* alog, size_t row0, int g, int tid, int lane, int wave) {
    LAS float* dts = (LAS float*)(sl + SS_DTS); LAS float* acum = (LAS float*)(sl + SS_ACUM); LAS float* tmp = (LAS float*)(sl + SS_TMP);
    { const int l = tid >> 2, hq = tid & 3; const float x = DT[(row0 + l) * 8 + 4 * g + hq] + dtb[4 * g + hq];
      const float dt = x > 20.f ? x : log1pf(__expf(x)); dts[hq * 128 + l] = dt; tmp[hq * 128 + l] = dt * (-__expf(alog[4 * g + hq]) * 1.4426950408889634f); }
    __syncthreads();
    if (wave < 4) { const float v0 = tmp[wave * 128 + 2 * lane], v1 = tmp[wave * 128 + 2 * lane + 1]; float s = v0 + v1;
#pragma unroll
        for (int off = 1; off < 64; off <<= 1) { const float t = __shfl_up(s, off); if (lane >= off) s += t; }
        acum[wave * 128 + 2 * lane] = s - v1; acum[wave * 128 + 2 * lane + 1] = s; }
    __syncthreads();
}
template <int NCOLS, int FACMODE>
__device__ __forceinline__ void conv_tile(const bf16* PROJ, size_t row0, int t0, int pcol0, const float* cw, const float* cb, int cch0, LAS unsigned char* dst, int pitch, const LAS unsigned char* sl, int hq0, int tid) {
    constexpr int NCH8 = NCOLS / 8, NSEG = 512 / NCH8, RPS = 128 / NSEG;
    const int c8 = tid % NCH8, seg = tid / NCH8, l0 = seg * RPS;
    float w[4][8], bias[8], hst[3][8];
#pragma unroll
    for (int k = 0; k < 4; ++k) { const f32x4 a = *(const f32x4*)(cw + k * 1024 + cch0 + c8 * 8), b = *(const f32x4*)(cw + k * 1024 + cch0 + c8 * 8 + 4);
        w[k][0] = a[0]; w[k][1] = a[1]; w[k][2] = a[2]; w[k][3] = a[3]; w[k][4] = b[0]; w[k][5] = b[1]; w[k][6] = b[2]; w[k][7] = b[3]; }
    { const f32x4 a = *(const f32x4*)(cb + cch0 + c8 * 8), b = *(const f32x4*)(cb + cch0 + c8 * 8 + 4);
      bias[0] = a[0]; bias[1] = a[1]; bias[2] = a[2]; bias[3] = a[3]; bias[4] = b[0]; bias[5] = b[1]; bias[6] = b[2]; bias[7] = b[3]; }
    const bf16* src = PROJ + pcol0 + c8 * 8;
#pragma unroll
    for (int k = 0; k < 3; ++k) { const int l = l0 - 3 + k; v4u v = (v4u){0u, 0u, 0u, 0u}; if (t0 + l >= 0) v = *(const v4u*)(src + (size_t)((long)row0 + l) * NPROJ);
        hst[k][0] = bflo(v.x); hst[k][1] = bfhi(v.x); hst[k][2] = bflo(v.y); hst[k][3] = bfhi(v.y); hst[k][4] = bflo(v.z); hst[k][5] = bfhi(v.z); hst[k][6] = bflo(v.w); hst[k][7] = bfhi(v.w); }
    const LAS float* dts = (const LAS float*)(sl + SS_DTS); const LAS float* acum = (const LAS float*)(sl + SS_ACUM);
    const int hq = hq0 + (c8 * 8) / 64;
    const float alast = (FACMODE == 2) ? acum[hq * 128 + 127] : 0.f;
#pragma unroll
    for (int rr = 0; rr < RPS; ++rr) { const int l = l0 + rr; const v4u v = *(const v4u*)(src + (row0 + l) * NPROJ);
        float cur[8]; cur[0] = bflo(v.x); cur[1] = bfhi(v.x); cur[2] = bflo(v.y); cur[3] = bfhi(v.y); cur[4] = bflo(v.z); cur[5] = bfhi(v.z); cur[6] = bflo(v.w); cur[7] = bfhi(v.w);
        float f = 1.f; if (FACMODE >= 1) f = dts[hq * 128 + l]; if (FACMODE == 2) f *= __builtin_amdgcn_exp2f(alast - acum[hq * 128 + l]);
        float o[8];
#pragma unroll
        for (int e = 0; e < 8; ++e) { const float a = bias[e] + w[0][e] * hst[0][e] + w[1][e] * hst[1][e] + w[2][e] * hst[2][e] + w[3][e] * cur[e]; o[e] = siluf(a) * f;
            hst[0][e] = hst[1][e]; hst[1][e] = hst[2][e]; hst[2][e] = cur[e]; }
        v4u ov; ov.x = pk2(o[0], o[1]); ov.y = pk2(o[2], o[3]); ov.z = pk2(o[4], o[5]); ov.w = pk2(o[6], o[7]);
        *(LAS v4u*)(dst + l * pitch + c8 * 16) = ov; }
}
template <int NCOLS>
__device__ __forceinline__ void conv_load(const bf16* PROJ, size_t row0, int t0, int pcol0, int tid, v4u (&hv)[3], v4u (&rv)[128 / (512 / (NCOLS / 8))]) {
    constexpr int NCH8 = NCOLS / 8, NSEG = 512 / NCH8, RPS = 128 / NSEG;
    const int c8 = tid % NCH8, seg = tid / NCH8, l0 = seg * RPS;
    const bf16* src = PROJ + pcol0 + c8 * 8;
#pragma unroll
    for (int k = 0; k < 3; ++k) { const int l = l0 - 3 + k; hv[k] = (v4u){0u, 0u, 0u, 0u}; if (t0 + l >= 0) hv[k] = *(const v4u*)(src + (size_t)((long)row0 + l) * NPROJ); }
#pragma unroll
    for (int rr = 0; rr < RPS; ++rr) rv[rr] = *(const v4u*)(src + (row0 + l0 + rr) * NPROJ);
}
template <int NCOLS, int FACMODE>
__device__ __forceinline__ void conv_apply(const v4u (&hv)[3], const v4u (&rv)[128 / (512 / (NCOLS / 8))], const float* cw, const float* cb, int cch0, LAS unsigned char* dst, int pitch, const LAS unsigned char* sl, int hq0, int tid) {
    constexpr int NCH8 = NCOLS / 8, NSEG = 512 / NCH8, RPS = 128 / NSEG;
    const int c8 = tid % NCH8, seg = tid / NCH8, l0 = seg * RPS;
    float w[4][8], bias[8], hst[3][8];
#pragma unroll
    for (int k = 0; k < 4; ++k) { const f32x4 a = *(const f32x4*)(cw + k * 1024 + cch0 + c8 * 8), b = *(const f32x4*)(cw + k * 1024 + cch0 + c8 * 8 + 4);
        w[k][0] = a[0]; w[k][1] = a[1]; w[k][2] = a[2]; w[k][3] = a[3]; w[k][4] = b[0]; w[k][5] = b[1]; w[k][6] = b[2]; w[k][7] = b[3]; }
    { const f32x4 a = *(const f32x4*)(cb + cch0 + c8 * 8), b = *(const f32x4*)(cb + cch0 + c8 * 8 + 4);
      bias[0] = a[0]; bias[1] = a[1]; bias[2] = a[2]; bias[3] = a[3]; bias[4] = b[0]; bias[5] = b[1]; bias[6] = b[2]; bias[7] = b[3]; }
#pragma unroll
    for (int k = 0; k < 3; ++k) { const v4u v = hv[k];
        hst[k][0] = bflo(v.x); hst[k][1] = bfhi(v.x); hst[k][2] = bflo(v.y); hst[k][3] = bfhi(v.y); hst[k][4] = bflo(v.z); hst[k][5] = bfhi(v.z); hst[k][6] = bflo(v.w); hst[k][7] = bfhi(v.w); }
    const LAS float* dts = (const LAS float*)(sl + SS_DTS); const LAS float* acum = (const LAS float*)(sl + SS_ACUM);
    const int hq = hq0 + (c8 * 8) / 64;
    const float alast = (FACMODE == 2) ? acum[hq * 128 + 127] : 0.f;
#pragma unroll
    for (int rr = 0; rr < RPS; ++rr) { const int l = l0 + rr; const v4u v = rv[rr];
        float cur[8]; cur[0] = bflo(v.x); cur[1] = bfhi(v.x); cur[2] = bflo(v.y); cur[3] = bfhi(v.y); cur[4] = bflo(v.z); cur[5] = bfhi(v.z); cur[6] = bflo(v.w); cur[7] = bfhi(v.w);
        float f = 1.f; if (FACMODE >= 1) f = dts[hq * 128 + l]; if (FACMODE == 2) f *= __builtin_amdgcn_exp2f(alast - acum[hq * 128 + l]);
        float o[8];
#pragma unroll
        for (int e = 0; e < 8; ++e) { const float a = bias[e] + w[0][e] * hst[0][e] + w[1][e] * hst[1][e] + w[2][e] * hst[2][e] + w[3][e] * cur[e]; o[e] = siluf(a) * f;
            hst[0][e] = hst[1][e]; hst[1][e] = hst[2][e]; hst[2][e] = cur[e]; }
        v4u ov; ov.x = pk2(o[0], o[1]); ov.y = pk2(o[2], o[3]); ov.z = pk2(o[4], o[5]); ov.w = pk2(o[6], o[7]);
        *(LAS v4u*)(dst + l * pitch + c8 * 16) = ov; }
}
__device__ __forceinline__ void ssd_s1_unit(LAS unsigned char* sl, const bf16* PROJ, const float* DT, const float* dtb, const float* alog, const float* cw, const float* cb, float* ST, float* CDEC, int un, int tid, int lane, int wave) {
    const int g = un & 1, bc = un >> 1; const size_t row0 = (size_t)bc * 128; const int t0 = (bc & 31) * 128;
    v4u hvB[3], rvB[4], hvX[3], rvX[8];
    conv_load<128>(PROJ, row0, t0, C_XS + 512 + g * 128, tid, hvB, rvB);
    conv_load<256>(PROJ, row0, t0, C_XS + g * 256, tid, hvX, rvX);
    __syncthreads();
    ssd_prep(sl, DT, dtb, alog, row0, g, tid, lane, wave);
    conv_apply<128, 0>(hvB, rvB, cw, cb, 512 + g * 128, sl + S1_B, S1_PB, sl, 0, tid);
    conv_apply<256, 2>(hvX, rvX, cw, cb, g * 256, sl + S1_X, S1_PX, sl, 0, tid);
    if (tid < 4) CDEC[(size_t)bc * 8 + 4 * g + tid] = __builtin_amdgcn_exp2f(((const LAS float*)(sl + SS_ACUM))[tid * 128 + 127]);
    __syncthreads();
    const int hq = wave >> 1, pt = wave & 1, h2 = lane >> 5, q = (lane & 15) >> 2, pp = lane & 3, dsel = (lane >> 4) & 1;
    const LAS unsigned char* xb = sl + S1_X + (8 * h2 + q) * S1_PX + (hq * 64 + pt * 32 + 16 * dsel + 4 * pp) * 2;
    const LAS unsigned char* bb = sl + S1_B + (8 * h2 + q) * S1_PB + (16 * dsel + 4 * pp) * 2;
    f32x16 acc[4];
#pragma unroll
    for (int nt = 0; nt < 4; ++nt) acc[nt] = (f32x16){};
#pragma unroll
    for (int ks = 0; ks < 8; ++ks) { const bf16x8 a = tr_pair(xb + (16 * ks) * S1_PX, xb + (16 * ks + 4) * S1_PX);
#pragma unroll
        for (int nt = 0; nt < 4; ++nt) { const bf16x8 b = tr_pair(bb + (16 * ks) * S1_PB + nt * 64, bb + (16 * ks + 4) * S1_PB + nt * 64); acc[nt] = __builtin_amdgcn_mfma_f32_32x32x16_bf16(a, b, acc[nt], 0, 0, 0); } }
    float* sp = ST + ((size_t)(bc * 8 + 4 * g + hq) * 64 + pt * 32) * 128 + (lane & 31);
#pragma unroll
    for (int nt = 0; nt < 4; ++nt)
#pragma unroll
        for (int rg = 0; rg < 16; ++rg) sp[(size_t)crow16(rg, h2) * 128 + 32 * nt] = acc[nt][rg];
}
__device__ __forceinline__ void ssd_s3_unit(LAS unsigned char* sl, const bf16* PROJ, const float* DT, const float* dtb, const float* alog, const float* cw, const float* cb, const float* dsk, const float* ng,
                                            const bf16* HIN, bf16* MIXED, int un, int tid, int lane, int wave) {
    const int g = un & 1, bc = un >> 1; const size_t row0 = (size_t)bc * 128; const int t0 = (bc & 31) * 128;
    const int lt = wave & 3, ph = wave >> 2, lq = lane & 31, hi = lane >> 5, q = (lane & 15) >> 2, pp = lane & 3, dsel = (lane >> 4) & 1;
    const int lrow = 32 * lt + lq;
    const size_t grow = row0 + lrow;
    v4u hvB[3], rvB[4], hvC[3], rvC[4], hvX[3], rvX[8];
    conv_load<128>(PROJ, row0, t0, C_XS + 512 + g * 128, tid, hvB, rvB);
    conv_load<128>(PROJ, row0, t0, C_XS + 768 + g * 128, tid, hvC, rvC);
    conv_load<256>(PROJ, row0, t0, C_XS + g * 256, tid, hvX, rvX);
    __syncthreads();
    ssd_prep(sl, DT, dtb, alog, row0, g, tid, lane, wave);
    conv_apply<128, 0>(hvB, rvB, cw, cb, 512 + g * 128, sl + S3_B, S3_PBC, sl, 0, tid);
    conv_apply<128, 0>(hvC, rvC, cw, cb, 768 + g * 128, sl + S3_C, S3_PBC, sl, 0, tid);
    conv_apply<256, 1>(hvX, rvX, cw, cb, g * 256, sl + S3_X, S3_PX, sl, 0, tid);
    bf16x8 hf[2][8];
    const bf16* hp0 = HIN + ((size_t)(bc * 8 + 4 * g) * 64 + ph * 32 + lq) * 128 + 8 * hi;
#pragma unroll
    for (int hq = 0; hq < 2; ++hq)
#pragma unroll
        for (int ks = 0; ks < 8; ++ks) hf[hq][ks] = *(const bf16x8*)(hp0 + (size_t)hq * 8192 + 16 * ks);
    __syncthreads();
    const LAS float* dts = (const LAS float*)(sl + SS_DTS); const LAS float* acum = (const LAS float*)(sl + SS_ACUM); LAS float* ssx = (LAS float*)(sl + SS_SSX);
    const LAS unsigned char* crd = sl + S3_C + lrow * S3_PBC + 16 * hi;
    f32x16 y[4];
#pragma unroll
    for (int hq = 0; hq < 4; ++hq) {
        f32x16 t = (f32x16){};
#pragma unroll
        for (int ks = 0; ks < 8; ++ks) t = __builtin_amdgcn_mfma_f32_32x32x16_bf16(hf[hq & 1][ks], *(const LAS bf16x8*)(crd + 32 * ks), t, 0, 0, 0);
        if (hq < 2) {
#pragma unroll
            for (int ks = 0; ks < 8; ++ks) hf[hq & 1][ks] = *(const bf16x8*)(hp0 + (size_t)(hq + 2) * 8192 + 16 * ks); }
        const float ea = __builtin_amdgcn_exp2f(acum[hq * 128 + lrow]);
#pragma unroll
        for (int rg = 0; rg < 16; ++rg) t[rg] *= ea;
        y[hq] = t; }
    v2u zr[4][4];
#pragma unroll
    for (int hq = 0; hq < 4; ++hq)
#pragma unroll
        for (int g4 = 0; g4 < 4; ++g4) zr[hq][g4] = *(const v2u*)(PROJ + grow * NPROJ + C_Z + g * 256 + hq * 64 + ph * 32 + 8 * g4 + 4 * hi);
#pragma unroll
    for (int st = 0; st < 4; ++st) if (st <= lt) {
        f32x16 ag = (f32x16){};
        { const LAS unsigned char* brd = sl + S3_B + (32 * st + lq) * S3_PBC + 16 * hi;
#pragma unroll
          for (int ks = 0; ks < 8; ++ks) ag = __builtin_amdgcn_mfma_f32_32x32x16_bf16(*(const LAS bf16x8*)(brd + 32 * ks), *(const LAS bf16x8*)(crd + 32 * ks), ag, 0, 0, 0); }
#pragma unroll
        for (int hq = 0; hq < 4; ++hq) {
            const float al = acum[hq * 128 + lrow], dd = dsk[4 * g + hq] * __builtin_amdgcn_rcpf(dts[hq * 128 + lrow]);
            const LAS unsigned char* xb = sl + S3_X + (4 * hi + q) * S3_PX + (hq * 64 + ph * 32 + 16 * dsel + 4 * pp) * 2;
            float pm[16];
#pragma unroll
            for (int g4 = 0; g4 < 4; ++g4) { const f32x4 as4 = *(const LAS f32x4*)(acum + hq * 128 + 32 * st + 8 * g4 + 4 * hi);
#pragma unroll
                for (int e = 0; e < 4; ++e) { const int rg = 4 * g4 + e; pm[rg] = ag[rg] * __builtin_amdgcn_exp2f(al - as4[e]); } }
            if (st == lt) { asm volatile("; diagonal tile");
#pragma unroll
                for (int rg = 0; rg < 16; ++rg) { const int sl_ = 8 * (rg >> 2) + 4 * hi + (rg & 3); pm[rg] = (sl_ > lq) ? 0.f : ((sl_ == lq) ? pm[rg] + dd : pm[rg]); } }
#pragma unroll
            for (int ks = 0; ks < 2; ++ks) { v4u wv; wv.x = pg8::cvt_pk_bf16(pm[8 * ks + 0], pm[8 * ks + 1]); wv.y = pg8::cvt_pk_bf16(pm[8 * ks + 2], pm[8 * ks + 3]); wv.z = pg8::cvt_pk_bf16(pm[8 * ks + 4], pm[8 * ks + 5]); wv.w = pg8::cvt_pk_bf16(pm[8 * ks + 6], pm[8 * ks + 7]);
                const bf16x8 xt = tr_pair(xb + (32 * st + 16 * ks) * S3_PX, xb + (32 * st + 16 * ks + 8) * S3_PX);
                y[hq] = __builtin_amdgcn_mfma_f32_32x32x16_bf16(xt, __builtin_bit_cast(bf16x8, wv), y[hq], 0, 0, 0); }
        }
    }
    unsigned ayp[4][8]; float ss = 0.f;
#pragma unroll
    for (int hq = 0; hq < 4; ++hq)
#pragma unroll
        for (int g4 = 0; g4 < 4; ++g4) { const v2u z = zr[hq][g4];
            const float y0 = y[hq][4 * g4 + 0] * siluf(bflo(z.x)), y1 = y[hq][4 * g4 + 1] * siluf(bfhi(z.x)), y2 = y[hq][4 * g4 + 2] * siluf(bflo(z.y)), y3 = y[hq][4 * g4 + 3] * siluf(bfhi(z.y));
            ss += (y0 * y0 + y1 * y1) + (y2 * y2 + y3 * y3);
            ayp[hq][2 * g4] = pg8::cvt_pk_bf16(y0, y1); ayp[hq][2 * g4 + 1] = pg8::cvt_pk_bf16(y2, y3); }
    ss += __shfl_xor(ss, 32);
    if (hi == 0) ssx[ph * 128 + lrow] = ss;
    __syncthreads();
    const float rs = 1.0f / sqrtf((ssx[lrow] + ssx[128 + lrow]) * (1.f / 256.f) + RMS_EPS);
#pragma unroll
    for (int hq = 0; hq < 4; ++hq)
#pragma unroll
        for (int g4 = 0; g4 < 4; ++g4) { const int ch = hq * 64 + ph * 32 + 8 * g4 + 4 * hi; const f32x4 gn = *(const f32x4*)(ng + g * 256 + ch);
            const unsigned p0 = ayp[hq][2 * g4], p1 = ayp[hq][2 * g4 + 1];
            v2u o; o.x = pg8::cvt_pk_bf16(bflo(p0) * rs * gn[0], bfhi(p0) * rs * gn[1]); o.y = pg8::cvt_pk_bf16(bflo(p1) * rs * gn[2], bfhi(p1) * rs * gn[3]);
            *(v2u*)(MIXED + grow * MIXW + 512 + g * 256 + ch) = o; }
}

struct Args { const float* in[20]; float* out; unsigned char* ws; int ph_lo, ph_hi, sub, pad; };
constexpr int NWAVES = 8;
constexpr int PH_PER_LAYER = 10, N_PHASES = 1 + NLAYER * PH_PER_LAYER;

#define in_x (args.in[0])
#define in_win (args.in[1])
#define in_convw (args.in[2])
#define in_convb (args.in[3])
#define in_dtb (args.in[4])
#define in_alog (args.in[5])
#define in_dsk (args.in[6])
#define in_ng (args.in[7])
#define in_scw (args.in[8])
#define in_wout (args.in[9])
#define in_ln1g (args.in[10])
#define in_ln1b (args.in[11])
#define in_rw (args.in[12])
#define in_rb (args.in[13])
#define in_wgu (args.in[14])
#define in_bgu (args.in[15])
#define in_wdn (args.in[16])
#define in_bdn (args.in[17])
#define in_ln2g (args.in[18])
#define in_ln2b (args.in[19])
#define ROPE ((float*)(args.ws + WS_ROPE))
#define WDT ((float*)(args.ws + WS_WDT))
#define ROUT ((bf16*)(args.ws + WS_ROUT))
#define WIN ((bf16*)(args.ws + WS_WIN))
#define WOUT ((bf16*)(args.ws + WS_WOUT))
#define WGU ((bf16*)(args.ws + WS_WGU))
#define WDN ((bf16*)(args.ws + WS_WDN))
#define XB ((bf16*)(args.ws + WS_XB))
#define XF ((float*)(args.ws + WS_XF))
#define XF2 ((float*)(args.ws + WS_XF2))
#define PROJ ((bf16*)(args.ws + WS_PROJ))
#define DT ((float*)(args.ws + WS_DT))
#define DTS ((float*)(args.ws + WS_DTS))
#define ACUM ((float*)(args.ws + WS_ACUM))
#define LSE ((float*)(args.ws + WS_LSE))
#define OP ((bf16*)(args.ws + WS_OP))
#define U ((bf16*)(args.ws + WS_U))
#define GB ((float*)(args.ws + WS_G))
#define ST ((float*)(args.ws + WS_ST))
#define YD ((float*)(args.ws + WS_YD))
#define MIXED ((bf16*)(args.ws + WS_MIXED))
#define MIXF ((bf16*)(args.ws + WS_MIXF))
#define TOPE ((int*)(args.ws + WS_TOPE))
#define TOPG ((float*)(args.ws + WS_TOPG))
#define ROWTOK ((int*)(args.ws + WS_ROWTOK))
#define ROWGATE ((float*)(args.ws + WS_ROWGATE))
#define HB ((bf16*)(args.ws + WS_H))
#define YB ((bf16*)(args.ws + WS_YB))
#define HIN ((bf16*)(args.ws + WS_G))
#define WGU8 ((unsigned char*)(args.ws + WS_WGU))
#define WDN8 ((unsigned char*)(args.ws + WS_WDN))
#define XB8 ((unsigned char*)(args.ws + WS_U))
#define H8 ((unsigned char*)(args.ws + WS_H))
#define YB8 ((unsigned char*)(args.ws + WS_YB))
#define WIN8 ((unsigned char*)(args.ws + WS_WGU + 128 * MiB))
#define XP8 ((unsigned char*)(args.ws + WS_WGU + 132 * MiB))
#define CDEC ((float*)(args.ws + WS_ACUM))
template <int layer>
__device__ __forceinline__ void run_layer(const Args& args, int lo, int hi, const XcdBarrier& bar) {
    extern __shared__ __attribute__((aligned(16))) unsigned char lds[];
    LAS unsigned char* ldsp = (LAS unsigned char*)lds;
    const int tid = threadIdx.x, lane = tid & 63, wave = __builtin_amdgcn_readfirstlane(tid >> 6);
    const int G = gridDim.x, bid = blockIdx.x;
    const int gw = bid * NWAVES + wave, NGW = G * NWAVES;
    gu32* ctl = (gu32*)(args.ws + WS_CTL);

#define IN(k) (lo <= (k) && (k) < hi)
#define SEAM(k) do { if (IN(k) && IN((k) + 1)) xcd_barrier(bar); } while (0)

        const int pb = 1 + layer * PH_PER_LAYER;
        const bf16* WINl = WIN + (size_t)layer * NPROJ * DM; const bf16* WOUTl = WOUT + (size_t)layer * DM * MIXW;
        const unsigned char* WGUl = WGU8 + (size_t)layer * NEXP * 2048 * DM; const unsigned char* WDNl = WDN8 + (size_t)layer * NEXP * DM * FF;
        gu32* gcnt = ctl + CW_CNT + 64 * layer;

        if (IN(pb + 0)) {
            {
              pg8::Gemm g{(const pg8::bf16_t*)XP8, (const pg8::bf16_t*)(WIN8 + (size_t)layer * 1536 * DM), MROWS, 1536, DM / 2}; pg8::StaticOrder S; S.init(MROWS, 1536, G, bid);
              pg8::EpiProj E{PROJ, NPROJ, ROPE, QSCALE, 1.0f / (SC_X * SC_WIN), 0};
              pg8::gemm_phase<pg8::EpiProj, pg8::StaticOrder, true, false, true>(ldsp + RING_OFF, g, S, E); }
            __syncthreads();
            { pg8::Gemm g{XB, WINl + (size_t)1536 * DM, MROWS, NPROJ - 1536, DM}; pg8::StaticOrder S; S.init(MROWS, NPROJ - 1536, G, bid);
              pg8::EpiProj E{PROJ, NPROJ, ROPE, QSCALE, 1.0f, 6};
              pg8::gemm_phase<pg8::EpiProj, pg8::StaticOrder, true, false>(ldsp + RING_OFF, g, S, E); }
        }
        SEAM(pb + 0);
        if (IN(pb + 1)) {
            if (args.sub & 1) attn_phase(ldsp + RING_OFF, PROJ, OP, LSE, bid, G, tid, wave, lane);
            if (args.sub & 2) { const float* cw = in_convw + (size_t)layer * 4 * 1024; const float* cb = in_convb + (size_t)layer * 1024;
              for (int un = bid; un < 512; un += G)
                  ssd_s1_unit(ldsp + RING_OFF, PROJ, DT, in_dtb + layer * 8, in_alog + layer * 8, cw, cb, ST, CDEC, un, tid, lane, wave);
              __syncthreads(); }
            const float* sw = in_scw + (size_t)layer * 3 * 512;
            if (args.sub & 4) {
                const int ch = (tid & 63) * 8;
                f32x4 wk[3][2];
#pragma unroll
                for (int k = 0; k < 3; ++k) { wk[k][0] = *(const f32x4*)(sw + k * 512 + ch); wk[k][1] = *(const f32x4*)(sw + k * 512 + ch + 4); }
#pragma unroll 1
                for (int it = bid * (NWAVES * 64) + tid; it < (MROWS / 4) * 64; it += G * (NWAVES * 64)) { const int row0 = (it >> 6) * 4; const bool head = (row0 & (SEQ - 1)) == 0;
                    v4u cc[6], hh[6], bb[4];
#pragma unroll
                    for (int i = 0; i < 6; ++i) { cc[i] = (v4u){0u, 0u, 0u, 0u}; hh[i] = cc[i];
                        if (i >= 2 || !head) { const bf16* pr = PROJ + (size_t)(row0 - 2 + i) * NPROJ; cc[i] = *(const v4u*)(pr + C_SC + ch); hh[i] = *(const v4u*)(pr + C_SH + ch); } }
#pragma unroll
                    for (int r = 0; r < 4; ++r) bb[r] = *(const v4u*)(PROJ + (size_t)(row0 + r) * NPROJ + C_SB + ch);
                    float p[6][8];
#pragma unroll
                    for (int i = 0; i < 6; ++i) { p[i][0] = bflo(cc[i].x) * bflo(hh[i].x); p[i][1] = bfhi(cc[i].x) * bfhi(hh[i].x); p[i][2] = bflo(cc[i].y) * bflo(hh[i].y); p[i][3] = bfhi(cc[i].y) * bfhi(hh[i].y);
                        p[i][4] = bflo(cc[i].z) * bflo(hh[i].z); p[i][5] = bfhi(cc[i].z) * bfhi(hh[i].z); p[i][6] = bflo(cc[i].w) * bflo(hh[i].w); p[i][7] = bfhi(cc[i].w) * bfhi(hh[i].w); }
#pragma unroll
                    for (int r = 0; r < 4; ++r) { float a[8];
#pragma unroll
                        for (int q = 0; q < 8; ++q) a[q] = wk[0][q >> 2][q & 3] * p[r][q] + wk[1][q >> 2][q & 3] * p[r + 1][q] + wk[2][q >> 2][q & 3] * p[r + 2][q];
                        const v4u b4 = bb[r];
                        v4u o; o.x = pk2(a[0] * bflo(b4.x), a[1] * bfhi(b4.x)); o.y = pk2(a[2] * bflo(b4.y), a[3] * bfhi(b4.y)); o.z = pk2(a[4] * bflo(b4.z), a[5] * bfhi(b4.z)); o.w = pk2(a[6] * bflo(b4.w), a[7] * bfhi(b4.w));
                        *(v4u*)(MIXED + (size_t)(row0 + r) * MIXW + 1024 + ch) = o; } }
            }
        }
        SEAM(pb + 1);
        if (IN(pb + 2)) {
            for (int it = bid * (NWAVES * 64) + tid; it < (int)(64L * 2048); it += G * (NWAVES * 64)) { const int pn4 = (int)(it & 2047), bh = (int)(it >> 11); const int h = bh & 7, b = bh >> 3; f32x4 hc = (f32x4){0.f, 0.f, 0.f, 0.f};
#pragma unroll 16
                for (int c = 0; c < 32; ++c) { const size_t idx = ((size_t)((b * 32 + c) * 8 + h)) * 8192 + pn4 * 4; const f32x4 st = *(const f32x4*)(ST + idx);
                    v2u o; o.x = pk2(hc[0], hc[1]); o.y = pk2(hc[2], hc[3]); *(v2u*)(HIN + idx) = o;
                    hc = hc * CDEC[(size_t)(b * 32 + c) * 8 + h] + st; } }
        }
        SEAM(pb + 2);
        if (IN(pb + 3)) {
            if (args.sub & 1) { const float* cw = in_convw + (size_t)layer * 4 * 1024; const float* cb = in_convb + (size_t)layer * 1024;
              for (int un = bid; un < 512; un += G)
                  ssd_s3_unit(ldsp + RING_OFF, PROJ, DT, in_dtb + layer * 8, in_alog + layer * 8, cw, cb, in_dsk + layer * 8, in_ng + (size_t)layer * 512, HIN, MIXED, un, tid, lane, wave);
              __syncthreads(); }
            if (args.sub & 2)
#pragma unroll 2
            for (int it = bid * (NWAVES * 64) + tid; it < (int)((long)MROWS * 32); it += G * (NWAVES * 64)) { const int c16 = (int)(it & 31), row = (int)(it >> 5); const int h = c16 >> 2;
                const float l0 = LSE[((size_t)0 * MROWS + row) * 8 + h], l1 = LSE[((size_t)1 * MROWS + row) * 8 + h], l2 = LSE[((size_t)2 * MROWS + row) * 8 + h];
                const float mm = fmaxf(l0, fmaxf(l1, l2)); float w0 = exp2f(l0 - mm), w1 = exp2f(l1 - mm), w2 = exp2f(l2 - mm); const float iw = (1.0f / SC_O) / (w0 + w1 + w2); w0 *= iw; w1 *= iw; w2 *= iw;
                const unsigned char* OP8 = (const unsigned char*)OP; typedef float f32x2_ __attribute__((ext_vector_type(2)));
                const v4u a0 = *(const v4u*)(OP8 + ((size_t)0 * MROWS + row) * 512 + c16 * 16), a1 = *(const v4u*)(OP8 + ((size_t)1 * MROWS + row) * 512 + c16 * 16), a2 = *(const v4u*)(OP8 + ((size_t)2 * MROWS + row) * 512 + c16 * 16);
                unsigned ow[8];
#pragma unroll
                for (int q = 0; q < 4; ++q) {
                    { const f32x2_ p0 = __builtin_amdgcn_cvt_pk_f32_fp8(a0[q], false), p1 = __builtin_amdgcn_cvt_pk_f32_fp8(a1[q], false), p2 = __builtin_amdgcn_cvt_pk_f32_fp8(a2[q], false); ow[2 * q] = pk2(w0 * p0[0] + w1 * p1[0] + w2 * p2[0], w0 * p0[1] + w1 * p1[1] + w2 * p2[1]); }
                    { const f32x2_ p0 = __builtin_amdgcn_cvt_pk_f32_fp8(a0[q], true), p1 = __builtin_amdgcn_cvt_pk_f32_fp8(a1[q], true), p2 = __builtin_amdgcn_cvt_pk_f32_fp8(a2[q], true); ow[2 * q + 1] = pk2(w0 * p0[0] + w1 * p1[0] + w2 * p2[0], w0 * p0[1] + w1 * p1[1] + w2 * p2[1]); } }
                bf16* op_ = MIXED + (size_t)row * MIXW + c16 * 16;
                *(v4u*)op_ = (v4u){ow[0], ow[1], ow[2], ow[3]}; *(v4u*)(op_ + 8) = (v4u){ow[4], ow[5], ow[6], ow[7]}; }
        }
        SEAM(pb + 3);
        if (IN(pb + 4)) {
#define FUSED_LN1_CALL(BASE, LIM) { pg8::Gemm g{MIXED, WOUTl, MROWS, DM, MIXW}; \
              pg8::EpiLn1 E{args.ws, in_ln1g + (size_t)layer * DM, in_ln1b + (size_t)layer * DM, WS_XB, WS_U, (layer ? WS_ROPE : WS_DTS), WS_CTL + (size_t)(CW_SEAM + layer * 8192) * 4, WS_CTL + (size_t)CW_TMO * 4, ALPHA, SC_X, LN_EPS, 0x700u + (unsigned)layer * 0x80u}; \
              pg8::StaticOrder S; S.init(MROWS, DM, G, bid); S.base = (BASE); S.lim = (LIM); \
              pg8::gemm_phase<pg8::EpiLn1, pg8::StaticOrder, false, false>(ldsp + RING_OFF, g, S, E); }
            FUSED_LN1_CALL(0, 256)
            __syncthreads();
            FUSED_LN1_CALL(256, 512)
            __syncthreads();
#undef FUSED_LN1_CALL
        }
        SEAM(pb + 4);
        if (IN(pb + 6)) {
            LAS int* lcnt = (LAS int*)(ldsp + L_LCNT); LAS int* lbase = (LAS int*)(ldsp + L_LBASE);
            const bf16* RT = ROUT + (size_t)layer * NEXP * DM; const float* rb = in_rb + (size_t)layer * NEXP;
            for (int blk = bid; blk < MROWS / 128; blk += G) {
                if (tid < 32) lcnt[tid] = 0;
                __syncthreads();
                const int r32 = lane & 31, hi = lane >> 5; const int row = blk * 128 + (wave & 3) * 32 + r32;
                float tv[4]; int te[4]; int lrank[4]; float gate[4];
                f32x16 acc = {};
                { const int kh = wave >> 2;
                  const bf16* ap = RT + (size_t)r32 * DM + 8 * hi + 512 * kh; const bf16* bp = XB + (size_t)row * DM + 8 * hi + 512 * kh;
#pragma unroll 16
                  for (int s = 0; s < 32; ++s) { const bf16x8 a = *(const bf16x8*)(ap + 16 * s), b = *(const bf16x8*)(bp + 16 * s); acc = __builtin_amdgcn_mfma_f32_32x32x16_bf16(a, b, acc, 0, 0, 0); }
                  LAS float* part = (LAS float*)(ldsp + RING_OFF) + (wave & 3) * 1024;
                  if (kh) {
#pragma unroll
                      for (int i = 0; i < 16; ++i) part[i * 64 + lane] = acc[i]; }
                  __syncthreads();
                  if (!kh) {
#pragma unroll
                      for (int i = 0; i < 16; ++i) acc[i] += part[i * 64 + lane]; } }
                if (wave < 4) {
#pragma unroll
                    for (int k = 0; k < 4; ++k) { tv[k] = -INFINITY; te[k] = 1 << 20; }
#pragma unroll
                    for (int i = 0; i < 16; ++i) { const int e = (i & 3) + 8 * (i >> 2) + 4 * hi; float v = acc[i] + rb[e]; int ve = e;
#pragma unroll
                        for (int k = 0; k < 4; ++k) { const bool gt = (v > tv[k]) || (v == tv[k] && ve < te[k]); const float nv = gt ? tv[k] : v; const int ne = gt ? te[k] : ve; tv[k] = gt ? v : tv[k]; te[k] = gt ? ve : te[k]; v = nv; ve = ne; } }
                    float pv[4]; int pe[4];
#pragma unroll
                    for (int k = 0; k < 4; ++k) { pv[k] = __shfl_xor(tv[k], 32); pe[k] = __shfl_xor(te[k], 32); }
#pragma unroll
                    for (int j = 0; j < 4; ++j) { float v = pv[j]; int ve = pe[j];
#pragma unroll
                        for (int k = 0; k < 4; ++k) { const bool gt = (v > tv[k]) || (v == tv[k] && ve < te[k]); const float nv = gt ? tv[k] : v; const int ne = gt ? te[k] : ve; tv[k] = gt ? v : tv[k]; te[k] = gt ? ve : te[k]; v = nv; ve = ne; } }
                    float se = 0.f;
#pragma unroll
                    for (int k = 0; k < 4; ++k) { gate[k] = __expf(tv[k] - tv[0]); se += gate[k]; }
                    const float ise = 1.0f / se;
#pragma unroll
                    for (int k = 0; k < 4; ++k) gate[k] *= ise;
                    if (hi == 0) {
#pragma unroll
                        for (int k = 0; k < 4; ++k) lrank[k] = __hip_atomic_fetch_add(lcnt + te[k], 1, __ATOMIC_RELAXED, __HIP_MEMORY_SCOPE_WORKGROUP);
                    }
                }
                __syncthreads();
                if (tid < 32) lbase[tid] = (int)__hip_atomic_fetch_add(gcnt + tid, (unsigned)lcnt[tid], RLX_AGENT);
                __syncthreads();
                if (wave < 4 && hi == 0) {
#pragma unroll
                    for (int k = 0; k < 4; ++k) { const int r = lbase[te[k]] + lrank[k]; const size_t o = (size_t)te[k] * 32768 + r;
                        ROWTOK[o] = row * 4 + k; ROWGATE[o] = gate[k]; }
                }
                __syncthreads();
            }
        }
        SEAM(pb + 6);
        if (IN(pb + 7) || IN(pb + 8)) {
            LAS int* tstart = (LAS int*)(ldsp + L_TSTART); LAS int* cntL = (LAS int*)(ldsp + L_CNT); LAS int* units = (LAS int*)(ldsp + L_UNITS); LAS int* unitsn = (LAS int*)(ldsp + L_UNITSN);
            if (tid < 64) {
                const int c = (tid < 32) ? (int)__hip_atomic_load(gcnt + tid, RLX_AGENT) : 0; const int t = (c + 255) >> 8; int incl = t;
#pragma unroll
                for (int d = 1; d < 32; d <<= 1) { const int v = __shfl_up(incl, d); if (tid >= d) incl += v; }
                if (tid < 32) { cntL[tid] = c; tstart[tid] = incl - t; }
                if (tid == 31) tstart[32] = incl; }
            __syncthreads();
            if (IN(pb + 7)) {
                pg8::moe_build_units(units, unitsn, tstart, 8, G, bid, tid);
                __syncthreads();
                pg8::Gemm g{(const pg8::bf16_t*)XB8, (const pg8::bf16_t*)WGUl, 0, 2048, DM / 2};
                pg8::MoeOrder S{units, __builtin_amdgcn_readfirstlane(unitsn[0]), cntL, ROWTOK, 1, (unsigned)DM, (size_t)2048 * DM, ROWGATE, in_bgu + (size_t)layer * NEXP * 2048};
                pg8::EpiSwiglu E{H8, in_bgu + (size_t)layer * NEXP * 2048, ROWGATE, cntL, 1.0f / (SC_X * SC_WGU), SC_H};
                pg8::gemm_phase<pg8::EpiSwiglu, pg8::MoeOrder, true, true, true>(ldsp + RING_OFF, g, S, E);
                __syncthreads();
            }
            SEAM(pb + 7);
            if (IN(pb + 8)) {
                pg8::moe_build_units(units, unitsn, tstart, 4, G, bid, tid);
                __syncthreads();
                pg8::Gemm g{(const pg8::bf16_t*)H8, (const pg8::bf16_t*)WDNl, 0, DM, FF / 2};
                pg8::MoeOrder S{units, __builtin_amdgcn_readfirstlane(unitsn[0]), cntL, ROWTOK, 0, (unsigned)FF, (size_t)DM * FF, ROWGATE, in_bdn + (size_t)layer * NEXP * DM};
                pg8::EpiScatter E{YB8, ROWTOK, cntL, SC_Y / (SC_H * SC_WDN), SC_Y};
                pg8::gemm_phase<pg8::EpiScatter, pg8::MoeOrder, true, false, true, true>(ldsp + RING_OFF, g, S, E);
                __syncthreads();
            }
        }
        SEAM(pb + 8);
        if (IN(pb + 9)) {
            constexpr bool NEXT = (layer + 1 < NLAYER);
            int lane; asm volatile("v_mbcnt_lo_u32_b32 %0, -1, 0\n\tv_mbcnt_hi_u32_b32 %0, -1, %0" : "=v"(lane));
            const float* gam = in_ln2g + (size_t)layer * DM; const float* bet = in_ln2b + (size_t)layer * DM;
            f32x4 gq[4], bq[4], wq[8][4];
#pragma unroll
            for (int q = 0; q < 4; ++q) { gq[q] = *(const f32x4*)(gam + 16 * lane + 4 * q); bq[q] = *(const f32x4*)(bet + 16 * lane + 4 * q); }
            if (NEXT) {
#pragma unroll
                for (int jj = 0; jj < 8; ++jj)
#pragma unroll
                    for (int q = 0; q < 4; ++q) wq[jj][q] = *(const f32x4*)(WDT + (size_t)(layer + 1) * 8 * 1024 + jj * 1024 + 16 * lane + 4 * q); }
            v4u nx0, nx1, ny[4];
            constexpr bool PF = !NEXT;
            if (PF && gw < MROWS) { nx0 = *(const v4u*)(XB + (size_t)gw * DM + 16 * lane); nx1 = *(const v4u*)(XB + (size_t)gw * DM + 16 * lane + 8);
#pragma unroll
                for (int k = 0; k < 4; ++k) ny[k] = *(const v4u*)(YB8 + ((size_t)gw * 4 + k) * DM + 16 * lane); }
#pragma unroll 1
            for (int m = gw; m < MROWS; m += NGW) {
                if (!PF) { nx0 = *(const v4u*)(XB + (size_t)m * DM + 16 * lane); nx1 = *(const v4u*)(XB + (size_t)m * DM + 16 * lane + 8);
#pragma unroll
                    for (int k = 0; k < 4; ++k) ny[k] = *(const v4u*)(YB8 + ((size_t)m * 4 + k) * DM + 16 * lane); }
                const v4u x0 = nx0, x1 = nx1; v4u yk[4];
#pragma unroll
                for (int k = 0; k < 4; ++k) yk[k] = ny[k];
                if (PF && m + NGW < MROWS) { const int mn = m + NGW; nx0 = *(const v4u*)(XB + (size_t)mn * DM + 16 * lane); nx1 = *(const v4u*)(XB + (size_t)mn * DM + 16 * lane + 8);
#pragma unroll
                    for (int k = 0; k < 4; ++k) ny[k] = *(const v4u*)(YB8 + ((size_t)mn * 4 + k) * DM + 16 * lane); }
                f32x4 v[4];
                v[0] = (f32x4){bflo(x0.x), bfhi(x0.x), bflo(x0.y), bfhi(x0.y)} * ALPHA; v[1] = (f32x4){bflo(x0.z), bfhi(x0.z), bflo(x0.w), bfhi(x0.w)} * ALPHA;
                v[2] = (f32x4){bflo(x1.x), bfhi(x1.x), bflo(x1.y), bfhi(x1.y)} * ALPHA; v[3] = (f32x4){bflo(x1.z), bfhi(x1.z), bflo(x1.w), bfhi(x1.w)} * ALPHA;
#pragma unroll
                for (int k = 0; k < 4; ++k)
#pragma unroll
                    for (int q = 0; q < 4; ++q) { typedef float f32x2_ __attribute__((ext_vector_type(2)));
                        const f32x2_ lo = __builtin_amdgcn_cvt_pk_f32_fp8(yk[k][q], false), hi = __builtin_amdgcn_cvt_pk_f32_fp8(yk[k][q], true);
                        v[q][0] += lo[0] * (1.0f / SC_Y); v[q][1] += lo[1] * (1.0f / SC_Y); v[q][2] += hi[0] * (1.0f / SC_Y); v[q][3] += hi[1] * (1.0f / SC_Y); }
                float s = 0.f;
#pragma unroll
                for (int q = 0; q < 4; ++q) s += (v[q][0] + v[q][1]) + (v[q][2] + v[q][3]);
                const float mean = wave_sum(s) * (1.f / DM); float s2 = 0.f;
#pragma unroll
                for (int q = 0; q < 4; ++q) { v[q] = v[q] - mean; s2 += (v[q][0] * v[q][0] + v[q][1] * v[q][1]) + (v[q][2] * v[q][2] + v[q][3] * v[q][3]); }
                const float rstd = 1.f / sqrtf(wave_sum(s2) * (1.f / DM) + LN_EPS);
#pragma unroll
                for (int q = 0; q < 4; ++q) { v[q] = v[q] * rstd * gq[q] + bq[q];
                    if (!NEXT) *(f32x4*)(args.out + (size_t)m * DM + 16 * lane + 4 * q) = v[q]; }
                if (NEXT) {
                    v4u w0, w1; w0.x = pk2(v[0][0], v[0][1]); w0.y = pk2(v[0][2], v[0][3]); w0.z = pk2(v[1][0], v[1][1]); w0.w = pk2(v[1][2], v[1][3]);
                    w1.x = pk2(v[2][0], v[2][1]); w1.y = pk2(v[2][2], v[2][3]); w1.z = pk2(v[3][0], v[3][1]); w1.w = pk2(v[3][2], v[3][3]);
                    *(v4u*)(XB + (size_t)m * DM + 16 * lane) = w0; *(v4u*)(XB + (size_t)m * DM + 16 * lane + 8) = w1;
                    v4u w; w.x = pg8::pk4_fp8(v[0][0] * SC_X, v[0][1] * SC_X, v[0][2] * SC_X, v[0][3] * SC_X); w.y = pg8::pk4_fp8(v[1][0] * SC_X, v[1][1] * SC_X, v[1][2] * SC_X, v[1][3] * SC_X);
                    w.z = pg8::pk4_fp8(v[2][0] * SC_X, v[2][1] * SC_X, v[2][2] * SC_X, v[2][3] * SC_X); w.w = pg8::pk4_fp8(v[3][0] * SC_X, v[3][1] * SC_X, v[3][2] * SC_X, v[3][3] * SC_X);
                    *(v4u*)(XP8 + (size_t)m * DM + 16 * lane) = w;
                    float r[8];
#pragma unroll
                    for (int jj = 0; jj < 8; ++jj) { float sd = 0.f;
#pragma unroll
                        for (int q = 0; q < 4; ++q) sd += v[q][0] * wq[jj][q][0] + v[q][1] * wq[jj][q][1] + v[q][2] * wq[jj][q][2] + v[q][3] * wq[jj][q][3];
                        r[jj] = wave_sum(sd); }
                    if (lane == 0) { float* dst = DT + (size_t)m * 8; *(f32x4*)dst = (f32x4){r[0], r[1], r[2], r[3]}; *(f32x4*)(dst + 4) = (f32x4){r[4], r[5], r[6], r[7]}; } }
            }
        }
        SEAM(pb + 9);
    #undef IN
#undef SEAM
}

__global__ void __launch_bounds__(NWAVES * 64, 2) mk_fwd(Args args) {
    extern __shared__ __attribute__((aligned(16))) unsigned char lds[];
    LAS unsigned char* ldsp = (LAS unsigned char*)lds;
    const int tid = threadIdx.x, lane = tid & 63, wave = __builtin_amdgcn_readfirstlane(tid >> 6);
    const int G = gridDim.x, bid = blockIdx.x;
    const int gw = bid * NWAVES + wave, NGW = G * NWAVES;
    gu32* ctl = (gu32*)(args.ws + WS_CTL);

    for (int u = tid; u < (LDS_BYTES - LDSCTL_OFF) / 4; u += NWAVES * 64) ((LAS unsigned*)(ldsp + LDSCTL_OFF))[u] = 0u;
    __syncthreads();
    XcdBarrier bar = xcd_barrier_post((unsigned*)(ctl + CW_BAR), (volatile LAS unsigned*)(ldsp + L_MISC) + 8);

    const int lo = args.ph_lo, hi = args.ph_hi;
#define IN(k) (lo <= (k) && (k) < hi)
#define SEAM(k) do { if (IN(k) && IN((k) + 1)) xcd_barrier(bar); } while (0)

    if (IN(0)) {
        LAS float* scr = (LAS float*)(ldsp + RING_OFF + wave * 16384);
        constexpr int I_IN = 16 * 73, I_OUT = 24 * 16, I_R = 16;
        constexpr int NIT = NLAYER * (I_IN + I_OUT + I_R);
        for (int it = gw; it < NIT; it += NGW) {
            int r = it;
            if (r < NLAYER * I_IN) { const int l = r / I_IN; r %= I_IN; p0_transpose_item64<1>(in_win + (size_t)l * DM * INW, DM, INW, WIN + (size_t)l * NPROJ * DM, WDT + (size_t)l * 8 * 1024, scr, r / 73, r % 73, lane); continue; } r -= NLAYER * I_IN;
            if (r < NLAYER * I_OUT) { const int l = r / I_OUT; r %= I_OUT; p0_transpose_item64<0>(in_wout + (size_t)l * MIXW * DM, MIXW, DM, WOUT + (size_t)l * DM * MIXW, nullptr, scr, r / 16, r % 16, lane); continue; } r -= NLAYER * I_OUT;
            { const int l = r / I_R; r %= I_R; p0_transpose_item<0>(in_rw + (size_t)l * DM * NEXP, DM, NEXP, ROUT + (size_t)l * NEXP * DM, nullptr, scr, r, 0, lane); }
        }
        { constexpr int NIT8 = 64 * 256 + 64 * 128 + NLAYER * 192;
          const int nmine = (gw < NIT8) ? (NIT8 - gw + NGW - 1) / NGW : 0; const int J = 2 * nmine;
          f32x4 lda[16], ldb[16];
          if (J > 0) { const SubT t = fp8_subtile(gw, 0, in_wgu, in_wdn, in_win, WGU8, WDN8, WIN8, lane); fp8_sub_load(t, lda); }
#pragma unroll 1
          for (int j = 0; j < J; j += 2) {
              const int item = gw + (j >> 1) * NGW;
              const SubT t0 = fp8_subtile(item, 0, in_wgu, in_wdn, in_win, WGU8, WDN8, WIN8, lane), t1 = fp8_subtile(item, 1, in_wgu, in_wdn, in_win, WGU8, WDN8, WIN8, lane);
              fp8_sub_load(t1, ldb);
              fp8_sub_process(t0, lda, scr, lane);
              if (j + 2 < J) { const SubT t2 = fp8_subtile(item + NGW, 0, in_wgu, in_wdn, in_win, WGU8, WDN8, WIN8, lane); fp8_sub_load(t2, lda); }
              fp8_sub_process(t1, ldb, scr, lane);
          } }
        __syncthreads();
    }
    if (IN(0)) {
        f32x4 wq[8][4];
#pragma unroll
        for (int j = 0; j < 4; ++j)
#pragma unroll
            for (int e = 0; e < 4; ++e) { const float* wp = in_win + (size_t)(4 * lane + 256 * j + e) * INW + 3072; const f32x4 w0 = *(const f32x4*)wp, w1 = *(const f32x4*)(wp + 4);
                wq[0][j][e] = w0[0]; wq[1][j][e] = w0[1]; wq[2][j][e] = w0[2]; wq[3][j][e] = w0[3]; wq[4][j][e] = w1[0]; wq[5][j][e] = w1[1]; wq[6][j][e] = w1[2]; wq[7][j][e] = w1[3]; }
        f32x4 nv[4];
        if (gw < MROWS) {
#pragma unroll
            for (int j = 0; j < 4; ++j) nv[j] = *(const f32x4*)(in_x + (size_t)gw * DM + 4 * lane + 256 * j); }
#pragma unroll 1
        for (int m = gw; m < MROWS; m += NGW) { bf16* ob = XB + (size_t)m * DM; f32x4 v[4];
#pragma unroll
            for (int j = 0; j < 4; ++j) v[j] = nv[j];
            if (m + NGW < MROWS) {
#pragma unroll
                for (int j = 0; j < 4; ++j) nv[j] = *(const f32x4*)(in_x + (size_t)(m + NGW) * DM + 4 * lane + 256 * j); }
#pragma unroll
            for (int j = 0; j < 4; ++j) { v2u w; w.x = pk2(v[j][0], v[j][1]); w.y = pk2(v[j][2], v[j][3]); *(v2u*)(ob + 4 * lane + 256 * j) = w;
                *(unsigned*)(XP8 + (size_t)m * DM + 4 * lane + 256 * j) = pg8::pk4_fp8(v[j][0] * SC_X, v[j][1] * SC_X, v[j][2] * SC_X, v[j][3] * SC_X); }
            row_dt_w(v, wq, DT + (size_t)m * 8, lane); }
    }

    SEAM(0);
    run_layer<0>(args, lo, hi, bar);
    run_layer<1>(args, lo, hi, bar);
#undef IN
#undef SEAM
}

extern "C" void kernel_launch(void* const* d_in, const int* in_sizes, int n_in, void* d_out, int out_size, void* d_ws, size_t ws_size, hipStream_t stream) {
    static int grid = 0;
    if (grid == 0) {
        if (n_in != 20 || out_size != MROWS * DM || ws_size < WS_END) { fprintf(stderr, "kernel_launch: unexpected problem (n_in %d, out %d, ws %zu)\n", n_in, out_size, ws_size); grid = -1; return; }
        if (hipFuncSetAttribute((const void*)mk_fwd, hipFuncAttributeMaxDynamicSharedMemorySize, LDS_BYTES) != hipSuccess) { fprintf(stderr, "kernel_launch: hipFuncSetAttribute failed\n"); grid = -1; return; }
        int dev = 0, cus = 0, per_cu = 0;
        (void)hipGetDevice(&dev); (void)hipDeviceGetAttribute(&cus, hipDeviceAttributeMultiprocessorCount, dev);
        if (hipOccupancyMaxActiveBlocksPerMultiprocessor(&per_cu, (const void*)mk_fwd, NWAVES * 64, LDS_BYTES) != hipSuccess || per_cu < 1) fprintf(stderr, "kernel_launch: occupancy query says %d\n", per_cu);
        (void)hipGetLastError();
        grid = cus > 0 ? cus : 256;
    }
    if (grid < 0) return;
    (void)hipMemsetAsync((char*)d_ws + WS_CTL, 0, CTL_ZERO_BYTES, stream);
    Args a{};
    for (int i = 0; i < 20; ++i) a.in[i] = (const float*)d_in[i];
    a.out = (float*)d_out; a.ws = (unsigned char*)d_ws;
    a.ph_lo = 0; a.ph_hi = N_PHASES; a.sub = 7; a.pad = 0;
    hipLaunchKernelGGL(mk_fwd, dim3(grid), dim3(NWAVES * 64), LDS_BYTES, stream, a);
#ifdef PROBE_PH
#ifndef PROBE_SUB
#define PROBE_SUB 7
#endif
    for (int i = 0; i < PROBE_N; ++i) { a.ph_lo = PROBE_PH; a.ph_hi = PROBE_PH + 1; a.sub = PROBE_SUB; hipLaunchKernelGGL(mk_fwd, dim3(grid), dim3(NWAVES * 64), LDS_BYTES, stream, a); }
#endif
}
```

```cpp
#include <hip/hip_runtime.h>
#include <cstdio>
#include <cstdint>
#include <cmath>

namespace pg8 {
#define PG8_LAS __attribute__((address_space(3)))
typedef unsigned short bf16_t;
typedef short bf16x8 __attribute__((ext_vector_type(8)));
typedef float f32x4 __attribute__((ext_vector_type(4)));
typedef float f32x2 __attribute__((ext_vector_type(2)));
typedef unsigned u32x4 __attribute__((ext_vector_type(4)));
constexpr int BM = 256, BK = 64, HALF = 128, HTB = HALF * BK * 2  , STAGE_BYTES = 8 * HTB, NXCD = 8, WGM = 8;

__host__ __device__ __forceinline__ int lds_byte(int r, int c) { const int st = (r >> 4) * 2 + (c >> 5), rr = r & 15, cc = c & 31, ob = rr * 64 + cc * 2; return st * 1024 + (ob ^ (((ob >> 9) & 1) << 5)); }
__host__ __device__ __forceinline__ void stage_rc(int b, int& R, int& C) { const int st = b / 1024, sb = b % 1024, swz = sb ^ (((sb >> 9) & 1) << 5); R = (st >> 1) * 16 + swz / 64; C = (st & 1) * 32 + (swz % 64) / 2; }
__host__ __device__ __forceinline__ int perm32(int rho) { const int n = rho >> 4, i = rho & 15; return 8 * (i >> 2) + 4 * n + (i & 3); }

struct Unit { int pm, pn, e, r0; };
struct Gemm { const bf16_t* A; const bf16_t* Bt; int M, N, K; };

struct StaticOrder {
    int nM, nN, nwg, G, c, base, lim;
    __device__ void init(int M, int N, int G_, int c_) { nM = M / BM; nN = N / BM; nwg = nM * nN; G = G_; c = c_; base = 0; lim = nwg; }
    __device__ __forceinline__ bool next(int i, Unit& u) const {
        const long L = (long)i * G + c + base; if (L >= lim) return false;
        int wgid = (int)L; { const int q = nwg / NXCD, r = nwg % NXCD, xcd = wgid % NXCD, off = wgid / NXCD; wgid = (xcd < r ? xcd * (q + 1) : r * (q + 1) + (xcd - r) * q) + off; }
        const int nig = WGM * nN, gid = wgid / nig, fm = gid * WGM, gsz = (nM - fm) < WGM ? (nM - fm) : WGM;
        u.pm = fm + ((wgid % nig) % gsz); u.pn = (wgid % nig) / gsz; u.e = 0; u.r0 = 0; return true;
    }
    __device__ __forceinline__ const char* abase(const Unit& u, const Gemm& g, size_t tstep) const { return (const char*)g.A + (size_t)u.pm * tstep; }
    __device__ __forceinline__ const char* bbase(const Unit& u, const Gemm& g, size_t tstep) const { return (const char*)g.Bt + (size_t)u.pn * tstep; }
    static constexpr bool SIDE = false;
    __device__ __forceinline__ unsigned arow(const Unit&, int) const { return 0u; }
    __device__ __forceinline__ unsigned arow_side(const Unit&, int, const PG8_LAS unsigned char*) const { return 0u; }
    __device__ __forceinline__ const void* side_src(const Unit&, const Unit&, int, int) const { return nullptr; }
    __device__ __forceinline__ void a_ready(const Unit&) const {}
    __device__ __forceinline__ void done(const Unit&) const {}
};

struct MoeOrder {
    const PG8_LAS int* units;
    int nunits;
    const PG8_LAS int* cnt;
    const int* rowtok;
    int gather;
    unsigned rowbytes;
    size_t bstride;
    __device__ __forceinline__ bool next(int i, Unit& u) const {
        if (i >= nunits) return false;
        u.pm = __builtin_amdgcn_readfirstlane(units[4 * i + 0]); u.pn = __builtin_amdgcn_readfirstlane(units[4 * i + 1]);
        u.e = __builtin_amdgcn_readfirstlane(units[4 * i + 2]); u.r0 = __builtin_amdgcn_readfirstlane(units[4 * i + 3]); return true;
    }
    __device__ __forceinline__ const char* abase(const Unit& u, const Gemm& g, size_t tstep) const { return gather ? (const char*)g.A : (const char*)g.A + (size_t)u.pm * tstep; }
    __device__ __forceinline__ const char* bbase(const Unit& u, const Gemm& g, size_t tstep) const { return (const char*)g.Bt + (size_t)u.e * bstride + (size_t)u.pn * tstep; }
    static constexpr bool SIDE = true;
    const float* rowgate; const float* bgu;
    __device__ __forceinline__ unsigned arow(const Unit& u, int R) const {
        const int r = u.r0 + R; const int idx = (r < cnt[u.e]) ? rowtok[(size_t)u.e * 32768 + r] : 0; return (unsigned)(idx >> 2) * rowbytes; }
    __device__ __forceinline__ unsigned arow_side(const Unit& u, int R, const PG8_LAS unsigned char* sd) const {
        const int r = u.r0 + R; const int v = ((const PG8_LAS int*)sd)[R]; const int idx = (r < cnt[u.e]) ? v : 0; return (unsigned)(idx >> 2) * rowbytes; }
    __device__ __forceinline__ const void* side_src(const Unit& cur, const Unit& rt, int wid, int lane) const {
        if (rowgate != nullptr && wid == 1) return rowgate + (size_t)cur.e * 32768 + cur.r0 + 4 * lane;
        if (bgu != nullptr && wid == 2) return gather ? (bgu + (size_t)cur.e * 2048 + (lane < 32 ? 0 : 1024 - 128) + cur.pn * 128 + 4 * lane)
                                                      : (bgu + (size_t)cur.e * 1024 + cur.pn * 256 + 4 * lane);
        return rowtok + (size_t)rt.e * 32768 + rt.r0 + 4 * lane; }
    __device__ __forceinline__ void a_ready(const Unit&) const {}
    __device__ __forceinline__ void done(const Unit&) const {}
};
__device__ __forceinline__ void moe_build_units(PG8_LAS int* units, PG8_LAS int* units_n, const PG8_LAS int* tstart, int nN, int G, int c, int tid) {
    if (tid < 64) {
        const int nT = tstart[32], nwg = nT * nN; const long L = (long)tid * G + c;
        int pm = 0, pn = 0, e = 0, r0 = 0;
        if (L < nwg) {
            int wgid = (int)L; { const int q = nwg / NXCD, r = nwg % NXCD, xcd = wgid % NXCD, off = wgid / NXCD; wgid = (xcd < r ? xcd * (q + 1) : r * (q + 1) + (xcd - r) * q) + off; }
            const int nig = WGM * nN, gid = wgid / nig, fm = gid * WGM, gsz = (nT - fm) < WGM ? (nT - fm) : WGM;
            pm = fm + ((wgid % nig) % gsz); pn = (wgid % nig) / gsz;
            for (int j = 1; j < 32; ++j) e += (tstart[j] <= pm) ? 1 : 0;
            r0 = (pm - tstart[e]) * 256;
        }
        units[4 * tid + 0] = pm; units[4 * tid + 1] = pn; units[4 * tid + 2] = e; units[4 * tid + 3] = r0;
        if (tid == 0) { int n = 0; if (c < nwg) n = (nwg - c + G - 1) / G; units_n[0] = n < 64 ? n : 64; }
    }
}

__host__ __device__ __forceinline__ unsigned hblk_off(int R, int p7) { const int ai = R >> 7, wr = (R >> 6) & 1, m = (R >> 4) & 3, fr = R & 15, wc = p7 >> 1, fq = ((p7 & 1) << 1) | (m & 1), mp = m >> 1;
    return (unsigned)(((((ai * 2 + wr) * 4 + wc) * 2 + mp) * 64 + fr + 16 * fq) * 16); }
typedef int v8i_t __attribute__((ext_vector_type(8)));
typedef int v4i_t __attribute__((ext_vector_type(4)));
__device__ __forceinline__ v8i_t cat8(bf16x8 lo, bf16x8 hi) { const v4i_t a = __builtin_bit_cast(v4i_t, lo), b = __builtin_bit_cast(v4i_t, hi); return __builtin_shufflevector(a, b, 0, 1, 2, 3, 4, 5, 6, 7); }
__device__ __forceinline__ void mfma8(f32x4& acc, v8i_t a, v8i_t b, int scl) { asm volatile("v_mfma_scale_f32_16x16x128_f8f6f4 %0, %1, %2, %0, %3, %3 op_sel_hi:[0,0,0]" : "+v"(acc) : "v"(a), "v"(b), "v"(scl)); }
__device__ __forceinline__ unsigned pk4_fp8(float a, float b, float c, float d) { unsigned w = 0u; w = __builtin_amdgcn_cvt_pk_fp8_f32(a, b, w, false); w = __builtin_amdgcn_cvt_pk_fp8_f32(c, d, w, true); return w; }
__device__ __forceinline__ unsigned cvt_pk_bf16(float lo, float hi) { unsigned r; asm volatile("v_cvt_pk_bf16_f32 %0, %1, %2" : "=v"(r) : "v"(lo), "v"(hi)); return r; }

struct EpiProj {
    static constexpr bool PERM = true, AFTER_DRAIN = false;
    bf16_t* O; int ldc; const float* rope; float qscale; float dqv; int pn_off;
    __device__ __forceinline__ void operator()(const f32x4 (&acc)[2][2][4][2], const Unit& u, int wr, int wc, int fr, int fq, const PG8_LAS unsigned char* sd) const {
        const int pnn = u.pn + pn_off; const int row0 = u.pm * BM + wr * 64 + fr; const int col0 = pnn * BM + wc * 32 + 8 * fq;
        const bool rot = pnn < 4; const float sc = (pnn < 2 ? qscale : 1.f) * dqv; const int gq = 4 * (wc & 1) + fq;
        float invr[4];
#pragma unroll
        for (int e = 0; e < 4; ++e) invr[e] = __builtin_amdgcn_exp2f(-(float)(4 * gq + e) * 0.41524101186092029f) * 0.15915494309189535f;
#pragma unroll
        for (int ai = 0; ai < 2; ++ai)
#pragma unroll
            for (int m = 0; m < 4; ++m) { const int row = row0 + ai * HALF + m * 16; bf16_t* rowp = O + (size_t)row * ldc + col0;
                f32x4 cs0 = (f32x4){1.f, 0.f, 1.f, 0.f}, cs1 = cs0;
                if (rot) { const float tp = (float)(row & 4095);
                    const float a0 = __builtin_amdgcn_fractf(tp * invr[0]), a1 = __builtin_amdgcn_fractf(tp * invr[1]), a2 = __builtin_amdgcn_fractf(tp * invr[2]), a3 = __builtin_amdgcn_fractf(tp * invr[3]);
                    cs0 = (f32x4){__builtin_amdgcn_cosf(a0), __builtin_amdgcn_sinf(a0), __builtin_amdgcn_cosf(a1), __builtin_amdgcn_sinf(a1)};
                    cs1 = (f32x4){__builtin_amdgcn_cosf(a2), __builtin_amdgcn_sinf(a2), __builtin_amdgcn_cosf(a3), __builtin_amdgcn_sinf(a3)}; }
#pragma unroll
                for (int bj = 0; bj < 2; ++bj) { f32x4 v0 = acc[ai][bj][m][0], v1 = acc[ai][bj][m][1];
                    if (rot) { f32x4 lo, hi;
                        lo[0] = v0[0] * cs0[0] - v1[0] * cs0[1]; hi[0] = v1[0] * cs0[0] + v0[0] * cs0[1];
                        lo[1] = v0[1] * cs0[2] - v1[1] * cs0[3]; hi[1] = v1[1] * cs0[2] + v0[1] * cs0[3];
                        lo[2] = v0[2] * cs1[0] - v1[2] * cs1[1]; hi[2] = v1[2] * cs1[0] + v0[2] * cs1[1];
                        lo[3] = v0[3] * cs1[2] - v1[3] * cs1[3]; hi[3] = v1[3] * cs1[2] + v0[3] * cs1[3];
                        v0 = lo * sc; v1 = hi * sc; }
                    else { v0 = v0 * dqv; v1 = v1 * dqv; }
                    u32x4 w; w.x = cvt_pk_bf16(v0[0], v0[1]); w.y = cvt_pk_bf16(v0[2], v0[3]); w.z = cvt_pk_bf16(v1[0], v1[1]); w.w = cvt_pk_bf16(v1[2], v1[3]);
                    *(u32x4*)(rowp + bj * HALF) = w; } }
    }
};
struct EpiF32 {
    static constexpr bool PERM = false, AFTER_DRAIN = false;
    float* O; int ldc;
    __device__ __forceinline__ void operator()(const f32x4 (&acc)[2][2][4][2], const Unit& u, int wr, int wc, int fr, int fq, const PG8_LAS unsigned char* sd) const {
        const int row0 = u.pm * BM + wr * 64 + fr; const int col0 = u.pn * BM + wc * 32 + 4 * fq;
#pragma unroll
        for (int ai = 0; ai < 2; ++ai)
#pragma unroll
            for (int m = 0; m < 4; ++m) { float* rowp = O + (size_t)(row0 + ai * HALF + m * 16) * ldc + col0;
#pragma unroll
                for (int bj = 0; bj < 2; ++bj)
#pragma unroll
                    for (int n = 0; n < 2; ++n) *(f32x4*)(rowp + bj * HALF + n * 16) = acc[ai][bj][m][n]; }
    }
};
struct EpiBf16Plain {
    static constexpr bool PERM = true, AFTER_DRAIN = false;
    bf16_t* O; int ldc;
    __device__ __forceinline__ void operator()(const f32x4 (&acc)[2][2][4][2], const Unit& u, int wr, int wc, int fr, int fq, const PG8_LAS unsigned char* sd) const {
        const int row0 = u.pm * BM + wr * 64 + fr; const int col0 = u.pn * BM + wc * 32 + 8 * fq;
#pragma unroll
        for (int ai = 0; ai < 2; ++ai)
#pragma unroll
            for (int m = 0; m < 4; ++m) { bf16_t* rowp = O + (size_t)(row0 + ai * HALF + m * 16) * ldc + col0;
#pragma unroll
                for (int bj = 0; bj < 2; ++bj) { const f32x4 v0 = acc[ai][bj][m][0], v1 = acc[ai][bj][m][1];
                    u32x4 w; w.x = cvt_pk_bf16(v0[0], v0[1]); w.y = cvt_pk_bf16(v0[2], v0[3]); w.z = cvt_pk_bf16(v1[0], v1[1]); w.w = cvt_pk_bf16(v1[2], v1[3]);
                    *(u32x4*)(rowp + bj * HALF) = w; } }
    }
};
struct EpiSwiglu {
    static constexpr bool PERM = true, AFTER_DRAIN = false;
    unsigned char* H; const float* bgu; const float* rowgate; const PG8_LAS int* cnt; float dq, hscale;
    __device__ __forceinline__ void operator()(const f32x4 (&acc)[2][2][4][2], const Unit& u, int wr, int wc, int fr, int fq, const PG8_LAS unsigned char* sd) const {
        const int n_e = cnt[u.e];
        constexpr float CS = -1.702f * 1.4426950408889634f;
        const float kk = hscale / CS, dqc = dq * CS, dqk = dq * kk, glo = 7.0f * CS, ub0 = -6.0f * kk, ub1 = 8.0f * kk;
        f32x4 bg[2], bu[2];
#pragma unroll
        for (int n = 0; n < 2; ++n) { bg[n] = *(const PG8_LAS f32x4*)(sd + 2048 + (wc * 32 + 8 * fq + 4 * n) * 4) * CS; bu[n] = (*(const PG8_LAS f32x4*)(sd + 2048 + 512 + (wc * 32 + 8 * fq + 4 * n) * 4) + 1.0f) * kk; }
        const int lane = fr + 16 * fq;
        float rgls[2][4];
#pragma unroll
        for (int ai = 0; ai < 2; ++ai)
#pragma unroll
            for (int m = 0; m < 4; ++m) rgls[ai][m] = ((const PG8_LAS float*)(sd + 1024))[ai * HALF + wr * 64 + m * 16 + fr];
#pragma unroll
        for (int ai = 0; ai < 2; ++ai)
#pragma unroll
            for (int mp = 0; mp < 2; ++mp) {
                unsigned pw[2][2];
#pragma unroll
                for (int mm = 0; mm < 2; ++mm) { const int m = 2 * mp + mm; const int r = ai * HALF + wr * 64 + m * 16 + fr; const int er = u.r0 + r;
                    const float rgl = rgls[ai][m]; const float irg = (er < n_e) ? __builtin_amdgcn_rcpf(rgl) : 1e30f;
                    float hv[8];
#pragma unroll
                    for (int n = 0; n < 2; ++n)
#pragma unroll
                        for (int q = 0; q < 4; q += 2) {
                            f32x2 g = (f32x2){acc[ai][0][m][n][q], acc[ai][0][m][n][q + 1]} * dqc + (f32x2){bg[n][q], bg[n][q + 1]};
                            f32x2 up = (f32x2){acc[ai][1][m][n][q], acc[ai][1][m][n][q + 1]} * dqk + (f32x2){bu[n][q], bu[n][q + 1]};
                            g.x = fmaxf(g.x, glo); g.y = fmaxf(g.y, glo); up.x = __builtin_amdgcn_fmed3f(up.x, ub0, ub1); up.y = __builtin_amdgcn_fmed3f(up.y, ub0, ub1);
                            f32x2 den; den.x = __builtin_amdgcn_exp2f(g.x); den.y = __builtin_amdgcn_exp2f(g.y); den = den * irg + irg;
                            f32x2 sg; sg.x = __builtin_amdgcn_rcpf(den.x); sg.y = __builtin_amdgcn_rcpf(den.y);
                            const f32x2 h2 = (up * g) * sg;
                            hv[n * 4 + q] = h2.x; hv[n * 4 + q + 1] = h2.y; }
                    pw[mm][0] = pk4_fp8(hv[0], hv[1], hv[2], hv[3]); pw[mm][1] = pk4_fp8(hv[4], hv[5], hv[6], hv[7]); }
                const auto s0 = __builtin_amdgcn_permlane16_swap(pw[0][0], pw[1][0], false, false); const auto s1 = __builtin_amdgcn_permlane16_swap(pw[0][1], pw[1][1], false, false);
                *(u32x4*)(H + ((size_t)u.pm * 8 + u.pn) * 32768 + ((((ai * 2 + wr) * 4 + wc) * 2 + mp) * 64 + lane) * 16) = (u32x4){s0[0], s1[0], s0[1], s1[1]};
                asm volatile("" ::: "memory"); }
    }
};
struct EpiScatter {
    static constexpr bool PERM = true, AFTER_DRAIN = false;
    unsigned char* Y; const int* rowtok; const PG8_LAS int* cnt; float dq, ysc;
    __device__ __forceinline__ void operator()(const f32x4 (&acc)[2][2][4][2], const Unit& u, int wr, int wc, int fr, int fq, const PG8_LAS unsigned char* sd) const {
        const int col0 = u.pn * BM + wc * 32 + 8 * fq; const int n_e = cnt[u.e];
        f32x4 bd[2][2];
#pragma unroll
        for (int bj = 0; bj < 2; ++bj)
#pragma unroll
            for (int n = 0; n < 2; ++n) bd[bj][n] = *(const PG8_LAS f32x4*)(sd + 2048 + (bj * HALF + wc * 32 + 8 * fq + 4 * n) * 4);
        int idxs[2][4]; float rgs[2][4];
#pragma unroll
        for (int ai = 0; ai < 2; ++ai)
#pragma unroll
            for (int m = 0; m < 4; ++m) { idxs[ai][m] = ((const PG8_LAS int*)sd)[ai * HALF + wr * 64 + m * 16 + fr]; rgs[ai][m] = ((const PG8_LAS float*)(sd + 1024))[ai * HALF + wr * 64 + m * 16 + fr]; }
#pragma unroll
        for (int ai = 0; ai < 2; ++ai)
#pragma unroll
            for (int m = 0; m < 4; ++m) { const int er = u.r0 + ai * HALF + wr * 64 + m * 16 + fr;
                const int idx = idxs[ai][m];
                if (er < n_e) { unsigned char* rowp = Y + (size_t)idx * 1024 + col0;
                    typedef unsigned u32x2 __attribute__((ext_vector_type(2)));
                    const float rg = rgs[ai][m] * ysc;
#pragma unroll
                    for (int bj = 0; bj < 2; ++bj) { const f32x4 v0 = acc[ai][bj][m][0] * dq + bd[bj][0] * rg, v1 = acc[ai][bj][m][1] * dq + bd[bj][1] * rg;
                        *(u32x2*)(rowp + bj * HALF) = (u32x2){pk4_fp8(v0[0], v0[1], v0[2], v0[3]), pk4_fp8(v1[0], v1[1], v1[2], v1[3])}; } } }
    }
};

struct PanelStats {
    unsigned* xbuf;
    unsigned* cnt;
    unsigned* tmo;
    int ntn; float eps;
    unsigned code;
    __device__ __forceinline__ bool run(const f32x4 (&v)[2][2][4][2], const Unit& u, int wr, int wc, int fr, int fq, PG8_LAS unsigned char* lds, int wid, int lane) const {
        typedef float f32x2v __attribute__((ext_vector_type(2)));
        PG8_LAS f32x2v* P = (PG8_LAS f32x2v*)lds;
        PG8_LAS f32x2v* S = (PG8_LAS f32x2v*)(lds + 8192);
        PG8_LAS unsigned* flag = (PG8_LAS unsigned*)(lds + 8192 + 2048);
#pragma unroll
        for (int ai = 0; ai < 2; ++ai)
#pragma unroll
            for (int m = 0; m < 4; ++m) {
                float s = 0.f;
#pragma unroll
                for (int bj = 0; bj < 2; ++bj)
#pragma unroll
                    for (int n = 0; n < 2; ++n) { const f32x4 x = v[ai][bj][m][n]; s += (x[0] + x[1]) + (x[2] + x[3]); }
                s += __shfl_xor(s, 16); s += __shfl_xor(s, 32);
                const float mw = s * (1.0f / 64.0f); float q = 0.f;
#pragma unroll
                for (int bj = 0; bj < 2; ++bj)
#pragma unroll
                    for (int n = 0; n < 2; ++n) { const f32x4 d = v[ai][bj][m][n] - mw; q += (d[0] * d[0] + d[1] * d[1]) + (d[2] * d[2] + d[3] * d[3]); }
                q += __shfl_xor(q, 16); q += __shfl_xor(q, 32);
                if (fq == 0) P[(ai * HALF + wr * 64 + m * 16 + fr) * 4 + wc] = (f32x2v){mw, q};
            }
        asm volatile("s_waitcnt lgkmcnt(0)" ::: "memory"); __builtin_amdgcn_s_barrier(); asm volatile("" ::: "memory");
#if defined(BROKEN_EXCHANGE_NO_WAIT)
#warning BROKEN CONTROL BUILD: the row-statistics exchange does not wait; results are wrong by design
        if (blockIdx.x >= 64) { const long long t0_ = clock64(); while (clock64() - t0_ < 60000) __builtin_amdgcn_s_sleep(8); }
#endif
        const int row = wid * 32 + (lane & 31);
        if (lane < 32) {
            const f32x2v a = P[row * 4 + 0], b = P[row * 4 + 1], c = P[row * 4 + 2], d = P[row * 4 + 3];
            const float mt = (a.x + b.x + c.x + d.x) * 0.25f;
            const float da = a.x - mt, db = b.x - mt, dc = c.x - mt, dd = d.x - mt;
            const float m2 = (a.y + b.y) + (c.y + d.y) + 64.0f * ((da * da + db * db) + (dc * dc + dd * dd));
            unsigned long long* slot = (unsigned long long*)xbuf + ((size_t)(u.pm * BM + row) * 4 + u.pn);
            __hip_atomic_store(slot, ((unsigned long long)__float_as_uint(m2) << 32) | __float_as_uint(mt), __ATOMIC_RELAXED, __HIP_MEMORY_SCOPE_AGENT);
        }
        asm volatile("s_waitcnt vmcnt(0)" ::: "memory");
        if (lane == 0) __hip_atomic_fetch_add(cnt + 64 * u.pm, 1u, __ATOMIC_RELAXED, __HIP_MEMORY_SCOPE_AGENT);
        if (wid == 0) {
            const unsigned want = 8u * (unsigned)ntn; unsigned sp = 0u;
            while ((unsigned)__builtin_amdgcn_readfirstlane(__hip_atomic_load(cnt + 64 * u.pm, __ATOMIC_RELAXED, __HIP_MEMORY_SCOPE_AGENT)) < want) { __builtin_amdgcn_s_sleep(2); if (++sp > (1u << 20)) break; }
            __builtin_amdgcn_fence(__ATOMIC_ACQUIRE, "agent");
        }
        asm volatile("s_waitcnt vmcnt(0) lgkmcnt(0)" ::: "memory"); __builtin_amdgcn_s_barrier(); asm volatile("" ::: "memory");
        const bool bad = false;
        if (lane < 32) {
            const unsigned long long* slot = (const unsigned long long*)xbuf + (size_t)(u.pm * BM + row) * 4; float mt[4], m2[4]; float ms = 0.f;
#pragma unroll
            for (int t = 0; t < 4; ++t) { if (t < ntn) { const unsigned long long w = __hip_atomic_load(slot + t, __ATOMIC_RELAXED, __HIP_MEMORY_SCOPE_AGENT); mt[t] = __uint_as_float((unsigned)w); m2[t] = __uint_as_float((unsigned)(w >> 32)); } else { mt[t] = 0.f; m2[t] = 0.f; } ms += mt[t]; }
            const float mean = ms / (float)ntn; float q = 0.f;
#pragma unroll
            for (int t = 0; t < 4; ++t) if (t < ntn) { const float dm = mt[t] - mean; q += m2[t] + 256.0f * dm * dm; }
            S[row] = (f32x2v){mean, 1.0f / sqrtf(q / (256.0f * (float)ntn) + eps)};
        }
        asm volatile("s_waitcnt lgkmcnt(0)" ::: "memory"); __builtin_amdgcn_s_barrier(); asm volatile("" ::: "memory");
        return bad;
    }
};

struct EpiLn1 {
    static constexpr bool PERM = true, AFTER_DRAIN = true;
    unsigned char* ws; const float* gam; const float* bet; size_t o_xb, o_x8, o_xbuf, o_cnt, o_tmo; float alpha, s8, eps; unsigned code;
    __device__ __forceinline__ void operator()(const f32x4 (&)[2][2][4][2], const Unit&, int, int, int, int, const PG8_LAS unsigned char*) const {}
    __device__ __forceinline__ void fused(f32x4 (&acc)[2][2][4][2], const Unit& u, int wr, int wc, int fr, int fq, PG8_LAS unsigned char* lds, int wid, int lane) const {
        typedef float f32x2v __attribute__((ext_vector_type(2))); typedef unsigned u32x2 __attribute__((ext_vector_type(2)));
        bf16_t* const XBp = (bf16_t*)(ws + o_xb); unsigned char* const X8 = ws + o_x8;
        const PanelStats st{(unsigned*)(ws + o_xbuf), (unsigned*)(ws + o_cnt), (unsigned*)(ws + o_tmo), 4, eps, code};
        const int col0 = u.pn * BM + wc * 32 + 8 * fq;
#pragma unroll
        for (int ai = 0; ai < 2; ++ai)
#pragma unroll
            for (int m = 0; m < 4; ++m) { const bf16_t* xr = XBp + (size_t)(u.pm * BM + ai * HALF + wr * 64 + m * 16 + fr) * 1024 + col0;
#pragma unroll
                for (int bj = 0; bj < 2; ++bj) { const u32x4 x = *(const u32x4*)(xr + bj * HALF);
                    acc[ai][bj][m][0] += (f32x4){__builtin_bit_cast(float, x.x << 16), __builtin_bit_cast(float, x.x & 0xffff0000u), __builtin_bit_cast(float, x.y << 16), __builtin_bit_cast(float, x.y & 0xffff0000u)} * alpha;
                    acc[ai][bj][m][1] += (f32x4){__builtin_bit_cast(float, x.z << 16), __builtin_bit_cast(float, x.z & 0xffff0000u), __builtin_bit_cast(float, x.w << 16), __builtin_bit_cast(float, x.w & 0xffff0000u)} * alpha; }
                asm volatile("" ::: "memory"); }
        (void)st.run(acc, u, wr, wc, fr, fq, lds, wid, lane);
        const PG8_LAS f32x2v* S = (const PG8_LAS f32x2v*)(lds + 8192);
#pragma unroll
        for (int bj = 0; bj < 2; ++bj) {
            const f32x4 g0 = *(const f32x4*)(gam + col0 + bj * HALF), g1 = *(const f32x4*)(gam + col0 + bj * HALF + 4), b0 = *(const f32x4*)(bet + col0 + bj * HALF), b1 = *(const f32x4*)(bet + col0 + bj * HALF + 4);
#pragma unroll
            for (int ai = 0; ai < 2; ++ai)
#pragma unroll
                for (int m = 0; m < 4; ++m) { const int r = ai * HALF + wr * 64 + m * 16 + fr; const f32x2v sr = S[r]; const size_t off = (size_t)(u.pm * BM + r) * 1024 + col0 + bj * HALF;
                    const f32x4 o0 = (acc[ai][bj][m][0] - sr.x) * sr.y * g0 + b0, o1 = (acc[ai][bj][m][1] - sr.x) * sr.y * g1 + b1;
                    u32x4 w; w.x = cvt_pk_bf16(o0[0], o0[1]); w.y = cvt_pk_bf16(o0[2], o0[3]); w.z = cvt_pk_bf16(o1[0], o1[1]); w.w = cvt_pk_bf16(o1[2], o1[3]);
                    *(u32x4*)(XBp + off) = w;
                    *(u32x2*)(X8 + off) = (u32x2){pk4_fp8(o0[0] * s8, o0[1] * s8, o0[2] * s8, o0[3] * s8), pk4_fp8(o1[0] * s8, o1[1] * s8, o1[2] * s8, o1[3] * s8)};
                    asm volatile("" ::: "memory"); } }
    }
};

template <class Epi, class Sched, bool ALIGN_EPI, bool GATHER, bool FP8 = false, bool ABLK = false>
__device__ __forceinline__ void gemm_phase(PG8_LAS unsigned char* lds, const Gemm g, const Sched& S, const Epi& E) {
    int lane; asm volatile("v_mbcnt_lo_u32_b32 %0, -1, 0\n\tv_mbcnt_hi_u32_b32 %0, -1, %0" : "=v"(lane));
    int tid = threadIdx.x; asm volatile("" : "+v"(tid));
    const int wid = __builtin_amdgcn_readfirstlane(tid >> 6), wr = wid >> 2, wc = wid & 3, fr = lane & 15, fq = lane >> 4;
    const int K = g.K, nt = K / BK;
    unsigned voffB[2];
#pragma unroll
    for (int i = 0; i < 2; ++i) { int R, C; stage_rc(tid * 16 + i * 8192, R, C); const int Rb = Epi::PERM ? ((R & ~31) + perm32(R & 31)) : R;
        voffB[i] = (unsigned)(Rb * K + C) * 2u; }
    constexpr int SIDE_BYTES = 8192;
    PG8_LAS unsigned char* const side = lds + STAGE_BYTES;
    const size_t kstep = (size_t)(BK * 2);
    const size_t kstepA = ABLK ? (size_t)32768 : kstep;
    const size_t hstep = (size_t)HALF * K * 2;
    const size_t tstep = 2 * hstep;
    const unsigned ldsw = (unsigned)wid * 1024u;
    const int aoff = lds_byte(wr * 64 + fr, fq * 8), boff = lds_byte(wc * 32 + fr, fq * 8);
#define PG8_SA(b, h) (((b) * 2 + (h)) * HTB)
#define PG8_SB(b, h) ((4 + (b) * 2 + (h)) * HTB)
#define PG8_STAGE(bufoff, gbase, voff) do { _Pragma("unroll") for (int _i = 0; _i < 2; ++_i) \
        __builtin_amdgcn_global_load_lds((const unsigned*)((const char*)(gbase) + (voff)[_i]), (PG8_LAS unsigned*)(lds + (bufoff) + ldsw + _i * 8192), 16, 0, 0); } while (0)
#define PG8_LDA(dst, b, h) do { _Pragma("unroll") for (int m = 0; m < 4; ++m) _Pragma("unroll") for (int k = 0; k < 2; ++k) dst[m][k] = *(const PG8_LAS bf16x8*)(lds + PG8_SA(b, h) + aoff + m * 2048 + k * 1024); } while (0)
#define PG8_LDB(dst, b, h) do { _Pragma("unroll") for (int n = 0; n < 2; ++n) _Pragma("unroll") for (int k = 0; k < 2; ++k) dst[n][k] = *(const PG8_LAS bf16x8*)(lds + PG8_SB(b, h) + boff + n * 2048 + k * 1024); } while (0)
#define PG8_MMA(ai, bj, At, Bt) do { __builtin_amdgcn_s_setprio(1); _Pragma("unroll") for (int m = 0; m < 4; ++m) _Pragma("unroll") for (int n = 0; n < 2; ++n) { \
        if constexpr (FP8) mfma8(acc[ai][bj][m][n], cat8(Bt[n][0], Bt[n][1]), cat8(At[m][0], At[m][1]), scl8); \
        else { _Pragma("unroll") for (int k = 0; k < 2; ++k) acc[ai][bj][m][n] = __builtin_amdgcn_mfma_f32_16x16x32_bf16(Bt[n][k], At[m][k], acc[ai][bj][m][n], 0, 0, 0); } } __builtin_amdgcn_s_setprio(0); } while (0)
#define PG8_WAIT_V(n) asm volatile("s_waitcnt vmcnt(" #n ")" ::: "memory")
#define PG8_WAIT_L(n) asm volatile("s_waitcnt lgkmcnt(" #n ")" ::: "memory")
#define PG8_BAR __builtin_amdgcn_s_barrier()
#define PG8_SCHED __builtin_amdgcn_sched_barrier(0)
#define PG8_SETOFFS(o, u) do { _Pragma("unroll") for (int _h = 0; _h < 2; ++_h) _Pragma("unroll") for (int _i = 0; _i < 2; ++_i) { int _R, _C; stage_rc(tid * 16 + _i * 8192, _R, _C); \
        o[_h][_i] = GATHER ? (S.arow(u, _R + HALF * _h) + (unsigned)(_C * 2)) : ABLK ? hblk_off(_R + HALF * _h, _C >> 3) : ((unsigned)((_R + HALF * _h) * K) * 2u + (unsigned)(_C * 2)); } } while (0)
    int scl8 = 0x7F7F7F7F; asm volatile("" : "+v"(scl8));
    Unit cur, nxt; int ui = 0;
    if (!S.next(0, cur)) return;
    f32x4 acc[2][2][4][2];
#pragma unroll
    for (int a = 0; a < 2; ++a)
#pragma unroll
        for (int b = 0; b < 2; ++b)
#pragma unroll
            for (int m = 0; m < 4; ++m)
#pragma unroll
                for (int n = 0; n < 2; ++n) { acc[a][b][m][n] = (f32x4){0.f, 0.f, 0.f, 0.f}; if constexpr (FP8) asm volatile("" : "+v"(acc[a][b][m][n])); }
    bf16x8 At[4][2], B0[2][2], B1[2][2];
    unsigned cAo[2][2];
    PG8_SETOFFS(cAo, cur);
    const char* cA = S.abase(cur, g, tstep); const char* cB = S.bbase(cur, g, tstep);
    S.a_ready(cur);
    PG8_STAGE(PG8_SB(0, 0), cB, voffB); PG8_STAGE(PG8_SB(0, 1), cB + hstep, voffB); PG8_STAGE(PG8_SA(0, 0), cA, cAo[0]); PG8_STAGE(PG8_SA(0, 1), cA, cAo[1]);
    if (wr == 1) PG8_BAR;
    PG8_WAIT_V(2); PG8_BAR;
    PG8_STAGE(PG8_SB(1, 0), cB + kstep, voffB); PG8_STAGE(PG8_SA(1, 0), cA + kstepA, cAo[0]); PG8_STAGE(PG8_SB(1, 1), cB + hstep + kstep, voffB);
    PG8_WAIT_V(6); PG8_BAR;
    for (;;) {
        const bool has_next = S.next(ui + 1, nxt);
        const char* nA = has_next ? S.abase(nxt, g, tstep) : cA; const char* nB = has_next ? S.bbase(nxt, g, tstep) : cB;
        if constexpr (Sched::SIDE) {
            const void* ssrc = S.side_src(cur, (GATHER && has_next) ? nxt : cur, wid, lane);
            __builtin_amdgcn_global_load_lds((const unsigned*)ssrc, (PG8_LAS unsigned*)(side + (ui & 1) * SIDE_BYTES + wid * 1024), 16, 0, 0); }
#pragma unroll 1
        for (int t = 0; t < nt; t += 2) {
            const bool last = (t == nt - 2);
            const char* a1 = cA + (size_t)(t + 1) * kstepA;
            const char* a2 = last ? nA : cA + (size_t)(t + 2) * kstepA; const char* b2 = last ? nB : cB + (size_t)(t + 2) * kstep;
            const char* a3 = a2 + kstepA; const char* b3 = b2 + kstep;
            if (last && has_next) S.a_ready(nxt);
            PG8_LDB(B0, 0, 0); PG8_LDB(B1, 0, 1); PG8_SCHED; PG8_LDA(At, 0, 0); PG8_STAGE(PG8_SA(1, 1), a1, cAo[1]);
            if constexpr (GATHER) { if (last && has_next) {
                const PG8_LAS unsigned char* sdn = side + (ui & 1) * SIDE_BYTES;
#pragma unroll
                for (int _h = 0; _h < 2; ++_h)
#pragma unroll
                    for (int _i = 0; _i < 2; ++_i) { int _R, _C; stage_rc(tid * 16 + _i * 8192, _R, _C); cAo[_h][_i] = S.arow_side(nxt, _R + HALF * _h, sdn) + (unsigned)(_C * 2); } } }
            PG8_WAIT_V(8); PG8_WAIT_L(0); PG8_BAR; PG8_MMA(0, 0, At, B0); PG8_MMA(0, 1, At, B1); PG8_BAR; PG8_SCHED;
            PG8_LDA(At, 0, 1); PG8_STAGE(PG8_SB(0, 0), b2, voffB); PG8_STAGE(PG8_SB(0, 1), b2 + hstep, voffB); PG8_STAGE(PG8_SA(0, 0), a2, cAo[0]);
            PG8_WAIT_V(8); PG8_WAIT_L(0); PG8_BAR; PG8_MMA(1, 0, At, B0); PG8_MMA(1, 1, At, B1); PG8_BAR; PG8_SCHED;
            PG8_LDB(B0, 1, 0); PG8_LDB(B1, 1, 1); PG8_SCHED; PG8_LDA(At, 1, 0); PG8_STAGE(PG8_SA(0, 1), a2, cAo[1]);
            PG8_WAIT_V(8); PG8_WAIT_L(0); PG8_BAR; PG8_MMA(0, 0, At, B0); PG8_MMA(0, 1, At, B1); PG8_BAR; PG8_SCHED;
            PG8_LDA(At, 1, 1); PG8_STAGE(PG8_SB(1, 0), b3, voffB); PG8_STAGE(PG8_SB(1, 1), b3 + hstep, voffB); PG8_STAGE(PG8_SA(1, 0), a3, cAo[0]);
            PG8_WAIT_V(8); PG8_WAIT_L(0); PG8_BAR; PG8_MMA(1, 0, At, B0); PG8_MMA(1, 1, At, B1); PG8_BAR; PG8_SCHED;
        }
        if constexpr (ALIGN_EPI) { if (wr == 0) PG8_BAR; }
        if constexpr (FP8) asm volatile("s_nop 15\n\ts_nop 15" ::: "memory");
        if constexpr (!Epi::AFTER_DRAIN) { PG8_SCHED; E(acc, cur, wr, wc, fr, fq, side + (ui & 1) * SIDE_BYTES); S.done(cur); PG8_SCHED; }
        if (!has_next) break;
#pragma unroll
        for (int a = 0; a < 2; ++a)
#pragma unroll
            for (int b = 0; b < 2; ++b)
#pragma unroll
                for (int m = 0; m < 4; ++m)
#pragma unroll
                    for (int n = 0; n < 2; ++n) { acc[a][b][m][n] = (f32x4){0.f, 0.f, 0.f, 0.f}; if constexpr (FP8) asm volatile("" : "+v"(acc[a][b][m][n])); }
        cur = nxt; cA = nA; cB = nB; ++ui;
        if constexpr (ALIGN_EPI) { if (wr == 1) PG8_BAR; }
    }
    PG8_WAIT_V(0);
    if constexpr (!ALIGN_EPI) { if (wr == 0) PG8_BAR; }
    PG8_BAR;
    if constexpr (Epi::AFTER_DRAIN) { E.fused(acc, cur, wr, wc, fr, fq, lds, wid, lane); S.done(cur); }
#undef PG8_SA
#undef PG8_SB
#undef PG8_STAGE
#undef PG8_LDA
#undef PG8_LDB
#undef PG8_MMA
#undef PG8_WAIT_V
#undef PG8_WAIT_L
#undef PG8_BAR
#undef PG8_SCHED
#undef PG8_SETOFFS
}
}

constexpr int NB = 8, SEQ = 4096, DM = 1024, MROWS = NB * SEQ, NLAYER = 2;
constexpr int NPROJ = 4608, INW = 4616;
constexpr int C_Q = 0, C_K = 512, C_V = 1024, C_Z = 1536, C_XS = 2048, C_SB = 3072, C_SC = 3584, C_SH = 4096;
constexpr int MIXW = 1536, NEXP = 32, TOPK = 4, FF = 1024;
constexpr float ALPHA = 1.4142135623730951f;
constexpr float LN_EPS = 1e-5f, RMS_EPS = 1e-5f;
constexpr float QSCALE = 0.125f * 1.4426950408889634f;

constexpr size_t MiB = 1u << 20;
constexpr size_t WS_CTL = 0, CTL_ZERO_BYTES = 1 * MiB;
constexpr size_t WS_ROPE = 1 * MiB;
constexpr size_t WS_WDT = 2 * MiB;
constexpr size_t WS_ROUT = 2 * MiB + 65536;
constexpr size_t WS_WIN = 4 * MiB;
constexpr size_t WS_WOUT = 24 * MiB;
constexpr size_t WS_WGU = 32 * MiB;
constexpr size_t WS_WDN = 288 * MiB;
constexpr size_t WS_XB = 416 * MiB;
constexpr size_t WS_XF = 480 * MiB;
constexpr size_t WS_XF2 = 608 * MiB;
constexpr size_t WS_PROJ = 736 * MiB;
constexpr size_t WS_DT = 1024 * MiB;
constexpr size_t WS_DTS = 1025 * MiB;
constexpr size_t WS_ACUM = 1026 * MiB;
constexpr size_t WS_LSE = 1027 * MiB;
constexpr size_t WS_OP = 1030 * MiB;
constexpr size_t WS_U = 1126 * MiB;
constexpr size_t WS_G = 1190 * MiB;
constexpr size_t WS_ST = 1222 * MiB;
constexpr size_t WS_YD = 1286 * MiB;
constexpr size_t WS_MIXED = 1350 * MiB;
constexpr size_t WS_MIXF = 1446 * MiB;
constexpr size_t WS_TOPE = 1574 * MiB;
constexpr size_t WS_TOPG = 1575 * MiB;
constexpr size_t WS_ROWTOK = 1576 * MiB;
constexpr size_t WS_ROWGATE = 1580 * MiB;
constexpr size_t WS_H = 736 * MiB;
constexpr size_t WS_YB = 1030 * MiB;
constexpr size_t WS_END = 1584 * MiB;
constexpr int CW_TMO = 0;
constexpr int CW_CNT = 64;
constexpr int CW_BAR = 4096;
constexpr int CW_SEAM = 16384;

constexpr int RING_OFF = 0, RING_BYTES = 131072;
constexpr int LDSCTL_OFF = 155648;
constexpr int L_MISC = LDSCTL_OFF;
constexpr int L_TSTART = LDSCTL_OFF + 256;
constexpr int L_CNT = LDSCTL_OFF + 512;
constexpr int L_LCNT = LDSCTL_OFF + 640;
constexpr int L_LBASE = LDSCTL_OFF + 768;
constexpr int L_UNITS = LDSCTL_OFF + 1024;
constexpr int L_UNITSN = LDSCTL_OFF + 2048;
constexpr int LDS_BYTES = 163840;

#define GAS __attribute__((address_space(1)))
#define LAS __attribute__((address_space(3)))
typedef unsigned short bf16;
typedef unsigned v4u __attribute__((ext_vector_type(4)));
typedef unsigned v2u __attribute__((ext_vector_type(2)));
typedef float f32x4 __attribute__((ext_vector_type(4)));
typedef float f32x16 __attribute__((ext_vector_type(16)));
typedef short bf16x8 __attribute__((ext_vector_type(8)));
typedef GAS unsigned gu32;
#define RLX_AGENT __ATOMIC_RELAXED, __HIP_MEMORY_SCOPE_AGENT
#define LDS_WAIT() asm volatile("s_waitcnt lgkmcnt(0)" ::: "memory")
#define VM_WAIT() asm volatile("s_waitcnt vmcnt(0)" ::: "memory")
__device__ __forceinline__ unsigned f2bf(float f) { unsigned u = __builtin_bit_cast(unsigned, f); return (u + 0x7fffu + ((u >> 16) & 1u)) >> 16; }
__device__ __forceinline__ unsigned pk2(float lo, float hi) { unsigned r; asm volatile("v_cvt_pk_bf16_f32 %0, %1, %2" : "=v"(r) : "v"(lo), "v"(hi)); return r; }
__device__ __forceinline__ float bf2f(unsigned short b) { return __builtin_bit_cast(float, (unsigned)b << 16); }
__device__ __forceinline__ float bflo(unsigned w) { return __builtin_bit_cast(float, w << 16); }
__device__ __forceinline__ float bfhi(unsigned w) { return __builtin_bit_cast(float, w & 0xffff0000u); }
__device__ __forceinline__ float siluf(float x) { return x * __builtin_amdgcn_rcpf(1.0f + __builtin_amdgcn_exp2f(-1.4426950408889634f * x)); }
#define XB_TMO      128
#define XB_XCNT(j)  (256  + 64 * (j))
#define XB_XSUB(j)  (1280 + 64 * (j))
#define XB_XGEN(j)  (2304 + 64 * (j))
#define XB_TOP      3328
#define XB_TOPGEN   3392
#define XCD_BAR_WORDS 3456
#define XB_SPIN_CAP (1u << 18)

__device__ __forceinline__ unsigned xb_ld(unsigned* p)              { return __hip_atomic_load(p, __ATOMIC_RELAXED, __HIP_MEMORY_SCOPE_AGENT); }
__device__ __forceinline__ unsigned xb_add(unsigned* p, unsigned v) { return __hip_atomic_fetch_add(p, v, __ATOMIC_RELAXED, __HIP_MEMORY_SCOPE_AGENT); }
__device__ __forceinline__ unsigned xb_xcc_id() { return (unsigned)__builtin_amdgcn_s_getreg((3 << 11) | 20) & 0xFu; }
#define XB_SPIN(cond, bar) do { unsigned _sp = 0; while (cond) { __builtin_amdgcn_s_sleep(1); \
    if ((++_sp & 255u) == 0u) { if (xb_ld(&(bar)[XB_TMO])) break; if (_sp > XB_SPIN_CAP) { atomicAdd(&(bar)[XB_TMO], 1u); break; } } } } while (0)

struct XcdBarrier {
    unsigned* bar; unsigned x;
    volatile LAS unsigned* st;
};

__device__ __forceinline__ XcdBarrier xcd_barrier_post(unsigned* bar, volatile LAS unsigned* st) {
    XcdBarrier b; b.bar = bar; b.x = xb_xcc_id(); b.st = st;
    if (threadIdx.x == 0) (void)xb_add(&bar[XB_XCNT(b.x)], 1u);
    return b;
}
__device__ __forceinline__ void xcd_barrier_complete(unsigned* bar, unsigned x, unsigned& nloc, unsigned& nx) {
    const unsigned G = gridDim.x * gridDim.y * gridDim.z;
    unsigned sum, cnt, mine, sp = 0u;
    for (;;) {
        sum = 0u; cnt = 0u; mine = 0u;
#pragma unroll
        for (unsigned j = 0; j < 16; ++j) { const unsigned c = xb_ld(&bar[XB_XCNT(j)]); sum += c; cnt += (c > 0u) ? 1u : 0u; mine = (j == x) ? c : mine; }
        if (sum == G) break;
        __builtin_amdgcn_s_sleep(1);
        if ((++sp & 255u) == 0u) { if (xb_ld(&bar[XB_TMO])) break; if (sp > XB_SPIN_CAP) { atomicAdd(&bar[XB_TMO], 1u); break; } }
    }
    nloc = mine > 0u ? mine : 1u; nx = cnt > 0u ? cnt : 1u;
}

__device__ __forceinline__ void xcd_barrier(const XcdBarrier& b) {
    asm volatile("s_waitcnt vmcnt(0)" ::: "memory");
    __syncthreads();
    if (threadIdx.x == 0) {
        unsigned* bar = b.bar;
        __builtin_amdgcn_s_waitcnt(0);
        unsigned nloc = b.st[0], nx = b.st[1];
        if (nloc == 0u) { xcd_barrier_complete(bar, b.x, nloc, nx); b.st[0] = nloc; b.st[1] = nx; }
        const unsigned old = xb_add(&bar[XB_XSUB(b.x)], 1u);
        const unsigned gen = old / nloc;
        if (old + 1u == (gen + 1u) * nloc) {
            __builtin_amdgcn_fence(__ATOMIC_RELEASE, "agent");
            asm volatile("s_waitcnt vmcnt(0)" ::: "memory");
            const unsigned og = xb_add(&bar[XB_TOP], 1u);
            const unsigned tg = og / nx;
            if (og + 1u == (tg + 1u) * nx) xb_add(&bar[XB_TOPGEN], 1u);
            else XB_SPIN(xb_ld(&bar[XB_TOPGEN]) == tg, bar);
            __builtin_amdgcn_fence(__ATOMIC_ACQUIRE, "agent");
            xb_add(&bar[XB_XGEN(b.x)], 1u);
            asm volatile("s_waitcnt vmcnt(0)" ::: "memory");
        } else {
            XB_SPIN(xb_ld(&bar[XB_XGEN(b.x)]) == gen, bar);
            __builtin_amdgcn_fence(__ATOMIC_ACQUIRE, "agent");
            asm volatile("s_waitcnt vmcnt(0)" ::: "memory");
        }
    }
    __syncthreads();
}

constexpr float SC_X = 4.f, SC_WGU = 32.f, SC_H = 4.f, SC_WDN = 4.f, SC_Y = 16.f, SC_WIN = 32.f, SC_O = 32.f;
__device__ __forceinline__ float wave_sum(float v) {
#pragma unroll
    for (int o = 1; o < 64; o <<= 1) v += __shfl_xor(v, o);
    return v;
}
__device__ __forceinline__ int win_dest_row(int n) {
    if (n < 1024) { const int hh = n >> 6, d = n & 63; const int p = (d < 32) ? (8 * (d >> 2) + (d & 3)) : (8 * ((d - 32) >> 2) + 4 + (d & 3)); return hh * 64 + p; }
    if (n < 3072) return n;
    if (n < 3080) return -1;
    return n - 8;
}
__device__ __forceinline__ int wgu_dest_row(int n) { return n < 1024 ? ((n >> 7) * 256 + (n & 127)) : (((n - 1024) >> 7) * 256 + 128 + ((n - 1024) & 127)); }
template <int MAP>
__device__ __forceinline__ void p0_transpose_item(const float* W, int K, int N, bf16* WT, float* wdt, LAS float* scr, int kb, int nb, int lane) {
    const int k0 = 64 * kb, n0 = 32 * nb;
    const int nn = n0 + (lane & 31); const bool nok = nn < N;
#pragma unroll 8
    for (int i = 0; i < 32; ++i) { const int kk = 2 * i + (lane >> 5); scr[kk * 33 + (lane & 31)] = nok ? W[(size_t)(k0 + kk) * N + nn] : 0.f; }
    LDS_WAIT(); asm volatile("" ::: "memory");
    const int c = lane & 7;
#pragma unroll
    for (int j = 0; j < 4; ++j) { const int n = (lane >> 3) + 8 * j; const LAS float* s = scr + (8 * c) * 33 + n;
        const int nsrc = n0 + n; if (nsrc >= N) continue;
        int drow = nsrc; if (MAP == 1) drow = win_dest_row(nsrc); if (MAP == 2) drow = wgu_dest_row(nsrc);
        if (MAP == 1 && drow < 0) { float* d = wdt + (size_t)(nsrc - 3072) * 1024 + k0 + 8 * c;
#pragma unroll
            for (int q = 0; q < 8; ++q) d[q] = s[q * 33]; continue; }
        v4u o; o.x = pk2(s[0 * 33], s[1 * 33]); o.y = pk2(s[2 * 33], s[3 * 33]); o.z = pk2(s[4 * 33], s[5 * 33]); o.w = pk2(s[6 * 33], s[7 * 33]);
        *(GAS v4u*)(WT + (size_t)drow * K + k0 + 8 * c) = o; }
    LDS_WAIT(); asm volatile("" ::: "memory");
}
template <int MAP>
__device__ __forceinline__ void p0_transpose_item64(const float* W, int K, int N, bf16* WT, float* wdt, LAS float* scr, int kb, int nb, int lane) {
    const int k0 = 64 * kb, n0 = 64 * nb;
    const bool lok = (n0 + 4 * (lane & 15) + 3) < N;
    f32x4 ld[16];
#pragma unroll
    for (int i = 0; i < 16; ++i) ld[i] = lok ? *(const f32x4*)(W + (size_t)(k0 + 4 * i + (lane >> 4)) * N + n0 + 4 * (lane & 15)) : (f32x4){0.f, 0.f, 0.f, 0.f};
#pragma unroll
    for (int i = 0; i < 16; ++i) *(LAS f32x4*)(scr + (4 * i + (lane >> 4)) * 64 + 4 * (lane & 15)) = ld[i];
    LDS_WAIT(); asm volatile("" ::: "memory");
    const int nsrc = n0 + lane;
    if (nsrc < N) {
        int drow = nsrc; if (MAP == 1) drow = win_dest_row(nsrc);
        if (MAP == 1 && drow < 0) { float* d = wdt + (size_t)(nsrc - 3072) * 1024 + k0;
#pragma unroll
            for (int q = 0; q < 16; ++q) *(f32x4*)(d + 4 * q) = (f32x4){scr[(4 * q) * 64 + lane], scr[(4 * q + 1) * 64 + lane], scr[(4 * q + 2) * 64 + lane], scr[(4 * q + 3) * 64 + lane]}; }
        else { GAS v4u* d = (GAS v4u*)(WT + (size_t)drow * K + k0);
#pragma unroll
            for (int q = 0; q < 8; ++q) { v4u o; o.x = pk2(scr[(8 * q) * 64 + lane], scr[(8 * q + 1) * 64 + lane]); o.y = pk2(scr[(8 * q + 2) * 64 + lane], scr[(8 * q + 3) * 64 + lane]);
                o.z = pk2(scr[(8 * q + 4) * 64 + lane], scr[(8 * q + 5) * 64 + lane]); o.w = pk2(scr[(8 * q + 6) * 64 + lane], scr[(8 * q + 7) * 64 + lane]); d[q] = o; } } }
    LDS_WAIT(); asm volatile("" ::: "memory");
}
struct SubT { const float* src; unsigned char* dst; int N; int n0; int mode; float scale; };
__device__ __forceinline__ SubT fp8_subtile(int item, int half, const float* wgu, const float* wdn, const float* win, unsigned char* WG8, unsigned char* WD8, unsigned char* WI8, int lane) {
    SubT t; int kb, nb;
    if (item < 64 * 256) { const int le = item >> 8, r = item & 255; kb = r >> 5; nb = r & 31; t.N = 2048; t.mode = 1; t.scale = SC_WGU;
        t.src = wgu + (size_t)le * 1024 * 2048; t.dst = WG8 + (size_t)le * 2048 * 1024; }
    else if (item < 64 * 256 + 64 * 128) { const int it2 = item - 64 * 256; const int le = it2 >> 7, r = it2 & 127; kb = r >> 4; nb = r & 15; t.N = 1024; t.mode = 0; t.scale = SC_WDN;
        t.src = wdn + (size_t)le * 1024 * 1024; t.dst = WD8 + (size_t)le * 1024 * 1024; }
    else { const int it3 = item - (64 * 256 + 64 * 128); const int l = it3 / 192, r = it3 % 192; kb = r / 24; nb = r % 24; t.N = INW; t.mode = 2; t.scale = SC_WIN;
        t.src = win + (size_t)l * 1024 * INW; t.dst = WI8 + (size_t)l * 1536 * 1024; }
    const int k0 = 128 * kb + 64 * half; t.n0 = 64 * nb;
    t.src += (size_t)(k0 + (lane >> 4)) * t.N + t.n0 + 4 * (lane & 15);
    t.dst += (size_t)k0;
    return t;
}
__device__ __forceinline__ void fp8_sub_load(const SubT& t, f32x4 (&ld)[16]) {
#pragma unroll
    for (int i = 0; i < 16; ++i) ld[i] = __builtin_nontemporal_load((const f32x4*)(t.src + (size_t)(4 * i) * t.N));
}
__device__ __forceinline__ void fp8_sub_process(const SubT& t, const f32x4 (&ld)[16], LAS float* scr, int lane) {
#pragma unroll
    for (int i = 0; i < 16; ++i) *(LAS f32x4*)(scr + (4 * i + (lane >> 4)) * 64 + 4 * (lane & 15)) = ld[i];
    LDS_WAIT(); asm volatile("" ::: "memory");
    unsigned w[16];
#pragma unroll
    for (int q = 0; q < 16; ++q) w[q] = pg8::pk4_fp8(scr[(4 * q + 0) * 64 + lane] * t.scale, scr[(4 * q + 1) * 64 + lane] * t.scale, scr[(4 * q + 2) * 64 + lane] * t.scale, scr[(4 * q + 3) * 64 + lane] * t.scale);
    LDS_WAIT(); asm volatile("" ::: "memory");
    LAS unsigned char* t2 = (LAS unsigned char*)scr;
#pragma unroll
    for (int q = 0; q < 4; ++q) *(LAS v4u*)(t2 + lane * 80 + 16 * q) = (v4u){w[4 * q], w[4 * q + 1], w[4 * q + 2], w[4 * q + 3]};
    LDS_WAIT(); asm volatile("" ::: "memory");
#pragma unroll
    for (int q = 0; q < 4; ++q) { const int n = 16 * q + (lane >> 2); const v4u v = *(const LAS v4u*)(t2 + n * 80 + 16 * (lane & 3));
        const int nn = (t.mode == 1) ? wgu_dest_row(t.n0 + n) : (t.mode == 2) ? win_dest_row(t.n0 + n) : (t.n0 + n);
        *(GAS v4u*)(t.dst + (size_t)nn * 1024 + 16 * (lane & 3)) = v; }
    LDS_WAIT(); asm volatile("" ::: "memory");
}
__device__ __forceinline__ void row_dt(const f32x4 (&v)[4], const float* wdt, float* dst, int lane) {
    float r[8];
#pragma unroll
    for (int jj = 0; jj < 8; ++jj) { float s = 0.f;
#pragma unroll
        for (int j = 0; j < 4; ++j) { const f32x4 w = *(const f32x4*)(wdt + jj * 1024 + 4 * lane + 256 * j); s += v[j][0] * w[0] + v[j][1] * w[1] + v[j][2] * w[2] + v[j][3] * w[3]; }
        r[jj] = wave_sum(s); }
    if (lane == 0) { *(f32x4*)dst = (f32x4){r[0], r[1], r[2], r[3]}; *(f32x4*)(dst + 4) = (f32x4){r[4], r[5], r[6], r[7]}; }
}
__device__ __forceinline__ void load_wdt(const float* wdt, f32x4 (&w)[8][4], int lane) {
#pragma unroll
    for (int jj = 0; jj < 8; ++jj)
#pragma unroll
        for (int j = 0; j < 4; ++j) w[jj][j] = *(const f32x4*)(wdt + jj * 1024 + 4 * lane + 256 * j);
}
__device__ __forceinline__ void row_dt_w(const f32x4 (&v)[4], const f32x4 (&w)[8][4], float* dst, int lane) {
    float r[8];
#pragma unroll
    for (int jj = 0; jj < 8; ++jj) { float s = 0.f;
#pragma unroll
        for (int j = 0; j < 4; ++j) s += v[j][0] * w[jj][j][0] + v[j][1] * w[jj][j][1] + v[j][2] * w[jj][j][2] + v[j][3] * w[jj][j][3];
        r[jj] = wave_sum(s); }
    if (lane == 0) { *(f32x4*)dst = (f32x4){r[0], r[1], r[2], r[3]}; *(f32x4*)(dst + 4) = (f32x4){r[4], r[5], r[6], r[7]}; }
}
__device__ __forceinline__ void row_dt_win(const f32x4 (&v)[4], const float* win, float* dst, int lane) {
    float r[8];
#pragma unroll
    for (int jj = 0; jj < 8; ++jj) r[jj] = 0.f;
#pragma unroll
    for (int j = 0; j < 4; ++j)
#pragma unroll
        for (int e = 0; e < 4; ++e) { const float* wp = win + (size_t)(4 * lane + 256 * j + e) * INW + 3072; const f32x4 w0 = *(const f32x4*)wp, w1 = *(const f32x4*)(wp + 4); const float x = v[j][e];
            r[0] += x * w0[0]; r[1] += x * w0[1]; r[2] += x * w0[2]; r[3] += x * w0[3]; r[4] += x * w1[0]; r[5] += x * w1[1]; r[6] += x * w1[2]; r[7] += x * w1[3]; }
#pragma unroll
    for (int jj = 0; jj < 8; ++jj) r[jj] = wave_sum(r[jj]);
    if (lane == 0) { *(f32x4*)dst = (f32x4){r[0], r[1], r[2], r[3]}; *(f32x4*)(dst + 4) = (f32x4){r[4], r[5], r[6], r[7]}; }
}
template <bool W8, bool WF>
__device__ __forceinline__ void ln_row(f32x4 (&v)[4], const float* gam, const float* bet, float* of32, bf16* ob16, unsigned char* o8, float s8, int lane) {
    float s = 0.f;
#pragma unroll
    for (int j = 0; j < 4; ++j) s += (v[j][0] + v[j][1]) + (v[j][2] + v[j][3]);
    const float mean = wave_sum(s) * (1.f / DM); float s2 = 0.f;
#pragma unroll
    for (int j = 0; j < 4; ++j) { v[j] = v[j] - mean; s2 += (v[j][0] * v[j][0] + v[j][1] * v[j][1]) + (v[j][2] * v[j][2] + v[j][3] * v[j][3]); }
    const float rstd = 1.f / sqrtf(wave_sum(s2) * (1.f / DM) + LN_EPS);
#pragma unroll
    for (int j = 0; j < 4; ++j) { const f32x4 g = *(const f32x4*)(gam + 4 * lane + 256 * j), b = *(const f32x4*)(bet + 4 * lane + 256 * j);
        v[j] = v[j] * rstd * g + b;
        if (WF) *(f32x4*)(of32 + 4 * lane + 256 * j) = v[j];
        v2u w; w.x = pk2(v[j][0], v[j][1]); w.y = pk2(v[j][2], v[j][3]); *(v2u*)(ob16 + 4 * lane + 256 * j) = w;
        if (W8) *(unsigned*)(o8 + 4 * lane + 256 * j) = pg8::pk4_fp8(v[j][0] * s8, v[j][1] * s8, v[j][2] * s8, v[j][3] * s8); }
}


typedef short v4i16_t __attribute__((ext_vector_type(4)));
__device__ __forceinline__ bf16x8 tr_pair(const LAS unsigned char* p0, const LAS unsigned char* p1) {
    const v4i16_t a = __builtin_amdgcn_ds_read_tr16_b64_v4i16((LAS v4i16_t*)p0), b = __builtin_amdgcn_ds_read_tr16_b64_v4i16((LAS v4i16_t*)p1);
    return (bf16x8){a[0], a[1], a[2], a[3], b[0], b[1], b[2], b[3]};
}
__device__ __forceinline__ int crow16(int r, int hi) { return (r & 3) + 8 * (r >> 2) + 4 * hi; }
constexpr int AK_PITCH = 144, AV_PITCH = 192, AK_TILE = 32 * AK_PITCH, AV_TILE = 32 * AV_PITCH;
constexpr int AT_K = 0, AT_V = 12 * AK_TILE;
struct AttnItem { int p, b, h, d, r, qt0; };
__device__ __forceinline__ AttnItem attn_item(int I) { AttnItem a; a.p = I >> 10; const int rem = I & 1023; a.b = rem >> 7; a.h = (rem >> 4) & 7; const int grp = rem & 15;
    a.d = (a.p == 0) ? 1 : (a.p == 1) ? 4 : 16; const int tpr = 128 / a.d; const int T = grp * 8; a.r = T / tpr; a.qt0 = T % tpr; return a; }
__device__ __forceinline__ void attn_request(const bf16* PROJ, const AttnItem& a, v4u (&st)[12], int tid) {
    const int rr = tid >> 4, ch = tid & 15; const int col = (ch < 8 ? C_K : C_V - 64) + a.h * 64 + ch * 8;
#pragma unroll
    for (int tl = 0; tl < 12; ++tl) { const int kt = a.qt0 - 4 + tl; st[tl] = (v4u){0u, 0u, 0u, 0u};
        if (kt >= 0) { const size_t row = (size_t)a.b * SEQ + (size_t)(32 * kt + rr) * a.d + a.r; st[tl] = *(const v4u*)(PROJ + row * NPROJ + col); } }
}
__device__ __forceinline__ void attn_deposit(LAS unsigned char* al, const v4u (&st)[12], int tid) {
    const int rr = tid >> 4, ch = tid & 15;
    LAS unsigned char* dst = (ch < 8) ? (al + AT_K + rr * AK_PITCH + ch * 16) : (al + AT_V + rr * AV_PITCH + (ch - 8) * 16); const int tstep = (ch < 8) ? AK_TILE : AV_TILE;
#pragma unroll
    for (int tl = 0; tl < 12; ++tl) *(LAS v4u*)(dst + tl * tstep) = st[tl];
}
__device__ __forceinline__ void attn_wave_compute(const bf16* PROJ, bf16* OPp, float* LSEp, const AttnItem& a, const LAS unsigned char* al, int wave, int lane) {
    const int i = lane & 31, h2 = lane >> 5; const int qt = a.qt0 + wave;
    const size_t rowq = (size_t)a.b * SEQ + (size_t)(32 * qt + i) * a.d + a.r;
    bf16x8 qf[4];
    { const bf16* qp = PROJ + rowq * NPROJ + C_Q + a.h * 64 + 8 * h2;
#pragma unroll
      for (int s = 0; s < 4; ++s) qf[s] = *(const bf16x8*)(qp + 16 * s); }
    f32x16 o0 = {}, o1 = {}; float mrun = -INFINITY, lrun = 0.f;
    const int kt0 = qt > 4 ? qt - 4 : 0;
    const LAS unsigned char* krd = al + AT_K + i * AK_PITCH + 16 * h2;
    const LAS unsigned char* trb = al + AT_V + (4 * h2 + ((lane & 15) >> 2)) * AV_PITCH + (16 * ((lane >> 4) & 1) + 4 * (lane & 3)) * 2;
#define ATT_QK(S, ktx) do { const LAS unsigned char* kp_ = krd + ((ktx) - a.qt0 + 4) * AK_TILE; \
        __builtin_amdgcn_s_setprio(1); \
        S = __builtin_amdgcn_mfma_f32_32x32x16_bf16(*(const LAS bf16x8*)(kp_), qf[0], (f32x16){}, 0, 0, 0); \
        _Pragma("unroll") for (int s = 1; s < 4; ++s) S = __builtin_amdgcn_mfma_f32_32x32x16_bf16(*(const LAS bf16x8*)(kp_ + 32 * s), qf[s], S, 0, 0, 0); \
        __builtin_amdgcn_s_setprio(0); } while (0)
#define ATT_STEP(S, ktx) do { const LAS unsigned char* vp = trb + ((ktx) - a.qt0 + 4) * AV_TILE; \
        if ((ktx) == qt) { asm volatile("; causal mask"); _Pragma("unroll") for (int rg = 0; rg < 16; ++rg) if (crow16(rg, h2) > i) S[rg] = -INFINITY; } \
        if ((ktx) + 4 == qt) { asm volatile("; window mask"); _Pragma("unroll") for (int rg = 0; rg < 16; ++rg) if (crow16(rg, h2) < i) S[rg] = -INFINITY; } \
        float mx = S[0]; \
        _Pragma("unroll") for (int rg = 1; rg < 16; ++rg) mx = fmaxf(mx, S[rg]); \
        mx = fmaxf(mx, __shfl_xor(mx, 32)); \
        const float mnew = fmaxf(mrun, mx), alpha = __builtin_amdgcn_exp2f(mrun - mnew); mrun = mnew; \
        float ps = 0.f; \
        _Pragma("unroll") for (int rg = 0; rg < 16; ++rg) { S[rg] = __builtin_amdgcn_exp2f(S[rg] - mnew); ps += S[rg]; } \
        lrun = lrun * alpha + ps; \
        _Pragma("unroll") for (int rg = 0; rg < 16; ++rg) { o0[rg] *= alpha; o1[rg] *= alpha; } \
        bf16x8 pf[2]; \
        _Pragma("unroll") for (int ks = 0; ks < 2; ++ks) { v4u w; w.x = pg8::cvt_pk_bf16(S[8 * ks + 0], S[8 * ks + 1]); w.y = pg8::cvt_pk_bf16(S[8 * ks + 2], S[8 * ks + 3]); w.z = pg8::cvt_pk_bf16(S[8 * ks + 4], S[8 * ks + 5]); w.w = pg8::cvt_pk_bf16(S[8 * ks + 6], S[8 * ks + 7]); pf[ks] = __builtin_bit_cast(bf16x8, w); } \
        _Pragma("unroll") for (int ks = 0; ks < 2; ++ks) { \
            const bf16x8 v0 = tr_pair(vp + (16 * ks) * AV_PITCH, vp + (16 * ks + 8) * AV_PITCH); \
            const bf16x8 v1 = tr_pair(vp + (16 * ks) * AV_PITCH + 64, vp + (16 * ks + 8) * AV_PITCH + 64); \
            __builtin_amdgcn_s_setprio(1); \
            o0 = __builtin_amdgcn_mfma_f32_32x32x16_bf16(v0, pf[ks], o0, 0, 0, 0); \
            o1 = __builtin_amdgcn_mfma_f32_32x32x16_bf16(v1, pf[ks], o1, 0, 0, 0); \
            __builtin_amdgcn_s_setprio(0); } } while (0)
    f32x16 sA, sB;
    ATT_QK(sA, kt0);
#pragma unroll 1
    for (int kt = kt0; ; kt += 2) {
        if (kt < qt) ATT_QK(sB, kt + 1);
        ATT_STEP(sA, kt);
        if (kt >= qt) break;
        if (kt + 1 < qt) ATT_QK(sA, kt + 2);
        ATT_STEP(sB, kt + 1);
        if (kt + 1 >= qt) break;
    }
#undef ATT_QK
#undef ATT_STEP
    const float lt = lrun + __shfl_xor(lrun, 32); const float il = 1.0f / lt;
    unsigned char* op = (unsigned char*)OPp + rowq * 512 + a.h * 64 + 4 * h2;
    const float ils = il * SC_O;
    unsigned p0[4], p1[4];
#pragma unroll
    for (int g4 = 0; g4 < 4; ++g4) { p0[g4] = pg8::pk4_fp8(o0[4 * g4 + 0] * ils, o0[4 * g4 + 1] * ils, o0[4 * g4 + 2] * ils, o0[4 * g4 + 3] * ils);
        p1[g4] = pg8::pk4_fp8(o1[4 * g4 + 0] * ils, o1[4 * g4 + 1] * ils, o1[4 * g4 + 2] * ils, o1[4 * g4 + 3] * ils); }
    { const auto s02 = __builtin_amdgcn_permlane32_swap(p0[0], p0[2], false, false), s13 = __builtin_amdgcn_permlane32_swap(p0[1], p0[3], false, false);
      const auto t02 = __builtin_amdgcn_permlane32_swap(p1[0], p1[2], false, false), t13 = __builtin_amdgcn_permlane32_swap(p1[1], p1[3], false, false);
      unsigned char* opw = (unsigned char*)OPp + rowq * 512 + a.h * 64 + 16 * h2;
      *(v4u*)opw = (v4u){s02[0], s02[1], s13[0], s13[1]}; *(v4u*)(opw + 32) = (v4u){t02[0], t02[1], t13[0], t13[1]}; }
    if (h2 == 0) LSEp[rowq * 8 + a.h] = mrun + log2f(lt);
}
__device__ __forceinline__ void attn_phase(LAS unsigned char* al, const bf16* PROJ, bf16* OP, float* LSE, int bid, int G, int tid, int wave, int lane) {
    v4u st[12];
    int I = bid;
    if (I < 3072) { const AttnItem a = attn_item(I); attn_request(PROJ, a, st, tid); }
    for (; I < 3072; I += G) {
        const AttnItem a = attn_item(I);
        __syncthreads();
        attn_deposit(al, st, tid);
        __syncthreads();
        if (I + G < 3072) { const AttnItem n = attn_item(I + G); attn_request(PROJ, n, st, tid); }
        attn_wave_compute(PROJ, (bf16*)((unsigned char*)OP + (size_t)a.p * MROWS * 512), LSE + (size_t)a.p * MROWS * 8, a, al, wave, lane);
    }
    __syncthreads();
}

constexpr int SS_DTS = 0, SS_ACUM = 2048, SS_TMP = 4096, SS_SSX = 6144, SS_IMG = 8192;
constexpr int S1_PB = 320, S1_PX = 576;
constexpr int S1_B = SS_IMG, S1_X = SS_IMG + 128 * S1_PB;
constexpr int S3_PBC = 272, S3_PX = 576;
constexpr int S3_B = SS_IMG, S3_C = S3_B + 128 * S3_PBC, S3_X = S3_C + 128 * S3_PBC;

__device__ __forceinline__ void ssd_prep(LAS unsigned char* sl, const float* DT, const float* dtb, const float* alog, size_t row0, int g, int tid, int lane, int wave) {
    LAS float* dts = (LAS float*)(sl + SS_DTS); LAS float* acum = (LAS float*)(sl + SS_ACUM); LAS float* tmp = (LAS float*)(sl + SS_TMP);
    { const int l = tid >> 2, hq = tid & 3; const float x = DT[(row0 + l) * 8 + 4 * g + hq] + dtb[4 * g + hq];
      const float dt = x > 20.f ? x : log1pf(__expf(x)); dts[hq * 128 + l] = dt; tmp[hq * 128 + l] = dt * (-__expf(alog[4 * g + hq]) * 1.4426950408889634f); }
    __syncthreads();
    if (wave < 4) { const float v0 = tmp[wave * 128 + 2 * lane], v1 = tmp[wave * 128 + 2 * lane + 1]; float s = v0 + v1;
#pragma unroll
        for (int off = 1; off < 64; off <<= 1) { const float t = __shfl_up(s, off); if (lane >= off) s += t; }
        acum[wave * 128 + 2 * lane] = s - v1; acum[wave * 128 + 2 * lane + 1] = s; }
    __syncthreads();
}
template <int NCOLS, int FACMODE>
__device__ __forceinline__ void conv_tile(const bf16* PROJ, size_t row0, int t0, int pcol0, const float* cw, const float* cb, int cch0, LAS unsigned char* dst, int pitch, const LAS unsigned char* sl, int hq0, int tid) {
    constexpr int NCH8 = NCOLS / 8, NSEG = 512 / NCH8, RPS = 128 / NSEG;
    const int c8 = tid % NCH8, seg = tid / NCH8, l0 = seg * RPS;
    float w[4][8], bias[8], hst[3][8];
#pragma unroll
    for (int k = 0; k < 4; ++k) { const f32x4 a = *(const f32x4*)(cw + k * 1024 + cch0 + c8 * 8), b = *(const f32x4*)(cw + k * 1024 + cch0 + c8 * 8 + 4);
        w[k][0] = a[0]; w[k][1] = a[1]; w[k][2] = a[2]; w[k][3] = a[3]; w[k][4] = b[0]; w[k][5] = b[1]; w[k][6] = b[2]; w[k][7] = b[3]; }
    { const f32x4 a = *(const f32x4*)(cb + cch0 + c8 * 8), b = *(const f32x4*)(cb + cch0 + c8 * 8 + 4);
      bias[0] = a[0]; bias[1] = a[1]; bias[2] = a[2]; bias[3] = a[3]; bias[4] = b[0]; bias[5] = b[1]; bias[6] = b[2]; bias[7] = b[3]; }
    const bf16* src = PROJ + pcol0 + c8 * 8;
#pragma unroll
    for (int k = 0; k < 3; ++k) { const int l = l0 - 3 + k; v4u v = (v4u){0u, 0u, 0u, 0u}; if (t0 + l >= 0) v = *(const v4u*)(src + (size_t)((long)row0 + l) * NPROJ);
        hst[k][0] = bflo(v.x); hst[k][1] = bfhi(v.x); hst[k][2] = bflo(v.y); hst[k][3] = bfhi(v.y); hst[k][4] = bflo(v.z); hst[k][5] = bfhi(v.z); hst[k][6] = bflo(v.w); hst[k][7] = bfhi(v.w); }
    const LAS float* dts = (const LAS float*)(sl + SS_DTS); const LAS float* acum = (const LAS float*)(sl + SS_ACUM);
    const int hq = hq0 + (c8 * 8) / 64;
    const float alast = (FACMODE == 2) ? acum[hq * 128 + 127] : 0.f;
#pragma unroll
    for (int rr = 0; rr < RPS; ++rr) { const int l = l0 + rr; const v4u v = *(const v4u*)(src + (row0 + l) * NPROJ);
        float cur[8]; cur[0] = bflo(v.x); cur[1] = bfhi(v.x); cur[2] = bflo(v.y); cur[3] = bfhi(v.y); cur[4] = bflo(v.z); cur[5] = bfhi(v.z); cur[6] = bflo(v.w); cur[7] = bfhi(v.w);
        float f = 1.f; if (FACMODE >= 1) f = dts[hq * 128 + l]; if (FACMODE == 2) f *= __builtin_amdgcn_exp2f(alast - acum[hq * 128 + l]);
        float o[8];
#pragma unroll
        for (int e = 0; e < 8; ++e) { const float a = bias[e] + w[0][e] * hst[0][e] + w[1][e] * hst[1][e] + w[2][e] * hst[2][e] + w[3][e] * cur[e]; o[e] = siluf(a) * f;
            hst[0][e] = hst[1][e]; hst[1][e] = hst[2][e]; hst[2][e] = cur[e]; }
        v4u ov; ov.x = pk2(o[0], o[1]); ov.y = pk2(o[2], o[3]); ov.z = pk2(o[4], o[5]); ov.w = pk2(o[6], o[7]);
        *(LAS v4u*)(dst + l * pitch + c8 * 16) = ov; }
}
template <int NCOLS>
__device__ __forceinline__ void conv_load(const bf16* PROJ, size_t row0, int t0, int pcol0, int tid, v4u (&hv)[3], v4u (&rv)[128 / (512 / (NCOLS / 8))]) {
    constexpr int NCH8 = NCOLS / 8, NSEG = 512 / NCH8, RPS = 128 / NSEG;
    const int c8 = tid % NCH8, seg = tid / NCH8, l0 = seg * RPS;
    const bf16* src = PROJ + pcol0 + c8 * 8;
#pragma unroll
    for (int k = 0; k < 3; ++k) { const int l = l0 - 3 + k; hv[k] = (v4u){0u, 0u, 0u, 0u}; if (t0 + l >= 0) hv[k] = *(const v4u*)(src + (size_t)((long)row0 + l) * NPROJ); }
#pragma unroll
    for (int rr = 0; rr < RPS; ++rr) rv[rr] = *(const v4u*)(src + (row0 + l0 + rr) * NPROJ);
}
template <int NCOLS, int FACMODE>
__device__ __forceinline__ void conv_apply(const v4u (&hv)[3], const v4u (&rv)[128 / (512 / (NCOLS / 8))], const float* cw, const float* cb, int cch0, LAS unsigned char* dst, int pitch, const LAS unsigned char* sl, int hq0, int tid) {
    typedef float f32x2 __attribute__((ext_vector_type(2)));
    constexpr int NCH8 = NCOLS / 8, NSEG = 512 / NCH8, RPS = 128 / NSEG;
    const int c8 = tid % NCH8, seg = tid / NCH8, l0 = seg * RPS;
    f32x2 w[4][4], bias[4], hst[3][4];
#pragma unroll
    for (int k = 0; k < 4; ++k) { const f32x4 a = *(const f32x4*)(cw + k * 1024 + cch0 + c8 * 8), b = *(const f32x4*)(cw + k * 1024 + cch0 + c8 * 8 + 4);
        w[k][0] = (f32x2){a[0], a[1]}; w[k][1] = (f32x2){a[2], a[3]}; w[k][2] = (f32x2){b[0], b[1]}; w[k][3] = (f32x2){b[2], b[3]}; }
    { const f32x4 a = *(const f32x4*)(cb + cch0 + c8 * 8), b = *(const f32x4*)(cb + cch0 + c8 * 8 + 4);
      bias[0] = (f32x2){a[0], a[1]}; bias[1] = (f32x2){a[2], a[3]}; bias[2] = (f32x2){b[0], b[1]}; bias[3] = (f32x2){b[2], b[3]}; }
#pragma unroll
    for (int k = 0; k < 3; ++k) { const v4u v = hv[k];
        hst[k][0] = (f32x2){bflo(v.x), bfhi(v.x)}; hst[k][1] = (f32x2){bflo(v.y), bfhi(v.y)}; hst[k][2] = (f32x2){bflo(v.z), bfhi(v.z)}; hst[k][3] = (f32x2){bflo(v.w), bfhi(v.w)}; }
    const LAS float* dts = (const LAS float*)(sl + SS_DTS); const LAS float* acum = (const LAS float*)(sl + SS_ACUM);
    const int hq = hq0 + (c8 * 8) / 64;
    const float alast = (FACMODE == 2) ? acum[hq * 128 + 127] : 0.f;
#pragma unroll
    for (int rr = 0; rr < RPS; ++rr) { const int l = l0 + rr; const v4u v = rv[rr];
        f32x2 cur[4]; cur[0] = (f32x2){bflo(v.x), bfhi(v.x)}; cur[1] = (f32x2){bflo(v.y), bfhi(v.y)}; cur[2] = (f32x2){bflo(v.z), bfhi(v.z)}; cur[3] = (f32x2){bflo(v.w), bfhi(v.w)};
        float f = 1.f; if (FACMODE >= 1) f = dts[hq * 128 + l]; if (FACMODE == 2) f *= __builtin_amdgcn_exp2f(alast - acum[hq * 128 + l]);
        unsigned ow[4];
#pragma unroll
        for (int e = 0; e < 4; ++e) { const f32x2 a = bias[e] + w[0][e] * hst[0][e] + w[1][e] * hst[1][e] + w[2][e] * hst[2][e] + w[3][e] * cur[e];
            const f32x2 t = a * -1.4426950408889634f; f32x2 d; d.x = __builtin_amdgcn_exp2f(t.x); d.y = __builtin_amdgcn_exp2f(t.y); d = d + 1.0f;
            f32x2 r; r.x = __builtin_amdgcn_rcpf(d.x); r.y = __builtin_amdgcn_rcpf(d.y);
            const f32x2 o = (a * f) * r;
            ow[e] = pk2(o.x, o.y);
            hst[0][e] = hst[1][e]; hst[1][e] = hst[2][e]; hst[2][e] = cur[e]; }
        *(LAS v4u*)(dst + l * pitch + c8 * 16) = (v4u){ow[0], ow[1], ow[2], ow[3]}; }
}
__device__ __forceinline__ void ssd_s1_unit(LAS unsigned char* sl, const bf16* PROJ, const float* DT, const float* dtb, const float* alog, const float* cw, const float* cb, float* ST, float* CDEC, int un, int tid, int lane, int wave) {
    const int g = un & 1, bc = un >> 1; const size_t row0 = (size_t)bc * 128; const int t0 = (bc & 31) * 128;
    v4u hvB[3], rvB[4], hvX[3], rvX[8];
    conv_load<128>(PROJ, row0, t0, C_XS + 512 + g * 128, tid, hvB, rvB);
    conv_load<256>(PROJ, row0, t0, C_XS + g * 256, tid, hvX, rvX);
    __syncthreads();
    ssd_prep(sl, DT, dtb, alog, row0, g, tid, lane, wave);
    conv_apply<128, 0>(hvB, rvB, cw, cb, 512 + g * 128, sl + S1_B, S1_PB, sl, 0, tid);
    conv_apply<256, 2>(hvX, rvX, cw, cb, g * 256, sl + S1_X, S1_PX, sl, 0, tid);
    if (tid < 4) CDEC[(size_t)bc * 8 + 4 * g + tid] = __builtin_amdgcn_exp2f(((const LAS float*)(sl + SS_ACUM))[tid * 128 + 127]);
    __syncthreads();
    const int hq = wave >> 1, pt = wave & 1, h2 = lane >> 5, q = (lane & 15) >> 2, pp = lane & 3, dsel = (lane >> 4) & 1;
    const LAS unsigned char* xb = sl + S1_X + (8 * h2 + q) * S1_PX + (hq * 64 + pt * 32 + 16 * dsel + 4 * pp) * 2;
    const LAS unsigned char* bb = sl + S1_B + (8 * h2 + q) * S1_PB + (16 * dsel + 4 * pp) * 2;
    f32x16 acc[4];
#pragma unroll
    for (int nt = 0; nt < 4; ++nt) acc[nt] = (f32x16){};
#pragma unroll
    for (int ks = 0; ks < 8; ++ks) { const bf16x8 a = tr_pair(xb + (16 * ks) * S1_PX, xb + (16 * ks + 4) * S1_PX);
#pragma unroll
        for (int nt = 0; nt < 4; ++nt) { const bf16x8 b = tr_pair(bb + (16 * ks) * S1_PB + nt * 64, bb + (16 * ks + 4) * S1_PB + nt * 64); acc[nt] = __builtin_amdgcn_mfma_f32_32x32x16_bf16(a, b, acc[nt], 0, 0, 0); } }
    const int qi = lane & 3;
    float* sp = ST + ((size_t)(bc * 8 + 4 * g + hq) * 64 + pt * 32 + 4 * h2 + qi) * 128 + (lane & 28);
#pragma unroll
    for (int nt = 0; nt < 4; ++nt)
#pragma unroll
        for (int g4 = 0; g4 < 4; ++g4) {
            float a0 = acc[nt][4 * g4 + 0], a1 = acc[nt][4 * g4 + 1], a2 = acc[nt][4 * g4 + 2], a3 = acc[nt][4 * g4 + 3];
            { const bool od = (qi & 1) != 0;
              const float t01 = od ? a0 : a1, t23 = od ? a2 : a3;
              const float r01 = __builtin_bit_cast(float, __builtin_amdgcn_mov_dpp(__builtin_bit_cast(int, t01), 0xB1, 0xf, 0xf, true));
              const float r23 = __builtin_bit_cast(float, __builtin_amdgcn_mov_dpp(__builtin_bit_cast(int, t23), 0xB1, 0xf, 0xf, true));
              if (od) { a0 = r01; a2 = r23; } else { a1 = r01; a3 = r23; } }
            { const bool up = (qi & 2) != 0;
              const float t02 = up ? a0 : a2, t13 = up ? a1 : a3;
              const float r02 = __builtin_bit_cast(float, __builtin_amdgcn_mov_dpp(__builtin_bit_cast(int, t02), 0x4E, 0xf, 0xf, true));
              const float r13 = __builtin_bit_cast(float, __builtin_amdgcn_mov_dpp(__builtin_bit_cast(int, t13), 0x4E, 0xf, 0xf, true));
              if (up) { a0 = r02; a1 = r13; } else { a2 = r02; a3 = r13; } }
            *(f32x4*)(sp + (size_t)(8 * g4) * 128 + 32 * nt) = (f32x4){a0, a1, a2, a3}; }
}
__device__ __forceinline__ void ssd_s3_unit(LAS unsigned char* sl, const bf16* PROJ, const float* DT, const float* dtb, const float* alog, const float* cw, const float* cb, const float* dsk, const float* ng,
                                            const bf16* HIN, bf16* MIXED, int un, int tid, int lane, int wave) {
    const int g = un & 1, bc = un >> 1; const size_t row0 = (size_t)bc * 128; const int t0 = (bc & 31) * 128;
    const int lt = wave & 3, ph = wave >> 2, lq = lane & 31, hi = lane >> 5, q = (lane & 15) >> 2, pp = lane & 3, dsel = (lane >> 4) & 1;
    const int lrow = 32 * lt + lq;
    const size_t grow = row0 + lrow;
    v4u hvB[3], rvB[4], hvC[3], rvC[4], hvX[3], rvX[8];
    conv_load<128>(PROJ, row0, t0, C_XS + 512 + g * 128, tid, hvB, rvB);
    conv_load<128>(PROJ, row0, t0, C_XS + 768 + g * 128, tid, hvC, rvC);
    conv_load<256>(PROJ, row0, t0, C_XS + g * 256, tid, hvX, rvX);
    __syncthreads();
    ssd_prep(sl, DT, dtb, alog, row0, g, tid, lane, wave);
    conv_apply<128, 0>(hvB, rvB, cw, cb, 512 + g * 128, sl + S3_B, S3_PBC, sl, 0, tid);
    conv_apply<128, 0>(hvC, rvC, cw, cb, 768 + g * 128, sl + S3_C, S3_PBC, sl, 0, tid);
    conv_apply<256, 1>(hvX, rvX, cw, cb, g * 256, sl + S3_X, S3_PX, sl, 0, tid);
    bf16x8 hf[2][8];
    const bf16* hp0 = HIN + ((size_t)(bc * 8 + 4 * g) * 64 + ph * 32 + lq) * 128 + 8 * hi;
#pragma unroll
    for (int hq = 0; hq < 2; ++hq)
#pragma unroll
        for (int ks = 0; ks < 8; ++ks) hf[hq][ks] = *(const bf16x8*)(hp0 + (size_t)hq * 8192 + 16 * ks);
    __syncthreads();
    const LAS float* dts = (const LAS float*)(sl + SS_DTS); const LAS float* acum = (const LAS float*)(sl + SS_ACUM); LAS float* ssx = (LAS float*)(sl + SS_SSX);
    const LAS unsigned char* crd = sl + S3_C + lrow * S3_PBC + 16 * hi;
    f32x16 y[4];
#pragma unroll
    for (int hq = 0; hq < 2; ++hq) {
        f32x16 t = (f32x16){};
#pragma unroll
        for (int ks = 0; ks < 8; ++ks) t = __builtin_amdgcn_mfma_f32_32x32x16_bf16(hf[hq & 1][ks], *(const LAS bf16x8*)(crd + 32 * ks), t, 0, 0, 0);
#pragma unroll
        for (int ks = 0; ks < 8; ++ks) hf[hq & 1][ks] = *(const bf16x8*)(hp0 + (size_t)(hq + 2) * 8192 + 16 * ks);
        const float ea = __builtin_amdgcn_exp2f(acum[hq * 128 + lrow]);
#pragma unroll
        for (int rg = 0; rg < 16; ++rg) t[rg] *= ea;
        y[hq] = t; }
#pragma unroll
    for (int st = 0; st < 4; ++st) if (st <= lt) {
        f32x16 ag = (f32x16){};
        { const LAS unsigned char* brd = sl + S3_B + (32 * st + lq) * S3_PBC + 16 * hi;
#pragma unroll
          for (int ks = 0; ks < 8; ++ks) ag = __builtin_amdgcn_mfma_f32_32x32x16_bf16(*(const LAS bf16x8*)(brd + 32 * ks), *(const LAS bf16x8*)(crd + 32 * ks), ag, 0, 0, 0); }
#pragma unroll
        for (int hq = 0; hq < 4; ++hq) {
            const float al = acum[hq * 128 + lrow], dd = dsk[4 * g + hq] * __builtin_amdgcn_rcpf(dts[hq * 128 + lrow]);
            const LAS unsigned char* xb = sl + S3_X + (4 * hi + q) * S3_PX + (hq * 64 + ph * 32 + 16 * dsel + 4 * pp) * 2;
            float pm[16];
#pragma unroll
            for (int g4 = 0; g4 < 4; ++g4) { const f32x4 as4 = *(const LAS f32x4*)(acum + hq * 128 + 32 * st + 8 * g4 + 4 * hi);
#pragma unroll
                for (int e = 0; e < 4; ++e) { const int rg = 4 * g4 + e; pm[rg] = ag[rg] * __builtin_amdgcn_exp2f(al - as4[e]); } }
            if (st == lt) { asm volatile("; diagonal tile");
#pragma unroll
                for (int rg = 0; rg < 16; ++rg) { const int sl_ = 8 * (rg >> 2) + 4 * hi + (rg & 3); pm[rg] = (sl_ > lq) ? 0.f : ((sl_ == lq) ? pm[rg] + dd : pm[rg]); } }
#pragma unroll
            for (int ks = 0; ks < 2; ++ks) { v4u wv; wv.x = pg8::cvt_pk_bf16(pm[8 * ks + 0], pm[8 * ks + 1]); wv.y = pg8::cvt_pk_bf16(pm[8 * ks + 2], pm[8 * ks + 3]); wv.z = pg8::cvt_pk_bf16(pm[8 * ks + 4], pm[8 * ks + 5]); wv.w = pg8::cvt_pk_bf16(pm[8 * ks + 6], pm[8 * ks + 7]);
                const bf16x8 xt = tr_pair(xb + (32 * st + 16 * ks) * S3_PX, xb + (32 * st + 16 * ks + 8) * S3_PX);
                y[hq] = __builtin_amdgcn_mfma_f32_32x32x16_bf16(xt, __builtin_bit_cast(bf16x8, wv), (hq >= 2 && st == 0 && ks == 0) ? (f32x16){} : y[hq], 0, 0, 0); }
        }
    }
    v2u zr[4][4];
#pragma unroll
    for (int hq = 0; hq < 4; ++hq)
#pragma unroll
        for (int g4 = 0; g4 < 4; ++g4) zr[hq][g4] = *(const v2u*)(PROJ + grow * NPROJ + C_Z + g * 256 + hq * 64 + ph * 32 + 8 * g4 + 4 * hi);
#pragma unroll
    for (int hq = 2; hq < 4; ++hq) {
        f32x16 t = (f32x16){};
#pragma unroll
        for (int ks = 0; ks < 8; ++ks) t = __builtin_amdgcn_mfma_f32_32x32x16_bf16(hf[hq & 1][ks], *(const LAS bf16x8*)(crd + 32 * ks), t, 0, 0, 0);
        const float ea = __builtin_amdgcn_exp2f(acum[hq * 128 + lrow]);
#pragma unroll
        for (int rg = 0; rg < 16; ++rg) y[hq][rg] += t[rg] * ea; }
    unsigned ayp[4][8]; float ss = 0.f;
#pragma unroll
    for (int hq = 0; hq < 4; ++hq)
#pragma unroll
        for (int g4 = 0; g4 < 4; ++g4) { const v2u z = zr[hq][g4];
            const float y0 = y[hq][4 * g4 + 0] * siluf(bflo(z.x)), y1 = y[hq][4 * g4 + 1] * siluf(bfhi(z.x)), y2 = y[hq][4 * g4 + 2] * siluf(bflo(z.y)), y3 = y[hq][4 * g4 + 3] * siluf(bfhi(z.y));
            ss += (y0 * y0 + y1 * y1) + (y2 * y2 + y3 * y3);
            ayp[hq][2 * g4] = pg8::cvt_pk_bf16(y0, y1); ayp[hq][2 * g4 + 1] = pg8::cvt_pk_bf16(y2, y3); }
    ss += __shfl_xor(ss, 32);
    if (hi == 0) ssx[ph * 128 + lrow] = ss;
    __syncthreads();
    const float rs = 1.0f / sqrtf((ssx[lrow] + ssx[128 + lrow]) * (1.f / 256.f) + RMS_EPS);
#pragma unroll
    for (int hq = 0; hq < 4; ++hq)
#pragma unroll
        for (int g4 = 0; g4 < 4; ++g4) { const int ch = hq * 64 + ph * 32 + 8 * g4 + 4 * hi; const f32x4 gn = *(const f32x4*)(ng + g * 256 + ch);
            const unsigned p0 = ayp[hq][2 * g4], p1 = ayp[hq][2 * g4 + 1];
            v2u o; o.x = pg8::cvt_pk_bf16(bflo(p0) * rs * gn[0], bfhi(p0) * rs * gn[1]); o.y = pg8::cvt_pk_bf16(bflo(p1) * rs * gn[2], bfhi(p1) * rs * gn[3]);
            *(v2u*)(MIXED + grow * MIXW + 512 + g * 256 + ch) = o; }
}

struct Args { const float* in[20]; float* out; unsigned char* ws; int ph_lo, ph_hi, sub, pad; };
constexpr int NWAVES = 8;
constexpr int PH_PER_LAYER = 10, N_PHASES = 1 + NLAYER * PH_PER_LAYER;

#define in_x (args.in[0])
#define in_win (args.in[1])
#define in_convw (args.in[2])
#define in_convb (args.in[3])
#define in_dtb (args.in[4])
#define in_alog (args.in[5])
#define in_dsk (args.in[6])
#define in_ng (args.in[7])
#define in_scw (args.in[8])
#define in_wout (args.in[9])
#define in_ln1g (args.in[10])
#define in_ln1b (args.in[11])
#define in_rw (args.in[12])
#define in_rb (args.in[13])
#define in_wgu (args.in[14])
#define in_bgu (args.in[15])
#define in_wdn (args.in[16])
#define in_bdn (args.in[17])
#define in_ln2g (args.in[18])
#define in_ln2b (args.in[19])
#define ROPE ((float*)(args.ws + WS_ROPE))
#define WDT ((float*)(args.ws + WS_WDT))
#define ROUT ((bf16*)(args.ws + WS_ROUT))
#define WIN ((bf16*)(args.ws + WS_WIN))
#define WOUT ((bf16*)(args.ws + WS_WOUT))
#define WGU ((bf16*)(args.ws + WS_WGU))
#define WDN ((bf16*)(args.ws + WS_WDN))
#define XB ((bf16*)(args.ws + WS_XB))
#define XF ((float*)(args.ws + WS_XF))
#define XF2 ((float*)(args.ws + WS_XF2))
#define PROJ ((bf16*)(args.ws + WS_PROJ))
#define DT ((float*)(args.ws + WS_DT))
#define DTS ((float*)(args.ws + WS_DTS))
#define ACUM ((float*)(args.ws + WS_ACUM))
#define LSE ((float*)(args.ws + WS_LSE))
#define OP ((bf16*)(args.ws + WS_OP))
#define U ((bf16*)(args.ws + WS_U))
#define GB ((float*)(args.ws + WS_G))
#define ST ((float*)(args.ws + WS_ST))
#define YD ((float*)(args.ws + WS_YD))
#define MIXED ((bf16*)(args.ws + WS_MIXED))
#define MIXF ((bf16*)(args.ws + WS_MIXF))
#define TOPE ((int*)(args.ws + WS_TOPE))
#define TOPG ((float*)(args.ws + WS_TOPG))
#define ROWTOK ((int*)(args.ws + WS_ROWTOK))
#define ROWGATE ((float*)(args.ws + WS_ROWGATE))
#define HB ((bf16*)(args.ws + WS_H))
#define YB ((bf16*)(args.ws + WS_YB))
#define HIN ((bf16*)(args.ws + WS_G))
#define WGU8 ((unsigned char*)(args.ws + WS_WGU))
#define WDN8 ((unsigned char*)(args.ws + WS_WDN))
#define XB8 ((unsigned char*)(args.ws + WS_U))
#define H8 ((unsigned char*)(args.ws + WS_H))
#define YB8 ((unsigned char*)(args.ws + WS_YB))
#define WIN8 ((unsigned char*)(args.ws + WS_WGU + 128 * MiB))
#define XP8 ((unsigned char*)(args.ws + WS_WGU + 132 * MiB))
#define CDEC ((float*)(args.ws + WS_ACUM))
template <int layer>
__device__ __forceinline__ void run_layer(const Args& args, int lo, int hi, const XcdBarrier& bar) {
    extern __shared__ __attribute__((aligned(16))) unsigned char lds[];
    LAS unsigned char* ldsp = (LAS unsigned char*)lds;
    const int tid = threadIdx.x, lane = tid & 63, wave = __builtin_amdgcn_readfirstlane(tid >> 6);
    const int G = gridDim.x, bid = blockIdx.x;
    const int gw = bid * NWAVES + wave, NGW = G * NWAVES;
    gu32* ctl = (gu32*)(args.ws + WS_CTL);

#define IN(k) (lo <= (k) && (k) < hi)
#define SEAM(k) do { if (IN(k) && IN((k) + 1)) xcd_barrier(bar); } while (0)

        const int pb = 1 + layer * PH_PER_LAYER;
        const bf16* WINl = WIN + (size_t)layer * NPROJ * DM; const bf16* WOUTl = WOUT + (size_t)layer * DM * MIXW;
        const unsigned char* WGUl = WGU8 + (size_t)layer * NEXP * 2048 * DM; const unsigned char* WDNl = WDN8 + (size_t)layer * NEXP * DM * FF;
        gu32* gcnt = ctl + CW_CNT + 64 * layer;

        if (IN(pb + 0)) {
            {
              pg8::Gemm g{(const pg8::bf16_t*)XP8, (const pg8::bf16_t*)(WIN8 + (size_t)layer * 1536 * DM), MROWS, 1536, DM / 2}; pg8::StaticOrder S; S.init(MROWS, 1536, G, bid);
              pg8::EpiProj E{PROJ, NPROJ, ROPE, QSCALE, 1.0f / (SC_X * SC_WIN), 0};
              pg8::gemm_phase<pg8::EpiProj, pg8::StaticOrder, true, false, true>(ldsp + RING_OFF, g, S, E); }
            __syncthreads();
            { pg8::Gemm g{XB, WINl + (size_t)1536 * DM, MROWS, NPROJ - 1536, DM}; pg8::StaticOrder S; S.init(MROWS, NPROJ - 1536, G, bid);
              pg8::EpiProj E{PROJ, NPROJ, ROPE, QSCALE, 1.0f, 6};
              pg8::gemm_phase<pg8::EpiProj, pg8::StaticOrder, true, false>(ldsp + RING_OFF, g, S, E); }
        }
        SEAM(pb + 0);
        if (IN(pb + 1)) {
            if (args.sub & 1) attn_phase(ldsp + RING_OFF, PROJ, OP, LSE, bid, G, tid, wave, lane);
            if (args.sub & 2) { const float* cw = in_convw + (size_t)layer * 4 * 1024; const float* cb = in_convb + (size_t)layer * 1024;
              for (int un = bid; un < 512; un += G)
                  ssd_s1_unit(ldsp + RING_OFF, PROJ, DT, in_dtb + layer * 8, in_alog + layer * 8, cw, cb, ST, CDEC, un, tid, lane, wave);
              __syncthreads(); }
            const float* sw = in_scw + (size_t)layer * 3 * 512;
            if (args.sub & 4) {
                const int ch = (tid & 63) * 8;
                f32x4 wk[3][2];
#pragma unroll
                for (int k = 0; k < 3; ++k) { wk[k][0] = *(const f32x4*)(sw + k * 512 + ch); wk[k][1] = *(const f32x4*)(sw + k * 512 + ch + 4); }
#pragma unroll 1
                for (int it = bid * (NWAVES * 64) + tid; it < (MROWS / 4) * 64; it += G * (NWAVES * 64)) { const int row0 = (it >> 6) * 4; const bool head = (row0 & (SEQ - 1)) == 0;
                    v4u cc[6], hh[6], bb[4];
#pragma unroll
                    for (int i = 0; i < 6; ++i) { cc[i] = (v4u){0u, 0u, 0u, 0u}; hh[i] = cc[i];
                        if (i >= 2 || !head) { const bf16* pr = PROJ + (size_t)(row0 - 2 + i) * NPROJ; cc[i] = *(const v4u*)(pr + C_SC + ch); hh[i] = *(const v4u*)(pr + C_SH + ch); } }
#pragma unroll
                    for (int r = 0; r < 4; ++r) bb[r] = *(const v4u*)(PROJ + (size_t)(row0 + r) * NPROJ + C_SB + ch);
                    float p[6][8];
#pragma unroll
                    for (int i = 0; i < 6; ++i) { p[i][0] = bflo(cc[i].x) * bflo(hh[i].x); p[i][1] = bfhi(cc[i].x) * bfhi(hh[i].x); p[i][2] = bflo(cc[i].y) * bflo(hh[i].y); p[i][3] = bfhi(cc[i].y) * bfhi(hh[i].y);
                        p[i][4] = bflo(cc[i].z) * bflo(hh[i].z); p[i][5] = bfhi(cc[i].z) * bfhi(hh[i].z); p[i][6] = bflo(cc[i].w) * bflo(hh[i].w); p[i][7] = bfhi(cc[i].w) * bfhi(hh[i].w); }
#pragma unroll
                    for (int r = 0; r < 4; ++r) { float a[8];
#pragma unroll
                        for (int q = 0; q < 8; ++q) a[q] = wk[0][q >> 2][q & 3] * p[r][q] + wk[1][q >> 2][q & 3] * p[r + 1][q] + wk[2][q >> 2][q & 3] * p[r + 2][q];
                        const v4u b4 = bb[r];
                        v4u o; o.x = pk2(a[0] * bflo(b4.x), a[1] * bfhi(b4.x)); o.y = pk2(a[2] * bflo(b4.y), a[3] * bfhi(b4.y)); o.z = pk2(a[4] * bflo(b4.z), a[5] * bfhi(b4.z)); o.w = pk2(a[6] * bflo(b4.w), a[7] * bfhi(b4.w));
                        *(v4u*)(MIXED + (size_t)(row0 + r) * MIXW + 1024 + ch) = o; } }
            }
        }
        SEAM(pb + 1);
        if (IN(pb + 2)) {
            for (int it = bid * (NWAVES * 64) + tid; it < (int)(64L * 2048); it += G * (NWAVES * 64)) { const int pn4 = (int)(it & 2047), bh = (int)(it >> 11); const int h = bh & 7, b = bh >> 3; f32x4 hc = (f32x4){0.f, 0.f, 0.f, 0.f};
#pragma unroll 16
                for (int c = 0; c < 32; ++c) { const size_t idx = ((size_t)((b * 32 + c) * 8 + h)) * 8192 + pn4 * 4; const f32x4 st = __builtin_nontemporal_load((const f32x4*)(ST + idx));
                    v2u o; o.x = pk2(hc[0], hc[1]); o.y = pk2(hc[2], hc[3]); *(v2u*)(HIN + idx) = o;
                    hc = hc * CDEC[(size_t)(b * 32 + c) * 8 + h] + st; } }
        }
        SEAM(pb + 2);
        if (IN(pb + 3)) {
            if (args.sub & 1) { const float* cw = in_convw + (size_t)layer * 4 * 1024; const float* cb = in_convb + (size_t)layer * 1024;
              for (int un = bid; un < 512; un += G)
                  ssd_s3_unit(ldsp + RING_OFF, PROJ, DT, in_dtb + layer * 8, in_alog + layer * 8, cw, cb, in_dsk + layer * 8, in_ng + (size_t)layer * 512, HIN, MIXED, un, tid, lane, wave);
              __syncthreads(); }
            if (args.sub & 2)
#pragma unroll 2
            for (int it = bid * (NWAVES * 64) + tid; it < (int)((long)MROWS * 32); it += G * (NWAVES * 64)) { const int c16 = (int)(it & 31), row = (int)(it >> 5); const int h = c16 >> 2;
                const float l0 = LSE[((size_t)0 * MROWS + row) * 8 + h], l1 = LSE[((size_t)1 * MROWS + row) * 8 + h], l2 = LSE[((size_t)2 * MROWS + row) * 8 + h];
                const float mm = fmaxf(l0, fmaxf(l1, l2)); float w0 = exp2f(l0 - mm), w1 = exp2f(l1 - mm), w2 = exp2f(l2 - mm); const float iw = (1.0f / SC_O) / (w0 + w1 + w2); w0 *= iw; w1 *= iw; w2 *= iw;
                const unsigned char* OP8 = (const unsigned char*)OP; typedef float f32x2_ __attribute__((ext_vector_type(2)));
                const v4u a0 = __builtin_nontemporal_load((const v4u*)(OP8 + ((size_t)0 * MROWS + row) * 512 + c16 * 16)), a1 = __builtin_nontemporal_load((const v4u*)(OP8 + ((size_t)1 * MROWS + row) * 512 + c16 * 16)), a2 = __builtin_nontemporal_load((const v4u*)(OP8 + ((size_t)2 * MROWS + row) * 512 + c16 * 16));
                unsigned ow[8];
#pragma unroll
                for (int q = 0; q < 4; ++q) {
                    { const f32x2_ p0 = __builtin_amdgcn_cvt_pk_f32_fp8(a0[q], false), p1 = __builtin_amdgcn_cvt_pk_f32_fp8(a1[q], false), p2 = __builtin_amdgcn_cvt_pk_f32_fp8(a2[q], false); ow[2 * q] = pk2(w0 * p0[0] + w1 * p1[0] + w2 * p2[0], w0 * p0[1] + w1 * p1[1] + w2 * p2[1]); }
                    { const f32x2_ p0 = __builtin_amdgcn_cvt_pk_f32_fp8(a0[q], true), p1 = __builtin_amdgcn_cvt_pk_f32_fp8(a1[q], true), p2 = __builtin_amdgcn_cvt_pk_f32_fp8(a2[q], true); ow[2 * q + 1] = pk2(w0 * p0[0] + w1 * p1[0] + w2 * p2[0], w0 * p0[1] + w1 * p1[1] + w2 * p2[1]); } }
                bf16* op_ = MIXED + (size_t)row * MIXW + c16 * 16;
                *(v4u*)op_ = (v4u){ow[0], ow[1], ow[2], ow[3]}; *(v4u*)(op_ + 8) = (v4u){ow[4], ow[5], ow[6], ow[7]}; }
        }
        SEAM(pb + 3);
        if (IN(pb + 4)) {
#define FUSED_LN1_CALL(BASE, LIM) { pg8::Gemm g{MIXED, WOUTl, MROWS, DM, MIXW}; \
              pg8::EpiLn1 E{args.ws, in_ln1g + (size_t)layer * DM, in_ln1b + (size_t)layer * DM, WS_XB, WS_U, (layer ? WS_ROPE : WS_DTS), WS_CTL + (size_t)(CW_SEAM + layer * 8192) * 4, WS_CTL + (size_t)CW_TMO * 4, ALPHA, SC_X, LN_EPS, 0x700u + (unsigned)layer * 0x80u}; \
              pg8::StaticOrder S; S.init(MROWS, DM, G, bid); S.base = (BASE); S.lim = (LIM); \
              pg8::gemm_phase<pg8::EpiLn1, pg8::StaticOrder, false, false>(ldsp + RING_OFF, g, S, E); }
            FUSED_LN1_CALL(0, 256)
            __syncthreads();
            FUSED_LN1_CALL(256, 512)
            __syncthreads();
#undef FUSED_LN1_CALL
        }
        SEAM(pb + 4);
        if (IN(pb + 6)) {
            LAS int* lcnt = (LAS int*)(ldsp + L_LCNT); LAS int* lbase = (LAS int*)(ldsp + L_LBASE);
            const bf16* RT = ROUT + (size_t)layer * NEXP * DM; const float* rb = in_rb + (size_t)layer * NEXP;
            for (int blk = bid; blk < MROWS / 128; blk += G) {
                if (tid < 32) lcnt[tid] = 0;
                __syncthreads();
                const int r32 = lane & 31, hi = lane >> 5; const int row = blk * 128 + (wave & 3) * 32 + r32;
                float tv[4]; int te[4]; int lrank[4]; float gate[4];
                f32x16 acc = {};
                { const int kh = wave >> 2;
                  const bf16* ap = RT + (size_t)r32 * DM + 8 * hi + 512 * kh; const bf16* bp = XB + (size_t)row * DM + 8 * hi + 512 * kh;
#pragma unroll 16
                  for (int s = 0; s < 32; ++s) { const bf16x8 a = *(const bf16x8*)(ap + 16 * s), b = *(const bf16x8*)(bp + 16 * s); acc = __builtin_amdgcn_mfma_f32_32x32x16_bf16(a, b, acc, 0, 0, 0); }
                  LAS float* part = (LAS float*)(ldsp + RING_OFF) + (wave & 3) * 1024;
                  if (kh) {
#pragma unroll
                      for (int i = 0; i < 16; ++i) part[i * 64 + lane] = acc[i]; }
                  __syncthreads();
                  if (!kh) {
#pragma unroll
                      for (int i = 0; i < 16; ++i) acc[i] += part[i * 64 + lane]; } }
                if (wave < 4) {
#pragma unroll
                    for (int k = 0; k < 4; ++k) { tv[k] = -INFINITY; te[k] = 1 << 20; }
#pragma unroll
                    for (int i = 0; i < 16; ++i) { const int e = (i & 3) + 8 * (i >> 2) + 4 * hi; float v = acc[i] + rb[e]; int ve = e;
#pragma unroll
                        for (int k = 0; k < 4; ++k) { const bool gt = (v > tv[k]) || (v == tv[k] && ve < te[k]); const float nv = gt ? tv[k] : v; const int ne = gt ? te[k] : ve; tv[k] = gt ? v : tv[k]; te[k] = gt ? ve : te[k]; v = nv; ve = ne; } }
                    float pv[4]; int pe[4];
#pragma unroll
                    for (int k = 0; k < 4; ++k) { pv[k] = __shfl_xor(tv[k], 32); pe[k] = __shfl_xor(te[k], 32); }
#pragma unroll
                    for (int j = 0; j < 4; ++j) { float v = pv[j]; int ve = pe[j];
#pragma unroll
                        for (int k = 0; k < 4; ++k) { const bool gt = (v > tv[k]) || (v == tv[k] && ve < te[k]); const float nv = gt ? tv[k] : v; const int ne = gt ? te[k] : ve; tv[k] = gt ? v : tv[k]; te[k] = gt ? ve : te[k]; v = nv; ve = ne; } }
                    float se = 0.f;
#pragma unroll
                    for (int k = 0; k < 4; ++k) { gate[k] = __expf(tv[k] - tv[0]); se += gate[k]; }
                    const float ise = 1.0f / se;
#pragma unroll
                    for (int k = 0; k < 4; ++k) gate[k] *= ise;
                    if (hi == 0) {
#pragma unroll
                        for (int k = 0; k < 4; ++k) lrank[k] = __hip_atomic_fetch_add(lcnt + te[k], 1, __ATOMIC_RELAXED, __HIP_MEMORY_SCOPE_WORKGROUP);
                    }
                }
                __syncthreads();
                if (tid < 32) lbase[tid] = (int)__hip_atomic_fetch_add(gcnt + tid, (unsigned)lcnt[tid], RLX_AGENT);
                __syncthreads();
                if (wave < 4 && hi == 0) {
#pragma unroll
                    for (int k = 0; k < 4; ++k) { const int r = lbase[te[k]] + lrank[k]; const size_t o = (size_t)te[k] * 32768 + r;
                        ROWTOK[o] = row * 4 + k; ROWGATE[o] = gate[k]; }
                }
                __syncthreads();
            }
        }
        SEAM(pb + 6);
        if (IN(pb + 7) || IN(pb + 8)) {
            LAS int* tstart = (LAS int*)(ldsp + L_TSTART); LAS int* cntL = (LAS int*)(ldsp + L_CNT); LAS int* units = (LAS int*)(ldsp + L_UNITS); LAS int* unitsn = (LAS int*)(ldsp + L_UNITSN);
            if (tid < 64) {
                const int c = (tid < 32) ? (int)__hip_atomic_load(gcnt + tid, RLX_AGENT) : 0; const int t = (c + 255) >> 8; int incl = t;
#pragma unroll
                for (int d = 1; d < 32; d <<= 1) { const int v = __shfl_up(incl, d); if (tid >= d) incl += v; }
                if (tid < 32) { cntL[tid] = c; tstart[tid] = incl - t; }
                if (tid == 31) tstart[32] = incl; }
            __syncthreads();
            if (IN(pb + 7)) {
                pg8::moe_build_units(units, unitsn, tstart, 8, G, bid, tid);
                __syncthreads();
                pg8::Gemm g{(const pg8::bf16_t*)XB8, (const pg8::bf16_t*)WGUl, 0, 2048, DM / 2};
                pg8::MoeOrder S{units, __builtin_amdgcn_readfirstlane(unitsn[0]), cntL, ROWTOK, 1, (unsigned)DM, (size_t)2048 * DM, ROWGATE, in_bgu + (size_t)layer * NEXP * 2048};
                pg8::EpiSwiglu E{H8, in_bgu + (size_t)layer * NEXP * 2048, ROWGATE, cntL, 1.0f / (SC_X * SC_WGU), SC_H};
                pg8::gemm_phase<pg8::EpiSwiglu, pg8::MoeOrder, true, true, true>(ldsp + RING_OFF, g, S, E);
                __syncthreads();
            }
            SEAM(pb + 7);
            if (IN(pb + 8)) {
                pg8::moe_build_units(units, unitsn, tstart, 4, G, bid, tid);
                __syncthreads();
                pg8::Gemm g{(const pg8::bf16_t*)H8, (const pg8::bf16_t*)WDNl, 0, DM, FF / 2};
                pg8::MoeOrder S{units, __builtin_amdgcn_readfirstlane(unitsn[0]), cntL, ROWTOK, 0, (unsigned)FF, (size_t)DM * FF, ROWGATE, in_bdn + (size_t)layer * NEXP * DM};
                pg8::EpiScatter E{YB8, ROWTOK, cntL, SC_Y / (SC_H * SC_WDN), SC_Y};
                pg8::gemm_phase<pg8::EpiScatter, pg8::MoeOrder, true, false, true, true>(ldsp + RING_OFF, g, S, E);
                __syncthreads();
            }
        }
        SEAM(pb + 8);
        if (IN(pb + 9)) {
            constexpr bool NEXT = (layer + 1 < NLAYER);
            int lane; asm volatile("v_mbcnt_lo_u32_b32 %0, -1, 0\n\tv_mbcnt_hi_u32_b32 %0, -1, %0" : "=v"(lane));
            const float* gam = in_ln2g + (size_t)layer * DM; const float* bet = in_ln2b + (size_t)layer * DM;
            f32x4 gq[4], bq[4], wq[8][4];
#pragma unroll
            for (int q = 0; q < 4; ++q) { gq[q] = *(const f32x4*)(gam + 16 * lane + 4 * q); bq[q] = *(const f32x4*)(bet + 16 * lane + 4 * q); }
            if (NEXT) {
#pragma unroll
                for (int jj = 0; jj < 8; ++jj)
#pragma unroll
                    for (int q = 0; q < 4; ++q) wq[jj][q] = *(const f32x4*)(WDT + (size_t)(layer + 1) * 8 * 1024 + jj * 1024 + 16 * lane + 4 * q); }
            v4u nx0, nx1, ny[4];
            constexpr bool PF = !NEXT;
            if (PF && gw < MROWS) { nx0 = __builtin_nontemporal_load((const v4u*)(XB + (size_t)gw * DM + 16 * lane)); nx1 = __builtin_nontemporal_load((const v4u*)(XB + (size_t)gw * DM + 16 * lane + 8));
#pragma unroll
                for (int k = 0; k < 4; ++k) ny[k] = __builtin_nontemporal_load((const v4u*)(YB8 + ((size_t)gw * 4 + k) * DM + 16 * lane)); }
#pragma unroll 1
            for (int m = gw; m < MROWS; m += NGW) {
                if (!PF) { nx0 = __builtin_nontemporal_load((const v4u*)(XB + (size_t)m * DM + 16 * lane)); nx1 = __builtin_nontemporal_load((const v4u*)(XB + (size_t)m * DM + 16 * lane + 8));
#pragma unroll
                    for (int k = 0; k < 4; ++k) ny[k] = __builtin_nontemporal_load((const v4u*)(YB8 + ((size_t)m * 4 + k) * DM + 16 * lane)); }
                const v4u x0 = nx0, x1 = nx1; v4u yk[4];
#pragma unroll
                for (int k = 0; k < 4; ++k) yk[k] = ny[k];
                if (PF && m + NGW < MROWS) { const int mn = m + NGW; nx0 = __builtin_nontemporal_load((const v4u*)(XB + (size_t)mn * DM + 16 * lane)); nx1 = __builtin_nontemporal_load((const v4u*)(XB + (size_t)mn * DM + 16 * lane + 8));
#pragma unroll
                    for (int k = 0; k < 4; ++k) ny[k] = __builtin_nontemporal_load((const v4u*)(YB8 + ((size_t)mn * 4 + k) * DM + 16 * lane)); }
                f32x4 v[4];
                v[0] = (f32x4){bflo(x0.x), bfhi(x0.x), bflo(x0.y), bfhi(x0.y)} * ALPHA; v[1] = (f32x4){bflo(x0.z), bfhi(x0.z), bflo(x0.w), bfhi(x0.w)} * ALPHA;
                v[2] = (f32x4){bflo(x1.x), bfhi(x1.x), bflo(x1.y), bfhi(x1.y)} * ALPHA; v[3] = (f32x4){bflo(x1.z), bfhi(x1.z), bflo(x1.w), bfhi(x1.w)} * ALPHA;
#pragma unroll
                for (int k = 0; k < 4; ++k)
#pragma unroll
                    for (int q = 0; q < 4; ++q) { typedef float f32x2_ __attribute__((ext_vector_type(2)));
                        const f32x2_ lo = __builtin_amdgcn_cvt_pk_f32_fp8(yk[k][q], false), hi = __builtin_amdgcn_cvt_pk_f32_fp8(yk[k][q], true);
                        v[q][0] += lo[0] * (1.0f / SC_Y); v[q][1] += lo[1] * (1.0f / SC_Y); v[q][2] += hi[0] * (1.0f / SC_Y); v[q][3] += hi[1] * (1.0f / SC_Y); }
                float s = 0.f;
#pragma unroll
                for (int q = 0; q < 4; ++q) s += (v[q][0] + v[q][1]) + (v[q][2] + v[q][3]);
                const float mean = wave_sum(s) * (1.f / DM); float s2 = 0.f;
#pragma unroll
                for (int q = 0; q < 4; ++q) { v[q] = v[q] - mean; s2 += (v[q][0] * v[q][0] + v[q][1] * v[q][1]) + (v[q][2] * v[q][2] + v[q][3] * v[q][3]); }
                const float rstd = 1.f / sqrtf(wave_sum(s2) * (1.f / DM) + LN_EPS);
#pragma unroll
                for (int q = 0; q < 4; ++q) { v[q] = v[q] * rstd * gq[q] + bq[q];
                    if (!NEXT) *(f32x4*)(args.out + (size_t)m * DM + 16 * lane + 4 * q) = v[q]; }
                if (NEXT) {
                    v4u w0, w1; w0.x = pk2(v[0][0], v[0][1]); w0.y = pk2(v[0][2], v[0][3]); w0.z = pk2(v[1][0], v[1][1]); w0.w = pk2(v[1][2], v[1][3]);
                    w1.x = pk2(v[2][0], v[2][1]); w1.y = pk2(v[2][2], v[2][3]); w1.z = pk2(v[3][0], v[3][1]); w1.w = pk2(v[3][2], v[3][3]);
                    *(v4u*)(XB + (size_t)m * DM + 16 * lane) = w0; *(v4u*)(XB + (size_t)m * DM + 16 * lane + 8) = w1;
                    v4u w; w.x = pg8::pk4_fp8(v[0][0] * SC_X, v[0][1] * SC_X, v[0][2] * SC_X, v[0][3] * SC_X); w.y = pg8::pk4_fp8(v[1][0] * SC_X, v[1][1] * SC_X, v[1][2] * SC_X, v[1][3] * SC_X);
                    w.z = pg8::pk4_fp8(v[2][0] * SC_X, v[2][1] * SC_X, v[2][2] * SC_X, v[2][3] * SC_X); w.w = pg8::pk4_fp8(v[3][0] * SC_X, v[3][1] * SC_X, v[3][2] * SC_X, v[3][3] * SC_X);
                    *(v4u*)(XP8 + (size_t)m * DM + 16 * lane) = w;
                    float r[8];
#pragma unroll
                    for (int jj = 0; jj < 8; ++jj) { float sd = 0.f;
#pragma unroll
                        for (int q = 0; q < 4; ++q) sd += v[q][0] * wq[jj][q][0] + v[q][1] * wq[jj][q][1] + v[q][2] * wq[jj][q][2] + v[q][3] * wq[jj][q][3];
                        r[jj] = wave_sum(sd); }
                    if (lane == 0) { float* dst = DT + (size_t)m * 8; *(f32x4*)dst = (f32x4){r[0], r[1], r[2], r[3]}; *(f32x4*)(dst + 4) = (f32x4){r[4], r[5], r[6], r[7]}; } }
            }
        }
        SEAM(pb + 9);
    #undef IN
#undef SEAM
}

__global__ void __launch_bounds__(NWAVES * 64, 2) mk_fwd(Args args) {
    extern __shared__ __attribute__((aligned(16))) unsigned char lds[];
    LAS unsigned char* ldsp = (LAS unsigned char*)lds;
    const int tid = threadIdx.x, lane = tid & 63, wave = __builtin_amdgcn_readfirstlane(tid >> 6);
    const int G = gridDim.x, bid = blockIdx.x;
    const int gw = bid * NWAVES + wave, NGW = G * NWAVES;
    gu32* ctl = (gu32*)(args.ws + WS_CTL);

    for (int u = tid; u < (LDS_BYTES - LDSCTL_OFF) / 4; u += NWAVES * 64) ((LAS unsigned*)(ldsp + LDSCTL_OFF))[u] = 0u;
    __syncthreads();
    XcdBarrier bar = xcd_barrier_post((unsigned*)(ctl + CW_BAR), (volatile LAS unsigned*)(ldsp + L_MISC) + 8);

    const int lo = args.ph_lo, hi = args.ph_hi;
#define IN(k) (lo <= (k) && (k) < hi)
#define SEAM(k) do { if (IN(k) && IN((k) + 1)) xcd_barrier(bar); } while (0)

    if (IN(0)) {
        LAS float* scr = (LAS float*)(ldsp + RING_OFF + wave * 16384);
        constexpr int I_IN = 16 * 73, I_OUT = 24 * 16, I_R = 16;
        constexpr int NIT = NLAYER * (I_IN + I_OUT + I_R);
        for (int it = gw; it < NIT; it += NGW) {
            int r = it;
            if (r < NLAYER * I_IN) { const int l = r / I_IN; r %= I_IN; p0_transpose_item64<1>(in_win + (size_t)l * DM * INW, DM, INW, WIN + (size_t)l * NPROJ * DM, WDT + (size_t)l * 8 * 1024, scr, r / 73, r % 73, lane); continue; } r -= NLAYER * I_IN;
            if (r < NLAYER * I_OUT) { const int l = r / I_OUT; r %= I_OUT; p0_transpose_item64<0>(in_wout + (size_t)l * MIXW * DM, MIXW, DM, WOUT + (size_t)l * DM * MIXW, nullptr, scr, r / 16, r % 16, lane); continue; } r -= NLAYER * I_OUT;
            { const int l = r / I_R; r %= I_R; p0_transpose_item<0>(in_rw + (size_t)l * DM * NEXP, DM, NEXP, ROUT + (size_t)l * NEXP * DM, nullptr, scr, r, 0, lane); }
        }
        { constexpr int NIT8 = 64 * 256 + 64 * 128 + NLAYER * 192;
          const int nmine = (gw < NIT8) ? (NIT8 - gw + NGW - 1) / NGW : 0; const int J = 2 * nmine;
          f32x4 lda[16], ldb[16];
          if (J > 0) { const SubT t = fp8_subtile(gw, 0, in_wgu, in_wdn, in_win, WGU8, WDN8, WIN8, lane); fp8_sub_load(t, lda); }
#pragma unroll 1
          for (int j = 0; j < J; j += 2) {
              const int item = gw + (j >> 1) * NGW;
              const SubT t0 = fp8_subtile(item, 0, in_wgu, in_wdn, in_win, WGU8, WDN8, WIN8, lane), t1 = fp8_subtile(item, 1, in_wgu, in_wdn, in_win, WGU8, WDN8, WIN8, lane);
              fp8_sub_load(t1, ldb);
              fp8_sub_process(t0, lda, scr, lane);
              if (j + 2 < J) { const SubT t2 = fp8_subtile(item + NGW, 0, in_wgu, in_wdn, in_win, WGU8, WDN8, WIN8, lane); fp8_sub_load(t2, lda); }
              fp8_sub_process(t1, ldb, scr, lane);
          } }
        __syncthreads();
    }
    if (IN(0)) {
        f32x4 wq[8][4];
#pragma unroll
        for (int j = 0; j < 4; ++j)
#pragma unroll
            for (int e = 0; e < 4; ++e) { const float* wp = in_win + (size_t)(4 * lane + 256 * j + e) * INW + 3072; const f32x4 w0 = *(const f32x4*)wp, w1 = *(const f32x4*)(wp + 4);
                wq[0][j][e] = w0[0]; wq[1][j][e] = w0[1]; wq[2][j][e] = w0[2]; wq[3][j][e] = w0[3]; wq[4][j][e] = w1[0]; wq[5][j][e] = w1[1]; wq[6][j][e] = w1[2]; wq[7][j][e] = w1[3]; }
        f32x4 nv[4];
        if (gw < MROWS) {
#pragma unroll
            for (int j = 0; j < 4; ++j) nv[j] = __builtin_nontemporal_load((const f32x4*)(in_x + (size_t)gw * DM + 4 * lane + 256 * j)); }
#pragma unroll 1
        for (int m = gw; m < MROWS; m += NGW) { bf16* ob = XB + (size_t)m * DM; f32x4 v[4];
#pragma unroll
            for (int j = 0; j < 4; ++j) v[j] = nv[j];
            if (m + NGW < MROWS) {
#pragma unroll
                for (int j = 0; j < 4; ++j) nv[j] = __builtin_nontemporal_load((const f32x4*)(in_x + (size_t)(m + NGW) * DM + 4 * lane + 256 * j)); }
#pragma unroll
            for (int j = 0; j < 4; ++j) { v2u w; w.x = pk2(v[j][0], v[j][1]); w.y = pk2(v[j][2], v[j][3]); *(v2u*)(ob + 4 * lane + 256 * j) = w;
                *(unsigned*)(XP8 + (size_t)m * DM + 4 * lane + 256 * j) = pg8::pk4_fp8(v[j][0] * SC_X, v[j][1] * SC_X, v[j][2] * SC_X, v[j][3] * SC_X); }
            row_dt_w(v, wq, DT + (size_t)m * 8, lane); }
    }

    SEAM(0);
    run_layer<0>(args, lo, hi, bar);
    run_layer<1>(args, lo, hi, bar);
#undef IN
#undef SEAM
}

extern "C" void kernel_launch(void* const* d_in, const int* in_sizes, int n_in, void* d_out, int out_size, void* d_ws, size_t ws_size, hipStream_t stream) {
    static int grid = 0;
    if (grid == 0) {
        if (n_in != 20 || out_size != MROWS * DM || ws_size < WS_END) { fprintf(stderr, "kernel_launch: unexpected problem (n_in %d, out %d, ws %zu)\n", n_in, out_size, ws_size); grid = -1; return; }
        if (hipFuncSetAttribute((const void*)mk_fwd, hipFuncAttributeMaxDynamicSharedMemorySize, LDS_BYTES) != hipSuccess) { fprintf(stderr, "kernel_launch: hipFuncSetAttribute failed\n"); grid = -1; return; }
        int dev = 0, cus = 0, per_cu = 0;
        (void)hipGetDevice(&dev); (void)hipDeviceGetAttribute(&cus, hipDeviceAttributeMultiprocessorCount, dev);
        if (hipOccupancyMaxActiveBlocksPerMultiprocessor(&per_cu, (const void*)mk_fwd, NWAVES * 64, LDS_BYTES) != hipSuccess || per_cu < 1) fprintf(stderr, "kernel_launch: occupancy query says %d\n", per_cu);
        (void)hipGetLastError();
        grid = cus > 0 ? cus : 256;
    }
    if (grid < 0) return;
    (void)hipMemsetAsync((char*)d_ws + WS_CTL, 0, CTL_ZERO_BYTES, stream);
    Args a{};
    for (int i = 0; i < 20; ++i) a.in[i] = (const float*)d_in[i];
    a.out = (float*)d_out; a.ws = (unsigned char*)d_ws;
    a.ph_lo = 0; a.ph_hi = N_PHASES; a.sub = 7; a.pad = 0;
    hipLaunchKernelGGL(mk_fwd, dim3(grid), dim3(NWAVES * 64), LDS_BYTES, stream, a);
#ifdef PROBE_PH
#ifndef PROBE_SUB
#define PROBE_SUB 7
#endif
    for (int i = 0; i < PROBE_N; ++i) { a.ph_lo = PROBE_PH; a.ph_hi = PROBE_PH + 1; a.sub = PROBE_SUB; hipLaunchKernelGGL(mk_fwd, dim3(grid), dim3(NWAVES * 64), LDS_BYTES, stream, a); }
#endif
}
```
